# Optimizing an MI355X kernel written in HIP

```python
import math
import jax, jax.numpy as jnp
from jax import lax
import numpy as np

D_MODEL = 1024
BATCH = 8
SEQ = 8192
DEPTH = 1

D_MIX = D_MODEL
RWKV_HEADS = 8
RWKV_HEAD_DIM = 64
D_RWKV = RWKV_HEADS * RWKV_HEAD_DIM
DECAY_RANK = 64
ICLR_RANK = 64
GATE_RANK = 128
D_SHIFT = 3 * D_RWKV + DECAY_RANK + ICLR_RANK + GATE_RANK
S5_GROUP_CH = 16
D_S5 = D_MIX - D_RWKV
S5_GROUPS = D_S5 // S5_GROUP_CH
S5_STATE = 64
D_IN = D_SHIFT + D_S5
N_MEM = 256
XATTN_HEADS = 4
XATTN_HEAD_DIM = D_MODEL // XATTN_HEADS
N_EXPERT_GROUPS = 4
EXPERTS_PER_GROUP = 8
N_EXPERTS = N_EXPERT_GROUPS * EXPERTS_PER_GROUP
EXPERT_TOP_K = 2
D_EXPERT = 512
MOE_BLOCK = 128
RMS_EPS = 1e-6
GN_EPS = 64e-5
L2_EPS = 1e-12

kernel_name = "hybrid_rwkv7_s5_memxattn_hiermoe"


def rmsnorm(x, g):
    xf = x.astype(jnp.float32)
    y = xf * lax.rsqrt(jnp.mean(xf * xf, axis=-1, keepdims=True) + RMS_EPS)
    return (y * g.astype(jnp.float32)).astype(x.dtype)


def token_shift(z, mu):
    prev = jnp.pad(z, ((0, 0), (1, 0), (0, 0)))[:, :-1]
    return z + (prev - z) * mu


def rwkv7_group(p, w0, w_decay_up, a0, w_iclr_up, w_gate_up, k_k, k_a, r_k, ln_w, ln_b):
    bsz, slen = p.shape[0], p.shape[1]
    cuts = [D_RWKV, 2 * D_RWKV, 3 * D_RWKV, 3 * D_RWKV + DECAY_RANK, 3 * D_RWKV + DECAY_RANK + ICLR_RANK]
    r, k, v, dw, da, dg = jnp.split(p, cuts, axis=-1)
    log_w = -jax.nn.softplus(-(w0 + jnp.tanh(dw) @ w_decay_up)) - 0.5
    decay = jnp.exp(-jnp.exp(log_w))
    a = jax.nn.sigmoid(a0 + da @ w_iclr_up)
    g = jax.nn.sigmoid(dg) @ w_gate_up
    hd = lambda t: t.reshape(bsz, slen, RWKV_HEADS, RWKV_HEAD_DIM)
    kk = hd(k * k_k)
    kk = kk / jnp.maximum(jnp.sqrt(jnp.sum(kk * kk, axis=-1, keepdims=True)), L2_EPS)
    k = k * (1.0 + (a - 1.0) * k_a)
    r, k, v, decay, a = hd(r), hd(k), hd(v), hd(decay), hd(a)

    def step(state, inp):
        r_t, w_t, k_t, v_t, kk_t, a_t = inp
        sa = jnp.einsum('bhvk,bhk->bhv', state, -kk_t)
        state = (state * w_t[:, :, None, :]
                 + sa[..., None] * (kk_t * a_t)[:, :, None, :]
                 + v_t[..., None] * k_t[:, :, None, :])
        return state, jnp.einsum('bhvk,bhk->bhv', state, r_t)

    xs = tuple(jnp.moveaxis(t, 1, 0) for t in (r, decay, k, v, kk, a))
    state0 = jnp.zeros((bsz, RWKV_HEADS, RWKV_HEAD_DIM, RWKV_HEAD_DIM), jnp.float32)
    _, y = lax.scan(step, state0, xs)
    y = jnp.moveaxis(y, 0, 1)
    mu = jnp.mean(y, axis=-1, keepdims=True)
    var = jnp.mean(jnp.square(y - mu), axis=-1, keepdims=True)
    y = (y - mu) * lax.rsqrt(var + GN_EPS)
    y = y * ln_w.reshape(RWKV_HEADS, RWKV_HEAD_DIM) + ln_b.reshape(RWKV_HEADS, RWKV_HEAD_DIM)
    y = y + jnp.sum(r * k * r_k, axis=-1, keepdims=True) * v
    return y.reshape(bsz, slen, D_RWKV) * g


def _ssm_combine(e1, e2):
    a1, b1 = e1
    a2, b2 = e2
    return a2 * a1, a2 * b1 + b2


def s5_group(u, lam_re, lam_im, log_dt, b_re, b_im, c_re, c_im, d_skip, w_glu, b_glu):
    bsz, slen = u.shape[0], u.shape[1]
    ug = u.reshape(bsz, slen, S5_GROUPS, S5_GROUP_CH)
    lam = lax.complex(lam_re.astype(jnp.float32), lam_im.astype(jnp.float32))
    dt = jnp.exp(log_dt.astype(jnp.float32))[:, None]
    lam_bar = jnp.exp(lam * dt)
    b = lax.complex(b_re.astype(jnp.float32), b_im.astype(jnp.float32))
    b_bar = ((lam_bar - 1.0) / lam)[..., None] * b
    bu = lax.complex(jnp.einsum('bsgh,gnh->bsgn', ug, jnp.real(b_bar)),
                     jnp.einsum('bsgh,gnh->bsgn', ug, jnp.imag(b_bar)))
    a_elems = jnp.broadcast_to(lam_bar, (1, slen, S5_GROUPS, S5_STATE))
    _, states = lax.associative_scan(_ssm_combine, (a_elems, bu), axis=1)
    y = (jnp.einsum('bsgn,ghn->bsgh', jnp.real(states), c_re)
         - jnp.einsum('bsgn,ghn->bsgh', jnp.imag(states), c_im)
         + d_skip * ug)
    z = jax.nn.gelu(y.reshape(bsz, slen, D_S5))
    return z * jax.nn.sigmoid(z @ w_glu + b_glu)


def memory_cross_attention(h, mem_n, w_q, w_k, w_v, w_o):
    bsz, slen = h.shape[0], h.shape[1]
    q = (h @ w_q).reshape(bsz, slen, XATTN_HEADS, XATTN_HEAD_DIM)
    k = (mem_n @ w_k).reshape(bsz, N_MEM, XATTN_HEADS, XATTN_HEAD_DIM)
    v = (mem_n @ w_v).reshape(bsz, N_MEM, XATTN_HEADS, XATTN_HEAD_DIM)
    s = jnp.einsum('bshd,bmhd->bhsm', q, k).astype(jnp.float32) * (XATTN_HEAD_DIM ** -0.5)
    pr = jax.nn.softmax(s, axis=-1).astype(v.dtype)
    o = jnp.einsum('bhsm,bmhd->bshd', pr, v).reshape(bsz, slen, D_MODEL)
    return o @ w_o


def hierarchical_moe(h, w_rg, b_rg, w_re, b_re, w_gate, w_up, w_down):
    bsz, slen = h.shape[0], h.shape[1]
    hf = h.reshape(-1, D_MODEL)
    n_tok = hf.shape[0]
    logits1 = (hf @ w_rg).astype(jnp.float32) + b_rg
    grp = jnp.argmax(logits1, axis=-1)
    g1 = jnp.take_along_axis(jax.nn.softmax(logits1, axis=-1), grp[:, None], axis=-1)
    logits2 = jnp.einsum('nd,gde->nge', hf, w_re).astype(jnp.float32) + b_re
    logits2 = jnp.take_along_axis(logits2, grp[:, None, None], axis=1)[:, 0]
    top_v, top_i = lax.top_k(logits2, EXPERT_TOP_K)
    gates = g1 * jax.nn.softmax(top_v, axis=-1)
    eid = grp[:, None] * EXPERTS_PER_GROUP + top_i
    n_assign = n_tok * EXPERT_TOP_K
    n_blocks = -(-n_assign // MOE_BLOCK) + N_EXPERTS
    n_slots = n_blocks * MOE_BLOCK
    flat_e = eid.reshape(-1)
    flat_g = gates.reshape(-1)
    flat_tok = jnp.repeat(jnp.arange(n_tok, dtype=jnp.int32), EXPERT_TOP_K)
    order = jnp.argsort(flat_e)
    sorted_e = flat_e[order]
    counts = jnp.bincount(flat_e, length=N_EXPERTS)
    padded = (counts + MOE_BLOCK - 1) // MOE_BLOCK * MOE_BLOCK
    pad_end = jnp.cumsum(padded)
    pad_start = pad_end - padded
    start = jnp.cumsum(counts) - counts
    dest = pad_start[sorted_e] + jnp.arange(n_assign) - start[sorted_e]
    slot_tok = jnp.zeros((n_slots,), jnp.int32).at[dest].set(flat_tok[order])
    slot_gate = jnp.zeros((n_slots,), jnp.float32).at[dest].set(flat_g[order])
    block_start = jnp.arange(n_blocks) * MOE_BLOCK
    block_expert = jnp.minimum(jnp.searchsorted(pad_end, block_start, side='right'), N_EXPERTS - 1)

    def run_block(args):
        tok, gate, e = args
        xb = hf[tok]
        hid = jax.nn.silu(xb @ w_gate[e]) * (xb @ w_up[e])
        return (hid @ w_down[e]) * gate[:, None].astype(xb.dtype)

    y = lax.map(run_block, (slot_tok.reshape(n_blocks, MOE_BLOCK),
                            slot_gate.reshape(n_blocks, MOE_BLOCK), block_expert))
    out = jnp.zeros_like(hf).at[slot_tok].add(y.reshape(n_slots, D_MODEL).astype(hf.dtype))
    return out.reshape(bsz, slen, D_MODEL)


def setup_inputs(seed: int = 0) -> dict:
    key = jax.random.key(seed)
    ks = iter(jax.random.split(key, 48))
    L = DEPTH
    f32 = jnp.float32
    nrm = lambda shape, scale: jax.random.normal(next(ks), shape, f32) * scale
    uni = lambda shape, lo, hi: jax.random.uniform(next(ks), shape, f32, lo, hi)
    gain = lambda shape: 1.0 + nrm(shape, 0.02)
    return {
        "x": nrm((BATCH, SEQ, D_MODEL), 1.0),
        "mem": nrm((BATCH, N_MEM, D_MODEL), 1.0),
        "norm_mix_w": gain((L, D_MODEL)),
        "w_in": nrm((L, D_MODEL, D_IN), D_MODEL ** -0.5),
        "mu_shift": uni((L, D_SHIFT), 0.0, 1.0),
        "w0": uni((L, D_RWKV), -6.0, 1.0),
        "w_decay_up": nrm((L, DECAY_RANK, D_RWKV), 0.5 * DECAY_RANK ** -0.5),
        "a0": uni((L, D_RWKV), -0.5, 0.5),
        "w_iclr_up": nrm((L, ICLR_RANK, D_RWKV), 0.5 * ICLR_RANK ** -0.5),
        "w_gate_up": nrm((L, GATE_RANK, D_RWKV), GATE_RANK ** -0.5),
        "k_k": 0.85 + nrm((L, D_RWKV), 0.02),
        "k_a": gain((L, D_RWKV)),
        "r_k": nrm((L, RWKV_HEADS, RWKV_HEAD_DIM), 0.1),
        "ln_x_w": gain((L, D_RWKV)),
        "ln_x_b": nrm((L, D_RWKV), 0.01),
        "s5_lam_re": -0.5 + nrm((L, S5_GROUPS, S5_STATE), 0.01),
        "s5_lam_im": jnp.pi * jnp.arange(S5_STATE, dtype=f32) + nrm((L, S5_GROUPS, S5_STATE), 0.01),
        "s5_log_dt": uni((L, S5_GROUPS), math.log(1e-3), math.log(1e-1)),
        "s5_b_re": nrm((L, S5_GROUPS, S5_STATE, S5_GROUP_CH), (2 * S5_GROUP_CH) ** -0.5),
        "s5_b_im": nrm((L, S5_GROUPS, S5_STATE, S5_GROUP_CH), (2 * S5_GROUP_CH) ** -0.5),
        "s5_c_re": nrm((L, S5_GROUPS, S5_GROUP_CH, S5_STATE), S5_STATE ** -0.5),
        "s5_c_im": nrm((L, S5_GROUPS, S5_GROUP_CH, S5_STATE), S5_STATE ** -0.5),
        "s5_d": nrm((L, S5_GROUPS, S5_GROUP_CH), 1.0),
        "w_glu": nrm((L, D_S5, D_S5), D_S5 ** -0.5),
        "b_glu": nrm((L, D_S5), 0.01),
        "w_mix_out": nrm((L, D_MIX, D_MODEL), D_MIX ** -0.5),
        "norm_xattn_w": gain((L, D_MODEL)),
        "norm_mem_w": gain((L, D_MODEL)),
        "w_q": nrm((L, D_MODEL, D_MODEL), D_MODEL ** -0.5),
        "w_k": nrm((L, D_MODEL, D_MODEL), D_MODEL ** -0.5),
        "w_v": nrm((L, D_MODEL, D_MODEL), D_MODEL ** -0.5),
        "w_o": nrm((L, D_MODEL, D_MODEL), D_MODEL ** -0.5),
        "norm_moe_w": gain((L, D_MODEL)),
        "w_router_group": nrm((L, D_MODEL, N_EXPERT_GROUPS), D_MODEL ** -0.5),
        "b_router_group": nrm((L, N_EXPERT_GROUPS), 0.01),
        "w_router_expert": nrm((L, N_EXPERT_GROUPS, D_MODEL, EXPERTS_PER_GROUP), D_MODEL ** -0.5),
        "b_router_expert": nrm((L, N_EXPERT_GROUPS, EXPERTS_PER_GROUP), 0.01),
        "w_exp_gate": nrm((L, N_EXPERTS, D_MODEL, D_EXPERT), D_MODEL ** -0.5),
        "w_exp_up": nrm((L, N_EXPERTS, D_MODEL, D_EXPERT), D_MODEL ** -0.5),
        "w_exp_down": nrm((L, N_EXPERTS, D_EXPERT, D_MODEL), D_EXPERT ** -0.5),
        "norm_final_w": gain((D_MODEL,)),
    }


def reference(x, mem, norm_mix_w, w_in, mu_shift, w0, w_decay_up, a0, w_iclr_up, w_gate_up, k_k, k_a,
              r_k, ln_x_w, ln_x_b, s5_lam_re, s5_lam_im, s5_log_dt, s5_b_re, s5_b_im, s5_c_re, s5_c_im,
              s5_d, w_glu, b_glu, w_mix_out, norm_xattn_w, norm_mem_w, w_q, w_k, w_v, w_o, norm_moe_w,
              w_router_group, b_router_group, w_router_expert, b_router_expert, w_exp_gate, w_exp_up,
              w_exp_down, norm_final_w):
    for l in range(DEPTH):
        h = rmsnorm(x, norm_mix_w[l])
        proj = (h @ w_in[l]).astype(jnp.float32)
        p_rwkv = token_shift(proj[..., :D_SHIFT], mu_shift[l])
        u_s5 = proj[..., D_SHIFT:]
        y_rwkv = rwkv7_group(p_rwkv, w0[l], w_decay_up[l], a0[l], w_iclr_up[l], w_gate_up[l],
                             k_k[l], k_a[l], r_k[l], ln_x_w[l], ln_x_b[l])
        y_s5 = s5_group(u_s5, s5_lam_re[l], s5_lam_im[l], s5_log_dt[l], s5_b_re[l], s5_b_im[l],
                        s5_c_re[l], s5_c_im[l], s5_d[l], w_glu[l], b_glu[l])
        y_mix = jnp.concatenate([y_rwkv, y_s5], axis=-1).astype(x.dtype)
        x = x + y_mix @ w_mix_out[l]
        h = rmsnorm(x, norm_xattn_w[l])
        mem_n = rmsnorm(mem, norm_mem_w[l])
        x = x + memory_cross_attention(h, mem_n, w_q[l], w_k[l], w_v[l], w_o[l])
        h = rmsnorm(x, norm_moe_w[l])
        x = x + hierarchical_moe(h, w_router_group[l], b_router_group[l], w_router_expert[l],
                                 b_router_expert[l], w_exp_gate[l], w_exp_up[l], w_exp_down[l])
    return rmsnorm(x, norm_final_w)
```

```cpp
#include <hip/hip_runtime.h>
#include <stdint.h>

namespace {
constexpr int NB = 8, S = 8192, D = 1024, M = NB * S;
constexpr int DR = 512, DSHIFT = 1792, DIN = 2304, NMEM = 256;
constexpr int NEXP = 32, DEXP = 512, NASSIGN = 2 * M;
constexpr size_t MiB = 1u << 20;

typedef unsigned short bf16;
__device__ __forceinline__ bf16 f2bf(float f) { unsigned u = __builtin_bit_cast(unsigned, f); return (bf16)((u + 0x7fffu + ((u >> 16) & 1u)) >> 16); }
__device__ __forceinline__ float bf2f(bf16 h) { return __builtin_bit_cast(float, (unsigned)h << 16); }

template <typename T> __device__ __forceinline__ float ldf(const T* p);
template <> __device__ __forceinline__ float ldf<float>(const float* p) { return *p; }
template <> __device__ __forceinline__ float ldf<bf16>(const bf16* p) { return bf2f(*p); }
template <typename T> __device__ __forceinline__ void stf(T* p, float v);
template <> __device__ __forceinline__ void stf<float>(float* p, float v) { *p = v; }
template <> __device__ __forceinline__ void stf<bf16>(bf16* p, float v) { *p = f2bf(v); }

__device__ __forceinline__ float wave_sum(float v) {
#pragma unroll
    for (int o = 1; o < 64; o <<= 1) v += __shfl_xor(v, o);
    return v;
}
__device__ __forceinline__ float sigmoidf_(float x) { return 1.f / (1.f + __expf(-x)); }

template <typename TO>
__global__ __launch_bounds__(256) void rmsnorm_k(const float* __restrict__ x, const float* __restrict__ w, TO* __restrict__ out, int rows) {
    const int lane = threadIdx.x & 63, wv = threadIdx.x >> 6;
    const int row = blockIdx.x * 4 + wv;
    if (row >= rows) return;
    const float4* xr = (const float4*)(x + (size_t)row * D);
    float4 v[4]; float s = 0.f;
#pragma unroll
    for (int j = 0; j < 4; ++j) { v[j] = xr[lane + 64 * j]; s += v[j].x * v[j].x + v[j].y * v[j].y + v[j].z * v[j].z + v[j].w * v[j].w; }
    s = wave_sum(s);
    const float rs = rsqrtf(s * (1.f / D) + 1e-6f);
#pragma unroll
    for (int j = 0; j < 4; ++j) {
        const int c = (lane + 64 * j) * 4;
        const float4 g = *(const float4*)(w + c);
        TO* o = out + (size_t)row * D + c;
        stf(o + 0, v[j].x * rs * g.x); stf(o + 1, v[j].y * rs * g.y); stf(o + 2, v[j].z * rs * g.z); stf(o + 3, v[j].w * rs * g.w);
    }
}

struct GemmArgs {
    const void* A; long lda; long sAz;
    const float* B; long sbk, sbn; long sBz;
    const float* B2;
    void* C; long ldc; long sCz;
    int M, N, K;
    const float* R; long ldr;
    float scale;
    const int* gather;
    const int* tiles;
    const int* ntiles;
    long sBe;
    const float* rowscale;
    int zdiv;
    long sAz2, sBz2, sCz2;
};
template <typename TA, typename TC, int EPI, bool GROUPED>
__global__ __launch_bounds__(256) void sgemm_k(GemmArgs g) {
    __shared__ float As[16][68];
    __shared__ float Bs[16][68];
    __shared__ float Bs2[(EPI == 3) ? 16 : 1][68];
    const int tid = threadIdx.x, tx = tid & 15, ty = tid >> 4;
    int row0, nrows; const float* B = g.B; const float* B2 = g.B2;
    const TA* A = (const TA*)g.A; TC* C = (TC*)g.C;
    if (GROUPED) {
        if ((int)blockIdx.y >= *g.ntiles) return;
        const int e = g.tiles[3 * blockIdx.y]; row0 = g.tiles[3 * blockIdx.y + 1]; nrows = g.tiles[3 * blockIdx.y + 2];
        B += (size_t)e * g.sBe; if (EPI == 3) B2 += (size_t)e * g.sBe;
    } else {
        row0 = blockIdx.y * 64; nrows = min(64, g.M - row0);
        const int z = blockIdx.z, z1 = z / g.zdiv, z2 = z % g.zdiv;
        A += z1 * g.sAz + z2 * g.sAz2; B += z1 * g.sBz + z2 * g.sBz2; C += z1 * g.sCz + z2 * g.sCz2;
    }
    const int col0 = blockIdx.x * 64;
    const int ar = tid >> 2, ak = (tid & 3) * 4;
    const bool arow_ok = ar < nrows;
    long arow = 0;
    if (arow_ok) arow = g.gather ? (long)g.gather[row0 + ar] : (long)(row0 + ar);
    const TA* ap = A + arow * g.lda + ak;
    const int bk = tid >> 4, bn = (tid & 15) * 4;
    const float* bp = B + (long)bk * g.sbk + (long)(col0 + bn) * g.sbn;
    const float* bp2 = (EPI == 3) ? (B2 + (long)bk * g.sbk + (long)(col0 + bn) * g.sbn) : nullptr;
    float acc[4][4] = {}; float acc2[4][4] = {};
    for (int k0 = 0; k0 < g.K; k0 += 16) {
        float a0 = 0.f, a1 = 0.f, a2 = 0.f, a3 = 0.f;
        if (arow_ok) { a0 = ldf(ap + k0); a1 = ldf(ap + k0 + 1); a2 = ldf(ap + k0 + 2); a3 = ldf(ap + k0 + 3); }
        const float* b = bp + (long)k0 * g.sbk;
        const float b0 = b[0], b1 = b[g.sbn], b2 = b[2 * g.sbn], b3 = b[3 * g.sbn];
        float c0 = 0.f, c1 = 0.f, c2 = 0.f, c3 = 0.f;
        if (EPI == 3) { const float* bb = bp2 + (long)k0 * g.sbk; c0 = bb[0]; c1 = bb[g.sbn]; c2 = bb[2 * g.sbn]; c3 = bb[3 * g.sbn]; }
        __syncthreads();
        As[ak][ar] = a0; As[ak + 1][ar] = a1; As[ak + 2][ar] = a2; As[ak + 3][ar] = a3;
        Bs[bk][bn] = b0; Bs[bk][bn + 1] = b1; Bs[bk][bn + 2] = b2; Bs[bk][bn + 3] = b3;
        if (EPI == 3) { Bs2[bk][bn] = c0; Bs2[bk][bn + 1] = c1; Bs2[bk][bn + 2] = c2; Bs2[bk][bn + 3] = c3; }
        __syncthreads();
#pragma unroll
        for (int k = 0; k < 16; ++k) {
            const float4 av = *(const float4*)&As[k][ty * 4];
            const float4 bv = *(const float4*)&Bs[k][tx * 4];
            const float a[4] = {av.x, av.y, av.z, av.w}, bb[4] = {bv.x, bv.y, bv.z, bv.w};
#pragma unroll
            for (int i = 0; i < 4; ++i)
#pragma unroll
                for (int j = 0; j < 4; ++j) acc[i][j] += a[i] * bb[j];
            if (EPI == 3) {
                const float4 cv = *(const float4*)&Bs2[k][tx * 4];
                const float cc[4] = {cv.x, cv.y, cv.z, cv.w};
#pragma unroll
                for (int i = 0; i < 4; ++i)
#pragma unroll
                    for (int j = 0; j < 4; ++j) acc2[i][j] += a[i] * cc[j];
            }
        }
    }
#pragma unroll
    for (int i = 0; i < 4; ++i) {
        const int r = ty * 4 + i;
        if (r >= nrows) continue;
        const long crow = row0 + r;
#pragma unroll
        for (int j = 0; j < 4; ++j) {
            const int c = col0 + tx * 4 + j;
            float v = acc[i][j];
            if (EPI == 1) v += g.R[crow * g.ldr + c];
            if (EPI == 2) v *= g.scale;
            if (EPI == 3) { const float s = v; v = s * sigmoidf_(s) * acc2[i][j]; }
            if (EPI == 4) v *= g.rowscale[crow];
            stf(C + crow * g.ldc + c, v);
        }
    }
}

struct RwkvBufs { bf16 *R, *Kp, *V, *KK, *Bv, *G; float* LW; float* RK; float* Y; };
__global__ __launch_bounds__(512) void rwkv_prep_k(const float* __restrict__ proj, const float* __restrict__ mu, const float* __restrict__ w0,
                                                   const float* __restrict__ wdec, const float* __restrict__ a0, const float* __restrict__ wiclr,
                                                   const float* __restrict__ wgate, const float* __restrict__ k_k, const float* __restrict__ k_a,
                                                   const float* __restrict__ r_k, RwkvBufs o) {
    __shared__ float lin[256];
    const int m = blockIdx.x, s = m % S, c = threadIdx.x;
    const float* z = proj + (size_t)m * DIN; const float* zp = z - DIN;
    auto shift = [&](int col) { const float zc = z[col]; const float pc = (s > 0) ? zp[col] : 0.f; return zc + (pc - zc) * mu[col]; };
    const float r = shift(c), k = shift(512 + c), v = shift(1024 + c);
    if (c < 256) {
        const float t = shift(1536 + c);
        lin[c] = (c < 64) ? tanhf(t) : (c < 128 ? t : sigmoidf_(t));
    }
    __syncthreads();
    float dec = w0[c], aic = a0[c], gg = 0.f;
#pragma unroll 8
    for (int j = 0; j < 64; ++j) { dec += lin[j] * wdec[j * 512 + c]; aic += lin[64 + j] * wiclr[j * 512 + c]; }
#pragma unroll 8
    for (int j = 0; j < 128; ++j) gg += lin[128 + j] * wgate[j * 512 + c];
    const float nd = -dec;
    const float sp = fmaxf(nd, 0.f) + log1pf(__expf(-fabsf(nd)));
    const float logw = -sp - 0.5f;
    const float lw = -__expf(logw);
    const float a = sigmoidf_(aic);
    float kk = k * k_k[c];
    const float ss = wave_sum(kk * kk);
    kk = kk / fmaxf(sqrtf(ss), 1e-12f);
    const float kp = k * (1.f + (a - 1.f) * k_a[c]);
    const float bv = kk * a;
    const float rk = wave_sum(r * kp * r_k[c]);
    const size_t i = (size_t)m * 512 + c;
    o.R[i] = f2bf(r); o.Kp[i] = f2bf(kp); o.V[i] = f2bf(v); o.KK[i] = f2bf(kk); o.Bv[i] = f2bf(bv); o.G[i] = f2bf(gg); o.LW[i] = lw;
    if ((c & 63) == 0) o.RK[(size_t)m * 8 + (c >> 6)] = rk;
}

__global__ __launch_bounds__(256) void rwkv_scan_k(RwkvBufs o) {
    const int lane = threadIdx.x & 63, wv = threadIdx.x >> 6, j = lane & 15;
    const int row = blockIdx.x * 16 + wv * 4 + (lane >> 4);
    const int bh = row >> 6, vi = row & 63, b = bh >> 3, h = bh & 7;
    float s0 = 0.f, s1 = 0.f, s2 = 0.f, s3 = 0.f;
    size_t idx = (size_t)b * S * 512 + h * 64;
    struct In { uint2 r, kp, kk, bb; float4 lw; bf16 v; };
    auto load = [&](size_t ix) { In q; q.r = *(const uint2*)(o.R + ix + 4 * j); q.kp = *(const uint2*)(o.Kp + ix + 4 * j); q.kk = *(const uint2*)(o.KK + ix + 4 * j);
        q.bb = *(const uint2*)(o.Bv + ix + 4 * j); q.lw = *(const float4*)(o.LW + ix + 4 * j); q.v = o.V[ix + vi]; return q; };
    auto lo = [](unsigned u) { return __builtin_bit_cast(float, u << 16); };
    auto hi = [](unsigned u) { return __builtin_bit_cast(float, u & 0xffff0000u); };
    In cur = load(idx);
    for (int t = 0; t < S; ++t) {
        In nxt = cur;
        if (t + 1 < S) nxt = load(idx + 512);
        const float w0_ = __expf(cur.lw.x), w1_ = __expf(cur.lw.y), w2_ = __expf(cur.lw.z), w3_ = __expf(cur.lw.w);
        float sa = s0 * lo(cur.kk.x) + s1 * hi(cur.kk.x) + s2 * lo(cur.kk.y) + s3 * hi(cur.kk.y);
        sa += __shfl_xor(sa, 1); sa += __shfl_xor(sa, 2); sa += __shfl_xor(sa, 4); sa += __shfl_xor(sa, 8);
        sa = -sa;
        const float vv = bf2f(cur.v);
        s0 = s0 * w0_ + sa * lo(cur.bb.x) + vv * lo(cur.kp.x);
        s1 = s1 * w1_ + sa * hi(cur.bb.x) + vv * hi(cur.kp.x);
        s2 = s2 * w2_ + sa * lo(cur.bb.y) + vv * lo(cur.kp.y);
        s3 = s3 * w3_ + sa * hi(cur.bb.y) + vv * hi(cur.kp.y);
        float y = s0 * lo(cur.r.x) + s1 * hi(cur.r.x) + s2 * lo(cur.r.y) + s3 * hi(cur.r.y);
        y += __shfl_xor(y, 1); y += __shfl_xor(y, 2); y += __shfl_xor(y, 4); y += __shfl_xor(y, 8);
        if (j == 0) o.Y[idx + vi] = y;
        idx += 512; cur = nxt;
    }
}

__global__ __launch_bounds__(512) void rwkv_post_k(RwkvBufs o, const float* __restrict__ lnw, const float* __restrict__ lnb, float* __restrict__ ymix) {
    const int m = blockIdx.x, c = threadIdx.x;
    const size_t i = (size_t)m * 512 + c;
    const float y = o.Y[i];
    const float mean = wave_sum(y) * (1.f / 64.f);
    const float d = y - mean;
    const float var = wave_sum(d * d) * (1.f / 64.f);
    float yn = d * rsqrtf(var + 64e-5f) * lnw[c] + lnb[c];
    yn += o.RK[(size_t)m * 8 + (c >> 6)] * bf2f(o.V[i]);
    ymix[(size_t)m * D + c] = yn * bf2f(o.G[i]);
}

__global__ __launch_bounds__(64) void s5_scan_k(const float* __restrict__ proj, const float* __restrict__ lam_re, const float* __restrict__ lam_im,
                                                const float* __restrict__ log_dt, const float* __restrict__ b_re, const float* __restrict__ b_im,
                                                const float* __restrict__ c_re, const float* __restrict__ c_im, const float* __restrict__ dsk,
                                                float* __restrict__ ys5) {
    const int bg = blockIdx.x, b = bg >> 5, g = bg & 31, n = threadIdx.x;
    const float lr = lam_re[g * 64 + n], li = lam_im[g * 64 + n], dt = __expf(log_dt[g]);
    const float er = __expf(lr * dt); float sn, cs; sincosf(li * dt, &sn, &cs);
    const float lbr = er * cs, lbi = er * sn;
    const float nr = lbr - 1.f, ni = lbi, den = lr * lr + li * li;
    const float cr = (nr * lr + ni * li) / den, ci = (ni * lr - nr * li) / den;
    float Br[16], Bi[16], Cr[16], Ci[16], Dk[16];
#pragma unroll
    for (int h = 0; h < 16; ++h) {
        const float br = b_re[(g * 64 + n) * 16 + h], bi = b_im[(g * 64 + n) * 16 + h];
        Br[h] = cr * br - ci * bi; Bi[h] = cr * bi + ci * br;
        Cr[h] = c_re[(g * 16 + h) * 64 + n]; Ci[h] = c_im[(g * 16 + h) * 64 + n];
        Dk[h] = dsk[g * 16 + h];
    }
    float xr = 0.f, xi = 0.f;
    const float* up = proj + (size_t)b * S * DIN + DSHIFT + g * 16;
    float* yp = ys5 + (size_t)b * S * 512 + g * 16;
    const int hsel = ((n >> 5) & 1) * 8 + ((n >> 4) & 1) * 4 + ((n >> 3) & 1) * 2 + ((n >> 2) & 1);
    for (int t = 0; t < S; ++t) {
        float u[16];
#pragma unroll
        for (int q = 0; q < 4; ++q) { const float4 t4 = *(const float4*)(up + 4 * q); u[4 * q] = t4.x; u[4 * q + 1] = t4.y; u[4 * q + 2] = t4.z; u[4 * q + 3] = t4.w; }
        float bur = 0.f, bui = 0.f;
#pragma unroll
        for (int h = 0; h < 16; ++h) { bur += u[h] * Br[h]; bui += u[h] * Bi[h]; }
        const float nxr = lbr * xr - lbi * xi + bur, nxi = lbr * xi + lbi * xr + bui;
        xr = nxr; xi = nxi;
        float vals[16];
#pragma unroll
        for (int h = 0; h < 16; ++h) vals[h] = Cr[h] * xr - Ci[h] * xi;
#pragma unroll
        for (int i = 0; i < 8; ++i) { const bool up_ = (n & 32) != 0; const float send = up_ ? vals[i] : vals[i + 8]; const float keep = up_ ? vals[i + 8] : vals[i]; vals[i] = keep + __shfl_xor(send, 32); }
#pragma unroll
        for (int i = 0; i < 4; ++i) { const bool up_ = (n & 16) != 0; const float send = up_ ? vals[i] : vals[i + 4]; const float keep = up_ ? vals[i + 4] : vals[i]; vals[i] = keep + __shfl_xor(send, 16); }
#pragma unroll
        for (int i = 0; i < 2; ++i) { const bool up_ = (n & 8) != 0; const float send = up_ ? vals[i] : vals[i + 2]; const float keep = up_ ? vals[i + 2] : vals[i]; vals[i] = keep + __shfl_xor(send, 8); }
        { const bool up_ = (n & 4) != 0; const float send = up_ ? vals[0] : vals[1]; const float keep = up_ ? vals[1] : vals[0]; vals[0] = keep + __shfl_xor(send, 4); }
        float yv = vals[0];
        yv += __shfl_xor(yv, 1); yv += __shfl_xor(yv, 2);
        float usel = 0.f, dsel = 0.f;
#pragma unroll
        for (int h = 0; h < 16; ++h) { if (h == hsel) { usel = u[h]; dsel = Dk[h]; } }
        if ((n & 3) == 0) yp[hsel] = yv + dsel * usel;
        up += DIN; yp += 512;
    }
}

__device__ __forceinline__ float gelu_tanh(float x) { const float t = tanhf(0.7978845608028654f * (x + 0.044715f * x * x * x)); return 0.5f * x * (1.f + t); }
__global__ void gelu_k(const float* __restrict__ in, float* __restrict__ out, size_t n) {
    size_t i = (size_t)blockIdx.x * blockDim.x + threadIdx.x;
    if (i < n) out[i] = gelu_tanh(in[i]);
}
__global__ void glu_k(const float* __restrict__ z, const float* __restrict__ zg, const float* __restrict__ bglu, float* __restrict__ ymix) {
    size_t i = (size_t)blockIdx.x * blockDim.x + threadIdx.x;
    if (i < (size_t)M * 512) { const int c = (int)(i & 511); const size_t m = i >> 9; ymix[m * D + 512 + c] = z[i] * sigmoidf_(zg[i] + bglu[c]); }
}

__global__ __launch_bounds__(256) void softmax256_k(float* __restrict__ sc, size_t rows) {
    const size_t row = (size_t)blockIdx.x * 4 + (threadIdx.x >> 6);
    const int lane = threadIdx.x & 63;
    if (row >= rows) return;
    float4* p = (float4*)(sc + row * 256) + lane;
    float4 v = *p;
    float mx = fmaxf(fmaxf(v.x, v.y), fmaxf(v.z, v.w));
#pragma unroll
    for (int o = 1; o < 64; o <<= 1) mx = fmaxf(mx, __shfl_xor(mx, o));
    v.x = __expf(v.x - mx); v.y = __expf(v.y - mx); v.z = __expf(v.z - mx); v.w = __expf(v.w - mx);
    const float s = wave_sum(v.x + v.y + v.z + v.w), inv = 1.f / s;
    v.x *= inv; v.y *= inv; v.z *= inv; v.w *= inv;
    *p = v;
}

struct MoeBufs { int* tok_e; float* tok_g; int* tok_slot; int* slot_tok; float* slot_gate; int* counts; int* offs; int* cursor; int* tiles; int* ntiles; };
__global__ void moe_zero_k(MoeBufs mb) { if (threadIdx.x < 32) { mb.counts[threadIdx.x] = 0; mb.cursor[threadIdx.x] = 0; } }
__global__ __launch_bounds__(256) void router_k(const float* __restrict__ h, const float* __restrict__ wrg, const float* __restrict__ brg,
                                                const float* __restrict__ wre, const float* __restrict__ bre, MoeBufs mb) {
    const int lane = threadIdx.x & 63, m = blockIdx.x * 4 + (threadIdx.x >> 6);
    const float* hr = h + (size_t)m * D;
    float l1[4] = {0.f, 0.f, 0.f, 0.f};
    for (int k = lane; k < D; k += 64) { const float x = hr[k]; const float4 w = *(const float4*)(wrg + k * 4); l1[0] += x * w.x; l1[1] += x * w.y; l1[2] += x * w.z; l1[3] += x * w.w; }
#pragma unroll
    for (int i = 0; i < 4; ++i) l1[i] = wave_sum(l1[i]) + brg[i];
    int grp = 0; float best = l1[0];
#pragma unroll
    for (int i = 1; i < 4; ++i) if (l1[i] > best) { best = l1[i]; grp = i; }
    float se = 0.f;
#pragma unroll
    for (int i = 0; i < 4; ++i) se += __expf(l1[i] - best);
    const float g1 = 1.f / se;
    float l2[8] = {};
    const float* we = wre + (size_t)grp * D * 8;
    for (int k = lane; k < D; k += 64) { const float x = hr[k]; const float4 w0 = *(const float4*)(we + k * 8), w1 = *(const float4*)(we + k * 8 + 4);
        l2[0] += x * w0.x; l2[1] += x * w0.y; l2[2] += x * w0.z; l2[3] += x * w0.w; l2[4] += x * w1.x; l2[5] += x * w1.y; l2[6] += x * w1.z; l2[7] += x * w1.w; }
#pragma unroll
    for (int i = 0; i < 8; ++i) l2[i] = wave_sum(l2[i]) + bre[grp * 8 + i];
    int i0 = 0; float v0 = l2[0];
#pragma unroll
    for (int i = 1; i < 8; ++i) if (l2[i] > v0) { v0 = l2[i]; i0 = i; }
    int i1 = -1; float v1 = -3.0e38f;
#pragma unroll
    for (int i = 0; i < 8; ++i) if (i != i0 && l2[i] > v1) { v1 = l2[i]; i1 = i; }
    const float e1 = __expf(v1 - v0), inv = 1.f / (1.f + e1);
    if (lane == 0) {
        const int ea = grp * 8 + i0, eb = grp * 8 + i1;
        mb.tok_e[2 * m] = ea; mb.tok_e[2 * m + 1] = eb;
        mb.tok_g[2 * m] = g1 * inv; mb.tok_g[2 * m + 1] = g1 * e1 * inv;
        atomicAdd(&mb.counts[ea], 1); atomicAdd(&mb.counts[eb], 1);
    }
}
__global__ void moe_plan_k(MoeBufs mb) {
    if (threadIdx.x == 0) {
        int off = 0, nt = 0;
        for (int e = 0; e < NEXP; ++e) {
            mb.offs[e] = off; const int c = mb.counts[e];
            for (int r0 = 0; r0 < c; r0 += 64) { mb.tiles[3 * nt] = e; mb.tiles[3 * nt + 1] = off + r0; mb.tiles[3 * nt + 2] = min(64, c - r0); ++nt; }
            off += c;
        }
        *mb.ntiles = nt;
    }
}
__global__ void moe_scatter_k(MoeBufs mb) {
    const int i = blockIdx.x * blockDim.x + threadIdx.x;
    if (i >= NASSIGN) return;
    const int e = mb.tok_e[i];
    const int pos = mb.offs[e] + atomicAdd(&mb.cursor[e], 1);
    mb.slot_tok[pos] = i >> 1; mb.slot_gate[pos] = mb.tok_g[i]; mb.tok_slot[i] = pos;
}
__global__ __launch_bounds__(256) void final_k(float* __restrict__ out, const bf16* __restrict__ yslot, const int* __restrict__ tok_slot, const float* __restrict__ w) {
    const int lane = threadIdx.x & 63, row = blockIdx.x * 4 + (threadIdx.x >> 6);
    float4* xr = (float4*)(out + (size_t)row * D);
    const uint2* ya = (const uint2*)(yslot + (size_t)tok_slot[2 * row] * D);
    const uint2* yb = (const uint2*)(yslot + (size_t)tok_slot[2 * row + 1] * D);
    float4 v[4]; float s = 0.f;
#pragma unroll
    for (int j = 0; j < 4; ++j) {
        v[j] = xr[lane + 64 * j];
        const uint2 a = ya[lane + 64 * j], b = yb[lane + 64 * j];
        v[j].x += bf2f((bf16)(a.x & 0xffff)) + bf2f((bf16)(b.x & 0xffff));
        v[j].y += bf2f((bf16)(a.x >> 16)) + bf2f((bf16)(b.x >> 16));
        v[j].z += bf2f((bf16)(a.y & 0xffff)) + bf2f((bf16)(b.y & 0xffff));
        v[j].w += bf2f((bf16)(a.y >> 16)) + bf2f((bf16)(b.y >> 16));
        s += v[j].x * v[j].x + v[j].y * v[j].y + v[j].z * v[j].z + v[j].w * v[j].w;
    }
    s = wave_sum(s);
    const float rs = rsqrtf(s * (1.f / D) + 1e-6f);
#pragma unroll
    for (int j = 0; j < 4; ++j) {
        const float4 g = *(const float4*)(w + (lane + 64 * j) * 4);
        xr[lane + 64 * j] = make_float4(v[j].x * rs * g.x, v[j].y * rs * g.y, v[j].z * rs * g.z, v[j].w * rs * g.w);
    }
}

template <typename TA, typename TC, int EPI>
void launch_gemm(const GemmArgs& g, int batches, hipStream_t st) {
    dim3 grid(g.N / 64, (g.M + 63) / 64, batches);
    hipLaunchKernelGGL((sgemm_k<TA, TC, EPI, false>), grid, dim3(256), 0, st, g);
}
}

extern "C" void kernel_launch(void* const* d_in, const int* in_sizes, int n_in, void* d_out, int out_size, void* d_ws, size_t ws_size, hipStream_t stream) {
    (void)in_sizes; (void)n_in; (void)out_size; (void)ws_size;
    auto in = [&](int i) { return (const float*)d_in[i]; };
    char* ws = (char*)d_ws; char* dout = (char*)d_out;
    float* out = (float*)d_out;
    float* PROJ = (float*)(ws + 0);
    float* H = (float*)(ws + 576 * MiB);
    hipLaunchKernelGGL(rmsnorm_k<float>, dim3(M / 4), dim3(256), 0, stream, in(0), in(2), H, M);
    { GemmArgs g{}; g.A = H; g.lda = D; g.B = in(3); g.sbk = DIN; g.sbn = 1; g.C = PROJ; g.ldc = DIN; g.M = M; g.N = DIN; g.K = D; g.zdiv = 1;
      launch_gemm<float, float, 0>(g, 1, stream); }
    RwkvBufs rb;
    rb.R = (bf16*)(ws + 576 * MiB); rb.Kp = (bf16*)(ws + 640 * MiB); rb.V = (bf16*)(ws + 704 * MiB); rb.KK = (bf16*)(ws + 768 * MiB); rb.Bv = (bf16*)(ws + 832 * MiB);
    rb.LW = (float*)(ws + 896 * MiB); rb.G = (bf16*)(dout + 0); rb.Y = (float*)(dout + 64 * MiB); rb.RK = (float*)(dout + 192 * MiB);
    hipLaunchKernelGGL(rwkv_prep_k, dim3(M), dim3(512), 0, stream, PROJ, in(4), in(5), in(6), in(7), in(8), in(9), in(10), in(11), in(12), rb);
    hipLaunchKernelGGL(rwkv_scan_k, dim3(NB * 8 * 64 / 16), dim3(256), 0, stream, rb);
    float* YS5 = (float*)(ws + 896 * MiB);
    hipLaunchKernelGGL(s5_scan_k, dim3(NB * 32), dim3(64), 0, stream, PROJ, in(15), in(16), in(17), in(18), in(19), in(20), in(21), in(22), YS5);
    float* YMIX = (float*)(ws + 0);
    hipLaunchKernelGGL(rwkv_post_k, dim3(M), dim3(512), 0, stream, rb, in(13), in(14), YMIX);
    float* Z = (float*)(ws + 256 * MiB); float* ZG = (float*)(ws + 384 * MiB);
    hipLaunchKernelGGL(gelu_k, dim3((M * 512) / 256), dim3(256), 0, stream, YS5, Z, (size_t)M * 512);
    { GemmArgs g{}; g.A = Z; g.lda = 512; g.B = in(23); g.sbk = 512; g.sbn = 1; g.C = ZG; g.ldc = 512; g.M = M; g.N = 512; g.K = 512; g.zdiv = 1;
      launch_gemm<float, float, 0>(g, 1, stream); }
    hipLaunchKernelGGL(glu_k, dim3((M * 512) / 256), dim3(256), 0, stream, Z, ZG, in(24), YMIX);
    { GemmArgs g{}; g.A = YMIX; g.lda = D; g.B = in(25); g.sbk = D; g.sbn = 1; g.C = out; g.ldc = D; g.M = M; g.N = D; g.K = D; g.R = in(0); g.ldr = D; g.zdiv = 1;
      launch_gemm<float, float, 1>(g, 1, stream); }
    float* H2 = (float*)(ws + 576 * MiB);
    float* MEMN = (float*)(ws + 832 * MiB); float* KM = (float*)(ws + 840 * MiB); float* VM = (float*)(ws + 848 * MiB);
    hipLaunchKernelGGL(rmsnorm_k<float>, dim3(M / 4), dim3(256), 0, stream, out, in(26), H2, M);
    hipLaunchKernelGGL(rmsnorm_k<float>, dim3(NB * NMEM / 4), dim3(256), 0, stream, in(1), in(27), MEMN, NB * NMEM);
    { GemmArgs g{}; g.A = MEMN; g.lda = D; g.B = in(29); g.sbk = D; g.sbn = 1; g.C = KM; g.ldc = D; g.M = NB * NMEM; g.N = D; g.K = D; g.zdiv = 1;
      launch_gemm<float, float, 0>(g, 1, stream);
      g.B = in(30); g.C = VM; launch_gemm<float, float, 0>(g, 1, stream); }
    float* Q = (float*)(ws + 0);
    { GemmArgs g{}; g.A = H2; g.lda = D; g.B = in(28); g.sbk = D; g.sbn = 1; g.C = Q; g.ldc = D; g.M = M; g.N = D; g.K = D; g.zdiv = 1;
      launch_gemm<float, float, 0>(g, 1, stream); }
    float* SC = (float*)(ws + 256 * MiB);
    { GemmArgs g{}; g.A = Q; g.lda = D; g.sAz = (long)S * D; g.sAz2 = 256; g.B = KM; g.sbk = 1; g.sbn = D; g.sBz = (long)NMEM * D; g.sBz2 = 256;
      g.C = SC; g.ldc = D; g.sCz = (long)S * D; g.sCz2 = 256; g.M = S; g.N = NMEM; g.K = 256; g.scale = 0.0625f; g.zdiv = 4;
      launch_gemm<float, float, 2>(g, NB * 4, stream); }
    hipLaunchKernelGGL(softmax256_k, dim3(M * 4 / 4), dim3(256), 0, stream, SC, (size_t)M * 4);
    float* O = (float*)(ws + 576 * MiB);
    { GemmArgs g{}; g.A = SC; g.lda = D; g.sAz = (long)S * D; g.sAz2 = 256; g.B = VM; g.sbk = D; g.sbn = 1; g.sBz = (long)NMEM * D; g.sBz2 = 256;
      g.C = O; g.ldc = D; g.sCz = (long)S * D; g.sCz2 = 256; g.M = S; g.N = 256; g.K = NMEM; g.zdiv = 4;
      launch_gemm<float, float, 0>(g, NB * 4, stream); }
    { GemmArgs g{}; g.A = O; g.lda = D; g.B = in(31); g.sbk = D; g.sbn = 1; g.C = out; g.ldc = D; g.M = M; g.N = D; g.K = D; g.R = out; g.ldr = D; g.zdiv = 1;
      launch_gemm<float, float, 1>(g, 1, stream); }
    float* H3 = (float*)(ws + 0);
    hipLaunchKernelGGL(rmsnorm_k<float>, dim3(M / 4), dim3(256), 0, stream, out, in(32), H3, M);
    MoeBufs mb; char* mbase = ws + 856 * MiB;
    mb.tok_e = (int*)(mbase); mb.tok_g = (float*)(mbase + 1 * MiB); mb.tok_slot = (int*)(mbase + 2 * MiB); mb.slot_tok = (int*)(mbase + 3 * MiB);
    mb.slot_gate = (float*)(mbase + 4 * MiB); mb.counts = (int*)(mbase + 5 * MiB); mb.offs = mb.counts + 64; mb.cursor = mb.counts + 128; mb.ntiles = mb.counts + 192;
    mb.tiles = (int*)(mbase + 6 * MiB);
    hipLaunchKernelGGL(moe_zero_k, dim3(1), dim3(64), 0, stream, mb);
    hipLaunchKernelGGL(router_k, dim3(M / 4), dim3(256), 0, stream, H3, in(33), in(34), in(35), in(36), mb);
    hipLaunchKernelGGL(moe_plan_k, dim3(1), dim3(64), 0, stream, mb);
    hipLaunchKernelGGL(moe_scatter_k, dim3(NASSIGN / 256), dim3(256), 0, stream, mb);
    float* HID = (float*)(ws + 256 * MiB);
    const int max_tiles = NASSIGN / 64 + NEXP;
    { GemmArgs g{}; g.A = H3; g.lda = D; g.B = in(37); g.B2 = in(38); g.sbk = DEXP; g.sbn = 1; g.sBe = (long)D * DEXP; g.C = HID; g.ldc = DEXP; g.M = NASSIGN; g.N = DEXP; g.K = D;
      g.gather = mb.slot_tok; g.tiles = mb.tiles; g.ntiles = mb.ntiles; g.zdiv = 1;
      hipLaunchKernelGGL((sgemm_k<float, float, 3, true>), dim3(DEXP / 64, max_tiles, 1), dim3(256), 0, stream, g); }
    bf16* YSLOT = (bf16*)(ws + 576 * MiB);
    { GemmArgs g{}; g.A = HID; g.lda = DEXP; g.B = in(39); g.sbk = D; g.sbn = 1; g.sBe = (long)DEXP * D; g.C = YSLOT; g.ldc = D; g.M = NASSIGN; g.N = D; g.K = DEXP;
      g.tiles = mb.tiles; g.ntiles = mb.ntiles; g.rowscale = mb.slot_gate; g.zdiv = 1;
      hipLaunchKernelGGL((sgemm_k<float, bf16, 4, true>), dim3(D / 64, max_tiles, 1), dim3(256), 0, stream, g); }
    hipLaunchKernelGGL(final_k, dim3(M / 4), dim3(256), 0, stream, out, YSLOT, mb.tok_slot, in(40));
}
```

```cpp
#include <hip/hip_runtime.h>
#include <hip/hip_cooperative_groups.h>
#include <stdint.h>
#include <cstdio>
namespace cg = cooperative_groups;

namespace {
constexpr int NB = 8, S = 8192, D = 1024, M = NB * S;
constexpr int DR = 512, DSHIFT = 1792, DIN = 2304, NMEM = 256;
constexpr int NEXP = 32, DEXP = 512, NASSIGN = 2 * M;
constexpr size_t MiB = 1u << 20;
constexpr int NT = 512;
constexpr int LDS_BYTES = 147456;
#define GB ((int)blockIdx.x)
#define GN ((int)gridDim.x)

typedef unsigned short bf16;
__device__ __forceinline__ bf16 f2bf(float f) { unsigned u = __builtin_bit_cast(unsigned, f); return (bf16)((u + 0x7fffu + ((u >> 16) & 1u)) >> 16); }
__device__ __forceinline__ float bf2f(bf16 h) { return __builtin_bit_cast(float, (unsigned)h << 16); }

template <typename T> __device__ __forceinline__ float ldf(const T* p);
template <> __device__ __forceinline__ float ldf<float>(const float* p) { return *p; }
template <> __device__ __forceinline__ float ldf<bf16>(const bf16* p) { return bf2f(*p); }
template <typename T> __device__ __forceinline__ void stf(T* p, float v);
template <> __device__ __forceinline__ void stf<float>(float* p, float v) { *p = v; }
template <> __device__ __forceinline__ void stf<bf16>(bf16* p, float v) { *p = f2bf(v); }

__device__ __forceinline__ float wave_sum(float v) {
#pragma unroll
    for (int o = 1; o < 64; o <<= 1) v += __shfl_xor(v, o);
    return v;
}
__device__ __forceinline__ float sigmoidf_(float x) { return 1.f / (1.f + __expf(-x)); }

template <typename TO>
__device__ void rmsnorm_ph(const float* __restrict__ x, const float* __restrict__ w, TO* __restrict__ out, int rows) {
    const int lane = threadIdx.x & 63, wv = threadIdx.x >> 6;
    for (int row = GB * 8 + wv; row < rows; row += GN * 8) {
        const float4* xr = (const float4*)(x + (size_t)row * D);
        float4 v[4]; float s = 0.f;
#pragma unroll
        for (int j = 0; j < 4; ++j) { v[j] = xr[lane + 64 * j]; s += v[j].x * v[j].x + v[j].y * v[j].y + v[j].z * v[j].z + v[j].w * v[j].w; }
        s = wave_sum(s);
        const float rs = rsqrtf(s * (1.f / D) + 1e-6f);
#pragma unroll
        for (int j = 0; j < 4; ++j) {
            const int c = (lane + 64 * j) * 4;
            const float4 g = *(const float4*)(w + c);
            TO* o = out + (size_t)row * D + c;
            stf(o + 0, v[j].x * rs * g.x); stf(o + 1, v[j].y * rs * g.y); stf(o + 2, v[j].z * rs * g.z); stf(o + 3, v[j].w * rs * g.w);
        }
    }
}

struct GemmArgs {
    const void* A; long lda; long sAz;
    const float* B; long sbk, sbn; long sBz;
    const float* B2;
    void* C; long ldc; long sCz;
    int M, N, K;
    const float* R; long ldr;
    float scale;
    const int* gather;
    const int* tiles;
    const int* ntiles;
    long sBe;
    const float* rowscale;
    int zdiv, nz;
    long sAz2, sBz2, sCz2;
};
template <typename TA, typename TC, int EPI, bool GROUPED>
__device__ void sgemm_ph(const GemmArgs& g, char* lds) {
    const int half = threadIdx.x >> 8, tid = threadIdx.x & 255, tx = tid & 15, ty = tid >> 4;
    float (*As)[68] = (float (*)[68])(lds + half * 16384);
    float (*Bs)[68] = (float (*)[68])(lds + half * 16384 + 4352);
    float (*Bs2)[68] = (float (*)[68])(lds + half * 16384 + 8704);
    const int ncol = g.N / 64;
    int nrowt, ntot;
    if (GROUPED) { nrowt = *g.ntiles; ntot = nrowt * ncol; }
    else { nrowt = (g.M + 63) / 64; ntot = nrowt * ncol * g.nz; }
    const int npair = (ntot + 1) / 2;
    for (int pr = GB; pr < npair; pr += GN) {
        const int ti = 2 * pr + half;
        const bool valid = ti < ntot;
        int row0 = 0, nrows = 0, col0 = 0; const float* B = g.B; const float* B2 = g.B2;
        const TA* A = (const TA*)g.A; TC* C = (TC*)g.C;
        if (valid) {
            col0 = (ti % ncol) * 64; const int rt = ti / ncol;
            if (GROUPED) {
                const int e = g.tiles[3 * rt]; row0 = g.tiles[3 * rt + 1]; nrows = g.tiles[3 * rt + 2];
                B += (size_t)e * g.sBe; if (EPI == 3) B2 += (size_t)e * g.sBe;
            } else {
                const int z = rt / nrowt, rr = rt % nrowt;
                row0 = rr * 64; nrows = min(64, g.M - row0);
                const int z1 = z / g.zdiv, z2 = z % g.zdiv;
                A += z1 * g.sAz + z2 * g.sAz2; B += z1 * g.sBz + z2 * g.sBz2; C += z1 * g.sCz + z2 * g.sCz2;
            }
        }
        const int ar = tid >> 2, ak = (tid & 3) * 4;
        const bool arow_ok = ar < nrows;
        long arow = 0;
        if (arow_ok) arow = g.gather ? (long)g.gather[row0 + ar] : (long)(row0 + ar);
        const TA* ap = A + arow * g.lda + ak;
        const int bk = tid >> 4, bn = (tid & 15) * 4;
        const float* bp = B + (long)bk * g.sbk + (long)(col0 + bn) * g.sbn;
        const float* bp2 = (EPI == 3) ? (B2 + (long)bk * g.sbk + (long)(col0 + bn) * g.sbn) : nullptr;
        float acc[4][4] = {}; float acc2[4][4] = {};
        for (int k0 = 0; k0 < g.K; k0 += 16) {
            float a0 = 0.f, a1 = 0.f, a2 = 0.f, a3 = 0.f;
            if (arow_ok) { a0 = ldf(ap + k0); a1 = ldf(ap + k0 + 1); a2 = ldf(ap + k0 + 2); a3 = ldf(ap + k0 + 3); }
            float b0 = 0.f, b1 = 0.f, b2 = 0.f, b3 = 0.f, c0 = 0.f, c1 = 0.f, c2 = 0.f, c3 = 0.f;
            if (valid) {
                const float* b = bp + (long)k0 * g.sbk;
                b0 = b[0]; b1 = b[g.sbn]; b2 = b[2 * g.sbn]; b3 = b[3 * g.sbn];
                if (EPI == 3) { const float* bb = bp2 + (long)k0 * g.sbk; c0 = bb[0]; c1 = bb[g.sbn]; c2 = bb[2 * g.sbn]; c3 = bb[3 * g.sbn]; }
            }
            __syncthreads();
            As[ak][ar] = a0; As[ak + 1][ar] = a1; As[ak + 2][ar] = a2; As[ak + 3][ar] = a3;
            Bs[bk][bn] = b0; Bs[bk][bn + 1] = b1; Bs[bk][bn + 2] = b2; Bs[bk][bn + 3] = b3;
            if (EPI == 3) { Bs2[bk][bn] = c0; Bs2[bk][bn + 1] = c1; Bs2[bk][bn + 2] = c2; Bs2[bk][bn + 3] = c3; }
            __syncthreads();
#pragma unroll
            for (int k = 0; k < 16; ++k) {
                const float4 av = *(const float4*)&As[k][ty * 4];
                const float4 bv = *(const float4*)&Bs[k][tx * 4];
                const float a[4] = {av.x, av.y, av.z, av.w}, bb[4] = {bv.x, bv.y, bv.z, bv.w};
#pragma unroll
                for (int i = 0; i < 4; ++i)
#pragma unroll
                    for (int j = 0; j < 4; ++j) acc[i][j] += a[i] * bb[j];
                if (EPI == 3) {
                    const float4 cv = *(const float4*)&Bs2[k][tx * 4];
                    const float cc[4] = {cv.x, cv.y, cv.z, cv.w};
#pragma unroll
                    for (int i = 0; i < 4; ++i)
#pragma unroll
                        for (int j = 0; j < 4; ++j) acc2[i][j] += a[i] * cc[j];
                }
            }
        }
#pragma unroll
        for (int i = 0; i < 4; ++i) {
            const int r = ty * 4 + i;
            if (r >= nrows) continue;
            const long crow = row0 + r;
#pragma unroll
            for (int j = 0; j < 4; ++j) {
                const int c = col0 + tx * 4 + j;
                float v = acc[i][j];
                if (EPI == 1) v += g.R[crow * g.ldr + c];
                if (EPI == 2) v *= g.scale;
                if (EPI == 3) { const float s = v; v = s * sigmoidf_(s) * acc2[i][j]; }
                if (EPI == 4) v *= g.rowscale[crow];
                stf(C + crow * g.ldc + c, v);
            }
        }
    }
}

struct RwkvBufs { bf16 *R, *Kp, *V, *KK, *Bv, *G; float* LW; float* RK; float* Y; };
__device__ void rwkv_prep_ph(const float* __restrict__ proj, const float* __restrict__ mu, const float* __restrict__ w0,
                             const float* __restrict__ wdec, const float* __restrict__ a0, const float* __restrict__ wiclr,
                             const float* __restrict__ wgate, const float* __restrict__ k_k, const float* __restrict__ k_a,
                             const float* __restrict__ r_k, const RwkvBufs& o, char* lds) {
    float* lin = (float*)lds;
    const int c = threadIdx.x;
    for (int m = GB; m < M; m += GN) {
        const int s = m % S;
        const float* z = proj + (size_t)m * DIN; const float* zp = z - DIN;
        auto shift = [&](int col) { const float zc = z[col]; const float pc = (s > 0) ? zp[col] : 0.f; return zc + (pc - zc) * mu[col]; };
        const float r = shift(c), k = shift(512 + c), v = shift(1024 + c);
        __syncthreads();
        if (c < 256) {
            const float t = shift(1536 + c);
            lin[c] = (c < 64) ? tanhf(t) : (c < 128 ? t : sigmoidf_(t));
        }
        __syncthreads();
        float dec = w0[c], aic = a0[c], gg = 0.f;
#pragma unroll 8
        for (int j = 0; j < 64; ++j) { dec += lin[j] * wdec[j * 512 + c]; aic += lin[64 + j] * wiclr[j * 512 + c]; }
#pragma unroll 8
        for (int j = 0; j < 128; ++j) gg += lin[128 + j] * wgate[j * 512 + c];
        const float nd = -dec;
        const float sp = fmaxf(nd, 0.f) + log1pf(__expf(-fabsf(nd)));
        const float logw = -sp - 0.5f;
        const float lw = -__expf(logw);
        const float a = sigmoidf_(aic);
        float kk = k * k_k[c];
        const float ss = wave_sum(kk * kk);
        kk = kk / fmaxf(sqrtf(ss), 1e-12f);
        const float kp = k * (1.f + (a - 1.f) * k_a[c]);
        const float bv = kk * a;
        const float rk = wave_sum(r * kp * r_k[c]);
        const size_t i = (size_t)m * 512 + c;
        o.R[i] = f2bf(r); o.Kp[i] = f2bf(kp); o.V[i] = f2bf(v); o.KK[i] = f2bf(kk); o.Bv[i] = f2bf(bv); o.G[i] = f2bf(gg); o.LW[i] = lw;
        if ((c & 63) == 0) o.RK[(size_t)m * 8 + (c >> 6)] = rk;
    }
}

__device__ void rwkv_scan_ph(const RwkvBufs& o) {
    const int lane = threadIdx.x & 63, wv = threadIdx.x >> 6, j = lane & 15;
    for (int item = GB + GN * wv; item < NB * 8 * 64 / 4; item += GN * 8) {
        const int row = item * 4 + (lane >> 4);
        const int bh = row >> 6, vi = row & 63, b = bh >> 3, h = bh & 7;
        float s0 = 0.f, s1 = 0.f, s2 = 0.f, s3 = 0.f;
        size_t idx = (size_t)b * S * 512 + h * 64;
        struct In { uint2 r, kp, kk, bb; float4 lw; bf16 v; };
        auto load = [&](size_t ix) { In q; q.r = *(const uint2*)(o.R + ix + 4 * j); q.kp = *(const uint2*)(o.Kp + ix + 4 * j); q.kk = *(const uint2*)(o.KK + ix + 4 * j);
            q.bb = *(const uint2*)(o.Bv + ix + 4 * j); q.lw = *(const float4*)(o.LW + ix + 4 * j); q.v = o.V[ix + vi]; return q; };
        auto lo = [](unsigned u) { return __builtin_bit_cast(float, u << 16); };
        auto hi = [](unsigned u) { return __builtin_bit_cast(float, u & 0xffff0000u); };
        In cur = load(idx);
        for (int t = 0; t < S; ++t) {
            In nxt = cur;
            if (t + 1 < S) nxt = load(idx + 512);
            const float w0_ = __expf(cur.lw.x), w1_ = __expf(cur.lw.y), w2_ = __expf(cur.lw.z), w3_ = __expf(cur.lw.w);
            float sa = s0 * lo(cur.kk.x) + s1 * hi(cur.kk.x) + s2 * lo(cur.kk.y) + s3 * hi(cur.kk.y);
            sa += __shfl_xor(sa, 1); sa += __shfl_xor(sa, 2); sa += __shfl_xor(sa, 4); sa += __shfl_xor(sa, 8);
            sa = -sa;
            const float vv = bf2f(cur.v);
            s0 = s0 * w0_ + sa * lo(cur.bb.x) + vv * lo(cur.kp.x);
            s1 = s1 * w1_ + sa * hi(cur.bb.x) + vv * hi(cur.kp.x);
            s2 = s2 * w2_ + sa * lo(cur.bb.y) + vv * lo(cur.kp.y);
            s3 = s3 * w3_ + sa * hi(cur.bb.y) + vv * hi(cur.kp.y);
            float y = s0 * lo(cur.r.x) + s1 * hi(cur.r.x) + s2 * lo(cur.r.y) + s3 * hi(cur.r.y);
            y += __shfl_xor(y, 1); y += __shfl_xor(y, 2); y += __shfl_xor(y, 4); y += __shfl_xor(y, 8);
            if (j == 0) o.Y[idx + vi] = y;
            idx += 512; cur = nxt;
        }
    }
}

__device__ void rwkv_post_ph(const RwkvBufs& o, const float* __restrict__ lnw, const float* __restrict__ lnb, float* __restrict__ ymix) {
    const int c = threadIdx.x;
    for (int m = GB; m < M; m += GN) {
        const size_t i = (size_t)m * 512 + c;
        const float y = o.Y[i];
        const float mean = wave_sum(y) * (1.f / 64.f);
        const float d = y - mean;
        const float var = wave_sum(d * d) * (1.f / 64.f);
        float yn = d * rsqrtf(var + 64e-5f) * lnw[c] + lnb[c];
        yn += o.RK[(size_t)m * 8 + (c >> 6)] * bf2f(o.V[i]);
        ymix[(size_t)m * D + c] = yn * bf2f(o.G[i]);
    }
}

__device__ void s5_scan_ph(const float* __restrict__ proj, const float* __restrict__ lam_re, const float* __restrict__ lam_im,
                           const float* __restrict__ log_dt, const float* __restrict__ b_re, const float* __restrict__ b_im,
                           const float* __restrict__ c_re, const float* __restrict__ c_im, const float* __restrict__ dsk,
                           float* __restrict__ ys5) {
    const int n = threadIdx.x & 63, wv = threadIdx.x >> 6;
    for (int bg = GB + GN * wv; bg < NB * 32; bg += GN * 8) {
        const int b = bg >> 5, g = bg & 31;
        const float lr = lam_re[g * 64 + n], li = lam_im[g * 64 + n], dt = __expf(log_dt[g]);
        const float er = __expf(lr * dt); float sn, cs; sincosf(li * dt, &sn, &cs);
        const float lbr = er * cs, lbi = er * sn;
        const float nr = lbr - 1.f, ni = lbi, den = lr * lr + li * li;
        const float cr = (nr * lr + ni * li) / den, ci = (ni * lr - nr * li) / den;
        float Br[16], Bi[16], Cr[16], Ci[16], Dk[16];
#pragma unroll
        for (int h = 0; h < 16; ++h) {
            const float br = b_re[(g * 64 + n) * 16 + h], bi = b_im[(g * 64 + n) * 16 + h];
            Br[h] = cr * br - ci * bi; Bi[h] = cr * bi + ci * br;
            Cr[h] = c_re[(g * 16 + h) * 64 + n]; Ci[h] = c_im[(g * 16 + h) * 64 + n];
            Dk[h] = dsk[g * 16 + h];
        }
        float xr = 0.f, xi = 0.f;
        const float* up = proj + (size_t)b * S * DIN + DSHIFT + g * 16;
        float* yp = ys5 + (size_t)b * S * 512 + g * 16;
        const int hsel = ((n >> 5) & 1) * 8 + ((n >> 4) & 1) * 4 + ((n >> 3) & 1) * 2 + ((n >> 2) & 1);
        for (int t = 0; t < S; ++t) {
            float u[16];
#pragma unroll
            for (int q = 0; q < 4; ++q) { const float4 t4 = *(const float4*)(up + 4 * q); u[4 * q] = t4.x; u[4 * q + 1] = t4.y; u[4 * q + 2] = t4.z; u[4 * q + 3] = t4.w; }
            float bur = 0.f, bui = 0.f;
#pragma unroll
            for (int h = 0; h < 16; ++h) { bur += u[h] * Br[h]; bui += u[h] * Bi[h]; }
            const float nxr = lbr * xr - lbi * xi + bur, nxi = lbr * xi + lbi * xr + bui;
            xr = nxr; xi = nxi;
            float vals[16];
#pragma unroll
            for (int h = 0; h < 16; ++h) vals[h] = Cr[h] * xr - Ci[h] * xi;
#pragma unroll
            for (int i = 0; i < 8; ++i) { const bool up_ = (n & 32) != 0; const float send = up_ ? vals[i] : vals[i + 8]; const float keep = up_ ? vals[i + 8] : vals[i]; vals[i] = keep + __shfl_xor(send, 32); }
#pragma unroll
            for (int i = 0; i < 4; ++i) { const bool up_ = (n & 16) != 0; const float send = up_ ? vals[i] : vals[i + 4]; const float keep = up_ ? vals[i + 4] : vals[i]; vals[i] = keep + __shfl_xor(send, 16); }
#pragma unroll
            for (int i = 0; i < 2; ++i) { const bool up_ = (n & 8) != 0; const float send = up_ ? vals[i] : vals[i + 2]; const float keep = up_ ? vals[i + 2] : vals[i]; vals[i] = keep + __shfl_xor(send, 8); }
            { const bool up_ = (n & 4) != 0; const float send = up_ ? vals[0] : vals[1]; const float keep = up_ ? vals[1] : vals[0]; vals[0] = keep + __shfl_xor(send, 4); }
            float yv = vals[0];
            yv += __shfl_xor(yv, 1); yv += __shfl_xor(yv, 2);
            float usel = 0.f, dsel = 0.f;
#pragma unroll
            for (int h = 0; h < 16; ++h) { if (h == hsel) { usel = u[h]; dsel = Dk[h]; } }
            if ((n & 3) == 0) yp[hsel] = yv + dsel * usel;
            up += DIN; yp += 512;
        }
    }
}

__device__ __forceinline__ float gelu_tanh(float x) { const float t = tanhf(0.7978845608028654f * (x + 0.044715f * x * x * x)); return 0.5f * x * (1.f + t); }
__device__ void gelu_ph(const float* __restrict__ in, float* __restrict__ out, size_t n) {
    for (size_t i = (size_t)GB * NT + threadIdx.x; i < n; i += (size_t)GN * NT) out[i] = gelu_tanh(in[i]);
}
__device__ void glu_ph(const float* __restrict__ z, const float* __restrict__ zg, const float* __restrict__ bglu, float* __restrict__ ymix) {
    for (size_t i = (size_t)GB * NT + threadIdx.x; i < (size_t)M * 512; i += (size_t)GN * NT) {
        const int c = (int)(i & 511); const size_t m = i >> 9; ymix[m * D + 512 + c] = z[i] * sigmoidf_(zg[i] + bglu[c]);
    }
}

__device__ void softmax256_ph(float* __restrict__ sc, size_t rows) {
    const int lane = threadIdx.x & 63, wv = threadIdx.x >> 6;
    for (size_t row = (size_t)GB * 8 + wv; row < rows; row += (size_t)GN * 8) {
        float4* p = (float4*)(sc + row * 256) + lane;
        float4 v = *p;
        float mx = fmaxf(fmaxf(v.x, v.y), fmaxf(v.z, v.w));
#pragma unroll
        for (int o = 1; o < 64; o <<= 1) mx = fmaxf(mx, __shfl_xor(mx, o));
        v.x = __expf(v.x - mx); v.y = __expf(v.y - mx); v.z = __expf(v.z - mx); v.w = __expf(v.w - mx);
        const float s = wave_sum(v.x + v.y + v.z + v.w), inv = 1.f / s;
        v.x *= inv; v.y *= inv; v.z *= inv; v.w *= inv;
        *p = v;
    }
}

struct MoeBufs { int* tok_e; float* tok_g; int* tok_slot; int* slot_tok; float* slot_gate; int* counts; int* offs; int* cursor; int* tiles; int* ntiles; };
__device__ void moe_zero_ph(const MoeBufs& mb) { if (GB == 0 && threadIdx.x < 32) { mb.counts[threadIdx.x] = 0; mb.cursor[threadIdx.x] = 0; } }
__device__ void router_ph(const float* __restrict__ h, const float* __restrict__ wrg, const float* __restrict__ brg,
                          const float* __restrict__ wre, const float* __restrict__ bre, const MoeBufs& mb) {
    const int lane = threadIdx.x & 63, wv = threadIdx.x >> 6;
    for (int m = GB * 8 + wv; m < M; m += GN * 8) {
        const float* hr = h + (size_t)m * D;
        float l1[4] = {0.f, 0.f, 0.f, 0.f};
        for (int k = lane; k < D; k += 64) { const float x = hr[k]; const float4 w = *(const float4*)(wrg + k * 4); l1[0] += x * w.x; l1[1] += x * w.y; l1[2] += x * w.z; l1[3] += x * w.w; }
#pragma unroll
        for (int i = 0; i < 4; ++i) l1[i] = wave_sum(l1[i]) + brg[i];
        int grp = 0; float best = l1[0];
#pragma unroll
        for (int i = 1; i < 4; ++i) if (l1[i] > best) { best = l1[i]; grp = i; }
        float se = 0.f;
#pragma unroll
        for (int i = 0; i < 4; ++i) se += __expf(l1[i] - best);
        const float g1 = 1.f / se;
        float l2[8] = {};
        const float* we = wre + (size_t)grp * D * 8;
        for (int k = lane; k < D; k += 64) { const float x = hr[k]; const float4 w0 = *(const float4*)(we + k * 8), w1 = *(const float4*)(we + k * 8 + 4);
            l2[0] += x * w0.x; l2[1] += x * w0.y; l2[2] += x * w0.z; l2[3] += x * w0.w; l2[4] += x * w1.x; l2[5] += x * w1.y; l2[6] += x * w1.z; l2[7] += x * w1.w; }
#pragma unroll
        for (int i = 0; i < 8; ++i) l2[i] = wave_sum(l2[i]) + bre[grp * 8 + i];
        int i0 = 0; float v0 = l2[0];
#pragma unroll
        for (int i = 1; i < 8; ++i) if (l2[i] > v0) { v0 = l2[i]; i0 = i; }
        int i1 = -1; float v1 = -3.0e38f;
#pragma unroll
        for (int i = 0; i < 8; ++i) if (i != i0 && l2[i] > v1) { v1 = l2[i]; i1 = i; }
        const float e1 = __expf(v1 - v0), inv = 1.f / (1.f + e1);
        if (lane == 0) {
            const int ea = grp * 8 + i0, eb = grp * 8 + i1;
            mb.tok_e[2 * m] = ea; mb.tok_e[2 * m + 1] = eb;
            mb.tok_g[2 * m] = g1 * inv; mb.tok_g[2 * m + 1] = g1 * e1 * inv;
            atomicAdd(&mb.counts[ea], 1); atomicAdd(&mb.counts[eb], 1);
        }
    }
}
__device__ void moe_plan_ph(const MoeBufs& mb) {
    if (GB == 0 && threadIdx.x == 0) {
        int off = 0, nt = 0;
        for (int e = 0; e < NEXP; ++e) {
            mb.offs[e] = off; const int c = mb.counts[e];
            for (int r0 = 0; r0 < c; r0 += 64) { mb.tiles[3 * nt] = e; mb.tiles[3 * nt + 1] = off + r0; mb.tiles[3 * nt + 2] = min(64, c - r0); ++nt; }
            off += c;
        }
        *mb.ntiles = nt;
    }
}
__device__ void moe_scatter_ph(const MoeBufs& mb) {
    for (int i = GB * NT + threadIdx.x; i < NASSIGN; i += GN * NT) {
        const int e = mb.tok_e[i];
        const int pos = mb.offs[e] + atomicAdd(&mb.cursor[e], 1);
        mb.slot_tok[pos] = i >> 1; mb.slot_gate[pos] = mb.tok_g[i]; mb.tok_slot[i] = pos;
    }
}
__device__ void final_ph(float* __restrict__ out, const bf16* __restrict__ yslot, const int* __restrict__ tok_slot, const float* __restrict__ w) {
    const int lane = threadIdx.x & 63, wv = threadIdx.x >> 6;
    for (int row = GB * 8 + wv; row < M; row += GN * 8) {
        float4* xr = (float4*)(out + (size_t)row * D);
        const uint2* ya = (const uint2*)(yslot + (size_t)tok_slot[2 * row] * D);
        const uint2* yb = (const uint2*)(yslot + (size_t)tok_slot[2 * row + 1] * D);
        float4 v[4]; float s = 0.f;
#pragma unroll
        for (int j = 0; j < 4; ++j) {
            v[j] = xr[lane + 64 * j];
            const uint2 a = ya[lane + 64 * j], b = yb[lane + 64 * j];
            v[j].x += bf2f((bf16)(a.x & 0xffff)) + bf2f((bf16)(b.x & 0xffff));
            v[j].y += bf2f((bf16)(a.x >> 16)) + bf2f((bf16)(b.x >> 16));
            v[j].z += bf2f((bf16)(a.y & 0xffff)) + bf2f((bf16)(b.y & 0xffff));
            v[j].w += bf2f((bf16)(a.y >> 16)) + bf2f((bf16)(b.y >> 16));
            s += v[j].x * v[j].x + v[j].y * v[j].y + v[j].z * v[j].z + v[j].w * v[j].w;
        }
        s = wave_sum(s);
        const float rs = rsqrtf(s * (1.f / D) + 1e-6f);
#pragma unroll
        for (int j = 0; j < 4; ++j) {
            const float4 g = *(const float4*)(w + (lane + 64 * j) * 4);
            xr[lane + 64 * j] = make_float4(v[j].x * rs * g.x, v[j].y * rs * g.y, v[j].z * rs * g.z, v[j].w * rs * g.w);
        }
    }
}

struct Params { const float* in[41]; float* out; char* ws; };

__global__ void __launch_bounds__(NT) fwd_kernel(Params p) {
    extern __shared__ __attribute__((aligned(16))) char lds[];
    cg::grid_group grid = cg::this_grid();
    char* ws = p.ws; char* dout = (char*)p.out; float* out = p.out;
#define IN(i) (p.in[i])
#define SYNC() grid.sync()
    float* PROJ = (float*)(ws + 0);
    float* H = (float*)(ws + 576 * MiB);
    rmsnorm_ph<float>(IN(0), IN(2), H, M);
    SYNC();
    { GemmArgs g{}; g.A = H; g.lda = D; g.B = IN(3); g.sbk = DIN; g.sbn = 1; g.C = PROJ; g.ldc = DIN; g.M = M; g.N = DIN; g.K = D; g.zdiv = 1; g.nz = 1;
      sgemm_ph<float, float, 0, false>(g, lds); }
    SYNC();
    RwkvBufs rb;
    rb.R = (bf16*)(ws + 576 * MiB); rb.Kp = (bf16*)(ws + 640 * MiB); rb.V = (bf16*)(ws + 704 * MiB); rb.KK = (bf16*)(ws + 768 * MiB); rb.Bv = (bf16*)(ws + 832 * MiB);
    rb.LW = (float*)(ws + 896 * MiB); rb.G = (bf16*)(dout + 0); rb.Y = (float*)(dout + 64 * MiB); rb.RK = (float*)(dout + 192 * MiB);
    rwkv_prep_ph(PROJ, IN(4), IN(5), IN(6), IN(7), IN(8), IN(9), IN(10), IN(11), IN(12), rb, lds);
    SYNC();
    rwkv_scan_ph(rb);
    SYNC();
    float* YS5 = (float*)(ws + 896 * MiB);
    s5_scan_ph(PROJ, IN(15), IN(16), IN(17), IN(18), IN(19), IN(20), IN(21), IN(22), YS5);
    SYNC();
    float* YMIX = (float*)(ws + 0);
    rwkv_post_ph(rb, IN(13), IN(14), YMIX);
    float* Z = (float*)(ws + 256 * MiB); float* ZG = (float*)(ws + 384 * MiB);
    gelu_ph(YS5, Z, (size_t)M * 512);
    SYNC();
    { GemmArgs g{}; g.A = Z; g.lda = 512; g.B = IN(23); g.sbk = 512; g.sbn = 1; g.C = ZG; g.ldc = 512; g.M = M; g.N = 512; g.K = 512; g.zdiv = 1; g.nz = 1;
      sgemm_ph<float, float, 0, false>(g, lds); }
    SYNC();
    glu_ph(Z, ZG, IN(24), YMIX);
    SYNC();
    { GemmArgs g{}; g.A = YMIX; g.lda = D; g.B = IN(25); g.sbk = D; g.sbn = 1; g.C = out; g.ldc = D; g.M = M; g.N = D; g.K = D; g.R = IN(0); g.ldr = D; g.zdiv = 1; g.nz = 1;
      sgemm_ph<float, float, 1, false>(g, lds); }
    SYNC();
    float* H2 = (float*)(ws + 576 * MiB);
    float* MEMN = (float*)(ws + 832 * MiB); float* KM = (float*)(ws + 840 * MiB); float* VM = (float*)(ws + 848 * MiB);
    rmsnorm_ph<float>(out, IN(26), H2, M);
    rmsnorm_ph<float>(IN(1), IN(27), MEMN, NB * NMEM);
    SYNC();
    { GemmArgs g{}; g.A = MEMN; g.lda = D; g.B = IN(29); g.sbk = D; g.sbn = 1; g.C = KM; g.ldc = D; g.M = NB * NMEM; g.N = D; g.K = D; g.zdiv = 1; g.nz = 1;
      sgemm_ph<float, float, 0, false>(g, lds);
      g.B = IN(30); g.C = VM; sgemm_ph<float, float, 0, false>(g, lds); }
    float* Q = (float*)(ws + 0);
    { GemmArgs g{}; g.A = H2; g.lda = D; g.B = IN(28); g.sbk = D; g.sbn = 1; g.C = Q; g.ldc = D; g.M = M; g.N = D; g.K = D; g.zdiv = 1; g.nz = 1;
      sgemm_ph<float, float, 0, false>(g, lds); }
    SYNC();
    float* SC = (float*)(ws + 256 * MiB);
    { GemmArgs g{}; g.A = Q; g.lda = D; g.sAz = (long)S * D; g.sAz2 = 256; g.B = KM; g.sbk = 1; g.sbn = D; g.sBz = (long)NMEM * D; g.sBz2 = 256;
      g.C = SC; g.ldc = D; g.sCz = (long)S * D; g.sCz2 = 256; g.M = S; g.N = NMEM; g.K = 256; g.scale = 0.0625f; g.zdiv = 4; g.nz = NB * 4;
      sgemm_ph<float, float, 2, false>(g, lds); }
    SYNC();
    softmax256_ph(SC, (size_t)M * 4);
    SYNC();
    float* O = (float*)(ws + 576 * MiB);
    { GemmArgs g{}; g.A = SC; g.lda = D; g.sAz = (long)S * D; g.sAz2 = 256; g.B = VM; g.sbk = D; g.sbn = 1; g.sBz = (long)NMEM * D; g.sBz2 = 256;
      g.C = O; g.ldc = D; g.sCz = (long)S * D; g.sCz2 = 256; g.M = S; g.N = 256; g.K = NMEM; g.zdiv = 4; g.nz = NB * 4;
      sgemm_ph<float, float, 0, false>(g, lds); }
    SYNC();
    { GemmArgs g{}; g.A = O; g.lda = D; g.B = IN(31); g.sbk = D; g.sbn = 1; g.C = out; g.ldc = D; g.M = M; g.N = D; g.K = D; g.R = out; g.ldr = D; g.zdiv = 1; g.nz = 1;
      sgemm_ph<float, float, 1, false>(g, lds); }
    SYNC();
    float* H3 = (float*)(ws + 0);
    MoeBufs mb; char* mbase = ws + 856 * MiB;
    mb.tok_e = (int*)(mbase); mb.tok_g = (float*)(mbase + 1 * MiB); mb.tok_slot = (int*)(mbase + 2 * MiB); mb.slot_tok = (int*)(mbase + 3 * MiB);
    mb.slot_gate = (float*)(mbase + 4 * MiB); mb.counts = (int*)(mbase + 5 * MiB); mb.offs = mb.counts + 64; mb.cursor = mb.counts + 128; mb.ntiles = mb.counts + 192;
    mb.tiles = (int*)(mbase + 6 * MiB);
    rmsnorm_ph<float>(out, IN(32), H3, M);
    moe_zero_ph(mb);
    SYNC();
    router_ph(H3, IN(33), IN(34), IN(35), IN(36), mb);
    SYNC();
    moe_plan_ph(mb);
    SYNC();
    moe_scatter_ph(mb);
    SYNC();
    float* HID = (float*)(ws + 256 * MiB);
    { GemmArgs g{}; g.A = H3; g.lda = D; g.B = IN(37); g.B2 = IN(38); g.sbk = DEXP; g.sbn = 1; g.sBe = (long)D * DEXP; g.C = HID; g.ldc = DEXP; g.M = NASSIGN; g.N = DEXP; g.K = D;
      g.gather = mb.slot_tok; g.tiles = mb.tiles; g.ntiles = mb.ntiles; g.zdiv = 1; g.nz = 1;
      sgemm_ph<float, float, 3, true>(g, lds); }
    SYNC();
    bf16* YSLOT = (bf16*)(ws + 576 * MiB);
    { GemmArgs g{}; g.A = HID; g.lda = DEXP; g.B = IN(39); g.sbk = D; g.sbn = 1; g.sBe = (long)DEXP * D; g.C = YSLOT; g.ldc = D; g.M = NASSIGN; g.N = D; g.K = DEXP;
      g.tiles = mb.tiles; g.ntiles = mb.ntiles; g.rowscale = mb.slot_gate; g.zdiv = 1; g.nz = 1;
      sgemm_ph<float, bf16, 4, true>(g, lds); }
    SYNC();
    final_ph(out, YSLOT, mb.tok_slot, IN(40));
}
}

extern "C" void kernel_launch(void* const* d_in, const int* in_sizes, int n_in, void* d_out, int out_size, void* d_ws, size_t ws_size, hipStream_t stream) {
    (void)in_sizes; (void)out_size; (void)ws_size;
    static int grid = 0;
    if (grid == 0) {
        int dev = 0, cus = 0, per_cu = 0;
        hipGetDevice(&dev);
        hipDeviceGetAttribute(&cus, hipDeviceAttributeMultiprocessorCount, dev);
        hipFuncSetAttribute((const void*)fwd_kernel, hipFuncAttributeMaxDynamicSharedMemorySize, LDS_BYTES);
        hipOccupancyMaxActiveBlocksPerMultiprocessor(&per_cu, (const void*)fwd_kernel, NT, LDS_BYTES);
        if (per_cu < 1) { fprintf(stderr, "occupancy query says %d blocks/CU\n", per_cu); per_cu = 1; }
        grid = cus * 1;
    }
    Params p{};
    for (int i = 0; i < 41 && i < n_in; ++i) p.in[i] = (const float*)d_in[i];
    p.out = (float*)d_out; p.ws = (char*)d_ws;
    void* args[] = {&p};
    hipError_t e = hipLaunchCooperativeKernel((const void*)fwd_kernel, dim3(grid), dim3(NT), args, LDS_BYTES, stream);
    if (e != hipSuccess) fprintf(stderr, "cooperative launch failed: %s (grid %d)\n", hipGetErrorString(e), grid);
}
```

```cpp
#include <hip/hip_runtime.h>
#include <hip/hip_cooperative_groups.h>
#include <stdint.h>
#include <cstdio>
namespace cg = cooperative_groups;

namespace {
constexpr int NB = 8, S = 8192, D = 1024, M = NB * S;
constexpr int DR = 512, DSHIFT = 1792, DIN = 2304, NMEM = 256;
constexpr int NEXP = 32, DEXP = 512, NASSIGN = 2 * M;
constexpr size_t MiB = 1u << 20;
constexpr int NT = 512;
constexpr int S5L = 32, S5R = M / S5L;
constexpr int LDS_BYTES = 147456;
#define GB ((int)blockIdx.x)
#define GN ((int)gridDim.x)

typedef unsigned short bf16;
__device__ __forceinline__ bf16 f2bf(float f) { unsigned u = __builtin_bit_cast(unsigned, f); return (bf16)((u + 0x7fffu + ((u >> 16) & 1u)) >> 16); }
__device__ __forceinline__ float bf2f(bf16 h) { return __builtin_bit_cast(float, (unsigned)h << 16); }

template <typename T> __device__ __forceinline__ float ldf(const T* p);
template <> __device__ __forceinline__ float ldf<float>(const float* p) { return *p; }
template <> __device__ __forceinline__ float ldf<bf16>(const bf16* p) { return bf2f(*p); }
template <typename T> __device__ __forceinline__ void stf(T* p, float v);
template <> __device__ __forceinline__ void stf<float>(float* p, float v) { *p = v; }
template <> __device__ __forceinline__ void stf<bf16>(bf16* p, float v) { *p = f2bf(v); }

__device__ __forceinline__ float wave_sum(float v) {
#pragma unroll
    for (int o = 1; o < 64; o <<= 1) v += __shfl_xor(v, o);
    return v;
}
__device__ __forceinline__ float sigmoidf_(float x) { return 1.f / (1.f + __expf(-x)); }


__device__ __forceinline__ float gelu_tanh(float x) { return x * sigmoidf_(1.5957691216057308f * (x + 0.044715f * x * x * x)); }

namespace pg8 {
#define PG8_LAS __attribute__((address_space(3)))
typedef short bf16x8 __attribute__((ext_vector_type(8)));
typedef float f32x4 __attribute__((ext_vector_type(4)));
typedef unsigned u32x4 __attribute__((ext_vector_type(4)));
constexpr int BM = 256, BK = 64, HALF = 128, HTB = HALF * BK * 2, STAGE_BYTES = 8 * HTB, NXCD = 8, WGM = 8;
__device__ __forceinline__ int lds_byte(int r, int c) { const int st = (r >> 4) * 2 + (c >> 5), rr = r & 15, cc = c & 31, ob = rr * 64 + cc * 2; return st * 1024 + (ob ^ (((ob >> 9) & 1) << 5)); }
__device__ __forceinline__ void stage_rc(int b, int& R, int& C) { const int st = b / 1024, sb = b % 1024, swz = sb ^ (((sb >> 9) & 1) << 5); R = (st >> 1) * 16 + swz / 64; C = (st & 1) * 32 + (swz % 64) / 2; }
__device__ __forceinline__ int perm32(int rho) { const int n = rho >> 4, i = rho & 15; return 8 * (i >> 2) + 4 * n + (i & 3); }
struct Unit { int pm, pn; };
struct PlainOrder {
    const bf16* A; const bf16* Bt; int lda, ldb, K; int nM, nN, nwg, G, c;
    __device__ void init(const bf16* A_, int lda_, const bf16* Bt_, int ldb_, int M, int N, int K_) { A = A_; Bt = Bt_; lda = lda_; ldb = ldb_; K = K_; nM = M / BM; nN = N / BM; nwg = nM * nN; G = GN; c = GB; }
    __device__ bool next(int i, Unit& u) const {
        const long L = (long)i * G + c; if (L >= nwg) return false;
        int wgid = (int)L; { const int q = nwg / NXCD, r = nwg % NXCD, xcd = wgid % NXCD, off = wgid / NXCD; wgid = (xcd < r ? xcd * (q + 1) : r * (q + 1) + (xcd - r) * q) + off; }
        const int nig = WGM * nN, gid = wgid / nig, fm = gid * WGM, gsz = (nM - fm) < WGM ? (nM - fm) : WGM;
        u.pm = fm + ((wgid % nig) % gsz); u.pn = (wgid % nig) / gsz; return true;
    }
    __device__ __forceinline__ const char* aptr(const Unit& u) const { return (const char*)(A + (size_t)u.pm * BM * lda); }
    __device__ __forceinline__ const char* bptr(const Unit& u) const { return (const char*)(Bt + (size_t)u.pn * BM * ldb); }
};
__device__ __forceinline__ unsigned cvt_pk_bf16(float lo, float hi) { unsigned r; asm volatile("v_cvt_pk_bf16_f32 %0, %1, %2" : "=v"(r) : "v"(lo), "v"(hi)); return r; }

template <class Epi, class Sched>
__device__ __forceinline__ void gemm_phase(PG8_LAS unsigned char* lds, const Sched& S, const Epi& E) {
    const int tid = threadIdx.x, wid = __builtin_amdgcn_readfirstlane(tid >> 6), lane = tid & 63, wr = wid >> 2, wc = wid & 3, fr = lane & 15, fq = lane >> 4;
    const int K = S.K, nt = K / BK;
    unsigned voffA[2], voffB[2];
#pragma unroll
    for (int i = 0; i < 2; ++i) { int R, C; stage_rc(tid * 16 + i * 8192, R, C); const int Rb = Epi::PERM ? ((R & ~31) + perm32(R & 31)) : R;
        voffA[i] = (unsigned)(R * S.lda + C) * 2u; voffB[i] = (unsigned)(Rb * S.ldb + C) * 2u; }
    const size_t kstep = (size_t)(BK * 2);
    const size_t hstepA = (size_t)HALF * S.lda * 2, hstepB = (size_t)HALF * S.ldb * 2;
    const unsigned ldsw = (unsigned)wid * 1024u;
    const int aoff = lds_byte(wr * 64 + fr, fq * 8), boff = lds_byte(wc * 32 + fr, fq * 8);
#define PG8_SA(b, h) (((b) * 2 + (h)) * HTB)
#define PG8_SB(b, h) ((4 + (b) * 2 + (h)) * HTB)
#define PG8_STAGE(bufoff, gbase, voff) do { _Pragma("unroll") for (int _i = 0; _i < 2; ++_i) \
        __builtin_amdgcn_global_load_lds((const unsigned*)((const char*)(gbase) + (voff)[_i]), (PG8_LAS unsigned*)(lds + (bufoff) + ldsw + _i * 8192), 16, 0, 0); } while (0)
#define PG8_LDA(dst, b, h) do { _Pragma("unroll") for (int m = 0; m < 4; ++m) _Pragma("unroll") for (int k = 0; k < 2; ++k) dst[m][k] = *(const PG8_LAS bf16x8*)(lds + PG8_SA(b, h) + aoff + m * 2048 + k * 1024); } while (0)
#define PG8_LDB(dst, b, h) do { _Pragma("unroll") for (int n = 0; n < 2; ++n) _Pragma("unroll") for (int k = 0; k < 2; ++k) dst[n][k] = *(const PG8_LAS bf16x8*)(lds + PG8_SB(b, h) + boff + n * 2048 + k * 1024); } while (0)
#define PG8_MMA(ai, bj, At, Bt) do { __builtin_amdgcn_s_setprio(1); _Pragma("unroll") for (int m = 0; m < 4; ++m) _Pragma("unroll") for (int n = 0; n < 2; ++n) _Pragma("unroll") for (int k = 0; k < 2; ++k) \
        acc[ai][bj][m][n] = __builtin_amdgcn_mfma_f32_16x16x32_bf16(Bt[n][k], At[m][k], acc[ai][bj][m][n], 0, 0, 0); __builtin_amdgcn_s_setprio(0); } while (0)
#define PG8_WAIT_V(n) asm volatile("s_waitcnt vmcnt(" #n ")" ::: "memory")
#define PG8_WAIT_L(n) asm volatile("s_waitcnt lgkmcnt(" #n ")" ::: "memory")
#define PG8_BAR __builtin_amdgcn_s_barrier()
#define PG8_SCHED __builtin_amdgcn_sched_barrier(0)
    Unit cur, nxt; int ui = 0;
    if (!S.next(0, cur)) return;
    f32x4 acc[2][2][4][2];
#pragma unroll
    for (int a = 0; a < 2; ++a)
#pragma unroll
        for (int b = 0; b < 2; ++b)
#pragma unroll
            for (int m = 0; m < 4; ++m)
#pragma unroll
                for (int n = 0; n < 2; ++n) acc[a][b][m][n] = (f32x4){0.f, 0.f, 0.f, 0.f};
    bf16x8 At[4][2], B0[2][2], B1[2][2];
    const char* cA = S.aptr(cur); const char* cB = S.bptr(cur);
    PG8_STAGE(PG8_SB(0, 0), cB, voffB); PG8_STAGE(PG8_SB(0, 1), cB + hstepB, voffB); PG8_STAGE(PG8_SA(0, 0), cA, voffA); PG8_STAGE(PG8_SA(0, 1), cA + hstepA, voffA);
    if (wr == 1) PG8_BAR;
    PG8_WAIT_V(2); PG8_BAR;
    PG8_STAGE(PG8_SB(1, 0), cB + kstep, voffB); PG8_STAGE(PG8_SA(1, 0), cA + kstep, voffA); PG8_STAGE(PG8_SB(1, 1), cB + hstepB + kstep, voffB);
    PG8_WAIT_V(6); PG8_BAR;
    for (;;) {
        const bool has_next = S.next(ui + 1, nxt);
        const char* nA = has_next ? S.aptr(nxt) : cA; const char* nB = has_next ? S.bptr(nxt) : cB;
        for (int t = 0; t < nt; t += 2) {
            const bool last = (t == nt - 2);
            const char* a1 = cA + (size_t)(t + 1) * kstep;
            const char* a2 = last ? nA : cA + (size_t)(t + 2) * kstep; const char* b2 = last ? nB : cB + (size_t)(t + 2) * kstep;
            const char* a3 = a2 + kstep; const char* b3 = b2 + kstep;
            PG8_LDB(B0, 0, 0); PG8_LDB(B1, 0, 1); PG8_SCHED; PG8_LDA(At, 0, 0); PG8_STAGE(PG8_SA(1, 1), a1 + hstepA, voffA);
            PG8_WAIT_V(8); PG8_WAIT_L(0); PG8_BAR; PG8_MMA(0, 0, At, B0); PG8_MMA(0, 1, At, B1); PG8_BAR; PG8_SCHED;
            PG8_LDA(At, 0, 1); PG8_STAGE(PG8_SB(0, 0), b2, voffB); PG8_STAGE(PG8_SB(0, 1), b2 + hstepB, voffB); PG8_STAGE(PG8_SA(0, 0), a2, voffA);
            PG8_WAIT_V(8); PG8_WAIT_L(0); PG8_BAR; PG8_MMA(1, 0, At, B0); PG8_MMA(1, 1, At, B1); PG8_BAR; PG8_SCHED;
            PG8_LDB(B0, 1, 0); PG8_LDB(B1, 1, 1); PG8_SCHED; PG8_LDA(At, 1, 0); PG8_STAGE(PG8_SA(0, 1), a2 + hstepA, voffA);
            PG8_WAIT_V(8); PG8_WAIT_L(0); PG8_BAR; PG8_MMA(0, 0, At, B0); PG8_MMA(0, 1, At, B1); PG8_BAR; PG8_SCHED;
            PG8_LDA(At, 1, 1); PG8_STAGE(PG8_SB(1, 0), b3, voffB); PG8_STAGE(PG8_SB(1, 1), b3 + hstepB, voffB); PG8_STAGE(PG8_SA(1, 0), a3, voffA);
            PG8_WAIT_V(8); PG8_WAIT_L(0); PG8_BAR; PG8_MMA(1, 0, At, B0); PG8_MMA(1, 1, At, B1); PG8_BAR; PG8_SCHED;
        }
        if (wr == 0) PG8_BAR;
        E(acc, cur, wr, wc, fr, fq);
        if (!has_next) break;
#pragma unroll
        for (int a = 0; a < 2; ++a)
#pragma unroll
            for (int b = 0; b < 2; ++b)
#pragma unroll
                for (int m = 0; m < 4; ++m)
#pragma unroll
                    for (int n = 0; n < 2; ++n) acc[a][b][m][n] = (f32x4){0.f, 0.f, 0.f, 0.f};
        cur = nxt; cA = nA; cB = nB; ++ui;
        if (wr == 1) PG8_BAR;
    }
    PG8_WAIT_V(0);
    PG8_BAR;
#undef PG8_SA
#undef PG8_SB
#undef PG8_STAGE
#undef PG8_LDA
#undef PG8_LDB
#undef PG8_MMA
#undef PG8_WAIT_V
#undef PG8_WAIT_L
#undef PG8_BAR
#undef PG8_SCHED
}

struct EpiF32 {
    static constexpr bool PERM = false;
    float* C; int ldc; const float* R; int ldr;
    __device__ __forceinline__ void operator()(const f32x4 (&acc)[2][2][4][2], const Unit& u, int wr, int wc, int fr, int fq) const {
        const int row0 = u.pm * BM + wr * 64 + fr, col0 = u.pn * BM + wc * 32 + 4 * fq;
#pragma unroll
        for (int ai = 0; ai < 2; ++ai)
#pragma unroll
            for (int m = 0; m < 4; ++m) { const size_t row = (size_t)(row0 + ai * HALF + m * 16);
#pragma unroll
                for (int bj = 0; bj < 2; ++bj)
#pragma unroll
                    for (int n = 0; n < 2; ++n) { const int col = col0 + bj * HALF + 16 * n; f32x4 v = acc[ai][bj][m][n];
                        if (R) v = v + *(const f32x4*)(R + row * ldr + col);
                        *(f32x4*)(C + row * ldc + col) = v; } }
    }
};
struct EpiBf16 {
    static constexpr bool PERM = true;
    bf16* O; int ldc;
    __device__ __forceinline__ void operator()(const f32x4 (&acc)[2][2][4][2], const Unit& u, int wr, int wc, int fr, int fq) const {
        const int row0 = u.pm * BM + wr * 64 + fr, col0 = u.pn * BM + wc * 32 + 8 * fq;
#pragma unroll
        for (int ai = 0; ai < 2; ++ai)
#pragma unroll
            for (int m = 0; m < 4; ++m) { bf16* rowp = O + (size_t)(row0 + ai * HALF + m * 16) * ldc + col0;
#pragma unroll
                for (int bj = 0; bj < 2; ++bj) { const f32x4 v0 = acc[ai][bj][m][0], v1 = acc[ai][bj][m][1];
                    u32x4 w; w.x = cvt_pk_bf16(v0[0], v0[1]); w.y = cvt_pk_bf16(v0[2], v0[3]); w.z = cvt_pk_bf16(v1[0], v1[1]); w.w = cvt_pk_bf16(v1[2], v1[3]);
                    *(u32x4*)(rowp + bj * HALF) = w; } }
    }
};
struct EpiGlu {
    static constexpr bool PERM = true;
    const bf16* Z; const float* bias; bf16* YM;
    __device__ __forceinline__ void operator()(const f32x4 (&acc)[2][2][4][2], const Unit& u, int wr, int wc, int fr, int fq) const {
        const int row0 = u.pm * BM + wr * 64 + fr, col0 = u.pn * BM + wc * 32 + 8 * fq;
#pragma unroll
        for (int ai = 0; ai < 2; ++ai)
#pragma unroll
            for (int m = 0; m < 4; ++m) { const size_t row = (size_t)(row0 + ai * HALF + m * 16);
#pragma unroll
                for (int bj = 0; bj < 2; ++bj) { const int col = col0 + bj * HALF;
                    const u32x4 zz = *(const u32x4*)(Z + row * 512 + col);
                    const f32x4 b0 = *(const f32x4*)(bias + col), b1 = *(const f32x4*)(bias + col + 4);
                    const f32x4 v0 = acc[ai][bj][m][0] + b0, v1 = acc[ai][bj][m][1] + b1;
                    float o[8]; const unsigned zw[4] = {zz.x, zz.y, zz.z, zz.w};
#pragma unroll
                    for (int q = 0; q < 4; ++q) { const float zl = __builtin_bit_cast(float, zw[q] << 16), zh = __builtin_bit_cast(float, zw[q] & 0xffff0000u);
                        const float al = (q < 2) ? v0[2 * q] : v1[2 * q - 4], ah = (q < 2) ? v0[2 * q + 1] : v1[2 * q - 3];
                        o[2 * q] = zl * sigmoidf_(al); o[2 * q + 1] = zh * sigmoidf_(ah); }
                    u32x4 w; w.x = cvt_pk_bf16(o[0], o[1]); w.y = cvt_pk_bf16(o[2], o[3]); w.z = cvt_pk_bf16(o[4], o[5]); w.w = cvt_pk_bf16(o[6], o[7]);
                    *(u32x4*)(YM + row * D + 512 + col) = w; } }
    }
};

struct MoeOrder {
    const bf16* A; const bf16* Bt; int lda, ldb, K; const int* tiles; int nunits, G, c; size_t bexp;
    __device__ void init(const bf16* A_, int lda_, const bf16* Bt_, int ldb_, int K_, const int* tiles_, int ntiles, size_t bexp_) { A = A_; Bt = Bt_; lda = lda_; ldb = ldb_; K = K_; tiles = tiles_; nunits = ntiles * 4; G = GN; c = GB; bexp = bexp_; }
    __device__ bool next(int i, Unit& u) const { const int L = i * G + c; if (L >= nunits) return false; u.pm = L >> 2; u.pn = L & 3; return true; }
    __device__ __forceinline__ const char* aptr(const Unit& u) const { return (const char*)(A + (size_t)u.pm * BM * lda); }
    __device__ __forceinline__ const char* bptr(const Unit& u) const { const int e = __hip_atomic_load(tiles + u.pm, __ATOMIC_RELAXED, __HIP_MEMORY_SCOPE_AGENT); return (const char*)(Bt + ((size_t)e * bexp + (size_t)u.pn * BM) * ldb); }
};
struct EpiSilu {
    static constexpr bool PERM = true;
    bf16* HID;
    __device__ __forceinline__ void operator()(const f32x4 (&acc)[2][2][4][2], const Unit& u, int wr, int wc, int fr, int fq) const {
        const int row0 = u.pm * BM + wr * 64 + fr, col0 = u.pn * HALF + wc * 32 + 8 * fq;
#pragma unroll
        for (int ai = 0; ai < 2; ++ai)
#pragma unroll
            for (int m = 0; m < 4; ++m) { const size_t row = (size_t)(row0 + ai * HALF + m * 16);
                float o[8];
#pragma unroll
                for (int n = 0; n < 2; ++n)
#pragma unroll
                    for (int q = 0; q < 4; ++q) { const float g = acc[ai][0][m][n][q], up = acc[ai][1][m][n][q]; o[4 * n + q] = g * sigmoidf_(g) * up; }
                u32x4 w; w.x = cvt_pk_bf16(o[0], o[1]); w.y = cvt_pk_bf16(o[2], o[3]); w.z = cvt_pk_bf16(o[4], o[5]); w.w = cvt_pk_bf16(o[6], o[7]);
                *(u32x4*)(HID + row * DEXP + col0) = w; }
    }
};
struct EpiGate {
    static constexpr bool PERM = true;
    bf16* Y; const float* gate;
    __device__ __forceinline__ void operator()(const f32x4 (&acc)[2][2][4][2], const Unit& u, int wr, int wc, int fr, int fq) const {
        const int row0 = u.pm * BM + wr * 64 + fr, col0 = u.pn * BM + wc * 32 + 8 * fq;
#pragma unroll
        for (int ai = 0; ai < 2; ++ai)
#pragma unroll
            for (int m = 0; m < 4; ++m) { const size_t row = (size_t)(row0 + ai * HALF + m * 16); const float gt = gate[row];
#pragma unroll
                for (int bj = 0; bj < 2; ++bj) { const f32x4 v0 = acc[ai][bj][m][0] * gt, v1 = acc[ai][bj][m][1] * gt;
                    u32x4 w; w.x = cvt_pk_bf16(v0[0], v0[1]); w.y = cvt_pk_bf16(v0[2], v0[3]); w.z = cvt_pk_bf16(v1[0], v1[1]); w.w = cvt_pk_bf16(v1[2], v1[3]);
                    *(u32x4*)(Y + row * D + col0 + bj * HALF) = w; } }
    }
};

struct EpiProj {
    static constexpr bool PERM = true;
    bf16* PROJ; bf16* US5;
    __device__ __forceinline__ void operator()(const f32x4 (&acc)[2][2][4][2], const Unit& u, int wr, int wc, int fr, int fq) const {
        const int row0 = u.pm * BM + wr * 64 + fr, col0 = u.pn * BM + wc * 32 + 8 * fq;
#pragma unroll
        for (int ai = 0; ai < 2; ++ai)
#pragma unroll
            for (int m = 0; m < 4; ++m) { const size_t row = (size_t)(row0 + ai * HALF + m * 16);
#pragma unroll
                for (int bj = 0; bj < 2; ++bj) { const f32x4 v0 = acc[ai][bj][m][0], v1 = acc[ai][bj][m][1]; const int col = col0 + bj * HALF;
                    u32x4 w; w.x = cvt_pk_bf16(v0[0], v0[1]); w.y = cvt_pk_bf16(v0[2], v0[3]); w.z = cvt_pk_bf16(v1[0], v1[1]); w.w = cvt_pk_bf16(v1[2], v1[3]);
                    if (col < DSHIFT) *(u32x4*)(PROJ + row * DSHIFT + col) = w;
                    else { const int cc = col - DSHIFT; *(u32x4*)(US5 + ((size_t)(cc >> 4) * M + row) * 16 + (cc & 15)) = w; } } }
    }
};
struct GroupOrder {
    const bf16* A; const bf16* Bt; int lda, ldb, K; int nM, nN, nunits, G, c; size_t sA, sB;
    __device__ void init(const bf16* A_, int lda_, size_t sA_, const bf16* Bt_, int ldb_, size_t sB_, int ngroups, int Mg, int Ng, int K_) {
        A = A_; Bt = Bt_; lda = lda_; ldb = ldb_; K = K_; sA = sA_; sB = sB_; nM = Mg / BM; nN = Ng / BM; nunits = ngroups * nM * nN; G = GN; c = GB; }
    __device__ bool next(int i, Unit& u) const { const int L = i * G + c; if (L >= nunits) return false; u.pn = L % nN; u.pm = L / nN; return true; }
    __device__ __forceinline__ const char* aptr(const Unit& u) const { const int g = u.pm / nM, pm = u.pm % nM; return (const char*)(A + (size_t)g * sA + (size_t)pm * BM * lda); }
    __device__ __forceinline__ const char* bptr(const Unit& u) const { const int g = u.pm / nM; return (const char*)(Bt + (size_t)g * sB + (size_t)u.pn * BM * ldb); }
};
struct EpiS5a {
    static constexpr bool PERM = false;
    bf16* YI; float* F;
    __device__ __forceinline__ void operator()(const f32x4 (&acc)[2][2][4][2], const Unit& u, int wr, int wc, int fr, int fq) const {
        const int row0 = u.pm * BM + wr * 64 + fr, col0 = u.pn * BM + wc * 32 + 4 * fq;
#pragma unroll
        for (int ai = 0; ai < 2; ++ai)
#pragma unroll
            for (int m = 0; m < 4; ++m) { const size_t row = (size_t)(row0 + ai * HALF + m * 16);
#pragma unroll
                for (int bj = 0; bj < 2; ++bj)
#pragma unroll
                    for (int n = 0; n < 2; ++n) { const int col = col0 + bj * HALF + 16 * n; const f32x4 v = acc[ai][bj][m][n];
                        if (col < 512) { uint2 w; w.x = cvt_pk_bf16(v[0], v[1]); w.y = cvt_pk_bf16(v[2], v[3]); *(uint2*)(YI + row * 512 + col) = w; }
                        else if (col < 640) *(f32x4*)(F + row * 128 + (col - 512)) = v; } }
    }
};
struct EpiS5b {
    static constexpr bool PERM = true;
    const bf16* YI; bf16* Z;
    __device__ __forceinline__ void operator()(const f32x4 (&acc)[2][2][4][2], const Unit& u, int wr, int wc, int fr, int fq) const {
        const int row0 = u.pm * BM + wr * 64 + fr, col0 = u.pn * BM + wc * 32 + 8 * fq;
#pragma unroll
        for (int ai = 0; ai < 2; ++ai)
#pragma unroll
            for (int m = 0; m < 4; ++m) { const int row = row0 + ai * HALF + m * 16; const int g = row / S5R, rl = row % S5R;
#pragma unroll
                for (int bj = 0; bj < 2; ++bj) { const int col = col0 + bj * HALF;
                    const u32x4 yi = *(const u32x4*)(YI + (size_t)row * 512 + col);
                    const unsigned yw[4] = {yi.x, yi.y, yi.z, yi.w};
                    const f32x4 v0 = acc[ai][bj][m][0], v1 = acc[ai][bj][m][1];
                    float o[8];
#pragma unroll
                    for (int q = 0; q < 4; ++q) { const float al = (q < 2) ? v0[2 * q] : v1[2 * q - 4], ah = (q < 2) ? v0[2 * q + 1] : v1[2 * q - 3];
                        o[2 * q] = gelu_tanh(al + __builtin_bit_cast(float, yw[q] << 16)); o[2 * q + 1] = gelu_tanh(ah + __builtin_bit_cast(float, yw[q] & 0xffff0000u)); }
                    u32x4 w; w.x = cvt_pk_bf16(o[0], o[1]); w.y = cvt_pk_bf16(o[2], o[3]); w.z = cvt_pk_bf16(o[4], o[5]); w.w = cvt_pk_bf16(o[6], o[7]);
                    const size_t tok = (size_t)rl * S5L + (col >> 4);
                    *(u32x4*)(Z + tok * 512 + g * 16 + (col & 15)) = w; } }
    }
};
struct AttnOrder {
    const bf16* A; const bf16* Bt; int lda, ldb, K; int G, c; int mode;
    __device__ void init(const bf16* A_, const bf16* Bt_, int ldb_, int mode_) { A = A_; Bt = Bt_; lda = D; ldb = ldb_; K = 256; G = GN; c = GB; mode = mode_; }
    __device__ bool next(int i, Unit& u) const { const int L = i * G + c; if (L >= NB * 4 * 32) return false; u.pn = L & 3; u.pm = L >> 2; return true; }
    __device__ __forceinline__ const char* aptr(const Unit& u) const { return (const char*)(A + (size_t)u.pm * BM * D + u.pn * 256); }
    __device__ __forceinline__ const char* bptr(const Unit& u) const { const int b = u.pm >> 5;
        return (const char*)(mode == 0 ? Bt + (size_t)b * 256 * ldb + u.pn * 256 : Bt + (size_t)u.pn * 256 * ldb + b * 256); }
};
struct EpiSoftmax {
    static constexpr bool PERM = true;
    bf16* P; PG8_LAS float* scr;
    __device__ __forceinline__ void operator()(f32x4 (&acc)[2][2][4][2], const Unit& u, int wr, int wc, int fr, int fq) const {
        const float SC = 0.0625f * 1.4426950408889634f;
        PG8_LAS float* smax = scr; PG8_LAS float* ssum = scr + 1024;
#pragma unroll
        for (int ai = 0; ai < 2; ++ai)
#pragma unroll
            for (int m = 0; m < 4; ++m) { float t = -3.0e38f;
#pragma unroll
                for (int bj = 0; bj < 2; ++bj)
#pragma unroll
                    for (int n = 0; n < 2; ++n) { const f32x4 v = acc[ai][bj][m][n]; t = fmaxf(t, fmaxf(fmaxf(v[0], v[1]), fmaxf(v[2], v[3]))); }
                t = fmaxf(t, __shfl_xor(t, 16)); t = fmaxf(t, __shfl_xor(t, 32));
                if (fq == 0) smax[(ai * HALF + wr * 64 + m * 16 + fr) * 4 + wc] = t; }
        asm volatile("s_waitcnt lgkmcnt(0)" ::: "memory"); __builtin_amdgcn_s_barrier(); asm volatile("" ::: "memory");
#pragma unroll
        for (int ai = 0; ai < 2; ++ai)
#pragma unroll
            for (int m = 0; m < 4; ++m) { const f32x4 q = *(const PG8_LAS f32x4*)(smax + (ai * HALF + wr * 64 + m * 16 + fr) * 4);
                const float mm = fmaxf(fmaxf(q[0], q[1]), fmaxf(q[2], q[3])) * SC; float s = 0.f;
#pragma unroll
                for (int bj = 0; bj < 2; ++bj)
#pragma unroll
                    for (int n = 0; n < 2; ++n)
#pragma unroll
                        for (int e = 0; e < 4; ++e) { const float p = __builtin_amdgcn_exp2f(acc[ai][bj][m][n][e] * SC - mm); acc[ai][bj][m][n][e] = p; s += p; }
                s += __shfl_xor(s, 16); s += __shfl_xor(s, 32);
                if (fq == 0) ssum[(ai * HALF + wr * 64 + m * 16 + fr) * 4 + wc] = s; }
        asm volatile("s_waitcnt lgkmcnt(0)" ::: "memory"); __builtin_amdgcn_s_barrier(); asm volatile("" ::: "memory");
        const int row0 = u.pm * BM + wr * 64 + fr, col0 = u.pn * 256 + wc * 32 + 8 * fq;
#pragma unroll
        for (int ai = 0; ai < 2; ++ai)
#pragma unroll
            for (int m = 0; m < 4; ++m) { const f32x4 q = *(const PG8_LAS f32x4*)(ssum + (ai * HALF + wr * 64 + m * 16 + fr) * 4);
                const float iv = 1.f / ((q[0] + q[1]) + (q[2] + q[3]));
                bf16* rowp = P + (size_t)(row0 + ai * HALF + m * 16) * D + col0;
#pragma unroll
                for (int bj = 0; bj < 2; ++bj) { const f32x4 v0 = acc[ai][bj][m][0] * iv, v1 = acc[ai][bj][m][1] * iv; u32x4 w;
                    w.x = cvt_pk_bf16(v0[0], v0[1]); w.y = cvt_pk_bf16(v0[2], v0[3]); w.z = cvt_pk_bf16(v1[0], v1[1]); w.w = cvt_pk_bf16(v1[2], v1[3]);
                    *(u32x4*)(rowp + bj * HALF) = w; } }
    }
};
struct EpiAttnO {
    static constexpr bool PERM = true;
    bf16* O;
    __device__ __forceinline__ void operator()(const f32x4 (&acc)[2][2][4][2], const Unit& u, int wr, int wc, int fr, int fq) const {
        const int row0 = u.pm * BM + wr * 64 + fr, col0 = u.pn * 256 + wc * 32 + 8 * fq;
#pragma unroll
        for (int ai = 0; ai < 2; ++ai)
#pragma unroll
            for (int m = 0; m < 4; ++m) { bf16* rowp = O + (size_t)(row0 + ai * HALF + m * 16) * D + col0;
#pragma unroll
                for (int bj = 0; bj < 2; ++bj) { const f32x4 v0 = acc[ai][bj][m][0], v1 = acc[ai][bj][m][1];
                    u32x4 w; w.x = cvt_pk_bf16(v0[0], v0[1]); w.y = cvt_pk_bf16(v0[2], v0[3]); w.z = cvt_pk_bf16(v1[0], v1[1]); w.w = cvt_pk_bf16(v1[2], v1[3]);
                    *(u32x4*)(rowp + bj * HALF) = w; } }
    }
};
}

#define LAS __attribute__((address_space(3)))
__device__ __forceinline__ unsigned pk2(float lo, float hi) { return (unsigned)f2bf(lo) | ((unsigned)f2bf(hi) << 16); }
__device__ __forceinline__ void transpose_item(const float* __restrict__ W, int K, int N, bf16* __restrict__ WT, int ldt, int row_off, int col_off, float* scr, int item, int lane, const float* __restrict__ kscale, int ldw = 0) {
    if (ldw == 0) ldw = N;
    const int nblk = N / 32, kb = item / nblk, nb = item % nblk, k0 = 64 * kb, n0 = 32 * nb;
#pragma unroll 8
    for (int i = 0; i < 32; ++i) { const int kk = 2 * i + (lane >> 5); float v = W[(size_t)(k0 + kk) * ldw + n0 + (lane & 31)]; if (kscale) v *= kscale[k0 + kk]; scr[kk * 33 + (lane & 31)] = v; }
    __builtin_amdgcn_s_waitcnt(0xc07f); asm volatile("" ::: "memory");
    const int c = lane & 7;
#pragma unroll
    for (int j = 0; j < 4; ++j) { const int n = (lane >> 3) + 8 * j; const float* s = scr + (8 * c) * 33 + n;
        uint4 o; o.x = pk2(s[0 * 33], s[1 * 33]); o.y = pk2(s[2 * 33], s[3 * 33]); o.z = pk2(s[4 * 33], s[5 * 33]); o.w = pk2(s[6 * 33], s[7 * 33]);
        *(uint4*)(WT + (size_t)(row_off + n0 + n) * ldt + col_off + k0 + 8 * c) = o; }
    __builtin_amdgcn_s_waitcnt(0xc07f); asm volatile("" ::: "memory");
}
__device__ void transpose_ph(const float* W, int K, int N, bf16* WT, int ldt, int row_off, int col_off, char* lds, const float* kscale = nullptr) {
    const int lane = threadIdx.x & 63, wv = threadIdx.x >> 6;
    float* scr = (float*)(lds + wv * 16384);
    const int nitems = (K / 64) * (N / 32);
    for (int it = GB * 8 + wv; it < nitems; it += GN * 8) transpose_item(W, K, N, WT, ldt, row_off, col_off, scr, it, lane, kscale);
}

template <typename TO>
__device__ void rmsnorm_ph(const float* __restrict__ x, const float* __restrict__ w, TO* __restrict__ out, int rows) {
    const int lane = threadIdx.x & 63, wv = threadIdx.x >> 6;
    for (int row = GB * 8 + wv; row < rows; row += GN * 8) {
        const float4* xr = (const float4*)(x + (size_t)row * D);
        float4 v[4]; float s = 0.f;
#pragma unroll
        for (int j = 0; j < 4; ++j) { v[j] = xr[lane + 64 * j]; s += v[j].x * v[j].x + v[j].y * v[j].y + v[j].z * v[j].z + v[j].w * v[j].w; }
        s = wave_sum(s);
        const float rs = rsqrtf(s * (1.f / D) + 1e-6f);
#pragma unroll
        for (int j = 0; j < 4; ++j) {
            const int c = (lane + 64 * j) * 4;
            const float4 g = *(const float4*)(w + c);
            TO* o = out + (size_t)row * D + c;
            stf(o + 0, v[j].x * rs * g.x); stf(o + 1, v[j].y * rs * g.y); stf(o + 2, v[j].z * rs * g.z); stf(o + 3, v[j].w * rs * g.w);
        }
    }
}

struct GemmArgs {
    const void* A; long lda; long sAz;
    const float* B; long sbk, sbn; long sBz;
    const float* B2;
    void* C; long ldc; long sCz;
    int M, N, K;
    const float* R; long ldr;
    float scale;
    const int* gather;
    const int* tiles;
    const int* ntiles;
    long sBe;
    const float* rowscale;
    int zdiv, nz;
    long sAz2, sBz2, sCz2;
};
template <typename TA, typename TC, int EPI, bool GROUPED>
__device__ void sgemm_ph(const GemmArgs& g, char* lds) {
    const int half = threadIdx.x >> 8, tid = threadIdx.x & 255, tx = tid & 15, ty = tid >> 4;
    float (*As)[68] = (float (*)[68])(lds + half * 16384);
    float (*Bs)[68] = (float (*)[68])(lds + half * 16384 + 4352);
    float (*Bs2)[68] = (float (*)[68])(lds + half * 16384 + 8704);
    const int ncol = g.N / 64;
    int nrowt, ntot;
    if (GROUPED) { nrowt = *g.ntiles; ntot = nrowt * ncol; }
    else { nrowt = (g.M + 63) / 64; ntot = nrowt * ncol * g.nz; }
    const int npair = (ntot + 1) / 2;
    for (int pr = GB; pr < npair; pr += GN) {
        const int ti = 2 * pr + half;
        const bool valid = ti < ntot;
        int row0 = 0, nrows = 0, col0 = 0; const float* B = g.B; const float* B2 = g.B2;
        const TA* A = (const TA*)g.A; TC* C = (TC*)g.C;
        if (valid) {
            col0 = (ti % ncol) * 64; const int rt = ti / ncol;
            if (GROUPED) {
                const int e = g.tiles[3 * rt]; row0 = g.tiles[3 * rt + 1]; nrows = g.tiles[3 * rt + 2];
                B += (size_t)e * g.sBe; if (EPI == 3) B2 += (size_t)e * g.sBe;
            } else {
                const int z = rt / nrowt, rr = rt % nrowt;
                row0 = rr * 64; nrows = min(64, g.M - row0);
                const int z1 = z / g.zdiv, z2 = z % g.zdiv;
                A += z1 * g.sAz + z2 * g.sAz2; B += z1 * g.sBz + z2 * g.sBz2; C += z1 * g.sCz + z2 * g.sCz2;
            }
        }
        const int ar = tid >> 2, ak = (tid & 3) * 4;
        const bool arow_ok = ar < nrows;
        long arow = 0;
        if (arow_ok) arow = g.gather ? (long)g.gather[row0 + ar] : (long)(row0 + ar);
        const TA* ap = A + arow * g.lda + ak;
        const int bk = tid >> 4, bn = (tid & 15) * 4;
        const float* bp = B + (long)bk * g.sbk + (long)(col0 + bn) * g.sbn;
        const float* bp2 = (EPI == 3) ? (B2 + (long)bk * g.sbk + (long)(col0 + bn) * g.sbn) : nullptr;
        float acc[4][4] = {}; float acc2[4][4] = {};
        for (int k0 = 0; k0 < g.K; k0 += 16) {
            float a0 = 0.f, a1 = 0.f, a2 = 0.f, a3 = 0.f;
            if (arow_ok) { a0 = ldf(ap + k0); a1 = ldf(ap + k0 + 1); a2 = ldf(ap + k0 + 2); a3 = ldf(ap + k0 + 3); }
            float b0 = 0.f, b1 = 0.f, b2 = 0.f, b3 = 0.f, c0 = 0.f, c1 = 0.f, c2 = 0.f, c3 = 0.f;
            if (valid) {
                const float* b = bp + (long)k0 * g.sbk;
                b0 = b[0]; b1 = b[g.sbn]; b2 = b[2 * g.sbn]; b3 = b[3 * g.sbn];
                if (EPI == 3) { const float* bb = bp2 + (long)k0 * g.sbk; c0 = bb[0]; c1 = bb[g.sbn]; c2 = bb[2 * g.sbn]; c3 = bb[3 * g.sbn]; }
            }
            __syncthreads();
            As[ak][ar] = a0; As[ak + 1][ar] = a1; As[ak + 2][ar] = a2; As[ak + 3][ar] = a3;
            Bs[bk][bn] = b0; Bs[bk][bn + 1] = b1; Bs[bk][bn + 2] = b2; Bs[bk][bn + 3] = b3;
            if (EPI == 3) { Bs2[bk][bn] = c0; Bs2[bk][bn + 1] = c1; Bs2[bk][bn + 2] = c2; Bs2[bk][bn + 3] = c3; }
            __syncthreads();
#pragma unroll
            for (int k = 0; k < 16; ++k) {
                const float4 av = *(const float4*)&As[k][ty * 4];
                const float4 bv = *(const float4*)&Bs[k][tx * 4];
                const float a[4] = {av.x, av.y, av.z, av.w}, bb[4] = {bv.x, bv.y, bv.z, bv.w};
#pragma unroll
                for (int i = 0; i < 4; ++i)
#pragma unroll
                    for (int j = 0; j < 4; ++j) acc[i][j] += a[i] * bb[j];
                if (EPI == 3) {
                    const float4 cv = *(const float4*)&Bs2[k][tx * 4];
                    const float cc[4] = {cv.x, cv.y, cv.z, cv.w};
#pragma unroll
                    for (int i = 0; i < 4; ++i)
#pragma unroll
                        for (int j = 0; j < 4; ++j) acc2[i][j] += a[i] * cc[j];
                }
            }
        }
#pragma unroll
        for (int i = 0; i < 4; ++i) {
            const int r = ty * 4 + i;
            if (r >= nrows) continue;
            const long crow = row0 + r;
#pragma unroll
            for (int j = 0; j < 4; ++j) {
                const int c = col0 + tx * 4 + j;
                float v = acc[i][j];
                if (EPI == 1) v += g.R[crow * g.ldr + c];
                if (EPI == 2) v *= g.scale;
                if (EPI == 3) { const float s = v; v = s * sigmoidf_(s) * acc2[i][j]; }
                if (EPI == 4) v *= g.rowscale[crow];
                stf(C + crow * g.ldc + c, v);
            }
        }
    }
}

struct RwkvBufs { bf16 *R, *Kp, *V, *KK, *Bv, *G; bf16* LW; float* RK; float* Y; };
__device__ void rwkv_prep_ph(const bf16* __restrict__ proj, const float* __restrict__ mu, const float* __restrict__ w0,
                             const float* __restrict__ wdec, const float* __restrict__ a0, const float* __restrict__ wiclr,
                             const float* __restrict__ wgate, const float* __restrict__ k_k, const float* __restrict__ k_a,
                             const float* __restrict__ r_k, const RwkvBufs& o, char* lds) {
    float* lin = (float*)lds;
    const int c = threadIdx.x;
    for (int m = GB; m < M; m += GN) {
        const int s = m % S;
        const bf16* z = proj + (size_t)m * DSHIFT; const bf16* zp = z - DSHIFT;
        auto shift = [&](int col) { const float zc = bf2f(z[col]); const float pc = (s > 0) ? bf2f(zp[col]) : 0.f; return zc + (pc - zc) * mu[col]; };
        const float r = shift(c), k = shift(512 + c), v = shift(1024 + c);
        __syncthreads();
        if (c < 256) {
            const float t = shift(1536 + c);
            lin[c] = (c < 64) ? tanhf(t) : (c < 128 ? t : sigmoidf_(t));
        }
        __syncthreads();
        float dec = w0[c], aic = a0[c], gg = 0.f;
#pragma unroll 8
        for (int j = 0; j < 64; ++j) { dec += lin[j] * wdec[j * 512 + c]; aic += lin[64 + j] * wiclr[j * 512 + c]; }
#pragma unroll 8
        for (int j = 0; j < 128; ++j) gg += lin[128 + j] * wgate[j * 512 + c];
        const float nd = -dec;
        const float sp = fmaxf(nd, 0.f) + log1pf(__expf(-fabsf(nd)));
        const float logw = -sp - 0.5f;
        const float lw = -__expf(logw);
        const float a = sigmoidf_(aic);
        float kk = k * k_k[c];
        const float ss = wave_sum(kk * kk);
        kk = kk / fmaxf(sqrtf(ss), 1e-12f);
        const float kp = k * (1.f + (a - 1.f) * k_a[c]);
        const float bv = kk * a;
        const float rk = wave_sum(r * kp * r_k[c]);
        const size_t i = (size_t)m * 512 + c;
        o.R[i] = f2bf(r); o.Kp[i] = f2bf(kp); o.V[i] = f2bf(v); o.KK[i] = f2bf(kk); o.Bv[i] = f2bf(bv); o.G[i] = f2bf(gg); o.LW[i] = f2bf(lw);
        if ((c & 63) == 0) o.RK[(size_t)m * 8 + (c >> 6)] = rk;
    }
}

__device__ void rwkv_scan_ph(const RwkvBufs& o) {
    const int lane = threadIdx.x & 63, wv = threadIdx.x >> 6, j = lane & 15;
    for (int item = GB + GN * wv; item < NB * 8 * 64 / 4; item += GN * 8) {
        const int row = item * 4 + (lane >> 4);
        const int bh = row >> 6, vi = row & 63, b = bh >> 3, h = bh & 7;
        float s0 = 0.f, s1 = 0.f, s2 = 0.f, s3 = 0.f;
        size_t idx = (size_t)b * S * 512 + h * 64;
        struct In { uint2 r, kp, kk, bb, lw; bf16 v; };
        auto load = [&](size_t ix) { In q; q.r = *(const uint2*)(o.R + ix + 4 * j); q.kp = *(const uint2*)(o.Kp + ix + 4 * j); q.kk = *(const uint2*)(o.KK + ix + 4 * j);
            q.bb = *(const uint2*)(o.Bv + ix + 4 * j); q.lw = *(const uint2*)(o.LW + ix + 4 * j); q.v = o.V[ix + vi]; return q; };
        auto lo = [](unsigned u) { return __builtin_bit_cast(float, u << 16); };
        auto hi = [](unsigned u) { return __builtin_bit_cast(float, u & 0xffff0000u); };
        In cur = load(idx);
        for (int t = 0; t < S; ++t) {
            In nxt = cur;
            if (t + 1 < S) nxt = load(idx + 512);
            const float w0_ = __expf(lo(cur.lw.x)), w1_ = __expf(hi(cur.lw.x)), w2_ = __expf(lo(cur.lw.y)), w3_ = __expf(hi(cur.lw.y));
            float sa = s0 * lo(cur.kk.x) + s1 * hi(cur.kk.x) + s2 * lo(cur.kk.y) + s3 * hi(cur.kk.y);
            sa += __shfl_xor(sa, 1); sa += __shfl_xor(sa, 2); sa += __shfl_xor(sa, 4); sa += __shfl_xor(sa, 8);
            sa = -sa;
            const float vv = bf2f(cur.v);
            s0 = s0 * w0_ + sa * lo(cur.bb.x) + vv * lo(cur.kp.x);
            s1 = s1 * w1_ + sa * hi(cur.bb.x) + vv * hi(cur.kp.x);
            s2 = s2 * w2_ + sa * lo(cur.bb.y) + vv * lo(cur.kp.y);
            s3 = s3 * w3_ + sa * hi(cur.bb.y) + vv * hi(cur.kp.y);
            float y = s0 * lo(cur.r.x) + s1 * hi(cur.r.x) + s2 * lo(cur.r.y) + s3 * hi(cur.r.y);
            y += __shfl_xor(y, 1); y += __shfl_xor(y, 2); y += __shfl_xor(y, 4); y += __shfl_xor(y, 8);
            if (j == 0) o.Y[idx + vi] = y;
            idx += 512; cur = nxt;
        }
    }
}

__device__ void rwkv_post_ph(const RwkvBufs& o, const float* __restrict__ lnw, const float* __restrict__ lnb, bf16* __restrict__ ymix) {
    const int c = threadIdx.x;
    for (int m = GB; m < M; m += GN) {
        const size_t i = (size_t)m * 512 + c;
        const float y = o.Y[i];
        const float mean = wave_sum(y) * (1.f / 64.f);
        const float d = y - mean;
        const float var = wave_sum(d * d) * (1.f / 64.f);
        float yn = d * rsqrtf(var + 64e-5f) * lnw[c] + lnb[c];
        yn += o.RK[(size_t)m * 8 + (c >> 6)] * bf2f(o.V[i]);
        ymix[(size_t)m * D + c] = f2bf(yn * bf2f(o.G[i]));
    }
}

__device__ void s5_scan_ph(const bf16* __restrict__ proj, const float* __restrict__ lam_re, const float* __restrict__ lam_im,
                           const float* __restrict__ log_dt, const float* __restrict__ b_re, const float* __restrict__ b_im,
                           const float* __restrict__ c_re, const float* __restrict__ c_im, const float* __restrict__ dsk,
                           float* __restrict__ ys5) {
    const int n = threadIdx.x & 63, wv = threadIdx.x >> 6;
    for (int bg = GB + GN * wv; bg < NB * 32; bg += GN * 8) {
        const int b = bg >> 5, g = bg & 31;
        const float lr = lam_re[g * 64 + n], li = lam_im[g * 64 + n], dt = __expf(log_dt[g]);
        const float er = __expf(lr * dt); float sn, cs; sincosf(li * dt, &sn, &cs);
        const float lbr = er * cs, lbi = er * sn;
        const float nr = lbr - 1.f, ni = lbi, den = lr * lr + li * li;
        const float cr = (nr * lr + ni * li) / den, ci = (ni * lr - nr * li) / den;
        float Br[16], Bi[16], Cr[16], Ci[16], Dk[16];
#pragma unroll
        for (int h = 0; h < 16; ++h) {
            const float br = b_re[(g * 64 + n) * 16 + h], bi = b_im[(g * 64 + n) * 16 + h];
            Br[h] = cr * br - ci * bi; Bi[h] = cr * bi + ci * br;
            Cr[h] = c_re[(g * 16 + h) * 64 + n]; Ci[h] = c_im[(g * 16 + h) * 64 + n];
            Dk[h] = dsk[g * 16 + h];
        }
        float xr = 0.f, xi = 0.f;
        const bf16* up = proj + (size_t)b * S * DIN + DSHIFT + g * 16;
        float* yp = ys5 + (size_t)b * S * 512 + g * 16;
        const int hsel = ((n >> 5) & 1) * 8 + ((n >> 4) & 1) * 4 + ((n >> 3) & 1) * 2 + ((n >> 2) & 1);
        for (int t = 0; t < S; ++t) {
            float u[16];
#pragma unroll
            for (int q = 0; q < 2; ++q) { const uint4 t4 = *(const uint4*)(up + 8 * q); const unsigned tw[4] = {t4.x, t4.y, t4.z, t4.w};
#pragma unroll
                for (int e = 0; e < 4; ++e) { u[8 * q + 2 * e] = __builtin_bit_cast(float, tw[e] << 16); u[8 * q + 2 * e + 1] = __builtin_bit_cast(float, tw[e] & 0xffff0000u); } }
            float bur = 0.f, bui = 0.f;
#pragma unroll
            for (int h = 0; h < 16; ++h) { bur += u[h] * Br[h]; bui += u[h] * Bi[h]; }
            const float nxr = lbr * xr - lbi * xi + bur, nxi = lbr * xi + lbi * xr + bui;
            xr = nxr; xi = nxi;
            float vals[16];
#pragma unroll
            for (int h = 0; h < 16; ++h) vals[h] = Cr[h] * xr - Ci[h] * xi;
#pragma unroll
            for (int i = 0; i < 8; ++i) { const bool up_ = (n & 32) != 0; const float send = up_ ? vals[i] : vals[i + 8]; const float keep = up_ ? vals[i + 8] : vals[i]; vals[i] = keep + __shfl_xor(send, 32); }
#pragma unroll
            for (int i = 0; i < 4; ++i) { const bool up_ = (n & 16) != 0; const float send = up_ ? vals[i] : vals[i + 4]; const float keep = up_ ? vals[i + 4] : vals[i]; vals[i] = keep + __shfl_xor(send, 16); }
#pragma unroll
            for (int i = 0; i < 2; ++i) { const bool up_ = (n & 8) != 0; const float send = up_ ? vals[i] : vals[i + 2]; const float keep = up_ ? vals[i + 2] : vals[i]; vals[i] = keep + __shfl_xor(send, 8); }
            { const bool up_ = (n & 4) != 0; const float send = up_ ? vals[0] : vals[1]; const float keep = up_ ? vals[1] : vals[0]; vals[0] = keep + __shfl_xor(send, 4); }
            float yv = vals[0];
            yv += __shfl_xor(yv, 1); yv += __shfl_xor(yv, 2);
            float usel = 0.f, dsel = 0.f;
#pragma unroll
            for (int h = 0; h < 16; ++h) { if (h == hsel) { usel = u[h]; dsel = Dk[h]; } }
            if ((n & 3) == 0) yp[hsel] = yv + dsel * usel;
            up += DIN; yp += 512;
        }
    }
}

__device__ void gelu_ph(const float* __restrict__ in, bf16* __restrict__ out, size_t n) {
    for (size_t i = (size_t)GB * NT + threadIdx.x; i < n; i += (size_t)GN * NT) out[i] = f2bf(gelu_tanh(in[i]));
}
__device__ void glu_ph(const float* __restrict__ z, const float* __restrict__ zg, const float* __restrict__ bglu, float* __restrict__ ymix) {
    for (size_t i = (size_t)GB * NT + threadIdx.x; i < (size_t)M * 512; i += (size_t)GN * NT) {
        const int c = (int)(i & 511); const size_t m = i >> 9; ymix[m * D + 512 + c] = z[i] * sigmoidf_(zg[i] + bglu[c]);
    }
}

__device__ void softmax256_ph(float* __restrict__ sc, size_t rows) {
    const int lane = threadIdx.x & 63, wv = threadIdx.x >> 6;
    for (size_t row = (size_t)GB * 8 + wv; row < rows; row += (size_t)GN * 8) {
        float4* p = (float4*)(sc + row * 256) + lane;
        float4 v = *p;
        float mx = fmaxf(fmaxf(v.x, v.y), fmaxf(v.z, v.w));
#pragma unroll
        for (int o = 1; o < 64; o <<= 1) mx = fmaxf(mx, __shfl_xor(mx, o));
        v.x = __expf(v.x - mx); v.y = __expf(v.y - mx); v.z = __expf(v.z - mx); v.w = __expf(v.w - mx);
        const float s = wave_sum(v.x + v.y + v.z + v.w), inv = 1.f / s;
        v.x *= inv; v.y *= inv; v.z *= inv; v.w *= inv;
        *p = v;
    }
}

constexpr int PSLOTS = NASSIGN + NEXP * 256;
constexpr int MAXTILES = PSLOTS / 256;
struct MoeBufs { int* tok_e; float* tok_g; int* tok_slot; int* slot_tok; float* slot_gate; int* counts; int* offs; int* cursor; int* tiles; int* ntiles; };
__device__ void moe_zero_ph(const MoeBufs& mb) {
    if (GB == 0 && threadIdx.x < 32) { mb.counts[threadIdx.x] = 0; mb.cursor[threadIdx.x] = 0; }
    for (int i = GB * NT + threadIdx.x; i < PSLOTS; i += GN * NT) { mb.slot_tok[i] = 0; mb.slot_gate[i] = 0.f; }
}
__device__ void router_ph(const float* __restrict__ x3, const float* __restrict__ nw, bf16* __restrict__ h3, const float* __restrict__ wrg, const float* __restrict__ brg,
                          const float* __restrict__ wre, const float* __restrict__ bre, const MoeBufs& mb) {
    const int lane = threadIdx.x & 63, wv = threadIdx.x >> 6;
    for (int m = GB * 8 + wv; m < M; m += GN * 8) {
        const float4* xr = (const float4*)(x3 + (size_t)m * D);
        float h[16]; float s = 0.f;
#pragma unroll
        for (int j = 0; j < 4; ++j) { const float4 v = xr[lane + 64 * j]; h[4 * j] = v.x; h[4 * j + 1] = v.y; h[4 * j + 2] = v.z; h[4 * j + 3] = v.w; s += v.x * v.x + v.y * v.y + v.z * v.z + v.w * v.w; }
        s = wave_sum(s);
        const float rs = rsqrtf(s * (1.f / D) + 1e-6f);
        float l1[4] = {0.f, 0.f, 0.f, 0.f};
#pragma unroll
        for (int j = 0; j < 4; ++j) {
            const int k0 = (lane + 64 * j) * 4;
            const float4 g = *(const float4*)(nw + k0);
            h[4 * j] *= rs * g.x; h[4 * j + 1] *= rs * g.y; h[4 * j + 2] *= rs * g.z; h[4 * j + 3] *= rs * g.w;
            uint2 o; o.x = pk2(h[4 * j], h[4 * j + 1]); o.y = pk2(h[4 * j + 2], h[4 * j + 3]);
            *(uint2*)(h3 + (size_t)m * D + k0) = o;
#pragma unroll
            for (int e = 0; e < 4; ++e) { const float4 w = *(const float4*)(wrg + (k0 + e) * 4); const float x = h[4 * j + e]; l1[0] += x * w.x; l1[1] += x * w.y; l1[2] += x * w.z; l1[3] += x * w.w; }
        }
#pragma unroll
        for (int i = 0; i < 4; ++i) l1[i] = wave_sum(l1[i]) + brg[i];
        int grp = 0; float best = l1[0];
#pragma unroll
        for (int i = 1; i < 4; ++i) if (l1[i] > best) { best = l1[i]; grp = i; }
        float se = 0.f;
#pragma unroll
        for (int i = 0; i < 4; ++i) se += __expf(l1[i] - best);
        const float g1 = 1.f / se;
        float l2[8] = {};
        const float* we = wre + (size_t)grp * D * 8;
#pragma unroll
        for (int j = 0; j < 4; ++j) {
            const int k0 = (lane + 64 * j) * 4;
#pragma unroll
            for (int e = 0; e < 4; ++e) { const float x = h[4 * j + e]; const float4 w0 = *(const float4*)(we + (k0 + e) * 8), w1 = *(const float4*)(we + (k0 + e) * 8 + 4);
                l2[0] += x * w0.x; l2[1] += x * w0.y; l2[2] += x * w0.z; l2[3] += x * w0.w; l2[4] += x * w1.x; l2[5] += x * w1.y; l2[6] += x * w1.z; l2[7] += x * w1.w; }
        }
#pragma unroll
        for (int i = 0; i < 8; ++i) l2[i] = wave_sum(l2[i]) + bre[grp * 8 + i];
        int i0 = 0; float v0 = l2[0];
#pragma unroll
        for (int i = 1; i < 8; ++i) if (l2[i] > v0) { v0 = l2[i]; i0 = i; }
        int i1 = -1; float v1 = -3.0e38f;
#pragma unroll
        for (int i = 0; i < 8; ++i) if (i != i0 && l2[i] > v1) { v1 = l2[i]; i1 = i; }
        const float e1 = __expf(v1 - v0), inv = 1.f / (1.f + e1);
        if (lane == 0) {
            const int ea = grp * 8 + i0, eb = grp * 8 + i1;
            mb.tok_e[2 * m] = ea; mb.tok_e[2 * m + 1] = eb;
            mb.tok_g[2 * m] = g1 * inv; mb.tok_g[2 * m + 1] = g1 * e1 * inv;
            atomicAdd(&mb.counts[ea], 1); atomicAdd(&mb.counts[eb], 1);
        }
    }
}
__device__ void moe_plan_ph(const MoeBufs& mb) {
    if (GB == 0 && threadIdx.x == 0) {
        int off = 0, nt = 0;
        for (int e = 0; e < NEXP; ++e) {
            mb.offs[e] = off; const int c = mb.counts[e];
            for (int r0 = 0; r0 < c; r0 += 256) { mb.tiles[nt] = e; ++nt; }
            off += ((c + 255) / 256) * 256;
        }
        *mb.ntiles = nt;
    }
}
__device__ void moe_scatter_ph(const MoeBufs& mb) {
    for (int i = GB * NT + threadIdx.x; i < NASSIGN; i += GN * NT) {
        const int e = mb.tok_e[i];
        const int pos = mb.offs[e] + atomicAdd(&mb.cursor[e], 1);
        mb.slot_tok[pos] = i >> 1; mb.slot_gate[pos] = mb.tok_g[i]; mb.tok_slot[i] = pos;
    }
}
__device__ void moe_gather_ph(const bf16* __restrict__ h3, bf16* __restrict__ xg, const MoeBufs& mb) {
    const int lane = threadIdx.x & 63, wv = threadIdx.x >> 6;
    const int nrows = __hip_atomic_load(mb.ntiles, __ATOMIC_RELAXED, __HIP_MEMORY_SCOPE_AGENT) * 256;
    for (int r = GB * 8 + wv; r < nrows; r += GN * 8) {
        const int t = mb.slot_tok[r];
        const uint4* s = (const uint4*)(h3 + (size_t)t * D); uint4* d = (uint4*)(xg + (size_t)r * D);
        d[lane] = s[lane]; d[lane + 64] = s[lane + 64];
    }
}
__device__ void moe_weights_ph(const float* __restrict__ wg, const float* __restrict__ wu, const float* __restrict__ wd, bf16* __restrict__ wgu_t, bf16* __restrict__ wd_t, char* lds) {
    const int lane = threadIdx.x & 63, wv = threadIdx.x >> 6;
    float* scr = (float*)(lds + wv * 16384);
    constexpr int I_GU = 16 * 16;
    constexpr int I_D = 8 * 32;
    constexpr int NIT = NEXP * (2 * I_GU + I_D);
    for (int it = GB * 8 + wv; it < NIT; it += GN * 8) {
        const int e = it / (2 * I_GU + I_D); int r = it % (2 * I_GU + I_D);
        if (r < 2 * I_GU) {
            const int up = r / I_GU; r %= I_GU;
            const int kb = r / 16, nb = r % 16;
            const int pn = nb / 4, nsub = nb % 4;
            const float* W = (up ? wu : wg) + (size_t)e * D * DEXP + nb * 32;
            transpose_item(W + (size_t)kb * 64 * DEXP, 64, 32, wgu_t, D, e * 1024 + pn * 256 + up * 128 + nsub * 32, kb * 64, scr, 0, lane, nullptr, DEXP);
        } else {
            r -= 2 * I_GU;
            const int kb = r / 32, nb = r % 32;
            const float* W = wd + (size_t)e * DEXP * D + nb * 32;
            transpose_item(W + (size_t)kb * 64 * D, 64, 32, wd_t, DEXP, e * 1024 + nb * 32, kb * 64, scr, 0, lane, nullptr, D);
        }
    }
}
__device__ void final_ph(float* __restrict__ out, const bf16* __restrict__ yslot, const int* __restrict__ tok_slot, const float* __restrict__ w) {
    const int lane = threadIdx.x & 63, wv = threadIdx.x >> 6;
    for (int row = GB * 8 + wv; row < M; row += GN * 8) {
        float4* xr = (float4*)(out + (size_t)row * D);
        const uint2* ya = (const uint2*)(yslot + (size_t)tok_slot[2 * row] * D);
        const uint2* yb = (const uint2*)(yslot + (size_t)tok_slot[2 * row + 1] * D);
        float4 v[4]; float s = 0.f;
#pragma unroll
        for (int j = 0; j < 4; ++j) {
            v[j] = xr[lane + 64 * j];
            const uint2 a = ya[lane + 64 * j], b = yb[lane + 64 * j];
            v[j].x += bf2f((bf16)(a.x & 0xffff)) + bf2f((bf16)(b.x & 0xffff));
            v[j].y += bf2f((bf16)(a.x >> 16)) + bf2f((bf16)(b.x >> 16));
            v[j].z += bf2f((bf16)(a.y & 0xffff)) + bf2f((bf16)(b.y & 0xffff));
            v[j].w += bf2f((bf16)(a.y >> 16)) + bf2f((bf16)(b.y >> 16));
            s += v[j].x * v[j].x + v[j].y * v[j].y + v[j].z * v[j].z + v[j].w * v[j].w;
        }
        s = wave_sum(s);
        const float rs = rsqrtf(s * (1.f / D) + 1e-6f);
#pragma unroll
        for (int j = 0; j < 4; ++j) {
            const float4 g = *(const float4*)(w + (lane + 64 * j) * 4);
            xr[lane + 64 * j] = make_float4(v[j].x * rs * g.x, v[j].y * rs * g.y, v[j].z * rs * g.z, v[j].w * rs * g.w);
        }
    }
}


struct S5Tab { float* Kmat; bf16* BtA; bf16* BtB; };
__device__ __forceinline__ void s5_lam(const float* lam_re, const float* lam_im, const float* log_dt, int g, int n, float& a, float& w) {
    const float dt = __expf(log_dt[g]); a = lam_re[g * 64 + n] * dt; w = lam_im[g * 64 + n] * dt;
}
__device__ __forceinline__ void cexpj(float a, float w, float j, float& re, float& im) { const float e = __expf(a * j); float s, c; sincosf(w * j, &s, &c); re = e * c; im = e * s; }
__device__ __forceinline__ void s5_bbar(const float* lam_re, const float* lam_im, const float* log_dt, const float* b_re, const float* b_im, int g, int n, int h, float& br, float& bi) {
    float a, w; s5_lam(lam_re, lam_im, log_dt, g, n, a, w);
    float lbr, lbi; cexpj(a, w, 1.f, lbr, lbi);
    const float lr = lam_re[g * 64 + n], li = lam_im[g * 64 + n];
    const float nr = lbr - 1.f, ni = lbi, den = lr * lr + li * li;
    const float cr = (nr * lr + ni * li) / den, ci = (ni * lr - nr * li) / den;
    const float xr = b_re[(g * 64 + n) * 16 + h], xi = b_im[(g * 64 + n) * 16 + h];
    br = cr * xr - ci * xi; bi = cr * xi + ci * xr;
}
__device__ void s5_tables0_ph(const float* lam_re, const float* lam_im, const float* log_dt, const float* b_re, const float* b_im, const float* c_re, const float* c_im, const S5Tab& T) {
    const int gtid = GB * NT + threadIdx.x, gsz = GN * NT;
    for (int i = gtid; i < 32 * 32 * 256; i += gsz) {
        const int h = i & 15, hp = (i >> 4) & 15, j = (i >> 8) & 31, g = i >> 13;
        float acc = 0.f;
        for (int n = 0; n < 64; ++n) {
            float a, w; s5_lam(lam_re, lam_im, log_dt, g, n, a, w);
            float pr, pi; cexpj(a, w, (float)j, pr, pi);
            float br, bi; s5_bbar(lam_re, lam_im, log_dt, b_re, b_im, g, n, h, br, bi);
            const float tr = pr * br - pi * bi, ti = pr * bi + pi * br;
            acc += c_re[(g * 16 + hp) * 64 + n] * tr - c_im[(g * 16 + hp) * 64 + n] * ti;
        }
        T.Kmat[i] = acc;
    }
    for (int i = gtid; i < 32 * 256 * 512; i += gsz) {
        const int col = i & 511, r = (i >> 9) & 255, g = i >> 17;
        float v = 0.f;
        if (r < 128) {
            const int n = r & 63, s = col >> 4, h = col & 15;
            float a, w; s5_lam(lam_re, lam_im, log_dt, g, n, a, w);
            float pr, pi; cexpj(a, w, (float)(S5L - 1 - s), pr, pi);
            float br, bi; s5_bbar(lam_re, lam_im, log_dt, b_re, b_im, g, n, h, br, bi);
            v = (r < 64) ? (pr * br - pi * bi) : (pr * bi + pi * br);
        }
        T.BtA[((size_t)g * 768 + 512 + r) * 512 + col] = f2bf(v);
    }
    for (int i = gtid; i < 32 * 512 * 256; i += gsz) {
        const int k = i & 255, row = (i >> 8) & 511, g = i >> 17;
        float v = 0.f;
        if (k < 128) {
            const int n = k & 63, sp = row >> 4, hp = row & 15;
            float a, w; s5_lam(lam_re, lam_im, log_dt, g, n, a, w);
            float pr, pi; cexpj(a, w, (float)(sp + 1), pr, pi);
            const float cr = c_re[(g * 16 + hp) * 64 + n], ci = c_im[(g * 16 + hp) * 64 + n];
            v = (k < 64) ? (cr * pr - ci * pi) : -(cr * pi + ci * pr);
        }
        T.BtB[i] = f2bf(v);
    }
}
__device__ void s5_tables1_ph(const float* dsk, const S5Tab& T) {
    const int gtid = GB * NT + threadIdx.x, gsz = GN * NT;
    for (int i = gtid; i < 32 * 512 * 512; i += gsz) {
        const int col = i & 511, row = (i >> 9) & 511, g = i >> 18;
        const int sp = row >> 4, hp = row & 15, s = col >> 4, h = col & 15;
        float v = 0.f;
        if (s <= sp) v = T.Kmat[((g * 32 + (sp - s)) * 16 + hp) * 16 + h];
        if (row == col) v += dsk[g * 16 + hp];
        T.BtA[((size_t)g * 768 + row) * 512 + col] = f2bf(v);
    }
}
__device__ void s5_carry_ph(const float* lam_re, const float* lam_im, const float* log_dt, const float* __restrict__ F, bf16* __restrict__ XST) {
    const int gtid = GB * NT + threadIdx.x, gsz = GN * NT;
    for (int i = gtid; i < 32 * S5R * 16; i += gsz) { const int row = i >> 4, q = i & 15; *(uint4*)(XST + (size_t)row * 256 + 128 + q * 8) = make_uint4(0, 0, 0, 0); }
    const int lane = threadIdx.x & 63, wv = threadIdx.x >> 6;
    for (int item = GB + GN * wv; item < NB * 32; item += GN * 8) {
        const int b = item >> 5, g = item & 31, n = lane;
        float a, w; s5_lam(lam_re, lam_im, log_dt, g, n, a, w);
        float pr, pi; cexpj(a, w, (float)S5L, pr, pi);
        float xr = 0.f, xi = 0.f;
        const size_t row0 = (size_t)g * S5R + (size_t)b * (S / S5L);
        const float* f = F + row0 * 128; bf16* xo = XST + row0 * 256;
        for (int c0 = 0; c0 < S / S5L; c0 += 8) {
            float fr[8], fi[8];
#pragma unroll
            for (int q = 0; q < 8; ++q) { fr[q] = f[(size_t)(c0 + q) * 128 + n]; fi[q] = f[(size_t)(c0 + q) * 128 + 64 + n]; }
#pragma unroll
            for (int q = 0; q < 8; ++q) {
                xo[(size_t)(c0 + q) * 256 + n] = f2bf(xr); xo[(size_t)(c0 + q) * 256 + 64 + n] = f2bf(xi);
                const float nr = pr * xr - pi * xi + fr[q], ni = pr * xi + pi * xr + fi[q];
                xr = nr; xi = ni;
            }
        }
    }
}

struct Params { const float* in[41]; float* out; char* ws; };

constexpr size_t W_PROJ = 0;
constexpr size_t W_US5 = 224;
constexpr size_t W_WTS = 288;
constexpr size_t W_YI = 352;
constexpr size_t W_F = 416;
constexpr size_t W_XST = 448;
constexpr size_t W_Z = 480;
constexpr size_t W_MISC = 544;
constexpr size_t W_XN = 576;
constexpr size_t WO_IN = 0, WO_GLU = 5 * MiB, WO_MIX = 6 * MiB, WO_Q = 8 * MiB, WO_K = 10 * MiB, WO_V = 12 * MiB, WO_O = 14 * MiB, WO_KMAT = 16 * MiB, WO_BTA = 17 * MiB, WO_BTB = 41 * MiB;

__global__ void __launch_bounds__(NT, 2) fwd_kernel(Params p) {
    extern __shared__ __attribute__((aligned(16))) char lds[];
    cg::grid_group grid = cg::this_grid();
    PG8_LAS unsigned char* ldsl = (PG8_LAS unsigned char*)lds;
    char* ws = p.ws; char* dout = (char*)p.out; float* out = p.out;
#define IN(i) (p.in[i])
#define SYNC() grid.sync()
    char* WT = ws + W_WTS * MiB;
    bf16* w_in_t = (bf16*)(WT + WO_IN); bf16* w_glu_t = (bf16*)(WT + WO_GLU); bf16* w_mix_t = (bf16*)(WT + WO_MIX);
    bf16* w_q_t = (bf16*)(WT + WO_Q); bf16* w_k_t = (bf16*)(WT + WO_K); bf16* w_v_t = (bf16*)(WT + WO_V); bf16* w_o_t = (bf16*)(WT + WO_O);
    S5Tab stab; stab.Kmat = (float*)(WT + WO_KMAT); stab.BtA = (bf16*)(WT + WO_BTA); stab.BtB = (bf16*)(WT + WO_BTB);
    bf16* PROJ = (bf16*)(ws + W_PROJ * MiB); bf16* US5 = (bf16*)(ws + W_US5 * MiB);
    bf16* XN = (bf16*)(ws + W_XN * MiB);
    transpose_ph(IN(3), D, DIN, w_in_t, D, 0, 0, lds);
    transpose_ph(IN(23), 512, 512, w_glu_t, 512, 0, 0, lds);
    transpose_ph(IN(25), D, D, w_mix_t, D, 0, 0, lds);
    transpose_ph(IN(28), D, D, w_q_t, D, 0, 0, lds);
    transpose_ph(IN(29), D, D, w_k_t, D, 0, 0, lds);
    transpose_ph(IN(30), D, D, w_v_t, D, 0, 0, lds);
    transpose_ph(IN(31), D, D, w_o_t, D, 0, 0, lds);
    s5_tables0_ph(IN(15), IN(16), IN(17), IN(18), IN(19), IN(20), IN(21), stab);
    rmsnorm_ph<bf16>(IN(0), IN(2), XN, M);
    SYNC();
    s5_tables1_ph(IN(22), stab);
    { pg8::PlainOrder S; S.init(XN, D, w_in_t, D, M, DIN, D); pg8::EpiProj E{PROJ, US5}; pg8::gemm_phase(ldsl, S, E); }
    SYNC();
    RwkvBufs rb;
    rb.R = (bf16*)(ws + 704 * MiB); rb.Kp = (bf16*)(ws + 768 * MiB); rb.V = (bf16*)(ws + 832 * MiB); rb.KK = (bf16*)(ws + 896 * MiB); rb.Bv = (bf16*)(ws + 960 * MiB);
    rb.LW = (bf16*)(dout + 192 * MiB); rb.G = (bf16*)(dout + 0); rb.Y = (float*)(dout + 64 * MiB); rb.RK = (float*)(ws + W_MISC * MiB);
    bf16* YI = (bf16*)(ws + W_YI * MiB); float* F = (float*)(ws + W_F * MiB); bf16* XST = (bf16*)(ws + W_XST * MiB); bf16* Z = (bf16*)(ws + W_Z * MiB);
    { pg8::GroupOrder S; S.init(US5, 512, (size_t)S5R * 512, stab.BtA, 512, (size_t)768 * 512, 32, S5R, 768, 512); pg8::EpiS5a E{YI, F}; pg8::gemm_phase(ldsl, S, E); }
    rwkv_prep_ph(PROJ, IN(4), IN(5), IN(6), IN(7), IN(8), IN(9), IN(10), IN(11), IN(12), rb, lds);
    SYNC();
    s5_carry_ph(IN(15), IN(16), IN(17), F, XST);
    rwkv_scan_ph(rb);
    SYNC();
    bf16* YMIX = (bf16*)(ws + 0);
    { pg8::GroupOrder S; S.init(XST, 256, (size_t)S5R * 256, stab.BtB, 256, (size_t)512 * 256, 32, S5R, 512, 256); pg8::EpiS5b E{YI, Z}; pg8::gemm_phase(ldsl, S, E); }
    rwkv_post_ph(rb, IN(13), IN(14), YMIX);
    SYNC();
    { pg8::PlainOrder S; S.init(Z, 512, w_glu_t, 512, M, 512, 512); pg8::EpiGlu E{Z, IN(24), YMIX}; pg8::gemm_phase(ldsl, S, E); }
    SYNC();
    { pg8::PlainOrder S; S.init(YMIX, D, w_mix_t, D, M, D, D); pg8::EpiF32 E{out, D, IN(0), D}; pg8::gemm_phase(ldsl, S, E); }
    SYNC();
    bf16* KM = (bf16*)(ws + (W_MISC + 2) * MiB); bf16* VT = (bf16*)(ws + (W_MISC + 6) * MiB); bf16* MEMN = (bf16*)(ws + (W_MISC + 10) * MiB);
    rmsnorm_ph<bf16>(out, IN(26), XN, M);
    rmsnorm_ph<bf16>(IN(1), IN(27), MEMN, NB * NMEM);
    SYNC();
    bf16* Q = (bf16*)(ws + 128 * MiB);
    { pg8::PlainOrder S; S.init(MEMN, D, w_k_t, D, NB * NMEM, D, D); pg8::EpiBf16 E{KM, D}; pg8::gemm_phase(ldsl, S, E); }
    { pg8::PlainOrder S; S.init(w_v_t, D, MEMN, D, D, NB * NMEM, D); pg8::EpiBf16 E{VT, NB * NMEM}; pg8::gemm_phase(ldsl, S, E); }
    { pg8::PlainOrder S; S.init(XN, D, w_q_t, D, M, D, D); pg8::EpiBf16 E{Q, D}; pg8::gemm_phase(ldsl, S, E); }
    SYNC();
    bf16* P = (bf16*)(ws + W_YI * MiB);
    { pg8::AttnOrder S; S.init(Q, KM, D, 0); pg8::EpiSoftmax E{P, (PG8_LAS float*)(ldsl + 131072)}; pg8::gemm_phase(ldsl, S, E); }
    SYNC();
    bf16* O = XN;
    { pg8::AttnOrder S; S.init(P, VT, NB * NMEM, 1); pg8::EpiAttnO E{O}; pg8::gemm_phase(ldsl, S, E); }
    SYNC();
    { pg8::PlainOrder S; S.init(O, D, w_o_t, D, M, D, D); pg8::EpiF32 E{out, D, out, D}; pg8::gemm_phase(ldsl, S, E); }
    SYNC();
    bf16* H3 = XN;
    bf16* XG = (bf16*)(ws + 0);
    bf16* WGU_t = (bf16*)(ws + 272 * MiB); bf16* WD_t = (bf16*)(ws + 336 * MiB);
    bf16* HID = (bf16*)(ws + 368 * MiB);
    bf16* YSLOT = (bf16*)(ws + 704 * MiB);
    MoeBufs mb; char* mbase = ws + 976 * MiB;
    mb.tok_e = (int*)(mbase); mb.tok_g = (float*)(mbase + 1 * MiB); mb.tok_slot = (int*)(mbase + 2 * MiB); mb.slot_tok = (int*)(mbase + 3 * MiB);
    mb.slot_gate = (float*)(mbase + 4 * MiB); mb.counts = (int*)(mbase + 5 * MiB); mb.offs = mb.counts + 64; mb.cursor = mb.counts + 128; mb.ntiles = mb.counts + 192;
    mb.tiles = (int*)(mbase + 6 * MiB);
    moe_zero_ph(mb);
    moe_weights_ph(IN(37), IN(38), IN(39), WGU_t, WD_t, lds);
    SYNC();
    router_ph(out, IN(32), H3, IN(33), IN(34), IN(35), IN(36), mb);
    SYNC();
    moe_plan_ph(mb);
    SYNC();
    moe_scatter_ph(mb);
    SYNC();
    moe_gather_ph(H3, XG, mb);
    SYNC();
    const int ntiles = __hip_atomic_load(mb.ntiles, __ATOMIC_RELAXED, __HIP_MEMORY_SCOPE_AGENT);
    { pg8::MoeOrder S; S.init(XG, D, WGU_t, D, D, mb.tiles, ntiles, 1024); pg8::EpiSilu E{HID}; pg8::gemm_phase(ldsl, S, E); }
    SYNC();
    { pg8::MoeOrder S; S.init(HID, DEXP, WD_t, DEXP, DEXP, mb.tiles, ntiles, 1024); pg8::EpiGate E{YSLOT, mb.slot_gate}; pg8::gemm_phase(ldsl, S, E); }
    SYNC();
    final_ph(out, YSLOT, mb.tok_slot, IN(40));
}
}

extern "C" void kernel_launch(void* const* d_in, const int* in_sizes, int n_in, void* d_out, int out_size, void* d_ws, size_t ws_size, hipStream_t stream) {
    (void)in_sizes; (void)out_size; (void)ws_size;
    static int grid = 0;
    if (grid == 0) {
        int dev = 0, cus = 0, per_cu = 0;
        hipGetDevice(&dev);
        hipDeviceGetAttribute(&cus, hipDeviceAttributeMultiprocessorCount, dev);
        hipFuncSetAttribute((const void*)fwd_kernel, hipFuncAttributeMaxDynamicSharedMemorySize, LDS_BYTES);
        hipOccupancyMaxActiveBlocksPerMultiprocessor(&per_cu, (const void*)fwd_kernel, NT, LDS_BYTES);
        if (per_cu < 1) { fprintf(stderr, "occupancy query says %d blocks/CU\n", per_cu); per_cu = 1; }
        grid = cus * 1;
    }
    Params p{};
    for (int i = 0; i < 41 && i < n_in; ++i) p.in[i] = (const float*)d_in[i];
    p.out = (float*)d_out; p.ws = (char*)d_ws;
    void* args[] = {&p};
    hipError_t e = hipLaunchCooperativeKernel((const void*)fwd_kernel, dim3(grid), dim3(NT), args, LDS_BYTES, stream);
    if (e != hipSuccess) fprintf(stderr, "cooperative launch failed: %s (grid %d)\n", hipGetErrorString(e), grid);
}
```

```cpp
#include <hip/hip_runtime.h>
#include <hip/hip_cooperative_groups.h>
#include <stdint.h>
#include <cstdio>
namespace cg = cooperative_groups;

namespace {
constexpr int NB = 8, S = 8192, D = 1024, M = NB * S;
constexpr int DR = 512, DSHIFT = 1792, DIN = 2304, NMEM = 256;
constexpr int NEXP = 32, DEXP = 512, NASSIGN = 2 * M;
constexpr size_t MiB = 1u << 20;
constexpr int NT = 512;
constexpr int S5L = 32, S5R = M / S5L;
constexpr int LDS_BYTES = 147456;
#define GB ((int)blockIdx.x)
#define GN ((int)gridDim.x)

typedef unsigned short bf16;
__device__ __forceinline__ bf16 f2bf(float f) { unsigned u = __builtin_bit_cast(unsigned, f); return (bf16)((u + 0x7fffu + ((u >> 16) & 1u)) >> 16); }
__device__ __forceinline__ float bf2f(bf16 h) { return __builtin_bit_cast(float, (unsigned)h << 16); }

template <typename T> __device__ __forceinline__ float ldf(const T* p);
template <> __device__ __forceinline__ float ldf<float>(const float* p) { return *p; }
template <> __device__ __forceinline__ float ldf<bf16>(const bf16* p) { return bf2f(*p); }
template <typename T> __device__ __forceinline__ void stf(T* p, float v);
template <> __device__ __forceinline__ void stf<float>(float* p, float v) { *p = v; }
template <> __device__ __forceinline__ void stf<bf16>(bf16* p, float v) { *p = f2bf(v); }

__device__ __forceinline__ float wave_sum(float v) {
#pragma unroll
    for (int o = 1; o < 64; o <<= 1) v += __shfl_xor(v, o);
    return v;
}
__device__ __forceinline__ float sigmoidf_(float x) { return 1.f / (1.f + __expf(-x)); }


__device__ __forceinline__ float gelu_tanh(float x) { return x * sigmoidf_(1.5957691216057308f * (x + 0.044715f * x * x * x)); }

namespace pg8 {
#define PG8_LAS __attribute__((address_space(3)))
typedef short bf16x8 __attribute__((ext_vector_type(8)));
typedef float f32x4 __attribute__((ext_vector_type(4)));
typedef unsigned u32x4 __attribute__((ext_vector_type(4)));
constexpr int BM = 256, BK = 64, HALF = 128, HTB = HALF * BK * 2, STAGE_BYTES = 8 * HTB, NXCD = 8, WGM = 8;
__device__ __forceinline__ int lds_byte(int r, int c) { const int st = (r >> 4) * 2 + (c >> 5), rr = r & 15, cc = c & 31, ob = rr * 64 + cc * 2; return st * 1024 + (ob ^ (((ob >> 9) & 1) << 5)); }
__device__ __forceinline__ void stage_rc(int b, int& R, int& C) { const int st = b / 1024, sb = b % 1024, swz = sb ^ (((sb >> 9) & 1) << 5); R = (st >> 1) * 16 + swz / 64; C = (st & 1) * 32 + (swz % 64) / 2; }
__device__ __forceinline__ int perm32(int rho) { const int n = rho >> 4, i = rho & 15; return 8 * (i >> 2) + 4 * n + (i & 3); }
struct Unit { int pm, pn; };
struct PlainOrder {
    const bf16* A; const bf16* Bt; int lda, ldb, K; int nM, nN, nwg, G, c;
    __device__ void init(const bf16* A_, int lda_, const bf16* Bt_, int ldb_, int M, int N, int K_) { A = A_; Bt = Bt_; lda = lda_; ldb = ldb_; K = K_; nM = M / BM; nN = N / BM; nwg = nM * nN; G = GN; c = GB; }
    __device__ bool next(int i, Unit& u) const {
        const long L = (long)i * G + c; if (L >= nwg) return false;
        int wgid = (int)L; { const int q = nwg / NXCD, r = nwg % NXCD, xcd = wgid % NXCD, off = wgid / NXCD; wgid = (xcd < r ? xcd * (q + 1) : r * (q + 1) + (xcd - r) * q) + off; }
        const int nig = WGM * nN, gid = wgid / nig, fm = gid * WGM, gsz = (nM - fm) < WGM ? (nM - fm) : WGM;
        u.pm = fm + ((wgid % nig) % gsz); u.pn = (wgid % nig) / gsz; return true;
    }
    __device__ __forceinline__ const char* aptr(const Unit& u) const { return (const char*)(A + (size_t)u.pm * BM * lda); }
    __device__ __forceinline__ const char* bptr(const Unit& u) const { return (const char*)(Bt + (size_t)u.pn * BM * ldb); }
};
__device__ __forceinline__ unsigned cvt_pk_bf16(float lo, float hi) { unsigned r; asm volatile("v_cvt_pk_bf16_f32 %0, %1, %2" : "=v"(r) : "v"(lo), "v"(hi)); return r; }

template <class Epi, class Sched>
__device__ __forceinline__ void gemm_phase(PG8_LAS unsigned char* lds, const Sched& S, const Epi& E) {
    const int tid = threadIdx.x, wid = __builtin_amdgcn_readfirstlane(tid >> 6), lane = tid & 63, wr = wid >> 2, wc = wid & 3, fr = lane & 15, fq = lane >> 4;
    const int K = S.K, nt = K / BK;
    unsigned voffA[2], voffB[2];
#pragma unroll
    for (int i = 0; i < 2; ++i) { int R, C; stage_rc(tid * 16 + i * 8192, R, C); const int Rb = Epi::PERM ? ((R & ~31) + perm32(R & 31)) : R;
        voffA[i] = (unsigned)(R * S.lda + C) * 2u; voffB[i] = (unsigned)(Rb * S.ldb + C) * 2u; }
    const size_t kstep = (size_t)(BK * 2);
    const size_t hstepA = (size_t)HALF * S.lda * 2, hstepB = (size_t)HALF * S.ldb * 2;
    const unsigned ldsw = (unsigned)wid * 1024u;
    const int aoff = lds_byte(wr * 64 + fr, fq * 8), boff = lds_byte(wc * 32 + fr, fq * 8);
#define PG8_SA(b, h) (((b) * 2 + (h)) * HTB)
#define PG8_SB(b, h) ((4 + (b) * 2 + (h)) * HTB)
#define PG8_STAGE(bufoff, gbase, voff) do { _Pragma("unroll") for (int _i = 0; _i < 2; ++_i) \
        __builtin_amdgcn_global_load_lds((const unsigned*)((const char*)(gbase) + (voff)[_i]), (PG8_LAS unsigned*)(lds + (bufoff) + ldsw + _i * 8192), 16, 0, 0); } while (0)
#define PG8_LDA(dst, b, h) do { _Pragma("unroll") for (int m = 0; m < 4; ++m) _Pragma("unroll") for (int k = 0; k < 2; ++k) dst[m][k] = *(const PG8_LAS bf16x8*)(lds + PG8_SA(b, h) + aoff + m * 2048 + k * 1024); } while (0)
#define PG8_LDB(dst, b, h) do { _Pragma("unroll") for (int n = 0; n < 2; ++n) _Pragma("unroll") for (int k = 0; k < 2; ++k) dst[n][k] = *(const PG8_LAS bf16x8*)(lds + PG8_SB(b, h) + boff + n * 2048 + k * 1024); } while (0)
#define PG8_MMA(ai, bj, At, Bt) do { __builtin_amdgcn_s_setprio(1); _Pragma("unroll") for (int m = 0; m < 4; ++m) _Pragma("unroll") for (int n = 0; n < 2; ++n) _Pragma("unroll") for (int k = 0; k < 2; ++k) \
        acc[ai][bj][m][n] = __builtin_amdgcn_mfma_f32_16x16x32_bf16(Bt[n][k], At[m][k], acc[ai][bj][m][n], 0, 0, 0); __builtin_amdgcn_s_setprio(0); } while (0)
#define PG8_WAIT_V(n) asm volatile("s_waitcnt vmcnt(" #n ")" ::: "memory")
#define PG8_WAIT_L(n) asm volatile("s_waitcnt lgkmcnt(" #n ")" ::: "memory")
#define PG8_BAR __builtin_amdgcn_s_barrier()
#define PG8_SCHED __builtin_amdgcn_sched_barrier(0)
    Unit cur, nxt; int ui = 0;
    if (!S.next(0, cur)) return;
    f32x4 acc[2][2][4][2];
#pragma unroll
    for (int a = 0; a < 2; ++a)
#pragma unroll
        for (int b = 0; b < 2; ++b)
#pragma unroll
            for (int m = 0; m < 4; ++m)
#pragma unroll
                for (int n = 0; n < 2; ++n) acc[a][b][m][n] = (f32x4){0.f, 0.f, 0.f, 0.f};
    bf16x8 At[4][2], B0[2][2], B1[2][2];
    const char* cA = S.aptr(cur); const char* cB = S.bptr(cur);
    PG8_STAGE(PG8_SB(0, 0), cB, voffB); PG8_STAGE(PG8_SB(0, 1), cB + hstepB, voffB); PG8_STAGE(PG8_SA(0, 0), cA, voffA); PG8_STAGE(PG8_SA(0, 1), cA + hstepA, voffA);
    if (wr == 1) PG8_BAR;
    PG8_WAIT_V(2); PG8_BAR;
    PG8_STAGE(PG8_SB(1, 0), cB + kstep, voffB); PG8_STAGE(PG8_SA(1, 0), cA + kstep, voffA); PG8_STAGE(PG8_SB(1, 1), cB + hstepB + kstep, voffB);
    PG8_WAIT_V(6); PG8_BAR;
    for (;;) {
        const bool has_next = S.next(ui + 1, nxt);
        const char* nA = has_next ? S.aptr(nxt) : cA; const char* nB = has_next ? S.bptr(nxt) : cB;
        for (int t = 0; t < nt; t += 2) {
            const bool last = (t == nt - 2);
            const char* a1 = cA + (size_t)(t + 1) * kstep;
            const char* a2 = last ? nA : cA + (size_t)(t + 2) * kstep; const char* b2 = last ? nB : cB + (size_t)(t + 2) * kstep;
            const char* a3 = a2 + kstep; const char* b3 = b2 + kstep;
            PG8_LDB(B0, 0, 0); PG8_LDB(B1, 0, 1); PG8_SCHED; PG8_LDA(At, 0, 0); PG8_STAGE(PG8_SA(1, 1), a1 + hstepA, voffA);
            PG8_WAIT_V(8); PG8_WAIT_L(0); PG8_BAR; PG8_MMA(0, 0, At, B0); PG8_MMA(0, 1, At, B1); PG8_BAR; PG8_SCHED;
            PG8_LDA(At, 0, 1); PG8_STAGE(PG8_SB(0, 0), b2, voffB); PG8_STAGE(PG8_SB(0, 1), b2 + hstepB, voffB); PG8_STAGE(PG8_SA(0, 0), a2, voffA);
            PG8_WAIT_V(8); PG8_WAIT_L(0); PG8_BAR; PG8_MMA(1, 0, At, B0); PG8_MMA(1, 1, At, B1); PG8_BAR; PG8_SCHED;
            PG8_LDB(B0, 1, 0); PG8_LDB(B1, 1, 1); PG8_SCHED; PG8_LDA(At, 1, 0); PG8_STAGE(PG8_SA(0, 1), a2 + hstepA, voffA);
            PG8_WAIT_V(8); PG8_WAIT_L(0); PG8_BAR; PG8_MMA(0, 0, At, B0); PG8_MMA(0, 1, At, B1); PG8_BAR; PG8_SCHED;
            PG8_LDA(At, 1, 1); PG8_STAGE(PG8_SB(1, 0), b3, voffB); PG8_STAGE(PG8_SB(1, 1), b3 + hstepB, voffB); PG8_STAGE(PG8_SA(1, 0), a3, voffA);
            PG8_WAIT_V(8); PG8_WAIT_L(0); PG8_BAR; PG8_MMA(1, 0, At, B0); PG8_MMA(1, 1, At, B1); PG8_BAR; PG8_SCHED;
        }
        if (wr == 0) PG8_BAR;
        E(acc, cur, wr, wc, fr, fq);
        if (!has_next) break;
#pragma unroll
        for (int a = 0; a < 2; ++a)
#pragma unroll
            for (int b = 0; b < 2; ++b)
#pragma unroll
                for (int m = 0; m < 4; ++m)
#pragma unroll
                    for (int n = 0; n < 2; ++n) acc[a][b][m][n] = (f32x4){0.f, 0.f, 0.f, 0.f};
        cur = nxt; cA = nA; cB = nB; ++ui;
        if (wr == 1) PG8_BAR;
    }
    PG8_WAIT_V(0);
    PG8_BAR;
#undef PG8_SA
#undef PG8_SB
#undef PG8_STAGE
#undef PG8_LDA
#undef PG8_LDB
#undef PG8_MMA
#undef PG8_WAIT_V
#undef PG8_WAIT_L
#undef PG8_BAR
#undef PG8_SCHED
}

struct EpiF32 {
    static constexpr bool PERM = false;
    float* C; int ldc; const float* R; int ldr;
    __device__ __forceinline__ void operator()(const f32x4 (&acc)[2][2][4][2], const Unit& u, int wr, int wc, int fr, int fq) const {
        const int row0 = u.pm * BM + wr * 64 + fr, col0 = u.pn * BM + wc * 32 + 4 * fq;
#pragma unroll
        for (int ai = 0; ai < 2; ++ai)
#pragma unroll
            for (int m = 0; m < 4; ++m) { const size_t row = (size_t)(row0 + ai * HALF + m * 16);
#pragma unroll
                for (int bj = 0; bj < 2; ++bj)
#pragma unroll
                    for (int n = 0; n < 2; ++n) { const int col = col0 + bj * HALF + 16 * n; f32x4 v = acc[ai][bj][m][n];
                        if (R) v = v + *(const f32x4*)(R + row * ldr + col);
                        *(f32x4*)(C + row * ldc + col) = v; } }
    }
};
struct EpiBf16 {
    static constexpr bool PERM = true;
    bf16* O; int ldc;
    __device__ __forceinline__ void operator()(const f32x4 (&acc)[2][2][4][2], const Unit& u, int wr, int wc, int fr, int fq) const {
        const int row0 = u.pm * BM + wr * 64 + fr, col0 = u.pn * BM + wc * 32 + 8 * fq;
#pragma unroll
        for (int ai = 0; ai < 2; ++ai)
#pragma unroll
            for (int m = 0; m < 4; ++m) { bf16* rowp = O + (size_t)(row0 + ai * HALF + m * 16) * ldc + col0;
#pragma unroll
                for (int bj = 0; bj < 2; ++bj) { const f32x4 v0 = acc[ai][bj][m][0], v1 = acc[ai][bj][m][1];
                    u32x4 w; w.x = cvt_pk_bf16(v0[0], v0[1]); w.y = cvt_pk_bf16(v0[2], v0[3]); w.z = cvt_pk_bf16(v1[0], v1[1]); w.w = cvt_pk_bf16(v1[2], v1[3]);
                    *(u32x4*)(rowp + bj * HALF) = w; } }
    }
};
struct EpiGlu {
    static constexpr bool PERM = true;
    const bf16* Z; const float* bias; bf16* YM;
    __device__ __forceinline__ void operator()(const f32x4 (&acc)[2][2][4][2], const Unit& u, int wr, int wc, int fr, int fq) const {
        const int row0 = u.pm * BM + wr * 64 + fr, col0 = u.pn * BM + wc * 32 + 8 * fq;
#pragma unroll
        for (int ai = 0; ai < 2; ++ai)
#pragma unroll
            for (int m = 0; m < 4; ++m) { const size_t row = (size_t)(row0 + ai * HALF + m * 16);
#pragma unroll
                for (int bj = 0; bj < 2; ++bj) { const int col = col0 + bj * HALF;
                    const u32x4 zz = *(const u32x4*)(Z + row * 512 + col);
                    const f32x4 b0 = *(const f32x4*)(bias + col), b1 = *(const f32x4*)(bias + col + 4);
                    const f32x4 v0 = acc[ai][bj][m][0] + b0, v1 = acc[ai][bj][m][1] + b1;
                    float o[8]; const unsigned zw[4] = {zz.x, zz.y, zz.z, zz.w};
#pragma unroll
                    for (int q = 0; q < 4; ++q) { const float zl = __builtin_bit_cast(float, zw[q] << 16), zh = __builtin_bit_cast(float, zw[q] & 0xffff0000u);
                        const float al = (q < 2) ? v0[2 * q] : v1[2 * q - 4], ah = (q < 2) ? v0[2 * q + 1] : v1[2 * q - 3];
                        o[2 * q] = zl * sigmoidf_(al); o[2 * q + 1] = zh * sigmoidf_(ah); }
                    u32x4 w; w.x = cvt_pk_bf16(o[0], o[1]); w.y = cvt_pk_bf16(o[2], o[3]); w.z = cvt_pk_bf16(o[4], o[5]); w.w = cvt_pk_bf16(o[6], o[7]);
                    *(u32x4*)(YM + row * D + 512 + col) = w; } }
    }
};

struct MoeOrder {
    const bf16* A; const bf16* Bt; int lda, ldb, K; const int* tiles; int nunits, G, c; size_t bexp;
    __device__ void init(const bf16* A_, int lda_, const bf16* Bt_, int ldb_, int K_, const int* tiles_, int ntiles, size_t bexp_) { A = A_; Bt = Bt_; lda = lda_; ldb = ldb_; K = K_; tiles = tiles_; nunits = ntiles * 4; G = GN; c = GB; bexp = bexp_; }
    __device__ bool next(int i, Unit& u) const { const int L = i * G + c; if (L >= nunits) return false; u.pm = L >> 2; u.pn = L & 3; return true; }
    __device__ __forceinline__ const char* aptr(const Unit& u) const { return (const char*)(A + (size_t)u.pm * BM * lda); }
    __device__ __forceinline__ const char* bptr(const Unit& u) const { const int e = __hip_atomic_load(tiles + u.pm, __ATOMIC_RELAXED, __HIP_MEMORY_SCOPE_AGENT); return (const char*)(Bt + ((size_t)e * bexp + (size_t)u.pn * BM) * ldb); }
};
struct EpiSilu {
    static constexpr bool PERM = true;
    bf16* HID;
    __device__ __forceinline__ void operator()(const f32x4 (&acc)[2][2][4][2], const Unit& u, int wr, int wc, int fr, int fq) const {
        const int row0 = u.pm * BM + wr * 64 + fr, col0 = u.pn * HALF + wc * 32 + 8 * fq;
#pragma unroll
        for (int ai = 0; ai < 2; ++ai)
#pragma unroll
            for (int m = 0; m < 4; ++m) { const size_t row = (size_t)(row0 + ai * HALF + m * 16);
                float o[8];
#pragma unroll
                for (int n = 0; n < 2; ++n)
#pragma unroll
                    for (int q = 0; q < 4; ++q) { const float g = acc[ai][0][m][n][q], up = acc[ai][1][m][n][q]; o[4 * n + q] = g * sigmoidf_(g) * up; }
                u32x4 w; w.x = cvt_pk_bf16(o[0], o[1]); w.y = cvt_pk_bf16(o[2], o[3]); w.z = cvt_pk_bf16(o[4], o[5]); w.w = cvt_pk_bf16(o[6], o[7]);
                *(u32x4*)(HID + row * DEXP + col0) = w; }
    }
};
struct EpiGate {
    static constexpr bool PERM = true;
    bf16* Y; const float* gate;
    __device__ __forceinline__ void operator()(const f32x4 (&acc)[2][2][4][2], const Unit& u, int wr, int wc, int fr, int fq) const {
        const int row0 = u.pm * BM + wr * 64 + fr, col0 = u.pn * BM + wc * 32 + 8 * fq;
#pragma unroll
        for (int ai = 0; ai < 2; ++ai)
#pragma unroll
            for (int m = 0; m < 4; ++m) { const size_t row = (size_t)(row0 + ai * HALF + m * 16); const float gt = gate[row];
#pragma unroll
                for (int bj = 0; bj < 2; ++bj) { const f32x4 v0 = acc[ai][bj][m][0] * gt, v1 = acc[ai][bj][m][1] * gt;
                    u32x4 w; w.x = cvt_pk_bf16(v0[0], v0[1]); w.y = cvt_pk_bf16(v0[2], v0[3]); w.z = cvt_pk_bf16(v1[0], v1[1]); w.w = cvt_pk_bf16(v1[2], v1[3]);
                    *(u32x4*)(Y + row * D + col0 + bj * HALF) = w; } }
    }
};

struct EpiProj {
    static constexpr bool PERM = true;
    bf16* PROJ; bf16* US5;
    __device__ __forceinline__ void operator()(const f32x4 (&acc)[2][2][4][2], const Unit& u, int wr, int wc, int fr, int fq) const {
        const int row0 = u.pm * BM + wr * 64 + fr, col0 = u.pn * BM + wc * 32 + 8 * fq;
#pragma unroll
        for (int ai = 0; ai < 2; ++ai)
#pragma unroll
            for (int m = 0; m < 4; ++m) { const size_t row = (size_t)(row0 + ai * HALF + m * 16);
#pragma unroll
                for (int bj = 0; bj < 2; ++bj) { const f32x4 v0 = acc[ai][bj][m][0], v1 = acc[ai][bj][m][1]; const int col = col0 + bj * HALF;
                    u32x4 w; w.x = cvt_pk_bf16(v0[0], v0[1]); w.y = cvt_pk_bf16(v0[2], v0[3]); w.z = cvt_pk_bf16(v1[0], v1[1]); w.w = cvt_pk_bf16(v1[2], v1[3]);
                    if (col < DSHIFT) *(u32x4*)(PROJ + row * DSHIFT + col) = w;
                    else { const int cc = col - DSHIFT; *(u32x4*)(US5 + ((size_t)(cc >> 4) * M + row) * 16 + (cc & 15)) = w; } } }
    }
};
struct GroupOrder {
    const bf16* A; const bf16* Bt; int lda, ldb, K; int nM, nN, nunits, G, c; size_t sA, sB;
    __device__ void init(const bf16* A_, int lda_, size_t sA_, const bf16* Bt_, int ldb_, size_t sB_, int ngroups, int Mg, int Ng, int K_) {
        A = A_; Bt = Bt_; lda = lda_; ldb = ldb_; K = K_; sA = sA_; sB = sB_; nM = Mg / BM; nN = Ng / BM; nunits = ngroups * nM * nN; G = GN; c = GB; }
    __device__ bool next(int i, Unit& u) const { const int L = i * G + c; if (L >= nunits) return false; u.pn = L % nN; u.pm = L / nN; return true; }
    __device__ __forceinline__ const char* aptr(const Unit& u) const { const int g = u.pm / nM, pm = u.pm % nM; return (const char*)(A + (size_t)g * sA + (size_t)pm * BM * lda); }
    __device__ __forceinline__ const char* bptr(const Unit& u) const { const int g = u.pm / nM; return (const char*)(Bt + (size_t)g * sB + (size_t)u.pn * BM * ldb); }
};
struct EpiS5a {
    static constexpr bool PERM = false;
    bf16* YI; float* F;
    __device__ __forceinline__ void operator()(const f32x4 (&acc)[2][2][4][2], const Unit& u, int wr, int wc, int fr, int fq) const {
        const int row0 = u.pm * BM + wr * 64 + fr, col0 = u.pn * BM + wc * 32 + 4 * fq;
#pragma unroll
        for (int ai = 0; ai < 2; ++ai)
#pragma unroll
            for (int m = 0; m < 4; ++m) { const size_t row = (size_t)(row0 + ai * HALF + m * 16);
#pragma unroll
                for (int bj = 0; bj < 2; ++bj)
#pragma unroll
                    for (int n = 0; n < 2; ++n) { const int col = col0 + bj * HALF + 16 * n; const f32x4 v = acc[ai][bj][m][n];
                        if (col < 512) { uint2 w; w.x = cvt_pk_bf16(v[0], v[1]); w.y = cvt_pk_bf16(v[2], v[3]); *(uint2*)(YI + row * 512 + col) = w; }
                        else if (col < 640) *(f32x4*)(F + row * 128 + (col - 512)) = v; } }
    }
};
struct EpiS5b {
    static constexpr bool PERM = true;
    const bf16* YI; bf16* Z;
    __device__ __forceinline__ void operator()(const f32x4 (&acc)[2][2][4][2], const Unit& u, int wr, int wc, int fr, int fq) const {
        const int row0 = u.pm * BM + wr * 64 + fr, col0 = u.pn * BM + wc * 32 + 8 * fq;
#pragma unroll
        for (int ai = 0; ai < 2; ++ai)
#pragma unroll
            for (int m = 0; m < 4; ++m) { const int row = row0 + ai * HALF + m * 16; const int g = row / S5R, rl = row % S5R;
#pragma unroll
                for (int bj = 0; bj < 2; ++bj) { const int col = col0 + bj * HALF;
                    const u32x4 yi = *(const u32x4*)(YI + (size_t)row * 512 + col);
                    const unsigned yw[4] = {yi.x, yi.y, yi.z, yi.w};
                    const f32x4 v0 = acc[ai][bj][m][0], v1 = acc[ai][bj][m][1];
                    float o[8];
#pragma unroll
                    for (int q = 0; q < 4; ++q) { const float al = (q < 2) ? v0[2 * q] : v1[2 * q - 4], ah = (q < 2) ? v0[2 * q + 1] : v1[2 * q - 3];
                        o[2 * q] = gelu_tanh(al + __builtin_bit_cast(float, yw[q] << 16)); o[2 * q + 1] = gelu_tanh(ah + __builtin_bit_cast(float, yw[q] & 0xffff0000u)); }
                    u32x4 w; w.x = cvt_pk_bf16(o[0], o[1]); w.y = cvt_pk_bf16(o[2], o[3]); w.z = cvt_pk_bf16(o[4], o[5]); w.w = cvt_pk_bf16(o[6], o[7]);
                    const size_t tok = (size_t)rl * S5L + (col >> 4);
                    *(u32x4*)(Z + tok * 512 + g * 16 + (col & 15)) = w; } }
    }
};
struct AttnOrder {
    const bf16* A; const bf16* Bt; int lda, ldb, K; int G, c; int mode;
    __device__ void init(const bf16* A_, const bf16* Bt_, int ldb_, int mode_) { A = A_; Bt = Bt_; lda = D; ldb = ldb_; K = 256; G = GN; c = GB; mode = mode_; }
    __device__ bool next(int i, Unit& u) const { const int L = i * G + c; if (L >= NB * 4 * 32) return false; u.pn = L & 3; u.pm = L >> 2; return true; }
    __device__ __forceinline__ const char* aptr(const Unit& u) const { return (const char*)(A + (size_t)u.pm * BM * D + u.pn * 256); }
    __device__ __forceinline__ const char* bptr(const Unit& u) const { const int b = u.pm >> 5;
        return (const char*)(mode == 0 ? Bt + (size_t)b * 256 * ldb + u.pn * 256 : Bt + (size_t)u.pn * 256 * ldb + b * 256); }
};
struct EpiSoftmax {
    static constexpr bool PERM = true;
    bf16* P; PG8_LAS float* scr;
    __device__ __forceinline__ void operator()(f32x4 (&acc)[2][2][4][2], const Unit& u, int wr, int wc, int fr, int fq) const {
        const float SC = 0.0625f * 1.4426950408889634f;
        PG8_LAS float* smax = scr; PG8_LAS float* ssum = scr + 1024;
#pragma unroll
        for (int ai = 0; ai < 2; ++ai)
#pragma unroll
            for (int m = 0; m < 4; ++m) { float t = -3.0e38f;
#pragma unroll
                for (int bj = 0; bj < 2; ++bj)
#pragma unroll
                    for (int n = 0; n < 2; ++n) { const f32x4 v = acc[ai][bj][m][n]; t = fmaxf(t, fmaxf(fmaxf(v[0], v[1]), fmaxf(v[2], v[3]))); }
                t = fmaxf(t, __shfl_xor(t, 16)); t = fmaxf(t, __shfl_xor(t, 32));
                if (fq == 0) smax[(ai * HALF + wr * 64 + m * 16 + fr) * 4 + wc] = t; }
        asm volatile("s_waitcnt lgkmcnt(0)" ::: "memory"); __builtin_amdgcn_s_barrier(); asm volatile("" ::: "memory");
#pragma unroll
        for (int ai = 0; ai < 2; ++ai)
#pragma unroll
            for (int m = 0; m < 4; ++m) { const f32x4 q = *(const PG8_LAS f32x4*)(smax + (ai * HALF + wr * 64 + m * 16 + fr) * 4);
                const float mm = fmaxf(fmaxf(q[0], q[1]), fmaxf(q[2], q[3])) * SC; float s = 0.f;
#pragma unroll
                for (int bj = 0; bj < 2; ++bj)
#pragma unroll
                    for (int n = 0; n < 2; ++n)
#pragma unroll
                        for (int e = 0; e < 4; ++e) { const float p = __builtin_amdgcn_exp2f(acc[ai][bj][m][n][e] * SC - mm); acc[ai][bj][m][n][e] = p; s += p; }
                s += __shfl_xor(s, 16); s += __shfl_xor(s, 32);
                if (fq == 0) ssum[(ai * HALF + wr * 64 + m * 16 + fr) * 4 + wc] = s; }
        asm volatile("s_waitcnt lgkmcnt(0)" ::: "memory"); __builtin_amdgcn_s_barrier(); asm volatile("" ::: "memory");
        const int row0 = u.pm * BM + wr * 64 + fr, col0 = u.pn * 256 + wc * 32 + 8 * fq;
#pragma unroll
        for (int ai = 0; ai < 2; ++ai)
#pragma unroll
            for (int m = 0; m < 4; ++m) { const f32x4 q = *(const PG8_LAS f32x4*)(ssum + (ai * HALF + wr * 64 + m * 16 + fr) * 4);
                const float iv = 1.f / ((q[0] + q[1]) + (q[2] + q[3]));
                bf16* rowp = P + (size_t)(row0 + ai * HALF + m * 16) * D + col0;
#pragma unroll
                for (int bj = 0; bj < 2; ++bj) { const f32x4 v0 = acc[ai][bj][m][0] * iv, v1 = acc[ai][bj][m][1] * iv; u32x4 w;
                    w.x = cvt_pk_bf16(v0[0], v0[1]); w.y = cvt_pk_bf16(v0[2], v0[3]); w.z = cvt_pk_bf16(v1[0], v1[1]); w.w = cvt_pk_bf16(v1[2], v1[3]);
                    *(u32x4*)(rowp + bj * HALF) = w; } }
    }
};
struct EpiAttnO {
    static constexpr bool PERM = true;
    bf16* O;
    __device__ __forceinline__ void operator()(const f32x4 (&acc)[2][2][4][2], const Unit& u, int wr, int wc, int fr, int fq) const {
        const int row0 = u.pm * BM + wr * 64 + fr, col0 = u.pn * 256 + wc * 32 + 8 * fq;
#pragma unroll
        for (int ai = 0; ai < 2; ++ai)
#pragma unroll
            for (int m = 0; m < 4; ++m) { bf16* rowp = O + (size_t)(row0 + ai * HALF + m * 16) * D + col0;
#pragma unroll
                for (int bj = 0; bj < 2; ++bj) { const f32x4 v0 = acc[ai][bj][m][0], v1 = acc[ai][bj][m][1];
                    u32x4 w; w.x = cvt_pk_bf16(v0[0], v0[1]); w.y = cvt_pk_bf16(v0[2], v0[3]); w.z = cvt_pk_bf16(v1[0], v1[1]); w.w = cvt_pk_bf16(v1[2], v1[3]);
                    *(u32x4*)(rowp + bj * HALF) = w; } }
    }
};

struct EpiLora {
    static constexpr bool PERM = true;
    bf16* LW; size_t ostride; const float* w0; const float* a0;
    __device__ __forceinline__ void operator()(const f32x4 (&acc)[2][2][4][2], const Unit& u, int wr, int wc, int fr, int fq) const {
        const int row0 = u.pm * BM + wr * 64 + fr, col0 = u.pn * BM + wc * 32 + 8 * fq;
        const int kind = u.pn >> 1;
        bf16* O = LW + (size_t)kind * ostride;
#pragma unroll
        for (int bj = 0; bj < 2; ++bj) { const int col = (col0 + bj * HALF) & 511;
            f32x4 b0 = (f32x4){0.f, 0.f, 0.f, 0.f}, b1 = b0;
            if (kind == 0) { b0 = *(const f32x4*)(w0 + col); b1 = *(const f32x4*)(w0 + col + 4); }
            else if (kind == 1) { b0 = *(const f32x4*)(a0 + col); b1 = *(const f32x4*)(a0 + col + 4); }
#pragma unroll
            for (int ai = 0; ai < 2; ++ai)
#pragma unroll
                for (int m = 0; m < 4; ++m) { const size_t row = (size_t)(row0 + ai * HALF + m * 16);
                    const f32x4 v0 = acc[ai][bj][m][0] + b0, v1 = acc[ai][bj][m][1] + b1; float o[8];
#pragma unroll
                    for (int e = 0; e < 8; ++e) { float x = (e < 4) ? v0[e & 3] : v1[e & 3];
                        if (kind == 0) { const float nd = -x; const float sp = fmaxf(nd, 0.f) + __logf(1.f + __expf(-fabsf(nd))); x = -__expf(-sp - 0.5f); }
                        else if (kind == 1) x = sigmoidf_(x);
                        o[e] = x; }
                    u32x4 w; w.x = cvt_pk_bf16(o[0], o[1]); w.y = cvt_pk_bf16(o[2], o[3]); w.z = cvt_pk_bf16(o[4], o[5]); w.w = cvt_pk_bf16(o[6], o[7]);
                    *(u32x4*)(O + row * 512 + col) = w; } }
    }
};
}

#define LAS __attribute__((address_space(3)))
__device__ __forceinline__ unsigned pk2(float lo, float hi) { return (unsigned)f2bf(lo) | ((unsigned)f2bf(hi) << 16); }
__device__ __forceinline__ void transpose_item(const float* __restrict__ W, int K, int N, bf16* __restrict__ WT, int ldt, int row_off, int col_off, float* scr, int item, int lane, const float* __restrict__ kscale, int ldw = 0) {
    if (ldw == 0) ldw = N;
    const int nblk = N / 32, kb = item / nblk, nb = item % nblk, k0 = 64 * kb, n0 = 32 * nb;
#pragma unroll 8
    for (int i = 0; i < 32; ++i) { const int kk = 2 * i + (lane >> 5); float v = W[(size_t)(k0 + kk) * ldw + n0 + (lane & 31)]; if (kscale) v *= kscale[k0 + kk]; scr[kk * 33 + (lane & 31)] = v; }
    __builtin_amdgcn_s_waitcnt(0xc07f); asm volatile("" ::: "memory");
    const int c = lane & 7;
#pragma unroll
    for (int j = 0; j < 4; ++j) { const int n = (lane >> 3) + 8 * j; const float* s = scr + (8 * c) * 33 + n;
        uint4 o; o.x = pk2(s[0 * 33], s[1 * 33]); o.y = pk2(s[2 * 33], s[3 * 33]); o.z = pk2(s[4 * 33], s[5 * 33]); o.w = pk2(s[6 * 33], s[7 * 33]);
        *(uint4*)(WT + (size_t)(row_off + n0 + n) * ldt + col_off + k0 + 8 * c) = o; }
    __builtin_amdgcn_s_waitcnt(0xc07f); asm volatile("" ::: "memory");
}
__device__ __forceinline__ void transpose_ph(const float* W, int K, int N, bf16* WT, int ldt, int row_off, int col_off, char* lds, const float* kscale = nullptr) {
    const int lane = threadIdx.x & 63, wv = threadIdx.x >> 6;
    float* scr = (float*)(lds + wv * 16384);
    const int nitems = (K / 64) * (N / 32);
    for (int it = GB * 8 + wv; it < nitems; it += GN * 8) transpose_item(W, K, N, WT, ldt, row_off, col_off, scr, it, lane, kscale);
}

template <typename TO>
__device__ __forceinline__ void rmsnorm_ph(const float* __restrict__ x, const float* __restrict__ w, TO* __restrict__ out, int rows) {
    const int lane = threadIdx.x & 63, wv = threadIdx.x >> 6;
    for (int row = GB * 8 + wv; row < rows; row += GN * 8) {
        const float4* xr = (const float4*)(x + (size_t)row * D);
        float4 v[4]; float s = 0.f;
#pragma unroll
        for (int j = 0; j < 4; ++j) { v[j] = xr[lane + 64 * j]; s += v[j].x * v[j].x + v[j].y * v[j].y + v[j].z * v[j].z + v[j].w * v[j].w; }
        s = wave_sum(s);
        const float rs = rsqrtf(s * (1.f / D) + 1e-6f);
#pragma unroll
        for (int j = 0; j < 4; ++j) {
            const int c = (lane + 64 * j) * 4;
            const float4 g = *(const float4*)(w + c);
            TO* o = out + (size_t)row * D + c;
            stf(o + 0, v[j].x * rs * g.x); stf(o + 1, v[j].y * rs * g.y); stf(o + 2, v[j].z * rs * g.z); stf(o + 3, v[j].w * rs * g.w);
        }
    }
}

__device__ __forceinline__ void rwkv_lin_ph(const bf16* __restrict__ proj, const float* __restrict__ mu, bf16* __restrict__ lin) {
    const int lane = threadIdx.x & 63, wv = threadIdx.x >> 6;
    const float4 m4 = *(const float4*)(mu + 1536 + 4 * lane);
    for (int m = GB * 8 + wv; m < M; m += GN * 8) {
        const uint2 z = *(const uint2*)(proj + (size_t)m * DSHIFT + 1536 + 4 * lane);
        uint2 zp = make_uint2(0, 0);
        if ((m & (S - 1)) != 0) zp = *(const uint2*)(proj + (size_t)(m - 1) * DSHIFT + 1536 + 4 * lane);
        float c[4] = {__builtin_bit_cast(float, z.x << 16), __builtin_bit_cast(float, z.x & 0xffff0000u), __builtin_bit_cast(float, z.y << 16), __builtin_bit_cast(float, z.y & 0xffff0000u)};
        const float q[4] = {__builtin_bit_cast(float, zp.x << 16), __builtin_bit_cast(float, zp.x & 0xffff0000u), __builtin_bit_cast(float, zp.y << 16), __builtin_bit_cast(float, zp.y & 0xffff0000u)};
        const float mm[4] = {m4.x, m4.y, m4.z, m4.w};
#pragma unroll
        for (int e = 0; e < 4; ++e) { float t = c[e] + (q[e] - c[e]) * mm[e];
            if (lane < 16) t = 1.f - 2.f / (1.f + __expf(2.f * t));
            else if (lane >= 32) t = sigmoidf_(t);
            c[e] = t; }
        uint2 o; o.x = pk2(c[0], c[1]); o.y = pk2(c[2], c[3]);
        *(uint2*)(lin + (size_t)m * 256 + 4 * lane) = o;
    }
}
__device__ __forceinline__ void rwkv_wl_ph(const float* __restrict__ wdec, const float* __restrict__ wiclr, const float* __restrict__ wgate, bf16* __restrict__ wl) {
    for (int i = GB * NT + threadIdx.x; i < 1536 * 256; i += GN * NT) {
        const int k = i & 255, n = i >> 8; float v = 0.f;
        if (n < 512) { if (k < 64) v = wdec[k * 512 + n]; }
        else if (n < 1024) { if (k >= 64 && k < 128) v = wiclr[(k - 64) * 512 + (n - 512)]; }
        else { if (k >= 128) v = wgate[(k - 128) * 512 + (n - 1024)]; }
        wl[i] = f2bf(v);
    }
}
struct RwkvIn { const bf16* proj; const bf16* LW; const bf16* AA; const float* mu; const float* k_k; const float* k_a; const float* r_k; float* Y; float* RK; };
template <int CTRL> __device__ __forceinline__ float dppf(float x) { return __builtin_bit_cast(float, __builtin_amdgcn_update_dpp(0, __builtin_bit_cast(int, x), CTRL, 0xf, 0xf, true)); }
__device__ __forceinline__ float red32(float x) {
    x += dppf<0xB1>(x); x += dppf<0x4E>(x); x += dppf<0x141>(x); x += dppf<0x140>(x);
    x += __builtin_bit_cast(float, __builtin_amdgcn_ds_swizzle(__builtin_bit_cast(int, x), 0x401F));
    return x;
}
constexpr int TB = 64;
__device__ __forceinline__ void rwkv_scan_ph(const RwkvIn& I, char* lds) {
    float* Rs = (float*)lds; float* Ws = Rs + TB * 64; float* Kps = Ws + TB * 64; float* KKs = Kps + TB * 64; float* Bs = KKs + TB * 64; float* Vs = Bs + TB * 64; float* Ys = Vs + TB * 64;
    const int lane = threadIdx.x & 63, wv = threadIdx.x >> 6;
    for (int item = GB; item < NB * 8 * 4; item += GN) {
        const int q = item & 3, h = (item >> 2) & 7, b = item >> 5;
        const int c = lane, col = h * 64 + c;
        const float mur = I.mu[col], muk = I.mu[512 + col], muv = I.mu[1024 + col], kkc = I.k_k[col], kac = I.k_a[col], rkc = I.r_k[col];
        const int j = lane & 31, row = 16 * q + 2 * wv + (lane >> 5);
        float s0 = 0.f, s1 = 0.f;
        unsigned st0[8], st1[8], st2[8], st3[8];
#define RW_ISSUE(blk) do { _Pragma("unroll") for (int i = 0; i < 8; ++i) { \
            const int t_ = (blk) * TB + wv * 8 + i; const size_t m_ = (size_t)b * S + t_; const bf16* z_ = I.proj + m_ * DSHIFT; \
            unsigned r_ = z_[col], k_ = z_[512 + col], v_ = z_[1024 + col]; \
            if (t_ > 0) { r_ |= (unsigned)z_[col - DSHIFT] << 16; k_ |= (unsigned)z_[512 + col - DSHIFT] << 16; v_ |= (unsigned)z_[1024 + col - DSHIFT] << 16; } \
            st0[i] = r_; st1[i] = k_; st2[i] = v_; st3[i] = (unsigned)I.AA[m_ * 512 + col] | ((unsigned)I.LW[m_ * 512 + col] << 16); } } while (0)
#define RW_COMMIT(blk) do { _Pragma("unroll") for (int i = 0; i < 8; ++i) { \
            const int tl_ = wv * 8 + i; const size_t m_ = (size_t)b * S + (blk) * TB + tl_; \
            float r_ = __builtin_bit_cast(float, st0[i] << 16), k_ = __builtin_bit_cast(float, st1[i] << 16), v_ = __builtin_bit_cast(float, st2[i] << 16); \
            r_ += (__builtin_bit_cast(float, st0[i] & 0xffff0000u) - r_) * mur; k_ += (__builtin_bit_cast(float, st1[i] & 0xffff0000u) - k_) * muk; v_ += (__builtin_bit_cast(float, st2[i] & 0xffff0000u) - v_) * muv; \
            const float a_ = __builtin_bit_cast(float, st3[i] << 16), lw_ = __builtin_bit_cast(float, st3[i] & 0xffff0000u); \
            float kk_ = k_ * kkc; const float ss_ = wave_sum(kk_ * kk_); kk_ = kk_ / fmaxf(sqrtf(ss_), 1e-12f); \
            const float kp_ = k_ * (1.f + (a_ - 1.f) * kac); \
            Rs[tl_ * 64 + c] = r_; Ws[tl_ * 64 + c] = __expf(lw_); Kps[tl_ * 64 + c] = kp_; KKs[tl_ * 64 + c] = kk_; Bs[tl_ * 64 + c] = kk_ * a_; Vs[tl_ * 64 + c] = v_; \
            if (q == 0) { const float rk_ = wave_sum(r_ * kp_ * rkc); if (lane == 0) I.RK[m_ * 8 + h] = rk_; } } } while (0)
        RW_ISSUE(0);
        __syncthreads();
        RW_COMMIT(0);
        __syncthreads();
        for (int blk = 0; blk < S / TB; ++blk) {
            if (blk + 1 < S / TB) RW_ISSUE(blk + 1);
            float2 r2 = *(const float2*)(Rs + 2 * j), w2 = *(const float2*)(Ws + 2 * j), k2 = *(const float2*)(Kps + 2 * j), n2 = *(const float2*)(KKs + 2 * j), b2 = *(const float2*)(Bs + 2 * j);
            float vv = Vs[row];
#pragma unroll 4
            for (int t = 0; t < TB; ++t) {
                const int tn = (t + 1 < TB) ? t + 1 : t;
                const float2 r2n = *(const float2*)(Rs + tn * 64 + 2 * j), w2n = *(const float2*)(Ws + tn * 64 + 2 * j), k2n = *(const float2*)(Kps + tn * 64 + 2 * j),
                             n2n = *(const float2*)(KKs + tn * 64 + 2 * j), b2n = *(const float2*)(Bs + tn * 64 + 2 * j);
                const float vvn = Vs[tn * 64 + row];
                const float sa = -red32(s0 * n2.x + s1 * n2.y);
                s0 = s0 * w2.x + (sa * b2.x + vv * k2.x);
                s1 = s1 * w2.y + (sa * b2.y + vv * k2.y);
                const float y = red32(s0 * r2.x + s1 * r2.y);
                if (j == 0) Ys[t * 16 + 2 * wv + (lane >> 5)] = y;
                r2 = r2n; w2 = w2n; k2 = k2n; n2 = n2n; b2 = b2n; vv = vvn;
            }
            __syncthreads();
            { const int t = threadIdx.x >> 3, r0 = (threadIdx.x & 7) * 2; const size_t m = (size_t)b * S + blk * TB + t;
              *(float2*)(I.Y + m * 512 + h * 64 + 16 * q + r0) = *(const float2*)(Ys + t * 16 + r0); }
            if (blk + 1 < S / TB) RW_COMMIT(blk + 1);
            __syncthreads();
        }
    }
}
__device__ __forceinline__ void rwkv_post_ph(const float* __restrict__ Y, const float* __restrict__ RK, const bf16* __restrict__ proj, const float* __restrict__ mu, const bf16* __restrict__ G,
                             const float* __restrict__ lnw, const float* __restrict__ lnb, bf16* __restrict__ ymix) {
    const int c = threadIdx.x;
    const float muv = mu[1024 + c], lw_ = lnw[c], lb_ = lnb[c];
    for (int m = GB; m < M; m += GN) {
        const size_t i = (size_t)m * 512 + c;
        const float y = Y[i];
        const float mean = wave_sum(y) * (1.f / 64.f);
        const float d = y - mean;
        const float var = wave_sum(d * d) * (1.f / 64.f);
        float yn = d * rsqrtf(var + 64e-5f) * lw_ + lb_;
        float v = bf2f(proj[(size_t)m * DSHIFT + 1024 + c]);
        const float pv = (m & (S - 1)) ? bf2f(proj[(size_t)(m - 1) * DSHIFT + 1024 + c]) : 0.f;
        v += (pv - v) * muv;
        yn += RK[(size_t)m * 8 + (c >> 6)] * v;
        ymix[(size_t)m * D + c] = f2bf(yn * bf2f(G[i]));
    }
}

constexpr int PSLOTS = NASSIGN + NEXP * 256;
constexpr int MAXTILES = PSLOTS / 256;
struct MoeBufs { int* tok_e; float* tok_g; int* tok_slot; int* slot_tok; float* slot_gate; int* counts; int* offs; int* cursor; int* tiles; int* ntiles; };
__device__ __forceinline__ void moe_zero_ph(const MoeBufs& mb) {
    if (GB == 0 && threadIdx.x < 32) { mb.counts[threadIdx.x] = 0; mb.cursor[threadIdx.x] = 0; }
    for (int i = GB * NT + threadIdx.x; i < PSLOTS; i += GN * NT) { mb.slot_tok[i] = 0; mb.slot_gate[i] = 0.f; }
}
__device__ __forceinline__ void router_ph(const float* __restrict__ x3, const float* __restrict__ nw, bf16* __restrict__ h3, const float* __restrict__ wrg, const float* __restrict__ brg,
                          const float* __restrict__ wre, const float* __restrict__ bre, const MoeBufs& mb) {
    const int lane = threadIdx.x & 63, wv = threadIdx.x >> 6;
    for (int m = GB * 8 + wv; m < M; m += GN * 8) {
        const float4* xr = (const float4*)(x3 + (size_t)m * D);
        float h[16]; float s = 0.f;
#pragma unroll
        for (int j = 0; j < 4; ++j) { const float4 v = xr[lane + 64 * j]; h[4 * j] = v.x; h[4 * j + 1] = v.y; h[4 * j + 2] = v.z; h[4 * j + 3] = v.w; s += v.x * v.x + v.y * v.y + v.z * v.z + v.w * v.w; }
        s = wave_sum(s);
        const float rs = rsqrtf(s * (1.f / D) + 1e-6f);
        float l1[4] = {0.f, 0.f, 0.f, 0.f};
#pragma unroll
        for (int j = 0; j < 4; ++j) {
            const int k0 = (lane + 64 * j) * 4;
            const float4 g = *(const float4*)(nw + k0);
            h[4 * j] *= rs * g.x; h[4 * j + 1] *= rs * g.y; h[4 * j + 2] *= rs * g.z; h[4 * j + 3] *= rs * g.w;
            uint2 o; o.x = pk2(h[4 * j], h[4 * j + 1]); o.y = pk2(h[4 * j + 2], h[4 * j + 3]);
            *(uint2*)(h3 + (size_t)m * D + k0) = o;
#pragma unroll
            for (int e = 0; e < 4; ++e) { const float4 w = *(const float4*)(wrg + (k0 + e) * 4); const float x = h[4 * j + e]; l1[0] += x * w.x; l1[1] += x * w.y; l1[2] += x * w.z; l1[3] += x * w.w; }
        }
#pragma unroll
        for (int i = 0; i < 4; ++i) l1[i] = wave_sum(l1[i]) + brg[i];
        int grp = 0; float best = l1[0];
#pragma unroll
        for (int i = 1; i < 4; ++i) if (l1[i] > best) { best = l1[i]; grp = i; }
        float se = 0.f;
#pragma unroll
        for (int i = 0; i < 4; ++i) se += __expf(l1[i] - best);
        const float g1 = 1.f / se;
        float l2[8] = {};
        const float* we = wre + (size_t)grp * D * 8;
#pragma unroll
        for (int j = 0; j < 4; ++j) {
            const int k0 = (lane + 64 * j) * 4;
#pragma unroll
            for (int e = 0; e < 4; ++e) { const float x = h[4 * j + e]; const float4 w0 = *(const float4*)(we + (k0 + e) * 8), w1 = *(const float4*)(we + (k0 + e) * 8 + 4);
                l2[0] += x * w0.x; l2[1] += x * w0.y; l2[2] += x * w0.z; l2[3] += x * w0.w; l2[4] += x * w1.x; l2[5] += x * w1.y; l2[6] += x * w1.z; l2[7] += x * w1.w; }
        }
#pragma unroll
        for (int i = 0; i < 8; ++i) l2[i] = wave_sum(l2[i]) + bre[grp * 8 + i];
        int i0 = 0; float v0 = l2[0];
#pragma unroll
        for (int i = 1; i < 8; ++i) if (l2[i] > v0) { v0 = l2[i]; i0 = i; }
        int i1 = -1; float v1 = -3.0e38f;
#pragma unroll
        for (int i = 0; i < 8; ++i) if (i != i0 && l2[i] > v1) { v1 = l2[i]; i1 = i; }
        const float e1 = __expf(v1 - v0), inv = 1.f / (1.f + e1);
        if (lane == 0) {
            const int ea = grp * 8 + i0, eb = grp * 8 + i1;
            mb.tok_e[2 * m] = ea; mb.tok_e[2 * m + 1] = eb;
            mb.tok_g[2 * m] = g1 * inv; mb.tok_g[2 * m + 1] = g1 * e1 * inv;
            atomicAdd(&mb.counts[ea], 1); atomicAdd(&mb.counts[eb], 1);
        }
    }
}
__device__ __forceinline__ void moe_plan_ph(const MoeBufs& mb) {
    if (GB == 0 && threadIdx.x == 0) {
        int off = 0, nt = 0;
        for (int e = 0; e < NEXP; ++e) {
            mb.offs[e] = off; const int c = mb.counts[e];
            for (int r0 = 0; r0 < c; r0 += 256) { mb.tiles[nt] = e; ++nt; }
            off += ((c + 255) / 256) * 256;
        }
        *mb.ntiles = nt;
    }
}
__device__ __forceinline__ void moe_scatter_ph(const MoeBufs& mb) {
    for (int i = GB * NT + threadIdx.x; i < NASSIGN; i += GN * NT) {
        const int e = mb.tok_e[i];
        const int pos = mb.offs[e] + atomicAdd(&mb.cursor[e], 1);
        mb.slot_tok[pos] = i >> 1; mb.slot_gate[pos] = mb.tok_g[i]; mb.tok_slot[i] = pos;
    }
}
__device__ __forceinline__ void moe_gather_ph(const bf16* __restrict__ h3, bf16* __restrict__ xg, const MoeBufs& mb) {
    const int lane = threadIdx.x & 63, wv = threadIdx.x >> 6;
    const int nrows = __hip_atomic_load(mb.ntiles, __ATOMIC_RELAXED, __HIP_MEMORY_SCOPE_AGENT) * 256;
    for (int r = GB * 8 + wv; r < nrows; r += GN * 8) {
        const int t = mb.slot_tok[r];
        const uint4* s = (const uint4*)(h3 + (size_t)t * D); uint4* d = (uint4*)(xg + (size_t)r * D);
        d[lane] = s[lane]; d[lane + 64] = s[lane + 64];
    }
}
__device__ __forceinline__ void moe_weights_ph(const float* __restrict__ wg, const float* __restrict__ wu, const float* __restrict__ wd, bf16* __restrict__ wgu_t, bf16* __restrict__ wd_t, char* lds) {
    const int lane = threadIdx.x & 63, wv = threadIdx.x >> 6;
    float* scr = (float*)(lds + wv * 16384);
    constexpr int I_GU = 16 * 16;
    constexpr int I_D = 8 * 32;
    constexpr int NIT = NEXP * (2 * I_GU + I_D);
    for (int it = GB * 8 + wv; it < NIT; it += GN * 8) {
        const int e = it / (2 * I_GU + I_D); int r = it % (2 * I_GU + I_D);
        if (r < 2 * I_GU) {
            const int up = r / I_GU; r %= I_GU;
            const int kb = r / 16, nb = r % 16;
            const int pn = nb / 4, nsub = nb % 4;
            const float* W = (up ? wu : wg) + (size_t)e * D * DEXP + nb * 32;
            transpose_item(W + (size_t)kb * 64 * DEXP, 64, 32, wgu_t, D, e * 1024 + pn * 256 + up * 128 + nsub * 32, kb * 64, scr, 0, lane, nullptr, DEXP);
        } else {
            r -= 2 * I_GU;
            const int kb = r / 32, nb = r % 32;
            const float* W = wd + (size_t)e * DEXP * D + nb * 32;
            transpose_item(W + (size_t)kb * 64 * D, 64, 32, wd_t, DEXP, e * 1024 + nb * 32, kb * 64, scr, 0, lane, nullptr, D);
        }
    }
}
__device__ __forceinline__ void final_ph(float* __restrict__ out, const bf16* __restrict__ yslot, const int* __restrict__ tok_slot, const float* __restrict__ w) {
    const int lane = threadIdx.x & 63, wv = threadIdx.x >> 6;
    for (int row = GB * 8 + wv; row < M; row += GN * 8) {
        float4* xr = (float4*)(out + (size_t)row * D);
        const uint2* ya = (const uint2*)(yslot + (size_t)tok_slot[2 * row] * D);
        const uint2* yb = (const uint2*)(yslot + (size_t)tok_slot[2 * row + 1] * D);
        float4 v[4]; float s = 0.f;
#pragma unroll
        for (int j = 0; j < 4; ++j) {
            v[j] = xr[lane + 64 * j];
            const uint2 a = ya[lane + 64 * j], b = yb[lane + 64 * j];
            v[j].x += bf2f((bf16)(a.x & 0xffff)) + bf2f((bf16)(b.x & 0xffff));
            v[j].y += bf2f((bf16)(a.x >> 16)) + bf2f((bf16)(b.x >> 16));
            v[j].z += bf2f((bf16)(a.y & 0xffff)) + bf2f((bf16)(b.y & 0xffff));
            v[j].w += bf2f((bf16)(a.y >> 16)) + bf2f((bf16)(b.y >> 16));
            s += v[j].x * v[j].x + v[j].y * v[j].y + v[j].z * v[j].z + v[j].w * v[j].w;
        }
        s = wave_sum(s);
        const float rs = rsqrtf(s * (1.f / D) + 1e-6f);
#pragma unroll
        for (int j = 0; j < 4; ++j) {
            const float4 g = *(const float4*)(w + (lane + 64 * j) * 4);
            xr[lane + 64 * j] = make_float4(v[j].x * rs * g.x, v[j].y * rs * g.y, v[j].z * rs * g.z, v[j].w * rs * g.w);
        }
    }
}


struct S5Tab { float* Kmat; bf16* BtA; bf16* BtB; };
__device__ __forceinline__ void s5_lam(const float* lam_re, const float* lam_im, const float* log_dt, int g, int n, float& a, float& w) {
    const float dt = __expf(log_dt[g]); a = lam_re[g * 64 + n] * dt; w = lam_im[g * 64 + n] * dt;
}
__device__ __forceinline__ void cexpj(float a, float w, float j, float& re, float& im) { const float e = __expf(a * j); float s, c; sincosf(w * j, &s, &c); re = e * c; im = e * s; }
__device__ __forceinline__ void s5_bbar(const float* lam_re, const float* lam_im, const float* log_dt, const float* b_re, const float* b_im, int g, int n, int h, float& br, float& bi) {
    float a, w; s5_lam(lam_re, lam_im, log_dt, g, n, a, w);
    float lbr, lbi; cexpj(a, w, 1.f, lbr, lbi);
    const float lr = lam_re[g * 64 + n], li = lam_im[g * 64 + n];
    const float nr = lbr - 1.f, ni = lbi, den = lr * lr + li * li;
    const float cr = (nr * lr + ni * li) / den, ci = (ni * lr - nr * li) / den;
    const float xr = b_re[(g * 64 + n) * 16 + h], xi = b_im[(g * 64 + n) * 16 + h];
    br = cr * xr - ci * xi; bi = cr * xi + ci * xr;
}
__device__ __forceinline__ void s5_tables0_ph(const float* lam_re, const float* lam_im, const float* log_dt, const float* b_re, const float* b_im, const float* c_re, const float* c_im, const S5Tab& T) {
    const int gtid = GB * NT + threadIdx.x, gsz = GN * NT;
    for (int i = gtid; i < 32 * 32 * 256; i += gsz) {
        const int h = i & 15, hp = (i >> 4) & 15, j = (i >> 8) & 31, g = i >> 13;
        float acc = 0.f;
        for (int n = 0; n < 64; ++n) {
            float a, w; s5_lam(lam_re, lam_im, log_dt, g, n, a, w);
            float pr, pi; cexpj(a, w, (float)j, pr, pi);
            float br, bi; s5_bbar(lam_re, lam_im, log_dt, b_re, b_im, g, n, h, br, bi);
            const float tr = pr * br - pi * bi, ti = pr * bi + pi * br;
            acc += c_re[(g * 16 + hp) * 64 + n] * tr - c_im[(g * 16 + hp) * 64 + n] * ti;
        }
        T.Kmat[i] = acc;
    }
    for (int i = gtid; i < 32 * 256 * 512; i += gsz) {
        const int col = i & 511, r = (i >> 9) & 255, g = i >> 17;
        float v = 0.f;
        if (r < 128) {
            const int n = r & 63, s = col >> 4, h = col & 15;
            float a, w; s5_lam(lam_re, lam_im, log_dt, g, n, a, w);
            float pr, pi; cexpj(a, w, (float)(S5L - 1 - s), pr, pi);
            float br, bi; s5_bbar(lam_re, lam_im, log_dt, b_re, b_im, g, n, h, br, bi);
            v = (r < 64) ? (pr * br - pi * bi) : (pr * bi + pi * br);
        }
        T.BtA[((size_t)g * 768 + 512 + r) * 512 + col] = f2bf(v);
    }
    for (int i = gtid; i < 32 * 512 * 256; i += gsz) {
        const int k = i & 255, row = (i >> 8) & 511, g = i >> 17;
        float v = 0.f;
        if (k < 128) {
            const int n = k & 63, sp = row >> 4, hp = row & 15;
            float a, w; s5_lam(lam_re, lam_im, log_dt, g, n, a, w);
            float pr, pi; cexpj(a, w, (float)(sp + 1), pr, pi);
            const float cr = c_re[(g * 16 + hp) * 64 + n], ci = c_im[(g * 16 + hp) * 64 + n];
            v = (k < 64) ? (cr * pr - ci * pi) : -(cr * pi + ci * pr);
        }
        T.BtB[i] = f2bf(v);
    }
}
__device__ __forceinline__ void s5_tables1_ph(const float* dsk, const S5Tab& T) {
    const int gtid = GB * NT + threadIdx.x, gsz = GN * NT;
    for (int i = gtid; i < 32 * 512 * 512; i += gsz) {
        const int col = i & 511, row = (i >> 9) & 511, g = i >> 18;
        const int sp = row >> 4, hp = row & 15, s = col >> 4, h = col & 15;
        float v = 0.f;
        if (s <= sp) v = T.Kmat[((g * 32 + (sp - s)) * 16 + hp) * 16 + h];
        if (row == col) v += dsk[g * 16 + hp];
        T.BtA[((size_t)g * 768 + row) * 512 + col] = f2bf(v);
    }
}
__device__ __forceinline__ void s5_carry_ph(const float* lam_re, const float* lam_im, const float* log_dt, const float* __restrict__ F, bf16* __restrict__ XST) {
    const int gtid = GB * NT + threadIdx.x, gsz = GN * NT;
    for (int i = gtid; i < 32 * S5R * 16; i += gsz) { const int row = i >> 4, q = i & 15; *(uint4*)(XST + (size_t)row * 256 + 128 + q * 8) = make_uint4(0, 0, 0, 0); }
    const int lane = threadIdx.x & 63, wv = threadIdx.x >> 6;
    for (int item = GB + GN * wv; item < NB * 32; item += GN * 8) {
        const int b = item >> 5, g = item & 31, n = lane;
        float a, w; s5_lam(lam_re, lam_im, log_dt, g, n, a, w);
        float pr, pi; cexpj(a, w, (float)S5L, pr, pi);
        float xr = 0.f, xi = 0.f;
        const size_t row0 = (size_t)g * S5R + (size_t)b * (S / S5L);
        const float* f = F + row0 * 128; bf16* xo = XST + row0 * 256;
        for (int c0 = 0; c0 < S / S5L; c0 += 8) {
            float fr[8], fi[8];
#pragma unroll
            for (int q = 0; q < 8; ++q) { fr[q] = f[(size_t)(c0 + q) * 128 + n]; fi[q] = f[(size_t)(c0 + q) * 128 + 64 + n]; }
#pragma unroll
            for (int q = 0; q < 8; ++q) {
                xo[(size_t)(c0 + q) * 256 + n] = f2bf(xr); xo[(size_t)(c0 + q) * 256 + 64 + n] = f2bf(xi);
                const float nr = pr * xr - pi * xi + fr[q], ni = pr * xi + pi * xr + fi[q];
                xr = nr; xi = ni;
            }
        }
    }
}

struct Params { const float* in[41]; float* out; char* ws; };

constexpr size_t W_PROJ = 0;
constexpr size_t W_US5 = 224;
constexpr size_t W_WTS = 288;
constexpr size_t W_YI = 352;
constexpr size_t W_F = 416;
constexpr size_t W_XST = 448;
constexpr size_t W_Z = 480;
constexpr size_t W_MISC = 544;
constexpr size_t W_XN = 576;
constexpr size_t WO_IN = 0, WO_GLU = 5 * MiB, WO_MIX = 6 * MiB, WO_Q = 8 * MiB, WO_K = 10 * MiB, WO_V = 12 * MiB, WO_O = 14 * MiB, WO_KMAT = 16 * MiB, WO_BTA = 17 * MiB, WO_BTB = 41 * MiB;

__global__ void __launch_bounds__(NT, 2) fwd_kernel(Params p) {
    extern __shared__ __attribute__((aligned(16))) char lds[];
    cg::grid_group grid = cg::this_grid();
    PG8_LAS unsigned char* ldsl = (PG8_LAS unsigned char*)lds;
    char* ws = p.ws; char* dout = (char*)p.out; float* out = p.out;
#define IN(i) (p.in[i])
#define SYNC() grid.sync()
    char* WT = ws + W_WTS * MiB;
    bf16* w_in_t = (bf16*)(WT + WO_IN); bf16* w_glu_t = (bf16*)(WT + WO_GLU); bf16* w_mix_t = (bf16*)(WT + WO_MIX);
    bf16* w_q_t = (bf16*)(WT + WO_Q); bf16* w_k_t = (bf16*)(WT + WO_K); bf16* w_v_t = (bf16*)(WT + WO_V); bf16* w_o_t = (bf16*)(WT + WO_O);
    S5Tab stab; stab.Kmat = (float*)(WT + WO_KMAT); stab.BtA = (bf16*)(WT + WO_BTA); stab.BtB = (bf16*)(WT + WO_BTB);
    bf16* PROJ = (bf16*)(ws + W_PROJ * MiB); bf16* US5 = (bf16*)(ws + W_US5 * MiB);
    bf16* XN = (bf16*)(ws + W_XN * MiB);
    transpose_ph(IN(3), D, DIN, w_in_t, D, 0, 0, lds);
    transpose_ph(IN(23), 512, 512, w_glu_t, 512, 0, 0, lds);
    transpose_ph(IN(25), D, D, w_mix_t, D, 0, 0, lds);
    transpose_ph(IN(28), D, D, w_q_t, D, 0, 0, lds);
    transpose_ph(IN(29), D, D, w_k_t, D, 0, 0, lds);
    transpose_ph(IN(30), D, D, w_v_t, D, 0, 0, lds);
    transpose_ph(IN(31), D, D, w_o_t, D, 0, 0, lds);
    s5_tables0_ph(IN(15), IN(16), IN(17), IN(18), IN(19), IN(20), IN(21), stab);
    bf16* wl_t = (bf16*)(WT + 49 * MiB);
    rwkv_wl_ph(IN(6), IN(8), IN(9), wl_t);
    rmsnorm_ph<bf16>(IN(0), IN(2), XN, M);
    SYNC();
    s5_tables1_ph(IN(22), stab);
    { pg8::PlainOrder S; S.init(XN, D, w_in_t, D, M, DIN, D); pg8::EpiProj E{PROJ, US5}; pg8::gemm_phase(ldsl, S, E); }
    SYNC();
    bf16* LIN = (bf16*)(ws + (W_MISC + 16) * MiB);
    rwkv_lin_ph(PROJ, IN(4), LIN);
    SYNC();
    bf16* YI = (bf16*)(ws + W_YI * MiB); float* F = (float*)(ws + W_F * MiB); bf16* XST = (bf16*)(ws + W_XST * MiB); bf16* Z = (bf16*)(ws + W_Z * MiB);
    bf16* LWb = (bf16*)(ws + 704 * MiB); bf16* AAb = (bf16*)(ws + 768 * MiB); bf16* Gb = (bf16*)(ws + 832 * MiB);
    float* Yr = (float*)(ws + 896 * MiB); float* RKb = (float*)(ws + W_MISC * MiB);
    { pg8::GroupOrder S; S.init(US5, 512, (size_t)S5R * 512, stab.BtA, 512, (size_t)768 * 512, 32, S5R, 768, 512); pg8::EpiS5a E{YI, F}; pg8::gemm_phase(ldsl, S, E); }
    { pg8::PlainOrder S; S.init(LIN, 256, wl_t, 256, M, 1536, 256); pg8::EpiLora E{LWb, (size_t)32 * MiB, IN(5), IN(7)}; pg8::gemm_phase(ldsl, S, E); }
    SYNC();
    s5_carry_ph(IN(15), IN(16), IN(17), F, XST);
    { RwkvIn ri{PROJ, LWb, AAb, IN(4), IN(10), IN(11), IN(12), Yr, RKb}; rwkv_scan_ph(ri, lds); }
    SYNC();
    bf16* YMIX = XN;
    { pg8::GroupOrder S; S.init(XST, 256, (size_t)S5R * 256, stab.BtB, 256, (size_t)512 * 256, 32, S5R, 512, 256); pg8::EpiS5b E{YI, Z}; pg8::gemm_phase(ldsl, S, E); }
    rwkv_post_ph(Yr, RKb, PROJ, IN(4), Gb, IN(13), IN(14), YMIX);
    SYNC();
    { pg8::PlainOrder S; S.init(Z, 512, w_glu_t, 512, M, 512, 512); pg8::EpiGlu E{Z, IN(24), YMIX}; pg8::gemm_phase(ldsl, S, E); }
    SYNC();
    { pg8::PlainOrder S; S.init(YMIX, D, w_mix_t, D, M, D, D); pg8::EpiF32 E{out, D, IN(0), D}; pg8::gemm_phase(ldsl, S, E); }
    SYNC();
    bf16* KM = (bf16*)(ws + (W_MISC + 2) * MiB); bf16* VT = (bf16*)(ws + (W_MISC + 6) * MiB); bf16* MEMN = (bf16*)(ws + (W_MISC + 10) * MiB);
    rmsnorm_ph<bf16>(out, IN(26), XN, M);
    rmsnorm_ph<bf16>(IN(1), IN(27), MEMN, NB * NMEM);
    SYNC();
    bf16* Q = (bf16*)(ws + 128 * MiB);
    { pg8::PlainOrder S; S.init(MEMN, D, w_k_t, D, NB * NMEM, D, D); pg8::EpiBf16 E{KM, D}; pg8::gemm_phase(ldsl, S, E); }
    { pg8::PlainOrder S; S.init(w_v_t, D, MEMN, D, D, NB * NMEM, D); pg8::EpiBf16 E{VT, NB * NMEM}; pg8::gemm_phase(ldsl, S, E); }
    { pg8::PlainOrder S; S.init(XN, D, w_q_t, D, M, D, D); pg8::EpiBf16 E{Q, D}; pg8::gemm_phase(ldsl, S, E); }
    SYNC();
    bf16* P = (bf16*)(ws + W_YI * MiB);
    { pg8::AttnOrder S; S.init(Q, KM, D, 0); pg8::EpiSoftmax E{P, (PG8_LAS float*)(ldsl + 131072)}; pg8::gemm_phase(ldsl, S, E); }
    SYNC();
    bf16* O = XN;
    { pg8::AttnOrder S; S.init(P, VT, NB * NMEM, 1); pg8::EpiAttnO E{O}; pg8::gemm_phase(ldsl, S, E); }
    SYNC();
    { pg8::PlainOrder S; S.init(O, D, w_o_t, D, M, D, D); pg8::EpiF32 E{out, D, out, D}; pg8::gemm_phase(ldsl, S, E); }
    SYNC();
    bf16* H3 = XN;
    bf16* XG = (bf16*)(ws + 0);
    bf16* WGU_t = (bf16*)(ws + 272 * MiB); bf16* WD_t = (bf16*)(ws + 336 * MiB);
    bf16* HID = (bf16*)(ws + 368 * MiB);
    bf16* YSLOT = (bf16*)(ws + 704 * MiB);
    MoeBufs mb; char* mbase = ws + 976 * MiB;
    mb.tok_e = (int*)(mbase); mb.tok_g = (float*)(mbase + 1 * MiB); mb.tok_slot = (int*)(mbase + 2 * MiB); mb.slot_tok = (int*)(mbase + 3 * MiB);
    mb.slot_gate = (float*)(mbase + 4 * MiB); mb.counts = (int*)(mbase + 5 * MiB); mb.offs = mb.counts + 64; mb.cursor = mb.counts + 128; mb.ntiles = mb.counts + 192;
    mb.tiles = (int*)(mbase + 6 * MiB);
    moe_zero_ph(mb);
    moe_weights_ph(IN(37), IN(38), IN(39), WGU_t, WD_t, lds);
    SYNC();
    router_ph(out, IN(32), H3, IN(33), IN(34), IN(35), IN(36), mb);
    SYNC();
    moe_plan_ph(mb);
    SYNC();
    moe_scatter_ph(mb);
    SYNC();
    moe_gather_ph(H3, XG, mb);
    SYNC();
    const int ntiles = __hip_atomic_load(mb.ntiles, __ATOMIC_RELAXED, __HIP_MEMORY_SCOPE_AGENT);
    { pg8::MoeOrder S; S.init(XG, D, WGU_t, D, D, mb.tiles, ntiles, 1024); pg8::EpiSilu E{HID}; pg8::gemm_phase(ldsl, S, E); }
    SYNC();
    { pg8::MoeOrder S; S.init(HID, DEXP, WD_t, DEXP, DEXP, mb.tiles, ntiles, 1024); pg8::EpiGate E{YSLOT, mb.slot_gate}; pg8::gemm_phase(ldsl, S, E); }
    SYNC();
    final_ph(out, YSLOT, mb.tok_slot, IN(40));
}
}

extern "C" void kernel_launch(void* const* d_in, const int* in_sizes, int n_in, void* d_out, int out_size, void* d_ws, size_t ws_size, hipStream_t stream) {
    (void)in_sizes; (void)out_size; (void)ws_size;
    static int grid = 0;
    if (grid == 0) {
        int dev = 0, cus = 0, per_cu = 0;
        hipGetDevice(&dev);
        hipDeviceGetAttribute(&cus, hipDeviceAttributeMultiprocessorCount, dev);
        hipFuncSetAttribute((const void*)fwd_kernel, hipFuncAttributeMaxDynamicSharedMemorySize, LDS_BYTES);
        hipOccupancyMaxActiveBlocksPerMultiprocessor(&per_cu, (const void*)fwd_kernel, NT, LDS_BYTES);
        if (per_cu < 1) { fprintf(stderr, "occupancy query says %d blocks/CU\n", per_cu); per_cu = 1; }
        grid = cus * 1;
    }
    Params p{};
    for (int i = 0; i < 41 && i < n_in; ++i) p.in[i] = (const float*)d_in[i];
    p.out = (float*)d_out; p.ws = (char*)d_ws;
    void* args[] = {&p};
    hipError_t e = hipLaunchCooperativeKernel((const void*)fwd_kernel, dim3(grid), dim3(NT), args, LDS_BYTES, stream);
    if (e != hipSuccess) fprintf(stderr, "cooperative launch failed: %s (grid %d)\n", hipGetErrorString(e), grid);
}
```

```cpp
#include <hip/hip_runtime.h>
#include <hip/hip_cooperative_groups.h>
#include <stdint.h>
#include <cstdio>
namespace cg = cooperative_groups;

namespace {
constexpr int NB = 8, S = 8192, D = 1024, M = NB * S;
constexpr int DR = 512, DSHIFT = 1792, DIN = 2304, NMEM = 256;
constexpr int NEXP = 32, DEXP = 512, NASSIGN = 2 * M;
constexpr size_t MiB = 1u << 20;
constexpr int NT = 512;
constexpr int S5L = 32, S5R = M / S5L;
constexpr int LDS_BYTES = 147456;
#define GB ((int)blockIdx.x)
#define GN ((int)gridDim.x)

typedef unsigned short bf16;
__device__ __forceinline__ bf16 f2bf(float f) { unsigned u = __builtin_bit_cast(unsigned, f); return (bf16)((u + 0x7fffu + ((u >> 16) & 1u)) >> 16); }
__device__ __forceinline__ float bf2f(bf16 h) { return __builtin_bit_cast(float, (unsigned)h << 16); }

template <typename T> __device__ __forceinline__ float ldf(const T* p);
template <> __device__ __forceinline__ float ldf<float>(const float* p) { return *p; }
template <> __device__ __forceinline__ float ldf<bf16>(const bf16* p) { return bf2f(*p); }
template <typename T> __device__ __forceinline__ void stf(T* p, float v);
template <> __device__ __forceinline__ void stf<float>(float* p, float v) { *p = v; }
template <> __device__ __forceinline__ void stf<bf16>(bf16* p, float v) { *p = f2bf(v); }

template <int CTRL, int ROWMASK> __device__ __forceinline__ float dppf_(float x) { return __builtin_bit_cast(float, __builtin_amdgcn_update_dpp(0, __builtin_bit_cast(int, x), CTRL, ROWMASK, 0xf, false)); }
__device__ __forceinline__ float wave_sum(float v) {
    v += dppf_<0xB1, 0xf>(v); v += dppf_<0x4E, 0xf>(v); v += dppf_<0x141, 0xf>(v); v += dppf_<0x140, 0xf>(v);
    v += dppf_<0x142, 0xa>(v);
    v += dppf_<0x143, 0xc>(v);
    return __builtin_bit_cast(float, __builtin_amdgcn_readlane(__builtin_bit_cast(int, v), 63));
}
__device__ __forceinline__ float sigmoidf_(float x) { return 1.f / (1.f + __expf(-x)); }


__device__ __forceinline__ float gelu_tanh(float x) { return x * sigmoidf_(1.5957691216057308f * (x + 0.044715f * x * x * x)); }

namespace pg8 {
#define PG8_LAS __attribute__((address_space(3)))
typedef short bf16x8 __attribute__((ext_vector_type(8)));
typedef float f32x4 __attribute__((ext_vector_type(4)));
typedef unsigned u32x4 __attribute__((ext_vector_type(4)));
constexpr int BM = 256, BK = 64, HALF = 128, HTB = HALF * BK * 2, STAGE_BYTES = 8 * HTB, NXCD = 8, WGM = 8;
__device__ __forceinline__ int lds_byte(int r, int c) { const int st = (r >> 4) * 2 + (c >> 5), rr = r & 15, cc = c & 31, ob = rr * 64 + cc * 2; return st * 1024 + (ob ^ (((ob >> 9) & 1) << 5)); }
__device__ __forceinline__ void stage_rc(int b, int& R, int& C) { const int st = b / 1024, sb = b % 1024, swz = sb ^ (((sb >> 9) & 1) << 5); R = (st >> 1) * 16 + swz / 64; C = (st & 1) * 32 + (swz % 64) / 2; }
__device__ __forceinline__ int perm32(int rho) { const int n = rho >> 4, i = rho & 15; return 8 * (i >> 2) + 4 * n + (i & 3); }
struct Unit { int pm, pn; };
struct PlainOrder {
    const bf16* A; const bf16* Bt; int lda, ldb, K; int nM, nN, nwg, G, c;
    __device__ void init(const bf16* A_, int lda_, const bf16* Bt_, int ldb_, int M, int N, int K_) { A = A_; Bt = Bt_; lda = lda_; ldb = ldb_; K = K_; nM = M / BM; nN = N / BM; nwg = nM * nN; G = GN; c = GB; }
    __device__ bool next(int i, Unit& u) const {
        const long L = (long)i * G + c; if (L >= nwg) return false;
        int wgid = (int)L; { const int q = nwg / NXCD, r = nwg % NXCD, xcd = wgid % NXCD, off = wgid / NXCD; wgid = (xcd < r ? xcd * (q + 1) : r * (q + 1) + (xcd - r) * q) + off; }
        const int nig = WGM * nN, gid = wgid / nig, fm = gid * WGM, gsz = (nM - fm) < WGM ? (nM - fm) : WGM;
        u.pm = fm + ((wgid % nig) % gsz); u.pn = (wgid % nig) / gsz; return true;
    }
    __device__ __forceinline__ const char* aptr(const Unit& u) const { return (const char*)(A + (size_t)u.pm * BM * lda); }
    __device__ __forceinline__ const char* bptr(const Unit& u) const { return (const char*)(Bt + (size_t)u.pn * BM * ldb); }
};
__device__ __forceinline__ unsigned cvt_pk_bf16(float lo, float hi) { unsigned r; asm volatile("v_cvt_pk_bf16_f32 %0, %1, %2" : "=v"(r) : "v"(lo), "v"(hi)); return r; }

template <class Epi, class Sched>
__device__ __forceinline__ void gemm_phase(PG8_LAS unsigned char* lds, const Sched& S, const Epi& E) {
    const int tid = threadIdx.x, wid = __builtin_amdgcn_readfirstlane(tid >> 6), lane = tid & 63, wr = wid >> 2, wc = wid & 3, fr = lane & 15, fq = lane >> 4;
    const int K = S.K, nt = K / BK;
    unsigned voffA[2], voffB[2];
#pragma unroll
    for (int i = 0; i < 2; ++i) { int R, C; stage_rc(tid * 16 + i * 8192, R, C); const int Rb = Epi::PERM ? ((R & ~31) + perm32(R & 31)) : R;
        voffA[i] = (unsigned)(R * S.lda + C) * 2u; voffB[i] = (unsigned)(Rb * S.ldb + C) * 2u; }
    const size_t kstep = (size_t)(BK * 2);
    const size_t hstepA = (size_t)HALF * S.lda * 2, hstepB = (size_t)HALF * S.ldb * 2;
    const unsigned ldsw = (unsigned)wid * 1024u;
    const int aoff = lds_byte(wr * 64 + fr, fq * 8), boff = lds_byte(wc * 32 + fr, fq * 8);
#define PG8_SA(b, h) (((b) * 2 + (h)) * HTB)
#define PG8_SB(b, h) ((4 + (b) * 2 + (h)) * HTB)
#define PG8_STAGE(bufoff, gbase, voff) do { _Pragma("unroll") for (int _i = 0; _i < 2; ++_i) \
        __builtin_amdgcn_global_load_lds((const unsigned*)((const char*)(gbase) + (voff)[_i]), (PG8_LAS unsigned*)(lds + (bufoff) + ldsw + _i * 8192), 16, 0, 0); } while (0)
#define PG8_LDA(dst, b, h) do { _Pragma("unroll") for (int m = 0; m < 4; ++m) _Pragma("unroll") for (int k = 0; k < 2; ++k) dst[m][k] = *(const PG8_LAS bf16x8*)(lds + PG8_SA(b, h) + aoff + m * 2048 + k * 1024); } while (0)
#define PG8_LDB(dst, b, h) do { _Pragma("unroll") for (int n = 0; n < 2; ++n) _Pragma("unroll") for (int k = 0; k < 2; ++k) dst[n][k] = *(const PG8_LAS bf16x8*)(lds + PG8_SB(b, h) + boff + n * 2048 + k * 1024); } while (0)
#define PG8_MMA(ai, bj, At, Bt) do { __builtin_amdgcn_s_setprio(1); _Pragma("unroll") for (int m = 0; m < 4; ++m) _Pragma("unroll") for (int n = 0; n < 2; ++n) _Pragma("unroll") for (int k = 0; k < 2; ++k) \
        acc[ai][bj][m][n] = __builtin_amdgcn_mfma_f32_16x16x32_bf16(Bt[n][k], At[m][k], acc[ai][bj][m][n], 0, 0, 0); __builtin_amdgcn_s_setprio(0); } while (0)
#define PG8_WAIT_V(n) asm volatile("s_waitcnt vmcnt(" #n ")" ::: "memory")
#define PG8_WAIT_L(n) asm volatile("s_waitcnt lgkmcnt(" #n ")" ::: "memory")
#define PG8_BAR __builtin_amdgcn_s_barrier()
#define PG8_SCHED __builtin_amdgcn_sched_barrier(0)
    Unit cur, nxt; int ui = 0;
    if (!S.next(0, cur)) return;
    f32x4 acc[2][2][4][2];
#pragma unroll
    for (int a = 0; a < 2; ++a)
#pragma unroll
        for (int b = 0; b < 2; ++b)
#pragma unroll
            for (int m = 0; m < 4; ++m)
#pragma unroll
                for (int n = 0; n < 2; ++n) acc[a][b][m][n] = (f32x4){0.f, 0.f, 0.f, 0.f};
    bf16x8 At[4][2], B0[2][2], B1[2][2];
    const char* cA = S.aptr(cur); const char* cB = S.bptr(cur);
    PG8_STAGE(PG8_SB(0, 0), cB, voffB); PG8_STAGE(PG8_SB(0, 1), cB + hstepB, voffB); PG8_STAGE(PG8_SA(0, 0), cA, voffA); PG8_STAGE(PG8_SA(0, 1), cA + hstepA, voffA);
    if (wr == 1) PG8_BAR;
    PG8_WAIT_V(2); PG8_BAR;
    PG8_STAGE(PG8_SB(1, 0), cB + kstep, voffB); PG8_STAGE(PG8_SA(1, 0), cA + kstep, voffA); PG8_STAGE(PG8_SB(1, 1), cB + hstepB + kstep, voffB);
    PG8_WAIT_V(6); PG8_BAR;
    for (;;) {
        const bool has_next = S.next(ui + 1, nxt);
        const char* nA = has_next ? S.aptr(nxt) : cA; const char* nB = has_next ? S.bptr(nxt) : cB;
        for (int t = 0; t < nt; t += 2) {
            const bool last = (t == nt - 2);
            const char* a1 = cA + (size_t)(t + 1) * kstep;
            const char* a2 = last ? nA : cA + (size_t)(t + 2) * kstep; const char* b2 = last ? nB : cB + (size_t)(t + 2) * kstep;
            const char* a3 = a2 + kstep; const char* b3 = b2 + kstep;
            PG8_LDB(B0, 0, 0); PG8_LDB(B1, 0, 1); PG8_SCHED; PG8_LDA(At, 0, 0); PG8_STAGE(PG8_SA(1, 1), a1 + hstepA, voffA);
            PG8_WAIT_V(8); PG8_WAIT_L(0); PG8_BAR; PG8_MMA(0, 0, At, B0); PG8_MMA(0, 1, At, B1); PG8_BAR; PG8_SCHED;
            PG8_LDA(At, 0, 1); PG8_STAGE(PG8_SB(0, 0), b2, voffB); PG8_STAGE(PG8_SB(0, 1), b2 + hstepB, voffB); PG8_STAGE(PG8_SA(0, 0), a2, voffA);
            PG8_WAIT_V(8); PG8_WAIT_L(0); PG8_BAR; PG8_MMA(1, 0, At, B0); PG8_MMA(1, 1, At, B1); PG8_BAR; PG8_SCHED;
            PG8_LDB(B0, 1, 0); PG8_LDB(B1, 1, 1); PG8_SCHED; PG8_LDA(At, 1, 0); PG8_STAGE(PG8_SA(0, 1), a2 + hstepA, voffA);
            PG8_WAIT_V(8); PG8_WAIT_L(0); PG8_BAR; PG8_MMA(0, 0, At, B0); PG8_MMA(0, 1, At, B1); PG8_BAR; PG8_SCHED;
            PG8_LDA(At, 1, 1); PG8_STAGE(PG8_SB(1, 0), b3, voffB); PG8_STAGE(PG8_SB(1, 1), b3 + hstepB, voffB); PG8_STAGE(PG8_SA(1, 0), a3, voffA);
            PG8_WAIT_V(8); PG8_WAIT_L(0); PG8_BAR; PG8_MMA(1, 0, At, B0); PG8_MMA(1, 1, At, B1); PG8_BAR; PG8_SCHED;
        }
        if (wr == 0) PG8_BAR;
        E(acc, cur, wr, wc, fr, fq);
        if (!has_next) break;
#pragma unroll
        for (int a = 0; a < 2; ++a)
#pragma unroll
            for (int b = 0; b < 2; ++b)
#pragma unroll
                for (int m = 0; m < 4; ++m)
#pragma unroll
                    for (int n = 0; n < 2; ++n) acc[a][b][m][n] = (f32x4){0.f, 0.f, 0.f, 0.f};
        cur = nxt; cA = nA; cB = nB; ++ui;
        if (wr == 1) PG8_BAR;
    }
    PG8_WAIT_V(0);
    PG8_BAR;
#undef PG8_SA
#undef PG8_SB
#undef PG8_STAGE
#undef PG8_LDA
#undef PG8_LDB
#undef PG8_MMA
#undef PG8_WAIT_V
#undef PG8_WAIT_L
#undef PG8_BAR
#undef PG8_SCHED
}

struct EpiF32 {
    static constexpr bool PERM = false;
    float* C; int ldc; const float* R; int ldr;
    __device__ __forceinline__ void operator()(const f32x4 (&acc)[2][2][4][2], const Unit& u, int wr, int wc, int fr, int fq) const {
        const int row0 = u.pm * BM + wr * 64 + fr, col0 = u.pn * BM + wc * 32 + 4 * fq;
#pragma unroll
        for (int ai = 0; ai < 2; ++ai)
#pragma unroll
            for (int m = 0; m < 4; ++m) { const size_t row = (size_t)(row0 + ai * HALF + m * 16);
#pragma unroll
                for (int bj = 0; bj < 2; ++bj)
#pragma unroll
                    for (int n = 0; n < 2; ++n) { const int col = col0 + bj * HALF + 16 * n; f32x4 v = acc[ai][bj][m][n];
                        if (R) v = v + *(const f32x4*)(R + row * ldr + col);
                        *(f32x4*)(C + row * ldc + col) = v; } }
    }
};
struct EpiBf16 {
    static constexpr bool PERM = true;
    bf16* O; int ldc;
    __device__ __forceinline__ void operator()(const f32x4 (&acc)[2][2][4][2], const Unit& u, int wr, int wc, int fr, int fq) const {
        const int row0 = u.pm * BM + wr * 64 + fr, col0 = u.pn * BM + wc * 32 + 8 * fq;
#pragma unroll
        for (int ai = 0; ai < 2; ++ai)
#pragma unroll
            for (int m = 0; m < 4; ++m) { bf16* rowp = O + (size_t)(row0 + ai * HALF + m * 16) * ldc + col0;
#pragma unroll
                for (int bj = 0; bj < 2; ++bj) { const f32x4 v0 = acc[ai][bj][m][0], v1 = acc[ai][bj][m][1];
                    u32x4 w; w.x = cvt_pk_bf16(v0[0], v0[1]); w.y = cvt_pk_bf16(v0[2], v0[3]); w.z = cvt_pk_bf16(v1[0], v1[1]); w.w = cvt_pk_bf16(v1[2], v1[3]);
                    *(u32x4*)(rowp + bj * HALF) = w; } }
    }
};
struct EpiGlu {
    static constexpr bool PERM = true;
    const bf16* Z; const float* bias; bf16* YM;
    __device__ __forceinline__ void operator()(const f32x4 (&acc)[2][2][4][2], const Unit& u, int wr, int wc, int fr, int fq) const {
        const int row0 = u.pm * BM + wr * 64 + fr, col0 = u.pn * BM + wc * 32 + 8 * fq;
#pragma unroll
        for (int ai = 0; ai < 2; ++ai)
#pragma unroll
            for (int m = 0; m < 4; ++m) { const size_t row = (size_t)(row0 + ai * HALF + m * 16);
#pragma unroll
                for (int bj = 0; bj < 2; ++bj) { const int col = col0 + bj * HALF;
                    const u32x4 zz = *(const u32x4*)(Z + row * 512 + col);
                    const f32x4 b0 = *(const f32x4*)(bias + col), b1 = *(const f32x4*)(bias + col + 4);
                    const f32x4 v0 = acc[ai][bj][m][0] + b0, v1 = acc[ai][bj][m][1] + b1;
                    float o[8]; const unsigned zw[4] = {zz.x, zz.y, zz.z, zz.w};
#pragma unroll
                    for (int q = 0; q < 4; ++q) { const float zl = __builtin_bit_cast(float, zw[q] << 16), zh = __builtin_bit_cast(float, zw[q] & 0xffff0000u);
                        const float al = (q < 2) ? v0[2 * q] : v1[2 * q - 4], ah = (q < 2) ? v0[2 * q + 1] : v1[2 * q - 3];
                        o[2 * q] = zl * sigmoidf_(al); o[2 * q + 1] = zh * sigmoidf_(ah); }
                    u32x4 w; w.x = cvt_pk_bf16(o[0], o[1]); w.y = cvt_pk_bf16(o[2], o[3]); w.z = cvt_pk_bf16(o[4], o[5]); w.w = cvt_pk_bf16(o[6], o[7]);
                    *(u32x4*)(YM + row * D + 512 + col) = w; } }
    }
};

struct MoeOrder {
    const bf16* A; const bf16* Bt; int lda, ldb, K; const int* tiles; int nunits, G, c; size_t bexp;
    __device__ void init(const bf16* A_, int lda_, const bf16* Bt_, int ldb_, int K_, const int* tiles_, int ntiles, size_t bexp_) { A = A_; Bt = Bt_; lda = lda_; ldb = ldb_; K = K_; tiles = tiles_; nunits = ntiles * 4; G = GN; c = GB; bexp = bexp_; }
    __device__ bool next(int i, Unit& u) const { const int L = i * G + c; if (L >= nunits) return false; u.pm = L >> 2; u.pn = L & 3; return true; }
    __device__ __forceinline__ const char* aptr(const Unit& u) const { return (const char*)(A + (size_t)u.pm * BM * lda); }
    __device__ __forceinline__ const char* bptr(const Unit& u) const { const int e = __hip_atomic_load(tiles + u.pm, __ATOMIC_RELAXED, __HIP_MEMORY_SCOPE_AGENT); return (const char*)(Bt + ((size_t)e * bexp + (size_t)u.pn * BM) * ldb); }
};
struct EpiSilu {
    static constexpr bool PERM = true;
    bf16* HID;
    __device__ __forceinline__ void operator()(const f32x4 (&acc)[2][2][4][2], const Unit& u, int wr, int wc, int fr, int fq) const {
        const int row0 = u.pm * BM + wr * 64 + fr, col0 = u.pn * HALF + wc * 32 + 8 * fq;
#pragma unroll
        for (int ai = 0; ai < 2; ++ai)
#pragma unroll
            for (int m = 0; m < 4; ++m) { const size_t row = (size_t)(row0 + ai * HALF + m * 16);
                float o[8];
#pragma unroll
                for (int n = 0; n < 2; ++n)
#pragma unroll
                    for (int q = 0; q < 4; ++q) { const float g = acc[ai][0][m][n][q], up = acc[ai][1][m][n][q]; o[4 * n + q] = g * sigmoidf_(g) * up; }
                u32x4 w; w.x = cvt_pk_bf16(o[0], o[1]); w.y = cvt_pk_bf16(o[2], o[3]); w.z = cvt_pk_bf16(o[4], o[5]); w.w = cvt_pk_bf16(o[6], o[7]);
                *(u32x4*)(HID + row * DEXP + col0) = w; }
    }
};
struct EpiGate {
    static constexpr bool PERM = true;
    bf16* Y; const float* gate;
    __device__ __forceinline__ void operator()(const f32x4 (&acc)[2][2][4][2], const Unit& u, int wr, int wc, int fr, int fq) const {
        const int row0 = u.pm * BM + wr * 64 + fr, col0 = u.pn * BM + wc * 32 + 8 * fq;
#pragma unroll
        for (int ai = 0; ai < 2; ++ai)
#pragma unroll
            for (int m = 0; m < 4; ++m) { const size_t row = (size_t)(row0 + ai * HALF + m * 16); const float gt = gate[row];
#pragma unroll
                for (int bj = 0; bj < 2; ++bj) { const f32x4 v0 = acc[ai][bj][m][0] * gt, v1 = acc[ai][bj][m][1] * gt;
                    u32x4 w; w.x = cvt_pk_bf16(v0[0], v0[1]); w.y = cvt_pk_bf16(v0[2], v0[3]); w.z = cvt_pk_bf16(v1[0], v1[1]); w.w = cvt_pk_bf16(v1[2], v1[3]);
                    *(u32x4*)(Y + row * D + col0 + bj * HALF) = w; } }
    }
};

struct EpiProj {
    static constexpr bool PERM = true;
    bf16* PROJ; bf16* US5;
    __device__ __forceinline__ void operator()(const f32x4 (&acc)[2][2][4][2], const Unit& u, int wr, int wc, int fr, int fq) const {
        const int row0 = u.pm * BM + wr * 64 + fr, col0 = u.pn * BM + wc * 32 + 8 * fq;
#pragma unroll
        for (int ai = 0; ai < 2; ++ai)
#pragma unroll
            for (int m = 0; m < 4; ++m) { const size_t row = (size_t)(row0 + ai * HALF + m * 16);
#pragma unroll
                for (int bj = 0; bj < 2; ++bj) { const f32x4 v0 = acc[ai][bj][m][0], v1 = acc[ai][bj][m][1]; const int col = col0 + bj * HALF;
                    u32x4 w; w.x = cvt_pk_bf16(v0[0], v0[1]); w.y = cvt_pk_bf16(v0[2], v0[3]); w.z = cvt_pk_bf16(v1[0], v1[1]); w.w = cvt_pk_bf16(v1[2], v1[3]);
                    if (col < DSHIFT) *(u32x4*)(PROJ + row * DSHIFT + col) = w;
                    else { const int cc = col - DSHIFT; *(u32x4*)(US5 + ((size_t)(cc >> 4) * M + row) * 16 + (cc & 15)) = w; } } }
    }
};
struct GroupOrder {
    const bf16* A; const bf16* Bt; int lda, ldb, K; int nM, nN, nunits, G, c; size_t sA, sB;
    __device__ void init(const bf16* A_, int lda_, size_t sA_, const bf16* Bt_, int ldb_, size_t sB_, int ngroups, int Mg, int Ng, int K_) {
        A = A_; Bt = Bt_; lda = lda_; ldb = ldb_; K = K_; sA = sA_; sB = sB_; nM = Mg / BM; nN = Ng / BM; nunits = ngroups * nM * nN; G = GN; c = GB; }
    __device__ bool next(int i, Unit& u) const { const int L = i * G + c; if (L >= nunits) return false; u.pn = L % nN; u.pm = L / nN; return true; }
    __device__ __forceinline__ const char* aptr(const Unit& u) const { const int g = u.pm / nM, pm = u.pm % nM; return (const char*)(A + (size_t)g * sA + (size_t)pm * BM * lda); }
    __device__ __forceinline__ const char* bptr(const Unit& u) const { const int g = u.pm / nM; return (const char*)(Bt + (size_t)g * sB + (size_t)u.pn * BM * ldb); }
};
struct EpiS5a {
    static constexpr bool PERM = false;
    bf16* YI; float* F;
    __device__ __forceinline__ void operator()(const f32x4 (&acc)[2][2][4][2], const Unit& u, int wr, int wc, int fr, int fq) const {
        const int row0 = u.pm * BM + wr * 64 + fr, col0 = u.pn * BM + wc * 32 + 4 * fq;
#pragma unroll
        for (int ai = 0; ai < 2; ++ai)
#pragma unroll
            for (int m = 0; m < 4; ++m) { const size_t row = (size_t)(row0 + ai * HALF + m * 16);
#pragma unroll
                for (int bj = 0; bj < 2; ++bj)
#pragma unroll
                    for (int n = 0; n < 2; ++n) { const int col = col0 + bj * HALF + 16 * n; const f32x4 v = acc[ai][bj][m][n];
                        if (col < 512) { uint2 w; w.x = cvt_pk_bf16(v[0], v[1]); w.y = cvt_pk_bf16(v[2], v[3]); *(uint2*)(YI + row * 512 + col) = w; }
                        else if (col < 640) *(f32x4*)(F + row * 128 + (col - 512)) = v; } }
    }
};
struct EpiS5b {
    static constexpr bool PERM = true;
    const bf16* YI; bf16* Z;
    __device__ __forceinline__ void operator()(const f32x4 (&acc)[2][2][4][2], const Unit& u, int wr, int wc, int fr, int fq) const {
        const int row0 = u.pm * BM + wr * 64 + fr, col0 = u.pn * BM + wc * 32 + 8 * fq;
#pragma unroll
        for (int ai = 0; ai < 2; ++ai)
#pragma unroll
            for (int m = 0; m < 4; ++m) { const int row = row0 + ai * HALF + m * 16; const int g = row / S5R, rl = row % S5R;
#pragma unroll
                for (int bj = 0; bj < 2; ++bj) { const int col = col0 + bj * HALF;
                    const u32x4 yi = *(const u32x4*)(YI + (size_t)row * 512 + col);
                    const unsigned yw[4] = {yi.x, yi.y, yi.z, yi.w};
                    const f32x4 v0 = acc[ai][bj][m][0], v1 = acc[ai][bj][m][1];
                    float o[8];
#pragma unroll
                    for (int q = 0; q < 4; ++q) { const float al = (q < 2) ? v0[2 * q] : v1[2 * q - 4], ah = (q < 2) ? v0[2 * q + 1] : v1[2 * q - 3];
                        o[2 * q] = gelu_tanh(al + __builtin_bit_cast(float, yw[q] << 16)); o[2 * q + 1] = gelu_tanh(ah + __builtin_bit_cast(float, yw[q] & 0xffff0000u)); }
                    u32x4 w; w.x = cvt_pk_bf16(o[0], o[1]); w.y = cvt_pk_bf16(o[2], o[3]); w.z = cvt_pk_bf16(o[4], o[5]); w.w = cvt_pk_bf16(o[6], o[7]);
                    const size_t tok = (size_t)rl * S5L + (col >> 4);
                    *(u32x4*)(Z + tok * 512 + g * 16 + (col & 15)) = w; } }
    }
};
struct AttnOrder {
    const bf16* A; const bf16* Bt; int lda, ldb, K; int G, c; int mode;
    __device__ void init(const bf16* A_, const bf16* Bt_, int ldb_, int mode_) { A = A_; Bt = Bt_; lda = D; ldb = ldb_; K = 256; G = GN; c = GB; mode = mode_; }
    __device__ bool next(int i, Unit& u) const { const int L = i * G + c; if (L >= NB * 4 * 32) return false; u.pn = L & 3; u.pm = L >> 2; return true; }
    __device__ __forceinline__ const char* aptr(const Unit& u) const { return (const char*)(A + (size_t)u.pm * BM * D + u.pn * 256); }
    __device__ __forceinline__ const char* bptr(const Unit& u) const { const int b = u.pm >> 5;
        return (const char*)(mode == 0 ? Bt + (size_t)b * 256 * ldb + u.pn * 256 : Bt + (size_t)u.pn * 256 * ldb + b * 256); }
};
struct EpiSoftmax {
    static constexpr bool PERM = true;
    bf16* P; PG8_LAS float* scr;
    __device__ __forceinline__ void operator()(f32x4 (&acc)[2][2][4][2], const Unit& u, int wr, int wc, int fr, int fq) const {
        const float SC = 0.0625f * 1.4426950408889634f;
        PG8_LAS float* smax = scr; PG8_LAS float* ssum = scr + 1024;
#pragma unroll
        for (int ai = 0; ai < 2; ++ai)
#pragma unroll
            for (int m = 0; m < 4; ++m) { float t = -3.0e38f;
#pragma unroll
                for (int bj = 0; bj < 2; ++bj)
#pragma unroll
                    for (int n = 0; n < 2; ++n) { const f32x4 v = acc[ai][bj][m][n]; t = fmaxf(t, fmaxf(fmaxf(v[0], v[1]), fmaxf(v[2], v[3]))); }
                t = fmaxf(t, __shfl_xor(t, 16)); t = fmaxf(t, __shfl_xor(t, 32));
                if (fq == 0) smax[(ai * HALF + wr * 64 + m * 16 + fr) * 4 + wc] = t; }
        asm volatile("s_waitcnt lgkmcnt(0)" ::: "memory"); __builtin_amdgcn_s_barrier(); asm volatile("" ::: "memory");
#pragma unroll
        for (int ai = 0; ai < 2; ++ai)
#pragma unroll
            for (int m = 0; m < 4; ++m) { const f32x4 q = *(const PG8_LAS f32x4*)(smax + (ai * HALF + wr * 64 + m * 16 + fr) * 4);
                const float mm = fmaxf(fmaxf(q[0], q[1]), fmaxf(q[2], q[3])) * SC; float s = 0.f;
#pragma unroll
                for (int bj = 0; bj < 2; ++bj)
#pragma unroll
                    for (int n = 0; n < 2; ++n)
#pragma unroll
                        for (int e = 0; e < 4; ++e) { const float p = __builtin_amdgcn_exp2f(acc[ai][bj][m][n][e] * SC - mm); acc[ai][bj][m][n][e] = p; s += p; }
                s += __shfl_xor(s, 16); s += __shfl_xor(s, 32);
                if (fq == 0) ssum[(ai * HALF + wr * 64 + m * 16 + fr) * 4 + wc] = s; }
        asm volatile("s_waitcnt lgkmcnt(0)" ::: "memory"); __builtin_amdgcn_s_barrier(); asm volatile("" ::: "memory");
        const int row0 = u.pm * BM + wr * 64 + fr, col0 = u.pn * 256 + wc * 32 + 8 * fq;
#pragma unroll
        for (int ai = 0; ai < 2; ++ai)
#pragma unroll
            for (int m = 0; m < 4; ++m) { const f32x4 q = *(const PG8_LAS f32x4*)(ssum + (ai * HALF + wr * 64 + m * 16 + fr) * 4);
                const float iv = 1.f / ((q[0] + q[1]) + (q[2] + q[3]));
                bf16* rowp = P + (size_t)(row0 + ai * HALF + m * 16) * D + col0;
#pragma unroll
                for (int bj = 0; bj < 2; ++bj) { const f32x4 v0 = acc[ai][bj][m][0] * iv, v1 = acc[ai][bj][m][1] * iv; u32x4 w;
                    w.x = cvt_pk_bf16(v0[0], v0[1]); w.y = cvt_pk_bf16(v0[2], v0[3]); w.z = cvt_pk_bf16(v1[0], v1[1]); w.w = cvt_pk_bf16(v1[2], v1[3]);
                    *(u32x4*)(rowp + bj * HALF) = w; } }
    }
};
struct EpiAttnO {
    static constexpr bool PERM = true;
    bf16* O;
    __device__ __forceinline__ void operator()(const f32x4 (&acc)[2][2][4][2], const Unit& u, int wr, int wc, int fr, int fq) const {
        const int row0 = u.pm * BM + wr * 64 + fr, col0 = u.pn * 256 + wc * 32 + 8 * fq;
#pragma unroll
        for (int ai = 0; ai < 2; ++ai)
#pragma unroll
            for (int m = 0; m < 4; ++m) { bf16* rowp = O + (size_t)(row0 + ai * HALF + m * 16) * D + col0;
#pragma unroll
                for (int bj = 0; bj < 2; ++bj) { const f32x4 v0 = acc[ai][bj][m][0], v1 = acc[ai][bj][m][1];
                    u32x4 w; w.x = cvt_pk_bf16(v0[0], v0[1]); w.y = cvt_pk_bf16(v0[2], v0[3]); w.z = cvt_pk_bf16(v1[0], v1[1]); w.w = cvt_pk_bf16(v1[2], v1[3]);
                    *(u32x4*)(rowp + bj * HALF) = w; } }
    }
};

struct EpiLora {
    static constexpr bool PERM = true;
    bf16* LW; size_t ostride; const float* w0; const float* a0;
    __device__ __forceinline__ void operator()(const f32x4 (&acc)[2][2][4][2], const Unit& u, int wr, int wc, int fr, int fq) const {
        const int row0 = u.pm * BM + wr * 64 + fr, col0 = u.pn * BM + wc * 32 + 8 * fq;
        const int kind = u.pn >> 1;
        bf16* O = LW + (size_t)kind * ostride;
#pragma unroll
        for (int bj = 0; bj < 2; ++bj) { const int col = (col0 + bj * HALF) & 511;
            f32x4 b0 = (f32x4){0.f, 0.f, 0.f, 0.f}, b1 = b0;
            if (kind == 0) { b0 = *(const f32x4*)(w0 + col); b1 = *(const f32x4*)(w0 + col + 4); }
            else if (kind == 1) { b0 = *(const f32x4*)(a0 + col); b1 = *(const f32x4*)(a0 + col + 4); }
#pragma unroll
            for (int ai = 0; ai < 2; ++ai)
#pragma unroll
                for (int m = 0; m < 4; ++m) { const size_t row = (size_t)(row0 + ai * HALF + m * 16);
                    const f32x4 v0 = acc[ai][bj][m][0] + b0, v1 = acc[ai][bj][m][1] + b1; float o[8];
#pragma unroll
                    for (int e = 0; e < 8; ++e) { float x = (e < 4) ? v0[e & 3] : v1[e & 3];
                        if (kind == 0) { const float nd = -x; const float sp = fmaxf(nd, 0.f) + __logf(1.f + __expf(-fabsf(nd))); x = -__expf(-sp - 0.5f); }
                        else if (kind == 1) x = sigmoidf_(x);
                        o[e] = x; }
                    u32x4 w; w.x = cvt_pk_bf16(o[0], o[1]); w.y = cvt_pk_bf16(o[2], o[3]); w.z = cvt_pk_bf16(o[4], o[5]); w.w = cvt_pk_bf16(o[6], o[7]);
                    *(u32x4*)(O + row * 512 + col) = w; } }
    }
};
}

#define LAS __attribute__((address_space(3)))
__device__ __forceinline__ unsigned pk2(float lo, float hi) { return (unsigned)f2bf(lo) | ((unsigned)f2bf(hi) << 16); }
__device__ __forceinline__ void transpose_item(const float* __restrict__ W, int K, int N, bf16* __restrict__ WT, int ldt, int row_off, int col_off, float* scr, int item, int lane, const float* __restrict__ kscale, int ldw = 0) {
    if (ldw == 0) ldw = N;
    const int nblk = N / 32, kb = item / nblk, nb = item % nblk, k0 = 64 * kb, n0 = 32 * nb;
#pragma unroll 8
    for (int i = 0; i < 32; ++i) { const int kk = 2 * i + (lane >> 5); float v = W[(size_t)(k0 + kk) * ldw + n0 + (lane & 31)]; if (kscale) v *= kscale[k0 + kk]; scr[kk * 33 + (lane & 31)] = v; }
    __builtin_amdgcn_s_waitcnt(0xc07f); asm volatile("" ::: "memory");
    const int c = lane & 7;
#pragma unroll
    for (int j = 0; j < 4; ++j) { const int n = (lane >> 3) + 8 * j; const float* s = scr + (8 * c) * 33 + n;
        uint4 o; o.x = pk2(s[0 * 33], s[1 * 33]); o.y = pk2(s[2 * 33], s[3 * 33]); o.z = pk2(s[4 * 33], s[5 * 33]); o.w = pk2(s[6 * 33], s[7 * 33]);
        *(uint4*)(WT + (size_t)(row_off + n0 + n) * ldt + col_off + k0 + 8 * c) = o; }
    __builtin_amdgcn_s_waitcnt(0xc07f); asm volatile("" ::: "memory");
}
__device__ __forceinline__ void transpose_ph(const float* W, int K, int N, bf16* WT, int ldt, int row_off, int col_off, char* lds, const float* kscale = nullptr) {
    const int lane = threadIdx.x & 63, wv = threadIdx.x >> 6;
    float* scr = (float*)(lds + wv * 16384);
    const int nitems = (K / 64) * (N / 32);
    for (int it = GB * 8 + wv; it < nitems; it += GN * 8) transpose_item(W, K, N, WT, ldt, row_off, col_off, scr, it, lane, kscale);
}

template <typename TO>
__device__ __forceinline__ void rmsnorm_ph(const float* __restrict__ x, const float* __restrict__ w, TO* __restrict__ out, int rows) {
    const int lane = threadIdx.x & 63, wv = threadIdx.x >> 6;
    for (int row = GB * 8 + wv; row < rows; row += GN * 8) {
        const float4* xr = (const float4*)(x + (size_t)row * D);
        float4 v[4]; float s = 0.f;
#pragma unroll
        for (int j = 0; j < 4; ++j) { v[j] = xr[lane + 64 * j]; s += v[j].x * v[j].x + v[j].y * v[j].y + v[j].z * v[j].z + v[j].w * v[j].w; }
        s = wave_sum(s);
        const float rs = rsqrtf(s * (1.f / D) + 1e-6f);
#pragma unroll
        for (int j = 0; j < 4; ++j) {
            const int c = (lane + 64 * j) * 4;
            const float4 g = *(const float4*)(w + c);
            TO* o = out + (size_t)row * D + c;
            stf(o + 0, v[j].x * rs * g.x); stf(o + 1, v[j].y * rs * g.y); stf(o + 2, v[j].z * rs * g.z); stf(o + 3, v[j].w * rs * g.w);
        }
    }
}

__device__ __forceinline__ void rwkv_lin_ph(const bf16* __restrict__ proj, const float* __restrict__ mu, bf16* __restrict__ lin) {
    const int lane = threadIdx.x & 63, wv = threadIdx.x >> 6;
    const float4 m4 = *(const float4*)(mu + 1536 + 4 * lane);
    for (int m = GB * 8 + wv; m < M; m += GN * 8) {
        const uint2 z = *(const uint2*)(proj + (size_t)m * DSHIFT + 1536 + 4 * lane);
        uint2 zp = make_uint2(0, 0);
        if ((m & (S - 1)) != 0) zp = *(const uint2*)(proj + (size_t)(m - 1) * DSHIFT + 1536 + 4 * lane);
        float c[4] = {__builtin_bit_cast(float, z.x << 16), __builtin_bit_cast(float, z.x & 0xffff0000u), __builtin_bit_cast(float, z.y << 16), __builtin_bit_cast(float, z.y & 0xffff0000u)};
        const float q[4] = {__builtin_bit_cast(float, zp.x << 16), __builtin_bit_cast(float, zp.x & 0xffff0000u), __builtin_bit_cast(float, zp.y << 16), __builtin_bit_cast(float, zp.y & 0xffff0000u)};
        const float mm[4] = {m4.x, m4.y, m4.z, m4.w};
#pragma unroll
        for (int e = 0; e < 4; ++e) { float t = c[e] + (q[e] - c[e]) * mm[e];
            if (lane < 16) t = 1.f - 2.f / (1.f + __expf(2.f * t));
            else if (lane >= 32) t = sigmoidf_(t);
            c[e] = t; }
        uint2 o; o.x = pk2(c[0], c[1]); o.y = pk2(c[2], c[3]);
        *(uint2*)(lin + (size_t)m * 256 + 4 * lane) = o;
    }
}
__device__ __forceinline__ void rwkv_wl_ph(const float* __restrict__ wdec, const float* __restrict__ wiclr, const float* __restrict__ wgate, bf16* __restrict__ wl) {
    for (int i = GB * NT + threadIdx.x; i < 1536 * 256; i += GN * NT) {
        const int k = i & 255, n = i >> 8; float v = 0.f;
        if (n < 512) { if (k < 64) v = wdec[k * 512 + n]; }
        else if (n < 1024) { if (k >= 64 && k < 128) v = wiclr[(k - 64) * 512 + (n - 512)]; }
        else { if (k >= 128) v = wgate[(k - 128) * 512 + (n - 1024)]; }
        wl[i] = f2bf(v);
    }
}
struct RwkvIn { const bf16* proj; const bf16* LW; const bf16* AA; const float* mu; const float* k_k; const float* k_a; const float* r_k; float* Y; float* RK; };
constexpr int TB = 64;
constexpr int RW_ITEMS = NB * 8 * 2;
template <int CTRL> __device__ __forceinline__ float dpp16(float x) { return __builtin_bit_cast(float, __builtin_amdgcn_update_dpp(0, __builtin_bit_cast(int, x), CTRL, 0xf, 0xf, true)); }
__device__ __forceinline__ void rwkv_scan_ph(const RwkvIn& I, char* lds) {
    float* Rs = (float*)lds; float* Ws = Rs + TB * 64; float* Kps = Ws + TB * 64; float* KKs = Kps + TB * 64; float* Bs = KKs + TB * 64; float* Vs = Bs + TB * 64; float* Ys = Vs + TB * 64;
    const int lane = threadIdx.x & 63, wv = threadIdx.x >> 6;
    for (int item = GB; item < RW_ITEMS; item += GN) {
        const int half = item & 1, h = (item >> 1) & 7, b = item >> 4;
        const int j = lane & 15, rl = 4 * wv + (lane >> 4), row = 32 * half + rl;
        float s0 = 0.f, s1 = 0.f, s2 = 0.f, s3 = 0.f, sa = 0.f;
        const int tau = threadIdx.x >> 3, cg = threadIdx.x & 7, ch0 = h * 64 + cg * 8;
        uint4 gr, gk, gv, qr, qk, qv, ga, gl;
#define RW_ISSUE(blk) do { const int t_ = (blk) * TB + tau; const size_t m_ = (size_t)b * S + t_; const bf16* z_ = I.proj + m_ * DSHIFT + ch0; \
            gr = *(const uint4*)(z_); gk = *(const uint4*)(z_ + 512); gv = *(const uint4*)(z_ + 1024); \
            if (t_ > 0) { qr = *(const uint4*)(z_ - DSHIFT); qk = *(const uint4*)(z_ + 512 - DSHIFT); qv = *(const uint4*)(z_ + 1024 - DSHIFT); } \
            else { qr = make_uint4(0, 0, 0, 0); qk = qr; qv = qr; } \
            ga = *(const uint4*)(I.AA + m_ * 512 + ch0); gl = *(const uint4*)(I.LW + m_ * 512 + ch0); } while (0)
#define RW_COMMIT(blk) do { \
            const unsigned wr_[4] = {gr.x, gr.y, gr.z, gr.w}, wk_[4] = {gk.x, gk.y, gk.z, gk.w}, wv_[4] = {gv.x, gv.y, gv.z, gv.w}; \
            const unsigned pr_[4] = {qr.x, qr.y, qr.z, qr.w}, pk_[4] = {qk.x, qk.y, qk.z, qk.w}, pv_[4] = {qv.x, qv.y, qv.z, qv.w}; \
            const unsigned wa_[4] = {ga.x, ga.y, ga.z, ga.w}, wl_[4] = {gl.x, gl.y, gl.z, gl.w}; \
            float r_[8], k_[8], v_[8], a_[8], kk_[8], ss_ = 0.f, rk_ = 0.f; \
            _Pragma("unroll") for (int e = 0; e < 8; ++e) { const int w_ = e >> 1; const bool hi_ = e & 1; \
                auto ex = [&](unsigned u) { return hi_ ? __builtin_bit_cast(float, u & 0xffff0000u) : __builtin_bit_cast(float, u << 16); }; \
                const float mr_ = I.mu[ch0 + e], mk_ = I.mu[512 + ch0 + e], mv_ = I.mu[1024 + ch0 + e]; \
                float x = ex(wr_[w_]); r_[e] = x + (ex(pr_[w_]) - x) * mr_; x = ex(wk_[w_]); k_[e] = x + (ex(pk_[w_]) - x) * mk_; x = ex(wv_[w_]); v_[e] = x + (ex(pv_[w_]) - x) * mv_; \
                a_[e] = ex(wa_[w_]); kk_[e] = k_[e] * I.k_k[ch0 + e]; ss_ += kk_[e] * kk_[e]; } \
            ss_ += dpp16<0xB1>(ss_); ss_ += dpp16<0x4E>(ss_); ss_ += dpp16<0x141>(ss_); \
            const float inv_ = 1.f / fmaxf(sqrtf(ss_), 1e-12f); \
            float o_[6][8]; \
            _Pragma("unroll") for (int e = 0; e < 8; ++e) { const int w_ = e >> 1; const bool hi_ = e & 1; \
                const float lw_ = hi_ ? __builtin_bit_cast(float, wl_[w_] & 0xffff0000u) : __builtin_bit_cast(float, wl_[w_] << 16); \
                const float kp_ = k_[e] * (1.f + (a_[e] - 1.f) * I.k_a[ch0 + e]); const float kn_ = kk_[e] * inv_; \
                o_[0][e] = r_[e]; o_[1][e] = __expf(lw_); o_[2][e] = kp_; o_[3][e] = kn_; o_[4][e] = kn_ * a_[e]; o_[5][e] = v_[e]; rk_ += r_[e] * kp_ * I.r_k[ch0 + e]; } \
            _Pragma("unroll") for (int q_ = 0; q_ < 6; ++q_) { float* d_ = Rs + q_ * (TB * 64) + tau * 64 + cg * 8; \
                *(float4*)d_ = make_float4(o_[q_][0], o_[q_][1], o_[q_][2], o_[q_][3]); *(float4*)(d_ + 4) = make_float4(o_[q_][4], o_[q_][5], o_[q_][6], o_[q_][7]); } \
            if (half == 0) { rk_ += dpp16<0xB1>(rk_); rk_ += dpp16<0x4E>(rk_); rk_ += dpp16<0x141>(rk_); \
                if (cg == 0) I.RK[((size_t)b * S + (blk) * TB + tau) * 8 + h] = rk_; } } while (0)
        RW_ISSUE(0);
        __syncthreads();
        RW_COMMIT(0);
        __syncthreads();
        for (int blk = 0; blk < S / TB; ++blk) {
            if (blk + 1 < S / TB) RW_ISSUE(blk + 1);
            float4 r4 = *(const float4*)(Rs + 4 * j), w4 = *(const float4*)(Ws + 4 * j), k4 = *(const float4*)(Kps + 4 * j), b4 = *(const float4*)(Bs + 4 * j);
            float vv = Vs[row];
            if (blk == 0) sa = 0.f;
#pragma unroll 2
            for (int t = 0; t < TB; ++t) {
                const int tn = (t + 1 < TB) ? t + 1 : t;
                const float4 n4n = *(const float4*)(KKs + tn * 64 + 4 * j);
                const float4 r4n = *(const float4*)(Rs + tn * 64 + 4 * j), w4n = *(const float4*)(Ws + tn * 64 + 4 * j), k4n = *(const float4*)(Kps + tn * 64 + 4 * j), b4n = *(const float4*)(Bs + tn * 64 + 4 * j);
                const float vvn = Vs[tn * 64 + row];
                s0 = s0 * w4.x + (sa * b4.x + vv * k4.x);
                s1 = s1 * w4.y + (sa * b4.y + vv * k4.y);
                s2 = s2 * w4.z + (sa * b4.z + vv * k4.z);
                s3 = s3 * w4.w + (sa * b4.w + vv * k4.w);
                float py = (s0 * r4.x + s1 * r4.y) + (s2 * r4.z + s3 * r4.w);
                float ps = (s0 * n4n.x + s1 * n4n.y) + (s2 * n4n.z + s3 * n4n.w);
                py += dpp16<0xB1>(py); ps += dpp16<0xB1>(ps);
                py += dpp16<0x4E>(py); ps += dpp16<0x4E>(ps);
                py += dpp16<0x141>(py); ps += dpp16<0x141>(ps);
                py += dpp16<0x140>(py); ps += dpp16<0x140>(ps);
                if (j == 0) Ys[t * 32 + rl] = py;
                if (t + 1 < TB) sa = -ps;
                r4 = r4n; w4 = w4n; k4 = k4n; b4 = b4n; vv = vvn;
            }
            __syncthreads();
            { const int t = threadIdx.x >> 3, r0 = (threadIdx.x & 7) * 4; const size_t m = (size_t)b * S + blk * TB + t;
              *(float4*)(I.Y + m * 512 + h * 64 + 32 * half + r0) = *(const float4*)(Ys + t * 32 + r0); }
            if (blk + 1 < S / TB) RW_COMMIT(blk + 1);
            __syncthreads();
            if (blk + 1 < S / TB) { const float4 n4 = *(const float4*)(KKs + 4 * j);
                float ps = (s0 * n4.x + s1 * n4.y) + (s2 * n4.z + s3 * n4.w);
                ps += dpp16<0xB1>(ps); ps += dpp16<0x4E>(ps); ps += dpp16<0x141>(ps); ps += dpp16<0x140>(ps);
                sa = -ps; }
        }
    }
}
__device__ __forceinline__ void rwkv_post_ph(const float* __restrict__ Y, const float* __restrict__ RK, const bf16* __restrict__ proj, const float* __restrict__ mu, const bf16* __restrict__ G,
                             const float* __restrict__ lnw, const float* __restrict__ lnb, bf16* __restrict__ ymix) {
    const int c = threadIdx.x;
    const float muv = mu[1024 + c], lw_ = lnw[c], lb_ = lnb[c];
    for (int m0 = GB * 4; m0 < M; m0 += GN * 4) {
        float y[4], v[4], pv[4], rk[4], g[4];
#pragma unroll
        for (int i = 0; i < 4; ++i) { const int m = m0 + i; const size_t ix = (size_t)m * 512 + c;
            y[i] = Y[ix]; v[i] = bf2f(proj[(size_t)m * DSHIFT + 1024 + c]); pv[i] = (m & (S - 1)) ? bf2f(proj[(size_t)(m - 1) * DSHIFT + 1024 + c]) : 0.f;
            rk[i] = RK[(size_t)m * 8 + (c >> 6)]; g[i] = bf2f(G[ix]); }
#pragma unroll
        for (int i = 0; i < 4; ++i) {
            const float mean = wave_sum(y[i]) * (1.f / 64.f);
            const float d = y[i] - mean;
            const float var = wave_sum(d * d) * (1.f / 64.f);
            float yn = d * rsqrtf(var + 64e-5f) * lw_ + lb_;
            const float vs = v[i] + (pv[i] - v[i]) * muv;
            yn += rk[i] * vs;
            ymix[(size_t)(m0 + i) * D + c] = f2bf(yn * g[i]);
        }
    }
}

constexpr int PSLOTS = NASSIGN + NEXP * 256;
constexpr int MAXTILES = PSLOTS / 256;
struct MoeBufs { int* tok_e; float* tok_g; int* tok_slot; int* slot_tok; float* slot_gate; int* counts; int* offs; int* cursor; int* tiles; int* ntiles; };
__device__ __forceinline__ void moe_zero_ph(const MoeBufs& mb) {
    if (GB == 0 && threadIdx.x < 32) { mb.counts[threadIdx.x] = 0; mb.cursor[threadIdx.x] = 0; }
    for (int i = GB * NT + threadIdx.x; i < PSLOTS; i += GN * NT) { mb.slot_tok[i] = 0; mb.slot_gate[i] = 0.f; }
}
__device__ __forceinline__ void router_ph(const float* __restrict__ x3, const float* __restrict__ nw, bf16* __restrict__ h3, const float* __restrict__ wrg, const float* __restrict__ brg,
                          const float* __restrict__ wre, const float* __restrict__ bre, const MoeBufs& mb) {
    const int lane = threadIdx.x & 63, wv = threadIdx.x >> 6;
    for (int m = GB * 8 + wv; m < M; m += GN * 8) {
        const float4* xr = (const float4*)(x3 + (size_t)m * D);
        float h[16]; float s = 0.f;
#pragma unroll
        for (int j = 0; j < 4; ++j) { const float4 v = xr[lane + 64 * j]; h[4 * j] = v.x; h[4 * j + 1] = v.y; h[4 * j + 2] = v.z; h[4 * j + 3] = v.w; s += v.x * v.x + v.y * v.y + v.z * v.z + v.w * v.w; }
        s = wave_sum(s);
        const float rs = rsqrtf(s * (1.f / D) + 1e-6f);
        float l1[4] = {0.f, 0.f, 0.f, 0.f};
#pragma unroll
        for (int j = 0; j < 4; ++j) {
            const int k0 = (lane + 64 * j) * 4;
            const float4 g = *(const float4*)(nw + k0);
            h[4 * j] *= rs * g.x; h[4 * j + 1] *= rs * g.y; h[4 * j + 2] *= rs * g.z; h[4 * j + 3] *= rs * g.w;
            uint2 o; o.x = pk2(h[4 * j], h[4 * j + 1]); o.y = pk2(h[4 * j + 2], h[4 * j + 3]);
            *(uint2*)(h3 + (size_t)m * D + k0) = o;
#pragma unroll
            for (int e = 0; e < 4; ++e) { const float4 w = *(const float4*)(wrg + (k0 + e) * 4); const float x = h[4 * j + e]; l1[0] += x * w.x; l1[1] += x * w.y; l1[2] += x * w.z; l1[3] += x * w.w; }
        }
#pragma unroll
        for (int i = 0; i < 4; ++i) l1[i] = wave_sum(l1[i]) + brg[i];
        int grp = 0; float best = l1[0];
#pragma unroll
        for (int i = 1; i < 4; ++i) if (l1[i] > best) { best = l1[i]; grp = i; }
        float se = 0.f;
#pragma unroll
        for (int i = 0; i < 4; ++i) se += __expf(l1[i] - best);
        const float g1 = 1.f / se;
        float l2[8] = {};
        const float* we = wre + (size_t)grp * D * 8;
#pragma unroll
        for (int j = 0; j < 4; ++j) {
            const int k0 = (lane + 64 * j) * 4;
#pragma unroll
            for (int e = 0; e < 4; ++e) { const float x = h[4 * j + e]; const float4 w0 = *(const float4*)(we + (k0 + e) * 8), w1 = *(const float4*)(we + (k0 + e) * 8 + 4);
                l2[0] += x * w0.x; l2[1] += x * w0.y; l2[2] += x * w0.z; l2[3] += x * w0.w; l2[4] += x * w1.x; l2[5] += x * w1.y; l2[6] += x * w1.z; l2[7] += x * w1.w; }
        }
#pragma unroll
        for (int i = 0; i < 8; ++i) l2[i] = wave_sum(l2[i]) + bre[grp * 8 + i];
        int i0 = 0; float v0 = l2[0];
#pragma unroll
        for (int i = 1; i < 8; ++i) if (l2[i] > v0) { v0 = l2[i]; i0 = i; }
        int i1 = -1; float v1 = -3.0e38f;
#pragma unroll
        for (int i = 0; i < 8; ++i) if (i != i0 && l2[i] > v1) { v1 = l2[i]; i1 = i; }
        const float e1 = __expf(v1 - v0), inv = 1.f / (1.f + e1);
        if (lane == 0) {
            const int ea = grp * 8 + i0, eb = grp * 8 + i1;
            mb.tok_e[2 * m] = ea; mb.tok_e[2 * m + 1] = eb;
            mb.tok_g[2 * m] = g1 * inv; mb.tok_g[2 * m + 1] = g1 * e1 * inv;
            atomicAdd(&mb.counts[ea], 1); atomicAdd(&mb.counts[eb], 1);
        }
    }
}
__device__ __forceinline__ void moe_plan_ph(const MoeBufs& mb) {
    if (GB == 0 && threadIdx.x == 0) {
        int off = 0, nt = 0;
        for (int e = 0; e < NEXP; ++e) {
            mb.offs[e] = off; const int c = mb.counts[e];
            for (int r0 = 0; r0 < c; r0 += 256) { mb.tiles[nt] = e; ++nt; }
            off += ((c + 255) / 256) * 256;
        }
        *mb.ntiles = nt;
    }
}
__device__ __forceinline__ void moe_scatter_ph(const MoeBufs& mb) {
    for (int i = GB * NT + threadIdx.x; i < NASSIGN; i += GN * NT) {
        const int e = mb.tok_e[i];
        const int pos = mb.offs[e] + atomicAdd(&mb.cursor[e], 1);
        mb.slot_tok[pos] = i >> 1; mb.slot_gate[pos] = mb.tok_g[i]; mb.tok_slot[i] = pos;
    }
}
__device__ __forceinline__ void moe_gather_ph(const bf16* __restrict__ h3, bf16* __restrict__ xg, const MoeBufs& mb) {
    const int lane = threadIdx.x & 63, wv = threadIdx.x >> 6;
    const int nrows = __hip_atomic_load(mb.ntiles, __ATOMIC_RELAXED, __HIP_MEMORY_SCOPE_AGENT) * 256;
    for (int r = GB * 8 + wv; r < nrows; r += GN * 8) {
        const int t = mb.slot_tok[r];
        const uint4* s = (const uint4*)(h3 + (size_t)t * D); uint4* d = (uint4*)(xg + (size_t)r * D);
        d[lane] = s[lane]; d[lane + 64] = s[lane + 64];
    }
}
__device__ __forceinline__ void moe_weights_ph(const float* __restrict__ wg, const float* __restrict__ wu, const float* __restrict__ wd, bf16* __restrict__ wgu_t, bf16* __restrict__ wd_t, char* lds) {
    const int lane = threadIdx.x & 63, wv = threadIdx.x >> 6;
    float* scr = (float*)(lds + wv * 16384);
    constexpr int I_GU = 16 * 16;
    constexpr int I_D = 8 * 32;
    constexpr int NIT = NEXP * (2 * I_GU + I_D);
    for (int it = GB * 8 + wv; it < NIT; it += GN * 8) {
        const int e = it / (2 * I_GU + I_D); int r = it % (2 * I_GU + I_D);
        if (r < 2 * I_GU) {
            const int up = r / I_GU; r %= I_GU;
            const int kb = r / 16, nb = r % 16;
            const int pn = nb / 4, nsub = nb % 4;
            const float* W = (up ? wu : wg) + (size_t)e * D * DEXP + nb * 32;
            transpose_item(W + (size_t)kb * 64 * DEXP, 64, 32, wgu_t, D, e * 1024 + pn * 256 + up * 128 + nsub * 32, kb * 64, scr, 0, lane, nullptr, DEXP);
        } else {
            r -= 2 * I_GU;
            const int kb = r / 32, nb = r % 32;
            const float* W = wd + (size_t)e * DEXP * D + nb * 32;
            transpose_item(W + (size_t)kb * 64 * D, 64, 32, wd_t, DEXP, e * 1024 + nb * 32, kb * 64, scr, 0, lane, nullptr, D);
        }
    }
}
__device__ __forceinline__ void final_ph(float* __restrict__ out, const bf16* __restrict__ yslot, const int* __restrict__ tok_slot, const float* __restrict__ w) {
    const int lane = threadIdx.x & 63, wv = threadIdx.x >> 6;
    for (int row = GB * 8 + wv; row < M; row += GN * 8) {
        float4* xr = (float4*)(out + (size_t)row * D);
        const uint2* ya = (const uint2*)(yslot + (size_t)tok_slot[2 * row] * D);
        const uint2* yb = (const uint2*)(yslot + (size_t)tok_slot[2 * row + 1] * D);
        float4 v[4]; float s = 0.f;
#pragma unroll
        for (int j = 0; j < 4; ++j) {
            v[j] = xr[lane + 64 * j];
            const uint2 a = ya[lane + 64 * j], b = yb[lane + 64 * j];
            v[j].x += bf2f((bf16)(a.x & 0xffff)) + bf2f((bf16)(b.x & 0xffff));
            v[j].y += bf2f((bf16)(a.x >> 16)) + bf2f((bf16)(b.x >> 16));
            v[j].z += bf2f((bf16)(a.y & 0xffff)) + bf2f((bf16)(b.y & 0xffff));
            v[j].w += bf2f((bf16)(a.y >> 16)) + bf2f((bf16)(b.y >> 16));
            s += v[j].x * v[j].x + v[j].y * v[j].y + v[j].z * v[j].z + v[j].w * v[j].w;
        }
        s = wave_sum(s);
        const float rs = rsqrtf(s * (1.f / D) + 1e-6f);
#pragma unroll
        for (int j = 0; j < 4; ++j) {
            const float4 g = *(const float4*)(w + (lane + 64 * j) * 4);
            xr[lane + 64 * j] = make_float4(v[j].x * rs * g.x, v[j].y * rs * g.y, v[j].z * rs * g.z, v[j].w * rs * g.w);
        }
    }
}


struct S5Tab { float* Kmat; bf16* BtA; bf16* BtB; };
__device__ __forceinline__ void s5_lam(const float* lam_re, const float* lam_im, const float* log_dt, int g, int n, float& a, float& w) {
    const float dt = __expf(log_dt[g]); a = lam_re[g * 64 + n] * dt; w = lam_im[g * 64 + n] * dt;
}
__device__ __forceinline__ void cexpj(float a, float w, float j, float& re, float& im) { const float e = __expf(a * j); float s, c; sincosf(w * j, &s, &c); re = e * c; im = e * s; }
__device__ __forceinline__ void s5_bbar(const float* lam_re, const float* lam_im, const float* log_dt, const float* b_re, const float* b_im, int g, int n, int h, float& br, float& bi) {
    float a, w; s5_lam(lam_re, lam_im, log_dt, g, n, a, w);
    float lbr, lbi; cexpj(a, w, 1.f, lbr, lbi);
    const float lr = lam_re[g * 64 + n], li = lam_im[g * 64 + n];
    const float nr = lbr - 1.f, ni = lbi, den = lr * lr + li * li;
    const float cr = (nr * lr + ni * li) / den, ci = (ni * lr - nr * li) / den;
    const float xr = b_re[(g * 64 + n) * 16 + h], xi = b_im[(g * 64 + n) * 16 + h];
    br = cr * xr - ci * xi; bi = cr * xi + ci * xr;
}
__device__ __forceinline__ void s5_tables0_ph(const float* lam_re, const float* lam_im, const float* log_dt, const float* b_re, const float* b_im, const float* c_re, const float* c_im, const S5Tab& T) {
    const int gtid = GB * NT + threadIdx.x, gsz = GN * NT;
    for (int i = gtid; i < 32 * 32 * 256; i += gsz) {
        const int h = i & 15, hp = (i >> 4) & 15, j = (i >> 8) & 31, g = i >> 13;
        float acc = 0.f;
        for (int n = 0; n < 64; ++n) {
            float a, w; s5_lam(lam_re, lam_im, log_dt, g, n, a, w);
            float pr, pi; cexpj(a, w, (float)j, pr, pi);
            float br, bi; s5_bbar(lam_re, lam_im, log_dt, b_re, b_im, g, n, h, br, bi);
            const float tr = pr * br - pi * bi, ti = pr * bi + pi * br;
            acc += c_re[(g * 16 + hp) * 64 + n] * tr - c_im[(g * 16 + hp) * 64 + n] * ti;
        }
        T.Kmat[i] = acc;
    }
    for (int i = gtid; i < 32 * 256 * 512; i += gsz) {
        const int col = i & 511, r = (i >> 9) & 255, g = i >> 17;
        float v = 0.f;
        if (r < 128) {
            const int n = r & 63, s = col >> 4, h = col & 15;
            float a, w; s5_lam(lam_re, lam_im, log_dt, g, n, a, w);
            float pr, pi; cexpj(a, w, (float)(S5L - 1 - s), pr, pi);
            float br, bi; s5_bbar(lam_re, lam_im, log_dt, b_re, b_im, g, n, h, br, bi);
            v = (r < 64) ? (pr * br - pi * bi) : (pr * bi + pi * br);
        }
        T.BtA[((size_t)g * 768 + 512 + r) * 512 + col] = f2bf(v);
    }
    for (int i = gtid; i < 32 * 512 * 256; i += gsz) {
        const int k = i & 255, row = (i >> 8) & 511, g = i >> 17;
        float v = 0.f;
        if (k < 128) {
            const int n = k & 63, sp = row >> 4, hp = row & 15;
            float a, w; s5_lam(lam_re, lam_im, log_dt, g, n, a, w);
            float pr, pi; cexpj(a, w, (float)(sp + 1), pr, pi);
            const float cr = c_re[(g * 16 + hp) * 64 + n], ci = c_im[(g * 16 + hp) * 64 + n];
            v = (k < 64) ? (cr * pr - ci * pi) : -(cr * pi + ci * pr);
        }
        T.BtB[i] = f2bf(v);
    }
}
__device__ __forceinline__ void s5_tables1_ph(const float* dsk, const S5Tab& T) {
    const int gtid = GB * NT + threadIdx.x, gsz = GN * NT;
    for (int i = gtid; i < 32 * 512 * 512; i += gsz) {
        const int col = i & 511, row = (i >> 9) & 511, g = i >> 18;
        const int sp = row >> 4, hp = row & 15, s = col >> 4, h = col & 15;
        float v = 0.f;
        if (s <= sp) v = T.Kmat[((g * 32 + (sp - s)) * 16 + hp) * 16 + h];
        if (row == col) v += dsk[g * 16 + hp];
        T.BtA[((size_t)g * 768 + row) * 512 + col] = f2bf(v);
    }
}
__device__ __forceinline__ void s5_carry_ph(const float* lam_re, const float* lam_im, const float* log_dt, const float* __restrict__ F, bf16* __restrict__ XST) {
    const int gtid = GB * NT + threadIdx.x, gsz = GN * NT;
    for (int i = gtid; i < 32 * S5R * 16; i += gsz) { const int row = i >> 4, q = i & 15; *(uint4*)(XST + (size_t)row * 256 + 128 + q * 8) = make_uint4(0, 0, 0, 0); }
    const int lane = threadIdx.x & 63, wv = threadIdx.x >> 6;
    const int nidle = (GN > RW_ITEMS) ? GN - RW_ITEMS : GN, myi = (GN > RW_ITEMS) ? GB - RW_ITEMS : GB;
    for (int item = (myi < 0 ? NB * 32 : myi + nidle * wv); item < NB * 32; item += nidle * 8) {
        const int b = item >> 5, g = item & 31, n = lane;
        float a, w; s5_lam(lam_re, lam_im, log_dt, g, n, a, w);
        float pr, pi; cexpj(a, w, (float)S5L, pr, pi);
        float xr = 0.f, xi = 0.f;
        const size_t row0 = (size_t)g * S5R + (size_t)b * (S / S5L);
        const float* f = F + row0 * 128; bf16* xo = XST + row0 * 256;
        for (int c0 = 0; c0 < S / S5L; c0 += 8) {
            float fr[8], fi[8];
#pragma unroll
            for (int q = 0; q < 8; ++q) { fr[q] = f[(size_t)(c0 + q) * 128 + n]; fi[q] = f[(size_t)(c0 + q) * 128 + 64 + n]; }
#pragma unroll
            for (int q = 0; q < 8; ++q) {
                xo[(size_t)(c0 + q) * 256 + n] = f2bf(xr); xo[(size_t)(c0 + q) * 256 + 64 + n] = f2bf(xi);
                const float nr = pr * xr - pi * xi + fr[q], ni = pr * xi + pi * xr + fi[q];
                xr = nr; xi = ni;
            }
        }
    }
}

struct Params { const float* in[41]; float* out; char* ws; };

constexpr size_t W_PROJ = 0;
constexpr size_t W_US5 = 224;
constexpr size_t W_WTS = 288;
constexpr size_t W_YI = 352;
constexpr size_t W_F = 416;
constexpr size_t W_XST = 448;
constexpr size_t W_Z = 480;
constexpr size_t W_MISC = 544;
constexpr size_t W_XN = 576;
constexpr size_t WO_IN = 0, WO_GLU = 5 * MiB, WO_MIX = 6 * MiB, WO_Q = 8 * MiB, WO_K = 10 * MiB, WO_V = 12 * MiB, WO_O = 14 * MiB, WO_KMAT = 16 * MiB, WO_BTA = 17 * MiB, WO_BTB = 41 * MiB;

__global__ void __launch_bounds__(NT, 2) fwd_kernel(Params p) {
    extern __shared__ __attribute__((aligned(16))) char lds[];
    cg::grid_group grid = cg::this_grid();
    PG8_LAS unsigned char* ldsl = (PG8_LAS unsigned char*)lds;
    char* ws = p.ws; char* dout = (char*)p.out; float* out = p.out;
#define IN(i) (p.in[i])
#define SYNC() grid.sync()
    char* WT = ws + W_WTS * MiB;
    bf16* w_in_t = (bf16*)(WT + WO_IN); bf16* w_glu_t = (bf16*)(WT + WO_GLU); bf16* w_mix_t = (bf16*)(WT + WO_MIX);
    bf16* w_q_t = (bf16*)(WT + WO_Q); bf16* w_k_t = (bf16*)(WT + WO_K); bf16* w_v_t = (bf16*)(WT + WO_V); bf16* w_o_t = (bf16*)(WT + WO_O);
    S5Tab stab; stab.Kmat = (float*)(WT + WO_KMAT); stab.BtA = (bf16*)(WT + WO_BTA); stab.BtB = (bf16*)(WT + WO_BTB);
    bf16* PROJ = (bf16*)(ws + W_PROJ * MiB); bf16* US5 = (bf16*)(ws + W_US5 * MiB);
    bf16* XN = (bf16*)(ws + W_XN * MiB);
    transpose_ph(IN(3), D, DIN, w_in_t, D, 0, 0, lds);
    transpose_ph(IN(23), 512, 512, w_glu_t, 512, 0, 0, lds);
    transpose_ph(IN(25), D, D, w_mix_t, D, 0, 0, lds);
    transpose_ph(IN(28), D, D, w_q_t, D, 0, 0, lds);
    transpose_ph(IN(29), D, D, w_k_t, D, 0, 0, lds);
    transpose_ph(IN(30), D, D, w_v_t, D, 0, 0, lds);
    transpose_ph(IN(31), D, D, w_o_t, D, 0, 0, lds);
    s5_tables0_ph(IN(15), IN(16), IN(17), IN(18), IN(19), IN(20), IN(21), stab);
    bf16* wl_t = (bf16*)(WT + 49 * MiB);
    rwkv_wl_ph(IN(6), IN(8), IN(9), wl_t);
    rmsnorm_ph<bf16>(IN(0), IN(2), XN, M);
    SYNC();
    s5_tables1_ph(IN(22), stab);
    { pg8::PlainOrder S; S.init(XN, D, w_in_t, D, M, DIN, D); pg8::EpiProj E{PROJ, US5}; pg8::gemm_phase(ldsl, S, E); }
    SYNC();
    bf16* LIN = (bf16*)(ws + (W_MISC + 16) * MiB);
    rwkv_lin_ph(PROJ, IN(4), LIN);
    SYNC();
    bf16* YI = (bf16*)(ws + W_YI * MiB); float* F = (float*)(ws + W_F * MiB); bf16* XST = (bf16*)(ws + W_XST * MiB); bf16* Z = (bf16*)(ws + W_Z * MiB);
    bf16* LWb = (bf16*)(ws + 704 * MiB); bf16* AAb = (bf16*)(ws + 768 * MiB); bf16* Gb = (bf16*)(ws + 832 * MiB);
    float* Yr = (float*)(ws + 896 * MiB); float* RKb = (float*)(ws + W_MISC * MiB);
    { pg8::GroupOrder S; S.init(US5, 512, (size_t)S5R * 512, stab.BtA, 512, (size_t)768 * 512, 32, S5R, 768, 512); pg8::EpiS5a E{YI, F}; pg8::gemm_phase(ldsl, S, E); }
    { pg8::PlainOrder S; S.init(LIN, 256, wl_t, 256, M, 1536, 256); pg8::EpiLora E{LWb, (size_t)32 * MiB, IN(5), IN(7)}; pg8::gemm_phase(ldsl, S, E); }
    SYNC();
    s5_carry_ph(IN(15), IN(16), IN(17), F, XST);
    { RwkvIn ri{PROJ, LWb, AAb, IN(4), IN(10), IN(11), IN(12), Yr, RKb}; rwkv_scan_ph(ri, lds); }
    SYNC();
    bf16* YMIX = XN;
    { pg8::GroupOrder S; S.init(XST, 256, (size_t)S5R * 256, stab.BtB, 256, (size_t)512 * 256, 32, S5R, 512, 256); pg8::EpiS5b E{YI, Z}; pg8::gemm_phase(ldsl, S, E); }
    rwkv_post_ph(Yr, RKb, PROJ, IN(4), Gb, IN(13), IN(14), YMIX);
    SYNC();
    { pg8::PlainOrder S; S.init(Z, 512, w_glu_t, 512, M, 512, 512); pg8::EpiGlu E{Z, IN(24), YMIX}; pg8::gemm_phase(ldsl, S, E); }
    SYNC();
    { pg8::PlainOrder S; S.init(YMIX, D, w_mix_t, D, M, D, D); pg8::EpiF32 E{out, D, IN(0), D}; pg8::gemm_phase(ldsl, S, E); }
    SYNC();
    bf16* KM = (bf16*)(ws + (W_MISC + 2) * MiB); bf16* VT = (bf16*)(ws + (W_MISC + 6) * MiB); bf16* MEMN = (bf16*)(ws + (W_MISC + 10) * MiB);
    rmsnorm_ph<bf16>(out, IN(26), XN, M);
    rmsnorm_ph<bf16>(IN(1), IN(27), MEMN, NB * NMEM);
    SYNC();
    bf16* Q = (bf16*)(ws + 128 * MiB);
    { pg8::PlainOrder S; S.init(MEMN, D, w_k_t, D, NB * NMEM, D, D); pg8::EpiBf16 E{KM, D}; pg8::gemm_phase(ldsl, S, E); }
    { pg8::PlainOrder S; S.init(w_v_t, D, MEMN, D, D, NB * NMEM, D); pg8::EpiBf16 E{VT, NB * NMEM}; pg8::gemm_phase(ldsl, S, E); }
    { pg8::PlainOrder S; S.init(XN, D, w_q_t, D, M, D, D); pg8::EpiBf16 E{Q, D}; pg8::gemm_phase(ldsl, S, E); }
    SYNC();
    bf16* P = (bf16*)(ws + W_YI * MiB);
    { pg8::AttnOrder S; S.init(Q, KM, D, 0); pg8::EpiSoftmax E{P, (PG8_LAS float*)(ldsl + 131072)}; pg8::gemm_phase(ldsl, S, E); }
    SYNC();
    bf16* O = XN;
    { pg8::AttnOrder S; S.init(P, VT, NB * NMEM, 1); pg8::EpiAttnO E{O}; pg8::gemm_phase(ldsl, S, E); }
    SYNC();
    { pg8::PlainOrder S; S.init(O, D, w_o_t, D, M, D, D); pg8::EpiF32 E{out, D, out, D}; pg8::gemm_phase(ldsl, S, E); }
    SYNC();
    bf16* H3 = XN;
    bf16* XG = (bf16*)(ws + 0);
    bf16* WGU_t = (bf16*)(ws + 272 * MiB); bf16* WD_t = (bf16*)(ws + 336 * MiB);
    bf16* HID = (bf16*)(ws + 368 * MiB);
    bf16* YSLOT = (bf16*)(ws + 704 * MiB);
    MoeBufs mb; char* mbase = ws + 976 * MiB;
    mb.tok_e = (int*)(mbase); mb.tok_g = (float*)(mbase + 1 * MiB); mb.tok_slot = (int*)(mbase + 2 * MiB); mb.slot_tok = (int*)(mbase + 3 * MiB);
    mb.slot_gate = (float*)(mbase + 4 * MiB); mb.counts = (int*)(mbase + 5 * MiB); mb.offs = mb.counts + 64; mb.cursor = mb.counts + 128; mb.ntiles = mb.counts + 192;
    mb.tiles = (int*)(mbase + 6 * MiB);
    moe_zero_ph(mb);
    moe_weights_ph(IN(37), IN(38), IN(39), WGU_t, WD_t, lds);
    SYNC();
    router_ph(out, IN(32), H3, IN(33), IN(34), IN(35), IN(36), mb);
    SYNC();
    moe_plan_ph(mb);
    SYNC();
    moe_scatter_ph(mb);
    SYNC();
    moe_gather_ph(H3, XG, mb);
    SYNC();
    const int ntiles = __hip_atomic_load(mb.ntiles, __ATOMIC_RELAXED, __HIP_MEMORY_SCOPE_AGENT);
    { pg8::MoeOrder S; S.init(XG, D, WGU_t, D, D, mb.tiles, ntiles, 1024); pg8::EpiSilu E{HID}; pg8::gemm_phase(ldsl, S, E); }
    SYNC();
    { pg8::MoeOrder S; S.init(HID, DEXP, WD_t, DEXP, DEXP, mb.tiles, ntiles, 1024); pg8::EpiGate E{YSLOT, mb.slot_gate}; pg8::gemm_phase(ldsl, S, E); }
    SYNC();
    final_ph(out, YSLOT, mb.tok_slot, IN(40));
}
}

extern "C" void kernel_launch(void* const* d_in, const int* in_sizes, int n_in, void* d_out, int out_size, void* d_ws, size_t ws_size, hipStream_t stream) {
    (void)in_sizes; (void)out_size; (void)ws_size;
    static int grid = 0;
    if (grid == 0) {
        int dev = 0, cus = 0, per_cu = 0;
        hipGetDevice(&dev);
        hipDeviceGetAttribute(&cus, hipDeviceAttributeMultiprocessorCount, dev);
        hipFuncSetAttribute((const void*)fwd_kernel, hipFuncAttributeMaxDynamicSharedMemorySize, LDS_BYTES);
        hipOccupancyMaxActiveBlocksPerMultiprocessor(&per_cu, (const void*)fwd_kernel, NT, LDS_BYTES);
        if (per_cu < 1) { fprintf(stderr, "occupancy query says %d blocks/CU\n", per_cu); per_cu = 1; }
        grid = cus * 1;
    }
    Params p{};
    for (int i = 0; i < 41 && i < n_in; ++i) p.in[i] = (const float*)d_in[i];
    p.out = (float*)d_out; p.ws = (char*)d_ws;
    void* args[] = {&p};
    hipError_t e = hipLaunchCooperativeKernel((const void*)fwd_kernel, dim3(grid), dim3(NT), args, LDS_BYTES, stream);
    if (e != hipSuccess) fprintf(stderr, "cooperative launch failed: %s (grid %d)\n", hipGetErrorString(e), grid);
}
```

```cpp
#include <hip/hip_runtime.h>
#include <hip/hip_cooperative_groups.h>
#include <stdint.h>
#include <cstdio>
namespace cg = cooperative_groups;

namespace {
constexpr int NB = 8, S = 8192, D = 1024, M = NB * S;
constexpr int DR = 512, DSHIFT = 1792, DIN = 2304, NMEM = 256;
constexpr int NEXP = 32, DEXP = 512, NASSIGN = 2 * M;
constexpr size_t MiB = 1u << 20;
constexpr int NT = 512;
constexpr int S5L = 32, S5R = M / S5L;
constexpr int LDS_BYTES = 147456;
#define GB ((int)blockIdx.x)
#define GN ((int)gridDim.x)

typedef unsigned short bf16;
__device__ __forceinline__ bf16 f2bf(float f) { unsigned u = __builtin_bit_cast(unsigned, f); return (bf16)((u + 0x7fffu + ((u >> 16) & 1u)) >> 16); }
__device__ __forceinline__ float bf2f(bf16 h) { return __builtin_bit_cast(float, (unsigned)h << 16); }

template <typename T> __device__ __forceinline__ float ldf(const T* p);
template <> __device__ __forceinline__ float ldf<float>(const float* p) { return *p; }
template <> __device__ __forceinline__ float ldf<bf16>(const bf16* p) { return bf2f(*p); }
template <typename T> __device__ __forceinline__ void stf(T* p, float v);
template <> __device__ __forceinline__ void stf<float>(float* p, float v) { *p = v; }
template <> __device__ __forceinline__ void stf<bf16>(bf16* p, float v) { *p = f2bf(v); }

template <int CTRL, int ROWMASK> __device__ __forceinline__ float dppf_(float x) { return __builtin_bit_cast(float, __builtin_amdgcn_update_dpp(0, __builtin_bit_cast(int, x), CTRL, ROWMASK, 0xf, false)); }
__device__ __forceinline__ float wave_sum(float v) {
    v += dppf_<0xB1, 0xf>(v); v += dppf_<0x4E, 0xf>(v); v += dppf_<0x141, 0xf>(v); v += dppf_<0x140, 0xf>(v);
    v += dppf_<0x142, 0xa>(v);
    v += dppf_<0x143, 0xc>(v);
    return __builtin_bit_cast(float, __builtin_amdgcn_readlane(__builtin_bit_cast(int, v), 63));
}
__device__ __forceinline__ float sigmoidf_(float x) { return 1.f / (1.f + __expf(-x)); }


__device__ __forceinline__ float gelu_tanh(float x) { return x * sigmoidf_(1.5957691216057308f * (x + 0.044715f * x * x * x)); }

namespace pg8 {
#define PG8_LAS __attribute__((address_space(3)))
typedef short bf16x8 __attribute__((ext_vector_type(8)));
typedef float f32x4 __attribute__((ext_vector_type(4)));
typedef unsigned u32x4 __attribute__((ext_vector_type(4)));
constexpr int BM = 256, BK = 64, HALF = 128, HTB = HALF * BK * 2, STAGE_BYTES = 8 * HTB, NXCD = 8, WGM = 8;
__device__ __forceinline__ int lds_byte(int r, int c) { const int st = (r >> 4) * 2 + (c >> 5), rr = r & 15, cc = c & 31, ob = rr * 64 + cc * 2; return st * 1024 + (ob ^ (((ob >> 9) & 1) << 5)); }
__device__ __forceinline__ void stage_rc(int b, int& R, int& C) { const int st = b / 1024, sb = b % 1024, swz = sb ^ (((sb >> 9) & 1) << 5); R = (st >> 1) * 16 + swz / 64; C = (st & 1) * 32 + (swz % 64) / 2; }
__device__ __forceinline__ int perm32(int rho) { const int n = rho >> 4, i = rho & 15; return 8 * (i >> 2) + 4 * n + (i & 3); }
struct Unit { int pm, pn; };
struct PlainOrder {
    const bf16* A; const bf16* Bt; int lda, ldb, K; int nM, nN, nwg, G, c;
    __device__ void init(const bf16* A_, int lda_, const bf16* Bt_, int ldb_, int M, int N, int K_) { A = A_; Bt = Bt_; lda = lda_; ldb = ldb_; K = K_; nM = M / BM; nN = N / BM; nwg = nM * nN; G = GN; c = GB; }
    __device__ bool next(int i, Unit& u) const {
        const long L = (long)i * G + c; if (L >= nwg) return false;
        int wgid = (int)L; { const int q = nwg / NXCD, r = nwg % NXCD, xcd = wgid % NXCD, off = wgid / NXCD; wgid = (xcd < r ? xcd * (q + 1) : r * (q + 1) + (xcd - r) * q) + off; }
        const int nig = WGM * nN, gid = wgid / nig, fm = gid * WGM, gsz = (nM - fm) < WGM ? (nM - fm) : WGM;
        u.pm = fm + ((wgid % nig) % gsz); u.pn = (wgid % nig) / gsz; return true;
    }
    __device__ __forceinline__ const char* aptr(const Unit& u) const { return (const char*)(A + (size_t)u.pm * BM * lda); }
    __device__ __forceinline__ const char* bptr(const Unit& u) const { return (const char*)(Bt + (size_t)u.pn * BM * ldb); }
};
__device__ __forceinline__ unsigned cvt_pk_bf16(float lo, float hi) { unsigned r; asm volatile("v_cvt_pk_bf16_f32 %0, %1, %2" : "=v"(r) : "v"(lo), "v"(hi)); return r; }

template <class Epi, class Sched>
__device__ __forceinline__ void gemm_phase(PG8_LAS unsigned char* lds, const Sched& S, const Epi& E) {
    const int tid = threadIdx.x, wid = __builtin_amdgcn_readfirstlane(tid >> 6), lane = tid & 63, wr = wid >> 2, wc = wid & 3, fr = lane & 15, fq = lane >> 4;
    const int K = S.K, nt = K / BK;
    unsigned voffA[2], voffB[2];
#pragma unroll
    for (int i = 0; i < 2; ++i) { int R, C; stage_rc(tid * 16 + i * 8192, R, C); const int Rb = Epi::PERM ? ((R & ~31) + perm32(R & 31)) : R;
        voffA[i] = (unsigned)(R * S.lda + C) * 2u; voffB[i] = (unsigned)(Rb * S.ldb + C) * 2u; }
    const size_t kstep = (size_t)(BK * 2);
    const size_t hstepA = (size_t)HALF * S.lda * 2, hstepB = (size_t)HALF * S.ldb * 2;
    const unsigned ldsw = (unsigned)wid * 1024u;
    const int aoff = lds_byte(wr * 64 + fr, fq * 8), boff = lds_byte(wc * 32 + fr, fq * 8);
#define PG8_SA(b, h) (((b) * 2 + (h)) * HTB)
#define PG8_SB(b, h) ((4 + (b) * 2 + (h)) * HTB)
#define PG8_STAGE(bufoff, gbase, voff) do { _Pragma("unroll") for (int _i = 0; _i < 2; ++_i) \
        __builtin_amdgcn_global_load_lds((const unsigned*)((const char*)(gbase) + (voff)[_i]), (PG8_LAS unsigned*)(lds + (bufoff) + ldsw + _i * 8192), 16, 0, 0); } while (0)
#define PG8_LDA(dst, b, h) do { _Pragma("unroll") for (int m = 0; m < 4; ++m) _Pragma("unroll") for (int k = 0; k < 2; ++k) dst[m][k] = *(const PG8_LAS bf16x8*)(lds + PG8_SA(b, h) + aoff + m * 2048 + k * 1024); } while (0)
#define PG8_LDB(dst, b, h) do { _Pragma("unroll") for (int n = 0; n < 2; ++n) _Pragma("unroll") for (int k = 0; k < 2; ++k) dst[n][k] = *(const PG8_LAS bf16x8*)(lds + PG8_SB(b, h) + boff + n * 2048 + k * 1024); } while (0)
#define PG8_MMA(ai, bj, At, Bt) do { __builtin_amdgcn_s_setprio(1); _Pragma("unroll") for (int m = 0; m < 4; ++m) _Pragma("unroll") for (int n = 0; n < 2; ++n) _Pragma("unroll") for (int k = 0; k < 2; ++k) \
        acc[ai][bj][m][n] = __builtin_amdgcn_mfma_f32_16x16x32_bf16(Bt[n][k], At[m][k], acc[ai][bj][m][n], 0, 0, 0); __builtin_amdgcn_s_setprio(0); } while (0)
#define PG8_WAIT_V(n) asm volatile("s_waitcnt vmcnt(" #n ")" ::: "memory")
#define PG8_WAIT_L(n) asm volatile("s_waitcnt lgkmcnt(" #n ")" ::: "memory")
#define PG8_BAR __builtin_amdgcn_s_barrier()
#define PG8_SCHED __builtin_amdgcn_sched_barrier(0)
    Unit cur, nxt; int ui = 0;
    if (!S.next(0, cur)) return;
    f32x4 acc[2][2][4][2];
#pragma unroll
    for (int a = 0; a < 2; ++a)
#pragma unroll
        for (int b = 0; b < 2; ++b)
#pragma unroll
            for (int m = 0; m < 4; ++m)
#pragma unroll
                for (int n = 0; n < 2; ++n) acc[a][b][m][n] = (f32x4){0.f, 0.f, 0.f, 0.f};
    bf16x8 At[4][2], B0[2][2], B1[2][2];
    const char* cA = S.aptr(cur); const char* cB = S.bptr(cur);
    PG8_STAGE(PG8_SB(0, 0), cB, voffB); PG8_STAGE(PG8_SB(0, 1), cB + hstepB, voffB); PG8_STAGE(PG8_SA(0, 0), cA, voffA); PG8_STAGE(PG8_SA(0, 1), cA + hstepA, voffA);
    if (wr == 1) PG8_BAR;
    PG8_WAIT_V(2); PG8_BAR;
    PG8_STAGE(PG8_SB(1, 0), cB + kstep, voffB); PG8_STAGE(PG8_SA(1, 0), cA + kstep, voffA); PG8_STAGE(PG8_SB(1, 1), cB + hstepB + kstep, voffB);
    PG8_WAIT_V(6); PG8_BAR;
    for (;;) {
        const bool has_next = S.next(ui + 1, nxt);
        const char* nA = has_next ? S.aptr(nxt) : cA; const char* nB = has_next ? S.bptr(nxt) : cB;
        for (int t = 0; t < nt; t += 2) {
            const bool last = (t == nt - 2);
            const char* a1 = cA + (size_t)(t + 1) * kstep;
            const char* a2 = last ? nA : cA + (size_t)(t + 2) * kstep; const char* b2 = last ? nB : cB + (size_t)(t + 2) * kstep;
            const char* a3 = a2 + kstep; const char* b3 = b2 + kstep;
            PG8_LDB(B0, 0, 0); PG8_LDB(B1, 0, 1); PG8_SCHED; PG8_LDA(At, 0, 0); PG8_STAGE(PG8_SA(1, 1), a1 + hstepA, voffA);
            PG8_WAIT_V(8); PG8_WAIT_L(0); PG8_BAR; PG8_MMA(0, 0, At, B0); PG8_MMA(0, 1, At, B1); PG8_BAR; PG8_SCHED;
            PG8_LDA(At, 0, 1); PG8_STAGE(PG8_SB(0, 0), b2, voffB); PG8_STAGE(PG8_SB(0, 1), b2 + hstepB, voffB); PG8_STAGE(PG8_SA(0, 0), a2, voffA);
            PG8_WAIT_V(8); PG8_WAIT_L(0); PG8_BAR; PG8_MMA(1, 0, At, B0); PG8_MMA(1, 1, At, B1); PG8_BAR; PG8_SCHED;
            PG8_LDB(B0, 1, 0); PG8_LDB(B1, 1, 1); PG8_SCHED; PG8_LDA(At, 1, 0); PG8_STAGE(PG8_SA(0, 1), a2 + hstepA, voffA);
            PG8_WAIT_V(8); PG8_WAIT_L(0); PG8_BAR; PG8_MMA(0, 0, At, B0); PG8_MMA(0, 1, At, B1); PG8_BAR; PG8_SCHED;
            PG8_LDA(At, 1, 1); PG8_STAGE(PG8_SB(1, 0), b3, voffB); PG8_STAGE(PG8_SB(1, 1), b3 + hstepB, voffB); PG8_STAGE(PG8_SA(1, 0), a3, voffA);
            PG8_WAIT_V(8); PG8_WAIT_L(0); PG8_BAR; PG8_MMA(1, 0, At, B0); PG8_MMA(1, 1, At, B1); PG8_BAR; PG8_SCHED;
        }
        if (wr == 0) PG8_BAR;
        E(acc, cur, wr, wc, fr, fq);
        if (!has_next) break;
#pragma unroll
        for (int a = 0; a < 2; ++a)
#pragma unroll
            for (int b = 0; b < 2; ++b)
#pragma unroll
                for (int m = 0; m < 4; ++m)
#pragma unroll
                    for (int n = 0; n < 2; ++n) acc[a][b][m][n] = (f32x4){0.f, 0.f, 0.f, 0.f};
        cur = nxt; cA = nA; cB = nB; ++ui;
        if (wr == 1) PG8_BAR;
    }
    PG8_WAIT_V(0);
    PG8_BAR;
#undef PG8_SA
#undef PG8_SB
#undef PG8_STAGE
#undef PG8_LDA
#undef PG8_LDB
#undef PG8_MMA
#undef PG8_WAIT_V
#undef PG8_WAIT_L
#undef PG8_BAR
#undef PG8_SCHED
}

struct EpiF32 {
    static constexpr bool PERM = false;
    float* C; int ldc; const float* R; int ldr;
    __device__ __forceinline__ void operator()(const f32x4 (&acc)[2][2][4][2], const Unit& u, int wr, int wc, int fr, int fq) const {
        const int row0 = u.pm * BM + wr * 64 + fr, col0 = u.pn * BM + wc * 32 + 4 * fq;
#pragma unroll
        for (int ai = 0; ai < 2; ++ai)
#pragma unroll
            for (int m = 0; m < 4; ++m) { const size_t row = (size_t)(row0 + ai * HALF + m * 16);
#pragma unroll
                for (int bj = 0; bj < 2; ++bj)
#pragma unroll
                    for (int n = 0; n < 2; ++n) { const int col = col0 + bj * HALF + 16 * n; f32x4 v = acc[ai][bj][m][n];
                        if (R) v = v + *(const f32x4*)(R + row * ldr + col);
                        *(f32x4*)(C + row * ldc + col) = v; } }
    }
};
struct EpiBf16 {
    static constexpr bool PERM = true;
    bf16* O; int ldc;
    __device__ __forceinline__ void operator()(const f32x4 (&acc)[2][2][4][2], const Unit& u, int wr, int wc, int fr, int fq) const {
        const int row0 = u.pm * BM + wr * 64 + fr, col0 = u.pn * BM + wc * 32 + 8 * fq;
#pragma unroll
        for (int ai = 0; ai < 2; ++ai)
#pragma unroll
            for (int m = 0; m < 4; ++m) { bf16* rowp = O + (size_t)(row0 + ai * HALF + m * 16) * ldc + col0;
#pragma unroll
                for (int bj = 0; bj < 2; ++bj) { const f32x4 v0 = acc[ai][bj][m][0], v1 = acc[ai][bj][m][1];
                    u32x4 w; w.x = cvt_pk_bf16(v0[0], v0[1]); w.y = cvt_pk_bf16(v0[2], v0[3]); w.z = cvt_pk_bf16(v1[0], v1[1]); w.w = cvt_pk_bf16(v1[2], v1[3]);
                    *(u32x4*)(rowp + bj * HALF) = w; } }
    }
};
struct EpiGlu {
    static constexpr bool PERM = true;
    const bf16* Z; const float* bias; bf16* YM;
    __device__ __forceinline__ void operator()(const f32x4 (&acc)[2][2][4][2], const Unit& u, int wr, int wc, int fr, int fq) const {
        const int row0 = u.pm * BM + wr * 64 + fr, col0 = u.pn * BM + wc * 32 + 8 * fq;
#pragma unroll
        for (int ai = 0; ai < 2; ++ai)
#pragma unroll
            for (int m = 0; m < 4; ++m) { const size_t row = (size_t)(row0 + ai * HALF + m * 16);
#pragma unroll
                for (int bj = 0; bj < 2; ++bj) { const int col = col0 + bj * HALF;
                    const u32x4 zz = *(const u32x4*)(Z + row * 512 + col);
                    const f32x4 b0 = *(const f32x4*)(bias + col), b1 = *(const f32x4*)(bias + col + 4);
                    const f32x4 v0 = acc[ai][bj][m][0] + b0, v1 = acc[ai][bj][m][1] + b1;
                    float o[8]; const unsigned zw[4] = {zz.x, zz.y, zz.z, zz.w};
#pragma unroll
                    for (int q = 0; q < 4; ++q) { const float zl = __builtin_bit_cast(float, zw[q] << 16), zh = __builtin_bit_cast(float, zw[q] & 0xffff0000u);
                        const float al = (q < 2) ? v0[2 * q] : v1[2 * q - 4], ah = (q < 2) ? v0[2 * q + 1] : v1[2 * q - 3];
                        o[2 * q] = zl * sigmoidf_(al); o[2 * q + 1] = zh * sigmoidf_(ah); }
                    u32x4 w; w.x = cvt_pk_bf16(o[0], o[1]); w.y = cvt_pk_bf16(o[2], o[3]); w.z = cvt_pk_bf16(o[4], o[5]); w.w = cvt_pk_bf16(o[6], o[7]);
                    *(u32x4*)(YM + row * D + 512 + col) = w; } }
    }
};

struct MoeOrder {
    const bf16* A; const bf16* Bt; int lda, ldb, K; const int* tiles; int nunits, G, c; size_t bexp;
    __device__ void init(const bf16* A_, int lda_, const bf16* Bt_, int ldb_, int K_, const int* tiles_, int ntiles, size_t bexp_) { A = A_; Bt = Bt_; lda = lda_; ldb = ldb_; K = K_; tiles = tiles_; nunits = ntiles * 4; G = GN; c = GB; bexp = bexp_; }
    __device__ bool next(int i, Unit& u) const { const int L = i * G + c; if (L >= nunits) return false; u.pm = L >> 2; u.pn = L & 3; return true; }
    __device__ __forceinline__ const char* aptr(const Unit& u) const { return (const char*)(A + (size_t)u.pm * BM * lda); }
    __device__ __forceinline__ const char* bptr(const Unit& u) const { const int e = __hip_atomic_load(tiles + u.pm, __ATOMIC_RELAXED, __HIP_MEMORY_SCOPE_AGENT); return (const char*)(Bt + ((size_t)e * bexp + (size_t)u.pn * BM) * ldb); }
};
struct EpiSilu {
    static constexpr bool PERM = true;
    bf16* HID;
    __device__ __forceinline__ void operator()(const f32x4 (&acc)[2][2][4][2], const Unit& u, int wr, int wc, int fr, int fq) const {
        const int row0 = u.pm * BM + wr * 64 + fr, col0 = u.pn * HALF + wc * 32 + 8 * fq;
#pragma unroll
        for (int ai = 0; ai < 2; ++ai)
#pragma unroll
            for (int m = 0; m < 4; ++m) { const size_t row = (size_t)(row0 + ai * HALF + m * 16);
                float o[8];
#pragma unroll
                for (int n = 0; n < 2; ++n)
#pragma unroll
                    for (int q = 0; q < 4; ++q) { const float g = acc[ai][0][m][n][q], up = acc[ai][1][m][n][q]; o[4 * n + q] = g * sigmoidf_(g) * up; }
                u32x4 w; w.x = cvt_pk_bf16(o[0], o[1]); w.y = cvt_pk_bf16(o[2], o[3]); w.z = cvt_pk_bf16(o[4], o[5]); w.w = cvt_pk_bf16(o[6], o[7]);
                *(u32x4*)(HID + row * DEXP + col0) = w; }
    }
};
struct EpiGate {
    static constexpr bool PERM = true;
    bf16* Y; const float* gate;
    __device__ __forceinline__ void operator()(const f32x4 (&acc)[2][2][4][2], const Unit& u, int wr, int wc, int fr, int fq) const {
        const int row0 = u.pm * BM + wr * 64 + fr, col0 = u.pn * BM + wc * 32 + 8 * fq;
#pragma unroll
        for (int ai = 0; ai < 2; ++ai)
#pragma unroll
            for (int m = 0; m < 4; ++m) { const size_t row = (size_t)(row0 + ai * HALF + m * 16); const float gt = gate[row];
#pragma unroll
                for (int bj = 0; bj < 2; ++bj) { const f32x4 v0 = acc[ai][bj][m][0] * gt, v1 = acc[ai][bj][m][1] * gt;
                    u32x4 w; w.x = cvt_pk_bf16(v0[0], v0[1]); w.y = cvt_pk_bf16(v0[2], v0[3]); w.z = cvt_pk_bf16(v1[0], v1[1]); w.w = cvt_pk_bf16(v1[2], v1[3]);
                    *(u32x4*)(Y + row * D + col0 + bj * HALF) = w; } }
    }
};

struct EpiProj {
    static constexpr bool PERM = true;
    bf16* PROJ; bf16* US5;
    __device__ __forceinline__ void operator()(const f32x4 (&acc)[2][2][4][2], const Unit& u, int wr, int wc, int fr, int fq) const {
        const int row0 = u.pm * BM + wr * 64 + fr, col0 = u.pn * BM + wc * 32 + 8 * fq;
#pragma unroll
        for (int ai = 0; ai < 2; ++ai)
#pragma unroll
            for (int m = 0; m < 4; ++m) { const size_t row = (size_t)(row0 + ai * HALF + m * 16);
#pragma unroll
                for (int bj = 0; bj < 2; ++bj) { const f32x4 v0 = acc[ai][bj][m][0], v1 = acc[ai][bj][m][1]; const int col = col0 + bj * HALF;
                    u32x4 w; w.x = cvt_pk_bf16(v0[0], v0[1]); w.y = cvt_pk_bf16(v0[2], v0[3]); w.z = cvt_pk_bf16(v1[0], v1[1]); w.w = cvt_pk_bf16(v1[2], v1[3]);
                    if (col < DSHIFT) *(u32x4*)(PROJ + row * DSHIFT + col) = w;
                    else { const int cc = col - DSHIFT; *(u32x4*)(US5 + ((size_t)(cc >> 4) * M + row) * 16 + (cc & 15)) = w; } } }
    }
};
struct GroupOrder {
    const bf16* A; const bf16* Bt; int lda, ldb, K; int nM, nN, nunits, G, c; size_t sA, sB;
    __device__ void init(const bf16* A_, int lda_, size_t sA_, const bf16* Bt_, int ldb_, size_t sB_, int ngroups, int Mg, int Ng, int K_) {
        A = A_; Bt = Bt_; lda = lda_; ldb = ldb_; K = K_; sA = sA_; sB = sB_; nM = Mg / BM; nN = Ng / BM; nunits = ngroups * nM * nN; G = GN; c = GB; }
    __device__ bool next(int i, Unit& u) const { const int L = i * G + c; if (L >= nunits) return false; u.pn = L % nN; u.pm = L / nN; return true; }
    __device__ __forceinline__ const char* aptr(const Unit& u) const { const int g = u.pm / nM, pm = u.pm % nM; return (const char*)(A + (size_t)g * sA + (size_t)pm * BM * lda); }
    __device__ __forceinline__ const char* bptr(const Unit& u) const { const int g = u.pm / nM; return (const char*)(Bt + (size_t)g * sB + (size_t)u.pn * BM * ldb); }
};
struct EpiS5a {
    static constexpr bool PERM = false;
    bf16* YI; float* F;
    __device__ __forceinline__ void operator()(const f32x4 (&acc)[2][2][4][2], const Unit& u, int wr, int wc, int fr, int fq) const {
        const int row0 = u.pm * BM + wr * 64 + fr, col0 = u.pn * BM + wc * 32 + 4 * fq;
#pragma unroll
        for (int ai = 0; ai < 2; ++ai)
#pragma unroll
            for (int m = 0; m < 4; ++m) { const size_t row = (size_t)(row0 + ai * HALF + m * 16);
#pragma unroll
                for (int bj = 0; bj < 2; ++bj)
#pragma unroll
                    for (int n = 0; n < 2; ++n) { const int col = col0 + bj * HALF + 16 * n; const f32x4 v = acc[ai][bj][m][n];
                        if (col < 512) { uint2 w; w.x = cvt_pk_bf16(v[0], v[1]); w.y = cvt_pk_bf16(v[2], v[3]); *(uint2*)(YI + row * 512 + col) = w; }
                        else if (col < 640) *(f32x4*)(F + row * 128 + (col - 512)) = v; } }
    }
};
struct EpiS5b {
    static constexpr bool PERM = true;
    const bf16* YI; bf16* Z;
    __device__ __forceinline__ void operator()(const f32x4 (&acc)[2][2][4][2], const Unit& u, int wr, int wc, int fr, int fq) const {
        const int row0 = u.pm * BM + wr * 64 + fr, col0 = u.pn * BM + wc * 32 + 8 * fq;
#pragma unroll
        for (int ai = 0; ai < 2; ++ai)
#pragma unroll
            for (int m = 0; m < 4; ++m) { const int row = row0 + ai * HALF + m * 16; const int g = row / S5R, rl = row % S5R;
#pragma unroll
                for (int bj = 0; bj < 2; ++bj) { const int col = col0 + bj * HALF;
                    const u32x4 yi = *(const u32x4*)(YI + (size_t)row * 512 + col);
                    const unsigned yw[4] = {yi.x, yi.y, yi.z, yi.w};
                    const f32x4 v0 = acc[ai][bj][m][0], v1 = acc[ai][bj][m][1];
                    float o[8];
#pragma unroll
                    for (int q = 0; q < 4; ++q) { const float al = (q < 2) ? v0[2 * q] : v1[2 * q - 4], ah = (q < 2) ? v0[2 * q + 1] : v1[2 * q - 3];
                        o[2 * q] = gelu_tanh(al + __builtin_bit_cast(float, yw[q] << 16)); o[2 * q + 1] = gelu_tanh(ah + __builtin_bit_cast(float, yw[q] & 0xffff0000u)); }
                    u32x4 w; w.x = cvt_pk_bf16(o[0], o[1]); w.y = cvt_pk_bf16(o[2], o[3]); w.z = cvt_pk_bf16(o[4], o[5]); w.w = cvt_pk_bf16(o[6], o[7]);
                    const size_t tok = (size_t)rl * S5L + (col >> 4);
                    *(u32x4*)(Z + tok * 512 + g * 16 + (col & 15)) = w; } }
    }
};
struct AttnOrder {
    const bf16* A; const bf16* Bt; int lda, ldb, K; int G, c; int mode;
    __device__ void init(const bf16* A_, const bf16* Bt_, int ldb_, int mode_) { A = A_; Bt = Bt_; lda = D; ldb = ldb_; K = 256; G = GN; c = GB; mode = mode_; }
    __device__ bool next(int i, Unit& u) const { const int L = i * G + c; if (L >= NB * 4 * 32) return false; u.pn = L & 3; u.pm = L >> 2; return true; }
    __device__ __forceinline__ const char* aptr(const Unit& u) const { return (const char*)(A + (size_t)u.pm * BM * D + u.pn * 256); }
    __device__ __forceinline__ const char* bptr(const Unit& u) const { const int b = u.pm >> 5;
        return (const char*)(mode == 0 ? Bt + (size_t)b * 256 * ldb + u.pn * 256 : Bt + (size_t)u.pn * 256 * ldb + b * 256); }
};
struct EpiSoftmax {
    static constexpr bool PERM = true;
    bf16* P; PG8_LAS float* scr;
    __device__ __forceinline__ void operator()(f32x4 (&acc)[2][2][4][2], const Unit& u, int wr, int wc, int fr, int fq) const {
        const float SC = 0.0625f * 1.4426950408889634f;
        PG8_LAS float* smax = scr; PG8_LAS float* ssum = scr + 1024;
#pragma unroll
        for (int ai = 0; ai < 2; ++ai)
#pragma unroll
            for (int m = 0; m < 4; ++m) { float t = -3.0e38f;
#pragma unroll
                for (int bj = 0; bj < 2; ++bj)
#pragma unroll
                    for (int n = 0; n < 2; ++n) { const f32x4 v = acc[ai][bj][m][n]; t = fmaxf(t, fmaxf(fmaxf(v[0], v[1]), fmaxf(v[2], v[3]))); }
                t = fmaxf(t, __shfl_xor(t, 16)); t = fmaxf(t, __shfl_xor(t, 32));
                if (fq == 0) smax[(ai * HALF + wr * 64 + m * 16 + fr) * 4 + wc] = t; }
        asm volatile("s_waitcnt lgkmcnt(0)" ::: "memory"); __builtin_amdgcn_s_barrier(); asm volatile("" ::: "memory");
#pragma unroll
        for (int ai = 0; ai < 2; ++ai)
#pragma unroll
            for (int m = 0; m < 4; ++m) { const f32x4 q = *(const PG8_LAS f32x4*)(smax + (ai * HALF + wr * 64 + m * 16 + fr) * 4);
                const float mm = fmaxf(fmaxf(q[0], q[1]), fmaxf(q[2], q[3])) * SC; float s = 0.f;
#pragma unroll
                for (int bj = 0; bj < 2; ++bj)
#pragma unroll
                    for (int n = 0; n < 2; ++n)
#pragma unroll
                        for (int e = 0; e < 4; ++e) { const float p = __builtin_amdgcn_exp2f(acc[ai][bj][m][n][e] * SC - mm); acc[ai][bj][m][n][e] = p; s += p; }
                s += __shfl_xor(s, 16); s += __shfl_xor(s, 32);
                if (fq == 0) ssum[(ai * HALF + wr * 64 + m * 16 + fr) * 4 + wc] = s; }
        asm volatile("s_waitcnt lgkmcnt(0)" ::: "memory"); __builtin_amdgcn_s_barrier(); asm volatile("" ::: "memory");
        const int row0 = u.pm * BM + wr * 64 + fr, col0 = u.pn * 256 + wc * 32 + 8 * fq;
#pragma unroll
        for (int ai = 0; ai < 2; ++ai)
#pragma unroll
            for (int m = 0; m < 4; ++m) { const f32x4 q = *(const PG8_LAS f32x4*)(ssum + (ai * HALF + wr * 64 + m * 16 + fr) * 4);
                const float iv = 1.f / ((q[0] + q[1]) + (q[2] + q[3]));
                bf16* rowp = P + (size_t)(row0 + ai * HALF + m * 16) * D + col0;
#pragma unroll
                for (int bj = 0; bj < 2; ++bj) { const f32x4 v0 = acc[ai][bj][m][0] * iv, v1 = acc[ai][bj][m][1] * iv; u32x4 w;
                    w.x = cvt_pk_bf16(v0[0], v0[1]); w.y = cvt_pk_bf16(v0[2], v0[3]); w.z = cvt_pk_bf16(v1[0], v1[1]); w.w = cvt_pk_bf16(v1[2], v1[3]);
                    *(u32x4*)(rowp + bj * HALF) = w; } }
    }
};
struct EpiAttnO {
    static constexpr bool PERM = true;
    bf16* O;
    __device__ __forceinline__ void operator()(const f32x4 (&acc)[2][2][4][2], const Unit& u, int wr, int wc, int fr, int fq) const {
        const int row0 = u.pm * BM + wr * 64 + fr, col0 = u.pn * 256 + wc * 32 + 8 * fq;
#pragma unroll
        for (int ai = 0; ai < 2; ++ai)
#pragma unroll
            for (int m = 0; m < 4; ++m) { bf16* rowp = O + (size_t)(row0 + ai * HALF + m * 16) * D + col0;
#pragma unroll
                for (int bj = 0; bj < 2; ++bj) { const f32x4 v0 = acc[ai][bj][m][0], v1 = acc[ai][bj][m][1];
                    u32x4 w; w.x = cvt_pk_bf16(v0[0], v0[1]); w.y = cvt_pk_bf16(v0[2], v0[3]); w.z = cvt_pk_bf16(v1[0], v1[1]); w.w = cvt_pk_bf16(v1[2], v1[3]);
                    *(u32x4*)(rowp + bj * HALF) = w; } }
    }
};

struct EpiLora {
    static constexpr bool PERM = true;
    bf16* LW; size_t ostride; const float* w0; const float* a0;
    __device__ __forceinline__ void operator()(const f32x4 (&acc)[2][2][4][2], const Unit& u, int wr, int wc, int fr, int fq) const {
        const int row0 = u.pm * BM + wr * 64 + fr, col0 = u.pn * BM + wc * 32 + 8 * fq;
        const int kind = u.pn >> 1;
        bf16* O = LW + (size_t)kind * ostride;
#pragma unroll
        for (int bj = 0; bj < 2; ++bj) { const int col = (col0 + bj * HALF) & 511;
            f32x4 b0 = (f32x4){0.f, 0.f, 0.f, 0.f}, b1 = b0;
            if (kind == 0) { b0 = *(const f32x4*)(w0 + col); b1 = *(const f32x4*)(w0 + col + 4); }
            else if (kind == 1) { b0 = *(const f32x4*)(a0 + col); b1 = *(const f32x4*)(a0 + col + 4); }
#pragma unroll
            for (int ai = 0; ai < 2; ++ai)
#pragma unroll
                for (int m = 0; m < 4; ++m) { const size_t row = (size_t)(row0 + ai * HALF + m * 16);
                    const f32x4 v0 = acc[ai][bj][m][0] + b0, v1 = acc[ai][bj][m][1] + b1; float o[8];
#pragma unroll
                    for (int e = 0; e < 8; ++e) { float x = (e < 4) ? v0[e & 3] : v1[e & 3];
                        if (kind == 0) { const float nd = -x; const float sp = fmaxf(nd, 0.f) + __logf(1.f + __expf(-fabsf(nd))); x = -__expf(-sp - 0.5f); }
                        else if (kind == 1) x = sigmoidf_(x);
                        o[e] = x; }
                    u32x4 w; w.x = cvt_pk_bf16(o[0], o[1]); w.y = cvt_pk_bf16(o[2], o[3]); w.z = cvt_pk_bf16(o[4], o[5]); w.w = cvt_pk_bf16(o[6], o[7]);
                    *(u32x4*)(O + row * 512 + col) = w; } }
    }
};
}

#define LAS __attribute__((address_space(3)))
__device__ __forceinline__ unsigned pk2(float lo, float hi) { return (unsigned)f2bf(lo) | ((unsigned)f2bf(hi) << 16); }
__device__ __forceinline__ void transpose_item(const float* __restrict__ W, int K, int N, bf16* __restrict__ WT, int ldt, int row_off, int col_off, float* scr, int item, int lane, const float* __restrict__ kscale, int ldw = 0) {
    if (ldw == 0) ldw = N;
    const int nblk = N / 32, kb = item / nblk, nb = item % nblk, k0 = 64 * kb, n0 = 32 * nb;
#pragma unroll 8
    for (int i = 0; i < 32; ++i) { const int kk = 2 * i + (lane >> 5); float v = W[(size_t)(k0 + kk) * ldw + n0 + (lane & 31)]; if (kscale) v *= kscale[k0 + kk]; scr[kk * 33 + (lane & 31)] = v; }
    __builtin_amdgcn_s_waitcnt(0xc07f); asm volatile("" ::: "memory");
    const int c = lane & 7;
#pragma unroll
    for (int j = 0; j < 4; ++j) { const int n = (lane >> 3) + 8 * j; const float* s = scr + (8 * c) * 33 + n;
        uint4 o; o.x = pk2(s[0 * 33], s[1 * 33]); o.y = pk2(s[2 * 33], s[3 * 33]); o.z = pk2(s[4 * 33], s[5 * 33]); o.w = pk2(s[6 * 33], s[7 * 33]);
        *(uint4*)(WT + (size_t)(row_off + n0 + n) * ldt + col_off + k0 + 8 * c) = o; }
    __builtin_amdgcn_s_waitcnt(0xc07f); asm volatile("" ::: "memory");
}
__device__ __forceinline__ void transpose_ph(const float* W, int K, int N, bf16* WT, int ldt, int row_off, int col_off, char* lds, const float* kscale = nullptr) {
    const int lane = threadIdx.x & 63, wv = threadIdx.x >> 6;
    float* scr = (float*)(lds + wv * 16384);
    const int nitems = (K / 64) * (N / 32);
    for (int it = GB * 8 + wv; it < nitems; it += GN * 8) transpose_item(W, K, N, WT, ldt, row_off, col_off, scr, it, lane, kscale);
}

template <typename TO>
__device__ __forceinline__ void rmsnorm_ph(const float* __restrict__ x, const float* __restrict__ w, TO* __restrict__ out, int rows) {
    const int lane = threadIdx.x & 63, wv = threadIdx.x >> 6;
    for (int row = GB * 8 + wv; row < rows; row += GN * 8) {
        const float4* xr = (const float4*)(x + (size_t)row * D);
        float4 v[4]; float s = 0.f;
#pragma unroll
        for (int j = 0; j < 4; ++j) { v[j] = xr[lane + 64 * j]; s += v[j].x * v[j].x + v[j].y * v[j].y + v[j].z * v[j].z + v[j].w * v[j].w; }
        s = wave_sum(s);
        const float rs = rsqrtf(s * (1.f / D) + 1e-6f);
#pragma unroll
        for (int j = 0; j < 4; ++j) {
            const int c = (lane + 64 * j) * 4;
            const float4 g = *(const float4*)(w + c);
            TO* o = out + (size_t)row * D + c;
            stf(o + 0, v[j].x * rs * g.x); stf(o + 1, v[j].y * rs * g.y); stf(o + 2, v[j].z * rs * g.z); stf(o + 3, v[j].w * rs * g.w);
        }
    }
}

__device__ __forceinline__ void rwkv_lin_ph(const bf16* __restrict__ proj, const float* __restrict__ mu, bf16* __restrict__ lin) {
    const int lane = threadIdx.x & 63, wv = threadIdx.x >> 6;
    const float4 m4 = *(const float4*)(mu + 1536 + 4 * lane);
    for (int m = GB * 8 + wv; m < M; m += GN * 8) {
        const uint2 z = *(const uint2*)(proj + (size_t)m * DSHIFT + 1536 + 4 * lane);
        uint2 zp = make_uint2(0, 0);
        if ((m & (S - 1)) != 0) zp = *(const uint2*)(proj + (size_t)(m - 1) * DSHIFT + 1536 + 4 * lane);
        float c[4] = {__builtin_bit_cast(float, z.x << 16), __builtin_bit_cast(float, z.x & 0xffff0000u), __builtin_bit_cast(float, z.y << 16), __builtin_bit_cast(float, z.y & 0xffff0000u)};
        const float q[4] = {__builtin_bit_cast(float, zp.x << 16), __builtin_bit_cast(float, zp.x & 0xffff0000u), __builtin_bit_cast(float, zp.y << 16), __builtin_bit_cast(float, zp.y & 0xffff0000u)};
        const float mm[4] = {m4.x, m4.y, m4.z, m4.w};
#pragma unroll
        for (int e = 0; e < 4; ++e) { float t = c[e] + (q[e] - c[e]) * mm[e];
            if (lane < 16) t = 1.f - 2.f / (1.f + __expf(2.f * t));
            else if (lane >= 32) t = sigmoidf_(t);
            c[e] = t; }
        uint2 o; o.x = pk2(c[0], c[1]); o.y = pk2(c[2], c[3]);
        *(uint2*)(lin + (size_t)m * 256 + 4 * lane) = o;
    }
}
__device__ __forceinline__ void rwkv_wl_ph(const float* __restrict__ wdec, const float* __restrict__ wiclr, const float* __restrict__ wgate, bf16* __restrict__ wl) {
    for (int i = GB * NT + threadIdx.x; i < 1536 * 256; i += GN * NT) {
        const int k = i & 255, n = i >> 8; float v = 0.f;
        if (n < 512) { if (k < 64) v = wdec[k * 512 + n]; }
        else if (n < 1024) { if (k >= 64 && k < 128) v = wiclr[(k - 64) * 512 + (n - 512)]; }
        else { if (k >= 128) v = wgate[(k - 128) * 512 + (n - 1024)]; }
        wl[i] = f2bf(v);
    }
}
struct RwkvIn { const bf16* proj; const bf16* LW; const bf16* AA; const float* mu; const float* k_k; const float* k_a; const float* r_k; float* Y; float* RK; };
constexpr int TB = 64;
constexpr int RW_ITEMS = NB * 8 * 2;
template <int CTRL> __device__ __forceinline__ float dpp16(float x) { return __builtin_bit_cast(float, __builtin_amdgcn_update_dpp(0, __builtin_bit_cast(int, x), CTRL, 0xf, 0xf, true)); }
__device__ __forceinline__ void rwkv_scan_ph(const RwkvIn& I, char* lds) {
    float* Rs = (float*)lds; float* Ws = Rs + TB * 64; float* Kps = Ws + TB * 64; float* KKs = Kps + TB * 64; float* Bs = KKs + TB * 64; float* Vs = Bs + TB * 64; float* Ys = Vs + TB * 64;
    const int lane = threadIdx.x & 63, wv = threadIdx.x >> 6;
    for (int item = GB; item < RW_ITEMS; item += GN) {
        const int half = item & 1, h = (item >> 1) & 7, b = item >> 4;
        const int j = lane & 15, rl = 4 * wv + (lane >> 4), row = 32 * half + rl;
        float s0 = 0.f, s1 = 0.f, s2 = 0.f, s3 = 0.f, sa = 0.f;
        const int tau = threadIdx.x >> 3, cg = threadIdx.x & 7, ch0 = h * 64 + cg * 8;
        uint4 gr, gk, gv, qr, qk, qv, ga, gl;
#define RW_ISSUE(blk) do { const int t_ = (blk) * TB + tau; const size_t m_ = (size_t)b * S + t_; const bf16* z_ = I.proj + m_ * DSHIFT + ch0; \
            gr = *(const uint4*)(z_); gk = *(const uint4*)(z_ + 512); gv = *(const uint4*)(z_ + 1024); \
            if (t_ > 0) { qr = *(const uint4*)(z_ - DSHIFT); qk = *(const uint4*)(z_ + 512 - DSHIFT); qv = *(const uint4*)(z_ + 1024 - DSHIFT); } \
            else { qr = make_uint4(0, 0, 0, 0); qk = qr; qv = qr; } \
            ga = *(const uint4*)(I.AA + m_ * 512 + ch0); gl = *(const uint4*)(I.LW + m_ * 512 + ch0); } while (0)
#define RW_COMMIT(blk) do { \
            const unsigned wr_[4] = {gr.x, gr.y, gr.z, gr.w}, wk_[4] = {gk.x, gk.y, gk.z, gk.w}, wv_[4] = {gv.x, gv.y, gv.z, gv.w}; \
            const unsigned pr_[4] = {qr.x, qr.y, qr.z, qr.w}, pk_[4] = {qk.x, qk.y, qk.z, qk.w}, pv_[4] = {qv.x, qv.y, qv.z, qv.w}; \
            const unsigned wa_[4] = {ga.x, ga.y, ga.z, ga.w}, wl_[4] = {gl.x, gl.y, gl.z, gl.w}; \
            float r_[8], k_[8], v_[8], a_[8], kk_[8], ss_ = 0.f, rk_ = 0.f; \
            _Pragma("unroll") for (int e = 0; e < 8; ++e) { const int w_ = e >> 1; const bool hi_ = e & 1; \
                auto ex = [&](unsigned u) { return hi_ ? __builtin_bit_cast(float, u & 0xffff0000u) : __builtin_bit_cast(float, u << 16); }; \
                const float mr_ = I.mu[ch0 + e], mk_ = I.mu[512 + ch0 + e], mv_ = I.mu[1024 + ch0 + e]; \
                float x = ex(wr_[w_]); r_[e] = x + (ex(pr_[w_]) - x) * mr_; x = ex(wk_[w_]); k_[e] = x + (ex(pk_[w_]) - x) * mk_; x = ex(wv_[w_]); v_[e] = x + (ex(pv_[w_]) - x) * mv_; \
                a_[e] = ex(wa_[w_]); kk_[e] = k_[e] * I.k_k[ch0 + e]; ss_ += kk_[e] * kk_[e]; } \
            ss_ += dpp16<0xB1>(ss_); ss_ += dpp16<0x4E>(ss_); ss_ += dpp16<0x141>(ss_); \
            const float inv_ = 1.f / fmaxf(sqrtf(ss_), 1e-12f); \
            float o_[6][8]; \
            _Pragma("unroll") for (int e = 0; e < 8; ++e) { const int w_ = e >> 1; const bool hi_ = e & 1; \
                const float lw_ = hi_ ? __builtin_bit_cast(float, wl_[w_] & 0xffff0000u) : __builtin_bit_cast(float, wl_[w_] << 16); \
                const float kp_ = k_[e] * (1.f + (a_[e] - 1.f) * I.k_a[ch0 + e]); const float kn_ = kk_[e] * inv_; \
                o_[0][e] = r_[e]; o_[1][e] = __expf(lw_); o_[2][e] = kp_; o_[3][e] = kn_; o_[4][e] = kn_ * a_[e]; o_[5][e] = v_[e]; rk_ += r_[e] * kp_ * I.r_k[ch0 + e]; } \
            _Pragma("unroll") for (int q_ = 0; q_ < 6; ++q_) { float* d_ = Rs + q_ * (TB * 64) + tau * 64 + cg * 8; \
                *(float4*)d_ = make_float4(o_[q_][0], o_[q_][1], o_[q_][2], o_[q_][3]); *(float4*)(d_ + 4) = make_float4(o_[q_][4], o_[q_][5], o_[q_][6], o_[q_][7]); } \
            if (half == 0) { rk_ += dpp16<0xB1>(rk_); rk_ += dpp16<0x4E>(rk_); rk_ += dpp16<0x141>(rk_); \
                if (cg == 0) I.RK[((size_t)b * S + (blk) * TB + tau) * 8 + h] = rk_; } } while (0)
        RW_ISSUE(0);
        __syncthreads();
        RW_COMMIT(0);
        __syncthreads();
        for (int blk = 0; blk < S / TB; ++blk) {
            if (blk + 1 < S / TB) RW_ISSUE(blk + 1);
            float4 r4 = *(const float4*)(Rs + 4 * j), w4 = *(const float4*)(Ws + 4 * j), k4 = *(const float4*)(Kps + 4 * j), b4 = *(const float4*)(Bs + 4 * j);
            float vv = Vs[row];
            if (blk == 0) sa = 0.f;
#pragma unroll 2
            for (int t = 0; t < TB; ++t) {
                const int tn = (t + 1 < TB) ? t + 1 : t;
                const float4 n4n = *(const float4*)(KKs + tn * 64 + 4 * j);
                const float4 r4n = *(const float4*)(Rs + tn * 64 + 4 * j), w4n = *(const float4*)(Ws + tn * 64 + 4 * j), k4n = *(const float4*)(Kps + tn * 64 + 4 * j), b4n = *(const float4*)(Bs + tn * 64 + 4 * j);
                const float vvn = Vs[tn * 64 + row];
                s0 = s0 * w4.x + (sa * b4.x + vv * k4.x);
                s1 = s1 * w4.y + (sa * b4.y + vv * k4.y);
                s2 = s2 * w4.z + (sa * b4.z + vv * k4.z);
                s3 = s3 * w4.w + (sa * b4.w + vv * k4.w);
                float py = (s0 * r4.x + s1 * r4.y) + (s2 * r4.z + s3 * r4.w);
                float ps = (s0 * n4n.x + s1 * n4n.y) + (s2 * n4n.z + s3 * n4n.w);
                py += dpp16<0xB1>(py); ps += dpp16<0xB1>(ps);
                py += dpp16<0x4E>(py); ps += dpp16<0x4E>(ps);
                py += dpp16<0x141>(py); ps += dpp16<0x141>(ps);
                py += dpp16<0x140>(py); ps += dpp16<0x140>(ps);
                if (j == 0) Ys[t * 32 + rl] = py;
                if (t + 1 < TB) sa = -ps;
                r4 = r4n; w4 = w4n; k4 = k4n; b4 = b4n; vv = vvn;
            }
            __syncthreads();
            { const int t = threadIdx.x >> 3, r0 = (threadIdx.x & 7) * 4; const size_t m = (size_t)b * S + blk * TB + t;
              *(float4*)(I.Y + m * 512 + h * 64 + 32 * half + r0) = *(const float4*)(Ys + t * 32 + r0); }
            if (blk + 1 < S / TB) RW_COMMIT(blk + 1);
            __syncthreads();
            if (blk + 1 < S / TB) { const float4 n4 = *(const float4*)(KKs + 4 * j);
                float ps = (s0 * n4.x + s1 * n4.y) + (s2 * n4.z + s3 * n4.w);
                ps += dpp16<0xB1>(ps); ps += dpp16<0x4E>(ps); ps += dpp16<0x141>(ps); ps += dpp16<0x140>(ps);
                sa = -ps; }
        }
    }
}
__device__ __forceinline__ void rwkv_post_ph(const float* __restrict__ Y, const float* __restrict__ RK, const bf16* __restrict__ proj, const float* __restrict__ mu, const bf16* __restrict__ G,
                             const float* __restrict__ lnw, const float* __restrict__ lnb, bf16* __restrict__ ymix) {
    const int c = threadIdx.x;
    const float muv = mu[1024 + c], lw_ = lnw[c], lb_ = lnb[c];
    for (int m0 = GB * 4; m0 < M; m0 += GN * 4) {
        float y[4], v[4], pv[4], rk[4], g[4];
#pragma unroll
        for (int i = 0; i < 4; ++i) { const int m = m0 + i; const size_t ix = (size_t)m * 512 + c;
            y[i] = Y[ix]; v[i] = bf2f(proj[(size_t)m * DSHIFT + 1024 + c]); pv[i] = (m & (S - 1)) ? bf2f(proj[(size_t)(m - 1) * DSHIFT + 1024 + c]) : 0.f;
            rk[i] = RK[(size_t)m * 8 + (c >> 6)]; g[i] = bf2f(G[ix]); }
#pragma unroll
        for (int i = 0; i < 4; ++i) {
            const float mean = wave_sum(y[i]) * (1.f / 64.f);
            const float d = y[i] - mean;
            const float var = wave_sum(d * d) * (1.f / 64.f);
            float yn = d * rsqrtf(var + 64e-5f) * lw_ + lb_;
            const float vs = v[i] + (pv[i] - v[i]) * muv;
            yn += rk[i] * vs;
            ymix[(size_t)(m0 + i) * D + c] = f2bf(yn * g[i]);
        }
    }
}

constexpr int PSLOTS = NASSIGN + NEXP * 256;
constexpr int MAXTILES = PSLOTS / 256;
struct MoeBufs { int* tok_e; float* tok_g; int* tok_slot; int* slot_tok; float* slot_gate; int* counts; int* offs; int* cursor; int* tiles; int* ntiles; };
__device__ __forceinline__ void moe_zero_ph(const MoeBufs& mb) {
    if (GB == 0 && threadIdx.x < 32) { mb.counts[threadIdx.x] = 0; mb.cursor[threadIdx.x] = 0; }
    for (int i = GB * NT + threadIdx.x; i < PSLOTS; i += GN * NT) { mb.slot_tok[i] = 0; mb.slot_gate[i] = 0.f; }
}
__device__ __forceinline__ void router_ph(const float* __restrict__ x3, const float* __restrict__ nw, bf16* __restrict__ h3, const float* __restrict__ wrg, const float* __restrict__ brg,
                          const float* __restrict__ wre, const float* __restrict__ bre, const MoeBufs& mb) {
    const int lane = threadIdx.x & 63, wv = threadIdx.x >> 6;
    for (int m = GB * 8 + wv; m < M; m += GN * 8) {
        const float4* xr = (const float4*)(x3 + (size_t)m * D);
        float h[16]; float s = 0.f;
#pragma unroll
        for (int j = 0; j < 4; ++j) { const float4 v = xr[lane + 64 * j]; h[4 * j] = v.x; h[4 * j + 1] = v.y; h[4 * j + 2] = v.z; h[4 * j + 3] = v.w; s += v.x * v.x + v.y * v.y + v.z * v.z + v.w * v.w; }
        s = wave_sum(s);
        const float rs = rsqrtf(s * (1.f / D) + 1e-6f);
        float l1[4] = {0.f, 0.f, 0.f, 0.f};
#pragma unroll
        for (int j = 0; j < 4; ++j) {
            const int k0 = (lane + 64 * j) * 4;
            const float4 g = *(const float4*)(nw + k0);
            h[4 * j] *= rs * g.x; h[4 * j + 1] *= rs * g.y; h[4 * j + 2] *= rs * g.z; h[4 * j + 3] *= rs * g.w;
            uint2 o; o.x = pk2(h[4 * j], h[4 * j + 1]); o.y = pk2(h[4 * j + 2], h[4 * j + 3]);
            *(uint2*)(h3 + (size_t)m * D + k0) = o;
#pragma unroll
            for (int e = 0; e < 4; ++e) { const float4 w = *(const float4*)(wrg + (k0 + e) * 4); const float x = h[4 * j + e]; l1[0] += x * w.x; l1[1] += x * w.y; l1[2] += x * w.z; l1[3] += x * w.w; }
        }
#pragma unroll
        for (int i = 0; i < 4; ++i) l1[i] = wave_sum(l1[i]) + brg[i];
        int grp = 0; float best = l1[0];
#pragma unroll
        for (int i = 1; i < 4; ++i) if (l1[i] > best) { best = l1[i]; grp = i; }
        float se = 0.f;
#pragma unroll
        for (int i = 0; i < 4; ++i) se += __expf(l1[i] - best);
        const float g1 = 1.f / se;
        float l2[8] = {};
        const float* we = wre + (size_t)grp * D * 8;
#pragma unroll
        for (int j = 0; j < 4; ++j) {
            const int k0 = (lane + 64 * j) * 4;
#pragma unroll
            for (int e = 0; e < 4; ++e) { const float x = h[4 * j + e]; const float4 w0 = *(const float4*)(we + (k0 + e) * 8), w1 = *(const float4*)(we + (k0 + e) * 8 + 4);
                l2[0] += x * w0.x; l2[1] += x * w0.y; l2[2] += x * w0.z; l2[3] += x * w0.w; l2[4] += x * w1.x; l2[5] += x * w1.y; l2[6] += x * w1.z; l2[7] += x * w1.w; }
        }
#pragma unroll
        for (int i = 0; i < 8; ++i) l2[i] = wave_sum(l2[i]) + bre[grp * 8 + i];
        int i0 = 0; float v0 = l2[0];
#pragma unroll
        for (int i = 1; i < 8; ++i) if (l2[i] > v0) { v0 = l2[i]; i0 = i; }
        int i1 = -1; float v1 = -3.0e38f;
#pragma unroll
        for (int i = 0; i < 8; ++i) if (i != i0 && l2[i] > v1) { v1 = l2[i]; i1 = i; }
        const float e1 = __expf(v1 - v0), inv = 1.f / (1.f + e1);
        if (lane == 0) {
            const int ea = grp * 8 + i0, eb = grp * 8 + i1;
            mb.tok_e[2 * m] = ea; mb.tok_e[2 * m + 1] = eb;
            mb.tok_g[2 * m] = g1 * inv; mb.tok_g[2 * m + 1] = g1 * e1 * inv;
            atomicAdd(&mb.counts[ea], 1); atomicAdd(&mb.counts[eb], 1);
        }
    }
}
__device__ __forceinline__ void moe_plan_ph(const MoeBufs& mb) {
    if (GB == 0 && threadIdx.x == 0) {
        int off = 0, nt = 0;
        for (int e = 0; e < NEXP; ++e) {
            mb.offs[e] = off; const int c = mb.counts[e];
            for (int r0 = 0; r0 < c; r0 += 256) { mb.tiles[nt] = e; ++nt; }
            off += ((c + 255) / 256) * 256;
        }
        *mb.ntiles = nt;
    }
}
__device__ __forceinline__ void moe_scatter_ph(const MoeBufs& mb) {
    for (int i = GB * NT + threadIdx.x; i < NASSIGN; i += GN * NT) {
        const int e = mb.tok_e[i];
        const int pos = mb.offs[e] + atomicAdd(&mb.cursor[e], 1);
        mb.slot_tok[pos] = i >> 1; mb.slot_gate[pos] = mb.tok_g[i]; mb.tok_slot[i] = pos;
    }
}
__device__ __forceinline__ void moe_gather_ph(const bf16* __restrict__ h3, bf16* __restrict__ xg, const MoeBufs& mb) {
    const int lane = threadIdx.x & 63, wv = threadIdx.x >> 6;
    const int nrows = __hip_atomic_load(mb.ntiles, __ATOMIC_RELAXED, __HIP_MEMORY_SCOPE_AGENT) * 256;
    for (int r = GB * 8 + wv; r < nrows; r += GN * 8) {
        const int t = mb.slot_tok[r];
        const uint4* s = (const uint4*)(h3 + (size_t)t * D); uint4* d = (uint4*)(xg + (size_t)r * D);
        d[lane] = s[lane]; d[lane + 64] = s[lane + 64];
    }
}
__device__ __forceinline__ void moe_weights_ph(const float* __restrict__ wg, const float* __restrict__ wu, const float* __restrict__ wd, bf16* __restrict__ wgu_t, bf16* __restrict__ wd_t, char* lds) {
    const int lane = threadIdx.x & 63, wv = threadIdx.x >> 6;
    float* scr = (float*)(lds + wv * 16384);
    constexpr int I_GU = 16 * 16;
    constexpr int I_D = 8 * 32;
    constexpr int NIT = NEXP * (2 * I_GU + I_D);
    for (int it = GB * 8 + wv; it < NIT; it += GN * 8) {
        const int e = it / (2 * I_GU + I_D); int r = it % (2 * I_GU + I_D);
        if (r < 2 * I_GU) {
            const int up = r / I_GU; r %= I_GU;
            const int kb = r / 16, nb = r % 16;
            const int pn = nb / 4, nsub = nb % 4;
            const float* W = (up ? wu : wg) + (size_t)e * D * DEXP + nb * 32;
            transpose_item(W + (size_t)kb * 64 * DEXP, 64, 32, wgu_t, D, e * 1024 + pn * 256 + up * 128 + nsub * 32, kb * 64, scr, 0, lane, nullptr, DEXP);
        } else {
            r -= 2 * I_GU;
            const int kb = r / 32, nb = r % 32;
            const float* W = wd + (size_t)e * DEXP * D + nb * 32;
            transpose_item(W + (size_t)kb * 64 * D, 64, 32, wd_t, DEXP, e * 1024 + nb * 32, kb * 64, scr, 0, lane, nullptr, D);
        }
    }
}
__device__ __forceinline__ void final_ph(float* __restrict__ out, const bf16* __restrict__ yslot, const int* __restrict__ tok_slot, const float* __restrict__ w) {
    const int lane = threadIdx.x & 63, wv = threadIdx.x >> 6;
    for (int row = GB * 8 + wv; row < M; row += GN * 8) {
        float4* xr = (float4*)(out + (size_t)row * D);
        const uint2* ya = (const uint2*)(yslot + (size_t)tok_slot[2 * row] * D);
        const uint2* yb = (const uint2*)(yslot + (size_t)tok_slot[2 * row + 1] * D);
        float4 v[4]; float s = 0.f;
#pragma unroll
        for (int j = 0; j < 4; ++j) {
            v[j] = xr[lane + 64 * j];
            const uint2 a = ya[lane + 64 * j], b = yb[lane + 64 * j];
            v[j].x += bf2f((bf16)(a.x & 0xffff)) + bf2f((bf16)(b.x & 0xffff));
            v[j].y += bf2f((bf16)(a.x >> 16)) + bf2f((bf16)(b.x >> 16));
            v[j].z += bf2f((bf16)(a.y & 0xffff)) + bf2f((bf16)(b.y & 0xffff));
            v[j].w += bf2f((bf16)(a.y >> 16)) + bf2f((bf16)(b.y >> 16));
            s += v[j].x * v[j].x + v[j].y * v[j].y + v[j].z * v[j].z + v[j].w * v[j].w;
        }
        s = wave_sum(s);
        const float rs = rsqrtf(s * (1.f / D) + 1e-6f);
#pragma unroll
        for (int j = 0; j < 4; ++j) {
            const float4 g = *(const float4*)(w + (lane + 64 * j) * 4);
            xr[lane + 64 * j] = make_float4(v[j].x * rs * g.x, v[j].y * rs * g.y, v[j].z * rs * g.z, v[j].w * rs * g.w);
        }
    }
}


struct S5Tab { float* Kmat; bf16* BtA; bf16* BtB; };
__device__ __forceinline__ void s5_lam(const float* lam_re, const float* lam_im, const float* log_dt, int g, int n, float& a, float& w) {
    const float dt = __expf(log_dt[g]); a = lam_re[g * 64 + n] * dt; w = lam_im[g * 64 + n] * dt;
}
__device__ __forceinline__ void cexpj(float a, float w, float j, float& re, float& im) { const float e = __expf(a * j); float s, c; sincosf(w * j, &s, &c); re = e * c; im = e * s; }
__device__ __forceinline__ void s5_bbar(const float* lam_re, const float* lam_im, const float* log_dt, const float* b_re, const float* b_im, int g, int n, int h, float& br, float& bi) {
    float a, w; s5_lam(lam_re, lam_im, log_dt, g, n, a, w);
    float lbr, lbi; cexpj(a, w, 1.f, lbr, lbi);
    const float lr = lam_re[g * 64 + n], li = lam_im[g * 64 + n];
    const float nr = lbr - 1.f, ni = lbi, den = lr * lr + li * li;
    const float cr = (nr * lr + ni * li) / den, ci = (ni * lr - nr * li) / den;
    const float xr = b_re[(g * 64 + n) * 16 + h], xi = b_im[(g * 64 + n) * 16 + h];
    br = cr * xr - ci * xi; bi = cr * xi + ci * xr;
}
__device__ __forceinline__ void s5_tables0_ph(const float* lam_re, const float* lam_im, const float* log_dt, const float* b_re, const float* b_im, const float* c_re, const float* c_im, const S5Tab& T) {
    const int gtid = GB * NT + threadIdx.x, gsz = GN * NT;
    for (int i = gtid; i < 32 * 32 * 256; i += gsz) {
        const int h = i & 15, hp = (i >> 4) & 15, j = (i >> 8) & 31, g = i >> 13;
        float acc = 0.f;
        for (int n = 0; n < 64; ++n) {
            float a, w; s5_lam(lam_re, lam_im, log_dt, g, n, a, w);
            float pr, pi; cexpj(a, w, (float)j, pr, pi);
            float br, bi; s5_bbar(lam_re, lam_im, log_dt, b_re, b_im, g, n, h, br, bi);
            const float tr = pr * br - pi * bi, ti = pr * bi + pi * br;
            acc += c_re[(g * 16 + hp) * 64 + n] * tr - c_im[(g * 16 + hp) * 64 + n] * ti;
        }
        T.Kmat[i] = acc;
    }
    for (int i = gtid; i < 32 * 256 * 512; i += gsz) {
        const int col = i & 511, r = (i >> 9) & 255, g = i >> 17;
        float v = 0.f;
        if (r < 128) {
            const int n = r & 63, s = col >> 4, h = col & 15;
            float a, w; s5_lam(lam_re, lam_im, log_dt, g, n, a, w);
            float pr, pi; cexpj(a, w, (float)(S5L - 1 - s), pr, pi);
            float br, bi; s5_bbar(lam_re, lam_im, log_dt, b_re, b_im, g, n, h, br, bi);
            v = (r < 64) ? (pr * br - pi * bi) : (pr * bi + pi * br);
        }
        T.BtA[((size_t)g * 768 + 512 + r) * 512 + col] = f2bf(v);
    }
    for (int i = gtid; i < 32 * 512 * 256; i += gsz) {
        const int k = i & 255, row = (i >> 8) & 511, g = i >> 17;
        float v = 0.f;
        if (k < 128) {
            const int n = k & 63, sp = row >> 4, hp = row & 15;
            float a, w; s5_lam(lam_re, lam_im, log_dt, g, n, a, w);
            float pr, pi; cexpj(a, w, (float)(sp + 1), pr, pi);
            const float cr = c_re[(g * 16 + hp) * 64 + n], ci = c_im[(g * 16 + hp) * 64 + n];
            v = (k < 64) ? (cr * pr - ci * pi) : -(cr * pi + ci * pr);
        }
        T.BtB[i] = f2bf(v);
    }
}
__device__ __forceinline__ void s5_tables1_ph(const float* dsk, const S5Tab& T) {
    const int gtid = GB * NT + threadIdx.x, gsz = GN * NT;
    for (int i = gtid; i < 32 * 512 * 512; i += gsz) {
        const int col = i & 511, row = (i >> 9) & 511, g = i >> 18;
        const int sp = row >> 4, hp = row & 15, s = col >> 4, h = col & 15;
        float v = 0.f;
        if (s <= sp) v = T.Kmat[((g * 32 + (sp - s)) * 16 + hp) * 16 + h];
        if (row == col) v += dsk[g * 16 + hp];
        T.BtA[((size_t)g * 768 + row) * 512 + col] = f2bf(v);
    }
}
__device__ __forceinline__ void s5_carry_ph(const float* lam_re, const float* lam_im, const float* log_dt, const float* __restrict__ F, bf16* __restrict__ XST) {
    const int gtid = GB * NT + threadIdx.x, gsz = GN * NT;
    for (int i = gtid; i < 32 * S5R * 16; i += gsz) { const int row = i >> 4, q = i & 15; *(uint4*)(XST + (size_t)row * 256 + 128 + q * 8) = make_uint4(0, 0, 0, 0); }
    const int lane = threadIdx.x & 63, wv = threadIdx.x >> 6;
    const int nidle = (GN > RW_ITEMS) ? GN - RW_ITEMS : GN, myi = (GN > RW_ITEMS) ? GB - RW_ITEMS : GB;
    for (int item = (myi < 0 ? NB * 32 : myi + nidle * wv); item < NB * 32; item += nidle * 8) {
        const int b = item >> 5, g = item & 31, n = lane;
        float a, w; s5_lam(lam_re, lam_im, log_dt, g, n, a, w);
        float pr, pi; cexpj(a, w, (float)S5L, pr, pi);
        float xr = 0.f, xi = 0.f;
        const size_t row0 = (size_t)g * S5R + (size_t)b * (S / S5L);
        const float* f = F + row0 * 128; bf16* xo = XST + row0 * 256;
        for (int c0 = 0; c0 < S / S5L; c0 += 8) {
            float fr[8], fi[8];
#pragma unroll
            for (int q = 0; q < 8; ++q) { fr[q] = f[(size_t)(c0 + q) * 128 + n]; fi[q] = f[(size_t)(c0 + q) * 128 + 64 + n]; }
#pragma unroll
            for (int q = 0; q < 8; ++q) {
                xo[(size_t)(c0 + q) * 256 + n] = f2bf(xr); xo[(size_t)(c0 + q) * 256 + 64 + n] = f2bf(xi);
                const float nr = pr * xr - pi * xi + fr[q], ni = pr * xi + pi * xr + fi[q];
                xr = nr; xi = ni;
            }
        }
    }
}

#define XB_TMO      128
#define XB_XCNT(j)  (256  + 64 * (j))
#define XB_XSUB(j)  (1280 + 64 * (j))
#define XB_XGEN(j)  (2304 + 64 * (j))
#define XB_TOP      3328
#define XB_TOPGEN   3392
#define XCD_BAR_WORDS 3456
#define XB_SPIN_CAP (1u << 20)
__device__ __forceinline__ unsigned xb_ld(unsigned* p)              { return __hip_atomic_load(p, __ATOMIC_RELAXED, __HIP_MEMORY_SCOPE_AGENT); }
__device__ __forceinline__ unsigned xb_add(unsigned* p, unsigned v) { return __hip_atomic_fetch_add(p, v, __ATOMIC_RELAXED, __HIP_MEMORY_SCOPE_AGENT); }
__device__ __forceinline__ unsigned xb_xcc_id() { return (unsigned)__builtin_amdgcn_s_getreg((3 << 11) | 20) & 0xFu; }
#define XB_SPIN(cond, bar) do { unsigned _sp = 0; while (cond) { __builtin_amdgcn_s_sleep(1); \
    if ((++_sp & 255u) == 0u) { if (xb_ld(&(bar)[XB_TMO])) break; if (_sp > XB_SPIN_CAP) { atomicAdd(&(bar)[XB_TMO], 1u); break; } } } } while (0)
struct XcdBarrier { unsigned* bar; unsigned x; volatile __attribute__((address_space(3))) unsigned* st; };
__device__ __forceinline__ XcdBarrier xcd_barrier_post(unsigned* bar, volatile __attribute__((address_space(3))) unsigned* st) {
    XcdBarrier b; b.bar = bar; b.x = xb_xcc_id(); b.st = st;
    if (threadIdx.x == 0) (void)xb_add(&bar[XB_XCNT(b.x)], 1u);
    return b;
}
__device__ __forceinline__ void xcd_barrier_complete(unsigned* bar, unsigned x, unsigned& nloc, unsigned& nx) {
    const unsigned G = gridDim.x * gridDim.y * gridDim.z;
    unsigned sum, cnt, mine, sp = 0u;
    for (;;) {
        sum = 0u; cnt = 0u; mine = 0u;
#pragma unroll
        for (unsigned j = 0; j < 16; ++j) { const unsigned c = xb_ld(&bar[XB_XCNT(j)]); sum += c; cnt += (c > 0u) ? 1u : 0u; mine = (j == x) ? c : mine; }
        if (sum == G) break;
        __builtin_amdgcn_s_sleep(1);
        if ((++sp & 255u) == 0u) { if (xb_ld(&bar[XB_TMO])) break; if (sp > XB_SPIN_CAP) { atomicAdd(&bar[XB_TMO], 1u); break; } }
    }
    nloc = mine > 0u ? mine : 1u; nx = cnt > 0u ? cnt : 1u;
}
__device__ __forceinline__ void xcd_barrier(const XcdBarrier& b) {
    asm volatile("s_waitcnt vmcnt(0)" ::: "memory");
    __syncthreads();
    if (threadIdx.x == 0) {
        unsigned* bar = b.bar;
        __builtin_amdgcn_s_waitcnt(0);
        unsigned nloc = b.st[0], nx = b.st[1];
        if (nloc == 0u) { xcd_barrier_complete(bar, b.x, nloc, nx); b.st[0] = nloc; b.st[1] = nx; }
        const unsigned old = xb_add(&bar[XB_XSUB(b.x)], 1u);
        const unsigned gen = old / nloc;
        if (old + 1u == (gen + 1u) * nloc) {
            __builtin_amdgcn_fence(__ATOMIC_RELEASE, "agent");
            asm volatile("s_waitcnt vmcnt(0)" ::: "memory");
            const unsigned og = xb_add(&bar[XB_TOP], 1u);
            const unsigned tg = og / nx;
            if (og + 1u == (tg + 1u) * nx) xb_add(&bar[XB_TOPGEN], 1u);
            else XB_SPIN(xb_ld(&bar[XB_TOPGEN]) == tg, bar);
            __builtin_amdgcn_fence(__ATOMIC_ACQUIRE, "agent");
            xb_add(&bar[XB_XGEN(b.x)], 1u);
            asm volatile("s_waitcnt vmcnt(0)" ::: "memory");
        } else {
            XB_SPIN(xb_ld(&bar[XB_XGEN(b.x)]) == gen, bar);
            __builtin_amdgcn_fence(__ATOMIC_ACQUIRE, "agent");
            asm volatile("s_waitcnt vmcnt(0)" ::: "memory");
        }
    }
    __syncthreads();
}

struct Params { const float* in[41]; float* out; char* ws; };

constexpr size_t W_PROJ = 0;
constexpr size_t W_US5 = 224;
constexpr size_t W_WTS = 288;
constexpr size_t W_YI = 352;
constexpr size_t W_F = 416;
constexpr size_t W_XST = 448;
constexpr size_t W_Z = 480;
constexpr size_t W_MISC = 544;
constexpr size_t W_XN = 576;
constexpr size_t W_CTL = 558;
constexpr size_t WO_IN = 0, WO_GLU = 5 * MiB, WO_MIX = 6 * MiB, WO_Q = 8 * MiB, WO_K = 10 * MiB, WO_V = 12 * MiB, WO_O = 14 * MiB, WO_KMAT = 16 * MiB, WO_BTA = 17 * MiB, WO_BTB = 41 * MiB;

__global__ void __launch_bounds__(NT, 2) fwd_kernel(Params p) {
    extern __shared__ __attribute__((aligned(16))) char lds[];
    cg::grid_group grid = cg::this_grid();
    PG8_LAS unsigned char* ldsl = (PG8_LAS unsigned char*)lds;
    char* ws = p.ws; char* dout = (char*)p.out; float* out = p.out;
#define IN(i) (p.in[i])
    volatile __attribute__((address_space(3))) unsigned* bst = (volatile __attribute__((address_space(3))) unsigned*)(ldsl + LDS_BYTES - 64);
    if (threadIdx.x < 2) bst[threadIdx.x] = 0u;
    __syncthreads();
    const XcdBarrier xbar = xcd_barrier_post((unsigned*)(ws + W_CTL * MiB), bst);
#define SYNC() xcd_barrier(xbar)
    char* WT = ws + W_WTS * MiB;
    bf16* w_in_t = (bf16*)(WT + WO_IN); bf16* w_glu_t = (bf16*)(WT + WO_GLU); bf16* w_mix_t = (bf16*)(WT + WO_MIX);
    bf16* w_q_t = (bf16*)(WT + WO_Q); bf16* w_k_t = (bf16*)(WT + WO_K); bf16* w_v_t = (bf16*)(WT + WO_V); bf16* w_o_t = (bf16*)(WT + WO_O);
    S5Tab stab; stab.Kmat = (float*)(WT + WO_KMAT); stab.BtA = (bf16*)(WT + WO_BTA); stab.BtB = (bf16*)(WT + WO_BTB);
    bf16* PROJ = (bf16*)(ws + W_PROJ * MiB); bf16* US5 = (bf16*)(ws + W_US5 * MiB);
    bf16* XN = (bf16*)(ws + W_XN * MiB);
    transpose_ph(IN(3), D, DIN, w_in_t, D, 0, 0, lds);
    transpose_ph(IN(23), 512, 512, w_glu_t, 512, 0, 0, lds);
    transpose_ph(IN(25), D, D, w_mix_t, D, 0, 0, lds);
    transpose_ph(IN(28), D, D, w_q_t, D, 0, 0, lds);
    transpose_ph(IN(29), D, D, w_k_t, D, 0, 0, lds);
    transpose_ph(IN(30), D, D, w_v_t, D, 0, 0, lds);
    transpose_ph(IN(31), D, D, w_o_t, D, 0, 0, lds);
    s5_tables0_ph(IN(15), IN(16), IN(17), IN(18), IN(19), IN(20), IN(21), stab);
    bf16* wl_t = (bf16*)(WT + 49 * MiB);
    rwkv_wl_ph(IN(6), IN(8), IN(9), wl_t);
    rmsnorm_ph<bf16>(IN(0), IN(2), XN, M);
    grid.sync();
    s5_tables1_ph(IN(22), stab);
    { pg8::PlainOrder S; S.init(XN, D, w_in_t, D, M, DIN, D); pg8::EpiProj E{PROJ, US5}; pg8::gemm_phase(ldsl, S, E); }
    SYNC();
    bf16* LIN = (bf16*)(ws + (W_MISC + 16) * MiB);
    rwkv_lin_ph(PROJ, IN(4), LIN);
    SYNC();
    bf16* YI = (bf16*)(ws + W_YI * MiB); float* F = (float*)(ws + W_F * MiB); bf16* XST = (bf16*)(ws + W_XST * MiB); bf16* Z = (bf16*)(ws + W_Z * MiB);
    bf16* LWb = (bf16*)(ws + 704 * MiB); bf16* AAb = (bf16*)(ws + 768 * MiB); bf16* Gb = (bf16*)(ws + 832 * MiB);
    float* Yr = (float*)(ws + 896 * MiB); float* RKb = (float*)(ws + W_MISC * MiB);
    { pg8::GroupOrder S; S.init(US5, 512, (size_t)S5R * 512, stab.BtA, 512, (size_t)768 * 512, 32, S5R, 768, 512); pg8::EpiS5a E{YI, F}; pg8::gemm_phase(ldsl, S, E); }
    { pg8::PlainOrder S; S.init(LIN, 256, wl_t, 256, M, 1536, 256); pg8::EpiLora E{LWb, (size_t)32 * MiB, IN(5), IN(7)}; pg8::gemm_phase(ldsl, S, E); }
    SYNC();
    s5_carry_ph(IN(15), IN(16), IN(17), F, XST);
    { RwkvIn ri{PROJ, LWb, AAb, IN(4), IN(10), IN(11), IN(12), Yr, RKb}; rwkv_scan_ph(ri, lds); }
    SYNC();
    bf16* YMIX = XN;
    { pg8::GroupOrder S; S.init(XST, 256, (size_t)S5R * 256, stab.BtB, 256, (size_t)512 * 256, 32, S5R, 512, 256); pg8::EpiS5b E{YI, Z}; pg8::gemm_phase(ldsl, S, E); }
    rwkv_post_ph(Yr, RKb, PROJ, IN(4), Gb, IN(13), IN(14), YMIX);
    SYNC();
    { pg8::PlainOrder S; S.init(Z, 512, w_glu_t, 512, M, 512, 512); pg8::EpiGlu E{Z, IN(24), YMIX}; pg8::gemm_phase(ldsl, S, E); }
    SYNC();
    { pg8::PlainOrder S; S.init(YMIX, D, w_mix_t, D, M, D, D); pg8::EpiF32 E{out, D, IN(0), D}; pg8::gemm_phase(ldsl, S, E); }
    SYNC();
    bf16* KM = (bf16*)(ws + (W_MISC + 2) * MiB); bf16* VT = (bf16*)(ws + (W_MISC + 6) * MiB); bf16* MEMN = (bf16*)(ws + (W_MISC + 10) * MiB);
    rmsnorm_ph<bf16>(out, IN(26), XN, M);
    rmsnorm_ph<bf16>(IN(1), IN(27), MEMN, NB * NMEM);
    SYNC();
    bf16* Q = (bf16*)(ws + 128 * MiB);
    { pg8::PlainOrder S; S.init(MEMN, D, w_k_t, D, NB * NMEM, D, D); pg8::EpiBf16 E{KM, D}; pg8::gemm_phase(ldsl, S, E); }
    { pg8::PlainOrder S; S.init(w_v_t, D, MEMN, D, D, NB * NMEM, D); pg8::EpiBf16 E{VT, NB * NMEM}; pg8::gemm_phase(ldsl, S, E); }
    { pg8::PlainOrder S; S.init(XN, D, w_q_t, D, M, D, D); pg8::EpiBf16 E{Q, D}; pg8::gemm_phase(ldsl, S, E); }
    SYNC();
    bf16* P = (bf16*)(ws + W_YI * MiB);
    { pg8::AttnOrder S; S.init(Q, KM, D, 0); pg8::EpiSoftmax E{P, (PG8_LAS float*)(ldsl + 131072)}; pg8::gemm_phase(ldsl, S, E); }
    SYNC();
    bf16* O = XN;
    { pg8::AttnOrder S; S.init(P, VT, NB * NMEM, 1); pg8::EpiAttnO E{O}; pg8::gemm_phase(ldsl, S, E); }
    SYNC();
    { pg8::PlainOrder S; S.init(O, D, w_o_t, D, M, D, D); pg8::EpiF32 E{out, D, out, D}; pg8::gemm_phase(ldsl, S, E); }
    SYNC();
    bf16* H3 = XN;
    bf16* XG = (bf16*)(ws + 0);
    bf16* WGU_t = (bf16*)(ws + 272 * MiB); bf16* WD_t = (bf16*)(ws + 336 * MiB);
    bf16* HID = (bf16*)(ws + 368 * MiB);
    bf16* YSLOT = (bf16*)(ws + 704 * MiB);
    MoeBufs mb; char* mbase = ws + 976 * MiB;
    mb.tok_e = (int*)(mbase); mb.tok_g = (float*)(mbase + 1 * MiB); mb.tok_slot = (int*)(mbase + 2 * MiB); mb.slot_tok = (int*)(mbase + 3 * MiB);
    mb.slot_gate = (float*)(mbase + 4 * MiB); mb.counts = (int*)(mbase + 5 * MiB); mb.offs = mb.counts + 64; mb.cursor = mb.counts + 128; mb.ntiles = mb.counts + 192;
    mb.tiles = (int*)(mbase + 6 * MiB);
    moe_zero_ph(mb);
    moe_weights_ph(IN(37), IN(38), IN(39), WGU_t, WD_t, lds);
    SYNC();
    router_ph(out, IN(32), H3, IN(33), IN(34), IN(35), IN(36), mb);
    SYNC();
    moe_plan_ph(mb);
    SYNC();
    moe_scatter_ph(mb);
    SYNC();
    moe_gather_ph(H3, XG, mb);
    SYNC();
    const int ntiles = __hip_atomic_load(mb.ntiles, __ATOMIC_RELAXED, __HIP_MEMORY_SCOPE_AGENT);
    { pg8::MoeOrder S; S.init(XG, D, WGU_t, D, D, mb.tiles, ntiles, 1024); pg8::EpiSilu E{HID}; pg8::gemm_phase(ldsl, S, E); }
    SYNC();
    { pg8::MoeOrder S; S.init(HID, DEXP, WD_t, DEXP, DEXP, mb.tiles, ntiles, 1024); pg8::EpiGate E{YSLOT, mb.slot_gate}; pg8::gemm_phase(ldsl, S, E); }
    SYNC();
    final_ph(out, YSLOT, mb.tok_slot, IN(40));
}
}

extern "C" void kernel_launch(void* const* d_in, const int* in_sizes, int n_in, void* d_out, int out_size, void* d_ws, size_t ws_size, hipStream_t stream) {
    (void)in_sizes; (void)out_size; (void)ws_size;
    static int grid = 0;
    if (grid == 0) {
        int dev = 0, cus = 0, per_cu = 0;
        hipGetDevice(&dev);
        hipDeviceGetAttribute(&cus, hipDeviceAttributeMultiprocessorCount, dev);
        hipFuncSetAttribute((const void*)fwd_kernel, hipFuncAttributeMaxDynamicSharedMemorySize, LDS_BYTES);
        hipOccupancyMaxActiveBlocksPerMultiprocessor(&per_cu, (const void*)fwd_kernel, NT, LDS_BYTES);
        if (per_cu < 1) { fprintf(stderr, "occupancy query says %d blocks/CU\n", per_cu); per_cu = 1; }
        grid = cus * 1;
    }
    (void)hipMemsetAsync((char*)d_ws + W_CTL * MiB, 0, 16384, stream);
    Params p{};
    for (int i = 0; i < 41 && i < n_in; ++i) p.in[i] = (const float*)d_in[i];
    p.out = (float*)d_out; p.ws = (char*)d_ws;
    void* args[] = {&p};
    hipError_t e = hipLaunchCooperativeKernel((const void*)fwd_kernel, dim3(grid), dim3(NT), args, LDS_BYTES, stream);
    if (e != hipSuccess) fprintf(stderr, "cooperative launch failed: %s (grid %d)\n", hipGetErrorString(e), grid);
}
```

```cpp
#include <hip/hip_runtime.h>
#include <hip/hip_cooperative_groups.h>
#include <stdint.h>
#include <cstdio>
namespace cg = cooperative_groups;

namespace {
constexpr int NB = 8, S = 8192, D = 1024, M = NB * S;
constexpr int DR = 512, DSHIFT = 1792, DIN = 2304, NMEM = 256;
constexpr int NEXP = 32, DEXP = 512, NASSIGN = 2 * M;
constexpr size_t MiB = 1u << 20;
constexpr int NT = 512;
constexpr int S5L = 32, S5R = M / S5L;
constexpr int LDS_BYTES = 147456;
#define GB ((int)blockIdx.x)
#define GN ((int)gridDim.x)

typedef unsigned short bf16;
__device__ __forceinline__ bf16 f2bf(float f) { unsigned u = __builtin_bit_cast(unsigned, f); return (bf16)((u + 0x7fffu + ((u >> 16) & 1u)) >> 16); }
__device__ __forceinline__ unsigned pk2(float lo, float hi) { return (unsigned)f2bf(lo) | ((unsigned)f2bf(hi) << 16); }
__device__ __forceinline__ int lane_id() { int l = (int)__builtin_amdgcn_mbcnt_hi(~0u, __builtin_amdgcn_mbcnt_lo(~0u, 0u)); asm volatile("" : "+v"(l)); return l; }
__device__ __forceinline__ float bf2f(bf16 h) { return __builtin_bit_cast(float, (unsigned)h << 16); }

template <typename T> __device__ __forceinline__ float ldf(const T* p);
template <> __device__ __forceinline__ float ldf<float>(const float* p) { return *p; }
template <> __device__ __forceinline__ float ldf<bf16>(const bf16* p) { return bf2f(*p); }
template <typename T> __device__ __forceinline__ void stf(T* p, float v);
template <> __device__ __forceinline__ void stf<float>(float* p, float v) { *p = v; }
template <> __device__ __forceinline__ void stf<bf16>(bf16* p, float v) { *p = f2bf(v); }

template <int CTRL, int ROWMASK> __device__ __forceinline__ float dppf_(float x) { return __builtin_bit_cast(float, __builtin_amdgcn_update_dpp(0, __builtin_bit_cast(int, x), CTRL, ROWMASK, 0xf, false)); }
__device__ __forceinline__ float wave_sum(float v) {
    v += dppf_<0xB1, 0xf>(v); v += dppf_<0x4E, 0xf>(v); v += dppf_<0x141, 0xf>(v); v += dppf_<0x140, 0xf>(v);
    v += dppf_<0x142, 0xa>(v);
    v += dppf_<0x143, 0xc>(v);
    return __builtin_bit_cast(float, __builtin_amdgcn_readlane(__builtin_bit_cast(int, v), 63));
}
__device__ __forceinline__ float sigmoidf_(float x) { return 1.f / (1.f + __expf(-x)); }


__device__ __forceinline__ float gelu_tanh(float x) { return x * sigmoidf_(1.5957691216057308f * (x + 0.044715f * x * x * x)); }

namespace pg8 {
#define PG8_LAS __attribute__((address_space(3)))
typedef short bf16x8 __attribute__((ext_vector_type(8)));
typedef float f32x4 __attribute__((ext_vector_type(4)));
typedef unsigned u32x4 __attribute__((ext_vector_type(4)));
constexpr int BM = 256, BK = 64, HALF = 128, HTB = HALF * BK * 2, STAGE_BYTES = 8 * HTB, NXCD = 8, WGM = 8;
__device__ __forceinline__ int lds_byte(int r, int c) { const int st = (r >> 4) * 2 + (c >> 5), rr = r & 15, cc = c & 31, ob = rr * 64 + cc * 2; return st * 1024 + (ob ^ (((ob >> 9) & 1) << 5)); }
__device__ __forceinline__ void stage_rc(int b, int& R, int& C) { const int st = b / 1024, sb = b % 1024, swz = sb ^ (((sb >> 9) & 1) << 5); R = (st >> 1) * 16 + swz / 64; C = (st & 1) * 32 + (swz % 64) / 2; }
__device__ __forceinline__ int perm32(int rho) { const int n = rho >> 4, i = rho & 15; return 8 * (i >> 2) + 4 * n + (i & 3); }
struct Unit { int pm, pn; };
struct PlainOrder {
    const bf16* A; const bf16* Bt; int lda, ldb, K; int nM, nN, nwg, G, c;
    __device__ void init(const bf16* A_, int lda_, const bf16* Bt_, int ldb_, int M, int N, int K_) { A = A_; Bt = Bt_; lda = lda_; ldb = ldb_; K = K_; nM = M / BM; nN = N / BM; nwg = nM * nN; G = GN; c = GB; }
    __device__ bool next(int i, Unit& u) const {
        const long L = (long)i * G + c; if (L >= nwg) return false;
        int wgid = (int)L; { const int q = nwg / NXCD, r = nwg % NXCD, xcd = wgid % NXCD, off = wgid / NXCD; wgid = (xcd < r ? xcd * (q + 1) : r * (q + 1) + (xcd - r) * q) + off; }
        const int nig = WGM * nN, gid = wgid / nig, fm = gid * WGM, gsz = (nM - fm) < WGM ? (nM - fm) : WGM;
        u.pm = fm + ((wgid % nig) % gsz); u.pn = (wgid % nig) / gsz; return true;
    }
    __device__ __forceinline__ const char* aptr(const Unit& u) const { return (const char*)(A + (size_t)u.pm * BM * lda); }
    __device__ __forceinline__ const char* bptr(const Unit& u) const { return (const char*)(Bt + (size_t)u.pn * BM * ldb); }
};
__device__ __forceinline__ unsigned cvt_pk_bf16(float lo, float hi) { unsigned r; asm volatile("v_cvt_pk_bf16_f32 %0, %1, %2" : "=v"(r) : "v"(lo), "v"(hi)); return r; }

template <class Epi, class Sched>
__device__ __forceinline__ void gemm_phase(const int WID_, PG8_LAS unsigned char* lds, const Sched& S, const Epi& E) {
    const int tid = (WID_ * 64 + lane_id()), wid = __builtin_amdgcn_readfirstlane(tid >> 6), lane = tid & 63, wr = wid >> 2, wc = wid & 3, fr = lane & 15, fq = lane >> 4;
    const int K = S.K, nt = K / BK;
    unsigned voffA[2], voffB[2];
#pragma unroll
    for (int i = 0; i < 2; ++i) { int R, C; stage_rc(tid * 16 + i * 8192, R, C); const int Rb = Epi::PERM ? ((R & ~31) + perm32(R & 31)) : R;
        voffA[i] = (unsigned)(R * S.lda + C) * 2u; voffB[i] = (unsigned)(Rb * S.ldb + C) * 2u; }
    const size_t kstep = (size_t)(BK * 2);
    const size_t hstepA = (size_t)HALF * S.lda * 2, hstepB = (size_t)HALF * S.ldb * 2;
    const unsigned ldsw = (unsigned)wid * 1024u;
    const int aoff = lds_byte(wr * 64 + fr, fq * 8), boff = lds_byte(wc * 32 + fr, fq * 8);
#define PG8_SA(b, h) (((b) * 2 + (h)) * HTB)
#define PG8_SB(b, h) ((4 + (b) * 2 + (h)) * HTB)
#define PG8_STAGE(bufoff, gbase, voff) do { _Pragma("unroll") for (int _i = 0; _i < 2; ++_i) \
        __builtin_amdgcn_global_load_lds((const unsigned*)((const char*)(gbase) + (voff)[_i]), (PG8_LAS unsigned*)(lds + (bufoff) + ldsw + _i * 8192), 16, 0, 0); } while (0)
#define PG8_LDA(dst, b, h) do { _Pragma("unroll") for (int m = 0; m < 4; ++m) _Pragma("unroll") for (int k = 0; k < 2; ++k) dst[m][k] = *(const PG8_LAS bf16x8*)(lds + PG8_SA(b, h) + aoff + m * 2048 + k * 1024); } while (0)
#define PG8_LDB(dst, b, h) do { _Pragma("unroll") for (int n = 0; n < 2; ++n) _Pragma("unroll") for (int k = 0; k < 2; ++k) dst[n][k] = *(const PG8_LAS bf16x8*)(lds + PG8_SB(b, h) + boff + n * 2048 + k * 1024); } while (0)
#define PG8_MMA(ai, bj, At, Bt) do { __builtin_amdgcn_s_setprio(1); _Pragma("unroll") for (int m = 0; m < 4; ++m) _Pragma("unroll") for (int n = 0; n < 2; ++n) _Pragma("unroll") for (int k = 0; k < 2; ++k) \
        acc[ai][bj][m][n] = __builtin_amdgcn_mfma_f32_16x16x32_bf16(Bt[n][k], At[m][k], acc[ai][bj][m][n], 0, 0, 0); __builtin_amdgcn_s_setprio(0); } while (0)
#define PG8_WAIT_V(n) asm volatile("s_waitcnt vmcnt(" #n ")" ::: "memory")
#define PG8_WAIT_L(n) asm volatile("s_waitcnt lgkmcnt(" #n ")" ::: "memory")
#define PG8_BAR __builtin_amdgcn_s_barrier()
#define PG8_SCHED __builtin_amdgcn_sched_barrier(0)
    Unit cur, nxt; int ui = 0;
    if (!S.next(0, cur)) return;
    f32x4 acc[2][2][4][2];
#pragma unroll
    for (int a = 0; a < 2; ++a)
#pragma unroll
        for (int b = 0; b < 2; ++b)
#pragma unroll
            for (int m = 0; m < 4; ++m)
#pragma unroll
                for (int n = 0; n < 2; ++n) acc[a][b][m][n] = (f32x4){0.f, 0.f, 0.f, 0.f};
    bf16x8 At[4][2], B0[2][2], B1[2][2];
    const char* cA = S.aptr(cur); const char* cB = S.bptr(cur);
    PG8_STAGE(PG8_SB(0, 0), cB, voffB); PG8_STAGE(PG8_SB(0, 1), cB + hstepB, voffB); PG8_STAGE(PG8_SA(0, 0), cA, voffA); PG8_STAGE(PG8_SA(0, 1), cA + hstepA, voffA);
    if (wr == 1) PG8_BAR;
    PG8_WAIT_V(2); PG8_BAR;
    PG8_STAGE(PG8_SB(1, 0), cB + kstep, voffB); PG8_STAGE(PG8_SA(1, 0), cA + kstep, voffA); PG8_STAGE(PG8_SB(1, 1), cB + hstepB + kstep, voffB);
    PG8_WAIT_V(6); PG8_BAR;
    for (;;) {
        const bool has_next = S.next(ui + 1, nxt);
        const char* nA = has_next ? S.aptr(nxt) : cA; const char* nB = has_next ? S.bptr(nxt) : cB;
        for (int t = 0; t < nt; t += 2) {
            const bool last = (t == nt - 2);
            const char* a1 = cA + (size_t)(t + 1) * kstep;
            const char* a2 = last ? nA : cA + (size_t)(t + 2) * kstep; const char* b2 = last ? nB : cB + (size_t)(t + 2) * kstep;
            const char* a3 = a2 + kstep; const char* b3 = b2 + kstep;
            PG8_LDB(B0, 0, 0); PG8_LDB(B1, 0, 1); PG8_SCHED; PG8_LDA(At, 0, 0); PG8_STAGE(PG8_SA(1, 1), a1 + hstepA, voffA);
            PG8_WAIT_V(8); PG8_WAIT_L(0); PG8_BAR; PG8_MMA(0, 0, At, B0); PG8_MMA(0, 1, At, B1); PG8_BAR; PG8_SCHED;
            PG8_LDA(At, 0, 1); PG8_STAGE(PG8_SB(0, 0), b2, voffB); PG8_STAGE(PG8_SB(0, 1), b2 + hstepB, voffB); PG8_STAGE(PG8_SA(0, 0), a2, voffA);
            PG8_WAIT_V(8); PG8_WAIT_L(0); PG8_BAR; PG8_MMA(1, 0, At, B0); PG8_MMA(1, 1, At, B1); PG8_BAR; PG8_SCHED;
            PG8_LDB(B0, 1, 0); PG8_LDB(B1, 1, 1); PG8_SCHED; PG8_LDA(At, 1, 0); PG8_STAGE(PG8_SA(0, 1), a2 + hstepA, voffA);
            PG8_WAIT_V(8); PG8_WAIT_L(0); PG8_BAR; PG8_MMA(0, 0, At, B0); PG8_MMA(0, 1, At, B1); PG8_BAR; PG8_SCHED;
            PG8_LDA(At, 1, 1); PG8_STAGE(PG8_SB(1, 0), b3, voffB); PG8_STAGE(PG8_SB(1, 1), b3 + hstepB, voffB); PG8_STAGE(PG8_SA(1, 0), a3, voffA);
            PG8_WAIT_V(8); PG8_WAIT_L(0); PG8_BAR; PG8_MMA(1, 0, At, B0); PG8_MMA(1, 1, At, B1); PG8_BAR; PG8_SCHED;
        }
        if (wr == 0) PG8_BAR;
        E(acc, cur, wr, wc, fr, fq);
        if (!has_next) break;
#pragma unroll
        for (int a = 0; a < 2; ++a)
#pragma unroll
            for (int b = 0; b < 2; ++b)
#pragma unroll
                for (int m = 0; m < 4; ++m)
#pragma unroll
                    for (int n = 0; n < 2; ++n) acc[a][b][m][n] = (f32x4){0.f, 0.f, 0.f, 0.f};
        cur = nxt; cA = nA; cB = nB; ++ui;
        if (wr == 1) PG8_BAR;
    }
    PG8_WAIT_V(0);
    PG8_BAR;
#undef PG8_SA
#undef PG8_SB
#undef PG8_STAGE
#undef PG8_LDA
#undef PG8_LDB
#undef PG8_MMA
#undef PG8_WAIT_V
#undef PG8_WAIT_L
#undef PG8_BAR
#undef PG8_SCHED
}

struct EpiF32 {
    static constexpr bool PERM = false;
    float* C; int ldc; const float* R; int ldr;
    __device__ __forceinline__ void operator()(const f32x4 (&acc)[2][2][4][2], const Unit& u, int wr, int wc, int fr, int fq) const {
        const int row0 = u.pm * BM + wr * 64 + fr, col0 = u.pn * BM + wc * 32 + 4 * fq;
#pragma unroll
        for (int ai = 0; ai < 2; ++ai)
#pragma unroll
            for (int m = 0; m < 4; ++m) { const size_t row = (size_t)(row0 + ai * HALF + m * 16);
#pragma unroll
                for (int bj = 0; bj < 2; ++bj)
#pragma unroll
                    for (int n = 0; n < 2; ++n) { const int col = col0 + bj * HALF + 16 * n; f32x4 v = acc[ai][bj][m][n];
                        if (R) v = v + *(const f32x4*)(R + row * ldr + col);
                        *(f32x4*)(C + row * ldc + col) = v; } }
    }
};
struct EpiBf16 {
    static constexpr bool PERM = true;
    bf16* O; int ldc;
    __device__ __forceinline__ void operator()(const f32x4 (&acc)[2][2][4][2], const Unit& u, int wr, int wc, int fr, int fq) const {
        const int row0 = u.pm * BM + wr * 64 + fr, col0 = u.pn * BM + wc * 32 + 8 * fq;
#pragma unroll
        for (int ai = 0; ai < 2; ++ai)
#pragma unroll
            for (int m = 0; m < 4; ++m) { bf16* rowp = O + (size_t)(row0 + ai * HALF + m * 16) * ldc + col0;
#pragma unroll
                for (int bj = 0; bj < 2; ++bj) { const f32x4 v0 = acc[ai][bj][m][0], v1 = acc[ai][bj][m][1];
                    u32x4 w; w.x = cvt_pk_bf16(v0[0], v0[1]); w.y = cvt_pk_bf16(v0[2], v0[3]); w.z = cvt_pk_bf16(v1[0], v1[1]); w.w = cvt_pk_bf16(v1[2], v1[3]);
                    *(u32x4*)(rowp + bj * HALF) = w; } }
    }
};
struct EpiGlu {
    static constexpr bool PERM = true;
    const bf16* Z; const float* bias; bf16* YM;
    __device__ __forceinline__ void operator()(const f32x4 (&acc)[2][2][4][2], const Unit& u, int wr, int wc, int fr, int fq) const {
        const int row0 = u.pm * BM + wr * 64 + fr, col0 = u.pn * BM + wc * 32 + 8 * fq;
#pragma unroll
        for (int ai = 0; ai < 2; ++ai)
#pragma unroll
            for (int m = 0; m < 4; ++m) { const size_t row = (size_t)(row0 + ai * HALF + m * 16);
#pragma unroll
                for (int bj = 0; bj < 2; ++bj) { const int col = col0 + bj * HALF;
                    const u32x4 zz = *(const u32x4*)(Z + row * 512 + col);
                    const f32x4 b0 = *(const f32x4*)(bias + col), b1 = *(const f32x4*)(bias + col + 4);
                    const f32x4 v0 = acc[ai][bj][m][0] + b0, v1 = acc[ai][bj][m][1] + b1;
                    float o[8]; const unsigned zw[4] = {zz.x, zz.y, zz.z, zz.w};
#pragma unroll
                    for (int q = 0; q < 4; ++q) { const float zl = __builtin_bit_cast(float, zw[q] << 16), zh = __builtin_bit_cast(float, zw[q] & 0xffff0000u);
                        const float al = (q < 2) ? v0[2 * q] : v1[2 * q - 4], ah = (q < 2) ? v0[2 * q + 1] : v1[2 * q - 3];
                        o[2 * q] = zl * sigmoidf_(al); o[2 * q + 1] = zh * sigmoidf_(ah); }
                    u32x4 w; w.x = cvt_pk_bf16(o[0], o[1]); w.y = cvt_pk_bf16(o[2], o[3]); w.z = cvt_pk_bf16(o[4], o[5]); w.w = cvt_pk_bf16(o[6], o[7]);
                    *(u32x4*)(YM + row * D + 512 + col) = w; } }
    }
};

struct MoeOrder {
    const bf16* A; const bf16* Bt; int lda, ldb, K; const int* tiles; int nunits, G, c; size_t bexp;
    __device__ void init(const bf16* A_, int lda_, const bf16* Bt_, int ldb_, int K_, const int* tiles_, int ntiles, size_t bexp_) { A = A_; Bt = Bt_; lda = lda_; ldb = ldb_; K = K_; tiles = tiles_; nunits = ntiles * 4; G = GN; c = GB; bexp = bexp_; }
    __device__ bool next(int i, Unit& u) const { const int L = i * G + c; if (L >= nunits) return false; u.pm = L >> 2; u.pn = L & 3; return true; }
    __device__ __forceinline__ const char* aptr(const Unit& u) const { return (const char*)(A + (size_t)u.pm * BM * lda); }
    __device__ __forceinline__ const char* bptr(const Unit& u) const { const int e = __hip_atomic_load(tiles + u.pm, __ATOMIC_RELAXED, __HIP_MEMORY_SCOPE_AGENT); return (const char*)(Bt + ((size_t)e * bexp + (size_t)u.pn * BM) * ldb); }
};
struct EpiSilu {
    static constexpr bool PERM = true;
    bf16* HID;
    __device__ __forceinline__ void operator()(const f32x4 (&acc)[2][2][4][2], const Unit& u, int wr, int wc, int fr, int fq) const {
        const int row0 = u.pm * BM + wr * 64 + fr, col0 = u.pn * HALF + wc * 32 + 8 * fq;
#pragma unroll
        for (int ai = 0; ai < 2; ++ai)
#pragma unroll
            for (int m = 0; m < 4; ++m) { const size_t row = (size_t)(row0 + ai * HALF + m * 16);
                float o[8];
#pragma unroll
                for (int n = 0; n < 2; ++n)
#pragma unroll
                    for (int q = 0; q < 4; ++q) { const float g = acc[ai][0][m][n][q], up = acc[ai][1][m][n][q]; o[4 * n + q] = g * sigmoidf_(g) * up; }
                u32x4 w; w.x = cvt_pk_bf16(o[0], o[1]); w.y = cvt_pk_bf16(o[2], o[3]); w.z = cvt_pk_bf16(o[4], o[5]); w.w = cvt_pk_bf16(o[6], o[7]);
                *(u32x4*)(HID + row * DEXP + col0) = w; }
    }
};
struct EpiGate {
    static constexpr bool PERM = true;
    bf16* Y; const float* gate;
    __device__ __forceinline__ void operator()(const f32x4 (&acc)[2][2][4][2], const Unit& u, int wr, int wc, int fr, int fq) const {
        const int row0 = u.pm * BM + wr * 64 + fr, col0 = u.pn * BM + wc * 32 + 8 * fq;
#pragma unroll
        for (int ai = 0; ai < 2; ++ai)
#pragma unroll
            for (int m = 0; m < 4; ++m) { const size_t row = (size_t)(row0 + ai * HALF + m * 16); const float gt = gate[row];
#pragma unroll
                for (int bj = 0; bj < 2; ++bj) { const f32x4 v0 = acc[ai][bj][m][0] * gt, v1 = acc[ai][bj][m][1] * gt;
                    u32x4 w; w.x = cvt_pk_bf16(v0[0], v0[1]); w.y = cvt_pk_bf16(v0[2], v0[3]); w.z = cvt_pk_bf16(v1[0], v1[1]); w.w = cvt_pk_bf16(v1[2], v1[3]);
                    *(u32x4*)(Y + row * D + col0 + bj * HALF) = w; } }
    }
};

struct EpiProj {
    static constexpr bool PERM = true;
    bf16* PROJ; bf16* US5;
    __device__ __forceinline__ void operator()(const f32x4 (&acc)[2][2][4][2], const Unit& u, int wr, int wc, int fr, int fq) const {
        const int row0 = u.pm * BM + wr * 64 + fr, col0 = u.pn * BM + wc * 32 + 8 * fq;
#pragma unroll
        for (int ai = 0; ai < 2; ++ai)
#pragma unroll
            for (int m = 0; m < 4; ++m) { const size_t row = (size_t)(row0 + ai * HALF + m * 16);
#pragma unroll
                for (int bj = 0; bj < 2; ++bj) { const f32x4 v0 = acc[ai][bj][m][0], v1 = acc[ai][bj][m][1]; const int col = col0 + bj * HALF;
                    u32x4 w; w.x = cvt_pk_bf16(v0[0], v0[1]); w.y = cvt_pk_bf16(v0[2], v0[3]); w.z = cvt_pk_bf16(v1[0], v1[1]); w.w = cvt_pk_bf16(v1[2], v1[3]);
                    if (col < DSHIFT) *(u32x4*)(PROJ + row * DSHIFT + col) = w;
                    else { const int cc = col - DSHIFT; *(u32x4*)(US5 + ((size_t)(cc >> 4) * M + row) * 16 + (cc & 15)) = w; } } }
    }
};
struct GroupOrder {
    const bf16* A; const bf16* Bt; int lda, ldb, K; int nM, nN, nunits, G, c; size_t sA, sB;
    __device__ void init(const bf16* A_, int lda_, size_t sA_, const bf16* Bt_, int ldb_, size_t sB_, int ngroups, int Mg, int Ng, int K_) {
        A = A_; Bt = Bt_; lda = lda_; ldb = ldb_; K = K_; sA = sA_; sB = sB_; nM = Mg / BM; nN = Ng / BM; nunits = ngroups * nM * nN; G = GN; c = GB; }
    __device__ bool next(int i, Unit& u) const { const int L = i * G + c; if (L >= nunits) return false; u.pn = L % nN; u.pm = L / nN; return true; }
    __device__ __forceinline__ const char* aptr(const Unit& u) const { const int g = u.pm / nM, pm = u.pm % nM; return (const char*)(A + (size_t)g * sA + (size_t)pm * BM * lda); }
    __device__ __forceinline__ const char* bptr(const Unit& u) const { const int g = u.pm / nM; return (const char*)(Bt + (size_t)g * sB + (size_t)u.pn * BM * ldb); }
};
struct EpiS5a {
    static constexpr bool PERM = false;
    bf16* YI; float* F;
    __device__ __forceinline__ void operator()(const f32x4 (&acc)[2][2][4][2], const Unit& u, int wr, int wc, int fr, int fq) const {
        const int row0 = u.pm * BM + wr * 64 + fr, col0 = u.pn * BM + wc * 32 + 4 * fq;
#pragma unroll
        for (int ai = 0; ai < 2; ++ai)
#pragma unroll
            for (int m = 0; m < 4; ++m) { const size_t row = (size_t)(row0 + ai * HALF + m * 16);
#pragma unroll
                for (int bj = 0; bj < 2; ++bj)
#pragma unroll
                    for (int n = 0; n < 2; ++n) { const int col = col0 + bj * HALF + 16 * n; const f32x4 v = acc[ai][bj][m][n];
                        if (col < 512) { uint2 w; w.x = cvt_pk_bf16(v[0], v[1]); w.y = cvt_pk_bf16(v[2], v[3]); *(uint2*)(YI + row * 512 + col) = w; }
                        else if (col < 640) *(f32x4*)(F + row * 128 + (col - 512)) = v; } }
    }
};
struct EpiS5b {
    static constexpr bool PERM = true;
    const bf16* YI; bf16* Z;
    __device__ __forceinline__ void operator()(const f32x4 (&acc)[2][2][4][2], const Unit& u, int wr, int wc, int fr, int fq) const {
        const int row0 = u.pm * BM + wr * 64 + fr, col0 = u.pn * BM + wc * 32 + 8 * fq;
#pragma unroll
        for (int ai = 0; ai < 2; ++ai)
#pragma unroll
            for (int m = 0; m < 4; ++m) { const int row = row0 + ai * HALF + m * 16; const int g = row / S5R, rl = row % S5R;
#pragma unroll
                for (int bj = 0; bj < 2; ++bj) { const int col = col0 + bj * HALF;
                    const u32x4 yi = *(const u32x4*)(YI + (size_t)row * 512 + col);
                    const unsigned yw[4] = {yi.x, yi.y, yi.z, yi.w};
                    const f32x4 v0 = acc[ai][bj][m][0], v1 = acc[ai][bj][m][1];
                    float o[8];
#pragma unroll
                    for (int q = 0; q < 4; ++q) { const float al = (q < 2) ? v0[2 * q] : v1[2 * q - 4], ah = (q < 2) ? v0[2 * q + 1] : v1[2 * q - 3];
                        o[2 * q] = gelu_tanh(al + __builtin_bit_cast(float, yw[q] << 16)); o[2 * q + 1] = gelu_tanh(ah + __builtin_bit_cast(float, yw[q] & 0xffff0000u)); }
                    u32x4 w; w.x = cvt_pk_bf16(o[0], o[1]); w.y = cvt_pk_bf16(o[2], o[3]); w.z = cvt_pk_bf16(o[4], o[5]); w.w = cvt_pk_bf16(o[6], o[7]);
                    const size_t tok = (size_t)rl * S5L + (col >> 4);
                    *(u32x4*)(Z + tok * 512 + g * 16 + (col & 15)) = w; } }
    }
};
struct AttnOrder {
    const bf16* A; const bf16* Bt; int lda, ldb, K; int G, c; int mode;
    __device__ void init(const bf16* A_, const bf16* Bt_, int ldb_, int mode_) { A = A_; Bt = Bt_; lda = D; ldb = ldb_; K = 256; G = GN; c = GB; mode = mode_; }
    __device__ bool next(int i, Unit& u) const { const int L = i * G + c; if (L >= NB * 4 * 32) return false; u.pn = L & 3; u.pm = L >> 2; return true; }
    __device__ __forceinline__ const char* aptr(const Unit& u) const { return (const char*)(A + (size_t)u.pm * BM * D + u.pn * 256); }
    __device__ __forceinline__ const char* bptr(const Unit& u) const { const int b = u.pm >> 5;
        return (const char*)(mode == 0 ? Bt + (size_t)b * 256 * ldb + u.pn * 256 : Bt + (size_t)u.pn * 256 * ldb + b * 256); }
};
struct EpiSoftmax {
    static constexpr bool PERM = true;
    bf16* P; PG8_LAS float* scr;
    __device__ __forceinline__ void operator()(f32x4 (&acc)[2][2][4][2], const Unit& u, int wr, int wc, int fr, int fq) const {
        const float SC = 0.0625f * 1.4426950408889634f;
        PG8_LAS float* smax = scr; PG8_LAS float* ssum = scr + 1024;
#pragma unroll
        for (int ai = 0; ai < 2; ++ai)
#pragma unroll
            for (int m = 0; m < 4; ++m) { float t = -3.0e38f;
#pragma unroll
                for (int bj = 0; bj < 2; ++bj)
#pragma unroll
                    for (int n = 0; n < 2; ++n) { const f32x4 v = acc[ai][bj][m][n]; t = fmaxf(t, fmaxf(fmaxf(v[0], v[1]), fmaxf(v[2], v[3]))); }
                t = fmaxf(t, __shfl_xor(t, 16)); t = fmaxf(t, __shfl_xor(t, 32));
                if (fq == 0) smax[(ai * HALF + wr * 64 + m * 16 + fr) * 4 + wc] = t; }
        asm volatile("s_waitcnt lgkmcnt(0)" ::: "memory"); __builtin_amdgcn_s_barrier(); asm volatile("" ::: "memory");
#pragma unroll
        for (int ai = 0; ai < 2; ++ai)
#pragma unroll
            for (int m = 0; m < 4; ++m) { const f32x4 q = *(const PG8_LAS f32x4*)(smax + (ai * HALF + wr * 64 + m * 16 + fr) * 4);
                const float mm = fmaxf(fmaxf(q[0], q[1]), fmaxf(q[2], q[3])) * SC; float s = 0.f;
#pragma unroll
                for (int bj = 0; bj < 2; ++bj)
#pragma unroll
                    for (int n = 0; n < 2; ++n)
#pragma unroll
                        for (int e = 0; e < 4; ++e) { const float p = __builtin_amdgcn_exp2f(acc[ai][bj][m][n][e] * SC - mm); acc[ai][bj][m][n][e] = p; s += p; }
                s += __shfl_xor(s, 16); s += __shfl_xor(s, 32);
                if (fq == 0) ssum[(ai * HALF + wr * 64 + m * 16 + fr) * 4 + wc] = s; }
        asm volatile("s_waitcnt lgkmcnt(0)" ::: "memory"); __builtin_amdgcn_s_barrier(); asm volatile("" ::: "memory");
        const int row0 = u.pm * BM + wr * 64 + fr, col0 = u.pn * 256 + wc * 32 + 8 * fq;
#pragma unroll
        for (int ai = 0; ai < 2; ++ai)
#pragma unroll
            for (int m = 0; m < 4; ++m) { const f32x4 q = *(const PG8_LAS f32x4*)(ssum + (ai * HALF + wr * 64 + m * 16 + fr) * 4);
                const float iv = 1.f / ((q[0] + q[1]) + (q[2] + q[3]));
                bf16* rowp = P + (size_t)(row0 + ai * HALF + m * 16) * D + col0;
#pragma unroll
                for (int bj = 0; bj < 2; ++bj) { const f32x4 v0 = acc[ai][bj][m][0] * iv, v1 = acc[ai][bj][m][1] * iv; u32x4 w;
                    w.x = cvt_pk_bf16(v0[0], v0[1]); w.y = cvt_pk_bf16(v0[2], v0[3]); w.z = cvt_pk_bf16(v1[0], v1[1]); w.w = cvt_pk_bf16(v1[2], v1[3]);
                    *(u32x4*)(rowp + bj * HALF) = w; } }
    }
};
struct EpiAttnO {
    static constexpr bool PERM = true;
    bf16* O;
    __device__ __forceinline__ void operator()(const f32x4 (&acc)[2][2][4][2], const Unit& u, int wr, int wc, int fr, int fq) const {
        const int row0 = u.pm * BM + wr * 64 + fr, col0 = u.pn * 256 + wc * 32 + 8 * fq;
#pragma unroll
        for (int ai = 0; ai < 2; ++ai)
#pragma unroll
            for (int m = 0; m < 4; ++m) { bf16* rowp = O + (size_t)(row0 + ai * HALF + m * 16) * D + col0;
#pragma unroll
                for (int bj = 0; bj < 2; ++bj) { const f32x4 v0 = acc[ai][bj][m][0], v1 = acc[ai][bj][m][1];
                    u32x4 w; w.x = cvt_pk_bf16(v0[0], v0[1]); w.y = cvt_pk_bf16(v0[2], v0[3]); w.z = cvt_pk_bf16(v1[0], v1[1]); w.w = cvt_pk_bf16(v1[2], v1[3]);
                    *(u32x4*)(rowp + bj * HALF) = w; } }
    }
};

struct EpiLora {
    static constexpr bool PERM = true;
    bf16* LW; size_t ostride; const float* w0; const float* a0;
    __device__ __forceinline__ void operator()(const f32x4 (&acc)[2][2][4][2], const Unit& u, int wr, int wc, int fr, int fq) const {
        const int row0 = u.pm * BM + wr * 64 + fr, col0 = u.pn * BM + wc * 32 + 8 * fq;
        const int kind = u.pn >> 1;
        bf16* O = LW + (size_t)kind * ostride;
#pragma unroll
        for (int bj = 0; bj < 2; ++bj) { const int col = (col0 + bj * HALF) & 511;
            f32x4 b0 = (f32x4){0.f, 0.f, 0.f, 0.f}, b1 = b0;
            if (kind == 0) { b0 = *(const f32x4*)(w0 + col); b1 = *(const f32x4*)(w0 + col + 4); }
            else if (kind == 1) { b0 = *(const f32x4*)(a0 + col); b1 = *(const f32x4*)(a0 + col + 4); }
#pragma unroll
            for (int ai = 0; ai < 2; ++ai)
#pragma unroll
                for (int m = 0; m < 4; ++m) { const size_t row = (size_t)(row0 + ai * HALF + m * 16);
                    const f32x4 v0 = acc[ai][bj][m][0] + b0, v1 = acc[ai][bj][m][1] + b1; float o[8];
#pragma unroll
                    for (int e = 0; e < 8; ++e) { float x = (e < 4) ? v0[e & 3] : v1[e & 3];
                        if (kind == 0) { const float nd = -x; const float sp = fmaxf(nd, 0.f) + __logf(1.f + __expf(-fabsf(nd))); x = -__expf(-sp - 0.5f); }
                        else if (kind == 1) x = sigmoidf_(x);
                        o[e] = x; }
                    u32x4 w; w.x = cvt_pk_bf16(o[0], o[1]); w.y = cvt_pk_bf16(o[2], o[3]); w.z = cvt_pk_bf16(o[4], o[5]); w.w = cvt_pk_bf16(o[6], o[7]);
                    *(u32x4*)(O + row * 512 + col) = w; } }
    }
};
}

#define LAS __attribute__((address_space(3)))
__device__ __forceinline__ void transpose_item(const float* __restrict__ W, int K, int N, bf16* __restrict__ WT, int ldt, int row_off, int col_off, float* scr, int item, int lane, const float* __restrict__ kscale, int ldw = 0) {
    if (ldw == 0) ldw = N;
    const int nblk = N / 32, kb = item / nblk, nb = item % nblk, k0 = 64 * kb, n0 = 32 * nb;
#pragma unroll 8
    for (int i = 0; i < 32; ++i) { const int kk = 2 * i + (lane >> 5); float v = W[(size_t)(k0 + kk) * ldw + n0 + (lane & 31)]; if (kscale) v *= kscale[k0 + kk]; scr[kk * 33 + (lane & 31)] = v; }
    __builtin_amdgcn_s_waitcnt(0xc07f); asm volatile("" ::: "memory");
    const int c = lane & 7;
#pragma unroll
    for (int j = 0; j < 4; ++j) { const int n = (lane >> 3) + 8 * j; const float* s = scr + (8 * c) * 33 + n;
        uint4 o; o.x = pk2(s[0 * 33], s[1 * 33]); o.y = pk2(s[2 * 33], s[3 * 33]); o.z = pk2(s[4 * 33], s[5 * 33]); o.w = pk2(s[6 * 33], s[7 * 33]);
        *(uint4*)(WT + (size_t)(row_off + n0 + n) * ldt + col_off + k0 + 8 * c) = o; }
    __builtin_amdgcn_s_waitcnt(0xc07f); asm volatile("" ::: "memory");
}
__device__ __forceinline__ void transpose_ph(const int WID_, const float* W, int K, int N, bf16* WT, int ldt, int row_off, int col_off, char* lds, const float* kscale = nullptr) {
    const int lane = (WID_ * 64 + lane_id()) & 63, wv = (WID_ * 64 + lane_id()) >> 6;
    float* scr = (float*)(lds + wv * 16384);
    const int nitems = (K / 64) * (N / 32);
    for (int it = GB * 8 + wv; it < nitems; it += GN * 8) transpose_item(W, K, N, WT, ldt, row_off, col_off, scr, it, lane, kscale);
}

template <typename TO>
__device__ __forceinline__ void rmsnorm_ph(const int WID_, const float* __restrict__ x, const float* __restrict__ w, TO* __restrict__ out, int rows) {
    const int lane = lane_id(), wv = WID_;
    float4 g[4];
#pragma unroll
    for (int j = 0; j < 4; ++j) g[j] = *(const float4*)(w + (lane + 64 * j) * 4);
    for (int row = (GB * 8 + wv) * 2; row < rows; row += GN * 16) {
        const float4* xr = (const float4*)(x + (size_t)row * D);
        float4 v[2][4]; float s[2] = {0.f, 0.f};
#pragma unroll
        for (int r = 0; r < 2; ++r)
#pragma unroll
            for (int j = 0; j < 4; ++j) v[r][j] = xr[r * (D / 4) + lane + 64 * j];
#pragma unroll
        for (int r = 0; r < 2; ++r) {
#pragma unroll
            for (int j = 0; j < 4; ++j) s[r] += v[r][j].x * v[r][j].x + v[r][j].y * v[r][j].y + v[r][j].z * v[r][j].z + v[r][j].w * v[r][j].w;
            s[r] = wave_sum(s[r]);
            const float rs = rsqrtf(s[r] * (1.f / D) + 1e-6f);
#pragma unroll
            for (int j = 0; j < 4; ++j) {
                uint2 o; o.x = pk2(v[r][j].x * rs * g[j].x, v[r][j].y * rs * g[j].y); o.y = pk2(v[r][j].z * rs * g[j].z, v[r][j].w * rs * g[j].w);
                *(uint2*)(out + (size_t)(row + r) * D + (lane + 64 * j) * 4) = o;
            }
        }
    }
}

__device__ __forceinline__ void rwkv_lin_ph(const int WID_, const bf16* __restrict__ proj, const float* __restrict__ mu, bf16* __restrict__ lin) {
    const int lane = lane_id(), wv = WID_;
    const float4 m4 = *(const float4*)(mu + 1536 + 4 * lane);
    const float mm[4] = {m4.x, m4.y, m4.z, m4.w};
    for (int m0 = (GB * 8 + wv) * 4; m0 < M; m0 += GN * 32) {
        uint2 z[4], zp[4];
#pragma unroll
        for (int i = 0; i < 4; ++i) { const int m = m0 + i; z[i] = *(const uint2*)(proj + (size_t)m * DSHIFT + 1536 + 4 * lane);
            zp[i] = make_uint2(0, 0); if ((m & (S - 1)) != 0) zp[i] = *(const uint2*)(proj + (size_t)(m - 1) * DSHIFT + 1536 + 4 * lane); }
#pragma unroll
        for (int i = 0; i < 4; ++i) {
            float c[4] = {__builtin_bit_cast(float, z[i].x << 16), __builtin_bit_cast(float, z[i].x & 0xffff0000u), __builtin_bit_cast(float, z[i].y << 16), __builtin_bit_cast(float, z[i].y & 0xffff0000u)};
            const float q[4] = {__builtin_bit_cast(float, zp[i].x << 16), __builtin_bit_cast(float, zp[i].x & 0xffff0000u), __builtin_bit_cast(float, zp[i].y << 16), __builtin_bit_cast(float, zp[i].y & 0xffff0000u)};
#pragma unroll
            for (int e = 0; e < 4; ++e) { float t = c[e] + (q[e] - c[e]) * mm[e];
                if (lane < 16) t = 1.f - 2.f / (1.f + __expf(2.f * t));
                else if (lane >= 32) t = sigmoidf_(t);
                c[e] = t; }
            uint2 o; o.x = pk2(c[0], c[1]); o.y = pk2(c[2], c[3]);
            *(uint2*)(lin + (size_t)(m0 + i) * 256 + 4 * lane) = o;
        }
    }
}
__device__ __forceinline__ void rwkv_wl_ph(const int WID_, const float* __restrict__ wdec, const float* __restrict__ wiclr, const float* __restrict__ wgate, bf16* __restrict__ wl) {
    for (int i = GB * NT + (WID_ * 64 + lane_id()); i < 1536 * 256; i += GN * NT) {
        const int k = i & 255, n = i >> 8; float v = 0.f;
        if (n < 512) { if (k < 64) v = wdec[k * 512 + n]; }
        else if (n < 1024) { if (k >= 64 && k < 128) v = wiclr[(k - 64) * 512 + (n - 512)]; }
        else { if (k >= 128) v = wgate[(k - 128) * 512 + (n - 1024)]; }
        wl[i] = f2bf(v);
    }
}
struct RwkvIn { const bf16* proj; const bf16* LW; const bf16* AA; const float* mu; const float* k_k; const float* k_a; const float* r_k; float* Y; float* RK; };
constexpr int TB = 64;
constexpr int RW_ITEMS = NB * 8 * 2;
template <int CTRL> __device__ __forceinline__ float dpp16(float x) { return __builtin_bit_cast(float, __builtin_amdgcn_update_dpp(0, __builtin_bit_cast(int, x), CTRL, 0xf, 0xf, true)); }
__device__ __forceinline__ void rwkv_scan_ph(const int WID_, const RwkvIn& I, char* lds) {
    float* Rs = (float*)lds; float* Ws = Rs + TB * 64; float* Kps = Ws + TB * 64; float* KKs = Kps + TB * 64; float* Bs = KKs + TB * 64; float* Vs = Bs + TB * 64; float* Ys = Vs + TB * 64;
    const int lane = (WID_ * 64 + lane_id()) & 63, wv = (WID_ * 64 + lane_id()) >> 6;
    for (int item = GB; item < RW_ITEMS; item += GN) {
        const int half = item & 1, h = (item >> 1) & 7, b = item >> 4;
        const int j = lane & 15, rl = 4 * wv + (lane >> 4), row = 32 * half + rl;
        float s0 = 0.f, s1 = 0.f, s2 = 0.f, s3 = 0.f, sa = 0.f;
        const int tau = (WID_ * 64 + lane_id()) >> 3, cg = (WID_ * 64 + lane_id()) & 7, ch0 = h * 64 + cg * 8;
        uint4 gr, gk, gv, qr, qk, qv, ga, gl;
#define RW_ISSUE(blk) do { const int t_ = (blk) * TB + tau; const size_t m_ = (size_t)b * S + t_; const bf16* z_ = I.proj + m_ * DSHIFT + ch0; \
            gr = *(const uint4*)(z_); gk = *(const uint4*)(z_ + 512); gv = *(const uint4*)(z_ + 1024); \
            if (t_ > 0) { qr = *(const uint4*)(z_ - DSHIFT); qk = *(const uint4*)(z_ + 512 - DSHIFT); qv = *(const uint4*)(z_ + 1024 - DSHIFT); } \
            else { qr = make_uint4(0, 0, 0, 0); qk = qr; qv = qr; } \
            ga = *(const uint4*)(I.AA + m_ * 512 + ch0); gl = *(const uint4*)(I.LW + m_ * 512 + ch0); } while (0)
#define RW_COMMIT(blk) do { \
            const unsigned wr_[4] = {gr.x, gr.y, gr.z, gr.w}, wk_[4] = {gk.x, gk.y, gk.z, gk.w}, wv_[4] = {gv.x, gv.y, gv.z, gv.w}; \
            const unsigned pr_[4] = {qr.x, qr.y, qr.z, qr.w}, pk_[4] = {qk.x, qk.y, qk.z, qk.w}, pv_[4] = {qv.x, qv.y, qv.z, qv.w}; \
            const unsigned wa_[4] = {ga.x, ga.y, ga.z, ga.w}, wl_[4] = {gl.x, gl.y, gl.z, gl.w}; \
            float r_[8], k_[8], v_[8], a_[8], kk_[8], ss_ = 0.f, rk_ = 0.f; \
            _Pragma("unroll") for (int e = 0; e < 8; ++e) { const int w_ = e >> 1; const bool hi_ = e & 1; \
                auto ex = [&](unsigned u) { return hi_ ? __builtin_bit_cast(float, u & 0xffff0000u) : __builtin_bit_cast(float, u << 16); }; \
                const float mr_ = I.mu[ch0 + e], mk_ = I.mu[512 + ch0 + e], mv_ = I.mu[1024 + ch0 + e]; \
                float x = ex(wr_[w_]); r_[e] = x + (ex(pr_[w_]) - x) * mr_; x = ex(wk_[w_]); k_[e] = x + (ex(pk_[w_]) - x) * mk_; x = ex(wv_[w_]); v_[e] = x + (ex(pv_[w_]) - x) * mv_; \
                a_[e] = ex(wa_[w_]); kk_[e] = k_[e] * I.k_k[ch0 + e]; ss_ += kk_[e] * kk_[e]; } \
            ss_ += dpp16<0xB1>(ss_); ss_ += dpp16<0x4E>(ss_); ss_ += dpp16<0x141>(ss_); \
            const float inv_ = 1.f / fmaxf(sqrtf(ss_), 1e-12f); \
            float o_[6][8]; \
            _Pragma("unroll") for (int e = 0; e < 8; ++e) { const int w_ = e >> 1; const bool hi_ = e & 1; \
                const float lw_ = hi_ ? __builtin_bit_cast(float, wl_[w_] & 0xffff0000u) : __builtin_bit_cast(float, wl_[w_] << 16); \
                const float kp_ = k_[e] * (1.f + (a_[e] - 1.f) * I.k_a[ch0 + e]); const float kn_ = kk_[e] * inv_; \
                o_[0][e] = r_[e]; o_[1][e] = __expf(lw_); o_[2][e] = kp_; o_[3][e] = kn_; o_[4][e] = kn_ * a_[e]; o_[5][e] = v_[e]; rk_ += r_[e] * kp_ * I.r_k[ch0 + e]; } \
            _Pragma("unroll") for (int q_ = 0; q_ < 6; ++q_) { float* d_ = Rs + q_ * (TB * 64) + tau * 64 + cg * 8; \
                *(float4*)d_ = make_float4(o_[q_][0], o_[q_][1], o_[q_][2], o_[q_][3]); *(float4*)(d_ + 4) = make_float4(o_[q_][4], o_[q_][5], o_[q_][6], o_[q_][7]); } \
            if (half == 0) { rk_ += dpp16<0xB1>(rk_); rk_ += dpp16<0x4E>(rk_); rk_ += dpp16<0x141>(rk_); \
                if (cg == 0) I.RK[((size_t)b * S + (blk) * TB + tau) * 8 + h] = rk_; } } while (0)
        RW_ISSUE(0);
        __syncthreads();
        RW_COMMIT(0);
        __syncthreads();
        for (int blk = 0; blk < S / TB; ++blk) {
            if (blk + 1 < S / TB) RW_ISSUE(blk + 1);
            float4 r4 = *(const float4*)(Rs + 4 * j), w4 = *(const float4*)(Ws + 4 * j), k4 = *(const float4*)(Kps + 4 * j), b4 = *(const float4*)(Bs + 4 * j);
            float vv = Vs[row];
            if (blk == 0) sa = 0.f;
#pragma unroll 2
            for (int t = 0; t < TB; ++t) {
                const int tn = (t + 1 < TB) ? t + 1 : t;
                const float4 n4n = *(const float4*)(KKs + tn * 64 + 4 * j);
                const float4 r4n = *(const float4*)(Rs + tn * 64 + 4 * j), w4n = *(const float4*)(Ws + tn * 64 + 4 * j), k4n = *(const float4*)(Kps + tn * 64 + 4 * j), b4n = *(const float4*)(Bs + tn * 64 + 4 * j);
                const float vvn = Vs[tn * 64 + row];
                s0 = s0 * w4.x + (sa * b4.x + vv * k4.x);
                s1 = s1 * w4.y + (sa * b4.y + vv * k4.y);
                s2 = s2 * w4.z + (sa * b4.z + vv * k4.z);
                s3 = s3 * w4.w + (sa * b4.w + vv * k4.w);
                float py = (s0 * r4.x + s1 * r4.y) + (s2 * r4.z + s3 * r4.w);
                float ps = (s0 * n4n.x + s1 * n4n.y) + (s2 * n4n.z + s3 * n4n.w);
                py += dpp16<0xB1>(py); ps += dpp16<0xB1>(ps);
                py += dpp16<0x4E>(py); ps += dpp16<0x4E>(ps);
                py += dpp16<0x141>(py); ps += dpp16<0x141>(ps);
                py += dpp16<0x140>(py); ps += dpp16<0x140>(ps);
                if (j == 0) Ys[t * 32 + rl] = py;
                if (t + 1 < TB) sa = -ps;
                r4 = r4n; w4 = w4n; k4 = k4n; b4 = b4n; vv = vvn;
            }
            __syncthreads();
            { const int t = (WID_ * 64 + lane_id()) >> 3, r0 = ((WID_ * 64 + lane_id()) & 7) * 4; const size_t m = (size_t)b * S + blk * TB + t;
              *(float4*)(I.Y + m * 512 + h * 64 + 32 * half + r0) = *(const float4*)(Ys + t * 32 + r0); }
            if (blk + 1 < S / TB) RW_COMMIT(blk + 1);
            __syncthreads();
            if (blk + 1 < S / TB) { const float4 n4 = *(const float4*)(KKs + 4 * j);
                float ps = (s0 * n4.x + s1 * n4.y) + (s2 * n4.z + s3 * n4.w);
                ps += dpp16<0xB1>(ps); ps += dpp16<0x4E>(ps); ps += dpp16<0x141>(ps); ps += dpp16<0x140>(ps);
                sa = -ps; }
        }
    }
}
__device__ __forceinline__ void rwkv_post_ph(const int WID_, const float* __restrict__ Y, const float* __restrict__ RK, const bf16* __restrict__ proj, const float* __restrict__ mu, const bf16* __restrict__ G,
                             const float* __restrict__ lnw, const float* __restrict__ lnb, bf16* __restrict__ ymix) {
    const int c = (WID_ * 64 + lane_id());
    const float muv = mu[1024 + c], lw_ = lnw[c], lb_ = lnb[c];
    for (int m0 = GB * 4; m0 < M; m0 += GN * 4) {
        float y[4], v[4], pv[4], rk[4], g[4];
#pragma unroll
        for (int i = 0; i < 4; ++i) { const int m = m0 + i; const size_t ix = (size_t)m * 512 + c;
            y[i] = Y[ix]; v[i] = bf2f(proj[(size_t)m * DSHIFT + 1024 + c]); pv[i] = (m & (S - 1)) ? bf2f(proj[(size_t)(m - 1) * DSHIFT + 1024 + c]) : 0.f;
            rk[i] = RK[(size_t)m * 8 + (c >> 6)]; g[i] = bf2f(G[ix]); }
#pragma unroll
        for (int i = 0; i < 4; ++i) {
            const float mean = wave_sum(y[i]) * (1.f / 64.f);
            const float d = y[i] - mean;
            const float var = wave_sum(d * d) * (1.f / 64.f);
            float yn = d * rsqrtf(var + 64e-5f) * lw_ + lb_;
            const float vs = v[i] + (pv[i] - v[i]) * muv;
            yn += rk[i] * vs;
            ymix[(size_t)(m0 + i) * D + c] = f2bf(yn * g[i]);
        }
    }
}

constexpr int PSLOTS = NASSIGN + NEXP * 256;
constexpr int MAXTILES = PSLOTS / 256;
struct MoeBufs { int* tok_e; float* tok_g; int* tok_slot; int* slot_tok; float* slot_gate; int* bcnt; int* bbase; int* offs; int* tiles; int* ntiles; };
__device__ __forceinline__ void moe_zero_ph(const int WID_, const MoeBufs& mb) {
    for (int i = GB * NT + (WID_ * 64 + lane_id()); i < PSLOTS; i += GN * NT) { mb.slot_tok[i] = 0; mb.slot_gate[i] = 0.f; }
}
__device__ __forceinline__ void router_ph(const int WID_, const float* __restrict__ x3, const float* __restrict__ nw, bf16* __restrict__ h3, const float* __restrict__ wrg, const float* __restrict__ brg,
                          const float* __restrict__ wre, const float* __restrict__ bre, const MoeBufs& mb, char* lds) {
    const int lane = lane_id(), wv = WID_;
    int* lcnt = (int*)lds;
    if (wv == 0 && lane < 32) lcnt[lane] = 0;
    __syncthreads();
    for (int m = GB * 8 + wv; m < M; m += GN * 8) {
        const float4* xr = (const float4*)(x3 + (size_t)m * D);
        float h[16]; float s = 0.f;
#pragma unroll
        for (int j = 0; j < 4; ++j) { const float4 v = xr[lane + 64 * j]; h[4 * j] = v.x; h[4 * j + 1] = v.y; h[4 * j + 2] = v.z; h[4 * j + 3] = v.w; s += v.x * v.x + v.y * v.y + v.z * v.z + v.w * v.w; }
        s = wave_sum(s);
        const float rs = rsqrtf(s * (1.f / D) + 1e-6f);
        float l1[4] = {0.f, 0.f, 0.f, 0.f};
#pragma unroll
        for (int j = 0; j < 4; ++j) {
            const int k0 = (lane + 64 * j) * 4;
            const float4 g = *(const float4*)(nw + k0);
            h[4 * j] *= rs * g.x; h[4 * j + 1] *= rs * g.y; h[4 * j + 2] *= rs * g.z; h[4 * j + 3] *= rs * g.w;
            uint2 o; o.x = pk2(h[4 * j], h[4 * j + 1]); o.y = pk2(h[4 * j + 2], h[4 * j + 3]);
            *(uint2*)(h3 + (size_t)m * D + k0) = o;
#pragma unroll
            for (int e = 0; e < 4; ++e) { const float4 w = *(const float4*)(wrg + (k0 + e) * 4); const float x = h[4 * j + e]; l1[0] += x * w.x; l1[1] += x * w.y; l1[2] += x * w.z; l1[3] += x * w.w; }
        }
#pragma unroll
        for (int i = 0; i < 4; ++i) l1[i] = wave_sum(l1[i]) + brg[i];
        int grp = 0; float best = l1[0];
#pragma unroll
        for (int i = 1; i < 4; ++i) if (l1[i] > best) { best = l1[i]; grp = i; }
        float se = 0.f;
#pragma unroll
        for (int i = 0; i < 4; ++i) se += __expf(l1[i] - best);
        const float g1 = 1.f / se;
        float l2[8] = {};
        const float* we = wre + (size_t)grp * D * 8;
#pragma unroll
        for (int j = 0; j < 4; ++j) {
            const int k0 = (lane + 64 * j) * 4;
#pragma unroll
            for (int e = 0; e < 4; ++e) { const float x = h[4 * j + e]; const float4 w0 = *(const float4*)(we + (k0 + e) * 8), w1 = *(const float4*)(we + (k0 + e) * 8 + 4);
                l2[0] += x * w0.x; l2[1] += x * w0.y; l2[2] += x * w0.z; l2[3] += x * w0.w; l2[4] += x * w1.x; l2[5] += x * w1.y; l2[6] += x * w1.z; l2[7] += x * w1.w; }
        }
#pragma unroll
        for (int i = 0; i < 8; ++i) l2[i] = wave_sum(l2[i]) + bre[grp * 8 + i];
        int i0 = 0; float v0 = l2[0];
#pragma unroll
        for (int i = 1; i < 8; ++i) if (l2[i] > v0) { v0 = l2[i]; i0 = i; }
        int i1 = -1; float v1 = -3.0e38f;
#pragma unroll
        for (int i = 0; i < 8; ++i) if (i != i0 && l2[i] > v1) { v1 = l2[i]; i1 = i; }
        const float e1 = __expf(v1 - v0), inv = 1.f / (1.f + e1);
        if (lane == 0) {
            const int ea = grp * 8 + i0, eb = grp * 8 + i1;
            mb.tok_e[2 * m] = ea; mb.tok_e[2 * m + 1] = eb;
            mb.tok_g[2 * m] = g1 * inv; mb.tok_g[2 * m + 1] = g1 * e1 * inv;
            atomicAdd(&lcnt[ea], 1); atomicAdd(&lcnt[eb], 1);
        }
    }
    __syncthreads();
    if (wv == 0 && lane < 32) mb.bcnt[GB * 32 + lane] = lcnt[lane];
    __syncthreads();
}
__device__ __forceinline__ void moe_plan_ph(const int WID_, const MoeBufs& mb, char* lds) {
    if (GB != 0) return;
    int* tot = (int*)lds; int* off = tot + 32;
    const int t = WID_ * 64 + lane_id();
    if (t < 32) { int run = 0; for (int b = 0; b < GN; ++b) { const int c = __hip_atomic_load(mb.bcnt + b * 32 + t, __ATOMIC_RELAXED, __HIP_MEMORY_SCOPE_AGENT); mb.bbase[b * 32 + t] = run; run += c; } tot[t] = run; }
    __syncthreads();
    if (t == 0) { int o = 0, nt = 0;
        for (int e = 0; e < NEXP; ++e) { off[e] = o; mb.offs[e] = o; const int c = tot[e]; for (int r0 = 0; r0 < c; r0 += 256) { mb.tiles[nt] = e; ++nt; } o += ((c + 255) / 256) * 256; }
        *mb.ntiles = nt; }
    __syncthreads();
}
__device__ __forceinline__ void moe_scatter_ph(const int WID_, const MoeBufs& mb, char* lds) {
    const int lane = lane_id(), wv = WID_;
    int* cur = (int*)lds;
    if (wv == 0 && lane < 32) cur[lane] = __hip_atomic_load(mb.offs + lane, __ATOMIC_RELAXED, __HIP_MEMORY_SCOPE_AGENT) + __hip_atomic_load(mb.bbase + GB * 32 + lane, __ATOMIC_RELAXED, __HIP_MEMORY_SCOPE_AGENT);
    __syncthreads();
    for (int m0 = (GB * 8 + wv); m0 < M; m0 += GN * 8 * 32) {
        const int i = lane >> 1, m = m0 + i * GN * 8;
        if (m < M) { const int a = 2 * m + (lane & 1); const int e = mb.tok_e[a];
            const int pos = atomicAdd(&cur[e], 1);
            mb.slot_tok[pos] = m; mb.slot_gate[pos] = mb.tok_g[a]; mb.tok_slot[a] = pos; }
    }
    __syncthreads();
}
__device__ __forceinline__ void moe_gather_ph(const int WID_, const bf16* __restrict__ h3, bf16* __restrict__ xg, const MoeBufs& mb) {
    const int lane = lane_id(), wv = WID_;
    const int nrows = __hip_atomic_load(mb.ntiles, __ATOMIC_RELAXED, __HIP_MEMORY_SCOPE_AGENT) * 256;
    for (int r0 = (GB * 8 + wv) * 4; r0 < nrows; r0 += GN * 32) {
        uint4 a[4], c[4];
#pragma unroll
        for (int i = 0; i < 4; ++i) { const int t = mb.slot_tok[r0 + i]; const uint4* s = (const uint4*)(h3 + (size_t)t * D); a[i] = s[lane]; c[i] = s[lane + 64]; }
#pragma unroll
        for (int i = 0; i < 4; ++i) { uint4* d = (uint4*)(xg + (size_t)(r0 + i) * D); d[lane] = a[i]; d[lane + 64] = c[i]; }
    }
}
__device__ __forceinline__ void moe_weights_ph(const int WID_, const float* __restrict__ wg, const float* __restrict__ wu, const float* __restrict__ wd, bf16* __restrict__ wgu_t, bf16* __restrict__ wd_t, char* lds) {
    const int lane = (WID_ * 64 + lane_id()) & 63, wv = (WID_ * 64 + lane_id()) >> 6;
    float* scr = (float*)(lds + wv * 16384);
    constexpr int I_GU = 16 * 16;
    constexpr int I_D = 8 * 32;
    constexpr int NIT = NEXP * (2 * I_GU + I_D);
    for (int it = GB * 8 + wv; it < NIT; it += GN * 8) {
        const int e = it / (2 * I_GU + I_D); int r = it % (2 * I_GU + I_D);
        if (r < 2 * I_GU) {
            const int up = r / I_GU; r %= I_GU;
            const int kb = r / 16, nb = r % 16;
            const int pn = nb / 4, nsub = nb % 4;
            const float* W = (up ? wu : wg) + (size_t)e * D * DEXP + nb * 32;
            transpose_item(W + (size_t)kb * 64 * DEXP, 64, 32, wgu_t, D, e * 1024 + pn * 256 + up * 128 + nsub * 32, kb * 64, scr, 0, lane, nullptr, DEXP);
        } else {
            r -= 2 * I_GU;
            const int kb = r / 32, nb = r % 32;
            const float* W = wd + (size_t)e * DEXP * D + nb * 32;
            transpose_item(W + (size_t)kb * 64 * D, 64, 32, wd_t, DEXP, e * 1024 + nb * 32, kb * 64, scr, 0, lane, nullptr, D);
        }
    }
}
__device__ __forceinline__ void final_ph(const int WID_, float* __restrict__ out, const bf16* __restrict__ yslot, const int* __restrict__ tok_slot, const float* __restrict__ w) {
    const int lane = lane_id(), wv = WID_;
    float4 g[4];
#pragma unroll
    for (int j = 0; j < 4; ++j) g[j] = *(const float4*)(w + (lane + 64 * j) * 4);
    for (int row0 = (GB * 8 + wv) * 2; row0 < M; row0 += GN * 16) {
        float4 v[2][4]; uint2 ya[2][4], yb[2][4];
#pragma unroll
        for (int r = 0; r < 2; ++r) { const int row = row0 + r;
            const float4* xr = (const float4*)(out + (size_t)row * D);
            const uint2* pa = (const uint2*)(yslot + (size_t)tok_slot[2 * row] * D);
            const uint2* pb = (const uint2*)(yslot + (size_t)tok_slot[2 * row + 1] * D);
#pragma unroll
            for (int j = 0; j < 4; ++j) { v[r][j] = xr[lane + 64 * j]; ya[r][j] = pa[lane + 64 * j]; yb[r][j] = pb[lane + 64 * j]; } }
#pragma unroll
        for (int r = 0; r < 2; ++r) { float s = 0.f;
#pragma unroll
            for (int j = 0; j < 4; ++j) { const uint2 a = ya[r][j], b = yb[r][j];
                v[r][j].x += __builtin_bit_cast(float, a.x << 16) + __builtin_bit_cast(float, b.x << 16);
                v[r][j].y += __builtin_bit_cast(float, a.x & 0xffff0000u) + __builtin_bit_cast(float, b.x & 0xffff0000u);
                v[r][j].z += __builtin_bit_cast(float, a.y << 16) + __builtin_bit_cast(float, b.y << 16);
                v[r][j].w += __builtin_bit_cast(float, a.y & 0xffff0000u) + __builtin_bit_cast(float, b.y & 0xffff0000u);
                s += v[r][j].x * v[r][j].x + v[r][j].y * v[r][j].y + v[r][j].z * v[r][j].z + v[r][j].w * v[r][j].w; }
            s = wave_sum(s);
            const float rs = rsqrtf(s * (1.f / D) + 1e-6f);
            float4* xo = (float4*)(out + (size_t)(row0 + r) * D);
#pragma unroll
            for (int j = 0; j < 4; ++j) xo[lane + 64 * j] = make_float4(v[r][j].x * rs * g[j].x, v[r][j].y * rs * g[j].y, v[r][j].z * rs * g[j].z, v[r][j].w * rs * g[j].w); }
    }
}

struct S5Tab { float* Kmat; bf16* BtA; bf16* BtB; };
__device__ __forceinline__ void s5_lam(const float* lam_re, const float* lam_im, const float* log_dt, int g, int n, float& a, float& w) {
    const float dt = __expf(log_dt[g]); a = lam_re[g * 64 + n] * dt; w = lam_im[g * 64 + n] * dt;
}
__device__ __forceinline__ void cexpj(float a, float w, float j, float& re, float& im) { const float e = __expf(a * j); float s, c; sincosf(w * j, &s, &c); re = e * c; im = e * s; }
__device__ __forceinline__ void s5_bbar(const float* lam_re, const float* lam_im, const float* log_dt, const float* b_re, const float* b_im, int g, int n, int h, float& br, float& bi) {
    float a, w; s5_lam(lam_re, lam_im, log_dt, g, n, a, w);
    float lbr, lbi; cexpj(a, w, 1.f, lbr, lbi);
    const float lr = lam_re[g * 64 + n], li = lam_im[g * 64 + n];
    const float nr = lbr - 1.f, ni = lbi, den = lr * lr + li * li;
    const float cr = (nr * lr + ni * li) / den, ci = (ni * lr - nr * li) / den;
    const float xr = b_re[(g * 64 + n) * 16 + h], xi = b_im[(g * 64 + n) * 16 + h];
    br = cr * xr - ci * xi; bi = cr * xi + ci * xr;
}
__device__ __forceinline__ void s5_tables0_ph(const int WID_, const float* lam_re, const float* lam_im, const float* log_dt, const float* b_re, const float* b_im, const float* c_re, const float* c_im, const S5Tab& T) {
    const int gtid = GB * NT + (WID_ * 64 + lane_id()), gsz = GN * NT;
    for (int i = gtid; i < 32 * 32 * 256; i += gsz) {
        const int h = i & 15, hp = (i >> 4) & 15, j = (i >> 8) & 31, g = i >> 13;
        float acc = 0.f;
        for (int n = 0; n < 64; ++n) {
            float a, w; s5_lam(lam_re, lam_im, log_dt, g, n, a, w);
            float pr, pi; cexpj(a, w, (float)j, pr, pi);
            float br, bi; s5_bbar(lam_re, lam_im, log_dt, b_re, b_im, g, n, h, br, bi);
            const float tr = pr * br - pi * bi, ti = pr * bi + pi * br;
            acc += c_re[(g * 16 + hp) * 64 + n] * tr - c_im[(g * 16 + hp) * 64 + n] * ti;
        }
        T.Kmat[i] = acc;
    }
    for (int i = gtid; i < 32 * 256 * 512; i += gsz) {
        const int col = i & 511, r = (i >> 9) & 255, g = i >> 17;
        float v = 0.f;
        if (r < 128) {
            const int n = r & 63, s = col >> 4, h = col & 15;
            float a, w; s5_lam(lam_re, lam_im, log_dt, g, n, a, w);
            float pr, pi; cexpj(a, w, (float)(S5L - 1 - s), pr, pi);
            float br, bi; s5_bbar(lam_re, lam_im, log_dt, b_re, b_im, g, n, h, br, bi);
            v = (r < 64) ? (pr * br - pi * bi) : (pr * bi + pi * br);
        }
        T.BtA[((size_t)g * 768 + 512 + r) * 512 + col] = f2bf(v);
    }
    for (int i = gtid; i < 32 * 512 * 256; i += gsz) {
        const int k = i & 255, row = (i >> 8) & 511, g = i >> 17;
        float v = 0.f;
        if (k < 128) {
            const int n = k & 63, sp = row >> 4, hp = row & 15;
            float a, w; s5_lam(lam_re, lam_im, log_dt, g, n, a, w);
            float pr, pi; cexpj(a, w, (float)(sp + 1), pr, pi);
            const float cr = c_re[(g * 16 + hp) * 64 + n], ci = c_im[(g * 16 + hp) * 64 + n];
            v = (k < 64) ? (cr * pr - ci * pi) : -(cr * pi + ci * pr);
        }
        T.BtB[i] = f2bf(v);
    }
}
__device__ __forceinline__ void s5_tables1_ph(const int WID_, const float* dsk, const S5Tab& T) {
    const int gtid = GB * NT + (WID_ * 64 + lane_id()), gsz = GN * NT;
    for (int i = gtid; i < 32 * 512 * 512; i += gsz) {
        const int col = i & 511, row = (i >> 9) & 511, g = i >> 18;
        const int sp = row >> 4, hp = row & 15, s = col >> 4, h = col & 15;
        float v = 0.f;
        if (s <= sp) v = T.Kmat[((g * 32 + (sp - s)) * 16 + hp) * 16 + h];
        if (row == col) v += dsk[g * 16 + hp];
        T.BtA[((size_t)g * 768 + row) * 512 + col] = f2bf(v);
    }
}
__device__ __forceinline__ void s5_carry_ph(const int WID_, const float* lam_re, const float* lam_im, const float* log_dt, const float* __restrict__ F, bf16* __restrict__ XST) {
    const int gtid = GB * NT + (WID_ * 64 + lane_id()), gsz = GN * NT;
    for (int i = gtid; i < 32 * S5R * 16; i += gsz) { const int row = i >> 4, q = i & 15; *(uint4*)(XST + (size_t)row * 256 + 128 + q * 8) = make_uint4(0, 0, 0, 0); }
    const int lane = (WID_ * 64 + lane_id()) & 63, wv = (WID_ * 64 + lane_id()) >> 6;
    const int nidle = (GN > RW_ITEMS) ? GN - RW_ITEMS : GN, myi = (GN > RW_ITEMS) ? GB - RW_ITEMS : GB;
    for (int item = (myi < 0 ? NB * 32 : myi + nidle * wv); item < NB * 32; item += nidle * 8) {
        const int b = item >> 5, g = item & 31, n = lane;
        float a, w; s5_lam(lam_re, lam_im, log_dt, g, n, a, w);
        float pr, pi; cexpj(a, w, (float)S5L, pr, pi);
        float xr = 0.f, xi = 0.f;
        const size_t row0 = (size_t)g * S5R + (size_t)b * (S / S5L);
        const float* f = F + row0 * 128; bf16* xo = XST + row0 * 256;
        for (int c0 = 0; c0 < S / S5L; c0 += 8) {
            float fr[8], fi[8];
#pragma unroll
            for (int q = 0; q < 8; ++q) { fr[q] = f[(size_t)(c0 + q) * 128 + n]; fi[q] = f[(size_t)(c0 + q) * 128 + 64 + n]; }
#pragma unroll
            for (int q = 0; q < 8; ++q) {
                xo[(size_t)(c0 + q) * 256 + n] = f2bf(xr); xo[(size_t)(c0 + q) * 256 + 64 + n] = f2bf(xi);
                const float nr = pr * xr - pi * xi + fr[q], ni = pr * xi + pi * xr + fi[q];
                xr = nr; xi = ni;
            }
        }
    }
}

#define XB_TMO      128
#define XB_XCNT(j)  (256  + 64 * (j))
#define XB_XSUB(j)  (1280 + 64 * (j))
#define XB_XGEN(j)  (2304 + 64 * (j))
#define XB_TOP      3328
#define XB_TOPGEN   3392
#define XCD_BAR_WORDS 3456
#define XB_SPIN_CAP (1u << 20)
__device__ __forceinline__ unsigned xb_ld(unsigned* p)              { return __hip_atomic_load(p, __ATOMIC_RELAXED, __HIP_MEMORY_SCOPE_AGENT); }
__device__ __forceinline__ unsigned xb_add(unsigned* p, unsigned v) { return __hip_atomic_fetch_add(p, v, __ATOMIC_RELAXED, __HIP_MEMORY_SCOPE_AGENT); }
__device__ __forceinline__ unsigned xb_xcc_id() { return (unsigned)__builtin_amdgcn_s_getreg((3 << 11) | 20) & 0xFu; }
#define XB_SPIN(cond, bar) do { unsigned _sp = 0; while (cond) { __builtin_amdgcn_s_sleep(1); \
    if ((++_sp & 255u) == 0u) { if (xb_ld(&(bar)[XB_TMO])) break; if (_sp > XB_SPIN_CAP) { atomicAdd(&(bar)[XB_TMO], 1u); break; } } } } while (0)
struct XcdBarrier { unsigned* bar; unsigned x; volatile __attribute__((address_space(3))) unsigned* st; };
__device__ __forceinline__ XcdBarrier xcd_barrier_post(const int WID_, unsigned* bar, volatile __attribute__((address_space(3))) unsigned* st) {
    XcdBarrier b; b.bar = bar; b.x = xb_xcc_id(); b.st = st;
    if ((WID_ * 64 + lane_id()) == 0) (void)xb_add(&bar[XB_XCNT(b.x)], 1u);
    return b;
}
__device__ __forceinline__ void xcd_barrier_complete(unsigned* bar, unsigned x, unsigned& nloc, unsigned& nx) {
    const unsigned G = gridDim.x * gridDim.y * gridDim.z;
    unsigned sum, cnt, mine, sp = 0u;
    for (;;) {
        sum = 0u; cnt = 0u; mine = 0u;
#pragma unroll
        for (unsigned j = 0; j < 16; ++j) { const unsigned c = xb_ld(&bar[XB_XCNT(j)]); sum += c; cnt += (c > 0u) ? 1u : 0u; mine = (j == x) ? c : mine; }
        if (sum == G) break;
        __builtin_amdgcn_s_sleep(1);
        if ((++sp & 255u) == 0u) { if (xb_ld(&bar[XB_TMO])) break; if (sp > XB_SPIN_CAP) { atomicAdd(&bar[XB_TMO], 1u); break; } }
    }
    nloc = mine > 0u ? mine : 1u; nx = cnt > 0u ? cnt : 1u;
}
__device__ __forceinline__ void xcd_barrier(const int WID_, const XcdBarrier& b) {
    asm volatile("s_waitcnt vmcnt(0)" ::: "memory");
    __syncthreads();
    if ((WID_ * 64 + lane_id()) == 0) {
        unsigned* bar = b.bar;
        __builtin_amdgcn_s_waitcnt(0);
        unsigned nloc = b.st[0], nx = b.st[1];
        if (nloc == 0u) { xcd_barrier_complete(bar, b.x, nloc, nx); b.st[0] = nloc; b.st[1] = nx; }
        const unsigned old = xb_add(&bar[XB_XSUB(b.x)], 1u);
        const unsigned gen = old / nloc;
        if (old + 1u == (gen + 1u) * nloc) {
            __builtin_amdgcn_fence(__ATOMIC_RELEASE, "agent");
            asm volatile("s_waitcnt vmcnt(0)" ::: "memory");
            const unsigned og = xb_add(&bar[XB_TOP], 1u);
            const unsigned tg = og / nx;
            if (og + 1u == (tg + 1u) * nx) xb_add(&bar[XB_TOPGEN], 1u);
            else XB_SPIN(xb_ld(&bar[XB_TOPGEN]) == tg, bar);
            __builtin_amdgcn_fence(__ATOMIC_ACQUIRE, "agent");
            xb_add(&bar[XB_XGEN(b.x)], 1u);
            asm volatile("s_waitcnt vmcnt(0)" ::: "memory");
        } else {
            XB_SPIN(xb_ld(&bar[XB_XGEN(b.x)]) == gen, bar);
            __builtin_amdgcn_fence(__ATOMIC_ACQUIRE, "agent");
            asm volatile("s_waitcnt vmcnt(0)" ::: "memory");
        }
    }
    __syncthreads();
}

struct Params { const float* in[41]; float* out; char* ws; };

constexpr size_t W_PROJ = 0;
constexpr size_t W_US5 = 224;
constexpr size_t W_WTS = 288;
constexpr size_t W_YI = 352;
constexpr size_t W_F = 416;
constexpr size_t W_XST = 448;
constexpr size_t W_Z = 480;
constexpr size_t W_MISC = 544;
constexpr size_t W_XN = 576;
constexpr size_t W_CTL = 558;
constexpr size_t WO_IN = 0, WO_GLU = 5 * MiB, WO_MIX = 6 * MiB, WO_Q = 8 * MiB, WO_K = 10 * MiB, WO_V = 12 * MiB, WO_O = 14 * MiB, WO_KMAT = 16 * MiB, WO_BTA = 17 * MiB, WO_BTB = 41 * MiB;

__global__ void __launch_bounds__(NT, 2) fwd_kernel(Params p) {
    extern __shared__ __attribute__((aligned(16))) char lds[];
    const int WID_ = __builtin_amdgcn_readfirstlane((int)(threadIdx.x >> 6));
    cg::grid_group grid = cg::this_grid();
    PG8_LAS unsigned char* ldsl = (PG8_LAS unsigned char*)lds;
    char* ws = p.ws; char* dout = (char*)p.out; float* out = p.out;
#define IN(i) (p.in[i])
    volatile __attribute__((address_space(3))) unsigned* bst = (volatile __attribute__((address_space(3))) unsigned*)(ldsl + LDS_BYTES - 64);
    if (WID_ == 0 && lane_id() < 2) bst[lane_id()] = 0u;
    __syncthreads();
    const XcdBarrier xbar = xcd_barrier_post(WID_, (unsigned*)(ws + W_CTL * MiB), bst);
#define SYNC() xcd_barrier(WID_, xbar)
    char* WT = ws + W_WTS * MiB;
    bf16* w_in_t = (bf16*)(WT + WO_IN); bf16* w_glu_t = (bf16*)(WT + WO_GLU); bf16* w_mix_t = (bf16*)(WT + WO_MIX);
    bf16* w_q_t = (bf16*)(WT + WO_Q); bf16* w_k_t = (bf16*)(WT + WO_K); bf16* w_v_t = (bf16*)(WT + WO_V); bf16* w_o_t = (bf16*)(WT + WO_O);
    S5Tab stab; stab.Kmat = (float*)(WT + WO_KMAT); stab.BtA = (bf16*)(WT + WO_BTA); stab.BtB = (bf16*)(WT + WO_BTB);
    bf16* PROJ = (bf16*)(ws + W_PROJ * MiB); bf16* US5 = (bf16*)(ws + W_US5 * MiB);
    bf16* XN = (bf16*)(ws + W_XN * MiB);
    transpose_ph(WID_, IN(3), D, DIN, w_in_t, D, 0, 0, lds);
    transpose_ph(WID_, IN(23), 512, 512, w_glu_t, 512, 0, 0, lds);
    transpose_ph(WID_, IN(25), D, D, w_mix_t, D, 0, 0, lds);
    transpose_ph(WID_, IN(28), D, D, w_q_t, D, 0, 0, lds);
    transpose_ph(WID_, IN(29), D, D, w_k_t, D, 0, 0, lds);
    transpose_ph(WID_, IN(30), D, D, w_v_t, D, 0, 0, lds);
    transpose_ph(WID_, IN(31), D, D, w_o_t, D, 0, 0, lds);
    s5_tables0_ph(WID_, IN(15), IN(16), IN(17), IN(18), IN(19), IN(20), IN(21), stab);
    bf16* wl_t = (bf16*)(WT + 49 * MiB);
    rwkv_wl_ph(WID_, IN(6), IN(8), IN(9), wl_t);
    rmsnorm_ph<bf16>(WID_, IN(0), IN(2), XN, M);
    grid.sync();
    s5_tables1_ph(WID_, IN(22), stab);
    { pg8::PlainOrder S; S.init(XN, D, w_in_t, D, M, DIN, D); pg8::EpiProj E{PROJ, US5}; pg8::gemm_phase(WID_, ldsl, S, E); }
    SYNC();
    bf16* LIN = (bf16*)(ws + (W_MISC + 16) * MiB);
    rwkv_lin_ph(WID_, PROJ, IN(4), LIN);
    SYNC();
    bf16* YI = (bf16*)(ws + W_YI * MiB); float* F = (float*)(ws + W_F * MiB); bf16* XST = (bf16*)(ws + W_XST * MiB); bf16* Z = (bf16*)(ws + W_Z * MiB);
    bf16* LWb = (bf16*)(ws + 704 * MiB); bf16* AAb = (bf16*)(ws + 768 * MiB); bf16* Gb = (bf16*)(ws + 832 * MiB);
    float* Yr = (float*)(ws + 896 * MiB); float* RKb = (float*)(ws + W_MISC * MiB);
    { pg8::GroupOrder S; S.init(US5, 512, (size_t)S5R * 512, stab.BtA, 512, (size_t)768 * 512, 32, S5R, 768, 512); pg8::EpiS5a E{YI, F}; pg8::gemm_phase(WID_, ldsl, S, E); }
    { pg8::PlainOrder S; S.init(LIN, 256, wl_t, 256, M, 1536, 256); pg8::EpiLora E{LWb, (size_t)32 * MiB, IN(5), IN(7)}; pg8::gemm_phase(WID_, ldsl, S, E); }
    SYNC();
    s5_carry_ph(WID_, IN(15), IN(16), IN(17), F, XST);
    { RwkvIn ri{PROJ, LWb, AAb, IN(4), IN(10), IN(11), IN(12), Yr, RKb}; rwkv_scan_ph(WID_, ri, lds); }
    SYNC();
    bf16* YMIX = XN;
    { pg8::GroupOrder S; S.init(XST, 256, (size_t)S5R * 256, stab.BtB, 256, (size_t)512 * 256, 32, S5R, 512, 256); pg8::EpiS5b E{YI, Z}; pg8::gemm_phase(WID_, ldsl, S, E); }
    rwkv_post_ph(WID_, Yr, RKb, PROJ, IN(4), Gb, IN(13), IN(14), YMIX);
    SYNC();
    { pg8::PlainOrder S; S.init(Z, 512, w_glu_t, 512, M, 512, 512); pg8::EpiGlu E{Z, IN(24), YMIX}; pg8::gemm_phase(WID_, ldsl, S, E); }
    SYNC();
    { pg8::PlainOrder S; S.init(YMIX, D, w_mix_t, D, M, D, D); pg8::EpiF32 E{out, D, IN(0), D}; pg8::gemm_phase(WID_, ldsl, S, E); }
    SYNC();
    bf16* KM = (bf16*)(ws + (W_MISC + 2) * MiB); bf16* VT = (bf16*)(ws + (W_MISC + 6) * MiB); bf16* MEMN = (bf16*)(ws + (W_MISC + 10) * MiB);
    rmsnorm_ph<bf16>(WID_, out, IN(26), XN, M);
    rmsnorm_ph<bf16>(WID_, IN(1), IN(27), MEMN, NB * NMEM);
    SYNC();
    bf16* Q = (bf16*)(ws + 128 * MiB);
    { pg8::PlainOrder S; S.init(MEMN, D, w_k_t, D, NB * NMEM, D, D); pg8::EpiBf16 E{KM, D}; pg8::gemm_phase(WID_, ldsl, S, E); }
    { pg8::PlainOrder S; S.init(w_v_t, D, MEMN, D, D, NB * NMEM, D); pg8::EpiBf16 E{VT, NB * NMEM}; pg8::gemm_phase(WID_, ldsl, S, E); }
    { pg8::PlainOrder S; S.init(XN, D, w_q_t, D, M, D, D); pg8::EpiBf16 E{Q, D}; pg8::gemm_phase(WID_, ldsl, S, E); }
    SYNC();
    bf16* P = (bf16*)(ws + W_YI * MiB);
    { pg8::AttnOrder S; S.init(Q, KM, D, 0); pg8::EpiSoftmax E{P, (PG8_LAS float*)(ldsl + 131072)}; pg8::gemm_phase(WID_, ldsl, S, E); }
    SYNC();
    bf16* O = XN;
    { pg8::AttnOrder S; S.init(P, VT, NB * NMEM, 1); pg8::EpiAttnO E{O}; pg8::gemm_phase(WID_, ldsl, S, E); }
    SYNC();
    { pg8::PlainOrder S; S.init(O, D, w_o_t, D, M, D, D); pg8::EpiF32 E{out, D, out, D}; pg8::gemm_phase(WID_, ldsl, S, E); }
    SYNC();
    bf16* H3 = XN;
    bf16* XG = (bf16*)(ws + 0);
    bf16* WGU_t = (bf16*)(ws + 272 * MiB); bf16* WD_t = (bf16*)(ws + 336 * MiB);
    bf16* HID = (bf16*)(ws + 368 * MiB);
    bf16* YSLOT = (bf16*)(ws + 704 * MiB);
    MoeBufs mb; char* mbase = ws + 976 * MiB;
    mb.tok_e = (int*)(mbase); mb.tok_g = (float*)(mbase + 1 * MiB); mb.tok_slot = (int*)(mbase + 2 * MiB); mb.slot_tok = (int*)(mbase + 3 * MiB);
    mb.slot_gate = (float*)(mbase + 4 * MiB); mb.bcnt = (int*)(mbase + 5 * MiB); mb.bbase = mb.bcnt + 16384; mb.offs = mb.bcnt + 32768; mb.ntiles = mb.offs + 64;
    mb.tiles = (int*)(mbase + 6 * MiB);
    moe_zero_ph(WID_, mb);
    moe_weights_ph(WID_, IN(37), IN(38), IN(39), WGU_t, WD_t, lds);
    SYNC();
    router_ph(WID_, out, IN(32), H3, IN(33), IN(34), IN(35), IN(36), mb, lds);
    SYNC();
    moe_plan_ph(WID_, mb, lds);
    SYNC();
    moe_scatter_ph(WID_, mb, lds);
    SYNC();
    moe_gather_ph(WID_, H3, XG, mb);
    SYNC();
    const int ntiles = __hip_atomic_load(mb.ntiles, __ATOMIC_RELAXED, __HIP_MEMORY_SCOPE_AGENT);
    { pg8::MoeOrder S; S.init(XG, D, WGU_t, D, D, mb.tiles, ntiles, 1024); pg8::EpiSilu E{HID}; pg8::gemm_phase(WID_, ldsl, S, E); }
    SYNC();
    { pg8::MoeOrder S; S.init(HID, DEXP, WD_t, DEXP, DEXP, mb.tiles, ntiles, 1024); pg8::EpiGate E{YSLOT, mb.slot_gate}; pg8::gemm_phase(WID_, ldsl, S, E); }
    SYNC();
    final_ph(WID_, out, YSLOT, mb.tok_slot, IN(40));
}
}

extern "C" void kernel_launch(void* const* d_in, const int* in_sizes, int n_in, void* d_out, int out_size, void* d_ws, size_t ws_size, hipStream_t stream) {
    (void)in_sizes; (void)out_size; (void)ws_size;
    static int grid = 0;
    if (grid == 0) {
        int dev = 0, cus = 0, per_cu = 0;
        hipGetDevice(&dev);
        hipDeviceGetAttribute(&cus, hipDeviceAttributeMultiprocessorCount, dev);
        hipFuncSetAttribute((const void*)fwd_kernel, hipFuncAttributeMaxDynamicSharedMemorySize, LDS_BYTES);
        hipOccupancyMaxActiveBlocksPerMultiprocessor(&per_cu, (const void*)fwd_kernel, NT, LDS_BYTES);
        if (per_cu < 1) { fprintf(stderr, "occupancy query says %d blocks/CU\n", per_cu); per_cu = 1; }
        grid = cus * 1;
    }
    (void)hipMemsetAsync((char*)d_ws + W_CTL * MiB, 0, 16384, stream);
    Params p{};
    for (int i = 0; i < 41 && i < n_in; ++i) p.in[i] = (const float*)d_in[i];
    p.out = (float*)d_out; p.ws = (char*)d_ws;
    void* args[] = {&p};
    hipError_t e = hipLaunchCooperativeKernel((const void*)fwd_kernel, dim3(grid), dim3(NT), args, LDS_BYTES, stream);
    if (e != hipSuccess) fprintf(stderr, "cooperative launch failed: %s (grid %d)\n", hipGetErrorString(e), grid);
}
```

```cpp
#include <hip/hip_runtime.h>
#include <hip/hip_cooperative_groups.h>
#include <stdint.h>
#include <cstdio>
namespace cg = cooperative_groups;

namespace {
constexpr int NB = 8, S = 8192, D = 1024, M = NB * S;
constexpr int DR = 512, DSHIFT = 1792, DIN = 2304, NMEM = 256;
constexpr int NEXP = 32, DEXP = 512, NASSIGN = 2 * M;
constexpr size_t MiB = 1u << 20;
constexpr int NT = 512;
constexpr int S5L = 32, S5R = M / S5L;
constexpr int LDS_BYTES = 147456;
#define GB ((int)blockIdx.x)
#define GN ((int)gridDim.x)

typedef unsigned short bf16;
__device__ __forceinline__ bf16 f2bf(float f) { unsigned u = __builtin_bit_cast(unsigned, f); return (bf16)((u + 0x7fffu + ((u >> 16) & 1u)) >> 16); }
__device__ __forceinline__ unsigned pk2(float lo, float hi) { return (unsigned)f2bf(lo) | ((unsigned)f2bf(hi) << 16); }
__device__ __forceinline__ int lane_id() { int l = (int)__builtin_amdgcn_mbcnt_hi(~0u, __builtin_amdgcn_mbcnt_lo(~0u, 0u)); asm volatile("" : "+v"(l)); return l; }
__device__ __forceinline__ float bf2f(bf16 h) { return __builtin_bit_cast(float, (unsigned)h << 16); }

template <typename T> __device__ __forceinline__ float ldf(const T* p);
template <> __device__ __forceinline__ float ldf<float>(const float* p) { return *p; }
template <> __device__ __forceinline__ float ldf<bf16>(const bf16* p) { return bf2f(*p); }
template <typename T> __device__ __forceinline__ void stf(T* p, float v);
template <> __device__ __forceinline__ void stf<float>(float* p, float v) { *p = v; }
template <> __device__ __forceinline__ void stf<bf16>(bf16* p, float v) { *p = f2bf(v); }

template <int CTRL, int ROWMASK> __device__ __forceinline__ float dppf_(float x) { return __builtin_bit_cast(float, __builtin_amdgcn_update_dpp(0, __builtin_bit_cast(int, x), CTRL, ROWMASK, 0xf, false)); }
__device__ __forceinline__ float wave_sum(float v) {
    v += dppf_<0xB1, 0xf>(v); v += dppf_<0x4E, 0xf>(v); v += dppf_<0x141, 0xf>(v); v += dppf_<0x140, 0xf>(v);
    v += dppf_<0x142, 0xa>(v);
    v += dppf_<0x143, 0xc>(v);
    return __builtin_bit_cast(float, __builtin_amdgcn_readlane(__builtin_bit_cast(int, v), 63));
}
__device__ __forceinline__ float sigmoidf_(float x) { return 1.f / (1.f + __expf(-x)); }


__device__ __forceinline__ float gelu_tanh(float x) { return x * sigmoidf_(1.5957691216057308f * (x + 0.044715f * x * x * x)); }

namespace pg8 {
#define PG8_LAS __attribute__((address_space(3)))
typedef short bf16x8 __attribute__((ext_vector_type(8)));
typedef float f32x4 __attribute__((ext_vector_type(4)));
typedef unsigned u32x4 __attribute__((ext_vector_type(4)));
constexpr int BM = 256, BK = 64, HALF = 128, HTB = HALF * BK * 2, STAGE_BYTES = 8 * HTB, NXCD = 8, WGM = 8;
__device__ __forceinline__ int lds_byte(int r, int c) { const int st = (r >> 4) * 2 + (c >> 5), rr = r & 15, cc = c & 31, ob = rr * 64 + cc * 2; return st * 1024 + (ob ^ (((ob >> 9) & 1) << 5)); }
__device__ __forceinline__ void stage_rc(int b, int& R, int& C) { const int st = b / 1024, sb = b % 1024, swz = sb ^ (((sb >> 9) & 1) << 5); R = (st >> 1) * 16 + swz / 64; C = (st & 1) * 32 + (swz % 64) / 2; }
__device__ __forceinline__ int perm32(int rho) { const int n = rho >> 4, i = rho & 15; return 8 * (i >> 2) + 4 * n + (i & 3); }
struct Unit { int pm, pn; };
struct PlainOrder {
    const bf16* A; const bf16* Bt; int lda, ldb, K; int nM, nN, nwg, G, c;
    __device__ void init(const bf16* A_, int lda_, const bf16* Bt_, int ldb_, int M, int N, int K_) { A = A_; Bt = Bt_; lda = lda_; ldb = ldb_; K = K_; nM = M / BM; nN = N / BM; nwg = nM * nN; G = GN; c = GB; }
    __device__ bool next(int i, Unit& u) const {
        const long L = (long)i * G + c; if (L >= nwg) return false;
        int wgid = (int)L; { const int q = nwg / NXCD, r = nwg % NXCD, xcd = wgid % NXCD, off = wgid / NXCD; wgid = (xcd < r ? xcd * (q + 1) : r * (q + 1) + (xcd - r) * q) + off; }
        const int nig = WGM * nN, gid = wgid / nig, fm = gid * WGM, gsz = (nM - fm) < WGM ? (nM - fm) : WGM;
        u.pm = fm + ((wgid % nig) % gsz); u.pn = (wgid % nig) / gsz; return true;
    }
    __device__ __forceinline__ const char* aptr(const Unit& u) const { return (const char*)(A + (size_t)u.pm * BM * lda); }
    __device__ __forceinline__ const char* bptr(const Unit& u) const { return (const char*)(Bt + (size_t)u.pn * BM * ldb); }
};
__device__ __forceinline__ unsigned cvt_pk_bf16(float lo, float hi) { unsigned r; asm volatile("v_cvt_pk_bf16_f32 %0, %1, %2" : "=v"(r) : "v"(lo), "v"(hi)); return r; }

template <class Epi, class Sched>
__device__ __forceinline__ void gemm_phase(const int WID_, PG8_LAS unsigned char* lds, const Sched& S, const Epi& E) {
    const int tid = (WID_ * 64 + lane_id()), wid = __builtin_amdgcn_readfirstlane(tid >> 6), lane = tid & 63, wr = wid >> 2, wc = wid & 3, fr = lane & 15, fq = lane >> 4;
    const int K = S.K, nt = K / BK;
    unsigned voffA[2], voffB[2];
#pragma unroll
    for (int i = 0; i < 2; ++i) { int R, C; stage_rc(tid * 16 + i * 8192, R, C); const int Rb = Epi::PERM ? ((R & ~31) + perm32(R & 31)) : R;
        voffA[i] = (unsigned)(R * S.lda + C) * 2u; voffB[i] = (unsigned)(Rb * S.ldb + C) * 2u; }
    const size_t kstep = (size_t)(BK * 2);
    const size_t hstepA = (size_t)HALF * S.lda * 2, hstepB = (size_t)HALF * S.ldb * 2;
    const unsigned ldsw = (unsigned)wid * 1024u;
    const int aoff = lds_byte(wr * 64 + fr, fq * 8), boff = lds_byte(wc * 32 + fr, fq * 8);
#define PG8_SA(b, h) (((b) * 2 + (h)) * HTB)
#define PG8_SB(b, h) ((4 + (b) * 2 + (h)) * HTB)
#define PG8_STAGE(bufoff, gbase, voff) do { _Pragma("unroll") for (int _i = 0; _i < 2; ++_i) \
        __builtin_amdgcn_global_load_lds((const unsigned*)((const char*)(gbase) + (voff)[_i]), (PG8_LAS unsigned*)(lds + (bufoff) + ldsw + _i * 8192), 16, 0, 0); } while (0)
#define PG8_LDA(dst, b, h) do { _Pragma("unroll") for (int m = 0; m < 4; ++m) _Pragma("unroll") for (int k = 0; k < 2; ++k) dst[m][k] = *(const PG8_LAS bf16x8*)(lds + PG8_SA(b, h) + aoff + m * 2048 + k * 1024); } while (0)
#define PG8_LDB(dst, b, h) do { _Pragma("unroll") for (int n = 0; n < 2; ++n) _Pragma("unroll") for (int k = 0; k < 2; ++k) dst[n][k] = *(const PG8_LAS bf16x8*)(lds + PG8_SB(b, h) + boff + n * 2048 + k * 1024); } while (0)
#define PG8_MMA(ai, bj, At, Bt) do { __builtin_amdgcn_s_setprio(1); _Pragma("unroll") for (int m = 0; m < 4; ++m) _Pragma("unroll") for (int n = 0; n < 2; ++n) _Pragma("unroll") for (int k = 0; k < 2; ++k) \
        acc[ai][bj][m][n] = __builtin_amdgcn_mfma_f32_16x16x32_bf16(Bt[n][k], At[m][k], acc[ai][bj][m][n], 0, 0, 0); __builtin_amdgcn_s_setprio(0); } while (0)
#define PG8_WAIT_V(n) asm volatile("s_waitcnt vmcnt(" #n ")" ::: "memory")
#define PG8_WAIT_L(n) asm volatile("s_waitcnt lgkmcnt(" #n ")" ::: "memory")
#define PG8_BAR __builtin_amdgcn_s_barrier()
#define PG8_SCHED __builtin_amdgcn_sched_barrier(0)
    Unit cur, nxt; int ui = 0;
    if (!S.next(0, cur)) return;
    f32x4 acc[2][2][4][2];
#pragma unroll
    for (int a = 0; a < 2; ++a)
#pragma unroll
        for (int b = 0; b < 2; ++b)
#pragma unroll
            for (int m = 0; m < 4; ++m)
#pragma unroll
                for (int n = 0; n < 2; ++n) acc[a][b][m][n] = (f32x4){0.f, 0.f, 0.f, 0.f};
    bf16x8 At[4][2], B0[2][2], B1[2][2];
    const char* cA = S.aptr(cur); const char* cB = S.bptr(cur);
    PG8_STAGE(PG8_SB(0, 0), cB, voffB); PG8_STAGE(PG8_SB(0, 1), cB + hstepB, voffB); PG8_STAGE(PG8_SA(0, 0), cA, voffA); PG8_STAGE(PG8_SA(0, 1), cA + hstepA, voffA);
    if (wr == 1) PG8_BAR;
    PG8_WAIT_V(2); PG8_BAR;
    PG8_STAGE(PG8_SB(1, 0), cB + kstep, voffB); PG8_STAGE(PG8_SA(1, 0), cA + kstep, voffA); PG8_STAGE(PG8_SB(1, 1), cB + hstepB + kstep, voffB);
    PG8_WAIT_V(6); PG8_BAR;
    for (;;) {
        const bool has_next = S.next(ui + 1, nxt);
        const char* nA = has_next ? S.aptr(nxt) : cA; const char* nB = has_next ? S.bptr(nxt) : cB;
        for (int t = 0; t < nt; t += 2) {
            const bool last = (t == nt - 2);
            const char* a1 = cA + (size_t)(t + 1) * kstep;
            const char* a2 = last ? nA : cA + (size_t)(t + 2) * kstep; const char* b2 = last ? nB : cB + (size_t)(t + 2) * kstep;
            const char* a3 = a2 + kstep; const char* b3 = b2 + kstep;
            PG8_LDB(B0, 0, 0); PG8_LDB(B1, 0, 1); PG8_SCHED; PG8_LDA(At, 0, 0); PG8_STAGE(PG8_SA(1, 1), a1 + hstepA, voffA);
            PG8_WAIT_V(8); PG8_WAIT_L(0); PG8_BAR; PG8_MMA(0, 0, At, B0); PG8_MMA(0, 1, At, B1); PG8_BAR; PG8_SCHED;
            PG8_LDA(At, 0, 1); PG8_STAGE(PG8_SB(0, 0), b2, voffB); PG8_STAGE(PG8_SB(0, 1), b2 + hstepB, voffB); PG8_STAGE(PG8_SA(0, 0), a2, voffA);
            PG8_WAIT_V(8); PG8_WAIT_L(0); PG8_BAR; PG8_MMA(1, 0, At, B0); PG8_MMA(1, 1, At, B1); PG8_BAR; PG8_SCHED;
            PG8_LDB(B0, 1, 0); PG8_LDB(B1, 1, 1); PG8_SCHED; PG8_LDA(At, 1, 0); PG8_STAGE(PG8_SA(0, 1), a2 + hstepA, voffA);
            PG8_WAIT_V(8); PG8_WAIT_L(0); PG8_BAR; PG8_MMA(0, 0, At, B0); PG8_MMA(0, 1, At, B1); PG8_BAR; PG8_SCHED;
            PG8_LDA(At, 1, 1); PG8_STAGE(PG8_SB(1, 0), b3, voffB); PG8_STAGE(PG8_SB(1, 1), b3 + hstepB, voffB); PG8_STAGE(PG8_SA(1, 0), a3, voffA);
            PG8_WAIT_V(8); PG8_WAIT_L(0); PG8_BAR; PG8_MMA(1, 0, At, B0); PG8_MMA(1, 1, At, B1); PG8_BAR; PG8_SCHED;
        }
        if (wr == 0) PG8_BAR;
        E(acc, cur, wr, wc, fr, fq);
        if (!has_next) break;
#pragma unroll
        for (int a = 0; a < 2; ++a)
#pragma unroll
            for (int b = 0; b < 2; ++b)
#pragma unroll
                for (int m = 0; m < 4; ++m)
#pragma unroll
                    for (int n = 0; n < 2; ++n) acc[a][b][m][n] = (f32x4){0.f, 0.f, 0.f, 0.f};
        cur = nxt; cA = nA; cB = nB; ++ui;
        if (wr == 1) PG8_BAR;
    }
    PG8_WAIT_V(0);
    PG8_BAR;
#undef PG8_SA
#undef PG8_SB
#undef PG8_STAGE
#undef PG8_LDA
#undef PG8_LDB
#undef PG8_MMA
#undef PG8_WAIT_V
#undef PG8_WAIT_L
#undef PG8_BAR
#undef PG8_SCHED
}

struct EpiF32 {
    static constexpr bool PERM = false;
    float* C; int ldc; const float* R; int ldr;
    __device__ __forceinline__ void operator()(const f32x4 (&acc)[2][2][4][2], const Unit& u, int wr, int wc, int fr, int fq) const {
        const int row0 = u.pm * BM + wr * 64 + fr, col0 = u.pn * BM + wc * 32 + 4 * fq;
#pragma unroll
        for (int ai = 0; ai < 2; ++ai)
#pragma unroll
            for (int m = 0; m < 4; ++m) { const size_t row = (size_t)(row0 + ai * HALF + m * 16);
#pragma unroll
                for (int bj = 0; bj < 2; ++bj)
#pragma unroll
                    for (int n = 0; n < 2; ++n) { const int col = col0 + bj * HALF + 16 * n; f32x4 v = acc[ai][bj][m][n];
                        if (R) v = v + *(const f32x4*)(R + row * ldr + col);
                        *(f32x4*)(C + row * ldc + col) = v; } }
    }
};
struct EpiBf16 {
    static constexpr bool PERM = true;
    bf16* O; int ldc;
    __device__ __forceinline__ void operator()(const f32x4 (&acc)[2][2][4][2], const Unit& u, int wr, int wc, int fr, int fq) const {
        const int row0 = u.pm * BM + wr * 64 + fr, col0 = u.pn * BM + wc * 32 + 8 * fq;
#pragma unroll
        for (int ai = 0; ai < 2; ++ai)
#pragma unroll
            for (int m = 0; m < 4; ++m) { bf16* rowp = O + (size_t)(row0 + ai * HALF + m * 16) * ldc + col0;
#pragma unroll
                for (int bj = 0; bj < 2; ++bj) { const f32x4 v0 = acc[ai][bj][m][0], v1 = acc[ai][bj][m][1];
                    u32x4 w; w.x = cvt_pk_bf16(v0[0], v0[1]); w.y = cvt_pk_bf16(v0[2], v0[3]); w.z = cvt_pk_bf16(v1[0], v1[1]); w.w = cvt_pk_bf16(v1[2], v1[3]);
                    *(u32x4*)(rowp + bj * HALF) = w; } }
    }
};
struct EpiGlu {
    static constexpr bool PERM = true;
    const bf16* Z; const float* bias; bf16* YM;
    __device__ __forceinline__ void operator()(const f32x4 (&acc)[2][2][4][2], const Unit& u, int wr, int wc, int fr, int fq) const {
        const int row0 = u.pm * BM + wr * 64 + fr, col0 = u.pn * BM + wc * 32 + 8 * fq;
#pragma unroll
        for (int ai = 0; ai < 2; ++ai)
#pragma unroll
            for (int m = 0; m < 4; ++m) { const size_t row = (size_t)(row0 + ai * HALF + m * 16);
#pragma unroll
                for (int bj = 0; bj < 2; ++bj) { const int col = col0 + bj * HALF;
                    const u32x4 zz = *(const u32x4*)(Z + row * 512 + col);
                    const f32x4 b0 = *(const f32x4*)(bias + col), b1 = *(const f32x4*)(bias + col + 4);
                    const f32x4 v0 = acc[ai][bj][m][0] + b0, v1 = acc[ai][bj][m][1] + b1;
                    float o[8]; const unsigned zw[4] = {zz.x, zz.y, zz.z, zz.w};
#pragma unroll
                    for (int q = 0; q < 4; ++q) { const float zl = __builtin_bit_cast(float, zw[q] << 16), zh = __builtin_bit_cast(float, zw[q] & 0xffff0000u);
                        const float al = (q < 2) ? v0[2 * q] : v1[2 * q - 4], ah = (q < 2) ? v0[2 * q + 1] : v1[2 * q - 3];
                        o[2 * q] = zl * sigmoidf_(al); o[2 * q + 1] = zh * sigmoidf_(ah); }
                    u32x4 w; w.x = cvt_pk_bf16(o[0], o[1]); w.y = cvt_pk_bf16(o[2], o[3]); w.z = cvt_pk_bf16(o[4], o[5]); w.w = cvt_pk_bf16(o[6], o[7]);
                    *(u32x4*)(YM + row * D + 512 + col) = w; } }
    }
};

struct MoeOrder {
    const bf16* A; const bf16* Bt; int lda, ldb, K; const int* tiles; int nunits, G, c; size_t bexp;
    __device__ void init(const bf16* A_, int lda_, const bf16* Bt_, int ldb_, int K_, const int* tiles_, int ntiles, size_t bexp_) { A = A_; Bt = Bt_; lda = lda_; ldb = ldb_; K = K_; tiles = tiles_; nunits = ntiles * 4; G = GN; c = GB; bexp = bexp_; }
    __device__ bool next(int i, Unit& u) const { const int L = i * G + c; if (L >= nunits) return false; u.pm = L >> 2; u.pn = L & 3; return true; }
    __device__ __forceinline__ const char* aptr(const Unit& u) const { return (const char*)(A + (size_t)u.pm * BM * lda); }
    __device__ __forceinline__ const char* bptr(const Unit& u) const { const int e = __hip_atomic_load(tiles + u.pm, __ATOMIC_RELAXED, __HIP_MEMORY_SCOPE_AGENT); return (const char*)(Bt + ((size_t)e * bexp + (size_t)u.pn * BM) * ldb); }
};
struct EpiSilu {
    static constexpr bool PERM = true;
    bf16* HID;
    __device__ __forceinline__ void operator()(const f32x4 (&acc)[2][2][4][2], const Unit& u, int wr, int wc, int fr, int fq) const {
        const int row0 = u.pm * BM + wr * 64 + fr, col0 = u.pn * HALF + wc * 32 + 8 * fq;
#pragma unroll
        for (int ai = 0; ai < 2; ++ai)
#pragma unroll
            for (int m = 0; m < 4; ++m) { const size_t row = (size_t)(row0 + ai * HALF + m * 16);
                float o[8];
#pragma unroll
                for (int n = 0; n < 2; ++n)
#pragma unroll
                    for (int q = 0; q < 4; ++q) { const float g = acc[ai][0][m][n][q], up = acc[ai][1][m][n][q]; o[4 * n + q] = g * sigmoidf_(g) * up; }
                u32x4 w; w.x = cvt_pk_bf16(o[0], o[1]); w.y = cvt_pk_bf16(o[2], o[3]); w.z = cvt_pk_bf16(o[4], o[5]); w.w = cvt_pk_bf16(o[6], o[7]);
                *(u32x4*)(HID + row * DEXP + col0) = w; }
    }
};
struct EpiGate {
    static constexpr bool PERM = true;
    bf16* Y; const float* gate;
    __device__ __forceinline__ void operator()(const f32x4 (&acc)[2][2][4][2], const Unit& u, int wr, int wc, int fr, int fq) const {
        const int row0 = u.pm * BM + wr * 64 + fr, col0 = u.pn * BM + wc * 32 + 8 * fq;
#pragma unroll
        for (int ai = 0; ai < 2; ++ai)
#pragma unroll
            for (int m = 0; m < 4; ++m) { const size_t row = (size_t)(row0 + ai * HALF + m * 16); const float gt = gate[row];
#pragma unroll
                for (int bj = 0; bj < 2; ++bj) { const f32x4 v0 = acc[ai][bj][m][0] * gt, v1 = acc[ai][bj][m][1] * gt;
                    u32x4 w; w.x = cvt_pk_bf16(v0[0], v0[1]); w.y = cvt_pk_bf16(v0[2], v0[3]); w.z = cvt_pk_bf16(v1[0], v1[1]); w.w = cvt_pk_bf16(v1[2], v1[3]);
                    *(u32x4*)(Y + row * D + col0 + bj * HALF) = w; } }
    }
};

struct EpiProj {
    static constexpr bool PERM = true;
    bf16* PROJ; bf16* US5;
    __device__ __forceinline__ void operator()(const f32x4 (&acc)[2][2][4][2], const Unit& u, int wr, int wc, int fr, int fq) const {
        const int row0 = u.pm * BM + wr * 64 + fr, col0 = u.pn * BM + wc * 32 + 8 * fq;
#pragma unroll
        for (int ai = 0; ai < 2; ++ai)
#pragma unroll
            for (int m = 0; m < 4; ++m) { const size_t row = (size_t)(row0 + ai * HALF + m * 16);
#pragma unroll
                for (int bj = 0; bj < 2; ++bj) { const f32x4 v0 = acc[ai][bj][m][0], v1 = acc[ai][bj][m][1]; const int col = col0 + bj * HALF;
                    u32x4 w; w.x = cvt_pk_bf16(v0[0], v0[1]); w.y = cvt_pk_bf16(v0[2], v0[3]); w.z = cvt_pk_bf16(v1[0], v1[1]); w.w = cvt_pk_bf16(v1[2], v1[3]);
                    if (col < DSHIFT) *(u32x4*)(PROJ + row * DSHIFT + col) = w;
                    else { const int cc = col - DSHIFT; *(u32x4*)(US5 + ((size_t)(cc >> 4) * M + row) * 16 + (cc & 15)) = w; } } }
    }
};
struct GroupOrder {
    const bf16* A; const bf16* Bt; int lda, ldb, K; int nM, nN, nunits, G, c; size_t sA, sB;
    __device__ void init(const bf16* A_, int lda_, size_t sA_, const bf16* Bt_, int ldb_, size_t sB_, int ngroups, int Mg, int Ng, int K_) {
        A = A_; Bt = Bt_; lda = lda_; ldb = ldb_; K = K_; sA = sA_; sB = sB_; nM = Mg / BM; nN = Ng / BM; nunits = ngroups * nM * nN; G = GN; c = GB; }
    __device__ bool next(int i, Unit& u) const { const int L = i * G + c; if (L >= nunits) return false; u.pn = L % nN; u.pm = L / nN; return true; }
    __device__ __forceinline__ const char* aptr(const Unit& u) const { const int g = u.pm / nM, pm = u.pm % nM; return (const char*)(A + (size_t)g * sA + (size_t)pm * BM * lda); }
    __device__ __forceinline__ const char* bptr(const Unit& u) const { const int g = u.pm / nM; return (const char*)(Bt + (size_t)g * sB + (size_t)u.pn * BM * ldb); }
};
struct EpiS5a {
    static constexpr bool PERM = false;
    bf16* YI; float* F;
    __device__ __forceinline__ void operator()(const f32x4 (&acc)[2][2][4][2], const Unit& u, int wr, int wc, int fr, int fq) const {
        const int row0 = u.pm * BM + wr * 64 + fr, col0 = u.pn * BM + wc * 32 + 4 * fq;
#pragma unroll
        for (int ai = 0; ai < 2; ++ai)
#pragma unroll
            for (int m = 0; m < 4; ++m) { const size_t row = (size_t)(row0 + ai * HALF + m * 16);
#pragma unroll
                for (int bj = 0; bj < 2; ++bj)
#pragma unroll
                    for (int n = 0; n < 2; ++n) { const int col = col0 + bj * HALF + 16 * n; const f32x4 v = acc[ai][bj][m][n];
                        if (col < 512) { uint2 w; w.x = cvt_pk_bf16(v[0], v[1]); w.y = cvt_pk_bf16(v[2], v[3]); *(uint2*)(YI + row * 512 + col) = w; }
                        else if (col < 640) *(f32x4*)(F + row * 128 + (col - 512)) = v; } }
    }
};
struct EpiS5b {
    static constexpr bool PERM = true;
    const bf16* YI; bf16* Z;
    __device__ __forceinline__ void operator()(const f32x4 (&acc)[2][2][4][2], const Unit& u, int wr, int wc, int fr, int fq) const {
        const int row0 = u.pm * BM + wr * 64 + fr, col0 = u.pn * BM + wc * 32 + 8 * fq;
#pragma unroll
        for (int ai = 0; ai < 2; ++ai)
#pragma unroll
            for (int m = 0; m < 4; ++m) { const int row = row0 + ai * HALF + m * 16; const int g = row / S5R, rl = row % S5R;
#pragma unroll
                for (int bj = 0; bj < 2; ++bj) { const int col = col0 + bj * HALF;
                    const u32x4 yi = *(const u32x4*)(YI + (size_t)row * 512 + col);
                    const unsigned yw[4] = {yi.x, yi.y, yi.z, yi.w};
                    const f32x4 v0 = acc[ai][bj][m][0], v1 = acc[ai][bj][m][1];
                    float o[8];
#pragma unroll
                    for (int q = 0; q < 4; ++q) { const float al = (q < 2) ? v0[2 * q] : v1[2 * q - 4], ah = (q < 2) ? v0[2 * q + 1] : v1[2 * q - 3];
                        o[2 * q] = gelu_tanh(al + __builtin_bit_cast(float, yw[q] << 16)); o[2 * q + 1] = gelu_tanh(ah + __builtin_bit_cast(float, yw[q] & 0xffff0000u)); }
                    u32x4 w; w.x = cvt_pk_bf16(o[0], o[1]); w.y = cvt_pk_bf16(o[2], o[3]); w.z = cvt_pk_bf16(o[4], o[5]); w.w = cvt_pk_bf16(o[6], o[7]);
                    const size_t tok = (size_t)rl * S5L + (col >> 4);
                    *(u32x4*)(Z + tok * 512 + g * 16 + (col & 15)) = w; } }
    }
};
struct AttnOrder {
    const bf16* A; const bf16* Bt; int lda, ldb, K; int G, c; int mode;
    __device__ void init(const bf16* A_, const bf16* Bt_, int ldb_, int mode_) { A = A_; Bt = Bt_; lda = D; ldb = ldb_; K = 256; G = GN; c = GB; mode = mode_; }
    __device__ bool next(int i, Unit& u) const { const int L = i * G + c; if (L >= NB * 4 * 32) return false; u.pn = L & 3; u.pm = L >> 2; return true; }
    __device__ __forceinline__ const char* aptr(const Unit& u) const { return (const char*)(A + (size_t)u.pm * BM * D + u.pn * 256); }
    __device__ __forceinline__ const char* bptr(const Unit& u) const { const int b = u.pm >> 5;
        return (const char*)(mode == 0 ? Bt + (size_t)b * 256 * ldb + u.pn * 256 : Bt + (size_t)u.pn * 256 * ldb + b * 256); }
};
struct EpiSoftmax {
    static constexpr bool PERM = true;
    bf16* P; PG8_LAS float* scr;
    __device__ __forceinline__ void operator()(f32x4 (&acc)[2][2][4][2], const Unit& u, int wr, int wc, int fr, int fq) const {
        const float SC = 0.0625f * 1.4426950408889634f;
        PG8_LAS float* smax = scr; PG8_LAS float* ssum = scr + 1024;
#pragma unroll
        for (int ai = 0; ai < 2; ++ai)
#pragma unroll
            for (int m = 0; m < 4; ++m) { float t = -3.0e38f;
#pragma unroll
                for (int bj = 0; bj < 2; ++bj)
#pragma unroll
                    for (int n = 0; n < 2; ++n) { const f32x4 v = acc[ai][bj][m][n]; t = fmaxf(t, fmaxf(fmaxf(v[0], v[1]), fmaxf(v[2], v[3]))); }
                t = fmaxf(t, __shfl_xor(t, 16)); t = fmaxf(t, __shfl_xor(t, 32));
                if (fq == 0) smax[(ai * HALF + wr * 64 + m * 16 + fr) * 4 + wc] = t; }
        asm volatile("s_waitcnt lgkmcnt(0)" ::: "memory"); __builtin_amdgcn_s_barrier(); asm volatile("" ::: "memory");
#pragma unroll
        for (int ai = 0; ai < 2; ++ai)
#pragma unroll
            for (int m = 0; m < 4; ++m) { const f32x4 q = *(const PG8_LAS f32x4*)(smax + (ai * HALF + wr * 64 + m * 16 + fr) * 4);
                const float mm = fmaxf(fmaxf(q[0], q[1]), fmaxf(q[2], q[3])) * SC; float s = 0.f;
#pragma unroll
                for (int bj = 0; bj < 2; ++bj)
#pragma unroll
                    for (int n = 0; n < 2; ++n)
#pragma unroll
                        for (int e = 0; e < 4; ++e) { const float p = __builtin_amdgcn_exp2f(acc[ai][bj][m][n][e] * SC - mm); acc[ai][bj][m][n][e] = p; s += p; }
                s += __shfl_xor(s, 16); s += __shfl_xor(s, 32);
                if (fq == 0) ssum[(ai * HALF + wr * 64 + m * 16 + fr) * 4 + wc] = s; }
        asm volatile("s_waitcnt lgkmcnt(0)" ::: "memory"); __builtin_amdgcn_s_barrier(); asm volatile("" ::: "memory");
        const int row0 = u.pm * BM + wr * 64 + fr, col0 = u.pn * 256 + wc * 32 + 8 * fq;
#pragma unroll
        for (int ai = 0; ai < 2; ++ai)
#pragma unroll
            for (int m = 0; m < 4; ++m) { const f32x4 q = *(const PG8_LAS f32x4*)(ssum + (ai * HALF + wr * 64 + m * 16 + fr) * 4);
                const float iv = 1.f / ((q[0] + q[1]) + (q[2] + q[3]));
                bf16* rowp = P + (size_t)(row0 + ai * HALF + m * 16) * D + col0;
#pragma unroll
                for (int bj = 0; bj < 2; ++bj) { const f32x4 v0 = acc[ai][bj][m][0] * iv, v1 = acc[ai][bj][m][1] * iv; u32x4 w;
                    w.x = cvt_pk_bf16(v0[0], v0[1]); w.y = cvt_pk_bf16(v0[2], v0[3]); w.z = cvt_pk_bf16(v1[0], v1[1]); w.w = cvt_pk_bf16(v1[2], v1[3]);
                    *(u32x4*)(rowp + bj * HALF) = w; } }
    }
};
struct EpiAttnO {
    static constexpr bool PERM = true;
    bf16* O;
    __device__ __forceinline__ void operator()(const f32x4 (&acc)[2][2][4][2], const Unit& u, int wr, int wc, int fr, int fq) const {
        const int row0 = u.pm * BM + wr * 64 + fr, col0 = u.pn * 256 + wc * 32 + 8 * fq;
#pragma unroll
        for (int ai = 0; ai < 2; ++ai)
#pragma unroll
            for (int m = 0; m < 4; ++m) { bf16* rowp = O + (size_t)(row0 + ai * HALF + m * 16) * D + col0;
#pragma unroll
                for (int bj = 0; bj < 2; ++bj) { const f32x4 v0 = acc[ai][bj][m][0], v1 = acc[ai][bj][m][1];
                    u32x4 w; w.x = cvt_pk_bf16(v0[0], v0[1]); w.y = cvt_pk_bf16(v0[2], v0[3]); w.z = cvt_pk_bf16(v1[0], v1[1]); w.w = cvt_pk_bf16(v1[2], v1[3]);
                    *(u32x4*)(rowp + bj * HALF) = w; } }
    }
};

struct EpiLora {
    static constexpr bool PERM = true;
    bf16* LW; size_t ostride; const float* w0; const float* a0;
    __device__ __forceinline__ void operator()(const f32x4 (&acc)[2][2][4][2], const Unit& u, int wr, int wc, int fr, int fq) const {
        const int row0 = u.pm * BM + wr * 64 + fr, col0 = u.pn * BM + wc * 32 + 8 * fq;
        const int kind = u.pn >> 1;
        bf16* O = LW + (size_t)kind * ostride;
#pragma unroll
        for (int bj = 0; bj < 2; ++bj) { const int col = (col0 + bj * HALF) & 511;
            f32x4 b0 = (f32x4){0.f, 0.f, 0.f, 0.f}, b1 = b0;
            if (kind == 0) { b0 = *(const f32x4*)(w0 + col); b1 = *(const f32x4*)(w0 + col + 4); }
            else if (kind == 1) { b0 = *(const f32x4*)(a0 + col); b1 = *(const f32x4*)(a0 + col + 4); }
#pragma unroll
            for (int ai = 0; ai < 2; ++ai)
#pragma unroll
                for (int m = 0; m < 4; ++m) { const size_t row = (size_t)(row0 + ai * HALF + m * 16);
                    const f32x4 v0 = acc[ai][bj][m][0] + b0, v1 = acc[ai][bj][m][1] + b1; float o[8];
#pragma unroll
                    for (int e = 0; e < 8; ++e) { float x = (e < 4) ? v0[e & 3] : v1[e & 3];
                        if (kind == 0) { const float nd = -x; const float sp = fmaxf(nd, 0.f) + __logf(1.f + __expf(-fabsf(nd))); x = -__expf(-sp - 0.5f); }
                        else if (kind == 1) x = sigmoidf_(x);
                        o[e] = x; }
                    u32x4 w; w.x = cvt_pk_bf16(o[0], o[1]); w.y = cvt_pk_bf16(o[2], o[3]); w.z = cvt_pk_bf16(o[4], o[5]); w.w = cvt_pk_bf16(o[6], o[7]);
                    *(u32x4*)(O + row * 512 + col) = w; } }
    }
};
}

#define LAS __attribute__((address_space(3)))
__device__ __forceinline__ void transpose_item(const float* __restrict__ W, int K, int N, bf16* __restrict__ WT, int ldt, int row_off, int col_off, float* scr, int item, int lane, const float* __restrict__ kscale, int ldw = 0) {
    if (ldw == 0) ldw = N;
    const int nblk = N / 32, kb = item / nblk, nb = item % nblk, k0 = 64 * kb, n0 = 32 * nb;
#pragma unroll 8
    for (int i = 0; i < 32; ++i) { const int kk = 2 * i + (lane >> 5); float v = W[(size_t)(k0 + kk) * ldw + n0 + (lane & 31)]; if (kscale) v *= kscale[k0 + kk]; scr[kk * 33 + (lane & 31)] = v; }
    __builtin_amdgcn_s_waitcnt(0xc07f); asm volatile("" ::: "memory");
    const int c = lane & 7;
#pragma unroll
    for (int j = 0; j < 4; ++j) { const int n = (lane >> 3) + 8 * j; const float* s = scr + (8 * c) * 33 + n;
        uint4 o; o.x = pk2(s[0 * 33], s[1 * 33]); o.y = pk2(s[2 * 33], s[3 * 33]); o.z = pk2(s[4 * 33], s[5 * 33]); o.w = pk2(s[6 * 33], s[7 * 33]);
        *(uint4*)(WT + (size_t)(row_off + n0 + n) * ldt + col_off + k0 + 8 * c) = o; }
    __builtin_amdgcn_s_waitcnt(0xc07f); asm volatile("" ::: "memory");
}
__device__ __forceinline__ void transpose_ph(const int WID_, const float* W, int K, int N, bf16* WT, int ldt, int row_off, int col_off, char* lds, const float* kscale = nullptr) {
    const int lane = (WID_ * 64 + lane_id()) & 63, wv = (WID_ * 64 + lane_id()) >> 6;
    float* scr = (float*)(lds + wv * 16384);
    const int nitems = (K / 64) * (N / 32);
    for (int it = GB * 8 + wv; it < nitems; it += GN * 8) transpose_item(W, K, N, WT, ldt, row_off, col_off, scr, it, lane, kscale);
}

template <typename TO>
__device__ __forceinline__ void rmsnorm_ph(const int WID_, const float* __restrict__ x, const float* __restrict__ w, TO* __restrict__ out, int rows) {
    const int lane = lane_id(), wv = WID_;
    float4 g[4];
#pragma unroll
    for (int j = 0; j < 4; ++j) g[j] = *(const float4*)(w + (lane + 64 * j) * 4);
    for (int row = (GB * 8 + wv) * 2; row < rows; row += GN * 16) {
        const float4* xr = (const float4*)(x + (size_t)row * D);
        float4 v[2][4]; float s[2] = {0.f, 0.f};
#pragma unroll
        for (int r = 0; r < 2; ++r)
#pragma unroll
            for (int j = 0; j < 4; ++j) v[r][j] = xr[r * (D / 4) + lane + 64 * j];
#pragma unroll
        for (int r = 0; r < 2; ++r) {
#pragma unroll
            for (int j = 0; j < 4; ++j) s[r] += v[r][j].x * v[r][j].x + v[r][j].y * v[r][j].y + v[r][j].z * v[r][j].z + v[r][j].w * v[r][j].w;
            s[r] = wave_sum(s[r]);
            const float rs = rsqrtf(s[r] * (1.f / D) + 1e-6f);
#pragma unroll
            for (int j = 0; j < 4; ++j) {
                uint2 o; o.x = pk2(v[r][j].x * rs * g[j].x, v[r][j].y * rs * g[j].y); o.y = pk2(v[r][j].z * rs * g[j].z, v[r][j].w * rs * g[j].w);
                *(uint2*)(out + (size_t)(row + r) * D + (lane + 64 * j) * 4) = o;
            }
        }
    }
}

__device__ __forceinline__ void rwkv_lin_ph(const int WID_, const bf16* __restrict__ proj, const float* __restrict__ mu, bf16* __restrict__ lin) {
    const int lane = lane_id(), wv = WID_;
    const float4 m4 = *(const float4*)(mu + 1536 + 4 * lane);
    const float mm[4] = {m4.x, m4.y, m4.z, m4.w};
    for (int m0 = (GB * 8 + wv) * 4; m0 < M; m0 += GN * 32) {
        uint2 z[4], zp[4];
#pragma unroll
        for (int i = 0; i < 4; ++i) { const int m = m0 + i; z[i] = *(const uint2*)(proj + (size_t)m * DSHIFT + 1536 + 4 * lane);
            zp[i] = make_uint2(0, 0); if ((m & (S - 1)) != 0) zp[i] = *(const uint2*)(proj + (size_t)(m - 1) * DSHIFT + 1536 + 4 * lane); }
#pragma unroll
        for (int i = 0; i < 4; ++i) {
            float c[4] = {__builtin_bit_cast(float, z[i].x << 16), __builtin_bit_cast(float, z[i].x & 0xffff0000u), __builtin_bit_cast(float, z[i].y << 16), __builtin_bit_cast(float, z[i].y & 0xffff0000u)};
            const float q[4] = {__builtin_bit_cast(float, zp[i].x << 16), __builtin_bit_cast(float, zp[i].x & 0xffff0000u), __builtin_bit_cast(float, zp[i].y << 16), __builtin_bit_cast(float, zp[i].y & 0xffff0000u)};
#pragma unroll
            for (int e = 0; e < 4; ++e) { float t = c[e] + (q[e] - c[e]) * mm[e];
                if (lane < 16) t = 1.f - 2.f / (1.f + __expf(2.f * t));
                else if (lane >= 32) t = sigmoidf_(t);
                c[e] = t; }
            uint2 o; o.x = pk2(c[0], c[1]); o.y = pk2(c[2], c[3]);
            *(uint2*)(lin + (size_t)(m0 + i) * 256 + 4 * lane) = o;
        }
    }
}
__device__ __forceinline__ void rwkv_wl_ph(const int WID_, const float* __restrict__ wdec, const float* __restrict__ wiclr, const float* __restrict__ wgate, bf16* __restrict__ wl) {
    for (int i = GB * NT + (WID_ * 64 + lane_id()); i < 1536 * 256; i += GN * NT) {
        const int k = i & 255, n = i >> 8; float v = 0.f;
        if (n < 512) { if (k < 64) v = wdec[k * 512 + n]; }
        else if (n < 1024) { if (k >= 64 && k < 128) v = wiclr[(k - 64) * 512 + (n - 512)]; }
        else { if (k >= 128) v = wgate[(k - 128) * 512 + (n - 1024)]; }
        wl[i] = f2bf(v);
    }
}
struct RwkvIn { const bf16* proj; const bf16* LW; const bf16* AA; const float* mu; const float* k_k; const float* k_a; const float* r_k; float* Y; float* RK; };
constexpr int TB = 64;
constexpr int RW_ITEMS = NB * 8;
template <int CTRL> __device__ __forceinline__ float dpp16(float x) { return __builtin_bit_cast(float, __builtin_amdgcn_update_dpp(0, __builtin_bit_cast(int, x), CTRL, 0xf, 0xf, true)); }
__device__ __forceinline__ void rwkv_scan_ph(const int WID_, const RwkvIn& I, char* lds) {
    float* Rs = (float*)lds; float* Ws = Rs + TB * 64; float* Kps = Ws + TB * 64; float* KKs = Kps + TB * 64; float* Bs = KKs + TB * 64; float* Vs = Bs + TB * 64; float* Ys = Vs + TB * 64;
    const int lane = (WID_ * 64 + lane_id()) & 63, wv = (WID_ * 64 + lane_id()) >> 6;
    for (int item = GB; item < RW_ITEMS; item += GN) {
        const int half = item & 1, h = (item >> 1) & 7, b = item >> 4;
        const int j = lane & 15, rl = 4 * wv + (lane >> 4), row = 32 * half + rl;
        float s0 = 0.f, s1 = 0.f, s2 = 0.f, s3 = 0.f, sa = 0.f;
        const int tau = (WID_ * 64 + lane_id()) >> 3, cg = (WID_ * 64 + lane_id()) & 7, ch0 = h * 64 + cg * 8;
        uint4 gr, gk, gv, qr, qk, qv, ga, gl;
#define RW_ISSUE(blk) do { const int t_ = (blk) * TB + tau; const size_t m_ = (size_t)b * S + t_; const bf16* z_ = I.proj + m_ * DSHIFT + ch0; \
            gr = *(const uint4*)(z_); gk = *(const uint4*)(z_ + 512); gv = *(const uint4*)(z_ + 1024); \
            if (t_ > 0) { qr = *(const uint4*)(z_ - DSHIFT); qk = *(const uint4*)(z_ + 512 - DSHIFT); qv = *(const uint4*)(z_ + 1024 - DSHIFT); } \
            else { qr = make_uint4(0, 0, 0, 0); qk = qr; qv = qr; } \
            ga = *(const uint4*)(I.AA + m_ * 512 + ch0); gl = *(const uint4*)(I.LW + m_ * 512 + ch0); } while (0)
#define RW_COMMIT(blk) do { \
            const unsigned wr_[4] = {gr.x, gr.y, gr.z, gr.w}, wk_[4] = {gk.x, gk.y, gk.z, gk.w}, wv_[4] = {gv.x, gv.y, gv.z, gv.w}; \
            const unsigned pr_[4] = {qr.x, qr.y, qr.z, qr.w}, pk_[4] = {qk.x, qk.y, qk.z, qk.w}, pv_[4] = {qv.x, qv.y, qv.z, qv.w}; \
            const unsigned wa_[4] = {ga.x, ga.y, ga.z, ga.w}, wl_[4] = {gl.x, gl.y, gl.z, gl.w}; \
            float r_[8], k_[8], v_[8], a_[8], kk_[8], ss_ = 0.f, rk_ = 0.f; \
            _Pragma("unroll") for (int e = 0; e < 8; ++e) { const int w_ = e >> 1; const bool hi_ = e & 1; \
                auto ex = [&](unsigned u) { return hi_ ? __builtin_bit_cast(float, u & 0xffff0000u) : __builtin_bit_cast(float, u << 16); }; \
                const float mr_ = I.mu[ch0 + e], mk_ = I.mu[512 + ch0 + e], mv_ = I.mu[1024 + ch0 + e]; \
                float x = ex(wr_[w_]); r_[e] = x + (ex(pr_[w_]) - x) * mr_; x = ex(wk_[w_]); k_[e] = x + (ex(pk_[w_]) - x) * mk_; x = ex(wv_[w_]); v_[e] = x + (ex(pv_[w_]) - x) * mv_; \
                a_[e] = ex(wa_[w_]); kk_[e] = k_[e] * I.k_k[ch0 + e]; ss_ += kk_[e] * kk_[e]; } \
            ss_ += dpp16<0xB1>(ss_); ss_ += dpp16<0x4E>(ss_); ss_ += dpp16<0x141>(ss_); \
            const float inv_ = 1.f / fmaxf(sqrtf(ss_), 1e-12f); \
            float o_[6][8]; \
            _Pragma("unroll") for (int e = 0; e < 8; ++e) { const int w_ = e >> 1; const bool hi_ = e & 1; \
                const float lw_ = hi_ ? __builtin_bit_cast(float, wl_[w_] & 0xffff0000u) : __builtin_bit_cast(float, wl_[w_] << 16); \
                const float kp_ = k_[e] * (1.f + (a_[e] - 1.f) * I.k_a[ch0 + e]); const float kn_ = kk_[e] * inv_; \
                o_[0][e] = r_[e]; o_[1][e] = __expf(lw_); o_[2][e] = kp_; o_[3][e] = kn_; o_[4][e] = kn_ * a_[e]; o_[5][e] = v_[e]; rk_ += r_[e] * kp_ * I.r_k[ch0 + e]; } \
            _Pragma("unroll") for (int q_ = 0; q_ < 6; ++q_) { float* d_ = Rs + q_ * (TB * 64) + tau * 64 + cg * 8; \
                *(float4*)d_ = make_float4(o_[q_][0], o_[q_][1], o_[q_][2], o_[q_][3]); *(float4*)(d_ + 4) = make_float4(o_[q_][4], o_[q_][5], o_[q_][6], o_[q_][7]); } \
            if (half == 0) { rk_ += dpp16<0xB1>(rk_); rk_ += dpp16<0x4E>(rk_); rk_ += dpp16<0x141>(rk_); \
                if (cg == 0) I.RK[((size_t)b * S + (blk) * TB + tau) * 8 + h] = rk_; } } while (0)
        RW_ISSUE(0);
        __syncthreads();
        RW_COMMIT(0);
        __syncthreads();
        for (int blk = 0; blk < S / TB; ++blk) {
            if (blk + 1 < S / TB) RW_ISSUE(blk + 1);
            float4 r4 = *(const float4*)(Rs + 4 * j), w4 = *(const float4*)(Ws + 4 * j), k4 = *(const float4*)(Kps + 4 * j), b4 = *(const float4*)(Bs + 4 * j);
            float vv = Vs[row];
            if (blk == 0) sa = 0.f;
#pragma unroll 2
            for (int t = 0; t < TB; ++t) {
                const int tn = (t + 1 < TB) ? t + 1 : t;
                const float4 n4n = *(const float4*)(KKs + tn * 64 + 4 * j);
                const float4 r4n = *(const float4*)(Rs + tn * 64 + 4 * j), w4n = *(const float4*)(Ws + tn * 64 + 4 * j), k4n = *(const float4*)(Kps + tn * 64 + 4 * j), b4n = *(const float4*)(Bs + tn * 64 + 4 * j);
                const float vvn = Vs[tn * 64 + row];
                s0 = s0 * w4.x + (sa * b4.x + vv * k4.x);
                s1 = s1 * w4.y + (sa * b4.y + vv * k4.y);
                s2 = s2 * w4.z + (sa * b4.z + vv * k4.z);
                s3 = s3 * w4.w + (sa * b4.w + vv * k4.w);
                float py = (s0 * r4.x + s1 * r4.y) + (s2 * r4.z + s3 * r4.w);
                float ps = (s0 * n4n.x + s1 * n4n.y) + (s2 * n4n.z + s3 * n4n.w);
                py += dpp16<0xB1>(py); ps += dpp16<0xB1>(ps);
                py += dpp16<0x4E>(py); ps += dpp16<0x4E>(ps);
                py += dpp16<0x141>(py); ps += dpp16<0x141>(ps);
                py += dpp16<0x140>(py); ps += dpp16<0x140>(ps);
                if (j == 0) Ys[t * 32 + rl] = py;
                if (t + 1 < TB) sa = -ps;
                r4 = r4n; w4 = w4n; k4 = k4n; b4 = b4n; vv = vvn;
            }
            __syncthreads();
            { const int t = (WID_ * 64 + lane_id()) >> 3, r0 = ((WID_ * 64 + lane_id()) & 7) * 4; const size_t m = (size_t)b * S + blk * TB + t;
              *(float4*)(I.Y + m * 512 + h * 64 + 32 * half + r0) = *(const float4*)(Ys + t * 32 + r0); }
            if (blk + 1 < S / TB) RW_COMMIT(blk + 1);
            __syncthreads();
            if (blk + 1 < S / TB) { const float4 n4 = *(const float4*)(KKs + 4 * j);
                float ps = (s0 * n4.x + s1 * n4.y) + (s2 * n4.z + s3 * n4.w);
                ps += dpp16<0xB1>(ps); ps += dpp16<0x4E>(ps); ps += dpp16<0x141>(ps); ps += dpp16<0x140>(ps);
                sa = -ps; }
        }
    }
}

namespace ck {
typedef float f32x2_t __attribute__((ext_vector_type(2)));
typedef __bf16 bf16x2_t __attribute__((ext_vector_type(2)));
__device__ __forceinline__ unsigned cvtpk(float lo, float hi) { const f32x2_t v = {lo, hi}; const bf16x2_t b = __builtin_convertvector(v, bf16x2_t); return __builtin_bit_cast(unsigned, b); }
typedef short bf16x8 __attribute__((ext_vector_type(8)));
typedef float f32x16 __attribute__((ext_vector_type(16)));
constexpr int LD = 72;
constexpr int MB = 64 * LD * 2;
constexpr int O_AB = 0, O_RB = MB, O_BB = 2 * MB, O_KB = 3 * MB, O_AT = 4 * MB, O_W1T = 5 * MB, O_BT = 6 * MB, O_KT = 7 * MB, O_VT = 8 * MB,
              O_NM = 9 * MB, O_AAK = 10 * MB, O_ARB = 11 * MB, O_ARK = 12 * MB, O_G = 13 * MB, O_TOT = O_G + 16384;
constexpr int O_TM = O_AB, O_X1T = O_BB, O_NMF = O_G, O_TT = O_G + 8192, O_ZT = O_TT + 5120;
constexpr int ITEM_BYTES = 32768;
template <typename PA, typename PB>
__device__ __forceinline__ f32x16 mm_tile(f32x16 acc, PA A, int lda, PB B, int ldb, int K, int lane) {
    const int r = lane & 31, h = lane >> 5;
    for (int ks = 0; ks < K; ks += 16) {
        const bf16x8 a = *(const bf16x8*)(A + r * lda + ks + 8 * h);
        const bf16x8 b = *(const bf16x8*)(B + r * ldb + ks + 8 * h);
        acc = __builtin_amdgcn_mfma_f32_32x32x16_bf16(a, b, acc, 0, 0, 0);
    }
    return acc;
}
__device__ __forceinline__ int crow(int reg, int h) { return (reg & 3) + 8 * (reg >> 2) + 4 * h; }
__device__ __forceinline__ void store_tr(const f32x16& acc, bf16* Ct, int ldct, int lane) {
    const int c = lane & 31, h = lane >> 5;
#pragma unroll
    for (int g = 0; g < 4; ++g) { uint2 w; w.x = cvtpk(acc[4 * g], acc[4 * g + 1]); w.y = cvtpk(acc[4 * g + 2], acc[4 * g + 3]); *(uint2*)(Ct + c * ldct + 8 * g + 4 * h) = w; }
}
__device__ __forceinline__ void store_rm(const f32x16& acc, bf16* C, int ldc, int lane) {
    const int c = lane & 31, h = lane >> 5;
#pragma unroll
    for (int rg = 0; rg < 16; ++rg) C[crow(rg, h) * ldc + c] = f2bf(acc[rg]);
}
__device__ __forceinline__ f32x16 zero16() { return (f32x16){0.f, 0.f, 0.f, 0.f, 0.f, 0.f, 0.f, 0.f, 0.f, 0.f, 0.f, 0.f, 0.f, 0.f, 0.f, 0.f}; }
struct In { const bf16* proj; const bf16* LW; const bf16* AA; const float* mu; const float* k_k; const float* k_a; const float* r_k; float* RK; char* items; };

__device__ __forceinline__ void phase1(const int WID_, const In& I, char* lds) {
    const int wv = WID_;
#define MAT(off) ((bf16*)(lds + (off)))
    float* G = (float*)(lds + O_G); float* TOT = (float*)(lds + O_TOT); float* NMF = (float*)(lds + O_NMF);
    for (int item = GB; item < NB * 8 * (S / 64); item += GN) {
        const int lane = lane_id(), tid = wv * 64 + lane;
        const int c = item & 127, h = (item >> 7) & 7, b = item >> 10;
        char* out = I.items + (size_t)item * ITEM_BYTES;
        const int s = tid >> 3, cg = tid & 7, ch0 = h * 64 + cg * 8, t = c * 64 + s; const size_t m = (size_t)b * S + t;
        float r_[8], kp_[8], v_[8], kk_[8], b_[8];
        {
            const bf16* z = I.proj + m * DSHIFT + ch0;
            const uint4 gr = *(const uint4*)(z), gk = *(const uint4*)(z + 512), gv = *(const uint4*)(z + 1024);
            uint4 qr = make_uint4(0, 0, 0, 0), qk = qr, qv = qr;
            if (t > 0) { qr = *(const uint4*)(z - DSHIFT); qk = *(const uint4*)(z + 512 - DSHIFT); qv = *(const uint4*)(z + 1024 - DSHIFT); }
            const uint4 ga = *(const uint4*)(I.AA + m * 512 + ch0), gl = *(const uint4*)(I.LW + m * 512 + ch0);
            const unsigned wr[4] = {gr.x, gr.y, gr.z, gr.w}, wk[4] = {gk.x, gk.y, gk.z, gk.w}, wv4[4] = {gv.x, gv.y, gv.z, gv.w};
            const unsigned pr[4] = {qr.x, qr.y, qr.z, qr.w}, pk[4] = {qk.x, qk.y, qk.z, qk.w}, pv[4] = {qv.x, qv.y, qv.z, qv.w};
            const unsigned wa[4] = {ga.x, ga.y, ga.z, ga.w}, wl[4] = {gl.x, gl.y, gl.z, gl.w};
            float ss = 0.f, rk = 0.f, a_[8];
#pragma unroll
            for (int e = 0; e < 8; ++e) { const int w_ = e >> 1; const bool hi = e & 1;
                auto ex = [&](unsigned u) { return hi ? __builtin_bit_cast(float, u & 0xffff0000u) : __builtin_bit_cast(float, u << 16); };
                float x = ex(wr[w_]); r_[e] = x + (ex(pr[w_]) - x) * I.mu[ch0 + e];
                x = ex(wk[w_]); const float k = x + (ex(pk[w_]) - x) * I.mu[512 + ch0 + e];
                x = ex(wv4[w_]); v_[e] = x + (ex(pv[w_]) - x) * I.mu[1024 + ch0 + e];
                a_[e] = ex(wa[w_]); kk_[e] = k * I.k_k[ch0 + e]; ss += kk_[e] * kk_[e];
                kp_[e] = k * (1.f + (a_[e] - 1.f) * I.k_a[ch0 + e]); rk += r_[e] * kp_[e] * I.r_k[ch0 + e];
                G[s * 64 + cg * 8 + e] = ex(wl[w_]); }
            ss += dpp16<0xB1>(ss); ss += dpp16<0x4E>(ss); ss += dpp16<0x141>(ss);
            const float inv = 1.f / fmaxf(sqrtf(ss), 1e-12f);
#pragma unroll
            for (int e = 0; e < 8; ++e) { kk_[e] *= inv; b_[e] = kk_[e] * a_[e]; }
            rk += dpp16<0xB1>(rk); rk += dpp16<0x4E>(rk); rk += dpp16<0x141>(rk);
            if (cg == 0) I.RK[m * 8 + h] = rk;
        }
        __syncthreads();
        { const int ch = tid & 63, part = tid >> 6; float run = 0.f;
#pragma unroll
          for (int i = 0; i < 8; ++i) { run += G[(8 * part + i) * 64 + ch]; G[(8 * part + i) * 64 + ch] = run; }
          TOT[part * 64 + ch] = run; }
        __syncthreads();
        { const int ch = tid & 63, part = tid >> 6; float off = 0.f;
          for (int p = 0; p < part; ++p) off += TOT[p * 64 + ch];
#pragma unroll
          for (int i = 0; i < 8; ++i) G[(8 * part + i) * 64 + ch] += off; }
        __syncthreads();
        float glast[8];
        {
            unsigned pab[4], prb[4], pbb[4], pkb[4];
            float ab[8], rb[8], bb[8], kb[8], bt[8], kt[8];
#pragma unroll
            for (int e = 0; e < 8; ++e) { const float g = G[s * 64 + cg * 8 + e], gm1 = (s > 0) ? G[(s - 1) * 64 + cg * 8 + e] : 0.f, gL = G[63 * 64 + cg * 8 + e];
                glast[e] = gL;
                const float eg = __expf(g), eng = __expf(-g), egm = __expf(gm1), egl = __expf(gL - g);
                ab[e] = -kk_[e] * egm; rb[e] = r_[e] * eg; bb[e] = b_[e] * eng; kb[e] = kp_[e] * eng; bt[e] = b_[e] * egl; kt[e] = kp_[e] * egl; }
#pragma unroll
            for (int q = 0; q < 4; ++q) { pab[q] = pk2(ab[2 * q], ab[2 * q + 1]); prb[q] = pk2(rb[2 * q], rb[2 * q + 1]); pbb[q] = pk2(bb[2 * q], bb[2 * q + 1]); pkb[q] = pk2(kb[2 * q], kb[2 * q + 1]); }
            *(uint4*)(MAT(O_AB) + s * LD + cg * 8) = make_uint4(pab[0], pab[1], pab[2], pab[3]);
            *(uint4*)(MAT(O_RB) + s * LD + cg * 8) = make_uint4(prb[0], prb[1], prb[2], prb[3]);
            *(uint4*)(MAT(O_BB) + s * LD + cg * 8) = make_uint4(pbb[0], pbb[1], pbb[2], pbb[3]);
            *(uint4*)(MAT(O_KB) + s * LD + cg * 8) = make_uint4(pkb[0], pkb[1], pkb[2], pkb[3]);
#pragma unroll
            for (int e = 0; e < 8; ++e) { const int k = cg * 8 + e;
                MAT(O_AT)[k * LD + s] = f2bf(ab[e]); MAT(O_BT)[k * LD + s] = f2bf(bt[e]); MAT(O_KT)[k * LD + s] = f2bf(kt[e]); MAT(O_VT)[k * LD + s] = f2bf(v_[e]); }
        }
        __syncthreads();
        if (s == 63) {
#pragma unroll
            for (int e = 0; e < 8; ++e) TOT[cg * 8 + e] = __expf(glast[e]);
        }
        {
            const int mat = tid >> 7, row = (tid >> 2) & 31, chunk = tid & 3;
            *(uint4*)(MAT(O_NM + mat * MB) + row * LD + 32 + chunk * 8) = make_uint4(0, 0, 0, 0);
        }
        for (int task = wv; task < 12; task += 8) {
            const int mat = task / 3, tt = task % 3, st = (tt == 0) ? 0 : 1, jt = (tt == 2) ? 1 : 0;
            const bf16* Asrc = MAT((mat & 1) ? O_KB : O_BB) + 32 * jt * LD;
            const bf16* Bsrc = MAT((mat >> 1) ? O_RB : O_AB) + 32 * st * LD;
            f32x16 acc = mm_tile(zero16(), Asrc, LD, Bsrc, LD, 64, lane);
            const int cs = 32 * st + (lane & 31), hh = lane >> 5; const bool incl = (mat >> 1) != 0;
#pragma unroll
            for (int rg = 0; rg < 16; ++rg) { const int j = 32 * jt + crow(rg, hh); const bool keep = incl ? (j <= cs) : (j < cs); if (!keep) acc[rg] = 0.f; }
            store_tr(acc, MAT(O_NM + mat * MB) + 32 * st * LD + 32 * jt, LD, lane);
            if (mat == 0 && st == jt) {
                float* d = NMF + st * 1024 + (lane & 31) * 32;
#pragma unroll
                for (int g = 0; g < 4; ++g) *(float4*)(d + 8 * g + 4 * hh) = make_float4(acc[4 * g], acc[4 * g + 1], acc[4 * g + 2], acc[4 * g + 3]);
            }
        }
        __syncthreads();
        if (wv == 0) {
            const int blk = lane >> 5, cc = lane & 31;
            const float* nb = NMF + blk * 1024;
            float T[32];
#pragma unroll
            for (int i = 0; i < 32; ++i) {
                float acc = (i == cc) ? 1.f : 0.f;
#pragma unroll
                for (int j4 = 0; j4 < i; j4 += 4) { const float4 n4 = *(const float4*)(nb + i * 32 + j4);
                    acc += n4.x * T[j4]; if (j4 + 1 < i) acc += n4.y * T[j4 + 1]; if (j4 + 2 < i) acc += n4.z * T[j4 + 2]; if (j4 + 3 < i) acc += n4.w * T[j4 + 3]; }
                T[i] = acc;
            }
            bf16* tm = MAT(O_TM) + (32 * blk) * LD + 32 * blk + cc;
#pragma unroll
            for (int i = 0; i < 32; ++i) tm[i * LD] = f2bf(T[i]);
            bf16* tt = MAT(O_TT) + blk * 32 * 40 + cc * 40;
#pragma unroll
            for (int q = 0; q < 4; ++q) *(uint4*)(tt + 8 * q) = make_uint4(pk2(T[8 * q], T[8 * q + 1]), pk2(T[8 * q + 2], T[8 * q + 3]), pk2(T[8 * q + 4], T[8 * q + 5]), pk2(T[8 * q + 6], T[8 * q + 7]));
        } else if (wv == 1) {
            const int row = lane >> 1, half = lane & 1;
            *(uint4*)(MAT(O_TM) + row * LD + 32 + half * 16) = make_uint4(0, 0, 0, 0); *(uint4*)(MAT(O_TM) + row * LD + 32 + half * 16 + 8) = make_uint4(0, 0, 0, 0);
        } else if (wv >= 4) {
            const int st = (wv - 4) >> 1, vt = (wv - 4) & 1;
            f32x16 acc = mm_tile(zero16(), MAT(O_AAK) + 32 * st * LD, LD, MAT(O_VT) + 32 * vt * LD, LD, 64, lane);
            store_tr(acc, MAT(O_W1T) + 32 * vt * LD + 32 * st, LD, lane);
        }
        __syncthreads();
        if (wv == 0) { f32x16 acc = mm_tile(zero16(), MAT(O_NM) + 32 * LD, LD, MAT(O_TT), 40, 32, lane); store_tr(acc, MAT(O_ZT), 40, lane); }
        __syncthreads();
        if (wv == 0) { f32x16 acc = mm_tile(zero16(), MAT(O_TM) + 32 * LD + 32, LD, MAT(O_ZT), 40, 32, lane); store_rm(acc, MAT(O_TM) + 32 * LD, LD, lane); }
        __syncthreads();
        { const int st = wv >> 2, ct = wv & 3;
          f32x16 acc = mm_tile(zero16(), MAT(O_TM) + 32 * st * LD, LD, MAT(O_AT) + 32 * ct * LD, LD, 64, lane);
          __syncthreads();
          store_tr(acc, MAT(O_X1T) + 32 * ct * LD + 32 * st, LD, lane); }
        __syncthreads();
        for (int u = wv; u < 16; u += 8) {
            const int kind = u >> 2, t0 = (u >> 1) & 1, t1 = u & 1, hh = lane >> 5, cc = lane & 31;
            if (kind == 0) {
                f32x16 acc = mm_tile(zero16(), MAT(O_BT) + 32 * t0 * LD, LD, MAT(O_X1T) + (64 + 32 * t1) * LD, LD, 64, lane);
                acc = mm_tile(acc, MAT(O_KT) + 32 * t0 * LD, LD, MAT(O_VT) + 32 * t1 * LD, LD, 64, lane);
                unsigned w[8];
#pragma unroll
                for (int q = 0; q < 8; ++q) w[q] = cvtpk(acc[2 * q], acc[2 * q + 1]);
                uint4* d = (uint4*)(out + 16384 + ((t0 * 2 + t1) * 64 + lane) * 32);
                d[0] = make_uint4(w[0], w[1], w[2], w[3]); d[1] = make_uint4(w[4], w[5], w[6], w[7]);
            } else if (kind == 1) {
                f32x16 acc = mm_tile(zero16(), MAT(O_ARB) + 32 * t0 * LD, LD, MAT(O_X1T) + (64 + 32 * t1) * LD, LD, 64, lane);
                acc = mm_tile(acc, MAT(O_ARK) + 32 * t0 * LD, LD, MAT(O_VT) + 32 * t1 * LD, LD, 64, lane);
                unsigned w[8];
#pragma unroll
                for (int q = 0; q < 8; ++q) w[q] = cvtpk(acc[2 * q], acc[2 * q + 1]);
                uint4* d = (uint4*)(out + 24576 + ((t0 * 2 + t1) * 64 + lane) * 32);
                d[0] = make_uint4(w[0], w[1], w[2], w[3]); d[1] = make_uint4(w[4], w[5], w[6], w[7]);
            } else if (kind == 2) {
                f32x16 acc = mm_tile(zero16(), MAT(O_X1T) + 32 * t0 * LD, LD, MAT(O_BT) + 32 * t1 * LD, LD, 64, lane);
                const int k = 32 * t1 + cc; const float gl = TOT[k];
                bf16* d = (bf16*)out + k * 64 + 32 * t0;
#pragma unroll
                for (int g = 0; g < 4; ++g) { float x[4];
#pragma unroll
                    for (int e = 0; e < 4; ++e) { const int kp = 32 * t0 + 8 * g + 4 * hh + e; x[e] = acc[4 * g + e] + ((kp == k) ? gl : 0.f); }
                    uint2 w; w.x = cvtpk(x[0], x[1]); w.y = cvtpk(x[2], x[3]); *(uint2*)(d + 8 * g + 4 * hh) = w; }
            } else {
                f32x16 acc = mm_tile(zero16(), MAT(O_X1T) + 32 * t0 * LD, LD, MAT(O_ARB) + 32 * t1 * LD, LD, 64, lane);
                const int sq = 32 * t1 + cc;
                bf16* d = (bf16*)(out + 8192) + sq * 64 + 32 * t0;
                const bf16* rb = MAT(O_RB) + sq * LD + 32 * t0;
#pragma unroll
                for (int g = 0; g < 4; ++g) { const uint2 rr = *(const uint2*)(rb + 8 * g + 4 * hh);
                    const float x0 = acc[4 * g] + __builtin_bit_cast(float, rr.x << 16), x1 = acc[4 * g + 1] + __builtin_bit_cast(float, rr.x & 0xffff0000u);
                    const float x2 = acc[4 * g + 2] + __builtin_bit_cast(float, rr.y << 16), x3 = acc[4 * g + 3] + __builtin_bit_cast(float, rr.y & 0xffff0000u);
                    uint2 w; w.x = cvtpk(x0, x1); w.y = cvtpk(x2, x3); *(uint2*)(d + 8 * g + 4 * hh) = w; }
            }
        }
        __syncthreads();
    }
#undef MAT
}
__device__ __forceinline__ void phase2(const int WID_, const char* items, float* Y, char* lds) {
    const int lane = lane_id(), wv = WID_, hh = lane >> 5, cc = lane & 31;
    bf16* HT0 = (bf16*)lds; bf16* HT1 = HT0 + 64 * LD;
    for (int head = GB; head < NB * 8; head += GN) {
        for (int i = wv * 64 + lane; i < 2 * 64 * LD / 8; i += NT) ((uint4*)lds)[i] = make_uint4(0, 0, 0, 0);
        __syncthreads();
        const int mi = (wv >> 1) & 1, ni = wv & 1; const bool upd = wv < 4;
        const int b = head >> 3, h = head & 7;
        for (int c = 0; c < S / 64; ++c) {
            const char* rec = items + (size_t)(head * 128 + c) * ITEM_BYTES;
            const bf16* Hc = (c & 1) ? HT1 : HT0; bf16* Hn = (c & 1) ? HT0 : HT1;
            const uint4* cin = (const uint4*)(rec + (upd ? 16384 : 24576) + ((mi * 2 + ni) * 64 + lane) * 32);
            const uint4 c0 = cin[0], c1 = cin[1];
            const unsigned cw[8] = {c0.x, c0.y, c0.z, c0.w, c1.x, c1.y, c1.z, c1.w};
            f32x16 acc;
#pragma unroll
            for (int q = 0; q < 8; ++q) { acc[2 * q] = __builtin_bit_cast(float, cw[q] << 16); acc[2 * q + 1] = __builtin_bit_cast(float, cw[q] & 0xffff0000u); }
            const bf16* A = (const bf16*)(rec + (upd ? 0 : 8192)) + 32 * mi * 64;
            acc = mm_tile(acc, A, 64, Hc + 32 * ni * LD, LD, 64, lane);
            if (upd) store_tr(acc, Hn + 32 * ni * LD + 32 * mi, LD, lane);
            else {
                float* yo = Y + ((size_t)b * S + c * 64 + 32 * mi) * 512 + h * 64 + 32 * ni + cc;
#pragma unroll
                for (int rg = 0; rg < 16; ++rg) yo[(size_t)crow(rg, hh) * 512] = acc[rg];
            }
            __syncthreads();
        }
    }
}
}

__device__ __forceinline__ void rwkv_post_ph(const int WID_, const float* __restrict__ Y, const float* __restrict__ RK, const bf16* __restrict__ proj, const float* __restrict__ mu, const bf16* __restrict__ G,
                             const float* __restrict__ lnw, const float* __restrict__ lnb, bf16* __restrict__ ymix) {
    const int c = (WID_ * 64 + lane_id());
    const float muv = mu[1024 + c], lw_ = lnw[c], lb_ = lnb[c];
    for (int m0 = GB * 4; m0 < M; m0 += GN * 4) {
        float y[4], v[4], pv[4], rk[4], g[4];
#pragma unroll
        for (int i = 0; i < 4; ++i) { const int m = m0 + i; const size_t ix = (size_t)m * 512 + c;
            y[i] = Y[ix]; v[i] = bf2f(proj[(size_t)m * DSHIFT + 1024 + c]); pv[i] = (m & (S - 1)) ? bf2f(proj[(size_t)(m - 1) * DSHIFT + 1024 + c]) : 0.f;
            rk[i] = RK[(size_t)m * 8 + (c >> 6)]; g[i] = bf2f(G[ix]); }
#pragma unroll
        for (int i = 0; i < 4; ++i) {
            const float mean = wave_sum(y[i]) * (1.f / 64.f);
            const float d = y[i] - mean;
            const float var = wave_sum(d * d) * (1.f / 64.f);
            float yn = d * rsqrtf(var + 64e-5f) * lw_ + lb_;
            const float vs = v[i] + (pv[i] - v[i]) * muv;
            yn += rk[i] * vs;
            ymix[(size_t)(m0 + i) * D + c] = f2bf(yn * g[i]);
        }
    }
}

constexpr int PSLOTS = NASSIGN + NEXP * 256;
constexpr int MAXTILES = PSLOTS / 256;
struct MoeBufs { int* tok_e; float* tok_g; int* tok_slot; int* slot_tok; float* slot_gate; int* bcnt; int* bbase; int* offs; int* tiles; int* ntiles; };
__device__ __forceinline__ void moe_zero_ph(const int WID_, const MoeBufs& mb) {
    for (int i = GB * NT + (WID_ * 64 + lane_id()); i < PSLOTS; i += GN * NT) { mb.slot_tok[i] = 0; mb.slot_gate[i] = 0.f; }
}
__device__ __forceinline__ void router_ph(const int WID_, const float* __restrict__ x3, const float* __restrict__ nw, bf16* __restrict__ h3, const float* __restrict__ wrg, const float* __restrict__ brg,
                          const float* __restrict__ wre, const float* __restrict__ bre, const MoeBufs& mb, char* lds) {
    const int lane = lane_id(), wv = WID_;
    int* lcnt = (int*)lds;
    if (wv == 0 && lane < 32) lcnt[lane] = 0;
    __syncthreads();
    for (int m = GB * 8 + wv; m < M; m += GN * 8) {
        const float4* xr = (const float4*)(x3 + (size_t)m * D);
        float h[16]; float s = 0.f;
#pragma unroll
        for (int j = 0; j < 4; ++j) { const float4 v = xr[lane + 64 * j]; h[4 * j] = v.x; h[4 * j + 1] = v.y; h[4 * j + 2] = v.z; h[4 * j + 3] = v.w; s += v.x * v.x + v.y * v.y + v.z * v.z + v.w * v.w; }
        s = wave_sum(s);
        const float rs = rsqrtf(s * (1.f / D) + 1e-6f);
        float l1[4] = {0.f, 0.f, 0.f, 0.f};
#pragma unroll
        for (int j = 0; j < 4; ++j) {
            const int k0 = (lane + 64 * j) * 4;
            const float4 g = *(const float4*)(nw + k0);
            h[4 * j] *= rs * g.x; h[4 * j + 1] *= rs * g.y; h[4 * j + 2] *= rs * g.z; h[4 * j + 3] *= rs * g.w;
            uint2 o; o.x = pk2(h[4 * j], h[4 * j + 1]); o.y = pk2(h[4 * j + 2], h[4 * j + 3]);
            *(uint2*)(h3 + (size_t)m * D + k0) = o;
#pragma unroll
            for (int e = 0; e < 4; ++e) { const float4 w = *(const float4*)(wrg + (k0 + e) * 4); const float x = h[4 * j + e]; l1[0] += x * w.x; l1[1] += x * w.y; l1[2] += x * w.z; l1[3] += x * w.w; }
        }
#pragma unroll
        for (int i = 0; i < 4; ++i) l1[i] = wave_sum(l1[i]) + brg[i];
        int grp = 0; float best = l1[0];
#pragma unroll
        for (int i = 1; i < 4; ++i) if (l1[i] > best) { best = l1[i]; grp = i; }
        float se = 0.f;
#pragma unroll
        for (int i = 0; i < 4; ++i) se += __expf(l1[i] - best);
        const float g1 = 1.f / se;
        float l2[8] = {};
        const float* we = wre + (size_t)grp * D * 8;
#pragma unroll
        for (int j = 0; j < 4; ++j) {
            const int k0 = (lane + 64 * j) * 4;
#pragma unroll
            for (int e = 0; e < 4; ++e) { const float x = h[4 * j + e]; const float4 w0 = *(const float4*)(we + (k0 + e) * 8), w1 = *(const float4*)(we + (k0 + e) * 8 + 4);
                l2[0] += x * w0.x; l2[1] += x * w0.y; l2[2] += x * w0.z; l2[3] += x * w0.w; l2[4] += x * w1.x; l2[5] += x * w1.y; l2[6] += x * w1.z; l2[7] += x * w1.w; }
        }
#pragma unroll
        for (int i = 0; i < 8; ++i) l2[i] = wave_sum(l2[i]) + bre[grp * 8 + i];
        int i0 = 0; float v0 = l2[0];
#pragma unroll
        for (int i = 1; i < 8; ++i) if (l2[i] > v0) { v0 = l2[i]; i0 = i; }
        int i1 = -1; float v1 = -3.0e38f;
#pragma unroll
        for (int i = 0; i < 8; ++i) if (i != i0 && l2[i] > v1) { v1 = l2[i]; i1 = i; }
        const float e1 = __expf(v1 - v0), inv = 1.f / (1.f + e1);
        if (lane == 0) {
            const int ea = grp * 8 + i0, eb = grp * 8 + i1;
            mb.tok_e[2 * m] = ea; mb.tok_e[2 * m + 1] = eb;
            mb.tok_g[2 * m] = g1 * inv; mb.tok_g[2 * m + 1] = g1 * e1 * inv;
            atomicAdd(&lcnt[ea], 1); atomicAdd(&lcnt[eb], 1);
        }
    }
    __syncthreads();
    if (wv == 0 && lane < 32) mb.bcnt[GB * 32 + lane] = lcnt[lane];
    __syncthreads();
}
__device__ __forceinline__ void moe_plan_ph(const int WID_, const MoeBufs& mb, char* lds) {
    if (GB != 0) return;
    int* tot = (int*)lds; int* off = tot + 32;
    const int t = WID_ * 64 + lane_id();
    if (t < 32) { int run = 0; for (int b = 0; b < GN; ++b) { const int c = __hip_atomic_load(mb.bcnt + b * 32 + t, __ATOMIC_RELAXED, __HIP_MEMORY_SCOPE_AGENT); mb.bbase[b * 32 + t] = run; run += c; } tot[t] = run; }
    __syncthreads();
    if (t == 0) { int o = 0, nt = 0;
        for (int e = 0; e < NEXP; ++e) { off[e] = o; mb.offs[e] = o; const int c = tot[e]; for (int r0 = 0; r0 < c; r0 += 256) { mb.tiles[nt] = e; ++nt; } o += ((c + 255) / 256) * 256; }
        *mb.ntiles = nt; }
    __syncthreads();
}
__device__ __forceinline__ void moe_scatter_ph(const int WID_, const MoeBufs& mb, char* lds) {
    const int lane = lane_id(), wv = WID_;
    int* cur = (int*)lds;
    if (wv == 0 && lane < 32) cur[lane] = __hip_atomic_load(mb.offs + lane, __ATOMIC_RELAXED, __HIP_MEMORY_SCOPE_AGENT) + __hip_atomic_load(mb.bbase + GB * 32 + lane, __ATOMIC_RELAXED, __HIP_MEMORY_SCOPE_AGENT);
    __syncthreads();
    for (int m0 = (GB * 8 + wv); m0 < M; m0 += GN * 8 * 32) {
        const int i = lane >> 1, m = m0 + i * GN * 8;
        if (m < M) { const int a = 2 * m + (lane & 1); const int e = mb.tok_e[a];
            const int pos = atomicAdd(&cur[e], 1);
            mb.slot_tok[pos] = m; mb.slot_gate[pos] = mb.tok_g[a]; mb.tok_slot[a] = pos; }
    }
    __syncthreads();
}
__device__ __forceinline__ void moe_gather_ph(const int WID_, const bf16* __restrict__ h3, bf16* __restrict__ xg, const MoeBufs& mb) {
    const int lane = lane_id(), wv = WID_;
    const int nrows = __hip_atomic_load(mb.ntiles, __ATOMIC_RELAXED, __HIP_MEMORY_SCOPE_AGENT) * 256;
    for (int r0 = (GB * 8 + wv) * 4; r0 < nrows; r0 += GN * 32) {
        uint4 a[4], c[4];
#pragma unroll
        for (int i = 0; i < 4; ++i) { const int t = mb.slot_tok[r0 + i]; const uint4* s = (const uint4*)(h3 + (size_t)t * D); a[i] = s[lane]; c[i] = s[lane + 64]; }
#pragma unroll
        for (int i = 0; i < 4; ++i) { uint4* d = (uint4*)(xg + (size_t)(r0 + i) * D); d[lane] = a[i]; d[lane + 64] = c[i]; }
    }
}
__device__ __forceinline__ void moe_weights_ph(const int WID_, const float* __restrict__ wg, const float* __restrict__ wu, const float* __restrict__ wd, bf16* __restrict__ wgu_t, bf16* __restrict__ wd_t, char* lds) {
    const int lane = (WID_ * 64 + lane_id()) & 63, wv = (WID_ * 64 + lane_id()) >> 6;
    float* scr = (float*)(lds + wv * 16384);
    constexpr int I_GU = 16 * 16;
    constexpr int I_D = 8 * 32;
    constexpr int NIT = NEXP * (2 * I_GU + I_D);
    for (int it = GB * 8 + wv; it < NIT; it += GN * 8) {
        const int e = it / (2 * I_GU + I_D); int r = it % (2 * I_GU + I_D);
        if (r < 2 * I_GU) {
            const int up = r / I_GU; r %= I_GU;
            const int kb = r / 16, nb = r % 16;
            const int pn = nb / 4, nsub = nb % 4;
            const float* W = (up ? wu : wg) + (size_t)e * D * DEXP + nb * 32;
            transpose_item(W + (size_t)kb * 64 * DEXP, 64, 32, wgu_t, D, e * 1024 + pn * 256 + up * 128 + nsub * 32, kb * 64, scr, 0, lane, nullptr, DEXP);
        } else {
            r -= 2 * I_GU;
            const int kb = r / 32, nb = r % 32;
            const float* W = wd + (size_t)e * DEXP * D + nb * 32;
            transpose_item(W + (size_t)kb * 64 * D, 64, 32, wd_t, DEXP, e * 1024 + nb * 32, kb * 64, scr, 0, lane, nullptr, D);
        }
    }
}
__device__ __forceinline__ void final_ph(const int WID_, float* __restrict__ out, const bf16* __restrict__ yslot, const int* __restrict__ tok_slot, const float* __restrict__ w) {
    const int lane = lane_id(), wv = WID_;
    float4 g[4];
#pragma unroll
    for (int j = 0; j < 4; ++j) g[j] = *(const float4*)(w + (lane + 64 * j) * 4);
    for (int row0 = (GB * 8 + wv) * 2; row0 < M; row0 += GN * 16) {
        float4 v[2][4]; uint2 ya[2][4], yb[2][4];
#pragma unroll
        for (int r = 0; r < 2; ++r) { const int row = row0 + r;
            const float4* xr = (const float4*)(out + (size_t)row * D);
            const uint2* pa = (const uint2*)(yslot + (size_t)tok_slot[2 * row] * D);
            const uint2* pb = (const uint2*)(yslot + (size_t)tok_slot[2 * row + 1] * D);
#pragma unroll
            for (int j = 0; j < 4; ++j) { v[r][j] = xr[lane + 64 * j]; ya[r][j] = pa[lane + 64 * j]; yb[r][j] = pb[lane + 64 * j]; } }
#pragma unroll
        for (int r = 0; r < 2; ++r) { float s = 0.f;
#pragma unroll
            for (int j = 0; j < 4; ++j) { const uint2 a = ya[r][j], b = yb[r][j];
                v[r][j].x += __builtin_bit_cast(float, a.x << 16) + __builtin_bit_cast(float, b.x << 16);
                v[r][j].y += __builtin_bit_cast(float, a.x & 0xffff0000u) + __builtin_bit_cast(float, b.x & 0xffff0000u);
                v[r][j].z += __builtin_bit_cast(float, a.y << 16) + __builtin_bit_cast(float, b.y << 16);
                v[r][j].w += __builtin_bit_cast(float, a.y & 0xffff0000u) + __builtin_bit_cast(float, b.y & 0xffff0000u);
                s += v[r][j].x * v[r][j].x + v[r][j].y * v[r][j].y + v[r][j].z * v[r][j].z + v[r][j].w * v[r][j].w; }
            s = wave_sum(s);
            const float rs = rsqrtf(s * (1.f / D) + 1e-6f);
            float4* xo = (float4*)(out + (size_t)(row0 + r) * D);
#pragma unroll
            for (int j = 0; j < 4; ++j) xo[lane + 64 * j] = make_float4(v[r][j].x * rs * g[j].x, v[r][j].y * rs * g[j].y, v[r][j].z * rs * g[j].z, v[r][j].w * rs * g[j].w); }
    }
}

struct S5Tab { float* Kmat; bf16* BtA; bf16* BtB; };
__device__ __forceinline__ void s5_lam(const float* lam_re, const float* lam_im, const float* log_dt, int g, int n, float& a, float& w) {
    const float dt = __expf(log_dt[g]); a = lam_re[g * 64 + n] * dt; w = lam_im[g * 64 + n] * dt;
}
__device__ __forceinline__ void cexpj(float a, float w, float j, float& re, float& im) { const float e = __expf(a * j); float s, c; sincosf(w * j, &s, &c); re = e * c; im = e * s; }
__device__ __forceinline__ void s5_bbar(const float* lam_re, const float* lam_im, const float* log_dt, const float* b_re, const float* b_im, int g, int n, int h, float& br, float& bi) {
    float a, w; s5_lam(lam_re, lam_im, log_dt, g, n, a, w);
    float lbr, lbi; cexpj(a, w, 1.f, lbr, lbi);
    const float lr = lam_re[g * 64 + n], li = lam_im[g * 64 + n];
    const float nr = lbr - 1.f, ni = lbi, den = lr * lr + li * li;
    const float cr = (nr * lr + ni * li) / den, ci = (ni * lr - nr * li) / den;
    const float xr = b_re[(g * 64 + n) * 16 + h], xi = b_im[(g * 64 + n) * 16 + h];
    br = cr * xr - ci * xi; bi = cr * xi + ci * xr;
}
__device__ __forceinline__ void s5_tables0_ph(const int WID_, const float* lam_re, const float* lam_im, const float* log_dt, const float* b_re, const float* b_im, const float* c_re, const float* c_im, const S5Tab& T) {
    const int gtid = GB * NT + (WID_ * 64 + lane_id()), gsz = GN * NT;
    for (int i = gtid; i < 32 * 32 * 256; i += gsz) {
        const int h = i & 15, hp = (i >> 4) & 15, j = (i >> 8) & 31, g = i >> 13;
        float acc = 0.f;
        for (int n = 0; n < 64; ++n) {
            float a, w; s5_lam(lam_re, lam_im, log_dt, g, n, a, w);
            float pr, pi; cexpj(a, w, (float)j, pr, pi);
            float br, bi; s5_bbar(lam_re, lam_im, log_dt, b_re, b_im, g, n, h, br, bi);
            const float tr = pr * br - pi * bi, ti = pr * bi + pi * br;
            acc += c_re[(g * 16 + hp) * 64 + n] * tr - c_im[(g * 16 + hp) * 64 + n] * ti;
        }
        T.Kmat[i] = acc;
    }
    for (int i = gtid; i < 32 * 256 * 512; i += gsz) {
        const int col = i & 511, r = (i >> 9) & 255, g = i >> 17;
        float v = 0.f;
        if (r < 128) {
            const int n = r & 63, s = col >> 4, h = col & 15;
            float a, w; s5_lam(lam_re, lam_im, log_dt, g, n, a, w);
            float pr, pi; cexpj(a, w, (float)(S5L - 1 - s), pr, pi);
            float br, bi; s5_bbar(lam_re, lam_im, log_dt, b_re, b_im, g, n, h, br, bi);
            v = (r < 64) ? (pr * br - pi * bi) : (pr * bi + pi * br);
        }
        T.BtA[((size_t)g * 768 + 512 + r) * 512 + col] = f2bf(v);
    }
    for (int i = gtid; i < 32 * 512 * 256; i += gsz) {
        const int k = i & 255, row = (i >> 8) & 511, g = i >> 17;
        float v = 0.f;
        if (k < 128) {
            const int n = k & 63, sp = row >> 4, hp = row & 15;
            float a, w; s5_lam(lam_re, lam_im, log_dt, g, n, a, w);
            float pr, pi; cexpj(a, w, (float)(sp + 1), pr, pi);
            const float cr = c_re[(g * 16 + hp) * 64 + n], ci = c_im[(g * 16 + hp) * 64 + n];
            v = (k < 64) ? (cr * pr - ci * pi) : -(cr * pi + ci * pr);
        }
        T.BtB[i] = f2bf(v);
    }
}
__device__ __forceinline__ void s5_tables1_ph(const int WID_, const float* dsk, const S5Tab& T) {
    const int gtid = GB * NT + (WID_ * 64 + lane_id()), gsz = GN * NT;
    for (int i = gtid; i < 32 * 512 * 512; i += gsz) {
        const int col = i & 511, row = (i >> 9) & 511, g = i >> 18;
        const int sp = row >> 4, hp = row & 15, s = col >> 4, h = col & 15;
        float v = 0.f;
        if (s <= sp) v = T.Kmat[((g * 32 + (sp - s)) * 16 + hp) * 16 + h];
        if (row == col) v += dsk[g * 16 + hp];
        T.BtA[((size_t)g * 768 + row) * 512 + col] = f2bf(v);
    }
}
__device__ __forceinline__ void s5_carry_ph(const int WID_, const float* lam_re, const float* lam_im, const float* log_dt, const float* __restrict__ F, bf16* __restrict__ XST) {
    const int gtid = GB * NT + (WID_ * 64 + lane_id()), gsz = GN * NT;
    for (int i = gtid; i < 32 * S5R * 16; i += gsz) { const int row = i >> 4, q = i & 15; *(uint4*)(XST + (size_t)row * 256 + 128 + q * 8) = make_uint4(0, 0, 0, 0); }
    const int lane = (WID_ * 64 + lane_id()) & 63, wv = (WID_ * 64 + lane_id()) >> 6;
    const int nidle = (GN > RW_ITEMS) ? GN - RW_ITEMS : GN, myi = (GN > RW_ITEMS) ? GB - RW_ITEMS : GB;
    for (int item = (myi < 0 ? NB * 32 : myi + nidle * wv); item < NB * 32; item += nidle * 8) {
        const int b = item >> 5, g = item & 31, n = lane;
        float a, w; s5_lam(lam_re, lam_im, log_dt, g, n, a, w);
        float pr, pi; cexpj(a, w, (float)S5L, pr, pi);
        float xr = 0.f, xi = 0.f;
        const size_t row0 = (size_t)g * S5R + (size_t)b * (S / S5L);
        const float* f = F + row0 * 128; bf16* xo = XST + row0 * 256;
        for (int c0 = 0; c0 < S / S5L; c0 += 8) {
            float fr[8], fi[8];
#pragma unroll
            for (int q = 0; q < 8; ++q) { fr[q] = f[(size_t)(c0 + q) * 128 + n]; fi[q] = f[(size_t)(c0 + q) * 128 + 64 + n]; }
#pragma unroll
            for (int q = 0; q < 8; ++q) {
                xo[(size_t)(c0 + q) * 256 + n] = f2bf(xr); xo[(size_t)(c0 + q) * 256 + 64 + n] = f2bf(xi);
                const float nr = pr * xr - pi * xi + fr[q], ni = pr * xi + pi * xr + fi[q];
                xr = nr; xi = ni;
            }
        }
    }
}

#define XB_TMO      128
#define XB_XCNT(j)  (256  + 64 * (j))
#define XB_XSUB(j)  (1280 + 64 * (j))
#define XB_XGEN(j)  (2304 + 64 * (j))
#define XB_TOP      3328
#define XB_TOPGEN   3392
#define XCD_BAR_WORDS 3456
#define XB_SPIN_CAP (1u << 20)
__device__ __forceinline__ unsigned xb_ld(unsigned* p)              { return __hip_atomic_load(p, __ATOMIC_RELAXED, __HIP_MEMORY_SCOPE_AGENT); }
__device__ __forceinline__ unsigned xb_add(unsigned* p, unsigned v) { return __hip_atomic_fetch_add(p, v, __ATOMIC_RELAXED, __HIP_MEMORY_SCOPE_AGENT); }
__device__ __forceinline__ unsigned xb_xcc_id() { return (unsigned)__builtin_amdgcn_s_getreg((3 << 11) | 20) & 0xFu; }
#define XB_SPIN(cond, bar) do { unsigned _sp = 0; while (cond) { __builtin_amdgcn_s_sleep(1); \
    if ((++_sp & 255u) == 0u) { if (xb_ld(&(bar)[XB_TMO])) break; if (_sp > XB_SPIN_CAP) { atomicAdd(&(bar)[XB_TMO], 1u); break; } } } } while (0)
struct XcdBarrier { unsigned* bar; unsigned x; volatile __attribute__((address_space(3))) unsigned* st; };
__device__ __forceinline__ XcdBarrier xcd_barrier_post(const int WID_, unsigned* bar, volatile __attribute__((address_space(3))) unsigned* st) {
    XcdBarrier b; b.bar = bar; b.x = xb_xcc_id(); b.st = st;
    if ((WID_ * 64 + lane_id()) == 0) (void)xb_add(&bar[XB_XCNT(b.x)], 1u);
    return b;
}
__device__ __forceinline__ void xcd_barrier_complete(unsigned* bar, unsigned x, unsigned& nloc, unsigned& nx) {
    const unsigned G = gridDim.x * gridDim.y * gridDim.z;
    unsigned sum, cnt, mine, sp = 0u;
    for (;;) {
        sum = 0u; cnt = 0u; mine = 0u;
#pragma unroll
        for (unsigned j = 0; j < 16; ++j) { const unsigned c = xb_ld(&bar[XB_XCNT(j)]); sum += c; cnt += (c > 0u) ? 1u : 0u; mine = (j == x) ? c : mine; }
        if (sum == G) break;
        __builtin_amdgcn_s_sleep(1);
        if ((++sp & 255u) == 0u) { if (xb_ld(&bar[XB_TMO])) break; if (sp > XB_SPIN_CAP) { atomicAdd(&bar[XB_TMO], 1u); break; } }
    }
    nloc = mine > 0u ? mine : 1u; nx = cnt > 0u ? cnt : 1u;
}
__device__ __forceinline__ void xcd_barrier(const int WID_, const XcdBarrier& b) {
    asm volatile("s_waitcnt vmcnt(0)" ::: "memory");
    __syncthreads();
    if ((WID_ * 64 + lane_id()) == 0) {
        unsigned* bar = b.bar;
        __builtin_amdgcn_s_waitcnt(0);
        unsigned nloc = b.st[0], nx = b.st[1];
        if (nloc == 0u) { xcd_barrier_complete(bar, b.x, nloc, nx); b.st[0] = nloc; b.st[1] = nx; }
        const unsigned old = xb_add(&bar[XB_XSUB(b.x)], 1u);
        const unsigned gen = old / nloc;
        if (old + 1u == (gen + 1u) * nloc) {
            __builtin_amdgcn_fence(__ATOMIC_RELEASE, "agent");
            asm volatile("s_waitcnt vmcnt(0)" ::: "memory");
            const unsigned og = xb_add(&bar[XB_TOP], 1u);
            const unsigned tg = og / nx;
            if (og + 1u == (tg + 1u) * nx) xb_add(&bar[XB_TOPGEN], 1u);
            else XB_SPIN(xb_ld(&bar[XB_TOPGEN]) == tg, bar);
            __builtin_amdgcn_fence(__ATOMIC_ACQUIRE, "agent");
            xb_add(&bar[XB_XGEN(b.x)], 1u);
            asm volatile("s_waitcnt vmcnt(0)" ::: "memory");
        } else {
            XB_SPIN(xb_ld(&bar[XB_XGEN(b.x)]) == gen, bar);
            __builtin_amdgcn_fence(__ATOMIC_ACQUIRE, "agent");
            asm volatile("s_waitcnt vmcnt(0)" ::: "memory");
        }
    }
    __syncthreads();
}

struct Params { const float* in[41]; float* out; char* ws; };

constexpr size_t W_PROJ = 0;
constexpr size_t W_US5 = 224;
constexpr size_t W_WTS = 288;
constexpr size_t W_YI = 352;
constexpr size_t W_F = 416;
constexpr size_t W_XST = 448;
constexpr size_t W_Z = 480;
constexpr size_t W_MISC = 544;
constexpr size_t W_XN = 576;
constexpr size_t W_CTL = 558;
constexpr size_t WO_IN = 0, WO_GLU = 5 * MiB, WO_MIX = 6 * MiB, WO_Q = 8 * MiB, WO_K = 10 * MiB, WO_V = 12 * MiB, WO_O = 14 * MiB, WO_KMAT = 16 * MiB, WO_BTA = 17 * MiB, WO_BTB = 41 * MiB;

__global__ void __launch_bounds__(NT, 2) fwd_kernel(Params p) {
    extern __shared__ __attribute__((aligned(16))) char lds[];
    const int WID_ = __builtin_amdgcn_readfirstlane((int)(threadIdx.x >> 6));
    cg::grid_group grid = cg::this_grid();
    PG8_LAS unsigned char* ldsl = (PG8_LAS unsigned char*)lds;
    char* ws = p.ws; char* dout = (char*)p.out; float* out = p.out;
#define IN(i) (p.in[i])
    volatile __attribute__((address_space(3))) unsigned* bst = (volatile __attribute__((address_space(3))) unsigned*)(ldsl + LDS_BYTES - 64);
    if (WID_ == 0 && lane_id() < 2) bst[lane_id()] = 0u;
    __syncthreads();
    const XcdBarrier xbar = xcd_barrier_post(WID_, (unsigned*)(ws + W_CTL * MiB), bst);
#define SYNC() xcd_barrier(WID_, xbar)
    char* WT = ws + W_WTS * MiB;
    bf16* w_in_t = (bf16*)(WT + WO_IN); bf16* w_glu_t = (bf16*)(WT + WO_GLU); bf16* w_mix_t = (bf16*)(WT + WO_MIX);
    bf16* w_q_t = (bf16*)(WT + WO_Q); bf16* w_k_t = (bf16*)(WT + WO_K); bf16* w_v_t = (bf16*)(WT + WO_V); bf16* w_o_t = (bf16*)(WT + WO_O);
    S5Tab stab; stab.Kmat = (float*)(WT + WO_KMAT); stab.BtA = (bf16*)(WT + WO_BTA); stab.BtB = (bf16*)(WT + WO_BTB);
    bf16* PROJ = (bf16*)(ws + W_PROJ * MiB); bf16* US5 = (bf16*)(ws + W_US5 * MiB);
    bf16* XN = (bf16*)(ws + W_XN * MiB);
    transpose_ph(WID_, IN(3), D, DIN, w_in_t, D, 0, 0, lds);
    transpose_ph(WID_, IN(23), 512, 512, w_glu_t, 512, 0, 0, lds);
    transpose_ph(WID_, IN(25), D, D, w_mix_t, D, 0, 0, lds);
    transpose_ph(WID_, IN(28), D, D, w_q_t, D, 0, 0, lds);
    transpose_ph(WID_, IN(29), D, D, w_k_t, D, 0, 0, lds);
    transpose_ph(WID_, IN(30), D, D, w_v_t, D, 0, 0, lds);
    transpose_ph(WID_, IN(31), D, D, w_o_t, D, 0, 0, lds);
    s5_tables0_ph(WID_, IN(15), IN(16), IN(17), IN(18), IN(19), IN(20), IN(21), stab);
    bf16* wl_t = (bf16*)(WT + 49 * MiB);
    rwkv_wl_ph(WID_, IN(6), IN(8), IN(9), wl_t);
    rmsnorm_ph<bf16>(WID_, IN(0), IN(2), XN, M);
    grid.sync();
    s5_tables1_ph(WID_, IN(22), stab);
    { pg8::PlainOrder S; S.init(XN, D, w_in_t, D, M, DIN, D); pg8::EpiProj E{PROJ, US5}; pg8::gemm_phase(WID_, ldsl, S, E); }
    SYNC();
    bf16* LIN = (bf16*)(ws + (W_MISC + 16) * MiB);
    rwkv_lin_ph(WID_, PROJ, IN(4), LIN);
    SYNC();
    bf16* YI = (bf16*)(ws + W_YI * MiB); float* F = (float*)(ws + W_F * MiB); bf16* XST = (bf16*)(ws + W_XST * MiB); bf16* Z = (bf16*)(ws + W_Z * MiB);
    bf16* LWb = (bf16*)(ws + 704 * MiB); bf16* AAb = (bf16*)(ws + 768 * MiB); bf16* Gb = (bf16*)(ws + 832 * MiB);
    float* Yr = (float*)(ws + 896 * MiB); float* RKb = (float*)(ws + W_MISC * MiB);
    { pg8::GroupOrder S; S.init(US5, 512, (size_t)S5R * 512, stab.BtA, 512, (size_t)768 * 512, 32, S5R, 768, 512); pg8::EpiS5a E{YI, F}; pg8::gemm_phase(WID_, ldsl, S, E); }
    { pg8::PlainOrder S; S.init(LIN, 256, wl_t, 256, M, 1536, 256); pg8::EpiLora E{LWb, (size_t)32 * MiB, IN(5), IN(7)}; pg8::gemm_phase(WID_, ldsl, S, E); }
    SYNC();
    { ck::In ci{PROJ, LWb, AAb, IN(4), IN(10), IN(11), IN(12), RKb, dout}; ck::phase1(WID_, ci, lds); }
    SYNC();
    s5_carry_ph(WID_, IN(15), IN(16), IN(17), F, XST);
    ck::phase2(WID_, dout, Yr, lds);
    SYNC();
    bf16* YMIX = XN;
    { pg8::GroupOrder S; S.init(XST, 256, (size_t)S5R * 256, stab.BtB, 256, (size_t)512 * 256, 32, S5R, 512, 256); pg8::EpiS5b E{YI, Z}; pg8::gemm_phase(WID_, ldsl, S, E); }
    rwkv_post_ph(WID_, Yr, RKb, PROJ, IN(4), Gb, IN(13), IN(14), YMIX);
    SYNC();
    { pg8::PlainOrder S; S.init(Z, 512, w_glu_t, 512, M, 512, 512); pg8::EpiGlu E{Z, IN(24), YMIX}; pg8::gemm_phase(WID_, ldsl, S, E); }
    SYNC();
    { pg8::PlainOrder S; S.init(YMIX, D, w_mix_t, D, M, D, D); pg8::EpiF32 E{out, D, IN(0), D}; pg8::gemm_phase(WID_, ldsl, S, E); }
    SYNC();
    bf16* KM = (bf16*)(ws + (W_MISC + 2) * MiB); bf16* VT = (bf16*)(ws + (W_MISC + 6) * MiB); bf16* MEMN = (bf16*)(ws + (W_MISC + 10) * MiB);
    rmsnorm_ph<bf16>(WID_, out, IN(26), XN, M);
    rmsnorm_ph<bf16>(WID_, IN(1), IN(27), MEMN, NB * NMEM);
    SYNC();
    bf16* Q = (bf16*)(ws + 128 * MiB);
    { pg8::PlainOrder S; S.init(MEMN, D, w_k_t, D, NB * NMEM, D, D); pg8::EpiBf16 E{KM, D}; pg8::gemm_phase(WID_, ldsl, S, E); }
    { pg8::PlainOrder S; S.init(w_v_t, D, MEMN, D, D, NB * NMEM, D); pg8::EpiBf16 E{VT, NB * NMEM}; pg8::gemm_phase(WID_, ldsl, S, E); }
    { pg8::PlainOrder S; S.init(XN, D, w_q_t, D, M, D, D); pg8::EpiBf16 E{Q, D}; pg8::gemm_phase(WID_, ldsl, S, E); }
    SYNC();
    bf16* P = (bf16*)(ws + W_YI * MiB);
    { pg8::AttnOrder S; S.init(Q, KM, D, 0); pg8::EpiSoftmax E{P, (PG8_LAS float*)(ldsl + 131072)}; pg8::gemm_phase(WID_, ldsl, S, E); }
    SYNC();
    bf16* O = XN;
    { pg8::AttnOrder S; S.init(P, VT, NB * NMEM, 1); pg8::EpiAttnO E{O}; pg8::gemm_phase(WID_, ldsl, S, E); }
    SYNC();
    { pg8::PlainOrder S; S.init(O, D, w_o_t, D, M, D, D); pg8::EpiF32 E{out, D, out, D}; pg8::gemm_phase(WID_, ldsl, S, E); }
    SYNC();
    bf16* H3 = XN;
    bf16* XG = (bf16*)(ws + 0);
    bf16* WGU_t = (bf16*)(ws + 272 * MiB); bf16* WD_t = (bf16*)(ws + 336 * MiB);
    bf16* HID = (bf16*)(ws + 368 * MiB);
    bf16* YSLOT = (bf16*)(ws + 704 * MiB);
    MoeBufs mb; char* mbase = ws + 976 * MiB;
    mb.tok_e = (int*)(mbase); mb.tok_g = (float*)(mbase + 1 * MiB); mb.tok_slot = (int*)(mbase + 2 * MiB); mb.slot_tok = (int*)(mbase + 3 * MiB);
    mb.slot_gate = (float*)(mbase + 4 * MiB); mb.bcnt = (int*)(mbase + 5 * MiB); mb.bbase = mb.bcnt + 16384; mb.offs = mb.bcnt + 32768; mb.ntiles = mb.offs + 64;
    mb.tiles = (int*)(mbase + 6 * MiB);
    moe_zero_ph(WID_, mb);
    moe_weights_ph(WID_, IN(37), IN(38), IN(39), WGU_t, WD_t, lds);
    SYNC();
    router_ph(WID_, out, IN(32), H3, IN(33), IN(34), IN(35), IN(36), mb, lds);
    SYNC();
    moe_plan_ph(WID_, mb, lds);
    SYNC();
    moe_scatter_ph(WID_, mb, lds);
    SYNC();
    moe_gather_ph(WID_, H3, XG, mb);
    SYNC();
    const int ntiles = __hip_atomic_load(mb.ntiles, __ATOMIC_RELAXED, __HIP_MEMORY_SCOPE_AGENT);
    { pg8::MoeOrder S; S.init(XG, D, WGU_t, D, D, mb.tiles, ntiles, 1024); pg8::EpiSilu E{HID}; pg8::gemm_phase(WID_, ldsl, S, E); }
    SYNC();
    { pg8::MoeOrder S; S.init(HID, DEXP, WD_t, DEXP, DEXP, mb.tiles, ntiles, 1024); pg8::EpiGate E{YSLOT, mb.slot_gate}; pg8::gemm_phase(WID_, ldsl, S, E); }
    SYNC();
    final_ph(WID_, out, YSLOT, mb.tok_slot, IN(40));
}
}

extern "C" void kernel_launch(void* const* d_in, const int* in_sizes, int n_in, void* d_out, int out_size, void* d_ws, size_t ws_size, hipStream_t stream) {
    (void)in_sizes; (void)out_size; (void)ws_size;
    static int grid = 0;
    if (grid == 0) {
        int dev = 0, cus = 0, per_cu = 0;
        hipGetDevice(&dev);
        hipDeviceGetAttribute(&cus, hipDeviceAttributeMultiprocessorCount, dev);
        hipFuncSetAttribute((const void*)fwd_kernel, hipFuncAttributeMaxDynamicSharedMemorySize, LDS_BYTES);
        hipOccupancyMaxActiveBlocksPerMultiprocessor(&per_cu, (const void*)fwd_kernel, NT, LDS_BYTES);
        if (per_cu < 1) { fprintf(stderr, "occupancy query says %d blocks/CU\n", per_cu); per_cu = 1; }
        grid = cus * 1;
    }
    (void)hipMemsetAsync((char*)d_ws + W_CTL * MiB, 0, 16384, stream);
    Params p{};
    for (int i = 0; i < 41 && i < n_in; ++i) p.in[i] = (const float*)d_in[i];
    p.out = (float*)d_out; p.ws = (char*)d_ws;
    void* args[] = {&p};
    hipError_t e = hipLaunchCooperativeKernel((const void*)fwd_kernel, dim3(grid), dim3(NT), args, LDS_BYTES, stream);
    if (e != hipSuccess) fprintf(stderr, "cooperative launch failed: %s (grid %d)\n", hipGetErrorString(e), grid);
}
```

```cpp
#include <hip/hip_runtime.h>
#include <hip/hip_cooperative_groups.h>
#include <stdint.h>
#include <cstdio>
namespace cg = cooperative_groups;

namespace {
constexpr int NB = 8, S = 8192, D = 1024, M = NB * S;
constexpr int DR = 512, DSHIFT = 1792, DIN = 2304, NMEM = 256;
constexpr int NEXP = 32, DEXP = 512, NASSIGN = 2 * M;
constexpr size_t MiB = 1u << 20;
constexpr int NT = 512;
constexpr int S5L = 32, S5R = M / S5L;
constexpr int LDS_BYTES = 147456;
#define GB ((int)blockIdx.x)
#define GN ((int)gridDim.x)

typedef unsigned short bf16;
__device__ __forceinline__ bf16 f2bf(float f) { unsigned u = __builtin_bit_cast(unsigned, f); return (bf16)((u + 0x7fffu + ((u >> 16) & 1u)) >> 16); }
__device__ __forceinline__ unsigned pk2(float lo, float hi) { return (unsigned)f2bf(lo) | ((unsigned)f2bf(hi) << 16); }
__device__ __forceinline__ int lane_id() { int l = (int)__builtin_amdgcn_mbcnt_hi(~0u, __builtin_amdgcn_mbcnt_lo(~0u, 0u)); asm volatile("" : "+v"(l)); return l; }
__device__ __forceinline__ float bf2f(bf16 h) { return __builtin_bit_cast(float, (unsigned)h << 16); }

template <typename T> __device__ __forceinline__ float ldf(const T* p);
template <> __device__ __forceinline__ float ldf<float>(const float* p) { return *p; }
template <> __device__ __forceinline__ float ldf<bf16>(const bf16* p) { return bf2f(*p); }
template <typename T> __device__ __forceinline__ void stf(T* p, float v);
template <> __device__ __forceinline__ void stf<float>(float* p, float v) { *p = v; }
template <> __device__ __forceinline__ void stf<bf16>(bf16* p, float v) { *p = f2bf(v); }

template <int CTRL, int ROWMASK> __device__ __forceinline__ float dppf_(float x) { return __builtin_bit_cast(float, __builtin_amdgcn_update_dpp(0, __builtin_bit_cast(int, x), CTRL, ROWMASK, 0xf, false)); }
__device__ __forceinline__ float wave_sum(float v) {
    v += dppf_<0xB1, 0xf>(v); v += dppf_<0x4E, 0xf>(v); v += dppf_<0x141, 0xf>(v); v += dppf_<0x140, 0xf>(v);
    v += dppf_<0x142, 0xa>(v);
    v += dppf_<0x143, 0xc>(v);
    return __builtin_bit_cast(float, __builtin_amdgcn_readlane(__builtin_bit_cast(int, v), 63));
}
__device__ __forceinline__ float sigmoidf_(float x) { return 1.f / (1.f + __expf(-x)); }


__device__ __forceinline__ float gelu_tanh(float x) { return x * sigmoidf_(1.5957691216057308f * (x + 0.044715f * x * x * x)); }

namespace pg8 {
#define PG8_LAS __attribute__((address_space(3)))
typedef short bf16x8 __attribute__((ext_vector_type(8)));
typedef float f32x4 __attribute__((ext_vector_type(4)));
typedef unsigned u32x4 __attribute__((ext_vector_type(4)));
constexpr int BM = 256, BK = 64, HALF = 128, HTB = HALF * BK * 2, STAGE_BYTES = 8 * HTB, NXCD = 8, WGM = 8;
__device__ __forceinline__ int lds_byte(int r, int c) { const int st = (r >> 4) * 2 + (c >> 5), rr = r & 15, cc = c & 31, ob = rr * 64 + cc * 2; return st * 1024 + (ob ^ (((ob >> 9) & 1) << 5)); }
__device__ __forceinline__ void stage_rc(int b, int& R, int& C) { const int st = b / 1024, sb = b % 1024, swz = sb ^ (((sb >> 9) & 1) << 5); R = (st >> 1) * 16 + swz / 64; C = (st & 1) * 32 + (swz % 64) / 2; }
__device__ __forceinline__ int perm32(int rho) { const int n = rho >> 4, i = rho & 15; return 8 * (i >> 2) + 4 * n + (i & 3); }
struct Unit { int pm, pn; };
struct PlainOrder {
    const bf16* A; const bf16* Bt; int lda, ldb, K; int nM, nN, nwg, G, c;
    __device__ void init(const bf16* A_, int lda_, const bf16* Bt_, int ldb_, int M, int N, int K_) { A = A_; Bt = Bt_; lda = lda_; ldb = ldb_; K = K_; nM = M / BM; nN = N / BM; nwg = nM * nN; G = GN; c = GB; }
    __device__ bool next(int i, Unit& u) const {
        const long L = (long)i * G + c; if (L >= nwg) return false;
        int wgid = (int)L; { const int q = nwg / NXCD, r = nwg % NXCD, xcd = wgid % NXCD, off = wgid / NXCD; wgid = (xcd < r ? xcd * (q + 1) : r * (q + 1) + (xcd - r) * q) + off; }
        const int nig = WGM * nN, gid = wgid / nig, fm = gid * WGM, gsz = (nM - fm) < WGM ? (nM - fm) : WGM;
        u.pm = fm + ((wgid % nig) % gsz); u.pn = (wgid % nig) / gsz; return true;
    }
    __device__ __forceinline__ const char* aptr(const Unit& u) const { return (const char*)(A + (size_t)u.pm * BM * lda); }
    __device__ __forceinline__ const char* bptr(const Unit& u) const { return (const char*)(Bt + (size_t)u.pn * BM * ldb); }
};
typedef float f32x2c __attribute__((ext_vector_type(2)));
typedef __bf16 bf16x2c __attribute__((ext_vector_type(2)));
__device__ __forceinline__ unsigned cvt_pk_bf16(float lo, float hi) { const f32x2c v = {lo, hi}; const bf16x2c b = __builtin_convertvector(v, bf16x2c); return __builtin_bit_cast(unsigned, b); }

template <class Epi, class Sched>
__device__ __forceinline__ void gemm_phase(const int WID_, PG8_LAS unsigned char* lds, const Sched& S, const Epi& E) {
    const int tid = (WID_ * 64 + lane_id()), wid = __builtin_amdgcn_readfirstlane(tid >> 6), lane = tid & 63, wr = wid >> 2, wc = wid & 3, fr = lane & 15, fq = lane >> 4;
    const int K = S.K, nt = K / BK;
    unsigned voffA[2], voffB[2];
#pragma unroll
    for (int i = 0; i < 2; ++i) { int R, C; stage_rc(tid * 16 + i * 8192, R, C); const int Rb = Epi::PERM ? ((R & ~31) + perm32(R & 31)) : R;
        voffA[i] = (unsigned)(R * S.lda + C) * 2u; voffB[i] = (unsigned)(Rb * S.ldb + C) * 2u; }
    const size_t kstep = (size_t)(BK * 2);
    const size_t hstepA = (size_t)HALF * S.lda * 2, hstepB = (size_t)HALF * S.ldb * 2;
    const unsigned ldsw = (unsigned)wid * 1024u;
    const int aoff = lds_byte(wr * 64 + fr, fq * 8), boff = lds_byte(wc * 32 + fr, fq * 8);
#define PG8_SA(b, h) (((b) * 2 + (h)) * HTB)
#define PG8_SB(b, h) ((4 + (b) * 2 + (h)) * HTB)
#define PG8_STAGE(bufoff, gbase, voff) do { _Pragma("unroll") for (int _i = 0; _i < 2; ++_i) \
        __builtin_amdgcn_global_load_lds((const unsigned*)((const char*)(gbase) + (voff)[_i]), (PG8_LAS unsigned*)(lds + (bufoff) + ldsw + _i * 8192), 16, 0, 0); } while (0)
#define PG8_LDA(dst, b, h) do { _Pragma("unroll") for (int m = 0; m < 4; ++m) _Pragma("unroll") for (int k = 0; k < 2; ++k) dst[m][k] = *(const PG8_LAS bf16x8*)(lds + PG8_SA(b, h) + aoff + m * 2048 + k * 1024); } while (0)
#define PG8_LDB(dst, b, h) do { _Pragma("unroll") for (int n = 0; n < 2; ++n) _Pragma("unroll") for (int k = 0; k < 2; ++k) dst[n][k] = *(const PG8_LAS bf16x8*)(lds + PG8_SB(b, h) + boff + n * 2048 + k * 1024); } while (0)
#define PG8_MMA(ai, bj, At, Bt) do { __builtin_amdgcn_s_setprio(1); _Pragma("unroll") for (int m = 0; m < 4; ++m) _Pragma("unroll") for (int n = 0; n < 2; ++n) _Pragma("unroll") for (int k = 0; k < 2; ++k) \
        acc[ai][bj][m][n] = __builtin_amdgcn_mfma_f32_16x16x32_bf16(Bt[n][k], At[m][k], acc[ai][bj][m][n], 0, 0, 0); __builtin_amdgcn_s_setprio(0); } while (0)
#define PG8_WAIT_V(n) asm volatile("s_waitcnt vmcnt(" #n ")" ::: "memory")
#define PG8_WAIT_L(n) asm volatile("s_waitcnt lgkmcnt(" #n ")" ::: "memory")
#define PG8_BAR __builtin_amdgcn_s_barrier()
#define PG8_SCHED __builtin_amdgcn_sched_barrier(0)
    Unit cur, nxt; int ui = 0;
    if (!S.next(0, cur)) return;
    f32x4 acc[2][2][4][2];
#pragma unroll
    for (int a = 0; a < 2; ++a)
#pragma unroll
        for (int b = 0; b < 2; ++b)
#pragma unroll
            for (int m = 0; m < 4; ++m)
#pragma unroll
                for (int n = 0; n < 2; ++n) acc[a][b][m][n] = (f32x4){0.f, 0.f, 0.f, 0.f};
    bf16x8 At[4][2], B0[2][2], B1[2][2];
    const char* cA = S.aptr(cur); const char* cB = S.bptr(cur);
    PG8_STAGE(PG8_SB(0, 0), cB, voffB); PG8_STAGE(PG8_SB(0, 1), cB + hstepB, voffB); PG8_STAGE(PG8_SA(0, 0), cA, voffA); PG8_STAGE(PG8_SA(0, 1), cA + hstepA, voffA);
    if (wr == 1) PG8_BAR;
    PG8_WAIT_V(2); PG8_BAR;
    PG8_STAGE(PG8_SB(1, 0), cB + kstep, voffB); PG8_STAGE(PG8_SA(1, 0), cA + kstep, voffA); PG8_STAGE(PG8_SB(1, 1), cB + hstepB + kstep, voffB);
    PG8_WAIT_V(6); PG8_BAR;
    for (;;) {
        const bool has_next = S.next(ui + 1, nxt);
        const char* nA = has_next ? S.aptr(nxt) : cA; const char* nB = has_next ? S.bptr(nxt) : cB;
        for (int t = 0; t < nt; t += 2) {
            const bool last = (t == nt - 2);
            const char* a1 = cA + (size_t)(t + 1) * kstep;
            const char* a2 = last ? nA : cA + (size_t)(t + 2) * kstep; const char* b2 = last ? nB : cB + (size_t)(t + 2) * kstep;
            const char* a3 = a2 + kstep; const char* b3 = b2 + kstep;
            PG8_LDB(B0, 0, 0); PG8_LDB(B1, 0, 1); PG8_SCHED; PG8_LDA(At, 0, 0); PG8_STAGE(PG8_SA(1, 1), a1 + hstepA, voffA);
            PG8_WAIT_V(8); PG8_WAIT_L(0); PG8_BAR; PG8_MMA(0, 0, At, B0); PG8_MMA(0, 1, At, B1); PG8_BAR; PG8_SCHED;
            PG8_LDA(At, 0, 1); PG8_STAGE(PG8_SB(0, 0), b2, voffB); PG8_STAGE(PG8_SB(0, 1), b2 + hstepB, voffB); PG8_STAGE(PG8_SA(0, 0), a2, voffA);
            PG8_WAIT_V(8); PG8_WAIT_L(0); PG8_BAR; PG8_MMA(1, 0, At, B0); PG8_MMA(1, 1, At, B1); PG8_BAR; PG8_SCHED;
            PG8_LDB(B0, 1, 0); PG8_LDB(B1, 1, 1); PG8_SCHED; PG8_LDA(At, 1, 0); PG8_STAGE(PG8_SA(0, 1), a2 + hstepA, voffA);
            PG8_WAIT_V(8); PG8_WAIT_L(0); PG8_BAR; PG8_MMA(0, 0, At, B0); PG8_MMA(0, 1, At, B1); PG8_BAR; PG8_SCHED;
            PG8_LDA(At, 1, 1); PG8_STAGE(PG8_SB(1, 0), b3, voffB); PG8_STAGE(PG8_SB(1, 1), b3 + hstepB, voffB); PG8_STAGE(PG8_SA(1, 0), a3, voffA);
            PG8_WAIT_V(8); PG8_WAIT_L(0); PG8_BAR; PG8_MMA(1, 0, At, B0); PG8_MMA(1, 1, At, B1); PG8_BAR; PG8_SCHED;
        }
        if (wr == 0) PG8_BAR;
        E(acc, cur, wr, wc, fr, fq);
        if (!has_next) break;
#pragma unroll
        for (int a = 0; a < 2; ++a)
#pragma unroll
            for (int b = 0; b < 2; ++b)
#pragma unroll
                for (int m = 0; m < 4; ++m)
#pragma unroll
                    for (int n = 0; n < 2; ++n) acc[a][b][m][n] = (f32x4){0.f, 0.f, 0.f, 0.f};
        cur = nxt; cA = nA; cB = nB; ++ui;
        if (wr == 1) PG8_BAR;
    }
    PG8_WAIT_V(0);
    PG8_BAR;
#undef PG8_SA
#undef PG8_SB
#undef PG8_STAGE
#undef PG8_LDA
#undef PG8_LDB
#undef PG8_MMA
#undef PG8_WAIT_V
#undef PG8_WAIT_L
#undef PG8_BAR
#undef PG8_SCHED
}

struct EpiF32 {
    static constexpr bool PERM = false;
    float* C; int ldc; const float* R; int ldr;
    __device__ __forceinline__ void operator()(const f32x4 (&acc)[2][2][4][2], const Unit& u, int wr, int wc, int fr, int fq) const {
        const int row0 = u.pm * BM + wr * 64 + fr, col0 = u.pn * BM + wc * 32 + 4 * fq;
#pragma unroll
        for (int ai = 0; ai < 2; ++ai)
#pragma unroll
            for (int m = 0; m < 4; ++m) { const size_t row = (size_t)(row0 + ai * HALF + m * 16);
#pragma unroll
                for (int bj = 0; bj < 2; ++bj)
#pragma unroll
                    for (int n = 0; n < 2; ++n) { const int col = col0 + bj * HALF + 16 * n; f32x4 v = acc[ai][bj][m][n];
                        if (R) v = v + *(const f32x4*)(R + row * ldr + col);
                        *(f32x4*)(C + row * ldc + col) = v; } }
    }
};
struct EpiBf16 {
    static constexpr bool PERM = true;
    bf16* O; int ldc;
    __device__ __forceinline__ void operator()(const f32x4 (&acc)[2][2][4][2], const Unit& u, int wr, int wc, int fr, int fq) const {
        const int row0 = u.pm * BM + wr * 64 + fr, col0 = u.pn * BM + wc * 32 + 8 * fq;
#pragma unroll
        for (int ai = 0; ai < 2; ++ai)
#pragma unroll
            for (int m = 0; m < 4; ++m) { bf16* rowp = O + (size_t)(row0 + ai * HALF + m * 16) * ldc + col0;
#pragma unroll
                for (int bj = 0; bj < 2; ++bj) { const f32x4 v0 = acc[ai][bj][m][0], v1 = acc[ai][bj][m][1];
                    u32x4 w; w.x = cvt_pk_bf16(v0[0], v0[1]); w.y = cvt_pk_bf16(v0[2], v0[3]); w.z = cvt_pk_bf16(v1[0], v1[1]); w.w = cvt_pk_bf16(v1[2], v1[3]);
                    *(u32x4*)(rowp + bj * HALF) = w; } }
    }
};
struct EpiGlu {
    static constexpr bool PERM = true;
    const bf16* Z; const float* bias; bf16* YM;
    __device__ __forceinline__ void operator()(const f32x4 (&acc)[2][2][4][2], const Unit& u, int wr, int wc, int fr, int fq) const {
        const int row0 = u.pm * BM + wr * 64 + fr, col0 = u.pn * BM + wc * 32 + 8 * fq;
#pragma unroll
        for (int ai = 0; ai < 2; ++ai)
#pragma unroll
            for (int m = 0; m < 4; ++m) { const size_t row = (size_t)(row0 + ai * HALF + m * 16);
#pragma unroll
                for (int bj = 0; bj < 2; ++bj) { const int col = col0 + bj * HALF;
                    const u32x4 zz = *(const u32x4*)(Z + row * 512 + col);
                    const f32x4 b0 = *(const f32x4*)(bias + col), b1 = *(const f32x4*)(bias + col + 4);
                    const f32x4 v0 = acc[ai][bj][m][0] + b0, v1 = acc[ai][bj][m][1] + b1;
                    float o[8]; const unsigned zw[4] = {zz.x, zz.y, zz.z, zz.w};
#pragma unroll
                    for (int q = 0; q < 4; ++q) { const float zl = __builtin_bit_cast(float, zw[q] << 16), zh = __builtin_bit_cast(float, zw[q] & 0xffff0000u);
                        const float al = (q < 2) ? v0[2 * q] : v1[2 * q - 4], ah = (q < 2) ? v0[2 * q + 1] : v1[2 * q - 3];
                        o[2 * q] = zl * sigmoidf_(al); o[2 * q + 1] = zh * sigmoidf_(ah); }
                    u32x4 w; w.x = cvt_pk_bf16(o[0], o[1]); w.y = cvt_pk_bf16(o[2], o[3]); w.z = cvt_pk_bf16(o[4], o[5]); w.w = cvt_pk_bf16(o[6], o[7]);
                    *(u32x4*)(YM + row * D + 512 + col) = w; } }
    }
};

struct MoeOrder {
    const bf16* A; const bf16* Bt; int lda, ldb, K; const int* tiles; int nunits, G, c; size_t bexp;
    __device__ void init(const bf16* A_, int lda_, const bf16* Bt_, int ldb_, int K_, const int* tiles_, int ntiles, size_t bexp_) { A = A_; Bt = Bt_; lda = lda_; ldb = ldb_; K = K_; tiles = tiles_; nunits = ntiles * 4; G = GN; c = GB; bexp = bexp_; }
    __device__ bool next(int i, Unit& u) const { const int L = i * G + c; if (L >= nunits) return false; u.pm = L >> 2; u.pn = L & 3; return true; }
    __device__ __forceinline__ const char* aptr(const Unit& u) const { return (const char*)(A + (size_t)u.pm * BM * lda); }
    __device__ __forceinline__ const char* bptr(const Unit& u) const { const int e = __hip_atomic_load(tiles + u.pm, __ATOMIC_RELAXED, __HIP_MEMORY_SCOPE_AGENT); return (const char*)(Bt + ((size_t)e * bexp + (size_t)u.pn * BM) * ldb); }
};
struct EpiSilu {
    static constexpr bool PERM = true;
    bf16* HID;
    __device__ __forceinline__ void operator()(const f32x4 (&acc)[2][2][4][2], const Unit& u, int wr, int wc, int fr, int fq) const {
        const int row0 = u.pm * BM + wr * 64 + fr, col0 = u.pn * HALF + wc * 32 + 8 * fq;
#pragma unroll
        for (int ai = 0; ai < 2; ++ai)
#pragma unroll
            for (int m = 0; m < 4; ++m) { const size_t row = (size_t)(row0 + ai * HALF + m * 16);
                float o[8];
#pragma unroll
                for (int n = 0; n < 2; ++n)
#pragma unroll
                    for (int q = 0; q < 4; ++q) { const float g = acc[ai][0][m][n][q], up = acc[ai][1][m][n][q]; o[4 * n + q] = g * sigmoidf_(g) * up; }
                u32x4 w; w.x = cvt_pk_bf16(o[0], o[1]); w.y = cvt_pk_bf16(o[2], o[3]); w.z = cvt_pk_bf16(o[4], o[5]); w.w = cvt_pk_bf16(o[6], o[7]);
                *(u32x4*)(HID + row * DEXP + col0) = w; }
    }
};
struct EpiGate {
    static constexpr bool PERM = true;
    bf16* Y; const float* gate;
    __device__ __forceinline__ void operator()(const f32x4 (&acc)[2][2][4][2], const Unit& u, int wr, int wc, int fr, int fq) const {
        const int row0 = u.pm * BM + wr * 64 + fr, col0 = u.pn * BM + wc * 32 + 8 * fq;
#pragma unroll
        for (int ai = 0; ai < 2; ++ai)
#pragma unroll
            for (int m = 0; m < 4; ++m) { const size_t row = (size_t)(row0 + ai * HALF + m * 16); const float gt = gate[row];
#pragma unroll
                for (int bj = 0; bj < 2; ++bj) { const f32x4 v0 = acc[ai][bj][m][0] * gt, v1 = acc[ai][bj][m][1] * gt;
                    u32x4 w; w.x = cvt_pk_bf16(v0[0], v0[1]); w.y = cvt_pk_bf16(v0[2], v0[3]); w.z = cvt_pk_bf16(v1[0], v1[1]); w.w = cvt_pk_bf16(v1[2], v1[3]);
                    *(u32x4*)(Y + row * D + col0 + bj * HALF) = w; } }
    }
};

struct EpiProj {
    static constexpr bool PERM = true;
    bf16* PROJ; bf16* US5;
    __device__ __forceinline__ void operator()(const f32x4 (&acc)[2][2][4][2], const Unit& u, int wr, int wc, int fr, int fq) const {
        const int row0 = u.pm * BM + wr * 64 + fr, col0 = u.pn * BM + wc * 32 + 8 * fq;
#pragma unroll
        for (int ai = 0; ai < 2; ++ai)
#pragma unroll
            for (int m = 0; m < 4; ++m) { const size_t row = (size_t)(row0 + ai * HALF + m * 16);
#pragma unroll
                for (int bj = 0; bj < 2; ++bj) { const f32x4 v0 = acc[ai][bj][m][0], v1 = acc[ai][bj][m][1]; const int col = col0 + bj * HALF;
                    u32x4 w; w.x = cvt_pk_bf16(v0[0], v0[1]); w.y = cvt_pk_bf16(v0[2], v0[3]); w.z = cvt_pk_bf16(v1[0], v1[1]); w.w = cvt_pk_bf16(v1[2], v1[3]);
                    if (col < DSHIFT) *(u32x4*)(PROJ + row * DSHIFT + col) = w;
                    else { const int cc = col - DSHIFT; *(u32x4*)(US5 + ((size_t)(cc >> 4) * M + row) * 16 + (cc & 15)) = w; } } }
    }
};
struct GroupOrder {
    const bf16* A; const bf16* Bt; int lda, ldb, K; int nM, nN, nunits, G, c; size_t sA, sB;
    __device__ void init(const bf16* A_, int lda_, size_t sA_, const bf16* Bt_, int ldb_, size_t sB_, int ngroups, int Mg, int Ng, int K_) {
        A = A_; Bt = Bt_; lda = lda_; ldb = ldb_; K = K_; sA = sA_; sB = sB_; nM = Mg / BM; nN = Ng / BM; nunits = ngroups * nM * nN; G = GN; c = GB; }
    __device__ bool next(int i, Unit& u) const { const int L = i * G + c; if (L >= nunits) return false; u.pn = L % nN; u.pm = L / nN; return true; }
    __device__ __forceinline__ const char* aptr(const Unit& u) const { const int g = u.pm / nM, pm = u.pm % nM; return (const char*)(A + (size_t)g * sA + (size_t)pm * BM * lda); }
    __device__ __forceinline__ const char* bptr(const Unit& u) const { const int g = u.pm / nM; return (const char*)(Bt + (size_t)g * sB + (size_t)u.pn * BM * ldb); }
};
struct EpiS5a {
    static constexpr bool PERM = false;
    bf16* YI; float* F;
    __device__ __forceinline__ void operator()(const f32x4 (&acc)[2][2][4][2], const Unit& u, int wr, int wc, int fr, int fq) const {
        const int row0 = u.pm * BM + wr * 64 + fr, col0 = u.pn * BM + wc * 32 + 4 * fq;
#pragma unroll
        for (int ai = 0; ai < 2; ++ai)
#pragma unroll
            for (int m = 0; m < 4; ++m) { const size_t row = (size_t)(row0 + ai * HALF + m * 16);
#pragma unroll
                for (int bj = 0; bj < 2; ++bj)
#pragma unroll
                    for (int n = 0; n < 2; ++n) { const int col = col0 + bj * HALF + 16 * n; const f32x4 v = acc[ai][bj][m][n];
                        if (col < 512) { uint2 w; w.x = cvt_pk_bf16(v[0], v[1]); w.y = cvt_pk_bf16(v[2], v[3]); *(uint2*)(YI + row * 512 + col) = w; }
                        else if (col < 640) *(f32x4*)(F + row * 128 + (col - 512)) = v; } }
    }
};
struct EpiS5b {
    static constexpr bool PERM = true;
    const bf16* YI; bf16* Z;
    __device__ __forceinline__ void operator()(const f32x4 (&acc)[2][2][4][2], const Unit& u, int wr, int wc, int fr, int fq) const {
        const int row0 = u.pm * BM + wr * 64 + fr, col0 = u.pn * BM + wc * 32 + 8 * fq;
#pragma unroll
        for (int ai = 0; ai < 2; ++ai)
#pragma unroll
            for (int m = 0; m < 4; ++m) { const int row = row0 + ai * HALF + m * 16; const int g = row / S5R, rl = row % S5R;
#pragma unroll
                for (int bj = 0; bj < 2; ++bj) { const int col = col0 + bj * HALF;
                    const u32x4 yi = *(const u32x4*)(YI + (size_t)row * 512 + col);
                    const unsigned yw[4] = {yi.x, yi.y, yi.z, yi.w};
                    const f32x4 v0 = acc[ai][bj][m][0], v1 = acc[ai][bj][m][1];
                    float o[8];
#pragma unroll
                    for (int q = 0; q < 4; ++q) { const float al = (q < 2) ? v0[2 * q] : v1[2 * q - 4], ah = (q < 2) ? v0[2 * q + 1] : v1[2 * q - 3];
                        o[2 * q] = gelu_tanh(al + __builtin_bit_cast(float, yw[q] << 16)); o[2 * q + 1] = gelu_tanh(ah + __builtin_bit_cast(float, yw[q] & 0xffff0000u)); }
                    u32x4 w; w.x = cvt_pk_bf16(o[0], o[1]); w.y = cvt_pk_bf16(o[2], o[3]); w.z = cvt_pk_bf16(o[4], o[5]); w.w = cvt_pk_bf16(o[6], o[7]);
                    const size_t tok = (size_t)rl * S5L + (col >> 4);
                    *(u32x4*)(Z + tok * 512 + g * 16 + (col & 15)) = w; } }
    }
};
struct AttnOrder {
    const bf16* A; const bf16* Bt; int lda, ldb, K; int G, c; int mode;
    __device__ void init(const bf16* A_, const bf16* Bt_, int ldb_, int mode_) { A = A_; Bt = Bt_; lda = D; ldb = ldb_; K = 256; G = GN; c = GB; mode = mode_; }
    __device__ bool next(int i, Unit& u) const { const int L = i * G + c; if (L >= NB * 4 * 32) return false; u.pn = L & 3; u.pm = L >> 2; return true; }
    __device__ __forceinline__ const char* aptr(const Unit& u) const { return (const char*)(A + (size_t)u.pm * BM * D + u.pn * 256); }
    __device__ __forceinline__ const char* bptr(const Unit& u) const { const int b = u.pm >> 5;
        return (const char*)(mode == 0 ? Bt + (size_t)b * 256 * ldb + u.pn * 256 : Bt + (size_t)u.pn * 256 * ldb + b * 256); }
};
struct EpiSoftmax {
    static constexpr bool PERM = true;
    bf16* P; PG8_LAS float* scr;
    __device__ __forceinline__ void operator()(f32x4 (&acc)[2][2][4][2], const Unit& u, int wr, int wc, int fr, int fq) const {
        const float SC = 0.0625f * 1.4426950408889634f;
        PG8_LAS float* smax = scr; PG8_LAS float* ssum = scr + 1024;
#pragma unroll
        for (int ai = 0; ai < 2; ++ai)
#pragma unroll
            for (int m = 0; m < 4; ++m) { float t = -3.0e38f;
#pragma unroll
                for (int bj = 0; bj < 2; ++bj)
#pragma unroll
                    for (int n = 0; n < 2; ++n) { const f32x4 v = acc[ai][bj][m][n]; t = fmaxf(t, fmaxf(fmaxf(v[0], v[1]), fmaxf(v[2], v[3]))); }
                t = fmaxf(t, __shfl_xor(t, 16)); t = fmaxf(t, __shfl_xor(t, 32));
                if (fq == 0) smax[(ai * HALF + wr * 64 + m * 16 + fr) * 4 + wc] = t; }
        asm volatile("s_waitcnt lgkmcnt(0)" ::: "memory"); __builtin_amdgcn_s_barrier(); asm volatile("" ::: "memory");
#pragma unroll
        for (int ai = 0; ai < 2; ++ai)
#pragma unroll
            for (int m = 0; m < 4; ++m) { const f32x4 q = *(const PG8_LAS f32x4*)(smax + (ai * HALF + wr * 64 + m * 16 + fr) * 4);
                const float mm = fmaxf(fmaxf(q[0], q[1]), fmaxf(q[2], q[3])) * SC; float s = 0.f;
#pragma unroll
                for (int bj = 0; bj < 2; ++bj)
#pragma unroll
                    for (int n = 0; n < 2; ++n)
#pragma unroll
                        for (int e = 0; e < 4; ++e) { const float p = __builtin_amdgcn_exp2f(acc[ai][bj][m][n][e] * SC - mm); acc[ai][bj][m][n][e] = p; s += p; }
                s += __shfl_xor(s, 16); s += __shfl_xor(s, 32);
                if (fq == 0) ssum[(ai * HALF + wr * 64 + m * 16 + fr) * 4 + wc] = s; }
        asm volatile("s_waitcnt lgkmcnt(0)" ::: "memory"); __builtin_amdgcn_s_barrier(); asm volatile("" ::: "memory");
        const int row0 = u.pm * BM + wr * 64 + fr, col0 = u.pn * 256 + wc * 32 + 8 * fq;
#pragma unroll
        for (int ai = 0; ai < 2; ++ai)
#pragma unroll
            for (int m = 0; m < 4; ++m) { const f32x4 q = *(const PG8_LAS f32x4*)(ssum + (ai * HALF + wr * 64 + m * 16 + fr) * 4);
                const float iv = 1.f / ((q[0] + q[1]) + (q[2] + q[3]));
                bf16* rowp = P + (size_t)(row0 + ai * HALF + m * 16) * D + col0;
#pragma unroll
                for (int bj = 0; bj < 2; ++bj) { const f32x4 v0 = acc[ai][bj][m][0] * iv, v1 = acc[ai][bj][m][1] * iv; u32x4 w;
                    w.x = cvt_pk_bf16(v0[0], v0[1]); w.y = cvt_pk_bf16(v0[2], v0[3]); w.z = cvt_pk_bf16(v1[0], v1[1]); w.w = cvt_pk_bf16(v1[2], v1[3]);
                    *(u32x4*)(rowp + bj * HALF) = w; } }
    }
};
struct EpiAttnO {
    static constexpr bool PERM = true;
    bf16* O;
    __device__ __forceinline__ void operator()(const f32x4 (&acc)[2][2][4][2], const Unit& u, int wr, int wc, int fr, int fq) const {
        const int row0 = u.pm * BM + wr * 64 + fr, col0 = u.pn * 256 + wc * 32 + 8 * fq;
#pragma unroll
        for (int ai = 0; ai < 2; ++ai)
#pragma unroll
            for (int m = 0; m < 4; ++m) { bf16* rowp = O + (size_t)(row0 + ai * HALF + m * 16) * D + col0;
#pragma unroll
                for (int bj = 0; bj < 2; ++bj) { const f32x4 v0 = acc[ai][bj][m][0], v1 = acc[ai][bj][m][1];
                    u32x4 w; w.x = cvt_pk_bf16(v0[0], v0[1]); w.y = cvt_pk_bf16(v0[2], v0[3]); w.z = cvt_pk_bf16(v1[0], v1[1]); w.w = cvt_pk_bf16(v1[2], v1[3]);
                    *(u32x4*)(rowp + bj * HALF) = w; } }
    }
};

struct EpiLora {
    static constexpr bool PERM = true;
    bf16* LW; size_t ostride; const float* w0; const float* a0;
    __device__ __forceinline__ void operator()(const f32x4 (&acc)[2][2][4][2], const Unit& u, int wr, int wc, int fr, int fq) const {
        const int row0 = u.pm * BM + wr * 64 + fr, col0 = u.pn * BM + wc * 32 + 8 * fq;
        const int kind = u.pn >> 1;
        bf16* O = LW + (size_t)kind * ostride;
#pragma unroll
        for (int bj = 0; bj < 2; ++bj) { const int col = (col0 + bj * HALF) & 511;
            f32x4 b0 = (f32x4){0.f, 0.f, 0.f, 0.f}, b1 = b0;
            if (kind == 0) { b0 = *(const f32x4*)(w0 + col); b1 = *(const f32x4*)(w0 + col + 4); }
            else if (kind == 1) { b0 = *(const f32x4*)(a0 + col); b1 = *(const f32x4*)(a0 + col + 4); }
#pragma unroll
            for (int ai = 0; ai < 2; ++ai)
#pragma unroll
                for (int m = 0; m < 4; ++m) { const size_t row = (size_t)(row0 + ai * HALF + m * 16);
                    const f32x4 v0 = acc[ai][bj][m][0] + b0, v1 = acc[ai][bj][m][1] + b1; float o[8];
#pragma unroll
                    for (int e = 0; e < 8; ++e) { float x = (e < 4) ? v0[e & 3] : v1[e & 3];
                        if (kind == 0) { const float nd = -x; const float sp = fmaxf(nd, 0.f) + __logf(1.f + __expf(-fabsf(nd))); x = -__expf(-sp - 0.5f); }
                        else if (kind == 1) x = sigmoidf_(x);
                        o[e] = x; }
                    u32x4 w; w.x = cvt_pk_bf16(o[0], o[1]); w.y = cvt_pk_bf16(o[2], o[3]); w.z = cvt_pk_bf16(o[4], o[5]); w.w = cvt_pk_bf16(o[6], o[7]);
                    *(u32x4*)(O + row * 512 + col) = w; } }
    }
};
}

#define LAS __attribute__((address_space(3)))
__device__ __forceinline__ void transpose_item(const float* __restrict__ W, int K, int N, bf16* __restrict__ WT, int ldt, int row_off, int col_off, float* scr, int item, int lane, const float* __restrict__ kscale, int ldw = 0) {
    if (ldw == 0) ldw = N;
    const int nblk = N / 32, kb = item / nblk, nb = item % nblk, k0 = 64 * kb, n0 = 32 * nb;
#pragma unroll 8
    for (int i = 0; i < 32; ++i) { const int kk = 2 * i + (lane >> 5); float v = W[(size_t)(k0 + kk) * ldw + n0 + (lane & 31)]; if (kscale) v *= kscale[k0 + kk]; scr[kk * 33 + (lane & 31)] = v; }
    __builtin_amdgcn_s_waitcnt(0xc07f); asm volatile("" ::: "memory");
    const int c = lane & 7;
#pragma unroll
    for (int j = 0; j < 4; ++j) { const int n = (lane >> 3) + 8 * j; const float* s = scr + (8 * c) * 33 + n;
        uint4 o; o.x = pk2(s[0 * 33], s[1 * 33]); o.y = pk2(s[2 * 33], s[3 * 33]); o.z = pk2(s[4 * 33], s[5 * 33]); o.w = pk2(s[6 * 33], s[7 * 33]);
        *(uint4*)(WT + (size_t)(row_off + n0 + n) * ldt + col_off + k0 + 8 * c) = o; }
    __builtin_amdgcn_s_waitcnt(0xc07f); asm volatile("" ::: "memory");
}
__device__ __forceinline__ void transpose_ph(const int WID_, const float* W, int K, int N, bf16* WT, int ldt, int row_off, int col_off, char* lds, const float* kscale = nullptr) {
    const int lane = (WID_ * 64 + lane_id()) & 63, wv = (WID_ * 64 + lane_id()) >> 6;
    float* scr = (float*)(lds + wv * 16384);
    const int nitems = (K / 64) * (N / 32);
    for (int it = GB * 8 + wv; it < nitems; it += GN * 8) transpose_item(W, K, N, WT, ldt, row_off, col_off, scr, it, lane, kscale);
}

template <typename TO>
__device__ __forceinline__ void rmsnorm_ph(const int WID_, const float* __restrict__ x, const float* __restrict__ w, TO* __restrict__ out, int rows) {
    const int lane = lane_id(), wv = WID_;
    float4 g[4];
#pragma unroll
    for (int j = 0; j < 4; ++j) g[j] = *(const float4*)(w + (lane + 64 * j) * 4);
    for (int row = (GB * 8 + wv) * 2; row < rows; row += GN * 16) {
        const float4* xr = (const float4*)(x + (size_t)row * D);
        float4 v[2][4]; float s[2] = {0.f, 0.f};
#pragma unroll
        for (int r = 0; r < 2; ++r)
#pragma unroll
            for (int j = 0; j < 4; ++j) v[r][j] = xr[r * (D / 4) + lane + 64 * j];
#pragma unroll
        for (int r = 0; r < 2; ++r) {
#pragma unroll
            for (int j = 0; j < 4; ++j) s[r] += v[r][j].x * v[r][j].x + v[r][j].y * v[r][j].y + v[r][j].z * v[r][j].z + v[r][j].w * v[r][j].w;
            s[r] = wave_sum(s[r]);
            const float rs = rsqrtf(s[r] * (1.f / D) + 1e-6f);
#pragma unroll
            for (int j = 0; j < 4; ++j) {
                uint2 o; o.x = pk2(v[r][j].x * rs * g[j].x, v[r][j].y * rs * g[j].y); o.y = pk2(v[r][j].z * rs * g[j].z, v[r][j].w * rs * g[j].w);
                *(uint2*)(out + (size_t)(row + r) * D + (lane + 64 * j) * 4) = o;
            }
        }
    }
}

__device__ __forceinline__ void rwkv_lin_ph(const int WID_, const bf16* __restrict__ proj, const float* __restrict__ mu, bf16* __restrict__ lin) {
    const int lane = lane_id(), wv = WID_;
    const float4 m4 = *(const float4*)(mu + 1536 + 4 * lane);
    const float mm[4] = {m4.x, m4.y, m4.z, m4.w};
    for (int m0 = (GB * 8 + wv) * 4; m0 < M; m0 += GN * 32) {
        uint2 z[4], zp[4];
#pragma unroll
        for (int i = 0; i < 4; ++i) { const int m = m0 + i; z[i] = *(const uint2*)(proj + (size_t)m * DSHIFT + 1536 + 4 * lane);
            zp[i] = make_uint2(0, 0); if ((m & (S - 1)) != 0) zp[i] = *(const uint2*)(proj + (size_t)(m - 1) * DSHIFT + 1536 + 4 * lane); }
#pragma unroll
        for (int i = 0; i < 4; ++i) {
            float c[4] = {__builtin_bit_cast(float, z[i].x << 16), __builtin_bit_cast(float, z[i].x & 0xffff0000u), __builtin_bit_cast(float, z[i].y << 16), __builtin_bit_cast(float, z[i].y & 0xffff0000u)};
            const float q[4] = {__builtin_bit_cast(float, zp[i].x << 16), __builtin_bit_cast(float, zp[i].x & 0xffff0000u), __builtin_bit_cast(float, zp[i].y << 16), __builtin_bit_cast(float, zp[i].y & 0xffff0000u)};
#pragma unroll
            for (int e = 0; e < 4; ++e) { float t = c[e] + (q[e] - c[e]) * mm[e];
                if (lane < 16) t = 1.f - 2.f / (1.f + __expf(2.f * t));
                else if (lane >= 32) t = sigmoidf_(t);
                c[e] = t; }
            uint2 o; o.x = pk2(c[0], c[1]); o.y = pk2(c[2], c[3]);
            *(uint2*)(lin + (size_t)(m0 + i) * 256 + 4 * lane) = o;
        }
    }
}
__device__ __forceinline__ void rwkv_wl_ph(const int WID_, const float* __restrict__ wdec, const float* __restrict__ wiclr, const float* __restrict__ wgate, bf16* __restrict__ wl) {
    for (int i = GB * NT + (WID_ * 64 + lane_id()); i < 1536 * 256; i += GN * NT) {
        const int k = i & 255, n = i >> 8; float v = 0.f;
        if (n < 512) { if (k < 64) v = wdec[k * 512 + n]; }
        else if (n < 1024) { if (k >= 64 && k < 128) v = wiclr[(k - 64) * 512 + (n - 512)]; }
        else { if (k >= 128) v = wgate[(k - 128) * 512 + (n - 1024)]; }
        wl[i] = f2bf(v);
    }
}
struct RwkvIn { const bf16* proj; const bf16* LW; const bf16* AA; const float* mu; const float* k_k; const float* k_a; const float* r_k; float* Y; float* RK; };
constexpr int TB = 64;
constexpr int RW_ITEMS = NB * 8;
template <int CTRL> __device__ __forceinline__ float dpp16(float x) { return __builtin_bit_cast(float, __builtin_amdgcn_update_dpp(0, __builtin_bit_cast(int, x), CTRL, 0xf, 0xf, true)); }
__device__ __forceinline__ void rwkv_scan_ph(const int WID_, const RwkvIn& I, char* lds) {
    float* Rs = (float*)lds; float* Ws = Rs + TB * 64; float* Kps = Ws + TB * 64; float* KKs = Kps + TB * 64; float* Bs = KKs + TB * 64; float* Vs = Bs + TB * 64; float* Ys = Vs + TB * 64;
    const int lane = (WID_ * 64 + lane_id()) & 63, wv = (WID_ * 64 + lane_id()) >> 6;
    for (int item = GB; item < RW_ITEMS; item += GN) {
        const int half = item & 1, h = (item >> 1) & 7, b = item >> 4;
        const int j = lane & 15, rl = 4 * wv + (lane >> 4), row = 32 * half + rl;
        float s0 = 0.f, s1 = 0.f, s2 = 0.f, s3 = 0.f, sa = 0.f;
        const int tau = (WID_ * 64 + lane_id()) >> 3, cg = (WID_ * 64 + lane_id()) & 7, ch0 = h * 64 + cg * 8;
        uint4 gr, gk, gv, qr, qk, qv, ga, gl;
#define RW_ISSUE(blk) do { const int t_ = (blk) * TB + tau; const size_t m_ = (size_t)b * S + t_; const bf16* z_ = I.proj + m_ * DSHIFT + ch0; \
            gr = *(const uint4*)(z_); gk = *(const uint4*)(z_ + 512); gv = *(const uint4*)(z_ + 1024); \
            if (t_ > 0) { qr = *(const uint4*)(z_ - DSHIFT); qk = *(const uint4*)(z_ + 512 - DSHIFT); qv = *(const uint4*)(z_ + 1024 - DSHIFT); } \
            else { qr = make_uint4(0, 0, 0, 0); qk = qr; qv = qr; } \
            ga = *(const uint4*)(I.AA + m_ * 512 + ch0); gl = *(const uint4*)(I.LW + m_ * 512 + ch0); } while (0)
#define RW_COMMIT(blk) do { \
            const unsigned wr_[4] = {gr.x, gr.y, gr.z, gr.w}, wk_[4] = {gk.x, gk.y, gk.z, gk.w}, wv_[4] = {gv.x, gv.y, gv.z, gv.w}; \
            const unsigned pr_[4] = {qr.x, qr.y, qr.z, qr.w}, pk_[4] = {qk.x, qk.y, qk.z, qk.w}, pv_[4] = {qv.x, qv.y, qv.z, qv.w}; \
            const unsigned wa_[4] = {ga.x, ga.y, ga.z, ga.w}, wl_[4] = {gl.x, gl.y, gl.z, gl.w}; \
            float r_[8], k_[8], v_[8], a_[8], kk_[8], ss_ = 0.f, rk_ = 0.f; \
            _Pragma("unroll") for (int e = 0; e < 8; ++e) { const int w_ = e >> 1; const bool hi_ = e & 1; \
                auto ex = [&](unsigned u) { return hi_ ? __builtin_bit_cast(float, u & 0xffff0000u) : __builtin_bit_cast(float, u << 16); }; \
                const float mr_ = I.mu[ch0 + e], mk_ = I.mu[512 + ch0 + e], mv_ = I.mu[1024 + ch0 + e]; \
                float x = ex(wr_[w_]); r_[e] = x + (ex(pr_[w_]) - x) * mr_; x = ex(wk_[w_]); k_[e] = x + (ex(pk_[w_]) - x) * mk_; x = ex(wv_[w_]); v_[e] = x + (ex(pv_[w_]) - x) * mv_; \
                a_[e] = ex(wa_[w_]); kk_[e] = k_[e] * I.k_k[ch0 + e]; ss_ += kk_[e] * kk_[e]; } \
            ss_ += dpp16<0xB1>(ss_); ss_ += dpp16<0x4E>(ss_); ss_ += dpp16<0x141>(ss_); \
            const float inv_ = 1.f / fmaxf(sqrtf(ss_), 1e-12f); \
            float o_[6][8]; \
            _Pragma("unroll") for (int e = 0; e < 8; ++e) { const int w_ = e >> 1; const bool hi_ = e & 1; \
                const float lw_ = hi_ ? __builtin_bit_cast(float, wl_[w_] & 0xffff0000u) : __builtin_bit_cast(float, wl_[w_] << 16); \
                const float kp_ = k_[e] * (1.f + (a_[e] - 1.f) * I.k_a[ch0 + e]); const float kn_ = kk_[e] * inv_; \
                o_[0][e] = r_[e]; o_[1][e] = __expf(lw_); o_[2][e] = kp_; o_[3][e] = kn_; o_[4][e] = kn_ * a_[e]; o_[5][e] = v_[e]; rk_ += r_[e] * kp_ * I.r_k[ch0 + e]; } \
            _Pragma("unroll") for (int q_ = 0; q_ < 6; ++q_) { float* d_ = Rs + q_ * (TB * 64) + tau * 64 + cg * 8; \
                *(float4*)d_ = make_float4(o_[q_][0], o_[q_][1], o_[q_][2], o_[q_][3]); *(float4*)(d_ + 4) = make_float4(o_[q_][4], o_[q_][5], o_[q_][6], o_[q_][7]); } \
            if (half == 0) { rk_ += dpp16<0xB1>(rk_); rk_ += dpp16<0x4E>(rk_); rk_ += dpp16<0x141>(rk_); \
                if (cg == 0) I.RK[((size_t)b * S + (blk) * TB + tau) * 8 + h] = rk_; } } while (0)
        RW_ISSUE(0);
        __syncthreads();
        RW_COMMIT(0);
        __syncthreads();
        for (int blk = 0; blk < S / TB; ++blk) {
            if (blk + 1 < S / TB) RW_ISSUE(blk + 1);
            float4 r4 = *(const float4*)(Rs + 4 * j), w4 = *(const float4*)(Ws + 4 * j), k4 = *(const float4*)(Kps + 4 * j), b4 = *(const float4*)(Bs + 4 * j);
            float vv = Vs[row];
            if (blk == 0) sa = 0.f;
#pragma unroll 2
            for (int t = 0; t < TB; ++t) {
                const int tn = (t + 1 < TB) ? t + 1 : t;
                const float4 n4n = *(const float4*)(KKs + tn * 64 + 4 * j);
                const float4 r4n = *(const float4*)(Rs + tn * 64 + 4 * j), w4n = *(const float4*)(Ws + tn * 64 + 4 * j), k4n = *(const float4*)(Kps + tn * 64 + 4 * j), b4n = *(const float4*)(Bs + tn * 64 + 4 * j);
                const float vvn = Vs[tn * 64 + row];
                s0 = s0 * w4.x + (sa * b4.x + vv * k4.x);
                s1 = s1 * w4.y + (sa * b4.y + vv * k4.y);
                s2 = s2 * w4.z + (sa * b4.z + vv * k4.z);
                s3 = s3 * w4.w + (sa * b4.w + vv * k4.w);
                float py = (s0 * r4.x + s1 * r4.y) + (s2 * r4.z + s3 * r4.w);
                float ps = (s0 * n4n.x + s1 * n4n.y) + (s2 * n4n.z + s3 * n4n.w);
                py += dpp16<0xB1>(py); ps += dpp16<0xB1>(ps);
                py += dpp16<0x4E>(py); ps += dpp16<0x4E>(ps);
                py += dpp16<0x141>(py); ps += dpp16<0x141>(ps);
                py += dpp16<0x140>(py); ps += dpp16<0x140>(ps);
                if (j == 0) Ys[t * 32 + rl] = py;
                if (t + 1 < TB) sa = -ps;
                r4 = r4n; w4 = w4n; k4 = k4n; b4 = b4n; vv = vvn;
            }
            __syncthreads();
            { const int t = (WID_ * 64 + lane_id()) >> 3, r0 = ((WID_ * 64 + lane_id()) & 7) * 4; const size_t m = (size_t)b * S + blk * TB + t;
              *(float4*)(I.Y + m * 512 + h * 64 + 32 * half + r0) = *(const float4*)(Ys + t * 32 + r0); }
            if (blk + 1 < S / TB) RW_COMMIT(blk + 1);
            __syncthreads();
            if (blk + 1 < S / TB) { const float4 n4 = *(const float4*)(KKs + 4 * j);
                float ps = (s0 * n4.x + s1 * n4.y) + (s2 * n4.z + s3 * n4.w);
                ps += dpp16<0xB1>(ps); ps += dpp16<0x4E>(ps); ps += dpp16<0x141>(ps); ps += dpp16<0x140>(ps);
                sa = -ps; }
        }
    }
}

namespace ck {
typedef float f32x2_t __attribute__((ext_vector_type(2)));
typedef __bf16 bf16x2_t __attribute__((ext_vector_type(2)));
__device__ __forceinline__ unsigned cvtpk(float lo, float hi) { const f32x2_t v = {lo, hi}; const bf16x2_t b = __builtin_convertvector(v, bf16x2_t); return __builtin_bit_cast(unsigned, b); }
typedef short bf16x8 __attribute__((ext_vector_type(8)));
typedef float f32x16 __attribute__((ext_vector_type(16)));
constexpr int LD = 72;
constexpr int MB = 64 * LD * 2;
constexpr int O_AB = 0, O_RB = MB, O_BB = 2 * MB, O_KB = 3 * MB, O_AT = 4 * MB, O_W1T = 5 * MB, O_BT = 6 * MB, O_KT = 7 * MB, O_VT = 8 * MB,
              O_NM = 9 * MB, O_AAK = 10 * MB, O_ARB = 11 * MB, O_ARK = 12 * MB, O_G = 13 * MB, O_TOT = O_G + 16384;
constexpr int O_TM = O_AB, O_X1T = O_BB, O_NMF = O_G, O_TT = O_G + 8192, O_ZT = O_TT + 5120;
constexpr int ITEM_BYTES = 32768;
template <int K, typename PA, typename PB>
__device__ __forceinline__ f32x16 mm_tile(f32x16 acc, PA A, int lda, PB B, int ldb, int lane) {
    const int r = lane & 31, h = lane >> 5;
    bf16x8 a[K / 16], b[K / 16];
#pragma unroll
    for (int q = 0; q < K / 16; ++q) { a[q] = *(const bf16x8*)(A + r * lda + 16 * q + 8 * h); b[q] = *(const bf16x8*)(B + r * ldb + 16 * q + 8 * h); }
#pragma unroll
    for (int q = 0; q < K / 16; ++q) acc = __builtin_amdgcn_mfma_f32_32x32x16_bf16(a[q], b[q], acc, 0, 0, 0);
    return acc;
}
__device__ __forceinline__ int crow(int reg, int h) { return (reg & 3) + 8 * (reg >> 2) + 4 * h; }
__device__ __forceinline__ void store_tr(const f32x16& acc, bf16* Ct, int ldct, int lane) {
    const int c = lane & 31, h = lane >> 5;
#pragma unroll
    for (int g = 0; g < 4; ++g) { uint2 w; w.x = cvtpk(acc[4 * g], acc[4 * g + 1]); w.y = cvtpk(acc[4 * g + 2], acc[4 * g + 3]); *(uint2*)(Ct + c * ldct + 8 * g + 4 * h) = w; }
}
__device__ __forceinline__ void store_rm(const f32x16& acc, bf16* C, int ldc, int lane) {
    const int c = lane & 31, h = lane >> 5;
#pragma unroll
    for (int rg = 0; rg < 16; ++rg) C[crow(rg, h) * ldc + c] = f2bf(acc[rg]);
}
__device__ __forceinline__ f32x16 zero16() { return (f32x16){0.f, 0.f, 0.f, 0.f, 0.f, 0.f, 0.f, 0.f, 0.f, 0.f, 0.f, 0.f, 0.f, 0.f, 0.f, 0.f}; }
struct In { const bf16* proj; const bf16* LW; const bf16* AA; const float* mu; const float* k_k; const float* k_a; const float* r_k; float* RK; char* items; };

__device__ __forceinline__ void phase1(const int WID_, const In& I, char* lds) {
    const int wv = WID_;
#define MAT(off) ((bf16*)(lds + (off)))
    float* G = (float*)(lds + O_G); float* TOT = (float*)(lds + O_TOT); float* NMF = (float*)(lds + O_NMF);
    for (int item = GB; item < NB * 8 * (S / 64); item += GN) {
        const int lane = lane_id(), tid = wv * 64 + lane;
        const int c = item & 127, h = (item >> 7) & 7, b = item >> 10;
        char* out = I.items + (size_t)item * ITEM_BYTES;
        const int s = tid >> 3, cg = tid & 7, ch0 = h * 64 + cg * 8, t = c * 64 + s; const size_t m = (size_t)b * S + t;
        float r_[8], kp_[8], v_[8], kk_[8], b_[8];
        {
            const bf16* z = I.proj + m * DSHIFT + ch0;
            const uint4 gr = *(const uint4*)(z), gk = *(const uint4*)(z + 512), gv = *(const uint4*)(z + 1024);
            uint4 qr = make_uint4(0, 0, 0, 0), qk = qr, qv = qr;
            if (t > 0) { qr = *(const uint4*)(z - DSHIFT); qk = *(const uint4*)(z + 512 - DSHIFT); qv = *(const uint4*)(z + 1024 - DSHIFT); }
            const uint4 ga = *(const uint4*)(I.AA + m * 512 + ch0), gl = *(const uint4*)(I.LW + m * 512 + ch0);
            const float4 c_mr0 = *(const float4*)(I.mu + ch0), c_mr1 = *(const float4*)(I.mu + ch0 + 4), c_mk0 = *(const float4*)(I.mu + 512 + ch0), c_mk1 = *(const float4*)(I.mu + 512 + ch0 + 4);
            const float4 c_mv0 = *(const float4*)(I.mu + 1024 + ch0), c_mv1 = *(const float4*)(I.mu + 1024 + ch0 + 4), c_kk0 = *(const float4*)(I.k_k + ch0), c_kk1 = *(const float4*)(I.k_k + ch0 + 4);
            const float4 c_ka0 = *(const float4*)(I.k_a + ch0), c_ka1 = *(const float4*)(I.k_a + ch0 + 4), c_rk0 = *(const float4*)(I.r_k + ch0), c_rk1 = *(const float4*)(I.r_k + ch0 + 4);
            const float mur[8] = {c_mr0.x, c_mr0.y, c_mr0.z, c_mr0.w, c_mr1.x, c_mr1.y, c_mr1.z, c_mr1.w}, muk[8] = {c_mk0.x, c_mk0.y, c_mk0.z, c_mk0.w, c_mk1.x, c_mk1.y, c_mk1.z, c_mk1.w};
            const float muv[8] = {c_mv0.x, c_mv0.y, c_mv0.z, c_mv0.w, c_mv1.x, c_mv1.y, c_mv1.z, c_mv1.w}, ckk[8] = {c_kk0.x, c_kk0.y, c_kk0.z, c_kk0.w, c_kk1.x, c_kk1.y, c_kk1.z, c_kk1.w};
            const float cka[8] = {c_ka0.x, c_ka0.y, c_ka0.z, c_ka0.w, c_ka1.x, c_ka1.y, c_ka1.z, c_ka1.w}, crk[8] = {c_rk0.x, c_rk0.y, c_rk0.z, c_rk0.w, c_rk1.x, c_rk1.y, c_rk1.z, c_rk1.w};
            const unsigned wr[4] = {gr.x, gr.y, gr.z, gr.w}, wk[4] = {gk.x, gk.y, gk.z, gk.w}, wv4[4] = {gv.x, gv.y, gv.z, gv.w};
            const unsigned pr[4] = {qr.x, qr.y, qr.z, qr.w}, pk[4] = {qk.x, qk.y, qk.z, qk.w}, pv[4] = {qv.x, qv.y, qv.z, qv.w};
            const unsigned wa[4] = {ga.x, ga.y, ga.z, ga.w}, wl[4] = {gl.x, gl.y, gl.z, gl.w};
            float ss = 0.f, rk = 0.f, a_[8];
#pragma unroll
            for (int e = 0; e < 8; ++e) { const int w_ = e >> 1; const bool hi = e & 1;
                auto ex = [&](unsigned u) { return hi ? __builtin_bit_cast(float, u & 0xffff0000u) : __builtin_bit_cast(float, u << 16); };
                float x = ex(wr[w_]); r_[e] = x + (ex(pr[w_]) - x) * mur[e];
                x = ex(wk[w_]); const float k = x + (ex(pk[w_]) - x) * muk[e];
                x = ex(wv4[w_]); v_[e] = x + (ex(pv[w_]) - x) * muv[e];
                a_[e] = ex(wa[w_]); kk_[e] = k * ckk[e]; ss += kk_[e] * kk_[e];
                kp_[e] = k * (1.f + (a_[e] - 1.f) * cka[e]); rk += r_[e] * kp_[e] * crk[e];
                G[s * 64 + cg * 8 + e] = ex(wl[w_]); }
            ss += dpp16<0xB1>(ss); ss += dpp16<0x4E>(ss); ss += dpp16<0x141>(ss);
            const float inv = 1.f / fmaxf(sqrtf(ss), 1e-12f);
#pragma unroll
            for (int e = 0; e < 8; ++e) { kk_[e] *= inv; b_[e] = kk_[e] * a_[e]; }
            rk += dpp16<0xB1>(rk); rk += dpp16<0x4E>(rk); rk += dpp16<0x141>(rk);
            if (cg == 0) I.RK[m * 8 + h] = rk;
        }
        __syncthreads();
        { const int ch = tid & 63, part = tid >> 6; float run = 0.f;
#pragma unroll
          for (int i = 0; i < 8; ++i) { run += G[(8 * part + i) * 64 + ch]; G[(8 * part + i) * 64 + ch] = run; }
          TOT[part * 64 + ch] = run; }
        __syncthreads();
        { const int ch = tid & 63, part = tid >> 6; float off = 0.f;
          for (int p = 0; p < part; ++p) off += TOT[p * 64 + ch];
#pragma unroll
          for (int i = 0; i < 8; ++i) G[(8 * part + i) * 64 + ch] += off; }
        __syncthreads();
        float glast[8];
        {
            unsigned pab[4], prb[4], pbb[4], pkb[4];
            float ab[8], rb[8], bb[8], kb[8], bt[8], kt[8];
#pragma unroll
            for (int e = 0; e < 8; ++e) { const float g = G[s * 64 + cg * 8 + e], gm1 = (s > 0) ? G[(s - 1) * 64 + cg * 8 + e] : 0.f, gL = G[63 * 64 + cg * 8 + e];
                glast[e] = gL;
                const float eg = __expf(g), eng = __expf(-g), egm = __expf(gm1), egl = __expf(gL - g);
                ab[e] = -kk_[e] * egm; rb[e] = r_[e] * eg; bb[e] = b_[e] * eng; kb[e] = kp_[e] * eng; bt[e] = b_[e] * egl; kt[e] = kp_[e] * egl; }
#pragma unroll
            for (int q = 0; q < 4; ++q) { pab[q] = pk2(ab[2 * q], ab[2 * q + 1]); prb[q] = pk2(rb[2 * q], rb[2 * q + 1]); pbb[q] = pk2(bb[2 * q], bb[2 * q + 1]); pkb[q] = pk2(kb[2 * q], kb[2 * q + 1]); }
            *(uint4*)(MAT(O_AB) + s * LD + cg * 8) = make_uint4(pab[0], pab[1], pab[2], pab[3]);
            *(uint4*)(MAT(O_RB) + s * LD + cg * 8) = make_uint4(prb[0], prb[1], prb[2], prb[3]);
            *(uint4*)(MAT(O_BB) + s * LD + cg * 8) = make_uint4(pbb[0], pbb[1], pbb[2], pbb[3]);
            *(uint4*)(MAT(O_KB) + s * LD + cg * 8) = make_uint4(pkb[0], pkb[1], pkb[2], pkb[3]);
#pragma unroll
            for (int e = 0; e < 8; ++e) { const int k = cg * 8 + e;
                MAT(O_AT)[k * LD + s] = f2bf(ab[e]); MAT(O_BT)[k * LD + s] = f2bf(bt[e]); MAT(O_KT)[k * LD + s] = f2bf(kt[e]); MAT(O_VT)[k * LD + s] = f2bf(v_[e]); }
        }
        __syncthreads();
        if (s == 63) {
#pragma unroll
            for (int e = 0; e < 8; ++e) TOT[cg * 8 + e] = __expf(glast[e]);
        }
        {
            const int mat = tid >> 7, row = (tid >> 2) & 31, chunk = tid & 3;
            *(uint4*)(MAT(O_NM + mat * MB) + row * LD + 32 + chunk * 8) = make_uint4(0, 0, 0, 0);
        }
        for (int task = wv; task < 12; task += 8) {
            const int mat = task / 3, tt = task % 3, st = (tt == 0) ? 0 : 1, jt = (tt == 2) ? 1 : 0;
            const bf16* Asrc = MAT((mat & 1) ? O_KB : O_BB) + 32 * jt * LD;
            const bf16* Bsrc = MAT((mat >> 1) ? O_RB : O_AB) + 32 * st * LD;
            f32x16 acc = mm_tile<64>(zero16(), Asrc, LD, Bsrc, LD, lane);
            const int cs = 32 * st + (lane & 31), hh = lane >> 5; const bool incl = (mat >> 1) != 0;
#pragma unroll
            for (int rg = 0; rg < 16; ++rg) { const int j = 32 * jt + crow(rg, hh); const bool keep = incl ? (j <= cs) : (j < cs); if (!keep) acc[rg] = 0.f; }
            store_tr(acc, MAT(O_NM + mat * MB) + 32 * st * LD + 32 * jt, LD, lane);
            if (mat == 0 && st == jt) {
                float* d = NMF + st * 1024 + (lane & 31) * 32;
#pragma unroll
                for (int g = 0; g < 4; ++g) *(float4*)(d + 8 * g + 4 * hh) = make_float4(acc[4 * g], acc[4 * g + 1], acc[4 * g + 2], acc[4 * g + 3]);
            }
        }
        __syncthreads();
        if (wv == 0) {
            const int d = lane >> 4, cc = lane & 15;
            const float* nb = NMF + (d >> 1) * 1024 + (16 * (d & 1)) * 32 + 16 * (d & 1);
            float T[16];
#pragma unroll
            for (int i = 0; i < 16; ++i) {
                float acc = (i == cc) ? 1.f : 0.f;
#pragma unroll
                for (int j4 = 0; j4 < i; j4 += 4) { const float4 n4 = *(const float4*)(nb + i * 32 + j4);
                    acc += n4.x * T[j4]; if (j4 + 1 < i) acc += n4.y * T[j4 + 1]; if (j4 + 2 < i) acc += n4.z * T[j4 + 2]; if (j4 + 3 < i) acc += n4.w * T[j4 + 3]; }
                T[i] = acc;
            }
            bf16* tm = MAT(O_TM) + (16 * d) * LD + 16 * d + cc;
#pragma unroll
            for (int i = 0; i < 16; ++i) tm[i * LD] = f2bf(T[i]);
            bf16* tt = MAT(O_TT) + (d >> 1) * 32 * 40 + (16 * (d & 1) + cc) * 40 + 16 * (d & 1);
            *(uint4*)(tt) = make_uint4(pk2(T[0], T[1]), pk2(T[2], T[3]), pk2(T[4], T[5]), pk2(T[6], T[7]));
            *(uint4*)(tt + 8) = make_uint4(pk2(T[8], T[9]), pk2(T[10], T[11]), pk2(T[12], T[13]), pk2(T[14], T[15]));
            { const int blk = lane >> 5, r16 = (lane >> 1) & 15, hf = lane & 1;
              *(uint4*)(MAT(O_TM) + (32 * blk + r16) * LD + 32 * blk + 16 + 8 * hf) = make_uint4(0, 0, 0, 0);
              *(uint4*)(MAT(O_TT) + blk * 32 * 40 + (16 + r16) * 40 + 8 * hf) = make_uint4(0, 0, 0, 0); }
        } else if (wv == 1) {
            const int row = lane >> 1, half = lane & 1;
            *(uint4*)(MAT(O_TM) + row * LD + 32 + half * 16) = make_uint4(0, 0, 0, 0); *(uint4*)(MAT(O_TM) + row * LD + 32 + half * 16 + 8) = make_uint4(0, 0, 0, 0);
        } else if (wv >= 4) {
            const int st = (wv - 4) >> 1, vt = (wv - 4) & 1;
            f32x16 acc = mm_tile<64>(zero16(), MAT(O_AAK) + 32 * st * LD, LD, MAT(O_VT) + 32 * vt * LD, LD, lane);
            store_tr(acc, MAT(O_W1T) + 32 * vt * LD + 32 * st, LD, lane);
        }
        __syncthreads();
        if (wv < 2) {
            typedef float f32x4v __attribute__((ext_vector_type(4)));
            const int blk = wv, fr = lane & 15, fq = lane >> 4;
            const bf16x8 zf = (bf16x8){0, 0, 0, 0, 0, 0, 0, 0};
            bf16x8 a = zf, bq = zf;
            if (fq < 2) { a = *(const bf16x8*)(MAT(O_NM) + (32 * blk + 16 + fr) * LD + 32 * blk + 8 * fq); bq = *(const bf16x8*)(MAT(O_TT) + blk * 32 * 40 + fr * 40 + 8 * fq); }
            f32x4v z = __builtin_amdgcn_mfma_f32_16x16x32_bf16(a, bq, (f32x4v){0.f, 0.f, 0.f, 0.f}, 0, 0, 0);
            bf16* zt = MAT(O_ZT) + blk * 16 * 24;
            { uint2 w; w.x = cvtpk(z[0], z[1]); w.y = cvtpk(z[2], z[3]); *(uint2*)(zt + fr * 24 + 4 * fq) = w; }
            asm volatile("s_waitcnt lgkmcnt(0)" ::: "memory");
            a = zf; bq = zf;
            if (fq < 2) { a = *(const bf16x8*)(MAT(O_TM) + (32 * blk + 16 + fr) * LD + 32 * blk + 16 + 8 * fq); bq = *(const bf16x8*)(zt + fr * 24 + 8 * fq); }
            const f32x4v t21 = __builtin_amdgcn_mfma_f32_16x16x32_bf16(a, bq, (f32x4v){0.f, 0.f, 0.f, 0.f}, 0, 0, 0);
#pragma unroll
            for (int rg = 0; rg < 4; ++rg) MAT(O_TM)[(32 * blk + 16 + 4 * fq + rg) * LD + 32 * blk + fr] = f2bf(t21[rg]);
            { uint2 w; w.x = cvtpk(t21[0], t21[1]); w.y = cvtpk(t21[2], t21[3]); *(uint2*)(MAT(O_TT) + blk * 32 * 40 + fr * 40 + 16 + 4 * fq) = w; }
        }
        __syncthreads();
        if (wv == 0) { f32x16 acc = mm_tile<32>(zero16(), MAT(O_NM) + 32 * LD, LD, MAT(O_TT), 40, lane); store_tr(acc, MAT(O_ZT), 40, lane); }
        __syncthreads();
        if (wv == 0) { f32x16 acc = mm_tile<32>(zero16(), MAT(O_TM) + 32 * LD + 32, LD, MAT(O_ZT), 40, lane); store_rm(acc, MAT(O_TM) + 32 * LD, LD, lane); }
        __syncthreads();
        { const int st = wv >> 2, ct = wv & 3;
          f32x16 acc = mm_tile<64>(zero16(), MAT(O_TM) + 32 * st * LD, LD, MAT(O_AT) + 32 * ct * LD, LD, lane);
          __syncthreads();
          store_tr(acc, MAT(O_X1T) + 32 * ct * LD + 32 * st, LD, lane); }
        __syncthreads();
        for (int u = wv; u < 16; u += 8) {
            const int kind = u >> 2, t0 = (u >> 1) & 1, t1 = u & 1, hh = lane >> 5, cc = lane & 31;
            if (kind == 0) {
                f32x16 acc = mm_tile<64>(zero16(), MAT(O_BT) + 32 * t0 * LD, LD, MAT(O_X1T) + (64 + 32 * t1) * LD, LD, lane);
                acc = mm_tile<64>(acc, MAT(O_KT) + 32 * t0 * LD, LD, MAT(O_VT) + 32 * t1 * LD, LD, lane);
                unsigned w[8];
#pragma unroll
                for (int q = 0; q < 8; ++q) w[q] = cvtpk(acc[2 * q], acc[2 * q + 1]);
                uint4* d = (uint4*)(out + 16384 + ((t0 * 2 + t1) * 64 + lane) * 32);
                d[0] = make_uint4(w[0], w[1], w[2], w[3]); d[1] = make_uint4(w[4], w[5], w[6], w[7]);
            } else if (kind == 1) {
                f32x16 acc = mm_tile<64>(zero16(), MAT(O_ARB) + 32 * t0 * LD, LD, MAT(O_X1T) + (64 + 32 * t1) * LD, LD, lane);
                acc = mm_tile<64>(acc, MAT(O_ARK) + 32 * t0 * LD, LD, MAT(O_VT) + 32 * t1 * LD, LD, lane);
                unsigned w[8];
#pragma unroll
                for (int q = 0; q < 8; ++q) w[q] = cvtpk(acc[2 * q], acc[2 * q + 1]);
                uint4* d = (uint4*)(out + 24576 + ((t0 * 2 + t1) * 64 + lane) * 32);
                d[0] = make_uint4(w[0], w[1], w[2], w[3]); d[1] = make_uint4(w[4], w[5], w[6], w[7]);
            } else if (kind == 2) {
                f32x16 acc = mm_tile<64>(zero16(), MAT(O_X1T) + 32 * t0 * LD, LD, MAT(O_BT) + 32 * t1 * LD, LD, lane);
                const int k = 32 * t1 + cc; const float gl = TOT[k];
                bf16* d = (bf16*)out + k * 64 + 32 * t0;
#pragma unroll
                for (int g = 0; g < 4; ++g) { float x[4];
#pragma unroll
                    for (int e = 0; e < 4; ++e) { const int kp = 32 * t0 + 8 * g + 4 * hh + e; x[e] = acc[4 * g + e] + ((kp == k) ? gl : 0.f); }
                    uint2 w; w.x = cvtpk(x[0], x[1]); w.y = cvtpk(x[2], x[3]); *(uint2*)(d + 8 * g + 4 * hh) = w; }
            } else {
                f32x16 acc = mm_tile<64>(zero16(), MAT(O_X1T) + 32 * t0 * LD, LD, MAT(O_ARB) + 32 * t1 * LD, LD, lane);
                const int sq = 32 * t1 + cc;
                bf16* d = (bf16*)(out + 8192) + sq * 64 + 32 * t0;
                const bf16* rb = MAT(O_RB) + sq * LD + 32 * t0;
#pragma unroll
                for (int g = 0; g < 4; ++g) { const uint2 rr = *(const uint2*)(rb + 8 * g + 4 * hh);
                    const float x0 = acc[4 * g] + __builtin_bit_cast(float, rr.x << 16), x1 = acc[4 * g + 1] + __builtin_bit_cast(float, rr.x & 0xffff0000u);
                    const float x2 = acc[4 * g + 2] + __builtin_bit_cast(float, rr.y << 16), x3 = acc[4 * g + 3] + __builtin_bit_cast(float, rr.y & 0xffff0000u);
                    uint2 w; w.x = cvtpk(x0, x1); w.y = cvtpk(x2, x3); *(uint2*)(d + 8 * g + 4 * hh) = w; }
            }
        }
        __syncthreads();
    }
#undef MAT
}
__device__ __forceinline__ void phase2(const int WID_, const char* items, float* Y, char* lds) {
    const int wv = WID_;
    bf16* HT0 = (bf16*)lds; bf16* HT1 = HT0 + 64 * LD;
    for (int head = GB; head < NB * 8; head += GN) {
        const int lane = lane_id(), hh = lane >> 5, cc = lane & 31;
        for (int i = wv * 64 + lane; i < 2 * 64 * LD / 8; i += NT) ((uint4*)lds)[i] = make_uint4(0, 0, 0, 0);
        __syncthreads();
        const int mi = (wv >> 1) & 1, ni = wv & 1; const bool upd = wv < 4;
        const int b = head >> 3, h = head & 7;
        const char* rec0 = items + (size_t)(head * 128) * ITEM_BYTES;
        const size_t coff = (upd ? 16384 : 24576) + ((mi * 2 + ni) * 64 + lane) * 32;
        const size_t aoff = (upd ? 0 : 8192) + ((32 * mi + cc) * 64 + 8 * hh) * 2;
        uint4 c0 = *(const uint4*)(rec0 + coff), c1 = *(const uint4*)(rec0 + coff + 16);
        bf16x8 af[4];
#pragma unroll
        for (int q = 0; q < 4; ++q) af[q] = *(const bf16x8*)(rec0 + aoff + 32 * q);
        for (int c = 0; c < S / 64; ++c) {
            const bf16* Hc = (c & 1) ? HT1 : HT0; bf16* Hn = (c & 1) ? HT0 : HT1;
            const unsigned cw[8] = {c0.x, c0.y, c0.z, c0.w, c1.x, c1.y, c1.z, c1.w};
            f32x16 acc;
#pragma unroll
            for (int q = 0; q < 8; ++q) { acc[2 * q] = __builtin_bit_cast(float, cw[q] << 16); acc[2 * q + 1] = __builtin_bit_cast(float, cw[q] & 0xffff0000u); }
            bf16x8 bfr[4];
#pragma unroll
            for (int q = 0; q < 4; ++q) bfr[q] = *(const bf16x8*)(Hc + (32 * ni + cc) * LD + 16 * q + 8 * hh);
#pragma unroll
            for (int q = 0; q < 4; ++q) acc = __builtin_amdgcn_mfma_f32_32x32x16_bf16(af[q], bfr[q], acc, 0, 0, 0);
            if (c + 1 < S / 64) { const char* rn = rec0 + (size_t)(c + 1) * ITEM_BYTES;
                c0 = *(const uint4*)(rn + coff); c1 = *(const uint4*)(rn + coff + 16);
#pragma unroll
                for (int q = 0; q < 4; ++q) af[q] = *(const bf16x8*)(rn + aoff + 32 * q); }
            if (upd) store_tr(acc, Hn + 32 * ni * LD + 32 * mi, LD, lane);
            else {
                float* yo = Y + ((size_t)b * S + c * 64 + 32 * mi) * 512 + h * 64 + 32 * ni + cc;
#pragma unroll
                for (int rg = 0; rg < 16; ++rg) yo[(size_t)crow(rg, hh) * 512] = acc[rg];
            }
            __syncthreads();
        }
    }
}
}

__device__ __forceinline__ void rwkv_post_ph(const int WID_, const float* __restrict__ Y, const float* __restrict__ RK, const bf16* __restrict__ proj, const float* __restrict__ mu, const bf16* __restrict__ G,
                             const float* __restrict__ lnw, const float* __restrict__ lnb, bf16* __restrict__ ymix) {
    const int lane = lane_id(), tk = WID_, grp = lane, ch0 = grp * 8, head = grp >> 3;
    const float4 mv0 = *(const float4*)(mu + 1024 + ch0), mv1 = *(const float4*)(mu + 1024 + ch0 + 4), lw0 = *(const float4*)(lnw + ch0), lw1 = *(const float4*)(lnw + ch0 + 4), lb0 = *(const float4*)(lnb + ch0), lb1 = *(const float4*)(lnb + ch0 + 4);
    const float muv[8] = {mv0.x, mv0.y, mv0.z, mv0.w, mv1.x, mv1.y, mv1.z, mv1.w}, lw_[8] = {lw0.x, lw0.y, lw0.z, lw0.w, lw1.x, lw1.y, lw1.z, lw1.w}, lb_[8] = {lb0.x, lb0.y, lb0.z, lb0.w, lb1.x, lb1.y, lb1.z, lb1.w};
    for (int m0 = GB * 16 + tk; m0 < M; m0 += GN * 16) {
        float4 ya[2], yb[2]; uint4 vv[2], pv[2], gg[2]; float rk[2];
#pragma unroll
        for (int u = 0; u < 2; ++u) { const int m = m0 + 8 * u;
            ya[u] = *(const float4*)(Y + (size_t)m * 512 + ch0); yb[u] = *(const float4*)(Y + (size_t)m * 512 + ch0 + 4);
            vv[u] = *(const uint4*)(proj + (size_t)m * DSHIFT + 1024 + ch0);
            pv[u] = (m & (S - 1)) ? *(const uint4*)(proj + (size_t)(m - 1) * DSHIFT + 1024 + ch0) : make_uint4(0, 0, 0, 0);
            gg[u] = *(const uint4*)(G + (size_t)m * 512 + ch0); rk[u] = RK[(size_t)m * 8 + head]; }
#pragma unroll
        for (int u = 0; u < 2; ++u) {
            const float y[8] = {ya[u].x, ya[u].y, ya[u].z, ya[u].w, yb[u].x, yb[u].y, yb[u].z, yb[u].w};
            float s = 0.f;
#pragma unroll
            for (int e = 0; e < 8; ++e) s += y[e];
            s += dpp16<0xB1>(s); s += dpp16<0x4E>(s); s += dpp16<0x141>(s);
            const float mean = s * (1.f / 64.f); float q = 0.f;
#pragma unroll
            for (int e = 0; e < 8; ++e) { const float d = y[e] - mean; q += d * d; }
            q += dpp16<0xB1>(q); q += dpp16<0x4E>(q); q += dpp16<0x141>(q);
            const float rstd = rsqrtf(q * (1.f / 64.f) + 64e-5f);
            const unsigned wv_[4] = {vv[u].x, vv[u].y, vv[u].z, vv[u].w}, wp_[4] = {pv[u].x, pv[u].y, pv[u].z, pv[u].w}, wg_[4] = {gg[u].x, gg[u].y, gg[u].z, gg[u].w};
            float o[8];
#pragma unroll
            for (int e = 0; e < 8; ++e) { const int w_ = e >> 1; const bool hi = e & 1;
                auto ex = [&](unsigned x) { return hi ? __builtin_bit_cast(float, x & 0xffff0000u) : __builtin_bit_cast(float, x << 16); };
                float v = ex(wv_[w_]); v += (ex(wp_[w_]) - v) * muv[e];
                o[e] = ((y[e] - mean) * rstd * lw_[e] + lb_[e] + rk[u] * v) * ex(wg_[w_]); }
            *(uint4*)(ymix + (size_t)(m0 + 8 * u) * D + ch0) = make_uint4(pk2(o[0], o[1]), pk2(o[2], o[3]), pk2(o[4], o[5]), pk2(o[6], o[7]));
        }
    }
}

constexpr int PSLOTS = NASSIGN + NEXP * 256;
constexpr int MAXTILES = PSLOTS / 256;
struct MoeBufs { int* tok_e; float* tok_g; int* tok_slot; int* slot_tok; float* slot_gate; int* bcnt; int* bbase; int* offs; int* tiles; int* ntiles; };
__device__ __forceinline__ void moe_zero_ph(const int WID_, const MoeBufs& mb) {
    for (int i = GB * NT + (WID_ * 64 + lane_id()); i < PSLOTS; i += GN * NT) { mb.slot_tok[i] = 0; mb.slot_gate[i] = 0.f; }
}
__device__ __forceinline__ void router_ph(const int WID_, const float* __restrict__ x3, const float* __restrict__ nw, bf16* __restrict__ h3, const float* __restrict__ wrg, const float* __restrict__ brg,
                          const float* __restrict__ wre, const float* __restrict__ bre, const MoeBufs& mb, char* lds) {
    const int lane = lane_id(), wv = WID_;
    int* lcnt = (int*)lds;
    _Float16* wg16 = (_Float16*)(lds + 256);
    _Float16* we16 = (_Float16*)(lds + 256 + 8192);
    if (wv == 0 && lane < 32) lcnt[lane] = 0;
    for (int i = wv * 64 + lane; i < 1024; i += NT) { const float4 w = *(const float4*)(wrg + i * 4);
        typedef _Float16 h4 __attribute__((ext_vector_type(4))); *(h4*)(wg16 + i * 4) = (h4){(_Float16)w.x, (_Float16)w.y, (_Float16)w.z, (_Float16)w.w}; }
    for (int i = wv * 64 + lane; i < 4 * 1024 * 2; i += NT) { const float4 w = *(const float4*)(wre + i * 4);
        typedef _Float16 h4 __attribute__((ext_vector_type(4))); *(h4*)(we16 + i * 4) = (h4){(_Float16)w.x, (_Float16)w.y, (_Float16)w.z, (_Float16)w.w}; }
    __syncthreads();
    typedef _Float16 h4 __attribute__((ext_vector_type(4)));
    typedef _Float16 h8 __attribute__((ext_vector_type(8)));
    for (int m = GB * 8 + wv; m < M; m += GN * 8) {
        const float4* xr = (const float4*)(x3 + (size_t)m * D);
        float h[16]; float s = 0.f;
#pragma unroll
        for (int j = 0; j < 4; ++j) { const float4 v = xr[lane + 64 * j]; h[4 * j] = v.x; h[4 * j + 1] = v.y; h[4 * j + 2] = v.z; h[4 * j + 3] = v.w; s += v.x * v.x + v.y * v.y + v.z * v.z + v.w * v.w; }
        s = wave_sum(s);
        const float rs = rsqrtf(s * (1.f / D) + 1e-6f);
        float l1[4] = {0.f, 0.f, 0.f, 0.f};
#pragma unroll
        for (int j = 0; j < 4; ++j) {
            const int k0 = (lane + 64 * j) * 4;
            const float4 g = *(const float4*)(nw + k0);
            h[4 * j] *= rs * g.x; h[4 * j + 1] *= rs * g.y; h[4 * j + 2] *= rs * g.z; h[4 * j + 3] *= rs * g.w;
            uint2 o; o.x = pk2(h[4 * j], h[4 * j + 1]); o.y = pk2(h[4 * j + 2], h[4 * j + 3]);
            *(uint2*)(h3 + (size_t)m * D + k0) = o;
#pragma unroll
            for (int e = 0; e < 4; ++e) { const h4 w = *(const h4*)(wg16 + (k0 + e) * 4); const float x = h[4 * j + e];
                l1[0] += x * (float)w[0]; l1[1] += x * (float)w[1]; l1[2] += x * (float)w[2]; l1[3] += x * (float)w[3]; }
        }
#pragma unroll
        for (int i = 0; i < 4; ++i) l1[i] = wave_sum(l1[i]) + brg[i];
        int grp = 0; float best = l1[0];
#pragma unroll
        for (int i = 1; i < 4; ++i) if (l1[i] > best) { best = l1[i]; grp = i; }
        float se = 0.f;
#pragma unroll
        for (int i = 0; i < 4; ++i) se += __expf(l1[i] - best);
        const float g1 = 1.f / se;
        float l2[8] = {};
        const _Float16* we = we16 + (size_t)grp * D * 8;
#pragma unroll
        for (int j = 0; j < 4; ++j) {
            const int k0 = (lane + 64 * j) * 4;
#pragma unroll
            for (int e = 0; e < 4; ++e) { const float x = h[4 * j + e]; const h8 w = *(const h8*)(we + (k0 + e) * 8);
#pragma unroll
                for (int q = 0; q < 8; ++q) l2[q] += x * (float)w[q]; }
        }
#pragma unroll
        for (int i = 0; i < 8; ++i) l2[i] = wave_sum(l2[i]) + bre[grp * 8 + i];
        int i0 = 0; float v0 = l2[0];
#pragma unroll
        for (int i = 1; i < 8; ++i) if (l2[i] > v0) { v0 = l2[i]; i0 = i; }
        int i1 = -1; float v1 = -3.0e38f;
#pragma unroll
        for (int i = 0; i < 8; ++i) if (i != i0 && l2[i] > v1) { v1 = l2[i]; i1 = i; }
        const float e1 = __expf(v1 - v0), inv = 1.f / (1.f + e1);
        if (lane == 0) {
            const int ea = grp * 8 + i0, eb = grp * 8 + i1;
            mb.tok_e[2 * m] = ea; mb.tok_e[2 * m + 1] = eb;
            mb.tok_g[2 * m] = g1 * inv; mb.tok_g[2 * m + 1] = g1 * e1 * inv;
            atomicAdd(&lcnt[ea], 1); atomicAdd(&lcnt[eb], 1);
        }
    }
    __syncthreads();
    if (wv == 0 && lane < 32) mb.bcnt[GB * 32 + lane] = lcnt[lane];
    __syncthreads();
}
__device__ __forceinline__ void moe_plan_ph(const int WID_, const MoeBufs& mb, char* lds) {
    if (GB != 0) return;
    int* tot = (int*)lds; int* off = tot + 32;
    const int t = WID_ * 64 + lane_id();
    if (t < 32) { int run = 0; for (int b = 0; b < GN; ++b) { const int c = __hip_atomic_load(mb.bcnt + b * 32 + t, __ATOMIC_RELAXED, __HIP_MEMORY_SCOPE_AGENT); mb.bbase[b * 32 + t] = run; run += c; } tot[t] = run; }
    __syncthreads();
    if (t == 0) { int o = 0, nt = 0;
        for (int e = 0; e < NEXP; ++e) { off[e] = o; mb.offs[e] = o; const int c = tot[e]; for (int r0 = 0; r0 < c; r0 += 256) { mb.tiles[nt] = e; ++nt; } o += ((c + 255) / 256) * 256; }
        *mb.ntiles = nt; }
    __syncthreads();
}
__device__ __forceinline__ void moe_scatter_ph(const int WID_, const MoeBufs& mb, char* lds) {
    const int lane = lane_id(), wv = WID_;
    int* cur = (int*)lds;
    if (wv == 0 && lane < 32) cur[lane] = __hip_atomic_load(mb.offs + lane, __ATOMIC_RELAXED, __HIP_MEMORY_SCOPE_AGENT) + __hip_atomic_load(mb.bbase + GB * 32 + lane, __ATOMIC_RELAXED, __HIP_MEMORY_SCOPE_AGENT);
    __syncthreads();
    for (int m0 = (GB * 8 + wv); m0 < M; m0 += GN * 8 * 32) {
        const int i = lane >> 1, m = m0 + i * GN * 8;
        if (m < M) { const int a = 2 * m + (lane & 1); const int e = mb.tok_e[a];
            const int pos = atomicAdd(&cur[e], 1);
            mb.slot_tok[pos] = m; mb.slot_gate[pos] = mb.tok_g[a]; mb.tok_slot[a] = pos; }
    }
    __syncthreads();
}
__device__ __forceinline__ void moe_gather_ph(const int WID_, const bf16* __restrict__ h3, bf16* __restrict__ xg, const MoeBufs& mb) {
    const int lane = lane_id(), wv = WID_;
    const int nrows = __hip_atomic_load(mb.ntiles, __ATOMIC_RELAXED, __HIP_MEMORY_SCOPE_AGENT) * 256;
    for (int r0 = (GB * 8 + wv) * 4; r0 < nrows; r0 += GN * 32) {
        uint4 a[4], c[4];
#pragma unroll
        for (int i = 0; i < 4; ++i) { const int t = mb.slot_tok[r0 + i]; const uint4* s = (const uint4*)(h3 + (size_t)t * D); a[i] = s[lane]; c[i] = s[lane + 64]; }
#pragma unroll
        for (int i = 0; i < 4; ++i) { uint4* d = (uint4*)(xg + (size_t)(r0 + i) * D); d[lane] = a[i]; d[lane + 64] = c[i]; }
    }
}
__device__ __forceinline__ void moe_weights_ph(const int WID_, const float* __restrict__ wg, const float* __restrict__ wu, const float* __restrict__ wd, bf16* __restrict__ wgu_t, bf16* __restrict__ wd_t, char* lds, int vb, int nvb) {
    const int lane = (WID_ * 64 + lane_id()) & 63, wv = (WID_ * 64 + lane_id()) >> 6;
    float* scr = (float*)(lds + wv * 16384);
    constexpr int I_GU = 16 * 16;
    constexpr int I_D = 8 * 32;
    constexpr int NIT = NEXP * (2 * I_GU + I_D);
    for (int it = vb * 8 + wv; it < NIT; it += nvb * 8) {
        const int e = it / (2 * I_GU + I_D); int r = it % (2 * I_GU + I_D);
        if (r < 2 * I_GU) {
            const int up = r / I_GU; r %= I_GU;
            const int kb = r / 16, nb = r % 16;
            const int pn = nb / 4, nsub = nb % 4;
            const float* W = (up ? wu : wg) + (size_t)e * D * DEXP + nb * 32;
            transpose_item(W + (size_t)kb * 64 * DEXP, 64, 32, wgu_t, D, e * 1024 + pn * 256 + up * 128 + nsub * 32, kb * 64, scr, 0, lane, nullptr, DEXP);
        } else {
            r -= 2 * I_GU;
            const int kb = r / 32, nb = r % 32;
            const float* W = wd + (size_t)e * DEXP * D + nb * 32;
            transpose_item(W + (size_t)kb * 64 * D, 64, 32, wd_t, DEXP, e * 1024 + nb * 32, kb * 64, scr, 0, lane, nullptr, D);
        }
    }
}
__device__ __forceinline__ void final_ph(const int WID_, float* __restrict__ out, const bf16* __restrict__ yslot, const int* __restrict__ tok_slot, const float* __restrict__ w) {
    const int lane = lane_id(), wv = WID_;
    float4 g[4];
#pragma unroll
    for (int j = 0; j < 4; ++j) g[j] = *(const float4*)(w + (lane + 64 * j) * 4);
    for (int row0 = (GB * 8 + wv) * 2; row0 < M; row0 += GN * 16) {
        float4 v[2][4]; uint2 ya[2][4], yb[2][4];
#pragma unroll
        for (int r = 0; r < 2; ++r) { const int row = row0 + r;
            const float4* xr = (const float4*)(out + (size_t)row * D);
            const uint2* pa = (const uint2*)(yslot + (size_t)tok_slot[2 * row] * D);
            const uint2* pb = (const uint2*)(yslot + (size_t)tok_slot[2 * row + 1] * D);
#pragma unroll
            for (int j = 0; j < 4; ++j) { v[r][j] = xr[lane + 64 * j]; ya[r][j] = pa[lane + 64 * j]; yb[r][j] = pb[lane + 64 * j]; } }
#pragma unroll
        for (int r = 0; r < 2; ++r) { float s = 0.f;
#pragma unroll
            for (int j = 0; j < 4; ++j) { const uint2 a = ya[r][j], b = yb[r][j];
                v[r][j].x += __builtin_bit_cast(float, a.x << 16) + __builtin_bit_cast(float, b.x << 16);
                v[r][j].y += __builtin_bit_cast(float, a.x & 0xffff0000u) + __builtin_bit_cast(float, b.x & 0xffff0000u);
                v[r][j].z += __builtin_bit_cast(float, a.y << 16) + __builtin_bit_cast(float, b.y << 16);
                v[r][j].w += __builtin_bit_cast(float, a.y & 0xffff0000u) + __builtin_bit_cast(float, b.y & 0xffff0000u);
                s += v[r][j].x * v[r][j].x + v[r][j].y * v[r][j].y + v[r][j].z * v[r][j].z + v[r][j].w * v[r][j].w; }
            s = wave_sum(s);
            const float rs = rsqrtf(s * (1.f / D) + 1e-6f);
            float4* xo = (float4*)(out + (size_t)(row0 + r) * D);
#pragma unroll
            for (int j = 0; j < 4; ++j) xo[lane + 64 * j] = make_float4(v[r][j].x * rs * g[j].x, v[r][j].y * rs * g[j].y, v[r][j].z * rs * g[j].z, v[r][j].w * rs * g[j].w); }
    }
}

struct S5Tab { float* Kmat; bf16* BtA; bf16* BtB; };
__device__ __forceinline__ void s5_lam(const float* lam_re, const float* lam_im, const float* log_dt, int g, int n, float& a, float& w) {
    const float dt = __expf(log_dt[g]); a = lam_re[g * 64 + n] * dt; w = lam_im[g * 64 + n] * dt;
}
__device__ __forceinline__ void cexpj(float a, float w, float j, float& re, float& im) { const float e = __expf(a * j); float s, c; sincosf(w * j, &s, &c); re = e * c; im = e * s; }
__device__ __forceinline__ void s5_bbar(const float* lam_re, const float* lam_im, const float* log_dt, const float* b_re, const float* b_im, int g, int n, int h, float& br, float& bi) {
    float a, w; s5_lam(lam_re, lam_im, log_dt, g, n, a, w);
    float lbr, lbi; cexpj(a, w, 1.f, lbr, lbi);
    const float lr = lam_re[g * 64 + n], li = lam_im[g * 64 + n];
    const float nr = lbr - 1.f, ni = lbi, den = lr * lr + li * li;
    const float cr = (nr * lr + ni * li) / den, ci = (ni * lr - nr * li) / den;
    const float xr = b_re[(g * 64 + n) * 16 + h], xi = b_im[(g * 64 + n) * 16 + h];
    br = cr * xr - ci * xi; bi = cr * xi + ci * xr;
}
__device__ __forceinline__ void s5_tables0_ph(const int WID_, const float* lam_re, const float* lam_im, const float* log_dt, const float* b_re, const float* b_im, const float* c_re, const float* c_im, const S5Tab& T) {
    const int gtid = GB * NT + (WID_ * 64 + lane_id()), gsz = GN * NT;
    for (int i = gtid; i < 32 * 32 * 256; i += gsz) {
        const int h = i & 15, hp = (i >> 4) & 15, j = (i >> 8) & 31, g = i >> 13;
        float acc = 0.f;
        for (int n = 0; n < 64; ++n) {
            float a, w; s5_lam(lam_re, lam_im, log_dt, g, n, a, w);
            float pr, pi; cexpj(a, w, (float)j, pr, pi);
            float br, bi; s5_bbar(lam_re, lam_im, log_dt, b_re, b_im, g, n, h, br, bi);
            const float tr = pr * br - pi * bi, ti = pr * bi + pi * br;
            acc += c_re[(g * 16 + hp) * 64 + n] * tr - c_im[(g * 16 + hp) * 64 + n] * ti;
        }
        T.Kmat[i] = acc;
    }
    for (int i = gtid; i < 32 * 256 * 512; i += gsz) {
        const int col = i & 511, r = (i >> 9) & 255, g = i >> 17;
        float v = 0.f;
        if (r < 128) {
            const int n = r & 63, s = col >> 4, h = col & 15;
            float a, w; s5_lam(lam_re, lam_im, log_dt, g, n, a, w);
            float pr, pi; cexpj(a, w, (float)(S5L - 1 - s), pr, pi);
            float br, bi; s5_bbar(lam_re, lam_im, log_dt, b_re, b_im, g, n, h, br, bi);
            v = (r < 64) ? (pr * br - pi * bi) : (pr * bi + pi * br);
        }
        T.BtA[((size_t)g * 768 + 512 + r) * 512 + col] = f2bf(v);
    }
    for (int i = gtid; i < 32 * 512 * 256; i += gsz) {
        const int k = i & 255, row = (i >> 8) & 511, g = i >> 17;
        float v = 0.f;
        if (k < 128) {
            const int n = k & 63, sp = row >> 4, hp = row & 15;
            float a, w; s5_lam(lam_re, lam_im, log_dt, g, n, a, w);
            float pr, pi; cexpj(a, w, (float)(sp + 1), pr, pi);
            const float cr = c_re[(g * 16 + hp) * 64 + n], ci = c_im[(g * 16 + hp) * 64 + n];
            v = (k < 64) ? (cr * pr - ci * pi) : -(cr * pi + ci * pr);
        }
        T.BtB[i] = f2bf(v);
    }
}
__device__ __forceinline__ void s5_tables1_ph(const int WID_, const float* dsk, const S5Tab& T) {
    const int gtid = GB * NT + (WID_ * 64 + lane_id()), gsz = GN * NT;
    for (int i = gtid; i < 32 * 512 * 512; i += gsz) {
        const int col = i & 511, row = (i >> 9) & 511, g = i >> 18;
        const int sp = row >> 4, hp = row & 15, s = col >> 4, h = col & 15;
        float v = 0.f;
        if (s <= sp) v = T.Kmat[((g * 32 + (sp - s)) * 16 + hp) * 16 + h];
        if (row == col) v += dsk[g * 16 + hp];
        T.BtA[((size_t)g * 768 + row) * 512 + col] = f2bf(v);
    }
}
__device__ __forceinline__ void s5_carry_ph(const int WID_, const float* lam_re, const float* lam_im, const float* log_dt, const float* __restrict__ F, bf16* __restrict__ XST, int vb, int nvb, char* lds) {
    float* TR = (float*)lds; float* TI = TR + 16 * 32;
    for (int item = vb; item < NB * 32 * 2; item += nvb) {
        const int lane = lane_id(), tid = WID_ * 64 + lane;
        const int nh = item & 1, g = (item >> 1) & 31, b = item >> 6, seg = tid >> 5, n = nh * 32 + (tid & 31);
        float a, w; s5_lam(lam_re, lam_im, log_dt, g, n, a, w);
        float pr, pi; cexpj(a, w, (float)S5L, pr, pi);
        const size_t row0 = (size_t)g * S5R + (size_t)b * (S / S5L) + seg * 16;
        const float* f = F + row0 * 128; bf16* xo = XST + row0 * 256;
        float fr[16], fi[16];
#pragma unroll
        for (int q = 0; q < 16; ++q) { fr[q] = f[(size_t)q * 128 + n]; fi[q] = f[(size_t)q * 128 + 64 + n]; }
#pragma unroll
        for (int q = 0; q < 16; ++q) if (nh == 0) *(uint2*)(xo + (size_t)q * 256 + 128 + (tid & 31) * 4) = make_uint2(0, 0);
        float xr = 0.f, xi = 0.f;
#pragma unroll
        for (int q = 0; q < 16; ++q) { const float nr = pr * xr - pi * xi + fr[q], ni = pr * xi + pi * xr + fi[q]; xr = nr; xi = ni; fr[q] = nr; fi[q] = ni; }
        TR[seg * 32 + (tid & 31)] = xr; TI[seg * 32 + (tid & 31)] = xi;
        __syncthreads();
        float p16r, p16i; cexpj(a, w, (float)(S5L * 16), p16r, p16i);
        float cr = 0.f, ci = 0.f;
        for (int s2 = 0; s2 < seg; ++s2) { const float tr = TR[s2 * 32 + (tid & 31)], ti = TI[s2 * 32 + (tid & 31)];
            const float nr = p16r * cr - p16i * ci + tr, ni = p16r * ci + p16i * cr + ti; cr = nr; ci = ni; }
        float er = cr, ei = ci;
#pragma unroll
        for (int q = 0; q < 16; ++q) {
            const float lr_ = (q > 0) ? fr[q - 1] : 0.f, li_ = (q > 0) ? fi[q - 1] : 0.f;
            xo[(size_t)q * 256 + n] = f2bf(er + lr_); xo[(size_t)q * 256 + 64 + n] = f2bf(ei + li_);
            const float nr = pr * er - pi * ei, ni = pr * ei + pi * er; er = nr; ei = ni;
        }
        __syncthreads();
    }
}
#define XB_TMO      128
#define XB_XCNT(j)  (256  + 64 * (j))
#define XB_XSUB(j)  (1280 + 64 * (j))
#define XB_XGEN(j)  (2304 + 64 * (j))
#define XB_TOP      3328
#define XB_TOPGEN   3392
#define XCD_BAR_WORDS 3456
#define XB_SPIN_CAP (1u << 20)
__device__ __forceinline__ unsigned xb_ld(unsigned* p)              { return __hip_atomic_load(p, __ATOMIC_RELAXED, __HIP_MEMORY_SCOPE_AGENT); }
__device__ __forceinline__ unsigned xb_add(unsigned* p, unsigned v) { return __hip_atomic_fetch_add(p, v, __ATOMIC_RELAXED, __HIP_MEMORY_SCOPE_AGENT); }
__device__ __forceinline__ unsigned xb_xcc_id() { return (unsigned)__builtin_amdgcn_s_getreg((3 << 11) | 20) & 0xFu; }
#define XB_SPIN(cond, bar) do { unsigned _sp = 0; while (cond) { __builtin_amdgcn_s_sleep(1); \
    if ((++_sp & 255u) == 0u) { if (xb_ld(&(bar)[XB_TMO])) break; if (_sp > XB_SPIN_CAP) { atomicAdd(&(bar)[XB_TMO], 1u); break; } } } } while (0)
struct XcdBarrier { unsigned* bar; unsigned x; volatile __attribute__((address_space(3))) unsigned* st; };
__device__ __forceinline__ XcdBarrier xcd_barrier_post(const int WID_, unsigned* bar, volatile __attribute__((address_space(3))) unsigned* st) {
    XcdBarrier b; b.bar = bar; b.x = xb_xcc_id(); b.st = st;
    if ((WID_ * 64 + lane_id()) == 0) (void)xb_add(&bar[XB_XCNT(b.x)], 1u);
    return b;
}
__device__ __forceinline__ void xcd_barrier_complete(unsigned* bar, unsigned x, unsigned& nloc, unsigned& nx) {
    const unsigned G = gridDim.x * gridDim.y * gridDim.z;
    unsigned sum, cnt, mine, sp = 0u;
    for (;;) {
        sum = 0u; cnt = 0u; mine = 0u;
#pragma unroll
        for (unsigned j = 0; j < 16; ++j) { const unsigned c = xb_ld(&bar[XB_XCNT(j)]); sum += c; cnt += (c > 0u) ? 1u : 0u; mine = (j == x) ? c : mine; }
        if (sum == G) break;
        __builtin_amdgcn_s_sleep(1);
        if ((++sp & 255u) == 0u) { if (xb_ld(&bar[XB_TMO])) break; if (sp > XB_SPIN_CAP) { atomicAdd(&bar[XB_TMO], 1u); break; } }
    }
    nloc = mine > 0u ? mine : 1u; nx = cnt > 0u ? cnt : 1u;
}
__device__ __forceinline__ void xcd_barrier(const int WID_, const XcdBarrier& b) {
    asm volatile("s_waitcnt vmcnt(0)" ::: "memory");
    __syncthreads();
    if ((WID_ * 64 + lane_id()) == 0) {
        unsigned* bar = b.bar;
        __builtin_amdgcn_s_waitcnt(0);
        unsigned nloc = b.st[0], nx = b.st[1];
        if (nloc == 0u) { xcd_barrier_complete(bar, b.x, nloc, nx); b.st[0] = nloc; b.st[1] = nx; }
        const unsigned old = xb_add(&bar[XB_XSUB(b.x)], 1u);
        const unsigned gen = old / nloc;
        if (old + 1u == (gen + 1u) * nloc) {
            __builtin_amdgcn_fence(__ATOMIC_RELEASE, "agent");
            asm volatile("s_waitcnt vmcnt(0)" ::: "memory");
            const unsigned og = xb_add(&bar[XB_TOP], 1u);
            const unsigned tg = og / nx;
            if (og + 1u == (tg + 1u) * nx) xb_add(&bar[XB_TOPGEN], 1u);
            else XB_SPIN(xb_ld(&bar[XB_TOPGEN]) == tg, bar);
            __builtin_amdgcn_fence(__ATOMIC_ACQUIRE, "agent");
            xb_add(&bar[XB_XGEN(b.x)], 1u);
            asm volatile("s_waitcnt vmcnt(0)" ::: "memory");
        } else {
            XB_SPIN(xb_ld(&bar[XB_XGEN(b.x)]) == gen, bar);
            __builtin_amdgcn_fence(__ATOMIC_ACQUIRE, "agent");
            asm volatile("s_waitcnt vmcnt(0)" ::: "memory");
        }
    }
    __syncthreads();
}

struct Params { const float* in[41]; float* out; char* ws; };

constexpr size_t W_PROJ = 0;
constexpr size_t W_US5 = 224;
constexpr size_t W_WTS = 288;
constexpr size_t W_YI = 352;
constexpr size_t W_F = 416;
constexpr size_t W_XST = 448;
constexpr size_t W_Z = 480;
constexpr size_t W_MISC = 544;
constexpr size_t W_XN = 576;
constexpr size_t W_CTL = 558;
constexpr size_t WO_IN = 0, WO_GLU = 5 * MiB, WO_MIX = 6 * MiB, WO_Q = 8 * MiB, WO_K = 10 * MiB, WO_V = 12 * MiB, WO_O = 14 * MiB, WO_KMAT = 16 * MiB, WO_BTA = 17 * MiB, WO_BTB = 41 * MiB;

__global__ void __launch_bounds__(NT, 2) fwd_kernel(Params p) {
    extern __shared__ __attribute__((aligned(16))) char lds[];
    const int WID_ = __builtin_amdgcn_readfirstlane((int)(threadIdx.x >> 6));
    cg::grid_group grid = cg::this_grid();
    PG8_LAS unsigned char* ldsl = (PG8_LAS unsigned char*)lds;
    char* ws = p.ws; char* dout = (char*)p.out; float* out = p.out;
#define IN(i) (p.in[i])
    volatile __attribute__((address_space(3))) unsigned* bst = (volatile __attribute__((address_space(3))) unsigned*)(ldsl + LDS_BYTES - 64);
    if (WID_ == 0 && lane_id() < 2) bst[lane_id()] = 0u;
    __syncthreads();
    const XcdBarrier xbar = xcd_barrier_post(WID_, (unsigned*)(ws + W_CTL * MiB), bst);
#ifndef PROBE_PHASE
#define PROBE_PHASE -1
#endif
    int sync_id = 0; unsigned long long pr_t0 = 0, pr_t1 = 0;
    if (PROBE_PHASE == 0) pr_t0 = __builtin_amdgcn_s_memrealtime();
#define SYNC() do { xcd_barrier(WID_, xbar); ++sync_id; if (sync_id == PROBE_PHASE) pr_t0 = __builtin_amdgcn_s_memrealtime(); if (sync_id == PROBE_PHASE + 1) pr_t1 = __builtin_amdgcn_s_memrealtime(); } while (0)
    char* WT = ws + W_WTS * MiB;
    bf16* w_in_t = (bf16*)(WT + WO_IN); bf16* w_glu_t = (bf16*)(WT + WO_GLU); bf16* w_mix_t = (bf16*)(WT + WO_MIX);
    bf16* w_q_t = (bf16*)(WT + WO_Q); bf16* w_k_t = (bf16*)(WT + WO_K); bf16* w_v_t = (bf16*)(WT + WO_V); bf16* w_o_t = (bf16*)(WT + WO_O);
    S5Tab stab; stab.Kmat = (float*)(WT + WO_KMAT); stab.BtA = (bf16*)(WT + WO_BTA); stab.BtB = (bf16*)(WT + WO_BTB);
    bf16* PROJ = (bf16*)(ws + W_PROJ * MiB); bf16* US5 = (bf16*)(ws + W_US5 * MiB);
    bf16* XN = (bf16*)(ws + W_XN * MiB);
    transpose_ph(WID_, IN(3), D, DIN, w_in_t, D, 0, 0, lds);
    transpose_ph(WID_, IN(23), 512, 512, w_glu_t, 512, 0, 0, lds);
    transpose_ph(WID_, IN(25), D, D, w_mix_t, D, 0, 0, lds);
    transpose_ph(WID_, IN(28), D, D, w_q_t, D, 0, 0, lds);
    transpose_ph(WID_, IN(29), D, D, w_k_t, D, 0, 0, lds);
    transpose_ph(WID_, IN(30), D, D, w_v_t, D, 0, 0, lds);
    transpose_ph(WID_, IN(31), D, D, w_o_t, D, 0, 0, lds);
    s5_tables0_ph(WID_, IN(15), IN(16), IN(17), IN(18), IN(19), IN(20), IN(21), stab);
    bf16* wl_t = (bf16*)(WT + 49 * MiB);
    rwkv_wl_ph(WID_, IN(6), IN(8), IN(9), wl_t);
    rmsnorm_ph<bf16>(WID_, IN(0), IN(2), XN, M);
    grid.sync(); ++sync_id; if (sync_id == PROBE_PHASE) pr_t0 = __builtin_amdgcn_s_memrealtime(); if (sync_id == PROBE_PHASE + 1) pr_t1 = __builtin_amdgcn_s_memrealtime();
    s5_tables1_ph(WID_, IN(22), stab);
    { pg8::PlainOrder S; S.init(XN, D, w_in_t, D, M, DIN, D); pg8::EpiProj E{PROJ, US5}; pg8::gemm_phase(WID_, ldsl, S, E); }
    SYNC();
    bf16* LIN = (bf16*)(ws + (W_MISC + 16) * MiB);
    rwkv_lin_ph(WID_, PROJ, IN(4), LIN);
    SYNC();
    bf16* YI = (bf16*)(ws + W_YI * MiB); float* F = (float*)(ws + W_F * MiB); bf16* XST = (bf16*)(ws + W_XST * MiB); bf16* Z = (bf16*)(ws + W_Z * MiB);
    bf16* LWb = (bf16*)(ws + 704 * MiB); bf16* AAb = (bf16*)(ws + 768 * MiB); bf16* Gb = (bf16*)(ws + 832 * MiB);
    float* Yr = (float*)(ws + 896 * MiB); float* RKb = (float*)(ws + W_MISC * MiB);
    { pg8::GroupOrder S; S.init(US5, 512, (size_t)S5R * 512, stab.BtA, 512, (size_t)768 * 512, 32, S5R, 768, 512); pg8::EpiS5a E{YI, F}; pg8::gemm_phase(WID_, ldsl, S, E); }
    { pg8::PlainOrder S; S.init(LIN, 256, wl_t, 256, M, 1536, 256); pg8::EpiLora E{LWb, (size_t)32 * MiB, IN(5), IN(7)}; pg8::gemm_phase(WID_, ldsl, S, E); }
    SYNC();
    { ck::In ci{PROJ, LWb, AAb, IN(4), IN(10), IN(11), IN(12), RKb, dout}; ck::phase1(WID_, ci, lds); }
    SYNC();
    bf16* WGU_t = (bf16*)(ws + 704 * MiB); bf16* WD_t = (bf16*)(ws + 768 * MiB);
    if (GB >= RW_ITEMS || GN <= RW_ITEMS) {
        const int vb = (GN > RW_ITEMS) ? GB - RW_ITEMS : GB, nvb = (GN > RW_ITEMS) ? GN - RW_ITEMS : GN;
        s5_carry_ph(WID_, IN(15), IN(16), IN(17), F, XST, vb, nvb, lds);
        moe_weights_ph(WID_, IN(37), IN(38), IN(39), WGU_t, WD_t, lds, vb, nvb);
    }
    if (GB < RW_ITEMS || GN <= RW_ITEMS) ck::phase2(WID_, dout, Yr, lds);
    SYNC();
    bf16* YMIX = XN;
    { pg8::GroupOrder S; S.init(XST, 256, (size_t)S5R * 256, stab.BtB, 256, (size_t)512 * 256, 32, S5R, 512, 256); pg8::EpiS5b E{YI, Z}; pg8::gemm_phase(WID_, ldsl, S, E); }
    rwkv_post_ph(WID_, Yr, RKb, PROJ, IN(4), Gb, IN(13), IN(14), YMIX);
    SYNC();
    { pg8::PlainOrder S; S.init(Z, 512, w_glu_t, 512, M, 512, 512); pg8::EpiGlu E{Z, IN(24), YMIX}; pg8::gemm_phase(WID_, ldsl, S, E); }
    SYNC();
    { pg8::PlainOrder S; S.init(YMIX, D, w_mix_t, D, M, D, D); pg8::EpiF32 E{out, D, IN(0), D}; pg8::gemm_phase(WID_, ldsl, S, E); }
    SYNC();
    bf16* KM = (bf16*)(ws + (W_MISC + 2) * MiB); bf16* VT = (bf16*)(ws + (W_MISC + 6) * MiB); bf16* MEMN = (bf16*)(ws + (W_MISC + 10) * MiB);
    rmsnorm_ph<bf16>(WID_, out, IN(26), XN, M);
    rmsnorm_ph<bf16>(WID_, IN(1), IN(27), MEMN, NB * NMEM);
    SYNC();
    bf16* Q = (bf16*)(ws + 128 * MiB);
    { pg8::PlainOrder S; S.init(MEMN, D, w_k_t, D, NB * NMEM, D, D); pg8::EpiBf16 E{KM, D}; pg8::gemm_phase(WID_, ldsl, S, E); }
    { pg8::PlainOrder S; S.init(w_v_t, D, MEMN, D, D, NB * NMEM, D); pg8::EpiBf16 E{VT, NB * NMEM}; pg8::gemm_phase(WID_, ldsl, S, E); }
    { pg8::PlainOrder S; S.init(XN, D, w_q_t, D, M, D, D); pg8::EpiBf16 E{Q, D}; pg8::gemm_phase(WID_, ldsl, S, E); }
    SYNC();
    bf16* P = (bf16*)(ws + W_YI * MiB);
    { pg8::AttnOrder S; S.init(Q, KM, D, 0); pg8::EpiSoftmax E{P, (PG8_LAS float*)(ldsl + 131072)}; pg8::gemm_phase(WID_, ldsl, S, E); }
    SYNC();
    bf16* O = XN;
    { pg8::AttnOrder S; S.init(P, VT, NB * NMEM, 1); pg8::EpiAttnO E{O}; pg8::gemm_phase(WID_, ldsl, S, E); }
    SYNC();
    { pg8::PlainOrder S; S.init(O, D, w_o_t, D, M, D, D); pg8::EpiF32 E{out, D, out, D}; pg8::gemm_phase(WID_, ldsl, S, E); }
    SYNC();
    bf16* H3 = XN;
    bf16* XG = (bf16*)(ws + 0);
    bf16* HID = (bf16*)(ws + 368 * MiB);
    bf16* YSLOT = (bf16*)(ws + 0);
    MoeBufs mb; char* mbase = ws + 976 * MiB;
    mb.tok_e = (int*)(mbase); mb.tok_g = (float*)(mbase + 1 * MiB); mb.tok_slot = (int*)(mbase + 2 * MiB); mb.slot_tok = (int*)(mbase + 3 * MiB);
    mb.slot_gate = (float*)(mbase + 4 * MiB); mb.bcnt = (int*)(mbase + 5 * MiB); mb.bbase = mb.bcnt + 16384; mb.offs = mb.bcnt + 32768; mb.ntiles = mb.offs + 64;
    mb.tiles = (int*)(mbase + 6 * MiB);
    moe_zero_ph(WID_, mb);
    router_ph(WID_, out, IN(32), H3, IN(33), IN(34), IN(35), IN(36), mb, lds);
    SYNC();
    moe_plan_ph(WID_, mb, lds);
    SYNC();
    moe_scatter_ph(WID_, mb, lds);
    SYNC();
    moe_gather_ph(WID_, H3, XG, mb);
    SYNC();
    const int ntiles = __hip_atomic_load(mb.ntiles, __ATOMIC_RELAXED, __HIP_MEMORY_SCOPE_AGENT);
    { pg8::MoeOrder S; S.init(XG, D, WGU_t, D, D, mb.tiles, ntiles, 1024); pg8::EpiSilu E{HID}; pg8::gemm_phase(WID_, ldsl, S, E); }
    SYNC();
    { pg8::MoeOrder S; S.init(HID, DEXP, WD_t, DEXP, DEXP, mb.tiles, ntiles, 1024); pg8::EpiGate E{YSLOT, mb.slot_gate}; pg8::gemm_phase(WID_, ldsl, S, E); }
    SYNC();
    final_ph(WID_, out, YSLOT, mb.tok_slot, IN(40));
    if (PROBE_PHASE >= 0) {
        if (pr_t1 == 0) pr_t1 = __builtin_amdgcn_s_memrealtime();
        if (GB == 0) { const unsigned long long t_end = __builtin_amdgcn_s_memrealtime(), wait = 8ull * (pr_t1 - pr_t0);
            while (__builtin_amdgcn_s_memrealtime() - t_end < wait) __builtin_amdgcn_s_sleep(8); }
    }
}
}

extern "C" void kernel_launch(void* const* d_in, const int* in_sizes, int n_in, void* d_out, int out_size, void* d_ws, size_t ws_size, hipStream_t stream) {
    (void)in_sizes; (void)out_size; (void)ws_size;
    static int grid = 0;
    if (grid == 0) {
        int dev = 0, cus = 0, per_cu = 0;
        hipGetDevice(&dev);
        hipDeviceGetAttribute(&cus, hipDeviceAttributeMultiprocessorCount, dev);
        hipFuncSetAttribute((const void*)fwd_kernel, hipFuncAttributeMaxDynamicSharedMemorySize, LDS_BYTES);
        hipOccupancyMaxActiveBlocksPerMultiprocessor(&per_cu, (const void*)fwd_kernel, NT, LDS_BYTES);
        if (per_cu < 1) { fprintf(stderr, "occupancy query says %d blocks/CU\n", per_cu); per_cu = 1; }
        grid = cus * 1;
    }
    (void)hipMemsetAsync((char*)d_ws + W_CTL * MiB, 0, 16384, stream);
    Params p{};
    for (int i = 0; i < 41 && i < n_in; ++i) p.in[i] = (const float*)d_in[i];
    p.out = (float*)d_out; p.ws = (char*)d_ws;
    void* args[] = {&p};
    hipError_t e = hipLaunchCooperativeKernel((const void*)fwd_kernel, dim3(grid), dim3(NT), args, LDS_BYTES, stream);
    if (e != hipSuccess) fprintf(stderr, "cooperative launch failed: %s (grid %d)\n", hipGetErrorString(e), grid);
}
```

```cpp
#include <hip/hip_runtime.h>
#include <hip/hip_cooperative_groups.h>
#include <stdint.h>
#include <cstdio>
namespace cg = cooperative_groups;

namespace {
constexpr int NB = 8, S = 8192, D = 1024, M = NB * S;
constexpr int DR = 512, DSHIFT = 1792, DIN = 2304, NMEM = 256;
constexpr int NEXP = 32, DEXP = 512, NASSIGN = 2 * M;
constexpr size_t MiB = 1u << 20;
constexpr int NT = 512;
constexpr int S5L = 32, S5R = M / S5L;
constexpr int LDS_BYTES = 147456;
#define GB ((int)blockIdx.x)
#define GN ((int)gridDim.x)

typedef unsigned short bf16;
__device__ __forceinline__ bf16 f2bf(float f) { unsigned u = __builtin_bit_cast(unsigned, f); return (bf16)((u + 0x7fffu + ((u >> 16) & 1u)) >> 16); }
__device__ __forceinline__ unsigned pk2(float lo, float hi) { return (unsigned)f2bf(lo) | ((unsigned)f2bf(hi) << 16); }
__device__ __forceinline__ int lane_id() { int l = (int)__builtin_amdgcn_mbcnt_hi(~0u, __builtin_amdgcn_mbcnt_lo(~0u, 0u)); asm volatile("" : "+v"(l)); return l; }
__device__ __forceinline__ float bf2f(bf16 h) { return __builtin_bit_cast(float, (unsigned)h << 16); }

template <typename T> __device__ __forceinline__ float ldf(const T* p);
template <> __device__ __forceinline__ float ldf<float>(const float* p) { return *p; }
template <> __device__ __forceinline__ float ldf<bf16>(const bf16* p) { return bf2f(*p); }
template <typename T> __device__ __forceinline__ void stf(T* p, float v);
template <> __device__ __forceinline__ void stf<float>(float* p, float v) { *p = v; }
template <> __device__ __forceinline__ void stf<bf16>(bf16* p, float v) { *p = f2bf(v); }

template <int CTRL, int ROWMASK> __device__ __forceinline__ float dppf_(float x) { return __builtin_bit_cast(float, __builtin_amdgcn_update_dpp(0, __builtin_bit_cast(int, x), CTRL, ROWMASK, 0xf, false)); }
__device__ __forceinline__ float wave_sum(float v) {
    v += dppf_<0xB1, 0xf>(v); v += dppf_<0x4E, 0xf>(v); v += dppf_<0x141, 0xf>(v); v += dppf_<0x140, 0xf>(v);
    v += dppf_<0x142, 0xa>(v);
    v += dppf_<0x143, 0xc>(v);
    return __builtin_bit_cast(float, __builtin_amdgcn_readlane(__builtin_bit_cast(int, v), 63));
}
__device__ __forceinline__ float sigmoidf_(float x) { return 1.f / (1.f + __expf(-x)); }


__device__ __forceinline__ float gelu_tanh(float x) { return x * sigmoidf_(1.5957691216057308f * (x + 0.044715f * x * x * x)); }

namespace pg8 {
#define PG8_LAS __attribute__((address_space(3)))
typedef short bf16x8 __attribute__((ext_vector_type(8)));
typedef float f32x4 __attribute__((ext_vector_type(4)));
typedef unsigned u32x4 __attribute__((ext_vector_type(4)));
constexpr int BM = 256, BK = 64, HALF = 128, HTB = HALF * BK * 2, STAGE_BYTES = 8 * HTB, NXCD = 8, WGM = 8;
__device__ __forceinline__ int lds_byte(int r, int c) { const int st = (r >> 4) * 2 + (c >> 5), rr = r & 15, cc = c & 31, ob = rr * 64 + cc * 2; return st * 1024 + (ob ^ (((ob >> 9) & 1) << 5)); }
__device__ __forceinline__ void stage_rc(int b, int& R, int& C) { const int st = b / 1024, sb = b % 1024, swz = sb ^ (((sb >> 9) & 1) << 5); R = (st >> 1) * 16 + swz / 64; C = (st & 1) * 32 + (swz % 64) / 2; }
__device__ __forceinline__ int perm32(int rho) { const int n = rho >> 4, i = rho & 15; return 8 * (i >> 2) + 4 * n + (i & 3); }
struct Unit { int pm, pn; };
struct PlainOrder {
    const bf16* A; const bf16* Bt; int lda, ldb, K; int nM, nN, nwg, G, c;
    __device__ void init(const bf16* A_, int lda_, const bf16* Bt_, int ldb_, int M, int N, int K_) { A = A_; Bt = Bt_; lda = lda_; ldb = ldb_; K = K_; nM = M / BM; nN = N / BM; nwg = nM * nN; G = GN; c = GB; }
    __device__ bool next(int i, Unit& u) const {
        const long L = (long)i * G + c; if (L >= nwg) return false;
        int wgid = (int)L; { const int q = nwg / NXCD, r = nwg % NXCD, xcd = wgid % NXCD, off = wgid / NXCD; wgid = (xcd < r ? xcd * (q + 1) : r * (q + 1) + (xcd - r) * q) + off; }
        const int nig = WGM * nN, gid = wgid / nig, fm = gid * WGM, gsz = (nM - fm) < WGM ? (nM - fm) : WGM;
        u.pm = fm + ((wgid % nig) % gsz); u.pn = (wgid % nig) / gsz; return true;
    }
    __device__ __forceinline__ const char* aptr(const Unit& u) const { return (const char*)(A + (size_t)u.pm * BM * lda); }
    __device__ __forceinline__ const char* bptr(const Unit& u) const { return (const char*)(Bt + (size_t)u.pn * BM * ldb); }
};
typedef float f32x2c __attribute__((ext_vector_type(2)));
typedef __bf16 bf16x2c __attribute__((ext_vector_type(2)));
__device__ __forceinline__ unsigned cvt_pk_bf16(float lo, float hi) { const f32x2c v = {lo, hi}; const bf16x2c b = __builtin_convertvector(v, bf16x2c); return __builtin_bit_cast(unsigned, b); }

template <class Epi, class Sched>
__device__ __forceinline__ void gemm_phase(const int WID_, PG8_LAS unsigned char* lds, const Sched& S, const Epi& E) {
    const int tid = (WID_ * 64 + lane_id()), wid = __builtin_amdgcn_readfirstlane(tid >> 6), lane = tid & 63, wr = wid >> 2, wc = wid & 3, fr = lane & 15, fq = lane >> 4;
    const int K = S.K, nt = K / BK;
    unsigned voffA[2], voffB[2];
#pragma unroll
    for (int i = 0; i < 2; ++i) { int R, C; stage_rc(tid * 16 + i * 8192, R, C); const int Rb = Epi::PERM ? ((R & ~31) + perm32(R & 31)) : R;
        voffA[i] = (unsigned)(R * S.lda + C) * 2u; voffB[i] = (unsigned)(Rb * S.ldb + C) * 2u; }
    const size_t kstep = (size_t)(BK * 2);
    const size_t hstepA = (size_t)HALF * S.lda * 2, hstepB = (size_t)HALF * S.ldb * 2;
    const unsigned ldsw = (unsigned)wid * 1024u;
    const int aoff = lds_byte(wr * 64 + fr, fq * 8), boff = lds_byte(wc * 32 + fr, fq * 8);
#define PG8_SA(b, h) (((b) * 2 + (h)) * HTB)
#define PG8_SB(b, h) ((4 + (b) * 2 + (h)) * HTB)
#define PG8_STAGE(bufoff, gbase, voff) do { _Pragma("unroll") for (int _i = 0; _i < 2; ++_i) \
        __builtin_amdgcn_global_load_lds((const unsigned*)((const char*)(gbase) + (voff)[_i]), (PG8_LAS unsigned*)(lds + (bufoff) + ldsw + _i * 8192), 16, 0, 0); } while (0)
#define PG8_LDA(dst, b, h) do { _Pragma("unroll") for (int m = 0; m < 4; ++m) _Pragma("unroll") for (int k = 0; k < 2; ++k) dst[m][k] = *(const PG8_LAS bf16x8*)(lds + PG8_SA(b, h) + aoff + m * 2048 + k * 1024); } while (0)
#define PG8_LDB(dst, b, h) do { _Pragma("unroll") for (int n = 0; n < 2; ++n) _Pragma("unroll") for (int k = 0; k < 2; ++k) dst[n][k] = *(const PG8_LAS bf16x8*)(lds + PG8_SB(b, h) + boff + n * 2048 + k * 1024); } while (0)
#define PG8_MMA(ai, bj, At, Bt) do { __builtin_amdgcn_s_setprio(1); _Pragma("unroll") for (int m = 0; m < 4; ++m) _Pragma("unroll") for (int n = 0; n < 2; ++n) _Pragma("unroll") for (int k = 0; k < 2; ++k) \
        acc[ai][bj][m][n] = __builtin_amdgcn_mfma_f32_16x16x32_bf16(Bt[n][k], At[m][k], acc[ai][bj][m][n], 0, 0, 0); __builtin_amdgcn_s_setprio(0); } while (0)
#define PG8_WAIT_V(n) asm volatile("s_waitcnt vmcnt(" #n ")" ::: "memory")
#define PG8_WAIT_L(n) asm volatile("s_waitcnt lgkmcnt(" #n ")" ::: "memory")
#define PG8_BAR __builtin_amdgcn_s_barrier()
#define PG8_SCHED __builtin_amdgcn_sched_barrier(0)
    Unit cur, nxt; int ui = 0;
    if (!S.next(0, cur)) return;
    f32x4 acc[2][2][4][2];
#pragma unroll
    for (int a = 0; a < 2; ++a)
#pragma unroll
        for (int b = 0; b < 2; ++b)
#pragma unroll
            for (int m = 0; m < 4; ++m)
#pragma unroll
                for (int n = 0; n < 2; ++n) acc[a][b][m][n] = (f32x4){0.f, 0.f, 0.f, 0.f};
    bf16x8 At[4][2], B0[2][2], B1[2][2];
    const char* cA = S.aptr(cur); const char* cB = S.bptr(cur);
    PG8_STAGE(PG8_SB(0, 0), cB, voffB); PG8_STAGE(PG8_SB(0, 1), cB + hstepB, voffB); PG8_STAGE(PG8_SA(0, 0), cA, voffA); PG8_STAGE(PG8_SA(0, 1), cA + hstepA, voffA);
    if (wr == 1) PG8_BAR;
    PG8_WAIT_V(2); PG8_BAR;
    PG8_STAGE(PG8_SB(1, 0), cB + kstep, voffB); PG8_STAGE(PG8_SA(1, 0), cA + kstep, voffA); PG8_STAGE(PG8_SB(1, 1), cB + hstepB + kstep, voffB);
    PG8_WAIT_V(6); PG8_BAR;
    for (;;) {
        const bool has_next = S.next(ui + 1, nxt);
        const char* nA = has_next ? S.aptr(nxt) : cA; const char* nB = has_next ? S.bptr(nxt) : cB;
        for (int t = 0; t < nt; t += 2) {
            const bool last = (t == nt - 2);
            const char* a1 = cA + (size_t)(t + 1) * kstep;
            const char* a2 = last ? nA : cA + (size_t)(t + 2) * kstep; const char* b2 = last ? nB : cB + (size_t)(t + 2) * kstep;
            const char* a3 = a2 + kstep; const char* b3 = b2 + kstep;
            PG8_LDB(B0, 0, 0); PG8_LDB(B1, 0, 1); PG8_SCHED; PG8_LDA(At, 0, 0); PG8_STAGE(PG8_SA(1, 1), a1 + hstepA, voffA);
            PG8_WAIT_V(8); PG8_WAIT_L(0); PG8_BAR; PG8_MMA(0, 0, At, B0); PG8_MMA(0, 1, At, B1); PG8_BAR; PG8_SCHED;
            PG8_LDA(At, 0, 1); PG8_STAGE(PG8_SB(0, 0), b2, voffB); PG8_STAGE(PG8_SB(0, 1), b2 + hstepB, voffB); PG8_STAGE(PG8_SA(0, 0), a2, voffA);
            PG8_WAIT_V(8); PG8_WAIT_L(0); PG8_BAR; PG8_MMA(1, 0, At, B0); PG8_MMA(1, 1, At, B1); PG8_BAR; PG8_SCHED;
            PG8_LDB(B0, 1, 0); PG8_LDB(B1, 1, 1); PG8_SCHED; PG8_LDA(At, 1, 0); PG8_STAGE(PG8_SA(0, 1), a2 + hstepA, voffA);
            PG8_WAIT_V(8); PG8_WAIT_L(0); PG8_BAR; PG8_MMA(0, 0, At, B0); PG8_MMA(0, 1, At, B1); PG8_BAR; PG8_SCHED;
            PG8_LDA(At, 1, 1); PG8_STAGE(PG8_SB(1, 0), b3, voffB); PG8_STAGE(PG8_SB(1, 1), b3 + hstepB, voffB); PG8_STAGE(PG8_SA(1, 0), a3, voffA);
            PG8_WAIT_V(8); PG8_WAIT_L(0); PG8_BAR; PG8_MMA(1, 0, At, B0); PG8_MMA(1, 1, At, B1); PG8_BAR; PG8_SCHED;
        }
        if (wr == 0) PG8_BAR;
        E(acc, cur, wr, wc, fr, fq);
        if (!has_next) break;
#pragma unroll
        for (int a = 0; a < 2; ++a)
#pragma unroll
            for (int b = 0; b < 2; ++b)
#pragma unroll
                for (int m = 0; m < 4; ++m)
#pragma unroll
                    for (int n = 0; n < 2; ++n) acc[a][b][m][n] = (f32x4){0.f, 0.f, 0.f, 0.f};
        cur = nxt; cA = nA; cB = nB; ++ui;
        if (wr == 1) PG8_BAR;
    }
    PG8_WAIT_V(0);
    PG8_BAR;
#undef PG8_SA
#undef PG8_SB
#undef PG8_STAGE
#undef PG8_LDA
#undef PG8_LDB
#undef PG8_MMA
#undef PG8_WAIT_V
#undef PG8_WAIT_L
#undef PG8_BAR
#undef PG8_SCHED
}

struct EpiF32 {
    static constexpr bool PERM = false;
    float* C; int ldc; const float* R; int ldr;
    __device__ __forceinline__ void operator()(const f32x4 (&acc)[2][2][4][2], const Unit& u, int wr, int wc, int fr, int fq) const {
        const int row0 = u.pm * BM + wr * 64 + fr, col0 = u.pn * BM + wc * 32 + 4 * fq;
#pragma unroll
        for (int ai = 0; ai < 2; ++ai)
#pragma unroll
            for (int m = 0; m < 4; ++m) { const size_t row = (size_t)(row0 + ai * HALF + m * 16);
#pragma unroll
                for (int bj = 0; bj < 2; ++bj)
#pragma unroll
                    for (int n = 0; n < 2; ++n) { const int col = col0 + bj * HALF + 16 * n; f32x4 v = acc[ai][bj][m][n];
                        if (R) v = v + *(const f32x4*)(R + row * ldr + col);
                        *(f32x4*)(C + row * ldc + col) = v; } }
    }
};
struct EpiBf16 {
    static constexpr bool PERM = true;
    bf16* O; int ldc;
    __device__ __forceinline__ void operator()(const f32x4 (&acc)[2][2][4][2], const Unit& u, int wr, int wc, int fr, int fq) const {
        const int row0 = u.pm * BM + wr * 64 + fr, col0 = u.pn * BM + wc * 32 + 8 * fq;
#pragma unroll
        for (int ai = 0; ai < 2; ++ai)
#pragma unroll
            for (int m = 0; m < 4; ++m) { bf16* rowp = O + (size_t)(row0 + ai * HALF + m * 16) * ldc + col0;
#pragma unroll
                for (int bj = 0; bj < 2; ++bj) { const f32x4 v0 = acc[ai][bj][m][0], v1 = acc[ai][bj][m][1];
                    u32x4 w; w.x = cvt_pk_bf16(v0[0], v0[1]); w.y = cvt_pk_bf16(v0[2], v0[3]); w.z = cvt_pk_bf16(v1[0], v1[1]); w.w = cvt_pk_bf16(v1[2], v1[3]);
                    *(u32x4*)(rowp + bj * HALF) = w; } }
    }
};
struct EpiGlu {
    static constexpr bool PERM = true;
    const bf16* Z; const float* bias; bf16* YM;
    __device__ __forceinline__ void operator()(const f32x4 (&acc)[2][2][4][2], const Unit& u, int wr, int wc, int fr, int fq) const {
        const int row0 = u.pm * BM + wr * 64 + fr, col0 = u.pn * BM + wc * 32 + 8 * fq;
#pragma unroll
        for (int ai = 0; ai < 2; ++ai)
#pragma unroll
            for (int m = 0; m < 4; ++m) { const size_t row = (size_t)(row0 + ai * HALF + m * 16);
#pragma unroll
                for (int bj = 0; bj < 2; ++bj) { const int col = col0 + bj * HALF;
                    const u32x4 zz = *(const u32x4*)(Z + row * 512 + col);
                    const f32x4 b0 = *(const f32x4*)(bias + col), b1 = *(const f32x4*)(bias + col + 4);
                    const f32x4 v0 = acc[ai][bj][m][0] + b0, v1 = acc[ai][bj][m][1] + b1;
                    float o[8]; const unsigned zw[4] = {zz.x, zz.y, zz.z, zz.w};
#pragma unroll
                    for (int q = 0; q < 4; ++q) { const float zl = __builtin_bit_cast(float, zw[q] << 16), zh = __builtin_bit_cast(float, zw[q] & 0xffff0000u);
                        const float al = (q < 2) ? v0[2 * q] : v1[2 * q - 4], ah = (q < 2) ? v0[2 * q + 1] : v1[2 * q - 3];
                        o[2 * q] = zl * sigmoidf_(al); o[2 * q + 1] = zh * sigmoidf_(ah); }
                    u32x4 w; w.x = cvt_pk_bf16(o[0], o[1]); w.y = cvt_pk_bf16(o[2], o[3]); w.z = cvt_pk_bf16(o[4], o[5]); w.w = cvt_pk_bf16(o[6], o[7]);
                    *(u32x4*)(YM + row * D + 512 + col) = w; } }
    }
};

struct MoeOrder {
    const bf16* A; const bf16* Bt; int lda, ldb, K; const int* tiles; int nunits, G, c; size_t bexp;
    __device__ void init(const bf16* A_, int lda_, const bf16* Bt_, int ldb_, int K_, const int* tiles_, int ntiles, size_t bexp_) { A = A_; Bt = Bt_; lda = lda_; ldb = ldb_; K = K_; tiles = tiles_; nunits = ntiles * 4; G = GN; c = GB; bexp = bexp_; }
    __device__ bool next(int i, Unit& u) const { const int L = i * G + c; if (L >= nunits) return false; u.pm = L >> 2; u.pn = L & 3; return true; }
    __device__ __forceinline__ const char* aptr(const Unit& u) const { return (const char*)(A + (size_t)u.pm * BM * lda); }
    __device__ __forceinline__ const char* bptr(const Unit& u) const { const int e = __hip_atomic_load(tiles + u.pm, __ATOMIC_RELAXED, __HIP_MEMORY_SCOPE_AGENT); return (const char*)(Bt + ((size_t)e * bexp + (size_t)u.pn * BM) * ldb); }
};
struct EpiSilu {
    static constexpr bool PERM = true;
    bf16* HID;
    __device__ __forceinline__ void operator()(const f32x4 (&acc)[2][2][4][2], const Unit& u, int wr, int wc, int fr, int fq) const {
        const int row0 = u.pm * BM + wr * 64 + fr, col0 = u.pn * HALF + wc * 32 + 8 * fq;
#pragma unroll
        for (int ai = 0; ai < 2; ++ai)
#pragma unroll
            for (int m = 0; m < 4; ++m) { const size_t row = (size_t)(row0 + ai * HALF + m * 16);
                float o[8];
#pragma unroll
                for (int n = 0; n < 2; ++n)
#pragma unroll
                    for (int q = 0; q < 4; ++q) { const float g = acc[ai][0][m][n][q], up = acc[ai][1][m][n][q]; o[4 * n + q] = g * sigmoidf_(g) * up; }
                u32x4 w; w.x = cvt_pk_bf16(o[0], o[1]); w.y = cvt_pk_bf16(o[2], o[3]); w.z = cvt_pk_bf16(o[4], o[5]); w.w = cvt_pk_bf16(o[6], o[7]);
                *(u32x4*)(HID + row * DEXP + col0) = w; }
    }
};
struct EpiGate {
    static constexpr bool PERM = true;
    bf16* Y; const float* gate;
    __device__ __forceinline__ void operator()(const f32x4 (&acc)[2][2][4][2], const Unit& u, int wr, int wc, int fr, int fq) const {
        const int row0 = u.pm * BM + wr * 64 + fr, col0 = u.pn * BM + wc * 32 + 8 * fq;
#pragma unroll
        for (int ai = 0; ai < 2; ++ai)
#pragma unroll
            for (int m = 0; m < 4; ++m) { const size_t row = (size_t)(row0 + ai * HALF + m * 16); const float gt = gate[row];
#pragma unroll
                for (int bj = 0; bj < 2; ++bj) { const f32x4 v0 = acc[ai][bj][m][0] * gt, v1 = acc[ai][bj][m][1] * gt;
                    u32x4 w; w.x = cvt_pk_bf16(v0[0], v0[1]); w.y = cvt_pk_bf16(v0[2], v0[3]); w.z = cvt_pk_bf16(v1[0], v1[1]); w.w = cvt_pk_bf16(v1[2], v1[3]);
                    *(u32x4*)(Y + row * D + col0 + bj * HALF) = w; } }
    }
};

struct EpiProj {
    static constexpr bool PERM = true;
    bf16* PROJ; bf16* US5;
    __device__ __forceinline__ void operator()(const f32x4 (&acc)[2][2][4][2], const Unit& u, int wr, int wc, int fr, int fq) const {
        const int row0 = u.pm * BM + wr * 64 + fr, col0 = u.pn * BM + wc * 32 + 8 * fq;
#pragma unroll
        for (int ai = 0; ai < 2; ++ai)
#pragma unroll
            for (int m = 0; m < 4; ++m) { const size_t row = (size_t)(row0 + ai * HALF + m * 16);
#pragma unroll
                for (int bj = 0; bj < 2; ++bj) { const f32x4 v0 = acc[ai][bj][m][0], v1 = acc[ai][bj][m][1]; const int col = col0 + bj * HALF;
                    u32x4 w; w.x = cvt_pk_bf16(v0[0], v0[1]); w.y = cvt_pk_bf16(v0[2], v0[3]); w.z = cvt_pk_bf16(v1[0], v1[1]); w.w = cvt_pk_bf16(v1[2], v1[3]);
                    if (col < DSHIFT) *(u32x4*)(PROJ + row * DSHIFT + col) = w;
                    else { const int cc = col - DSHIFT; *(u32x4*)(US5 + ((size_t)(cc >> 4) * M + row) * 16 + (cc & 15)) = w; } } }
    }
};
struct GroupOrder {
    const bf16* A; const bf16* Bt; int lda, ldb, K; int nM, nN, nunits, G, c; size_t sA, sB;
    __device__ void init(const bf16* A_, int lda_, size_t sA_, const bf16* Bt_, int ldb_, size_t sB_, int ngroups, int Mg, int Ng, int K_) {
        A = A_; Bt = Bt_; lda = lda_; ldb = ldb_; K = K_; sA = sA_; sB = sB_; nM = Mg / BM; nN = Ng / BM; nunits = ngroups * nM * nN; G = GN; c = GB; }
    __device__ bool next(int i, Unit& u) const { const int L = i * G + c; if (L >= nunits) return false; u.pn = L % nN; u.pm = L / nN; return true; }
    __device__ __forceinline__ const char* aptr(const Unit& u) const { const int g = u.pm / nM, pm = u.pm % nM; return (const char*)(A + (size_t)g * sA + (size_t)pm * BM * lda); }
    __device__ __forceinline__ const char* bptr(const Unit& u) const { const int g = u.pm / nM; return (const char*)(Bt + (size_t)g * sB + (size_t)u.pn * BM * ldb); }
};
struct EpiS5a {
    static constexpr bool PERM = false;
    bf16* YI; float* F;
    __device__ __forceinline__ void operator()(const f32x4 (&acc)[2][2][4][2], const Unit& u, int wr, int wc, int fr, int fq) const {
        const int row0 = u.pm * BM + wr * 64 + fr, col0 = u.pn * BM + wc * 32 + 4 * fq;
#pragma unroll
        for (int ai = 0; ai < 2; ++ai)
#pragma unroll
            for (int m = 0; m < 4; ++m) { const size_t row = (size_t)(row0 + ai * HALF + m * 16);
#pragma unroll
                for (int bj = 0; bj < 2; ++bj)
#pragma unroll
                    for (int n = 0; n < 2; ++n) { const int col = col0 + bj * HALF + 16 * n; const f32x4 v = acc[ai][bj][m][n];
                        if (col < 512) { uint2 w; w.x = cvt_pk_bf16(v[0], v[1]); w.y = cvt_pk_bf16(v[2], v[3]); *(uint2*)(YI + row * 512 + col) = w; }
                        else if (col < 640) *(f32x4*)(F + row * 128 + (col - 512)) = v; } }
    }
};
struct EpiS5b {
    static constexpr bool PERM = true;
    const bf16* YI; bf16* Z;
    __device__ __forceinline__ void operator()(const f32x4 (&acc)[2][2][4][2], const Unit& u, int wr, int wc, int fr, int fq) const {
        const int row0 = u.pm * BM + wr * 64 + fr, col0 = u.pn * BM + wc * 32 + 8 * fq;
#pragma unroll
        for (int ai = 0; ai < 2; ++ai)
#pragma unroll
            for (int m = 0; m < 4; ++m) { const int row = row0 + ai * HALF + m * 16; const int g = row / S5R, rl = row % S5R;
#pragma unroll
                for (int bj = 0; bj < 2; ++bj) { const int col = col0 + bj * HALF;
                    const u32x4 yi = *(const u32x4*)(YI + (size_t)row * 512 + col);
                    const unsigned yw[4] = {yi.x, yi.y, yi.z, yi.w};
                    const f32x4 v0 = acc[ai][bj][m][0], v1 = acc[ai][bj][m][1];
                    float o[8];
#pragma unroll
                    for (int q = 0; q < 4; ++q) { const float al = (q < 2) ? v0[2 * q] : v1[2 * q - 4], ah = (q < 2) ? v0[2 * q + 1] : v1[2 * q - 3];
                        o[2 * q] = gelu_tanh(al + __builtin_bit_cast(float, yw[q] << 16)); o[2 * q + 1] = gelu_tanh(ah + __builtin_bit_cast(float, yw[q] & 0xffff0000u)); }
                    u32x4 w; w.x = cvt_pk_bf16(o[0], o[1]); w.y = cvt_pk_bf16(o[2], o[3]); w.z = cvt_pk_bf16(o[4], o[5]); w.w = cvt_pk_bf16(o[6], o[7]);
                    const size_t tok = (size_t)rl * S5L + (col >> 4);
                    *(u32x4*)(Z + tok * 512 + g * 16 + (col & 15)) = w; } }
    }
};
struct AttnOrder {
    const bf16* A; const bf16* Bt; int lda, ldb, K; int G, c; int mode;
    __device__ void init(const bf16* A_, const bf16* Bt_, int ldb_, int mode_) { A = A_; Bt = Bt_; lda = D; ldb = ldb_; K = 256; G = GN; c = GB; mode = mode_; }
    __device__ bool next(int i, Unit& u) const { const int L = i * G + c; if (L >= NB * 4 * 32) return false; u.pn = L & 3; u.pm = L >> 2; return true; }
    __device__ __forceinline__ const char* aptr(const Unit& u) const { return (const char*)(A + (size_t)u.pm * BM * D + u.pn * 256); }
    __device__ __forceinline__ const char* bptr(const Unit& u) const { const int b = u.pm >> 5;
        return (const char*)(mode == 0 ? Bt + (size_t)b * 256 * ldb + u.pn * 256 : Bt + (size_t)u.pn * 256 * ldb + b * 256); }
};
struct EpiSoftmax {
    static constexpr bool PERM = true;
    bf16* P; PG8_LAS float* scr;
    __device__ __forceinline__ void operator()(f32x4 (&acc)[2][2][4][2], const Unit& u, int wr, int wc, int fr, int fq) const {
        const float SC = 0.0625f * 1.4426950408889634f;
        PG8_LAS float* smax = scr; PG8_LAS float* ssum = scr + 1024;
#pragma unroll
        for (int ai = 0; ai < 2; ++ai)
#pragma unroll
            for (int m = 0; m < 4; ++m) { float t = -3.0e38f;
#pragma unroll
                for (int bj = 0; bj < 2; ++bj)
#pragma unroll
                    for (int n = 0; n < 2; ++n) { const f32x4 v = acc[ai][bj][m][n]; t = fmaxf(t, fmaxf(fmaxf(v[0], v[1]), fmaxf(v[2], v[3]))); }
                t = fmaxf(t, __shfl_xor(t, 16)); t = fmaxf(t, __shfl_xor(t, 32));
                if (fq == 0) smax[(ai * HALF + wr * 64 + m * 16 + fr) * 4 + wc] = t; }
        asm volatile("s_waitcnt lgkmcnt(0)" ::: "memory"); __builtin_amdgcn_s_barrier(); asm volatile("" ::: "memory");
#pragma unroll
        for (int ai = 0; ai < 2; ++ai)
#pragma unroll
            for (int m = 0; m < 4; ++m) { const f32x4 q = *(const PG8_LAS f32x4*)(smax + (ai * HALF + wr * 64 + m * 16 + fr) * 4);
                const float mm = fmaxf(fmaxf(q[0], q[1]), fmaxf(q[2], q[3])) * SC; float s = 0.f;
#pragma unroll
                for (int bj = 0; bj < 2; ++bj)
#pragma unroll
                    for (int n = 0; n < 2; ++n)
#pragma unroll
                        for (int e = 0; e < 4; ++e) { const float p = __builtin_amdgcn_exp2f(acc[ai][bj][m][n][e] * SC - mm); acc[ai][bj][m][n][e] = p; s += p; }
                s += __shfl_xor(s, 16); s += __shfl_xor(s, 32);
                if (fq == 0) ssum[(ai * HALF + wr * 64 + m * 16 + fr) * 4 + wc] = s; }
        asm volatile("s_waitcnt lgkmcnt(0)" ::: "memory"); __builtin_amdgcn_s_barrier(); asm volatile("" ::: "memory");
        const int row0 = u.pm * BM + wr * 64 + fr, col0 = u.pn * 256 + wc * 32 + 8 * fq;
#pragma unroll
        for (int ai = 0; ai < 2; ++ai)
#pragma unroll
            for (int m = 0; m < 4; ++m) { const f32x4 q = *(const PG8_LAS f32x4*)(ssum + (ai * HALF + wr * 64 + m * 16 + fr) * 4);
                const float iv = 1.f / ((q[0] + q[1]) + (q[2] + q[3]));
                bf16* rowp = P + (size_t)(row0 + ai * HALF + m * 16) * D + col0;
#pragma unroll
                for (int bj = 0; bj < 2; ++bj) { const f32x4 v0 = acc[ai][bj][m][0] * iv, v1 = acc[ai][bj][m][1] * iv; u32x4 w;
                    w.x = cvt_pk_bf16(v0[0], v0[1]); w.y = cvt_pk_bf16(v0[2], v0[3]); w.z = cvt_pk_bf16(v1[0], v1[1]); w.w = cvt_pk_bf16(v1[2], v1[3]);
                    *(u32x4*)(rowp + bj * HALF) = w; } }
    }
};
struct EpiAttnO {
    static constexpr bool PERM = true;
    bf16* O;
    __device__ __forceinline__ void operator()(const f32x4 (&acc)[2][2][4][2], const Unit& u, int wr, int wc, int fr, int fq) const {
        const int row0 = u.pm * BM + wr * 64 + fr, col0 = u.pn * 256 + wc * 32 + 8 * fq;
#pragma unroll
        for (int ai = 0; ai < 2; ++ai)
#pragma unroll
            for (int m = 0; m < 4; ++m) { bf16* rowp = O + (size_t)(row0 + ai * HALF + m * 16) * D + col0;
#pragma unroll
                for (int bj = 0; bj < 2; ++bj) { const f32x4 v0 = acc[ai][bj][m][0], v1 = acc[ai][bj][m][1];
                    u32x4 w; w.x = cvt_pk_bf16(v0[0], v0[1]); w.y = cvt_pk_bf16(v0[2], v0[3]); w.z = cvt_pk_bf16(v1[0], v1[1]); w.w = cvt_pk_bf16(v1[2], v1[3]);
                    *(u32x4*)(rowp + bj * HALF) = w; } }
    }
};

struct EpiLora {
    static constexpr bool PERM = true;
    bf16* LW; size_t ostride; const float* w0; const float* a0;
    __device__ __forceinline__ void operator()(const f32x4 (&acc)[2][2][4][2], const Unit& u, int wr, int wc, int fr, int fq) const {
        const int row0 = u.pm * BM + wr * 64 + fr, col0 = u.pn * BM + wc * 32 + 8 * fq;
        const int kind = u.pn >> 1;
        bf16* O = LW + (size_t)kind * ostride;
#pragma unroll
        for (int bj = 0; bj < 2; ++bj) { const int col = (col0 + bj * HALF) & 511;
            f32x4 b0 = (f32x4){0.f, 0.f, 0.f, 0.f}, b1 = b0;
            if (kind == 0) { b0 = *(const f32x4*)(w0 + col); b1 = *(const f32x4*)(w0 + col + 4); }
            else if (kind == 1) { b0 = *(const f32x4*)(a0 + col); b1 = *(const f32x4*)(a0 + col + 4); }
#pragma unroll
            for (int ai = 0; ai < 2; ++ai)
#pragma unroll
                for (int m = 0; m < 4; ++m) { const size_t row = (size_t)(row0 + ai * HALF + m * 16);
                    const f32x4 v0 = acc[ai][bj][m][0] + b0, v1 = acc[ai][bj][m][1] + b1; float o[8];
#pragma unroll
                    for (int e = 0; e < 8; ++e) { float x = (e < 4) ? v0[e & 3] : v1[e & 3];
                        if (kind == 0) { const float nd = -x; const float sp = fmaxf(nd, 0.f) + __logf(1.f + __expf(-fabsf(nd))); x = -__expf(-sp - 0.5f); }
                        else if (kind == 1) x = sigmoidf_(x);
                        o[e] = x; }
                    u32x4 w; w.x = cvt_pk_bf16(o[0], o[1]); w.y = cvt_pk_bf16(o[2], o[3]); w.z = cvt_pk_bf16(o[4], o[5]); w.w = cvt_pk_bf16(o[6], o[7]);
                    *(u32x4*)(O + row * 512 + col) = w; } }
    }
};
}

#define LAS __attribute__((address_space(3)))
__device__ __forceinline__ void transpose_item(const float* __restrict__ W, int K, int N, bf16* __restrict__ WT, int ldt, int row_off, int col_off, float* scr, int item, int lane, const float* __restrict__ kscale, int ldw = 0) {
    if (ldw == 0) ldw = N;
    const int nblk = N / 32, kb = item / nblk, nb = item % nblk, k0 = 64 * kb, n0 = 32 * nb;
#pragma unroll 8
    for (int i = 0; i < 32; ++i) { const int kk = 2 * i + (lane >> 5); float v = W[(size_t)(k0 + kk) * ldw + n0 + (lane & 31)]; if (kscale) v *= kscale[k0 + kk]; scr[kk * 33 + (lane & 31)] = v; }
    __builtin_amdgcn_s_waitcnt(0xc07f); asm volatile("" ::: "memory");
    const int c = lane & 7;
#pragma unroll
    for (int j = 0; j < 4; ++j) { const int n = (lane >> 3) + 8 * j; const float* s = scr + (8 * c) * 33 + n;
        uint4 o; o.x = pk2(s[0 * 33], s[1 * 33]); o.y = pk2(s[2 * 33], s[3 * 33]); o.z = pk2(s[4 * 33], s[5 * 33]); o.w = pk2(s[6 * 33], s[7 * 33]);
        *(uint4*)(WT + (size_t)(row_off + n0 + n) * ldt + col_off + k0 + 8 * c) = o; }
    __builtin_amdgcn_s_waitcnt(0xc07f); asm volatile("" ::: "memory");
}
__device__ __forceinline__ void transpose_ph(const int WID_, const float* W, int K, int N, bf16* WT, int ldt, int row_off, int col_off, char* lds, const float* kscale = nullptr) {
    const int lane = (WID_ * 64 + lane_id()) & 63, wv = (WID_ * 64 + lane_id()) >> 6;
    float* scr = (float*)(lds + wv * 16384);
    const int nitems = (K / 64) * (N / 32);
    for (int it = GB * 8 + wv; it < nitems; it += GN * 8) transpose_item(W, K, N, WT, ldt, row_off, col_off, scr, it, lane, kscale);
}

template <typename TO>
__device__ __forceinline__ void rmsnorm_ph(const int WID_, const float* __restrict__ x, const float* __restrict__ w, TO* __restrict__ out, int rows) {
    const int lane = lane_id(), wv = WID_;
    float4 g[4];
#pragma unroll
    for (int j = 0; j < 4; ++j) g[j] = *(const float4*)(w + (lane + 64 * j) * 4);
    for (int row = (GB * 8 + wv) * 2; row < rows; row += GN * 16) {
        const float4* xr = (const float4*)(x + (size_t)row * D);
        float4 v[2][4]; float s[2] = {0.f, 0.f};
#pragma unroll
        for (int r = 0; r < 2; ++r)
#pragma unroll
            for (int j = 0; j < 4; ++j) v[r][j] = xr[r * (D / 4) + lane + 64 * j];
#pragma unroll
        for (int r = 0; r < 2; ++r) {
#pragma unroll
            for (int j = 0; j < 4; ++j) s[r] += v[r][j].x * v[r][j].x + v[r][j].y * v[r][j].y + v[r][j].z * v[r][j].z + v[r][j].w * v[r][j].w;
            s[r] = wave_sum(s[r]);
            const float rs = rsqrtf(s[r] * (1.f / D) + 1e-6f);
#pragma unroll
            for (int j = 0; j < 4; ++j) {
                uint2 o; o.x = pk2(v[r][j].x * rs * g[j].x, v[r][j].y * rs * g[j].y); o.y = pk2(v[r][j].z * rs * g[j].z, v[r][j].w * rs * g[j].w);
                *(uint2*)(out + (size_t)(row + r) * D + (lane + 64 * j) * 4) = o;
            }
        }
    }
}

__device__ __forceinline__ void rwkv_lin_ph(const int WID_, const bf16* __restrict__ proj, const float* __restrict__ mu, bf16* __restrict__ lin) {
    const int lane = lane_id(), wv = WID_;
    const float4 m4 = *(const float4*)(mu + 1536 + 4 * lane);
    const float mm[4] = {m4.x, m4.y, m4.z, m4.w};
    for (int m0 = (GB * 8 + wv) * 4; m0 < M; m0 += GN * 32) {
        uint2 z[4], zp[4];
#pragma unroll
        for (int i = 0; i < 4; ++i) { const int m = m0 + i; z[i] = *(const uint2*)(proj + (size_t)m * DSHIFT + 1536 + 4 * lane);
            zp[i] = make_uint2(0, 0); if ((m & (S - 1)) != 0) zp[i] = *(const uint2*)(proj + (size_t)(m - 1) * DSHIFT + 1536 + 4 * lane); }
#pragma unroll
        for (int i = 0; i < 4; ++i) {
            float c[4] = {__builtin_bit_cast(float, z[i].x << 16), __builtin_bit_cast(float, z[i].x & 0xffff0000u), __builtin_bit_cast(float, z[i].y << 16), __builtin_bit_cast(float, z[i].y & 0xffff0000u)};
            const float q[4] = {__builtin_bit_cast(float, zp[i].x << 16), __builtin_bit_cast(float, zp[i].x & 0xffff0000u), __builtin_bit_cast(float, zp[i].y << 16), __builtin_bit_cast(float, zp[i].y & 0xffff0000u)};
#pragma unroll
            for (int e = 0; e < 4; ++e) { float t = c[e] + (q[e] - c[e]) * mm[e];
                if (lane < 16) t = 1.f - 2.f / (1.f + __expf(2.f * t));
                else if (lane >= 32) t = sigmoidf_(t);
                c[e] = t; }
            uint2 o; o.x = pk2(c[0], c[1]); o.y = pk2(c[2], c[3]);
            *(uint2*)(lin + (size_t)(m0 + i) * 256 + 4 * lane) = o;
        }
    }
}
__device__ __forceinline__ void rwkv_wl_ph(const int WID_, const float* __restrict__ wdec, const float* __restrict__ wiclr, const float* __restrict__ wgate, bf16* __restrict__ wl) {
    for (int i = GB * NT + (WID_ * 64 + lane_id()); i < 1536 * 256; i += GN * NT) {
        const int k = i & 255, n = i >> 8; float v = 0.f;
        if (n < 512) { if (k < 64) v = wdec[k * 512 + n]; }
        else if (n < 1024) { if (k >= 64 && k < 128) v = wiclr[(k - 64) * 512 + (n - 512)]; }
        else { if (k >= 128) v = wgate[(k - 128) * 512 + (n - 1024)]; }
        wl[i] = f2bf(v);
    }
}
struct RwkvIn { const bf16* proj; const bf16* LW; const bf16* AA; const float* mu; const float* k_k; const float* k_a; const float* r_k; float* Y; float* RK; };
constexpr int TB = 64;
constexpr int RW_ITEMS = NB * 8;
template <int CTRL> __device__ __forceinline__ float dpp16(float x) { return __builtin_bit_cast(float, __builtin_amdgcn_update_dpp(0, __builtin_bit_cast(int, x), CTRL, 0xf, 0xf, true)); }
__device__ __forceinline__ void rwkv_scan_ph(const int WID_, const RwkvIn& I, char* lds) {
    float* Rs = (float*)lds; float* Ws = Rs + TB * 64; float* Kps = Ws + TB * 64; float* KKs = Kps + TB * 64; float* Bs = KKs + TB * 64; float* Vs = Bs + TB * 64; float* Ys = Vs + TB * 64;
    const int lane = (WID_ * 64 + lane_id()) & 63, wv = (WID_ * 64 + lane_id()) >> 6;
    for (int item = GB; item < RW_ITEMS; item += GN) {
        const int half = item & 1, h = (item >> 1) & 7, b = item >> 4;
        const int j = lane & 15, rl = 4 * wv + (lane >> 4), row = 32 * half + rl;
        float s0 = 0.f, s1 = 0.f, s2 = 0.f, s3 = 0.f, sa = 0.f;
        const int tau = (WID_ * 64 + lane_id()) >> 3, cg = (WID_ * 64 + lane_id()) & 7, ch0 = h * 64 + cg * 8;
        uint4 gr, gk, gv, qr, qk, qv, ga, gl;
#define RW_ISSUE(blk) do { const int t_ = (blk) * TB + tau; const size_t m_ = (size_t)b * S + t_; const bf16* z_ = I.proj + m_ * DSHIFT + ch0; \
            gr = *(const uint4*)(z_); gk = *(const uint4*)(z_ + 512); gv = *(const uint4*)(z_ + 1024); \
            if (t_ > 0) { qr = *(const uint4*)(z_ - DSHIFT); qk = *(const uint4*)(z_ + 512 - DSHIFT); qv = *(const uint4*)(z_ + 1024 - DSHIFT); } \
            else { qr = make_uint4(0, 0, 0, 0); qk = qr; qv = qr; } \
            ga = *(const uint4*)(I.AA + m_ * 512 + ch0); gl = *(const uint4*)(I.LW + m_ * 512 + ch0); } while (0)
#define RW_COMMIT(blk) do { \
            const unsigned wr_[4] = {gr.x, gr.y, gr.z, gr.w}, wk_[4] = {gk.x, gk.y, gk.z, gk.w}, wv_[4] = {gv.x, gv.y, gv.z, gv.w}; \
            const unsigned pr_[4] = {qr.x, qr.y, qr.z, qr.w}, pk_[4] = {qk.x, qk.y, qk.z, qk.w}, pv_[4] = {qv.x, qv.y, qv.z, qv.w}; \
            const unsigned wa_[4] = {ga.x, ga.y, ga.z, ga.w}, wl_[4] = {gl.x, gl.y, gl.z, gl.w}; \
            float r_[8], k_[8], v_[8], a_[8], kk_[8], ss_ = 0.f, rk_ = 0.f; \
            _Pragma("unroll") for (int e = 0; e < 8; ++e) { const int w_ = e >> 1; const bool hi_ = e & 1; \
                auto ex = [&](unsigned u) { return hi_ ? __builtin_bit_cast(float, u & 0xffff0000u) : __builtin_bit_cast(float, u << 16); }; \
                const float mr_ = I.mu[ch0 + e], mk_ = I.mu[512 + ch0 + e], mv_ = I.mu[1024 + ch0 + e]; \
                float x = ex(wr_[w_]); r_[e] = x + (ex(pr_[w_]) - x) * mr_; x = ex(wk_[w_]); k_[e] = x + (ex(pk_[w_]) - x) * mk_; x = ex(wv_[w_]); v_[e] = x + (ex(pv_[w_]) - x) * mv_; \
                a_[e] = ex(wa_[w_]); kk_[e] = k_[e] * I.k_k[ch0 + e]; ss_ += kk_[e] * kk_[e]; } \
            ss_ += dpp16<0xB1>(ss_); ss_ += dpp16<0x4E>(ss_); ss_ += dpp16<0x141>(ss_); \
            const float inv_ = 1.f / fmaxf(sqrtf(ss_), 1e-12f); \
            float o_[6][8]; \
            _Pragma("unroll") for (int e = 0; e < 8; ++e) { const int w_ = e >> 1; const bool hi_ = e & 1; \
                const float lw_ = hi_ ? __builtin_bit_cast(float, wl_[w_] & 0xffff0000u) : __builtin_bit_cast(float, wl_[w_] << 16); \
                const float kp_ = k_[e] * (1.f + (a_[e] - 1.f) * I.k_a[ch0 + e]); const float kn_ = kk_[e] * inv_; \
                o_[0][e] = r_[e]; o_[1][e] = __expf(lw_); o_[2][e] = kp_; o_[3][e] = kn_; o_[4][e] = kn_ * a_[e]; o_[5][e] = v_[e]; rk_ += r_[e] * kp_ * I.r_k[ch0 + e]; } \
            _Pragma("unroll") for (int q_ = 0; q_ < 6; ++q_) { float* d_ = Rs + q_ * (TB * 64) + tau * 64 + cg * 8; \
                *(float4*)d_ = make_float4(o_[q_][0], o_[q_][1], o_[q_][2], o_[q_][3]); *(float4*)(d_ + 4) = make_float4(o_[q_][4], o_[q_][5], o_[q_][6], o_[q_][7]); } \
            if (half == 0) { rk_ += dpp16<0xB1>(rk_); rk_ += dpp16<0x4E>(rk_); rk_ += dpp16<0x141>(rk_); \
                if (cg == 0) I.RK[((size_t)b * S + (blk) * TB + tau) * 8 + h] = rk_; } } while (0)
        RW_ISSUE(0);
        __syncthreads();
        RW_COMMIT(0);
        __syncthreads();
        for (int blk = 0; blk < S / TB; ++blk) {
            if (blk + 1 < S / TB) RW_ISSUE(blk + 1);
            float4 r4 = *(const float4*)(Rs + 4 * j), w4 = *(const float4*)(Ws + 4 * j), k4 = *(const float4*)(Kps + 4 * j), b4 = *(const float4*)(Bs + 4 * j);
            float vv = Vs[row];
            if (blk == 0) sa = 0.f;
#pragma unroll 2
            for (int t = 0; t < TB; ++t) {
                const int tn = (t + 1 < TB) ? t + 1 : t;
                const float4 n4n = *(const float4*)(KKs + tn * 64 + 4 * j);
                const float4 r4n = *(const float4*)(Rs + tn * 64 + 4 * j), w4n = *(const float4*)(Ws + tn * 64 + 4 * j), k4n = *(const float4*)(Kps + tn * 64 + 4 * j), b4n = *(const float4*)(Bs + tn * 64 + 4 * j);
                const float vvn = Vs[tn * 64 + row];
                s0 = s0 * w4.x + (sa * b4.x + vv * k4.x);
                s1 = s1 * w4.y + (sa * b4.y + vv * k4.y);
                s2 = s2 * w4.z + (sa * b4.z + vv * k4.z);
                s3 = s3 * w4.w + (sa * b4.w + vv * k4.w);
                float py = (s0 * r4.x + s1 * r4.y) + (s2 * r4.z + s3 * r4.w);
                float ps = (s0 * n4n.x + s1 * n4n.y) + (s2 * n4n.z + s3 * n4n.w);
                py += dpp16<0xB1>(py); ps += dpp16<0xB1>(ps);
                py += dpp16<0x4E>(py); ps += dpp16<0x4E>(ps);
                py += dpp16<0x141>(py); ps += dpp16<0x141>(ps);
                py += dpp16<0x140>(py); ps += dpp16<0x140>(ps);
                if (j == 0) Ys[t * 32 + rl] = py;
                if (t + 1 < TB) sa = -ps;
                r4 = r4n; w4 = w4n; k4 = k4n; b4 = b4n; vv = vvn;
            }
            __syncthreads();
            { const int t = (WID_ * 64 + lane_id()) >> 3, r0 = ((WID_ * 64 + lane_id()) & 7) * 4; const size_t m = (size_t)b * S + blk * TB + t;
              *(float4*)(I.Y + m * 512 + h * 64 + 32 * half + r0) = *(const float4*)(Ys + t * 32 + r0); }
            if (blk + 1 < S / TB) RW_COMMIT(blk + 1);
            __syncthreads();
            if (blk + 1 < S / TB) { const float4 n4 = *(const float4*)(KKs + 4 * j);
                float ps = (s0 * n4.x + s1 * n4.y) + (s2 * n4.z + s3 * n4.w);
                ps += dpp16<0xB1>(ps); ps += dpp16<0x4E>(ps); ps += dpp16<0x141>(ps); ps += dpp16<0x140>(ps);
                sa = -ps; }
        }
    }
}

namespace ck {
#define CK_BAR() do { asm volatile("s_waitcnt lgkmcnt(0)" ::: "memory"); __builtin_amdgcn_s_barrier(); asm volatile("" ::: "memory"); } while (0)
typedef float f32x2_t __attribute__((ext_vector_type(2)));
typedef __bf16 bf16x2_t __attribute__((ext_vector_type(2)));
__device__ __forceinline__ unsigned cvtpk(float lo, float hi) { const f32x2_t v = {lo, hi}; const bf16x2_t b = __builtin_convertvector(v, bf16x2_t); return __builtin_bit_cast(unsigned, b); }
typedef short bf16x8 __attribute__((ext_vector_type(8)));
typedef float f32x16 __attribute__((ext_vector_type(16)));
constexpr int LD = 72;
constexpr int MB = 64 * LD * 2;
constexpr int O_AB = 0, O_RB = MB, O_BB = 2 * MB, O_KB = 3 * MB, O_AT = 4 * MB, O_W1T = 5 * MB, O_BT = 6 * MB, O_KT = 7 * MB, O_VT = 8 * MB,
              O_NM = 9 * MB, O_AAK = 10 * MB, O_ARB = 11 * MB, O_ARK = 12 * MB, O_G = 13 * MB, O_TOT = O_G + 16384;
constexpr int O_TM = O_AB, O_X1T = O_BB, O_NMF = O_G, O_TT = O_G + 8192, O_ZT = O_TT + 5120;
constexpr int ITEM_BYTES = 32768;
template <int K, typename PA, typename PB>
__device__ __forceinline__ f32x16 mm_tile(f32x16 acc, PA A, int lda, PB B, int ldb, int lane) {
    const int r = lane & 31, h = lane >> 5;
    bf16x8 a[K / 16], b[K / 16];
#pragma unroll
    for (int q = 0; q < K / 16; ++q) { a[q] = *(const bf16x8*)(A + r * lda + 16 * q + 8 * h); b[q] = *(const bf16x8*)(B + r * ldb + 16 * q + 8 * h); }
#pragma unroll
    for (int q = 0; q < K / 16; ++q) acc = __builtin_amdgcn_mfma_f32_32x32x16_bf16(a[q], b[q], acc, 0, 0, 0);
    return acc;
}
__device__ __forceinline__ int crow(int reg, int h) { return (reg & 3) + 8 * (reg >> 2) + 4 * h; }
__device__ __forceinline__ void store_tr(const f32x16& acc, bf16* Ct, int ldct, int lane) {
    const int c = lane & 31, h = lane >> 5;
#pragma unroll
    for (int g = 0; g < 4; ++g) { uint2 w; w.x = cvtpk(acc[4 * g], acc[4 * g + 1]); w.y = cvtpk(acc[4 * g + 2], acc[4 * g + 3]); *(uint2*)(Ct + c * ldct + 8 * g + 4 * h) = w; }
}
__device__ __forceinline__ void store_rm(const f32x16& acc, bf16* C, int ldc, int lane) {
    const int c = lane & 31, h = lane >> 5;
#pragma unroll
    for (int rg = 0; rg < 16; ++rg) C[crow(rg, h) * ldc + c] = f2bf(acc[rg]);
}
__device__ __forceinline__ f32x16 zero16() { return (f32x16){0.f, 0.f, 0.f, 0.f, 0.f, 0.f, 0.f, 0.f, 0.f, 0.f, 0.f, 0.f, 0.f, 0.f, 0.f, 0.f}; }
__device__ __forceinline__ void store_frag16(const f32x16& acc, bf16* base, int t0, int t1, int lane) {
    const int cc = lane & 31, hh = lane >> 5, col = 32 * t1 + cc;
#pragma unroll
    for (int g = 0; g < 4; ++g) { const int row = 32 * t0 + 8 * g + 4 * hh;
        uint2 w; w.x = cvtpk(acc[4 * g], acc[4 * g + 1]); w.y = cvtpk(acc[4 * g + 2], acc[4 * g + 3]);
        *(uint2*)(base + (((row >> 4) * 4 + (col >> 4)) * 64 + (col & 15) + 16 * ((row & 15) >> 2)) * 4) = w; }
}
struct In { const bf16* proj; const bf16* LW; const bf16* AA; const float* mu; const float* k_k; const float* k_a; const float* r_k; float* RK; char* items; };

__device__ __forceinline__ void phase1(const int WID_, const In& I, char* lds) {
    const int wv = WID_;
#define MAT(off) ((bf16*)(lds + (off)))
    float* G = (float*)(lds + O_G); float* TOT = (float*)(lds + O_TOT); float* NMF = (float*)(lds + O_NMF);
    for (int item = GB; item < NB * 8 * (S / 64); item += GN) {
        const int lane = lane_id(), tid = wv * 64 + lane;
        const int c = item & 127, h = (item >> 7) & 7, b = item >> 10;
        char* out = I.items + (size_t)item * ITEM_BYTES;
        const int s = tid >> 3, cg = tid & 7, ch0 = h * 64 + cg * 8, t = c * 64 + s; const size_t m = (size_t)b * S + t;
        float r_[8], kp_[8], v_[8], kk_[8], b_[8];
        {
            const bf16* z = I.proj + m * DSHIFT + ch0;
            const uint4 gr = *(const uint4*)(z), gk = *(const uint4*)(z + 512), gv = *(const uint4*)(z + 1024);
            uint4 qr = make_uint4(0, 0, 0, 0), qk = qr, qv = qr;
            if (t > 0) { qr = *(const uint4*)(z - DSHIFT); qk = *(const uint4*)(z + 512 - DSHIFT); qv = *(const uint4*)(z + 1024 - DSHIFT); }
            const uint4 ga = *(const uint4*)(I.AA + m * 512 + ch0), gl = *(const uint4*)(I.LW + m * 512 + ch0);
            const float4 c_mr0 = *(const float4*)(I.mu + ch0), c_mr1 = *(const float4*)(I.mu + ch0 + 4), c_mk0 = *(const float4*)(I.mu + 512 + ch0), c_mk1 = *(const float4*)(I.mu + 512 + ch0 + 4);
            const float4 c_mv0 = *(const float4*)(I.mu + 1024 + ch0), c_mv1 = *(const float4*)(I.mu + 1024 + ch0 + 4), c_kk0 = *(const float4*)(I.k_k + ch0), c_kk1 = *(const float4*)(I.k_k + ch0 + 4);
            const float4 c_ka0 = *(const float4*)(I.k_a + ch0), c_ka1 = *(const float4*)(I.k_a + ch0 + 4), c_rk0 = *(const float4*)(I.r_k + ch0), c_rk1 = *(const float4*)(I.r_k + ch0 + 4);
            const float mur[8] = {c_mr0.x, c_mr0.y, c_mr0.z, c_mr0.w, c_mr1.x, c_mr1.y, c_mr1.z, c_mr1.w}, muk[8] = {c_mk0.x, c_mk0.y, c_mk0.z, c_mk0.w, c_mk1.x, c_mk1.y, c_mk1.z, c_mk1.w};
            const float muv[8] = {c_mv0.x, c_mv0.y, c_mv0.z, c_mv0.w, c_mv1.x, c_mv1.y, c_mv1.z, c_mv1.w}, ckk[8] = {c_kk0.x, c_kk0.y, c_kk0.z, c_kk0.w, c_kk1.x, c_kk1.y, c_kk1.z, c_kk1.w};
            const float cka[8] = {c_ka0.x, c_ka0.y, c_ka0.z, c_ka0.w, c_ka1.x, c_ka1.y, c_ka1.z, c_ka1.w}, crk[8] = {c_rk0.x, c_rk0.y, c_rk0.z, c_rk0.w, c_rk1.x, c_rk1.y, c_rk1.z, c_rk1.w};
            const unsigned wr[4] = {gr.x, gr.y, gr.z, gr.w}, wk[4] = {gk.x, gk.y, gk.z, gk.w}, wv4[4] = {gv.x, gv.y, gv.z, gv.w};
            const unsigned pr[4] = {qr.x, qr.y, qr.z, qr.w}, pk[4] = {qk.x, qk.y, qk.z, qk.w}, pv[4] = {qv.x, qv.y, qv.z, qv.w};
            const unsigned wa[4] = {ga.x, ga.y, ga.z, ga.w}, wl[4] = {gl.x, gl.y, gl.z, gl.w};
            float ss = 0.f, rk = 0.f, a_[8];
#pragma unroll
            for (int e = 0; e < 8; ++e) { const int w_ = e >> 1; const bool hi = e & 1;
                auto ex = [&](unsigned u) { return hi ? __builtin_bit_cast(float, u & 0xffff0000u) : __builtin_bit_cast(float, u << 16); };
                float x = ex(wr[w_]); r_[e] = x + (ex(pr[w_]) - x) * mur[e];
                x = ex(wk[w_]); const float k = x + (ex(pk[w_]) - x) * muk[e];
                x = ex(wv4[w_]); v_[e] = x + (ex(pv[w_]) - x) * muv[e];
                a_[e] = ex(wa[w_]); kk_[e] = k * ckk[e]; ss += kk_[e] * kk_[e];
                kp_[e] = k * (1.f + (a_[e] - 1.f) * cka[e]); rk += r_[e] * kp_[e] * crk[e];
                G[s * 64 + cg * 8 + e] = ex(wl[w_]); }
            ss += dpp16<0xB1>(ss); ss += dpp16<0x4E>(ss); ss += dpp16<0x141>(ss);
            const float inv = 1.f / fmaxf(sqrtf(ss), 1e-12f);
#pragma unroll
            for (int e = 0; e < 8; ++e) { kk_[e] *= inv; b_[e] = kk_[e] * a_[e]; }
            rk += dpp16<0xB1>(rk); rk += dpp16<0x4E>(rk); rk += dpp16<0x141>(rk);
            if (cg == 0) I.RK[m * 8 + h] = rk;
        }
        CK_BAR();
        { const int ch = tid & 63, part = tid >> 6; float run = 0.f;
#pragma unroll
          for (int i = 0; i < 8; ++i) { run += G[(8 * part + i) * 64 + ch]; G[(8 * part + i) * 64 + ch] = run; }
          TOT[part * 64 + ch] = run; }
        CK_BAR();
        { const int ch = tid & 63, part = tid >> 6; float off = 0.f;
          for (int p = 0; p < part; ++p) off += TOT[p * 64 + ch];
#pragma unroll
          for (int i = 0; i < 8; ++i) G[(8 * part + i) * 64 + ch] += off; }
        CK_BAR();
        float glast[8];
        {
            unsigned pab[4], prb[4], pbb[4], pkb[4];
            float ab[8], rb[8], bb[8], kb[8], bt[8], kt[8];
#pragma unroll
            for (int e = 0; e < 8; ++e) { const float g = G[s * 64 + cg * 8 + e], gm1 = (s > 0) ? G[(s - 1) * 64 + cg * 8 + e] : 0.f, gL = G[63 * 64 + cg * 8 + e];
                glast[e] = gL;
                const float eg = __expf(g), eng = __expf(-g), egm = __expf(gm1), egl = __expf(gL - g);
                ab[e] = -kk_[e] * egm; rb[e] = r_[e] * eg; bb[e] = b_[e] * eng; kb[e] = kp_[e] * eng; bt[e] = b_[e] * egl; kt[e] = kp_[e] * egl; }
#pragma unroll
            for (int q = 0; q < 4; ++q) { pab[q] = pk2(ab[2 * q], ab[2 * q + 1]); prb[q] = pk2(rb[2 * q], rb[2 * q + 1]); pbb[q] = pk2(bb[2 * q], bb[2 * q + 1]); pkb[q] = pk2(kb[2 * q], kb[2 * q + 1]); }
            *(uint4*)(MAT(O_AB) + s * LD + cg * 8) = make_uint4(pab[0], pab[1], pab[2], pab[3]);
            *(uint4*)(MAT(O_RB) + s * LD + cg * 8) = make_uint4(prb[0], prb[1], prb[2], prb[3]);
            *(uint4*)(MAT(O_BB) + s * LD + cg * 8) = make_uint4(pbb[0], pbb[1], pbb[2], pbb[3]);
            *(uint4*)(MAT(O_KB) + s * LD + cg * 8) = make_uint4(pkb[0], pkb[1], pkb[2], pkb[3]);
#pragma unroll
            for (int e = 0; e < 8; ++e) { const int k = cg * 8 + e;
                MAT(O_AT)[k * LD + s] = f2bf(ab[e]); MAT(O_BT)[k * LD + s] = f2bf(bt[e]); MAT(O_KT)[k * LD + s] = f2bf(kt[e]); MAT(O_VT)[k * LD + s] = f2bf(v_[e]); }
        }
        CK_BAR();
        if (s == 63) {
#pragma unroll
            for (int e = 0; e < 8; ++e) TOT[cg * 8 + e] = __expf(glast[e]);
        }
        {
            const int mat = tid >> 7, row = (tid >> 2) & 31, chunk = tid & 3;
            *(uint4*)(MAT(O_NM + mat * MB) + row * LD + 32 + chunk * 8) = make_uint4(0, 0, 0, 0);
        }
        for (int task = wv; task < 12; task += 8) {
            const int mat = task / 3, tt = task % 3, st = (tt == 0) ? 0 : 1, jt = (tt == 2) ? 1 : 0;
            const bf16* Asrc = MAT((mat & 1) ? O_KB : O_BB) + 32 * jt * LD;
            const bf16* Bsrc = MAT((mat >> 1) ? O_RB : O_AB) + 32 * st * LD;
            f32x16 acc = mm_tile<64>(zero16(), Asrc, LD, Bsrc, LD, lane);
            const int cs = 32 * st + (lane & 31), hh = lane >> 5; const bool incl = (mat >> 1) != 0;
#pragma unroll
            for (int rg = 0; rg < 16; ++rg) { const int j = 32 * jt + crow(rg, hh); const bool keep = incl ? (j <= cs) : (j < cs); if (!keep) acc[rg] = 0.f; }
            store_tr(acc, MAT(O_NM + mat * MB) + 32 * st * LD + 32 * jt, LD, lane);
            if (mat == 0 && st == jt) {
                float* d = NMF + st * 1024 + (lane & 31) * 32;
#pragma unroll
                for (int g = 0; g < 4; ++g) *(float4*)(d + 8 * g + 4 * hh) = make_float4(acc[4 * g], acc[4 * g + 1], acc[4 * g + 2], acc[4 * g + 3]);
            }
        }
        CK_BAR();
        if (wv == 0) {
            const int d = lane >> 4, cc = lane & 15;
            const float* nb = NMF + (d >> 1) * 1024 + (16 * (d & 1)) * 32 + 16 * (d & 1);
            float T[16];
#pragma unroll
            for (int i = 0; i < 16; ++i) {
                float acc = (i == cc) ? 1.f : 0.f;
#pragma unroll
                for (int j4 = 0; j4 < i; j4 += 4) { const float4 n4 = *(const float4*)(nb + i * 32 + j4);
                    acc += n4.x * T[j4]; if (j4 + 1 < i) acc += n4.y * T[j4 + 1]; if (j4 + 2 < i) acc += n4.z * T[j4 + 2]; if (j4 + 3 < i) acc += n4.w * T[j4 + 3]; }
                T[i] = acc;
            }
            bf16* tm = MAT(O_TM) + (16 * d) * LD + 16 * d + cc;
#pragma unroll
            for (int i = 0; i < 16; ++i) tm[i * LD] = f2bf(T[i]);
            bf16* tt = MAT(O_TT) + (d >> 1) * 32 * 40 + (16 * (d & 1) + cc) * 40 + 16 * (d & 1);
            *(uint4*)(tt) = make_uint4(pk2(T[0], T[1]), pk2(T[2], T[3]), pk2(T[4], T[5]), pk2(T[6], T[7]));
            *(uint4*)(tt + 8) = make_uint4(pk2(T[8], T[9]), pk2(T[10], T[11]), pk2(T[12], T[13]), pk2(T[14], T[15]));
            { const int blk = lane >> 5, r16 = (lane >> 1) & 15, hf = lane & 1;
              *(uint4*)(MAT(O_TM) + (32 * blk + r16) * LD + 32 * blk + 16 + 8 * hf) = make_uint4(0, 0, 0, 0);
              *(uint4*)(MAT(O_TT) + blk * 32 * 40 + (16 + r16) * 40 + 8 * hf) = make_uint4(0, 0, 0, 0); }
        } else if (wv == 1) {
            const int row = lane >> 1, half = lane & 1;
            *(uint4*)(MAT(O_TM) + row * LD + 32 + half * 16) = make_uint4(0, 0, 0, 0); *(uint4*)(MAT(O_TM) + row * LD + 32 + half * 16 + 8) = make_uint4(0, 0, 0, 0);
        } else if (wv >= 4) {
            const int st = (wv - 4) >> 1, vt = (wv - 4) & 1;
            f32x16 acc = mm_tile<64>(zero16(), MAT(O_AAK) + 32 * st * LD, LD, MAT(O_VT) + 32 * vt * LD, LD, lane);
            store_tr(acc, MAT(O_W1T) + 32 * vt * LD + 32 * st, LD, lane);
        }
        CK_BAR();
        if (wv < 2) {
            typedef float f32x4v __attribute__((ext_vector_type(4)));
            const int blk = wv, fr = lane & 15, fq = lane >> 4;
            const bf16x8 zf = (bf16x8){0, 0, 0, 0, 0, 0, 0, 0};
            bf16x8 a = zf, bq = zf;
            if (fq < 2) { a = *(const bf16x8*)(MAT(O_NM) + (32 * blk + 16 + fr) * LD + 32 * blk + 8 * fq); bq = *(const bf16x8*)(MAT(O_TT) + blk * 32 * 40 + fr * 40 + 8 * fq); }
            f32x4v z = __builtin_amdgcn_mfma_f32_16x16x32_bf16(a, bq, (f32x4v){0.f, 0.f, 0.f, 0.f}, 0, 0, 0);
            bf16* zt = MAT(O_ZT) + blk * 16 * 24;
            { uint2 w; w.x = cvtpk(z[0], z[1]); w.y = cvtpk(z[2], z[3]); *(uint2*)(zt + fr * 24 + 4 * fq) = w; }
            asm volatile("s_waitcnt lgkmcnt(0)" ::: "memory");
            a = zf; bq = zf;
            if (fq < 2) { a = *(const bf16x8*)(MAT(O_TM) + (32 * blk + 16 + fr) * LD + 32 * blk + 16 + 8 * fq); bq = *(const bf16x8*)(zt + fr * 24 + 8 * fq); }
            const f32x4v t21 = __builtin_amdgcn_mfma_f32_16x16x32_bf16(a, bq, (f32x4v){0.f, 0.f, 0.f, 0.f}, 0, 0, 0);
#pragma unroll
            for (int rg = 0; rg < 4; ++rg) MAT(O_TM)[(32 * blk + 16 + 4 * fq + rg) * LD + 32 * blk + fr] = f2bf(t21[rg]);
            { uint2 w; w.x = cvtpk(t21[0], t21[1]); w.y = cvtpk(t21[2], t21[3]); *(uint2*)(MAT(O_TT) + blk * 32 * 40 + fr * 40 + 16 + 4 * fq) = w; }
        }
        CK_BAR();
        if (wv == 0) { f32x16 acc = mm_tile<32>(zero16(), MAT(O_NM) + 32 * LD, LD, MAT(O_TT), 40, lane); store_tr(acc, MAT(O_ZT), 40, lane); }
        CK_BAR();
        if (wv == 0) { f32x16 acc = mm_tile<32>(zero16(), MAT(O_TM) + 32 * LD + 32, LD, MAT(O_ZT), 40, lane); store_rm(acc, MAT(O_TM) + 32 * LD, LD, lane); }
        CK_BAR();
        { const int st = wv >> 2, ct = wv & 3;
          f32x16 acc = mm_tile<64>(zero16(), MAT(O_TM) + 32 * st * LD, LD, MAT(O_AT) + 32 * ct * LD, LD, lane);
          CK_BAR();
          store_tr(acc, MAT(O_X1T) + 32 * ct * LD + 32 * st, LD, lane); }
        CK_BAR();
        for (int u = wv; u < 16; u += 8) {
            const int kind = u >> 2, t0 = (u >> 1) & 1, t1 = u & 1, hh = lane >> 5, cc = lane & 31;
            if (kind == 0) {
                f32x16 acc = mm_tile<64>(zero16(), MAT(O_BT) + 32 * t0 * LD, LD, MAT(O_X1T) + (64 + 32 * t1) * LD, LD, lane);
                acc = mm_tile<64>(acc, MAT(O_KT) + 32 * t0 * LD, LD, MAT(O_VT) + 32 * t1 * LD, LD, lane);
                store_frag16(acc, (bf16*)(out + 16384), t0, t1, lane);
            } else if (kind == 1) {
                f32x16 acc = mm_tile<64>(zero16(), MAT(O_ARB) + 32 * t0 * LD, LD, MAT(O_X1T) + (64 + 32 * t1) * LD, LD, lane);
                acc = mm_tile<64>(acc, MAT(O_ARK) + 32 * t0 * LD, LD, MAT(O_VT) + 32 * t1 * LD, LD, lane);
                store_frag16(acc, (bf16*)(out + 24576), t0, t1, lane);
            } else if (kind == 2) {
                f32x16 acc = mm_tile<64>(zero16(), MAT(O_X1T) + 32 * t0 * LD, LD, MAT(O_BT) + 32 * t1 * LD, LD, lane);
                const int k = 32 * t1 + cc; const float gl = TOT[k];
                bf16* d = (bf16*)out + k * 64 + 32 * t0;
#pragma unroll
                for (int g = 0; g < 4; ++g) { float x[4];
#pragma unroll
                    for (int e = 0; e < 4; ++e) { const int kp = 32 * t0 + 8 * g + 4 * hh + e; x[e] = acc[4 * g + e] + ((kp == k) ? gl : 0.f); }
                    uint2 w; w.x = cvtpk(x[0], x[1]); w.y = cvtpk(x[2], x[3]); *(uint2*)(d + 8 * g + 4 * hh) = w; }
            } else {
                f32x16 acc = mm_tile<64>(zero16(), MAT(O_X1T) + 32 * t0 * LD, LD, MAT(O_ARB) + 32 * t1 * LD, LD, lane);
                const int sq = 32 * t1 + cc;
                bf16* d = (bf16*)(out + 8192) + sq * 64 + 32 * t0;
                const bf16* rb = MAT(O_RB) + sq * LD + 32 * t0;
#pragma unroll
                for (int g = 0; g < 4; ++g) { const uint2 rr = *(const uint2*)(rb + 8 * g + 4 * hh);
                    const float x0 = acc[4 * g] + __builtin_bit_cast(float, rr.x << 16), x1 = acc[4 * g + 1] + __builtin_bit_cast(float, rr.x & 0xffff0000u);
                    const float x2 = acc[4 * g + 2] + __builtin_bit_cast(float, rr.y << 16), x3 = acc[4 * g + 3] + __builtin_bit_cast(float, rr.y & 0xffff0000u);
                    uint2 w; w.x = cvtpk(x0, x1); w.y = cvtpk(x2, x3); *(uint2*)(d + 8 * g + 4 * hh) = w; }
            }
        }
        CK_BAR();
    }
#undef MAT
}
typedef float f32x4w __attribute__((ext_vector_type(4)));
struct P2R { bf16x8 a0, a1; uint2 c; };
__device__ __forceinline__ void p2_load(P2R& o, const char* rec, size_t aoff, size_t coff) { o.a0 = *(const bf16x8*)(rec + aoff); o.a1 = *(const bf16x8*)(rec + aoff + 64); o.c = *(const uint2*)(rec + coff); }
__device__ __forceinline__ void phase2(const int WID_, const char* items, float* Y, char* lds) {
    const int wv = WID_;
    bf16* HT0 = (bf16*)lds; bf16* HT1 = HT0 + 16 * LD;
    for (int item = GB; item < NB * 8 * 4; item += GN) {
        const int lane = lane_id(), fr = lane & 15, fq = lane >> 4;
        const int vq = (item >> 3) & 3, head = (item & 7) + 8 * (item >> 5), b = head >> 3, h = head & 7;
        for (int i = wv * 64 + lane; i < 2 * 16 * LD / 8; i += NT) ((uint4*)lds)[i] = make_uint4(0, 0, 0, 0);
        CK_BAR();
        const bool upd = wv < 4; const int rb = wv & 3;
        const char* rec0 = items + (size_t)(head * 128) * ITEM_BYTES;
        const size_t aoff = (upd ? 0 : 8192) + ((16 * rb + fr) * 64 + 8 * fq) * 2;
        const size_t coff = (upd ? 16384 : 24576) + ((rb * 4 + vq) * 64 + lane) * 8;
        float* yo = Y + ((size_t)b * S + 16 * rb + 4 * fq) * 512 + h * 64 + 16 * vq + fr;
        P2R r0, r1, r2, r3, r4, r5, r6, r7, r8, r9, r10, r11, r12, r13, r14, r15;
#define P2_PRE(R, i) p2_load(R, rec0 + (size_t)(i) * ITEM_BYTES, aoff, coff)
        P2_PRE(r0, 0); P2_PRE(r1, 1); P2_PRE(r2, 2); P2_PRE(r3, 3); P2_PRE(r4, 4); P2_PRE(r5, 5); P2_PRE(r6, 6); P2_PRE(r7, 7);
        P2_PRE(r8, 8); P2_PRE(r9, 9); P2_PRE(r10, 10); P2_PRE(r11, 11); P2_PRE(r12, 12); P2_PRE(r13, 13); P2_PRE(r14, 14);
#define P2_STEP(R, RN, cstep) do { const int c_ = (cstep); \
            const bf16* Hc = (c_ & 1) ? HT1 : HT0; bf16* Hn = (c_ & 1) ? HT0 : HT1; \
            f32x4w acc = (f32x4w){__builtin_bit_cast(float, R.c.x << 16), __builtin_bit_cast(float, R.c.x & 0xffff0000u), __builtin_bit_cast(float, R.c.y << 16), __builtin_bit_cast(float, R.c.y & 0xffff0000u)}; \
            const bf16x8 b0 = *(const bf16x8*)(Hc + fr * LD + 8 * fq), b1 = *(const bf16x8*)(Hc + fr * LD + 32 + 8 * fq); \
            acc = __builtin_amdgcn_mfma_f32_16x16x32_bf16(R.a0, b0, acc, 0, 0, 0); acc = __builtin_amdgcn_mfma_f32_16x16x32_bf16(R.a1, b1, acc, 0, 0, 0); \
            if (upd) { uint2 w; w.x = cvtpk(acc[0], acc[1]); w.y = cvtpk(acc[2], acc[3]); *(uint2*)(Hn + fr * LD + 16 * rb + 4 * fq) = w; } \
            else { float* y_ = yo + (size_t)c_ * 64 * 512; y_[0] = acc[0]; y_[512] = acc[1]; y_[1024] = acc[2]; y_[1536] = acc[3]; } \
            if (c_ + 15 < S / 64) P2_PRE(RN, c_ + 15); \
            CK_BAR(); } while (0)
        for (int c = 0; c < S / 64; c += 16) {
            P2_STEP(r0, r15, c); P2_STEP(r1, r0, c + 1); P2_STEP(r2, r1, c + 2); P2_STEP(r3, r2, c + 3);
            P2_STEP(r4, r3, c + 4); P2_STEP(r5, r4, c + 5); P2_STEP(r6, r5, c + 6); P2_STEP(r7, r6, c + 7);
            P2_STEP(r8, r7, c + 8); P2_STEP(r9, r8, c + 9); P2_STEP(r10, r9, c + 10); P2_STEP(r11, r10, c + 11);
            P2_STEP(r12, r11, c + 12); P2_STEP(r13, r12, c + 13); P2_STEP(r14, r13, c + 14); P2_STEP(r15, r14, c + 15);
        }
#undef P2_STEP
#undef P2_PRE
    }
}
}

__device__ __forceinline__ void rwkv_post_ph(const int WID_, const float* __restrict__ Y, const float* __restrict__ RK, const bf16* __restrict__ proj, const float* __restrict__ mu, const bf16* __restrict__ G,
                             const float* __restrict__ lnw, const float* __restrict__ lnb, bf16* __restrict__ ymix) {
    const int lane = lane_id(), tk = WID_, grp = lane, ch0 = grp * 8, head = grp >> 3;
    const float4 mv0 = *(const float4*)(mu + 1024 + ch0), mv1 = *(const float4*)(mu + 1024 + ch0 + 4), lw0 = *(const float4*)(lnw + ch0), lw1 = *(const float4*)(lnw + ch0 + 4), lb0 = *(const float4*)(lnb + ch0), lb1 = *(const float4*)(lnb + ch0 + 4);
    const float muv[8] = {mv0.x, mv0.y, mv0.z, mv0.w, mv1.x, mv1.y, mv1.z, mv1.w}, lw_[8] = {lw0.x, lw0.y, lw0.z, lw0.w, lw1.x, lw1.y, lw1.z, lw1.w}, lb_[8] = {lb0.x, lb0.y, lb0.z, lb0.w, lb1.x, lb1.y, lb1.z, lb1.w};
    for (int m0 = GB * 16 + tk; m0 < M; m0 += GN * 16) {
        float4 ya[2], yb[2]; uint4 vv[2], pv[2], gg[2]; float rk[2];
#pragma unroll
        for (int u = 0; u < 2; ++u) { const int m = m0 + 8 * u;
            ya[u] = *(const float4*)(Y + (size_t)m * 512 + ch0); yb[u] = *(const float4*)(Y + (size_t)m * 512 + ch0 + 4);
            vv[u] = *(const uint4*)(proj + (size_t)m * DSHIFT + 1024 + ch0);
            pv[u] = (m & (S - 1)) ? *(const uint4*)(proj + (size_t)(m - 1) * DSHIFT + 1024 + ch0) : make_uint4(0, 0, 0, 0);
            gg[u] = *(const uint4*)(G + (size_t)m * 512 + ch0); rk[u] = RK[(size_t)m * 8 + head]; }
#pragma unroll
        for (int u = 0; u < 2; ++u) {
            const float y[8] = {ya[u].x, ya[u].y, ya[u].z, ya[u].w, yb[u].x, yb[u].y, yb[u].z, yb[u].w};
            float s = 0.f;
#pragma unroll
            for (int e = 0; e < 8; ++e) s += y[e];
            s += dpp16<0xB1>(s); s += dpp16<0x4E>(s); s += dpp16<0x141>(s);
            const float mean = s * (1.f / 64.f); float q = 0.f;
#pragma unroll
            for (int e = 0; e < 8; ++e) { const float d = y[e] - mean; q += d * d; }
            q += dpp16<0xB1>(q); q += dpp16<0x4E>(q); q += dpp16<0x141>(q);
            const float rstd = rsqrtf(q * (1.f / 64.f) + 64e-5f);
            const unsigned wv_[4] = {vv[u].x, vv[u].y, vv[u].z, vv[u].w}, wp_[4] = {pv[u].x, pv[u].y, pv[u].z, pv[u].w}, wg_[4] = {gg[u].x, gg[u].y, gg[u].z, gg[u].w};
            float o[8];
#pragma unroll
            for (int e = 0; e < 8; ++e) { const int w_ = e >> 1; const bool hi = e & 1;
                auto ex = [&](unsigned x) { return hi ? __builtin_bit_cast(float, x & 0xffff0000u) : __builtin_bit_cast(float, x << 16); };
                float v = ex(wv_[w_]); v += (ex(wp_[w_]) - v) * muv[e];
                o[e] = ((y[e] - mean) * rstd * lw_[e] + lb_[e] + rk[u] * v) * ex(wg_[w_]); }
            *(uint4*)(ymix + (size_t)(m0 + 8 * u) * D + ch0) = make_uint4(pk2(o[0], o[1]), pk2(o[2], o[3]), pk2(o[4], o[5]), pk2(o[6], o[7]));
        }
    }
}

constexpr int PSLOTS = NASSIGN + NEXP * 256;
constexpr int MAXTILES = PSLOTS / 256;
struct MoeBufs { int* tok_e; float* tok_g; int* tok_slot; int* slot_tok; float* slot_gate; int* bcnt; int* bbase; int* offs; int* tiles; int* ntiles; };
__device__ __forceinline__ void moe_zero_ph(const int WID_, const MoeBufs& mb) {
    for (int i = GB * NT + (WID_ * 64 + lane_id()); i < PSLOTS; i += GN * NT) { mb.slot_tok[i] = 0; mb.slot_gate[i] = 0.f; }
}
__device__ __forceinline__ void router_ph(const int WID_, const float* __restrict__ x3, const float* __restrict__ nw, bf16* __restrict__ h3, const float* __restrict__ wrg, const float* __restrict__ brg,
                          const float* __restrict__ wre, const float* __restrict__ bre, const MoeBufs& mb, char* lds) {
    const int lane = lane_id(), wv = WID_;
    int* lcnt = (int*)lds;
    _Float16* wg16 = (_Float16*)(lds + 256);
    _Float16* we16 = (_Float16*)(lds + 256 + 8192);
    if (wv == 0 && lane < 32) lcnt[lane] = 0;
    for (int i = wv * 64 + lane; i < 1024; i += NT) { const float4 w = *(const float4*)(wrg + i * 4);
        typedef _Float16 h4 __attribute__((ext_vector_type(4))); *(h4*)(wg16 + i * 4) = (h4){(_Float16)w.x, (_Float16)w.y, (_Float16)w.z, (_Float16)w.w}; }
    for (int i = wv * 64 + lane; i < 4 * 1024 * 2; i += NT) { const float4 w = *(const float4*)(wre + i * 4);
        typedef _Float16 h4 __attribute__((ext_vector_type(4))); *(h4*)(we16 + i * 4) = (h4){(_Float16)w.x, (_Float16)w.y, (_Float16)w.z, (_Float16)w.w}; }
    __syncthreads();
    typedef _Float16 h4 __attribute__((ext_vector_type(4)));
    typedef _Float16 h8 __attribute__((ext_vector_type(8)));
    for (int m = GB * 8 + wv; m < M; m += GN * 8) {
        const float4* xr = (const float4*)(x3 + (size_t)m * D);
        float h[16]; float s = 0.f;
#pragma unroll
        for (int j = 0; j < 4; ++j) { const float4 v = xr[lane + 64 * j]; h[4 * j] = v.x; h[4 * j + 1] = v.y; h[4 * j + 2] = v.z; h[4 * j + 3] = v.w; s += v.x * v.x + v.y * v.y + v.z * v.z + v.w * v.w; }
        s = wave_sum(s);
        const float rs = rsqrtf(s * (1.f / D) + 1e-6f);
        float l1[4] = {0.f, 0.f, 0.f, 0.f};
#pragma unroll
        for (int j = 0; j < 4; ++j) {
            const int k0 = (lane + 64 * j) * 4;
            const float4 g = *(const float4*)(nw + k0);
            h[4 * j] *= rs * g.x; h[4 * j + 1] *= rs * g.y; h[4 * j + 2] *= rs * g.z; h[4 * j + 3] *= rs * g.w;
            uint2 o; o.x = pk2(h[4 * j], h[4 * j + 1]); o.y = pk2(h[4 * j + 2], h[4 * j + 3]);
            *(uint2*)(h3 + (size_t)m * D + k0) = o;
#pragma unroll
            for (int e = 0; e < 4; ++e) { const h4 w = *(const h4*)(wg16 + (k0 + e) * 4); const float x = h[4 * j + e];
                l1[0] += x * (float)w[0]; l1[1] += x * (float)w[1]; l1[2] += x * (float)w[2]; l1[3] += x * (float)w[3]; }
        }
#pragma unroll
        for (int i = 0; i < 4; ++i) l1[i] = wave_sum(l1[i]) + brg[i];
        int grp = 0; float best = l1[0];
#pragma unroll
        for (int i = 1; i < 4; ++i) if (l1[i] > best) { best = l1[i]; grp = i; }
        float se = 0.f;
#pragma unroll
        for (int i = 0; i < 4; ++i) se += __expf(l1[i] - best);
        const float g1 = 1.f / se;
        float l2[8] = {};
        const _Float16* we = we16 + (size_t)grp * D * 8;
#pragma unroll
        for (int j = 0; j < 4; ++j) {
            const int k0 = (lane + 64 * j) * 4;
#pragma unroll
            for (int e = 0; e < 4; ++e) { const float x = h[4 * j + e]; const h8 w = *(const h8*)(we + (k0 + e) * 8);
#pragma unroll
                for (int q = 0; q < 8; ++q) l2[q] += x * (float)w[q]; }
        }
#pragma unroll
        for (int i = 0; i < 8; ++i) l2[i] = wave_sum(l2[i]) + bre[grp * 8 + i];
        int i0 = 0; float v0 = l2[0];
#pragma unroll
        for (int i = 1; i < 8; ++i) if (l2[i] > v0) { v0 = l2[i]; i0 = i; }
        int i1 = -1; float v1 = -3.0e38f;
#pragma unroll
        for (int i = 0; i < 8; ++i) if (i != i0 && l2[i] > v1) { v1 = l2[i]; i1 = i; }
        const float e1 = __expf(v1 - v0), inv = 1.f / (1.f + e1);
        if (lane == 0) {
            const int ea = grp * 8 + i0, eb = grp * 8 + i1;
            mb.tok_e[2 * m] = ea; mb.tok_e[2 * m + 1] = eb;
            mb.tok_g[2 * m] = g1 * inv; mb.tok_g[2 * m + 1] = g1 * e1 * inv;
            atomicAdd(&lcnt[ea], 1); atomicAdd(&lcnt[eb], 1);
        }
    }
    __syncthreads();
    if (wv == 0 && lane < 32) mb.bcnt[GB * 32 + lane] = lcnt[lane];
    __syncthreads();
}
__device__ __forceinline__ void moe_plan_ph(const int WID_, const MoeBufs& mb, char* lds) {
    if (GB != 0) return;
    int* tot = (int*)lds; int* off = tot + 32;
    const int t = WID_ * 64 + lane_id();
    if (t < 32) { int run = 0; for (int b = 0; b < GN; ++b) { const int c = __hip_atomic_load(mb.bcnt + b * 32 + t, __ATOMIC_RELAXED, __HIP_MEMORY_SCOPE_AGENT); mb.bbase[b * 32 + t] = run; run += c; } tot[t] = run; }
    __syncthreads();
    if (t == 0) { int o = 0, nt = 0;
        for (int e = 0; e < NEXP; ++e) { off[e] = o; mb.offs[e] = o; const int c = tot[e]; for (int r0 = 0; r0 < c; r0 += 256) { mb.tiles[nt] = e; ++nt; } o += ((c + 255) / 256) * 256; }
        *mb.ntiles = nt; }
    __syncthreads();
}
__device__ __forceinline__ void moe_scatter_ph(const int WID_, const MoeBufs& mb, char* lds) {
    const int lane = lane_id(), wv = WID_;
    int* cur = (int*)lds;
    if (wv == 0 && lane < 32) cur[lane] = __hip_atomic_load(mb.offs + lane, __ATOMIC_RELAXED, __HIP_MEMORY_SCOPE_AGENT) + __hip_atomic_load(mb.bbase + GB * 32 + lane, __ATOMIC_RELAXED, __HIP_MEMORY_SCOPE_AGENT);
    __syncthreads();
    for (int m0 = (GB * 8 + wv); m0 < M; m0 += GN * 8 * 32) {
        const int i = lane >> 1, m = m0 + i * GN * 8;
        if (m < M) { const int a = 2 * m + (lane & 1); const int e = mb.tok_e[a];
            const int pos = atomicAdd(&cur[e], 1);
            mb.slot_tok[pos] = m; mb.slot_gate[pos] = mb.tok_g[a]; mb.tok_slot[a] = pos; }
    }
    __syncthreads();
}
__device__ __forceinline__ void moe_gather_ph(const int WID_, const bf16* __restrict__ h3, bf16* __restrict__ xg, const MoeBufs& mb) {
    const int lane = lane_id(), wv = WID_;
    const int nrows = __hip_atomic_load(mb.ntiles, __ATOMIC_RELAXED, __HIP_MEMORY_SCOPE_AGENT) * 256;
    for (int r0 = (GB * 8 + wv) * 4; r0 < nrows; r0 += GN * 32) {
        uint4 a[4], c[4];
#pragma unroll
        for (int i = 0; i < 4; ++i) { const int t = mb.slot_tok[r0 + i]; const uint4* s = (const uint4*)(h3 + (size_t)t * D); a[i] = s[lane]; c[i] = s[lane + 64]; }
#pragma unroll
        for (int i = 0; i < 4; ++i) { uint4* d = (uint4*)(xg + (size_t)(r0 + i) * D); d[lane] = a[i]; d[lane + 64] = c[i]; }
    }
}
__device__ __forceinline__ void moe_weights_ph(const int WID_, const float* __restrict__ wg, const float* __restrict__ wu, const float* __restrict__ wd, bf16* __restrict__ wgu_t, bf16* __restrict__ wd_t, char* lds, int vb, int nvb) {
    const int lane = (WID_ * 64 + lane_id()) & 63, wv = (WID_ * 64 + lane_id()) >> 6;
    float* scr = (float*)(lds + wv * 16384);
    constexpr int I_GU = 16 * 16;
    constexpr int I_D = 8 * 32;
    constexpr int NIT = NEXP * (2 * I_GU + I_D);
    for (int it = vb * 8 + wv; it < NIT; it += nvb * 8) {
        const int e = it / (2 * I_GU + I_D); int r = it % (2 * I_GU + I_D);
        if (r < 2 * I_GU) {
            const int up = r / I_GU; r %= I_GU;
            const int kb = r / 16, nb = r % 16;
            const int pn = nb / 4, nsub = nb % 4;
            const float* W = (up ? wu : wg) + (size_t)e * D * DEXP + nb * 32;
            transpose_item(W + (size_t)kb * 64 * DEXP, 64, 32, wgu_t, D, e * 1024 + pn * 256 + up * 128 + nsub * 32, kb * 64, scr, 0, lane, nullptr, DEXP);
        } else {
            r -= 2 * I_GU;
            const int kb = r / 32, nb = r % 32;
            const float* W = wd + (size_t)e * DEXP * D + nb * 32;
            transpose_item(W + (size_t)kb * 64 * D, 64, 32, wd_t, DEXP, e * 1024 + nb * 32, kb * 64, scr, 0, lane, nullptr, D);
        }
    }
}
__device__ __forceinline__ void final_ph(const int WID_, float* __restrict__ out, const bf16* __restrict__ yslot, const int* __restrict__ tok_slot, const float* __restrict__ w) {
    const int lane = lane_id(), wv = WID_;
    float4 g[4];
#pragma unroll
    for (int j = 0; j < 4; ++j) g[j] = *(const float4*)(w + (lane + 64 * j) * 4);
    for (int row0 = (GB * 8 + wv) * 2; row0 < M; row0 += GN * 16) {
        float4 v[2][4]; uint2 ya[2][4], yb[2][4];
#pragma unroll
        for (int r = 0; r < 2; ++r) { const int row = row0 + r;
            const float4* xr = (const float4*)(out + (size_t)row * D);
            const uint2* pa = (const uint2*)(yslot + (size_t)tok_slot[2 * row] * D);
            const uint2* pb = (const uint2*)(yslot + (size_t)tok_slot[2 * row + 1] * D);
#pragma unroll
            for (int j = 0; j < 4; ++j) { v[r][j] = xr[lane + 64 * j]; ya[r][j] = pa[lane + 64 * j]; yb[r][j] = pb[lane + 64 * j]; } }
#pragma unroll
        for (int r = 0; r < 2; ++r) { float s = 0.f;
#pragma unroll
            for (int j = 0; j < 4; ++j) { const uint2 a = ya[r][j], b = yb[r][j];
                v[r][j].x += __builtin_bit_cast(float, a.x << 16) + __builtin_bit_cast(float, b.x << 16);
                v[r][j].y += __builtin_bit_cast(float, a.x & 0xffff0000u) + __builtin_bit_cast(float, b.x & 0xffff0000u);
                v[r][j].z += __builtin_bit_cast(float, a.y << 16) + __builtin_bit_cast(float, b.y << 16);
                v[r][j].w += __builtin_bit_cast(float, a.y & 0xffff0000u) + __builtin_bit_cast(float, b.y & 0xffff0000u);
                s += v[r][j].x * v[r][j].x + v[r][j].y * v[r][j].y + v[r][j].z * v[r][j].z + v[r][j].w * v[r][j].w; }
            s = wave_sum(s);
            const float rs = rsqrtf(s * (1.f / D) + 1e-6f);
            float4* xo = (float4*)(out + (size_t)(row0 + r) * D);
#pragma unroll
            for (int j = 0; j < 4; ++j) xo[lane + 64 * j] = make_float4(v[r][j].x * rs * g[j].x, v[r][j].y * rs * g[j].y, v[r][j].z * rs * g[j].z, v[r][j].w * rs * g[j].w); }
    }
}

struct S5Tab { float* Kmat; bf16* BtA; bf16* BtB; };
__device__ __forceinline__ void s5_lam(const float* lam_re, const float* lam_im, const float* log_dt, int g, int n, float& a, float& w) {
    const float dt = __expf(log_dt[g]); a = lam_re[g * 64 + n] * dt; w = lam_im[g * 64 + n] * dt;
}
__device__ __forceinline__ void cexpj(float a, float w, float j, float& re, float& im) { const float e = __expf(a * j); float s, c; sincosf(w * j, &s, &c); re = e * c; im = e * s; }
__device__ __forceinline__ void s5_bbar(const float* lam_re, const float* lam_im, const float* log_dt, const float* b_re, const float* b_im, int g, int n, int h, float& br, float& bi) {
    float a, w; s5_lam(lam_re, lam_im, log_dt, g, n, a, w);
    float lbr, lbi; cexpj(a, w, 1.f, lbr, lbi);
    const float lr = lam_re[g * 64 + n], li = lam_im[g * 64 + n];
    const float nr = lbr - 1.f, ni = lbi, den = lr * lr + li * li;
    const float cr = (nr * lr + ni * li) / den, ci = (ni * lr - nr * li) / den;
    const float xr = b_re[(g * 64 + n) * 16 + h], xi = b_im[(g * 64 + n) * 16 + h];
    br = cr * xr - ci * xi; bi = cr * xi + ci * xr;
}
__device__ __forceinline__ void s5_tables0_ph(const int WID_, const float* lam_re, const float* lam_im, const float* log_dt, const float* b_re, const float* b_im, const float* c_re, const float* c_im, const S5Tab& T) {
    const int gtid = GB * NT + (WID_ * 64 + lane_id()), gsz = GN * NT;
    for (int i = gtid; i < 32 * 32 * 256; i += gsz) {
        const int h = i & 15, hp = (i >> 4) & 15, j = (i >> 8) & 31, g = i >> 13;
        float acc = 0.f;
        for (int n = 0; n < 64; ++n) {
            float a, w; s5_lam(lam_re, lam_im, log_dt, g, n, a, w);
            float pr, pi; cexpj(a, w, (float)j, pr, pi);
            float br, bi; s5_bbar(lam_re, lam_im, log_dt, b_re, b_im, g, n, h, br, bi);
            const float tr = pr * br - pi * bi, ti = pr * bi + pi * br;
            acc += c_re[(g * 16 + hp) * 64 + n] * tr - c_im[(g * 16 + hp) * 64 + n] * ti;
        }
        T.Kmat[i] = acc;
    }
    for (int i = gtid; i < 32 * 256 * 512; i += gsz) {
        const int col = i & 511, r = (i >> 9) & 255, g = i >> 17;
        float v = 0.f;
        if (r < 128) {
            const int n = r & 63, s = col >> 4, h = col & 15;
            float a, w; s5_lam(lam_re, lam_im, log_dt, g, n, a, w);
            float pr, pi; cexpj(a, w, (float)(S5L - 1 - s), pr, pi);
            float br, bi; s5_bbar(lam_re, lam_im, log_dt, b_re, b_im, g, n, h, br, bi);
            v = (r < 64) ? (pr * br - pi * bi) : (pr * bi + pi * br);
        }
        T.BtA[((size_t)g * 768 + 512 + r) * 512 + col] = f2bf(v);
    }
    for (int i = gtid; i < 32 * 512 * 256; i += gsz) {
        const int k = i & 255, row = (i >> 8) & 511, g = i >> 17;
        float v = 0.f;
        if (k < 128) {
            const int n = k & 63, sp = row >> 4, hp = row & 15;
            float a, w; s5_lam(lam_re, lam_im, log_dt, g, n, a, w);
            float pr, pi; cexpj(a, w, (float)(sp + 1), pr, pi);
            const float cr = c_re[(g * 16 + hp) * 64 + n], ci = c_im[(g * 16 + hp) * 64 + n];
            v = (k < 64) ? (cr * pr - ci * pi) : -(cr * pi + ci * pr);
        }
        T.BtB[i] = f2bf(v);
    }
}
__device__ __forceinline__ void s5_tables1_ph(const int WID_, const float* dsk, const S5Tab& T) {
    const int gtid = GB * NT + (WID_ * 64 + lane_id()), gsz = GN * NT;
    for (int i = gtid; i < 32 * 512 * 512; i += gsz) {
        const int col = i & 511, row = (i >> 9) & 511, g = i >> 18;
        const int sp = row >> 4, hp = row & 15, s = col >> 4, h = col & 15;
        float v = 0.f;
        if (s <= sp) v = T.Kmat[((g * 32 + (sp - s)) * 16 + hp) * 16 + h];
        if (row == col) v += dsk[g * 16 + hp];
        T.BtA[((size_t)g * 768 + row) * 512 + col] = f2bf(v);
    }
}
__device__ __forceinline__ void s5_carry_ph(const int WID_, const float* lam_re, const float* lam_im, const float* log_dt, const float* __restrict__ F, bf16* __restrict__ XST, int vb, int nvb, char* lds) {
    float* TR = (float*)lds; float* TI = TR + 16 * 32;
    for (int item = vb; item < NB * 32 * 2; item += nvb) {
        const int lane = lane_id(), tid = WID_ * 64 + lane;
        const int nh = item & 1, g = (item >> 1) & 31, b = item >> 6, seg = tid >> 5, n = nh * 32 + (tid & 31);
        float a, w; s5_lam(lam_re, lam_im, log_dt, g, n, a, w);
        float pr, pi; cexpj(a, w, (float)S5L, pr, pi);
        const size_t row0 = (size_t)g * S5R + (size_t)b * (S / S5L) + seg * 16;
        const float* f = F + row0 * 128; bf16* xo = XST + row0 * 256;
        float fr[16], fi[16];
#pragma unroll
        for (int q = 0; q < 16; ++q) { fr[q] = f[(size_t)q * 128 + n]; fi[q] = f[(size_t)q * 128 + 64 + n]; }
#pragma unroll
        for (int q = 0; q < 16; ++q) if (nh == 0) *(uint2*)(xo + (size_t)q * 256 + 128 + (tid & 31) * 4) = make_uint2(0, 0);
        float xr = 0.f, xi = 0.f;
#pragma unroll
        for (int q = 0; q < 16; ++q) { const float nr = pr * xr - pi * xi + fr[q], ni = pr * xi + pi * xr + fi[q]; xr = nr; xi = ni; fr[q] = nr; fi[q] = ni; }
        TR[seg * 32 + (tid & 31)] = xr; TI[seg * 32 + (tid & 31)] = xi;
        __syncthreads();
        float p16r, p16i; cexpj(a, w, (float)(S5L * 16), p16r, p16i);
        float cr = 0.f, ci = 0.f;
        for (int s2 = 0; s2 < seg; ++s2) { const float tr = TR[s2 * 32 + (tid & 31)], ti = TI[s2 * 32 + (tid & 31)];
            const float nr = p16r * cr - p16i * ci + tr, ni = p16r * ci + p16i * cr + ti; cr = nr; ci = ni; }
        float er = cr, ei = ci;
#pragma unroll
        for (int q = 0; q < 16; ++q) {
            const float lr_ = (q > 0) ? fr[q - 1] : 0.f, li_ = (q > 0) ? fi[q - 1] : 0.f;
            xo[(size_t)q * 256 + n] = f2bf(er + lr_); xo[(size_t)q * 256 + 64 + n] = f2bf(ei + li_);
            const float nr = pr * er - pi * ei, ni = pr * ei + pi * er; er = nr; ei = ni;
        }
        __syncthreads();
    }
}
#define XB_TMO      128
#define XB_XCNT(j)  (256  + 64 * (j))
#define XB_XSUB(j)  (1280 + 64 * (j))
#define XB_XGEN(j)  (2304 + 64 * (j))
#define XB_TOP      3328
#define XB_TOPGEN   3392
#define XCD_BAR_WORDS 3456
#define XB_SPIN_CAP (1u << 20)
__device__ __forceinline__ unsigned xb_ld(unsigned* p)              { return __hip_atomic_load(p, __ATOMIC_RELAXED, __HIP_MEMORY_SCOPE_AGENT); }
__device__ __forceinline__ unsigned xb_add(unsigned* p, unsigned v) { return __hip_atomic_fetch_add(p, v, __ATOMIC_RELAXED, __HIP_MEMORY_SCOPE_AGENT); }
__device__ __forceinline__ unsigned xb_xcc_id() { return (unsigned)__builtin_amdgcn_s_getreg((3 << 11) | 20) & 0xFu; }
#define XB_SPIN(cond, bar) do { unsigned _sp = 0; while (cond) { __builtin_amdgcn_s_sleep(1); \
    if ((++_sp & 255u) == 0u) { if (xb_ld(&(bar)[XB_TMO])) break; if (_sp > XB_SPIN_CAP) { atomicAdd(&(bar)[XB_TMO], 1u); break; } } } } while (0)
struct XcdBarrier { unsigned* bar; unsigned x; volatile __attribute__((address_space(3))) unsigned* st; };
__device__ __forceinline__ XcdBarrier xcd_barrier_post(const int WID_, unsigned* bar, volatile __attribute__((address_space(3))) unsigned* st) {
    XcdBarrier b; b.bar = bar; b.x = xb_xcc_id(); b.st = st;
    if ((WID_ * 64 + lane_id()) == 0) (void)xb_add(&bar[XB_XCNT(b.x)], 1u);
    return b;
}
__device__ __forceinline__ void xcd_barrier_complete(unsigned* bar, unsigned x, unsigned& nloc, unsigned& nx) {
    const unsigned G = gridDim.x * gridDim.y * gridDim.z;
    unsigned sum, cnt, mine, sp = 0u;
    for (;;) {
        sum = 0u; cnt = 0u; mine = 0u;
#pragma unroll
        for (unsigned j = 0; j < 16; ++j) { const unsigned c = xb_ld(&bar[XB_XCNT(j)]); sum += c; cnt += (c > 0u) ? 1u : 0u; mine = (j == x) ? c : mine; }
        if (sum == G) break;
        __builtin_amdgcn_s_sleep(1);
        if ((++sp & 255u) == 0u) { if (xb_ld(&bar[XB_TMO])) break; if (sp > XB_SPIN_CAP) { atomicAdd(&bar[XB_TMO], 1u); break; } }
    }
    nloc = mine > 0u ? mine : 1u; nx = cnt > 0u ? cnt : 1u;
}
__device__ __forceinline__ void xcd_barrier(const int WID_, const XcdBarrier& b) {
    asm volatile("s_waitcnt vmcnt(0)" ::: "memory");
    __syncthreads();
    if ((WID_ * 64 + lane_id()) == 0) {
        unsigned* bar = b.bar;
        __builtin_amdgcn_s_waitcnt(0);
        unsigned nloc = b.st[0], nx = b.st[1];
        if (nloc == 0u) { xcd_barrier_complete(bar, b.x, nloc, nx); b.st[0] = nloc; b.st[1] = nx; }
        const unsigned old = xb_add(&bar[XB_XSUB(b.x)], 1u);
        const unsigned gen = old / nloc;
        if (old + 1u == (gen + 1u) * nloc) {
            __builtin_amdgcn_fence(__ATOMIC_RELEASE, "agent");
            asm volatile("s_waitcnt vmcnt(0)" ::: "memory");
            const unsigned og = xb_add(&bar[XB_TOP], 1u);
            const unsigned tg = og / nx;
            if (og + 1u == (tg + 1u) * nx) xb_add(&bar[XB_TOPGEN], 1u);
            else XB_SPIN(xb_ld(&bar[XB_TOPGEN]) == tg, bar);
            __builtin_amdgcn_fence(__ATOMIC_ACQUIRE, "agent");
            xb_add(&bar[XB_XGEN(b.x)], 1u);
            asm volatile("s_waitcnt vmcnt(0)" ::: "memory");
        } else {
            XB_SPIN(xb_ld(&bar[XB_XGEN(b.x)]) == gen, bar);
            __builtin_amdgcn_fence(__ATOMIC_ACQUIRE, "agent");
            asm volatile("s_waitcnt vmcnt(0)" ::: "memory");
        }
    }
    __syncthreads();
}

struct Params { const float* in[41]; float* out; char* ws; };

constexpr size_t W_PROJ = 0;
constexpr size_t W_US5 = 224;
constexpr size_t W_WTS = 288;
constexpr size_t W_YI = 352;
constexpr size_t W_F = 416;
constexpr size_t W_XST = 448;
constexpr size_t W_Z = 480;
constexpr size_t W_MISC = 544;
constexpr size_t W_XN = 576;
constexpr size_t W_CTL = 558;
constexpr size_t WO_IN = 0, WO_GLU = 5 * MiB, WO_MIX = 6 * MiB, WO_Q = 8 * MiB, WO_K = 10 * MiB, WO_V = 12 * MiB, WO_O = 14 * MiB, WO_KMAT = 16 * MiB, WO_BTA = 17 * MiB, WO_BTB = 41 * MiB;

__global__ void __launch_bounds__(NT, 2) fwd_kernel(Params p) {
    extern __shared__ __attribute__((aligned(16))) char lds[];
    const int WID_ = __builtin_amdgcn_readfirstlane((int)(threadIdx.x >> 6));
    cg::grid_group grid = cg::this_grid();
    PG8_LAS unsigned char* ldsl = (PG8_LAS unsigned char*)lds;
    char* ws = p.ws; char* dout = (char*)p.out; float* out = p.out;
#define IN(i) (p.in[i])
    volatile __attribute__((address_space(3))) unsigned* bst = (volatile __attribute__((address_space(3))) unsigned*)(ldsl + LDS_BYTES - 64);
    if (WID_ == 0 && lane_id() < 2) bst[lane_id()] = 0u;
    __syncthreads();
    const XcdBarrier xbar = xcd_barrier_post(WID_, (unsigned*)(ws + W_CTL * MiB), bst);
#ifndef PROBE_PHASE
#define PROBE_PHASE -1
#endif
    int sync_id = 0; unsigned long long pr_t0 = 0, pr_t1 = 0;
    if (PROBE_PHASE == 0) pr_t0 = __builtin_amdgcn_s_memrealtime();
#define SYNC() do { xcd_barrier(WID_, xbar); ++sync_id; if (sync_id == PROBE_PHASE) pr_t0 = __builtin_amdgcn_s_memrealtime(); if (sync_id == PROBE_PHASE + 1) pr_t1 = __builtin_amdgcn_s_memrealtime(); } while (0)
    char* WT = ws + W_WTS * MiB;
    bf16* w_in_t = (bf16*)(WT + WO_IN); bf16* w_glu_t = (bf16*)(WT + WO_GLU); bf16* w_mix_t = (bf16*)(WT + WO_MIX);
    bf16* w_q_t = (bf16*)(WT + WO_Q); bf16* w_k_t = (bf16*)(WT + WO_K); bf16* w_v_t = (bf16*)(WT + WO_V); bf16* w_o_t = (bf16*)(WT + WO_O);
    S5Tab stab; stab.Kmat = (float*)(WT + WO_KMAT); stab.BtA = (bf16*)(WT + WO_BTA); stab.BtB = (bf16*)(WT + WO_BTB);
    bf16* PROJ = (bf16*)(ws + W_PROJ * MiB); bf16* US5 = (bf16*)(ws + W_US5 * MiB);
    bf16* XN = (bf16*)(ws + W_XN * MiB);
    transpose_ph(WID_, IN(3), D, DIN, w_in_t, D, 0, 0, lds);
    transpose_ph(WID_, IN(23), 512, 512, w_glu_t, 512, 0, 0, lds);
    transpose_ph(WID_, IN(25), D, D, w_mix_t, D, 0, 0, lds);
    transpose_ph(WID_, IN(28), D, D, w_q_t, D, 0, 0, lds);
    transpose_ph(WID_, IN(29), D, D, w_k_t, D, 0, 0, lds);
    transpose_ph(WID_, IN(30), D, D, w_v_t, D, 0, 0, lds);
    transpose_ph(WID_, IN(31), D, D, w_o_t, D, 0, 0, lds);
    s5_tables0_ph(WID_, IN(15), IN(16), IN(17), IN(18), IN(19), IN(20), IN(21), stab);
    bf16* wl_t = (bf16*)(WT + 49 * MiB);
    rwkv_wl_ph(WID_, IN(6), IN(8), IN(9), wl_t);
    rmsnorm_ph<bf16>(WID_, IN(0), IN(2), XN, M);
    grid.sync(); ++sync_id; if (sync_id == PROBE_PHASE) pr_t0 = __builtin_amdgcn_s_memrealtime(); if (sync_id == PROBE_PHASE + 1) pr_t1 = __builtin_amdgcn_s_memrealtime();
    s5_tables1_ph(WID_, IN(22), stab);
    { pg8::PlainOrder S; S.init(XN, D, w_in_t, D, M, DIN, D); pg8::EpiProj E{PROJ, US5}; pg8::gemm_phase(WID_, ldsl, S, E); }
    SYNC();
    bf16* LIN = (bf16*)(ws + (W_MISC + 16) * MiB);
    rwkv_lin_ph(WID_, PROJ, IN(4), LIN);
    SYNC();
    bf16* YI = (bf16*)(ws + W_YI * MiB); float* F = (float*)(ws + W_F * MiB); bf16* XST = (bf16*)(ws + W_XST * MiB); bf16* Z = (bf16*)(ws + W_Z * MiB);
    bf16* LWb = (bf16*)(ws + 704 * MiB); bf16* AAb = (bf16*)(ws + 768 * MiB); bf16* Gb = (bf16*)(ws + 832 * MiB);
    float* Yr = (float*)(ws + 896 * MiB); float* RKb = (float*)(ws + W_MISC * MiB);
    { pg8::GroupOrder S; S.init(US5, 512, (size_t)S5R * 512, stab.BtA, 512, (size_t)768 * 512, 32, S5R, 768, 512); pg8::EpiS5a E{YI, F}; pg8::gemm_phase(WID_, ldsl, S, E); }
    { pg8::PlainOrder S; S.init(LIN, 256, wl_t, 256, M, 1536, 256); pg8::EpiLora E{LWb, (size_t)32 * MiB, IN(5), IN(7)}; pg8::gemm_phase(WID_, ldsl, S, E); }
    SYNC();
    { ck::In ci{PROJ, LWb, AAb, IN(4), IN(10), IN(11), IN(12), RKb, dout}; ck::phase1(WID_, ci, lds); }
    SYNC();
    bf16* WGU_t = (bf16*)(ws + 704 * MiB); bf16* WD_t = (bf16*)(ws + 768 * MiB);
    ck::phase2(WID_, dout, Yr, lds);
    __syncthreads();
    s5_carry_ph(WID_, IN(15), IN(16), IN(17), F, XST, GB, GN, lds);
    moe_weights_ph(WID_, IN(37), IN(38), IN(39), WGU_t, WD_t, lds, GB, GN);
    SYNC();
    bf16* YMIX = XN;
    { pg8::GroupOrder S; S.init(XST, 256, (size_t)S5R * 256, stab.BtB, 256, (size_t)512 * 256, 32, S5R, 512, 256); pg8::EpiS5b E{YI, Z}; pg8::gemm_phase(WID_, ldsl, S, E); }
    rwkv_post_ph(WID_, Yr, RKb, PROJ, IN(4), Gb, IN(13), IN(14), YMIX);
    SYNC();
    { pg8::PlainOrder S; S.init(Z, 512, w_glu_t, 512, M, 512, 512); pg8::EpiGlu E{Z, IN(24), YMIX}; pg8::gemm_phase(WID_, ldsl, S, E); }
    SYNC();
    { pg8::PlainOrder S; S.init(YMIX, D, w_mix_t, D, M, D, D); pg8::EpiF32 E{out, D, IN(0), D}; pg8::gemm_phase(WID_, ldsl, S, E); }
    SYNC();
    bf16* KM = (bf16*)(ws + (W_MISC + 2) * MiB); bf16* VT = (bf16*)(ws + (W_MISC + 6) * MiB); bf16* MEMN = (bf16*)(ws + (W_MISC + 10) * MiB);
    rmsnorm_ph<bf16>(WID_, out, IN(26), XN, M);
    rmsnorm_ph<bf16>(WID_, IN(1), IN(27), MEMN, NB * NMEM);
    SYNC();
    bf16* Q = (bf16*)(ws + 128 * MiB);
    { pg8::PlainOrder S; S.init(MEMN, D, w_k_t, D, NB * NMEM, D, D); pg8::EpiBf16 E{KM, D}; pg8::gemm_phase(WID_, ldsl, S, E); }
    { pg8::PlainOrder S; S.init(w_v_t, D, MEMN, D, D, NB * NMEM, D); pg8::EpiBf16 E{VT, NB * NMEM}; pg8::gemm_phase(WID_, ldsl, S, E); }
    { pg8::PlainOrder S; S.init(XN, D, w_q_t, D, M, D, D); pg8::EpiBf16 E{Q, D}; pg8::gemm_phase(WID_, ldsl, S, E); }
    SYNC();
    bf16* P = (bf16*)(ws + W_YI * MiB);
    { pg8::AttnOrder S; S.init(Q, KM, D, 0); pg8::EpiSoftmax E{P, (PG8_LAS float*)(ldsl + 131072)}; pg8::gemm_phase(WID_, ldsl, S, E); }
    SYNC();
    bf16* O = XN;
    { pg8::AttnOrder S; S.init(P, VT, NB * NMEM, 1); pg8::EpiAttnO E{O}; pg8::gemm_phase(WID_, ldsl, S, E); }
    SYNC();
    { pg8::PlainOrder S; S.init(O, D, w_o_t, D, M, D, D); pg8::EpiF32 E{out, D, out, D}; pg8::gemm_phase(WID_, ldsl, S, E); }
    SYNC();
    bf16* H3 = XN;
    bf16* XG = (bf16*)(ws + 0);
    bf16* HID = (bf16*)(ws + 368 * MiB);
    bf16* YSLOT = (bf16*)(ws + 0);
    MoeBufs mb; char* mbase = ws + 976 * MiB;
    mb.tok_e = (int*)(mbase); mb.tok_g = (float*)(mbase + 1 * MiB); mb.tok_slot = (int*)(mbase + 2 * MiB); mb.slot_tok = (int*)(mbase + 3 * MiB);
    mb.slot_gate = (float*)(mbase + 4 * MiB); mb.bcnt = (int*)(mbase + 5 * MiB); mb.bbase = mb.bcnt + 16384; mb.offs = mb.bcnt + 32768; mb.ntiles = mb.offs + 64;
    mb.tiles = (int*)(mbase + 6 * MiB);
    moe_zero_ph(WID_, mb);
    router_ph(WID_, out, IN(32), H3, IN(33), IN(34), IN(35), IN(36), mb, lds);
    SYNC();
    moe_plan_ph(WID_, mb, lds);
    SYNC();
    moe_scatter_ph(WID_, mb, lds);
    SYNC();
    moe_gather_ph(WID_, H3, XG, mb);
    SYNC();
    const int ntiles = __hip_atomic_load(mb.ntiles, __ATOMIC_RELAXED, __HIP_MEMORY_SCOPE_AGENT);
    { pg8::MoeOrder S; S.init(XG, D, WGU_t, D, D, mb.tiles, ntiles, 1024); pg8::EpiSilu E{HID}; pg8::gemm_phase(WID_, ldsl, S, E); }
    SYNC();
    { pg8::MoeOrder S; S.init(HID, DEXP, WD_t, DEXP, DEXP, mb.tiles, ntiles, 1024); pg8::EpiGate E{YSLOT, mb.slot_gate}; pg8::gemm_phase(WID_, ldsl, S, E); }
    SYNC();
    final_ph(WID_, out, YSLOT, mb.tok_slot, IN(40));
    if (PROBE_PHASE >= 0) {
        if (pr_t1 == 0) pr_t1 = __builtin_amdgcn_s_memrealtime();
        if (GB == 0) { const unsigned long long t_end = __builtin_amdgcn_s_memrealtime(), wait = 8ull * (pr_t1 - pr_t0);
            while (__builtin_amdgcn_s_memrealtime() - t_end < wait) __builtin_amdgcn_s_sleep(8); }
    }
}
}

extern "C" void kernel_launch(void* const* d_in, const int* in_sizes, int n_in, void* d_out, int out_size, void* d_ws, size_t ws_size, hipStream_t stream) {
    (void)in_sizes; (void)out_size; (void)ws_size;
    static int grid = 0;
    if (grid == 0) {
        int dev = 0, cus = 0, per_cu = 0;
        hipGetDevice(&dev);
        hipDeviceGetAttribute(&cus, hipDeviceAttributeMultiprocessorCount, dev);
        hipFuncSetAttribute((const void*)fwd_kernel, hipFuncAttributeMaxDynamicSharedMemorySize, LDS_BYTES);
        hipOccupancyMaxActiveBlocksPerMultiprocessor(&per_cu, (const void*)fwd_kernel, NT, LDS_BYTES);
        if (per_cu < 1) { fprintf(stderr, "occupancy query says %d blocks/CU\n", per_cu); per_cu = 1; }
        grid = cus * 1;
    }
    (void)hipMemsetAsync((char*)d_ws + W_CTL * MiB, 0, 16384, stream);
    Params p{};
    for (int i = 0; i < 41 && i < n_in; ++i) p.in[i] = (const float*)d_in[i];
    p.out = (float*)d_out; p.ws = (char*)d_ws;
    void* args[] = {&p};
    hipError_t e = hipLaunchCooperativeKernel((const void*)fwd_kernel, dim3(grid), dim3(NT), args, LDS_BYTES, stream);
    if (e != hipSuccess) fprintf(stderr, "cooperative launch failed: %s (grid %d)\n", hipGetErrorString(e), grid);
}
```

```cpp
#include <hip/hip_runtime.h>
#include <hip/hip_cooperative_groups.h>
#include <stdint.h>
#include <cstdio>
namespace cg = cooperative_groups;

namespace {
constexpr int NB = 8, S = 8192, D = 1024, M = NB * S;
constexpr int DR = 512, DSHIFT = 1792, DIN = 2304, NMEM = 256;
constexpr int NEXP = 32, DEXP = 512, NASSIGN = 2 * M;
constexpr size_t MiB = 1u << 20;
constexpr int NT = 512;
constexpr int S5L = 32, S5R = M / S5L;
constexpr int LDS_BYTES = 147456;
#define GB ((int)blockIdx.x)
#define GN ((int)gridDim.x)

typedef unsigned short bf16;
typedef float f32x2h __attribute__((ext_vector_type(2)));
typedef __bf16 bf16x2h __attribute__((ext_vector_type(2)));
__device__ __forceinline__ unsigned pk2(float lo, float hi) { const f32x2h v = {lo, hi}; const bf16x2h b = __builtin_convertvector(v, bf16x2h); return __builtin_bit_cast(unsigned, b); }
__device__ __forceinline__ bf16 f2bf(float f) { return (bf16)(pk2(f, f) & 0xffffu); }
__device__ __forceinline__ int lane_id() { int l = (int)__builtin_amdgcn_mbcnt_hi(~0u, __builtin_amdgcn_mbcnt_lo(~0u, 0u)); asm volatile("" : "+v"(l)); return l; }
__device__ __forceinline__ float bf2f(bf16 h) { return __builtin_bit_cast(float, (unsigned)h << 16); }

template <typename T> __device__ __forceinline__ float ldf(const T* p);
template <> __device__ __forceinline__ float ldf<float>(const float* p) { return *p; }
template <> __device__ __forceinline__ float ldf<bf16>(const bf16* p) { return bf2f(*p); }
template <typename T> __device__ __forceinline__ void stf(T* p, float v);
template <> __device__ __forceinline__ void stf<float>(float* p, float v) { *p = v; }
template <> __device__ __forceinline__ void stf<bf16>(bf16* p, float v) { *p = f2bf(v); }

template <int CTRL, int ROWMASK> __device__ __forceinline__ float dppf_(float x) { return __builtin_bit_cast(float, __builtin_amdgcn_update_dpp(0, __builtin_bit_cast(int, x), CTRL, ROWMASK, 0xf, false)); }
__device__ __forceinline__ float wave_sum(float v) {
    v += dppf_<0xB1, 0xf>(v); v += dppf_<0x4E, 0xf>(v); v += dppf_<0x141, 0xf>(v); v += dppf_<0x140, 0xf>(v);
    v += dppf_<0x142, 0xa>(v);
    v += dppf_<0x143, 0xc>(v);
    return __builtin_bit_cast(float, __builtin_amdgcn_readlane(__builtin_bit_cast(int, v), 63));
}
__device__ __forceinline__ float sigmoidf_(float x) { return 1.f / (1.f + __expf(-x)); }


__device__ __forceinline__ float gelu_tanh(float x) { return x * sigmoidf_(1.5957691216057308f * (x + 0.044715f * x * x * x)); }

namespace pg8 {
#define PG8_LAS __attribute__((address_space(3)))
typedef short bf16x8 __attribute__((ext_vector_type(8)));
typedef float f32x4 __attribute__((ext_vector_type(4)));
typedef unsigned u32x4 __attribute__((ext_vector_type(4)));
constexpr int BM = 256, BK = 64, HALF = 128, HTB = HALF * BK * 2, STAGE_BYTES = 8 * HTB, NXCD = 8, WGM = 8;
__device__ __forceinline__ int lds_byte(int r, int c) { const int st = (r >> 4) * 2 + (c >> 5), rr = r & 15, cc = c & 31, ob = rr * 64 + cc * 2; return st * 1024 + (ob ^ (((ob >> 9) & 1) << 5)); }
__device__ __forceinline__ void stage_rc(int b, int& R, int& C) { const int st = b / 1024, sb = b % 1024, swz = sb ^ (((sb >> 9) & 1) << 5); R = (st >> 1) * 16 + swz / 64; C = (st & 1) * 32 + (swz % 64) / 2; }
__device__ __forceinline__ int perm32(int rho) { const int n = rho >> 4, i = rho & 15; return 8 * (i >> 2) + 4 * n + (i & 3); }
struct Unit { int pm, pn; };
struct PlainOrder {
    static constexpr bool GATHER = false; __device__ __forceinline__ int grow(const Unit&, int) const { return 0; }
    const bf16* A; const bf16* Bt; int lda, ldb, K; int nM, nN, nwg, G, c;
    __device__ void init(const bf16* A_, int lda_, const bf16* Bt_, int ldb_, int M, int N, int K_) { A = A_; Bt = Bt_; lda = lda_; ldb = ldb_; K = K_; nM = M / BM; nN = N / BM; nwg = nM * nN; G = GN; c = GB; }
    __device__ bool next(int i, Unit& u) const {
        const long L = (long)i * G + c; if (L >= nwg) return false;
        int wgid = (int)L; { const int q = nwg / NXCD, r = nwg % NXCD, xcd = wgid % NXCD, off = wgid / NXCD; wgid = (xcd < r ? xcd * (q + 1) : r * (q + 1) + (xcd - r) * q) + off; }
        const int nig = WGM * nN, gid = wgid / nig, fm = gid * WGM, gsz = (nM - fm) < WGM ? (nM - fm) : WGM;
        u.pm = fm + ((wgid % nig) % gsz); u.pn = (wgid % nig) / gsz; return true;
    }
    __device__ __forceinline__ const char* aptr(const Unit& u) const { return (const char*)(A + (size_t)u.pm * BM * lda); }
    __device__ __forceinline__ const char* bptr(const Unit& u) const { return (const char*)(Bt + (size_t)u.pn * BM * ldb); }
};
typedef float f32x2c __attribute__((ext_vector_type(2)));
typedef __bf16 bf16x2c __attribute__((ext_vector_type(2)));
__device__ __forceinline__ unsigned cvt_pk_bf16(float lo, float hi) { const f32x2c v = {lo, hi}; const bf16x2c b = __builtin_convertvector(v, bf16x2c); return __builtin_bit_cast(unsigned, b); }

template <class Epi, class Sched>
__device__ __forceinline__ void gemm_phase(const int WID_, PG8_LAS unsigned char* lds, const Sched& S, const Epi& E) {
    const int tid = (WID_ * 64 + lane_id()), wid = __builtin_amdgcn_readfirstlane(tid >> 6), lane = tid & 63, wr = wid >> 2, wc = wid & 3, fr = lane & 15, fq = lane >> 4;
    const int K = S.K, nt = K / BK;
    unsigned voffA[2], voffB[2];
#pragma unroll
    for (int i = 0; i < 2; ++i) { int R, C; stage_rc(tid * 16 + i * 8192, R, C); const int Rb = Epi::PERM ? ((R & ~31) + perm32(R & 31)) : R;
        voffA[i] = (unsigned)(R * S.lda + C) * 2u; voffB[i] = (unsigned)(Rb * S.ldb + C) * 2u; }
    constexpr bool GA = Sched::GATHER;
    int gR[2], gC[2];
#pragma unroll
    for (int i = 0; i < 2; ++i) stage_rc(tid * 16 + i * 8192, gR[i], gC[i]);
    unsigned vgc[2][2] = {{0u, 0u}, {0u, 0u}}, vgn[2][2] = {{0u, 0u}, {0u, 0u}};
#define PG8_GOFF(dst, u) do { if constexpr (GA) { _Pragma("unroll") for (int h_ = 0; h_ < 2; ++h_) _Pragma("unroll") for (int i_ = 0; i_ < 2; ++i_) \
        dst[h_][i_] = (unsigned)(S.grow(u, h_ * HALF + gR[i_]) * S.lda + gC[i_]) * 2u; } } while (0)
    const size_t kstep = (size_t)(BK * 2);
    const size_t hstepA = GA ? 0 : (size_t)HALF * S.lda * 2, hstepB = (size_t)HALF * S.ldb * 2;
    const unsigned ldsw = (unsigned)wid * 1024u;
    const int aoff = lds_byte(wr * 64 + fr, fq * 8), boff = lds_byte(wc * 32 + fr, fq * 8);
#define PG8_SA(b, h) (((b) * 2 + (h)) * HTB)
#define PG8_SB(b, h) ((4 + (b) * 2 + (h)) * HTB)
#define PG8_STAGE(bufoff, gbase, voff) do { _Pragma("unroll") for (int _i = 0; _i < 2; ++_i) \
        __builtin_amdgcn_global_load_lds((const unsigned*)((const char*)(gbase) + (voff)[_i]), (PG8_LAS unsigned*)(lds + (bufoff) + ldsw + _i * 8192), 16, 0, 0); } while (0)
#define PG8_STAGE_A(bufoff, gbase, h, nx) do { _Pragma("unroll") for (int _i = 0; _i < 2; ++_i) { \
        const unsigned vo_ = GA ? ((nx) ? vgn[h][_i] : vgc[h][_i]) : voffA[_i]; \
        __builtin_amdgcn_global_load_lds((const unsigned*)((const char*)(gbase) + vo_), (PG8_LAS unsigned*)(lds + (bufoff) + ldsw + _i * 8192), 16, 0, 0); } } while (0)
#define PG8_LDA(dst, b, h) do { _Pragma("unroll") for (int m = 0; m < 4; ++m) _Pragma("unroll") for (int k = 0; k < 2; ++k) dst[m][k] = *(const PG8_LAS bf16x8*)(lds + PG8_SA(b, h) + aoff + m * 2048 + k * 1024); } while (0)
#define PG8_LDB(dst, b, h) do { _Pragma("unroll") for (int n = 0; n < 2; ++n) _Pragma("unroll") for (int k = 0; k < 2; ++k) dst[n][k] = *(const PG8_LAS bf16x8*)(lds + PG8_SB(b, h) + boff + n * 2048 + k * 1024); } while (0)
#define PG8_MMA(ai, bj, At, Bt) do { __builtin_amdgcn_s_setprio(1); _Pragma("unroll") for (int m = 0; m < 4; ++m) _Pragma("unroll") for (int n = 0; n < 2; ++n) _Pragma("unroll") for (int k = 0; k < 2; ++k) \
        acc[ai][bj][m][n] = __builtin_amdgcn_mfma_f32_16x16x32_bf16(Bt[n][k], At[m][k], acc[ai][bj][m][n], 0, 0, 0); __builtin_amdgcn_s_setprio(0); } while (0)
#define PG8_WAIT_V(n) asm volatile("s_waitcnt vmcnt(" #n ")" ::: "memory")
#define PG8_WAIT_L(n) asm volatile("s_waitcnt lgkmcnt(" #n ")" ::: "memory")
#define PG8_BAR __builtin_amdgcn_s_barrier()
#define PG8_SCHED __builtin_amdgcn_sched_barrier(0)
    Unit cur, nxt; int ui = 0;
    if (!S.next(0, cur)) return;
    f32x4 acc[2][2][4][2];
#pragma unroll
    for (int a = 0; a < 2; ++a)
#pragma unroll
        for (int b = 0; b < 2; ++b)
#pragma unroll
            for (int m = 0; m < 4; ++m)
#pragma unroll
                for (int n = 0; n < 2; ++n) acc[a][b][m][n] = (f32x4){0.f, 0.f, 0.f, 0.f};
    bf16x8 At[4][2], B0[2][2], B1[2][2];
    const char* cA = S.aptr(cur); const char* cB = S.bptr(cur);
    PG8_STAGE(PG8_SB(0, 0), cB, voffB); PG8_STAGE(PG8_SB(0, 1), cB + hstepB, voffB); PG8_GOFF(vgc, cur); PG8_STAGE_A(PG8_SA(0, 0), cA, 0, false); PG8_STAGE_A(PG8_SA(0, 1), cA + hstepA, 1, false);
    if (wr == 1) PG8_BAR;
    PG8_WAIT_V(2); PG8_BAR;
    PG8_STAGE(PG8_SB(1, 0), cB + kstep, voffB); PG8_STAGE_A(PG8_SA(1, 0), cA + kstep, 0, false); PG8_STAGE(PG8_SB(1, 1), cB + hstepB + kstep, voffB);
    PG8_WAIT_V(6); PG8_BAR;
    for (;;) {
        const bool has_next = S.next(ui + 1, nxt);
        const char* nA = has_next ? S.aptr(nxt) : cA; const char* nB = has_next ? S.bptr(nxt) : cB;
        if (has_next) PG8_GOFF(vgn, nxt); else { if constexpr (GA) { _Pragma("unroll") for (int h_ = 0; h_ < 2; ++h_) _Pragma("unroll") for (int i_ = 0; i_ < 2; ++i_) vgn[h_][i_] = vgc[h_][i_]; } }
        for (int t = 0; t < nt; t += 2) {
            const bool last = (t == nt - 2);
            const char* a1 = cA + (size_t)(t + 1) * kstep;
            const char* a2 = last ? nA : cA + (size_t)(t + 2) * kstep; const char* b2 = last ? nB : cB + (size_t)(t + 2) * kstep;
            const char* a3 = a2 + kstep; const char* b3 = b2 + kstep;
            PG8_LDB(B0, 0, 0); PG8_LDB(B1, 0, 1); PG8_SCHED; PG8_LDA(At, 0, 0); PG8_STAGE_A(PG8_SA(1, 1), a1 + hstepA, 1, false);
            PG8_WAIT_V(8); PG8_WAIT_L(0); PG8_BAR; PG8_MMA(0, 0, At, B0); PG8_MMA(0, 1, At, B1); PG8_BAR; PG8_SCHED;
            PG8_LDA(At, 0, 1); PG8_STAGE(PG8_SB(0, 0), b2, voffB); PG8_STAGE(PG8_SB(0, 1), b2 + hstepB, voffB); PG8_STAGE_A(PG8_SA(0, 0), a2, 0, last);
            PG8_WAIT_V(8); PG8_WAIT_L(0); PG8_BAR; PG8_MMA(1, 0, At, B0); PG8_MMA(1, 1, At, B1); PG8_BAR; PG8_SCHED;
            PG8_LDB(B0, 1, 0); PG8_LDB(B1, 1, 1); PG8_SCHED; PG8_LDA(At, 1, 0); PG8_STAGE_A(PG8_SA(0, 1), a2 + hstepA, 1, last);
            PG8_WAIT_V(8); PG8_WAIT_L(0); PG8_BAR; PG8_MMA(0, 0, At, B0); PG8_MMA(0, 1, At, B1); PG8_BAR; PG8_SCHED;
            PG8_LDA(At, 1, 1); PG8_STAGE(PG8_SB(1, 0), b3, voffB); PG8_STAGE(PG8_SB(1, 1), b3 + hstepB, voffB); PG8_STAGE_A(PG8_SA(1, 0), a3, 0, last);
            PG8_WAIT_V(8); PG8_WAIT_L(0); PG8_BAR; PG8_MMA(1, 0, At, B0); PG8_MMA(1, 1, At, B1); PG8_BAR; PG8_SCHED;
        }
        if (wr == 0) PG8_BAR;
        E(acc, cur, wr, wc, fr, fq);
        if (!has_next) break;
#pragma unroll
        for (int a = 0; a < 2; ++a)
#pragma unroll
            for (int b = 0; b < 2; ++b)
#pragma unroll
                for (int m = 0; m < 4; ++m)
#pragma unroll
                    for (int n = 0; n < 2; ++n) acc[a][b][m][n] = (f32x4){0.f, 0.f, 0.f, 0.f};
        cur = nxt; cA = nA; cB = nB; ++ui;
        if constexpr (GA) { _Pragma("unroll") for (int h_ = 0; h_ < 2; ++h_) _Pragma("unroll") for (int i_ = 0; i_ < 2; ++i_) vgc[h_][i_] = vgn[h_][i_]; }
        if (wr == 1) PG8_BAR;
    }
    PG8_WAIT_V(0);
    PG8_BAR;
#undef PG8_SA
#undef PG8_SB
#undef PG8_STAGE
#undef PG8_STAGE_A
#undef PG8_GOFF
#undef PG8_LDA
#undef PG8_LDB
#undef PG8_MMA
#undef PG8_WAIT_V
#undef PG8_WAIT_L
#undef PG8_BAR
#undef PG8_SCHED
}

struct EpiF32 {
    static constexpr bool PERM = false;
    float* C; int ldc; const float* R; int ldr;
    __device__ __forceinline__ void operator()(const f32x4 (&acc)[2][2][4][2], const Unit& u, int wr, int wc, int fr, int fq) const {
        const int row0 = u.pm * BM + wr * 64 + fr, col0 = u.pn * BM + wc * 32 + 4 * fq;
#pragma unroll
        for (int ai = 0; ai < 2; ++ai)
#pragma unroll
            for (int m = 0; m < 4; ++m) { const size_t row = (size_t)(row0 + ai * HALF + m * 16);
#pragma unroll
                for (int bj = 0; bj < 2; ++bj)
#pragma unroll
                    for (int n = 0; n < 2; ++n) { const int col = col0 + bj * HALF + 16 * n; f32x4 v = acc[ai][bj][m][n];
                        if (R) v = v + *(const f32x4*)(R + row * ldr + col);
                        *(f32x4*)(C + row * ldc + col) = v; } }
    }
};
struct EpiBf16 {
    static constexpr bool PERM = true;
    bf16* O; int ldc;
    __device__ __forceinline__ void operator()(const f32x4 (&acc)[2][2][4][2], const Unit& u, int wr, int wc, int fr, int fq) const {
        const int row0 = u.pm * BM + wr * 64 + fr, col0 = u.pn * BM + wc * 32 + 8 * fq;
#pragma unroll
        for (int ai = 0; ai < 2; ++ai)
#pragma unroll
            for (int m = 0; m < 4; ++m) { bf16* rowp = O + (size_t)(row0 + ai * HALF + m * 16) * ldc + col0;
#pragma unroll
                for (int bj = 0; bj < 2; ++bj) { const f32x4 v0 = acc[ai][bj][m][0], v1 = acc[ai][bj][m][1];
                    u32x4 w; w.x = cvt_pk_bf16(v0[0], v0[1]); w.y = cvt_pk_bf16(v0[2], v0[3]); w.z = cvt_pk_bf16(v1[0], v1[1]); w.w = cvt_pk_bf16(v1[2], v1[3]);
                    *(u32x4*)(rowp + bj * HALF) = w; } }
    }
};
struct EpiGlu {
    static constexpr bool PERM = true;
    const bf16* Z; const float* bias; bf16* YM;
    __device__ __forceinline__ void operator()(const f32x4 (&acc)[2][2][4][2], const Unit& u, int wr, int wc, int fr, int fq) const {
        const int row0 = u.pm * BM + wr * 64 + fr, col0 = u.pn * BM + wc * 32 + 8 * fq;
#pragma unroll
        for (int ai = 0; ai < 2; ++ai)
#pragma unroll
            for (int m = 0; m < 4; ++m) { const size_t row = (size_t)(row0 + ai * HALF + m * 16);
#pragma unroll
                for (int bj = 0; bj < 2; ++bj) { const int col = col0 + bj * HALF;
                    const u32x4 zz = *(const u32x4*)(Z + row * 512 + col);
                    const f32x4 b0 = *(const f32x4*)(bias + col), b1 = *(const f32x4*)(bias + col + 4);
                    const f32x4 v0 = acc[ai][bj][m][0] + b0, v1 = acc[ai][bj][m][1] + b1;
                    float o[8]; const unsigned zw[4] = {zz.x, zz.y, zz.z, zz.w};
#pragma unroll
                    for (int q = 0; q < 4; ++q) { const float zl = __builtin_bit_cast(float, zw[q] << 16), zh = __builtin_bit_cast(float, zw[q] & 0xffff0000u);
                        const float al = (q < 2) ? v0[2 * q] : v1[2 * q - 4], ah = (q < 2) ? v0[2 * q + 1] : v1[2 * q - 3];
                        o[2 * q] = zl * sigmoidf_(al); o[2 * q + 1] = zh * sigmoidf_(ah); }
                    u32x4 w; w.x = cvt_pk_bf16(o[0], o[1]); w.y = cvt_pk_bf16(o[2], o[3]); w.z = cvt_pk_bf16(o[4], o[5]); w.w = cvt_pk_bf16(o[6], o[7]);
                    *(u32x4*)(YM + row * D + 512 + col) = w; } }
    }
};

template <bool GATHER_>
struct MoeOrderT {
    static constexpr bool GATHER = GATHER_;
    const bf16* A; const bf16* Bt; int lda, ldb, K; const int* tiles; const int* rows; int nunits, G, c; size_t bexp;
    __device__ void init(const bf16* A_, int lda_, const bf16* Bt_, int ldb_, int K_, const int* tiles_, int ntiles, size_t bexp_, const int* rows_) { A = A_; Bt = Bt_; lda = lda_; ldb = ldb_; K = K_; tiles = tiles_; rows = rows_; nunits = ntiles * 4; G = GN; c = GB; bexp = bexp_; }
    __device__ bool next(int i, Unit& u) const { const int L = i * G + c; if (L >= nunits) return false; u.pm = L >> 2; u.pn = L & 3; return true; }
    __device__ __forceinline__ const char* aptr(const Unit& u) const { return GATHER ? (const char*)A : (const char*)(A + (size_t)u.pm * BM * lda); }
    __device__ __forceinline__ int grow(const Unit& u, int r) const { return rows[u.pm * BM + r]; }
    __device__ __forceinline__ const char* bptr(const Unit& u) const { const int e = __hip_atomic_load(tiles + u.pm, __ATOMIC_RELAXED, __HIP_MEMORY_SCOPE_AGENT); return (const char*)(Bt + ((size_t)e * bexp + (size_t)u.pn * BM) * ldb); }
};
struct EpiSilu {
    static constexpr bool PERM = true;
    bf16* HID;
    __device__ __forceinline__ void operator()(const f32x4 (&acc)[2][2][4][2], const Unit& u, int wr, int wc, int fr, int fq) const {
        const int row0 = u.pm * BM + wr * 64 + fr, col0 = u.pn * HALF + wc * 32 + 8 * fq;
#pragma unroll
        for (int ai = 0; ai < 2; ++ai)
#pragma unroll
            for (int m = 0; m < 4; ++m) { const size_t row = (size_t)(row0 + ai * HALF + m * 16);
                float o[8];
#pragma unroll
                for (int n = 0; n < 2; ++n)
#pragma unroll
                    for (int q = 0; q < 4; ++q) { const float g = acc[ai][0][m][n][q], up = acc[ai][1][m][n][q]; o[4 * n + q] = g * sigmoidf_(g) * up; }
                u32x4 w; w.x = cvt_pk_bf16(o[0], o[1]); w.y = cvt_pk_bf16(o[2], o[3]); w.z = cvt_pk_bf16(o[4], o[5]); w.w = cvt_pk_bf16(o[6], o[7]);
                *(u32x4*)(HID + row * DEXP + col0) = w; }
    }
};
struct EpiGate {
    static constexpr bool PERM = true;
    bf16* Y; const float* gate;
    __device__ __forceinline__ void operator()(const f32x4 (&acc)[2][2][4][2], const Unit& u, int wr, int wc, int fr, int fq) const {
        const int row0 = u.pm * BM + wr * 64 + fr, col0 = u.pn * BM + wc * 32 + 8 * fq;
#pragma unroll
        for (int ai = 0; ai < 2; ++ai)
#pragma unroll
            for (int m = 0; m < 4; ++m) { const size_t row = (size_t)(row0 + ai * HALF + m * 16); const float gt = gate[row];
#pragma unroll
                for (int bj = 0; bj < 2; ++bj) { const f32x4 v0 = acc[ai][bj][m][0] * gt, v1 = acc[ai][bj][m][1] * gt;
                    u32x4 w; w.x = cvt_pk_bf16(v0[0], v0[1]); w.y = cvt_pk_bf16(v0[2], v0[3]); w.z = cvt_pk_bf16(v1[0], v1[1]); w.w = cvt_pk_bf16(v1[2], v1[3]);
                    *(u32x4*)(Y + row * D + col0 + bj * HALF) = w; } }
    }
};

struct EpiProj {
    static constexpr bool PERM = true;
    bf16* PROJ; bf16* US5;
    __device__ __forceinline__ void operator()(const f32x4 (&acc)[2][2][4][2], const Unit& u, int wr, int wc, int fr, int fq) const {
        const int row0 = u.pm * BM + wr * 64 + fr, col0 = u.pn * BM + wc * 32 + 8 * fq;
#pragma unroll
        for (int ai = 0; ai < 2; ++ai)
#pragma unroll
            for (int m = 0; m < 4; ++m) { const size_t row = (size_t)(row0 + ai * HALF + m * 16);
#pragma unroll
                for (int bj = 0; bj < 2; ++bj) { const f32x4 v0 = acc[ai][bj][m][0], v1 = acc[ai][bj][m][1]; const int col = col0 + bj * HALF;
                    u32x4 w; w.x = cvt_pk_bf16(v0[0], v0[1]); w.y = cvt_pk_bf16(v0[2], v0[3]); w.z = cvt_pk_bf16(v1[0], v1[1]); w.w = cvt_pk_bf16(v1[2], v1[3]);
                    if (col < DSHIFT) *(u32x4*)(PROJ + row * DSHIFT + col) = w;
                    else { const int cc = col - DSHIFT; *(u32x4*)(US5 + ((size_t)(cc >> 4) * M + row) * 16 + (cc & 15)) = w; } } }
    }
};
struct GroupOrder {
    static constexpr bool GATHER = false; __device__ __forceinline__ int grow(const Unit&, int) const { return 0; }
    const bf16* A; const bf16* Bt; int lda, ldb, K; int nM, nN, nunits, G, c; size_t sA, sB;
    __device__ void init(const bf16* A_, int lda_, size_t sA_, const bf16* Bt_, int ldb_, size_t sB_, int ngroups, int Mg, int Ng, int K_) {
        A = A_; Bt = Bt_; lda = lda_; ldb = ldb_; K = K_; sA = sA_; sB = sB_; nM = Mg / BM; nN = Ng / BM; nunits = ngroups * nM * nN; G = GN; c = GB; }
    __device__ bool next(int i, Unit& u) const { const int L = i * G + c; if (L >= nunits) return false; u.pn = L % nN; u.pm = L / nN; return true; }
    __device__ __forceinline__ const char* aptr(const Unit& u) const { const int g = u.pm / nM, pm = u.pm % nM; return (const char*)(A + (size_t)g * sA + (size_t)pm * BM * lda); }
    __device__ __forceinline__ const char* bptr(const Unit& u) const { const int g = u.pm / nM; return (const char*)(Bt + (size_t)g * sB + (size_t)u.pn * BM * ldb); }
};
struct EpiS5a {
    static constexpr bool PERM = false;
    bf16* YI; float* F;
    __device__ __forceinline__ void operator()(const f32x4 (&acc)[2][2][4][2], const Unit& u, int wr, int wc, int fr, int fq) const {
        const int row0 = u.pm * BM + wr * 64 + fr, col0 = u.pn * BM + wc * 32 + 4 * fq;
#pragma unroll
        for (int ai = 0; ai < 2; ++ai)
#pragma unroll
            for (int m = 0; m < 4; ++m) { const size_t row = (size_t)(row0 + ai * HALF + m * 16);
#pragma unroll
                for (int bj = 0; bj < 2; ++bj)
#pragma unroll
                    for (int n = 0; n < 2; ++n) { const int col = col0 + bj * HALF + 16 * n; const f32x4 v = acc[ai][bj][m][n];
                        if (col < 512) { uint2 w; w.x = cvt_pk_bf16(v[0], v[1]); w.y = cvt_pk_bf16(v[2], v[3]); *(uint2*)(YI + row * 512 + col) = w; }
                        else if (col < 640) *(f32x4*)(F + row * 128 + (col - 512)) = v; } }
    }
};
struct EpiS5b {
    static constexpr bool PERM = true;
    const bf16* YI; bf16* Z;
    __device__ __forceinline__ void operator()(const f32x4 (&acc)[2][2][4][2], const Unit& u, int wr, int wc, int fr, int fq) const {
        const int row0 = u.pm * BM + wr * 64 + fr, col0 = u.pn * BM + wc * 32 + 8 * fq;
#pragma unroll
        for (int ai = 0; ai < 2; ++ai)
#pragma unroll
            for (int m = 0; m < 4; ++m) { const int row = row0 + ai * HALF + m * 16; const int g = row / S5R, rl = row % S5R;
#pragma unroll
                for (int bj = 0; bj < 2; ++bj) { const int col = col0 + bj * HALF;
                    const u32x4 yi = *(const u32x4*)(YI + (size_t)row * 512 + col);
                    const unsigned yw[4] = {yi.x, yi.y, yi.z, yi.w};
                    const f32x4 v0 = acc[ai][bj][m][0], v1 = acc[ai][bj][m][1];
                    float o[8];
#pragma unroll
                    for (int q = 0; q < 4; ++q) { const float al = (q < 2) ? v0[2 * q] : v1[2 * q - 4], ah = (q < 2) ? v0[2 * q + 1] : v1[2 * q - 3];
                        o[2 * q] = gelu_tanh(al + __builtin_bit_cast(float, yw[q] << 16)); o[2 * q + 1] = gelu_tanh(ah + __builtin_bit_cast(float, yw[q] & 0xffff0000u)); }
                    u32x4 w; w.x = cvt_pk_bf16(o[0], o[1]); w.y = cvt_pk_bf16(o[2], o[3]); w.z = cvt_pk_bf16(o[4], o[5]); w.w = cvt_pk_bf16(o[6], o[7]);
                    const size_t tok = (size_t)rl * S5L + (col >> 4);
                    *(u32x4*)(Z + tok * 512 + g * 16 + (col & 15)) = w; } }
    }
};
struct AttnOrder {
    static constexpr bool GATHER = false; __device__ __forceinline__ int grow(const Unit&, int) const { return 0; }
    const bf16* A; const bf16* Bt; int lda, ldb, K; int G, c; int mode;
    __device__ void init(const bf16* A_, const bf16* Bt_, int ldb_, int mode_) { A = A_; Bt = Bt_; lda = D; ldb = ldb_; K = 256; G = GN; c = GB; mode = mode_; }
    __device__ bool next(int i, Unit& u) const { const int L = i * G + c; if (L >= NB * 4 * 32) return false; u.pn = L & 3; u.pm = L >> 2; return true; }
    __device__ __forceinline__ const char* aptr(const Unit& u) const { return (const char*)(A + (size_t)u.pm * BM * D + u.pn * 256); }
    __device__ __forceinline__ const char* bptr(const Unit& u) const { const int b = u.pm >> 5;
        return (const char*)(mode == 0 ? Bt + (size_t)b * 256 * ldb + u.pn * 256 : Bt + (size_t)u.pn * 256 * ldb + b * 256); }
};
struct EpiSoftmax {
    static constexpr bool PERM = true;
    bf16* P; PG8_LAS float* scr;
    __device__ __forceinline__ void operator()(f32x4 (&acc)[2][2][4][2], const Unit& u, int wr, int wc, int fr, int fq) const {
        const float SC = 0.0625f * 1.4426950408889634f;
        PG8_LAS float* smax = scr; PG8_LAS float* ssum = scr + 1024;
#pragma unroll
        for (int ai = 0; ai < 2; ++ai)
#pragma unroll
            for (int m = 0; m < 4; ++m) { float t = -3.0e38f;
#pragma unroll
                for (int bj = 0; bj < 2; ++bj)
#pragma unroll
                    for (int n = 0; n < 2; ++n) { const f32x4 v = acc[ai][bj][m][n]; t = fmaxf(t, fmaxf(fmaxf(v[0], v[1]), fmaxf(v[2], v[3]))); }
                t = fmaxf(t, __shfl_xor(t, 16)); t = fmaxf(t, __shfl_xor(t, 32));
                if (fq == 0) smax[(ai * HALF + wr * 64 + m * 16 + fr) * 4 + wc] = t; }
        asm volatile("s_waitcnt lgkmcnt(0)" ::: "memory"); __builtin_amdgcn_s_barrier(); asm volatile("" ::: "memory");
#pragma unroll
        for (int ai = 0; ai < 2; ++ai)
#pragma unroll
            for (int m = 0; m < 4; ++m) { const f32x4 q = *(const PG8_LAS f32x4*)(smax + (ai * HALF + wr * 64 + m * 16 + fr) * 4);
                const float mm = fmaxf(fmaxf(q[0], q[1]), fmaxf(q[2], q[3])) * SC; float s = 0.f;
#pragma unroll
                for (int bj = 0; bj < 2; ++bj)
#pragma unroll
                    for (int n = 0; n < 2; ++n)
#pragma unroll
                        for (int e = 0; e < 4; ++e) { const float p = __builtin_amdgcn_exp2f(acc[ai][bj][m][n][e] * SC - mm); acc[ai][bj][m][n][e] = p; s += p; }
                s += __shfl_xor(s, 16); s += __shfl_xor(s, 32);
                if (fq == 0) ssum[(ai * HALF + wr * 64 + m * 16 + fr) * 4 + wc] = s; }
        asm volatile("s_waitcnt lgkmcnt(0)" ::: "memory"); __builtin_amdgcn_s_barrier(); asm volatile("" ::: "memory");
        const int row0 = u.pm * BM + wr * 64 + fr, col0 = u.pn * 256 + wc * 32 + 8 * fq;
#pragma unroll
        for (int ai = 0; ai < 2; ++ai)
#pragma unroll
            for (int m = 0; m < 4; ++m) { const f32x4 q = *(const PG8_LAS f32x4*)(ssum + (ai * HALF + wr * 64 + m * 16 + fr) * 4);
                const float iv = 1.f / ((q[0] + q[1]) + (q[2] + q[3]));
                bf16* rowp = P + (size_t)(row0 + ai * HALF + m * 16) * D + col0;
#pragma unroll
                for (int bj = 0; bj < 2; ++bj) { const f32x4 v0 = acc[ai][bj][m][0] * iv, v1 = acc[ai][bj][m][1] * iv; u32x4 w;
                    w.x = cvt_pk_bf16(v0[0], v0[1]); w.y = cvt_pk_bf16(v0[2], v0[3]); w.z = cvt_pk_bf16(v1[0], v1[1]); w.w = cvt_pk_bf16(v1[2], v1[3]);
                    *(u32x4*)(rowp + bj * HALF) = w; } }
    }
};
struct EpiAttnO {
    static constexpr bool PERM = true;
    bf16* O;
    __device__ __forceinline__ void operator()(const f32x4 (&acc)[2][2][4][2], const Unit& u, int wr, int wc, int fr, int fq) const {
        const int row0 = u.pm * BM + wr * 64 + fr, col0 = u.pn * 256 + wc * 32 + 8 * fq;
#pragma unroll
        for (int ai = 0; ai < 2; ++ai)
#pragma unroll
            for (int m = 0; m < 4; ++m) { bf16* rowp = O + (size_t)(row0 + ai * HALF + m * 16) * D + col0;
#pragma unroll
                for (int bj = 0; bj < 2; ++bj) { const f32x4 v0 = acc[ai][bj][m][0], v1 = acc[ai][bj][m][1];
                    u32x4 w; w.x = cvt_pk_bf16(v0[0], v0[1]); w.y = cvt_pk_bf16(v0[2], v0[3]); w.z = cvt_pk_bf16(v1[0], v1[1]); w.w = cvt_pk_bf16(v1[2], v1[3]);
                    *(u32x4*)(rowp + bj * HALF) = w; } }
    }
};

struct EpiLora {
    static constexpr bool PERM = true;
    bf16* LW; size_t ostride; const float* w0; const float* a0;
    __device__ __forceinline__ void operator()(const f32x4 (&acc)[2][2][4][2], const Unit& u, int wr, int wc, int fr, int fq) const {
        const int row0 = u.pm * BM + wr * 64 + fr, col0 = u.pn * BM + wc * 32 + 8 * fq;
        const int kind = u.pn >> 1;
        bf16* O = LW + (size_t)kind * ostride;
#pragma unroll
        for (int bj = 0; bj < 2; ++bj) { const int col = (col0 + bj * HALF) & 511;
            f32x4 b0 = (f32x4){0.f, 0.f, 0.f, 0.f}, b1 = b0;
            if (kind == 0) { b0 = *(const f32x4*)(w0 + col); b1 = *(const f32x4*)(w0 + col + 4); }
            else if (kind == 1) { b0 = *(const f32x4*)(a0 + col); b1 = *(const f32x4*)(a0 + col + 4); }
#pragma unroll
            for (int ai = 0; ai < 2; ++ai)
#pragma unroll
                for (int m = 0; m < 4; ++m) { const size_t row = (size_t)(row0 + ai * HALF + m * 16);
                    const f32x4 v0 = acc[ai][bj][m][0] + b0, v1 = acc[ai][bj][m][1] + b1; float o[8];
#pragma unroll
                    for (int e = 0; e < 8; ++e) { float x = (e < 4) ? v0[e & 3] : v1[e & 3];
                        if (kind == 0) { const float nd = -x; const float sp = fmaxf(nd, 0.f) + __logf(1.f + __expf(-fabsf(nd))); x = -__expf(-sp - 0.5f); }
                        else if (kind == 1) x = sigmoidf_(x);
                        o[e] = x; }
                    u32x4 w; w.x = cvt_pk_bf16(o[0], o[1]); w.y = cvt_pk_bf16(o[2], o[3]); w.z = cvt_pk_bf16(o[4], o[5]); w.w = cvt_pk_bf16(o[6], o[7]);
                    *(u32x4*)(O + row * 512 + col) = w; } }
    }
};
}

#define LAS __attribute__((address_space(3)))
__device__ __forceinline__ void transpose_item(const float* __restrict__ W, int K, int N, bf16* __restrict__ WT, int ldt, int row_off, int col_off, float* scr, int item, int lane, const float* __restrict__ kscale, int ldw = 0) {
    if (ldw == 0) ldw = N;
    const int nblk = N / 32, kb = item / nblk, nb = item % nblk, k0 = 64 * kb, n0 = 32 * nb;
#pragma unroll 8
    for (int i = 0; i < 32; ++i) { const int kk = 2 * i + (lane >> 5); float v = W[(size_t)(k0 + kk) * ldw + n0 + (lane & 31)]; if (kscale) v *= kscale[k0 + kk]; scr[kk * 33 + (lane & 31)] = v; }
    __builtin_amdgcn_s_waitcnt(0xc07f); asm volatile("" ::: "memory");
    const int c = lane & 7;
#pragma unroll
    for (int j = 0; j < 4; ++j) { const int n = (lane >> 3) + 8 * j; const float* s = scr + (8 * c) * 33 + n;
        uint4 o; o.x = pk2(s[0 * 33], s[1 * 33]); o.y = pk2(s[2 * 33], s[3 * 33]); o.z = pk2(s[4 * 33], s[5 * 33]); o.w = pk2(s[6 * 33], s[7 * 33]);
        *(uint4*)(WT + (size_t)(row_off + n0 + n) * ldt + col_off + k0 + 8 * c) = o; }
    __builtin_amdgcn_s_waitcnt(0xc07f); asm volatile("" ::: "memory");
}
__device__ __forceinline__ void transpose_ph(const int WID_, const float* W, int K, int N, bf16* WT, int ldt, int row_off, int col_off, char* lds, const float* kscale = nullptr) {
    const int lane = (WID_ * 64 + lane_id()) & 63, wv = (WID_ * 64 + lane_id()) >> 6;
    float* scr = (float*)(lds + wv * 16384);
    const int nitems = (K / 64) * (N / 32);
    for (int it = GB * 8 + wv; it < nitems; it += GN * 8) transpose_item(W, K, N, WT, ldt, row_off, col_off, scr, it, lane, kscale);
}

template <typename TO>
__device__ __forceinline__ void rmsnorm_ph(const int WID_, const float* __restrict__ x, const float* __restrict__ w, TO* __restrict__ out, int rows) {
    const int lane = lane_id(), wv = WID_;
    float4 g[4];
#pragma unroll
    for (int j = 0; j < 4; ++j) g[j] = *(const float4*)(w + (lane + 64 * j) * 4);
    for (int row = (GB * 8 + wv) * 2; row < rows; row += GN * 16) {
        const float4* xr = (const float4*)(x + (size_t)row * D);
        float4 v[2][4]; float s[2] = {0.f, 0.f};
#pragma unroll
        for (int r = 0; r < 2; ++r)
#pragma unroll
            for (int j = 0; j < 4; ++j) v[r][j] = xr[r * (D / 4) + lane + 64 * j];
#pragma unroll
        for (int r = 0; r < 2; ++r) {
#pragma unroll
            for (int j = 0; j < 4; ++j) s[r] += v[r][j].x * v[r][j].x + v[r][j].y * v[r][j].y + v[r][j].z * v[r][j].z + v[r][j].w * v[r][j].w;
            s[r] = wave_sum(s[r]);
            const float rs = rsqrtf(s[r] * (1.f / D) + 1e-6f);
#pragma unroll
            for (int j = 0; j < 4; ++j) {
                uint2 o; o.x = pk2(v[r][j].x * rs * g[j].x, v[r][j].y * rs * g[j].y); o.y = pk2(v[r][j].z * rs * g[j].z, v[r][j].w * rs * g[j].w);
                *(uint2*)(out + (size_t)(row + r) * D + (lane + 64 * j) * 4) = o;
            }
        }
    }
}

__device__ __forceinline__ void rwkv_lin_ph(const int WID_, const bf16* __restrict__ proj, const float* __restrict__ mu, bf16* __restrict__ lin) {
    const int lane = lane_id(), wv = WID_;
    const float4 m4 = *(const float4*)(mu + 1536 + 4 * lane);
    const float mm[4] = {m4.x, m4.y, m4.z, m4.w};
    for (int m0 = (GB * 8 + wv) * 4; m0 < M; m0 += GN * 32) {
        uint2 z[4], zp[4];
#pragma unroll
        for (int i = 0; i < 4; ++i) { const int m = m0 + i; z[i] = *(const uint2*)(proj + (size_t)m * DSHIFT + 1536 + 4 * lane);
            zp[i] = make_uint2(0, 0); if ((m & (S - 1)) != 0) zp[i] = *(const uint2*)(proj + (size_t)(m - 1) * DSHIFT + 1536 + 4 * lane); }
#pragma unroll
        for (int i = 0; i < 4; ++i) {
            float c[4] = {__builtin_bit_cast(float, z[i].x << 16), __builtin_bit_cast(float, z[i].x & 0xffff0000u), __builtin_bit_cast(float, z[i].y << 16), __builtin_bit_cast(float, z[i].y & 0xffff0000u)};
            const float q[4] = {__builtin_bit_cast(float, zp[i].x << 16), __builtin_bit_cast(float, zp[i].x & 0xffff0000u), __builtin_bit_cast(float, zp[i].y << 16), __builtin_bit_cast(float, zp[i].y & 0xffff0000u)};
#pragma unroll
            for (int e = 0; e < 4; ++e) { float t = c[e] + (q[e] - c[e]) * mm[e];
                if (lane < 16) t = 1.f - 2.f / (1.f + __expf(2.f * t));
                else if (lane >= 32) t = sigmoidf_(t);
                c[e] = t; }
            uint2 o; o.x = pk2(c[0], c[1]); o.y = pk2(c[2], c[3]);
            *(uint2*)(lin + (size_t)(m0 + i) * 256 + 4 * lane) = o;
        }
    }
}
__device__ __forceinline__ void rwkv_wl_ph(const int WID_, const float* __restrict__ wdec, const float* __restrict__ wiclr, const float* __restrict__ wgate, bf16* __restrict__ wl) {
    for (int i = GB * NT + (WID_ * 64 + lane_id()); i < 1536 * 256; i += GN * NT) {
        const int k = i & 255, n = i >> 8; float v = 0.f;
        if (n < 512) { if (k < 64) v = wdec[k * 512 + n]; }
        else if (n < 1024) { if (k >= 64 && k < 128) v = wiclr[(k - 64) * 512 + (n - 512)]; }
        else { if (k >= 128) v = wgate[(k - 128) * 512 + (n - 1024)]; }
        wl[i] = f2bf(v);
    }
}
struct RwkvIn { const bf16* proj; const bf16* LW; const bf16* AA; const float* mu; const float* k_k; const float* k_a; const float* r_k; float* Y; float* RK; };
constexpr int TB = 64;
constexpr int RW_ITEMS = NB * 8;
template <int CTRL> __device__ __forceinline__ float dpp16(float x) { return __builtin_bit_cast(float, __builtin_amdgcn_update_dpp(0, __builtin_bit_cast(int, x), CTRL, 0xf, 0xf, true)); }
__device__ __forceinline__ void rwkv_scan_ph(const int WID_, const RwkvIn& I, char* lds) {
    float* Rs = (float*)lds; float* Ws = Rs + TB * 64; float* Kps = Ws + TB * 64; float* KKs = Kps + TB * 64; float* Bs = KKs + TB * 64; float* Vs = Bs + TB * 64; float* Ys = Vs + TB * 64;
    const int lane = (WID_ * 64 + lane_id()) & 63, wv = (WID_ * 64 + lane_id()) >> 6;
    for (int item = GB; item < RW_ITEMS; item += GN) {
        const int half = item & 1, h = (item >> 1) & 7, b = item >> 4;
        const int j = lane & 15, rl = 4 * wv + (lane >> 4), row = 32 * half + rl;
        float s0 = 0.f, s1 = 0.f, s2 = 0.f, s3 = 0.f, sa = 0.f;
        const int tau = (WID_ * 64 + lane_id()) >> 3, cg = (WID_ * 64 + lane_id()) & 7, ch0 = h * 64 + cg * 8;
        uint4 gr, gk, gv, qr, qk, qv, ga, gl;
#define RW_ISSUE(blk) do { const int t_ = (blk) * TB + tau; const size_t m_ = (size_t)b * S + t_; const bf16* z_ = I.proj + m_ * DSHIFT + ch0; \
            gr = *(const uint4*)(z_); gk = *(const uint4*)(z_ + 512); gv = *(const uint4*)(z_ + 1024); \
            if (t_ > 0) { qr = *(const uint4*)(z_ - DSHIFT); qk = *(const uint4*)(z_ + 512 - DSHIFT); qv = *(const uint4*)(z_ + 1024 - DSHIFT); } \
            else { qr = make_uint4(0, 0, 0, 0); qk = qr; qv = qr; } \
            ga = *(const uint4*)(I.AA + m_ * 512 + ch0); gl = *(const uint4*)(I.LW + m_ * 512 + ch0); } while (0)
#define RW_COMMIT(blk) do { \
            const unsigned wr_[4] = {gr.x, gr.y, gr.z, gr.w}, wk_[4] = {gk.x, gk.y, gk.z, gk.w}, wv_[4] = {gv.x, gv.y, gv.z, gv.w}; \
            const unsigned pr_[4] = {qr.x, qr.y, qr.z, qr.w}, pk_[4] = {qk.x, qk.y, qk.z, qk.w}, pv_[4] = {qv.x, qv.y, qv.z, qv.w}; \
            const unsigned wa_[4] = {ga.x, ga.y, ga.z, ga.w}, wl_[4] = {gl.x, gl.y, gl.z, gl.w}; \
            float r_[8], k_[8], v_[8], a_[8], kk_[8], ss_ = 0.f, rk_ = 0.f; \
            _Pragma("unroll") for (int e = 0; e < 8; ++e) { const int w_ = e >> 1; const bool hi_ = e & 1; \
                auto ex = [&](unsigned u) { return hi_ ? __builtin_bit_cast(float, u & 0xffff0000u) : __builtin_bit_cast(float, u << 16); }; \
                const float mr_ = I.mu[ch0 + e], mk_ = I.mu[512 + ch0 + e], mv_ = I.mu[1024 + ch0 + e]; \
                float x = ex(wr_[w_]); r_[e] = x + (ex(pr_[w_]) - x) * mr_; x = ex(wk_[w_]); k_[e] = x + (ex(pk_[w_]) - x) * mk_; x = ex(wv_[w_]); v_[e] = x + (ex(pv_[w_]) - x) * mv_; \
                a_[e] = ex(wa_[w_]); kk_[e] = k_[e] * I.k_k[ch0 + e]; ss_ += kk_[e] * kk_[e]; } \
            ss_ += dpp16<0xB1>(ss_); ss_ += dpp16<0x4E>(ss_); ss_ += dpp16<0x141>(ss_); \
            const float inv_ = 1.f / fmaxf(sqrtf(ss_), 1e-12f); \
            float o_[6][8]; \
            _Pragma("unroll") for (int e = 0; e < 8; ++e) { const int w_ = e >> 1; const bool hi_ = e & 1; \
                const float lw_ = hi_ ? __builtin_bit_cast(float, wl_[w_] & 0xffff0000u) : __builtin_bit_cast(float, wl_[w_] << 16); \
                const float kp_ = k_[e] * (1.f + (a_[e] - 1.f) * I.k_a[ch0 + e]); const float kn_ = kk_[e] * inv_; \
                o_[0][e] = r_[e]; o_[1][e] = __expf(lw_); o_[2][e] = kp_; o_[3][e] = kn_; o_[4][e] = kn_ * a_[e]; o_[5][e] = v_[e]; rk_ += r_[e] * kp_ * I.r_k[ch0 + e]; } \
            _Pragma("unroll") for (int q_ = 0; q_ < 6; ++q_) { float* d_ = Rs + q_ * (TB * 64) + tau * 64 + cg * 8; \
                *(float4*)d_ = make_float4(o_[q_][0], o_[q_][1], o_[q_][2], o_[q_][3]); *(float4*)(d_ + 4) = make_float4(o_[q_][4], o_[q_][5], o_[q_][6], o_[q_][7]); } \
            if (half == 0) { rk_ += dpp16<0xB1>(rk_); rk_ += dpp16<0x4E>(rk_); rk_ += dpp16<0x141>(rk_); \
                if (cg == 0) I.RK[((size_t)b * S + (blk) * TB + tau) * 8 + h] = rk_; } } while (0)
        RW_ISSUE(0);
        __syncthreads();
        RW_COMMIT(0);
        __syncthreads();
        for (int blk = 0; blk < S / TB; ++blk) {
            if (blk + 1 < S / TB) RW_ISSUE(blk + 1);
            float4 r4 = *(const float4*)(Rs + 4 * j), w4 = *(const float4*)(Ws + 4 * j), k4 = *(const float4*)(Kps + 4 * j), b4 = *(const float4*)(Bs + 4 * j);
            float vv = Vs[row];
            if (blk == 0) sa = 0.f;
#pragma unroll 2
            for (int t = 0; t < TB; ++t) {
                const int tn = (t + 1 < TB) ? t + 1 : t;
                const float4 n4n = *(const float4*)(KKs + tn * 64 + 4 * j);
                const float4 r4n = *(const float4*)(Rs + tn * 64 + 4 * j), w4n = *(const float4*)(Ws + tn * 64 + 4 * j), k4n = *(const float4*)(Kps + tn * 64 + 4 * j), b4n = *(const float4*)(Bs + tn * 64 + 4 * j);
                const float vvn = Vs[tn * 64 + row];
                s0 = s0 * w4.x + (sa * b4.x + vv * k4.x);
                s1 = s1 * w4.y + (sa * b4.y + vv * k4.y);
                s2 = s2 * w4.z + (sa * b4.z + vv * k4.z);
                s3 = s3 * w4.w + (sa * b4.w + vv * k4.w);
                float py = (s0 * r4.x + s1 * r4.y) + (s2 * r4.z + s3 * r4.w);
                float ps = (s0 * n4n.x + s1 * n4n.y) + (s2 * n4n.z + s3 * n4n.w);
                py += dpp16<0xB1>(py); ps += dpp16<0xB1>(ps);
                py += dpp16<0x4E>(py); ps += dpp16<0x4E>(ps);
                py += dpp16<0x141>(py); ps += dpp16<0x141>(ps);
                py += dpp16<0x140>(py); ps += dpp16<0x140>(ps);
                if (j == 0) Ys[t * 32 + rl] = py;
                if (t + 1 < TB) sa = -ps;
                r4 = r4n; w4 = w4n; k4 = k4n; b4 = b4n; vv = vvn;
            }
            __syncthreads();
            { const int t = (WID_ * 64 + lane_id()) >> 3, r0 = ((WID_ * 64 + lane_id()) & 7) * 4; const size_t m = (size_t)b * S + blk * TB + t;
              *(float4*)(I.Y + m * 512 + h * 64 + 32 * half + r0) = *(const float4*)(Ys + t * 32 + r0); }
            if (blk + 1 < S / TB) RW_COMMIT(blk + 1);
            __syncthreads();
            if (blk + 1 < S / TB) { const float4 n4 = *(const float4*)(KKs + 4 * j);
                float ps = (s0 * n4.x + s1 * n4.y) + (s2 * n4.z + s3 * n4.w);
                ps += dpp16<0xB1>(ps); ps += dpp16<0x4E>(ps); ps += dpp16<0x141>(ps); ps += dpp16<0x140>(ps);
                sa = -ps; }
        }
    }
}

namespace ck {
#define CK_BAR() do { asm volatile("s_waitcnt lgkmcnt(0)" ::: "memory"); __builtin_amdgcn_s_barrier(); asm volatile("" ::: "memory"); } while (0)
typedef float f32x2_t __attribute__((ext_vector_type(2)));
typedef __bf16 bf16x2_t __attribute__((ext_vector_type(2)));
__device__ __forceinline__ unsigned cvtpk(float lo, float hi) { const f32x2_t v = {lo, hi}; const bf16x2_t b = __builtin_convertvector(v, bf16x2_t); return __builtin_bit_cast(unsigned, b); }
typedef short bf16x8 __attribute__((ext_vector_type(8)));
typedef float f32x16 __attribute__((ext_vector_type(16)));
constexpr int LD = 72;
constexpr int MB = 64 * LD * 2;
constexpr int O_AB = 0, O_RB = MB, O_BB = 2 * MB, O_KB = 3 * MB, O_AT = 4 * MB, O_W1T = 5 * MB, O_BT = 6 * MB, O_KT = 7 * MB, O_VT = 8 * MB,
              O_NM = 9 * MB, O_AAK = 10 * MB, O_ARB = 11 * MB, O_ARK = 12 * MB, O_G = 13 * MB, O_TOT = O_G + 16384;
constexpr int O_TM = O_AB, O_X1T = O_BB, O_NMF = O_G, O_TT = O_G + 8192, O_ZT = O_TT + 5120;
constexpr int ITEM_BYTES = 32768;
template <int K, typename PA, typename PB>
__device__ __forceinline__ f32x16 mm_tile(f32x16 acc, PA A, int lda, PB B, int ldb, int lane) {
    const int r = lane & 31, h = lane >> 5;
    bf16x8 a[K / 16], b[K / 16];
#pragma unroll
    for (int q = 0; q < K / 16; ++q) { a[q] = *(const bf16x8*)(A + r * lda + 16 * q + 8 * h); b[q] = *(const bf16x8*)(B + r * ldb + 16 * q + 8 * h); }
#pragma unroll
    for (int q = 0; q < K / 16; ++q) acc = __builtin_amdgcn_mfma_f32_32x32x16_bf16(a[q], b[q], acc, 0, 0, 0);
    return acc;
}
__device__ __forceinline__ int crow(int reg, int h) { return (reg & 3) + 8 * (reg >> 2) + 4 * h; }
__device__ __forceinline__ void store_tr(const f32x16& acc, bf16* Ct, int ldct, int lane) {
    const int c = lane & 31, h = lane >> 5;
#pragma unroll
    for (int g = 0; g < 4; ++g) { uint2 w; w.x = cvtpk(acc[4 * g], acc[4 * g + 1]); w.y = cvtpk(acc[4 * g + 2], acc[4 * g + 3]); *(uint2*)(Ct + c * ldct + 8 * g + 4 * h) = w; }
}
__device__ __forceinline__ void store_rm(const f32x16& acc, bf16* C, int ldc, int lane) {
    const int c = lane & 31, h = lane >> 5;
#pragma unroll
    for (int rg = 0; rg < 16; ++rg) C[crow(rg, h) * ldc + c] = f2bf(acc[rg]);
}
__device__ __forceinline__ f32x16 zero16() { return (f32x16){0.f, 0.f, 0.f, 0.f, 0.f, 0.f, 0.f, 0.f, 0.f, 0.f, 0.f, 0.f, 0.f, 0.f, 0.f, 0.f}; }
__device__ __forceinline__ void store_frag16(const f32x16& acc, bf16* base, int t0, int t1, int lane) {
    const int cc = lane & 31, hh = lane >> 5, col = 32 * t1 + cc;
#pragma unroll
    for (int g = 0; g < 4; ++g) { const int row = 32 * t0 + 8 * g + 4 * hh;
        uint2 w; w.x = cvtpk(acc[4 * g], acc[4 * g + 1]); w.y = cvtpk(acc[4 * g + 2], acc[4 * g + 3]);
        *(uint2*)(base + (((row >> 4) * 4 + (col >> 4)) * 64 + (col & 15) + 16 * ((row & 15) >> 2)) * 4) = w; }
}
struct In { const bf16* proj; const bf16* LW; const bf16* AA; const float* mu; const float* k_k; const float* k_a; const float* r_k; float* RK; char* items; };

__device__ __forceinline__ void phase1(const int WID_, const In& I, char* lds) {
    const int wv = WID_;
#define MAT(off) ((bf16*)(lds + (off)))
    float* G = (float*)(lds + O_G); float* TOT = (float*)(lds + O_TOT); float* NMF = (float*)(lds + O_NMF);
    uint4 nx_r, nx_k, nx_v, nx_qr, nx_qk, nx_qv, nx_a, nx_l;
    { const int lane0 = lane_id(), tid0 = wv * 64 + lane0; const int item = GB;
      if (item < NB * 8 * (S / 64)) { const int c = item & 127, h = (item >> 7) & 7, b = item >> 10, s = tid0 >> 3, cg = tid0 & 7, ch0 = h * 64 + cg * 8, t = c * 64 + s; const size_t m = (size_t)b * S + t;
        const bf16* z = I.proj + m * DSHIFT + ch0;
        nx_r = *(const uint4*)(z); nx_k = *(const uint4*)(z + 512); nx_v = *(const uint4*)(z + 1024);
        nx_qr = make_uint4(0, 0, 0, 0); nx_qk = nx_qr; nx_qv = nx_qr;
        if (t > 0) { nx_qr = *(const uint4*)(z - DSHIFT); nx_qk = *(const uint4*)(z + 512 - DSHIFT); nx_qv = *(const uint4*)(z + 1024 - DSHIFT); }
        nx_a = *(const uint4*)(I.AA + m * 512 + ch0); nx_l = *(const uint4*)(I.LW + m * 512 + ch0); } }
    for (int item = GB; item < NB * 8 * (S / 64); item += GN) {
        const int lane = lane_id(), tid = wv * 64 + lane;
        const int c = item & 127, h = (item >> 7) & 7, b = item >> 10;
        char* out = I.items + (size_t)item * ITEM_BYTES;
        const int s = tid >> 3, cg = tid & 7, ch0 = h * 64 + cg * 8, t = c * 64 + s; const size_t m = (size_t)b * S + t;
        float r_[8], kp_[8], v_[8], kk_[8], b_[8];
        {
            const uint4 gr = nx_r, gk = nx_k, gv = nx_v, qr = nx_qr, qk = nx_qk, qv = nx_qv, ga = nx_a, gl = nx_l;
            const float4 c_mr0 = *(const float4*)(I.mu + ch0), c_mr1 = *(const float4*)(I.mu + ch0 + 4), c_mk0 = *(const float4*)(I.mu + 512 + ch0), c_mk1 = *(const float4*)(I.mu + 512 + ch0 + 4);
            const float4 c_mv0 = *(const float4*)(I.mu + 1024 + ch0), c_mv1 = *(const float4*)(I.mu + 1024 + ch0 + 4), c_kk0 = *(const float4*)(I.k_k + ch0), c_kk1 = *(const float4*)(I.k_k + ch0 + 4);
            const float4 c_ka0 = *(const float4*)(I.k_a + ch0), c_ka1 = *(const float4*)(I.k_a + ch0 + 4), c_rk0 = *(const float4*)(I.r_k + ch0), c_rk1 = *(const float4*)(I.r_k + ch0 + 4);
            const float mur[8] = {c_mr0.x, c_mr0.y, c_mr0.z, c_mr0.w, c_mr1.x, c_mr1.y, c_mr1.z, c_mr1.w}, muk[8] = {c_mk0.x, c_mk0.y, c_mk0.z, c_mk0.w, c_mk1.x, c_mk1.y, c_mk1.z, c_mk1.w};
            const float muv[8] = {c_mv0.x, c_mv0.y, c_mv0.z, c_mv0.w, c_mv1.x, c_mv1.y, c_mv1.z, c_mv1.w}, ckk[8] = {c_kk0.x, c_kk0.y, c_kk0.z, c_kk0.w, c_kk1.x, c_kk1.y, c_kk1.z, c_kk1.w};
            const float cka[8] = {c_ka0.x, c_ka0.y, c_ka0.z, c_ka0.w, c_ka1.x, c_ka1.y, c_ka1.z, c_ka1.w}, crk[8] = {c_rk0.x, c_rk0.y, c_rk0.z, c_rk0.w, c_rk1.x, c_rk1.y, c_rk1.z, c_rk1.w};
            const unsigned wr[4] = {gr.x, gr.y, gr.z, gr.w}, wk[4] = {gk.x, gk.y, gk.z, gk.w}, wv4[4] = {gv.x, gv.y, gv.z, gv.w};
            const unsigned pr[4] = {qr.x, qr.y, qr.z, qr.w}, pk[4] = {qk.x, qk.y, qk.z, qk.w}, pv[4] = {qv.x, qv.y, qv.z, qv.w};
            const unsigned wa[4] = {ga.x, ga.y, ga.z, ga.w}, wl[4] = {gl.x, gl.y, gl.z, gl.w};
            float ss = 0.f, rk = 0.f, a_[8];
#pragma unroll
            for (int e = 0; e < 8; ++e) { const int w_ = e >> 1; const bool hi = e & 1;
                auto ex = [&](unsigned u) { return hi ? __builtin_bit_cast(float, u & 0xffff0000u) : __builtin_bit_cast(float, u << 16); };
                float x = ex(wr[w_]); r_[e] = x + (ex(pr[w_]) - x) * mur[e];
                x = ex(wk[w_]); const float k = x + (ex(pk[w_]) - x) * muk[e];
                x = ex(wv4[w_]); v_[e] = x + (ex(pv[w_]) - x) * muv[e];
                a_[e] = ex(wa[w_]); kk_[e] = k * ckk[e]; ss += kk_[e] * kk_[e];
                kp_[e] = k * (1.f + (a_[e] - 1.f) * cka[e]); rk += r_[e] * kp_[e] * crk[e];
                G[s * 64 + cg * 8 + e] = ex(wl[w_]); }
            ss += dpp16<0xB1>(ss); ss += dpp16<0x4E>(ss); ss += dpp16<0x141>(ss);
            const float inv = 1.f / fmaxf(sqrtf(ss), 1e-12f);
#pragma unroll
            for (int e = 0; e < 8; ++e) { kk_[e] *= inv; b_[e] = kk_[e] * a_[e]; }
            rk += dpp16<0xB1>(rk); rk += dpp16<0x4E>(rk); rk += dpp16<0x141>(rk);
            if (cg == 0) I.RK[m * 8 + h] = rk;
        }
        CK_BAR();
        { const int ch = tid & 63, part = tid >> 6; float run = 0.f;
#pragma unroll
          for (int i = 0; i < 8; ++i) { run += G[(8 * part + i) * 64 + ch]; G[(8 * part + i) * 64 + ch] = run; }
          TOT[part * 64 + ch] = run; }
        CK_BAR();
        { const int ch = tid & 63, part = tid >> 6; float off = 0.f;
          for (int p = 0; p < part; ++p) off += TOT[p * 64 + ch];
#pragma unroll
          for (int i = 0; i < 8; ++i) G[(8 * part + i) * 64 + ch] += off; }
        CK_BAR();
        float glast[8];
        {
            unsigned pab[4], prb[4], pbb[4], pkb[4];
            float ab[8], rb[8], bb[8], kb[8], bt[8], kt[8];
#pragma unroll
            for (int e = 0; e < 8; ++e) { const float g = G[s * 64 + cg * 8 + e], gm1 = (s > 0) ? G[(s - 1) * 64 + cg * 8 + e] : 0.f, gL = G[63 * 64 + cg * 8 + e];
                glast[e] = gL;
                const float eg = __expf(g), eng = __expf(-g), egm = __expf(gm1), egl = __expf(gL - g);
                ab[e] = -kk_[e] * egm; rb[e] = r_[e] * eg; bb[e] = b_[e] * eng; kb[e] = kp_[e] * eng; bt[e] = b_[e] * egl; kt[e] = kp_[e] * egl; }
#pragma unroll
            for (int q = 0; q < 4; ++q) { pab[q] = pk2(ab[2 * q], ab[2 * q + 1]); prb[q] = pk2(rb[2 * q], rb[2 * q + 1]); pbb[q] = pk2(bb[2 * q], bb[2 * q + 1]); pkb[q] = pk2(kb[2 * q], kb[2 * q + 1]); }
            *(uint4*)(MAT(O_AB) + s * LD + cg * 8) = make_uint4(pab[0], pab[1], pab[2], pab[3]);
            *(uint4*)(MAT(O_RB) + s * LD + cg * 8) = make_uint4(prb[0], prb[1], prb[2], prb[3]);
            *(uint4*)(MAT(O_BB) + s * LD + cg * 8) = make_uint4(pbb[0], pbb[1], pbb[2], pbb[3]);
            *(uint4*)(MAT(O_KB) + s * LD + cg * 8) = make_uint4(pkb[0], pkb[1], pkb[2], pkb[3]);
#pragma unroll
            for (int e = 0; e < 8; ++e) { const int k = cg * 8 + e;
                MAT(O_AT)[k * LD + s] = f2bf(ab[e]); MAT(O_BT)[k * LD + s] = f2bf(bt[e]); MAT(O_KT)[k * LD + s] = f2bf(kt[e]); MAT(O_VT)[k * LD + s] = f2bf(v_[e]); }
        }
        CK_BAR();
        { const int itn = item + GN;
          if (itn < NB * 8 * (S / 64)) { const int c2 = itn & 127, h2 = (itn >> 7) & 7, b2 = itn >> 10, ch2 = h2 * 64 + cg * 8, t2 = c2 * 64 + s; const size_t m2 = (size_t)b2 * S + t2;
            const bf16* z = I.proj + m2 * DSHIFT + ch2;
            nx_r = *(const uint4*)(z); nx_k = *(const uint4*)(z + 512); nx_v = *(const uint4*)(z + 1024);
            nx_qr = make_uint4(0, 0, 0, 0); nx_qk = nx_qr; nx_qv = nx_qr;
            if (t2 > 0) { nx_qr = *(const uint4*)(z - DSHIFT); nx_qk = *(const uint4*)(z + 512 - DSHIFT); nx_qv = *(const uint4*)(z + 1024 - DSHIFT); }
            nx_a = *(const uint4*)(I.AA + m2 * 512 + ch2); nx_l = *(const uint4*)(I.LW + m2 * 512 + ch2); } }
        if (s == 63) {
#pragma unroll
            for (int e = 0; e < 8; ++e) TOT[cg * 8 + e] = __expf(glast[e]);
        }
        {
            const int mat = tid >> 7, row = (tid >> 2) & 31, chunk = tid & 3;
            *(uint4*)(MAT(O_NM + mat * MB) + row * LD + 32 + chunk * 8) = make_uint4(0, 0, 0, 0);
        }
        for (int task = wv; task < 12; task += 8) {
            const int mat = task / 3, tt = task % 3, st = (tt == 0) ? 0 : 1, jt = (tt == 2) ? 1 : 0;
            const bf16* Asrc = MAT((mat & 1) ? O_KB : O_BB) + 32 * jt * LD;
            const bf16* Bsrc = MAT((mat >> 1) ? O_RB : O_AB) + 32 * st * LD;
            f32x16 acc = mm_tile<64>(zero16(), Asrc, LD, Bsrc, LD, lane);
            const int cs = 32 * st + (lane & 31), hh = lane >> 5; const bool incl = (mat >> 1) != 0;
#pragma unroll
            for (int rg = 0; rg < 16; ++rg) { const int j = 32 * jt + crow(rg, hh); const bool keep = incl ? (j <= cs) : (j < cs); if (!keep) acc[rg] = 0.f; }
            store_tr(acc, MAT(O_NM + mat * MB) + 32 * st * LD + 32 * jt, LD, lane);
            if (mat == 0 && st == jt) {
                float* d = NMF + st * 1024 + (lane & 31) * 32;
#pragma unroll
                for (int g = 0; g < 4; ++g) *(float4*)(d + 8 * g + 4 * hh) = make_float4(acc[4 * g], acc[4 * g + 1], acc[4 * g + 2], acc[4 * g + 3]);
            }
        }
        CK_BAR();
        if (wv == 0) {
            const int d = lane >> 4, cc = lane & 15;
            const float* nb = NMF + (d >> 1) * 1024 + (16 * (d & 1)) * 32 + 16 * (d & 1);
            float T[16];
#pragma unroll
            for (int i = 0; i < 16; ++i) {
                float acc = (i == cc) ? 1.f : 0.f;
#pragma unroll
                for (int j4 = 0; j4 < i; j4 += 4) { const float4 n4 = *(const float4*)(nb + i * 32 + j4);
                    acc += n4.x * T[j4]; if (j4 + 1 < i) acc += n4.y * T[j4 + 1]; if (j4 + 2 < i) acc += n4.z * T[j4 + 2]; if (j4 + 3 < i) acc += n4.w * T[j4 + 3]; }
                T[i] = acc;
            }
            bf16* tm = MAT(O_TM) + (16 * d) * LD + 16 * d + cc;
#pragma unroll
            for (int i = 0; i < 16; ++i) tm[i * LD] = f2bf(T[i]);
            bf16* tt = MAT(O_TT) + (d >> 1) * 32 * 40 + (16 * (d & 1) + cc) * 40 + 16 * (d & 1);
            *(uint4*)(tt) = make_uint4(pk2(T[0], T[1]), pk2(T[2], T[3]), pk2(T[4], T[5]), pk2(T[6], T[7]));
            *(uint4*)(tt + 8) = make_uint4(pk2(T[8], T[9]), pk2(T[10], T[11]), pk2(T[12], T[13]), pk2(T[14], T[15]));
            { const int blk = lane >> 5, r16 = (lane >> 1) & 15, hf = lane & 1;
              *(uint4*)(MAT(O_TM) + (32 * blk + r16) * LD + 32 * blk + 16 + 8 * hf) = make_uint4(0, 0, 0, 0);
              *(uint4*)(MAT(O_TT) + blk * 32 * 40 + (16 + r16) * 40 + 8 * hf) = make_uint4(0, 0, 0, 0); }
        } else if (wv == 1) {
            const int row = lane >> 1, half = lane & 1;
            *(uint4*)(MAT(O_TM) + row * LD + 32 + half * 16) = make_uint4(0, 0, 0, 0); *(uint4*)(MAT(O_TM) + row * LD + 32 + half * 16 + 8) = make_uint4(0, 0, 0, 0);
        } else if (wv >= 4) {
            const int st = (wv - 4) >> 1, vt = (wv - 4) & 1;
            f32x16 acc = mm_tile<64>(zero16(), MAT(O_AAK) + 32 * st * LD, LD, MAT(O_VT) + 32 * vt * LD, LD, lane);
            store_tr(acc, MAT(O_W1T) + 32 * vt * LD + 32 * st, LD, lane);
        }
        CK_BAR();
        if (wv < 2) {
            typedef float f32x4v __attribute__((ext_vector_type(4)));
            const int blk = wv, fr = lane & 15, fq = lane >> 4;
            const bf16x8 zf = (bf16x8){0, 0, 0, 0, 0, 0, 0, 0};
            bf16x8 a = zf, bq = zf;
            if (fq < 2) { a = *(const bf16x8*)(MAT(O_NM) + (32 * blk + 16 + fr) * LD + 32 * blk + 8 * fq); bq = *(const bf16x8*)(MAT(O_TT) + blk * 32 * 40 + fr * 40 + 8 * fq); }
            f32x4v z = __builtin_amdgcn_mfma_f32_16x16x32_bf16(a, bq, (f32x4v){0.f, 0.f, 0.f, 0.f}, 0, 0, 0);
            bf16* zt = MAT(O_ZT) + blk * 16 * 24;
            { uint2 w; w.x = cvtpk(z[0], z[1]); w.y = cvtpk(z[2], z[3]); *(uint2*)(zt + fr * 24 + 4 * fq) = w; }
            asm volatile("s_waitcnt lgkmcnt(0)" ::: "memory");
            a = zf; bq = zf;
            if (fq < 2) { a = *(const bf16x8*)(MAT(O_TM) + (32 * blk + 16 + fr) * LD + 32 * blk + 16 + 8 * fq); bq = *(const bf16x8*)(zt + fr * 24 + 8 * fq); }
            const f32x4v t21 = __builtin_amdgcn_mfma_f32_16x16x32_bf16(a, bq, (f32x4v){0.f, 0.f, 0.f, 0.f}, 0, 0, 0);
#pragma unroll
            for (int rg = 0; rg < 4; ++rg) MAT(O_TM)[(32 * blk + 16 + 4 * fq + rg) * LD + 32 * blk + fr] = f2bf(t21[rg]);
            { uint2 w; w.x = cvtpk(t21[0], t21[1]); w.y = cvtpk(t21[2], t21[3]); *(uint2*)(MAT(O_TT) + blk * 32 * 40 + fr * 40 + 16 + 4 * fq) = w; }
        }
        CK_BAR();
        if (wv == 0) { f32x16 acc = mm_tile<32>(zero16(), MAT(O_NM) + 32 * LD, LD, MAT(O_TT), 40, lane); store_tr(acc, MAT(O_ZT), 40, lane); }
        CK_BAR();
        if (wv == 0) { f32x16 acc = mm_tile<32>(zero16(), MAT(O_TM) + 32 * LD + 32, LD, MAT(O_ZT), 40, lane); store_rm(acc, MAT(O_TM) + 32 * LD, LD, lane); }
        CK_BAR();
        { const int st = wv >> 2, ct = wv & 3;
          f32x16 acc = mm_tile<64>(zero16(), MAT(O_TM) + 32 * st * LD, LD, MAT(O_AT) + 32 * ct * LD, LD, lane);
          CK_BAR();
          store_tr(acc, MAT(O_X1T) + 32 * ct * LD + 32 * st, LD, lane); }
        CK_BAR();
        for (int u = wv; u < 16; u += 8) {
            const int kind = u >> 2, t0 = (u >> 1) & 1, t1 = u & 1, hh = lane >> 5, cc = lane & 31;
            if (kind == 0) {
                f32x16 acc = mm_tile<64>(zero16(), MAT(O_BT) + 32 * t0 * LD, LD, MAT(O_X1T) + (64 + 32 * t1) * LD, LD, lane);
                acc = mm_tile<64>(acc, MAT(O_KT) + 32 * t0 * LD, LD, MAT(O_VT) + 32 * t1 * LD, LD, lane);
                store_frag16(acc, (bf16*)(out + 16384), t0, t1, lane);
            } else if (kind == 1) {
                f32x16 acc = mm_tile<64>(zero16(), MAT(O_ARB) + 32 * t0 * LD, LD, MAT(O_X1T) + (64 + 32 * t1) * LD, LD, lane);
                acc = mm_tile<64>(acc, MAT(O_ARK) + 32 * t0 * LD, LD, MAT(O_VT) + 32 * t1 * LD, LD, lane);
                store_frag16(acc, (bf16*)(out + 24576), t0, t1, lane);
            } else if (kind == 2) {
                f32x16 acc = mm_tile<64>(zero16(), MAT(O_X1T) + 32 * t0 * LD, LD, MAT(O_BT) + 32 * t1 * LD, LD, lane);
                const int k = 32 * t1 + cc; const float gl = TOT[k];
                bf16* d = (bf16*)out + k * 64 + 32 * t0;
#pragma unroll
                for (int g = 0; g < 4; ++g) { float x[4];
#pragma unroll
                    for (int e = 0; e < 4; ++e) { const int kp = 32 * t0 + 8 * g + 4 * hh + e; x[e] = acc[4 * g + e] + ((kp == k) ? gl : 0.f); }
                    uint2 w; w.x = cvtpk(x[0], x[1]); w.y = cvtpk(x[2], x[3]); *(uint2*)(d + 8 * g + 4 * hh) = w; }
            } else {
                f32x16 acc = mm_tile<64>(zero16(), MAT(O_X1T) + 32 * t0 * LD, LD, MAT(O_ARB) + 32 * t1 * LD, LD, lane);
                const int sq = 32 * t1 + cc;
                bf16* d = (bf16*)(out + 8192) + sq * 64 + 32 * t0;
                const bf16* rb = MAT(O_RB) + sq * LD + 32 * t0;
#pragma unroll
                for (int g = 0; g < 4; ++g) { const uint2 rr = *(const uint2*)(rb + 8 * g + 4 * hh);
                    const float x0 = acc[4 * g] + __builtin_bit_cast(float, rr.x << 16), x1 = acc[4 * g + 1] + __builtin_bit_cast(float, rr.x & 0xffff0000u);
                    const float x2 = acc[4 * g + 2] + __builtin_bit_cast(float, rr.y << 16), x3 = acc[4 * g + 3] + __builtin_bit_cast(float, rr.y & 0xffff0000u);
                    uint2 w; w.x = cvtpk(x0, x1); w.y = cvtpk(x2, x3); *(uint2*)(d + 8 * g + 4 * hh) = w; }
            }
        }
        CK_BAR();
    }
#undef MAT
}
typedef float f32x4w __attribute__((ext_vector_type(4)));
struct P2R { bf16x8 a0, a1; uint2 c; };
__device__ __forceinline__ void p2_load(P2R& o, const char* rec, size_t aoff, size_t coff) { o.a0 = *(const bf16x8*)(rec + aoff); o.a1 = *(const bf16x8*)(rec + aoff + 64); o.c = *(const uint2*)(rec + coff); }
__device__ __forceinline__ void phase2(const int WID_, const char* items, float* Y, char* lds) {
    const int wv = WID_;
    bf16* HT0 = (bf16*)lds; bf16* HT1 = HT0 + 16 * LD;
    for (int item = GB; item < NB * 8 * 4; item += GN) {
        const int lane = lane_id(), fr = lane & 15, fq = lane >> 4;
        const int vq = (item >> 3) & 3, head = (item & 7) + 8 * (item >> 5), b = head >> 3, h = head & 7;
        for (int i = wv * 64 + lane; i < 2 * 16 * LD / 8; i += NT) ((uint4*)lds)[i] = make_uint4(0, 0, 0, 0);
        CK_BAR();
        const bool upd = wv < 4; const int rb = wv & 3;
        const char* rec0 = items + (size_t)(head * 128) * ITEM_BYTES;
        const size_t aoff = (upd ? 0 : 8192) + ((16 * rb + fr) * 64 + 8 * fq) * 2;
        const size_t coff = (upd ? 16384 : 24576) + ((rb * 4 + vq) * 64 + lane) * 8;
        float* yo = Y + ((size_t)b * S + 16 * rb + 4 * fq) * 512 + h * 64 + 16 * vq + fr;
        P2R r0, r1, r2, r3, r4, r5, r6, r7, r8, r9, r10, r11, r12, r13, r14, r15;
#define P2_PRE(R, i) p2_load(R, rec0 + (size_t)(i) * ITEM_BYTES, aoff, coff)
        P2_PRE(r0, 0); P2_PRE(r1, 1); P2_PRE(r2, 2); P2_PRE(r3, 3); P2_PRE(r4, 4); P2_PRE(r5, 5); P2_PRE(r6, 6); P2_PRE(r7, 7);
        P2_PRE(r8, 8); P2_PRE(r9, 9); P2_PRE(r10, 10); P2_PRE(r11, 11); P2_PRE(r12, 12); P2_PRE(r13, 13); P2_PRE(r14, 14);
#define P2_STEP(R, RN, cstep) do { const int c_ = (cstep); \
            const bf16* Hc = (c_ & 1) ? HT1 : HT0; bf16* Hn = (c_ & 1) ? HT0 : HT1; \
            f32x4w acc = (f32x4w){__builtin_bit_cast(float, R.c.x << 16), __builtin_bit_cast(float, R.c.x & 0xffff0000u), __builtin_bit_cast(float, R.c.y << 16), __builtin_bit_cast(float, R.c.y & 0xffff0000u)}; \
            const bf16x8 b0 = *(const bf16x8*)(Hc + fr * LD + 8 * fq), b1 = *(const bf16x8*)(Hc + fr * LD + 32 + 8 * fq); \
            acc = __builtin_amdgcn_mfma_f32_16x16x32_bf16(R.a0, b0, acc, 0, 0, 0); acc = __builtin_amdgcn_mfma_f32_16x16x32_bf16(R.a1, b1, acc, 0, 0, 0); \
            if (upd) { uint2 w; w.x = cvtpk(acc[0], acc[1]); w.y = cvtpk(acc[2], acc[3]); *(uint2*)(Hn + fr * LD + 16 * rb + 4 * fq) = w; } \
            else { float* y_ = yo + (size_t)c_ * 64 * 512; y_[0] = acc[0]; y_[512] = acc[1]; y_[1024] = acc[2]; y_[1536] = acc[3]; } \
            if (c_ + 15 < S / 64) P2_PRE(RN, c_ + 15); \
            CK_BAR(); } while (0)
        for (int c = 0; c < S / 64; c += 16) {
            P2_STEP(r0, r15, c); P2_STEP(r1, r0, c + 1); P2_STEP(r2, r1, c + 2); P2_STEP(r3, r2, c + 3);
            P2_STEP(r4, r3, c + 4); P2_STEP(r5, r4, c + 5); P2_STEP(r6, r5, c + 6); P2_STEP(r7, r6, c + 7);
            P2_STEP(r8, r7, c + 8); P2_STEP(r9, r8, c + 9); P2_STEP(r10, r9, c + 10); P2_STEP(r11, r10, c + 11);
            P2_STEP(r12, r11, c + 12); P2_STEP(r13, r12, c + 13); P2_STEP(r14, r13, c + 14); P2_STEP(r15, r14, c + 15);
        }
#undef P2_STEP
#undef P2_PRE
    }
}
}

__device__ __forceinline__ void rwkv_post_ph(const int WID_, const float* __restrict__ Y, const float* __restrict__ RK, const bf16* __restrict__ proj, const float* __restrict__ mu, const bf16* __restrict__ G,
                             const float* __restrict__ lnw, const float* __restrict__ lnb, bf16* __restrict__ ymix) {
    const int lane = lane_id(), tk = WID_, grp = lane, ch0 = grp * 8, head = grp >> 3;
    const float4 mv0 = *(const float4*)(mu + 1024 + ch0), mv1 = *(const float4*)(mu + 1024 + ch0 + 4), lw0 = *(const float4*)(lnw + ch0), lw1 = *(const float4*)(lnw + ch0 + 4), lb0 = *(const float4*)(lnb + ch0), lb1 = *(const float4*)(lnb + ch0 + 4);
    const float muv[8] = {mv0.x, mv0.y, mv0.z, mv0.w, mv1.x, mv1.y, mv1.z, mv1.w}, lw_[8] = {lw0.x, lw0.y, lw0.z, lw0.w, lw1.x, lw1.y, lw1.z, lw1.w}, lb_[8] = {lb0.x, lb0.y, lb0.z, lb0.w, lb1.x, lb1.y, lb1.z, lb1.w};
    for (int m0 = GB * 16 + tk; m0 < M; m0 += GN * 16) {
        float4 ya[2], yb[2]; uint4 vv[2], pv[2], gg[2]; float rk[2];
#pragma unroll
        for (int u = 0; u < 2; ++u) { const int m = m0 + 8 * u;
            ya[u] = *(const float4*)(Y + (size_t)m * 512 + ch0); yb[u] = *(const float4*)(Y + (size_t)m * 512 + ch0 + 4);
            vv[u] = *(const uint4*)(proj + (size_t)m * DSHIFT + 1024 + ch0);
            pv[u] = (m & (S - 1)) ? *(const uint4*)(proj + (size_t)(m - 1) * DSHIFT + 1024 + ch0) : make_uint4(0, 0, 0, 0);
            gg[u] = *(const uint4*)(G + (size_t)m * 512 + ch0); rk[u] = RK[(size_t)m * 8 + head]; }
#pragma unroll
        for (int u = 0; u < 2; ++u) {
            const float y[8] = {ya[u].x, ya[u].y, ya[u].z, ya[u].w, yb[u].x, yb[u].y, yb[u].z, yb[u].w};
            float s = 0.f;
#pragma unroll
            for (int e = 0; e < 8; ++e) s += y[e];
            s += dpp16<0xB1>(s); s += dpp16<0x4E>(s); s += dpp16<0x141>(s);
            const float mean = s * (1.f / 64.f); float q = 0.f;
#pragma unroll
            for (int e = 0; e < 8; ++e) { const float d = y[e] - mean; q += d * d; }
            q += dpp16<0xB1>(q); q += dpp16<0x4E>(q); q += dpp16<0x141>(q);
            const float rstd = rsqrtf(q * (1.f / 64.f) + 64e-5f);
            const unsigned wv_[4] = {vv[u].x, vv[u].y, vv[u].z, vv[u].w}, wp_[4] = {pv[u].x, pv[u].y, pv[u].z, pv[u].w}, wg_[4] = {gg[u].x, gg[u].y, gg[u].z, gg[u].w};
            float o[8];
#pragma unroll
            for (int e = 0; e < 8; ++e) { const int w_ = e >> 1; const bool hi = e & 1;
                auto ex = [&](unsigned x) { return hi ? __builtin_bit_cast(float, x & 0xffff0000u) : __builtin_bit_cast(float, x << 16); };
                float v = ex(wv_[w_]); v += (ex(wp_[w_]) - v) * muv[e];
                o[e] = ((y[e] - mean) * rstd * lw_[e] + lb_[e] + rk[u] * v) * ex(wg_[w_]); }
            *(uint4*)(ymix + (size_t)(m0 + 8 * u) * D + ch0) = make_uint4(pk2(o[0], o[1]), pk2(o[2], o[3]), pk2(o[4], o[5]), pk2(o[6], o[7]));
        }
    }
}

constexpr int PSLOTS = NASSIGN + NEXP * 256;
constexpr int MAXTILES = PSLOTS / 256;
struct MoeBufs { int* tok_e; float* tok_g; int* tok_slot; int* slot_tok; float* slot_gate; int* bcnt; int* bbase; int* offs; int* tiles; int* ntiles; };
__device__ __forceinline__ void moe_zero_ph(const int WID_, const MoeBufs& mb) {
    for (int i = GB * NT + (WID_ * 64 + lane_id()); i < PSLOTS; i += GN * NT) { mb.slot_tok[i] = 0; mb.slot_gate[i] = 0.f; }
}
__device__ __forceinline__ void router_ph(const int WID_, const float* __restrict__ x3, const float* __restrict__ nw, bf16* __restrict__ h3, const float* __restrict__ wrg, const float* __restrict__ brg,
                          const float* __restrict__ wre, const float* __restrict__ bre, const MoeBufs& mb, char* lds) {
    const int lane = lane_id(), wv = WID_;
    int* lcnt = (int*)lds;
    _Float16* wg16 = (_Float16*)(lds + 256);
    _Float16* we16 = (_Float16*)(lds + 256 + 8192);
    if (wv == 0 && lane < 32) lcnt[lane] = 0;
    for (int i = wv * 64 + lane; i < 1024; i += NT) { const float4 w = *(const float4*)(wrg + i * 4);
        typedef _Float16 h4 __attribute__((ext_vector_type(4))); *(h4*)(wg16 + i * 4) = (h4){(_Float16)w.x, (_Float16)w.y, (_Float16)w.z, (_Float16)w.w}; }
    for (int i = wv * 64 + lane; i < 4 * 1024 * 2; i += NT) { const float4 w = *(const float4*)(wre + i * 4);
        typedef _Float16 h4 __attribute__((ext_vector_type(4))); *(h4*)(we16 + i * 4) = (h4){(_Float16)w.x, (_Float16)w.y, (_Float16)w.z, (_Float16)w.w}; }
    __syncthreads();
    typedef _Float16 h4 __attribute__((ext_vector_type(4)));
    typedef _Float16 h8 __attribute__((ext_vector_type(8)));
    for (int m = GB * 8 + wv; m < M; m += GN * 8) {
        const float4* xr = (const float4*)(x3 + (size_t)m * D);
        float h[16]; float s = 0.f;
#pragma unroll
        for (int j = 0; j < 4; ++j) { const float4 v = xr[lane + 64 * j]; h[4 * j] = v.x; h[4 * j + 1] = v.y; h[4 * j + 2] = v.z; h[4 * j + 3] = v.w; s += v.x * v.x + v.y * v.y + v.z * v.z + v.w * v.w; }
        s = wave_sum(s);
        const float rs = rsqrtf(s * (1.f / D) + 1e-6f);
        float l1[4] = {0.f, 0.f, 0.f, 0.f};
#pragma unroll
        for (int j = 0; j < 4; ++j) {
            const int k0 = (lane + 64 * j) * 4;
            const float4 g = *(const float4*)(nw + k0);
            h[4 * j] *= rs * g.x; h[4 * j + 1] *= rs * g.y; h[4 * j + 2] *= rs * g.z; h[4 * j + 3] *= rs * g.w;
            uint2 o; o.x = pk2(h[4 * j], h[4 * j + 1]); o.y = pk2(h[4 * j + 2], h[4 * j + 3]);
            *(uint2*)(h3 + (size_t)m * D + k0) = o;
#pragma unroll
            for (int e = 0; e < 4; ++e) { const h4 w = *(const h4*)(wg16 + (k0 + e) * 4); const float x = h[4 * j + e];
                l1[0] += x * (float)w[0]; l1[1] += x * (float)w[1]; l1[2] += x * (float)w[2]; l1[3] += x * (float)w[3]; }
        }
#pragma unroll
        for (int i = 0; i < 4; ++i) l1[i] = wave_sum(l1[i]) + brg[i];
        int grp = 0; float best = l1[0];
#pragma unroll
        for (int i = 1; i < 4; ++i) if (l1[i] > best) { best = l1[i]; grp = i; }
        float se = 0.f;
#pragma unroll
        for (int i = 0; i < 4; ++i) se += __expf(l1[i] - best);
        const float g1 = 1.f / se;
        float l2[8] = {};
        const _Float16* we = we16 + (size_t)grp * D * 8;
#pragma unroll
        for (int j = 0; j < 4; ++j) {
            const int k0 = (lane + 64 * j) * 4;
#pragma unroll
            for (int e = 0; e < 4; ++e) { const float x = h[4 * j + e]; const h8 w = *(const h8*)(we + (k0 + e) * 8);
#pragma unroll
                for (int q = 0; q < 8; ++q) l2[q] += x * (float)w[q]; }
        }
#pragma unroll
        for (int i = 0; i < 8; ++i) l2[i] = wave_sum(l2[i]) + bre[grp * 8 + i];
        int i0 = 0; float v0 = l2[0];
#pragma unroll
        for (int i = 1; i < 8; ++i) if (l2[i] > v0) { v0 = l2[i]; i0 = i; }
        int i1 = -1; float v1 = -3.0e38f;
#pragma unroll
        for (int i = 0; i < 8; ++i) if (i != i0 && l2[i] > v1) { v1 = l2[i]; i1 = i; }
        const float e1 = __expf(v1 - v0), inv = 1.f / (1.f + e1);
        if (lane == 0) {
            const int ea = grp * 8 + i0, eb = grp * 8 + i1;
            mb.tok_e[2 * m] = ea; mb.tok_e[2 * m + 1] = eb;
            mb.tok_g[2 * m] = g1 * inv; mb.tok_g[2 * m + 1] = g1 * e1 * inv;
            atomicAdd(&lcnt[ea], 1); atomicAdd(&lcnt[eb], 1);
        }
    }
    __syncthreads();
    if (wv == 0 && lane < 32) mb.bcnt[GB * 32 + lane] = lcnt[lane];
    __syncthreads();
}
__device__ __forceinline__ void moe_plan_ph(const int WID_, const MoeBufs& mb, char* lds) {
    if (GB != 0) return;
    int* tot = (int*)lds; int* off = tot + 32;
    const int t = WID_ * 64 + lane_id();
    if (t < 32) { int run = 0; for (int b = 0; b < GN; ++b) { const int c = __hip_atomic_load(mb.bcnt + b * 32 + t, __ATOMIC_RELAXED, __HIP_MEMORY_SCOPE_AGENT); mb.bbase[b * 32 + t] = run; run += c; } tot[t] = run; }
    __syncthreads();
    if (t == 0) { int o = 0, nt = 0;
        for (int e = 0; e < NEXP; ++e) { off[e] = o; mb.offs[e] = o; const int c = tot[e]; for (int r0 = 0; r0 < c; r0 += 256) { mb.tiles[nt] = e; ++nt; } o += ((c + 255) / 256) * 256; }
        *mb.ntiles = nt; }
    __syncthreads();
}
__device__ __forceinline__ void moe_scatter_ph(const int WID_, const MoeBufs& mb, char* lds) {
    const int lane = lane_id(), wv = WID_;
    int* cur = (int*)lds;
    if (wv == 0 && lane < 32) cur[lane] = __hip_atomic_load(mb.offs + lane, __ATOMIC_RELAXED, __HIP_MEMORY_SCOPE_AGENT) + __hip_atomic_load(mb.bbase + GB * 32 + lane, __ATOMIC_RELAXED, __HIP_MEMORY_SCOPE_AGENT);
    __syncthreads();
    for (int m0 = (GB * 8 + wv); m0 < M; m0 += GN * 8 * 32) {
        const int i = lane >> 1, m = m0 + i * GN * 8;
        if (m < M) { const int a = 2 * m + (lane & 1); const int e = mb.tok_e[a];
            const int pos = atomicAdd(&cur[e], 1);
            mb.slot_tok[pos] = m; mb.slot_gate[pos] = mb.tok_g[a]; mb.tok_slot[a] = pos; }
    }
    __syncthreads();
}
__device__ __forceinline__ void moe_gather_ph(const int WID_, const bf16* __restrict__ h3, bf16* __restrict__ xg, const MoeBufs& mb) {
    const int lane = lane_id(), wv = WID_;
    const int nrows = __hip_atomic_load(mb.ntiles, __ATOMIC_RELAXED, __HIP_MEMORY_SCOPE_AGENT) * 256;
    for (int r0 = (GB * 8 + wv) * 4; r0 < nrows; r0 += GN * 32) {
        uint4 a[4], c[4];
#pragma unroll
        for (int i = 0; i < 4; ++i) { const int t = mb.slot_tok[r0 + i]; const uint4* s = (const uint4*)(h3 + (size_t)t * D); a[i] = s[lane]; c[i] = s[lane + 64]; }
#pragma unroll
        for (int i = 0; i < 4; ++i) { uint4* d = (uint4*)(xg + (size_t)(r0 + i) * D); d[lane] = a[i]; d[lane + 64] = c[i]; }
    }
}
__device__ __forceinline__ void moe_weights_ph(const int WID_, const float* __restrict__ wg, const float* __restrict__ wu, const float* __restrict__ wd, bf16* __restrict__ wgu_t, bf16* __restrict__ wd_t, char* lds, int vb, int nvb) {
    const int lane = (WID_ * 64 + lane_id()) & 63, wv = (WID_ * 64 + lane_id()) >> 6;
    float* scr = (float*)(lds + wv * 16384);
    constexpr int I_GU = 16 * 16;
    constexpr int I_D = 8 * 32;
    constexpr int NIT = NEXP * (2 * I_GU + I_D);
    for (int it = vb * 8 + wv; it < NIT; it += nvb * 8) {
        const int e = it / (2 * I_GU + I_D); int r = it % (2 * I_GU + I_D);
        if (r < 2 * I_GU) {
            const int up = r / I_GU; r %= I_GU;
            const int kb = r / 16, nb = r % 16;
            const int pn = nb / 4, nsub = nb % 4;
            const float* W = (up ? wu : wg) + (size_t)e * D * DEXP + nb * 32;
            transpose_item(W + (size_t)kb * 64 * DEXP, 64, 32, wgu_t, D, e * 1024 + pn * 256 + up * 128 + nsub * 32, kb * 64, scr, 0, lane, nullptr, DEXP);
        } else {
            r -= 2 * I_GU;
            const int kb = r / 32, nb = r % 32;
            const float* W = wd + (size_t)e * DEXP * D + nb * 32;
            transpose_item(W + (size_t)kb * 64 * D, 64, 32, wd_t, DEXP, e * 1024 + nb * 32, kb * 64, scr, 0, lane, nullptr, D);
        }
    }
}
__device__ __forceinline__ void final_ph(const int WID_, float* __restrict__ out, const bf16* __restrict__ yslot, const int* __restrict__ tok_slot, const float* __restrict__ w) {
    const int lane = lane_id(), wv = WID_;
    float4 g[4];
#pragma unroll
    for (int j = 0; j < 4; ++j) g[j] = *(const float4*)(w + (lane + 64 * j) * 4);
    for (int row0 = (GB * 8 + wv) * 2; row0 < M; row0 += GN * 16) {
        float4 v[2][4]; uint2 ya[2][4], yb[2][4];
#pragma unroll
        for (int r = 0; r < 2; ++r) { const int row = row0 + r;
            const float4* xr = (const float4*)(out + (size_t)row * D);
            const uint2* pa = (const uint2*)(yslot + (size_t)tok_slot[2 * row] * D);
            const uint2* pb = (const uint2*)(yslot + (size_t)tok_slot[2 * row + 1] * D);
#pragma unroll
            for (int j = 0; j < 4; ++j) { v[r][j] = xr[lane + 64 * j]; ya[r][j] = pa[lane + 64 * j]; yb[r][j] = pb[lane + 64 * j]; } }
#pragma unroll
        for (int r = 0; r < 2; ++r) { float s = 0.f;
#pragma unroll
            for (int j = 0; j < 4; ++j) { const uint2 a = ya[r][j], b = yb[r][j];
                v[r][j].x += __builtin_bit_cast(float, a.x << 16) + __builtin_bit_cast(float, b.x << 16);
                v[r][j].y += __builtin_bit_cast(float, a.x & 0xffff0000u) + __builtin_bit_cast(float, b.x & 0xffff0000u);
                v[r][j].z += __builtin_bit_cast(float, a.y << 16) + __builtin_bit_cast(float, b.y << 16);
                v[r][j].w += __builtin_bit_cast(float, a.y & 0xffff0000u) + __builtin_bit_cast(float, b.y & 0xffff0000u);
                s += v[r][j].x * v[r][j].x + v[r][j].y * v[r][j].y + v[r][j].z * v[r][j].z + v[r][j].w * v[r][j].w; }
            s = wave_sum(s);
            const float rs = rsqrtf(s * (1.f / D) + 1e-6f);
            float4* xo = (float4*)(out + (size_t)(row0 + r) * D);
#pragma unroll
            for (int j = 0; j < 4; ++j) xo[lane + 64 * j] = make_float4(v[r][j].x * rs * g[j].x, v[r][j].y * rs * g[j].y, v[r][j].z * rs * g[j].z, v[r][j].w * rs * g[j].w); }
    }
}

struct S5Tab { float* Kmat; bf16* BtA; bf16* BtB; };
__device__ __forceinline__ void s5_lam(const float* lam_re, const float* lam_im, const float* log_dt, int g, int n, float& a, float& w) {
    const float dt = __expf(log_dt[g]); a = lam_re[g * 64 + n] * dt; w = lam_im[g * 64 + n] * dt;
}
__device__ __forceinline__ void cexpj(float a, float w, float j, float& re, float& im) { const float e = __expf(a * j); float s, c; sincosf(w * j, &s, &c); re = e * c; im = e * s; }
__device__ __forceinline__ void s5_bbar(const float* lam_re, const float* lam_im, const float* log_dt, const float* b_re, const float* b_im, int g, int n, int h, float& br, float& bi) {
    float a, w; s5_lam(lam_re, lam_im, log_dt, g, n, a, w);
    float lbr, lbi; cexpj(a, w, 1.f, lbr, lbi);
    const float lr = lam_re[g * 64 + n], li = lam_im[g * 64 + n];
    const float nr = lbr - 1.f, ni = lbi, den = lr * lr + li * li;
    const float cr = (nr * lr + ni * li) / den, ci = (ni * lr - nr * li) / den;
    const float xr = b_re[(g * 64 + n) * 16 + h], xi = b_im[(g * 64 + n) * 16 + h];
    br = cr * xr - ci * xi; bi = cr * xi + ci * xr;
}
__device__ __forceinline__ void s5_tables0_ph(const int WID_, const float* lam_re, const float* lam_im, const float* log_dt, const float* b_re, const float* b_im, const float* c_re, const float* c_im, const S5Tab& T) {
    const int gtid = GB * NT + (WID_ * 64 + lane_id()), gsz = GN * NT;
    for (int i = gtid; i < 32 * 32 * 256; i += gsz) {
        const int h = i & 15, hp = (i >> 4) & 15, j = (i >> 8) & 31, g = i >> 13;
        float acc = 0.f;
        for (int n = 0; n < 64; ++n) {
            float a, w; s5_lam(lam_re, lam_im, log_dt, g, n, a, w);
            float pr, pi; cexpj(a, w, (float)j, pr, pi);
            float br, bi; s5_bbar(lam_re, lam_im, log_dt, b_re, b_im, g, n, h, br, bi);
            const float tr = pr * br - pi * bi, ti = pr * bi + pi * br;
            acc += c_re[(g * 16 + hp) * 64 + n] * tr - c_im[(g * 16 + hp) * 64 + n] * ti;
        }
        T.Kmat[i] = acc;
    }
    for (int i = gtid; i < 32 * 256 * 512; i += gsz) {
        const int col = i & 511, r = (i >> 9) & 255, g = i >> 17;
        float v = 0.f;
        if (r < 128) {
            const int n = r & 63, s = col >> 4, h = col & 15;
            float a, w; s5_lam(lam_re, lam_im, log_dt, g, n, a, w);
            float pr, pi; cexpj(a, w, (float)(S5L - 1 - s), pr, pi);
            float br, bi; s5_bbar(lam_re, lam_im, log_dt, b_re, b_im, g, n, h, br, bi);
            v = (r < 64) ? (pr * br - pi * bi) : (pr * bi + pi * br);
        }
        T.BtA[((size_t)g * 768 + 512 + r) * 512 + col] = f2bf(v);
    }
    for (int i = gtid; i < 32 * 512 * 256; i += gsz) {
        const int k = i & 255, row = (i >> 8) & 511, g = i >> 17;
        float v = 0.f;
        if (k < 128) {
            const int n = k & 63, sp = row >> 4, hp = row & 15;
            float a, w; s5_lam(lam_re, lam_im, log_dt, g, n, a, w);
            float pr, pi; cexpj(a, w, (float)(sp + 1), pr, pi);
            const float cr = c_re[(g * 16 + hp) * 64 + n], ci = c_im[(g * 16 + hp) * 64 + n];
            v = (k < 64) ? (cr * pr - ci * pi) : -(cr * pi + ci * pr);
        }
        T.BtB[i] = f2bf(v);
    }
}
__device__ __forceinline__ void s5_tables1_ph(const int WID_, const float* dsk, const S5Tab& T) {
    const int gtid = GB * NT + (WID_ * 64 + lane_id()), gsz = GN * NT;
    for (int i = gtid; i < 32 * 512 * 512; i += gsz) {
        const int col = i & 511, row = (i >> 9) & 511, g = i >> 18;
        const int sp = row >> 4, hp = row & 15, s = col >> 4, h = col & 15;
        float v = 0.f;
        if (s <= sp) v = T.Kmat[((g * 32 + (sp - s)) * 16 + hp) * 16 + h];
        if (row == col) v += dsk[g * 16 + hp];
        T.BtA[((size_t)g * 768 + row) * 512 + col] = f2bf(v);
    }
}
__device__ __forceinline__ void s5_carry_ph(const int WID_, const float* lam_re, const float* lam_im, const float* log_dt, const float* __restrict__ F, bf16* __restrict__ XST, int vb, int nvb, char* lds) {
    float* TR = (float*)lds; float* TI = TR + 16 * 32;
    for (int item = vb; item < NB * 32 * 2; item += nvb) {
        const int lane = lane_id(), tid = WID_ * 64 + lane;
        const int nh = item & 1, g = (item >> 1) & 31, b = item >> 6, seg = tid >> 5, n = nh * 32 + (tid & 31);
        float a, w; s5_lam(lam_re, lam_im, log_dt, g, n, a, w);
        float pr, pi; cexpj(a, w, (float)S5L, pr, pi);
        const size_t row0 = (size_t)g * S5R + (size_t)b * (S / S5L) + seg * 16;
        const float* f = F + row0 * 128; bf16* xo = XST + row0 * 256;
        float fr[16], fi[16];
#pragma unroll
        for (int q = 0; q < 16; ++q) { fr[q] = f[(size_t)q * 128 + n]; fi[q] = f[(size_t)q * 128 + 64 + n]; }
#pragma unroll
        for (int q = 0; q < 16; ++q) if (nh == 0) *(uint2*)(xo + (size_t)q * 256 + 128 + (tid & 31) * 4) = make_uint2(0, 0);
        float xr = 0.f, xi = 0.f;
#pragma unroll
        for (int q = 0; q < 16; ++q) { const float nr = pr * xr - pi * xi + fr[q], ni = pr * xi + pi * xr + fi[q]; xr = nr; xi = ni; fr[q] = nr; fi[q] = ni; }
        TR[seg * 32 + (tid & 31)] = xr; TI[seg * 32 + (tid & 31)] = xi;
        __syncthreads();
        float p16r, p16i; cexpj(a, w, (float)(S5L * 16), p16r, p16i);
        float cr = 0.f, ci = 0.f;
        for (int s2 = 0; s2 < seg; ++s2) { const float tr = TR[s2 * 32 + (tid & 31)], ti = TI[s2 * 32 + (tid & 31)];
            const float nr = p16r * cr - p16i * ci + tr, ni = p16r * ci + p16i * cr + ti; cr = nr; ci = ni; }
        float er = cr, ei = ci;
#pragma unroll
        for (int q = 0; q < 16; ++q) {
            const float lr_ = (q > 0) ? fr[q - 1] : 0.f, li_ = (q > 0) ? fi[q - 1] : 0.f;
            xo[(size_t)q * 256 + n] = f2bf(er + lr_); xo[(size_t)q * 256 + 64 + n] = f2bf(ei + li_);
            const float nr = pr * er - pi * ei, ni = pr * ei + pi * er; er = nr; ei = ni;
        }
        __syncthreads();
    }
}
#define XB_TMO      128
#define XB_XCNT(j)  (256  + 64 * (j))
#define XB_XSUB(j)  (1280 + 64 * (j))
#define XB_XGEN(j)  (2304 + 64 * (j))
#define XB_TOP      3328
#define XB_TOPGEN   3392
#define XCD_BAR_WORDS 3456
#define XB_SPIN_CAP (1u << 20)
__device__ __forceinline__ unsigned xb_ld(unsigned* p)              { return __hip_atomic_load(p, __ATOMIC_RELAXED, __HIP_MEMORY_SCOPE_AGENT); }
__device__ __forceinline__ unsigned xb_add(unsigned* p, unsigned v) { return __hip_atomic_fetch_add(p, v, __ATOMIC_RELAXED, __HIP_MEMORY_SCOPE_AGENT); }
__device__ __forceinline__ unsigned xb_xcc_id() { return (unsigned)__builtin_amdgcn_s_getreg((3 << 11) | 20) & 0xFu; }
#define XB_SPIN(cond, bar) do { unsigned _sp = 0; while (cond) { __builtin_amdgcn_s_sleep(1); \
    if ((++_sp & 255u) == 0u) { if (xb_ld(&(bar)[XB_TMO])) break; if (_sp > XB_SPIN_CAP) { atomicAdd(&(bar)[XB_TMO], 1u); break; } } } } while (0)
struct XcdBarrier { unsigned* bar; unsigned x; volatile __attribute__((address_space(3))) unsigned* st; };
__device__ __forceinline__ XcdBarrier xcd_barrier_post(const int WID_, unsigned* bar, volatile __attribute__((address_space(3))) unsigned* st) {
    XcdBarrier b; b.bar = bar; b.x = xb_xcc_id(); b.st = st;
    if ((WID_ * 64 + lane_id()) == 0) (void)xb_add(&bar[XB_XCNT(b.x)], 1u);
    return b;
}
__device__ __forceinline__ void xcd_barrier_complete(unsigned* bar, unsigned x, unsigned& nloc, unsigned& nx) {
    const unsigned G = gridDim.x * gridDim.y * gridDim.z;
    unsigned sum, cnt, mine, sp = 0u;
    for (;;) {
        sum = 0u; cnt = 0u; mine = 0u;
#pragma unroll
        for (unsigned j = 0; j < 16; ++j) { const unsigned c = xb_ld(&bar[XB_XCNT(j)]); sum += c; cnt += (c > 0u) ? 1u : 0u; mine = (j == x) ? c : mine; }
        if (sum == G) break;
        __builtin_amdgcn_s_sleep(1);
        if ((++sp & 255u) == 0u) { if (xb_ld(&bar[XB_TMO])) break; if (sp > XB_SPIN_CAP) { atomicAdd(&bar[XB_TMO], 1u); break; } }
    }
    nloc = mine > 0u ? mine : 1u; nx = cnt > 0u ? cnt : 1u;
}
__device__ __forceinline__ void xcd_barrier(const int WID_, const XcdBarrier& b) {
    asm volatile("s_waitcnt vmcnt(0)" ::: "memory");
    __syncthreads();
    if ((WID_ * 64 + lane_id()) == 0) {
        unsigned* bar = b.bar;
        __builtin_amdgcn_s_waitcnt(0);
        unsigned nloc = b.st[0], nx = b.st[1];
        if (nloc == 0u) { xcd_barrier_complete(bar, b.x, nloc, nx); b.st[0] = nloc; b.st[1] = nx; }
        const unsigned old = xb_add(&bar[XB_XSUB(b.x)], 1u);
        const unsigned gen = old / nloc;
        if (old + 1u == (gen + 1u) * nloc) {
            __builtin_amdgcn_fence(__ATOMIC_RELEASE, "agent");
            asm volatile("s_waitcnt vmcnt(0)" ::: "memory");
            const unsigned og = xb_add(&bar[XB_TOP], 1u);
            const unsigned tg = og / nx;
            if (og + 1u == (tg + 1u) * nx) xb_add(&bar[XB_TOPGEN], 1u);
            else XB_SPIN(xb_ld(&bar[XB_TOPGEN]) == tg, bar);
            __builtin_amdgcn_fence(__ATOMIC_ACQUIRE, "agent");
            xb_add(&bar[XB_XGEN(b.x)], 1u);
            asm volatile("s_waitcnt vmcnt(0)" ::: "memory");
        } else {
            XB_SPIN(xb_ld(&bar[XB_XGEN(b.x)]) == gen, bar);
            __builtin_amdgcn_fence(__ATOMIC_ACQUIRE, "agent");
            asm volatile("s_waitcnt vmcnt(0)" ::: "memory");
        }
    }
    __syncthreads();
}

struct Params { const float* in[41]; float* out; char* ws; };

constexpr size_t W_PROJ = 0;
constexpr size_t W_US5 = 224;
constexpr size_t W_WTS = 288;
constexpr size_t W_YI = 352;
constexpr size_t W_F = 416;
constexpr size_t W_XST = 448;
constexpr size_t W_Z = 480;
constexpr size_t W_MISC = 544;
constexpr size_t W_XN = 576;
constexpr size_t W_CTL = 558;
constexpr size_t WO_IN = 0, WO_GLU = 5 * MiB, WO_MIX = 6 * MiB, WO_Q = 8 * MiB, WO_K = 10 * MiB, WO_V = 12 * MiB, WO_O = 14 * MiB, WO_KMAT = 16 * MiB, WO_BTA = 17 * MiB, WO_BTB = 41 * MiB;

__global__ void __launch_bounds__(NT, 2) fwd_kernel(Params p) {
    extern __shared__ __attribute__((aligned(16))) char lds[];
    const int WID_ = __builtin_amdgcn_readfirstlane((int)(threadIdx.x >> 6));
    cg::grid_group grid = cg::this_grid();
    PG8_LAS unsigned char* ldsl = (PG8_LAS unsigned char*)lds;
    char* ws = p.ws; char* dout = (char*)p.out; float* out = p.out;
#define IN(i) (p.in[i])
    volatile __attribute__((address_space(3))) unsigned* bst = (volatile __attribute__((address_space(3))) unsigned*)(ldsl + LDS_BYTES - 64);
    if (WID_ == 0 && lane_id() < 2) bst[lane_id()] = 0u;
    __syncthreads();
    const XcdBarrier xbar = xcd_barrier_post(WID_, (unsigned*)(ws + W_CTL * MiB), bst);
#ifndef PROBE_PHASE
#define PROBE_PHASE -1
#endif
    int sync_id = 0; unsigned long long pr_t0 = 0, pr_t1 = 0;
    if (PROBE_PHASE == 0) pr_t0 = __builtin_amdgcn_s_memrealtime();
#define SYNC() do { xcd_barrier(WID_, xbar); ++sync_id; if (sync_id == PROBE_PHASE) pr_t0 = __builtin_amdgcn_s_memrealtime(); if (sync_id == PROBE_PHASE + 1) pr_t1 = __builtin_amdgcn_s_memrealtime(); } while (0)
    char* WT = ws + W_WTS * MiB;
    bf16* w_in_t = (bf16*)(WT + WO_IN); bf16* w_glu_t = (bf16*)(WT + WO_GLU); bf16* w_mix_t = (bf16*)(WT + WO_MIX);
    bf16* w_q_t = (bf16*)(WT + WO_Q); bf16* w_k_t = (bf16*)(WT + WO_K); bf16* w_v_t = (bf16*)(WT + WO_V); bf16* w_o_t = (bf16*)(WT + WO_O);
    S5Tab stab; stab.Kmat = (float*)(WT + WO_KMAT); stab.BtA = (bf16*)(WT + WO_BTA); stab.BtB = (bf16*)(WT + WO_BTB);
    bf16* PROJ = (bf16*)(ws + W_PROJ * MiB); bf16* US5 = (bf16*)(ws + W_US5 * MiB);
    bf16* XN = (bf16*)(ws + W_XN * MiB);
    transpose_ph(WID_, IN(3), D, DIN, w_in_t, D, 0, 0, lds);
    transpose_ph(WID_, IN(23), 512, 512, w_glu_t, 512, 0, 0, lds);
    transpose_ph(WID_, IN(25), D, D, w_mix_t, D, 0, 0, lds);
    transpose_ph(WID_, IN(28), D, D, w_q_t, D, 0, 0, lds);
    transpose_ph(WID_, IN(29), D, D, w_k_t, D, 0, 0, lds);
    transpose_ph(WID_, IN(30), D, D, w_v_t, D, 0, 0, lds);
    transpose_ph(WID_, IN(31), D, D, w_o_t, D, 0, 0, lds);
    s5_tables0_ph(WID_, IN(15), IN(16), IN(17), IN(18), IN(19), IN(20), IN(21), stab);
    bf16* wl_t = (bf16*)(WT + 49 * MiB);
    rwkv_wl_ph(WID_, IN(6), IN(8), IN(9), wl_t);
    rmsnorm_ph<bf16>(WID_, IN(0), IN(2), XN, M);
    grid.sync(); ++sync_id; if (sync_id == PROBE_PHASE) pr_t0 = __builtin_amdgcn_s_memrealtime(); if (sync_id == PROBE_PHASE + 1) pr_t1 = __builtin_amdgcn_s_memrealtime();
    s5_tables1_ph(WID_, IN(22), stab);
    { pg8::PlainOrder S; S.init(XN, D, w_in_t, D, M, DIN, D); pg8::EpiProj E{PROJ, US5}; pg8::gemm_phase(WID_, ldsl, S, E); }
    SYNC();
    bf16* LIN = (bf16*)(ws + (W_MISC + 16) * MiB);
    rwkv_lin_ph(WID_, PROJ, IN(4), LIN);
    SYNC();
    bf16* YI = (bf16*)(ws + W_YI * MiB); float* F = (float*)(ws + W_F * MiB); bf16* XST = (bf16*)(ws + W_XST * MiB); bf16* Z = (bf16*)(ws + W_Z * MiB);
    bf16* LWb = (bf16*)(ws + 704 * MiB); bf16* AAb = (bf16*)(ws + 768 * MiB); bf16* Gb = (bf16*)(ws + 832 * MiB);
    float* Yr = (float*)(ws + 896 * MiB); float* RKb = (float*)(ws + W_MISC * MiB);
    { pg8::GroupOrder S; S.init(US5, 512, (size_t)S5R * 512, stab.BtA, 512, (size_t)768 * 512, 32, S5R, 768, 512); pg8::EpiS5a E{YI, F}; pg8::gemm_phase(WID_, ldsl, S, E); }
    { pg8::PlainOrder S; S.init(LIN, 256, wl_t, 256, M, 1536, 256); pg8::EpiLora E{LWb, (size_t)32 * MiB, IN(5), IN(7)}; pg8::gemm_phase(WID_, ldsl, S, E); }
    SYNC();
    { ck::In ci{PROJ, LWb, AAb, IN(4), IN(10), IN(11), IN(12), RKb, dout}; ck::phase1(WID_, ci, lds); }
    SYNC();
    bf16* WGU_t = (bf16*)(ws + 704 * MiB); bf16* WD_t = (bf16*)(ws + 768 * MiB);
    ck::phase2(WID_, dout, Yr, lds);
    __syncthreads();
    s5_carry_ph(WID_, IN(15), IN(16), IN(17), F, XST, GB, GN, lds);
    moe_weights_ph(WID_, IN(37), IN(38), IN(39), WGU_t, WD_t, lds, GB, GN);
    SYNC();
    bf16* YMIX = XN;
    { pg8::GroupOrder S; S.init(XST, 256, (size_t)S5R * 256, stab.BtB, 256, (size_t)512 * 256, 32, S5R, 512, 256); pg8::EpiS5b E{YI, Z}; pg8::gemm_phase(WID_, ldsl, S, E); }
    rwkv_post_ph(WID_, Yr, RKb, PROJ, IN(4), Gb, IN(13), IN(14), YMIX);
    SYNC();
    { pg8::PlainOrder S; S.init(Z, 512, w_glu_t, 512, M, 512, 512); pg8::EpiGlu E{Z, IN(24), YMIX}; pg8::gemm_phase(WID_, ldsl, S, E); }
    SYNC();
    { pg8::PlainOrder S; S.init(YMIX, D, w_mix_t, D, M, D, D); pg8::EpiF32 E{out, D, IN(0), D}; pg8::gemm_phase(WID_, ldsl, S, E); }
    SYNC();
    bf16* KM = (bf16*)(ws + (W_MISC + 2) * MiB); bf16* VT = (bf16*)(ws + (W_MISC + 6) * MiB); bf16* MEMN = (bf16*)(ws + (W_MISC + 10) * MiB);
    rmsnorm_ph<bf16>(WID_, out, IN(26), XN, M);
    rmsnorm_ph<bf16>(WID_, IN(1), IN(27), MEMN, NB * NMEM);
    SYNC();
    bf16* Q = (bf16*)(ws + 128 * MiB);
    { pg8::PlainOrder S; S.init(MEMN, D, w_k_t, D, NB * NMEM, D, D); pg8::EpiBf16 E{KM, D}; pg8::gemm_phase(WID_, ldsl, S, E); }
    { pg8::PlainOrder S; S.init(w_v_t, D, MEMN, D, D, NB * NMEM, D); pg8::EpiBf16 E{VT, NB * NMEM}; pg8::gemm_phase(WID_, ldsl, S, E); }
    { pg8::PlainOrder S; S.init(XN, D, w_q_t, D, M, D, D); pg8::EpiBf16 E{Q, D}; pg8::gemm_phase(WID_, ldsl, S, E); }
    SYNC();
    bf16* P = (bf16*)(ws + W_YI * MiB);
    { pg8::AttnOrder S; S.init(Q, KM, D, 0); pg8::EpiSoftmax E{P, (PG8_LAS float*)(ldsl + 131072)}; pg8::gemm_phase(WID_, ldsl, S, E); }
    SYNC();
    bf16* O = XN;
    { pg8::AttnOrder S; S.init(P, VT, NB * NMEM, 1); pg8::EpiAttnO E{O}; pg8::gemm_phase(WID_, ldsl, S, E); }
    SYNC();
    { pg8::PlainOrder S; S.init(O, D, w_o_t, D, M, D, D); pg8::EpiF32 E{out, D, out, D}; pg8::gemm_phase(WID_, ldsl, S, E); }
    SYNC();
    bf16* H3 = XN;
    bf16* XG = (bf16*)(ws + 0);
    bf16* HID = (bf16*)(ws + 368 * MiB);
    bf16* YSLOT = (bf16*)(ws + 0);
    MoeBufs mb; char* mbase = ws + 976 * MiB;
    mb.tok_e = (int*)(mbase); mb.tok_g = (float*)(mbase + 1 * MiB); mb.tok_slot = (int*)(mbase + 2 * MiB); mb.slot_tok = (int*)(mbase + 3 * MiB);
    mb.slot_gate = (float*)(mbase + 4 * MiB); mb.bcnt = (int*)(mbase + 5 * MiB); mb.bbase = mb.bcnt + 16384; mb.offs = mb.bcnt + 32768; mb.ntiles = mb.offs + 64;
    mb.tiles = (int*)(mbase + 6 * MiB);
    moe_zero_ph(WID_, mb);
    router_ph(WID_, out, IN(32), H3, IN(33), IN(34), IN(35), IN(36), mb, lds);
    SYNC();
    moe_plan_ph(WID_, mb, lds);
    SYNC();
    moe_scatter_ph(WID_, mb, lds);
    SYNC();
    const int ntiles = __hip_atomic_load(mb.ntiles, __ATOMIC_RELAXED, __HIP_MEMORY_SCOPE_AGENT);
    { pg8::MoeOrderT<true> S; S.init(H3, D, WGU_t, D, D, mb.tiles, ntiles, 1024, mb.slot_tok); pg8::EpiSilu E{HID}; pg8::gemm_phase(WID_, ldsl, S, E); }
    SYNC();
    { pg8::MoeOrderT<false> S; S.init(HID, DEXP, WD_t, DEXP, DEXP, mb.tiles, ntiles, 1024, nullptr); pg8::EpiGate E{YSLOT, mb.slot_gate}; pg8::gemm_phase(WID_, ldsl, S, E); }
    SYNC();
    final_ph(WID_, out, YSLOT, mb.tok_slot, IN(40));
    if (PROBE_PHASE >= 0) {
        if (pr_t1 == 0) pr_t1 = __builtin_amdgcn_s_memrealtime();
        if (GB == 0) { const unsigned long long t_end = __builtin_amdgcn_s_memrealtime(), wait = 8ull * (pr_t1 - pr_t0);
            while (__builtin_amdgcn_s_memrealtime() - t_end < wait) __builtin_amdgcn_s_sleep(8); }
    }
}
}

extern "C" void kernel_launch(void* const* d_in, const int* in_sizes, int n_in, void* d_out, int out_size, void* d_ws, size_t ws_size, hipStream_t stream) {
    (void)in_sizes; (void)out_size; (void)ws_size;
    static int grid = 0;
    if (grid == 0) {
        int dev = 0, cus = 0, per_cu = 0;
        hipGetDevice(&dev);
        hipDeviceGetAttribute(&cus, hipDeviceAttributeMultiprocessorCount, dev);
        hipFuncSetAttribute((const void*)fwd_kernel, hipFuncAttributeMaxDynamicSharedMemorySize, LDS_BYTES);
        hipOccupancyMaxActiveBlocksPerMultiprocessor(&per_cu, (const void*)fwd_kernel, NT, LDS_BYTES);
        if (per_cu < 1) { fprintf(stderr, "occupancy query says %d blocks/CU\n", per_cu); per_cu = 1; }
        grid = cus * 1;
    }
    (void)hipMemsetAsync((char*)d_ws + W_CTL * MiB, 0, 16384, stream);
    Params p{};
    for (int i = 0; i < 41 && i < n_in; ++i) p.in[i] = (const float*)d_in[i];
    p.out = (float*)d_out; p.ws = (char*)d_ws;
    void* args[] = {&p};
    hipError_t e = hipLaunchCooperativeKernel((const void*)fwd_kernel, dim3(grid), dim3(NT), args, LDS_BYTES, stream);
    if (e != hipSuccess) fprintf(stderr, "cooperative launch failed: %s (grid %d)\n", hipGetErrorString(e), grid);
}
```

```cpp
#include <hip/hip_runtime.h>
#include <hip/hip_cooperative_groups.h>
#include <stdint.h>
#include <cstdio>
namespace cg = cooperative_groups;

namespace {
constexpr int NB = 8, S = 8192, D = 1024, M = NB * S;
constexpr int DR = 512, DSHIFT = 1792, DIN = 2304, NMEM = 256;
constexpr int NEXP = 32, DEXP = 512, NASSIGN = 2 * M;
constexpr size_t MiB = 1u << 20;
constexpr int NT = 512;
constexpr int S5L = 32, S5R = M / S5L;
constexpr int LDS_BYTES = 147456;
#define GB ((int)blockIdx.x)
#define GN ((int)gridDim.x)

typedef unsigned short bf16;
typedef float f32x2h __attribute__((ext_vector_type(2)));
typedef __bf16 bf16x2h __attribute__((ext_vector_type(2)));
__device__ __forceinline__ unsigned pk2(float lo, float hi) { const f32x2h v = {lo, hi}; const bf16x2h b = __builtin_convertvector(v, bf16x2h); return __builtin_bit_cast(unsigned, b); }
__device__ __forceinline__ bf16 f2bf(float f) { return (bf16)(pk2(f, f) & 0xffffu); }
__device__ __forceinline__ int lane_id() { int l = (int)__builtin_amdgcn_mbcnt_hi(~0u, __builtin_amdgcn_mbcnt_lo(~0u, 0u)); asm volatile("" : "+v"(l)); return l; }
__device__ __forceinline__ float bf2f(bf16 h) { return __builtin_bit_cast(float, (unsigned)h << 16); }

template <typename T> __device__ __forceinline__ float ldf(const T* p);
template <> __device__ __forceinline__ float ldf<float>(const float* p) { return *p; }
template <> __device__ __forceinline__ float ldf<bf16>(const bf16* p) { return bf2f(*p); }
template <typename T> __device__ __forceinline__ void stf(T* p, float v);
template <> __device__ __forceinline__ void stf<float>(float* p, float v) { *p = v; }
template <> __device__ __forceinline__ void stf<bf16>(bf16* p, float v) { *p = f2bf(v); }

template <int CTRL, int ROWMASK> __device__ __forceinline__ float dppf_(float x) { return __builtin_bit_cast(float, __builtin_amdgcn_update_dpp(0, __builtin_bit_cast(int, x), CTRL, ROWMASK, 0xf, false)); }
__device__ __forceinline__ float wave_sum(float v) {
    v += dppf_<0xB1, 0xf>(v); v += dppf_<0x4E, 0xf>(v); v += dppf_<0x141, 0xf>(v); v += dppf_<0x140, 0xf>(v);
    v += dppf_<0x142, 0xa>(v);
    v += dppf_<0x143, 0xc>(v);
    return __builtin_bit_cast(float, __builtin_amdgcn_readlane(__builtin_bit_cast(int, v), 63));
}
__device__ __forceinline__ float sigmoidf_(float x) { return 1.f / (1.f + __expf(-x)); }


__device__ __forceinline__ float gelu_tanh(float x) { return x * sigmoidf_(1.5957691216057308f * (x + 0.044715f * x * x * x)); }

namespace pg8 {
#define PG8_LAS __attribute__((address_space(3)))
typedef short bf16x8 __attribute__((ext_vector_type(8)));
typedef float f32x4 __attribute__((ext_vector_type(4)));
typedef unsigned u32x4 __attribute__((ext_vector_type(4)));
constexpr int BM = 256, BK = 64, HALF = 128, HTB = HALF * BK * 2, STAGE_BYTES = 8 * HTB, NXCD = 8, WGM = 8;
__device__ __forceinline__ int lds_byte(int r, int c) { const int st = (r >> 4) * 2 + (c >> 5), rr = r & 15, cc = c & 31, ob = rr * 64 + cc * 2; return st * 1024 + (ob ^ (((ob >> 9) & 1) << 5)); }
__device__ __forceinline__ void stage_rc(int b, int& R, int& C) { const int st = b / 1024, sb = b % 1024, swz = sb ^ (((sb >> 9) & 1) << 5); R = (st >> 1) * 16 + swz / 64; C = (st & 1) * 32 + (swz % 64) / 2; }
__device__ __forceinline__ int perm32(int rho) { const int n = rho >> 4, i = rho & 15; return 8 * (i >> 2) + 4 * n + (i & 3); }
struct Unit { int pm, pn; };
struct PlainOrder {
    static constexpr bool GATHER = false; __device__ __forceinline__ int grow(const Unit&, int) const { return 0; }
    const bf16* A; const bf16* Bt; int lda, ldb, K; int nM, nN, nwg, G, c;
    __device__ void init(const bf16* A_, int lda_, const bf16* Bt_, int ldb_, int M, int N, int K_) { A = A_; Bt = Bt_; lda = lda_; ldb = ldb_; K = K_; nM = M / BM; nN = N / BM; nwg = nM * nN; G = GN; c = GB; }
    __device__ bool next(int i, Unit& u) const {
        const long L = (long)i * G + c; if (L >= nwg) return false;
        int wgid = (int)L; { const int q = nwg / NXCD, r = nwg % NXCD, xcd = wgid % NXCD, off = wgid / NXCD; wgid = (xcd < r ? xcd * (q + 1) : r * (q + 1) + (xcd - r) * q) + off; }
        const int nig = WGM * nN, gid = wgid / nig, fm = gid * WGM, gsz = (nM - fm) < WGM ? (nM - fm) : WGM;
        u.pm = fm + ((wgid % nig) % gsz); u.pn = (wgid % nig) / gsz; return true;
    }
    __device__ __forceinline__ const char* aptr(const Unit& u) const { return (const char*)(A + (size_t)u.pm * BM * lda); }
    __device__ __forceinline__ const char* bptr(const Unit& u) const { return (const char*)(Bt + (size_t)u.pn * BM * ldb); }
};
typedef float f32x2c __attribute__((ext_vector_type(2)));
typedef __bf16 bf16x2c __attribute__((ext_vector_type(2)));
__device__ __forceinline__ unsigned cvt_pk_bf16(float lo, float hi) { const f32x2c v = {lo, hi}; const bf16x2c b = __builtin_convertvector(v, bf16x2c); return __builtin_bit_cast(unsigned, b); }

template <class Epi, class Sched>
__device__ __forceinline__ void gemm_phase(const int WID_, PG8_LAS unsigned char* lds, const Sched& S, const Epi& E) {
    const int tid = (WID_ * 64 + lane_id()), wid = __builtin_amdgcn_readfirstlane(tid >> 6), lane = tid & 63, wr = wid >> 2, wc = wid & 3, fr = lane & 15, fq = lane >> 4;
    const int K = S.K, nt = K / BK;
    unsigned voffA[2], voffB[2];
#pragma unroll
    for (int i = 0; i < 2; ++i) { int R, C; stage_rc(tid * 16 + i * 8192, R, C); const int Rb = Epi::PERM ? ((R & ~31) + perm32(R & 31)) : R;
        voffA[i] = (unsigned)(R * S.lda + C) * 2u; voffB[i] = (unsigned)(Rb * S.ldb + C) * 2u; }
    constexpr bool GA = Sched::GATHER;
    int gR[2], gC[2];
#pragma unroll
    for (int i = 0; i < 2; ++i) stage_rc(tid * 16 + i * 8192, gR[i], gC[i]);
    unsigned vgc[2][2] = {{0u, 0u}, {0u, 0u}}, vgn[2][2] = {{0u, 0u}, {0u, 0u}};
#define PG8_GOFF(dst, u) do { if constexpr (GA) { _Pragma("unroll") for (int h_ = 0; h_ < 2; ++h_) _Pragma("unroll") for (int i_ = 0; i_ < 2; ++i_) \
        dst[h_][i_] = (unsigned)(S.grow(u, h_ * HALF + gR[i_]) * S.lda + gC[i_]) * 2u; } } while (0)
    const size_t kstep = (size_t)(BK * 2);
    const size_t hstepA = GA ? 0 : (size_t)HALF * S.lda * 2, hstepB = (size_t)HALF * S.ldb * 2;
    const unsigned ldsw = (unsigned)wid * 1024u;
    const int aoff = lds_byte(wr * 64 + fr, fq * 8), boff = lds_byte(wc * 32 + fr, fq * 8);
#define PG8_SA(b, h) (((b) * 2 + (h)) * HTB)
#define PG8_SB(b, h) ((4 + (b) * 2 + (h)) * HTB)
#define PG8_STAGE(bufoff, gbase, voff) do { _Pragma("unroll") for (int _i = 0; _i < 2; ++_i) \
        __builtin_amdgcn_global_load_lds((const unsigned*)((const char*)(gbase) + (voff)[_i]), (PG8_LAS unsigned*)(lds + (bufoff) + ldsw + _i * 8192), 16, 0, 0); } while (0)
#define PG8_STAGE_A(bufoff, gbase, h, nx) do { _Pragma("unroll") for (int _i = 0; _i < 2; ++_i) { \
        const unsigned vo_ = GA ? ((nx) ? vgn[h][_i] : vgc[h][_i]) : voffA[_i]; \
        __builtin_amdgcn_global_load_lds((const unsigned*)((const char*)(gbase) + vo_), (PG8_LAS unsigned*)(lds + (bufoff) + ldsw + _i * 8192), 16, 0, 0); } } while (0)
#define PG8_LDA(dst, b, h) do { _Pragma("unroll") for (int m = 0; m < 4; ++m) _Pragma("unroll") for (int k = 0; k < 2; ++k) dst[m][k] = *(const PG8_LAS bf16x8*)(lds + PG8_SA(b, h) + aoff + m * 2048 + k * 1024); } while (0)
#define PG8_LDB(dst, b, h) do { _Pragma("unroll") for (int n = 0; n < 2; ++n) _Pragma("unroll") for (int k = 0; k < 2; ++k) dst[n][k] = *(const PG8_LAS bf16x8*)(lds + PG8_SB(b, h) + boff + n * 2048 + k * 1024); } while (0)
#define PG8_MMA(ai, bj, At, Bt) do { __builtin_amdgcn_s_setprio(1); _Pragma("unroll") for (int m = 0; m < 4; ++m) _Pragma("unroll") for (int n = 0; n < 2; ++n) _Pragma("unroll") for (int k = 0; k < 2; ++k) \
        acc[ai][bj][m][n] = __builtin_amdgcn_mfma_f32_16x16x32_bf16(Bt[n][k], At[m][k], acc[ai][bj][m][n], 0, 0, 0); __builtin_amdgcn_s_setprio(0); } while (0)
#define PG8_WAIT_V(n) asm volatile("s_waitcnt vmcnt(" #n ")" ::: "memory")
#define PG8_WAIT_L(n) asm volatile("s_waitcnt lgkmcnt(" #n ")" ::: "memory")
#define PG8_BAR __builtin_amdgcn_s_barrier()
#define PG8_SCHED __builtin_amdgcn_sched_barrier(0)
    Unit cur, nxt; int ui = 0;
    if (!S.next(0, cur)) return;
    f32x4 acc[2][2][4][2];
#pragma unroll
    for (int a = 0; a < 2; ++a)
#pragma unroll
        for (int b = 0; b < 2; ++b)
#pragma unroll
            for (int m = 0; m < 4; ++m)
#pragma unroll
                for (int n = 0; n < 2; ++n) acc[a][b][m][n] = (f32x4){0.f, 0.f, 0.f, 0.f};
    bf16x8 At[4][2], B0[2][2], B1[2][2];
    const char* cA = S.aptr(cur); const char* cB = S.bptr(cur);
    PG8_STAGE(PG8_SB(0, 0), cB, voffB); PG8_STAGE(PG8_SB(0, 1), cB + hstepB, voffB); PG8_GOFF(vgc, cur); PG8_STAGE_A(PG8_SA(0, 0), cA, 0, false); PG8_STAGE_A(PG8_SA(0, 1), cA + hstepA, 1, false);
    if (wr == 1) PG8_BAR;
    PG8_WAIT_V(2); PG8_BAR;
    PG8_STAGE(PG8_SB(1, 0), cB + kstep, voffB); PG8_STAGE_A(PG8_SA(1, 0), cA + kstep, 0, false); PG8_STAGE(PG8_SB(1, 1), cB + hstepB + kstep, voffB);
    PG8_WAIT_V(6); PG8_BAR;
    for (;;) {
        const bool has_next = S.next(ui + 1, nxt);
        const char* nA = has_next ? S.aptr(nxt) : cA; const char* nB = has_next ? S.bptr(nxt) : cB;
        if (has_next) PG8_GOFF(vgn, nxt); else { if constexpr (GA) { _Pragma("unroll") for (int h_ = 0; h_ < 2; ++h_) _Pragma("unroll") for (int i_ = 0; i_ < 2; ++i_) vgn[h_][i_] = vgc[h_][i_]; } }
        for (int t = 0; t < nt; t += 2) {
            const bool last = (t == nt - 2);
            const char* a1 = cA + (size_t)(t + 1) * kstep;
            const char* a2 = last ? nA : cA + (size_t)(t + 2) * kstep; const char* b2 = last ? nB : cB + (size_t)(t + 2) * kstep;
            const char* a3 = a2 + kstep; const char* b3 = b2 + kstep;
            PG8_LDB(B0, 0, 0); PG8_LDB(B1, 0, 1); PG8_SCHED; PG8_LDA(At, 0, 0); PG8_STAGE_A(PG8_SA(1, 1), a1 + hstepA, 1, false);
            PG8_WAIT_V(8); PG8_WAIT_L(0); PG8_BAR; PG8_MMA(0, 0, At, B0); PG8_MMA(0, 1, At, B1); PG8_BAR; PG8_SCHED;
            PG8_LDA(At, 0, 1); PG8_STAGE(PG8_SB(0, 0), b2, voffB); PG8_STAGE(PG8_SB(0, 1), b2 + hstepB, voffB); PG8_STAGE_A(PG8_SA(0, 0), a2, 0, last);
            PG8_WAIT_V(8); PG8_WAIT_L(0); PG8_BAR; PG8_MMA(1, 0, At, B0); PG8_MMA(1, 1, At, B1); PG8_BAR; PG8_SCHED;
            PG8_LDB(B0, 1, 0); PG8_LDB(B1, 1, 1); PG8_SCHED; PG8_LDA(At, 1, 0); PG8_STAGE_A(PG8_SA(0, 1), a2 + hstepA, 1, last);
            PG8_WAIT_V(8); PG8_WAIT_L(0); PG8_BAR; PG8_MMA(0, 0, At, B0); PG8_MMA(0, 1, At, B1); PG8_BAR; PG8_SCHED;
            PG8_LDA(At, 1, 1); PG8_STAGE(PG8_SB(1, 0), b3, voffB); PG8_STAGE(PG8_SB(1, 1), b3 + hstepB, voffB); PG8_STAGE_A(PG8_SA(1, 0), a3, 0, last);
            PG8_WAIT_V(8); PG8_WAIT_L(0); PG8_BAR; PG8_MMA(1, 0, At, B0); PG8_MMA(1, 1, At, B1); PG8_BAR; PG8_SCHED;
        }
        if (wr == 0) PG8_BAR;
        E(acc, cur, wr, wc, fr, fq);
        if (!has_next) break;
#pragma unroll
        for (int a = 0; a < 2; ++a)
#pragma unroll
            for (int b = 0; b < 2; ++b)
#pragma unroll
                for (int m = 0; m < 4; ++m)
#pragma unroll
                    for (int n = 0; n < 2; ++n) acc[a][b][m][n] = (f32x4){0.f, 0.f, 0.f, 0.f};
        cur = nxt; cA = nA; cB = nB; ++ui;
        if constexpr (GA) { _Pragma("unroll") for (int h_ = 0; h_ < 2; ++h_) _Pragma("unroll") for (int i_ = 0; i_ < 2; ++i_) vgc[h_][i_] = vgn[h_][i_]; }
        if (wr == 1) PG8_BAR;
    }
    PG8_WAIT_V(0);
    PG8_BAR;
#undef PG8_SA
#undef PG8_SB
#undef PG8_STAGE
#undef PG8_STAGE_A
#undef PG8_GOFF
#undef PG8_LDA
#undef PG8_LDB
#undef PG8_MMA
#undef PG8_WAIT_V
#undef PG8_WAIT_L
#undef PG8_BAR
#undef PG8_SCHED
}

struct EpiF32 {
    static constexpr bool PERM = false;
    float* C; int ldc; const float* R; int ldr;
    __device__ __forceinline__ void operator()(const f32x4 (&acc)[2][2][4][2], const Unit& u, int wr, int wc, int fr, int fq) const {
        const int row0 = u.pm * BM + wr * 64 + fr, col0 = u.pn * BM + wc * 32 + 4 * fq;
#pragma unroll
        for (int ai = 0; ai < 2; ++ai)
#pragma unroll
            for (int m = 0; m < 4; ++m) { const size_t row = (size_t)(row0 + ai * HALF + m * 16);
#pragma unroll
                for (int bj = 0; bj < 2; ++bj)
#pragma unroll
                    for (int n = 0; n < 2; ++n) { const int col = col0 + bj * HALF + 16 * n; f32x4 v = acc[ai][bj][m][n];
                        if (R) v = v + *(const f32x4*)(R + row * ldr + col);
                        *(f32x4*)(C + row * ldc + col) = v; } }
    }
};
struct EpiBf16 {
    static constexpr bool PERM = true;
    bf16* O; int ldc;
    __device__ __forceinline__ void operator()(const f32x4 (&acc)[2][2][4][2], const Unit& u, int wr, int wc, int fr, int fq) const {
        const int row0 = u.pm * BM + wr * 64 + fr, col0 = u.pn * BM + wc * 32 + 8 * fq;
#pragma unroll
        for (int ai = 0; ai < 2; ++ai)
#pragma unroll
            for (int m = 0; m < 4; ++m) { bf16* rowp = O + (size_t)(row0 + ai * HALF + m * 16) * ldc + col0;
#pragma unroll
                for (int bj = 0; bj < 2; ++bj) { const f32x4 v0 = acc[ai][bj][m][0], v1 = acc[ai][bj][m][1];
                    u32x4 w; w.x = cvt_pk_bf16(v0[0], v0[1]); w.y = cvt_pk_bf16(v0[2], v0[3]); w.z = cvt_pk_bf16(v1[0], v1[1]); w.w = cvt_pk_bf16(v1[2], v1[3]);
                    *(u32x4*)(rowp + bj * HALF) = w; } }
    }
};
struct EpiGlu {
    static constexpr bool PERM = true;
    const bf16* Z; const float* bias; bf16* YM;
    __device__ __forceinline__ void operator()(const f32x4 (&acc)[2][2][4][2], const Unit& u, int wr, int wc, int fr, int fq) const {
        const int row0 = u.pm * BM + wr * 64 + fr, col0 = u.pn * BM + wc * 32 + 8 * fq;
#pragma unroll
        for (int ai = 0; ai < 2; ++ai)
#pragma unroll
            for (int m = 0; m < 4; ++m) { const size_t row = (size_t)(row0 + ai * HALF + m * 16);
#pragma unroll
                for (int bj = 0; bj < 2; ++bj) { const int col = col0 + bj * HALF;
                    const u32x4 zz = *(const u32x4*)(Z + row * 512 + col);
                    const f32x4 b0 = *(const f32x4*)(bias + col), b1 = *(const f32x4*)(bias + col + 4);
                    const f32x4 v0 = acc[ai][bj][m][0] + b0, v1 = acc[ai][bj][m][1] + b1;
                    float o[8]; const unsigned zw[4] = {zz.x, zz.y, zz.z, zz.w};
#pragma unroll
                    for (int q = 0; q < 4; ++q) { const float zl = __builtin_bit_cast(float, zw[q] << 16), zh = __builtin_bit_cast(float, zw[q] & 0xffff0000u);
                        const float al = (q < 2) ? v0[2 * q] : v1[2 * q - 4], ah = (q < 2) ? v0[2 * q + 1] : v1[2 * q - 3];
                        o[2 * q] = zl * sigmoidf_(al); o[2 * q + 1] = zh * sigmoidf_(ah); }
                    u32x4 w; w.x = cvt_pk_bf16(o[0], o[1]); w.y = cvt_pk_bf16(o[2], o[3]); w.z = cvt_pk_bf16(o[4], o[5]); w.w = cvt_pk_bf16(o[6], o[7]);
                    *(u32x4*)(YM + row * D + 512 + col) = w; } }
    }
};

template <bool GATHER_>
struct MoeOrderT {
    static constexpr bool GATHER = GATHER_;
    const bf16* A; const bf16* Bt; int lda, ldb, K; const int* tiles; const int* rows; int nunits, G, c; size_t bexp;
    __device__ void init(const bf16* A_, int lda_, const bf16* Bt_, int ldb_, int K_, const int* tiles_, int ntiles, size_t bexp_, const int* rows_) { A = A_; Bt = Bt_; lda = lda_; ldb = ldb_; K = K_; tiles = tiles_; rows = rows_; nunits = ntiles * 4; G = GN; c = GB; bexp = bexp_; }
    __device__ bool next(int i, Unit& u) const { const int L = i * G + c; if (L >= nunits) return false; u.pm = L >> 2; u.pn = L & 3; return true; }
    __device__ __forceinline__ const char* aptr(const Unit& u) const { return GATHER ? (const char*)A : (const char*)(A + (size_t)u.pm * BM * lda); }
    __device__ __forceinline__ int grow(const Unit& u, int r) const { return rows[u.pm * BM + r]; }
    __device__ __forceinline__ const char* bptr(const Unit& u) const { const int e = __hip_atomic_load(tiles + u.pm, __ATOMIC_RELAXED, __HIP_MEMORY_SCOPE_AGENT); return (const char*)(Bt + ((size_t)e * bexp + (size_t)u.pn * BM) * ldb); }
};
struct EpiSilu {
    static constexpr bool PERM = true;
    bf16* HID;
    __device__ __forceinline__ void operator()(const f32x4 (&acc)[2][2][4][2], const Unit& u, int wr, int wc, int fr, int fq) const {
        const int row0 = u.pm * BM + wr * 64 + fr, col0 = u.pn * HALF + wc * 32 + 8 * fq;
#pragma unroll
        for (int ai = 0; ai < 2; ++ai)
#pragma unroll
            for (int m = 0; m < 4; ++m) { const size_t row = (size_t)(row0 + ai * HALF + m * 16);
                float o[8];
#pragma unroll
                for (int n = 0; n < 2; ++n)
#pragma unroll
                    for (int q = 0; q < 4; ++q) { const float g = acc[ai][0][m][n][q], up = acc[ai][1][m][n][q]; o[4 * n + q] = g * sigmoidf_(g) * up; }
                u32x4 w; w.x = cvt_pk_bf16(o[0], o[1]); w.y = cvt_pk_bf16(o[2], o[3]); w.z = cvt_pk_bf16(o[4], o[5]); w.w = cvt_pk_bf16(o[6], o[7]);
                *(u32x4*)(HID + row * DEXP + col0) = w; }
    }
};
struct EpiGate {
    static constexpr bool PERM = true;
    bf16* Y; const float* gate;
    __device__ __forceinline__ void operator()(const f32x4 (&acc)[2][2][4][2], const Unit& u, int wr, int wc, int fr, int fq) const {
        const int row0 = u.pm * BM + wr * 64 + fr, col0 = u.pn * BM + wc * 32 + 8 * fq;
#pragma unroll
        for (int ai = 0; ai < 2; ++ai)
#pragma unroll
            for (int m = 0; m < 4; ++m) { const size_t row = (size_t)(row0 + ai * HALF + m * 16); const float gt = gate[row];
#pragma unroll
                for (int bj = 0; bj < 2; ++bj) { const f32x4 v0 = acc[ai][bj][m][0] * gt, v1 = acc[ai][bj][m][1] * gt;
                    u32x4 w; w.x = cvt_pk_bf16(v0[0], v0[1]); w.y = cvt_pk_bf16(v0[2], v0[3]); w.z = cvt_pk_bf16(v1[0], v1[1]); w.w = cvt_pk_bf16(v1[2], v1[3]);
                    *(u32x4*)(Y + row * D + col0 + bj * HALF) = w; } }
    }
};

struct EpiProj {
    static constexpr bool PERM = true;
    bf16* PROJ; bf16* US5;
    __device__ __forceinline__ void operator()(const f32x4 (&acc)[2][2][4][2], const Unit& u, int wr, int wc, int fr, int fq) const {
        const int row0 = u.pm * BM + wr * 64 + fr, col0 = u.pn * BM + wc * 32 + 8 * fq;
#pragma unroll
        for (int ai = 0; ai < 2; ++ai)
#pragma unroll
            for (int m = 0; m < 4; ++m) { const size_t row = (size_t)(row0 + ai * HALF + m * 16);
#pragma unroll
                for (int bj = 0; bj < 2; ++bj) { const f32x4 v0 = acc[ai][bj][m][0], v1 = acc[ai][bj][m][1]; const int col = col0 + bj * HALF;
                    u32x4 w; w.x = cvt_pk_bf16(v0[0], v0[1]); w.y = cvt_pk_bf16(v0[2], v0[3]); w.z = cvt_pk_bf16(v1[0], v1[1]); w.w = cvt_pk_bf16(v1[2], v1[3]);
                    if (col < DSHIFT) *(u32x4*)(PROJ + row * DSHIFT + col) = w;
                    else { const int cc = col - DSHIFT; *(u32x4*)(US5 + ((size_t)(cc >> 4) * M + row) * 16 + (cc & 15)) = w; } } }
    }
};
struct GroupOrder {
    static constexpr bool GATHER = false; __device__ __forceinline__ int grow(const Unit&, int) const { return 0; }
    const bf16* A; const bf16* Bt; int lda, ldb, K; int nM, nN, nunits, G, c; size_t sA, sB;
    __device__ void init(const bf16* A_, int lda_, size_t sA_, const bf16* Bt_, int ldb_, size_t sB_, int ngroups, int Mg, int Ng, int K_) {
        A = A_; Bt = Bt_; lda = lda_; ldb = ldb_; K = K_; sA = sA_; sB = sB_; nM = Mg / BM; nN = Ng / BM; nunits = ngroups * nM * nN; G = GN; c = GB; }
    __device__ bool next(int i, Unit& u) const { const int L = i * G + c; if (L >= nunits) return false; u.pn = L % nN; u.pm = L / nN; return true; }
    __device__ __forceinline__ const char* aptr(const Unit& u) const { const int g = u.pm / nM, pm = u.pm % nM; return (const char*)(A + (size_t)g * sA + (size_t)pm * BM * lda); }
    __device__ __forceinline__ const char* bptr(const Unit& u) const { const int g = u.pm / nM; return (const char*)(Bt + (size_t)g * sB + (size_t)u.pn * BM * ldb); }
};
struct EpiS5a {
    static constexpr bool PERM = false;
    bf16* YI; float* F;
    __device__ __forceinline__ void operator()(const f32x4 (&acc)[2][2][4][2], const Unit& u, int wr, int wc, int fr, int fq) const {
        const int row0 = u.pm * BM + wr * 64 + fr, col0 = u.pn * BM + wc * 32 + 4 * fq;
#pragma unroll
        for (int ai = 0; ai < 2; ++ai)
#pragma unroll
            for (int m = 0; m < 4; ++m) { const size_t row = (size_t)(row0 + ai * HALF + m * 16);
#pragma unroll
                for (int bj = 0; bj < 2; ++bj)
#pragma unroll
                    for (int n = 0; n < 2; ++n) { const int col = col0 + bj * HALF + 16 * n; const f32x4 v = acc[ai][bj][m][n];
                        if (col < 512) { uint2 w; w.x = cvt_pk_bf16(v[0], v[1]); w.y = cvt_pk_bf16(v[2], v[3]); *(uint2*)(YI + row * 512 + col) = w; }
                        else if (col < 640) *(f32x4*)(F + row * 128 + (col - 512)) = v; } }
    }
};
struct EpiS5b {
    static constexpr bool PERM = true;
    const bf16* YI; bf16* Z;
    __device__ __forceinline__ void operator()(const f32x4 (&acc)[2][2][4][2], const Unit& u, int wr, int wc, int fr, int fq) const {
        const int row0 = u.pm * BM + wr * 64 + fr, col0 = u.pn * BM + wc * 32 + 8 * fq;
#pragma unroll
        for (int ai = 0; ai < 2; ++ai)
#pragma unroll
            for (int m = 0; m < 4; ++m) { const int row = row0 + ai * HALF + m * 16; const int g = row / S5R, rl = row % S5R;
#pragma unroll
                for (int bj = 0; bj < 2; ++bj) { const int col = col0 + bj * HALF;
                    const u32x4 yi = *(const u32x4*)(YI + (size_t)row * 512 + col);
                    const unsigned yw[4] = {yi.x, yi.y, yi.z, yi.w};
                    const f32x4 v0 = acc[ai][bj][m][0], v1 = acc[ai][bj][m][1];
                    float o[8];
#pragma unroll
                    for (int q = 0; q < 4; ++q) { const float al = (q < 2) ? v0[2 * q] : v1[2 * q - 4], ah = (q < 2) ? v0[2 * q + 1] : v1[2 * q - 3];
                        o[2 * q] = gelu_tanh(al + __builtin_bit_cast(float, yw[q] << 16)); o[2 * q + 1] = gelu_tanh(ah + __builtin_bit_cast(float, yw[q] & 0xffff0000u)); }
                    u32x4 w; w.x = cvt_pk_bf16(o[0], o[1]); w.y = cvt_pk_bf16(o[2], o[3]); w.z = cvt_pk_bf16(o[4], o[5]); w.w = cvt_pk_bf16(o[6], o[7]);
                    const size_t tok = (size_t)rl * S5L + (col >> 4);
                    *(u32x4*)(Z + tok * 512 + g * 16 + (col & 15)) = w; } }
    }
};
struct AttnOrder {
    static constexpr bool GATHER = false; __device__ __forceinline__ int grow(const Unit&, int) const { return 0; }
    const bf16* A; const bf16* Bt; int lda, ldb, K; int G, c; int mode;
    __device__ void init(const bf16* A_, const bf16* Bt_, int ldb_, int mode_) { A = A_; Bt = Bt_; lda = D; ldb = ldb_; K = 256; G = GN; c = GB; mode = mode_; }
    __device__ bool next(int i, Unit& u) const { const int L = i * G + c; if (L >= NB * 4 * 32) return false; u.pn = L & 3; u.pm = L >> 2; return true; }
    __device__ __forceinline__ const char* aptr(const Unit& u) const { return (const char*)(A + (size_t)u.pm * BM * D + u.pn * 256); }
    __device__ __forceinline__ const char* bptr(const Unit& u) const { const int b = u.pm >> 5;
        return (const char*)(mode == 0 ? Bt + (size_t)b * 256 * ldb + u.pn * 256 : Bt + (size_t)u.pn * 256 * ldb + b * 256); }
};
struct EpiSoftmax {
    static constexpr bool PERM = true;
    bf16* P; PG8_LAS float* scr;
    __device__ __forceinline__ void operator()(f32x4 (&acc)[2][2][4][2], const Unit& u, int wr, int wc, int fr, int fq) const {
        const float SC = 0.0625f * 1.4426950408889634f;
        PG8_LAS float* smax = scr; PG8_LAS float* ssum = scr + 1024;
#pragma unroll
        for (int ai = 0; ai < 2; ++ai)
#pragma unroll
            for (int m = 0; m < 4; ++m) { float t = -3.0e38f;
#pragma unroll
                for (int bj = 0; bj < 2; ++bj)
#pragma unroll
                    for (int n = 0; n < 2; ++n) { const f32x4 v = acc[ai][bj][m][n]; t = fmaxf(t, fmaxf(fmaxf(v[0], v[1]), fmaxf(v[2], v[3]))); }
                t = fmaxf(t, __shfl_xor(t, 16)); t = fmaxf(t, __shfl_xor(t, 32));
                if (fq == 0) smax[(ai * HALF + wr * 64 + m * 16 + fr) * 4 + wc] = t; }
        asm volatile("s_waitcnt lgkmcnt(0)" ::: "memory"); __builtin_amdgcn_s_barrier(); asm volatile("" ::: "memory");
#pragma unroll
        for (int ai = 0; ai < 2; ++ai)
#pragma unroll
            for (int m = 0; m < 4; ++m) { const f32x4 q = *(const PG8_LAS f32x4*)(smax + (ai * HALF + wr * 64 + m * 16 + fr) * 4);
                const float mm = fmaxf(fmaxf(q[0], q[1]), fmaxf(q[2], q[3])) * SC; float s = 0.f;
#pragma unroll
                for (int bj = 0; bj < 2; ++bj)
#pragma unroll
                    for (int n = 0; n < 2; ++n)
#pragma unroll
                        for (int e = 0; e < 4; ++e) { const float p = __builtin_amdgcn_exp2f(acc[ai][bj][m][n][e] * SC - mm); acc[ai][bj][m][n][e] = p; s += p; }
                s += __shfl_xor(s, 16); s += __shfl_xor(s, 32);
                if (fq == 0) ssum[(ai * HALF + wr * 64 + m * 16 + fr) * 4 + wc] = s; }
        asm volatile("s_waitcnt lgkmcnt(0)" ::: "memory"); __builtin_amdgcn_s_barrier(); asm volatile("" ::: "memory");
        const int row0 = u.pm * BM + wr * 64 + fr, col0 = u.pn * 256 + wc * 32 + 8 * fq;
#pragma unroll
        for (int ai = 0; ai < 2; ++ai)
#pragma unroll
            for (int m = 0; m < 4; ++m) { const f32x4 q = *(const PG8_LAS f32x4*)(ssum + (ai * HALF + wr * 64 + m * 16 + fr) * 4);
                const float iv = 1.f / ((q[0] + q[1]) + (q[2] + q[3]));
                bf16* rowp = P + (size_t)(row0 + ai * HALF + m * 16) * D + col0;
#pragma unroll
                for (int bj = 0; bj < 2; ++bj) { const f32x4 v0 = acc[ai][bj][m][0] * iv, v1 = acc[ai][bj][m][1] * iv; u32x4 w;
                    w.x = cvt_pk_bf16(v0[0], v0[1]); w.y = cvt_pk_bf16(v0[2], v0[3]); w.z = cvt_pk_bf16(v1[0], v1[1]); w.w = cvt_pk_bf16(v1[2], v1[3]);
                    *(u32x4*)(rowp + bj * HALF) = w; } }
    }
};
struct EpiAttnO {
    static constexpr bool PERM = true;
    bf16* O;
    __device__ __forceinline__ void operator()(const f32x4 (&acc)[2][2][4][2], const Unit& u, int wr, int wc, int fr, int fq) const {
        const int row0 = u.pm * BM + wr * 64 + fr, col0 = u.pn * 256 + wc * 32 + 8 * fq;
#pragma unroll
        for (int ai = 0; ai < 2; ++ai)
#pragma unroll
            for (int m = 0; m < 4; ++m) { bf16* rowp = O + (size_t)(row0 + ai * HALF + m * 16) * D + col0;
#pragma unroll
                for (int bj = 0; bj < 2; ++bj) { const f32x4 v0 = acc[ai][bj][m][0], v1 = acc[ai][bj][m][1];
                    u32x4 w; w.x = cvt_pk_bf16(v0[0], v0[1]); w.y = cvt_pk_bf16(v0[2], v0[3]); w.z = cvt_pk_bf16(v1[0], v1[1]); w.w = cvt_pk_bf16(v1[2], v1[3]);
                    *(u32x4*)(rowp + bj * HALF) = w; } }
    }
};

struct EpiLora {
    static constexpr bool PERM = true;
    bf16* LW; size_t ostride; const float* w0; const float* a0;
    __device__ __forceinline__ void operator()(const f32x4 (&acc)[2][2][4][2], const Unit& u, int wr, int wc, int fr, int fq) const {
        const int row0 = u.pm * BM + wr * 64 + fr, col0 = u.pn * BM + wc * 32 + 8 * fq;
        const int kind = u.pn >> 1;
        bf16* O = LW + (size_t)kind * ostride;
#pragma unroll
        for (int bj = 0; bj < 2; ++bj) { const int col = (col0 + bj * HALF) & 511;
            f32x4 b0 = (f32x4){0.f, 0.f, 0.f, 0.f}, b1 = b0;
            if (kind == 0) { b0 = *(const f32x4*)(w0 + col); b1 = *(const f32x4*)(w0 + col + 4); }
            else if (kind == 1) { b0 = *(const f32x4*)(a0 + col); b1 = *(const f32x4*)(a0 + col + 4); }
#pragma unroll
            for (int ai = 0; ai < 2; ++ai)
#pragma unroll
                for (int m = 0; m < 4; ++m) { const size_t row = (size_t)(row0 + ai * HALF + m * 16);
                    const f32x4 v0 = acc[ai][bj][m][0] + b0, v1 = acc[ai][bj][m][1] + b1; float o[8];
#pragma unroll
                    for (int e = 0; e < 8; ++e) { float x = (e < 4) ? v0[e & 3] : v1[e & 3];
                        if (kind == 0) { const float nd = -x; const float sp = fmaxf(nd, 0.f) + __logf(1.f + __expf(-fabsf(nd))); x = -__expf(-sp - 0.5f); }
                        else if (kind == 1) x = sigmoidf_(x);
                        o[e] = x; }
                    u32x4 w; w.x = cvt_pk_bf16(o[0], o[1]); w.y = cvt_pk_bf16(o[2], o[3]); w.z = cvt_pk_bf16(o[4], o[5]); w.w = cvt_pk_bf16(o[6], o[7]);
                    *(u32x4*)(O + row * 512 + col) = w; } }
    }
};
}

#define LAS __attribute__((address_space(3)))
__device__ __forceinline__ void transpose_item(const float* __restrict__ W, int K, int N, bf16* __restrict__ WT, int ldt, int row_off, int col_off, float* scr, int item, int lane, const float* __restrict__ kscale, int ldw = 0) {
    if (ldw == 0) ldw = N;
    const int nblk = N / 32, kb = item / nblk, nb = item % nblk, k0 = 64 * kb, n0 = 32 * nb;
#pragma unroll 8
    for (int i = 0; i < 32; ++i) { const int kk = 2 * i + (lane >> 5); float v = W[(size_t)(k0 + kk) * ldw + n0 + (lane & 31)]; if (kscale) v *= kscale[k0 + kk]; scr[kk * 33 + (lane & 31)] = v; }
    __builtin_amdgcn_s_waitcnt(0xc07f); asm volatile("" ::: "memory");
    const int c = lane & 7;
#pragma unroll
    for (int j = 0; j < 4; ++j) { const int n = (lane >> 3) + 8 * j; const float* s = scr + (8 * c) * 33 + n;
        uint4 o; o.x = pk2(s[0 * 33], s[1 * 33]); o.y = pk2(s[2 * 33], s[3 * 33]); o.z = pk2(s[4 * 33], s[5 * 33]); o.w = pk2(s[6 * 33], s[7 * 33]);
        *(uint4*)(WT + (size_t)(row_off + n0 + n) * ldt + col_off + k0 + 8 * c) = o; }
    __builtin_amdgcn_s_waitcnt(0xc07f); asm volatile("" ::: "memory");
}
__device__ __forceinline__ void transpose_ph(const int WID_, const float* W, int K, int N, bf16* WT, int ldt, int row_off, int col_off, char* lds, const float* kscale = nullptr) {
    const int lane = (WID_ * 64 + lane_id()) & 63, wv = (WID_ * 64 + lane_id()) >> 6;
    float* scr = (float*)(lds + wv * 16384);
    const int nitems = (K / 64) * (N / 32);
    for (int it = GB * 8 + wv; it < nitems; it += GN * 8) transpose_item(W, K, N, WT, ldt, row_off, col_off, scr, it, lane, kscale);
}

template <typename TO>
__device__ __forceinline__ void rmsnorm_ph(const int WID_, const float* __restrict__ x, const float* __restrict__ w, TO* __restrict__ out, int rows) {
    const int lane = lane_id(), wv = WID_;
    float4 g[4];
#pragma unroll
    for (int j = 0; j < 4; ++j) g[j] = *(const float4*)(w + (lane + 64 * j) * 4);
    for (int row = (GB * 8 + wv) * 2; row < rows; row += GN * 16) {
        const float4* xr = (const float4*)(x + (size_t)row * D);
        float4 v[2][4]; float s[2] = {0.f, 0.f};
#pragma unroll
        for (int r = 0; r < 2; ++r)
#pragma unroll
            for (int j = 0; j < 4; ++j) v[r][j] = xr[r * (D / 4) + lane + 64 * j];
#pragma unroll
        for (int r = 0; r < 2; ++r) {
#pragma unroll
            for (int j = 0; j < 4; ++j) s[r] += v[r][j].x * v[r][j].x + v[r][j].y * v[r][j].y + v[r][j].z * v[r][j].z + v[r][j].w * v[r][j].w;
            s[r] = wave_sum(s[r]);
            const float rs = rsqrtf(s[r] * (1.f / D) + 1e-6f);
#pragma unroll
            for (int j = 0; j < 4; ++j) {
                uint2 o; o.x = pk2(v[r][j].x * rs * g[j].x, v[r][j].y * rs * g[j].y); o.y = pk2(v[r][j].z * rs * g[j].z, v[r][j].w * rs * g[j].w);
                *(uint2*)(out + (size_t)(row + r) * D + (lane + 64 * j) * 4) = o;
            }
        }
    }
}

__device__ __forceinline__ void rwkv_lin_ph(const int WID_, const bf16* __restrict__ proj, const float* __restrict__ mu, bf16* __restrict__ lin) {
    const int lane = lane_id(), wv = WID_;
    const float4 m4 = *(const float4*)(mu + 1536 + 4 * lane);
    const float mm[4] = {m4.x, m4.y, m4.z, m4.w};
    for (int m0 = (GB * 8 + wv) * 4; m0 < M; m0 += GN * 32) {
        uint2 z[4], zp[4];
#pragma unroll
        for (int i = 0; i < 4; ++i) { const int m = m0 + i; z[i] = *(const uint2*)(proj + (size_t)m * DSHIFT + 1536 + 4 * lane);
            zp[i] = make_uint2(0, 0); if ((m & (S - 1)) != 0) zp[i] = *(const uint2*)(proj + (size_t)(m - 1) * DSHIFT + 1536 + 4 * lane); }
#pragma unroll
        for (int i = 0; i < 4; ++i) {
            float c[4] = {__builtin_bit_cast(float, z[i].x << 16), __builtin_bit_cast(float, z[i].x & 0xffff0000u), __builtin_bit_cast(float, z[i].y << 16), __builtin_bit_cast(float, z[i].y & 0xffff0000u)};
            const float q[4] = {__builtin_bit_cast(float, zp[i].x << 16), __builtin_bit_cast(float, zp[i].x & 0xffff0000u), __builtin_bit_cast(float, zp[i].y << 16), __builtin_bit_cast(float, zp[i].y & 0xffff0000u)};
#pragma unroll
            for (int e = 0; e < 4; ++e) { float t = c[e] + (q[e] - c[e]) * mm[e];
                if (lane < 16) t = 1.f - 2.f / (1.f + __expf(2.f * t));
                else if (lane >= 32) t = sigmoidf_(t);
                c[e] = t; }
            uint2 o; o.x = pk2(c[0], c[1]); o.y = pk2(c[2], c[3]);
            *(uint2*)(lin + (size_t)(m0 + i) * 256 + 4 * lane) = o;
        }
    }
}
__device__ __forceinline__ void rwkv_wl_ph(const int WID_, const float* __restrict__ wdec, const float* __restrict__ wiclr, const float* __restrict__ wgate, bf16* __restrict__ wl) {
    for (int i = GB * NT + (WID_ * 64 + lane_id()); i < 1536 * 256; i += GN * NT) {
        const int k = i & 255, n = i >> 8; float v = 0.f;
        if (n < 512) { if (k < 64) v = wdec[k * 512 + n]; }
        else if (n < 1024) { if (k >= 64 && k < 128) v = wiclr[(k - 64) * 512 + (n - 512)]; }
        else { if (k >= 128) v = wgate[(k - 128) * 512 + (n - 1024)]; }
        wl[i] = f2bf(v);
    }
}
struct RwkvIn { const bf16* proj; const bf16* LW; const bf16* AA; const float* mu; const float* k_k; const float* k_a; const float* r_k; float* Y; float* RK; };
constexpr int TB = 64;
constexpr int RW_ITEMS = NB * 8;
template <int CTRL> __device__ __forceinline__ float dpp16(float x) { return __builtin_bit_cast(float, __builtin_amdgcn_update_dpp(0, __builtin_bit_cast(int, x), CTRL, 0xf, 0xf, true)); }
__device__ __forceinline__ void rwkv_scan_ph(const int WID_, const RwkvIn& I, char* lds) {
    float* Rs = (float*)lds; float* Ws = Rs + TB * 64; float* Kps = Ws + TB * 64; float* KKs = Kps + TB * 64; float* Bs = KKs + TB * 64; float* Vs = Bs + TB * 64; float* Ys = Vs + TB * 64;
    const int lane = (WID_ * 64 + lane_id()) & 63, wv = (WID_ * 64 + lane_id()) >> 6;
    for (int item = GB; item < RW_ITEMS; item += GN) {
        const int half = item & 1, h = (item >> 1) & 7, b = item >> 4;
        const int j = lane & 15, rl = 4 * wv + (lane >> 4), row = 32 * half + rl;
        float s0 = 0.f, s1 = 0.f, s2 = 0.f, s3 = 0.f, sa = 0.f;
        const int tau = (WID_ * 64 + lane_id()) >> 3, cg = (WID_ * 64 + lane_id()) & 7, ch0 = h * 64 + cg * 8;
        uint4 gr, gk, gv, qr, qk, qv, ga, gl;
#define RW_ISSUE(blk) do { const int t_ = (blk) * TB + tau; const size_t m_ = (size_t)b * S + t_; const bf16* z_ = I.proj + m_ * DSHIFT + ch0; \
            gr = *(const uint4*)(z_); gk = *(const uint4*)(z_ + 512); gv = *(const uint4*)(z_ + 1024); \
            if (t_ > 0) { qr = *(const uint4*)(z_ - DSHIFT); qk = *(const uint4*)(z_ + 512 - DSHIFT); qv = *(const uint4*)(z_ + 1024 - DSHIFT); } \
            else { qr = make_uint4(0, 0, 0, 0); qk = qr; qv = qr; } \
            ga = *(const uint4*)(I.AA + m_ * 512 + ch0); gl = *(const uint4*)(I.LW + m_ * 512 + ch0); } while (0)
#define RW_COMMIT(blk) do { \
            const unsigned wr_[4] = {gr.x, gr.y, gr.z, gr.w}, wk_[4] = {gk.x, gk.y, gk.z, gk.w}, wv_[4] = {gv.x, gv.y, gv.z, gv.w}; \
            const unsigned pr_[4] = {qr.x, qr.y, qr.z, qr.w}, pk_[4] = {qk.x, qk.y, qk.z, qk.w}, pv_[4] = {qv.x, qv.y, qv.z, qv.w}; \
            const unsigned wa_[4] = {ga.x, ga.y, ga.z, ga.w}, wl_[4] = {gl.x, gl.y, gl.z, gl.w}; \
            float r_[8], k_[8], v_[8], a_[8], kk_[8], ss_ = 0.f, rk_ = 0.f; \
            _Pragma("unroll") for (int e = 0; e < 8; ++e) { const int w_ = e >> 1; const bool hi_ = e & 1; \
                auto ex = [&](unsigned u) { return hi_ ? __builtin_bit_cast(float, u & 0xffff0000u) : __builtin_bit_cast(float, u << 16); }; \
                const float mr_ = I.mu[ch0 + e], mk_ = I.mu[512 + ch0 + e], mv_ = I.mu[1024 + ch0 + e]; \
                float x = ex(wr_[w_]); r_[e] = x + (ex(pr_[w_]) - x) * mr_; x = ex(wk_[w_]); k_[e] = x + (ex(pk_[w_]) - x) * mk_; x = ex(wv_[w_]); v_[e] = x + (ex(pv_[w_]) - x) * mv_; \
                a_[e] = ex(wa_[w_]); kk_[e] = k_[e] * I.k_k[ch0 + e]; ss_ += kk_[e] * kk_[e]; } \
            ss_ += dpp16<0xB1>(ss_); ss_ += dpp16<0x4E>(ss_); ss_ += dpp16<0x141>(ss_); \
            const float inv_ = 1.f / fmaxf(sqrtf(ss_), 1e-12f); \
            float o_[6][8]; \
            _Pragma("unroll") for (int e = 0; e < 8; ++e) { const int w_ = e >> 1; const bool hi_ = e & 1; \
                const float lw_ = hi_ ? __builtin_bit_cast(float, wl_[w_] & 0xffff0000u) : __builtin_bit_cast(float, wl_[w_] << 16); \
                const float kp_ = k_[e] * (1.f + (a_[e] - 1.f) * I.k_a[ch0 + e]); const float kn_ = kk_[e] * inv_; \
                o_[0][e] = r_[e]; o_[1][e] = __expf(lw_); o_[2][e] = kp_; o_[3][e] = kn_; o_[4][e] = kn_ * a_[e]; o_[5][e] = v_[e]; rk_ += r_[e] * kp_ * I.r_k[ch0 + e]; } \
            _Pragma("unroll") for (int q_ = 0; q_ < 6; ++q_) { float* d_ = Rs + q_ * (TB * 64) + tau * 64 + cg * 8; \
                *(float4*)d_ = make_float4(o_[q_][0], o_[q_][1], o_[q_][2], o_[q_][3]); *(float4*)(d_ + 4) = make_float4(o_[q_][4], o_[q_][5], o_[q_][6], o_[q_][7]); } \
            if (half == 0) { rk_ += dpp16<0xB1>(rk_); rk_ += dpp16<0x4E>(rk_); rk_ += dpp16<0x141>(rk_); \
                if (cg == 0) I.RK[((size_t)b * S + (blk) * TB + tau) * 8 + h] = rk_; } } while (0)
        RW_ISSUE(0);
        __syncthreads();
        RW_COMMIT(0);
        __syncthreads();
        for (int blk = 0; blk < S / TB; ++blk) {
            if (blk + 1 < S / TB) RW_ISSUE(blk + 1);
            float4 r4 = *(const float4*)(Rs + 4 * j), w4 = *(const float4*)(Ws + 4 * j), k4 = *(const float4*)(Kps + 4 * j), b4 = *(const float4*)(Bs + 4 * j);
            float vv = Vs[row];
            if (blk == 0) sa = 0.f;
#pragma unroll 2
            for (int t = 0; t < TB; ++t) {
                const int tn = (t + 1 < TB) ? t + 1 : t;
                const float4 n4n = *(const float4*)(KKs + tn * 64 + 4 * j);
                const float4 r4n = *(const float4*)(Rs + tn * 64 + 4 * j), w4n = *(const float4*)(Ws + tn * 64 + 4 * j), k4n = *(const float4*)(Kps + tn * 64 + 4 * j), b4n = *(const float4*)(Bs + tn * 64 + 4 * j);
                const float vvn = Vs[tn * 64 + row];
                s0 = s0 * w4.x + (sa * b4.x + vv * k4.x);
                s1 = s1 * w4.y + (sa * b4.y + vv * k4.y);
                s2 = s2 * w4.z + (sa * b4.z + vv * k4.z);
                s3 = s3 * w4.w + (sa * b4.w + vv * k4.w);
                float py = (s0 * r4.x + s1 * r4.y) + (s2 * r4.z + s3 * r4.w);
                float ps = (s0 * n4n.x + s1 * n4n.y) + (s2 * n4n.z + s3 * n4n.w);
                py += dpp16<0xB1>(py); ps += dpp16<0xB1>(ps);
                py += dpp16<0x4E>(py); ps += dpp16<0x4E>(ps);
                py += dpp16<0x141>(py); ps += dpp16<0x141>(ps);
                py += dpp16<0x140>(py); ps += dpp16<0x140>(ps);
                if (j == 0) Ys[t * 32 + rl] = py;
                if (t + 1 < TB) sa = -ps;
                r4 = r4n; w4 = w4n; k4 = k4n; b4 = b4n; vv = vvn;
            }
            __syncthreads();
            { const int t = (WID_ * 64 + lane_id()) >> 3, r0 = ((WID_ * 64 + lane_id()) & 7) * 4; const size_t m = (size_t)b * S + blk * TB + t;
              *(float4*)(I.Y + m * 512 + h * 64 + 32 * half + r0) = *(const float4*)(Ys + t * 32 + r0); }
            if (blk + 1 < S / TB) RW_COMMIT(blk + 1);
            __syncthreads();
            if (blk + 1 < S / TB) { const float4 n4 = *(const float4*)(KKs + 4 * j);
                float ps = (s0 * n4.x + s1 * n4.y) + (s2 * n4.z + s3 * n4.w);
                ps += dpp16<0xB1>(ps); ps += dpp16<0x4E>(ps); ps += dpp16<0x141>(ps); ps += dpp16<0x140>(ps);
                sa = -ps; }
        }
    }
}

namespace ck {
#define CK_BAR() do { asm volatile("s_waitcnt lgkmcnt(0)" ::: "memory"); __builtin_amdgcn_s_barrier(); asm volatile("" ::: "memory"); } while (0)
typedef float f32x2_t __attribute__((ext_vector_type(2)));
typedef __bf16 bf16x2_t __attribute__((ext_vector_type(2)));
__device__ __forceinline__ unsigned cvtpk(float lo, float hi) { const f32x2_t v = {lo, hi}; const bf16x2_t b = __builtin_convertvector(v, bf16x2_t); return __builtin_bit_cast(unsigned, b); }
typedef short bf16x8 __attribute__((ext_vector_type(8)));
typedef float f32x16 __attribute__((ext_vector_type(16)));
constexpr int LD = 72;
constexpr int MB = 64 * LD * 2;
constexpr int O_AB = 0, O_RB = MB, O_BB = 2 * MB, O_KB = 3 * MB, O_AT = 4 * MB, O_W1T = 5 * MB, O_BT = 6 * MB, O_KT = 7 * MB, O_VT = 8 * MB,
              O_NM = 9 * MB, O_AAK = 10 * MB, O_ARB = 11 * MB, O_ARK = 12 * MB, O_G = 13 * MB, O_TOT = O_G + 16384;
constexpr int O_TM = O_AB, O_X1T = O_BB, O_NMF = O_G, O_TT = O_G + 8192, O_ZT = O_TT + 5120;
constexpr int ITEM_BYTES = 32768;
template <int K, typename PA, typename PB>
__device__ __forceinline__ f32x16 mm_tile(f32x16 acc, PA A, int lda, PB B, int ldb, int lane) {
    const int r = lane & 31, h = lane >> 5;
    bf16x8 a[K / 16], b[K / 16];
#pragma unroll
    for (int q = 0; q < K / 16; ++q) { a[q] = *(const bf16x8*)(A + r * lda + 16 * q + 8 * h); b[q] = *(const bf16x8*)(B + r * ldb + 16 * q + 8 * h); }
#pragma unroll
    for (int q = 0; q < K / 16; ++q) acc = __builtin_amdgcn_mfma_f32_32x32x16_bf16(a[q], b[q], acc, 0, 0, 0);
    return acc;
}
__device__ __forceinline__ int crow(int reg, int h) { return (reg & 3) + 8 * (reg >> 2) + 4 * h; }
__device__ __forceinline__ void store_tr(const f32x16& acc, bf16* Ct, int ldct, int lane) {
    const int c = lane & 31, h = lane >> 5;
#pragma unroll
    for (int g = 0; g < 4; ++g) { uint2 w; w.x = cvtpk(acc[4 * g], acc[4 * g + 1]); w.y = cvtpk(acc[4 * g + 2], acc[4 * g + 3]); *(uint2*)(Ct + c * ldct + 8 * g + 4 * h) = w; }
}
__device__ __forceinline__ void store_rm(const f32x16& acc, bf16* C, int ldc, int lane) {
    const int c = lane & 31, h = lane >> 5;
#pragma unroll
    for (int rg = 0; rg < 16; ++rg) C[crow(rg, h) * ldc + c] = f2bf(acc[rg]);
}
__device__ __forceinline__ f32x16 zero16() { return (f32x16){0.f, 0.f, 0.f, 0.f, 0.f, 0.f, 0.f, 0.f, 0.f, 0.f, 0.f, 0.f, 0.f, 0.f, 0.f, 0.f}; }
__device__ __forceinline__ void store_frag16(const f32x16& acc, bf16* base, int t0, int t1, int lane) {
    const int cc = lane & 31, hh = lane >> 5, col = 32 * t1 + cc;
#pragma unroll
    for (int g = 0; g < 4; ++g) { const int row = 32 * t0 + 8 * g + 4 * hh;
        uint2 w; w.x = cvtpk(acc[4 * g], acc[4 * g + 1]); w.y = cvtpk(acc[4 * g + 2], acc[4 * g + 3]);
        *(uint2*)(base + (((row >> 4) * 4 + (col >> 4)) * 64 + (col & 15) + 16 * ((row & 15) >> 2)) * 4) = w; }
}
struct In { const bf16* proj; const bf16* LW; const bf16* AA; const float* mu; const float* k_k; const float* k_a; const float* r_k; float* RK; char* items; };

__device__ __forceinline__ void phase1(const int WID_, const In& I, char* lds) {
    const int wv = WID_;
#define MAT(off) ((bf16*)(lds + (off)))
    float* G = (float*)(lds + O_G); float* TOT = (float*)(lds + O_TOT); float* NMF = (float*)(lds + O_NMF);
    uint4 nx_r, nx_k, nx_v, nx_qr, nx_qk, nx_qv, nx_a, nx_l;
    { const int lane0 = lane_id(), tid0 = wv * 64 + lane0; const int item = GB;
      if (item < NB * 8 * (S / 64)) { const int c = item & 127, h = (item >> 7) & 7, b = item >> 10, s = tid0 >> 3, cg = tid0 & 7, ch0 = h * 64 + cg * 8, t = c * 64 + s; const size_t m = (size_t)b * S + t;
        const bf16* z = I.proj + m * DSHIFT + ch0;
        nx_r = *(const uint4*)(z); nx_k = *(const uint4*)(z + 512); nx_v = *(const uint4*)(z + 1024);
        nx_qr = make_uint4(0, 0, 0, 0); nx_qk = nx_qr; nx_qv = nx_qr;
        if (t > 0) { nx_qr = *(const uint4*)(z - DSHIFT); nx_qk = *(const uint4*)(z + 512 - DSHIFT); nx_qv = *(const uint4*)(z + 1024 - DSHIFT); }
        nx_a = *(const uint4*)(I.AA + m * 512 + ch0); nx_l = *(const uint4*)(I.LW + m * 512 + ch0); } }
    for (int item = GB; item < NB * 8 * (S / 64); item += GN) {
        const int lane = lane_id(), tid = wv * 64 + lane;
        const int c = item & 127, h = (item >> 7) & 7, b = item >> 10;
        char* out = I.items + (size_t)item * ITEM_BYTES;
        const int s = tid >> 3, cg = tid & 7, ch0 = h * 64 + cg * 8, t = c * 64 + s; const size_t m = (size_t)b * S + t;
        float r_[8], kp_[8], v_[8], kk_[8], b_[8];
        {
            const uint4 gr = nx_r, gk = nx_k, gv = nx_v, qr = nx_qr, qk = nx_qk, qv = nx_qv, ga = nx_a, gl = nx_l;
            const float4 c_mr0 = *(const float4*)(I.mu + ch0), c_mr1 = *(const float4*)(I.mu + ch0 + 4), c_mk0 = *(const float4*)(I.mu + 512 + ch0), c_mk1 = *(const float4*)(I.mu + 512 + ch0 + 4);
            const float4 c_mv0 = *(const float4*)(I.mu + 1024 + ch0), c_mv1 = *(const float4*)(I.mu + 1024 + ch0 + 4), c_kk0 = *(const float4*)(I.k_k + ch0), c_kk1 = *(const float4*)(I.k_k + ch0 + 4);
            const float4 c_ka0 = *(const float4*)(I.k_a + ch0), c_ka1 = *(const float4*)(I.k_a + ch0 + 4), c_rk0 = *(const float4*)(I.r_k + ch0), c_rk1 = *(const float4*)(I.r_k + ch0 + 4);
            const float mur[8] = {c_mr0.x, c_mr0.y, c_mr0.z, c_mr0.w, c_mr1.x, c_mr1.y, c_mr1.z, c_mr1.w}, muk[8] = {c_mk0.x, c_mk0.y, c_mk0.z, c_mk0.w, c_mk1.x, c_mk1.y, c_mk1.z, c_mk1.w};
            const float muv[8] = {c_mv0.x, c_mv0.y, c_mv0.z, c_mv0.w, c_mv1.x, c_mv1.y, c_mv1.z, c_mv1.w}, ckk[8] = {c_kk0.x, c_kk0.y, c_kk0.z, c_kk0.w, c_kk1.x, c_kk1.y, c_kk1.z, c_kk1.w};
            const float cka[8] = {c_ka0.x, c_ka0.y, c_ka0.z, c_ka0.w, c_ka1.x, c_ka1.y, c_ka1.z, c_ka1.w}, crk[8] = {c_rk0.x, c_rk0.y, c_rk0.z, c_rk0.w, c_rk1.x, c_rk1.y, c_rk1.z, c_rk1.w};
            const unsigned wr[4] = {gr.x, gr.y, gr.z, gr.w}, wk[4] = {gk.x, gk.y, gk.z, gk.w}, wv4[4] = {gv.x, gv.y, gv.z, gv.w};
            const unsigned pr[4] = {qr.x, qr.y, qr.z, qr.w}, pk[4] = {qk.x, qk.y, qk.z, qk.w}, pv[4] = {qv.x, qv.y, qv.z, qv.w};
            const unsigned wa[4] = {ga.x, ga.y, ga.z, ga.w}, wl[4] = {gl.x, gl.y, gl.z, gl.w};
            float ss = 0.f, rk = 0.f, a_[8];
#pragma unroll
            for (int e = 0; e < 8; ++e) { const int w_ = e >> 1; const bool hi = e & 1;
                auto ex = [&](unsigned u) { return hi ? __builtin_bit_cast(float, u & 0xffff0000u) : __builtin_bit_cast(float, u << 16); };
                float x = ex(wr[w_]); r_[e] = x + (ex(pr[w_]) - x) * mur[e];
                x = ex(wk[w_]); const float k = x + (ex(pk[w_]) - x) * muk[e];
                x = ex(wv4[w_]); v_[e] = x + (ex(pv[w_]) - x) * muv[e];
                a_[e] = ex(wa[w_]); kk_[e] = k * ckk[e]; ss += kk_[e] * kk_[e];
                kp_[e] = k * (1.f + (a_[e] - 1.f) * cka[e]); rk += r_[e] * kp_[e] * crk[e];
                G[s * 64 + cg * 8 + e] = ex(wl[w_]); }
            ss += dpp16<0xB1>(ss); ss += dpp16<0x4E>(ss); ss += dpp16<0x141>(ss);
            const float inv = 1.f / fmaxf(sqrtf(ss), 1e-12f);
#pragma unroll
            for (int e = 0; e < 8; ++e) { kk_[e] *= inv; b_[e] = kk_[e] * a_[e]; }
            rk += dpp16<0xB1>(rk); rk += dpp16<0x4E>(rk); rk += dpp16<0x141>(rk);
            if (cg == 0) I.RK[m * 8 + h] = rk;
        }
        CK_BAR();
        { const int ch = tid & 63, part = tid >> 6; float run = 0.f;
#pragma unroll
          for (int i = 0; i < 8; ++i) { run += G[(8 * part + i) * 64 + ch]; G[(8 * part + i) * 64 + ch] = run; }
          TOT[part * 64 + ch] = run; }
        CK_BAR();
        { const int ch = tid & 63, part = tid >> 6; float off = 0.f;
          for (int p = 0; p < part; ++p) off += TOT[p * 64 + ch];
#pragma unroll
          for (int i = 0; i < 8; ++i) G[(8 * part + i) * 64 + ch] += off; }
        CK_BAR();
        float glast[8];
        {
            unsigned pab[4], prb[4], pbb[4], pkb[4];
            float ab[8], rb[8], bb[8], kb[8], bt[8], kt[8];
#pragma unroll
            for (int e = 0; e < 8; ++e) { const float g = G[s * 64 + cg * 8 + e], gm1 = (s > 0) ? G[(s - 1) * 64 + cg * 8 + e] : 0.f, gL = G[63 * 64 + cg * 8 + e];
                glast[e] = gL;
                const float eg = __expf(g), eng = __expf(-g), egm = __expf(gm1), egl = __expf(gL - g);
                ab[e] = -kk_[e] * egm; rb[e] = r_[e] * eg; bb[e] = b_[e] * eng; kb[e] = kp_[e] * eng; bt[e] = b_[e] * egl; kt[e] = kp_[e] * egl; }
#pragma unroll
            for (int q = 0; q < 4; ++q) { pab[q] = pk2(ab[2 * q], ab[2 * q + 1]); prb[q] = pk2(rb[2 * q], rb[2 * q + 1]); pbb[q] = pk2(bb[2 * q], bb[2 * q + 1]); pkb[q] = pk2(kb[2 * q], kb[2 * q + 1]); }
            *(uint4*)(MAT(O_AB) + s * LD + cg * 8) = make_uint4(pab[0], pab[1], pab[2], pab[3]);
            *(uint4*)(MAT(O_RB) + s * LD + cg * 8) = make_uint4(prb[0], prb[1], prb[2], prb[3]);
            *(uint4*)(MAT(O_BB) + s * LD + cg * 8) = make_uint4(pbb[0], pbb[1], pbb[2], pbb[3]);
            *(uint4*)(MAT(O_KB) + s * LD + cg * 8) = make_uint4(pkb[0], pkb[1], pkb[2], pkb[3]);
#pragma unroll
            for (int e = 0; e < 8; ++e) { const int k = cg * 8 + e;
                MAT(O_AT)[k * LD + s] = f2bf(ab[e]); MAT(O_BT)[k * LD + s] = f2bf(bt[e]); MAT(O_KT)[k * LD + s] = f2bf(kt[e]); MAT(O_VT)[k * LD + s] = f2bf(v_[e]); }
        }
        CK_BAR();
        { const int itn = item + GN;
          if (itn < NB * 8 * (S / 64)) { const int c2 = itn & 127, h2 = (itn >> 7) & 7, b2 = itn >> 10, ch2 = h2 * 64 + cg * 8, t2 = c2 * 64 + s; const size_t m2 = (size_t)b2 * S + t2;
            const bf16* z = I.proj + m2 * DSHIFT + ch2;
            nx_r = *(const uint4*)(z); nx_k = *(const uint4*)(z + 512); nx_v = *(const uint4*)(z + 1024);
            nx_qr = make_uint4(0, 0, 0, 0); nx_qk = nx_qr; nx_qv = nx_qr;
            if (t2 > 0) { nx_qr = *(const uint4*)(z - DSHIFT); nx_qk = *(const uint4*)(z + 512 - DSHIFT); nx_qv = *(const uint4*)(z + 1024 - DSHIFT); }
            nx_a = *(const uint4*)(I.AA + m2 * 512 + ch2); nx_l = *(const uint4*)(I.LW + m2 * 512 + ch2); } }
        if (s == 63) {
#pragma unroll
            for (int e = 0; e < 8; ++e) TOT[cg * 8 + e] = __expf(glast[e]);
        }
        {
            const int mat = tid >> 7, row = (tid >> 2) & 31, chunk = tid & 3;
            *(uint4*)(MAT(O_NM + mat * MB) + row * LD + 32 + chunk * 8) = make_uint4(0, 0, 0, 0);
        }
        for (int task = wv; task < 12; task += 8) {
            const int mat = task / 3, tt = task % 3, st = (tt == 0) ? 0 : 1, jt = (tt == 2) ? 1 : 0;
            const bf16* Asrc = MAT((mat & 1) ? O_KB : O_BB) + 32 * jt * LD;
            const bf16* Bsrc = MAT((mat >> 1) ? O_RB : O_AB) + 32 * st * LD;
            f32x16 acc = mm_tile<64>(zero16(), Asrc, LD, Bsrc, LD, lane);
            const int cs = 32 * st + (lane & 31), hh = lane >> 5; const bool incl = (mat >> 1) != 0;
#pragma unroll
            for (int rg = 0; rg < 16; ++rg) { const int j = 32 * jt + crow(rg, hh); const bool keep = incl ? (j <= cs) : (j < cs); if (!keep) acc[rg] = 0.f; }
            store_tr(acc, MAT(O_NM + mat * MB) + 32 * st * LD + 32 * jt, LD, lane);
            if (mat == 0 && st == jt) {
                float* d = NMF + st * 1024 + (lane & 31) * 32;
#pragma unroll
                for (int g = 0; g < 4; ++g) *(float4*)(d + 8 * g + 4 * hh) = make_float4(acc[4 * g], acc[4 * g + 1], acc[4 * g + 2], acc[4 * g + 3]);
            }
        }
        CK_BAR();
        if (wv == 0) {
            const int d = lane >> 4, cc = lane & 15;
            const float* nb = NMF + (d >> 1) * 1024 + (16 * (d & 1)) * 32 + 16 * (d & 1);
            float T[16];
#pragma unroll
            for (int i = 0; i < 16; ++i) {
                float acc = (i == cc) ? 1.f : 0.f;
#pragma unroll
                for (int j4 = 0; j4 < i; j4 += 4) { const float4 n4 = *(const float4*)(nb + i * 32 + j4);
                    acc += n4.x * T[j4]; if (j4 + 1 < i) acc += n4.y * T[j4 + 1]; if (j4 + 2 < i) acc += n4.z * T[j4 + 2]; if (j4 + 3 < i) acc += n4.w * T[j4 + 3]; }
                T[i] = acc;
            }
            bf16* tm = MAT(O_TM) + (16 * d) * LD + 16 * d + cc;
#pragma unroll
            for (int i = 0; i < 16; ++i) tm[i * LD] = f2bf(T[i]);
            bf16* tt = MAT(O_TT) + (d >> 1) * 32 * 40 + (16 * (d & 1) + cc) * 40 + 16 * (d & 1);
            *(uint4*)(tt) = make_uint4(pk2(T[0], T[1]), pk2(T[2], T[3]), pk2(T[4], T[5]), pk2(T[6], T[7]));
            *(uint4*)(tt + 8) = make_uint4(pk2(T[8], T[9]), pk2(T[10], T[11]), pk2(T[12], T[13]), pk2(T[14], T[15]));
            { const int blk = lane >> 5, r16 = (lane >> 1) & 15, hf = lane & 1;
              *(uint4*)(MAT(O_TM) + (32 * blk + r16) * LD + 32 * blk + 16 + 8 * hf) = make_uint4(0, 0, 0, 0);
              *(uint4*)(MAT(O_TT) + blk * 32 * 40 + (16 + r16) * 40 + 8 * hf) = make_uint4(0, 0, 0, 0); }
        } else if (wv == 1) {
            const int row = lane >> 1, half = lane & 1;
            *(uint4*)(MAT(O_TM) + row * LD + 32 + half * 16) = make_uint4(0, 0, 0, 0); *(uint4*)(MAT(O_TM) + row * LD + 32 + half * 16 + 8) = make_uint4(0, 0, 0, 0);
        } else if (wv >= 4) {
            const int st = (wv - 4) >> 1, vt = (wv - 4) & 1;
            f32x16 acc = mm_tile<64>(zero16(), MAT(O_AAK) + 32 * st * LD, LD, MAT(O_VT) + 32 * vt * LD, LD, lane);
            store_tr(acc, MAT(O_W1T) + 32 * vt * LD + 32 * st, LD, lane);
        }
        CK_BAR();
        if (wv < 2) {
            typedef float f32x4v __attribute__((ext_vector_type(4)));
            const int blk = wv, fr = lane & 15, fq = lane >> 4;
            const bf16x8 zf = (bf16x8){0, 0, 0, 0, 0, 0, 0, 0};
            bf16x8 a = zf, bq = zf;
            if (fq < 2) { a = *(const bf16x8*)(MAT(O_NM) + (32 * blk + 16 + fr) * LD + 32 * blk + 8 * fq); bq = *(const bf16x8*)(MAT(O_TT) + blk * 32 * 40 + fr * 40 + 8 * fq); }
            f32x4v z = __builtin_amdgcn_mfma_f32_16x16x32_bf16(a, bq, (f32x4v){0.f, 0.f, 0.f, 0.f}, 0, 0, 0);
            bf16* zt = MAT(O_ZT) + blk * 16 * 24;
            { uint2 w; w.x = cvtpk(z[0], z[1]); w.y = cvtpk(z[2], z[3]); *(uint2*)(zt + fr * 24 + 4 * fq) = w; }
            asm volatile("s_waitcnt lgkmcnt(0)" ::: "memory");
            a = zf; bq = zf;
            if (fq < 2) { a = *(const bf16x8*)(MAT(O_TM) + (32 * blk + 16 + fr) * LD + 32 * blk + 16 + 8 * fq); bq = *(const bf16x8*)(zt + fr * 24 + 8 * fq); }
            const f32x4v t21 = __builtin_amdgcn_mfma_f32_16x16x32_bf16(a, bq, (f32x4v){0.f, 0.f, 0.f, 0.f}, 0, 0, 0);
#pragma unroll
            for (int rg = 0; rg < 4; ++rg) MAT(O_TM)[(32 * blk + 16 + 4 * fq + rg) * LD + 32 * blk + fr] = f2bf(t21[rg]);
            { uint2 w; w.x = cvtpk(t21[0], t21[1]); w.y = cvtpk(t21[2], t21[3]); *(uint2*)(MAT(O_TT) + blk * 32 * 40 + fr * 40 + 16 + 4 * fq) = w; }
        }
        CK_BAR();
        if (wv == 0) { f32x16 acc = mm_tile<32>(zero16(), MAT(O_NM) + 32 * LD, LD, MAT(O_TT), 40, lane); store_tr(acc, MAT(O_ZT), 40, lane); }
        CK_BAR();
        if (wv == 0) { f32x16 acc = mm_tile<32>(zero16(), MAT(O_TM) + 32 * LD + 32, LD, MAT(O_ZT), 40, lane); store_rm(acc, MAT(O_TM) + 32 * LD, LD, lane); }
        CK_BAR();
        { const int st = wv >> 2, ct = wv & 3;
          f32x16 acc = mm_tile<64>(zero16(), MAT(O_TM) + 32 * st * LD, LD, MAT(O_AT) + 32 * ct * LD, LD, lane);
          CK_BAR();
          store_tr(acc, MAT(O_X1T) + 32 * ct * LD + 32 * st, LD, lane); }
        CK_BAR();
        for (int u = wv; u < 16; u += 8) {
            const int kind = u >> 2, t0 = (u >> 1) & 1, t1 = u & 1, hh = lane >> 5, cc = lane & 31;
            if (kind == 0) {
                f32x16 acc = mm_tile<64>(zero16(), MAT(O_BT) + 32 * t0 * LD, LD, MAT(O_X1T) + (64 + 32 * t1) * LD, LD, lane);
                acc = mm_tile<64>(acc, MAT(O_KT) + 32 * t0 * LD, LD, MAT(O_VT) + 32 * t1 * LD, LD, lane);
                store_frag16(acc, (bf16*)(out + 16384), t0, t1, lane);
            } else if (kind == 1) {
                f32x16 acc = mm_tile<64>(zero16(), MAT(O_ARB) + 32 * t0 * LD, LD, MAT(O_X1T) + (64 + 32 * t1) * LD, LD, lane);
                acc = mm_tile<64>(acc, MAT(O_ARK) + 32 * t0 * LD, LD, MAT(O_VT) + 32 * t1 * LD, LD, lane);
                store_frag16(acc, (bf16*)(out + 24576), t0, t1, lane);
            } else if (kind == 2) {
                f32x16 acc = mm_tile<64>(zero16(), MAT(O_X1T) + 32 * t0 * LD, LD, MAT(O_BT) + 32 * t1 * LD, LD, lane);
                const int k = 32 * t1 + cc; const float gl = TOT[k];
                bf16* d = (bf16*)out + k * 64 + 32 * t0;
#pragma unroll
                for (int g = 0; g < 4; ++g) { float x[4];
#pragma unroll
                    for (int e = 0; e < 4; ++e) { const int kp = 32 * t0 + 8 * g + 4 * hh + e; x[e] = acc[4 * g + e] + ((kp == k) ? gl : 0.f); }
                    uint2 w; w.x = cvtpk(x[0], x[1]); w.y = cvtpk(x[2], x[3]); *(uint2*)(d + 8 * g + 4 * hh) = w; }
            } else {
                f32x16 acc = mm_tile<64>(zero16(), MAT(O_X1T) + 32 * t0 * LD, LD, MAT(O_ARB) + 32 * t1 * LD, LD, lane);
                const int sq = 32 * t1 + cc;
                bf16* d = (bf16*)(out + 8192) + sq * 64 + 32 * t0;
                const bf16* rb = MAT(O_RB) + sq * LD + 32 * t0;
#pragma unroll
                for (int g = 0; g < 4; ++g) { const uint2 rr = *(const uint2*)(rb + 8 * g + 4 * hh);
                    const float x0 = acc[4 * g] + __builtin_bit_cast(float, rr.x << 16), x1 = acc[4 * g + 1] + __builtin_bit_cast(float, rr.x & 0xffff0000u);
                    const float x2 = acc[4 * g + 2] + __builtin_bit_cast(float, rr.y << 16), x3 = acc[4 * g + 3] + __builtin_bit_cast(float, rr.y & 0xffff0000u);
                    uint2 w; w.x = cvtpk(x0, x1); w.y = cvtpk(x2, x3); *(uint2*)(d + 8 * g + 4 * hh) = w; }
            }
        }
        CK_BAR();
    }
#undef MAT
}
typedef float f32x4w __attribute__((ext_vector_type(4)));
constexpr int P2_SLOT = 2 * 64 * LD * 2 + 4096;
__device__ __forceinline__ void phase2(const int WID_, const char* items, float* Y, char* lds) {
    const int wv = WID_;
    bf16* HT0 = (bf16*)lds; bf16* HT1 = HT0 + 16 * LD;
    char* SL = lds + 8192;
    for (int item = GB; item < NB * 8 * 4; item += GN) {
        const int lane = lane_id(), tid = wv * 64 + lane, fr = lane & 15, fq = lane >> 4;
        const int vq = (item >> 3) & 3, head = (item & 7) + 8 * (item >> 5), b = head >> 3, h = head & 7;
        for (int i = tid; i < 2 * 16 * LD / 8; i += NT) ((uint4*)lds)[i] = make_uint4(0, 0, 0, 0);
        const bool upd = wv < 4; const int rb = wv & 3;
        const char* rec0 = items + (size_t)(head * 128) * ITEM_BYTES;
        const size_t g_pq = (size_t)tid * 16;
        const int l_pq = (tid >> 3) * (LD * 2) + (tid & 7) * 16;
        const int piece = (tid >> 5) & 7;
        const size_t g_f = 16384 + (size_t)(piece >> 2) * 8192 + (((piece & 3) * 4 + vq) * 64) * 8 + (tid & 31) * 16;
        const int l_f = 2 * 64 * LD * 2 + piece * 512 + (tid & 31) * 16;
        float* yo = Y + ((size_t)b * S + 16 * rb + 4 * fq) * 512 + h * 64 + 16 * vq + fr;
        const int a_lds = (upd ? 0 : 64 * LD * 2) + (16 * rb + fr) * (LD * 2) + 16 * fq;
        const int c_lds = 2 * 64 * LD * 2 + ((upd ? 0 : 4) + rb) * 512 + lane * 8;
        uint4 rp0, rp1, rp2, rp3, rp4, rp5, rp6, rp7, rq0, rq1, rq2, rq3, rq4, rq5, rq6, rq7, rf0, rf1, rf2, rf3, rf4, rf5, rf6, rf7;
#define P2_LD(n, i) do { const char* rc_ = rec0 + (size_t)(i) * ITEM_BYTES; rp##n = *(const uint4*)(rc_ + g_pq); rq##n = *(const uint4*)(rc_ + 8192 + g_pq); rf##n = *(const uint4*)(rc_ + g_f); } while (0)
#define P2_ST(n, slot) do { char* s_ = SL + (slot) * P2_SLOT; *(uint4*)(s_ + l_pq) = rp##n; *(uint4*)(s_ + 64 * LD * 2 + l_pq) = rq##n; *(uint4*)(s_ + l_f) = rf##n; } while (0)
        P2_LD(0, 0); P2_LD(1, 1); P2_LD(2, 2); P2_LD(3, 3); P2_LD(4, 4); P2_LD(5, 5); P2_LD(6, 6); P2_LD(7, 7);
        P2_ST(0, 0); P2_LD(0, 8);
        CK_BAR();
#define P2_STEP(RN, cstep) do { const int c_ = (cstep); \
            const bf16* Hc = (c_ & 1) ? HT1 : HT0; bf16* Hn = (c_ & 1) ? HT0 : HT1; const char* sl_ = SL + (c_ & 1) * P2_SLOT; \
            const uint2 cv = *(const uint2*)(sl_ + c_lds); \
            f32x4w acc = (f32x4w){__builtin_bit_cast(float, cv.x << 16), __builtin_bit_cast(float, cv.x & 0xffff0000u), __builtin_bit_cast(float, cv.y << 16), __builtin_bit_cast(float, cv.y & 0xffff0000u)}; \
            const bf16x8 a0 = *(const bf16x8*)(sl_ + a_lds), a1 = *(const bf16x8*)(sl_ + a_lds + 64); \
            const bf16x8 b0 = *(const bf16x8*)(Hc + fr * LD + 8 * fq), b1 = *(const bf16x8*)(Hc + fr * LD + 32 + 8 * fq); \
            if (c_ + 1 < S / 64) P2_ST(RN, (c_ + 1) & 1); \
            if (c_ + 9 < S / 64) P2_LD(RN, c_ + 9); \
            acc = __builtin_amdgcn_mfma_f32_16x16x32_bf16(a0, b0, acc, 0, 0, 0); acc = __builtin_amdgcn_mfma_f32_16x16x32_bf16(a1, b1, acc, 0, 0, 0); \
            if (upd) { uint2 w; w.x = cvtpk(acc[0], acc[1]); w.y = cvtpk(acc[2], acc[3]); *(uint2*)(Hn + fr * LD + 16 * rb + 4 * fq) = w; } \
            else { float* y_ = yo + (size_t)c_ * 64 * 512; y_[0] = acc[0]; y_[512] = acc[1]; y_[1024] = acc[2]; y_[1536] = acc[3]; } \
            CK_BAR(); } while (0)
        for (int c = 0; c < S / 64; c += 8) {
            P2_STEP(1, c); P2_STEP(2, c + 1); P2_STEP(3, c + 2); P2_STEP(4, c + 3); P2_STEP(5, c + 4); P2_STEP(6, c + 5); P2_STEP(7, c + 6); P2_STEP(0, c + 7);
        }
#undef P2_STEP
#undef P2_LD
#undef P2_ST
    }
}
}

__device__ __forceinline__ void rwkv_post_ph(const int WID_, const float* __restrict__ Y, const float* __restrict__ RK, const bf16* __restrict__ proj, const float* __restrict__ mu, const bf16* __restrict__ G,
                             const float* __restrict__ lnw, const float* __restrict__ lnb, bf16* __restrict__ ymix) {
    const int lane = lane_id(), tk = WID_, grp = lane, ch0 = grp * 8, head = grp >> 3;
    const float4 mv0 = *(const float4*)(mu + 1024 + ch0), mv1 = *(const float4*)(mu + 1024 + ch0 + 4), lw0 = *(const float4*)(lnw + ch0), lw1 = *(const float4*)(lnw + ch0 + 4), lb0 = *(const float4*)(lnb + ch0), lb1 = *(const float4*)(lnb + ch0 + 4);
    const float muv[8] = {mv0.x, mv0.y, mv0.z, mv0.w, mv1.x, mv1.y, mv1.z, mv1.w}, lw_[8] = {lw0.x, lw0.y, lw0.z, lw0.w, lw1.x, lw1.y, lw1.z, lw1.w}, lb_[8] = {lb0.x, lb0.y, lb0.z, lb0.w, lb1.x, lb1.y, lb1.z, lb1.w};
    for (int m0 = GB * 16 + tk; m0 < M; m0 += GN * 16) {
        float4 ya[2], yb[2]; uint4 vv[2], pv[2], gg[2]; float rk[2];
#pragma unroll
        for (int u = 0; u < 2; ++u) { const int m = m0 + 8 * u;
            ya[u] = *(const float4*)(Y + (size_t)m * 512 + ch0); yb[u] = *(const float4*)(Y + (size_t)m * 512 + ch0 + 4);
            vv[u] = *(const uint4*)(proj + (size_t)m * DSHIFT + 1024 + ch0);
            pv[u] = (m & (S - 1)) ? *(const uint4*)(proj + (size_t)(m - 1) * DSHIFT + 1024 + ch0) : make_uint4(0, 0, 0, 0);
            gg[u] = *(const uint4*)(G + (size_t)m * 512 + ch0); rk[u] = RK[(size_t)m * 8 + head]; }
#pragma unroll
        for (int u = 0; u < 2; ++u) {
            const float y[8] = {ya[u].x, ya[u].y, ya[u].z, ya[u].w, yb[u].x, yb[u].y, yb[u].z, yb[u].w};
            float s = 0.f;
#pragma unroll
            for (int e = 0; e < 8; ++e) s += y[e];
            s += dpp16<0xB1>(s); s += dpp16<0x4E>(s); s += dpp16<0x141>(s);
            const float mean = s * (1.f / 64.f); float q = 0.f;
#pragma unroll
            for (int e = 0; e < 8; ++e) { const float d = y[e] - mean; q += d * d; }
            q += dpp16<0xB1>(q); q += dpp16<0x4E>(q); q += dpp16<0x141>(q);
            const float rstd = rsqrtf(q * (1.f / 64.f) + 64e-5f);
            const unsigned wv_[4] = {vv[u].x, vv[u].y, vv[u].z, vv[u].w}, wp_[4] = {pv[u].x, pv[u].y, pv[u].z, pv[u].w}, wg_[4] = {gg[u].x, gg[u].y, gg[u].z, gg[u].w};
            float o[8];
#pragma unroll
            for (int e = 0; e < 8; ++e) { const int w_ = e >> 1; const bool hi = e & 1;
                auto ex = [&](unsigned x) { return hi ? __builtin_bit_cast(float, x & 0xffff0000u) : __builtin_bit_cast(float, x << 16); };
                float v = ex(wv_[w_]); v += (ex(wp_[w_]) - v) * muv[e];
                o[e] = ((y[e] - mean) * rstd * lw_[e] + lb_[e] + rk[u] * v) * ex(wg_[w_]); }
            *(uint4*)(ymix + (size_t)(m0 + 8 * u) * D + ch0) = make_uint4(pk2(o[0], o[1]), pk2(o[2], o[3]), pk2(o[4], o[5]), pk2(o[6], o[7]));
        }
    }
}

constexpr int PSLOTS = NASSIGN + NEXP * 256;
constexpr int MAXTILES = PSLOTS / 256;
struct MoeBufs { int* tok_e; float* tok_g; int* tok_slot; int* slot_tok; float* slot_gate; int* bcnt; int* bbase; int* offs; int* tiles; int* ntiles; };
__device__ __forceinline__ void moe_zero_ph(const int WID_, const MoeBufs& mb) {
    for (int i = GB * NT + (WID_ * 64 + lane_id()); i < PSLOTS; i += GN * NT) { mb.slot_tok[i] = 0; mb.slot_gate[i] = 0.f; }
}
__device__ __forceinline__ void router_ph(const int WID_, const float* __restrict__ x3, const float* __restrict__ nw, bf16* __restrict__ h3, const float* __restrict__ wrg, const float* __restrict__ brg,
                          const float* __restrict__ wre, const float* __restrict__ bre, const MoeBufs& mb, char* lds) {
    const int lane = lane_id(), wv = WID_;
    int* lcnt = (int*)lds;
    _Float16* wg16 = (_Float16*)(lds + 256);
    _Float16* we16 = (_Float16*)(lds + 256 + 8192);
    if (wv == 0 && lane < 32) lcnt[lane] = 0;
    for (int i = wv * 64 + lane; i < 1024; i += NT) { const float4 w = *(const float4*)(wrg + i * 4);
        typedef _Float16 h4 __attribute__((ext_vector_type(4))); *(h4*)(wg16 + i * 4) = (h4){(_Float16)w.x, (_Float16)w.y, (_Float16)w.z, (_Float16)w.w}; }
    for (int i = wv * 64 + lane; i < 4 * 1024 * 2; i += NT) { const float4 w = *(const float4*)(wre + i * 4);
        typedef _Float16 h4 __attribute__((ext_vector_type(4))); *(h4*)(we16 + i * 4) = (h4){(_Float16)w.x, (_Float16)w.y, (_Float16)w.z, (_Float16)w.w}; }
    __syncthreads();
    typedef _Float16 h4 __attribute__((ext_vector_type(4)));
    typedef _Float16 h8 __attribute__((ext_vector_type(8)));
    for (int m = GB * 8 + wv; m < M; m += GN * 8) {
        const float4* xr = (const float4*)(x3 + (size_t)m * D);
        float h[16]; float s = 0.f;
#pragma unroll
        for (int j = 0; j < 4; ++j) { const float4 v = xr[lane + 64 * j]; h[4 * j] = v.x; h[4 * j + 1] = v.y; h[4 * j + 2] = v.z; h[4 * j + 3] = v.w; s += v.x * v.x + v.y * v.y + v.z * v.z + v.w * v.w; }
        s = wave_sum(s);
        const float rs = rsqrtf(s * (1.f / D) + 1e-6f);
        float l1[4] = {0.f, 0.f, 0.f, 0.f};
#pragma unroll
        for (int j = 0; j < 4; ++j) {
            const int k0 = (lane + 64 * j) * 4;
            const float4 g = *(const float4*)(nw + k0);
            h[4 * j] *= rs * g.x; h[4 * j + 1] *= rs * g.y; h[4 * j + 2] *= rs * g.z; h[4 * j + 3] *= rs * g.w;
            uint2 o; o.x = pk2(h[4 * j], h[4 * j + 1]); o.y = pk2(h[4 * j + 2], h[4 * j + 3]);
            *(uint2*)(h3 + (size_t)m * D + k0) = o;
#pragma unroll
            for (int e = 0; e < 4; ++e) { const h4 w = *(const h4*)(wg16 + (k0 + e) * 4); const float x = h[4 * j + e];
                l1[0] += x * (float)w[0]; l1[1] += x * (float)w[1]; l1[2] += x * (float)w[2]; l1[3] += x * (float)w[3]; }
        }
#pragma unroll
        for (int i = 0; i < 4; ++i) l1[i] = wave_sum(l1[i]) + brg[i];
        int grp = 0; float best = l1[0];
#pragma unroll
        for (int i = 1; i < 4; ++i) if (l1[i] > best) { best = l1[i]; grp = i; }
        float se = 0.f;
#pragma unroll
        for (int i = 0; i < 4; ++i) se += __expf(l1[i] - best);
        const float g1 = 1.f / se;
        float l2[8] = {};
        const _Float16* we = we16 + (size_t)grp * D * 8;
#pragma unroll
        for (int j = 0; j < 4; ++j) {
            const int k0 = (lane + 64 * j) * 4;
#pragma unroll
            for (int e = 0; e < 4; ++e) { const float x = h[4 * j + e]; const h8 w = *(const h8*)(we + (k0 + e) * 8);
#pragma unroll
                for (int q = 0; q < 8; ++q) l2[q] += x * (float)w[q]; }
        }
#pragma unroll
        for (int i = 0; i < 8; ++i) l2[i] = wave_sum(l2[i]) + bre[grp * 8 + i];
        int i0 = 0; float v0 = l2[0];
#pragma unroll
        for (int i = 1; i < 8; ++i) if (l2[i] > v0) { v0 = l2[i]; i0 = i; }
        int i1 = -1; float v1 = -3.0e38f;
#pragma unroll
        for (int i = 0; i < 8; ++i) if (i != i0 && l2[i] > v1) { v1 = l2[i]; i1 = i; }
        const float e1 = __expf(v1 - v0), inv = 1.f / (1.f + e1);
        if (lane == 0) {
            const int ea = grp * 8 + i0, eb = grp * 8 + i1;
            mb.tok_e[2 * m] = ea; mb.tok_e[2 * m + 1] = eb;
            mb.tok_g[2 * m] = g1 * inv; mb.tok_g[2 * m + 1] = g1 * e1 * inv;
            atomicAdd(&lcnt[ea], 1); atomicAdd(&lcnt[eb], 1);
        }
    }
    __syncthreads();
    if (wv == 0 && lane < 32) mb.bcnt[GB * 32 + lane] = lcnt[lane];
    __syncthreads();
}
__device__ __forceinline__ void moe_plan_ph(const int WID_, const MoeBufs& mb, char* lds) {
    if (GB != 0) return;
    int* tot = (int*)lds; int* off = tot + 32;
    const int t = WID_ * 64 + lane_id();
    if (t < 32) { int run = 0; for (int b = 0; b < GN; ++b) { const int c = __hip_atomic_load(mb.bcnt + b * 32 + t, __ATOMIC_RELAXED, __HIP_MEMORY_SCOPE_AGENT); mb.bbase[b * 32 + t] = run; run += c; } tot[t] = run; }
    __syncthreads();
    if (t == 0) { int o = 0, nt = 0;
        for (int e = 0; e < NEXP; ++e) { off[e] = o; mb.offs[e] = o; const int c = tot[e]; for (int r0 = 0; r0 < c; r0 += 256) { mb.tiles[nt] = e; ++nt; } o += ((c + 255) / 256) * 256; }
        *mb.ntiles = nt; }
    __syncthreads();
}
__device__ __forceinline__ void moe_scatter_ph(const int WID_, const MoeBufs& mb, char* lds) {
    const int lane = lane_id(), wv = WID_;
    int* cur = (int*)lds;
    if (wv == 0 && lane < 32) cur[lane] = __hip_atomic_load(mb.offs + lane, __ATOMIC_RELAXED, __HIP_MEMORY_SCOPE_AGENT) + __hip_atomic_load(mb.bbase + GB * 32 + lane, __ATOMIC_RELAXED, __HIP_MEMORY_SCOPE_AGENT);
    __syncthreads();
    for (int m0 = (GB * 8 + wv); m0 < M; m0 += GN * 8 * 32) {
        const int i = lane >> 1, m = m0 + i * GN * 8;
        if (m < M) { const int a = 2 * m + (lane & 1); const int e = mb.tok_e[a];
            const int pos = atomicAdd(&cur[e], 1);
            mb.slot_tok[pos] = m; mb.slot_gate[pos] = mb.tok_g[a]; mb.tok_slot[a] = pos; }
    }
    __syncthreads();
}
__device__ __forceinline__ void moe_gather_ph(const int WID_, const bf16* __restrict__ h3, bf16* __restrict__ xg, const MoeBufs& mb) {
    const int lane = lane_id(), wv = WID_;
    const int nrows = __hip_atomic_load(mb.ntiles, __ATOMIC_RELAXED, __HIP_MEMORY_SCOPE_AGENT) * 256;
    for (int r0 = (GB * 8 + wv) * 4; r0 < nrows; r0 += GN * 32) {
        uint4 a[4], c[4];
#pragma unroll
        for (int i = 0; i < 4; ++i) { const int t = mb.slot_tok[r0 + i]; const uint4* s = (const uint4*)(h3 + (size_t)t * D); a[i] = s[lane]; c[i] = s[lane + 64]; }
#pragma unroll
        for (int i = 0; i < 4; ++i) { uint4* d = (uint4*)(xg + (size_t)(r0 + i) * D); d[lane] = a[i]; d[lane + 64] = c[i]; }
    }
}
__device__ __forceinline__ void moe_weights_ph(const int WID_, const float* __restrict__ wg, const float* __restrict__ wu, const float* __restrict__ wd, bf16* __restrict__ wgu_t, bf16* __restrict__ wd_t, char* lds, int vb, int nvb) {
    const int lane = (WID_ * 64 + lane_id()) & 63, wv = (WID_ * 64 + lane_id()) >> 6;
    float* scr = (float*)(lds + wv * 16384);
    constexpr int I_GU = 16 * 16;
    constexpr int I_D = 8 * 32;
    constexpr int NIT = NEXP * (2 * I_GU + I_D);
    for (int it = vb * 8 + wv; it < NIT; it += nvb * 8) {
        const int e = it / (2 * I_GU + I_D); int r = it % (2 * I_GU + I_D);
        if (r < 2 * I_GU) {
            const int up = r / I_GU; r %= I_GU;
            const int kb = r / 16, nb = r % 16;
            const int pn = nb / 4, nsub = nb % 4;
            const float* W = (up ? wu : wg) + (size_t)e * D * DEXP + nb * 32;
            transpose_item(W + (size_t)kb * 64 * DEXP, 64, 32, wgu_t, D, e * 1024 + pn * 256 + up * 128 + nsub * 32, kb * 64, scr, 0, lane, nullptr, DEXP);
        } else {
            r -= 2 * I_GU;
            const int kb = r / 32, nb = r % 32;
            const float* W = wd + (size_t)e * DEXP * D + nb * 32;
            transpose_item(W + (size_t)kb * 64 * D, 64, 32, wd_t, DEXP, e * 1024 + nb * 32, kb * 64, scr, 0, lane, nullptr, D);
        }
    }
}
__device__ __forceinline__ void final_ph(const int WID_, float* __restrict__ out, const bf16* __restrict__ yslot, const int* __restrict__ tok_slot, const float* __restrict__ w) {
    const int lane = lane_id(), wv = WID_;
    float4 g[4];
#pragma unroll
    for (int j = 0; j < 4; ++j) g[j] = *(const float4*)(w + (lane + 64 * j) * 4);
    for (int row0 = (GB * 8 + wv) * 2; row0 < M; row0 += GN * 16) {
        float4 v[2][4]; uint2 ya[2][4], yb[2][4];
#pragma unroll
        for (int r = 0; r < 2; ++r) { const int row = row0 + r;
            const float4* xr = (const float4*)(out + (size_t)row * D);
            const uint2* pa = (const uint2*)(yslot + (size_t)tok_slot[2 * row] * D);
            const uint2* pb = (const uint2*)(yslot + (size_t)tok_slot[2 * row + 1] * D);
#pragma unroll
            for (int j = 0; j < 4; ++j) { v[r][j] = xr[lane + 64 * j]; ya[r][j] = pa[lane + 64 * j]; yb[r][j] = pb[lane + 64 * j]; } }
#pragma unroll
        for (int r = 0; r < 2; ++r) { float s = 0.f;
#pragma unroll
            for (int j = 0; j < 4; ++j) { const uint2 a = ya[r][j], b = yb[r][j];
                v[r][j].x += __builtin_bit_cast(float, a.x << 16) + __builtin_bit_cast(float, b.x << 16);
                v[r][j].y += __builtin_bit_cast(float, a.x & 0xffff0000u) + __builtin_bit_cast(float, b.x & 0xffff0000u);
                v[r][j].z += __builtin_bit_cast(float, a.y << 16) + __builtin_bit_cast(float, b.y << 16);
                v[r][j].w += __builtin_bit_cast(float, a.y & 0xffff0000u) + __builtin_bit_cast(float, b.y & 0xffff0000u);
                s += v[r][j].x * v[r][j].x + v[r][j].y * v[r][j].y + v[r][j].z * v[r][j].z + v[r][j].w * v[r][j].w; }
            s = wave_sum(s);
            const float rs = rsqrtf(s * (1.f / D) + 1e-6f);
            float4* xo = (float4*)(out + (size_t)(row0 + r) * D);
#pragma unroll
            for (int j = 0; j < 4; ++j) xo[lane + 64 * j] = make_float4(v[r][j].x * rs * g[j].x, v[r][j].y * rs * g[j].y, v[r][j].z * rs * g[j].z, v[r][j].w * rs * g[j].w); }
    }
}

struct S5Tab { float* Kmat; bf16* BtA; bf16* BtB; };
__device__ __forceinline__ void s5_lam(const float* lam_re, const float* lam_im, const float* log_dt, int g, int n, float& a, float& w) {
    const float dt = __expf(log_dt[g]); a = lam_re[g * 64 + n] * dt; w = lam_im[g * 64 + n] * dt;
}
__device__ __forceinline__ void cexpj(float a, float w, float j, float& re, float& im) { const float e = __expf(a * j); float s, c; sincosf(w * j, &s, &c); re = e * c; im = e * s; }
__device__ __forceinline__ void s5_bbar(const float* lam_re, const float* lam_im, const float* log_dt, const float* b_re, const float* b_im, int g, int n, int h, float& br, float& bi) {
    float a, w; s5_lam(lam_re, lam_im, log_dt, g, n, a, w);
    float lbr, lbi; cexpj(a, w, 1.f, lbr, lbi);
    const float lr = lam_re[g * 64 + n], li = lam_im[g * 64 + n];
    const float nr = lbr - 1.f, ni = lbi, den = lr * lr + li * li;
    const float cr = (nr * lr + ni * li) / den, ci = (ni * lr - nr * li) / den;
    const float xr = b_re[(g * 64 + n) * 16 + h], xi = b_im[(g * 64 + n) * 16 + h];
    br = cr * xr - ci * xi; bi = cr * xi + ci * xr;
}
__device__ __forceinline__ void s5_tables0_ph(const int WID_, const float* lam_re, const float* lam_im, const float* log_dt, const float* b_re, const float* b_im, const float* c_re, const float* c_im, const S5Tab& T, char* lds) {
    float* PWR = (float*)lds; float* PWI = PWR + 64 * 34;
    float* BBR = PWI + 64 * 34; float* BBI = BBR + 64 * 16;
    float* CCR = BBI + 64 * 16; float* CCI = CCR + 16 * 64;
    const int tid = WID_ * 64 + lane_id();
    for (int item = GB; item < 32 * 8; item += GN) {
        const int g = item & 31, part = item >> 5;
        __syncthreads();
        for (int i = tid; i < 64 * 34; i += NT) { const int n = i / 34, j = i % 34; float a, w; s5_lam(lam_re, lam_im, log_dt, g, n, a, w); float pr, pi; cexpj(a, w, (float)j, pr, pi); PWR[i] = pr; PWI[i] = pi; }
        for (int i = tid; i < 64 * 16; i += NT) { const int n = i >> 4, h = i & 15; float br, bi; s5_bbar(lam_re, lam_im, log_dt, b_re, b_im, g, n, h, br, bi); BBR[i] = br; BBI[i] = bi;
            const int hp = i >> 6, n2 = i & 63; CCR[i] = c_re[(g * 16 + hp) * 64 + n2]; CCI[i] = c_im[(g * 16 + hp) * 64 + n2]; }
        __syncthreads();
        for (int i = tid; i < 4 * 256; i += NT) { const int h = i & 15, hp = (i >> 4) & 15, j = 4 * part + (i >> 8);
            float acc = 0.f;
            for (int n = 0; n < 64; ++n) { const float pr = PWR[n * 34 + j], pi = PWI[n * 34 + j], br = BBR[n * 16 + h], bi = BBI[n * 16 + h];
                const float tr = pr * br - pi * bi, ti = pr * bi + pi * br; acc += CCR[hp * 64 + n] * tr - CCI[hp * 64 + n] * ti; }
            T.Kmat[((g * 32 + j) * 16 + hp) * 16 + h] = acc; }
        for (int i = tid; i < 32 * 512; i += NT) { const int col = i & 511, r = 32 * part + (i >> 9); float v = 0.f;
            if (r < 128) { const int n = r & 63, s = col >> 4, h = col & 15; const float pr = PWR[n * 34 + (S5L - 1 - s)], pi = PWI[n * 34 + (S5L - 1 - s)], br = BBR[n * 16 + h], bi = BBI[n * 16 + h];
                v = (r < 64) ? (pr * br - pi * bi) : (pr * bi + pi * br); }
            T.BtA[((size_t)g * 768 + 512 + r) * 512 + col] = f2bf(v); }
        for (int i = tid; i < 64 * 256; i += NT) { const int k = i & 255, row = 64 * part + (i >> 8); float v = 0.f;
            if (k < 128) { const int n = k & 63, sp = row >> 4, hp = row & 15; const float pr = PWR[n * 34 + sp + 1], pi = PWI[n * 34 + sp + 1], cr = CCR[hp * 64 + n], ci = CCI[hp * 64 + n];
                v = (k < 64) ? (cr * pr - ci * pi) : -(cr * pi + ci * pr); }
            T.BtB[((size_t)g * 512 + row) * 256 + k] = f2bf(v); }
    }
    __syncthreads();
}
__device__ __forceinline__ void s5_tables1_ph(const int WID_, const float* dsk, const S5Tab& T) {
    const int gtid = GB * NT + (WID_ * 64 + lane_id()), gsz = GN * NT;
    for (int i = gtid; i < 32 * 512 * 512; i += gsz) {
        const int col = i & 511, row = (i >> 9) & 511, g = i >> 18;
        const int sp = row >> 4, hp = row & 15, s = col >> 4, h = col & 15;
        float v = 0.f;
        if (s <= sp) v = T.Kmat[((g * 32 + (sp - s)) * 16 + hp) * 16 + h];
        if (row == col) v += dsk[g * 16 + hp];
        T.BtA[((size_t)g * 768 + row) * 512 + col] = f2bf(v);
    }
}
__device__ __forceinline__ void s5_carry_ph(const int WID_, const float* lam_re, const float* lam_im, const float* log_dt, const float* __restrict__ F, bf16* __restrict__ XST, int vb, int nvb, char* lds) {
    float* TR = (float*)lds; float* TI = TR + 16 * 32;
    for (int item = vb; item < NB * 32 * 2; item += nvb) {
        const int lane = lane_id(), tid = WID_ * 64 + lane;
        const int nh = item & 1, g = (item >> 1) & 31, b = item >> 6, seg = tid >> 5, n = nh * 32 + (tid & 31);
        float a, w; s5_lam(lam_re, lam_im, log_dt, g, n, a, w);
        float pr, pi; cexpj(a, w, (float)S5L, pr, pi);
        const size_t row0 = (size_t)g * S5R + (size_t)b * (S / S5L) + seg * 16;
        const float* f = F + row0 * 128; bf16* xo = XST + row0 * 256;
        float fr[16], fi[16];
#pragma unroll
        for (int q = 0; q < 16; ++q) { fr[q] = f[(size_t)q * 128 + n]; fi[q] = f[(size_t)q * 128 + 64 + n]; }
#pragma unroll
        for (int q = 0; q < 16; ++q) if (nh == 0) *(uint2*)(xo + (size_t)q * 256 + 128 + (tid & 31) * 4) = make_uint2(0, 0);
        float xr = 0.f, xi = 0.f;
#pragma unroll
        for (int q = 0; q < 16; ++q) { const float nr = pr * xr - pi * xi + fr[q], ni = pr * xi + pi * xr + fi[q]; xr = nr; xi = ni; fr[q] = nr; fi[q] = ni; }
        TR[seg * 32 + (tid & 31)] = xr; TI[seg * 32 + (tid & 31)] = xi;
        __syncthreads();
        float p16r, p16i; cexpj(a, w, (float)(S5L * 16), p16r, p16i);
        float cr = 0.f, ci = 0.f;
        for (int s2 = 0; s2 < seg; ++s2) { const float tr = TR[s2 * 32 + (tid & 31)], ti = TI[s2 * 32 + (tid & 31)];
            const float nr = p16r * cr - p16i * ci + tr, ni = p16r * ci + p16i * cr + ti; cr = nr; ci = ni; }
        float er = cr, ei = ci;
#pragma unroll
        for (int q = 0; q < 16; ++q) {
            const float lr_ = (q > 0) ? fr[q - 1] : 0.f, li_ = (q > 0) ? fi[q - 1] : 0.f;
            xo[(size_t)q * 256 + n] = f2bf(er + lr_); xo[(size_t)q * 256 + 64 + n] = f2bf(ei + li_);
            const float nr = pr * er - pi * ei, ni = pr * ei + pi * er; er = nr; ei = ni;
        }
        __syncthreads();
    }
}
#define XB_TMO      128
#define XB_XCNT(j)  (256  + 64 * (j))
#define XB_XSUB(j)  (1280 + 64 * (j))
#define XB_XGEN(j)  (2304 + 64 * (j))
#define XB_TOP      3328
#define XB_TOPGEN   3392
#define XCD_BAR_WORDS 3456
#define XB_SPIN_CAP (1u << 20)
__device__ __forceinline__ unsigned xb_ld(unsigned* p)              { return __hip_atomic_load(p, __ATOMIC_RELAXED, __HIP_MEMORY_SCOPE_AGENT); }
__device__ __forceinline__ unsigned xb_add(unsigned* p, unsigned v) { return __hip_atomic_fetch_add(p, v, __ATOMIC_RELAXED, __HIP_MEMORY_SCOPE_AGENT); }
__device__ __forceinline__ unsigned xb_xcc_id() { return (unsigned)__builtin_amdgcn_s_getreg((3 << 11) | 20) & 0xFu; }
#define XB_SPIN(cond, bar) do { unsigned _sp = 0; while (cond) { __builtin_amdgcn_s_sleep(1); \
    if ((++_sp & 255u) == 0u) { if (xb_ld(&(bar)[XB_TMO])) break; if (_sp > XB_SPIN_CAP) { atomicAdd(&(bar)[XB_TMO], 1u); break; } } } } while (0)
struct XcdBarrier { unsigned* bar; unsigned x; volatile __attribute__((address_space(3))) unsigned* st; };
__device__ __forceinline__ XcdBarrier xcd_barrier_post(const int WID_, unsigned* bar, volatile __attribute__((address_space(3))) unsigned* st) {
    XcdBarrier b; b.bar = bar; b.x = xb_xcc_id(); b.st = st;
    if ((WID_ * 64 + lane_id()) == 0) (void)xb_add(&bar[XB_XCNT(b.x)], 1u);
    return b;
}
__device__ __forceinline__ void xcd_barrier_complete(unsigned* bar, unsigned x, unsigned& nloc, unsigned& nx) {
    const unsigned G = gridDim.x * gridDim.y * gridDim.z;
    unsigned sum, cnt, mine, sp = 0u;
    for (;;) {
        sum = 0u; cnt = 0u; mine = 0u;
#pragma unroll
        for (unsigned j = 0; j < 16; ++j) { const unsigned c = xb_ld(&bar[XB_XCNT(j)]); sum += c; cnt += (c > 0u) ? 1u : 0u; mine = (j == x) ? c : mine; }
        if (sum == G) break;
        __builtin_amdgcn_s_sleep(1);
        if ((++sp & 255u) == 0u) { if (xb_ld(&bar[XB_TMO])) break; if (sp > XB_SPIN_CAP) { atomicAdd(&bar[XB_TMO], 1u); break; } }
    }
    nloc = mine > 0u ? mine : 1u; nx = cnt > 0u ? cnt : 1u;
}
__device__ __forceinline__ void xcd_barrier(const int WID_, const XcdBarrier& b) {
    asm volatile("s_waitcnt vmcnt(0)" ::: "memory");
    __syncthreads();
    if ((WID_ * 64 + lane_id()) == 0) {
        unsigned* bar = b.bar;
        __builtin_amdgcn_s_waitcnt(0);
        unsigned nloc = b.st[0], nx = b.st[1];
        if (nloc == 0u) { xcd_barrier_complete(bar, b.x, nloc, nx); b.st[0] = nloc; b.st[1] = nx; }
        const unsigned old = xb_add(&bar[XB_XSUB(b.x)], 1u);
        const unsigned gen = old / nloc;
        if (old + 1u == (gen + 1u) * nloc) {
            __builtin_amdgcn_fence(__ATOMIC_RELEASE, "agent");
            asm volatile("s_waitcnt vmcnt(0)" ::: "memory");
            const unsigned og = xb_add(&bar[XB_TOP], 1u);
            const unsigned tg = og / nx;
            if (og + 1u == (tg + 1u) * nx) xb_add(&bar[XB_TOPGEN], 1u);
            else XB_SPIN(xb_ld(&bar[XB_TOPGEN]) == tg, bar);
            __builtin_amdgcn_fence(__ATOMIC_ACQUIRE, "agent");
            xb_add(&bar[XB_XGEN(b.x)], 1u);
            asm volatile("s_waitcnt vmcnt(0)" ::: "memory");
        } else {
            XB_SPIN(xb_ld(&bar[XB_XGEN(b.x)]) == gen, bar);
            __builtin_amdgcn_fence(__ATOMIC_ACQUIRE, "agent");
            asm volatile("s_waitcnt vmcnt(0)" ::: "memory");
        }
    }
    __syncthreads();
}

struct Params { const float* in[41]; float* out; char* ws; };

constexpr size_t W_PROJ = 0;
constexpr size_t W_US5 = 224;
constexpr size_t W_WTS = 288;
constexpr size_t W_YI = 352;
constexpr size_t W_F = 416;
constexpr size_t W_XST = 448;
constexpr size_t W_Z = 480;
constexpr size_t W_MISC = 544;
constexpr size_t W_XN = 576;
constexpr size_t W_CTL = 558;
constexpr size_t WO_IN = 0, WO_GLU = 5 * MiB, WO_MIX = 6 * MiB, WO_Q = 8 * MiB, WO_K = 10 * MiB, WO_V = 12 * MiB, WO_O = 14 * MiB, WO_KMAT = 16 * MiB, WO_BTA = 17 * MiB, WO_BTB = 41 * MiB;

__global__ void __launch_bounds__(NT, 2) fwd_kernel(Params p) {
    extern __shared__ __attribute__((aligned(16))) char lds[];
    const int WID_ = __builtin_amdgcn_readfirstlane((int)(threadIdx.x >> 6));
    cg::grid_group grid = cg::this_grid();
    PG8_LAS unsigned char* ldsl = (PG8_LAS unsigned char*)lds;
    char* ws = p.ws; char* dout = (char*)p.out; float* out = p.out;
#define IN(i) (p.in[i])
    volatile __attribute__((address_space(3))) unsigned* bst = (volatile __attribute__((address_space(3))) unsigned*)(ldsl + LDS_BYTES - 64);
    if (WID_ == 0 && lane_id() < 2) bst[lane_id()] = 0u;
    __syncthreads();
    const XcdBarrier xbar = xcd_barrier_post(WID_, (unsigned*)(ws + W_CTL * MiB), bst);
#ifndef PROBE_PHASE
#define PROBE_PHASE -1
#endif
    int sync_id = 0; unsigned long long pr_t0 = 0, pr_t1 = 0;
    if (PROBE_PHASE == 0) pr_t0 = __builtin_amdgcn_s_memrealtime();
#define SYNC() do { xcd_barrier(WID_, xbar); ++sync_id; if (sync_id == PROBE_PHASE) pr_t0 = __builtin_amdgcn_s_memrealtime(); if (sync_id == PROBE_PHASE + 1) pr_t1 = __builtin_amdgcn_s_memrealtime(); } while (0)
    char* WT = ws + W_WTS * MiB;
    bf16* w_in_t = (bf16*)(WT + WO_IN); bf16* w_glu_t = (bf16*)(WT + WO_GLU); bf16* w_mix_t = (bf16*)(WT + WO_MIX);
    bf16* w_q_t = (bf16*)(WT + WO_Q); bf16* w_k_t = (bf16*)(WT + WO_K); bf16* w_v_t = (bf16*)(WT + WO_V); bf16* w_o_t = (bf16*)(WT + WO_O);
    S5Tab stab; stab.Kmat = (float*)(WT + WO_KMAT); stab.BtA = (bf16*)(WT + WO_BTA); stab.BtB = (bf16*)(WT + WO_BTB);
    bf16* PROJ = (bf16*)(ws + W_PROJ * MiB); bf16* US5 = (bf16*)(ws + W_US5 * MiB);
    bf16* XN = (bf16*)(ws + W_XN * MiB);
    transpose_ph(WID_, IN(3), D, DIN, w_in_t, D, 0, 0, lds);
    transpose_ph(WID_, IN(23), 512, 512, w_glu_t, 512, 0, 0, lds);
    transpose_ph(WID_, IN(25), D, D, w_mix_t, D, 0, 0, lds);
    transpose_ph(WID_, IN(28), D, D, w_q_t, D, 0, 0, lds);
    transpose_ph(WID_, IN(29), D, D, w_k_t, D, 0, 0, lds);
    transpose_ph(WID_, IN(30), D, D, w_v_t, D, 0, 0, lds);
    transpose_ph(WID_, IN(31), D, D, w_o_t, D, 0, 0, lds);
    s5_tables0_ph(WID_, IN(15), IN(16), IN(17), IN(18), IN(19), IN(20), IN(21), stab, lds);
    bf16* wl_t = (bf16*)(WT + 49 * MiB);
    rwkv_wl_ph(WID_, IN(6), IN(8), IN(9), wl_t);
    rmsnorm_ph<bf16>(WID_, IN(0), IN(2), XN, M);
    grid.sync(); ++sync_id; if (sync_id == PROBE_PHASE) pr_t0 = __builtin_amdgcn_s_memrealtime(); if (sync_id == PROBE_PHASE + 1) pr_t1 = __builtin_amdgcn_s_memrealtime();
    s5_tables1_ph(WID_, IN(22), stab);
    { pg8::PlainOrder S; S.init(XN, D, w_in_t, D, M, DIN, D); pg8::EpiProj E{PROJ, US5}; pg8::gemm_phase(WID_, ldsl, S, E); }
    SYNC();
    bf16* LIN = (bf16*)(ws + (W_MISC + 16) * MiB);
    rwkv_lin_ph(WID_, PROJ, IN(4), LIN);
    SYNC();
    bf16* YI = (bf16*)(ws + W_YI * MiB); float* F = (float*)(ws + W_F * MiB); bf16* XST = (bf16*)(ws + W_XST * MiB); bf16* Z = (bf16*)(ws + W_Z * MiB);
    bf16* LWb = (bf16*)(ws + 704 * MiB); bf16* AAb = (bf16*)(ws + 768 * MiB); bf16* Gb = (bf16*)(ws + 832 * MiB);
    float* Yr = (float*)(ws + 896 * MiB); float* RKb = (float*)(ws + W_MISC * MiB);
    { pg8::GroupOrder S; S.init(US5, 512, (size_t)S5R * 512, stab.BtA, 512, (size_t)768 * 512, 32, S5R, 768, 512); pg8::EpiS5a E{YI, F}; pg8::gemm_phase(WID_, ldsl, S, E); }
    { pg8::PlainOrder S; S.init(LIN, 256, wl_t, 256, M, 1536, 256); pg8::EpiLora E{LWb, (size_t)32 * MiB, IN(5), IN(7)}; pg8::gemm_phase(WID_, ldsl, S, E); }
    SYNC();
    { ck::In ci{PROJ, LWb, AAb, IN(4), IN(10), IN(11), IN(12), RKb, dout}; ck::phase1(WID_, ci, lds); }
    SYNC();
    bf16* WGU_t = (bf16*)(ws + 704 * MiB); bf16* WD_t = (bf16*)(ws + 768 * MiB);
    ck::phase2(WID_, dout, Yr, lds);
    __syncthreads();
    s5_carry_ph(WID_, IN(15), IN(16), IN(17), F, XST, GB, GN, lds);
    moe_weights_ph(WID_, IN(37), IN(38), IN(39), WGU_t, WD_t, lds, GB, GN);
    SYNC();
    bf16* YMIX = XN;
    { pg8::GroupOrder S; S.init(XST, 256, (size_t)S5R * 256, stab.BtB, 256, (size_t)512 * 256, 32, S5R, 512, 256); pg8::EpiS5b E{YI, Z}; pg8::gemm_phase(WID_, ldsl, S, E); }
    rwkv_post_ph(WID_, Yr, RKb, PROJ, IN(4), Gb, IN(13), IN(14), YMIX);
    SYNC();
    { pg8::PlainOrder S; S.init(Z, 512, w_glu_t, 512, M, 512, 512); pg8::EpiGlu E{Z, IN(24), YMIX}; pg8::gemm_phase(WID_, ldsl, S, E); }
    SYNC();
    { pg8::PlainOrder S; S.init(YMIX, D, w_mix_t, D, M, D, D); pg8::EpiF32 E{out, D, IN(0), D}; pg8::gemm_phase(WID_, ldsl, S, E); }
    SYNC();
    bf16* KM = (bf16*)(ws + (W_MISC + 2) * MiB); bf16* VT = (bf16*)(ws + (W_MISC + 6) * MiB); bf16* MEMN = (bf16*)(ws + (W_MISC + 10) * MiB);
    rmsnorm_ph<bf16>(WID_, out, IN(26), XN, M);
    rmsnorm_ph<bf16>(WID_, IN(1), IN(27), MEMN, NB * NMEM);
    SYNC();
    bf16* Q = (bf16*)(ws + 128 * MiB);
    { pg8::PlainOrder S; S.init(MEMN, D, w_k_t, D, NB * NMEM, D, D); pg8::EpiBf16 E{KM, D}; pg8::gemm_phase(WID_, ldsl, S, E); }
    { pg8::PlainOrder S; S.init(w_v_t, D, MEMN, D, D, NB * NMEM, D); pg8::EpiBf16 E{VT, NB * NMEM}; pg8::gemm_phase(WID_, ldsl, S, E); }
    { pg8::PlainOrder S; S.init(XN, D, w_q_t, D, M, D, D); pg8::EpiBf16 E{Q, D}; pg8::gemm_phase(WID_, ldsl, S, E); }
    SYNC();
    bf16* P = (bf16*)(ws + W_YI * MiB);
    { pg8::AttnOrder S; S.init(Q, KM, D, 0); pg8::EpiSoftmax E{P, (PG8_LAS float*)(ldsl + 131072)}; pg8::gemm_phase(WID_, ldsl, S, E); }
    SYNC();
    bf16* O = XN;
    { pg8::AttnOrder S; S.init(P, VT, NB * NMEM, 1); pg8::EpiAttnO E{O}; pg8::gemm_phase(WID_, ldsl, S, E); }
    SYNC();
    { pg8::PlainOrder S; S.init(O, D, w_o_t, D, M, D, D); pg8::EpiF32 E{out, D, out, D}; pg8::gemm_phase(WID_, ldsl, S, E); }
    SYNC();
    bf16* H3 = XN;
    bf16* XG = (bf16*)(ws + 0);
    bf16* HID = (bf16*)(ws + 368 * MiB);
    bf16* YSLOT = (bf16*)(ws + 0);
    MoeBufs mb; char* mbase = ws + 976 * MiB;
    mb.tok_e = (int*)(mbase); mb.tok_g = (float*)(mbase + 1 * MiB); mb.tok_slot = (int*)(mbase + 2 * MiB); mb.slot_tok = (int*)(mbase + 3 * MiB);
    mb.slot_gate = (float*)(mbase + 4 * MiB); mb.bcnt = (int*)(mbase + 5 * MiB); mb.bbase = mb.bcnt + 16384; mb.offs = mb.bcnt + 32768; mb.ntiles = mb.offs + 64;
    mb.tiles = (int*)(mbase + 6 * MiB);
    moe_zero_ph(WID_, mb);
    router_ph(WID_, out, IN(32), H3, IN(33), IN(34), IN(35), IN(36), mb, lds);
    SYNC();
    moe_plan_ph(WID_, mb, lds);
    SYNC();
    moe_scatter_ph(WID_, mb, lds);
    SYNC();
    const int ntiles = __hip_atomic_load(mb.ntiles, __ATOMIC_RELAXED, __HIP_MEMORY_SCOPE_AGENT);
    { pg8::MoeOrderT<true> S; S.init(H3, D, WGU_t, D, D, mb.tiles, ntiles, 1024, mb.slot_tok); pg8::EpiSilu E{HID}; pg8::gemm_phase(WID_, ldsl, S, E); }
    SYNC();
    { pg8::MoeOrderT<false> S; S.init(HID, DEXP, WD_t, DEXP, DEXP, mb.tiles, ntiles, 1024, nullptr); pg8::EpiGate E{YSLOT, mb.slot_gate}; pg8::gemm_phase(WID_, ldsl, S, E); }
    SYNC();
    final_ph(WID_, out, YSLOT, mb.tok_slot, IN(40));
    if (PROBE_PHASE >= 0) {
        if (pr_t1 == 0) pr_t1 = __builtin_amdgcn_s_memrealtime();
        if (GB == 0) { const unsigned long long t_end = __builtin_amdgcn_s_memrealtime(), wait = 8ull * (pr_t1 - pr_t0);
            while (__builtin_amdgcn_s_memrealtime() - t_end < wait) __builtin_amdgcn_s_sleep(8); }
    }
}
}

extern "C" void kernel_launch(void* const* d_in, const int* in_sizes, int n_in, void* d_out, int out_size, void* d_ws, size_t ws_size, hipStream_t stream) {
    (void)in_sizes; (void)out_size; (void)ws_size;
    static int grid = 0;
    if (grid == 0) {
        int dev = 0, cus = 0, per_cu = 0;
        hipGetDevice(&dev);
        hipDeviceGetAttribute(&cus, hipDeviceAttributeMultiprocessorCount, dev);
        hipFuncSetAttribute((const void*)fwd_kernel, hipFuncAttributeMaxDynamicSharedMemorySize, LDS_BYTES);
        hipOccupancyMaxActiveBlocksPerMultiprocessor(&per_cu, (const void*)fwd_kernel, NT, LDS_BYTES);
        if (per_cu < 1) { fprintf(stderr, "occupancy query says %d blocks/CU\n", per_cu); per_cu = 1; }
        grid = cus * 1;
    }
    (void)hipMemsetAsync((char*)d_ws + W_CTL * MiB, 0, 16384, stream);
    Params p{};
    for (int i = 0; i < 41 && i < n_in; ++i) p.in[i] = (const float*)d_in[i];
    p.out = (float*)d_out; p.ws = (char*)d_ws;
    void* args[] = {&p};
    hipError_t e = hipLaunchCooperativeKernel((const void*)fwd_kernel, dim3(grid), dim3(NT), args, LDS_BYTES, stream);
    if (e != hipSuccess) fprintf(stderr, "cooperative launch failed: %s (grid %d)\n", hipGetErrorString(e), grid);
}
```

```cpp
#include <hip/hip_runtime.h>
#include <hip/hip_cooperative_groups.h>
#include <stdint.h>
#include <cstdio>
namespace cg = cooperative_groups;

namespace {
constexpr int NB = 8, S = 8192, D = 1024, M = NB * S;
constexpr int DR = 512, DSHIFT = 1792, DIN = 2304, NMEM = 256;
constexpr int NEXP = 32, DEXP = 512, NASSIGN = 2 * M;
constexpr size_t MiB = 1u << 20;
constexpr int NT = 512;
constexpr int S5L = 32, S5R = M / S5L;
constexpr int LDS_BYTES = 147456;
#define GB ((int)blockIdx.x)
#define GN ((int)gridDim.x)

typedef unsigned short bf16;
typedef float f32x2h __attribute__((ext_vector_type(2)));
typedef __bf16 bf16x2h __attribute__((ext_vector_type(2)));
__device__ __forceinline__ unsigned pk2(float lo, float hi) { const f32x2h v = {lo, hi}; const bf16x2h b = __builtin_convertvector(v, bf16x2h); return __builtin_bit_cast(unsigned, b); }
__device__ __forceinline__ bf16 f2bf(float f) { return (bf16)(pk2(f, f) & 0xffffu); }
__device__ __forceinline__ int lane_id() { int l; asm volatile("v_mbcnt_lo_u32_b32 %0, -1, 0\n\tv_mbcnt_hi_u32_b32 %0, -1, %0" : "=v"(l)); return l; }
__device__ __forceinline__ float bf2f(bf16 h) { return __builtin_bit_cast(float, (unsigned)h << 16); }

template <typename T> __device__ __forceinline__ float ldf(const T* p);
template <> __device__ __forceinline__ float ldf<float>(const float* p) { return *p; }
template <> __device__ __forceinline__ float ldf<bf16>(const bf16* p) { return bf2f(*p); }
template <typename T> __device__ __forceinline__ void stf(T* p, float v);
template <> __device__ __forceinline__ void stf<float>(float* p, float v) { *p = v; }
template <> __device__ __forceinline__ void stf<bf16>(bf16* p, float v) { *p = f2bf(v); }

template <int CTRL, int ROWMASK> __device__ __forceinline__ float dppf_(float x) { return __builtin_bit_cast(float, __builtin_amdgcn_update_dpp(0, __builtin_bit_cast(int, x), CTRL, ROWMASK, 0xf, false)); }
__device__ __forceinline__ float wave_sum(float v) {
    v += dppf_<0xB1, 0xf>(v); v += dppf_<0x4E, 0xf>(v); v += dppf_<0x141, 0xf>(v); v += dppf_<0x140, 0xf>(v);
    v += dppf_<0x142, 0xa>(v);
    v += dppf_<0x143, 0xc>(v);
    return __builtin_bit_cast(float, __builtin_amdgcn_readlane(__builtin_bit_cast(int, v), 63));
}
__device__ __forceinline__ float sigmoidf_(float x) { return 1.f / (1.f + __expf(-x)); }


__device__ __forceinline__ float gelu_tanh(float x) { return x * sigmoidf_(1.5957691216057308f * (x + 0.044715f * x * x * x)); }

namespace pg8 {
#define PG8_LAS __attribute__((address_space(3)))
typedef short bf16x8 __attribute__((ext_vector_type(8)));
typedef float f32x4 __attribute__((ext_vector_type(4)));
typedef unsigned u32x4 __attribute__((ext_vector_type(4)));
constexpr int BM = 256, BK = 64, HALF = 128, HTB = HALF * BK * 2, STAGE_BYTES = 8 * HTB, NXCD = 8, WGM = 8;
__device__ __forceinline__ int lds_byte(int r, int c) { const int st = (r >> 4) * 2 + (c >> 5), rr = r & 15, cc = c & 31, ob = rr * 64 + cc * 2; return st * 1024 + (ob ^ (((ob >> 9) & 1) << 5)); }
__device__ __forceinline__ void stage_rc(int b, int& R, int& C) { const int st = b / 1024, sb = b % 1024, swz = sb ^ (((sb >> 9) & 1) << 5); R = (st >> 1) * 16 + swz / 64; C = (st & 1) * 32 + (swz % 64) / 2; }
__device__ __forceinline__ int perm32(int rho) { const int n = rho >> 4, i = rho & 15; return 8 * (i >> 2) + 4 * n + (i & 3); }
struct Unit { int pm, pn; };
struct PlainOrder {
    static constexpr bool GATHER = false; __device__ __forceinline__ int grow(const Unit&, int) const { return 0; }
    const bf16* A; const bf16* Bt; int lda, ldb, K; int nM, nN, nwg, G, c;
    __device__ void init(const bf16* A_, int lda_, const bf16* Bt_, int ldb_, int M, int N, int K_) { A = A_; Bt = Bt_; lda = lda_; ldb = ldb_; K = K_; nM = M / BM; nN = N / BM; nwg = nM * nN; G = GN; c = GB; }
    __device__ bool next(int i, Unit& u) const {
        const long L = (long)i * G + c; if (L >= nwg) return false;
        int wgid = (int)L; { const int q = nwg / NXCD, r = nwg % NXCD, xcd = wgid % NXCD, off = wgid / NXCD; wgid = (xcd < r ? xcd * (q + 1) : r * (q + 1) + (xcd - r) * q) + off; }
        const int nig = WGM * nN, gid = wgid / nig, fm = gid * WGM, gsz = (nM - fm) < WGM ? (nM - fm) : WGM;
        u.pm = fm + ((wgid % nig) % gsz); u.pn = (wgid % nig) / gsz; return true;
    }
    __device__ __forceinline__ const char* aptr(const Unit& u) const { return (const char*)(A + (size_t)u.pm * BM * lda); }
    __device__ __forceinline__ const char* bptr(const Unit& u) const { return (const char*)(Bt + (size_t)u.pn * BM * ldb); }
};
typedef float f32x2c __attribute__((ext_vector_type(2)));
typedef __bf16 bf16x2c __attribute__((ext_vector_type(2)));
__device__ __forceinline__ unsigned cvt_pk_bf16(float lo, float hi) { const f32x2c v = {lo, hi}; const bf16x2c b = __builtin_convertvector(v, bf16x2c); return __builtin_bit_cast(unsigned, b); }

template <class Epi, class Sched>
__device__ __forceinline__ void gemm_phase(const int WID_, PG8_LAS unsigned char* lds, const Sched& S, const Epi& E) {
    const int tid = (WID_ * 64 + lane_id()), wid = __builtin_amdgcn_readfirstlane(tid >> 6), lane = tid & 63, wr = wid >> 2, wc = wid & 3, fr = lane & 15, fq = lane >> 4;
    const int K = S.K, nt = K / BK;
    unsigned voffA[2], voffB[2];
#pragma unroll
    for (int i = 0; i < 2; ++i) { int R, C; stage_rc(tid * 16 + i * 8192, R, C); const int Rb = Epi::PERM ? ((R & ~31) + perm32(R & 31)) : R;
        voffA[i] = (unsigned)(R * S.lda + C) * 2u; voffB[i] = (unsigned)(Rb * S.ldb + C) * 2u; }
    constexpr bool GA = Sched::GATHER;
    int gR[2], gC[2];
#pragma unroll
    for (int i = 0; i < 2; ++i) stage_rc(tid * 16 + i * 8192, gR[i], gC[i]);
    unsigned vgc[2][2] = {{0u, 0u}, {0u, 0u}}, vgn[2][2] = {{0u, 0u}, {0u, 0u}};
#define PG8_GOFF(dst, u) do { if constexpr (GA) { _Pragma("unroll") for (int h_ = 0; h_ < 2; ++h_) _Pragma("unroll") for (int i_ = 0; i_ < 2; ++i_) \
        dst[h_][i_] = (unsigned)(S.grow(u, h_ * HALF + gR[i_]) * S.lda + gC[i_]) * 2u; } } while (0)
    const size_t kstep = (size_t)(BK * 2);
    const size_t hstepA = GA ? 0 : (size_t)HALF * S.lda * 2, hstepB = (size_t)HALF * S.ldb * 2;
    const unsigned ldsw = (unsigned)wid * 1024u;
    const int aoff = lds_byte(wr * 64 + fr, fq * 8), boff = lds_byte(wc * 32 + fr, fq * 8);
#define PG8_SA(b, h) (((b) * 2 + (h)) * HTB)
#define PG8_SB(b, h) ((4 + (b) * 2 + (h)) * HTB)
#define PG8_STAGE(bufoff, gbase, voff) do { _Pragma("unroll") for (int _i = 0; _i < 2; ++_i) \
        __builtin_amdgcn_global_load_lds((const unsigned*)((const char*)(gbase) + (voff)[_i]), (PG8_LAS unsigned*)(lds + (bufoff) + ldsw + _i * 8192), 16, 0, 0); } while (0)
#define PG8_STAGE_A(bufoff, gbase, h, nx) do { _Pragma("unroll") for (int _i = 0; _i < 2; ++_i) { \
        const unsigned vo_ = GA ? ((nx) ? vgn[h][_i] : vgc[h][_i]) : voffA[_i]; \
        __builtin_amdgcn_global_load_lds((const unsigned*)((const char*)(gbase) + vo_), (PG8_LAS unsigned*)(lds + (bufoff) + ldsw + _i * 8192), 16, 0, 0); } } while (0)
#define PG8_LDA(dst, b, h) do { _Pragma("unroll") for (int m = 0; m < 4; ++m) _Pragma("unroll") for (int k = 0; k < 2; ++k) dst[m][k] = *(const PG8_LAS bf16x8*)(lds + PG8_SA(b, h) + aoff + m * 2048 + k * 1024); } while (0)
#define PG8_LDB(dst, b, h) do { _Pragma("unroll") for (int n = 0; n < 2; ++n) _Pragma("unroll") for (int k = 0; k < 2; ++k) dst[n][k] = *(const PG8_LAS bf16x8*)(lds + PG8_SB(b, h) + boff + n * 2048 + k * 1024); } while (0)
#define PG8_MMA(ai, bj, At, Bt) do { __builtin_amdgcn_s_setprio(1); _Pragma("unroll") for (int m = 0; m < 4; ++m) _Pragma("unroll") for (int n = 0; n < 2; ++n) _Pragma("unroll") for (int k = 0; k < 2; ++k) \
        acc[ai][bj][m][n] = __builtin_amdgcn_mfma_f32_16x16x32_bf16(Bt[n][k], At[m][k], acc[ai][bj][m][n], 0, 0, 0); __builtin_amdgcn_s_setprio(0); } while (0)
#define PG8_WAIT_V(n) asm volatile("s_waitcnt vmcnt(" #n ")" ::: "memory")
#define PG8_WAIT_L(n) asm volatile("s_waitcnt lgkmcnt(" #n ")" ::: "memory")
#define PG8_BAR __builtin_amdgcn_s_barrier()
#define PG8_SCHED __builtin_amdgcn_sched_barrier(0)
    Unit cur, nxt; int ui = 0;
    if (!S.next(0, cur)) return;
    f32x4 acc[2][2][4][2];
#pragma unroll
    for (int a = 0; a < 2; ++a)
#pragma unroll
        for (int b = 0; b < 2; ++b)
#pragma unroll
            for (int m = 0; m < 4; ++m)
#pragma unroll
                for (int n = 0; n < 2; ++n) acc[a][b][m][n] = (f32x4){0.f, 0.f, 0.f, 0.f};
    bf16x8 At[4][2], B0[2][2], B1[2][2];
    const char* cA = S.aptr(cur); const char* cB = S.bptr(cur);
    PG8_STAGE(PG8_SB(0, 0), cB, voffB); PG8_STAGE(PG8_SB(0, 1), cB + hstepB, voffB); PG8_GOFF(vgc, cur); PG8_STAGE_A(PG8_SA(0, 0), cA, 0, false); PG8_STAGE_A(PG8_SA(0, 1), cA + hstepA, 1, false);
    if (wr == 1) PG8_BAR;
    PG8_WAIT_V(2); PG8_BAR;
    PG8_STAGE(PG8_SB(1, 0), cB + kstep, voffB); PG8_STAGE_A(PG8_SA(1, 0), cA + kstep, 0, false); PG8_STAGE(PG8_SB(1, 1), cB + hstepB + kstep, voffB);
    PG8_WAIT_V(6); PG8_BAR;
    for (;;) {
        const bool has_next = S.next(ui + 1, nxt);
        const char* nA = has_next ? S.aptr(nxt) : cA; const char* nB = has_next ? S.bptr(nxt) : cB;
        if (has_next) PG8_GOFF(vgn, nxt); else { if constexpr (GA) { _Pragma("unroll") for (int h_ = 0; h_ < 2; ++h_) _Pragma("unroll") for (int i_ = 0; i_ < 2; ++i_) vgn[h_][i_] = vgc[h_][i_]; } }
        for (int t = 0; t < nt; t += 2) {
            const bool last = (t == nt - 2);
            const char* a1 = cA + (size_t)(t + 1) * kstep;
            const char* a2 = last ? nA : cA + (size_t)(t + 2) * kstep; const char* b2 = last ? nB : cB + (size_t)(t + 2) * kstep;
            const char* a3 = a2 + kstep; const char* b3 = b2 + kstep;
            PG8_LDB(B0, 0, 0); PG8_LDB(B1, 0, 1); PG8_SCHED; PG8_LDA(At, 0, 0); PG8_STAGE_A(PG8_SA(1, 1), a1 + hstepA, 1, false);
            PG8_WAIT_V(8); PG8_WAIT_L(0); PG8_BAR; PG8_MMA(0, 0, At, B0); PG8_MMA(0, 1, At, B1); PG8_BAR; PG8_SCHED;
            PG8_LDA(At, 0, 1); PG8_STAGE(PG8_SB(0, 0), b2, voffB); PG8_STAGE(PG8_SB(0, 1), b2 + hstepB, voffB); PG8_STAGE_A(PG8_SA(0, 0), a2, 0, last);
            PG8_WAIT_V(8); PG8_WAIT_L(0); PG8_BAR; PG8_MMA(1, 0, At, B0); PG8_MMA(1, 1, At, B1); PG8_BAR; PG8_SCHED;
            PG8_LDB(B0, 1, 0); PG8_LDB(B1, 1, 1); PG8_SCHED; PG8_LDA(At, 1, 0); PG8_STAGE_A(PG8_SA(0, 1), a2 + hstepA, 1, last);
            PG8_WAIT_V(8); PG8_WAIT_L(0); PG8_BAR; PG8_MMA(0, 0, At, B0); PG8_MMA(0, 1, At, B1); PG8_BAR; PG8_SCHED;
            PG8_LDA(At, 1, 1); PG8_STAGE(PG8_SB(1, 0), b3, voffB); PG8_STAGE(PG8_SB(1, 1), b3 + hstepB, voffB); PG8_STAGE_A(PG8_SA(1, 0), a3, 0, last);
            PG8_WAIT_V(8); PG8_WAIT_L(0); PG8_BAR; PG8_MMA(1, 0, At, B0); PG8_MMA(1, 1, At, B1); PG8_BAR; PG8_SCHED;
        }
        if (wr == 0) PG8_BAR;
        E(acc, cur, wr, wc, fr, fq);
        if (!has_next) break;
#pragma unroll
        for (int a = 0; a < 2; ++a)
#pragma unroll
            for (int b = 0; b < 2; ++b)
#pragma unroll
                for (int m = 0; m < 4; ++m)
#pragma unroll
                    for (int n = 0; n < 2; ++n) acc[a][b][m][n] = (f32x4){0.f, 0.f, 0.f, 0.f};
        cur = nxt; cA = nA; cB = nB; ++ui;
        if constexpr (GA) { _Pragma("unroll") for (int h_ = 0; h_ < 2; ++h_) _Pragma("unroll") for (int i_ = 0; i_ < 2; ++i_) vgc[h_][i_] = vgn[h_][i_]; }
        if (wr == 1) PG8_BAR;
    }
    PG8_WAIT_V(0);
    PG8_BAR;
#undef PG8_SA
#undef PG8_SB
#undef PG8_STAGE
#undef PG8_STAGE_A
#undef PG8_GOFF
#undef PG8_LDA
#undef PG8_LDB
#undef PG8_MMA
#undef PG8_WAIT_V
#undef PG8_WAIT_L
#undef PG8_BAR
#undef PG8_SCHED
}

struct EpiF32 {
    static constexpr bool PERM = false;
    float* C; int ldc; const float* R; int ldr;
    __device__ __forceinline__ void operator()(const f32x4 (&acc)[2][2][4][2], const Unit& u, int wr, int wc, int fr, int fq) const {
        const int row0 = u.pm * BM + wr * 64 + fr, col0 = u.pn * BM + wc * 32 + 4 * fq;
#pragma unroll
        for (int ai = 0; ai < 2; ++ai)
#pragma unroll
            for (int m = 0; m < 4; ++m) { const size_t row = (size_t)(row0 + ai * HALF + m * 16);
#pragma unroll
                for (int bj = 0; bj < 2; ++bj)
#pragma unroll
                    for (int n = 0; n < 2; ++n) { const int col = col0 + bj * HALF + 16 * n; f32x4 v = acc[ai][bj][m][n];
                        if (R) v = v + *(const f32x4*)(R + row * ldr + col);
                        *(f32x4*)(C + row * ldc + col) = v; } }
    }
};
struct EpiBf16 {
    static constexpr bool PERM = true;
    bf16* O; int ldc;
    __device__ __forceinline__ void operator()(const f32x4 (&acc)[2][2][4][2], const Unit& u, int wr, int wc, int fr, int fq) const {
        const int row0 = u.pm * BM + wr * 64 + fr, col0 = u.pn * BM + wc * 32 + 8 * fq;
#pragma unroll
        for (int ai = 0; ai < 2; ++ai)
#pragma unroll
            for (int m = 0; m < 4; ++m) { bf16* rowp = O + (size_t)(row0 + ai * HALF + m * 16) * ldc + col0;
#pragma unroll
                for (int bj = 0; bj < 2; ++bj) { const f32x4 v0 = acc[ai][bj][m][0], v1 = acc[ai][bj][m][1];
                    u32x4 w; w.x = cvt_pk_bf16(v0[0], v0[1]); w.y = cvt_pk_bf16(v0[2], v0[3]); w.z = cvt_pk_bf16(v1[0], v1[1]); w.w = cvt_pk_bf16(v1[2], v1[3]);
                    *(u32x4*)(rowp + bj * HALF) = w; } }
    }
};
struct EpiGlu {
    static constexpr bool PERM = true;
    const bf16* Z; const float* bias; bf16* YM;
    __device__ __forceinline__ void operator()(const f32x4 (&acc)[2][2][4][2], const Unit& u, int wr, int wc, int fr, int fq) const {
        const int row0 = u.pm * BM + wr * 64 + fr, col0 = u.pn * BM + wc * 32 + 8 * fq;
#pragma unroll
        for (int ai = 0; ai < 2; ++ai)
#pragma unroll
            for (int m = 0; m < 4; ++m) { const size_t row = (size_t)(row0 + ai * HALF + m * 16);
#pragma unroll
                for (int bj = 0; bj < 2; ++bj) { const int col = col0 + bj * HALF;
                    const u32x4 zz = *(const u32x4*)(Z + row * 512 + col);
                    const f32x4 b0 = *(const f32x4*)(bias + col), b1 = *(const f32x4*)(bias + col + 4);
                    const f32x4 v0 = acc[ai][bj][m][0] + b0, v1 = acc[ai][bj][m][1] + b1;
                    float o[8]; const unsigned zw[4] = {zz.x, zz.y, zz.z, zz.w};
#pragma unroll
                    for (int q = 0; q < 4; ++q) { const float zl = __builtin_bit_cast(float, zw[q] << 16), zh = __builtin_bit_cast(float, zw[q] & 0xffff0000u);
                        const float al = (q < 2) ? v0[2 * q] : v1[2 * q - 4], ah = (q < 2) ? v0[2 * q + 1] : v1[2 * q - 3];
                        o[2 * q] = zl * sigmoidf_(al); o[2 * q + 1] = zh * sigmoidf_(ah); }
                    u32x4 w; w.x = cvt_pk_bf16(o[0], o[1]); w.y = cvt_pk_bf16(o[2], o[3]); w.z = cvt_pk_bf16(o[4], o[5]); w.w = cvt_pk_bf16(o[6], o[7]);
                    *(u32x4*)(YM + row * D + 512 + col) = w; } }
    }
};

template <bool GATHER_>
struct MoeOrderT {
    static constexpr bool GATHER = GATHER_;
    const bf16* A; const bf16* Bt; int lda, ldb, K; const int* tiles; const int* rows; int nunits, G, c; size_t bexp;
    __device__ void init(const bf16* A_, int lda_, const bf16* Bt_, int ldb_, int K_, const int* tiles_, int ntiles, size_t bexp_, const int* rows_) { A = A_; Bt = Bt_; lda = lda_; ldb = ldb_; K = K_; tiles = tiles_; rows = rows_; nunits = ntiles * 4; G = GN; c = GB; bexp = bexp_; }
    __device__ bool next(int i, Unit& u) const { const int L = i * G + c; if (L >= nunits) return false; u.pm = L >> 2; u.pn = L & 3; return true; }
    __device__ __forceinline__ const char* aptr(const Unit& u) const { return GATHER ? (const char*)A : (const char*)(A + (size_t)u.pm * BM * lda); }
    __device__ __forceinline__ int grow(const Unit& u, int r) const { return rows[u.pm * BM + r]; }
    __device__ __forceinline__ const char* bptr(const Unit& u) const { const int e = __hip_atomic_load(tiles + u.pm, __ATOMIC_RELAXED, __HIP_MEMORY_SCOPE_AGENT); return (const char*)(Bt + ((size_t)e * bexp + (size_t)u.pn * BM) * ldb); }
};
struct EpiSilu {
    static constexpr bool PERM = true;
    bf16* HID;
    __device__ __forceinline__ void operator()(const f32x4 (&acc)[2][2][4][2], const Unit& u, int wr, int wc, int fr, int fq) const {
        const int row0 = u.pm * BM + wr * 64 + fr, col0 = u.pn * HALF + wc * 32 + 8 * fq;
#pragma unroll
        for (int ai = 0; ai < 2; ++ai)
#pragma unroll
            for (int m = 0; m < 4; ++m) { const size_t row = (size_t)(row0 + ai * HALF + m * 16);
                float o[8];
#pragma unroll
                for (int n = 0; n < 2; ++n)
#pragma unroll
                    for (int q = 0; q < 4; ++q) { const float g = acc[ai][0][m][n][q], up = acc[ai][1][m][n][q]; o[4 * n + q] = g * sigmoidf_(g) * up; }
                u32x4 w; w.x = cvt_pk_bf16(o[0], o[1]); w.y = cvt_pk_bf16(o[2], o[3]); w.z = cvt_pk_bf16(o[4], o[5]); w.w = cvt_pk_bf16(o[6], o[7]);
                *(u32x4*)(HID + row * DEXP + col0) = w; }
    }
};
struct EpiGate {
    static constexpr bool PERM = true;
    bf16* Y; const float* gate;
    __device__ __forceinline__ void operator()(const f32x4 (&acc)[2][2][4][2], const Unit& u, int wr, int wc, int fr, int fq) const {
        const int row0 = u.pm * BM + wr * 64 + fr, col0 = u.pn * BM + wc * 32 + 8 * fq;
#pragma unroll
        for (int ai = 0; ai < 2; ++ai)
#pragma unroll
            for (int m = 0; m < 4; ++m) { const size_t row = (size_t)(row0 + ai * HALF + m * 16); const float gt = gate[row];
#pragma unroll
                for (int bj = 0; bj < 2; ++bj) { const f32x4 v0 = acc[ai][bj][m][0] * gt, v1 = acc[ai][bj][m][1] * gt;
                    u32x4 w; w.x = cvt_pk_bf16(v0[0], v0[1]); w.y = cvt_pk_bf16(v0[2], v0[3]); w.z = cvt_pk_bf16(v1[0], v1[1]); w.w = cvt_pk_bf16(v1[2], v1[3]);
                    *(u32x4*)(Y + row * D + col0 + bj * HALF) = w; } }
    }
};

struct EpiProj {
    static constexpr bool PERM = true;
    bf16* PROJ; bf16* US5;
    __device__ __forceinline__ void operator()(const f32x4 (&acc)[2][2][4][2], const Unit& u, int wr, int wc, int fr, int fq) const {
        const int row0 = u.pm * BM + wr * 64 + fr, col0 = u.pn * BM + wc * 32 + 8 * fq;
#pragma unroll
        for (int ai = 0; ai < 2; ++ai)
#pragma unroll
            for (int m = 0; m < 4; ++m) { const size_t row = (size_t)(row0 + ai * HALF + m * 16);
#pragma unroll
                for (int bj = 0; bj < 2; ++bj) { const f32x4 v0 = acc[ai][bj][m][0], v1 = acc[ai][bj][m][1]; const int col = col0 + bj * HALF;
                    u32x4 w; w.x = cvt_pk_bf16(v0[0], v0[1]); w.y = cvt_pk_bf16(v0[2], v0[3]); w.z = cvt_pk_bf16(v1[0], v1[1]); w.w = cvt_pk_bf16(v1[2], v1[3]);
                    if (col < DSHIFT) *(u32x4*)(PROJ + row * DSHIFT + col) = w;
                    else { const int cc = col - DSHIFT; *(u32x4*)(US5 + ((size_t)(cc >> 4) * M + row) * 16 + (cc & 15)) = w; } } }
    }
};
struct GroupOrder {
    static constexpr bool GATHER = false; __device__ __forceinline__ int grow(const Unit&, int) const { return 0; }
    const bf16* A; const bf16* Bt; int lda, ldb, K; int nM, nN, nunits, G, c; size_t sA, sB;
    __device__ void init(const bf16* A_, int lda_, size_t sA_, const bf16* Bt_, int ldb_, size_t sB_, int ngroups, int Mg, int Ng, int K_) {
        A = A_; Bt = Bt_; lda = lda_; ldb = ldb_; K = K_; sA = sA_; sB = sB_; nM = Mg / BM; nN = Ng / BM; nunits = ngroups * nM * nN; G = GN; c = GB; }
    __device__ bool next(int i, Unit& u) const { const int L = i * G + c; if (L >= nunits) return false; u.pn = L % nN; u.pm = L / nN; return true; }
    __device__ __forceinline__ const char* aptr(const Unit& u) const { const int g = u.pm / nM, pm = u.pm % nM; return (const char*)(A + (size_t)g * sA + (size_t)pm * BM * lda); }
    __device__ __forceinline__ const char* bptr(const Unit& u) const { const int g = u.pm / nM; return (const char*)(Bt + (size_t)g * sB + (size_t)u.pn * BM * ldb); }
};
struct EpiS5a {
    static constexpr bool PERM = false;
    bf16* YI; float* F;
    __device__ __forceinline__ void operator()(const f32x4 (&acc)[2][2][4][2], const Unit& u, int wr, int wc, int fr, int fq) const {
        const int row0 = u.pm * BM + wr * 64 + fr, col0 = u.pn * BM + wc * 32 + 4 * fq;
#pragma unroll
        for (int ai = 0; ai < 2; ++ai)
#pragma unroll
            for (int m = 0; m < 4; ++m) { const size_t row = (size_t)(row0 + ai * HALF + m * 16);
#pragma unroll
                for (int bj = 0; bj < 2; ++bj)
#pragma unroll
                    for (int n = 0; n < 2; ++n) { const int col = col0 + bj * HALF + 16 * n; const f32x4 v = acc[ai][bj][m][n];
                        if (col < 512) { uint2 w; w.x = cvt_pk_bf16(v[0], v[1]); w.y = cvt_pk_bf16(v[2], v[3]); *(uint2*)(YI + row * 512 + col) = w; }
                        else if (col < 640) *(f32x4*)(F + row * 128 + (col - 512)) = v; } }
    }
};
struct EpiS5b {
    static constexpr bool PERM = true;
    const bf16* YI; bf16* Z;
    __device__ __forceinline__ void operator()(const f32x4 (&acc)[2][2][4][2], const Unit& u, int wr, int wc, int fr, int fq) const {
        const int row0 = u.pm * BM + wr * 64 + fr, col0 = u.pn * BM + wc * 32 + 8 * fq;
#pragma unroll
        for (int ai = 0; ai < 2; ++ai)
#pragma unroll
            for (int m = 0; m < 4; ++m) { const int row = row0 + ai * HALF + m * 16; const int g = row / S5R, rl = row % S5R;
#pragma unroll
                for (int bj = 0; bj < 2; ++bj) { const int col = col0 + bj * HALF;
                    const u32x4 yi = *(const u32x4*)(YI + (size_t)row * 512 + col);
                    const unsigned yw[4] = {yi.x, yi.y, yi.z, yi.w};
                    const f32x4 v0 = acc[ai][bj][m][0], v1 = acc[ai][bj][m][1];
                    float o[8];
#pragma unroll
                    for (int q = 0; q < 4; ++q) { const float al = (q < 2) ? v0[2 * q] : v1[2 * q - 4], ah = (q < 2) ? v0[2 * q + 1] : v1[2 * q - 3];
                        o[2 * q] = gelu_tanh(al + __builtin_bit_cast(float, yw[q] << 16)); o[2 * q + 1] = gelu_tanh(ah + __builtin_bit_cast(float, yw[q] & 0xffff0000u)); }
                    u32x4 w; w.x = cvt_pk_bf16(o[0], o[1]); w.y = cvt_pk_bf16(o[2], o[3]); w.z = cvt_pk_bf16(o[4], o[5]); w.w = cvt_pk_bf16(o[6], o[7]);
                    const size_t tok = (size_t)rl * S5L + (col >> 4);
                    *(u32x4*)(Z + tok * 512 + g * 16 + (col & 15)) = w; } }
    }
};
struct AttnOrder {
    static constexpr bool GATHER = false; __device__ __forceinline__ int grow(const Unit&, int) const { return 0; }
    const bf16* A; const bf16* Bt; int lda, ldb, K; int G, c; int mode;
    __device__ void init(const bf16* A_, const bf16* Bt_, int ldb_, int mode_) { A = A_; Bt = Bt_; lda = D; ldb = ldb_; K = 256; G = GN; c = GB; mode = mode_; }
    __device__ bool next(int i, Unit& u) const { const int L = i * G + c; if (L >= NB * 4 * 32) return false; u.pn = L & 3; u.pm = L >> 2; return true; }
    __device__ __forceinline__ const char* aptr(const Unit& u) const { return (const char*)(A + (size_t)u.pm * BM * D + u.pn * 256); }
    __device__ __forceinline__ const char* bptr(const Unit& u) const { const int b = u.pm >> 5;
        return (const char*)(mode == 0 ? Bt + (size_t)b * 256 * ldb + u.pn * 256 : Bt + (size_t)u.pn * 256 * ldb + b * 256); }
};
struct EpiSoftmax {
    static constexpr bool PERM = true;
    bf16* P; PG8_LAS float* scr;
    __device__ __forceinline__ void operator()(f32x4 (&acc)[2][2][4][2], const Unit& u, int wr, int wc, int fr, int fq) const {
        const float SC = 0.0625f * 1.4426950408889634f;
        PG8_LAS float* smax = scr; PG8_LAS float* ssum = scr + 1024;
#pragma unroll
        for (int ai = 0; ai < 2; ++ai)
#pragma unroll
            for (int m = 0; m < 4; ++m) { float t = -3.0e38f;
#pragma unroll
                for (int bj = 0; bj < 2; ++bj)
#pragma unroll
                    for (int n = 0; n < 2; ++n) { const f32x4 v = acc[ai][bj][m][n]; t = fmaxf(t, fmaxf(fmaxf(v[0], v[1]), fmaxf(v[2], v[3]))); }
                t = fmaxf(t, __shfl_xor(t, 16)); t = fmaxf(t, __shfl_xor(t, 32));
                if (fq == 0) smax[(ai * HALF + wr * 64 + m * 16 + fr) * 4 + wc] = t; }
        asm volatile("s_waitcnt lgkmcnt(0)" ::: "memory"); __builtin_amdgcn_s_barrier(); asm volatile("" ::: "memory");
#pragma unroll
        for (int ai = 0; ai < 2; ++ai)
#pragma unroll
            for (int m = 0; m < 4; ++m) { const f32x4 q = *(const PG8_LAS f32x4*)(smax + (ai * HALF + wr * 64 + m * 16 + fr) * 4);
                const float mm = fmaxf(fmaxf(q[0], q[1]), fmaxf(q[2], q[3])) * SC; float s = 0.f;
#pragma unroll
                for (int bj = 0; bj < 2; ++bj)
#pragma unroll
                    for (int n = 0; n < 2; ++n)
#pragma unroll
                        for (int e = 0; e < 4; ++e) { const float p = __builtin_amdgcn_exp2f(acc[ai][bj][m][n][e] * SC - mm); acc[ai][bj][m][n][e] = p; s += p; }
                s += __shfl_xor(s, 16); s += __shfl_xor(s, 32);
                if (fq == 0) ssum[(ai * HALF + wr * 64 + m * 16 + fr) * 4 + wc] = s; }
        asm volatile("s_waitcnt lgkmcnt(0)" ::: "memory"); __builtin_amdgcn_s_barrier(); asm volatile("" ::: "memory");
        const int row0 = u.pm * BM + wr * 64 + fr, col0 = u.pn * 256 + wc * 32 + 8 * fq;
#pragma unroll
        for (int ai = 0; ai < 2; ++ai)
#pragma unroll
            for (int m = 0; m < 4; ++m) { const f32x4 q = *(const PG8_LAS f32x4*)(ssum + (ai * HALF + wr * 64 + m * 16 + fr) * 4);
                const float iv = 1.f / ((q[0] + q[1]) + (q[2] + q[3]));
                bf16* rowp = P + (size_t)(row0 + ai * HALF + m * 16) * D + col0;
#pragma unroll
                for (int bj = 0; bj < 2; ++bj) { const f32x4 v0 = acc[ai][bj][m][0] * iv, v1 = acc[ai][bj][m][1] * iv; u32x4 w;
                    w.x = cvt_pk_bf16(v0[0], v0[1]); w.y = cvt_pk_bf16(v0[2], v0[3]); w.z = cvt_pk_bf16(v1[0], v1[1]); w.w = cvt_pk_bf16(v1[2], v1[3]);
                    *(u32x4*)(rowp + bj * HALF) = w; } }
    }
};
struct EpiAttnO {
    static constexpr bool PERM = true;
    bf16* O;
    __device__ __forceinline__ void operator()(const f32x4 (&acc)[2][2][4][2], const Unit& u, int wr, int wc, int fr, int fq) const {
        const int row0 = u.pm * BM + wr * 64 + fr, col0 = u.pn * 256 + wc * 32 + 8 * fq;
#pragma unroll
        for (int ai = 0; ai < 2; ++ai)
#pragma unroll
            for (int m = 0; m < 4; ++m) { bf16* rowp = O + (size_t)(row0 + ai * HALF + m * 16) * D + col0;
#pragma unroll
                for (int bj = 0; bj < 2; ++bj) { const f32x4 v0 = acc[ai][bj][m][0], v1 = acc[ai][bj][m][1];
                    u32x4 w; w.x = cvt_pk_bf16(v0[0], v0[1]); w.y = cvt_pk_bf16(v0[2], v0[3]); w.z = cvt_pk_bf16(v1[0], v1[1]); w.w = cvt_pk_bf16(v1[2], v1[3]);
                    *(u32x4*)(rowp + bj * HALF) = w; } }
    }
};

struct EpiLora {
    static constexpr bool PERM = true;
    bf16* LW; size_t ostride; const float* w0; const float* a0;
    __device__ __forceinline__ void operator()(const f32x4 (&acc)[2][2][4][2], const Unit& u, int wr, int wc, int fr, int fq) const {
        const int row0 = u.pm * BM + wr * 64 + fr, col0 = u.pn * BM + wc * 32 + 8 * fq;
        const int kind = u.pn >> 1;
        bf16* O = LW + (size_t)kind * ostride;
#pragma unroll
        for (int bj = 0; bj < 2; ++bj) { const int col = (col0 + bj * HALF) & 511;
            f32x4 b0 = (f32x4){0.f, 0.f, 0.f, 0.f}, b1 = b0;
            if (kind == 0) { b0 = *(const f32x4*)(w0 + col); b1 = *(const f32x4*)(w0 + col + 4); }
            else if (kind == 1) { b0 = *(const f32x4*)(a0 + col); b1 = *(const f32x4*)(a0 + col + 4); }
#pragma unroll
            for (int ai = 0; ai < 2; ++ai)
#pragma unroll
                for (int m = 0; m < 4; ++m) { const size_t row = (size_t)(row0 + ai * HALF + m * 16);
                    const f32x4 v0 = acc[ai][bj][m][0] + b0, v1 = acc[ai][bj][m][1] + b1; float o[8];
#pragma unroll
                    for (int e = 0; e < 8; ++e) { float x = (e < 4) ? v0[e & 3] : v1[e & 3];
                        if (kind == 0) x = -0.6065306597126334f * sigmoidf_(x);
                        else if (kind == 1) x = sigmoidf_(x);
                        o[e] = x; }
                    u32x4 w; w.x = cvt_pk_bf16(o[0], o[1]); w.y = cvt_pk_bf16(o[2], o[3]); w.z = cvt_pk_bf16(o[4], o[5]); w.w = cvt_pk_bf16(o[6], o[7]);
                    *(u32x4*)(O + row * 512 + col) = w; } }
    }
};

struct TileOrder {
    static constexpr bool GATHER = false; __device__ __forceinline__ int grow(const Unit&, int) const { return 0; }
    const bf16* A; const bf16* Bt; int lda, ldb, K, nN, pm;
    __device__ void init(const bf16* A_, int lda_, const bf16* Bt_, int ldb_, int K_, int nN_, int pm_) { A = A_; Bt = Bt_; lda = lda_; ldb = ldb_; K = K_; nN = nN_; pm = pm_; }
    __device__ bool next(int i, Unit& u) const { if (i >= nN) return false; int pm_ = pm; asm volatile("" : "+s"(pm_)); u.pm = pm_; u.pn = i; return true; }
    __device__ __forceinline__ const char* aptr(const Unit& u) const { return (const char*)(A + (size_t)u.pm * BM * lda); }
    __device__ __forceinline__ const char* bptr(const Unit& u) const { return (const char*)(Bt + (size_t)u.pn * BM * ldb); }
};
struct AttnTileOrder {
    static constexpr bool GATHER = false; __device__ __forceinline__ int grow(const Unit&, int) const { return 0; }
    const bf16* A; const bf16* Bt; int lda, ldb, K, pm, mode;
    __device__ void init(const bf16* A_, const bf16* Bt_, int ldb_, int mode_, int pm_) { A = A_; Bt = Bt_; lda = D; ldb = ldb_; K = 256; mode = mode_; pm = pm_; }
    __device__ bool next(int i, Unit& u) const { if (i >= 4) return false; int pm_ = pm; asm volatile("" : "+s"(pm_)); u.pm = pm_; u.pn = i; return true; }
    __device__ __forceinline__ const char* aptr(const Unit& u) const { return (const char*)(A + (size_t)u.pm * BM * D + u.pn * 256); }
    __device__ __forceinline__ const char* bptr(const Unit& u) const { const int b = u.pm >> 5;
        return (const char*)(mode == 0 ? Bt + (size_t)b * 256 * ldb + u.pn * 256 : Bt + (size_t)u.pn * 256 * ldb + b * 256); }
};
}

#define LAS __attribute__((address_space(3)))
__device__ __forceinline__ void transpose_item(const float* __restrict__ W, int K, int N, bf16* __restrict__ WT, int ldt, int row_off, int col_off, float* scr, int item, int lane, const float* __restrict__ kscale, int ldw = 0) {
    if (ldw == 0) ldw = N;
    const int nblk = N / 32, kb = item / nblk, nb = item % nblk, k0 = 64 * kb, n0 = 32 * nb;
#pragma unroll 8
    for (int i = 0; i < 32; ++i) { const int kk = 2 * i + (lane >> 5); float v = W[(size_t)(k0 + kk) * ldw + n0 + (lane & 31)]; if (kscale) v *= kscale[k0 + kk]; scr[kk * 33 + (lane & 31)] = v; }
    __builtin_amdgcn_s_waitcnt(0xc07f); asm volatile("" ::: "memory");
    const int c = lane & 7;
#pragma unroll
    for (int j = 0; j < 4; ++j) { const int n = (lane >> 3) + 8 * j; const float* s = scr + (8 * c) * 33 + n;
        uint4 o; o.x = pk2(s[0 * 33], s[1 * 33]); o.y = pk2(s[2 * 33], s[3 * 33]); o.z = pk2(s[4 * 33], s[5 * 33]); o.w = pk2(s[6 * 33], s[7 * 33]);
        *(uint4*)(WT + (size_t)(row_off + n0 + n) * ldt + col_off + k0 + 8 * c) = o; }
    __builtin_amdgcn_s_waitcnt(0xc07f); asm volatile("" ::: "memory");
}
__device__ __forceinline__ void transpose_ph(const int WID_, const float* W, int K, int N, bf16* WT, int ldt, int row_off, int col_off, char* lds, const float* kscale = nullptr) {
    const int lane = (WID_ * 64 + lane_id()) & 63, wv = (WID_ * 64 + lane_id()) >> 6;
    float* scr = (float*)(lds + wv * 16384);
    const int nitems = (K / 64) * (N / 32);
    for (int it = GB * 8 + wv; it < nitems; it += GN * 8) transpose_item(W, K, N, WT, ldt, row_off, col_off, scr, it, lane, kscale);
}

template <typename TO>
__device__ __forceinline__ void rmsnorm_ph(const int WID_, const float* __restrict__ x, const float* __restrict__ w, TO* __restrict__ out, int rows, int row_lo = 0, int vb = GB, int nvb = GN) {
    const int lane = lane_id(), wv = WID_;
    float4 g[4];
#pragma unroll
    for (int j = 0; j < 4; ++j) g[j] = *(const float4*)(w + (lane + 64 * j) * 4);
    for (int row = row_lo + (vb * 8 + wv) * 2; row < rows; row += nvb * 16) {
        const float4* xr = (const float4*)(x + (size_t)row * D);
        float4 v[2][4]; float s[2] = {0.f, 0.f};
#pragma unroll
        for (int r = 0; r < 2; ++r)
#pragma unroll
            for (int j = 0; j < 4; ++j) v[r][j] = xr[r * (D / 4) + lane + 64 * j];
#pragma unroll
        for (int r = 0; r < 2; ++r) {
#pragma unroll
            for (int j = 0; j < 4; ++j) s[r] += v[r][j].x * v[r][j].x + v[r][j].y * v[r][j].y + v[r][j].z * v[r][j].z + v[r][j].w * v[r][j].w;
            s[r] = wave_sum(s[r]);
            const float rs = rsqrtf(s[r] * (1.f / D) + 1e-6f);
#pragma unroll
            for (int j = 0; j < 4; ++j) {
                uint2 o; o.x = pk2(v[r][j].x * rs * g[j].x, v[r][j].y * rs * g[j].y); o.y = pk2(v[r][j].z * rs * g[j].z, v[r][j].w * rs * g[j].w);
                *(uint2*)(out + (size_t)(row + r) * D + (lane + 64 * j) * 4) = o;
            }
        }
    }
}

__device__ __forceinline__ void rwkv_lin_ph(const int WID_, const bf16* __restrict__ proj, const float* __restrict__ mu, bf16* __restrict__ lin) {
    const int lane = lane_id(), wv = WID_;
    const float4 m4 = *(const float4*)(mu + 1536 + 4 * lane);
    const float mm[4] = {m4.x, m4.y, m4.z, m4.w};
    for (int m0 = (GB * 8 + wv) * 4; m0 < M; m0 += GN * 32) {
        uint2 z[4], zp[4];
#pragma unroll
        for (int i = 0; i < 4; ++i) { const int m = m0 + i; z[i] = *(const uint2*)(proj + (size_t)m * DSHIFT + 1536 + 4 * lane);
            zp[i] = make_uint2(0, 0); if ((m & (S - 1)) != 0) zp[i] = *(const uint2*)(proj + (size_t)(m - 1) * DSHIFT + 1536 + 4 * lane); }
#pragma unroll
        for (int i = 0; i < 4; ++i) {
            float c[4] = {__builtin_bit_cast(float, z[i].x << 16), __builtin_bit_cast(float, z[i].x & 0xffff0000u), __builtin_bit_cast(float, z[i].y << 16), __builtin_bit_cast(float, z[i].y & 0xffff0000u)};
            const float q[4] = {__builtin_bit_cast(float, zp[i].x << 16), __builtin_bit_cast(float, zp[i].x & 0xffff0000u), __builtin_bit_cast(float, zp[i].y << 16), __builtin_bit_cast(float, zp[i].y & 0xffff0000u)};
#pragma unroll
            for (int e = 0; e < 4; ++e) { float t = c[e] + (q[e] - c[e]) * mm[e];
                if (lane < 16) t = 1.f - 2.f / (1.f + __expf(2.f * t));
                else if (lane >= 32) t = sigmoidf_(t);
                c[e] = t; }
            uint2 o; o.x = pk2(c[0], c[1]); o.y = pk2(c[2], c[3]);
            *(uint2*)(lin + (size_t)(m0 + i) * 256 + 4 * lane) = o;
        }
    }
}
__device__ __forceinline__ void rwkv_wl_ph(const int WID_, const float* __restrict__ wdec, const float* __restrict__ wiclr, const float* __restrict__ wgate, bf16* __restrict__ wl) {
    for (int i = GB * NT + (WID_ * 64 + lane_id()); i < 1536 * 256; i += GN * NT) {
        const int k = i & 255, n = i >> 8; float v = 0.f;
        if (n < 512) { if (k < 64) v = wdec[k * 512 + n]; }
        else if (n < 1024) { if (k >= 64 && k < 128) v = wiclr[(k - 64) * 512 + (n - 512)]; }
        else { if (k >= 128) v = wgate[(k - 128) * 512 + (n - 1024)]; }
        wl[i] = f2bf(v);
    }
}
template <int CTRL> __device__ __forceinline__ float dpp16(float x) { return __builtin_bit_cast(float, __builtin_amdgcn_update_dpp(0, __builtin_bit_cast(int, x), CTRL, 0xf, 0xf, true)); }
constexpr int RW_ITEMS = NB * 8;

namespace ck {
#define CK_BAR() do { asm volatile("s_waitcnt lgkmcnt(0)" ::: "memory"); __builtin_amdgcn_s_barrier(); asm volatile("" ::: "memory"); } while (0)
typedef float f32x2_t __attribute__((ext_vector_type(2)));
typedef __bf16 bf16x2_t __attribute__((ext_vector_type(2)));
__device__ __forceinline__ unsigned cvtpk(float lo, float hi) { const f32x2_t v = {lo, hi}; const bf16x2_t b = __builtin_convertvector(v, bf16x2_t); return __builtin_bit_cast(unsigned, b); }
typedef short bf16x8 __attribute__((ext_vector_type(8)));
typedef float f32x16 __attribute__((ext_vector_type(16)));
constexpr int LD = 72;
constexpr int MB = 64 * LD * 2;
constexpr int O_AB = 0, O_RB = MB, O_BB = 2 * MB, O_KB = 3 * MB, O_AT = 4 * MB, O_W1T = 5 * MB, O_BT = 6 * MB, O_KT = 7 * MB, O_VT = 8 * MB,
              O_NM = 9 * MB, O_AAK = 10 * MB, O_ARB = 11 * MB, O_ARK = 12 * MB, O_G = 13 * MB, O_TOT = O_G + 16384;
constexpr int O_TM = O_AB, O_X1T = O_BB, O_NMF = O_G, O_TT = O_G + 8192, O_ZT = O_TT + 5120;
constexpr int ITEM_BYTES = 32768;
template <int K, typename PA, typename PB>
__device__ __forceinline__ f32x16 mm_tile(f32x16 acc, PA A, int lda, PB B, int ldb, int lane) {
    const int r = lane & 31, h = lane >> 5;
    bf16x8 a[K / 16], b[K / 16];
#pragma unroll
    for (int q = 0; q < K / 16; ++q) { a[q] = *(const bf16x8*)(A + r * lda + 16 * q + 8 * h); b[q] = *(const bf16x8*)(B + r * ldb + 16 * q + 8 * h); }
#pragma unroll
    for (int q = 0; q < K / 16; ++q) acc = __builtin_amdgcn_mfma_f32_32x32x16_bf16(a[q], b[q], acc, 0, 0, 0);
    return acc;
}
__device__ __forceinline__ int crow(int reg, int h) { return (reg & 3) + 8 * (reg >> 2) + 4 * h; }
__device__ __forceinline__ void store_tr(const f32x16& acc, bf16* Ct, int ldct, int lane) {
    const int c = lane & 31, h = lane >> 5;
#pragma unroll
    for (int g = 0; g < 4; ++g) { uint2 w; w.x = cvtpk(acc[4 * g], acc[4 * g + 1]); w.y = cvtpk(acc[4 * g + 2], acc[4 * g + 3]); *(uint2*)(Ct + c * ldct + 8 * g + 4 * h) = w; }
}
__device__ __forceinline__ void store_rm(const f32x16& acc, bf16* C, int ldc, int lane) {
    const int c = lane & 31, h = lane >> 5;
#pragma unroll
    for (int rg = 0; rg < 16; ++rg) C[crow(rg, h) * ldc + c] = f2bf(acc[rg]);
}
__device__ __forceinline__ f32x16 zero16() { return (f32x16){0.f, 0.f, 0.f, 0.f, 0.f, 0.f, 0.f, 0.f, 0.f, 0.f, 0.f, 0.f, 0.f, 0.f, 0.f, 0.f}; }
__device__ __forceinline__ void store_frag16(const f32x16& acc, bf16* base, int t0, int t1, int lane) {
    const int cc = lane & 31, hh = lane >> 5, col = 32 * t1 + cc;
#pragma unroll
    for (int g = 0; g < 4; ++g) { const int row = 32 * t0 + 8 * g + 4 * hh;
        uint2 w; w.x = cvtpk(acc[4 * g], acc[4 * g + 1]); w.y = cvtpk(acc[4 * g + 2], acc[4 * g + 3]);
        *(uint2*)(base + (((row >> 4) * 4 + (col >> 4)) * 64 + (col & 15) + 16 * ((row & 15) >> 2)) * 4) = w; }
}
struct In { const bf16* proj; const bf16* LW; const bf16* AA; const float* mu; const float* k_k; const float* k_a; const float* r_k; float* RK; char* items; };

__device__ __forceinline__ void phase1(const int WID_, const In& I, char* lds) {
    const int wv = WID_;
#define MAT(off) ((bf16*)(lds + (off)))
    float* G = (float*)(lds + O_G); float* TOT = (float*)(lds + O_TOT); float* NMF = (float*)(lds + O_NMF);
    uint4 nx_r, nx_k, nx_v, nx_qr, nx_qk, nx_qv, nx_a, nx_l;
    { const int lane0 = lane_id(), tid0 = wv * 64 + lane0; const int item = GB;
      if (item < NB * 8 * (S / 64)) { const int c = item & 127, h = (item >> 7) & 7, b = item >> 10, s = tid0 >> 3, cg = tid0 & 7, ch0 = h * 64 + cg * 8, t = c * 64 + s; const size_t m = (size_t)b * S + t;
        const bf16* z = I.proj + m * DSHIFT + ch0;
        nx_r = *(const uint4*)(z); nx_k = *(const uint4*)(z + 512); nx_v = *(const uint4*)(z + 1024);
        nx_qr = make_uint4(0, 0, 0, 0); nx_qk = nx_qr; nx_qv = nx_qr;
        if (t > 0) { nx_qr = *(const uint4*)(z - DSHIFT); nx_qk = *(const uint4*)(z + 512 - DSHIFT); nx_qv = *(const uint4*)(z + 1024 - DSHIFT); }
        nx_a = *(const uint4*)(I.AA + m * 512 + ch0); nx_l = *(const uint4*)(I.LW + m * 512 + ch0); } }
    for (int item = GB; item < NB * 8 * (S / 64); item += GN) {
        const int lane = lane_id(), tid = wv * 64 + lane;
        const int c = item & 127, h = (item >> 7) & 7, b = item >> 10;
        char* out = I.items + (size_t)item * ITEM_BYTES;
        const int s = tid >> 3, cg = tid & 7, ch0 = h * 64 + cg * 8, t = c * 64 + s; const size_t m = (size_t)b * S + t;
        float r_[8], kp_[8], v_[8], kk_[8], b_[8];
        {
            const uint4 gr = nx_r, gk = nx_k, gv = nx_v, qr = nx_qr, qk = nx_qk, qv = nx_qv, ga = nx_a, gl = nx_l;
            const float4 c_mr0 = *(const float4*)(I.mu + ch0), c_mr1 = *(const float4*)(I.mu + ch0 + 4), c_mk0 = *(const float4*)(I.mu + 512 + ch0), c_mk1 = *(const float4*)(I.mu + 512 + ch0 + 4);
            const float4 c_mv0 = *(const float4*)(I.mu + 1024 + ch0), c_mv1 = *(const float4*)(I.mu + 1024 + ch0 + 4), c_kk0 = *(const float4*)(I.k_k + ch0), c_kk1 = *(const float4*)(I.k_k + ch0 + 4);
            const float4 c_ka0 = *(const float4*)(I.k_a + ch0), c_ka1 = *(const float4*)(I.k_a + ch0 + 4), c_rk0 = *(const float4*)(I.r_k + ch0), c_rk1 = *(const float4*)(I.r_k + ch0 + 4);
            const float mur[8] = {c_mr0.x, c_mr0.y, c_mr0.z, c_mr0.w, c_mr1.x, c_mr1.y, c_mr1.z, c_mr1.w}, muk[8] = {c_mk0.x, c_mk0.y, c_mk0.z, c_mk0.w, c_mk1.x, c_mk1.y, c_mk1.z, c_mk1.w};
            const float muv[8] = {c_mv0.x, c_mv0.y, c_mv0.z, c_mv0.w, c_mv1.x, c_mv1.y, c_mv1.z, c_mv1.w}, ckk[8] = {c_kk0.x, c_kk0.y, c_kk0.z, c_kk0.w, c_kk1.x, c_kk1.y, c_kk1.z, c_kk1.w};
            const float cka[8] = {c_ka0.x, c_ka0.y, c_ka0.z, c_ka0.w, c_ka1.x, c_ka1.y, c_ka1.z, c_ka1.w}, crk[8] = {c_rk0.x, c_rk0.y, c_rk0.z, c_rk0.w, c_rk1.x, c_rk1.y, c_rk1.z, c_rk1.w};
            const unsigned wr[4] = {gr.x, gr.y, gr.z, gr.w}, wk[4] = {gk.x, gk.y, gk.z, gk.w}, wv4[4] = {gv.x, gv.y, gv.z, gv.w};
            const unsigned pr[4] = {qr.x, qr.y, qr.z, qr.w}, pk[4] = {qk.x, qk.y, qk.z, qk.w}, pv[4] = {qv.x, qv.y, qv.z, qv.w};
            const unsigned wa[4] = {ga.x, ga.y, ga.z, ga.w}, wl[4] = {gl.x, gl.y, gl.z, gl.w};
            float ss = 0.f, rk = 0.f, a_[8];
#pragma unroll
            for (int e = 0; e < 8; ++e) { const int w_ = e >> 1; const bool hi = e & 1;
                auto ex = [&](unsigned u) { return hi ? __builtin_bit_cast(float, u & 0xffff0000u) : __builtin_bit_cast(float, u << 16); };
                float x = ex(wr[w_]); r_[e] = x + (ex(pr[w_]) - x) * mur[e];
                x = ex(wk[w_]); const float k = x + (ex(pk[w_]) - x) * muk[e];
                x = ex(wv4[w_]); v_[e] = x + (ex(pv[w_]) - x) * muv[e];
                a_[e] = ex(wa[w_]); kk_[e] = k * ckk[e]; ss += kk_[e] * kk_[e];
                kp_[e] = k * (1.f + (a_[e] - 1.f) * cka[e]); rk += r_[e] * kp_[e] * crk[e];
                G[s * 64 + cg * 8 + e] = ex(wl[w_]); }
            ss += dpp16<0xB1>(ss); ss += dpp16<0x4E>(ss); ss += dpp16<0x141>(ss);
            const float inv = 1.f / fmaxf(sqrtf(ss), 1e-12f);
#pragma unroll
            for (int e = 0; e < 8; ++e) { kk_[e] *= inv; b_[e] = kk_[e] * a_[e]; }
            rk += dpp16<0xB1>(rk); rk += dpp16<0x4E>(rk); rk += dpp16<0x141>(rk);
            if (cg == 0) I.RK[m * 8 + h] = rk;
        }
        CK_BAR();
        { const int ch = tid & 63, part = tid >> 6; float run = 0.f;
#pragma unroll
          for (int i = 0; i < 8; ++i) { run += G[(8 * part + i) * 64 + ch]; G[(8 * part + i) * 64 + ch] = run; }
          TOT[part * 64 + ch] = run; }
        CK_BAR();
        { const int ch = tid & 63, part = tid >> 6; float off = 0.f;
          for (int p = 0; p < part; ++p) off += TOT[p * 64 + ch];
#pragma unroll
          for (int i = 0; i < 8; ++i) G[(8 * part + i) * 64 + ch] += off; }
        CK_BAR();
        float glast[8];
        {
            unsigned pab[4], prb[4], pbb[4], pkb[4];
            float ab[8], rb[8], bb[8], kb[8], bt[8], kt[8];
            const float4 g0_ = *(const float4*)(G + s * 64 + cg * 8), g1_ = *(const float4*)(G + s * 64 + cg * 8 + 4);
            const int sm = (s > 0) ? s - 1 : 0; const float msk = (s > 0) ? 1.f : 0.f;
            const float4 m0_ = *(const float4*)(G + sm * 64 + cg * 8), m1_ = *(const float4*)(G + sm * 64 + cg * 8 + 4);
            const float4 l0_ = *(const float4*)(G + 63 * 64 + cg * 8), l1_ = *(const float4*)(G + 63 * 64 + cg * 8 + 4);
            const float gv_[8] = {g0_.x, g0_.y, g0_.z, g0_.w, g1_.x, g1_.y, g1_.z, g1_.w}, mv_[8] = {m0_.x, m0_.y, m0_.z, m0_.w, m1_.x, m1_.y, m1_.z, m1_.w}, lv_[8] = {l0_.x, l0_.y, l0_.z, l0_.w, l1_.x, l1_.y, l1_.z, l1_.w};
#pragma unroll
            for (int e = 0; e < 8; ++e) { const float g = gv_[e], gm1 = mv_[e] * msk, gL = lv_[e];
                glast[e] = gL;
                const float eg = __expf(g), eng = __expf(-g), egm = __expf(gm1), egl = __expf(gL - g);
                ab[e] = -kk_[e] * egm; rb[e] = r_[e] * eg; bb[e] = b_[e] * eng; kb[e] = kp_[e] * eng; bt[e] = b_[e] * egl; kt[e] = kp_[e] * egl; }
#pragma unroll
            for (int q = 0; q < 4; ++q) { pab[q] = pk2(ab[2 * q], ab[2 * q + 1]); prb[q] = pk2(rb[2 * q], rb[2 * q + 1]); pbb[q] = pk2(bb[2 * q], bb[2 * q + 1]); pkb[q] = pk2(kb[2 * q], kb[2 * q + 1]); }
            *(uint4*)(MAT(O_AB) + s * LD + cg * 8) = make_uint4(pab[0], pab[1], pab[2], pab[3]);
            *(uint4*)(MAT(O_RB) + s * LD + cg * 8) = make_uint4(prb[0], prb[1], prb[2], prb[3]);
            *(uint4*)(MAT(O_BB) + s * LD + cg * 8) = make_uint4(pbb[0], pbb[1], pbb[2], pbb[3]);
            *(uint4*)(MAT(O_KB) + s * LD + cg * 8) = make_uint4(pkb[0], pkb[1], pkb[2], pkb[3]);
#pragma unroll
            for (int e = 0; e < 8; ++e) { const int k = cg * 8 + e;
                MAT(O_AT)[k * LD + s] = f2bf(ab[e]); MAT(O_BT)[k * LD + s] = f2bf(bt[e]); MAT(O_KT)[k * LD + s] = f2bf(kt[e]); MAT(O_VT)[k * LD + s] = f2bf(v_[e]); }
        }
        CK_BAR();
        { const int itn = item + GN;
          if (itn < NB * 8 * (S / 64)) { const int c2 = itn & 127, h2 = (itn >> 7) & 7, b2 = itn >> 10, ch2 = h2 * 64 + cg * 8, t2 = c2 * 64 + s; const size_t m2 = (size_t)b2 * S + t2;
            const bf16* z = I.proj + m2 * DSHIFT + ch2;
            nx_r = *(const uint4*)(z); nx_k = *(const uint4*)(z + 512); nx_v = *(const uint4*)(z + 1024);
            nx_qr = make_uint4(0, 0, 0, 0); nx_qk = nx_qr; nx_qv = nx_qr;
            if (t2 > 0) { nx_qr = *(const uint4*)(z - DSHIFT); nx_qk = *(const uint4*)(z + 512 - DSHIFT); nx_qv = *(const uint4*)(z + 1024 - DSHIFT); }
            nx_a = *(const uint4*)(I.AA + m2 * 512 + ch2); nx_l = *(const uint4*)(I.LW + m2 * 512 + ch2); } }
        if (s == 63) {
#pragma unroll
            for (int e = 0; e < 8; ++e) TOT[cg * 8 + e] = __expf(glast[e]);
        }
        {
            const int mat = tid >> 7, row = (tid >> 2) & 31, chunk = tid & 3;
            *(uint4*)(MAT(O_NM + mat * MB) + row * LD + 32 + chunk * 8) = make_uint4(0, 0, 0, 0);
        }
        for (int task = wv; task < 12; task += 8) {
            const int mat = task / 3, tt = task % 3, st = (tt == 0) ? 0 : 1, jt = (tt == 2) ? 1 : 0;
            const bf16* Asrc = MAT((mat & 1) ? O_KB : O_BB) + 32 * jt * LD;
            const bf16* Bsrc = MAT((mat >> 1) ? O_RB : O_AB) + 32 * st * LD;
            f32x16 acc = mm_tile<64>(zero16(), Asrc, LD, Bsrc, LD, lane);
            const int cs = 32 * st + (lane & 31), hh = lane >> 5; const bool incl = (mat >> 1) != 0;
#pragma unroll
            for (int rg = 0; rg < 16; ++rg) { const int j = 32 * jt + crow(rg, hh); const bool keep = incl ? (j <= cs) : (j < cs); if (!keep) acc[rg] = 0.f; }
            store_tr(acc, MAT(O_NM + mat * MB) + 32 * st * LD + 32 * jt, LD, lane);
            if (mat == 0 && st == jt) {
                float* d = NMF + st * 1024 + (lane & 31) * 32;
#pragma unroll
                for (int g = 0; g < 4; ++g) *(float4*)(d + 8 * g + 4 * hh) = make_float4(acc[4 * g], acc[4 * g + 1], acc[4 * g + 2], acc[4 * g + 3]);
            }
        }
        CK_BAR();
        if (wv == 0) {
            const int d = lane >> 4, cc = lane & 15;
            const float* nb = NMF + (d >> 1) * 1024 + (16 * (d & 1)) * 32 + 16 * (d & 1);
            float T[16];
#pragma unroll
            for (int i = 0; i < 16; ++i) {
                float acc = (i == cc) ? 1.f : 0.f;
#pragma unroll
                for (int j4 = 0; j4 < i; j4 += 4) { const float4 n4 = *(const float4*)(nb + i * 32 + j4);
                    acc += n4.x * T[j4]; if (j4 + 1 < i) acc += n4.y * T[j4 + 1]; if (j4 + 2 < i) acc += n4.z * T[j4 + 2]; if (j4 + 3 < i) acc += n4.w * T[j4 + 3]; }
                T[i] = acc;
            }
            bf16* tm = MAT(O_TM) + (16 * d) * LD + 16 * d + cc;
#pragma unroll
            for (int i = 0; i < 16; ++i) tm[i * LD] = f2bf(T[i]);
            bf16* tt = MAT(O_TT) + (d >> 1) * 32 * 40 + (16 * (d & 1) + cc) * 40 + 16 * (d & 1);
            *(uint4*)(tt) = make_uint4(pk2(T[0], T[1]), pk2(T[2], T[3]), pk2(T[4], T[5]), pk2(T[6], T[7]));
            *(uint4*)(tt + 8) = make_uint4(pk2(T[8], T[9]), pk2(T[10], T[11]), pk2(T[12], T[13]), pk2(T[14], T[15]));
            { const int blk = lane >> 5, r16 = (lane >> 1) & 15, hf = lane & 1;
              *(uint4*)(MAT(O_TM) + (32 * blk + r16) * LD + 32 * blk + 16 + 8 * hf) = make_uint4(0, 0, 0, 0);
              *(uint4*)(MAT(O_TT) + blk * 32 * 40 + (16 + r16) * 40 + 8 * hf) = make_uint4(0, 0, 0, 0); }
        } else if (wv == 1) {
            const int row = lane >> 1, half = lane & 1;
            *(uint4*)(MAT(O_TM) + row * LD + 32 + half * 16) = make_uint4(0, 0, 0, 0); *(uint4*)(MAT(O_TM) + row * LD + 32 + half * 16 + 8) = make_uint4(0, 0, 0, 0);
        } else if (wv >= 4) {
            const int st = (wv - 4) >> 1, vt = (wv - 4) & 1;
            f32x16 acc = mm_tile<64>(zero16(), MAT(O_AAK) + 32 * st * LD, LD, MAT(O_VT) + 32 * vt * LD, LD, lane);
            store_tr(acc, MAT(O_W1T) + 32 * vt * LD + 32 * st, LD, lane);
        }
        CK_BAR();
        if (wv < 2) {
            typedef float f32x4v __attribute__((ext_vector_type(4)));
            const int blk = wv, fr = lane & 15, fq = lane >> 4;
            const bf16x8 zf = (bf16x8){0, 0, 0, 0, 0, 0, 0, 0};
            bf16x8 a = zf, bq = zf;
            if (fq < 2) { a = *(const bf16x8*)(MAT(O_NM) + (32 * blk + 16 + fr) * LD + 32 * blk + 8 * fq); bq = *(const bf16x8*)(MAT(O_TT) + blk * 32 * 40 + fr * 40 + 8 * fq); }
            f32x4v z = __builtin_amdgcn_mfma_f32_16x16x32_bf16(a, bq, (f32x4v){0.f, 0.f, 0.f, 0.f}, 0, 0, 0);
            bf16* zt = MAT(O_ZT) + blk * 16 * 24;
            { uint2 w; w.x = cvtpk(z[0], z[1]); w.y = cvtpk(z[2], z[3]); *(uint2*)(zt + fr * 24 + 4 * fq) = w; }
            asm volatile("s_waitcnt lgkmcnt(0)" ::: "memory");
            a = zf; bq = zf;
            if (fq < 2) { a = *(const bf16x8*)(MAT(O_TM) + (32 * blk + 16 + fr) * LD + 32 * blk + 16 + 8 * fq); bq = *(const bf16x8*)(zt + fr * 24 + 8 * fq); }
            const f32x4v t21 = __builtin_amdgcn_mfma_f32_16x16x32_bf16(a, bq, (f32x4v){0.f, 0.f, 0.f, 0.f}, 0, 0, 0);
#pragma unroll
            for (int rg = 0; rg < 4; ++rg) MAT(O_TM)[(32 * blk + 16 + 4 * fq + rg) * LD + 32 * blk + fr] = f2bf(t21[rg]);
            { uint2 w; w.x = cvtpk(t21[0], t21[1]); w.y = cvtpk(t21[2], t21[3]); *(uint2*)(MAT(O_TT) + blk * 32 * 40 + fr * 40 + 16 + 4 * fq) = w; }
        }
        CK_BAR();
        if (wv == 0) { f32x16 acc = mm_tile<32>(zero16(), MAT(O_NM) + 32 * LD, LD, MAT(O_TT), 40, lane); store_tr(acc, MAT(O_ZT), 40, lane); }
        CK_BAR();
        if (wv == 0) { f32x16 acc = mm_tile<32>(zero16(), MAT(O_TM) + 32 * LD + 32, LD, MAT(O_ZT), 40, lane); store_rm(acc, MAT(O_TM) + 32 * LD, LD, lane); }
        CK_BAR();
        { const int st = wv >> 2, ct = wv & 3;
          f32x16 acc = mm_tile<64>(zero16(), MAT(O_TM) + 32 * st * LD, LD, MAT(O_AT) + 32 * ct * LD, LD, lane);
          CK_BAR();
          store_tr(acc, MAT(O_X1T) + 32 * ct * LD + 32 * st, LD, lane); }
        CK_BAR();
        for (int u = wv; u < 16; u += 8) {
            const int kind = u >> 2, t0 = (u >> 1) & 1, t1 = u & 1, hh = lane >> 5, cc = lane & 31;
            if (kind == 0) {
                f32x16 acc = mm_tile<64>(zero16(), MAT(O_BT) + 32 * t0 * LD, LD, MAT(O_X1T) + (64 + 32 * t1) * LD, LD, lane);
                acc = mm_tile<64>(acc, MAT(O_KT) + 32 * t0 * LD, LD, MAT(O_VT) + 32 * t1 * LD, LD, lane);
                store_frag16(acc, (bf16*)(out + 16384), t0, t1, lane);
            } else if (kind == 1) {
                f32x16 acc = mm_tile<64>(zero16(), MAT(O_ARB) + 32 * t0 * LD, LD, MAT(O_X1T) + (64 + 32 * t1) * LD, LD, lane);
                acc = mm_tile<64>(acc, MAT(O_ARK) + 32 * t0 * LD, LD, MAT(O_VT) + 32 * t1 * LD, LD, lane);
                store_frag16(acc, (bf16*)(out + 24576), t0, t1, lane);
            } else if (kind == 2) {
                f32x16 acc = mm_tile<64>(zero16(), MAT(O_X1T) + 32 * t0 * LD, LD, MAT(O_BT) + 32 * t1 * LD, LD, lane);
                const int k = 32 * t1 + cc; const float gl = TOT[k];
                bf16* d = (bf16*)out + k * 64 + 32 * t0;
#pragma unroll
                for (int g = 0; g < 4; ++g) { float x[4];
#pragma unroll
                    for (int e = 0; e < 4; ++e) { const int kp = 32 * t0 + 8 * g + 4 * hh + e; x[e] = acc[4 * g + e] + ((kp == k) ? gl : 0.f); }
                    uint2 w; w.x = cvtpk(x[0], x[1]); w.y = cvtpk(x[2], x[3]); *(uint2*)(d + 8 * g + 4 * hh) = w; }
            } else {
                f32x16 acc = mm_tile<64>(zero16(), MAT(O_X1T) + 32 * t0 * LD, LD, MAT(O_ARB) + 32 * t1 * LD, LD, lane);
                const int sq = 32 * t1 + cc;
                bf16* d = (bf16*)(out + 8192) + sq * 64 + 32 * t0;
                const bf16* rb = MAT(O_RB) + sq * LD + 32 * t0;
#pragma unroll
                for (int g = 0; g < 4; ++g) { const uint2 rr = *(const uint2*)(rb + 8 * g + 4 * hh);
                    const float x0 = acc[4 * g] + __builtin_bit_cast(float, rr.x << 16), x1 = acc[4 * g + 1] + __builtin_bit_cast(float, rr.x & 0xffff0000u);
                    const float x2 = acc[4 * g + 2] + __builtin_bit_cast(float, rr.y << 16), x3 = acc[4 * g + 3] + __builtin_bit_cast(float, rr.y & 0xffff0000u);
                    uint2 w; w.x = cvtpk(x0, x1); w.y = cvtpk(x2, x3); *(uint2*)(d + 8 * g + 4 * hh) = w; }
            }
        }
        CK_BAR();
    }
#undef MAT
}
typedef float f32x4w __attribute__((ext_vector_type(4)));
constexpr int P2_SLOT = 2 * 64 * LD * 2 + 4096;
__device__ __forceinline__ void phase2(const int WID_, const char* items, float* Y, char* lds) {
    const int wv = WID_;
    bf16* HT0 = (bf16*)lds; bf16* HT1 = HT0 + 16 * LD;
    char* SL = lds + 8192;
    for (int item = GB; item < NB * 8 * 4; item += GN) {
        const int lane = lane_id(), tid = wv * 64 + lane, fr = lane & 15, fq = lane >> 4;
        const int vq = (item >> 3) & 3, head = (item & 7) + 8 * (item >> 5), b = head >> 3, h = head & 7;
        for (int i = tid; i < 2 * 16 * LD / 8; i += NT) ((uint4*)lds)[i] = make_uint4(0, 0, 0, 0);
        const bool upd = wv < 4; const int rb = wv & 3;
        const char* rec0 = items + (size_t)(head * 128) * ITEM_BYTES;
        const size_t g_pq = (size_t)tid * 16;
        const int l_pq = (tid >> 3) * (LD * 2) + (tid & 7) * 16;
        const int piece = (tid >> 5) & 7;
        const size_t g_f = 16384 + (size_t)(piece >> 2) * 8192 + (((piece & 3) * 4 + vq) * 64) * 8 + (tid & 31) * 16;
        const int l_f = 2 * 64 * LD * 2 + piece * 512 + (tid & 31) * 16;
        float* yo = Y + ((size_t)b * S + 16 * rb + 4 * fq) * 512 + h * 64 + 16 * vq + fr;
        const int a_lds = (upd ? 0 : 64 * LD * 2) + (16 * rb + fr) * (LD * 2) + 16 * fq;
        const int c_lds = 2 * 64 * LD * 2 + ((upd ? 0 : 4) + rb) * 512 + lane * 8;
        uint4 rp0, rp1, rp2, rp3, rp4, rp5, rp6, rp7, rq0, rq1, rq2, rq3, rq4, rq5, rq6, rq7, rf0, rf1, rf2, rf3, rf4, rf5, rf6, rf7;
#define P2_LD(n, i) do { const char* rc_ = rec0 + (size_t)(i) * ITEM_BYTES; rp##n = *(const uint4*)(rc_ + g_pq); rq##n = *(const uint4*)(rc_ + 8192 + g_pq); rf##n = *(const uint4*)(rc_ + g_f); } while (0)
#define P2_ST(n, slot) do { char* s_ = SL + (slot) * P2_SLOT; *(uint4*)(s_ + l_pq) = rp##n; *(uint4*)(s_ + 64 * LD * 2 + l_pq) = rq##n; *(uint4*)(s_ + l_f) = rf##n; } while (0)
        P2_LD(0, 0); P2_LD(1, 1); P2_LD(2, 2); P2_LD(3, 3); P2_LD(4, 4); P2_LD(5, 5); P2_LD(6, 6); P2_LD(7, 7);
        P2_ST(0, 0); P2_LD(0, 8);
        CK_BAR();
#define P2_STEP(RN, cstep) do { const int c_ = (cstep); \
            const bf16* Hc = (c_ & 1) ? HT1 : HT0; bf16* Hn = (c_ & 1) ? HT0 : HT1; const char* sl_ = SL + (c_ & 1) * P2_SLOT; \
            const uint2 cv = *(const uint2*)(sl_ + c_lds); \
            f32x4w acc = (f32x4w){__builtin_bit_cast(float, cv.x << 16), __builtin_bit_cast(float, cv.x & 0xffff0000u), __builtin_bit_cast(float, cv.y << 16), __builtin_bit_cast(float, cv.y & 0xffff0000u)}; \
            const bf16x8 a0 = *(const bf16x8*)(sl_ + a_lds), a1 = *(const bf16x8*)(sl_ + a_lds + 64); \
            const bf16x8 b0 = *(const bf16x8*)(Hc + fr * LD + 8 * fq), b1 = *(const bf16x8*)(Hc + fr * LD + 32 + 8 * fq); \
            if (c_ + 1 < S / 64) P2_ST(RN, (c_ + 1) & 1); \
            if (c_ + 9 < S / 64) P2_LD(RN, c_ + 9); \
            acc = __builtin_amdgcn_mfma_f32_16x16x32_bf16(a0, b0, acc, 0, 0, 0); acc = __builtin_amdgcn_mfma_f32_16x16x32_bf16(a1, b1, acc, 0, 0, 0); \
            if (upd) { uint2 w; w.x = cvtpk(acc[0], acc[1]); w.y = cvtpk(acc[2], acc[3]); *(uint2*)(Hn + fr * LD + 16 * rb + 4 * fq) = w; } \
            else { float* y_ = yo + (size_t)c_ * 64 * 512; y_[0] = acc[0]; y_[512] = acc[1]; y_[1024] = acc[2]; y_[1536] = acc[3]; } \
            CK_BAR(); } while (0)
        for (int c = 0; c < S / 64; c += 8) {
            P2_STEP(1, c); P2_STEP(2, c + 1); P2_STEP(3, c + 2); P2_STEP(4, c + 3); P2_STEP(5, c + 4); P2_STEP(6, c + 5); P2_STEP(7, c + 6); P2_STEP(0, c + 7);
        }
#undef P2_STEP
#undef P2_LD
#undef P2_ST
    }
}
}

__device__ __forceinline__ void rwkv_post_ph(const int WID_, const float* __restrict__ Y, const float* __restrict__ RK, const bf16* __restrict__ proj, const float* __restrict__ mu, const bf16* __restrict__ G,
                             const float* __restrict__ lnw, const float* __restrict__ lnb, bf16* __restrict__ ymix) {
    const int lane = lane_id(), tk = WID_, grp = lane, ch0 = grp * 8, head = grp >> 3;
    const float4 mv0 = *(const float4*)(mu + 1024 + ch0), mv1 = *(const float4*)(mu + 1024 + ch0 + 4), lw0 = *(const float4*)(lnw + ch0), lw1 = *(const float4*)(lnw + ch0 + 4), lb0 = *(const float4*)(lnb + ch0), lb1 = *(const float4*)(lnb + ch0 + 4);
    const float muv[8] = {mv0.x, mv0.y, mv0.z, mv0.w, mv1.x, mv1.y, mv1.z, mv1.w}, lw_[8] = {lw0.x, lw0.y, lw0.z, lw0.w, lw1.x, lw1.y, lw1.z, lw1.w}, lb_[8] = {lb0.x, lb0.y, lb0.z, lb0.w, lb1.x, lb1.y, lb1.z, lb1.w};
    for (int m0 = GB * 16 + tk; m0 < M; m0 += GN * 16) {
        float4 ya[2], yb[2]; uint4 vv[2], pv[2], gg[2]; float rk[2];
#pragma unroll
        for (int u = 0; u < 2; ++u) { const int m = m0 + 8 * u;
            ya[u] = *(const float4*)(Y + (size_t)m * 512 + ch0); yb[u] = *(const float4*)(Y + (size_t)m * 512 + ch0 + 4);
            vv[u] = *(const uint4*)(proj + (size_t)m * DSHIFT + 1024 + ch0);
            pv[u] = (m & (S - 1)) ? *(const uint4*)(proj + (size_t)(m - 1) * DSHIFT + 1024 + ch0) : make_uint4(0, 0, 0, 0);
            gg[u] = *(const uint4*)(G + (size_t)m * 512 + ch0); rk[u] = RK[(size_t)m * 8 + head]; }
#pragma unroll
        for (int u = 0; u < 2; ++u) {
            const float y[8] = {ya[u].x, ya[u].y, ya[u].z, ya[u].w, yb[u].x, yb[u].y, yb[u].z, yb[u].w};
            float s = 0.f;
#pragma unroll
            for (int e = 0; e < 8; ++e) s += y[e];
            s += dpp16<0xB1>(s); s += dpp16<0x4E>(s); s += dpp16<0x141>(s);
            const float mean = s * (1.f / 64.f); float q = 0.f;
#pragma unroll
            for (int e = 0; e < 8; ++e) { const float d = y[e] - mean; q += d * d; }
            q += dpp16<0xB1>(q); q += dpp16<0x4E>(q); q += dpp16<0x141>(q);
            const float rstd = rsqrtf(q * (1.f / 64.f) + 64e-5f);
            const unsigned wv_[4] = {vv[u].x, vv[u].y, vv[u].z, vv[u].w}, wp_[4] = {pv[u].x, pv[u].y, pv[u].z, pv[u].w}, wg_[4] = {gg[u].x, gg[u].y, gg[u].z, gg[u].w};
            float o[8];
#pragma unroll
            for (int e = 0; e < 8; ++e) { const int w_ = e >> 1; const bool hi = e & 1;
                auto ex = [&](unsigned x) { return hi ? __builtin_bit_cast(float, x & 0xffff0000u) : __builtin_bit_cast(float, x << 16); };
                float v = ex(wv_[w_]); v += (ex(wp_[w_]) - v) * muv[e];
                o[e] = ((y[e] - mean) * rstd * lw_[e] + lb_[e] + rk[u] * v) * ex(wg_[w_]); }
            *(uint4*)(ymix + (size_t)(m0 + 8 * u) * D + ch0) = make_uint4(pk2(o[0], o[1]), pk2(o[2], o[3]), pk2(o[4], o[5]), pk2(o[6], o[7]));
        }
    }
}

constexpr int PSLOTS = NASSIGN + NEXP * 256;
constexpr int MAXTILES = PSLOTS / 256;
struct MoeBufs { int* tok_e; float* tok_g; int* tok_slot; int* slot_tok; float* slot_gate; int* bcnt; int* bbase; int* offs; int* tiles; int* ntiles; };
__device__ __forceinline__ void moe_zero_ph(const int WID_, const MoeBufs& mb) {
    for (int i = GB * NT + (WID_ * 64 + lane_id()); i < PSLOTS; i += GN * NT) { mb.slot_tok[i] = 0; mb.slot_gate[i] = 0.f; }
}
__device__ __forceinline__ void router_ph(const int WID_, const float* __restrict__ x3, const float* __restrict__ nw, bf16* __restrict__ h3, const float* __restrict__ wrg, const float* __restrict__ brg,
                          const float* __restrict__ wre, const float* __restrict__ bre, const MoeBufs& mb, char* lds, int tile) {
    const int lane = lane_id(), wv = WID_;
    int* lcnt = (int*)lds;
    _Float16* wg16 = (_Float16*)(lds + 256);
    _Float16* we16 = (_Float16*)(lds + 256 + 8192);
    if (wv == 0 && lane < 32) lcnt[lane] = 0;
    for (int i = wv * 64 + lane; i < 1024; i += NT) { const float4 w = *(const float4*)(wrg + i * 4);
        typedef _Float16 h4 __attribute__((ext_vector_type(4))); *(h4*)(wg16 + i * 4) = (h4){(_Float16)w.x, (_Float16)w.y, (_Float16)w.z, (_Float16)w.w}; }
    for (int i = wv * 64 + lane; i < 4 * 1024 * 2; i += NT) { const float4 w = *(const float4*)(wre + i * 4);
        typedef _Float16 h4 __attribute__((ext_vector_type(4))); *(h4*)(we16 + i * 4) = (h4){(_Float16)w.x, (_Float16)w.y, (_Float16)w.z, (_Float16)w.w}; }
    __syncthreads();
    typedef _Float16 h4 __attribute__((ext_vector_type(4)));
    typedef _Float16 h8 __attribute__((ext_vector_type(8)));
    for (int m = tile * 256 + wv; m < tile * 256 + 256; m += 8) {
        const float4* xr = (const float4*)(x3 + (size_t)m * D);
        float h[16]; float s = 0.f;
#pragma unroll
        for (int j = 0; j < 4; ++j) { const float4 v = xr[lane + 64 * j]; h[4 * j] = v.x; h[4 * j + 1] = v.y; h[4 * j + 2] = v.z; h[4 * j + 3] = v.w; s += v.x * v.x + v.y * v.y + v.z * v.z + v.w * v.w; }
        s = wave_sum(s);
        const float rs = rsqrtf(s * (1.f / D) + 1e-6f);
        float l1[4] = {0.f, 0.f, 0.f, 0.f};
#pragma unroll
        for (int j = 0; j < 4; ++j) {
            const int k0 = (lane + 64 * j) * 4;
            const float4 g = *(const float4*)(nw + k0);
            h[4 * j] *= rs * g.x; h[4 * j + 1] *= rs * g.y; h[4 * j + 2] *= rs * g.z; h[4 * j + 3] *= rs * g.w;
            uint2 o; o.x = pk2(h[4 * j], h[4 * j + 1]); o.y = pk2(h[4 * j + 2], h[4 * j + 3]);
            *(uint2*)(h3 + (size_t)m * D + k0) = o;
#pragma unroll
            for (int e = 0; e < 4; ++e) { const h4 w = *(const h4*)(wg16 + (k0 + e) * 4); const float x = h[4 * j + e];
                l1[0] += x * (float)w[0]; l1[1] += x * (float)w[1]; l1[2] += x * (float)w[2]; l1[3] += x * (float)w[3]; }
        }
#pragma unroll
        for (int i = 0; i < 4; ++i) l1[i] = wave_sum(l1[i]) + brg[i];
        int grp = 0; float best = l1[0];
#pragma unroll
        for (int i = 1; i < 4; ++i) if (l1[i] > best) { best = l1[i]; grp = i; }
        float se = 0.f;
#pragma unroll
        for (int i = 0; i < 4; ++i) se += __expf(l1[i] - best);
        const float g1 = 1.f / se;
        float l2[8] = {};
        const _Float16* we = we16 + (size_t)grp * D * 8;
#pragma unroll
        for (int j = 0; j < 4; ++j) {
            const int k0 = (lane + 64 * j) * 4;
#pragma unroll
            for (int e = 0; e < 4; ++e) { const float x = h[4 * j + e]; const h8 w = *(const h8*)(we + (k0 + e) * 8);
#pragma unroll
                for (int q = 0; q < 8; ++q) l2[q] += x * (float)w[q]; }
        }
#pragma unroll
        for (int i = 0; i < 8; ++i) l2[i] = wave_sum(l2[i]) + bre[grp * 8 + i];
        int i0 = 0; float v0 = l2[0];
#pragma unroll
        for (int i = 1; i < 8; ++i) if (l2[i] > v0) { v0 = l2[i]; i0 = i; }
        int i1 = -1; float v1 = -3.0e38f;
#pragma unroll
        for (int i = 0; i < 8; ++i) if (i != i0 && l2[i] > v1) { v1 = l2[i]; i1 = i; }
        const float e1 = __expf(v1 - v0), inv = 1.f / (1.f + e1);
        if (lane == 0) {
            const int ea = grp * 8 + i0, eb = grp * 8 + i1;
            mb.tok_e[2 * m] = ea; mb.tok_e[2 * m + 1] = eb;
            mb.tok_g[2 * m] = g1 * inv; mb.tok_g[2 * m + 1] = g1 * e1 * inv;
            atomicAdd(&lcnt[ea], 1); atomicAdd(&lcnt[eb], 1);
        }
    }
    __syncthreads();
    if (wv == 0 && lane < 32) mb.bcnt[tile * 32 + lane] = lcnt[lane];
    __syncthreads();
}
__device__ __forceinline__ void moe_plan_ph(const int WID_, const MoeBufs& mb, char* lds) {
    if (GB != 0) return;
    int* tot = (int*)lds; int* off = tot + 32;
    const int t = WID_ * 64 + lane_id();
    if (t < 32) { int run = 0; for (int b = 0; b < M / 256; ++b) { const int c = __hip_atomic_load(mb.bcnt + b * 32 + t, __ATOMIC_RELAXED, __HIP_MEMORY_SCOPE_AGENT); mb.bbase[b * 32 + t] = run; run += c; } tot[t] = run; }
    __syncthreads();
    if (t == 0) { int o = 0, nt = 0;
        for (int e = 0; e < NEXP; ++e) { off[e] = o; mb.offs[e] = o; const int c = tot[e]; for (int r0 = 0; r0 < c; r0 += 256) { mb.tiles[nt] = e; ++nt; } o += ((c + 255) / 256) * 256; }
        *mb.ntiles = nt; }
    __syncthreads();
}
__device__ __forceinline__ void moe_scatter_ph(const int WID_, const MoeBufs& mb, char* lds) {
    const int lane = lane_id(), wv = WID_;
    int* cur = (int*)lds;
    for (int tile = GB; tile < M / 256; tile += GN) {
        __syncthreads();
        if (wv == 0 && lane < 32) cur[lane] = __hip_atomic_load(mb.offs + lane, __ATOMIC_RELAXED, __HIP_MEMORY_SCOPE_AGENT) + __hip_atomic_load(mb.bbase + tile * 32 + lane, __ATOMIC_RELAXED, __HIP_MEMORY_SCOPE_AGENT);
        __syncthreads();
        const int a = tile * 512 + wv * 64 + lane; const int e = mb.tok_e[a];
        const int pos = atomicAdd(&cur[e], 1);
        mb.slot_tok[pos] = a >> 1; mb.slot_gate[pos] = mb.tok_g[a]; mb.tok_slot[a] = pos;
    }
    __syncthreads();
}
__device__ __forceinline__ void moe_weights_ph(const int WID_, const float* __restrict__ wg, const float* __restrict__ wu, const float* __restrict__ wd, bf16* __restrict__ wgu_t, bf16* __restrict__ wd_t, char* lds, int vb, int nvb) {
    const int lane = (WID_ * 64 + lane_id()) & 63, wv = (WID_ * 64 + lane_id()) >> 6;
    float* scr = (float*)(lds + wv * 16384);
    constexpr int I_GU = 16 * 16;
    constexpr int I_D = 8 * 32;
    constexpr int NIT = NEXP * (2 * I_GU + I_D);
    for (int it = vb * 8 + wv; it < NIT; it += nvb * 8) {
        const int e = it / (2 * I_GU + I_D); int r = it % (2 * I_GU + I_D);
        if (r < 2 * I_GU) {
            const int up = r / I_GU; r %= I_GU;
            const int kb = r / 16, nb = r % 16;
            const int pn = nb / 4, nsub = nb % 4;
            const float* W = (up ? wu : wg) + (size_t)e * D * DEXP + nb * 32;
            transpose_item(W + (size_t)kb * 64 * DEXP, 64, 32, wgu_t, D, e * 1024 + pn * 256 + up * 128 + nsub * 32, kb * 64, scr, 0, lane, nullptr, DEXP);
        } else {
            r -= 2 * I_GU;
            const int kb = r / 32, nb = r % 32;
            const float* W = wd + (size_t)e * DEXP * D + nb * 32;
            transpose_item(W + (size_t)kb * 64 * D, 64, 32, wd_t, DEXP, e * 1024 + nb * 32, kb * 64, scr, 0, lane, nullptr, D);
        }
    }
}
__device__ __forceinline__ void final_ph(const int WID_, float* __restrict__ out, const bf16* __restrict__ yslot, const int* __restrict__ tok_slot, const float* __restrict__ w) {
    const int lane = lane_id(), wv = WID_;
    float4 g[4];
#pragma unroll
    for (int j = 0; j < 4; ++j) g[j] = *(const float4*)(w + (lane + 64 * j) * 4);
    for (int row0 = (GB * 8 + wv) * 2; row0 < M; row0 += GN * 16) {
        float4 v[2][4]; uint2 ya[2][4], yb[2][4];
#pragma unroll
        for (int r = 0; r < 2; ++r) { const int row = row0 + r;
            const float4* xr = (const float4*)(out + (size_t)row * D);
            const uint2* pa = (const uint2*)(yslot + (size_t)tok_slot[2 * row] * D);
            const uint2* pb = (const uint2*)(yslot + (size_t)tok_slot[2 * row + 1] * D);
#pragma unroll
            for (int j = 0; j < 4; ++j) { v[r][j] = xr[lane + 64 * j]; ya[r][j] = pa[lane + 64 * j]; yb[r][j] = pb[lane + 64 * j]; } }
#pragma unroll
        for (int r = 0; r < 2; ++r) { float s = 0.f;
#pragma unroll
            for (int j = 0; j < 4; ++j) { const uint2 a = ya[r][j], b = yb[r][j];
                v[r][j].x += __builtin_bit_cast(float, a.x << 16) + __builtin_bit_cast(float, b.x << 16);
                v[r][j].y += __builtin_bit_cast(float, a.x & 0xffff0000u) + __builtin_bit_cast(float, b.x & 0xffff0000u);
                v[r][j].z += __builtin_bit_cast(float, a.y << 16) + __builtin_bit_cast(float, b.y << 16);
                v[r][j].w += __builtin_bit_cast(float, a.y & 0xffff0000u) + __builtin_bit_cast(float, b.y & 0xffff0000u);
                s += v[r][j].x * v[r][j].x + v[r][j].y * v[r][j].y + v[r][j].z * v[r][j].z + v[r][j].w * v[r][j].w; }
            s = wave_sum(s);
            const float rs = rsqrtf(s * (1.f / D) + 1e-6f);
            float4* xo = (float4*)(out + (size_t)(row0 + r) * D);
#pragma unroll
            for (int j = 0; j < 4; ++j) xo[lane + 64 * j] = make_float4(v[r][j].x * rs * g[j].x, v[r][j].y * rs * g[j].y, v[r][j].z * rs * g[j].z, v[r][j].w * rs * g[j].w); }
    }
}

struct S5Tab { float* Kmat; bf16* BtA; bf16* BtB; };
__device__ __forceinline__ void s5_lam(const float* lam_re, const float* lam_im, const float* log_dt, int g, int n, float& a, float& w) {
    const float dt = __expf(log_dt[g]); a = lam_re[g * 64 + n] * dt; w = lam_im[g * 64 + n] * dt;
}
__device__ __forceinline__ void cexpj(float a, float w, float j, float& re, float& im) { const float e = __expf(a * j); float s, c; sincosf(w * j, &s, &c); re = e * c; im = e * s; }
__device__ __forceinline__ void s5_bbar(const float* lam_re, const float* lam_im, const float* log_dt, const float* b_re, const float* b_im, int g, int n, int h, float& br, float& bi) {
    float a, w; s5_lam(lam_re, lam_im, log_dt, g, n, a, w);
    float lbr, lbi; cexpj(a, w, 1.f, lbr, lbi);
    const float lr = lam_re[g * 64 + n], li = lam_im[g * 64 + n];
    const float nr = lbr - 1.f, ni = lbi, den = lr * lr + li * li;
    const float cr = (nr * lr + ni * li) / den, ci = (ni * lr - nr * li) / den;
    const float xr = b_re[(g * 64 + n) * 16 + h], xi = b_im[(g * 64 + n) * 16 + h];
    br = cr * xr - ci * xi; bi = cr * xi + ci * xr;
}
__device__ __forceinline__ void s5_tables0_ph(const int WID_, const float* lam_re, const float* lam_im, const float* log_dt, const float* b_re, const float* b_im, const float* c_re, const float* c_im, const S5Tab& T, char* lds) {
    float* PWR = (float*)lds; float* PWI = PWR + 64 * 34;
    float* BBR = PWI + 64 * 34; float* BBI = BBR + 64 * 16;
    float* CCR = BBI + 64 * 16; float* CCI = CCR + 16 * 64;
    const int tid = WID_ * 64 + lane_id();
    for (int item = GB; item < 32 * 8; item += GN) {
        const int g = item & 31, part = item >> 5;
        __syncthreads();
        for (int i = tid; i < 64 * 34; i += NT) { const int n = i / 34, j = i % 34; float a, w; s5_lam(lam_re, lam_im, log_dt, g, n, a, w); float pr, pi; cexpj(a, w, (float)j, pr, pi); PWR[i] = pr; PWI[i] = pi; }
        for (int i = tid; i < 64 * 16; i += NT) { const int n = i >> 4, h = i & 15; float br, bi; s5_bbar(lam_re, lam_im, log_dt, b_re, b_im, g, n, h, br, bi); BBR[i] = br; BBI[i] = bi;
            const int hp = i >> 6, n2 = i & 63; CCR[i] = c_re[(g * 16 + hp) * 64 + n2]; CCI[i] = c_im[(g * 16 + hp) * 64 + n2]; }
        __syncthreads();
        for (int i = tid; i < 4 * 256; i += NT) { const int h = i & 15, hp = (i >> 4) & 15, j = 4 * part + (i >> 8);
            float acc = 0.f;
            for (int n = 0; n < 64; ++n) { const float pr = PWR[n * 34 + j], pi = PWI[n * 34 + j], br = BBR[n * 16 + h], bi = BBI[n * 16 + h];
                const float tr = pr * br - pi * bi, ti = pr * bi + pi * br; acc += CCR[hp * 64 + n] * tr - CCI[hp * 64 + n] * ti; }
            T.Kmat[((g * 32 + j) * 16 + hp) * 16 + h] = acc; }
        for (int i = tid; i < 32 * 512; i += NT) { const int col = i & 511, r = 32 * part + (i >> 9); float v = 0.f;
            if (r < 128) { const int n = r & 63, s = col >> 4, h = col & 15; const float pr = PWR[n * 34 + (S5L - 1 - s)], pi = PWI[n * 34 + (S5L - 1 - s)], br = BBR[n * 16 + h], bi = BBI[n * 16 + h];
                v = (r < 64) ? (pr * br - pi * bi) : (pr * bi + pi * br); }
            T.BtA[((size_t)g * 768 + 512 + r) * 512 + col] = f2bf(v); }
        for (int i = tid; i < 64 * 256; i += NT) { const int k = i & 255, row = 64 * part + (i >> 8); float v = 0.f;
            if (k < 128) { const int n = k & 63, sp = row >> 4, hp = row & 15; const float pr = PWR[n * 34 + sp + 1], pi = PWI[n * 34 + sp + 1], cr = CCR[hp * 64 + n], ci = CCI[hp * 64 + n];
                v = (k < 64) ? (cr * pr - ci * pi) : -(cr * pi + ci * pr); }
            T.BtB[((size_t)g * 512 + row) * 256 + k] = f2bf(v); }
    }
    __syncthreads();
}
__device__ __forceinline__ void s5_tables1_ph(const int WID_, const float* dsk, const S5Tab& T) {
    const int gtid = GB * NT + (WID_ * 64 + lane_id()), gsz = GN * NT;
    for (int i = gtid; i < 32 * 512 * 512; i += gsz) {
        const int col = i & 511, row = (i >> 9) & 511, g = i >> 18;
        const int sp = row >> 4, hp = row & 15, s = col >> 4, h = col & 15;
        float v = 0.f;
        if (s <= sp) v = T.Kmat[((g * 32 + (sp - s)) * 16 + hp) * 16 + h];
        if (row == col) v += dsk[g * 16 + hp];
        T.BtA[((size_t)g * 768 + row) * 512 + col] = f2bf(v);
    }
}
__device__ __forceinline__ void s5_carry_ph(const int WID_, const float* lam_re, const float* lam_im, const float* log_dt, const float* __restrict__ F, bf16* __restrict__ XST, int vb, int nvb, char* lds) {
    float* TR = (float*)lds; float* TI = TR + 16 * 32;
    for (int item = vb; item < NB * 32 * 2; item += nvb) {
        const int lane = lane_id(), tid = WID_ * 64 + lane;
        const int nh = item & 1, g = (item >> 1) & 31, b = item >> 6, seg = tid >> 5, n = nh * 32 + (tid & 31);
        float a, w; s5_lam(lam_re, lam_im, log_dt, g, n, a, w);
        float pr, pi; cexpj(a, w, (float)S5L, pr, pi);
        const size_t row0 = (size_t)g * S5R + (size_t)b * (S / S5L) + seg * 16;
        const float* f = F + row0 * 128; bf16* xo = XST + row0 * 256;
        float fr[16], fi[16];
#pragma unroll
        for (int q = 0; q < 16; ++q) { fr[q] = f[(size_t)q * 128 + n]; fi[q] = f[(size_t)q * 128 + 64 + n]; }
#pragma unroll
        for (int q = 0; q < 16; ++q) if (nh == 0) *(uint2*)(xo + (size_t)q * 256 + 128 + (tid & 31) * 4) = make_uint2(0, 0);
        float xr = 0.f, xi = 0.f;
#pragma unroll
        for (int q = 0; q < 16; ++q) { const float nr = pr * xr - pi * xi + fr[q], ni = pr * xi + pi * xr + fi[q]; xr = nr; xi = ni; fr[q] = nr; fi[q] = ni; }
        TR[seg * 32 + (tid & 31)] = xr; TI[seg * 32 + (tid & 31)] = xi;
        __syncthreads();
        float p16r, p16i; cexpj(a, w, (float)(S5L * 16), p16r, p16i);
        float cr = 0.f, ci = 0.f;
        for (int s2 = 0; s2 < seg; ++s2) { const float tr = TR[s2 * 32 + (tid & 31)], ti = TI[s2 * 32 + (tid & 31)];
            const float nr = p16r * cr - p16i * ci + tr, ni = p16r * ci + p16i * cr + ti; cr = nr; ci = ni; }
        float er = cr, ei = ci;
#pragma unroll
        for (int q = 0; q < 16; ++q) {
            const float lr_ = (q > 0) ? fr[q - 1] : 0.f, li_ = (q > 0) ? fi[q - 1] : 0.f;
            xo[(size_t)q * 256 + n] = f2bf(er + lr_); xo[(size_t)q * 256 + 64 + n] = f2bf(ei + li_);
            const float nr = pr * er - pi * ei, ni = pr * ei + pi * er; er = nr; ei = ni;
        }
        __syncthreads();
    }
}
#define XB_TMO      128
#define XB_XCNT(j)  (256  + 64 * (j))
#define XB_XSUB(j)  (1280 + 64 * (j))
#define XB_XGEN(j)  (2304 + 64 * (j))
#define XB_TOP      3328
#define XB_TOPGEN   3392
#define XCD_BAR_WORDS 3456
#define XB_SPIN_CAP (1u << 20)
__device__ __forceinline__ unsigned xb_ld(unsigned* p)              { return __hip_atomic_load(p, __ATOMIC_RELAXED, __HIP_MEMORY_SCOPE_AGENT); }
__device__ __forceinline__ unsigned xb_add(unsigned* p, unsigned v) { return __hip_atomic_fetch_add(p, v, __ATOMIC_RELAXED, __HIP_MEMORY_SCOPE_AGENT); }
__device__ __forceinline__ unsigned xb_xcc_id() { return (unsigned)__builtin_amdgcn_s_getreg((3 << 11) | 20) & 0xFu; }
#define XB_SPIN(cond, bar) do { unsigned _sp = 0; while (cond) { __builtin_amdgcn_s_sleep(1); \
    if ((++_sp & 255u) == 0u) { if (xb_ld(&(bar)[XB_TMO])) break; if (_sp > XB_SPIN_CAP) { atomicAdd(&(bar)[XB_TMO], 1u); break; } } } } while (0)
struct XcdBarrier { unsigned* bar; unsigned x; volatile __attribute__((address_space(3))) unsigned* st; };
__device__ __forceinline__ XcdBarrier xcd_barrier_post(const int WID_, unsigned* bar, volatile __attribute__((address_space(3))) unsigned* st) {
    XcdBarrier b; b.bar = bar; b.x = xb_xcc_id(); b.st = st;
    if ((WID_ * 64 + lane_id()) == 0) (void)xb_add(&bar[XB_XCNT(b.x)], 1u);
    return b;
}
__device__ __forceinline__ void xcd_barrier_complete(unsigned* bar, unsigned x, unsigned& nloc, unsigned& nx) {
    const unsigned G = gridDim.x * gridDim.y * gridDim.z;
    unsigned sum, cnt, mine, sp = 0u;
    for (;;) {
        sum = 0u; cnt = 0u; mine = 0u;
#pragma unroll
        for (unsigned j = 0; j < 16; ++j) { const unsigned c = xb_ld(&bar[XB_XCNT(j)]); sum += c; cnt += (c > 0u) ? 1u : 0u; mine = (j == x) ? c : mine; }
        if (sum == G) break;
        __builtin_amdgcn_s_sleep(1);
        if ((++sp & 255u) == 0u) { if (xb_ld(&bar[XB_TMO])) break; if (sp > XB_SPIN_CAP) { atomicAdd(&bar[XB_TMO], 1u); break; } }
    }
    nloc = mine > 0u ? mine : 1u; nx = cnt > 0u ? cnt : 1u;
}
__device__ __forceinline__ void xcd_barrier(const int WID_, const XcdBarrier& b) {
    asm volatile("s_waitcnt vmcnt(0)" ::: "memory");
    __syncthreads();
    if ((WID_ * 64 + lane_id()) == 0) {
        unsigned* bar = b.bar;
        __builtin_amdgcn_s_waitcnt(0);
        unsigned nloc = b.st[0], nx = b.st[1];
        if (nloc == 0u) { xcd_barrier_complete(bar, b.x, nloc, nx); b.st[0] = nloc; b.st[1] = nx; }
        const unsigned old = xb_add(&bar[XB_XSUB(b.x)], 1u);
        const unsigned gen = old / nloc;
        if (old + 1u == (gen + 1u) * nloc) {
            __builtin_amdgcn_fence(__ATOMIC_RELEASE, "agent");
            asm volatile("s_waitcnt vmcnt(0)" ::: "memory");
            const unsigned og = xb_add(&bar[XB_TOP], 1u);
            const unsigned tg = og / nx;
            if (og + 1u == (tg + 1u) * nx) xb_add(&bar[XB_TOPGEN], 1u);
            else XB_SPIN(xb_ld(&bar[XB_TOPGEN]) == tg, bar);
            __builtin_amdgcn_fence(__ATOMIC_ACQUIRE, "agent");
            xb_add(&bar[XB_XGEN(b.x)], 1u);
            asm volatile("s_waitcnt vmcnt(0)" ::: "memory");
        } else {
            XB_SPIN(xb_ld(&bar[XB_XGEN(b.x)]) == gen, bar);
            __builtin_amdgcn_fence(__ATOMIC_ACQUIRE, "agent");
            asm volatile("s_waitcnt vmcnt(0)" ::: "memory");
        }
    }
    __syncthreads();
}

struct Params { const float* in[41]; float* out; char* ws; };

constexpr size_t W_PROJ = 0;
constexpr size_t W_US5 = 224;
constexpr size_t W_WTS = 288;
constexpr size_t W_YI = 352;
constexpr size_t W_F = 416;
constexpr size_t W_XST = 448;
constexpr size_t W_Z = 480;
constexpr size_t W_MISC = 544;
constexpr size_t W_XN = 576;
constexpr size_t W_CTL = 558;
constexpr size_t WO_IN = 0, WO_GLU = 5 * MiB, WO_MIX = 6 * MiB, WO_Q = 8 * MiB, WO_K = 10 * MiB, WO_V = 12 * MiB, WO_O = 14 * MiB, WO_KMAT = 16 * MiB, WO_BTA = 17 * MiB, WO_BTB = 41 * MiB;

__global__ void __launch_bounds__(NT, 2) fwd_kernel(Params p) {
    extern __shared__ __attribute__((aligned(16))) char lds[];
    const int WID_ = __builtin_amdgcn_readfirstlane((int)(threadIdx.x >> 6));
    cg::grid_group grid = cg::this_grid();
    PG8_LAS unsigned char* ldsl = (PG8_LAS unsigned char*)lds;
    char* ws = p.ws; char* dout = (char*)p.out; float* out = p.out;
#define IN(i) (p.in[i])
    volatile __attribute__((address_space(3))) unsigned* bst = (volatile __attribute__((address_space(3))) unsigned*)(ldsl + LDS_BYTES - 64);
    if (WID_ == 0 && lane_id() < 2) bst[lane_id()] = 0u;
    __syncthreads();
    const XcdBarrier xbar = xcd_barrier_post(WID_, (unsigned*)(ws + W_CTL * MiB), bst);
#ifndef PROBE_PHASE
#define PROBE_PHASE -1
#endif
    int sync_id = 0; unsigned long long pr_t0 = 0, pr_t1 = 0;
    if (PROBE_PHASE == 0) pr_t0 = __builtin_amdgcn_s_memrealtime();
#define SYNC() do { xcd_barrier(WID_, xbar); ++sync_id; if (sync_id == PROBE_PHASE) pr_t0 = __builtin_amdgcn_s_memrealtime(); if (sync_id == PROBE_PHASE + 1) pr_t1 = __builtin_amdgcn_s_memrealtime(); } while (0)
    char* WT = ws + W_WTS * MiB;
    bf16* w_in_t = (bf16*)(WT + WO_IN); bf16* w_glu_t = (bf16*)(WT + WO_GLU); bf16* w_mix_t = (bf16*)(WT + WO_MIX);
    bf16* w_q_t = (bf16*)(WT + WO_Q); bf16* w_k_t = (bf16*)(WT + WO_K); bf16* w_v_t = (bf16*)(WT + WO_V); bf16* w_o_t = (bf16*)(WT + WO_O);
    S5Tab stab; stab.Kmat = (float*)(WT + WO_KMAT); stab.BtA = (bf16*)(WT + WO_BTA); stab.BtB = (bf16*)(WT + WO_BTB);
    bf16* PROJ = (bf16*)(ws + W_PROJ * MiB); bf16* US5 = (bf16*)(ws + W_US5 * MiB);
    bf16* XN = (bf16*)(ws + W_XN * MiB);
    transpose_ph(WID_, IN(3), D, DIN, w_in_t, D, 0, 0, lds);
    transpose_ph(WID_, IN(23), 512, 512, w_glu_t, 512, 0, 0, lds);
    transpose_ph(WID_, IN(25), D, D, w_mix_t, D, 0, 0, lds);
    transpose_ph(WID_, IN(28), D, D, w_q_t, D, 0, 0, lds);
    transpose_ph(WID_, IN(29), D, D, w_k_t, D, 0, 0, lds);
    transpose_ph(WID_, IN(30), D, D, w_v_t, D, 0, 0, lds);
    transpose_ph(WID_, IN(31), D, D, w_o_t, D, 0, 0, lds);
    s5_tables0_ph(WID_, IN(15), IN(16), IN(17), IN(18), IN(19), IN(20), IN(21), stab, lds);
    bf16* wl_t = (bf16*)(WT + 49 * MiB);
    rwkv_wl_ph(WID_, IN(6), IN(8), IN(9), wl_t);
    rmsnorm_ph<bf16>(WID_, IN(0), IN(2), XN, M);
    bf16* MEMN = (bf16*)(ws + (W_MISC + 10) * MiB);
    rmsnorm_ph<bf16>(WID_, IN(1), IN(27), MEMN, NB * NMEM);
    grid.sync(); ++sync_id; if (sync_id == PROBE_PHASE) pr_t0 = __builtin_amdgcn_s_memrealtime(); if (sync_id == PROBE_PHASE + 1) pr_t1 = __builtin_amdgcn_s_memrealtime();
    s5_tables1_ph(WID_, IN(22), stab);
    { pg8::PlainOrder S; S.init(XN, D, w_in_t, D, M, DIN, D); pg8::EpiProj E{PROJ, US5}; pg8::gemm_phase(WID_, ldsl, S, E); }
    SYNC();
    bf16* LIN = (bf16*)(ws + (W_MISC + 16) * MiB);
    rwkv_lin_ph(WID_, PROJ, IN(4), LIN);
    SYNC();
    bf16* YI = (bf16*)(ws + W_YI * MiB); float* F = (float*)(ws + W_F * MiB); bf16* XST = (bf16*)(ws + W_XST * MiB); bf16* Z = (bf16*)(ws + W_Z * MiB);
    bf16* LWb = (bf16*)(ws + 704 * MiB); bf16* AAb = (bf16*)(ws + 768 * MiB); bf16* Gb = (bf16*)(ws + 832 * MiB);
    float* Yr = (float*)(ws + 896 * MiB); float* RKb = (float*)(ws + W_MISC * MiB);
    { pg8::GroupOrder S; S.init(US5, 512, (size_t)S5R * 512, stab.BtA, 512, (size_t)768 * 512, 32, S5R, 768, 512); pg8::EpiS5a E{YI, F}; pg8::gemm_phase(WID_, ldsl, S, E); }
    { pg8::PlainOrder S; S.init(LIN, 256, wl_t, 256, M, 1536, 256); pg8::EpiLora E{LWb, (size_t)32 * MiB, IN(5), IN(7)}; pg8::gemm_phase(WID_, ldsl, S, E); }
    SYNC();
    { ck::In ci{PROJ, LWb, AAb, IN(4), IN(10), IN(11), IN(12), RKb, dout}; ck::phase1(WID_, ci, lds); }
    SYNC();
    bf16* WGU_t = (bf16*)(ws + 704 * MiB); bf16* WD_t = (bf16*)(ws + 768 * MiB);
    ck::phase2(WID_, dout, Yr, lds);
    __syncthreads();
    s5_carry_ph(WID_, IN(15), IN(16), IN(17), F, XST, GB, GN, lds);
    moe_weights_ph(WID_, IN(37), IN(38), IN(39), WGU_t, WD_t, lds, GB, GN);
    SYNC();
    bf16* YMIX = XN;
    bf16* KM = (bf16*)(ws + (W_MISC + 2) * MiB); bf16* VT = (bf16*)(ws + (W_MISC + 6) * MiB);
    { pg8::GroupOrder S; S.init(XST, 256, (size_t)S5R * 256, stab.BtB, 256, (size_t)512 * 256, 32, S5R, 512, 256); pg8::EpiS5b E{YI, Z}; pg8::gemm_phase(WID_, ldsl, S, E); }
    { pg8::PlainOrder S; S.init(MEMN, D, w_k_t, D, NB * NMEM, D, D); pg8::EpiBf16 E{KM, D}; pg8::gemm_phase(WID_, ldsl, S, E); }
    { pg8::PlainOrder S; S.init(w_v_t, D, MEMN, D, D, NB * NMEM, D); pg8::EpiBf16 E{VT, NB * NMEM}; pg8::gemm_phase(WID_, ldsl, S, E); }
    rwkv_post_ph(WID_, Yr, RKb, PROJ, IN(4), Gb, IN(13), IN(14), YMIX);
    SYNC();
    bf16* XN2 = (bf16*)(ws + 0);
    bf16* Q = (bf16*)(ws + 128 * MiB);
    bf16* P = (bf16*)(ws + W_YI * MiB);
    bf16* O = (bf16*)(ws + 800 * MiB);
    bf16* H3 = XN;
    bf16* HID = (bf16*)(ws + 368 * MiB);
    bf16* YSLOT = (bf16*)(ws + 0);
#define MKMB(mb) MoeBufs mb; { char* mbase = p.ws + 976 * MiB; \
    mb.tok_e = (int*)(mbase); mb.tok_g = (float*)(mbase + 1 * MiB); mb.tok_slot = (int*)(mbase + 2 * MiB); mb.slot_tok = (int*)(mbase + 3 * MiB); \
    mb.slot_gate = (float*)(mbase + 4 * MiB); mb.bcnt = (int*)(mbase + 5 * MiB); mb.bbase = mb.bcnt + 16384; mb.offs = mb.bcnt + 32768; mb.ntiles = mb.offs + 64; \
    mb.tiles = (int*)(mbase + 6 * MiB); }
    { MKMB(mb); moe_zero_ph(WID_, mb); }
#define BLK_SYNC() do { asm volatile("s_waitcnt vmcnt(0)" ::: "memory"); __syncthreads(); \
        if (WID_ == 0 && lane_id() == 0) { __builtin_amdgcn_fence(__ATOMIC_ACQUIRE, "agent"); asm volatile("s_waitcnt vmcnt(0)" ::: "memory"); } __syncthreads(); } while (0)
    for (int tl = GB; tl < M / 256; tl += GN) {
        { pg8::TileOrder S; S.init(Z, 512, w_glu_t, 512, 512, 2, tl); pg8::EpiGlu E{Z, IN(24), YMIX}; pg8::gemm_phase(WID_, ldsl, S, E); }
        BLK_SYNC();
        { pg8::TileOrder S; S.init(YMIX, D, w_mix_t, D, D, 4, tl); pg8::EpiF32 E{out, D, IN(0), D}; pg8::gemm_phase(WID_, ldsl, S, E); }
        BLK_SYNC();
        rmsnorm_ph<bf16>(WID_, out, IN(26), XN2, tl * 256 + 256, tl * 256, 0, 1);
        BLK_SYNC();
        { pg8::TileOrder S; S.init(XN2, D, w_q_t, D, D, 4, tl); pg8::EpiBf16 E{Q, D}; pg8::gemm_phase(WID_, ldsl, S, E); }
        BLK_SYNC();
        { pg8::AttnTileOrder S; S.init(Q, KM, D, 0, tl); pg8::EpiSoftmax E{P, (PG8_LAS float*)(ldsl + 131072)}; pg8::gemm_phase(WID_, ldsl, S, E); }
        BLK_SYNC();
        { pg8::AttnTileOrder S; S.init(P, VT, NB * NMEM, 1, tl); pg8::EpiAttnO E{O}; pg8::gemm_phase(WID_, ldsl, S, E); }
        BLK_SYNC();
        { pg8::TileOrder S; S.init(O, D, w_o_t, D, D, 4, tl); pg8::EpiF32 E{out, D, out, D}; pg8::gemm_phase(WID_, ldsl, S, E); }
        BLK_SYNC();
        { MKMB(mb); router_ph(WID_, p.out, IN(32), (bf16*)(p.ws + W_XN * MiB), IN(33), IN(34), IN(35), IN(36), mb, lds, tl); }
    }
    SYNC();
    { MKMB(mb); moe_plan_ph(WID_, mb, lds); }
    SYNC();
    { MKMB(mb); moe_scatter_ph(WID_, mb, lds); }
    MKMB(mb);
    SYNC();
    const int ntiles = __hip_atomic_load(mb.ntiles, __ATOMIC_RELAXED, __HIP_MEMORY_SCOPE_AGENT);
    { pg8::MoeOrderT<true> S; S.init(H3, D, WGU_t, D, D, mb.tiles, ntiles, 1024, mb.slot_tok); pg8::EpiSilu E{HID}; pg8::gemm_phase(WID_, ldsl, S, E); }
    SYNC();
    { pg8::MoeOrderT<false> S; S.init(HID, DEXP, WD_t, DEXP, DEXP, mb.tiles, ntiles, 1024, nullptr); pg8::EpiGate E{YSLOT, mb.slot_gate}; pg8::gemm_phase(WID_, ldsl, S, E); }
    SYNC();
    final_ph(WID_, out, YSLOT, mb.tok_slot, IN(40));
    if (PROBE_PHASE >= 0) {
        if (pr_t1 == 0) pr_t1 = __builtin_amdgcn_s_memrealtime();
        if (GB == 0) { const unsigned long long t_end = __builtin_amdgcn_s_memrealtime(), wait = 8ull * (pr_t1 - pr_t0);
            while (__builtin_amdgcn_s_memrealtime() - t_end < wait) __builtin_amdgcn_s_sleep(8); }
    }
}
}

extern "C" void kernel_launch(void* const* d_in, const int* in_sizes, int n_in, void* d_out, int out_size, void* d_ws, size_t ws_size, hipStream_t stream) {
    (void)in_sizes; (void)out_size; (void)ws_size;
    static int grid = 0;
    if (grid == 0) {
        int dev = 0, cus = 0, per_cu = 0;
        hipGetDevice(&dev);
        hipDeviceGetAttribute(&cus, hipDeviceAttributeMultiprocessorCount, dev);
        hipFuncSetAttribute((const void*)fwd_kernel, hipFuncAttributeMaxDynamicSharedMemorySize, LDS_BYTES);
        hipOccupancyMaxActiveBlocksPerMultiprocessor(&per_cu, (const void*)fwd_kernel, NT, LDS_BYTES);
        if (per_cu < 1) { fprintf(stderr, "occupancy query says %d blocks/CU\n", per_cu); per_cu = 1; }
        grid = cus * 1;
    }
    (void)hipMemsetAsync((char*)d_ws + W_CTL * MiB, 0, 16384, stream);
    Params p{};
    for (int i = 0; i < 41 && i < n_in; ++i) p.in[i] = (const float*)d_in[i];
    p.out = (float*)d_out; p.ws = (char*)d_ws;
    void* args[] = {&p};
    hipError_t e = hipLaunchCooperativeKernel((const void*)fwd_kernel, dim3(grid), dim3(NT), args, LDS_BYTES, stream);
    if (e != hipSuccess) fprintf(stderr, "cooperative launch failed: %s (grid %d)\n", hipGetErrorString(e), grid);
}
```

```cpp
#include <hip/hip_runtime.h>
#include <hip/hip_cooperative_groups.h>
#include <stdint.h>
#include <cstdio>
namespace cg = cooperative_groups;

namespace {
constexpr int NB = 8, S = 8192, D = 1024, M = NB * S;
constexpr int DR = 512, DSHIFT = 1792, DIN = 2304, NMEM = 256;
constexpr int NEXP = 32, DEXP = 512, NASSIGN = 2 * M;
constexpr size_t MiB = 1u << 20;
constexpr int NT = 512;
constexpr int S5L = 32, S5R = M / S5L;
constexpr int LDS_BYTES = 147456;
#define GB ((int)blockIdx.x)
#define GN ((int)gridDim.x)

typedef unsigned short bf16;
typedef float f32x2h __attribute__((ext_vector_type(2)));
typedef __bf16 bf16x2h __attribute__((ext_vector_type(2)));
__device__ __forceinline__ unsigned pk2(float lo, float hi) { const f32x2h v = {lo, hi}; const bf16x2h b = __builtin_convertvector(v, bf16x2h); return __builtin_bit_cast(unsigned, b); }
__device__ __forceinline__ bf16 f2bf(float f) { return (bf16)(pk2(f, f) & 0xffffu); }
__device__ __forceinline__ int lane_id() { int l; asm volatile("v_mbcnt_lo_u32_b32 %0, -1, 0\n\tv_mbcnt_hi_u32_b32 %0, -1, %0" : "=v"(l)); return l; }
__device__ __forceinline__ float bf2f(bf16 h) { return __builtin_bit_cast(float, (unsigned)h << 16); }

template <typename T> __device__ __forceinline__ float ldf(const T* p);
template <> __device__ __forceinline__ float ldf<float>(const float* p) { return *p; }
template <> __device__ __forceinline__ float ldf<bf16>(const bf16* p) { return bf2f(*p); }
template <typename T> __device__ __forceinline__ void stf(T* p, float v);
template <> __device__ __forceinline__ void stf<float>(float* p, float v) { *p = v; }
template <> __device__ __forceinline__ void stf<bf16>(bf16* p, float v) { *p = f2bf(v); }

template <int CTRL, int ROWMASK> __device__ __forceinline__ float dppf_(float x) { return __builtin_bit_cast(float, __builtin_amdgcn_update_dpp(0, __builtin_bit_cast(int, x), CTRL, ROWMASK, 0xf, false)); }
__device__ __forceinline__ float wave_sum(float v) {
    v += dppf_<0xB1, 0xf>(v); v += dppf_<0x4E, 0xf>(v); v += dppf_<0x141, 0xf>(v); v += dppf_<0x140, 0xf>(v);
    v += dppf_<0x142, 0xa>(v);
    v += dppf_<0x143, 0xc>(v);
    return __builtin_bit_cast(float, __builtin_amdgcn_readlane(__builtin_bit_cast(int, v), 63));
}
__device__ __forceinline__ float sigmoidf_(float x) { return 1.f / (1.f + __expf(-x)); }


__device__ __forceinline__ float gelu_tanh(float x) { return x * sigmoidf_(1.5957691216057308f * (x + 0.044715f * x * x * x)); }

namespace pg8 {
#define PG8_LAS __attribute__((address_space(3)))
typedef short bf16x8 __attribute__((ext_vector_type(8)));
typedef float f32x4 __attribute__((ext_vector_type(4)));
typedef unsigned u32x4 __attribute__((ext_vector_type(4)));
constexpr int BM = 256, BK = 64, HALF = 128, HTB = HALF * BK * 2, STAGE_BYTES = 8 * HTB, NXCD = 8, WGM = 8;
__device__ __forceinline__ int lds_byte(int r, int c) { const int st = (r >> 4) * 2 + (c >> 5), rr = r & 15, cc = c & 31, ob = rr * 64 + cc * 2; return st * 1024 + (ob ^ (((ob >> 9) & 1) << 5)); }
__device__ __forceinline__ void stage_rc(int b, int& R, int& C) { const int st = b / 1024, sb = b % 1024, swz = sb ^ (((sb >> 9) & 1) << 5); R = (st >> 1) * 16 + swz / 64; C = (st & 1) * 32 + (swz % 64) / 2; }
__device__ __forceinline__ int perm32(int rho) { const int n = rho >> 4, i = rho & 15; return 8 * (i >> 2) + 4 * n + (i & 3); }
struct Unit { int pm, pn; };
struct PlainOrder {
    static constexpr bool GATHER = false; __device__ __forceinline__ int grow(const Unit&, int) const { return 0; }
    const bf16* A; const bf16* Bt; int lda, ldb, K; int nM, nN, nwg, G, c;
    __device__ void init(const bf16* A_, int lda_, const bf16* Bt_, int ldb_, int M, int N, int K_, int coff = 0) { A = A_; Bt = Bt_; lda = lda_; ldb = ldb_; K = K_; nM = M / BM; nN = N / BM; nwg = nM * nN; G = GN; c = (GB + GN - coff % GN) % GN; }
    __device__ bool next(int i, Unit& u) const {
        const long L = (long)i * G + c; if (L >= nwg) return false;
        int wgid = (int)L; { const int q = nwg / NXCD, r = nwg % NXCD, xcd = wgid % NXCD, off = wgid / NXCD; wgid = (xcd < r ? xcd * (q + 1) : r * (q + 1) + (xcd - r) * q) + off; }
        const int nig = WGM * nN, gid = wgid / nig, fm = gid * WGM, gsz = (nM - fm) < WGM ? (nM - fm) : WGM;
        u.pm = fm + ((wgid % nig) % gsz); u.pn = (wgid % nig) / gsz; return true;
    }
    __device__ __forceinline__ const char* aptr(const Unit& u) const { return (const char*)(A + (size_t)u.pm * BM * lda); }
    __device__ __forceinline__ const char* bptr(const Unit& u) const { return (const char*)(Bt + (size_t)u.pn * BM * ldb); }
};
typedef float f32x2c __attribute__((ext_vector_type(2)));
typedef __bf16 bf16x2c __attribute__((ext_vector_type(2)));
__device__ __forceinline__ unsigned cvt_pk_bf16(float lo, float hi) { const f32x2c v = {lo, hi}; const bf16x2c b = __builtin_convertvector(v, bf16x2c); return __builtin_bit_cast(unsigned, b); }

template <class Epi, class Sched>
__device__ __forceinline__ void gemm_phase(const int WID_, PG8_LAS unsigned char* lds, const Sched& S, const Epi& E) {
    const int tid = (WID_ * 64 + lane_id()), wid = __builtin_amdgcn_readfirstlane(tid >> 6), lane = tid & 63, wr = wid >> 2, wc = wid & 3, fr = lane & 15, fq = lane >> 4;
    const int K = S.K, nt = K / BK;
    unsigned voffA[2], voffB[2];
#pragma unroll
    for (int i = 0; i < 2; ++i) { int R, C; stage_rc(tid * 16 + i * 8192, R, C); const int Rb = Epi::PERM ? ((R & ~31) + perm32(R & 31)) : R;
        voffA[i] = (unsigned)(R * S.lda + C) * 2u; voffB[i] = (unsigned)(Rb * S.ldb + C) * 2u; }
    constexpr bool GA = Sched::GATHER;
    int gR[2], gC[2];
#pragma unroll
    for (int i = 0; i < 2; ++i) stage_rc(tid * 16 + i * 8192, gR[i], gC[i]);
    unsigned vgc[2][2] = {{0u, 0u}, {0u, 0u}}, vgn[2][2] = {{0u, 0u}, {0u, 0u}};
#define PG8_GOFF(dst, u) do { if constexpr (GA) { _Pragma("unroll") for (int h_ = 0; h_ < 2; ++h_) _Pragma("unroll") for (int i_ = 0; i_ < 2; ++i_) \
        dst[h_][i_] = (unsigned)(S.grow(u, h_ * HALF + gR[i_]) * S.lda + gC[i_]) * 2u; } } while (0)
    const size_t kstep = (size_t)(BK * 2);
    const size_t hstepA = GA ? 0 : (size_t)HALF * S.lda * 2, hstepB = (size_t)HALF * S.ldb * 2;
    const unsigned ldsw = (unsigned)wid * 1024u;
    const int aoff = lds_byte(wr * 64 + fr, fq * 8), boff = lds_byte(wc * 32 + fr, fq * 8);
#define PG8_SA(b, h) (((b) * 2 + (h)) * HTB)
#define PG8_SB(b, h) ((4 + (b) * 2 + (h)) * HTB)
#define PG8_STAGE(bufoff, gbase, voff) do { _Pragma("unroll") for (int _i = 0; _i < 2; ++_i) \
        __builtin_amdgcn_global_load_lds((const unsigned*)((const char*)(gbase) + (voff)[_i]), (PG8_LAS unsigned*)(lds + (bufoff) + ldsw + _i * 8192), 16, 0, 0); } while (0)
#define PG8_STAGE_A(bufoff, gbase, h, nx) do { _Pragma("unroll") for (int _i = 0; _i < 2; ++_i) { \
        const unsigned vo_ = GA ? ((nx) ? vgn[h][_i] : vgc[h][_i]) : voffA[_i]; \
        __builtin_amdgcn_global_load_lds((const unsigned*)((const char*)(gbase) + vo_), (PG8_LAS unsigned*)(lds + (bufoff) + ldsw + _i * 8192), 16, 0, 0); } } while (0)
#define PG8_LDA(dst, b, h) do { _Pragma("unroll") for (int m = 0; m < 4; ++m) _Pragma("unroll") for (int k = 0; k < 2; ++k) dst[m][k] = *(const PG8_LAS bf16x8*)(lds + PG8_SA(b, h) + aoff + m * 2048 + k * 1024); } while (0)
#define PG8_LDB(dst, b, h) do { _Pragma("unroll") for (int n = 0; n < 2; ++n) _Pragma("unroll") for (int k = 0; k < 2; ++k) dst[n][k] = *(const PG8_LAS bf16x8*)(lds + PG8_SB(b, h) + boff + n * 2048 + k * 1024); } while (0)
#define PG8_MMA(ai, bj, At, Bt) do { __builtin_amdgcn_s_setprio(1); _Pragma("unroll") for (int m = 0; m < 4; ++m) _Pragma("unroll") for (int n = 0; n < 2; ++n) _Pragma("unroll") for (int k = 0; k < 2; ++k) \
        acc[ai][bj][m][n] = __builtin_amdgcn_mfma_f32_16x16x32_bf16(Bt[n][k], At[m][k], acc[ai][bj][m][n], 0, 0, 0); __builtin_amdgcn_s_setprio(0); } while (0)
#define PG8_WAIT_V(n) asm volatile("s_waitcnt vmcnt(" #n ")" ::: "memory")
#define PG8_WAIT_L(n) asm volatile("s_waitcnt lgkmcnt(" #n ")" ::: "memory")
#define PG8_BAR __builtin_amdgcn_s_barrier()
#define PG8_SCHED __builtin_amdgcn_sched_barrier(0)
    Unit cur, nxt; int ui = 0;
    if (!S.next(0, cur)) return;
    f32x4 acc[2][2][4][2];
#pragma unroll
    for (int a = 0; a < 2; ++a)
#pragma unroll
        for (int b = 0; b < 2; ++b)
#pragma unroll
            for (int m = 0; m < 4; ++m)
#pragma unroll
                for (int n = 0; n < 2; ++n) acc[a][b][m][n] = (f32x4){0.f, 0.f, 0.f, 0.f};
    bf16x8 At[4][2], B0[2][2], B1[2][2];
    const char* cA = S.aptr(cur); const char* cB = S.bptr(cur);
    PG8_STAGE(PG8_SB(0, 0), cB, voffB); PG8_STAGE(PG8_SB(0, 1), cB + hstepB, voffB); PG8_GOFF(vgc, cur); PG8_STAGE_A(PG8_SA(0, 0), cA, 0, false); PG8_STAGE_A(PG8_SA(0, 1), cA + hstepA, 1, false);
    if (wr == 1) PG8_BAR;
    PG8_WAIT_V(2); PG8_BAR;
    PG8_STAGE(PG8_SB(1, 0), cB + kstep, voffB); PG8_STAGE_A(PG8_SA(1, 0), cA + kstep, 0, false); PG8_STAGE(PG8_SB(1, 1), cB + hstepB + kstep, voffB);
    PG8_WAIT_V(6); PG8_BAR;
    for (;;) {
        const bool has_next = S.next(ui + 1, nxt);
        const char* nA = has_next ? S.aptr(nxt) : cA; const char* nB = has_next ? S.bptr(nxt) : cB;
        if (has_next) PG8_GOFF(vgn, nxt); else { if constexpr (GA) { _Pragma("unroll") for (int h_ = 0; h_ < 2; ++h_) _Pragma("unroll") for (int i_ = 0; i_ < 2; ++i_) vgn[h_][i_] = vgc[h_][i_]; } }
        for (int t = 0; t < nt; t += 2) {
            const bool last = (t == nt - 2);
            const char* a1 = cA + (size_t)(t + 1) * kstep;
            const char* a2 = last ? nA : cA + (size_t)(t + 2) * kstep; const char* b2 = last ? nB : cB + (size_t)(t + 2) * kstep;
            const char* a3 = a2 + kstep; const char* b3 = b2 + kstep;
            PG8_LDB(B0, 0, 0); PG8_LDB(B1, 0, 1); PG8_SCHED; PG8_LDA(At, 0, 0); PG8_STAGE_A(PG8_SA(1, 1), a1 + hstepA, 1, false);
            PG8_WAIT_V(8); PG8_WAIT_L(0); PG8_BAR; PG8_MMA(0, 0, At, B0); PG8_MMA(0, 1, At, B1); PG8_BAR; PG8_SCHED;
            PG8_LDA(At, 0, 1); PG8_STAGE(PG8_SB(0, 0), b2, voffB); PG8_STAGE(PG8_SB(0, 1), b2 + hstepB, voffB); PG8_STAGE_A(PG8_SA(0, 0), a2, 0, last);
            PG8_WAIT_V(8); PG8_WAIT_L(0); PG8_BAR; PG8_MMA(1, 0, At, B0); PG8_MMA(1, 1, At, B1); PG8_BAR; PG8_SCHED;
            PG8_LDB(B0, 1, 0); PG8_LDB(B1, 1, 1); PG8_SCHED; PG8_LDA(At, 1, 0); PG8_STAGE_A(PG8_SA(0, 1), a2 + hstepA, 1, last);
            PG8_WAIT_V(8); PG8_WAIT_L(0); PG8_BAR; PG8_MMA(0, 0, At, B0); PG8_MMA(0, 1, At, B1); PG8_BAR; PG8_SCHED;
            PG8_LDA(At, 1, 1); PG8_STAGE(PG8_SB(1, 0), b3, voffB); PG8_STAGE(PG8_SB(1, 1), b3 + hstepB, voffB); PG8_STAGE_A(PG8_SA(1, 0), a3, 0, last);
            PG8_WAIT_V(8); PG8_WAIT_L(0); PG8_BAR; PG8_MMA(1, 0, At, B0); PG8_MMA(1, 1, At, B1); PG8_BAR; PG8_SCHED;
        }
        if (wr == 0) PG8_BAR;
        E(acc, cur, wr, wc, fr, fq);
        if (!has_next) break;
#pragma unroll
        for (int a = 0; a < 2; ++a)
#pragma unroll
            for (int b = 0; b < 2; ++b)
#pragma unroll
                for (int m = 0; m < 4; ++m)
#pragma unroll
                    for (int n = 0; n < 2; ++n) acc[a][b][m][n] = (f32x4){0.f, 0.f, 0.f, 0.f};
        cur = nxt; cA = nA; cB = nB; ++ui;
        if constexpr (GA) { _Pragma("unroll") for (int h_ = 0; h_ < 2; ++h_) _Pragma("unroll") for (int i_ = 0; i_ < 2; ++i_) vgc[h_][i_] = vgn[h_][i_]; }
        if (wr == 1) PG8_BAR;
    }
    PG8_WAIT_V(0);
    PG8_BAR;
#undef PG8_SA
#undef PG8_SB
#undef PG8_STAGE
#undef PG8_STAGE_A
#undef PG8_GOFF
#undef PG8_LDA
#undef PG8_LDB
#undef PG8_MMA
#undef PG8_WAIT_V
#undef PG8_WAIT_L
#undef PG8_BAR
#undef PG8_SCHED
}

struct EpiF32 {
    static constexpr bool PERM = false;
    float* C; int ldc; const float* R; int ldr;
    __device__ __forceinline__ void operator()(const f32x4 (&acc)[2][2][4][2], const Unit& u, int wr, int wc, int fr, int fq) const {
        const int row0 = u.pm * BM + wr * 64 + fr, col0 = u.pn * BM + wc * 32 + 4 * fq;
#pragma unroll
        for (int ai = 0; ai < 2; ++ai)
#pragma unroll
            for (int m = 0; m < 4; ++m) { const size_t row = (size_t)(row0 + ai * HALF + m * 16);
#pragma unroll
                for (int bj = 0; bj < 2; ++bj)
#pragma unroll
                    for (int n = 0; n < 2; ++n) { const int col = col0 + bj * HALF + 16 * n; f32x4 v = acc[ai][bj][m][n];
                        if (R) v = v + *(const f32x4*)(R + row * ldr + col);
                        *(f32x4*)(C + row * ldc + col) = v; } }
    }
};
struct EpiBf16 {
    static constexpr bool PERM = true;
    bf16* O; int ldc;
    __device__ __forceinline__ void operator()(const f32x4 (&acc)[2][2][4][2], const Unit& u, int wr, int wc, int fr, int fq) const {
        const int row0 = u.pm * BM + wr * 64 + fr, col0 = u.pn * BM + wc * 32 + 8 * fq;
#pragma unroll
        for (int ai = 0; ai < 2; ++ai)
#pragma unroll
            for (int m = 0; m < 4; ++m) { bf16* rowp = O + (size_t)(row0 + ai * HALF + m * 16) * ldc + col0;
#pragma unroll
                for (int bj = 0; bj < 2; ++bj) { const f32x4 v0 = acc[ai][bj][m][0], v1 = acc[ai][bj][m][1];
                    u32x4 w; w.x = cvt_pk_bf16(v0[0], v0[1]); w.y = cvt_pk_bf16(v0[2], v0[3]); w.z = cvt_pk_bf16(v1[0], v1[1]); w.w = cvt_pk_bf16(v1[2], v1[3]);
                    *(u32x4*)(rowp + bj * HALF) = w; } }
    }
};
struct EpiGlu {
    static constexpr bool PERM = true;
    const bf16* Z; const float* bias; bf16* YM;
    __device__ __forceinline__ void operator()(const f32x4 (&acc)[2][2][4][2], const Unit& u, int wr, int wc, int fr, int fq) const {
        const int row0 = u.pm * BM + wr * 64 + fr, col0 = u.pn * BM + wc * 32 + 8 * fq;
#pragma unroll
        for (int ai = 0; ai < 2; ++ai)
#pragma unroll
            for (int m = 0; m < 4; ++m) { const size_t row = (size_t)(row0 + ai * HALF + m * 16);
#pragma unroll
                for (int bj = 0; bj < 2; ++bj) { const int col = col0 + bj * HALF;
                    const u32x4 zz = *(const u32x4*)(Z + row * 512 + col);
                    const f32x4 b0 = *(const f32x4*)(bias + col), b1 = *(const f32x4*)(bias + col + 4);
                    const f32x4 v0 = acc[ai][bj][m][0] + b0, v1 = acc[ai][bj][m][1] + b1;
                    float o[8]; const unsigned zw[4] = {zz.x, zz.y, zz.z, zz.w};
#pragma unroll
                    for (int q = 0; q < 4; ++q) { const float zl = __builtin_bit_cast(float, zw[q] << 16), zh = __builtin_bit_cast(float, zw[q] & 0xffff0000u);
                        const float al = (q < 2) ? v0[2 * q] : v1[2 * q - 4], ah = (q < 2) ? v0[2 * q + 1] : v1[2 * q - 3];
                        o[2 * q] = zl * sigmoidf_(al); o[2 * q + 1] = zh * sigmoidf_(ah); }
                    u32x4 w; w.x = cvt_pk_bf16(o[0], o[1]); w.y = cvt_pk_bf16(o[2], o[3]); w.z = cvt_pk_bf16(o[4], o[5]); w.w = cvt_pk_bf16(o[6], o[7]);
                    *(u32x4*)(YM + row * D + 512 + col) = w; } }
    }
};

template <bool GATHER_>
struct MoeOrderT {
    static constexpr bool GATHER = GATHER_;
    const bf16* A; const bf16* Bt; int lda, ldb, K; const int* tiles; const int* rows; int nunits, G, c; size_t bexp;
    __device__ void init(const bf16* A_, int lda_, const bf16* Bt_, int ldb_, int K_, const int* tiles_, int ntiles, size_t bexp_, const int* rows_) { A = A_; Bt = Bt_; lda = lda_; ldb = ldb_; K = K_; tiles = tiles_; rows = rows_; nunits = ntiles * 4; G = GN; c = GB; bexp = bexp_; }
    __device__ bool next(int i, Unit& u) const { const int L = i * G + c; if (L >= nunits) return false; u.pm = L >> 2; u.pn = L & 3; return true; }
    __device__ __forceinline__ const char* aptr(const Unit& u) const { return GATHER ? (const char*)A : (const char*)(A + (size_t)u.pm * BM * lda); }
    __device__ __forceinline__ int grow(const Unit& u, int r) const { return rows[u.pm * BM + r]; }
    __device__ __forceinline__ const char* bptr(const Unit& u) const { const int e = __hip_atomic_load(tiles + u.pm, __ATOMIC_RELAXED, __HIP_MEMORY_SCOPE_AGENT); return (const char*)(Bt + ((size_t)e * bexp + (size_t)u.pn * BM) * ldb); }
};
struct EpiSilu {
    static constexpr bool PERM = true;
    bf16* HID;
    __device__ __forceinline__ void operator()(const f32x4 (&acc)[2][2][4][2], const Unit& u, int wr, int wc, int fr, int fq) const {
        const int row0 = u.pm * BM + wr * 64 + fr, col0 = u.pn * HALF + wc * 32 + 8 * fq;
#pragma unroll
        for (int ai = 0; ai < 2; ++ai)
#pragma unroll
            for (int m = 0; m < 4; ++m) { const size_t row = (size_t)(row0 + ai * HALF + m * 16);
                float o[8];
#pragma unroll
                for (int n = 0; n < 2; ++n)
#pragma unroll
                    for (int q = 0; q < 4; ++q) { const float g = acc[ai][0][m][n][q], up = acc[ai][1][m][n][q]; o[4 * n + q] = g * sigmoidf_(g) * up; }
                u32x4 w; w.x = cvt_pk_bf16(o[0], o[1]); w.y = cvt_pk_bf16(o[2], o[3]); w.z = cvt_pk_bf16(o[4], o[5]); w.w = cvt_pk_bf16(o[6], o[7]);
                *(u32x4*)(HID + row * DEXP + col0) = w; }
    }
};
struct EpiGate {
    static constexpr bool PERM = true;
    bf16* Y; const float* gate;
    __device__ __forceinline__ void operator()(const f32x4 (&acc)[2][2][4][2], const Unit& u, int wr, int wc, int fr, int fq) const {
        const int row0 = u.pm * BM + wr * 64 + fr, col0 = u.pn * BM + wc * 32 + 8 * fq;
#pragma unroll
        for (int ai = 0; ai < 2; ++ai)
#pragma unroll
            for (int m = 0; m < 4; ++m) { const size_t row = (size_t)(row0 + ai * HALF + m * 16); const float gt = gate[row];
#pragma unroll
                for (int bj = 0; bj < 2; ++bj) { const f32x4 v0 = acc[ai][bj][m][0] * gt, v1 = acc[ai][bj][m][1] * gt;
                    u32x4 w; w.x = cvt_pk_bf16(v0[0], v0[1]); w.y = cvt_pk_bf16(v0[2], v0[3]); w.z = cvt_pk_bf16(v1[0], v1[1]); w.w = cvt_pk_bf16(v1[2], v1[3]);
                    *(u32x4*)(Y + row * D + col0 + bj * HALF) = w; } }
    }
};

struct EpiProj {
    static constexpr bool PERM = true;
    bf16* PROJ; bf16* US5;
    __device__ __forceinline__ void operator()(const f32x4 (&acc)[2][2][4][2], const Unit& u, int wr, int wc, int fr, int fq) const {
        const int row0 = u.pm * BM + wr * 64 + fr, col0 = u.pn * BM + wc * 32 + 8 * fq;
#pragma unroll
        for (int ai = 0; ai < 2; ++ai)
#pragma unroll
            for (int m = 0; m < 4; ++m) { const size_t row = (size_t)(row0 + ai * HALF + m * 16);
#pragma unroll
                for (int bj = 0; bj < 2; ++bj) { const f32x4 v0 = acc[ai][bj][m][0], v1 = acc[ai][bj][m][1]; const int col = col0 + bj * HALF;
                    u32x4 w; w.x = cvt_pk_bf16(v0[0], v0[1]); w.y = cvt_pk_bf16(v0[2], v0[3]); w.z = cvt_pk_bf16(v1[0], v1[1]); w.w = cvt_pk_bf16(v1[2], v1[3]);
                    if (col < DSHIFT) *(u32x4*)(PROJ + row * DSHIFT + col) = w;
                    else { const int cc = col - DSHIFT; *(u32x4*)(US5 + ((size_t)(cc >> 4) * M + row) * 16 + (cc & 15)) = w; } } }
    }
};
struct GroupOrder {
    static constexpr bool GATHER = false; __device__ __forceinline__ int grow(const Unit&, int) const { return 0; }
    const bf16* A; const bf16* Bt; int lda, ldb, K; int nM, nN, nunits, G, c; size_t sA, sB;
    __device__ void init(const bf16* A_, int lda_, size_t sA_, const bf16* Bt_, int ldb_, size_t sB_, int ngroups, int Mg, int Ng, int K_) {
        A = A_; Bt = Bt_; lda = lda_; ldb = ldb_; K = K_; sA = sA_; sB = sB_; nM = Mg / BM; nN = Ng / BM; nunits = ngroups * nM * nN; G = GN; c = GB; }
    __device__ bool next(int i, Unit& u) const { const int L = i * G + c; if (L >= nunits) return false; u.pn = L % nN; u.pm = L / nN; return true; }
    __device__ __forceinline__ const char* aptr(const Unit& u) const { const int g = u.pm / nM, pm = u.pm % nM; return (const char*)(A + (size_t)g * sA + (size_t)pm * BM * lda); }
    __device__ __forceinline__ const char* bptr(const Unit& u) const { const int g = u.pm / nM; return (const char*)(Bt + (size_t)g * sB + (size_t)u.pn * BM * ldb); }
};
struct EpiS5a {
    static constexpr bool PERM = false;
    bf16* YI; float* F;
    __device__ __forceinline__ void operator()(const f32x4 (&acc)[2][2][4][2], const Unit& u, int wr, int wc, int fr, int fq) const {
        const int row0 = u.pm * BM + wr * 64 + fr, col0 = u.pn * BM + wc * 32 + 4 * fq;
#pragma unroll
        for (int ai = 0; ai < 2; ++ai)
#pragma unroll
            for (int m = 0; m < 4; ++m) { const size_t row = (size_t)(row0 + ai * HALF + m * 16);
#pragma unroll
                for (int bj = 0; bj < 2; ++bj)
#pragma unroll
                    for (int n = 0; n < 2; ++n) { const int col = col0 + bj * HALF + 16 * n; const f32x4 v = acc[ai][bj][m][n];
                        if (col < 512) { uint2 w; w.x = cvt_pk_bf16(v[0], v[1]); w.y = cvt_pk_bf16(v[2], v[3]); *(uint2*)(YI + row * 512 + col) = w; }
                        else if (col < 640) *(f32x4*)(F + row * 128 + (col - 512)) = v; } }
    }
};
struct EpiS5b {
    static constexpr bool PERM = true;
    const bf16* YI; bf16* Z;
    __device__ __forceinline__ void operator()(const f32x4 (&acc)[2][2][4][2], const Unit& u, int wr, int wc, int fr, int fq) const {
        const int row0 = u.pm * BM + wr * 64 + fr, col0 = u.pn * BM + wc * 32 + 8 * fq;
#pragma unroll
        for (int ai = 0; ai < 2; ++ai)
#pragma unroll
            for (int m = 0; m < 4; ++m) { const int row = row0 + ai * HALF + m * 16; const int g = row / S5R, rl = row % S5R;
#pragma unroll
                for (int bj = 0; bj < 2; ++bj) { const int col = col0 + bj * HALF;
                    const u32x4 yi = *(const u32x4*)(YI + (size_t)row * 512 + col);
                    const unsigned yw[4] = {yi.x, yi.y, yi.z, yi.w};
                    const f32x4 v0 = acc[ai][bj][m][0], v1 = acc[ai][bj][m][1];
                    float o[8];
#pragma unroll
                    for (int q = 0; q < 4; ++q) { const float al = (q < 2) ? v0[2 * q] : v1[2 * q - 4], ah = (q < 2) ? v0[2 * q + 1] : v1[2 * q - 3];
                        o[2 * q] = gelu_tanh(al + __builtin_bit_cast(float, yw[q] << 16)); o[2 * q + 1] = gelu_tanh(ah + __builtin_bit_cast(float, yw[q] & 0xffff0000u)); }
                    u32x4 w; w.x = cvt_pk_bf16(o[0], o[1]); w.y = cvt_pk_bf16(o[2], o[3]); w.z = cvt_pk_bf16(o[4], o[5]); w.w = cvt_pk_bf16(o[6], o[7]);
                    const size_t tok = (size_t)rl * S5L + (col >> 4);
                    *(u32x4*)(Z + tok * 512 + g * 16 + (col & 15)) = w; } }
    }
};
struct AttnOrder {
    static constexpr bool GATHER = false; __device__ __forceinline__ int grow(const Unit&, int) const { return 0; }
    const bf16* A; const bf16* Bt; int lda, ldb, K; int G, c; int mode;
    __device__ void init(const bf16* A_, const bf16* Bt_, int ldb_, int mode_) { A = A_; Bt = Bt_; lda = D; ldb = ldb_; K = 256; G = GN; c = GB; mode = mode_; }
    __device__ bool next(int i, Unit& u) const { const int L = i * G + c; if (L >= NB * 4 * 32) return false; u.pn = L & 3; u.pm = L >> 2; return true; }
    __device__ __forceinline__ const char* aptr(const Unit& u) const { return (const char*)(A + (size_t)u.pm * BM * D + u.pn * 256); }
    __device__ __forceinline__ const char* bptr(const Unit& u) const { const int b = u.pm >> 5;
        return (const char*)(mode == 0 ? Bt + (size_t)b * 256 * ldb + u.pn * 256 : Bt + (size_t)u.pn * 256 * ldb + b * 256); }
};
struct EpiSoftmax {
    static constexpr bool PERM = true;
    bf16* P; PG8_LAS float* scr;
    __device__ __forceinline__ void operator()(f32x4 (&acc)[2][2][4][2], const Unit& u, int wr, int wc, int fr, int fq) const {
        const float SC = 0.0625f * 1.4426950408889634f;
        PG8_LAS float* smax = scr; PG8_LAS float* ssum = scr + 1024;
#pragma unroll
        for (int ai = 0; ai < 2; ++ai)
#pragma unroll
            for (int m = 0; m < 4; ++m) { float t = -3.0e38f;
#pragma unroll
                for (int bj = 0; bj < 2; ++bj)
#pragma unroll
                    for (int n = 0; n < 2; ++n) { const f32x4 v = acc[ai][bj][m][n]; t = fmaxf(t, fmaxf(fmaxf(v[0], v[1]), fmaxf(v[2], v[3]))); }
                t = fmaxf(t, __shfl_xor(t, 16)); t = fmaxf(t, __shfl_xor(t, 32));
                if (fq == 0) smax[(ai * HALF + wr * 64 + m * 16 + fr) * 4 + wc] = t; }
        asm volatile("s_waitcnt lgkmcnt(0)" ::: "memory"); __builtin_amdgcn_s_barrier(); asm volatile("" ::: "memory");
#pragma unroll
        for (int ai = 0; ai < 2; ++ai)
#pragma unroll
            for (int m = 0; m < 4; ++m) { const f32x4 q = *(const PG8_LAS f32x4*)(smax + (ai * HALF + wr * 64 + m * 16 + fr) * 4);
                const float mm = fmaxf(fmaxf(q[0], q[1]), fmaxf(q[2], q[3])) * SC; float s = 0.f;
#pragma unroll
                for (int bj = 0; bj < 2; ++bj)
#pragma unroll
                    for (int n = 0; n < 2; ++n)
#pragma unroll
                        for (int e = 0; e < 4; ++e) { const float p = __builtin_amdgcn_exp2f(acc[ai][bj][m][n][e] * SC - mm); acc[ai][bj][m][n][e] = p; s += p; }
                s += __shfl_xor(s, 16); s += __shfl_xor(s, 32);
                if (fq == 0) ssum[(ai * HALF + wr * 64 + m * 16 + fr) * 4 + wc] = s; }
        asm volatile("s_waitcnt lgkmcnt(0)" ::: "memory"); __builtin_amdgcn_s_barrier(); asm volatile("" ::: "memory");
        const int row0 = u.pm * BM + wr * 64 + fr, col0 = u.pn * 256 + wc * 32 + 8 * fq;
#pragma unroll
        for (int ai = 0; ai < 2; ++ai)
#pragma unroll
            for (int m = 0; m < 4; ++m) { const f32x4 q = *(const PG8_LAS f32x4*)(ssum + (ai * HALF + wr * 64 + m * 16 + fr) * 4);
                const float iv = 1.f / ((q[0] + q[1]) + (q[2] + q[3]));
                bf16* rowp = P + (size_t)(row0 + ai * HALF + m * 16) * D + col0;
#pragma unroll
                for (int bj = 0; bj < 2; ++bj) { const f32x4 v0 = acc[ai][bj][m][0] * iv, v1 = acc[ai][bj][m][1] * iv; u32x4 w;
                    w.x = cvt_pk_bf16(v0[0], v0[1]); w.y = cvt_pk_bf16(v0[2], v0[3]); w.z = cvt_pk_bf16(v1[0], v1[1]); w.w = cvt_pk_bf16(v1[2], v1[3]);
                    *(u32x4*)(rowp + bj * HALF) = w; } }
    }
};
struct EpiAttnO {
    static constexpr bool PERM = true;
    bf16* O;
    __device__ __forceinline__ void operator()(const f32x4 (&acc)[2][2][4][2], const Unit& u, int wr, int wc, int fr, int fq) const {
        const int row0 = u.pm * BM + wr * 64 + fr, col0 = u.pn * 256 + wc * 32 + 8 * fq;
#pragma unroll
        for (int ai = 0; ai < 2; ++ai)
#pragma unroll
            for (int m = 0; m < 4; ++m) { bf16* rowp = O + (size_t)(row0 + ai * HALF + m * 16) * D + col0;
#pragma unroll
                for (int bj = 0; bj < 2; ++bj) { const f32x4 v0 = acc[ai][bj][m][0], v1 = acc[ai][bj][m][1];
                    u32x4 w; w.x = cvt_pk_bf16(v0[0], v0[1]); w.y = cvt_pk_bf16(v0[2], v0[3]); w.z = cvt_pk_bf16(v1[0], v1[1]); w.w = cvt_pk_bf16(v1[2], v1[3]);
                    *(u32x4*)(rowp + bj * HALF) = w; } }
    }
};

struct EpiLora {
    static constexpr bool PERM = true;
    bf16* LW; size_t ostride; const float* w0; const float* a0;
    __device__ __forceinline__ void operator()(const f32x4 (&acc)[2][2][4][2], const Unit& u, int wr, int wc, int fr, int fq) const {
        const int row0 = u.pm * BM + wr * 64 + fr, col0 = u.pn * BM + wc * 32 + 8 * fq;
        const int kind = u.pn >> 1;
        bf16* O = LW + (size_t)kind * ostride;
#pragma unroll
        for (int bj = 0; bj < 2; ++bj) { const int col = (col0 + bj * HALF) & 511;
            f32x4 b0 = (f32x4){0.f, 0.f, 0.f, 0.f}, b1 = b0;
            if (kind == 0) { b0 = *(const f32x4*)(w0 + col); b1 = *(const f32x4*)(w0 + col + 4); }
            else if (kind == 1) { b0 = *(const f32x4*)(a0 + col); b1 = *(const f32x4*)(a0 + col + 4); }
#pragma unroll
            for (int ai = 0; ai < 2; ++ai)
#pragma unroll
                for (int m = 0; m < 4; ++m) { const size_t row = (size_t)(row0 + ai * HALF + m * 16);
                    const f32x4 v0 = acc[ai][bj][m][0] + b0, v1 = acc[ai][bj][m][1] + b1; float o[8];
#pragma unroll
                    for (int e = 0; e < 8; ++e) { float x = (e < 4) ? v0[e & 3] : v1[e & 3];
                        if (kind == 0) x = -0.6065306597126334f * sigmoidf_(x);
                        else if (kind == 1) x = sigmoidf_(x);
                        o[e] = x; }
                    u32x4 w; w.x = cvt_pk_bf16(o[0], o[1]); w.y = cvt_pk_bf16(o[2], o[3]); w.z = cvt_pk_bf16(o[4], o[5]); w.w = cvt_pk_bf16(o[6], o[7]);
                    *(u32x4*)(O + row * 512 + col) = w; } }
    }
};

struct TileOrder {
    static constexpr bool GATHER = false; __device__ __forceinline__ int grow(const Unit&, int) const { return 0; }
    const bf16* A; const bf16* Bt; int lda, ldb, K, nN, pm;
    __device__ void init(const bf16* A_, int lda_, const bf16* Bt_, int ldb_, int K_, int nN_, int pm_) { A = A_; Bt = Bt_; lda = lda_; ldb = ldb_; K = K_; nN = nN_; pm = pm_; }
    __device__ bool next(int i, Unit& u) const { if (i >= nN) return false; int pm_ = pm; asm volatile("" : "+s"(pm_)); u.pm = pm_; u.pn = i; return true; }
    __device__ __forceinline__ const char* aptr(const Unit& u) const { return (const char*)(A + (size_t)u.pm * BM * lda); }
    __device__ __forceinline__ const char* bptr(const Unit& u) const { return (const char*)(Bt + (size_t)u.pn * BM * ldb); }
};
struct AttnTileOrder {
    static constexpr bool GATHER = false; __device__ __forceinline__ int grow(const Unit&, int) const { return 0; }
    const bf16* A; const bf16* Bt; int lda, ldb, K, pm, mode;
    __device__ void init(const bf16* A_, const bf16* Bt_, int ldb_, int mode_, int pm_) { A = A_; Bt = Bt_; lda = D; ldb = ldb_; K = 256; mode = mode_; pm = pm_; }
    __device__ bool next(int i, Unit& u) const { if (i >= 4) return false; int pm_ = pm; asm volatile("" : "+s"(pm_)); u.pm = pm_; u.pn = i; return true; }
    __device__ __forceinline__ const char* aptr(const Unit& u) const { return (const char*)(A + (size_t)u.pm * BM * D + u.pn * 256); }
    __device__ __forceinline__ const char* bptr(const Unit& u) const { const int b = u.pm >> 5;
        return (const char*)(mode == 0 ? Bt + (size_t)b * 256 * ldb + u.pn * 256 : Bt + (size_t)u.pn * 256 * ldb + b * 256); }
};
}

#define LAS __attribute__((address_space(3)))
__device__ __forceinline__ void transpose_item(const float* __restrict__ W, int K, int N, bf16* __restrict__ WT, int ldt, int row_off, int col_off, float* scr, int item, int lane, const float* __restrict__ kscale, int ldw = 0) {
    if (ldw == 0) ldw = N;
    const int nblk = N / 32, kb = item / nblk, nb = item % nblk, k0 = 64 * kb, n0 = 32 * nb;
#pragma unroll 8
    for (int i = 0; i < 32; ++i) { const int kk = 2 * i + (lane >> 5); float v = W[(size_t)(k0 + kk) * ldw + n0 + (lane & 31)]; if (kscale) v *= kscale[k0 + kk]; scr[kk * 33 + (lane & 31)] = v; }
    __builtin_amdgcn_s_waitcnt(0xc07f); asm volatile("" ::: "memory");
    const int c = lane & 7;
#pragma unroll
    for (int j = 0; j < 4; ++j) { const int n = (lane >> 3) + 8 * j; const float* s = scr + (8 * c) * 33 + n;
        uint4 o; o.x = pk2(s[0 * 33], s[1 * 33]); o.y = pk2(s[2 * 33], s[3 * 33]); o.z = pk2(s[4 * 33], s[5 * 33]); o.w = pk2(s[6 * 33], s[7 * 33]);
        *(uint4*)(WT + (size_t)(row_off + n0 + n) * ldt + col_off + k0 + 8 * c) = o; }
    __builtin_amdgcn_s_waitcnt(0xc07f); asm volatile("" ::: "memory");
}
__device__ __forceinline__ void transpose_ph(const int WID_, const float* W, int K, int N, bf16* WT, int ldt, int row_off, int col_off, char* lds, const float* kscale = nullptr) {
    const int lane = (WID_ * 64 + lane_id()) & 63, wv = (WID_ * 64 + lane_id()) >> 6;
    float* scr = (float*)(lds + wv * 16384);
    const int nitems = (K / 64) * (N / 32);
    for (int it = GB * 8 + wv; it < nitems; it += GN * 8) transpose_item(W, K, N, WT, ldt, row_off, col_off, scr, it, lane, kscale);
}

template <typename TO>
__device__ __forceinline__ void rmsnorm_ph(const int WID_, const float* __restrict__ x, const float* __restrict__ w, TO* __restrict__ out, int rows, int row_lo = 0, int vb = GB, int nvb = GN) {
    const int lane = lane_id(), wv = WID_;
    float4 g[4];
#pragma unroll
    for (int j = 0; j < 4; ++j) g[j] = *(const float4*)(w + (lane + 64 * j) * 4);
    for (int row = row_lo + (vb * 8 + wv) * 2; row < rows; row += nvb * 16) {
        const float4* xr = (const float4*)(x + (size_t)row * D);
        float4 v[2][4]; float s[2] = {0.f, 0.f};
#pragma unroll
        for (int r = 0; r < 2; ++r)
#pragma unroll
            for (int j = 0; j < 4; ++j) v[r][j] = xr[r * (D / 4) + lane + 64 * j];
#pragma unroll
        for (int r = 0; r < 2; ++r) {
#pragma unroll
            for (int j = 0; j < 4; ++j) s[r] += v[r][j].x * v[r][j].x + v[r][j].y * v[r][j].y + v[r][j].z * v[r][j].z + v[r][j].w * v[r][j].w;
            s[r] = wave_sum(s[r]);
            const float rs = rsqrtf(s[r] * (1.f / D) + 1e-6f);
#pragma unroll
            for (int j = 0; j < 4; ++j) {
                uint2 o; o.x = pk2(v[r][j].x * rs * g[j].x, v[r][j].y * rs * g[j].y); o.y = pk2(v[r][j].z * rs * g[j].z, v[r][j].w * rs * g[j].w);
                *(uint2*)(out + (size_t)(row + r) * D + (lane + 64 * j) * 4) = o;
            }
        }
    }
}

__device__ __forceinline__ void rwkv_lin_ph(const int WID_, const bf16* __restrict__ proj, const float* __restrict__ mu, bf16* __restrict__ lin) {
    const int lane = lane_id(), wv = WID_;
    const float4 m4 = *(const float4*)(mu + 1536 + 4 * lane);
    const float mm[4] = {m4.x, m4.y, m4.z, m4.w};
    for (int m0 = (GB * 8 + wv) * 4; m0 < M; m0 += GN * 32) {
        uint2 z[4], zp[4];
#pragma unroll
        for (int i = 0; i < 4; ++i) { const int m = m0 + i; z[i] = *(const uint2*)(proj + (size_t)m * DSHIFT + 1536 + 4 * lane);
            zp[i] = make_uint2(0, 0); if ((m & (S - 1)) != 0) zp[i] = *(const uint2*)(proj + (size_t)(m - 1) * DSHIFT + 1536 + 4 * lane); }
#pragma unroll
        for (int i = 0; i < 4; ++i) {
            float c[4] = {__builtin_bit_cast(float, z[i].x << 16), __builtin_bit_cast(float, z[i].x & 0xffff0000u), __builtin_bit_cast(float, z[i].y << 16), __builtin_bit_cast(float, z[i].y & 0xffff0000u)};
            const float q[4] = {__builtin_bit_cast(float, zp[i].x << 16), __builtin_bit_cast(float, zp[i].x & 0xffff0000u), __builtin_bit_cast(float, zp[i].y << 16), __builtin_bit_cast(float, zp[i].y & 0xffff0000u)};
#pragma unroll
            for (int e = 0; e < 4; ++e) { float t = c[e] + (q[e] - c[e]) * mm[e];
                if (lane < 16) t = 1.f - 2.f / (1.f + __expf(2.f * t));
                else if (lane >= 32) t = sigmoidf_(t);
                c[e] = t; }
            uint2 o; o.x = pk2(c[0], c[1]); o.y = pk2(c[2], c[3]);
            *(uint2*)(lin + (size_t)(m0 + i) * 256 + 4 * lane) = o;
        }
    }
}
__device__ __forceinline__ void rwkv_wl_ph(const int WID_, const float* __restrict__ wdec, const float* __restrict__ wiclr, const float* __restrict__ wgate, bf16* __restrict__ wl) {
    for (int i = GB * NT + (WID_ * 64 + lane_id()); i < 1536 * 256; i += GN * NT) {
        const int k = i & 255, n = i >> 8; float v = 0.f;
        if (n < 512) { if (k < 64) v = wdec[k * 512 + n]; }
        else if (n < 1024) { if (k >= 64 && k < 128) v = wiclr[(k - 64) * 512 + (n - 512)]; }
        else { if (k >= 128) v = wgate[(k - 128) * 512 + (n - 1024)]; }
        wl[i] = f2bf(v);
    }
}
template <int CTRL> __device__ __forceinline__ float dpp16(float x) { return __builtin_bit_cast(float, __builtin_amdgcn_update_dpp(0, __builtin_bit_cast(int, x), CTRL, 0xf, 0xf, true)); }
constexpr int RW_ITEMS = NB * 8;

namespace ck {
#define CK_BAR() do { asm volatile("s_waitcnt lgkmcnt(0)" ::: "memory"); __builtin_amdgcn_s_barrier(); asm volatile("" ::: "memory"); } while (0)
typedef float f32x2_t __attribute__((ext_vector_type(2)));
typedef __bf16 bf16x2_t __attribute__((ext_vector_type(2)));
__device__ __forceinline__ unsigned cvtpk(float lo, float hi) { const f32x2_t v = {lo, hi}; const bf16x2_t b = __builtin_convertvector(v, bf16x2_t); return __builtin_bit_cast(unsigned, b); }
typedef short bf16x8 __attribute__((ext_vector_type(8)));
typedef float f32x16 __attribute__((ext_vector_type(16)));
constexpr int LD = 72;
constexpr int MB = 64 * LD * 2;
constexpr int O_AB = 0, O_RB = MB, O_BB = 2 * MB, O_KB = 3 * MB, O_AT = 4 * MB, O_W1T = 5 * MB, O_BT = 6 * MB, O_KT = 7 * MB, O_VT = 8 * MB,
              O_NM = 9 * MB, O_AAK = 10 * MB, O_ARB = 11 * MB, O_ARK = 12 * MB, O_G = 13 * MB, O_TOT = O_G + 16384;
constexpr int O_TM = O_AB, O_X1T = O_BB, O_NMF = O_G, O_TT = O_G + 8192, O_ZT = O_TT + 5120;
constexpr int ITEM_BYTES = 32768;
template <int K, typename PA, typename PB>
__device__ __forceinline__ f32x16 mm_tile(f32x16 acc, PA A, int lda, PB B, int ldb, int lane) {
    const int r = lane & 31, h = lane >> 5;
    bf16x8 a[K / 16], b[K / 16];
#pragma unroll
    for (int q = 0; q < K / 16; ++q) { a[q] = *(const bf16x8*)(A + r * lda + 16 * q + 8 * h); b[q] = *(const bf16x8*)(B + r * ldb + 16 * q + 8 * h); }
#pragma unroll
    for (int q = 0; q < K / 16; ++q) acc = __builtin_amdgcn_mfma_f32_32x32x16_bf16(a[q], b[q], acc, 0, 0, 0);
    return acc;
}
__device__ __forceinline__ int crow(int reg, int h) { return (reg & 3) + 8 * (reg >> 2) + 4 * h; }
__device__ __forceinline__ void store_tr(const f32x16& acc, bf16* Ct, int ldct, int lane) {
    const int c = lane & 31, h = lane >> 5;
#pragma unroll
    for (int g = 0; g < 4; ++g) { uint2 w; w.x = cvtpk(acc[4 * g], acc[4 * g + 1]); w.y = cvtpk(acc[4 * g + 2], acc[4 * g + 3]); *(uint2*)(Ct + c * ldct + 8 * g + 4 * h) = w; }
}
__device__ __forceinline__ void store_rm(const f32x16& acc, bf16* C, int ldc, int lane) {
    const int c = lane & 31, h = lane >> 5;
#pragma unroll
    for (int rg = 0; rg < 16; ++rg) C[crow(rg, h) * ldc + c] = f2bf(acc[rg]);
}
__device__ __forceinline__ f32x16 zero16() { return (f32x16){0.f, 0.f, 0.f, 0.f, 0.f, 0.f, 0.f, 0.f, 0.f, 0.f, 0.f, 0.f, 0.f, 0.f, 0.f, 0.f}; }
__device__ __forceinline__ void store_frag16(const f32x16& acc, bf16* base, int t0, int t1, int lane) {
    const int cc = lane & 31, hh = lane >> 5, col = 32 * t1 + cc;
#pragma unroll
    for (int g = 0; g < 4; ++g) { const int row = 32 * t0 + 8 * g + 4 * hh;
        uint2 w; w.x = cvtpk(acc[4 * g], acc[4 * g + 1]); w.y = cvtpk(acc[4 * g + 2], acc[4 * g + 3]);
        *(uint2*)(base + (((row >> 4) * 4 + (col >> 4)) * 64 + (col & 15) + 16 * ((row & 15) >> 2)) * 4) = w; }
}
struct In { const bf16* proj; const bf16* LW; const bf16* AA; const float* mu; const float* k_k; const float* k_a; const float* r_k; float* RK; char* items; };

__device__ __forceinline__ void phase1(const int WID_, const In& I, char* lds) {
    const int wv = WID_;
#define MAT(off) ((bf16*)(lds + (off)))
    float* G = (float*)(lds + O_G); float* TOT = (float*)(lds + O_TOT); float* NMF = (float*)(lds + O_NMF);
    uint4 nx_r, nx_k, nx_v, nx_qr, nx_qk, nx_qv, nx_a, nx_l;
    { const int lane0 = lane_id(), tid0 = wv * 64 + lane0; const int item = GB;
      if (item < NB * 8 * (S / 64)) { const int c = item & 127, h = (item >> 7) & 7, b = item >> 10, s = tid0 >> 3, cg = tid0 & 7, ch0 = h * 64 + cg * 8, t = c * 64 + s; const size_t m = (size_t)b * S + t;
        const bf16* z = I.proj + m * DSHIFT + ch0;
        nx_r = *(const uint4*)(z); nx_k = *(const uint4*)(z + 512); nx_v = *(const uint4*)(z + 1024);
        nx_qr = make_uint4(0, 0, 0, 0); nx_qk = nx_qr; nx_qv = nx_qr;
        if (t > 0) { nx_qr = *(const uint4*)(z - DSHIFT); nx_qk = *(const uint4*)(z + 512 - DSHIFT); nx_qv = *(const uint4*)(z + 1024 - DSHIFT); }
        nx_a = *(const uint4*)(I.AA + m * 512 + ch0); nx_l = *(const uint4*)(I.LW + m * 512 + ch0); } }
    for (int item = GB; item < NB * 8 * (S / 64); item += GN) {
        const int lane = lane_id(), tid = wv * 64 + lane;
        const int c = item & 127, h = (item >> 7) & 7, b = item >> 10;
        char* out = I.items + (size_t)item * ITEM_BYTES;
        const int s = tid >> 3, cg = tid & 7, ch0 = h * 64 + cg * 8, t = c * 64 + s; const size_t m = (size_t)b * S + t;
        float r_[8], kp_[8], v_[8], kk_[8], b_[8];
        {
            const uint4 gr = nx_r, gk = nx_k, gv = nx_v, qr = nx_qr, qk = nx_qk, qv = nx_qv, ga = nx_a, gl = nx_l;
            const float4 c_mr0 = *(const float4*)(I.mu + ch0), c_mr1 = *(const float4*)(I.mu + ch0 + 4), c_mk0 = *(const float4*)(I.mu + 512 + ch0), c_mk1 = *(const float4*)(I.mu + 512 + ch0 + 4);
            const float4 c_mv0 = *(const float4*)(I.mu + 1024 + ch0), c_mv1 = *(const float4*)(I.mu + 1024 + ch0 + 4), c_kk0 = *(const float4*)(I.k_k + ch0), c_kk1 = *(const float4*)(I.k_k + ch0 + 4);
            const float4 c_ka0 = *(const float4*)(I.k_a + ch0), c_ka1 = *(const float4*)(I.k_a + ch0 + 4), c_rk0 = *(const float4*)(I.r_k + ch0), c_rk1 = *(const float4*)(I.r_k + ch0 + 4);
            const float mur[8] = {c_mr0.x, c_mr0.y, c_mr0.z, c_mr0.w, c_mr1.x, c_mr1.y, c_mr1.z, c_mr1.w}, muk[8] = {c_mk0.x, c_mk0.y, c_mk0.z, c_mk0.w, c_mk1.x, c_mk1.y, c_mk1.z, c_mk1.w};
            const float muv[8] = {c_mv0.x, c_mv0.y, c_mv0.z, c_mv0.w, c_mv1.x, c_mv1.y, c_mv1.z, c_mv1.w}, ckk[8] = {c_kk0.x, c_kk0.y, c_kk0.z, c_kk0.w, c_kk1.x, c_kk1.y, c_kk1.z, c_kk1.w};
            const float cka[8] = {c_ka0.x, c_ka0.y, c_ka0.z, c_ka0.w, c_ka1.x, c_ka1.y, c_ka1.z, c_ka1.w}, crk[8] = {c_rk0.x, c_rk0.y, c_rk0.z, c_rk0.w, c_rk1.x, c_rk1.y, c_rk1.z, c_rk1.w};
            const unsigned wr[4] = {gr.x, gr.y, gr.z, gr.w}, wk[4] = {gk.x, gk.y, gk.z, gk.w}, wv4[4] = {gv.x, gv.y, gv.z, gv.w};
            const unsigned pr[4] = {qr.x, qr.y, qr.z, qr.w}, pk[4] = {qk.x, qk.y, qk.z, qk.w}, pv[4] = {qv.x, qv.y, qv.z, qv.w};
            const unsigned wa[4] = {ga.x, ga.y, ga.z, ga.w}, wl[4] = {gl.x, gl.y, gl.z, gl.w};
            float ss = 0.f, rk = 0.f, a_[8];
#pragma unroll
            for (int e = 0; e < 8; ++e) { const int w_ = e >> 1; const bool hi = e & 1;
                auto ex = [&](unsigned u) { return hi ? __builtin_bit_cast(float, u & 0xffff0000u) : __builtin_bit_cast(float, u << 16); };
                float x = ex(wr[w_]); r_[e] = x + (ex(pr[w_]) - x) * mur[e];
                x = ex(wk[w_]); const float k = x + (ex(pk[w_]) - x) * muk[e];
                x = ex(wv4[w_]); v_[e] = x + (ex(pv[w_]) - x) * muv[e];
                a_[e] = ex(wa[w_]); kk_[e] = k * ckk[e]; ss += kk_[e] * kk_[e];
                kp_[e] = k * (1.f + (a_[e] - 1.f) * cka[e]); rk += r_[e] * kp_[e] * crk[e];
                G[s * 64 + cg * 8 + e] = ex(wl[w_]); }
            ss += dpp16<0xB1>(ss); ss += dpp16<0x4E>(ss); ss += dpp16<0x141>(ss);
            const float inv = 1.f / fmaxf(sqrtf(ss), 1e-12f);
#pragma unroll
            for (int e = 0; e < 8; ++e) { kk_[e] *= inv; b_[e] = kk_[e] * a_[e]; }
            rk += dpp16<0xB1>(rk); rk += dpp16<0x4E>(rk); rk += dpp16<0x141>(rk);
            if (cg == 0) I.RK[m * 8 + h] = rk;
        }
        CK_BAR();
        { const int ch = tid & 63, part = tid >> 6; float run = 0.f;
#pragma unroll
          for (int i = 0; i < 8; ++i) { run += G[(8 * part + i) * 64 + ch]; G[(8 * part + i) * 64 + ch] = run; }
          TOT[part * 64 + ch] = run; }
        CK_BAR();
        { const int ch = tid & 63, part = tid >> 6; float off = 0.f;
          for (int p = 0; p < part; ++p) off += TOT[p * 64 + ch];
#pragma unroll
          for (int i = 0; i < 8; ++i) G[(8 * part + i) * 64 + ch] += off; }
        CK_BAR();
        float glast[8];
        {
            unsigned pab[4], prb[4], pbb[4], pkb[4];
            float ab[8], rb[8], bb[8], kb[8], bt[8], kt[8];
            const float4 g0_ = *(const float4*)(G + s * 64 + cg * 8), g1_ = *(const float4*)(G + s * 64 + cg * 8 + 4);
            const int sm = (s > 0) ? s - 1 : 0; const float msk = (s > 0) ? 1.f : 0.f;
            const float4 m0_ = *(const float4*)(G + sm * 64 + cg * 8), m1_ = *(const float4*)(G + sm * 64 + cg * 8 + 4);
            const float4 l0_ = *(const float4*)(G + 63 * 64 + cg * 8), l1_ = *(const float4*)(G + 63 * 64 + cg * 8 + 4);
            const float gv_[8] = {g0_.x, g0_.y, g0_.z, g0_.w, g1_.x, g1_.y, g1_.z, g1_.w}, mv_[8] = {m0_.x, m0_.y, m0_.z, m0_.w, m1_.x, m1_.y, m1_.z, m1_.w}, lv_[8] = {l0_.x, l0_.y, l0_.z, l0_.w, l1_.x, l1_.y, l1_.z, l1_.w};
#pragma unroll
            for (int e = 0; e < 8; ++e) { const float g = gv_[e], gm1 = mv_[e] * msk, gL = lv_[e];
                glast[e] = gL;
                const float eg = __expf(g), eng = __expf(-g), egm = __expf(gm1), egl = __expf(gL - g);
                ab[e] = -kk_[e] * egm; rb[e] = r_[e] * eg; bb[e] = b_[e] * eng; kb[e] = kp_[e] * eng; bt[e] = b_[e] * egl; kt[e] = kp_[e] * egl; }
#pragma unroll
            for (int q = 0; q < 4; ++q) { pab[q] = pk2(ab[2 * q], ab[2 * q + 1]); prb[q] = pk2(rb[2 * q], rb[2 * q + 1]); pbb[q] = pk2(bb[2 * q], bb[2 * q + 1]); pkb[q] = pk2(kb[2 * q], kb[2 * q + 1]); }
            *(uint4*)(MAT(O_AB) + s * LD + cg * 8) = make_uint4(pab[0], pab[1], pab[2], pab[3]);
            *(uint4*)(MAT(O_RB) + s * LD + cg * 8) = make_uint4(prb[0], prb[1], prb[2], prb[3]);
            *(uint4*)(MAT(O_BB) + s * LD + cg * 8) = make_uint4(pbb[0], pbb[1], pbb[2], pbb[3]);
            *(uint4*)(MAT(O_KB) + s * LD + cg * 8) = make_uint4(pkb[0], pkb[1], pkb[2], pkb[3]);
#pragma unroll
            for (int e = 0; e < 8; ++e) { const int k = cg * 8 + e;
                MAT(O_AT)[k * LD + s] = f2bf(ab[e]); MAT(O_BT)[k * LD + s] = f2bf(bt[e]); MAT(O_KT)[k * LD + s] = f2bf(kt[e]); MAT(O_VT)[k * LD + s] = f2bf(v_[e]); }
        }
        CK_BAR();
        { const int itn = item + GN;
          if (itn < NB * 8 * (S / 64)) { const int c2 = itn & 127, h2 = (itn >> 7) & 7, b2 = itn >> 10, ch2 = h2 * 64 + cg * 8, t2 = c2 * 64 + s; const size_t m2 = (size_t)b2 * S + t2;
            const bf16* z = I.proj + m2 * DSHIFT + ch2;
            nx_r = *(const uint4*)(z); nx_k = *(const uint4*)(z + 512); nx_v = *(const uint4*)(z + 1024);
            nx_qr = make_uint4(0, 0, 0, 0); nx_qk = nx_qr; nx_qv = nx_qr;
            if (t2 > 0) { nx_qr = *(const uint4*)(z - DSHIFT); nx_qk = *(const uint4*)(z + 512 - DSHIFT); nx_qv = *(const uint4*)(z + 1024 - DSHIFT); }
            nx_a = *(const uint4*)(I.AA + m2 * 512 + ch2); nx_l = *(const uint4*)(I.LW + m2 * 512 + ch2); } }
        if (s == 63) {
#pragma unroll
            for (int e = 0; e < 8; ++e) TOT[cg * 8 + e] = __expf(glast[e]);
        }
        {
            const int mat = tid >> 7, row = (tid >> 2) & 31, chunk = tid & 3;
            *(uint4*)(MAT(O_NM + mat * MB) + row * LD + 32 + chunk * 8) = make_uint4(0, 0, 0, 0);
        }
        for (int task = wv; task < 12; task += 8) {
            const int mat = task / 3, tt = task % 3, st = (tt == 0) ? 0 : 1, jt = (tt == 2) ? 1 : 0;
            const bf16* Asrc = MAT((mat & 1) ? O_KB : O_BB) + 32 * jt * LD;
            const bf16* Bsrc = MAT((mat >> 1) ? O_RB : O_AB) + 32 * st * LD;
            f32x16 acc = mm_tile<64>(zero16(), Asrc, LD, Bsrc, LD, lane);
            const int cs = 32 * st + (lane & 31), hh = lane >> 5; const bool incl = (mat >> 1) != 0;
#pragma unroll
            for (int rg = 0; rg < 16; ++rg) { const int j = 32 * jt + crow(rg, hh); const bool keep = incl ? (j <= cs) : (j < cs); if (!keep) acc[rg] = 0.f; }
            store_tr(acc, MAT(O_NM + mat * MB) + 32 * st * LD + 32 * jt, LD, lane);
            if (mat == 0 && st == jt) {
                float* d = NMF + st * 1024 + (lane & 31) * 32;
#pragma unroll
                for (int g = 0; g < 4; ++g) *(float4*)(d + 8 * g + 4 * hh) = make_float4(acc[4 * g], acc[4 * g + 1], acc[4 * g + 2], acc[4 * g + 3]);
            }
        }
        CK_BAR();
        if (wv == 0) {
            const int d = lane >> 4, cc = lane & 15;
            const float* nb = NMF + (d >> 1) * 1024 + (16 * (d & 1)) * 32 + 16 * (d & 1);
            float T[16];
#pragma unroll
            for (int i = 0; i < 16; ++i) {
                float acc = (i == cc) ? 1.f : 0.f;
#pragma unroll
                for (int j4 = 0; j4 < i; j4 += 4) { const float4 n4 = *(const float4*)(nb + i * 32 + j4);
                    acc += n4.x * T[j4]; if (j4 + 1 < i) acc += n4.y * T[j4 + 1]; if (j4 + 2 < i) acc += n4.z * T[j4 + 2]; if (j4 + 3 < i) acc += n4.w * T[j4 + 3]; }
                T[i] = acc;
            }
            bf16* tm = MAT(O_TM) + (16 * d) * LD + 16 * d + cc;
#pragma unroll
            for (int i = 0; i < 16; ++i) tm[i * LD] = f2bf(T[i]);
            bf16* tt = MAT(O_TT) + (d >> 1) * 32 * 40 + (16 * (d & 1) + cc) * 40 + 16 * (d & 1);
            *(uint4*)(tt) = make_uint4(pk2(T[0], T[1]), pk2(T[2], T[3]), pk2(T[4], T[5]), pk2(T[6], T[7]));
            *(uint4*)(tt + 8) = make_uint4(pk2(T[8], T[9]), pk2(T[10], T[11]), pk2(T[12], T[13]), pk2(T[14], T[15]));
            { const int blk = lane >> 5, r16 = (lane >> 1) & 15, hf = lane & 1;
              *(uint4*)(MAT(O_TM) + (32 * blk + r16) * LD + 32 * blk + 16 + 8 * hf) = make_uint4(0, 0, 0, 0);
              *(uint4*)(MAT(O_TT) + blk * 32 * 40 + (16 + r16) * 40 + 8 * hf) = make_uint4(0, 0, 0, 0); }
        } else if (wv == 1) {
            const int row = lane >> 1, half = lane & 1;
            *(uint4*)(MAT(O_TM) + row * LD + 32 + half * 16) = make_uint4(0, 0, 0, 0); *(uint4*)(MAT(O_TM) + row * LD + 32 + half * 16 + 8) = make_uint4(0, 0, 0, 0);
        } else if (wv >= 4) {
            const int st = (wv - 4) >> 1, vt = (wv - 4) & 1;
            f32x16 acc = mm_tile<64>(zero16(), MAT(O_AAK) + 32 * st * LD, LD, MAT(O_VT) + 32 * vt * LD, LD, lane);
            store_tr(acc, MAT(O_W1T) + 32 * vt * LD + 32 * st, LD, lane);
        }
        CK_BAR();
        if (wv < 2) {
            typedef float f32x4v __attribute__((ext_vector_type(4)));
            const int blk = wv, fr = lane & 15, fq = lane >> 4;
            const bf16x8 zf = (bf16x8){0, 0, 0, 0, 0, 0, 0, 0};
            bf16x8 a = zf, bq = zf;
            if (fq < 2) { a = *(const bf16x8*)(MAT(O_NM) + (32 * blk + 16 + fr) * LD + 32 * blk + 8 * fq); bq = *(const bf16x8*)(MAT(O_TT) + blk * 32 * 40 + fr * 40 + 8 * fq); }
            f32x4v z = __builtin_amdgcn_mfma_f32_16x16x32_bf16(a, bq, (f32x4v){0.f, 0.f, 0.f, 0.f}, 0, 0, 0);
            bf16* zt = MAT(O_ZT) + blk * 16 * 24;
            { uint2 w; w.x = cvtpk(z[0], z[1]); w.y = cvtpk(z[2], z[3]); *(uint2*)(zt + fr * 24 + 4 * fq) = w; }
            asm volatile("s_waitcnt lgkmcnt(0)" ::: "memory");
            a = zf; bq = zf;
            if (fq < 2) { a = *(const bf16x8*)(MAT(O_TM) + (32 * blk + 16 + fr) * LD + 32 * blk + 16 + 8 * fq); bq = *(const bf16x8*)(zt + fr * 24 + 8 * fq); }
            const f32x4v t21 = __builtin_amdgcn_mfma_f32_16x16x32_bf16(a, bq, (f32x4v){0.f, 0.f, 0.f, 0.f}, 0, 0, 0);
#pragma unroll
            for (int rg = 0; rg < 4; ++rg) MAT(O_TM)[(32 * blk + 16 + 4 * fq + rg) * LD + 32 * blk + fr] = f2bf(t21[rg]);
            { uint2 w; w.x = cvtpk(t21[0], t21[1]); w.y = cvtpk(t21[2], t21[3]); *(uint2*)(MAT(O_TT) + blk * 32 * 40 + fr * 40 + 16 + 4 * fq) = w; }
        }
        CK_BAR();
        if (wv == 0) { f32x16 acc = mm_tile<32>(zero16(), MAT(O_NM) + 32 * LD, LD, MAT(O_TT), 40, lane); store_tr(acc, MAT(O_ZT), 40, lane); }
        CK_BAR();
        if (wv == 0) { f32x16 acc = mm_tile<32>(zero16(), MAT(O_TM) + 32 * LD + 32, LD, MAT(O_ZT), 40, lane); store_rm(acc, MAT(O_TM) + 32 * LD, LD, lane); }
        CK_BAR();
        { const int st = wv >> 2, ct = wv & 3;
          f32x16 acc = mm_tile<64>(zero16(), MAT(O_TM) + 32 * st * LD, LD, MAT(O_AT) + 32 * ct * LD, LD, lane);
          CK_BAR();
          store_tr(acc, MAT(O_X1T) + 32 * ct * LD + 32 * st, LD, lane); }
        CK_BAR();
        for (int u = wv; u < 16; u += 8) {
            const int kind = u >> 2, t0 = (u >> 1) & 1, t1 = u & 1, hh = lane >> 5, cc = lane & 31;
            if (kind == 0) {
                f32x16 acc = mm_tile<64>(zero16(), MAT(O_BT) + 32 * t0 * LD, LD, MAT(O_X1T) + (64 + 32 * t1) * LD, LD, lane);
                acc = mm_tile<64>(acc, MAT(O_KT) + 32 * t0 * LD, LD, MAT(O_VT) + 32 * t1 * LD, LD, lane);
                store_frag16(acc, (bf16*)(out + 16384), t0, t1, lane);
            } else if (kind == 1) {
                f32x16 acc = mm_tile<64>(zero16(), MAT(O_ARB) + 32 * t0 * LD, LD, MAT(O_X1T) + (64 + 32 * t1) * LD, LD, lane);
                acc = mm_tile<64>(acc, MAT(O_ARK) + 32 * t0 * LD, LD, MAT(O_VT) + 32 * t1 * LD, LD, lane);
                store_frag16(acc, (bf16*)(out + 24576), t0, t1, lane);
            } else if (kind == 2) {
                f32x16 acc = mm_tile<64>(zero16(), MAT(O_X1T) + 32 * t0 * LD, LD, MAT(O_BT) + 32 * t1 * LD, LD, lane);
                const int k = 32 * t1 + cc; const float gl = TOT[k];
                bf16* d = (bf16*)out + k * 64 + 32 * t0;
#pragma unroll
                for (int g = 0; g < 4; ++g) { float x[4];
#pragma unroll
                    for (int e = 0; e < 4; ++e) { const int kp = 32 * t0 + 8 * g + 4 * hh + e; x[e] = acc[4 * g + e] + ((kp == k) ? gl : 0.f); }
                    uint2 w; w.x = cvtpk(x[0], x[1]); w.y = cvtpk(x[2], x[3]); *(uint2*)(d + 8 * g + 4 * hh) = w; }
            } else {
                f32x16 acc = mm_tile<64>(zero16(), MAT(O_X1T) + 32 * t0 * LD, LD, MAT(O_ARB) + 32 * t1 * LD, LD, lane);
                const int sq = 32 * t1 + cc;
                bf16* d = (bf16*)(out + 8192) + sq * 64 + 32 * t0;
                const bf16* rb = MAT(O_RB) + sq * LD + 32 * t0;
#pragma unroll
                for (int g = 0; g < 4; ++g) { const uint2 rr = *(const uint2*)(rb + 8 * g + 4 * hh);
                    const float x0 = acc[4 * g] + __builtin_bit_cast(float, rr.x << 16), x1 = acc[4 * g + 1] + __builtin_bit_cast(float, rr.x & 0xffff0000u);
                    const float x2 = acc[4 * g + 2] + __builtin_bit_cast(float, rr.y << 16), x3 = acc[4 * g + 3] + __builtin_bit_cast(float, rr.y & 0xffff0000u);
                    uint2 w; w.x = cvtpk(x0, x1); w.y = cvtpk(x2, x3); *(uint2*)(d + 8 * g + 4 * hh) = w; }
            }
        }
        CK_BAR();
    }
#undef MAT
}
typedef float f32x4w __attribute__((ext_vector_type(4)));
constexpr int P2_SLOT = 2 * 64 * LD * 2 + 4096;
__device__ __forceinline__ void phase2(const int WID_, const char* items, float* Y, char* lds) {
    const int wv = WID_;
    bf16* HT0 = (bf16*)lds; bf16* HT1 = HT0 + 16 * LD;
    char* SL = lds + 8192;
    for (int item = GB; item < NB * 8 * 4; item += GN) {
        const int lane = lane_id(), tid = wv * 64 + lane, fr = lane & 15, fq = lane >> 4;
        const int vq = (item >> 3) & 3, head = (item & 7) + 8 * (item >> 5), b = head >> 3, h = head & 7;
        for (int i = tid; i < 2 * 16 * LD / 8; i += NT) ((uint4*)lds)[i] = make_uint4(0, 0, 0, 0);
        const bool upd = wv < 4; const int rb = wv & 3;
        const char* rec0 = items + (size_t)(head * 128) * ITEM_BYTES;
        const size_t g_pq = (size_t)tid * 16;
        const int l_pq = (tid >> 3) * (LD * 2) + (tid & 7) * 16;
        const int piece = (tid >> 5) & 7;
        const size_t g_f = 16384 + (size_t)(piece >> 2) * 8192 + (((piece & 3) * 4 + vq) * 64) * 8 + (tid & 31) * 16;
        const int l_f = 2 * 64 * LD * 2 + piece * 512 + (tid & 31) * 16;
        float* yo = Y + ((size_t)b * S + 16 * rb + 4 * fq) * 512 + h * 64 + 16 * vq + fr;
        const int a_lds = (upd ? 0 : 64 * LD * 2) + (16 * rb + fr) * (LD * 2) + 16 * fq;
        const int c_lds = 2 * 64 * LD * 2 + ((upd ? 0 : 4) + rb) * 512 + lane * 8;
        uint4 rp0, rp1, rp2, rp3, rp4, rp5, rp6, rp7, rq0, rq1, rq2, rq3, rq4, rq5, rq6, rq7, rf0, rf1, rf2, rf3, rf4, rf5, rf6, rf7;
#define P2_LD(n, i) do { const char* rc_ = rec0 + (size_t)(i) * ITEM_BYTES; rp##n = *(const uint4*)(rc_ + g_pq); rq##n = *(const uint4*)(rc_ + 8192 + g_pq); rf##n = *(const uint4*)(rc_ + g_f); } while (0)
#define P2_ST(n, slot) do { char* s_ = SL + (slot) * P2_SLOT; *(uint4*)(s_ + l_pq) = rp##n; *(uint4*)(s_ + 64 * LD * 2 + l_pq) = rq##n; *(uint4*)(s_ + l_f) = rf##n; } while (0)
        P2_LD(0, 0); P2_LD(1, 1); P2_LD(2, 2); P2_LD(3, 3); P2_LD(4, 4); P2_LD(5, 5); P2_LD(6, 6); P2_LD(7, 7);
        P2_ST(0, 0); P2_LD(0, 8);
        CK_BAR();
#define P2_STEP(RN, cstep) do { const int c_ = (cstep); \
            const bf16* Hc = (c_ & 1) ? HT1 : HT0; bf16* Hn = (c_ & 1) ? HT0 : HT1; const char* sl_ = SL + (c_ & 1) * P2_SLOT; \
            const uint2 cv = *(const uint2*)(sl_ + c_lds); \
            f32x4w acc = (f32x4w){__builtin_bit_cast(float, cv.x << 16), __builtin_bit_cast(float, cv.x & 0xffff0000u), __builtin_bit_cast(float, cv.y << 16), __builtin_bit_cast(float, cv.y & 0xffff0000u)}; \
            const bf16x8 a0 = *(const bf16x8*)(sl_ + a_lds), a1 = *(const bf16x8*)(sl_ + a_lds + 64); \
            const bf16x8 b0 = *(const bf16x8*)(Hc + fr * LD + 8 * fq), b1 = *(const bf16x8*)(Hc + fr * LD + 32 + 8 * fq); \
            if (c_ + 1 < S / 64) P2_ST(RN, (c_ + 1) & 1); \
            if (c_ + 9 < S / 64) P2_LD(RN, c_ + 9); \
            acc = __builtin_amdgcn_mfma_f32_16x16x32_bf16(a0, b0, acc, 0, 0, 0); acc = __builtin_amdgcn_mfma_f32_16x16x32_bf16(a1, b1, acc, 0, 0, 0); \
            if (upd) { uint2 w; w.x = cvtpk(acc[0], acc[1]); w.y = cvtpk(acc[2], acc[3]); *(uint2*)(Hn + fr * LD + 16 * rb + 4 * fq) = w; } \
            else { float* y_ = yo + (size_t)c_ * 64 * 512; y_[0] = acc[0]; y_[512] = acc[1]; y_[1024] = acc[2]; y_[1536] = acc[3]; } \
            CK_BAR(); } while (0)
        for (int c = 0; c < S / 64; c += 8) {
            P2_STEP(1, c); P2_STEP(2, c + 1); P2_STEP(3, c + 2); P2_STEP(4, c + 3); P2_STEP(5, c + 4); P2_STEP(6, c + 5); P2_STEP(7, c + 6); P2_STEP(0, c + 7);
        }
#undef P2_STEP
#undef P2_LD
#undef P2_ST
    }
}
}

__device__ __forceinline__ void rwkv_post_ph(const int WID_, const float* __restrict__ Y, const float* __restrict__ RK, const bf16* __restrict__ proj, const float* __restrict__ mu, const bf16* __restrict__ G,
                             const float* __restrict__ lnw, const float* __restrict__ lnb, bf16* __restrict__ ymix) {
    const int lane = lane_id(), tk = WID_, grp = lane, ch0 = grp * 8, head = grp >> 3;
    const float4 mv0 = *(const float4*)(mu + 1024 + ch0), mv1 = *(const float4*)(mu + 1024 + ch0 + 4), lw0 = *(const float4*)(lnw + ch0), lw1 = *(const float4*)(lnw + ch0 + 4), lb0 = *(const float4*)(lnb + ch0), lb1 = *(const float4*)(lnb + ch0 + 4);
    const float muv[8] = {mv0.x, mv0.y, mv0.z, mv0.w, mv1.x, mv1.y, mv1.z, mv1.w}, lw_[8] = {lw0.x, lw0.y, lw0.z, lw0.w, lw1.x, lw1.y, lw1.z, lw1.w}, lb_[8] = {lb0.x, lb0.y, lb0.z, lb0.w, lb1.x, lb1.y, lb1.z, lb1.w};
    for (int m0 = GB * 16 + tk; m0 < M; m0 += GN * 16) {
        float4 ya[2], yb[2]; uint4 vv[2], pv[2], gg[2]; float rk[2];
#pragma unroll
        for (int u = 0; u < 2; ++u) { const int m = m0 + 8 * u;
            ya[u] = *(const float4*)(Y + (size_t)m * 512 + ch0); yb[u] = *(const float4*)(Y + (size_t)m * 512 + ch0 + 4);
            vv[u] = *(const uint4*)(proj + (size_t)m * DSHIFT + 1024 + ch0);
            pv[u] = (m & (S - 1)) ? *(const uint4*)(proj + (size_t)(m - 1) * DSHIFT + 1024 + ch0) : make_uint4(0, 0, 0, 0);
            gg[u] = *(const uint4*)(G + (size_t)m * 512 + ch0); rk[u] = RK[(size_t)m * 8 + head]; }
#pragma unroll
        for (int u = 0; u < 2; ++u) {
            const float y[8] = {ya[u].x, ya[u].y, ya[u].z, ya[u].w, yb[u].x, yb[u].y, yb[u].z, yb[u].w};
            float s = 0.f;
#pragma unroll
            for (int e = 0; e < 8; ++e) s += y[e];
            s += dpp16<0xB1>(s); s += dpp16<0x4E>(s); s += dpp16<0x141>(s);
            const float mean = s * (1.f / 64.f); float q = 0.f;
#pragma unroll
            for (int e = 0; e < 8; ++e) { const float d = y[e] - mean; q += d * d; }
            q += dpp16<0xB1>(q); q += dpp16<0x4E>(q); q += dpp16<0x141>(q);
            const float rstd = rsqrtf(q * (1.f / 64.f) + 64e-5f);
            const unsigned wv_[4] = {vv[u].x, vv[u].y, vv[u].z, vv[u].w}, wp_[4] = {pv[u].x, pv[u].y, pv[u].z, pv[u].w}, wg_[4] = {gg[u].x, gg[u].y, gg[u].z, gg[u].w};
            float o[8];
#pragma unroll
            for (int e = 0; e < 8; ++e) { const int w_ = e >> 1; const bool hi = e & 1;
                auto ex = [&](unsigned x) { return hi ? __builtin_bit_cast(float, x & 0xffff0000u) : __builtin_bit_cast(float, x << 16); };
                float v = ex(wv_[w_]); v += (ex(wp_[w_]) - v) * muv[e];
                o[e] = ((y[e] - mean) * rstd * lw_[e] + lb_[e] + rk[u] * v) * ex(wg_[w_]); }
            *(uint4*)(ymix + (size_t)(m0 + 8 * u) * D + ch0) = make_uint4(pk2(o[0], o[1]), pk2(o[2], o[3]), pk2(o[4], o[5]), pk2(o[6], o[7]));
        }
    }
}

constexpr int PSLOTS = NASSIGN + NEXP * 256;
constexpr int MAXTILES = PSLOTS / 256;
struct MoeBufs { int* tok_e; float* tok_g; int* tok_slot; int* slot_tok; float* slot_gate; int* bcnt; int* bbase; int* offs; int* tiles; int* ntiles; };
__device__ __forceinline__ void moe_zero_ph(const int WID_, const MoeBufs& mb) {
    for (int i = GB * NT + (WID_ * 64 + lane_id()); i < PSLOTS; i += GN * NT) { mb.slot_tok[i] = 0; mb.slot_gate[i] = 0.f; }
}
__device__ __forceinline__ void router_ph(const int WID_, const float* __restrict__ x3, const float* __restrict__ nw, bf16* __restrict__ h3, const float* __restrict__ wrg, const float* __restrict__ brg,
                          const float* __restrict__ wre, const float* __restrict__ bre, const MoeBufs& mb, char* lds, int tile) {
    const int lane = lane_id(), wv = WID_;
    int* lcnt = (int*)lds;
    _Float16* wg16 = (_Float16*)(lds + 256);
    _Float16* we16 = (_Float16*)(lds + 256 + 8192);
    if (wv == 0 && lane < 32) lcnt[lane] = 0;
    for (int i = wv * 64 + lane; i < 1024; i += NT) { const float4 w = *(const float4*)(wrg + i * 4);
        typedef _Float16 h4 __attribute__((ext_vector_type(4))); *(h4*)(wg16 + i * 4) = (h4){(_Float16)w.x, (_Float16)w.y, (_Float16)w.z, (_Float16)w.w}; }
    for (int i = wv * 64 + lane; i < 4 * 1024 * 2; i += NT) { const float4 w = *(const float4*)(wre + i * 4);
        typedef _Float16 h4 __attribute__((ext_vector_type(4))); *(h4*)(we16 + i * 4) = (h4){(_Float16)w.x, (_Float16)w.y, (_Float16)w.z, (_Float16)w.w}; }
    __syncthreads();
    typedef _Float16 h4 __attribute__((ext_vector_type(4)));
    typedef _Float16 h8 __attribute__((ext_vector_type(8)));
    for (int m = tile * 256 + wv; m < tile * 256 + 256; m += 8) {
        const float4* xr = (const float4*)(x3 + (size_t)m * D);
        float h[16]; float s = 0.f;
#pragma unroll
        for (int j = 0; j < 4; ++j) { const float4 v = xr[lane + 64 * j]; h[4 * j] = v.x; h[4 * j + 1] = v.y; h[4 * j + 2] = v.z; h[4 * j + 3] = v.w; s += v.x * v.x + v.y * v.y + v.z * v.z + v.w * v.w; }
        s = wave_sum(s);
        const float rs = rsqrtf(s * (1.f / D) + 1e-6f);
        float l1[4] = {0.f, 0.f, 0.f, 0.f};
#pragma unroll
        for (int j = 0; j < 4; ++j) {
            const int k0 = (lane + 64 * j) * 4;
            const float4 g = *(const float4*)(nw + k0);
            h[4 * j] *= rs * g.x; h[4 * j + 1] *= rs * g.y; h[4 * j + 2] *= rs * g.z; h[4 * j + 3] *= rs * g.w;
            uint2 o; o.x = pk2(h[4 * j], h[4 * j + 1]); o.y = pk2(h[4 * j + 2], h[4 * j + 3]);
            *(uint2*)(h3 + (size_t)m * D + k0) = o;
#pragma unroll
            for (int e = 0; e < 4; ++e) { const h4 w = *(const h4*)(wg16 + (k0 + e) * 4); const float x = h[4 * j + e];
                l1[0] += x * (float)w[0]; l1[1] += x * (float)w[1]; l1[2] += x * (float)w[2]; l1[3] += x * (float)w[3]; }
        }
#pragma unroll
        for (int i = 0; i < 4; ++i) l1[i] = wave_sum(l1[i]) + brg[i];
        int grp = 0; float best = l1[0];
#pragma unroll
        for (int i = 1; i < 4; ++i) if (l1[i] > best) { best = l1[i]; grp = i; }
        float se = 0.f;
#pragma unroll
        for (int i = 0; i < 4; ++i) se += __expf(l1[i] - best);
        const float g1 = 1.f / se;
        float l2[8] = {};
        const _Float16* we = we16 + (size_t)grp * D * 8;
#pragma unroll
        for (int j = 0; j < 4; ++j) {
            const int k0 = (lane + 64 * j) * 4;
#pragma unroll
            for (int e = 0; e < 4; ++e) { const float x = h[4 * j + e]; const h8 w = *(const h8*)(we + (k0 + e) * 8);
#pragma unroll
                for (int q = 0; q < 8; ++q) l2[q] += x * (float)w[q]; }
        }
#pragma unroll
        for (int i = 0; i < 8; ++i) l2[i] = wave_sum(l2[i]) + bre[grp * 8 + i];
        int i0 = 0; float v0 = l2[0];
#pragma unroll
        for (int i = 1; i < 8; ++i) if (l2[i] > v0) { v0 = l2[i]; i0 = i; }
        int i1 = -1; float v1 = -3.0e38f;
#pragma unroll
        for (int i = 0; i < 8; ++i) if (i != i0 && l2[i] > v1) { v1 = l2[i]; i1 = i; }
        const float e1 = __expf(v1 - v0), inv = 1.f / (1.f + e1);
        if (lane == 0) {
            const int ea = grp * 8 + i0, eb = grp * 8 + i1;
            mb.tok_e[2 * m] = ea; mb.tok_e[2 * m + 1] = eb;
            mb.tok_g[2 * m] = g1 * inv; mb.tok_g[2 * m + 1] = g1 * e1 * inv;
            atomicAdd(&lcnt[ea], 1); atomicAdd(&lcnt[eb], 1);
        }
    }
    __syncthreads();
    if (wv == 0 && lane < 32) mb.bcnt[tile * 32 + lane] = lcnt[lane];
    __syncthreads();
}
__device__ __forceinline__ void moe_plan_ph(const int WID_, const MoeBufs& mb, char* lds) {
    if (GB != 0) return;
    int* tot = (int*)lds; int* off = tot + 32;
    const int t = WID_ * 64 + lane_id();
    if (t < 32) { int run = 0; for (int b = 0; b < M / 256; ++b) { const int c = __hip_atomic_load(mb.bcnt + b * 32 + t, __ATOMIC_RELAXED, __HIP_MEMORY_SCOPE_AGENT); mb.bbase[b * 32 + t] = run; run += c; } tot[t] = run; }
    __syncthreads();
    if (t == 0) { int o = 0, nt = 0;
        for (int e = 0; e < NEXP; ++e) { off[e] = o; mb.offs[e] = o; const int c = tot[e]; for (int r0 = 0; r0 < c; r0 += 256) { mb.tiles[nt] = e; ++nt; } o += ((c + 255) / 256) * 256; }
        *mb.ntiles = nt; }
    __syncthreads();
}
__device__ __forceinline__ void moe_scatter_ph(const int WID_, const MoeBufs& mb, char* lds) {
    const int lane = lane_id(), wv = WID_;
    int* cur = (int*)lds;
    for (int tile = GB; tile < M / 256; tile += GN) {
        __syncthreads();
        if (wv == 0 && lane < 32) cur[lane] = __hip_atomic_load(mb.offs + lane, __ATOMIC_RELAXED, __HIP_MEMORY_SCOPE_AGENT) + __hip_atomic_load(mb.bbase + tile * 32 + lane, __ATOMIC_RELAXED, __HIP_MEMORY_SCOPE_AGENT);
        __syncthreads();
        const int a = tile * 512 + wv * 64 + lane; const int e = mb.tok_e[a];
        const int pos = atomicAdd(&cur[e], 1);
        mb.slot_tok[pos] = a >> 1; mb.slot_gate[pos] = mb.tok_g[a]; mb.tok_slot[a] = pos;
    }
    __syncthreads();
}
__device__ __forceinline__ void moe_weights_ph(const int WID_, const float* __restrict__ wg, const float* __restrict__ wu, const float* __restrict__ wd, bf16* __restrict__ wgu_t, bf16* __restrict__ wd_t, char* lds, int vb, int nvb) {
    const int lane = (WID_ * 64 + lane_id()) & 63, wv = (WID_ * 64 + lane_id()) >> 6;
    float* scr = (float*)(lds + wv * 16384);
    constexpr int I_GU = 16 * 16;
    constexpr int I_D = 8 * 32;
    constexpr int NIT = NEXP * (2 * I_GU + I_D);
    for (int it = vb * 8 + wv; it < NIT; it += nvb * 8) {
        const int e = it / (2 * I_GU + I_D); int r = it % (2 * I_GU + I_D);
        if (r < 2 * I_GU) {
            const int up = r / I_GU; r %= I_GU;
            const int kb = r / 16, nb = r % 16;
            const int pn = nb / 4, nsub = nb % 4;
            const float* W = (up ? wu : wg) + (size_t)e * D * DEXP + nb * 32;
            transpose_item(W + (size_t)kb * 64 * DEXP, 64, 32, wgu_t, D, e * 1024 + pn * 256 + up * 128 + nsub * 32, kb * 64, scr, 0, lane, nullptr, DEXP);
        } else {
            r -= 2 * I_GU;
            const int kb = r / 32, nb = r % 32;
            const float* W = wd + (size_t)e * DEXP * D + nb * 32;
            transpose_item(W + (size_t)kb * 64 * D, 64, 32, wd_t, DEXP, e * 1024 + nb * 32, kb * 64, scr, 0, lane, nullptr, D);
        }
    }
}
__device__ __forceinline__ void final_ph(const int WID_, float* __restrict__ out, const bf16* __restrict__ yslot, const int* __restrict__ tok_slot, const float* __restrict__ w) {
    const int lane = lane_id(), wv = WID_;
    float4 g[4];
#pragma unroll
    for (int j = 0; j < 4; ++j) g[j] = *(const float4*)(w + (lane + 64 * j) * 4);
    for (int row0 = (GB * 8 + wv) * 2; row0 < M; row0 += GN * 16) {
        float4 v[2][4]; uint2 ya[2][4], yb[2][4];
#pragma unroll
        for (int r = 0; r < 2; ++r) { const int row = row0 + r;
            const float4* xr = (const float4*)(out + (size_t)row * D);
            const uint2* pa = (const uint2*)(yslot + (size_t)tok_slot[2 * row] * D);
            const uint2* pb = (const uint2*)(yslot + (size_t)tok_slot[2 * row + 1] * D);
#pragma unroll
            for (int j = 0; j < 4; ++j) { v[r][j] = xr[lane + 64 * j]; ya[r][j] = pa[lane + 64 * j]; yb[r][j] = pb[lane + 64 * j]; } }
#pragma unroll
        for (int r = 0; r < 2; ++r) { float s = 0.f;
#pragma unroll
            for (int j = 0; j < 4; ++j) { const uint2 a = ya[r][j], b = yb[r][j];
                v[r][j].x += __builtin_bit_cast(float, a.x << 16) + __builtin_bit_cast(float, b.x << 16);
                v[r][j].y += __builtin_bit_cast(float, a.x & 0xffff0000u) + __builtin_bit_cast(float, b.x & 0xffff0000u);
                v[r][j].z += __builtin_bit_cast(float, a.y << 16) + __builtin_bit_cast(float, b.y << 16);
                v[r][j].w += __builtin_bit_cast(float, a.y & 0xffff0000u) + __builtin_bit_cast(float, b.y & 0xffff0000u);
                s += v[r][j].x * v[r][j].x + v[r][j].y * v[r][j].y + v[r][j].z * v[r][j].z + v[r][j].w * v[r][j].w; }
            s = wave_sum(s);
            const float rs = rsqrtf(s * (1.f / D) + 1e-6f);
            float4* xo = (float4*)(out + (size_t)(row0 + r) * D);
#pragma unroll
            for (int j = 0; j < 4; ++j) xo[lane + 64 * j] = make_float4(v[r][j].x * rs * g[j].x, v[r][j].y * rs * g[j].y, v[r][j].z * rs * g[j].z, v[r][j].w * rs * g[j].w); }
    }
}

struct S5Tab { float* Kmat; bf16* BtA; bf16* BtB; };
__device__ __forceinline__ void s5_lam(const float* lam_re, const float* lam_im, const float* log_dt, int g, int n, float& a, float& w) {
    const float dt = __expf(log_dt[g]); a = lam_re[g * 64 + n] * dt; w = lam_im[g * 64 + n] * dt;
}
__device__ __forceinline__ void cexpj(float a, float w, float j, float& re, float& im) { const float e = __expf(a * j); float s, c; sincosf(w * j, &s, &c); re = e * c; im = e * s; }
__device__ __forceinline__ void s5_bbar(const float* lam_re, const float* lam_im, const float* log_dt, const float* b_re, const float* b_im, int g, int n, int h, float& br, float& bi) {
    float a, w; s5_lam(lam_re, lam_im, log_dt, g, n, a, w);
    float lbr, lbi; cexpj(a, w, 1.f, lbr, lbi);
    const float lr = lam_re[g * 64 + n], li = lam_im[g * 64 + n];
    const float nr = lbr - 1.f, ni = lbi, den = lr * lr + li * li;
    const float cr = (nr * lr + ni * li) / den, ci = (ni * lr - nr * li) / den;
    const float xr = b_re[(g * 64 + n) * 16 + h], xi = b_im[(g * 64 + n) * 16 + h];
    br = cr * xr - ci * xi; bi = cr * xi + ci * xr;
}
__device__ __forceinline__ void s5_tables0_ph(const int WID_, const float* lam_re, const float* lam_im, const float* log_dt, const float* b_re, const float* b_im, const float* c_re, const float* c_im, const S5Tab& T, char* lds) {
    float* PWR = (float*)lds; float* PWI = PWR + 64 * 34;
    float* BBR = PWI + 64 * 34; float* BBI = BBR + 64 * 16;
    float* CCR = BBI + 64 * 16; float* CCI = CCR + 16 * 64;
    const int tid = WID_ * 64 + lane_id();
    for (int item = GB; item < 32 * 8; item += GN) {
        const int g = item & 31, part = item >> 5;
        __syncthreads();
        for (int i = tid; i < 64 * 34; i += NT) { const int n = i / 34, j = i % 34; float a, w; s5_lam(lam_re, lam_im, log_dt, g, n, a, w); float pr, pi; cexpj(a, w, (float)j, pr, pi); PWR[i] = pr; PWI[i] = pi; }
        for (int i = tid; i < 64 * 16; i += NT) { const int n = i >> 4, h = i & 15; float br, bi; s5_bbar(lam_re, lam_im, log_dt, b_re, b_im, g, n, h, br, bi); BBR[i] = br; BBI[i] = bi;
            const int hp = i >> 6, n2 = i & 63; CCR[i] = c_re[(g * 16 + hp) * 64 + n2]; CCI[i] = c_im[(g * 16 + hp) * 64 + n2]; }
        __syncthreads();
        for (int i = tid; i < 4 * 256; i += NT) { const int h = i & 15, hp = (i >> 4) & 15, j = 4 * part + (i >> 8);
            float acc = 0.f;
            for (int n = 0; n < 64; ++n) { const float pr = PWR[n * 34 + j], pi = PWI[n * 34 + j], br = BBR[n * 16 + h], bi = BBI[n * 16 + h];
                const float tr = pr * br - pi * bi, ti = pr * bi + pi * br; acc += CCR[hp * 64 + n] * tr - CCI[hp * 64 + n] * ti; }
            T.Kmat[((g * 32 + j) * 16 + hp) * 16 + h] = acc; }
        for (int i = tid; i < 32 * 512; i += NT) { const int col = i & 511, r = 32 * part + (i >> 9); float v = 0.f;
            if (r < 128) { const int n = r & 63, s = col >> 4, h = col & 15; const float pr = PWR[n * 34 + (S5L - 1 - s)], pi = PWI[n * 34 + (S5L - 1 - s)], br = BBR[n * 16 + h], bi = BBI[n * 16 + h];
                v = (r < 64) ? (pr * br - pi * bi) : (pr * bi + pi * br); }
            T.BtA[((size_t)g * 768 + 512 + r) * 512 + col] = f2bf(v); }
        for (int i = tid; i < 64 * 256; i += NT) { const int k = i & 255, row = 64 * part + (i >> 8); float v = 0.f;
            if (k < 128) { const int n = k & 63, sp = row >> 4, hp = row & 15; const float pr = PWR[n * 34 + sp + 1], pi = PWI[n * 34 + sp + 1], cr = CCR[hp * 64 + n], ci = CCI[hp * 64 + n];
                v = (k < 64) ? (cr * pr - ci * pi) : -(cr * pi + ci * pr); }
            T.BtB[((size_t)g * 512 + row) * 256 + k] = f2bf(v); }
    }
    __syncthreads();
}
__device__ __forceinline__ void s5_tables1_ph(const int WID_, const float* dsk, const S5Tab& T) {
    const int gtid = GB * NT + (WID_ * 64 + lane_id()), gsz = GN * NT;
    for (int i = gtid; i < 32 * 512 * 512; i += gsz) {
        const int col = i & 511, row = (i >> 9) & 511, g = i >> 18;
        const int sp = row >> 4, hp = row & 15, s = col >> 4, h = col & 15;
        float v = 0.f;
        if (s <= sp) v = T.Kmat[((g * 32 + (sp - s)) * 16 + hp) * 16 + h];
        if (row == col) v += dsk[g * 16 + hp];
        T.BtA[((size_t)g * 768 + row) * 512 + col] = f2bf(v);
    }
}
__device__ __forceinline__ void s5_carry_ph(const int WID_, const float* lam_re, const float* lam_im, const float* log_dt, const float* __restrict__ F, bf16* __restrict__ XST, int vb, int nvb, char* lds) {
    float* TR = (float*)lds; float* TI = TR + 16 * 32;
    for (int item = vb; item < NB * 32 * 2; item += nvb) {
        const int lane = lane_id(), tid = WID_ * 64 + lane;
        const int nh = item & 1, g = (item >> 1) & 31, b = item >> 6, seg = tid >> 5, n = nh * 32 + (tid & 31);
        float a, w; s5_lam(lam_re, lam_im, log_dt, g, n, a, w);
        float pr, pi; cexpj(a, w, (float)S5L, pr, pi);
        const size_t row0 = (size_t)g * S5R + (size_t)b * (S / S5L) + seg * 16;
        const float* f = F + row0 * 128; bf16* xo = XST + row0 * 256;
        float fr[16], fi[16];
#pragma unroll
        for (int q = 0; q < 16; ++q) { fr[q] = f[(size_t)q * 128 + n]; fi[q] = f[(size_t)q * 128 + 64 + n]; }
#pragma unroll
        for (int q = 0; q < 16; ++q) if (nh == 0) *(uint2*)(xo + (size_t)q * 256 + 128 + (tid & 31) * 4) = make_uint2(0, 0);
        float xr = 0.f, xi = 0.f;
#pragma unroll
        for (int q = 0; q < 16; ++q) { const float nr = pr * xr - pi * xi + fr[q], ni = pr * xi + pi * xr + fi[q]; xr = nr; xi = ni; fr[q] = nr; fi[q] = ni; }
        TR[seg * 32 + (tid & 31)] = xr; TI[seg * 32 + (tid & 31)] = xi;
        __syncthreads();
        float p16r, p16i; cexpj(a, w, (float)(S5L * 16), p16r, p16i);
        float cr = 0.f, ci = 0.f;
        for (int s2 = 0; s2 < seg; ++s2) { const float tr = TR[s2 * 32 + (tid & 31)], ti = TI[s2 * 32 + (tid & 31)];
            const float nr = p16r * cr - p16i * ci + tr, ni = p16r * ci + p16i * cr + ti; cr = nr; ci = ni; }
        float er = cr, ei = ci;
#pragma unroll
        for (int q = 0; q < 16; ++q) {
            const float lr_ = (q > 0) ? fr[q - 1] : 0.f, li_ = (q > 0) ? fi[q - 1] : 0.f;
            xo[(size_t)q * 256 + n] = f2bf(er + lr_); xo[(size_t)q * 256 + 64 + n] = f2bf(ei + li_);
            const float nr = pr * er - pi * ei, ni = pr * ei + pi * er; er = nr; ei = ni;
        }
        __syncthreads();
    }
}
#define XB_TMO      128
#define XB_XCNT(j)  (256  + 64 * (j))
#define XB_XSUB(j)  (1280 + 64 * (j))
#define XB_XGEN(j)  (2304 + 64 * (j))
#define XB_TOP      3328
#define XB_TOPGEN   3392
#define XCD_BAR_WORDS 3456
#define XB_SPIN_CAP (1u << 20)
__device__ __forceinline__ unsigned xb_ld(unsigned* p)              { return __hip_atomic_load(p, __ATOMIC_RELAXED, __HIP_MEMORY_SCOPE_AGENT); }
__device__ __forceinline__ unsigned xb_add(unsigned* p, unsigned v) { return __hip_atomic_fetch_add(p, v, __ATOMIC_RELAXED, __HIP_MEMORY_SCOPE_AGENT); }
__device__ __forceinline__ unsigned xb_xcc_id() { return (unsigned)__builtin_amdgcn_s_getreg((3 << 11) | 20) & 0xFu; }
#define XB_SPIN(cond, bar) do { unsigned _sp = 0; while (cond) { __builtin_amdgcn_s_sleep(1); \
    if ((++_sp & 255u) == 0u) { if (xb_ld(&(bar)[XB_TMO])) break; if (_sp > XB_SPIN_CAP) { atomicAdd(&(bar)[XB_TMO], 1u); break; } } } } while (0)
struct XcdBarrier { unsigned* bar; unsigned x; volatile __attribute__((address_space(3))) unsigned* st; };
__device__ __forceinline__ XcdBarrier xcd_barrier_post(const int WID_, unsigned* bar, volatile __attribute__((address_space(3))) unsigned* st) {
    XcdBarrier b; b.bar = bar; b.x = xb_xcc_id(); b.st = st;
    if ((WID_ * 64 + lane_id()) == 0) (void)xb_add(&bar[XB_XCNT(b.x)], 1u);
    return b;
}
__device__ __forceinline__ void xcd_barrier_complete(unsigned* bar, unsigned x, unsigned& nloc, unsigned& nx) {
    const unsigned G = gridDim.x * gridDim.y * gridDim.z;
    unsigned sum, cnt, mine, sp = 0u;
    for (;;) {
        sum = 0u; cnt = 0u; mine = 0u;
#pragma unroll
        for (unsigned j = 0; j < 16; ++j) { const unsigned c = xb_ld(&bar[XB_XCNT(j)]); sum += c; cnt += (c > 0u) ? 1u : 0u; mine = (j == x) ? c : mine; }
        if (sum == G) break;
        __builtin_amdgcn_s_sleep(1);
        if ((++sp & 255u) == 0u) { if (xb_ld(&bar[XB_TMO])) break; if (sp > XB_SPIN_CAP) { atomicAdd(&bar[XB_TMO], 1u); break; } }
    }
    nloc = mine > 0u ? mine : 1u; nx = cnt > 0u ? cnt : 1u;
}
__device__ __forceinline__ void xcd_barrier(const int WID_, const XcdBarrier& b) {
    asm volatile("s_waitcnt vmcnt(0)" ::: "memory");
    __syncthreads();
    if ((WID_ * 64 + lane_id()) == 0) {
        unsigned* bar = b.bar;
        __builtin_amdgcn_s_waitcnt(0);
        unsigned nloc = b.st[0], nx = b.st[1];
        if (nloc == 0u) { xcd_barrier_complete(bar, b.x, nloc, nx); b.st[0] = nloc; b.st[1] = nx; }
        const unsigned old = xb_add(&bar[XB_XSUB(b.x)], 1u);
        const unsigned gen = old / nloc;
        if (old + 1u == (gen + 1u) * nloc) {
            __builtin_amdgcn_fence(__ATOMIC_RELEASE, "agent");
            asm volatile("s_waitcnt vmcnt(0)" ::: "memory");
            const unsigned og = xb_add(&bar[XB_TOP], 1u);
            const unsigned tg = og / nx;
            if (og + 1u == (tg + 1u) * nx) xb_add(&bar[XB_TOPGEN], 1u);
            else XB_SPIN(xb_ld(&bar[XB_TOPGEN]) == tg, bar);
            __builtin_amdgcn_fence(__ATOMIC_ACQUIRE, "agent");
            xb_add(&bar[XB_XGEN(b.x)], 1u);
            asm volatile("s_waitcnt vmcnt(0)" ::: "memory");
        } else {
            XB_SPIN(xb_ld(&bar[XB_XGEN(b.x)]) == gen, bar);
            __builtin_amdgcn_fence(__ATOMIC_ACQUIRE, "agent");
            asm volatile("s_waitcnt vmcnt(0)" ::: "memory");
        }
    }
    __syncthreads();
}

struct Params { const float* in[41]; float* out; char* ws; };

constexpr size_t W_PROJ = 0;
constexpr size_t W_US5 = 224;
constexpr size_t W_WTS = 288;
constexpr size_t W_YI = 352;
constexpr size_t W_F = 416;
constexpr size_t W_XST = 448;
constexpr size_t W_Z = 480;
constexpr size_t W_MISC = 544;
constexpr size_t W_XN = 576;
constexpr size_t W_CTL = 558;
constexpr size_t WO_IN = 0, WO_GLU = 5 * MiB, WO_MIX = 6 * MiB, WO_Q = 8 * MiB, WO_K = 10 * MiB, WO_V = 12 * MiB, WO_O = 14 * MiB, WO_KMAT = 16 * MiB, WO_BTA = 17 * MiB, WO_BTB = 41 * MiB;

__global__ void __launch_bounds__(NT, 2) fwd_kernel(Params p) {
    extern __shared__ __attribute__((aligned(16))) char lds[];
    const int WID_ = __builtin_amdgcn_readfirstlane((int)(threadIdx.x >> 6));
    cg::grid_group grid = cg::this_grid();
    PG8_LAS unsigned char* ldsl = (PG8_LAS unsigned char*)lds;
    char* ws = p.ws; char* dout = (char*)p.out; float* out = p.out;
#define IN(i) (p.in[i])
    volatile __attribute__((address_space(3))) unsigned* bst = (volatile __attribute__((address_space(3))) unsigned*)(ldsl + LDS_BYTES - 64);
    if (WID_ == 0 && lane_id() < 2) bst[lane_id()] = 0u;
    __syncthreads();
    const XcdBarrier xbar = xcd_barrier_post(WID_, (unsigned*)(ws + W_CTL * MiB), bst);
#ifndef PROBE_PHASE
#define PROBE_PHASE -1
#endif
    int sync_id = 0; unsigned long long pr_t0 = 0, pr_t1 = 0;
    if (PROBE_PHASE == 0) pr_t0 = __builtin_amdgcn_s_memrealtime();
#define SYNC() do { xcd_barrier(WID_, xbar); ++sync_id; if (sync_id == PROBE_PHASE) pr_t0 = __builtin_amdgcn_s_memrealtime(); if (sync_id == PROBE_PHASE + 1) pr_t1 = __builtin_amdgcn_s_memrealtime(); } while (0)
    char* WT = ws + W_WTS * MiB;
    bf16* w_in_t = (bf16*)(WT + WO_IN); bf16* w_glu_t = (bf16*)(WT + WO_GLU); bf16* w_mix_t = (bf16*)(WT + WO_MIX);
    bf16* w_q_t = (bf16*)(WT + WO_Q); bf16* w_k_t = (bf16*)(WT + WO_K); bf16* w_v_t = (bf16*)(WT + WO_V); bf16* w_o_t = (bf16*)(WT + WO_O);
    S5Tab stab; stab.Kmat = (float*)(WT + WO_KMAT); stab.BtA = (bf16*)(WT + WO_BTA); stab.BtB = (bf16*)(WT + WO_BTB);
    bf16* PROJ = (bf16*)(ws + W_PROJ * MiB); bf16* US5 = (bf16*)(ws + W_US5 * MiB);
    bf16* XN = (bf16*)(ws + W_XN * MiB);
    transpose_ph(WID_, IN(3), D, DIN, w_in_t, D, 0, 0, lds);
    transpose_ph(WID_, IN(23), 512, 512, w_glu_t, 512, 0, 0, lds);
    transpose_ph(WID_, IN(25), D, D, w_mix_t, D, 0, 0, lds);
    transpose_ph(WID_, IN(28), D, D, w_q_t, D, 0, 0, lds);
    transpose_ph(WID_, IN(29), D, D, w_k_t, D, 0, 0, lds);
    transpose_ph(WID_, IN(30), D, D, w_v_t, D, 0, 0, lds);
    transpose_ph(WID_, IN(31), D, D, w_o_t, D, 0, 0, lds);
    s5_tables0_ph(WID_, IN(15), IN(16), IN(17), IN(18), IN(19), IN(20), IN(21), stab, lds);
    bf16* wl_t = (bf16*)(WT + 49 * MiB);
    rwkv_wl_ph(WID_, IN(6), IN(8), IN(9), wl_t);
    rmsnorm_ph<bf16>(WID_, IN(0), IN(2), XN, M);
    bf16* MEMN = (bf16*)(ws + (W_MISC + 10) * MiB);
    rmsnorm_ph<bf16>(WID_, IN(1), IN(27), MEMN, NB * NMEM);
    grid.sync(); ++sync_id; if (sync_id == PROBE_PHASE) pr_t0 = __builtin_amdgcn_s_memrealtime(); if (sync_id == PROBE_PHASE + 1) pr_t1 = __builtin_amdgcn_s_memrealtime();
    s5_tables1_ph(WID_, IN(22), stab);
    { pg8::PlainOrder S; S.init(XN, D, w_in_t, D, M, DIN, D); pg8::EpiProj E{PROJ, US5}; pg8::gemm_phase(WID_, ldsl, S, E); }
    SYNC();
    bf16* LIN = (bf16*)(ws + (W_MISC + 16) * MiB);
    rwkv_lin_ph(WID_, PROJ, IN(4), LIN);
    SYNC();
    bf16* YI = (bf16*)(ws + W_YI * MiB); float* F = (float*)(ws + W_F * MiB); bf16* XST = (bf16*)(ws + W_XST * MiB); bf16* Z = (bf16*)(ws + W_Z * MiB);
    bf16* LWb = (bf16*)(ws + 704 * MiB); bf16* AAb = (bf16*)(ws + 768 * MiB); bf16* Gb = (bf16*)(ws + 832 * MiB);
    float* Yr = (float*)(ws + 896 * MiB); float* RKb = (float*)(ws + W_MISC * MiB);
    { pg8::GroupOrder S; S.init(US5, 512, (size_t)S5R * 512, stab.BtA, 512, (size_t)768 * 512, 32, S5R, 768, 512); pg8::EpiS5a E{YI, F}; pg8::gemm_phase(WID_, ldsl, S, E); }
    { pg8::PlainOrder S; S.init(LIN, 256, wl_t, 256, M, 1536, 256); pg8::EpiLora E{LWb, (size_t)32 * MiB, IN(5), IN(7)}; pg8::gemm_phase(WID_, ldsl, S, E); }
    SYNC();
    { ck::In ci{PROJ, LWb, AAb, IN(4), IN(10), IN(11), IN(12), RKb, dout}; ck::phase1(WID_, ci, lds); }
    SYNC();
    bf16* WGU_t = (bf16*)(ws + 704 * MiB); bf16* WD_t = (bf16*)(ws + 768 * MiB);
    ck::phase2(WID_, dout, Yr, lds);
    __syncthreads();
    s5_carry_ph(WID_, IN(15), IN(16), IN(17), F, XST, GB, GN, lds);
    moe_weights_ph(WID_, IN(37), IN(38), IN(39), WGU_t, WD_t, lds, GB, GN);
    SYNC();
    bf16* YMIX = XN;
    bf16* KM = (bf16*)(ws + (W_MISC + 2) * MiB); bf16* VT = (bf16*)(ws + (W_MISC + 6) * MiB);
    { pg8::GroupOrder S; S.init(XST, 256, (size_t)S5R * 256, stab.BtB, 256, (size_t)512 * 256, 32, S5R, 512, 256); pg8::EpiS5b E{YI, Z}; pg8::gemm_phase(WID_, ldsl, S, E); }
    { pg8::PlainOrder S; S.init(MEMN, D, w_k_t, D, NB * NMEM, D, D); pg8::EpiBf16 E{KM, D}; pg8::gemm_phase(WID_, ldsl, S, E); }
    { pg8::PlainOrder S; S.init(w_v_t, D, MEMN, D, D, NB * NMEM, D, 32); pg8::EpiBf16 E{VT, NB * NMEM}; pg8::gemm_phase(WID_, ldsl, S, E); }
    rwkv_post_ph(WID_, Yr, RKb, PROJ, IN(4), Gb, IN(13), IN(14), YMIX);
    SYNC();
    bf16* XN2 = (bf16*)(ws + 0);
    bf16* Q = (bf16*)(ws + 128 * MiB);
    bf16* P = (bf16*)(ws + W_YI * MiB);
    bf16* O = (bf16*)(ws + 800 * MiB);
    bf16* H3 = XN;
    bf16* HID = (bf16*)(ws + 368 * MiB);
    bf16* YSLOT = (bf16*)(ws + 0);
#define MKMB(mb) MoeBufs mb; { char* mbase = p.ws + 976 * MiB; \
    mb.tok_e = (int*)(mbase); mb.tok_g = (float*)(mbase + 1 * MiB); mb.tok_slot = (int*)(mbase + 2 * MiB); mb.slot_tok = (int*)(mbase + 3 * MiB); \
    mb.slot_gate = (float*)(mbase + 4 * MiB); mb.bcnt = (int*)(mbase + 5 * MiB); mb.bbase = mb.bcnt + 16384; mb.offs = mb.bcnt + 32768; mb.ntiles = mb.offs + 64; \
    mb.tiles = (int*)(mbase + 6 * MiB); }
    { MKMB(mb); moe_zero_ph(WID_, mb); }
#define BLK_SYNC() do { asm volatile("s_waitcnt vmcnt(0)" ::: "memory"); __syncthreads(); \
        if (WID_ == 0 && lane_id() == 0) { __builtin_amdgcn_fence(__ATOMIC_ACQUIRE, "agent"); asm volatile("s_waitcnt vmcnt(0)" ::: "memory"); } __syncthreads(); } while (0)
    for (int tl = GB; tl < M / 256; tl += GN) {
        { pg8::TileOrder S; S.init(Z, 512, w_glu_t, 512, 512, 2, tl); pg8::EpiGlu E{Z, IN(24), YMIX}; pg8::gemm_phase(WID_, ldsl, S, E); }
        BLK_SYNC();
        { pg8::TileOrder S; S.init(YMIX, D, w_mix_t, D, D, 4, tl); pg8::EpiF32 E{out, D, IN(0), D}; pg8::gemm_phase(WID_, ldsl, S, E); }
        BLK_SYNC();
        rmsnorm_ph<bf16>(WID_, out, IN(26), XN2, tl * 256 + 256, tl * 256, 0, 1);
        BLK_SYNC();
        { pg8::TileOrder S; S.init(XN2, D, w_q_t, D, D, 4, tl); pg8::EpiBf16 E{Q, D}; pg8::gemm_phase(WID_, ldsl, S, E); }
        BLK_SYNC();
        { pg8::AttnTileOrder S; S.init(Q, KM, D, 0, tl); pg8::EpiSoftmax E{P, (PG8_LAS float*)(ldsl + 131072)}; pg8::gemm_phase(WID_, ldsl, S, E); }
        BLK_SYNC();
        { pg8::AttnTileOrder S; S.init(P, VT, NB * NMEM, 1, tl); pg8::EpiAttnO E{O}; pg8::gemm_phase(WID_, ldsl, S, E); }
        BLK_SYNC();
        { pg8::TileOrder S; S.init(O, D, w_o_t, D, D, 4, tl); pg8::EpiF32 E{out, D, out, D}; pg8::gemm_phase(WID_, ldsl, S, E); }
        BLK_SYNC();
        { MKMB(mb); router_ph(WID_, p.out, IN(32), (bf16*)(p.ws + W_XN * MiB), IN(33), IN(34), IN(35), IN(36), mb, lds, tl); }
    }
    SYNC();
    { MKMB(mb); moe_plan_ph(WID_, mb, lds); }
    SYNC();
    { MKMB(mb); moe_scatter_ph(WID_, mb, lds); }
    MKMB(mb);
    SYNC();
    const int ntiles = __hip_atomic_load(mb.ntiles, __ATOMIC_RELAXED, __HIP_MEMORY_SCOPE_AGENT);
    { pg8::MoeOrderT<true> S; S.init(H3, D, WGU_t, D, D, mb.tiles, ntiles, 1024, mb.slot_tok); pg8::EpiSilu E{HID}; pg8::gemm_phase(WID_, ldsl, S, E); }
    SYNC();
    { pg8::MoeOrderT<false> S; S.init(HID, DEXP, WD_t, DEXP, DEXP, mb.tiles, ntiles, 1024, nullptr); pg8::EpiGate E{YSLOT, mb.slot_gate}; pg8::gemm_phase(WID_, ldsl, S, E); }
    SYNC();
    final_ph(WID_, out, YSLOT, mb.tok_slot, IN(40));
    if (PROBE_PHASE >= 0) {
        if (pr_t1 == 0) pr_t1 = __builtin_amdgcn_s_memrealtime();
        if (GB == 0) { const unsigned long long t_end = __builtin_amdgcn_s_memrealtime(), wait = 8ull * (pr_t1 - pr_t0);
            while (__builtin_amdgcn_s_memrealtime() - t_end < wait) __builtin_amdgcn_s_sleep(8); }
    }
}
}

extern "C" void kernel_launch(void* const* d_in, const int* in_sizes, int n_in, void* d_out, int out_size, void* d_ws, size_t ws_size, hipStream_t stream) {
    (void)in_sizes; (void)out_size; (void)ws_size;
    static int grid = 0;
    if (grid == 0) {
        int dev = 0, cus = 0, per_cu = 0;
        hipGetDevice(&dev);
        hipDeviceGetAttribute(&cus, hipDeviceAttributeMultiprocessorCount, dev);
        hipFuncSetAttribute((const void*)fwd_kernel, hipFuncAttributeMaxDynamicSharedMemorySize, LDS_BYTES);
        hipOccupancyMaxActiveBlocksPerMultiprocessor(&per_cu, (const void*)fwd_kernel, NT, LDS_BYTES);
        if (per_cu < 1) { fprintf(stderr, "occupancy query says %d blocks/CU\n", per_cu); per_cu = 1; }
        grid = cus * 1;
    }
    (void)hipMemsetAsync((char*)d_ws + W_CTL * MiB, 0, 16384, stream);
    Params p{};
    for (int i = 0; i < 41 && i < n_in; ++i) p.in[i] = (const float*)d_in[i];
    p.out = (float*)d_out; p.ws = (char*)d_ws;
    void* args[] = {&p};
    hipError_t e = hipLaunchCooperativeKernel((const void*)fwd_kernel, dim3(grid), dim3(NT), args, LDS_BYTES, stream);
    if (e != hipSuccess) fprintf(stderr, "cooperative launch failed: %s (grid %d)\n", hipGetErrorString(e), grid);
}
```

```cpp
#include <hip/hip_runtime.h>
#include <hip/hip_cooperative_groups.h>
#include <stdint.h>
#include <cstdio>
namespace cg = cooperative_groups;

namespace {
constexpr int NB = 8, S = 8192, D = 1024, M = NB * S;
constexpr int DR = 512, DSHIFT = 1792, DIN = 2304, NMEM = 256;
constexpr int NEXP = 32, DEXP = 512, NASSIGN = 2 * M;
constexpr size_t MiB = 1u << 20;
constexpr int NT = 512;
constexpr int S5L = 32, S5R = M / S5L;
constexpr int LDS_BYTES = 147456;
#define GB ((int)blockIdx.x)
#define GN ((int)gridDim.x)

typedef unsigned short bf16;
typedef float f32x2h __attribute__((ext_vector_type(2)));
typedef __bf16 bf16x2h __attribute__((ext_vector_type(2)));
__device__ __forceinline__ unsigned pk2(float lo, float hi) { const f32x2h v = {lo, hi}; const bf16x2h b = __builtin_convertvector(v, bf16x2h); return __builtin_bit_cast(unsigned, b); }
__device__ __forceinline__ bf16 f2bf(float f) { return (bf16)(pk2(f, f) & 0xffffu); }
__device__ __forceinline__ int lane_id() { int l; asm volatile("v_mbcnt_lo_u32_b32 %0, -1, 0\n\tv_mbcnt_hi_u32_b32 %0, -1, %0" : "=v"(l)); return l; }
__device__ __forceinline__ float bf2f(bf16 h) { return __builtin_bit_cast(float, (unsigned)h << 16); }

template <typename T> __device__ __forceinline__ float ldf(const T* p);
template <> __device__ __forceinline__ float ldf<float>(const float* p) { return *p; }
template <> __device__ __forceinline__ float ldf<bf16>(const bf16* p) { return bf2f(*p); }
template <typename T> __device__ __forceinline__ void stf(T* p, float v);
template <> __device__ __forceinline__ void stf<float>(float* p, float v) { *p = v; }
template <> __device__ __forceinline__ void stf<bf16>(bf16* p, float v) { *p = f2bf(v); }

template <int CTRL, int ROWMASK> __device__ __forceinline__ float dppf_(float x) { return __builtin_bit_cast(float, __builtin_amdgcn_update_dpp(0, __builtin_bit_cast(int, x), CTRL, ROWMASK, 0xf, false)); }
__device__ __forceinline__ float wave_sum(float v) {
    v += dppf_<0xB1, 0xf>(v); v += dppf_<0x4E, 0xf>(v); v += dppf_<0x141, 0xf>(v); v += dppf_<0x140, 0xf>(v);
    v += dppf_<0x142, 0xa>(v);
    v += dppf_<0x143, 0xc>(v);
    return __builtin_bit_cast(float, __builtin_amdgcn_readlane(__builtin_bit_cast(int, v), 63));
}
__device__ __forceinline__ float sigmoidf_(float x) { return 1.f / (1.f + __expf(-x)); }


__device__ __forceinline__ float gelu_tanh(float x) { return x * sigmoidf_(1.5957691216057308f * (x + 0.044715f * x * x * x)); }

namespace pg8 {
#define PG8_LAS __attribute__((address_space(3)))
typedef short bf16x8 __attribute__((ext_vector_type(8)));
typedef float f32x4 __attribute__((ext_vector_type(4)));
typedef unsigned u32x4 __attribute__((ext_vector_type(4)));
constexpr int BM = 256, BK = 64, HALF = 128, HTB = HALF * BK * 2, STAGE_BYTES = 8 * HTB, NXCD = 8, WGM = 8;
__device__ __forceinline__ int lds_byte(int r, int c) { const int st = (r >> 4) * 2 + (c >> 5), rr = r & 15, cc = c & 31, ob = rr * 64 + cc * 2; return st * 1024 + (ob ^ (((ob >> 9) & 1) << 5)); }
__device__ __forceinline__ void stage_rc(int b, int& R, int& C) { const int st = b / 1024, sb = b % 1024, swz = sb ^ (((sb >> 9) & 1) << 5); R = (st >> 1) * 16 + swz / 64; C = (st & 1) * 32 + (swz % 64) / 2; }
__device__ __forceinline__ int perm32(int rho) { const int n = rho >> 4, i = rho & 15; return 8 * (i >> 2) + 4 * n + (i & 3); }
struct Unit { int pm, pn; };
struct PlainOrder {
    static constexpr bool GATHER = false; __device__ __forceinline__ int grow(const Unit&, int) const { return 0; }
    const bf16* A; const bf16* Bt; int lda, ldb, K; int nM, nN, nwg, G, c;
    __device__ void init(const bf16* A_, int lda_, const bf16* Bt_, int ldb_, int M, int N, int K_, int coff = 0) { A = A_; Bt = Bt_; lda = lda_; ldb = ldb_; K = K_; nM = M / BM; nN = N / BM; nwg = nM * nN; G = GN; c = (GB + GN - coff % GN) % GN; }
    __device__ bool next(int i, Unit& u) const {
        const long L = (long)i * G + c; if (L >= nwg) return false;
        int wgid = (int)L; { const int q = nwg / NXCD, r = nwg % NXCD, xcd = wgid % NXCD, off = wgid / NXCD; wgid = (xcd < r ? xcd * (q + 1) : r * (q + 1) + (xcd - r) * q) + off; }
        const int nig = WGM * nN, gid = wgid / nig, fm = gid * WGM, gsz = (nM - fm) < WGM ? (nM - fm) : WGM;
        u.pm = fm + ((wgid % nig) % gsz); u.pn = (wgid % nig) / gsz; return true;
    }
    __device__ __forceinline__ const char* aptr(const Unit& u) const { return (const char*)(A + (size_t)u.pm * BM * lda); }
    __device__ __forceinline__ const char* bptr(const Unit& u) const { return (const char*)(Bt + (size_t)u.pn * BM * ldb); }
};
typedef float f32x2c __attribute__((ext_vector_type(2)));
typedef __bf16 bf16x2c __attribute__((ext_vector_type(2)));
__device__ __forceinline__ unsigned cvt_pk_bf16(float lo, float hi) { const f32x2c v = {lo, hi}; const bf16x2c b = __builtin_convertvector(v, bf16x2c); return __builtin_bit_cast(unsigned, b); }

template <class Epi, class Sched>
__device__ __forceinline__ void gemm_phase(const int WID_, PG8_LAS unsigned char* lds, const Sched& S, const Epi& E) {
    const int tid = (WID_ * 64 + lane_id()), wid = __builtin_amdgcn_readfirstlane(tid >> 6), lane = tid & 63, wr = wid >> 2, wc = wid & 3, fr = lane & 15, fq = lane >> 4;
    const int K = S.K, nt = K / BK;
    unsigned voffA[2], voffB[2];
#pragma unroll
    for (int i = 0; i < 2; ++i) { int R, C; stage_rc(tid * 16 + i * 8192, R, C); const int Rb = Epi::PERM ? ((R & ~31) + perm32(R & 31)) : R;
        voffA[i] = (unsigned)(R * S.lda + C) * 2u; voffB[i] = (unsigned)(Rb * S.ldb + C) * 2u; }
    constexpr bool GA = Sched::GATHER;
    int gR[2], gC[2];
#pragma unroll
    for (int i = 0; i < 2; ++i) stage_rc(tid * 16 + i * 8192, gR[i], gC[i]);
    unsigned vgc[2][2] = {{0u, 0u}, {0u, 0u}}, vgn[2][2] = {{0u, 0u}, {0u, 0u}};
#define PG8_GOFF(dst, u) do { if constexpr (GA) { _Pragma("unroll") for (int h_ = 0; h_ < 2; ++h_) _Pragma("unroll") for (int i_ = 0; i_ < 2; ++i_) \
        dst[h_][i_] = (unsigned)(S.grow(u, h_ * HALF + gR[i_]) * S.lda + gC[i_]) * 2u; } } while (0)
    const size_t kstep = (size_t)(BK * 2);
    const size_t hstepA = GA ? 0 : (size_t)HALF * S.lda * 2, hstepB = (size_t)HALF * S.ldb * 2;
    const unsigned ldsw = (unsigned)wid * 1024u;
    const int aoff = lds_byte(wr * 64 + fr, fq * 8), boff = lds_byte(wc * 32 + fr, fq * 8);
#define PG8_SA(b, h) (((b) * 2 + (h)) * HTB)
#define PG8_SB(b, h) ((4 + (b) * 2 + (h)) * HTB)
#define PG8_STAGE(bufoff, gbase, voff) do { _Pragma("unroll") for (int _i = 0; _i < 2; ++_i) \
        __builtin_amdgcn_global_load_lds((const unsigned*)((const char*)(gbase) + (voff)[_i]), (PG8_LAS unsigned*)(lds + (bufoff) + ldsw + _i * 8192), 16, 0, 0); } while (0)
#define PG8_STAGE_A(bufoff, gbase, h, nx) do { _Pragma("unroll") for (int _i = 0; _i < 2; ++_i) { \
        const unsigned vo_ = GA ? ((nx) ? vgn[h][_i] : vgc[h][_i]) : voffA[_i]; \
        __builtin_amdgcn_global_load_lds((const unsigned*)((const char*)(gbase) + vo_), (PG8_LAS unsigned*)(lds + (bufoff) + ldsw + _i * 8192), 16, 0, 0); } } while (0)
#define PG8_LDA(dst, b, h) do { _Pragma("unroll") for (int m = 0; m < 4; ++m) _Pragma("unroll") for (int k = 0; k < 2; ++k) dst[m][k] = *(const PG8_LAS bf16x8*)(lds + PG8_SA(b, h) + aoff + m * 2048 + k * 1024); } while (0)
#define PG8_LDB(dst, b, h) do { _Pragma("unroll") for (int n = 0; n < 2; ++n) _Pragma("unroll") for (int k = 0; k < 2; ++k) dst[n][k] = *(const PG8_LAS bf16x8*)(lds + PG8_SB(b, h) + boff + n * 2048 + k * 1024); } while (0)
#define PG8_MMA(ai, bj, At, Bt) do { __builtin_amdgcn_s_setprio(1); _Pragma("unroll") for (int m = 0; m < 4; ++m) _Pragma("unroll") for (int n = 0; n < 2; ++n) _Pragma("unroll") for (int k = 0; k < 2; ++k) \
        acc[ai][bj][m][n] = __builtin_amdgcn_mfma_f32_16x16x32_bf16(Bt[n][k], At[m][k], acc[ai][bj][m][n], 0, 0, 0); __builtin_amdgcn_s_setprio(0); } while (0)
#define PG8_WAIT_V(n) asm volatile("s_waitcnt vmcnt(" #n ")" ::: "memory")
#define PG8_WAIT_L(n) asm volatile("s_waitcnt lgkmcnt(" #n ")" ::: "memory")
#define PG8_BAR __builtin_amdgcn_s_barrier()
#define PG8_SCHED __builtin_amdgcn_sched_barrier(0)
    Unit cur, nxt; int ui = 0;
    if (!S.next(0, cur)) return;
    f32x4 acc[2][2][4][2];
#pragma unroll
    for (int a = 0; a < 2; ++a)
#pragma unroll
        for (int b = 0; b < 2; ++b)
#pragma unroll
            for (int m = 0; m < 4; ++m)
#pragma unroll
                for (int n = 0; n < 2; ++n) acc[a][b][m][n] = (f32x4){0.f, 0.f, 0.f, 0.f};
    bf16x8 At[4][2], B0[2][2], B1[2][2];
    const char* cA = S.aptr(cur); const char* cB = S.bptr(cur);
    PG8_STAGE(PG8_SB(0, 0), cB, voffB); PG8_STAGE(PG8_SB(0, 1), cB + hstepB, voffB); PG8_GOFF(vgc, cur); PG8_STAGE_A(PG8_SA(0, 0), cA, 0, false); PG8_STAGE_A(PG8_SA(0, 1), cA + hstepA, 1, false);
    if (wr == 1) PG8_BAR;
    PG8_WAIT_V(2); PG8_BAR;
    PG8_STAGE(PG8_SB(1, 0), cB + kstep, voffB); PG8_STAGE_A(PG8_SA(1, 0), cA + kstep, 0, false); PG8_STAGE(PG8_SB(1, 1), cB + hstepB + kstep, voffB);
    PG8_WAIT_V(6); PG8_BAR;
    for (;;) {
        const bool has_next = S.next(ui + 1, nxt);
        const char* nA = has_next ? S.aptr(nxt) : cA; const char* nB = has_next ? S.bptr(nxt) : cB;
        if (has_next) PG8_GOFF(vgn, nxt); else { if constexpr (GA) { _Pragma("unroll") for (int h_ = 0; h_ < 2; ++h_) _Pragma("unroll") for (int i_ = 0; i_ < 2; ++i_) vgn[h_][i_] = vgc[h_][i_]; } }
        for (int t = 0; t < nt; t += 2) {
            const bool last = (t == nt - 2);
            const char* a1 = cA + (size_t)(t + 1) * kstep;
            const char* a2 = last ? nA : cA + (size_t)(t + 2) * kstep; const char* b2 = last ? nB : cB + (size_t)(t + 2) * kstep;
            const char* a3 = a2 + kstep; const char* b3 = b2 + kstep;
            PG8_LDB(B0, 0, 0); PG8_LDB(B1, 0, 1); PG8_SCHED; PG8_LDA(At, 0, 0); PG8_STAGE_A(PG8_SA(1, 1), a1 + hstepA, 1, false);
            PG8_WAIT_V(8); PG8_WAIT_L(0); PG8_BAR; PG8_MMA(0, 0, At, B0); PG8_MMA(0, 1, At, B1); PG8_BAR; PG8_SCHED;
            PG8_LDA(At, 0, 1); PG8_STAGE(PG8_SB(0, 0), b2, voffB); PG8_STAGE(PG8_SB(0, 1), b2 + hstepB, voffB); PG8_STAGE_A(PG8_SA(0, 0), a2, 0, last);
            PG8_WAIT_V(8); PG8_WAIT_L(0); PG8_BAR; PG8_MMA(1, 0, At, B0); PG8_MMA(1, 1, At, B1); PG8_BAR; PG8_SCHED;
            PG8_LDB(B0, 1, 0); PG8_LDB(B1, 1, 1); PG8_SCHED; PG8_LDA(At, 1, 0); PG8_STAGE_A(PG8_SA(0, 1), a2 + hstepA, 1, last);
            PG8_WAIT_V(8); PG8_WAIT_L(0); PG8_BAR; PG8_MMA(0, 0, At, B0); PG8_MMA(0, 1, At, B1); PG8_BAR; PG8_SCHED;
            PG8_LDA(At, 1, 1); PG8_STAGE(PG8_SB(1, 0), b3, voffB); PG8_STAGE(PG8_SB(1, 1), b3 + hstepB, voffB); PG8_STAGE_A(PG8_SA(1, 0), a3, 0, last);
            PG8_WAIT_V(8); PG8_WAIT_L(0); PG8_BAR; PG8_MMA(1, 0, At, B0); PG8_MMA(1, 1, At, B1); PG8_BAR; PG8_SCHED;
        }
        if (wr == 0) PG8_BAR;
        E(acc, cur, wr, wc, fr, fq);
        if (!has_next) break;
#pragma unroll
        for (int a = 0; a < 2; ++a)
#pragma unroll
            for (int b = 0; b < 2; ++b)
#pragma unroll
                for (int m = 0; m < 4; ++m)
#pragma unroll
                    for (int n = 0; n < 2; ++n) acc[a][b][m][n] = (f32x4){0.f, 0.f, 0.f, 0.f};
        cur = nxt; cA = nA; cB = nB; ++ui;
        if constexpr (GA) { _Pragma("unroll") for (int h_ = 0; h_ < 2; ++h_) _Pragma("unroll") for (int i_ = 0; i_ < 2; ++i_) vgc[h_][i_] = vgn[h_][i_]; }
        if (wr == 1) PG8_BAR;
    }
    PG8_WAIT_V(0);
    PG8_BAR;
#undef PG8_SA
#undef PG8_SB
#undef PG8_STAGE
#undef PG8_STAGE_A
#undef PG8_GOFF
#undef PG8_LDA
#undef PG8_LDB
#undef PG8_MMA
#undef PG8_WAIT_V
#undef PG8_WAIT_L
#undef PG8_BAR
#undef PG8_SCHED
}

struct EpiF32 {
    static constexpr bool PERM = false;
    float* C; int ldc; const float* R; int ldr;
    __device__ __forceinline__ void operator()(const f32x4 (&acc)[2][2][4][2], const Unit& u, int wr, int wc, int fr, int fq) const {
        const int row0 = u.pm * BM + wr * 64 + fr, col0 = u.pn * BM + wc * 32 + 4 * fq;
#pragma unroll
        for (int ai = 0; ai < 2; ++ai)
#pragma unroll
            for (int m = 0; m < 4; ++m) { const size_t row = (size_t)(row0 + ai * HALF + m * 16);
#pragma unroll
                for (int bj = 0; bj < 2; ++bj)
#pragma unroll
                    for (int n = 0; n < 2; ++n) { const int col = col0 + bj * HALF + 16 * n; f32x4 v = acc[ai][bj][m][n];
                        if (R) v = v + *(const f32x4*)(R + row * ldr + col);
                        *(f32x4*)(C + row * ldc + col) = v; } }
    }
};
struct EpiBf16 {
    static constexpr bool PERM = true;
    bf16* O; int ldc;
    __device__ __forceinline__ void operator()(const f32x4 (&acc)[2][2][4][2], const Unit& u, int wr, int wc, int fr, int fq) const {
        const int row0 = u.pm * BM + wr * 64 + fr, col0 = u.pn * BM + wc * 32 + 8 * fq;
#pragma unroll
        for (int ai = 0; ai < 2; ++ai)
#pragma unroll
            for (int m = 0; m < 4; ++m) { bf16* rowp = O + (size_t)(row0 + ai * HALF + m * 16) * ldc + col0;
#pragma unroll
                for (int bj = 0; bj < 2; ++bj) { const f32x4 v0 = acc[ai][bj][m][0], v1 = acc[ai][bj][m][1];
                    u32x4 w; w.x = cvt_pk_bf16(v0[0], v0[1]); w.y = cvt_pk_bf16(v0[2], v0[3]); w.z = cvt_pk_bf16(v1[0], v1[1]); w.w = cvt_pk_bf16(v1[2], v1[3]);
                    *(u32x4*)(rowp + bj * HALF) = w; } }
    }
};
struct EpiGlu {
    static constexpr bool PERM = true;
    const bf16* Z; const float* bias; bf16* YM;
    __device__ __forceinline__ void operator()(const f32x4 (&acc)[2][2][4][2], const Unit& u, int wr, int wc, int fr, int fq) const {
        const int row0 = u.pm * BM + wr * 64 + fr, col0 = u.pn * BM + wc * 32 + 8 * fq;
#pragma unroll
        for (int ai = 0; ai < 2; ++ai)
#pragma unroll
            for (int m = 0; m < 4; ++m) { const size_t row = (size_t)(row0 + ai * HALF + m * 16);
#pragma unroll
                for (int bj = 0; bj < 2; ++bj) { const int col = col0 + bj * HALF;
                    const u32x4 zz = *(const u32x4*)(Z + row * 512 + col);
                    const f32x4 b0 = *(const f32x4*)(bias + col), b1 = *(const f32x4*)(bias + col + 4);
                    const f32x4 v0 = acc[ai][bj][m][0] + b0, v1 = acc[ai][bj][m][1] + b1;
                    float o[8]; const unsigned zw[4] = {zz.x, zz.y, zz.z, zz.w};
#pragma unroll
                    for (int q = 0; q < 4; ++q) { const float zl = __builtin_bit_cast(float, zw[q] << 16), zh = __builtin_bit_cast(float, zw[q] & 0xffff0000u);
                        const float al = (q < 2) ? v0[2 * q] : v1[2 * q - 4], ah = (q < 2) ? v0[2 * q + 1] : v1[2 * q - 3];
                        o[2 * q] = zl * sigmoidf_(al); o[2 * q + 1] = zh * sigmoidf_(ah); }
                    u32x4 w; w.x = cvt_pk_bf16(o[0], o[1]); w.y = cvt_pk_bf16(o[2], o[3]); w.z = cvt_pk_bf16(o[4], o[5]); w.w = cvt_pk_bf16(o[6], o[7]);
                    *(u32x4*)(YM + row * D + 512 + col) = w; } }
    }
};

template <bool GATHER_>
struct MoeOrderT {
    static constexpr bool GATHER = GATHER_;
    const bf16* A; const bf16* Bt; int lda, ldb, K; const int* tiles; const int* rows; int nunits, G, c; size_t bexp;
    __device__ void init(const bf16* A_, int lda_, const bf16* Bt_, int ldb_, int K_, const int* tiles_, int ntiles, size_t bexp_, const int* rows_) { A = A_; Bt = Bt_; lda = lda_; ldb = ldb_; K = K_; tiles = tiles_; rows = rows_; nunits = ntiles * 4; G = GN; c = GB; bexp = bexp_; }
    __device__ bool next(int i, Unit& u) const { const int L = i * G + c; if (L >= nunits) return false; u.pm = L >> 2; u.pn = L & 3; return true; }
    __device__ __forceinline__ const char* aptr(const Unit& u) const { return GATHER ? (const char*)A : (const char*)(A + (size_t)u.pm * BM * lda); }
    __device__ __forceinline__ int grow(const Unit& u, int r) const { return rows[u.pm * BM + r]; }
    __device__ __forceinline__ const char* bptr(const Unit& u) const { const int e = __hip_atomic_load(tiles + u.pm, __ATOMIC_RELAXED, __HIP_MEMORY_SCOPE_AGENT); return (const char*)(Bt + ((size_t)e * bexp + (size_t)u.pn * BM) * ldb); }
};
struct EpiSilu {
    static constexpr bool PERM = true;
    bf16* HID;
    __device__ __forceinline__ void operator()(const f32x4 (&acc)[2][2][4][2], const Unit& u, int wr, int wc, int fr, int fq) const {
        const int row0 = u.pm * BM + wr * 64 + fr, col0 = u.pn * HALF + wc * 32 + 8 * fq;
#pragma unroll
        for (int ai = 0; ai < 2; ++ai)
#pragma unroll
            for (int m = 0; m < 4; ++m) { const size_t row = (size_t)(row0 + ai * HALF + m * 16);
                float o[8];
#pragma unroll
                for (int n = 0; n < 2; ++n)
#pragma unroll
                    for (int q = 0; q < 4; ++q) { const float g = acc[ai][0][m][n][q], up = acc[ai][1][m][n][q]; o[4 * n + q] = g * sigmoidf_(g) * up; }
                u32x4 w; w.x = cvt_pk_bf16(o[0], o[1]); w.y = cvt_pk_bf16(o[2], o[3]); w.z = cvt_pk_bf16(o[4], o[5]); w.w = cvt_pk_bf16(o[6], o[7]);
                *(u32x4*)(HID + row * DEXP + col0) = w; }
    }
};
struct EpiGate {
    static constexpr bool PERM = true;
    bf16* Y; const float* gate;
    __device__ __forceinline__ void operator()(const f32x4 (&acc)[2][2][4][2], const Unit& u, int wr, int wc, int fr, int fq) const {
        const int row0 = u.pm * BM + wr * 64 + fr, col0 = u.pn * BM + wc * 32 + 8 * fq;
#pragma unroll
        for (int ai = 0; ai < 2; ++ai)
#pragma unroll
            for (int m = 0; m < 4; ++m) { const size_t row = (size_t)(row0 + ai * HALF + m * 16); const float gt = gate[row];
#pragma unroll
                for (int bj = 0; bj < 2; ++bj) { const f32x4 v0 = acc[ai][bj][m][0] * gt, v1 = acc[ai][bj][m][1] * gt;
                    u32x4 w; w.x = cvt_pk_bf16(v0[0], v0[1]); w.y = cvt_pk_bf16(v0[2], v0[3]); w.z = cvt_pk_bf16(v1[0], v1[1]); w.w = cvt_pk_bf16(v1[2], v1[3]);
                    *(u32x4*)(Y + row * D + col0 + bj * HALF) = w; } }
    }
};

struct EpiProj {
    static constexpr bool PERM = true;
    bf16* PROJ; bf16* US5;
    __device__ __forceinline__ void operator()(const f32x4 (&acc)[2][2][4][2], const Unit& u, int wr, int wc, int fr, int fq) const {
        const int row0 = u.pm * BM + wr * 64 + fr, col0 = u.pn * BM + wc * 32 + 8 * fq;
#pragma unroll
        for (int ai = 0; ai < 2; ++ai)
#pragma unroll
            for (int m = 0; m < 4; ++m) { const size_t row = (size_t)(row0 + ai * HALF + m * 16);
#pragma unroll
                for (int bj = 0; bj < 2; ++bj) { const f32x4 v0 = acc[ai][bj][m][0], v1 = acc[ai][bj][m][1]; const int col = col0 + bj * HALF;
                    u32x4 w; w.x = cvt_pk_bf16(v0[0], v0[1]); w.y = cvt_pk_bf16(v0[2], v0[3]); w.z = cvt_pk_bf16(v1[0], v1[1]); w.w = cvt_pk_bf16(v1[2], v1[3]);
                    if (col < DSHIFT) *(u32x4*)(PROJ + row * DSHIFT + col) = w;
                    else { const int cc = col - DSHIFT; *(u32x4*)(US5 + ((size_t)(cc >> 4) * M + row) * 16 + (cc & 15)) = w; } } }
    }
};
struct GroupOrder {
    static constexpr bool GATHER = false; __device__ __forceinline__ int grow(const Unit&, int) const { return 0; }
    const bf16* A; const bf16* Bt; int lda, ldb, K; int nM, nN, nunits, G, c; size_t sA, sB;
    __device__ void init(const bf16* A_, int lda_, size_t sA_, const bf16* Bt_, int ldb_, size_t sB_, int ngroups, int Mg, int Ng, int K_) {
        A = A_; Bt = Bt_; lda = lda_; ldb = ldb_; K = K_; sA = sA_; sB = sB_; nM = Mg / BM; nN = Ng / BM; nunits = ngroups * nM * nN; G = GN; c = GB; }
    __device__ bool next(int i, Unit& u) const { const int L = i * G + c; if (L >= nunits) return false; u.pn = L % nN; u.pm = L / nN; return true; }
    __device__ __forceinline__ const char* aptr(const Unit& u) const { const int g = u.pm / nM, pm = u.pm % nM; return (const char*)(A + (size_t)g * sA + (size_t)pm * BM * lda); }
    __device__ __forceinline__ const char* bptr(const Unit& u) const { const int g = u.pm / nM; return (const char*)(Bt + (size_t)g * sB + (size_t)u.pn * BM * ldb); }
};
struct EpiS5a {
    static constexpr bool PERM = false;
    bf16* YI; float* F;
    __device__ __forceinline__ void operator()(const f32x4 (&acc)[2][2][4][2], const Unit& u, int wr, int wc, int fr, int fq) const {
        const int row0 = u.pm * BM + wr * 64 + fr, col0 = u.pn * BM + wc * 32 + 4 * fq;
#pragma unroll
        for (int ai = 0; ai < 2; ++ai)
#pragma unroll
            for (int m = 0; m < 4; ++m) { const size_t row = (size_t)(row0 + ai * HALF + m * 16);
#pragma unroll
                for (int bj = 0; bj < 2; ++bj)
#pragma unroll
                    for (int n = 0; n < 2; ++n) { const int col = col0 + bj * HALF + 16 * n; const f32x4 v = acc[ai][bj][m][n];
                        if (col < 512) { uint2 w; w.x = cvt_pk_bf16(v[0], v[1]); w.y = cvt_pk_bf16(v[2], v[3]); *(uint2*)(YI + row * 512 + col) = w; }
                        else if (col < 640) *(f32x4*)(F + row * 128 + (col - 512)) = v; } }
    }
};
struct EpiS5b {
    static constexpr bool PERM = true;
    const bf16* YI; bf16* Z;
    __device__ __forceinline__ void operator()(const f32x4 (&acc)[2][2][4][2], const Unit& u, int wr, int wc, int fr, int fq) const {
        const int row0 = u.pm * BM + wr * 64 + fr, col0 = u.pn * BM + wc * 32 + 8 * fq;
#pragma unroll
        for (int ai = 0; ai < 2; ++ai)
#pragma unroll
            for (int m = 0; m < 4; ++m) { const int row = row0 + ai * HALF + m * 16; const int g = row / S5R, rl = row % S5R;
#pragma unroll
                for (int bj = 0; bj < 2; ++bj) { const int col = col0 + bj * HALF;
                    const u32x4 yi = *(const u32x4*)(YI + (size_t)row * 512 + col);
                    const unsigned yw[4] = {yi.x, yi.y, yi.z, yi.w};
                    const f32x4 v0 = acc[ai][bj][m][0], v1 = acc[ai][bj][m][1];
                    float o[8];
#pragma unroll
                    for (int q = 0; q < 4; ++q) { const float al = (q < 2) ? v0[2 * q] : v1[2 * q - 4], ah = (q < 2) ? v0[2 * q + 1] : v1[2 * q - 3];
                        o[2 * q] = gelu_tanh(al + __builtin_bit_cast(float, yw[q] << 16)); o[2 * q + 1] = gelu_tanh(ah + __builtin_bit_cast(float, yw[q] & 0xffff0000u)); }
                    u32x4 w; w.x = cvt_pk_bf16(o[0], o[1]); w.y = cvt_pk_bf16(o[2], o[3]); w.z = cvt_pk_bf16(o[4], o[5]); w.w = cvt_pk_bf16(o[6], o[7]);
                    const size_t tok = (size_t)rl * S5L + (col >> 4);
                    *(u32x4*)(Z + tok * 512 + g * 16 + (col & 15)) = w; } }
    }
};
struct AttnOrder {
    static constexpr bool GATHER = false; __device__ __forceinline__ int grow(const Unit&, int) const { return 0; }
    const bf16* A; const bf16* Bt; int lda, ldb, K; int G, c; int mode;
    __device__ void init(const bf16* A_, const bf16* Bt_, int ldb_, int mode_) { A = A_; Bt = Bt_; lda = D; ldb = ldb_; K = 256; G = GN; c = GB; mode = mode_; }
    __device__ bool next(int i, Unit& u) const { const int L = i * G + c; if (L >= NB * 4 * 32) return false; u.pn = L & 3; u.pm = L >> 2; return true; }
    __device__ __forceinline__ const char* aptr(const Unit& u) const { return (const char*)(A + (size_t)u.pm * BM * D + u.pn * 256); }
    __device__ __forceinline__ const char* bptr(const Unit& u) const { const int b = u.pm >> 5;
        return (const char*)(mode == 0 ? Bt + (size_t)b * 256 * ldb + u.pn * 256 : Bt + (size_t)u.pn * 256 * ldb + b * 256); }
};
struct EpiSoftmax {
    static constexpr bool PERM = true;
    bf16* P; PG8_LAS float* scr;
    __device__ __forceinline__ void operator()(f32x4 (&acc)[2][2][4][2], const Unit& u, int wr, int wc, int fr, int fq) const {
        const float SC = 0.0625f * 1.4426950408889634f;
        PG8_LAS float* smax = scr; PG8_LAS float* ssum = scr + 1024;
#pragma unroll
        for (int ai = 0; ai < 2; ++ai)
#pragma unroll
            for (int m = 0; m < 4; ++m) { float t = -3.0e38f;
#pragma unroll
                for (int bj = 0; bj < 2; ++bj)
#pragma unroll
                    for (int n = 0; n < 2; ++n) { const f32x4 v = acc[ai][bj][m][n]; t = fmaxf(t, fmaxf(fmaxf(v[0], v[1]), fmaxf(v[2], v[3]))); }
                t = fmaxf(t, __shfl_xor(t, 16)); t = fmaxf(t, __shfl_xor(t, 32));
                if (fq == 0) smax[(ai * HALF + wr * 64 + m * 16 + fr) * 4 + wc] = t; }
        asm volatile("s_waitcnt lgkmcnt(0)" ::: "memory"); __builtin_amdgcn_s_barrier(); asm volatile("" ::: "memory");
#pragma unroll
        for (int ai = 0; ai < 2; ++ai)
#pragma unroll
            for (int m = 0; m < 4; ++m) { const f32x4 q = *(const PG8_LAS f32x4*)(smax + (ai * HALF + wr * 64 + m * 16 + fr) * 4);
                const float mm = fmaxf(fmaxf(q[0], q[1]), fmaxf(q[2], q[3])) * SC; float s = 0.f;
#pragma unroll
                for (int bj = 0; bj < 2; ++bj)
#pragma unroll
                    for (int n = 0; n < 2; ++n)
#pragma unroll
                        for (int e = 0; e < 4; ++e) { const float p = __builtin_amdgcn_exp2f(acc[ai][bj][m][n][e] * SC - mm); acc[ai][bj][m][n][e] = p; s += p; }
                s += __shfl_xor(s, 16); s += __shfl_xor(s, 32);
                if (fq == 0) ssum[(ai * HALF + wr * 64 + m * 16 + fr) * 4 + wc] = s; }
        asm volatile("s_waitcnt lgkmcnt(0)" ::: "memory"); __builtin_amdgcn_s_barrier(); asm volatile("" ::: "memory");
        const int row0 = u.pm * BM + wr * 64 + fr, col0 = u.pn * 256 + wc * 32 + 8 * fq;
#pragma unroll
        for (int ai = 0; ai < 2; ++ai)
#pragma unroll
            for (int m = 0; m < 4; ++m) { const f32x4 q = *(const PG8_LAS f32x4*)(ssum + (ai * HALF + wr * 64 + m * 16 + fr) * 4);
                const float iv = 1.f / ((q[0] + q[1]) + (q[2] + q[3]));
                bf16* rowp = P + (size_t)(row0 + ai * HALF + m * 16) * D + col0;
#pragma unroll
                for (int bj = 0; bj < 2; ++bj) { const f32x4 v0 = acc[ai][bj][m][0] * iv, v1 = acc[ai][bj][m][1] * iv; u32x4 w;
                    w.x = cvt_pk_bf16(v0[0], v0[1]); w.y = cvt_pk_bf16(v0[2], v0[3]); w.z = cvt_pk_bf16(v1[0], v1[1]); w.w = cvt_pk_bf16(v1[2], v1[3]);
                    *(u32x4*)(rowp + bj * HALF) = w; } }
    }
};
struct EpiAttnO {
    static constexpr bool PERM = true;
    bf16* O;
    __device__ __forceinline__ void operator()(const f32x4 (&acc)[2][2][4][2], const Unit& u, int wr, int wc, int fr, int fq) const {
        const int row0 = u.pm * BM + wr * 64 + fr, col0 = u.pn * 256 + wc * 32 + 8 * fq;
#pragma unroll
        for (int ai = 0; ai < 2; ++ai)
#pragma unroll
            for (int m = 0; m < 4; ++m) { bf16* rowp = O + (size_t)(row0 + ai * HALF + m * 16) * D + col0;
#pragma unroll
                for (int bj = 0; bj < 2; ++bj) { const f32x4 v0 = acc[ai][bj][m][0], v1 = acc[ai][bj][m][1];
                    u32x4 w; w.x = cvt_pk_bf16(v0[0], v0[1]); w.y = cvt_pk_bf16(v0[2], v0[3]); w.z = cvt_pk_bf16(v1[0], v1[1]); w.w = cvt_pk_bf16(v1[2], v1[3]);
                    *(u32x4*)(rowp + bj * HALF) = w; } }
    }
};

struct EpiLora {
    static constexpr bool PERM = true;
    bf16* LW; size_t ostride; const float* w0; const float* a0;
    __device__ __forceinline__ void operator()(const f32x4 (&acc)[2][2][4][2], const Unit& u, int wr, int wc, int fr, int fq) const {
        const int row0 = u.pm * BM + wr * 64 + fr, col0 = u.pn * BM + wc * 32 + 8 * fq;
        const int kind = u.pn >> 1;
        bf16* O = LW + (size_t)kind * ostride;
#pragma unroll
        for (int bj = 0; bj < 2; ++bj) { const int col = (col0 + bj * HALF) & 511;
            f32x4 b0 = (f32x4){0.f, 0.f, 0.f, 0.f}, b1 = b0;
            if (kind == 0) { b0 = *(const f32x4*)(w0 + col); b1 = *(const f32x4*)(w0 + col + 4); }
            else if (kind == 1) { b0 = *(const f32x4*)(a0 + col); b1 = *(const f32x4*)(a0 + col + 4); }
#pragma unroll
            for (int ai = 0; ai < 2; ++ai)
#pragma unroll
                for (int m = 0; m < 4; ++m) { const size_t row = (size_t)(row0 + ai * HALF + m * 16);
                    const f32x4 v0 = acc[ai][bj][m][0] + b0, v1 = acc[ai][bj][m][1] + b1; float o[8];
#pragma unroll
                    for (int e = 0; e < 8; ++e) { float x = (e < 4) ? v0[e & 3] : v1[e & 3];
                        if (kind == 0) x = -0.6065306597126334f * sigmoidf_(x);
                        else if (kind == 1) x = sigmoidf_(x);
                        o[e] = x; }
                    u32x4 w; w.x = cvt_pk_bf16(o[0], o[1]); w.y = cvt_pk_bf16(o[2], o[3]); w.z = cvt_pk_bf16(o[4], o[5]); w.w = cvt_pk_bf16(o[6], o[7]);
                    *(u32x4*)(O + row * 512 + col) = w; } }
    }
};

struct TileOrder {
    static constexpr bool GATHER = false; __device__ __forceinline__ int grow(const Unit&, int) const { return 0; }
    const bf16* A; const bf16* Bt; int lda, ldb, K, nN, pm;
    __device__ void init(const bf16* A_, int lda_, const bf16* Bt_, int ldb_, int K_, int nN_, int pm_) { A = A_; Bt = Bt_; lda = lda_; ldb = ldb_; K = K_; nN = nN_; pm = pm_; }
    __device__ bool next(int i, Unit& u) const { if (i >= nN) return false; int pm_ = pm; asm volatile("" : "+s"(pm_)); u.pm = pm_; u.pn = i; return true; }
    __device__ __forceinline__ const char* aptr(const Unit& u) const { return (const char*)(A + (size_t)u.pm * BM * lda); }
    __device__ __forceinline__ const char* bptr(const Unit& u) const { return (const char*)(Bt + (size_t)u.pn * BM * ldb); }
};
struct AttnTileOrder {
    static constexpr bool GATHER = false; __device__ __forceinline__ int grow(const Unit&, int) const { return 0; }
    const bf16* A; const bf16* Bt; int lda, ldb, K, pm, mode;
    __device__ void init(const bf16* A_, const bf16* Bt_, int ldb_, int mode_, int pm_) { A = A_; Bt = Bt_; lda = D; ldb = ldb_; K = 256; mode = mode_; pm = pm_; }
    __device__ bool next(int i, Unit& u) const { if (i >= 4) return false; int pm_ = pm; asm volatile("" : "+s"(pm_)); u.pm = pm_; u.pn = i; return true; }
    __device__ __forceinline__ const char* aptr(const Unit& u) const { return (const char*)(A + (size_t)u.pm * BM * D + u.pn * 256); }
    __device__ __forceinline__ const char* bptr(const Unit& u) const { const int b = u.pm >> 5;
        return (const char*)(mode == 0 ? Bt + (size_t)b * 256 * ldb + u.pn * 256 : Bt + (size_t)u.pn * 256 * ldb + b * 256); }
};
}

#define LAS __attribute__((address_space(3)))
__device__ __forceinline__ void transpose_item(const float* __restrict__ W, int K, int N, bf16* __restrict__ WT, int ldt, int row_off, int col_off, float* scr, int item, int lane, const float* __restrict__ kscale, int ldw = 0) {
    if (ldw == 0) ldw = N;
    const int nblk = N / 32, kb = item / nblk, nb = item % nblk, k0 = 64 * kb, n0 = 32 * nb;
#pragma unroll 8
    for (int i = 0; i < 32; ++i) { const int kk = 2 * i + (lane >> 5); float v = W[(size_t)(k0 + kk) * ldw + n0 + (lane & 31)]; if (kscale) v *= kscale[k0 + kk]; scr[kk * 33 + (lane & 31)] = v; }
    __builtin_amdgcn_s_waitcnt(0xc07f); asm volatile("" ::: "memory");
    const int c = lane & 7;
#pragma unroll
    for (int j = 0; j < 4; ++j) { const int n = (lane >> 3) + 8 * j; const float* s = scr + (8 * c) * 33 + n;
        uint4 o; o.x = pk2(s[0 * 33], s[1 * 33]); o.y = pk2(s[2 * 33], s[3 * 33]); o.z = pk2(s[4 * 33], s[5 * 33]); o.w = pk2(s[6 * 33], s[7 * 33]);
        *(uint4*)(WT + (size_t)(row_off + n0 + n) * ldt + col_off + k0 + 8 * c) = o; }
    __builtin_amdgcn_s_waitcnt(0xc07f); asm volatile("" ::: "memory");
}
__device__ __forceinline__ void transpose_ph(const int WID_, const float* W, int K, int N, bf16* WT, int ldt, int row_off, int col_off, char* lds, const float* kscale = nullptr) {
    const int lane = (WID_ * 64 + lane_id()) & 63, wv = (WID_ * 64 + lane_id()) >> 6;
    float* scr = (float*)(lds + wv * 16384);
    const int nitems = (K / 64) * (N / 32);
    for (int it = GB * 8 + wv; it < nitems; it += GN * 8) transpose_item(W, K, N, WT, ldt, row_off, col_off, scr, it, lane, kscale);
}

template <typename TO>
__device__ __forceinline__ void rmsnorm_ph(const int WID_, const float* __restrict__ x, const float* __restrict__ w, TO* __restrict__ out, int rows, int row_lo = 0, int vb = GB, int nvb = GN) {
    const int lane = lane_id(), wv = WID_;
    float4 g[4];
#pragma unroll
    for (int j = 0; j < 4; ++j) g[j] = *(const float4*)(w + (lane + 64 * j) * 4);
    for (int row = row_lo + (vb * 8 + wv) * 2; row < rows; row += nvb * 16) {
        const float4* xr = (const float4*)(x + (size_t)row * D);
        float4 v[2][4]; float s[2] = {0.f, 0.f};
#pragma unroll
        for (int r = 0; r < 2; ++r)
#pragma unroll
            for (int j = 0; j < 4; ++j) v[r][j] = xr[r * (D / 4) + lane + 64 * j];
#pragma unroll
        for (int r = 0; r < 2; ++r) {
#pragma unroll
            for (int j = 0; j < 4; ++j) s[r] += v[r][j].x * v[r][j].x + v[r][j].y * v[r][j].y + v[r][j].z * v[r][j].z + v[r][j].w * v[r][j].w;
            s[r] = wave_sum(s[r]);
            const float rs = rsqrtf(s[r] * (1.f / D) + 1e-6f);
#pragma unroll
            for (int j = 0; j < 4; ++j) {
                uint2 o; o.x = pk2(v[r][j].x * rs * g[j].x, v[r][j].y * rs * g[j].y); o.y = pk2(v[r][j].z * rs * g[j].z, v[r][j].w * rs * g[j].w);
                *(uint2*)(out + (size_t)(row + r) * D + (lane + 64 * j) * 4) = o;
            }
        }
    }
}

__device__ __forceinline__ void rwkv_lin_ph(const int WID_, const bf16* __restrict__ proj, const float* __restrict__ mu, bf16* __restrict__ lin) {
    const int lane = lane_id(), wv = WID_;
    const float4 m4 = *(const float4*)(mu + 1536 + 4 * lane);
    const float mm[4] = {m4.x, m4.y, m4.z, m4.w};
    for (int m0 = (GB * 8 + wv) * 4; m0 < M; m0 += GN * 32) {
        uint2 z[4], zp[4];
#pragma unroll
        for (int i = 0; i < 4; ++i) { const int m = m0 + i; z[i] = *(const uint2*)(proj + (size_t)m * DSHIFT + 1536 + 4 * lane);
            zp[i] = make_uint2(0, 0); if ((m & (S - 1)) != 0) zp[i] = *(const uint2*)(proj + (size_t)(m - 1) * DSHIFT + 1536 + 4 * lane); }
#pragma unroll
        for (int i = 0; i < 4; ++i) {
            float c[4] = {__builtin_bit_cast(float, z[i].x << 16), __builtin_bit_cast(float, z[i].x & 0xffff0000u), __builtin_bit_cast(float, z[i].y << 16), __builtin_bit_cast(float, z[i].y & 0xffff0000u)};
            const float q[4] = {__builtin_bit_cast(float, zp[i].x << 16), __builtin_bit_cast(float, zp[i].x & 0xffff0000u), __builtin_bit_cast(float, zp[i].y << 16), __builtin_bit_cast(float, zp[i].y & 0xffff0000u)};
#pragma unroll
            for (int e = 0; e < 4; ++e) { float t = c[e] + (q[e] - c[e]) * mm[e];
                if (lane < 16) t = 1.f - 2.f / (1.f + __expf(2.f * t));
                else if (lane >= 32) t = sigmoidf_(t);
                c[e] = t; }
            uint2 o; o.x = pk2(c[0], c[1]); o.y = pk2(c[2], c[3]);
            *(uint2*)(lin + (size_t)(m0 + i) * 256 + 4 * lane) = o;
        }
    }
}
__device__ __forceinline__ void rwkv_wl_ph(const int WID_, const float* __restrict__ wdec, const float* __restrict__ wiclr, const float* __restrict__ wgate, bf16* __restrict__ wl) {
    for (int i = GB * NT + (WID_ * 64 + lane_id()); i < 1536 * 256; i += GN * NT) {
        const int k = i & 255, n = i >> 8; float v = 0.f;
        if (n < 512) { if (k < 64) v = wdec[k * 512 + n]; }
        else if (n < 1024) { if (k >= 64 && k < 128) v = wiclr[(k - 64) * 512 + (n - 512)]; }
        else { if (k >= 128) v = wgate[(k - 128) * 512 + (n - 1024)]; }
        wl[i] = f2bf(v);
    }
}
template <int CTRL> __device__ __forceinline__ float dpp16(float x) { return __builtin_bit_cast(float, __builtin_amdgcn_update_dpp(0, __builtin_bit_cast(int, x), CTRL, 0xf, 0xf, true)); }
constexpr int RW_ITEMS = NB * 8;

namespace ck {
#define CK_BAR() do { asm volatile("s_waitcnt lgkmcnt(0)" ::: "memory"); __builtin_amdgcn_s_barrier(); asm volatile("" ::: "memory"); } while (0)
typedef float f32x2_t __attribute__((ext_vector_type(2)));
typedef __bf16 bf16x2_t __attribute__((ext_vector_type(2)));
__device__ __forceinline__ unsigned cvtpk(float lo, float hi) { const f32x2_t v = {lo, hi}; const bf16x2_t b = __builtin_convertvector(v, bf16x2_t); return __builtin_bit_cast(unsigned, b); }
typedef short bf16x8 __attribute__((ext_vector_type(8)));
typedef float f32x16 __attribute__((ext_vector_type(16)));
constexpr int LD = 72;
constexpr int MB = 64 * LD * 2;
constexpr int O_AB = 0, O_RB = MB, O_BB = 2 * MB, O_KB = 3 * MB, O_AT = 4 * MB, O_W1T = 5 * MB, O_BT = 6 * MB, O_KT = 7 * MB, O_VT = 8 * MB,
              O_NM = 9 * MB, O_AAK = 10 * MB, O_ARB = 11 * MB, O_ARK = 12 * MB, O_G = 13 * MB, O_TOT = O_G + 16384;
constexpr int O_TM = O_AB, O_X1T = O_BB, O_NMF = O_G, O_TT = O_G + 8192, O_ZT = O_TT + 5120;
constexpr int ITEM_BYTES = 32768;
template <int K, typename PA, typename PB>
__device__ __forceinline__ f32x16 mm_tile(f32x16 acc, PA A, int lda, PB B, int ldb, int lane) {
    const int r = lane & 31, h = lane >> 5;
    bf16x8 a[K / 16], b[K / 16];
#pragma unroll
    for (int q = 0; q < K / 16; ++q) { a[q] = *(const bf16x8*)(A + r * lda + 16 * q + 8 * h); b[q] = *(const bf16x8*)(B + r * ldb + 16 * q + 8 * h); }
#pragma unroll
    for (int q = 0; q < K / 16; ++q) acc = __builtin_amdgcn_mfma_f32_32x32x16_bf16(a[q], b[q], acc, 0, 0, 0);
    return acc;
}
__device__ __forceinline__ int crow(int reg, int h) { return (reg & 3) + 8 * (reg >> 2) + 4 * h; }
__device__ __forceinline__ void store_tr(const f32x16& acc, bf16* Ct, int ldct, int lane) {
    const int c = lane & 31, h = lane >> 5;
#pragma unroll
    for (int g = 0; g < 4; ++g) { uint2 w; w.x = cvtpk(acc[4 * g], acc[4 * g + 1]); w.y = cvtpk(acc[4 * g + 2], acc[4 * g + 3]); *(uint2*)(Ct + c * ldct + 8 * g + 4 * h) = w; }
}
__device__ __forceinline__ void store_rm(const f32x16& acc, bf16* C, int ldc, int lane) {
    const int c = lane & 31, h = lane >> 5;
#pragma unroll
    for (int rg = 0; rg < 16; ++rg) C[crow(rg, h) * ldc + c] = f2bf(acc[rg]);
}
__device__ __forceinline__ f32x16 zero16() { return (f32x16){0.f, 0.f, 0.f, 0.f, 0.f, 0.f, 0.f, 0.f, 0.f, 0.f, 0.f, 0.f, 0.f, 0.f, 0.f, 0.f}; }
__device__ __forceinline__ void store_frag16(const f32x16& acc, bf16* base, int t0, int t1, int lane) {
    const int cc = lane & 31, hh = lane >> 5, col = 32 * t1 + cc;
#pragma unroll
    for (int g = 0; g < 4; ++g) { const int row = 32 * t0 + 8 * g + 4 * hh;
        uint2 w; w.x = cvtpk(acc[4 * g], acc[4 * g + 1]); w.y = cvtpk(acc[4 * g + 2], acc[4 * g + 3]);
        *(uint2*)(base + (((row >> 4) * 4 + (col >> 4)) * 64 + (col & 15) + 16 * ((row & 15) >> 2)) * 4) = w; }
}
struct In { const bf16* proj; const bf16* LW; const bf16* AA; const float* mu; const float* k_k; const float* k_a; const float* r_k; float* RK; char* items; };

__device__ __forceinline__ void phase1(const int WID_, const In& I, char* lds) {
    const int wv = WID_;
#define MAT(off) ((bf16*)(lds + (off)))
    float* G = (float*)(lds + O_G); float* TOT = (float*)(lds + O_TOT); float* NMF = (float*)(lds + O_NMF);
    uint4 nx_r, nx_k, nx_v, nx_qr, nx_qk, nx_qv, nx_a, nx_l;
    { const int lane0 = lane_id(), tid0 = wv * 64 + lane0; const int item = GB;
      if (item < NB * 8 * (S / 64)) { const int c = item & 127, h = (item >> 7) & 7, b = item >> 10, s = tid0 >> 3, cg = tid0 & 7, ch0 = h * 64 + cg * 8, t = c * 64 + s; const size_t m = (size_t)b * S + t;
        const bf16* z = I.proj + m * DSHIFT + ch0;
        nx_r = *(const uint4*)(z); nx_k = *(const uint4*)(z + 512); nx_v = *(const uint4*)(z + 1024);
        nx_qr = make_uint4(0, 0, 0, 0); nx_qk = nx_qr; nx_qv = nx_qr;
        if (t > 0) { nx_qr = *(const uint4*)(z - DSHIFT); nx_qk = *(const uint4*)(z + 512 - DSHIFT); nx_qv = *(const uint4*)(z + 1024 - DSHIFT); }
        nx_a = *(const uint4*)(I.AA + m * 512 + ch0); nx_l = *(const uint4*)(I.LW + m * 512 + ch0); } }
    for (int item = GB; item < NB * 8 * (S / 64); item += GN) {
        const int lane = lane_id(), tid = wv * 64 + lane;
        const int c = item & 127, h = (item >> 7) & 7, b = item >> 10;
        char* out = I.items + (size_t)item * ITEM_BYTES;
        const int s = tid >> 3, cg = tid & 7, ch0 = h * 64 + cg * 8, t = c * 64 + s; const size_t m = (size_t)b * S + t;
        float r_[8], kp_[8], v_[8], kk_[8], b_[8];
        {
            const uint4 gr = nx_r, gk = nx_k, gv = nx_v, qr = nx_qr, qk = nx_qk, qv = nx_qv, ga = nx_a, gl = nx_l;
            const float4 c_mr0 = *(const float4*)(I.mu + ch0), c_mr1 = *(const float4*)(I.mu + ch0 + 4), c_mk0 = *(const float4*)(I.mu + 512 + ch0), c_mk1 = *(const float4*)(I.mu + 512 + ch0 + 4);
            const float4 c_mv0 = *(const float4*)(I.mu + 1024 + ch0), c_mv1 = *(const float4*)(I.mu + 1024 + ch0 + 4), c_kk0 = *(const float4*)(I.k_k + ch0), c_kk1 = *(const float4*)(I.k_k + ch0 + 4);
            const float4 c_ka0 = *(const float4*)(I.k_a + ch0), c_ka1 = *(const float4*)(I.k_a + ch0 + 4), c_rk0 = *(const float4*)(I.r_k + ch0), c_rk1 = *(const float4*)(I.r_k + ch0 + 4);
            const float mur[8] = {c_mr0.x, c_mr0.y, c_mr0.z, c_mr0.w, c_mr1.x, c_mr1.y, c_mr1.z, c_mr1.w}, muk[8] = {c_mk0.x, c_mk0.y, c_mk0.z, c_mk0.w, c_mk1.x, c_mk1.y, c_mk1.z, c_mk1.w};
            const float muv[8] = {c_mv0.x, c_mv0.y, c_mv0.z, c_mv0.w, c_mv1.x, c_mv1.y, c_mv1.z, c_mv1.w}, ckk[8] = {c_kk0.x, c_kk0.y, c_kk0.z, c_kk0.w, c_kk1.x, c_kk1.y, c_kk1.z, c_kk1.w};
            const float cka[8] = {c_ka0.x, c_ka0.y, c_ka0.z, c_ka0.w, c_ka1.x, c_ka1.y, c_ka1.z, c_ka1.w}, crk[8] = {c_rk0.x, c_rk0.y, c_rk0.z, c_rk0.w, c_rk1.x, c_rk1.y, c_rk1.z, c_rk1.w};
            const unsigned wr[4] = {gr.x, gr.y, gr.z, gr.w}, wk[4] = {gk.x, gk.y, gk.z, gk.w}, wv4[4] = {gv.x, gv.y, gv.z, gv.w};
            const unsigned pr[4] = {qr.x, qr.y, qr.z, qr.w}, pk[4] = {qk.x, qk.y, qk.z, qk.w}, pv[4] = {qv.x, qv.y, qv.z, qv.w};
            const unsigned wa[4] = {ga.x, ga.y, ga.z, ga.w}, wl[4] = {gl.x, gl.y, gl.z, gl.w};
            float ss = 0.f, rk = 0.f, a_[8];
#pragma unroll
            for (int e = 0; e < 8; ++e) { const int w_ = e >> 1; const bool hi = e & 1;
                auto ex = [&](unsigned u) { return hi ? __builtin_bit_cast(float, u & 0xffff0000u) : __builtin_bit_cast(float, u << 16); };
                float x = ex(wr[w_]); r_[e] = x + (ex(pr[w_]) - x) * mur[e];
                x = ex(wk[w_]); const float k = x + (ex(pk[w_]) - x) * muk[e];
                x = ex(wv4[w_]); v_[e] = x + (ex(pv[w_]) - x) * muv[e];
                a_[e] = ex(wa[w_]); kk_[e] = k * ckk[e]; ss += kk_[e] * kk_[e];
                kp_[e] = k * (1.f + (a_[e] - 1.f) * cka[e]); rk += r_[e] * kp_[e] * crk[e];
                G[s * 64 + cg * 8 + e] = ex(wl[w_]); }
            ss += dpp16<0xB1>(ss); ss += dpp16<0x4E>(ss); ss += dpp16<0x141>(ss);
            const float inv = 1.f / fmaxf(sqrtf(ss), 1e-12f);
#pragma unroll
            for (int e = 0; e < 8; ++e) { kk_[e] *= inv; b_[e] = kk_[e] * a_[e]; }
            rk += dpp16<0xB1>(rk); rk += dpp16<0x4E>(rk); rk += dpp16<0x141>(rk);
            if (cg == 0) I.RK[m * 8 + h] = rk;
        }
        CK_BAR();
        { const int ch = tid & 63, part = tid >> 6; float run = 0.f;
#pragma unroll
          for (int i = 0; i < 8; ++i) { run += G[(8 * part + i) * 64 + ch]; G[(8 * part + i) * 64 + ch] = run; }
          TOT[part * 64 + ch] = run; }
        CK_BAR();
        { const int ch = tid & 63, part = tid >> 6; float off = 0.f;
          for (int p = 0; p < part; ++p) off += TOT[p * 64 + ch];
#pragma unroll
          for (int i = 0; i < 8; ++i) G[(8 * part + i) * 64 + ch] += off; }
        CK_BAR();
        float glast[8];
        {
            unsigned pab[4], prb[4], pbb[4], pkb[4];
            float ab[8], rb[8], bb[8], kb[8], bt[8], kt[8];
            const float4 g0_ = *(const float4*)(G + s * 64 + cg * 8), g1_ = *(const float4*)(G + s * 64 + cg * 8 + 4);
            const int sm = (s > 0) ? s - 1 : 0; const float msk = (s > 0) ? 1.f : 0.f;
            const float4 m0_ = *(const float4*)(G + sm * 64 + cg * 8), m1_ = *(const float4*)(G + sm * 64 + cg * 8 + 4);
            const float4 l0_ = *(const float4*)(G + 63 * 64 + cg * 8), l1_ = *(const float4*)(G + 63 * 64 + cg * 8 + 4);
            const float gv_[8] = {g0_.x, g0_.y, g0_.z, g0_.w, g1_.x, g1_.y, g1_.z, g1_.w}, mv_[8] = {m0_.x, m0_.y, m0_.z, m0_.w, m1_.x, m1_.y, m1_.z, m1_.w}, lv_[8] = {l0_.x, l0_.y, l0_.z, l0_.w, l1_.x, l1_.y, l1_.z, l1_.w};
#pragma unroll
            for (int e = 0; e < 8; ++e) { const float g = gv_[e], gm1 = mv_[e] * msk, gL = lv_[e];
                glast[e] = gL;
                const float eg = __expf(g), eng = __expf(-g), egm = __expf(gm1), egl = __expf(gL - g);
                ab[e] = -kk_[e] * egm; rb[e] = r_[e] * eg; bb[e] = b_[e] * eng; kb[e] = kp_[e] * eng; bt[e] = b_[e] * egl; kt[e] = kp_[e] * egl; }
#pragma unroll
            for (int q = 0; q < 4; ++q) { pab[q] = pk2(ab[2 * q], ab[2 * q + 1]); prb[q] = pk2(rb[2 * q], rb[2 * q + 1]); pbb[q] = pk2(bb[2 * q], bb[2 * q + 1]); pkb[q] = pk2(kb[2 * q], kb[2 * q + 1]); }
            *(uint4*)(MAT(O_AB) + s * LD + cg * 8) = make_uint4(pab[0], pab[1], pab[2], pab[3]);
            *(uint4*)(MAT(O_RB) + s * LD + cg * 8) = make_uint4(prb[0], prb[1], prb[2], prb[3]);
            *(uint4*)(MAT(O_BB) + s * LD + cg * 8) = make_uint4(pbb[0], pbb[1], pbb[2], pbb[3]);
            *(uint4*)(MAT(O_KB) + s * LD + cg * 8) = make_uint4(pkb[0], pkb[1], pkb[2], pkb[3]);
#pragma unroll
            for (int e = 0; e < 8; ++e) { const int k = cg * 8 + e;
                MAT(O_AT)[k * LD + s] = f2bf(ab[e]); MAT(O_BT)[k * LD + s] = f2bf(bt[e]); MAT(O_KT)[k * LD + s] = f2bf(kt[e]); MAT(O_VT)[k * LD + s] = f2bf(v_[e]); }
        }
        CK_BAR();
        { const int itn = item + GN;
          if (itn < NB * 8 * (S / 64)) { const int c2 = itn & 127, h2 = (itn >> 7) & 7, b2 = itn >> 10, ch2 = h2 * 64 + cg * 8, t2 = c2 * 64 + s; const size_t m2 = (size_t)b2 * S + t2;
            const bf16* z = I.proj + m2 * DSHIFT + ch2;
            nx_r = *(const uint4*)(z); nx_k = *(const uint4*)(z + 512); nx_v = *(const uint4*)(z + 1024);
            nx_qr = make_uint4(0, 0, 0, 0); nx_qk = nx_qr; nx_qv = nx_qr;
            if (t2 > 0) { nx_qr = *(const uint4*)(z - DSHIFT); nx_qk = *(const uint4*)(z + 512 - DSHIFT); nx_qv = *(const uint4*)(z + 1024 - DSHIFT); }
            nx_a = *(const uint4*)(I.AA + m2 * 512 + ch2); nx_l = *(const uint4*)(I.LW + m2 * 512 + ch2); } }
        if (s == 63) {
#pragma unroll
            for (int e = 0; e < 8; ++e) TOT[cg * 8 + e] = __expf(glast[e]);
        }
        {
            const int mat = tid >> 7, row = (tid >> 2) & 31, chunk = tid & 3;
            *(uint4*)(MAT(O_NM + mat * MB) + row * LD + 32 + chunk * 8) = make_uint4(0, 0, 0, 0);
        }
        for (int task = wv; task < 12; task += 8) {
            const int mat = task / 3, tt = task % 3, st = (tt == 0) ? 0 : 1, jt = (tt == 2) ? 1 : 0;
            const bf16* Asrc = MAT((mat & 1) ? O_KB : O_BB) + 32 * jt * LD;
            const bf16* Bsrc = MAT((mat >> 1) ? O_RB : O_AB) + 32 * st * LD;
            f32x16 acc = mm_tile<64>(zero16(), Asrc, LD, Bsrc, LD, lane);
            const int cs = 32 * st + (lane & 31), hh = lane >> 5; const bool incl = (mat >> 1) != 0;
#pragma unroll
            for (int rg = 0; rg < 16; ++rg) { const int j = 32 * jt + crow(rg, hh); const bool keep = incl ? (j <= cs) : (j < cs); if (!keep) acc[rg] = 0.f; }
            store_tr(acc, MAT(O_NM + mat * MB) + 32 * st * LD + 32 * jt, LD, lane);
            if (mat == 0 && st == jt) {
                float* d = NMF + st * 1024 + (lane & 31) * 32;
#pragma unroll
                for (int g = 0; g < 4; ++g) *(float4*)(d + 8 * g + 4 * hh) = make_float4(acc[4 * g], acc[4 * g + 1], acc[4 * g + 2], acc[4 * g + 3]);
            }
        }
        CK_BAR();
        if (wv == 0) {
            const int d = lane >> 4, cc = lane & 15;
            const float* nb = NMF + (d >> 1) * 1024 + (16 * (d & 1)) * 32 + 16 * (d & 1);
            float T[16];
#pragma unroll
            for (int i = 0; i < 16; ++i) {
                float acc = (i == cc) ? 1.f : 0.f;
#pragma unroll
                for (int j4 = 0; j4 < i; j4 += 4) { const float4 n4 = *(const float4*)(nb + i * 32 + j4);
                    acc += n4.x * T[j4]; if (j4 + 1 < i) acc += n4.y * T[j4 + 1]; if (j4 + 2 < i) acc += n4.z * T[j4 + 2]; if (j4 + 3 < i) acc += n4.w * T[j4 + 3]; }
                T[i] = acc;
            }
            bf16* tm = MAT(O_TM) + (16 * d) * LD + 16 * d + cc;
#pragma unroll
            for (int i = 0; i < 16; ++i) tm[i * LD] = f2bf(T[i]);
            bf16* tt = MAT(O_TT) + (d >> 1) * 32 * 40 + (16 * (d & 1) + cc) * 40 + 16 * (d & 1);
            *(uint4*)(tt) = make_uint4(pk2(T[0], T[1]), pk2(T[2], T[3]), pk2(T[4], T[5]), pk2(T[6], T[7]));
            *(uint4*)(tt + 8) = make_uint4(pk2(T[8], T[9]), pk2(T[10], T[11]), pk2(T[12], T[13]), pk2(T[14], T[15]));
            { const int blk = lane >> 5, r16 = (lane >> 1) & 15, hf = lane & 1;
              *(uint4*)(MAT(O_TM) + (32 * blk + r16) * LD + 32 * blk + 16 + 8 * hf) = make_uint4(0, 0, 0, 0);
              *(uint4*)(MAT(O_TT) + blk * 32 * 40 + (16 + r16) * 40 + 8 * hf) = make_uint4(0, 0, 0, 0); }
        } else if (wv == 1) {
            const int row = lane >> 1, half = lane & 1;
            *(uint4*)(MAT(O_TM) + row * LD + 32 + half * 16) = make_uint4(0, 0, 0, 0); *(uint4*)(MAT(O_TM) + row * LD + 32 + half * 16 + 8) = make_uint4(0, 0, 0, 0);
        } else if (wv >= 4) {
            const int st = (wv - 4) >> 1, vt = (wv - 4) & 1;
            f32x16 acc = mm_tile<64>(zero16(), MAT(O_AAK) + 32 * st * LD, LD, MAT(O_VT) + 32 * vt * LD, LD, lane);
            store_tr(acc, MAT(O_W1T) + 32 * vt * LD + 32 * st, LD, lane);
        }
        CK_BAR();
        if (wv < 2) {
            typedef float f32x4v __attribute__((ext_vector_type(4)));
            const int blk = wv, fr = lane & 15, fq = lane >> 4;
            const bf16x8 zf = (bf16x8){0, 0, 0, 0, 0, 0, 0, 0};
            bf16x8 a = zf, bq = zf;
            if (fq < 2) { a = *(const bf16x8*)(MAT(O_NM) + (32 * blk + 16 + fr) * LD + 32 * blk + 8 * fq); bq = *(const bf16x8*)(MAT(O_TT) + blk * 32 * 40 + fr * 40 + 8 * fq); }
            f32x4v z = __builtin_amdgcn_mfma_f32_16x16x32_bf16(a, bq, (f32x4v){0.f, 0.f, 0.f, 0.f}, 0, 0, 0);
            bf16* zt = MAT(O_ZT) + blk * 16 * 24;
            { uint2 w; w.x = cvtpk(z[0], z[1]); w.y = cvtpk(z[2], z[3]); *(uint2*)(zt + fr * 24 + 4 * fq) = w; }
            asm volatile("s_waitcnt lgkmcnt(0)" ::: "memory");
            a = zf; bq = zf;
            if (fq < 2) { a = *(const bf16x8*)(MAT(O_TM) + (32 * blk + 16 + fr) * LD + 32 * blk + 16 + 8 * fq); bq = *(const bf16x8*)(zt + fr * 24 + 8 * fq); }
            const f32x4v t21 = __builtin_amdgcn_mfma_f32_16x16x32_bf16(a, bq, (f32x4v){0.f, 0.f, 0.f, 0.f}, 0, 0, 0);
#pragma unroll
            for (int rg = 0; rg < 4; ++rg) MAT(O_TM)[(32 * blk + 16 + 4 * fq + rg) * LD + 32 * blk + fr] = f2bf(t21[rg]);
            { uint2 w; w.x = cvtpk(t21[0], t21[1]); w.y = cvtpk(t21[2], t21[3]); *(uint2*)(MAT(O_TT) + blk * 32 * 40 + fr * 40 + 16 + 4 * fq) = w; }
        }
        CK_BAR();
        if (wv == 0) { f32x16 acc = mm_tile<32>(zero16(), MAT(O_NM) + 32 * LD, LD, MAT(O_TT), 40, lane); store_tr(acc, MAT(O_ZT), 40, lane); }
        CK_BAR();
        if (wv == 0) { f32x16 acc = mm_tile<32>(zero16(), MAT(O_TM) + 32 * LD + 32, LD, MAT(O_ZT), 40, lane); store_rm(acc, MAT(O_TM) + 32 * LD, LD, lane); }
        CK_BAR();
        { const int st = wv >> 2, ct = wv & 3;
          f32x16 acc = mm_tile<64>(zero16(), MAT(O_TM) + 32 * st * LD, LD, MAT(O_AT) + 32 * ct * LD, LD, lane);
          CK_BAR();
          store_tr(acc, MAT(O_X1T) + 32 * ct * LD + 32 * st, LD, lane); }
        CK_BAR();
        for (int u = wv; u < 16; u += 8) {
            const int kind = u >> 2, t0 = (u >> 1) & 1, t1 = u & 1, hh = lane >> 5, cc = lane & 31;
            if (kind == 0) {
                f32x16 acc = mm_tile<64>(zero16(), MAT(O_BT) + 32 * t0 * LD, LD, MAT(O_X1T) + (64 + 32 * t1) * LD, LD, lane);
                acc = mm_tile<64>(acc, MAT(O_KT) + 32 * t0 * LD, LD, MAT(O_VT) + 32 * t1 * LD, LD, lane);
                store_frag16(acc, (bf16*)(out + 16384), t0, t1, lane);
            } else if (kind == 1) {
                f32x16 acc = mm_tile<64>(zero16(), MAT(O_ARB) + 32 * t0 * LD, LD, MAT(O_X1T) + (64 + 32 * t1) * LD, LD, lane);
                acc = mm_tile<64>(acc, MAT(O_ARK) + 32 * t0 * LD, LD, MAT(O_VT) + 32 * t1 * LD, LD, lane);
                store_frag16(acc, (bf16*)(out + 24576), t0, t1, lane);
            } else if (kind == 2) {
                f32x16 acc = mm_tile<64>(zero16(), MAT(O_X1T) + 32 * t0 * LD, LD, MAT(O_BT) + 32 * t1 * LD, LD, lane);
                const int k = 32 * t1 + cc; const float gl = TOT[k];
                bf16* d = (bf16*)out + k * 64 + 32 * t0;
#pragma unroll
                for (int g = 0; g < 4; ++g) { float x[4];
#pragma unroll
                    for (int e = 0; e < 4; ++e) { const int kp = 32 * t0 + 8 * g + 4 * hh + e; x[e] = acc[4 * g + e] + ((kp == k) ? gl : 0.f); }
                    uint2 w; w.x = cvtpk(x[0], x[1]); w.y = cvtpk(x[2], x[3]); *(uint2*)(d + 8 * g + 4 * hh) = w; }
            } else {
                f32x16 acc = mm_tile<64>(zero16(), MAT(O_X1T) + 32 * t0 * LD, LD, MAT(O_ARB) + 32 * t1 * LD, LD, lane);
                const int sq = 32 * t1 + cc;
                bf16* d = (bf16*)(out + 8192) + sq * 64 + 32 * t0;
                const bf16* rb = MAT(O_RB) + sq * LD + 32 * t0;
#pragma unroll
                for (int g = 0; g < 4; ++g) { const uint2 rr = *(const uint2*)(rb + 8 * g + 4 * hh);
                    const float x0 = acc[4 * g] + __builtin_bit_cast(float, rr.x << 16), x1 = acc[4 * g + 1] + __builtin_bit_cast(float, rr.x & 0xffff0000u);
                    const float x2 = acc[4 * g + 2] + __builtin_bit_cast(float, rr.y << 16), x3 = acc[4 * g + 3] + __builtin_bit_cast(float, rr.y & 0xffff0000u);
                    uint2 w; w.x = cvtpk(x0, x1); w.y = cvtpk(x2, x3); *(uint2*)(d + 8 * g + 4 * hh) = w; }
            }
        }
        CK_BAR();
    }
#undef MAT
}
typedef float f32x4w __attribute__((ext_vector_type(4)));
constexpr int P2_SLOT = 2 * 64 * LD * 2 + 4096;
__device__ __forceinline__ void phase2(const int WID_, const char* items, float* Y, char* lds) {
    const int wv = WID_;
    bf16* HT0 = (bf16*)lds; bf16* HT1 = HT0 + 16 * LD;
    char* SL = lds + 8192;
    for (int item = GB; item < NB * 8 * 4; item += GN) {
        const int lane = lane_id(), tid = wv * 64 + lane, fr = lane & 15, fq = lane >> 4;
        const int vq = (item >> 3) & 3, head = (item & 7) + 8 * (item >> 5), b = head >> 3, h = head & 7;
        for (int i = tid; i < 2 * 16 * LD / 8; i += NT) ((uint4*)lds)[i] = make_uint4(0, 0, 0, 0);
        const bool upd = wv < 4; const int rb = wv & 3;
        const char* rec0 = items + (size_t)(head * 128) * ITEM_BYTES;
        const size_t g_pq = (size_t)tid * 16;
        const int l_pq = (tid >> 3) * (LD * 2) + (tid & 7) * 16;
        const int piece = (tid >> 5) & 7;
        const size_t g_f = 16384 + (size_t)(piece >> 2) * 8192 + (((piece & 3) * 4 + vq) * 64) * 8 + (tid & 31) * 16;
        const int l_f = 2 * 64 * LD * 2 + piece * 512 + (tid & 31) * 16;
        float* yo = Y + ((size_t)b * S + 16 * rb + 4 * fq) * 512 + h * 64 + 16 * vq + fr;
        const int a_lds = (upd ? 0 : 64 * LD * 2) + (16 * rb + fr) * (LD * 2) + 16 * fq;
        const int c_lds = 2 * 64 * LD * 2 + ((upd ? 0 : 4) + rb) * 512 + lane * 8;
        uint4 rp0, rp1, rp2, rp3, rp4, rp5, rp6, rp7, rq0, rq1, rq2, rq3, rq4, rq5, rq6, rq7, rf0, rf1, rf2, rf3, rf4, rf5, rf6, rf7;
#define P2_LD(n, i) do { const char* rc_ = rec0 + (size_t)(i) * ITEM_BYTES; rp##n = *(const uint4*)(rc_ + g_pq); rq##n = *(const uint4*)(rc_ + 8192 + g_pq); rf##n = *(const uint4*)(rc_ + g_f); } while (0)
#define P2_ST(n, slot) do { char* s_ = SL + (slot) * P2_SLOT; *(uint4*)(s_ + l_pq) = rp##n; *(uint4*)(s_ + 64 * LD * 2 + l_pq) = rq##n; *(uint4*)(s_ + l_f) = rf##n; } while (0)
        P2_LD(0, 0); P2_LD(1, 1); P2_LD(2, 2); P2_LD(3, 3); P2_LD(4, 4); P2_LD(5, 5); P2_LD(6, 6); P2_LD(7, 7);
        P2_ST(0, 0); P2_LD(0, 8);
        CK_BAR();
#define P2_STEP(RN, cstep) do { const int c_ = (cstep); \
            const bf16* Hc = (c_ & 1) ? HT1 : HT0; bf16* Hn = (c_ & 1) ? HT0 : HT1; const char* sl_ = SL + (c_ & 1) * P2_SLOT; \
            const uint2 cv = *(const uint2*)(sl_ + c_lds); \
            f32x4w acc = (f32x4w){__builtin_bit_cast(float, cv.x << 16), __builtin_bit_cast(float, cv.x & 0xffff0000u), __builtin_bit_cast(float, cv.y << 16), __builtin_bit_cast(float, cv.y & 0xffff0000u)}; \
            const bf16x8 a0 = *(const bf16x8*)(sl_ + a_lds), a1 = *(const bf16x8*)(sl_ + a_lds + 64); \
            const bf16x8 b0 = *(const bf16x8*)(Hc + fr * LD + 8 * fq), b1 = *(const bf16x8*)(Hc + fr * LD + 32 + 8 * fq); \
            if (c_ + 1 < S / 64) P2_ST(RN, (c_ + 1) & 1); \
            if (c_ + 9 < S / 64) P2_LD(RN, c_ + 9); \
            acc = __builtin_amdgcn_mfma_f32_16x16x32_bf16(a0, b0, acc, 0, 0, 0); acc = __builtin_amdgcn_mfma_f32_16x16x32_bf16(a1, b1, acc, 0, 0, 0); \
            if (upd) { uint2 w; w.x = cvtpk(acc[0], acc[1]); w.y = cvtpk(acc[2], acc[3]); *(uint2*)(Hn + fr * LD + 16 * rb + 4 * fq) = w; } \
            else { float* y_ = yo + (size_t)c_ * 64 * 512; y_[0] = acc[0]; y_[512] = acc[1]; y_[1024] = acc[2]; y_[1536] = acc[3]; } \
            CK_BAR(); } while (0)
        for (int c = 0; c < S / 64; c += 8) {
            P2_STEP(1, c); P2_STEP(2, c + 1); P2_STEP(3, c + 2); P2_STEP(4, c + 3); P2_STEP(5, c + 4); P2_STEP(6, c + 5); P2_STEP(7, c + 6); P2_STEP(0, c + 7);
        }
#undef P2_STEP
#undef P2_LD
#undef P2_ST
    }
}
}

__device__ __forceinline__ void rwkv_post_ph(const int WID_, const float* __restrict__ Y, const float* __restrict__ RK, const bf16* __restrict__ proj, const float* __restrict__ mu, const bf16* __restrict__ G,
                             const float* __restrict__ lnw, const float* __restrict__ lnb, bf16* __restrict__ ymix) {
    const int lane = lane_id(), tk = WID_, grp = lane, ch0 = grp * 8, head = grp >> 3;
    const float4 mv0 = *(const float4*)(mu + 1024 + ch0), mv1 = *(const float4*)(mu + 1024 + ch0 + 4), lw0 = *(const float4*)(lnw + ch0), lw1 = *(const float4*)(lnw + ch0 + 4), lb0 = *(const float4*)(lnb + ch0), lb1 = *(const float4*)(lnb + ch0 + 4);
    const float muv[8] = {mv0.x, mv0.y, mv0.z, mv0.w, mv1.x, mv1.y, mv1.z, mv1.w}, lw_[8] = {lw0.x, lw0.y, lw0.z, lw0.w, lw1.x, lw1.y, lw1.z, lw1.w}, lb_[8] = {lb0.x, lb0.y, lb0.z, lb0.w, lb1.x, lb1.y, lb1.z, lb1.w};
    const int g_lo = GN == 256 ? (GB < 64 ? GB * 9 : 576 + ((GB - 64) * 3520) / 192) : (GB * (M / 16)) / GN;
    const int g_hi = GN == 256 ? (GB < 64 ? GB * 9 + 9 : 576 + ((GB - 63) * 3520) / 192) : ((GB + 1) * (M / 16)) / GN;
    for (int g = g_lo; g < g_hi; ++g) { const int m0 = g * 16 + tk;
        float4 ya[2], yb[2]; uint4 vv[2], pv[2], gg[2]; float rk[2];
#pragma unroll
        for (int u = 0; u < 2; ++u) { const int m = m0 + 8 * u;
            ya[u] = *(const float4*)(Y + (size_t)m * 512 + ch0); yb[u] = *(const float4*)(Y + (size_t)m * 512 + ch0 + 4);
            vv[u] = *(const uint4*)(proj + (size_t)m * DSHIFT + 1024 + ch0);
            pv[u] = (m & (S - 1)) ? *(const uint4*)(proj + (size_t)(m - 1) * DSHIFT + 1024 + ch0) : make_uint4(0, 0, 0, 0);
            gg[u] = *(const uint4*)(G + (size_t)m * 512 + ch0); rk[u] = RK[(size_t)m * 8 + head]; }
#pragma unroll
        for (int u = 0; u < 2; ++u) {
            const float y[8] = {ya[u].x, ya[u].y, ya[u].z, ya[u].w, yb[u].x, yb[u].y, yb[u].z, yb[u].w};
            float s = 0.f;
#pragma unroll
            for (int e = 0; e < 8; ++e) s += y[e];
            s += dpp16<0xB1>(s); s += dpp16<0x4E>(s); s += dpp16<0x141>(s);
            const float mean = s * (1.f / 64.f); float q = 0.f;
#pragma unroll
            for (int e = 0; e < 8; ++e) { const float d = y[e] - mean; q += d * d; }
            q += dpp16<0xB1>(q); q += dpp16<0x4E>(q); q += dpp16<0x141>(q);
            const float rstd = rsqrtf(q * (1.f / 64.f) + 64e-5f);
            const unsigned wv_[4] = {vv[u].x, vv[u].y, vv[u].z, vv[u].w}, wp_[4] = {pv[u].x, pv[u].y, pv[u].z, pv[u].w}, wg_[4] = {gg[u].x, gg[u].y, gg[u].z, gg[u].w};
            float o[8];
#pragma unroll
            for (int e = 0; e < 8; ++e) { const int w_ = e >> 1; const bool hi = e & 1;
                auto ex = [&](unsigned x) { return hi ? __builtin_bit_cast(float, x & 0xffff0000u) : __builtin_bit_cast(float, x << 16); };
                float v = ex(wv_[w_]); v += (ex(wp_[w_]) - v) * muv[e];
                o[e] = ((y[e] - mean) * rstd * lw_[e] + lb_[e] + rk[u] * v) * ex(wg_[w_]); }
            *(uint4*)(ymix + (size_t)(m0 + 8 * u) * D + ch0) = make_uint4(pk2(o[0], o[1]), pk2(o[2], o[3]), pk2(o[4], o[5]), pk2(o[6], o[7]));
        }
    }
}

constexpr int PSLOTS = NASSIGN + NEXP * 256;
constexpr int MAXTILES = PSLOTS / 256;
struct MoeBufs { int* tok_e; float* tok_g; int* tok_slot; int* slot_tok; float* slot_gate; int* bcnt; int* bbase; int* offs; int* tiles; int* ntiles; };
__device__ __forceinline__ void moe_zero_ph(const int WID_, const MoeBufs& mb) {
    for (int i = GB * NT + (WID_ * 64 + lane_id()); i < PSLOTS; i += GN * NT) { mb.slot_tok[i] = 0; mb.slot_gate[i] = 0.f; }
}
__device__ __forceinline__ void router_ph(const int WID_, const float* __restrict__ x3, const float* __restrict__ nw, bf16* __restrict__ h3, const float* __restrict__ wrg, const float* __restrict__ brg,
                          const float* __restrict__ wre, const float* __restrict__ bre, const MoeBufs& mb, char* lds, int tile) {
    const int lane = lane_id(), wv = WID_;
    int* lcnt = (int*)lds;
    _Float16* wg16 = (_Float16*)(lds + 256);
    _Float16* we16 = (_Float16*)(lds + 256 + 8192);
    if (wv == 0 && lane < 32) lcnt[lane] = 0;
    for (int i = wv * 64 + lane; i < 1024; i += NT) { const float4 w = *(const float4*)(wrg + i * 4);
        typedef _Float16 h4 __attribute__((ext_vector_type(4))); *(h4*)(wg16 + i * 4) = (h4){(_Float16)w.x, (_Float16)w.y, (_Float16)w.z, (_Float16)w.w}; }
    for (int i = wv * 64 + lane; i < 4 * 1024 * 2; i += NT) { const float4 w = *(const float4*)(wre + i * 4);
        typedef _Float16 h4 __attribute__((ext_vector_type(4))); *(h4*)(we16 + i * 4) = (h4){(_Float16)w.x, (_Float16)w.y, (_Float16)w.z, (_Float16)w.w}; }
    __syncthreads();
    typedef _Float16 h4 __attribute__((ext_vector_type(4)));
    typedef _Float16 h8 __attribute__((ext_vector_type(8)));
    for (int m = tile * 256 + wv; m < tile * 256 + 256; m += 8) {
        const float4* xr = (const float4*)(x3 + (size_t)m * D);
        float h[16]; float s = 0.f;
#pragma unroll
        for (int j = 0; j < 4; ++j) { const float4 v = xr[lane + 64 * j]; h[4 * j] = v.x; h[4 * j + 1] = v.y; h[4 * j + 2] = v.z; h[4 * j + 3] = v.w; s += v.x * v.x + v.y * v.y + v.z * v.z + v.w * v.w; }
        s = wave_sum(s);
        const float rs = rsqrtf(s * (1.f / D) + 1e-6f);
        float l1[4] = {0.f, 0.f, 0.f, 0.f};
#pragma unroll
        for (int j = 0; j < 4; ++j) {
            const int k0 = (lane + 64 * j) * 4;
            const float4 g = *(const float4*)(nw + k0);
            h[4 * j] *= rs * g.x; h[4 * j + 1] *= rs * g.y; h[4 * j + 2] *= rs * g.z; h[4 * j + 3] *= rs * g.w;
            uint2 o; o.x = pk2(h[4 * j], h[4 * j + 1]); o.y = pk2(h[4 * j + 2], h[4 * j + 3]);
            *(uint2*)(h3 + (size_t)m * D + k0) = o;
#pragma unroll
            for (int e = 0; e < 4; ++e) { const h4 w = *(const h4*)(wg16 + (k0 + e) * 4); const float x = h[4 * j + e];
                l1[0] += x * (float)w[0]; l1[1] += x * (float)w[1]; l1[2] += x * (float)w[2]; l1[3] += x * (float)w[3]; }
        }
#pragma unroll
        for (int i = 0; i < 4; ++i) l1[i] = wave_sum(l1[i]) + brg[i];
        int grp = 0; float best = l1[0];
#pragma unroll
        for (int i = 1; i < 4; ++i) if (l1[i] > best) { best = l1[i]; grp = i; }
        float se = 0.f;
#pragma unroll
        for (int i = 0; i < 4; ++i) se += __expf(l1[i] - best);
        const float g1 = 1.f / se;
        float l2[8] = {};
        const _Float16* we = we16 + (size_t)grp * D * 8;
#pragma unroll
        for (int j = 0; j < 4; ++j) {
            const int k0 = (lane + 64 * j) * 4;
#pragma unroll
            for (int e = 0; e < 4; ++e) { const float x = h[4 * j + e]; const h8 w = *(const h8*)(we + (k0 + e) * 8);
#pragma unroll
                for (int q = 0; q < 8; ++q) l2[q] += x * (float)w[q]; }
        }
#pragma unroll
        for (int i = 0; i < 8; ++i) l2[i] = wave_sum(l2[i]) + bre[grp * 8 + i];
        int i0 = 0; float v0 = l2[0];
#pragma unroll
        for (int i = 1; i < 8; ++i) if (l2[i] > v0) { v0 = l2[i]; i0 = i; }
        int i1 = -1; float v1 = -3.0e38f;
#pragma unroll
        for (int i = 0; i < 8; ++i) if (i != i0 && l2[i] > v1) { v1 = l2[i]; i1 = i; }
        const float e1 = __expf(v1 - v0), inv = 1.f / (1.f + e1);
        if (lane == 0) {
            const int ea = grp * 8 + i0, eb = grp * 8 + i1;
            mb.tok_e[2 * m] = ea; mb.tok_e[2 * m + 1] = eb;
            mb.tok_g[2 * m] = g1 * inv; mb.tok_g[2 * m + 1] = g1 * e1 * inv;
            atomicAdd(&lcnt[ea], 1); atomicAdd(&lcnt[eb], 1);
        }
    }
    __syncthreads();
    if (wv == 0 && lane < 32) mb.bcnt[tile * 32 + lane] = lcnt[lane];
    __syncthreads();
}
__device__ __forceinline__ void moe_plan_ph(const int WID_, const MoeBufs& mb, char* lds) {
    if (GB != 0) return;
    int* tot = (int*)lds; int* off = tot + 32;
    const int t = WID_ * 64 + lane_id();
    if (t < 32) { int run = 0; for (int b = 0; b < M / 256; ++b) { const int c = __hip_atomic_load(mb.bcnt + b * 32 + t, __ATOMIC_RELAXED, __HIP_MEMORY_SCOPE_AGENT); mb.bbase[b * 32 + t] = run; run += c; } tot[t] = run; }
    __syncthreads();
    if (t == 0) { int o = 0, nt = 0;
        for (int e = 0; e < NEXP; ++e) { off[e] = o; mb.offs[e] = o; const int c = tot[e]; for (int r0 = 0; r0 < c; r0 += 256) { mb.tiles[nt] = e; ++nt; } o += ((c + 255) / 256) * 256; }
        *mb.ntiles = nt; }
    __syncthreads();
}
__device__ __forceinline__ void moe_scatter_ph(const int WID_, const MoeBufs& mb, char* lds) {
    const int lane = lane_id(), wv = WID_;
    int* cur = (int*)lds;
    for (int tile = GB; tile < M / 256; tile += GN) {
        __syncthreads();
        if (wv == 0 && lane < 32) cur[lane] = __hip_atomic_load(mb.offs + lane, __ATOMIC_RELAXED, __HIP_MEMORY_SCOPE_AGENT) + __hip_atomic_load(mb.bbase + tile * 32 + lane, __ATOMIC_RELAXED, __HIP_MEMORY_SCOPE_AGENT);
        __syncthreads();
        const int a = tile * 512 + wv * 64 + lane; const int e = mb.tok_e[a];
        const int pos = atomicAdd(&cur[e], 1);
        mb.slot_tok[pos] = a >> 1; mb.slot_gate[pos] = mb.tok_g[a]; mb.tok_slot[a] = pos;
    }
    __syncthreads();
}
__device__ __forceinline__ void moe_weights_ph(const int WID_, const float* __restrict__ wg, const float* __restrict__ wu, const float* __restrict__ wd, bf16* __restrict__ wgu_t, bf16* __restrict__ wd_t, char* lds, int vb, int nvb) {
    const int lane = (WID_ * 64 + lane_id()) & 63, wv = (WID_ * 64 + lane_id()) >> 6;
    float* scr = (float*)(lds + wv * 16384);
    constexpr int I_GU = 16 * 16;
    constexpr int I_D = 8 * 32;
    constexpr int NIT = NEXP * (2 * I_GU + I_D);
    for (int it = vb * 8 + wv; it < NIT; it += nvb * 8) {
        const int e = it / (2 * I_GU + I_D); int r = it % (2 * I_GU + I_D);
        if (r < 2 * I_GU) {
            const int up = r / I_GU; r %= I_GU;
            const int kb = r / 16, nb = r % 16;
            const int pn = nb / 4, nsub = nb % 4;
            const float* W = (up ? wu : wg) + (size_t)e * D * DEXP + nb * 32;
            transpose_item(W + (size_t)kb * 64 * DEXP, 64, 32, wgu_t, D, e * 1024 + pn * 256 + up * 128 + nsub * 32, kb * 64, scr, 0, lane, nullptr, DEXP);
        } else {
            r -= 2 * I_GU;
            const int kb = r / 32, nb = r % 32;
            const float* W = wd + (size_t)e * DEXP * D + nb * 32;
            transpose_item(W + (size_t)kb * 64 * D, 64, 32, wd_t, DEXP, e * 1024 + nb * 32, kb * 64, scr, 0, lane, nullptr, D);
        }
    }
}
__device__ __forceinline__ void final_ph(const int WID_, float* __restrict__ out, const bf16* __restrict__ yslot, const int* __restrict__ tok_slot, const float* __restrict__ w) {
    const int lane = lane_id(), wv = WID_;
    float4 g[4];
#pragma unroll
    for (int j = 0; j < 4; ++j) g[j] = *(const float4*)(w + (lane + 64 * j) * 4);
    for (int row0 = (GB * 8 + wv) * 2; row0 < M; row0 += GN * 16) {
        float4 v[2][4]; uint2 ya[2][4], yb[2][4];
#pragma unroll
        for (int r = 0; r < 2; ++r) { const int row = row0 + r;
            const float4* xr = (const float4*)(out + (size_t)row * D);
            const uint2* pa = (const uint2*)(yslot + (size_t)tok_slot[2 * row] * D);
            const uint2* pb = (const uint2*)(yslot + (size_t)tok_slot[2 * row + 1] * D);
#pragma unroll
            for (int j = 0; j < 4; ++j) { v[r][j] = xr[lane + 64 * j]; ya[r][j] = pa[lane + 64 * j]; yb[r][j] = pb[lane + 64 * j]; } }
#pragma unroll
        for (int r = 0; r < 2; ++r) { float s = 0.f;
#pragma unroll
            for (int j = 0; j < 4; ++j) { const uint2 a = ya[r][j], b = yb[r][j];
                v[r][j].x += __builtin_bit_cast(float, a.x << 16) + __builtin_bit_cast(float, b.x << 16);
                v[r][j].y += __builtin_bit_cast(float, a.x & 0xffff0000u) + __builtin_bit_cast(float, b.x & 0xffff0000u);
                v[r][j].z += __builtin_bit_cast(float, a.y << 16) + __builtin_bit_cast(float, b.y << 16);
                v[r][j].w += __builtin_bit_cast(float, a.y & 0xffff0000u) + __builtin_bit_cast(float, b.y & 0xffff0000u);
                s += v[r][j].x * v[r][j].x + v[r][j].y * v[r][j].y + v[r][j].z * v[r][j].z + v[r][j].w * v[r][j].w; }
            s = wave_sum(s);
            const float rs = rsqrtf(s * (1.f / D) + 1e-6f);
            float4* xo = (float4*)(out + (size_t)(row0 + r) * D);
#pragma unroll
            for (int j = 0; j < 4; ++j) xo[lane + 64 * j] = make_float4(v[r][j].x * rs * g[j].x, v[r][j].y * rs * g[j].y, v[r][j].z * rs * g[j].z, v[r][j].w * rs * g[j].w); }
    }
}

struct S5Tab { float* Kmat; bf16* BtA; bf16* BtB; };
__device__ __forceinline__ void s5_lam(const float* lam_re, const float* lam_im, const float* log_dt, int g, int n, float& a, float& w) {
    const float dt = __expf(log_dt[g]); a = lam_re[g * 64 + n] * dt; w = lam_im[g * 64 + n] * dt;
}
__device__ __forceinline__ void cexpj(float a, float w, float j, float& re, float& im) { const float e = __expf(a * j); float s, c; sincosf(w * j, &s, &c); re = e * c; im = e * s; }
__device__ __forceinline__ void s5_bbar(const float* lam_re, const float* lam_im, const float* log_dt, const float* b_re, const float* b_im, int g, int n, int h, float& br, float& bi) {
    float a, w; s5_lam(lam_re, lam_im, log_dt, g, n, a, w);
    float lbr, lbi; cexpj(a, w, 1.f, lbr, lbi);
    const float lr = lam_re[g * 64 + n], li = lam_im[g * 64 + n];
    const float nr = lbr - 1.f, ni = lbi, den = lr * lr + li * li;
    const float cr = (nr * lr + ni * li) / den, ci = (ni * lr - nr * li) / den;
    const float xr = b_re[(g * 64 + n) * 16 + h], xi = b_im[(g * 64 + n) * 16 + h];
    br = cr * xr - ci * xi; bi = cr * xi + ci * xr;
}
__device__ __forceinline__ void s5_tables0_ph(const int WID_, const float* lam_re, const float* lam_im, const float* log_dt, const float* b_re, const float* b_im, const float* c_re, const float* c_im, const S5Tab& T, char* lds) {
    float* PWR = (float*)lds; float* PWI = PWR + 64 * 34;
    float* BBR = PWI + 64 * 34; float* BBI = BBR + 64 * 16;
    float* CCR = BBI + 64 * 16; float* CCI = CCR + 16 * 64;
    const int tid = WID_ * 64 + lane_id();
    for (int item = GB; item < 32 * 8; item += GN) {
        const int g = item & 31, part = item >> 5;
        __syncthreads();
        for (int i = tid; i < 64 * 34; i += NT) { const int n = i / 34, j = i % 34; float a, w; s5_lam(lam_re, lam_im, log_dt, g, n, a, w); float pr, pi; cexpj(a, w, (float)j, pr, pi); PWR[i] = pr; PWI[i] = pi; }
        for (int i = tid; i < 64 * 16; i += NT) { const int n = i >> 4, h = i & 15; float br, bi; s5_bbar(lam_re, lam_im, log_dt, b_re, b_im, g, n, h, br, bi); BBR[i] = br; BBI[i] = bi;
            const int hp = i >> 6, n2 = i & 63; CCR[i] = c_re[(g * 16 + hp) * 64 + n2]; CCI[i] = c_im[(g * 16 + hp) * 64 + n2]; }
        __syncthreads();
        for (int i = tid; i < 4 * 256; i += NT) { const int h = i & 15, hp = (i >> 4) & 15, j = 4 * part + (i >> 8);
            float acc = 0.f;
            for (int n = 0; n < 64; ++n) { const float pr = PWR[n * 34 + j], pi = PWI[n * 34 + j], br = BBR[n * 16 + h], bi = BBI[n * 16 + h];
                const float tr = pr * br - pi * bi, ti = pr * bi + pi * br; acc += CCR[hp * 64 + n] * tr - CCI[hp * 64 + n] * ti; }
            T.Kmat[((g * 32 + j) * 16 + hp) * 16 + h] = acc; }
        for (int i = tid; i < 32 * 512; i += NT) { const int col = i & 511, r = 32 * part + (i >> 9); float v = 0.f;
            if (r < 128) { const int n = r & 63, s = col >> 4, h = col & 15; const float pr = PWR[n * 34 + (S5L - 1 - s)], pi = PWI[n * 34 + (S5L - 1 - s)], br = BBR[n * 16 + h], bi = BBI[n * 16 + h];
                v = (r < 64) ? (pr * br - pi * bi) : (pr * bi + pi * br); }
            T.BtA[((size_t)g * 768 + 512 + r) * 512 + col] = f2bf(v); }
        for (int i = tid; i < 64 * 256; i += NT) { const int k = i & 255, row = 64 * part + (i >> 8); float v = 0.f;
            if (k < 128) { const int n = k & 63, sp = row >> 4, hp = row & 15; const float pr = PWR[n * 34 + sp + 1], pi = PWI[n * 34 + sp + 1], cr = CCR[hp * 64 + n], ci = CCI[hp * 64 + n];
                v = (k < 64) ? (cr * pr - ci * pi) : -(cr * pi + ci * pr); }
            T.BtB[((size_t)g * 512 + row) * 256 + k] = f2bf(v); }
    }
    __syncthreads();
}
__device__ __forceinline__ void s5_tables1_ph(const int WID_, const float* dsk, const S5Tab& T) {
    const int gtid = GB * NT + (WID_ * 64 + lane_id()), gsz = GN * NT;
    for (int i = gtid; i < 32 * 512 * 512; i += gsz) {
        const int col = i & 511, row = (i >> 9) & 511, g = i >> 18;
        const int sp = row >> 4, hp = row & 15, s = col >> 4, h = col & 15;
        float v = 0.f;
        if (s <= sp) v = T.Kmat[((g * 32 + (sp - s)) * 16 + hp) * 16 + h];
        if (row == col) v += dsk[g * 16 + hp];
        T.BtA[((size_t)g * 768 + row) * 512 + col] = f2bf(v);
    }
}
__device__ __forceinline__ void s5_carry_ph(const int WID_, const float* lam_re, const float* lam_im, const float* log_dt, const float* __restrict__ F, bf16* __restrict__ XST, int vb, int nvb, char* lds) {
    float* TR = (float*)lds; float* TI = TR + 16 * 32;
    for (int item = vb; item < NB * 32 * 2; item += nvb) {
        const int lane = lane_id(), tid = WID_ * 64 + lane;
        const int nh = item & 1, g = (item >> 1) & 31, b = item >> 6, seg = tid >> 5, n = nh * 32 + (tid & 31);
        float a, w; s5_lam(lam_re, lam_im, log_dt, g, n, a, w);
        float pr, pi; cexpj(a, w, (float)S5L, pr, pi);
        const size_t row0 = (size_t)g * S5R + (size_t)b * (S / S5L) + seg * 16;
        const float* f = F + row0 * 128; bf16* xo = XST + row0 * 256;
        float fr[16], fi[16];
#pragma unroll
        for (int q = 0; q < 16; ++q) { fr[q] = f[(size_t)q * 128 + n]; fi[q] = f[(size_t)q * 128 + 64 + n]; }
#pragma unroll
        for (int q = 0; q < 16; ++q) if (nh == 0) *(uint2*)(xo + (size_t)q * 256 + 128 + (tid & 31) * 4) = make_uint2(0, 0);
        float xr = 0.f, xi = 0.f;
#pragma unroll
        for (int q = 0; q < 16; ++q) { const float nr = pr * xr - pi * xi + fr[q], ni = pr * xi + pi * xr + fi[q]; xr = nr; xi = ni; fr[q] = nr; fi[q] = ni; }
        TR[seg * 32 + (tid & 31)] = xr; TI[seg * 32 + (tid & 31)] = xi;
        __syncthreads();
        float p16r, p16i; cexpj(a, w, (float)(S5L * 16), p16r, p16i);
        float cr = 0.f, ci = 0.f;
        for (int s2 = 0; s2 < seg; ++s2) { const float tr = TR[s2 * 32 + (tid & 31)], ti = TI[s2 * 32 + (tid & 31)];
            const float nr = p16r * cr - p16i * ci + tr, ni = p16r * ci + p16i * cr + ti; cr = nr; ci = ni; }
        float er = cr, ei = ci;
#pragma unroll
        for (int q = 0; q < 16; ++q) {
            const float lr_ = (q > 0) ? fr[q - 1] : 0.f, li_ = (q > 0) ? fi[q - 1] : 0.f;
            xo[(size_t)q * 256 + n] = f2bf(er + lr_); xo[(size_t)q * 256 + 64 + n] = f2bf(ei + li_);
            const float nr = pr * er - pi * ei, ni = pr * ei + pi * er; er = nr; ei = ni;
        }
        __syncthreads();
    }
}
#define XB_TMO      128
#define XB_XCNT(j)  (256  + 64 * (j))
#define XB_XSUB(j)  (1280 + 64 * (j))
#define XB_XGEN(j)  (2304 + 64 * (j))
#define XB_TOP      3328
#define XB_TOPGEN   3392
#define XCD_BAR_WORDS 3456
#define XB_SPIN_CAP (1u << 20)
__device__ __forceinline__ unsigned xb_ld(unsigned* p)              { return __hip_atomic_load(p, __ATOMIC_RELAXED, __HIP_MEMORY_SCOPE_AGENT); }
__device__ __forceinline__ unsigned xb_add(unsigned* p, unsigned v) { return __hip_atomic_fetch_add(p, v, __ATOMIC_RELAXED, __HIP_MEMORY_SCOPE_AGENT); }
__device__ __forceinline__ unsigned xb_xcc_id() { return (unsigned)__builtin_amdgcn_s_getreg((3 << 11) | 20) & 0xFu; }
#define XB_SPIN(cond, bar) do { unsigned _sp = 0; while (cond) { __builtin_amdgcn_s_sleep(1); \
    if ((++_sp & 255u) == 0u) { if (xb_ld(&(bar)[XB_TMO])) break; if (_sp > XB_SPIN_CAP) { atomicAdd(&(bar)[XB_TMO], 1u); break; } } } } while (0)
struct XcdBarrier { unsigned* bar; unsigned x; volatile __attribute__((address_space(3))) unsigned* st; };
__device__ __forceinline__ XcdBarrier xcd_barrier_post(const int WID_, unsigned* bar, volatile __attribute__((address_space(3))) unsigned* st) {
    XcdBarrier b; b.bar = bar; b.x = xb_xcc_id(); b.st = st;
    if ((WID_ * 64 + lane_id()) == 0) (void)xb_add(&bar[XB_XCNT(b.x)], 1u);
    return b;
}
__device__ __forceinline__ void xcd_barrier_complete(unsigned* bar, unsigned x, unsigned& nloc, unsigned& nx) {
    const unsigned G = gridDim.x * gridDim.y * gridDim.z;
    unsigned sum, cnt, mine, sp = 0u;
    for (;;) {
        sum = 0u; cnt = 0u; mine = 0u;
#pragma unroll
        for (unsigned j = 0; j < 16; ++j) { const unsigned c = xb_ld(&bar[XB_XCNT(j)]); sum += c; cnt += (c > 0u) ? 1u : 0u; mine = (j == x) ? c : mine; }
        if (sum == G) break;
        __builtin_amdgcn_s_sleep(1);
        if ((++sp & 255u) == 0u) { if (xb_ld(&bar[XB_TMO])) break; if (sp > XB_SPIN_CAP) { atomicAdd(&bar[XB_TMO], 1u); break; } }
    }
    nloc = mine > 0u ? mine : 1u; nx = cnt > 0u ? cnt : 1u;
}
__device__ __forceinline__ void xcd_barrier(const int WID_, const XcdBarrier& b) {
    asm volatile("s_waitcnt vmcnt(0)" ::: "memory");
    __syncthreads();
    if ((WID_ * 64 + lane_id()) == 0) {
        unsigned* bar = b.bar;
        __builtin_amdgcn_s_waitcnt(0);
        unsigned nloc = b.st[0], nx = b.st[1];
        if (nloc == 0u) { xcd_barrier_complete(bar, b.x, nloc, nx); b.st[0] = nloc; b.st[1] = nx; }
        const unsigned old = xb_add(&bar[XB_XSUB(b.x)], 1u);
        const unsigned gen = old / nloc;
        if (old + 1u == (gen + 1u) * nloc) {
            __builtin_amdgcn_fence(__ATOMIC_RELEASE, "agent");
            asm volatile("s_waitcnt vmcnt(0)" ::: "memory");
            const unsigned og = xb_add(&bar[XB_TOP], 1u);
            const unsigned tg = og / nx;
            if (og + 1u == (tg + 1u) * nx) xb_add(&bar[XB_TOPGEN], 1u);
            else XB_SPIN(xb_ld(&bar[XB_TOPGEN]) == tg, bar);
            __builtin_amdgcn_fence(__ATOMIC_ACQUIRE, "agent");
            xb_add(&bar[XB_XGEN(b.x)], 1u);
            asm volatile("s_waitcnt vmcnt(0)" ::: "memory");
        } else {
            XB_SPIN(xb_ld(&bar[XB_XGEN(b.x)]) == gen, bar);
            __builtin_amdgcn_fence(__ATOMIC_ACQUIRE, "agent");
            asm volatile("s_waitcnt vmcnt(0)" ::: "memory");
        }
    }
    __syncthreads();
}

struct Params { const float* in[41]; float* out; char* ws; };

constexpr size_t W_PROJ = 0;
constexpr size_t W_US5 = 224;
constexpr size_t W_WTS = 288;
constexpr size_t W_YI = 352;
constexpr size_t W_F = 416;
constexpr size_t W_XST = 448;
constexpr size_t W_Z = 480;
constexpr size_t W_MISC = 544;
constexpr size_t W_XN = 576;
constexpr size_t W_CTL = 558;
constexpr size_t WO_IN = 0, WO_GLU = 5 * MiB, WO_MIX = 6 * MiB, WO_Q = 8 * MiB, WO_K = 10 * MiB, WO_V = 12 * MiB, WO_O = 14 * MiB, WO_KMAT = 16 * MiB, WO_BTA = 17 * MiB, WO_BTB = 41 * MiB;

__global__ void __launch_bounds__(NT, 2) fwd_kernel(Params p) {
    extern __shared__ __attribute__((aligned(16))) char lds[];
    const int WID_ = __builtin_amdgcn_readfirstlane((int)(threadIdx.x >> 6));
    cg::grid_group grid = cg::this_grid();
    PG8_LAS unsigned char* ldsl = (PG8_LAS unsigned char*)lds;
    char* ws = p.ws; char* dout = (char*)p.out; float* out = p.out;
#define IN(i) (p.in[i])
    volatile __attribute__((address_space(3))) unsigned* bst = (volatile __attribute__((address_space(3))) unsigned*)(ldsl + LDS_BYTES - 64);
    if (WID_ == 0 && lane_id() < 2) bst[lane_id()] = 0u;
    __syncthreads();
    const XcdBarrier xbar = xcd_barrier_post(WID_, (unsigned*)(ws + W_CTL * MiB), bst);
#ifndef PROBE_PHASE
#define PROBE_PHASE -1
#endif
    int sync_id = 0; unsigned long long pr_t0 = 0, pr_t1 = 0;
    if (PROBE_PHASE == 0) pr_t0 = __builtin_amdgcn_s_memrealtime();
#define SYNC() do { xcd_barrier(WID_, xbar); ++sync_id; if (sync_id == PROBE_PHASE) pr_t0 = __builtin_amdgcn_s_memrealtime(); if (sync_id == PROBE_PHASE + 1) pr_t1 = __builtin_amdgcn_s_memrealtime(); } while (0)
    char* WT = ws + W_WTS * MiB;
    bf16* w_in_t = (bf16*)(WT + WO_IN); bf16* w_glu_t = (bf16*)(WT + WO_GLU); bf16* w_mix_t = (bf16*)(WT + WO_MIX);
    bf16* w_q_t = (bf16*)(WT + WO_Q); bf16* w_k_t = (bf16*)(WT + WO_K); bf16* w_v_t = (bf16*)(WT + WO_V); bf16* w_o_t = (bf16*)(WT + WO_O);
    S5Tab stab; stab.Kmat = (float*)(WT + WO_KMAT); stab.BtA = (bf16*)(WT + WO_BTA); stab.BtB = (bf16*)(WT + WO_BTB);
    bf16* PROJ = (bf16*)(ws + W_PROJ * MiB); bf16* US5 = (bf16*)(ws + W_US5 * MiB);
    bf16* XN = (bf16*)(ws + W_XN * MiB);
    transpose_ph(WID_, IN(3), D, DIN, w_in_t, D, 0, 0, lds);
    transpose_ph(WID_, IN(23), 512, 512, w_glu_t, 512, 0, 0, lds);
    transpose_ph(WID_, IN(25), D, D, w_mix_t, D, 0, 0, lds);
    transpose_ph(WID_, IN(28), D, D, w_q_t, D, 0, 0, lds);
    transpose_ph(WID_, IN(29), D, D, w_k_t, D, 0, 0, lds);
    transpose_ph(WID_, IN(30), D, D, w_v_t, D, 0, 0, lds);
    transpose_ph(WID_, IN(31), D, D, w_o_t, D, 0, 0, lds);
    s5_tables0_ph(WID_, IN(15), IN(16), IN(17), IN(18), IN(19), IN(20), IN(21), stab, lds);
    bf16* wl_t = (bf16*)(WT + 49 * MiB);
    rwkv_wl_ph(WID_, IN(6), IN(8), IN(9), wl_t);
    rmsnorm_ph<bf16>(WID_, IN(0), IN(2), XN, M);
    bf16* MEMN = (bf16*)(ws + (W_MISC + 10) * MiB);
    rmsnorm_ph<bf16>(WID_, IN(1), IN(27), MEMN, NB * NMEM);
    grid.sync(); ++sync_id; if (sync_id == PROBE_PHASE) pr_t0 = __builtin_amdgcn_s_memrealtime(); if (sync_id == PROBE_PHASE + 1) pr_t1 = __builtin_amdgcn_s_memrealtime();
    s5_tables1_ph(WID_, IN(22), stab);
    { pg8::PlainOrder S; S.init(XN, D, w_in_t, D, M, DIN, D); pg8::EpiProj E{PROJ, US5}; pg8::gemm_phase(WID_, ldsl, S, E); }
    SYNC();
    bf16* LIN = (bf16*)(ws + (W_MISC + 16) * MiB);
    rwkv_lin_ph(WID_, PROJ, IN(4), LIN);
    SYNC();
    bf16* YI = (bf16*)(ws + W_YI * MiB); float* F = (float*)(ws + W_F * MiB); bf16* XST = (bf16*)(ws + W_XST * MiB); bf16* Z = (bf16*)(ws + W_Z * MiB);
    bf16* LWb = (bf16*)(ws + 704 * MiB); bf16* AAb = (bf16*)(ws + 768 * MiB); bf16* Gb = (bf16*)(ws + 832 * MiB);
    float* Yr = (float*)(ws + 896 * MiB); float* RKb = (float*)(ws + W_MISC * MiB);
    { pg8::GroupOrder S; S.init(US5, 512, (size_t)S5R * 512, stab.BtA, 512, (size_t)768 * 512, 32, S5R, 768, 512); pg8::EpiS5a E{YI, F}; pg8::gemm_phase(WID_, ldsl, S, E); }
    { pg8::PlainOrder S; S.init(LIN, 256, wl_t, 256, M, 1536, 256); pg8::EpiLora E{LWb, (size_t)32 * MiB, IN(5), IN(7)}; pg8::gemm_phase(WID_, ldsl, S, E); }
    SYNC();
    { ck::In ci{PROJ, LWb, AAb, IN(4), IN(10), IN(11), IN(12), RKb, dout}; ck::phase1(WID_, ci, lds); }
    SYNC();
    bf16* WGU_t = (bf16*)(ws + 704 * MiB); bf16* WD_t = (bf16*)(ws + 768 * MiB);
    ck::phase2(WID_, dout, Yr, lds);
    __syncthreads();
    s5_carry_ph(WID_, IN(15), IN(16), IN(17), F, XST, GB, GN, lds);
    moe_weights_ph(WID_, IN(37), IN(38), IN(39), WGU_t, WD_t, lds, GB, GN);
    SYNC();
    bf16* YMIX = XN;
    bf16* KM = (bf16*)(ws + (W_MISC + 2) * MiB); bf16* VT = (bf16*)(ws + (W_MISC + 6) * MiB);
    { pg8::GroupOrder S; S.init(XST, 256, (size_t)S5R * 256, stab.BtB, 256, (size_t)512 * 256, 32, S5R, 512, 256); pg8::EpiS5b E{YI, Z}; pg8::gemm_phase(WID_, ldsl, S, E); }
    { pg8::PlainOrder S; S.init(MEMN, D, w_k_t, D, NB * NMEM, D, D); pg8::EpiBf16 E{KM, D}; pg8::gemm_phase(WID_, ldsl, S, E); }
    { pg8::PlainOrder S; S.init(w_v_t, D, MEMN, D, D, NB * NMEM, D, 32); pg8::EpiBf16 E{VT, NB * NMEM}; pg8::gemm_phase(WID_, ldsl, S, E); }
    rwkv_post_ph(WID_, Yr, RKb, PROJ, IN(4), Gb, IN(13), IN(14), YMIX);
    SYNC();
    bf16* XN2 = (bf16*)(ws + 0);
    bf16* Q = (bf16*)(ws + 128 * MiB);
    bf16* P = (bf16*)(ws + W_YI * MiB);
    bf16* O = (bf16*)(ws + 800 * MiB);
    bf16* H3 = XN;
    bf16* HID = (bf16*)(ws + 368 * MiB);
    bf16* YSLOT = (bf16*)(ws + 0);
#define MKMB(mb) MoeBufs mb; { char* mbase = p.ws + 976 * MiB; \
    mb.tok_e = (int*)(mbase); mb.tok_g = (float*)(mbase + 1 * MiB); mb.tok_slot = (int*)(mbase + 2 * MiB); mb.slot_tok = (int*)(mbase + 3 * MiB); \
    mb.slot_gate = (float*)(mbase + 4 * MiB); mb.bcnt = (int*)(mbase + 5 * MiB); mb.bbase = mb.bcnt + 16384; mb.offs = mb.bcnt + 32768; mb.ntiles = mb.offs + 64; \
    mb.tiles = (int*)(mbase + 6 * MiB); }
    { MKMB(mb); moe_zero_ph(WID_, mb); }
#define BLK_SYNC() do { asm volatile("s_waitcnt vmcnt(0)" ::: "memory"); __syncthreads(); \
        if (WID_ == 0 && lane_id() == 0) { __builtin_amdgcn_fence(__ATOMIC_ACQUIRE, "agent"); asm volatile("s_waitcnt vmcnt(0)" ::: "memory"); } __syncthreads(); } while (0)
    for (int tl = GB; tl < M / 256; tl += GN) {
        { pg8::TileOrder S; S.init(Z, 512, w_glu_t, 512, 512, 2, tl); pg8::EpiGlu E{Z, IN(24), YMIX}; pg8::gemm_phase(WID_, ldsl, S, E); }
        BLK_SYNC();
        { pg8::TileOrder S; S.init(YMIX, D, w_mix_t, D, D, 4, tl); pg8::EpiF32 E{out, D, IN(0), D}; pg8::gemm_phase(WID_, ldsl, S, E); }
        BLK_SYNC();
        rmsnorm_ph<bf16>(WID_, out, IN(26), XN2, tl * 256 + 256, tl * 256, 0, 1);
        BLK_SYNC();
        { pg8::TileOrder S; S.init(XN2, D, w_q_t, D, D, 4, tl); pg8::EpiBf16 E{Q, D}; pg8::gemm_phase(WID_, ldsl, S, E); }
        BLK_SYNC();
        { pg8::AttnTileOrder S; S.init(Q, KM, D, 0, tl); pg8::EpiSoftmax E{P, (PG8_LAS float*)(ldsl + 131072)}; pg8::gemm_phase(WID_, ldsl, S, E); }
        BLK_SYNC();
        { pg8::AttnTileOrder S; S.init(P, VT, NB * NMEM, 1, tl); pg8::EpiAttnO E{O}; pg8::gemm_phase(WID_, ldsl, S, E); }
        BLK_SYNC();
        { pg8::TileOrder S; S.init(O, D, w_o_t, D, D, 4, tl); pg8::EpiF32 E{out, D, out, D}; pg8::gemm_phase(WID_, ldsl, S, E); }
        BLK_SYNC();
        { MKMB(mb); router_ph(WID_, p.out, IN(32), (bf16*)(p.ws + W_XN * MiB), IN(33), IN(34), IN(35), IN(36), mb, lds, tl); }
    }
    SYNC();
    { MKMB(mb); moe_plan_ph(WID_, mb, lds); }
    SYNC();
    { MKMB(mb); moe_scatter_ph(WID_, mb, lds); }
    MKMB(mb);
    SYNC();
    const int ntiles = __hip_atomic_load(mb.ntiles, __ATOMIC_RELAXED, __HIP_MEMORY_SCOPE_AGENT);
    { pg8::MoeOrderT<true> S; S.init(H3, D, WGU_t, D, D, mb.tiles, ntiles, 1024, mb.slot_tok); pg8::EpiSilu E{HID}; pg8::gemm_phase(WID_, ldsl, S, E); }
    SYNC();
    { pg8::MoeOrderT<false> S; S.init(HID, DEXP, WD_t, DEXP, DEXP, mb.tiles, ntiles, 1024, nullptr); pg8::EpiGate E{YSLOT, mb.slot_gate}; pg8::gemm_phase(WID_, ldsl, S, E); }
    SYNC();
    final_ph(WID_, out, YSLOT, mb.tok_slot, IN(40));
    if (PROBE_PHASE >= 0) {
        if (pr_t1 == 0) pr_t1 = __builtin_amdgcn_s_memrealtime();
        if (GB == 0) { const unsigned long long t_end = __builtin_amdgcn_s_memrealtime(), wait = 8ull * (pr_t1 - pr_t0);
            while (__builtin_amdgcn_s_memrealtime() - t_end < wait) __builtin_amdgcn_s_sleep(8); }
    }
}
}

extern "C" void kernel_launch(void* const* d_in, const int* in_sizes, int n_in, void* d_out, int out_size, void* d_ws, size_t ws_size, hipStream_t stream) {
    (void)in_sizes; (void)out_size; (void)ws_size;
    static int grid = 0;
    if (grid == 0) {
        int dev = 0, cus = 0, per_cu = 0;
        hipGetDevice(&dev);
        hipDeviceGetAttribute(&cus, hipDeviceAttributeMultiprocessorCount, dev);
        hipFuncSetAttribute((const void*)fwd_kernel, hipFuncAttributeMaxDynamicSharedMemorySize, LDS_BYTES);
        hipOccupancyMaxActiveBlocksPerMultiprocessor(&per_cu, (const void*)fwd_kernel, NT, LDS_BYTES);
        if (per_cu < 1) { fprintf(stderr, "occupancy query says %d blocks/CU\n", per_cu); per_cu = 1; }
        grid = cus * 1;
    }
    (void)hipMemsetAsync((char*)d_ws + W_CTL * MiB, 0, 16384, stream);
    Params p{};
    for (int i = 0; i < 41 && i < n_in; ++i) p.in[i] = (const float*)d_in[i];
    p.out = (float*)d_out; p.ws = (char*)d_ws;
    void* args[] = {&p};
    hipError_t e = hipLaunchCooperativeKernel((const void*)fwd_kernel, dim3(grid), dim3(NT), args, LDS_BYTES, stream);
    if (e != hipSuccess) fprintf(stderr, "cooperative launch failed: %s (grid %d)\n", hipGetErrorString(e), grid);
}
```

```cpp
#include <hip/hip_runtime.h>
#include <hip/hip_cooperative_groups.h>
#include <stdint.h>
#include <cstdio>
namespace cg = cooperative_groups;

namespace {
constexpr int NB = 8, S = 8192, D = 1024, M = NB * S;
constexpr int DR = 512, DSHIFT = 1792, DIN = 2304, NMEM = 256;
constexpr int NEXP = 32, DEXP = 512, NASSIGN = 2 * M;
constexpr size_t MiB = 1u << 20;
constexpr int NT = 512;
constexpr int S5L = 32, S5R = M / S5L;
constexpr int LDS_BYTES = 147456;
#define GB ((int)blockIdx.x)
#define GN ((int)gridDim.x)

typedef unsigned short bf16;
typedef float f32x2h __attribute__((ext_vector_type(2)));
typedef __bf16 bf16x2h __attribute__((ext_vector_type(2)));
__device__ __forceinline__ unsigned pk2(float lo, float hi) { const f32x2h v = {lo, hi}; const bf16x2h b = __builtin_convertvector(v, bf16x2h); return __builtin_bit_cast(unsigned, b); }
__device__ __forceinline__ bf16 f2bf(float f) { return (bf16)(pk2(f, f) & 0xffffu); }
__device__ __forceinline__ int lane_id() { int l; asm volatile("v_mbcnt_lo_u32_b32 %0, -1, 0\n\tv_mbcnt_hi_u32_b32 %0, -1, %0" : "=v"(l)); return l; }
__device__ __forceinline__ float bf2f(bf16 h) { return __builtin_bit_cast(float, (unsigned)h << 16); }

template <typename T> __device__ __forceinline__ float ldf(const T* p);
template <> __device__ __forceinline__ float ldf<float>(const float* p) { return *p; }
template <> __device__ __forceinline__ float ldf<bf16>(const bf16* p) { return bf2f(*p); }
template <typename T> __device__ __forceinline__ void stf(T* p, float v);
template <> __device__ __forceinline__ void stf<float>(float* p, float v) { *p = v; }
template <> __device__ __forceinline__ void stf<bf16>(bf16* p, float v) { *p = f2bf(v); }

template <int CTRL, int ROWMASK> __device__ __forceinline__ float dppf_(float x) { return __builtin_bit_cast(float, __builtin_amdgcn_update_dpp(0, __builtin_bit_cast(int, x), CTRL, ROWMASK, 0xf, false)); }
__device__ __forceinline__ float wave_sum(float v) {
    v += dppf_<0xB1, 0xf>(v); v += dppf_<0x4E, 0xf>(v); v += dppf_<0x141, 0xf>(v); v += dppf_<0x140, 0xf>(v);
    v += dppf_<0x142, 0xa>(v);
    v += dppf_<0x143, 0xc>(v);
    return __builtin_bit_cast(float, __builtin_amdgcn_readlane(__builtin_bit_cast(int, v), 63));
}
__device__ __forceinline__ float sigmoidf_(float x) { return 1.f / (1.f + __expf(-x)); }


__device__ __forceinline__ float gelu_tanh(float x) { return x * sigmoidf_(1.5957691216057308f * (x + 0.044715f * x * x * x)); }

namespace pg8 {
#define PG8_LAS __attribute__((address_space(3)))
typedef short bf16x8 __attribute__((ext_vector_type(8)));
typedef float f32x4 __attribute__((ext_vector_type(4)));
typedef unsigned u32x4 __attribute__((ext_vector_type(4)));
constexpr int BM = 256, BK = 64, HALF = 128, HTB = HALF * BK * 2, STAGE_BYTES = 8 * HTB, NXCD = 8, WGM = 8;
__device__ __forceinline__ int lds_byte(int r, int c) { const int st = (r >> 4) * 2 + (c >> 5), rr = r & 15, cc = c & 31, ob = rr * 64 + cc * 2; return st * 1024 + (ob ^ (((ob >> 9) & 1) << 5)); }
__device__ __forceinline__ void stage_rc(int b, int& R, int& C) { const int st = b / 1024, sb = b % 1024, swz = sb ^ (((sb >> 9) & 1) << 5); R = (st >> 1) * 16 + swz / 64; C = (st & 1) * 32 + (swz % 64) / 2; }
__device__ __forceinline__ int perm32(int rho) { const int n = rho >> 4, i = rho & 15; return 8 * (i >> 2) + 4 * n + (i & 3); }
struct Unit { int pm, pn; };
struct PlainOrder {
    static constexpr bool GATHER = false; __device__ __forceinline__ int grow(const Unit&, int) const { return 0; }
    const bf16* A; const bf16* Bt; int lda, ldb, K; int nM, nN, nwg, G, c;
    __device__ void init(const bf16* A_, int lda_, const bf16* Bt_, int ldb_, int M, int N, int K_, int coff = 0) { A = A_; Bt = Bt_; lda = lda_; ldb = ldb_; K = K_; nM = M / BM; nN = N / BM; nwg = nM * nN; G = GN; c = (GB + GN - coff % GN) % GN; }
    __device__ bool next(int i, Unit& u) const {
        const long L = (long)i * G + c; if (L >= nwg) return false;
        int wgid = (int)L; { const int q = nwg / NXCD, r = nwg % NXCD, xcd = wgid % NXCD, off = wgid / NXCD; wgid = (xcd < r ? xcd * (q + 1) : r * (q + 1) + (xcd - r) * q) + off; }
        const int nig = WGM * nN, gid = wgid / nig, fm = gid * WGM, gsz = (nM - fm) < WGM ? (nM - fm) : WGM;
        u.pm = fm + ((wgid % nig) % gsz); u.pn = (wgid % nig) / gsz; return true;
    }
    __device__ __forceinline__ const char* aptr(const Unit& u) const { return (const char*)(A + (size_t)u.pm * BM * lda); }
    __device__ __forceinline__ const char* bptr(const Unit& u) const { return (const char*)(Bt + (size_t)u.pn * BM * ldb); }
};
typedef float f32x2c __attribute__((ext_vector_type(2)));
typedef __bf16 bf16x2c __attribute__((ext_vector_type(2)));
__device__ __forceinline__ unsigned cvt_pk_bf16(float lo, float hi) { const f32x2c v = {lo, hi}; const bf16x2c b = __builtin_convertvector(v, bf16x2c); return __builtin_bit_cast(unsigned, b); }

template <class Epi, class Sched>
__device__ __forceinline__ void gemm_phase(const int WID_, PG8_LAS unsigned char* lds, const Sched& S, const Epi& E) {
    const int tid = (WID_ * 64 + lane_id()), wid = __builtin_amdgcn_readfirstlane(tid >> 6), lane = tid & 63, wr = wid >> 2, wc = wid & 3, fr = lane & 15, fq = lane >> 4;
    const int K = S.K, nt = K / BK;
    unsigned voffA[2], voffB[2];
#pragma unroll
    for (int i = 0; i < 2; ++i) { int R, C; stage_rc(tid * 16 + i * 8192, R, C); const int Rb = Epi::PERM ? ((R & ~31) + perm32(R & 31)) : R;
        voffA[i] = (unsigned)(R * S.lda + C) * 2u; voffB[i] = (unsigned)(Rb * S.ldb + C) * 2u; }
    constexpr bool GA = Sched::GATHER;
    int gR[2], gC[2];
#pragma unroll
    for (int i = 0; i < 2; ++i) stage_rc(tid * 16 + i * 8192, gR[i], gC[i]);
    unsigned vgc[2][2] = {{0u, 0u}, {0u, 0u}}, vgn[2][2] = {{0u, 0u}, {0u, 0u}};
#define PG8_GOFF(dst, u) do { if constexpr (GA) { _Pragma("unroll") for (int h_ = 0; h_ < 2; ++h_) _Pragma("unroll") for (int i_ = 0; i_ < 2; ++i_) \
        dst[h_][i_] = (unsigned)(S.grow(u, h_ * HALF + gR[i_]) * S.lda + gC[i_]) * 2u; } } while (0)
    const size_t kstep = (size_t)(BK * 2);
    const size_t hstepA = GA ? 0 : (size_t)HALF * S.lda * 2, hstepB = (size_t)HALF * S.ldb * 2;
    const unsigned ldsw = (unsigned)wid * 1024u;
    const int aoff = lds_byte(wr * 64 + fr, fq * 8), boff = lds_byte(wc * 32 + fr, fq * 8);
#define PG8_SA(b, h) (((b) * 2 + (h)) * HTB)
#define PG8_SB(b, h) ((4 + (b) * 2 + (h)) * HTB)
#define PG8_STAGE(bufoff, gbase, voff) do { _Pragma("unroll") for (int _i = 0; _i < 2; ++_i) \
        __builtin_amdgcn_global_load_lds((const unsigned*)((const char*)(gbase) + (voff)[_i]), (PG8_LAS unsigned*)(lds + (bufoff) + ldsw + _i * 8192), 16, 0, 0); } while (0)
#define PG8_STAGE_A(bufoff, gbase, h, nx) do { _Pragma("unroll") for (int _i = 0; _i < 2; ++_i) { \
        const unsigned vo_ = GA ? ((nx) ? vgn[h][_i] : vgc[h][_i]) : voffA[_i]; \
        __builtin_amdgcn_global_load_lds((const unsigned*)((const char*)(gbase) + vo_), (PG8_LAS unsigned*)(lds + (bufoff) + ldsw + _i * 8192), 16, 0, 0); } } while (0)
#define PG8_LDA(dst, b, h) do { _Pragma("unroll") for (int m = 0; m < 4; ++m) _Pragma("unroll") for (int k = 0; k < 2; ++k) dst[m][k] = *(const PG8_LAS bf16x8*)(lds + PG8_SA(b, h) + aoff + m * 2048 + k * 1024); } while (0)
#define PG8_LDB(dst, b, h) do { _Pragma("unroll") for (int n = 0; n < 2; ++n) _Pragma("unroll") for (int k = 0; k < 2; ++k) dst[n][k] = *(const PG8_LAS bf16x8*)(lds + PG8_SB(b, h) + boff + n * 2048 + k * 1024); } while (0)
#define PG8_MMA(ai, bj, At, Bt) do { __builtin_amdgcn_s_setprio(1); _Pragma("unroll") for (int m = 0; m < 4; ++m) _Pragma("unroll") for (int n = 0; n < 2; ++n) _Pragma("unroll") for (int k = 0; k < 2; ++k) \
        acc[ai][bj][m][n] = __builtin_amdgcn_mfma_f32_16x16x32_bf16(Bt[n][k], At[m][k], acc[ai][bj][m][n], 0, 0, 0); __builtin_amdgcn_s_setprio(0); } while (0)
#define PG8_WAIT_V(n) asm volatile("s_waitcnt vmcnt(" #n ")" ::: "memory")
#define PG8_WAIT_L(n) asm volatile("s_waitcnt lgkmcnt(" #n ")" ::: "memory")
#define PG8_BAR __builtin_amdgcn_s_barrier()
#define PG8_SCHED __builtin_amdgcn_sched_barrier(0)
    Unit cur, nxt; int ui = 0;
    if (!S.next(0, cur)) return;
    f32x4 acc[2][2][4][2];
#pragma unroll
    for (int a = 0; a < 2; ++a)
#pragma unroll
        for (int b = 0; b < 2; ++b)
#pragma unroll
            for (int m = 0; m < 4; ++m)
#pragma unroll
                for (int n = 0; n < 2; ++n) acc[a][b][m][n] = (f32x4){0.f, 0.f, 0.f, 0.f};
    bf16x8 At[4][2], B0[2][2], B1[2][2];
    const char* cA = S.aptr(cur); const char* cB = S.bptr(cur);
    PG8_STAGE(PG8_SB(0, 0), cB, voffB); PG8_STAGE(PG8_SB(0, 1), cB + hstepB, voffB); PG8_GOFF(vgc, cur); PG8_STAGE_A(PG8_SA(0, 0), cA, 0, false); PG8_STAGE_A(PG8_SA(0, 1), cA + hstepA, 1, false);
    if (wr == 1) PG8_BAR;
    PG8_WAIT_V(2); PG8_BAR;
    PG8_STAGE(PG8_SB(1, 0), cB + kstep, voffB); PG8_STAGE_A(PG8_SA(1, 0), cA + kstep, 0, false); PG8_STAGE(PG8_SB(1, 1), cB + hstepB + kstep, voffB);
    PG8_WAIT_V(6); PG8_BAR;
    for (;;) {
        const bool has_next = S.next(ui + 1, nxt);
        const char* nA = has_next ? S.aptr(nxt) : cA; const char* nB = has_next ? S.bptr(nxt) : cB;
        if (has_next) PG8_GOFF(vgn, nxt); else { if constexpr (GA) { _Pragma("unroll") for (int h_ = 0; h_ < 2; ++h_) _Pragma("unroll") for (int i_ = 0; i_ < 2; ++i_) vgn[h_][i_] = vgc[h_][i_]; } }
        for (int t = 0; t < nt; t += 2) {
            const bool last = (t == nt - 2);
            const char* a1 = cA + (size_t)(t + 1) * kstep;
            const char* a2 = last ? nA : cA + (size_t)(t + 2) * kstep; const char* b2 = last ? nB : cB + (size_t)(t + 2) * kstep;
            const char* a3 = a2 + kstep; const char* b3 = b2 + kstep;
            PG8_LDB(B0, 0, 0); PG8_LDB(B1, 0, 1); PG8_SCHED; PG8_LDA(At, 0, 0); PG8_STAGE_A(PG8_SA(1, 1), a1 + hstepA, 1, false);
            PG8_WAIT_V(8); PG8_WAIT_L(0); PG8_BAR; PG8_MMA(0, 0, At, B0); PG8_MMA(0, 1, At, B1); PG8_BAR; PG8_SCHED;
            PG8_LDA(At, 0, 1); PG8_STAGE(PG8_SB(0, 0), b2, voffB); PG8_STAGE(PG8_SB(0, 1), b2 + hstepB, voffB); PG8_STAGE_A(PG8_SA(0, 0), a2, 0, last);
            PG8_WAIT_V(8); PG8_WAIT_L(0); PG8_BAR; PG8_MMA(1, 0, At, B0); PG8_MMA(1, 1, At, B1); PG8_BAR; PG8_SCHED;
            PG8_LDB(B0, 1, 0); PG8_LDB(B1, 1, 1); PG8_SCHED; PG8_LDA(At, 1, 0); PG8_STAGE_A(PG8_SA(0, 1), a2 + hstepA, 1, last);
            PG8_WAIT_V(8); PG8_WAIT_L(0); PG8_BAR; PG8_MMA(0, 0, At, B0); PG8_MMA(0, 1, At, B1); PG8_BAR; PG8_SCHED;
            PG8_LDA(At, 1, 1); PG8_STAGE(PG8_SB(1, 0), b3, voffB); PG8_STAGE(PG8_SB(1, 1), b3 + hstepB, voffB); PG8_STAGE_A(PG8_SA(1, 0), a3, 0, last);
            PG8_WAIT_V(8); PG8_WAIT_L(0); PG8_BAR; PG8_MMA(1, 0, At, B0); PG8_MMA(1, 1, At, B1); PG8_BAR; PG8_SCHED;
        }
        if (wr == 0) PG8_BAR;
        E(acc, cur, wr, wc, fr, fq);
        if (!has_next) break;
#pragma unroll
        for (int a = 0; a < 2; ++a)
#pragma unroll
            for (int b = 0; b < 2; ++b)
#pragma unroll
                for (int m = 0; m < 4; ++m)
#pragma unroll
                    for (int n = 0; n < 2; ++n) acc[a][b][m][n] = (f32x4){0.f, 0.f, 0.f, 0.f};
        cur = nxt; cA = nA; cB = nB; ++ui;
        if constexpr (GA) { _Pragma("unroll") for (int h_ = 0; h_ < 2; ++h_) _Pragma("unroll") for (int i_ = 0; i_ < 2; ++i_) vgc[h_][i_] = vgn[h_][i_]; }
        if (wr == 1) PG8_BAR;
    }
    PG8_WAIT_V(0);
    PG8_BAR;
#undef PG8_SA
#undef PG8_SB
#undef PG8_STAGE
#undef PG8_STAGE_A
#undef PG8_GOFF
#undef PG8_LDA
#undef PG8_LDB
#undef PG8_MMA
#undef PG8_WAIT_V
#undef PG8_WAIT_L
#undef PG8_BAR
#undef PG8_SCHED
}

struct EpiF32 {
    static constexpr bool PERM = false;
    float* C; int ldc; const float* R; int ldr;
    __device__ __forceinline__ void operator()(const f32x4 (&acc)[2][2][4][2], const Unit& u, int wr, int wc, int fr, int fq) const {
        const int row0 = u.pm * BM + wr * 64 + fr, col0 = u.pn * BM + wc * 32 + 4 * fq;
#pragma unroll
        for (int ai = 0; ai < 2; ++ai)
#pragma unroll
            for (int m = 0; m < 4; ++m) { const size_t row = (size_t)(row0 + ai * HALF + m * 16);
#pragma unroll
                for (int bj = 0; bj < 2; ++bj)
#pragma unroll
                    for (int n = 0; n < 2; ++n) { const int col = col0 + bj * HALF + 16 * n; f32x4 v = acc[ai][bj][m][n];
                        if (R) v = v + *(const f32x4*)(R + row * ldr + col);
                        *(f32x4*)(C + row * ldc + col) = v; } }
    }
};
struct EpiBf16 {
    static constexpr bool PERM = true;
    bf16* O; int ldc;
    __device__ __forceinline__ void operator()(const f32x4 (&acc)[2][2][4][2], const Unit& u, int wr, int wc, int fr, int fq) const {
        const int row0 = u.pm * BM + wr * 64 + fr, col0 = u.pn * BM + wc * 32 + 8 * fq;
#pragma unroll
        for (int ai = 0; ai < 2; ++ai)
#pragma unroll
            for (int m = 0; m < 4; ++m) { bf16* rowp = O + (size_t)(row0 + ai * HALF + m * 16) * ldc + col0;
#pragma unroll
                for (int bj = 0; bj < 2; ++bj) { const f32x4 v0 = acc[ai][bj][m][0], v1 = acc[ai][bj][m][1];
                    u32x4 w; w.x = cvt_pk_bf16(v0[0], v0[1]); w.y = cvt_pk_bf16(v0[2], v0[3]); w.z = cvt_pk_bf16(v1[0], v1[1]); w.w = cvt_pk_bf16(v1[2], v1[3]);
                    *(u32x4*)(rowp + bj * HALF) = w; } }
    }
};
struct EpiGlu {
    static constexpr bool PERM = true;
    const bf16* Z; const float* bias; bf16* YM;
    __device__ __forceinline__ void operator()(const f32x4 (&acc)[2][2][4][2], const Unit& u, int wr, int wc, int fr, int fq) const {
        const int row0 = u.pm * BM + wr * 64 + fr, col0 = u.pn * BM + wc * 32 + 8 * fq;
#pragma unroll
        for (int ai = 0; ai < 2; ++ai)
#pragma unroll
            for (int m = 0; m < 4; ++m) { const size_t row = (size_t)(row0 + ai * HALF + m * 16);
#pragma unroll
                for (int bj = 0; bj < 2; ++bj) { const int col = col0 + bj * HALF;
                    const u32x4 zz = *(const u32x4*)(Z + row * 512 + col);
                    const f32x4 b0 = *(const f32x4*)(bias + col), b1 = *(const f32x4*)(bias + col + 4);
                    const f32x4 v0 = acc[ai][bj][m][0] + b0, v1 = acc[ai][bj][m][1] + b1;
                    float o[8]; const unsigned zw[4] = {zz.x, zz.y, zz.z, zz.w};
#pragma unroll
                    for (int q = 0; q < 4; ++q) { const float zl = __builtin_bit_cast(float, zw[q] << 16), zh = __builtin_bit_cast(float, zw[q] & 0xffff0000u);
                        const float al = (q < 2) ? v0[2 * q] : v1[2 * q - 4], ah = (q < 2) ? v0[2 * q + 1] : v1[2 * q - 3];
                        o[2 * q] = zl * sigmoidf_(al); o[2 * q + 1] = zh * sigmoidf_(ah); }
                    u32x4 w; w.x = cvt_pk_bf16(o[0], o[1]); w.y = cvt_pk_bf16(o[2], o[3]); w.z = cvt_pk_bf16(o[4], o[5]); w.w = cvt_pk_bf16(o[6], o[7]);
                    *(u32x4*)(YM + row * D + 512 + col) = w; } }
    }
};

template <bool GATHER_>
struct MoeOrderT {
    static constexpr bool GATHER = GATHER_;
    const bf16* A; const bf16* Bt; int lda, ldb, K; const int* tiles; const int* rows; int nunits, G, c; size_t bexp;
    __device__ void init(const bf16* A_, int lda_, const bf16* Bt_, int ldb_, int K_, const int* tiles_, int ntiles, size_t bexp_, const int* rows_) { A = A_; Bt = Bt_; lda = lda_; ldb = ldb_; K = K_; tiles = tiles_; rows = rows_; nunits = ntiles * 4; G = GN; c = GB; bexp = bexp_; }
    __device__ bool next(int i, Unit& u) const { const int L = i * G + c; if (L >= nunits) return false; u.pm = L >> 2; u.pn = L & 3; return true; }
    __device__ __forceinline__ const char* aptr(const Unit& u) const { return GATHER ? (const char*)A : (const char*)(A + (size_t)u.pm * BM * lda); }
    __device__ __forceinline__ int grow(const Unit& u, int r) const { return rows[u.pm * BM + r]; }
    __device__ __forceinline__ const char* bptr(const Unit& u) const { const int e = __hip_atomic_load(tiles + u.pm, __ATOMIC_RELAXED, __HIP_MEMORY_SCOPE_AGENT); return (const char*)(Bt + ((size_t)e * bexp + (size_t)u.pn * BM) * ldb); }
};
struct EpiSilu {
    static constexpr bool PERM = true;
    bf16* HID;
    __device__ __forceinline__ void operator()(const f32x4 (&acc)[2][2][4][2], const Unit& u, int wr, int wc, int fr, int fq) const {
        const int row0 = u.pm * BM + wr * 64 + fr, col0 = u.pn * HALF + wc * 32 + 8 * fq;
#pragma unroll
        for (int ai = 0; ai < 2; ++ai)
#pragma unroll
            for (int m = 0; m < 4; ++m) { const size_t row = (size_t)(row0 + ai * HALF + m * 16);
                float o[8];
#pragma unroll
                for (int n = 0; n < 2; ++n)
#pragma unroll
                    for (int q = 0; q < 4; ++q) { const float g = acc[ai][0][m][n][q], up = acc[ai][1][m][n][q]; o[4 * n + q] = g * sigmoidf_(g) * up; }
                u32x4 w; w.x = cvt_pk_bf16(o[0], o[1]); w.y = cvt_pk_bf16(o[2], o[3]); w.z = cvt_pk_bf16(o[4], o[5]); w.w = cvt_pk_bf16(o[6], o[7]);
                *(u32x4*)(HID + row * DEXP + col0) = w; }
    }
};
struct EpiGate {
    static constexpr bool PERM = true;
    bf16* Y; const float* gate;
    __device__ __forceinline__ void operator()(const f32x4 (&acc)[2][2][4][2], const Unit& u, int wr, int wc, int fr, int fq) const {
        const int row0 = u.pm * BM + wr * 64 + fr, col0 = u.pn * BM + wc * 32 + 8 * fq;
#pragma unroll
        for (int ai = 0; ai < 2; ++ai)
#pragma unroll
            for (int m = 0; m < 4; ++m) { const size_t row = (size_t)(row0 + ai * HALF + m * 16); const float gt = gate[row];
#pragma unroll
                for (int bj = 0; bj < 2; ++bj) { const f32x4 v0 = acc[ai][bj][m][0] * gt, v1 = acc[ai][bj][m][1] * gt;
                    u32x4 w; w.x = cvt_pk_bf16(v0[0], v0[1]); w.y = cvt_pk_bf16(v0[2], v0[3]); w.z = cvt_pk_bf16(v1[0], v1[1]); w.w = cvt_pk_bf16(v1[2], v1[3]);
                    *(u32x4*)(Y + row * D + col0 + bj * HALF) = w; } }
    }
};

struct EpiProj {
    static constexpr bool PERM = true;
    bf16* PROJ; bf16* US5;
    __device__ __forceinline__ void operator()(const f32x4 (&acc)[2][2][4][2], const Unit& u, int wr, int wc, int fr, int fq) const {
        const int row0 = u.pm * BM + wr * 64 + fr, col0 = u.pn * BM + wc * 32 + 8 * fq;
#pragma unroll
        for (int ai = 0; ai < 2; ++ai)
#pragma unroll
            for (int m = 0; m < 4; ++m) { const size_t row = (size_t)(row0 + ai * HALF + m * 16);
#pragma unroll
                for (int bj = 0; bj < 2; ++bj) { const f32x4 v0 = acc[ai][bj][m][0], v1 = acc[ai][bj][m][1]; const int col = col0 + bj * HALF;
                    u32x4 w; w.x = cvt_pk_bf16(v0[0], v0[1]); w.y = cvt_pk_bf16(v0[2], v0[3]); w.z = cvt_pk_bf16(v1[0], v1[1]); w.w = cvt_pk_bf16(v1[2], v1[3]);
                    if (col < DSHIFT) *(u32x4*)(PROJ + row * DSHIFT + col) = w;
                    else { const int cc = col - DSHIFT; *(u32x4*)(US5 + ((size_t)(cc >> 4) * M + row) * 16 + (cc & 15)) = w; } } }
    }
};
struct GroupOrder {
    static constexpr bool GATHER = false; __device__ __forceinline__ int grow(const Unit&, int) const { return 0; }
    const bf16* A; const bf16* Bt; int lda, ldb, K; int nM, nN, nunits, G, c; size_t sA, sB;
    __device__ void init(const bf16* A_, int lda_, size_t sA_, const bf16* Bt_, int ldb_, size_t sB_, int ngroups, int Mg, int Ng, int K_) {
        A = A_; Bt = Bt_; lda = lda_; ldb = ldb_; K = K_; sA = sA_; sB = sB_; nM = Mg / BM; nN = Ng / BM; nunits = ngroups * nM * nN; G = GN; c = GB; }
    __device__ bool next(int i, Unit& u) const { const int L = i * G + c; if (L >= nunits) return false; u.pn = L % nN; u.pm = L / nN; return true; }
    __device__ __forceinline__ const char* aptr(const Unit& u) const { const int g = u.pm / nM, pm = u.pm % nM; return (const char*)(A + (size_t)g * sA + (size_t)pm * BM * lda); }
    __device__ __forceinline__ const char* bptr(const Unit& u) const { const int g = u.pm / nM; return (const char*)(Bt + (size_t)g * sB + (size_t)u.pn * BM * ldb); }
};
struct EpiS5a {
    static constexpr bool PERM = false;
    bf16* YI; float* F;
    __device__ __forceinline__ void operator()(const f32x4 (&acc)[2][2][4][2], const Unit& u, int wr, int wc, int fr, int fq) const {
        const int row0 = u.pm * BM + wr * 64 + fr, col0 = u.pn * BM + wc * 32 + 4 * fq;
#pragma unroll
        for (int ai = 0; ai < 2; ++ai)
#pragma unroll
            for (int m = 0; m < 4; ++m) { const size_t row = (size_t)(row0 + ai * HALF + m * 16);
#pragma unroll
                for (int bj = 0; bj < 2; ++bj)
#pragma unroll
                    for (int n = 0; n < 2; ++n) { const int col = col0 + bj * HALF + 16 * n; const f32x4 v = acc[ai][bj][m][n];
                        if (col < 512) { uint2 w; w.x = cvt_pk_bf16(v[0], v[1]); w.y = cvt_pk_bf16(v[2], v[3]); *(uint2*)(YI + row * 512 + col) = w; }
                        else if (col < 640) *(f32x4*)(F + row * 128 + (col - 512)) = v; } }
    }
};
struct EpiS5b {
    static constexpr bool PERM = true;
    const bf16* YI; bf16* Z;
    __device__ __forceinline__ void operator()(const f32x4 (&acc)[2][2][4][2], const Unit& u, int wr, int wc, int fr, int fq) const {
        const int row0 = u.pm * BM + wr * 64 + fr, col0 = u.pn * BM + wc * 32 + 8 * fq;
#pragma unroll
        for (int ai = 0; ai < 2; ++ai)
#pragma unroll
            for (int m = 0; m < 4; ++m) { const int row = row0 + ai * HALF + m * 16; const int g = row / S5R, rl = row % S5R;
#pragma unroll
                for (int bj = 0; bj < 2; ++bj) { const int col = col0 + bj * HALF;
                    const u32x4 yi = *(const u32x4*)(YI + (size_t)row * 512 + col);
                    const unsigned yw[4] = {yi.x, yi.y, yi.z, yi.w};
                    const f32x4 v0 = acc[ai][bj][m][0], v1 = acc[ai][bj][m][1];
                    float o[8];
#pragma unroll
                    for (int q = 0; q < 4; ++q) { const float al = (q < 2) ? v0[2 * q] : v1[2 * q - 4], ah = (q < 2) ? v0[2 * q + 1] : v1[2 * q - 3];
                        o[2 * q] = gelu_tanh(al + __builtin_bit_cast(float, yw[q] << 16)); o[2 * q + 1] = gelu_tanh(ah + __builtin_bit_cast(float, yw[q] & 0xffff0000u)); }
                    u32x4 w; w.x = cvt_pk_bf16(o[0], o[1]); w.y = cvt_pk_bf16(o[2], o[3]); w.z = cvt_pk_bf16(o[4], o[5]); w.w = cvt_pk_bf16(o[6], o[7]);
                    const size_t tok = (size_t)rl * S5L + (col >> 4);
                    *(u32x4*)(Z + tok * 512 + g * 16 + (col & 15)) = w; } }
    }
};
struct AttnOrder {
    static constexpr bool GATHER = false; __device__ __forceinline__ int grow(const Unit&, int) const { return 0; }
    const bf16* A; const bf16* Bt; int lda, ldb, K; int G, c; int mode;
    __device__ void init(const bf16* A_, const bf16* Bt_, int ldb_, int mode_) { A = A_; Bt = Bt_; lda = D; ldb = ldb_; K = 256; G = GN; c = GB; mode = mode_; }
    __device__ bool next(int i, Unit& u) const { const int L = i * G + c; if (L >= NB * 4 * 32) return false; u.pn = L & 3; u.pm = L >> 2; return true; }
    __device__ __forceinline__ const char* aptr(const Unit& u) const { return (const char*)(A + (size_t)u.pm * BM * D + u.pn * 256); }
    __device__ __forceinline__ const char* bptr(const Unit& u) const { const int b = u.pm >> 5;
        return (const char*)(mode == 0 ? Bt + (size_t)b * 256 * ldb + u.pn * 256 : Bt + (size_t)u.pn * 256 * ldb + b * 256); }
};
struct EpiSoftmax {
    static constexpr bool PERM = true;
    bf16* P; PG8_LAS float* scr;
    __device__ __forceinline__ void operator()(f32x4 (&acc)[2][2][4][2], const Unit& u, int wr, int wc, int fr, int fq) const {
        const float SC = 0.0625f * 1.4426950408889634f;
        PG8_LAS float* smax = scr; PG8_LAS float* ssum = scr + 1024;
#pragma unroll
        for (int ai = 0; ai < 2; ++ai)
#pragma unroll
            for (int m = 0; m < 4; ++m) { float t = -3.0e38f;
#pragma unroll
                for (int bj = 0; bj < 2; ++bj)
#pragma unroll
                    for (int n = 0; n < 2; ++n) { const f32x4 v = acc[ai][bj][m][n]; t = fmaxf(t, fmaxf(fmaxf(v[0], v[1]), fmaxf(v[2], v[3]))); }
                t = fmaxf(t, __shfl_xor(t, 16)); t = fmaxf(t, __shfl_xor(t, 32));
                if (fq == 0) smax[(ai * HALF + wr * 64 + m * 16 + fr) * 4 + wc] = t; }
        asm volatile("s_waitcnt lgkmcnt(0)" ::: "memory"); __builtin_amdgcn_s_barrier(); asm volatile("" ::: "memory");
#pragma unroll
        for (int ai = 0; ai < 2; ++ai)
#pragma unroll
            for (int m = 0; m < 4; ++m) { const f32x4 q = *(const PG8_LAS f32x4*)(smax + (ai * HALF + wr * 64 + m * 16 + fr) * 4);
                const float mm = fmaxf(fmaxf(q[0], q[1]), fmaxf(q[2], q[3])) * SC; float s = 0.f;
#pragma unroll
                for (int bj = 0; bj < 2; ++bj)
#pragma unroll
                    for (int n = 0; n < 2; ++n)
#pragma unroll
                        for (int e = 0; e < 4; ++e) { const float p = __builtin_amdgcn_exp2f(acc[ai][bj][m][n][e] * SC - mm); acc[ai][bj][m][n][e] = p; s += p; }
                s += __shfl_xor(s, 16); s += __shfl_xor(s, 32);
                if (fq == 0) ssum[(ai * HALF + wr * 64 + m * 16 + fr) * 4 + wc] = s; }
        asm volatile("s_waitcnt lgkmcnt(0)" ::: "memory"); __builtin_amdgcn_s_barrier(); asm volatile("" ::: "memory");
        const int row0 = u.pm * BM + wr * 64 + fr, col0 = u.pn * 256 + wc * 32 + 8 * fq;
#pragma unroll
        for (int ai = 0; ai < 2; ++ai)
#pragma unroll
            for (int m = 0; m < 4; ++m) { const f32x4 q = *(const PG8_LAS f32x4*)(ssum + (ai * HALF + wr * 64 + m * 16 + fr) * 4);
                const float iv = 1.f / ((q[0] + q[1]) + (q[2] + q[3]));
                bf16* rowp = P + (size_t)(row0 + ai * HALF + m * 16) * D + col0;
#pragma unroll
                for (int bj = 0; bj < 2; ++bj) { const f32x4 v0 = acc[ai][bj][m][0] * iv, v1 = acc[ai][bj][m][1] * iv; u32x4 w;
                    w.x = cvt_pk_bf16(v0[0], v0[1]); w.y = cvt_pk_bf16(v0[2], v0[3]); w.z = cvt_pk_bf16(v1[0], v1[1]); w.w = cvt_pk_bf16(v1[2], v1[3]);
                    *(u32x4*)(rowp + bj * HALF) = w; } }
    }
};
struct EpiAttnO {
    static constexpr bool PERM = true;
    bf16* O;
    __device__ __forceinline__ void operator()(const f32x4 (&acc)[2][2][4][2], const Unit& u, int wr, int wc, int fr, int fq) const {
        const int row0 = u.pm * BM + wr * 64 + fr, col0 = u.pn * 256 + wc * 32 + 8 * fq;
#pragma unroll
        for (int ai = 0; ai < 2; ++ai)
#pragma unroll
            for (int m = 0; m < 4; ++m) { bf16* rowp = O + (size_t)(row0 + ai * HALF + m * 16) * D + col0;
#pragma unroll
                for (int bj = 0; bj < 2; ++bj) { const f32x4 v0 = acc[ai][bj][m][0], v1 = acc[ai][bj][m][1];
                    u32x4 w; w.x = cvt_pk_bf16(v0[0], v0[1]); w.y = cvt_pk_bf16(v0[2], v0[3]); w.z = cvt_pk_bf16(v1[0], v1[1]); w.w = cvt_pk_bf16(v1[2], v1[3]);
                    *(u32x4*)(rowp + bj * HALF) = w; } }
    }
};

struct EpiLora {
    static constexpr bool PERM = true;
    bf16* LW; size_t ostride; const float* w0; const float* a0;
    __device__ __forceinline__ void operator()(const f32x4 (&acc)[2][2][4][2], const Unit& u, int wr, int wc, int fr, int fq) const {
        const int row0 = u.pm * BM + wr * 64 + fr, col0 = u.pn * BM + wc * 32 + 8 * fq;
        const int kind = u.pn >> 1;
        bf16* O = LW + (size_t)kind * ostride;
#pragma unroll
        for (int bj = 0; bj < 2; ++bj) { const int col = (col0 + bj * HALF) & 511;
            f32x4 b0 = (f32x4){0.f, 0.f, 0.f, 0.f}, b1 = b0;
            if (kind == 0) { b0 = *(const f32x4*)(w0 + col); b1 = *(const f32x4*)(w0 + col + 4); }
            else if (kind == 1) { b0 = *(const f32x4*)(a0 + col); b1 = *(const f32x4*)(a0 + col + 4); }
#pragma unroll
            for (int ai = 0; ai < 2; ++ai)
#pragma unroll
                for (int m = 0; m < 4; ++m) { const size_t row = (size_t)(row0 + ai * HALF + m * 16);
                    const f32x4 v0 = acc[ai][bj][m][0] + b0, v1 = acc[ai][bj][m][1] + b1; float o[8];
#pragma unroll
                    for (int e = 0; e < 8; ++e) { float x = (e < 4) ? v0[e & 3] : v1[e & 3];
                        if (kind == 0) x = -0.6065306597126334f * sigmoidf_(x);
                        else if (kind == 1) x = sigmoidf_(x);
                        o[e] = x; }
                    u32x4 w; w.x = cvt_pk_bf16(o[0], o[1]); w.y = cvt_pk_bf16(o[2], o[3]); w.z = cvt_pk_bf16(o[4], o[5]); w.w = cvt_pk_bf16(o[6], o[7]);
                    *(u32x4*)(O + row * 512 + col) = w; } }
    }
};

struct TileOrder {
    static constexpr bool GATHER = false; __device__ __forceinline__ int grow(const Unit&, int) const { return 0; }
    const bf16* A; const bf16* Bt; int lda, ldb, K, nN, pm;
    __device__ void init(const bf16* A_, int lda_, const bf16* Bt_, int ldb_, int K_, int nN_, int pm_) { A = A_; Bt = Bt_; lda = lda_; ldb = ldb_; K = K_; nN = nN_; pm = pm_; }
    __device__ bool next(int i, Unit& u) const { if (i >= nN) return false; int pm_ = pm; asm volatile("" : "+s"(pm_)); u.pm = pm_; u.pn = (i + (GB >> 3)) & (nN - 1); return true; }
    __device__ __forceinline__ const char* aptr(const Unit& u) const { return (const char*)(A + (size_t)u.pm * BM * lda); }
    __device__ __forceinline__ const char* bptr(const Unit& u) const { return (const char*)(Bt + (size_t)u.pn * BM * ldb); }
};
struct AttnTileOrder {
    static constexpr bool GATHER = false; __device__ __forceinline__ int grow(const Unit&, int) const { return 0; }
    const bf16* A; const bf16* Bt; int lda, ldb, K, pm, mode;
    __device__ void init(const bf16* A_, const bf16* Bt_, int ldb_, int mode_, int pm_) { A = A_; Bt = Bt_; lda = D; ldb = ldb_; K = 256; mode = mode_; pm = pm_; }
    __device__ bool next(int i, Unit& u) const { if (i >= 4) return false; int pm_ = pm; asm volatile("" : "+s"(pm_)); u.pm = pm_; u.pn = (i + (GB >> 3)) & 3; return true; }
    __device__ __forceinline__ const char* aptr(const Unit& u) const { return (const char*)(A + (size_t)u.pm * BM * D + u.pn * 256); }
    __device__ __forceinline__ const char* bptr(const Unit& u) const { const int b = u.pm >> 5;
        return (const char*)(mode == 0 ? Bt + (size_t)b * 256 * ldb + u.pn * 256 : Bt + (size_t)u.pn * 256 * ldb + b * 256); }
};
}

#define LAS __attribute__((address_space(3)))
__device__ __forceinline__ void transpose_item(const float* __restrict__ W, int K, int N, bf16* __restrict__ WT, int ldt, int row_off, int col_off, float* scr, int item, int lane, const float* __restrict__ kscale, int ldw = 0) {
    if (ldw == 0) ldw = N;
    const int nblk = N / 32, kb = item / nblk, nb = item % nblk, k0 = 64 * kb, n0 = 32 * nb;
#pragma unroll 8
    for (int i = 0; i < 32; ++i) { const int kk = 2 * i + (lane >> 5); float v = W[(size_t)(k0 + kk) * ldw + n0 + (lane & 31)]; if (kscale) v *= kscale[k0 + kk]; scr[kk * 33 + (lane & 31)] = v; }
    __builtin_amdgcn_s_waitcnt(0xc07f); asm volatile("" ::: "memory");
    const int c = lane & 7;
#pragma unroll
    for (int j = 0; j < 4; ++j) { const int n = (lane >> 3) + 8 * j; const float* s = scr + (8 * c) * 33 + n;
        uint4 o; o.x = pk2(s[0 * 33], s[1 * 33]); o.y = pk2(s[2 * 33], s[3 * 33]); o.z = pk2(s[4 * 33], s[5 * 33]); o.w = pk2(s[6 * 33], s[7 * 33]);
        *(uint4*)(WT + (size_t)(row_off + n0 + n) * ldt + col_off + k0 + 8 * c) = o; }
    __builtin_amdgcn_s_waitcnt(0xc07f); asm volatile("" ::: "memory");
}
__device__ __forceinline__ void transpose_ph(const int WID_, const float* W, int K, int N, bf16* WT, int ldt, int row_off, int col_off, char* lds, const float* kscale = nullptr) {
    const int lane = (WID_ * 64 + lane_id()) & 63, wv = (WID_ * 64 + lane_id()) >> 6;
    float* scr = (float*)(lds + wv * 16384);
    const int nitems = (K / 64) * (N / 32);
    for (int it = GB * 8 + wv; it < nitems; it += GN * 8) transpose_item(W, K, N, WT, ldt, row_off, col_off, scr, it, lane, kscale);
}

template <typename TO>
__device__ __forceinline__ void rmsnorm_ph(const int WID_, const float* __restrict__ x, const float* __restrict__ w, TO* __restrict__ out, int rows, int row_lo = 0, int vb = GB, int nvb = GN) {
    const int lane = lane_id(), wv = WID_;
    float4 g[4];
#pragma unroll
    for (int j = 0; j < 4; ++j) g[j] = *(const float4*)(w + (lane + 64 * j) * 4);
    for (int row = row_lo + (vb * 8 + wv) * 2; row < rows; row += nvb * 16) {
        const float4* xr = (const float4*)(x + (size_t)row * D);
        float4 v[2][4]; float s[2] = {0.f, 0.f};
#pragma unroll
        for (int r = 0; r < 2; ++r)
#pragma unroll
            for (int j = 0; j < 4; ++j) v[r][j] = xr[r * (D / 4) + lane + 64 * j];
#pragma unroll
        for (int r = 0; r < 2; ++r) {
#pragma unroll
            for (int j = 0; j < 4; ++j) s[r] += v[r][j].x * v[r][j].x + v[r][j].y * v[r][j].y + v[r][j].z * v[r][j].z + v[r][j].w * v[r][j].w;
            s[r] = wave_sum(s[r]);
            const float rs = rsqrtf(s[r] * (1.f / D) + 1e-6f);
#pragma unroll
            for (int j = 0; j < 4; ++j) {
                uint2 o; o.x = pk2(v[r][j].x * rs * g[j].x, v[r][j].y * rs * g[j].y); o.y = pk2(v[r][j].z * rs * g[j].z, v[r][j].w * rs * g[j].w);
                *(uint2*)(out + (size_t)(row + r) * D + (lane + 64 * j) * 4) = o;
            }
        }
    }
}

__device__ __forceinline__ void rwkv_lin_ph(const int WID_, const bf16* __restrict__ proj, const float* __restrict__ mu, bf16* __restrict__ lin) {
    const int lane = lane_id(), wv = WID_;
    const float4 m4 = *(const float4*)(mu + 1536 + 4 * lane);
    const float mm[4] = {m4.x, m4.y, m4.z, m4.w};
    for (int m0 = (GB * 8 + wv) * 4; m0 < M; m0 += GN * 32) {
        uint2 z[4], zp[4];
#pragma unroll
        for (int i = 0; i < 4; ++i) { const int m = m0 + i; z[i] = *(const uint2*)(proj + (size_t)m * DSHIFT + 1536 + 4 * lane);
            zp[i] = make_uint2(0, 0); if ((m & (S - 1)) != 0) zp[i] = *(const uint2*)(proj + (size_t)(m - 1) * DSHIFT + 1536 + 4 * lane); }
#pragma unroll
        for (int i = 0; i < 4; ++i) {
            float c[4] = {__builtin_bit_cast(float, z[i].x << 16), __builtin_bit_cast(float, z[i].x & 0xffff0000u), __builtin_bit_cast(float, z[i].y << 16), __builtin_bit_cast(float, z[i].y & 0xffff0000u)};
            const float q[4] = {__builtin_bit_cast(float, zp[i].x << 16), __builtin_bit_cast(float, zp[i].x & 0xffff0000u), __builtin_bit_cast(float, zp[i].y << 16), __builtin_bit_cast(float, zp[i].y & 0xffff0000u)};
#pragma unroll
            for (int e = 0; e < 4; ++e) { float t = c[e] + (q[e] - c[e]) * mm[e];
                if (lane < 16) t = 1.f - 2.f / (1.f + __expf(2.f * t));
                else if (lane >= 32) t = sigmoidf_(t);
                c[e] = t; }
            uint2 o; o.x = pk2(c[0], c[1]); o.y = pk2(c[2], c[3]);
            *(uint2*)(lin + (size_t)(m0 + i) * 256 + 4 * lane) = o;
        }
    }
}
__device__ __forceinline__ void rwkv_wl_ph(const int WID_, const float* __restrict__ wdec, const float* __restrict__ wiclr, const float* __restrict__ wgate, bf16* __restrict__ wl) {
    for (int i = GB * NT + (WID_ * 64 + lane_id()); i < 1536 * 256; i += GN * NT) {
        const int k = i & 255, n = i >> 8; float v = 0.f;
        if (n < 512) { if (k < 64) v = wdec[k * 512 + n]; }
        else if (n < 1024) { if (k >= 64 && k < 128) v = wiclr[(k - 64) * 512 + (n - 512)]; }
        else { if (k >= 128) v = wgate[(k - 128) * 512 + (n - 1024)]; }
        wl[i] = f2bf(v);
    }
}
template <int CTRL> __device__ __forceinline__ float dpp16(float x) { return __builtin_bit_cast(float, __builtin_amdgcn_update_dpp(0, __builtin_bit_cast(int, x), CTRL, 0xf, 0xf, true)); }
constexpr int RW_ITEMS = NB * 8;

namespace ck {
#define CK_BAR() do { asm volatile("s_waitcnt lgkmcnt(0)" ::: "memory"); __builtin_amdgcn_s_barrier(); asm volatile("" ::: "memory"); } while (0)
typedef float f32x2_t __attribute__((ext_vector_type(2)));
typedef __bf16 bf16x2_t __attribute__((ext_vector_type(2)));
__device__ __forceinline__ unsigned cvtpk(float lo, float hi) { const f32x2_t v = {lo, hi}; const bf16x2_t b = __builtin_convertvector(v, bf16x2_t); return __builtin_bit_cast(unsigned, b); }
typedef short bf16x8 __attribute__((ext_vector_type(8)));
typedef float f32x16 __attribute__((ext_vector_type(16)));
constexpr int LD = 72;
constexpr int MB = 64 * LD * 2;
constexpr int O_AB = 0, O_RB = MB, O_BB = 2 * MB, O_KB = 3 * MB, O_AT = 4 * MB, O_W1T = 5 * MB, O_BT = 6 * MB, O_KT = 7 * MB, O_VT = 8 * MB,
              O_NM = 9 * MB, O_AAK = 10 * MB, O_ARB = 11 * MB, O_ARK = 12 * MB, O_G = 13 * MB, O_TOT = O_G + 16384;
constexpr int O_TM = O_AB, O_X1T = O_BB, O_NMF = O_G, O_TT = O_G + 8192, O_ZT = O_TT + 5120;
constexpr int ITEM_BYTES = 32768;
template <int K, typename PA, typename PB>
__device__ __forceinline__ f32x16 mm_tile(f32x16 acc, PA A, int lda, PB B, int ldb, int lane) {
    const int r = lane & 31, h = lane >> 5;
    bf16x8 a[K / 16], b[K / 16];
#pragma unroll
    for (int q = 0; q < K / 16; ++q) { a[q] = *(const bf16x8*)(A + r * lda + 16 * q + 8 * h); b[q] = *(const bf16x8*)(B + r * ldb + 16 * q + 8 * h); }
#pragma unroll
    for (int q = 0; q < K / 16; ++q) acc = __builtin_amdgcn_mfma_f32_32x32x16_bf16(a[q], b[q], acc, 0, 0, 0);
    return acc;
}
__device__ __forceinline__ int crow(int reg, int h) { return (reg & 3) + 8 * (reg >> 2) + 4 * h; }
__device__ __forceinline__ void store_tr(const f32x16& acc, bf16* Ct, int ldct, int lane) {
    const int c = lane & 31, h = lane >> 5;
#pragma unroll
    for (int g = 0; g < 4; ++g) { uint2 w; w.x = cvtpk(acc[4 * g], acc[4 * g + 1]); w.y = cvtpk(acc[4 * g + 2], acc[4 * g + 3]); *(uint2*)(Ct + c * ldct + 8 * g + 4 * h) = w; }
}
__device__ __forceinline__ void store_rm(const f32x16& acc, bf16* C, int ldc, int lane) {
    const int c = lane & 31, h = lane >> 5;
#pragma unroll
    for (int rg = 0; rg < 16; ++rg) C[crow(rg, h) * ldc + c] = f2bf(acc[rg]);
}
__device__ __forceinline__ f32x16 zero16() { return (f32x16){0.f, 0.f, 0.f, 0.f, 0.f, 0.f, 0.f, 0.f, 0.f, 0.f, 0.f, 0.f, 0.f, 0.f, 0.f, 0.f}; }
__device__ __forceinline__ void store_frag16(const f32x16& acc, bf16* base, int t0, int t1, int lane) {
    const int cc = lane & 31, hh = lane >> 5, col = 32 * t1 + cc;
#pragma unroll
    for (int g = 0; g < 4; ++g) { const int row = 32 * t0 + 8 * g + 4 * hh;
        uint2 w; w.x = cvtpk(acc[4 * g], acc[4 * g + 1]); w.y = cvtpk(acc[4 * g + 2], acc[4 * g + 3]);
        *(uint2*)(base + (((row >> 4) * 4 + (col >> 4)) * 64 + (col & 15) + 16 * ((row & 15) >> 2)) * 4) = w; }
}
struct In { const bf16* proj; const bf16* LW; const bf16* AA; const float* mu; const float* k_k; const float* k_a; const float* r_k; float* RK; char* items; };

__device__ __forceinline__ void phase1(const int WID_, const In& I, char* lds) {
    const int wv = WID_;
#define MAT(off) ((bf16*)(lds + (off)))
    float* G = (float*)(lds + O_G); float* TOT = (float*)(lds + O_TOT); float* NMF = (float*)(lds + O_NMF);
    uint4 nx_r, nx_k, nx_v, nx_qr, nx_qk, nx_qv, nx_a, nx_l;
    { const int lane0 = lane_id(), tid0 = wv * 64 + lane0; const int item = GB;
      if (item < NB * 8 * (S / 64)) { const int c = item & 127, h = (item >> 7) & 7, b = item >> 10, s = tid0 >> 3, cg = tid0 & 7, ch0 = h * 64 + cg * 8, t = c * 64 + s; const size_t m = (size_t)b * S + t;
        const bf16* z = I.proj + m * DSHIFT + ch0;
        nx_r = *(const uint4*)(z); nx_k = *(const uint4*)(z + 512); nx_v = *(const uint4*)(z + 1024);
        nx_qr = make_uint4(0, 0, 0, 0); nx_qk = nx_qr; nx_qv = nx_qr;
        if (t > 0) { nx_qr = *(const uint4*)(z - DSHIFT); nx_qk = *(const uint4*)(z + 512 - DSHIFT); nx_qv = *(const uint4*)(z + 1024 - DSHIFT); }
        nx_a = *(const uint4*)(I.AA + m * 512 + ch0); nx_l = *(const uint4*)(I.LW + m * 512 + ch0); } }
    for (int item = GB; item < NB * 8 * (S / 64); item += GN) {
        const int lane = lane_id(), tid = wv * 64 + lane;
        const int c = item & 127, h = (item >> 7) & 7, b = item >> 10;
        char* out = I.items + (size_t)item * ITEM_BYTES;
        const int s = tid >> 3, cg = tid & 7, ch0 = h * 64 + cg * 8, t = c * 64 + s; const size_t m = (size_t)b * S + t;
        float r_[8], kp_[8], v_[8], kk_[8], b_[8];
        {
            const uint4 gr = nx_r, gk = nx_k, gv = nx_v, qr = nx_qr, qk = nx_qk, qv = nx_qv, ga = nx_a, gl = nx_l;
            const float4 c_mr0 = *(const float4*)(I.mu + ch0), c_mr1 = *(const float4*)(I.mu + ch0 + 4), c_mk0 = *(const float4*)(I.mu + 512 + ch0), c_mk1 = *(const float4*)(I.mu + 512 + ch0 + 4);
            const float4 c_mv0 = *(const float4*)(I.mu + 1024 + ch0), c_mv1 = *(const float4*)(I.mu + 1024 + ch0 + 4), c_kk0 = *(const float4*)(I.k_k + ch0), c_kk1 = *(const float4*)(I.k_k + ch0 + 4);
            const float4 c_ka0 = *(const float4*)(I.k_a + ch0), c_ka1 = *(const float4*)(I.k_a + ch0 + 4), c_rk0 = *(const float4*)(I.r_k + ch0), c_rk1 = *(const float4*)(I.r_k + ch0 + 4);
            const float mur[8] = {c_mr0.x, c_mr0.y, c_mr0.z, c_mr0.w, c_mr1.x, c_mr1.y, c_mr1.z, c_mr1.w}, muk[8] = {c_mk0.x, c_mk0.y, c_mk0.z, c_mk0.w, c_mk1.x, c_mk1.y, c_mk1.z, c_mk1.w};
            const float muv[8] = {c_mv0.x, c_mv0.y, c_mv0.z, c_mv0.w, c_mv1.x, c_mv1.y, c_mv1.z, c_mv1.w}, ckk[8] = {c_kk0.x, c_kk0.y, c_kk0.z, c_kk0.w, c_kk1.x, c_kk1.y, c_kk1.z, c_kk1.w};
            const float cka[8] = {c_ka0.x, c_ka0.y, c_ka0.z, c_ka0.w, c_ka1.x, c_ka1.y, c_ka1.z, c_ka1.w}, crk[8] = {c_rk0.x, c_rk0.y, c_rk0.z, c_rk0.w, c_rk1.x, c_rk1.y, c_rk1.z, c_rk1.w};
            const unsigned wr[4] = {gr.x, gr.y, gr.z, gr.w}, wk[4] = {gk.x, gk.y, gk.z, gk.w}, wv4[4] = {gv.x, gv.y, gv.z, gv.w};
            const unsigned pr[4] = {qr.x, qr.y, qr.z, qr.w}, pk[4] = {qk.x, qk.y, qk.z, qk.w}, pv[4] = {qv.x, qv.y, qv.z, qv.w};
            const unsigned wa[4] = {ga.x, ga.y, ga.z, ga.w}, wl[4] = {gl.x, gl.y, gl.z, gl.w};
            float ss = 0.f, rk = 0.f, a_[8];
#pragma unroll
            for (int e = 0; e < 8; ++e) { const int w_ = e >> 1; const bool hi = e & 1;
                auto ex = [&](unsigned u) { return hi ? __builtin_bit_cast(float, u & 0xffff0000u) : __builtin_bit_cast(float, u << 16); };
                float x = ex(wr[w_]); r_[e] = x + (ex(pr[w_]) - x) * mur[e];
                x = ex(wk[w_]); const float k = x + (ex(pk[w_]) - x) * muk[e];
                x = ex(wv4[w_]); v_[e] = x + (ex(pv[w_]) - x) * muv[e];
                a_[e] = ex(wa[w_]); kk_[e] = k * ckk[e]; ss += kk_[e] * kk_[e];
                kp_[e] = k * (1.f + (a_[e] - 1.f) * cka[e]); rk += r_[e] * kp_[e] * crk[e];
                G[s * 64 + cg * 8 + e] = ex(wl[w_]); }
            ss += dpp16<0xB1>(ss); ss += dpp16<0x4E>(ss); ss += dpp16<0x141>(ss);
            const float inv = 1.f / fmaxf(sqrtf(ss), 1e-12f);
#pragma unroll
            for (int e = 0; e < 8; ++e) { kk_[e] *= inv; b_[e] = kk_[e] * a_[e]; }
            rk += dpp16<0xB1>(rk); rk += dpp16<0x4E>(rk); rk += dpp16<0x141>(rk);
            if (cg == 0) I.RK[m * 8 + h] = rk;
        }
        CK_BAR();
        { const int ch = tid & 63, part = tid >> 6; float run = 0.f;
#pragma unroll
          for (int i = 0; i < 8; ++i) { run += G[(8 * part + i) * 64 + ch]; G[(8 * part + i) * 64 + ch] = run; }
          TOT[part * 64 + ch] = run; }
        CK_BAR();
        { const int ch = tid & 63, part = tid >> 6; float off = 0.f;
          for (int p = 0; p < part; ++p) off += TOT[p * 64 + ch];
#pragma unroll
          for (int i = 0; i < 8; ++i) G[(8 * part + i) * 64 + ch] += off; }
        CK_BAR();
        float glast[8];
        {
            unsigned pab[4], prb[4], pbb[4], pkb[4];
            float ab[8], rb[8], bb[8], kb[8], bt[8], kt[8];
            const float4 g0_ = *(const float4*)(G + s * 64 + cg * 8), g1_ = *(const float4*)(G + s * 64 + cg * 8 + 4);
            const int sm = (s > 0) ? s - 1 : 0; const float msk = (s > 0) ? 1.f : 0.f;
            const float4 m0_ = *(const float4*)(G + sm * 64 + cg * 8), m1_ = *(const float4*)(G + sm * 64 + cg * 8 + 4);
            const float4 l0_ = *(const float4*)(G + 63 * 64 + cg * 8), l1_ = *(const float4*)(G + 63 * 64 + cg * 8 + 4);
            const float gv_[8] = {g0_.x, g0_.y, g0_.z, g0_.w, g1_.x, g1_.y, g1_.z, g1_.w}, mv_[8] = {m0_.x, m0_.y, m0_.z, m0_.w, m1_.x, m1_.y, m1_.z, m1_.w}, lv_[8] = {l0_.x, l0_.y, l0_.z, l0_.w, l1_.x, l1_.y, l1_.z, l1_.w};
#pragma unroll
            for (int e = 0; e < 8; ++e) { const float g = gv_[e], gm1 = mv_[e] * msk, gL = lv_[e];
                glast[e] = gL;
                const float eg = __expf(g), eng = __expf(-g), egm = __expf(gm1), egl = __expf(gL - g);
                ab[e] = -kk_[e] * egm; rb[e] = r_[e] * eg; bb[e] = b_[e] * eng; kb[e] = kp_[e] * eng; bt[e] = b_[e] * egl; kt[e] = kp_[e] * egl; }
#pragma unroll
            for (int q = 0; q < 4; ++q) { pab[q] = pk2(ab[2 * q], ab[2 * q + 1]); prb[q] = pk2(rb[2 * q], rb[2 * q + 1]); pbb[q] = pk2(bb[2 * q], bb[2 * q + 1]); pkb[q] = pk2(kb[2 * q], kb[2 * q + 1]); }
            *(uint4*)(MAT(O_AB) + s * LD + cg * 8) = make_uint4(pab[0], pab[1], pab[2], pab[3]);
            *(uint4*)(MAT(O_RB) + s * LD + cg * 8) = make_uint4(prb[0], prb[1], prb[2], prb[3]);
            *(uint4*)(MAT(O_BB) + s * LD + cg * 8) = make_uint4(pbb[0], pbb[1], pbb[2], pbb[3]);
            *(uint4*)(MAT(O_KB) + s * LD + cg * 8) = make_uint4(pkb[0], pkb[1], pkb[2], pkb[3]);
#pragma unroll
            for (int e = 0; e < 8; ++e) { const int k = cg * 8 + e;
                MAT(O_AT)[k * LD + s] = f2bf(ab[e]); MAT(O_BT)[k * LD + s] = f2bf(bt[e]); MAT(O_KT)[k * LD + s] = f2bf(kt[e]); MAT(O_VT)[k * LD + s] = f2bf(v_[e]); }
        }
        CK_BAR();
        { const int itn = item + GN;
          if (itn < NB * 8 * (S / 64)) { const int c2 = itn & 127, h2 = (itn >> 7) & 7, b2 = itn >> 10, ch2 = h2 * 64 + cg * 8, t2 = c2 * 64 + s; const size_t m2 = (size_t)b2 * S + t2;
            const bf16* z = I.proj + m2 * DSHIFT + ch2;
            nx_r = *(const uint4*)(z); nx_k = *(const uint4*)(z + 512); nx_v = *(const uint4*)(z + 1024);
            nx_qr = make_uint4(0, 0, 0, 0); nx_qk = nx_qr; nx_qv = nx_qr;
            if (t2 > 0) { nx_qr = *(const uint4*)(z - DSHIFT); nx_qk = *(const uint4*)(z + 512 - DSHIFT); nx_qv = *(const uint4*)(z + 1024 - DSHIFT); }
            nx_a = *(const uint4*)(I.AA + m2 * 512 + ch2); nx_l = *(const uint4*)(I.LW + m2 * 512 + ch2); } }
        if (s == 63) {
#pragma unroll
            for (int e = 0; e < 8; ++e) TOT[cg * 8 + e] = __expf(glast[e]);
        }
        {
            const int mat = tid >> 7, row = (tid >> 2) & 31, chunk = tid & 3;
            *(uint4*)(MAT(O_NM + mat * MB) + row * LD + 32 + chunk * 8) = make_uint4(0, 0, 0, 0);
        }
        for (int task = wv; task < 12; task += 8) {
            const int mat = task / 3, tt = task % 3, st = (tt == 0) ? 0 : 1, jt = (tt == 2) ? 1 : 0;
            const bf16* Asrc = MAT((mat & 1) ? O_KB : O_BB) + 32 * jt * LD;
            const bf16* Bsrc = MAT((mat >> 1) ? O_RB : O_AB) + 32 * st * LD;
            f32x16 acc = mm_tile<64>(zero16(), Asrc, LD, Bsrc, LD, lane);
            const int cs = 32 * st + (lane & 31), hh = lane >> 5; const bool incl = (mat >> 1) != 0;
#pragma unroll
            for (int rg = 0; rg < 16; ++rg) { const int j = 32 * jt + crow(rg, hh); const bool keep = incl ? (j <= cs) : (j < cs); if (!keep) acc[rg] = 0.f; }
            store_tr(acc, MAT(O_NM + mat * MB) + 32 * st * LD + 32 * jt, LD, lane);
            if (mat == 0 && st == jt) {
                float* d = NMF + st * 1024 + (lane & 31) * 32;
#pragma unroll
                for (int g = 0; g < 4; ++g) *(float4*)(d + 8 * g + 4 * hh) = make_float4(acc[4 * g], acc[4 * g + 1], acc[4 * g + 2], acc[4 * g + 3]);
            }
        }
        CK_BAR();
        if (wv == 0) {
            const int d = lane >> 4, cc = lane & 15;
            const float* nb = NMF + (d >> 1) * 1024 + (16 * (d & 1)) * 32 + 16 * (d & 1);
            float T[16];
#pragma unroll
            for (int i = 0; i < 16; ++i) {
                float acc = (i == cc) ? 1.f : 0.f;
#pragma unroll
                for (int j4 = 0; j4 < i; j4 += 4) { const float4 n4 = *(const float4*)(nb + i * 32 + j4);
                    acc += n4.x * T[j4]; if (j4 + 1 < i) acc += n4.y * T[j4 + 1]; if (j4 + 2 < i) acc += n4.z * T[j4 + 2]; if (j4 + 3 < i) acc += n4.w * T[j4 + 3]; }
                T[i] = acc;
            }
            bf16* tm = MAT(O_TM) + (16 * d) * LD + 16 * d + cc;
#pragma unroll
            for (int i = 0; i < 16; ++i) tm[i * LD] = f2bf(T[i]);
            bf16* tt = MAT(O_TT) + (d >> 1) * 32 * 40 + (16 * (d & 1) + cc) * 40 + 16 * (d & 1);
            *(uint4*)(tt) = make_uint4(pk2(T[0], T[1]), pk2(T[2], T[3]), pk2(T[4], T[5]), pk2(T[6], T[7]));
            *(uint4*)(tt + 8) = make_uint4(pk2(T[8], T[9]), pk2(T[10], T[11]), pk2(T[12], T[13]), pk2(T[14], T[15]));
            { const int blk = lane >> 5, r16 = (lane >> 1) & 15, hf = lane & 1;
              *(uint4*)(MAT(O_TM) + (32 * blk + r16) * LD + 32 * blk + 16 + 8 * hf) = make_uint4(0, 0, 0, 0);
              *(uint4*)(MAT(O_TT) + blk * 32 * 40 + (16 + r16) * 40 + 8 * hf) = make_uint4(0, 0, 0, 0); }
        } else if (wv == 1) {
            const int row = lane >> 1, half = lane & 1;
            *(uint4*)(MAT(O_TM) + row * LD + 32 + half * 16) = make_uint4(0, 0, 0, 0); *(uint4*)(MAT(O_TM) + row * LD + 32 + half * 16 + 8) = make_uint4(0, 0, 0, 0);
        } else if (wv >= 4) {
            const int st = (wv - 4) >> 1, vt = (wv - 4) & 1;
            f32x16 acc = mm_tile<64>(zero16(), MAT(O_AAK) + 32 * st * LD, LD, MAT(O_VT) + 32 * vt * LD, LD, lane);
            store_tr(acc, MAT(O_W1T) + 32 * vt * LD + 32 * st, LD, lane);
        }
        CK_BAR();
        if (wv < 2) {
            typedef float f32x4v __attribute__((ext_vector_type(4)));
            const int blk = wv, fr = lane & 15, fq = lane >> 4;
            const bf16x8 zf = (bf16x8){0, 0, 0, 0, 0, 0, 0, 0};
            bf16x8 a = zf, bq = zf;
            if (fq < 2) { a = *(const bf16x8*)(MAT(O_NM) + (32 * blk + 16 + fr) * LD + 32 * blk + 8 * fq); bq = *(const bf16x8*)(MAT(O_TT) + blk * 32 * 40 + fr * 40 + 8 * fq); }
            f32x4v z = __builtin_amdgcn_mfma_f32_16x16x32_bf16(a, bq, (f32x4v){0.f, 0.f, 0.f, 0.f}, 0, 0, 0);
            bf16* zt = MAT(O_ZT) + blk * 16 * 24;
            { uint2 w; w.x = cvtpk(z[0], z[1]); w.y = cvtpk(z[2], z[3]); *(uint2*)(zt + fr * 24 + 4 * fq) = w; }
            asm volatile("s_waitcnt lgkmcnt(0)" ::: "memory");
            a = zf; bq = zf;
            if (fq < 2) { a = *(const bf16x8*)(MAT(O_TM) + (32 * blk + 16 + fr) * LD + 32 * blk + 16 + 8 * fq); bq = *(const bf16x8*)(zt + fr * 24 + 8 * fq); }
            const f32x4v t21 = __builtin_amdgcn_mfma_f32_16x16x32_bf16(a, bq, (f32x4v){0.f, 0.f, 0.f, 0.f}, 0, 0, 0);
#pragma unroll
            for (int rg = 0; rg < 4; ++rg) MAT(O_TM)[(32 * blk + 16 + 4 * fq + rg) * LD + 32 * blk + fr] = f2bf(t21[rg]);
            { uint2 w; w.x = cvtpk(t21[0], t21[1]); w.y = cvtpk(t21[2], t21[3]); *(uint2*)(MAT(O_TT) + blk * 32 * 40 + fr * 40 + 16 + 4 * fq) = w; }
        }
        CK_BAR();
        if (wv == 0) { f32x16 acc = mm_tile<32>(zero16(), MAT(O_NM) + 32 * LD, LD, MAT(O_TT), 40, lane); store_tr(acc, MAT(O_ZT), 40, lane); }
        CK_BAR();
        if (wv == 0) { f32x16 acc = mm_tile<32>(zero16(), MAT(O_TM) + 32 * LD + 32, LD, MAT(O_ZT), 40, lane); store_rm(acc, MAT(O_TM) + 32 * LD, LD, lane); }
        CK_BAR();
        { const int st = wv >> 2, ct = wv & 3;
          f32x16 acc = mm_tile<64>(zero16(), MAT(O_TM) + 32 * st * LD, LD, MAT(O_AT) + 32 * ct * LD, LD, lane);
          CK_BAR();
          store_tr(acc, MAT(O_X1T) + 32 * ct * LD + 32 * st, LD, lane); }
        CK_BAR();
        for (int u = wv; u < 16; u += 8) {
            const int kind = u >> 2, t0 = (u >> 1) & 1, t1 = u & 1, hh = lane >> 5, cc = lane & 31;
            if (kind == 0) {
                f32x16 acc = mm_tile<64>(zero16(), MAT(O_BT) + 32 * t0 * LD, LD, MAT(O_X1T) + (64 + 32 * t1) * LD, LD, lane);
                acc = mm_tile<64>(acc, MAT(O_KT) + 32 * t0 * LD, LD, MAT(O_VT) + 32 * t1 * LD, LD, lane);
                store_frag16(acc, (bf16*)(out + 16384), t0, t1, lane);
            } else if (kind == 1) {
                f32x16 acc = mm_tile<64>(zero16(), MAT(O_ARB) + 32 * t0 * LD, LD, MAT(O_X1T) + (64 + 32 * t1) * LD, LD, lane);
                acc = mm_tile<64>(acc, MAT(O_ARK) + 32 * t0 * LD, LD, MAT(O_VT) + 32 * t1 * LD, LD, lane);
                store_frag16(acc, (bf16*)(out + 24576), t0, t1, lane);
            } else if (kind == 2) {
                f32x16 acc = mm_tile<64>(zero16(), MAT(O_X1T) + 32 * t0 * LD, LD, MAT(O_BT) + 32 * t1 * LD, LD, lane);
                const int k = 32 * t1 + cc; const float gl = TOT[k];
                bf16* d = (bf16*)out + k * 64 + 32 * t0;
#pragma unroll
                for (int g = 0; g < 4; ++g) { float x[4];
#pragma unroll
                    for (int e = 0; e < 4; ++e) { const int kp = 32 * t0 + 8 * g + 4 * hh + e; x[e] = acc[4 * g + e] + ((kp == k) ? gl : 0.f); }
                    uint2 w; w.x = cvtpk(x[0], x[1]); w.y = cvtpk(x[2], x[3]); *(uint2*)(d + 8 * g + 4 * hh) = w; }
            } else {
                f32x16 acc = mm_tile<64>(zero16(), MAT(O_X1T) + 32 * t0 * LD, LD, MAT(O_ARB) + 32 * t1 * LD, LD, lane);
                const int sq = 32 * t1 + cc;
                bf16* d = (bf16*)(out + 8192) + sq * 64 + 32 * t0;
                const bf16* rb = MAT(O_RB) + sq * LD + 32 * t0;
#pragma unroll
                for (int g = 0; g < 4; ++g) { const uint2 rr = *(const uint2*)(rb + 8 * g + 4 * hh);
                    const float x0 = acc[4 * g] + __builtin_bit_cast(float, rr.x << 16), x1 = acc[4 * g + 1] + __builtin_bit_cast(float, rr.x & 0xffff0000u);
                    const float x2 = acc[4 * g + 2] + __builtin_bit_cast(float, rr.y << 16), x3 = acc[4 * g + 3] + __builtin_bit_cast(float, rr.y & 0xffff0000u);
                    uint2 w; w.x = cvtpk(x0, x1); w.y = cvtpk(x2, x3); *(uint2*)(d + 8 * g + 4 * hh) = w; }
            }
        }
        CK_BAR();
    }
#undef MAT
}
typedef float f32x4w __attribute__((ext_vector_type(4)));
constexpr int P2_SLOT = 2 * 64 * LD * 2 + 4096;
__device__ __forceinline__ void phase2(const int WID_, const char* items, float* Y, char* lds) {
    const int wv = WID_;
    bf16* HT0 = (bf16*)lds; bf16* HT1 = HT0 + 16 * LD;
    char* SL = lds + 8192;
    for (int item = GB; item < NB * 8 * 4; item += GN) {
        const int lane = lane_id(), tid = wv * 64 + lane, fr = lane & 15, fq = lane >> 4;
        const int vq = (item >> 3) & 3, head = (item & 7) + 8 * (item >> 5), b = head >> 3, h = head & 7;
        for (int i = tid; i < 2 * 16 * LD / 8; i += NT) ((uint4*)lds)[i] = make_uint4(0, 0, 0, 0);
        const bool upd = wv < 4; const int rb = wv & 3;
        const char* rec0 = items + (size_t)(head * 128) * ITEM_BYTES;
        const size_t g_pq = (size_t)tid * 16;
        const int l_pq = (tid >> 3) * (LD * 2) + (tid & 7) * 16;
        const int piece = (tid >> 5) & 7;
        const size_t g_f = 16384 + (size_t)(piece >> 2) * 8192 + (((piece & 3) * 4 + vq) * 64) * 8 + (tid & 31) * 16;
        const int l_f = 2 * 64 * LD * 2 + piece * 512 + (tid & 31) * 16;
        float* yo = Y + ((size_t)b * S + 16 * rb + 4 * fq) * 512 + h * 64 + 16 * vq + fr;
        const int a_lds = (upd ? 0 : 64 * LD * 2) + (16 * rb + fr) * (LD * 2) + 16 * fq;
        const int c_lds = 2 * 64 * LD * 2 + ((upd ? 0 : 4) + rb) * 512 + lane * 8;
        uint4 rp0, rp1, rp2, rp3, rp4, rp5, rp6, rp7, rq0, rq1, rq2, rq3, rq4, rq5, rq6, rq7, rf0, rf1, rf2, rf3, rf4, rf5, rf6, rf7;
#define P2_LD(n, i) do { const char* rc_ = rec0 + (size_t)(i) * ITEM_BYTES; rp##n = *(const uint4*)(rc_ + g_pq); rq##n = *(const uint4*)(rc_ + 8192 + g_pq); rf##n = *(const uint4*)(rc_ + g_f); } while (0)
#define P2_ST(n, slot) do { char* s_ = SL + (slot) * P2_SLOT; *(uint4*)(s_ + l_pq) = rp##n; *(uint4*)(s_ + 64 * LD * 2 + l_pq) = rq##n; *(uint4*)(s_ + l_f) = rf##n; } while (0)
        P2_LD(0, 0); P2_LD(1, 1); P2_LD(2, 2); P2_LD(3, 3); P2_LD(4, 4); P2_LD(5, 5); P2_LD(6, 6); P2_LD(7, 7);
        P2_ST(0, 0); P2_LD(0, 8);
        CK_BAR();
#define P2_STEP(RN, cstep) do { const int c_ = (cstep); \
            const bf16* Hc = (c_ & 1) ? HT1 : HT0; bf16* Hn = (c_ & 1) ? HT0 : HT1; const char* sl_ = SL + (c_ & 1) * P2_SLOT; \
            const uint2 cv = *(const uint2*)(sl_ + c_lds); \
            f32x4w acc = (f32x4w){__builtin_bit_cast(float, cv.x << 16), __builtin_bit_cast(float, cv.x & 0xffff0000u), __builtin_bit_cast(float, cv.y << 16), __builtin_bit_cast(float, cv.y & 0xffff0000u)}; \
            const bf16x8 a0 = *(const bf16x8*)(sl_ + a_lds), a1 = *(const bf16x8*)(sl_ + a_lds + 64); \
            const bf16x8 b0 = *(const bf16x8*)(Hc + fr * LD + 8 * fq), b1 = *(const bf16x8*)(Hc + fr * LD + 32 + 8 * fq); \
            if (c_ + 1 < S / 64) P2_ST(RN, (c_ + 1) & 1); \
            if (c_ + 9 < S / 64) P2_LD(RN, c_ + 9); \
            acc = __builtin_amdgcn_mfma_f32_16x16x32_bf16(a0, b0, acc, 0, 0, 0); acc = __builtin_amdgcn_mfma_f32_16x16x32_bf16(a1, b1, acc, 0, 0, 0); \
            if (upd) { uint2 w; w.x = cvtpk(acc[0], acc[1]); w.y = cvtpk(acc[2], acc[3]); *(uint2*)(Hn + fr * LD + 16 * rb + 4 * fq) = w; } \
            else { float* y_ = yo + (size_t)c_ * 64 * 512; y_[0] = acc[0]; y_[512] = acc[1]; y_[1024] = acc[2]; y_[1536] = acc[3]; } \
            CK_BAR(); } while (0)
        for (int c = 0; c < S / 64; c += 8) {
            P2_STEP(1, c); P2_STEP(2, c + 1); P2_STEP(3, c + 2); P2_STEP(4, c + 3); P2_STEP(5, c + 4); P2_STEP(6, c + 5); P2_STEP(7, c + 6); P2_STEP(0, c + 7);
        }
#undef P2_STEP
#undef P2_LD
#undef P2_ST
    }
}
}

__device__ __forceinline__ void rwkv_post_ph(const int WID_, const float* __restrict__ Y, const float* __restrict__ RK, const bf16* __restrict__ proj, const float* __restrict__ mu, const bf16* __restrict__ G,
                             const float* __restrict__ lnw, const float* __restrict__ lnb, bf16* __restrict__ ymix) {
    const int lane = lane_id(), tk = WID_, grp = lane, ch0 = grp * 8, head = grp >> 3;
    const float4 mv0 = *(const float4*)(mu + 1024 + ch0), mv1 = *(const float4*)(mu + 1024 + ch0 + 4), lw0 = *(const float4*)(lnw + ch0), lw1 = *(const float4*)(lnw + ch0 + 4), lb0 = *(const float4*)(lnb + ch0), lb1 = *(const float4*)(lnb + ch0 + 4);
    const float muv[8] = {mv0.x, mv0.y, mv0.z, mv0.w, mv1.x, mv1.y, mv1.z, mv1.w}, lw_[8] = {lw0.x, lw0.y, lw0.z, lw0.w, lw1.x, lw1.y, lw1.z, lw1.w}, lb_[8] = {lb0.x, lb0.y, lb0.z, lb0.w, lb1.x, lb1.y, lb1.z, lb1.w};
    const int g_lo = GN == 256 ? (GB < 64 ? GB * 9 : 576 + ((GB - 64) * 3520) / 192) : (GB * (M / 16)) / GN;
    const int g_hi = GN == 256 ? (GB < 64 ? GB * 9 + 9 : 576 + ((GB - 63) * 3520) / 192) : ((GB + 1) * (M / 16)) / GN;
    for (int g = g_lo; g < g_hi; ++g) { const int m0 = g * 16 + tk;
        float4 ya[2], yb[2]; uint4 vv[2], pv[2], gg[2]; float rk[2];
#pragma unroll
        for (int u = 0; u < 2; ++u) { const int m = m0 + 8 * u;
            ya[u] = *(const float4*)(Y + (size_t)m * 512 + ch0); yb[u] = *(const float4*)(Y + (size_t)m * 512 + ch0 + 4);
            vv[u] = *(const uint4*)(proj + (size_t)m * DSHIFT + 1024 + ch0);
            pv[u] = (m & (S - 1)) ? *(const uint4*)(proj + (size_t)(m - 1) * DSHIFT + 1024 + ch0) : make_uint4(0, 0, 0, 0);
            gg[u] = *(const uint4*)(G + (size_t)m * 512 + ch0); rk[u] = RK[(size_t)m * 8 + head]; }
#pragma unroll
        for (int u = 0; u < 2; ++u) {
            const float y[8] = {ya[u].x, ya[u].y, ya[u].z, ya[u].w, yb[u].x, yb[u].y, yb[u].z, yb[u].w};
            float s = 0.f;
#pragma unroll
            for (int e = 0; e < 8; ++e) s += y[e];
            s += dpp16<0xB1>(s); s += dpp16<0x4E>(s); s += dpp16<0x141>(s);
            const float mean = s * (1.f / 64.f); float q = 0.f;
#pragma unroll
            for (int e = 0; e < 8; ++e) { const float d = y[e] - mean; q += d * d; }
            q += dpp16<0xB1>(q); q += dpp16<0x4E>(q); q += dpp16<0x141>(q);
            const float rstd = rsqrtf(q * (1.f / 64.f) + 64e-5f);
            const unsigned wv_[4] = {vv[u].x, vv[u].y, vv[u].z, vv[u].w}, wp_[4] = {pv[u].x, pv[u].y, pv[u].z, pv[u].w}, wg_[4] = {gg[u].x, gg[u].y, gg[u].z, gg[u].w};
            float o[8];
#pragma unroll
            for (int e = 0; e < 8; ++e) { const int w_ = e >> 1; const bool hi = e & 1;
                auto ex = [&](unsigned x) { return hi ? __builtin_bit_cast(float, x & 0xffff0000u) : __builtin_bit_cast(float, x << 16); };
                float v = ex(wv_[w_]); v += (ex(wp_[w_]) - v) * muv[e];
                o[e] = ((y[e] - mean) * rstd * lw_[e] + lb_[e] + rk[u] * v) * ex(wg_[w_]); }
            *(uint4*)(ymix + (size_t)(m0 + 8 * u) * D + ch0) = make_uint4(pk2(o[0], o[1]), pk2(o[2], o[3]), pk2(o[4], o[5]), pk2(o[6], o[7]));
        }
    }
}

constexpr int PSLOTS = NASSIGN + NEXP * 256;
constexpr int MAXTILES = PSLOTS / 256;
struct MoeBufs { int* tok_e; float* tok_g; int* tok_slot; int* slot_tok; float* slot_gate; int* bcnt; int* bbase; int* offs; int* tiles; int* ntiles; };
__device__ __forceinline__ void moe_zero_ph(const int WID_, const MoeBufs& mb) {
    for (int i = GB * NT + (WID_ * 64 + lane_id()); i < PSLOTS; i += GN * NT) { mb.slot_tok[i] = 0; mb.slot_gate[i] = 0.f; }
}
__device__ __forceinline__ void router_ph(const int WID_, const float* __restrict__ x3, const float* __restrict__ nw, bf16* __restrict__ h3, const float* __restrict__ wrg, const float* __restrict__ brg,
                          const float* __restrict__ wre, const float* __restrict__ bre, const MoeBufs& mb, char* lds, int tile) {
    const int lane = lane_id(), wv = WID_;
    int* lcnt = (int*)lds;
    _Float16* wg16 = (_Float16*)(lds + 256);
    _Float16* we16 = (_Float16*)(lds + 256 + 8192);
    if (wv == 0 && lane < 32) lcnt[lane] = 0;
    for (int i = wv * 64 + lane; i < 1024; i += NT) { const float4 w = *(const float4*)(wrg + i * 4);
        typedef _Float16 h4 __attribute__((ext_vector_type(4))); *(h4*)(wg16 + i * 4) = (h4){(_Float16)w.x, (_Float16)w.y, (_Float16)w.z, (_Float16)w.w}; }
    for (int i = wv * 64 + lane; i < 4 * 1024 * 2; i += NT) { const float4 w = *(const float4*)(wre + i * 4);
        typedef _Float16 h4 __attribute__((ext_vector_type(4))); *(h4*)(we16 + i * 4) = (h4){(_Float16)w.x, (_Float16)w.y, (_Float16)w.z, (_Float16)w.w}; }
    __syncthreads();
    typedef _Float16 h4 __attribute__((ext_vector_type(4)));
    typedef _Float16 h8 __attribute__((ext_vector_type(8)));
    for (int m = tile * 256 + wv; m < tile * 256 + 256; m += 8) {
        const float4* xr = (const float4*)(x3 + (size_t)m * D);
        float h[16]; float s = 0.f;
#pragma unroll
        for (int j = 0; j < 4; ++j) { const float4 v = xr[lane + 64 * j]; h[4 * j] = v.x; h[4 * j + 1] = v.y; h[4 * j + 2] = v.z; h[4 * j + 3] = v.w; s += v.x * v.x + v.y * v.y + v.z * v.z + v.w * v.w; }
        s = wave_sum(s);
        const float rs = rsqrtf(s * (1.f / D) + 1e-6f);
        float l1[4] = {0.f, 0.f, 0.f, 0.f};
#pragma unroll
        for (int j = 0; j < 4; ++j) {
            const int k0 = (lane + 64 * j) * 4;
            const float4 g = *(const float4*)(nw + k0);
            h[4 * j] *= rs * g.x; h[4 * j + 1] *= rs * g.y; h[4 * j + 2] *= rs * g.z; h[4 * j + 3] *= rs * g.w;
            uint2 o; o.x = pk2(h[4 * j], h[4 * j + 1]); o.y = pk2(h[4 * j + 2], h[4 * j + 3]);
            *(uint2*)(h3 + (size_t)m * D + k0) = o;
#pragma unroll
            for (int e = 0; e < 4; ++e) { const h4 w = *(const h4*)(wg16 + (k0 + e) * 4); const float x = h[4 * j + e];
                l1[0] += x * (float)w[0]; l1[1] += x * (float)w[1]; l1[2] += x * (float)w[2]; l1[3] += x * (float)w[3]; }
        }
#pragma unroll
        for (int i = 0; i < 4; ++i) l1[i] = wave_sum(l1[i]) + brg[i];
        int grp = 0; float best = l1[0];
#pragma unroll
        for (int i = 1; i < 4; ++i) if (l1[i] > best) { best = l1[i]; grp = i; }
        float se = 0.f;
#pragma unroll
        for (int i = 0; i < 4; ++i) se += __expf(l1[i] - best);
        const float g1 = 1.f / se;
        float l2[8] = {};
        const _Float16* we = we16 + (size_t)grp * D * 8;
#pragma unroll
        for (int j = 0; j < 4; ++j) {
            const int k0 = (lane + 64 * j) * 4;
#pragma unroll
            for (int e = 0; e < 4; ++e) { const float x = h[4 * j + e]; const h8 w = *(const h8*)(we + (k0 + e) * 8);
#pragma unroll
                for (int q = 0; q < 8; ++q) l2[q] += x * (float)w[q]; }
        }
#pragma unroll
        for (int i = 0; i < 8; ++i) l2[i] = wave_sum(l2[i]) + bre[grp * 8 + i];
        int i0 = 0; float v0 = l2[0];
#pragma unroll
        for (int i = 1; i < 8; ++i) if (l2[i] > v0) { v0 = l2[i]; i0 = i; }
        int i1 = -1; float v1 = -3.0e38f;
#pragma unroll
        for (int i = 0; i < 8; ++i) if (i != i0 && l2[i] > v1) { v1 = l2[i]; i1 = i; }
        const float e1 = __expf(v1 - v0), inv = 1.f / (1.f + e1);
        if (lane == 0) {
            const int ea = grp * 8 + i0, eb = grp * 8 + i1;
            mb.tok_e[2 * m] = ea; mb.tok_e[2 * m + 1] = eb;
            mb.tok_g[2 * m] = g1 * inv; mb.tok_g[2 * m + 1] = g1 * e1 * inv;
            atomicAdd(&lcnt[ea], 1); atomicAdd(&lcnt[eb], 1);
        }
    }
    __syncthreads();
    if (wv == 0 && lane < 32) mb.bcnt[tile * 32 + lane] = lcnt[lane];
    __syncthreads();
}
__device__ __forceinline__ void moe_plan_ph(const int WID_, const MoeBufs& mb, char* lds) {
    if (GB != 0) return;
    int* tot = (int*)lds; int* off = tot + 32;
    const int t = WID_ * 64 + lane_id();
    if (t < 32) { int run = 0; for (int b = 0; b < M / 256; ++b) { const int c = __hip_atomic_load(mb.bcnt + b * 32 + t, __ATOMIC_RELAXED, __HIP_MEMORY_SCOPE_AGENT); mb.bbase[b * 32 + t] = run; run += c; } tot[t] = run; }
    __syncthreads();
    if (t == 0) { int o = 0, nt = 0;
        for (int e = 0; e < NEXP; ++e) { off[e] = o; mb.offs[e] = o; const int c = tot[e]; for (int r0 = 0; r0 < c; r0 += 256) { mb.tiles[nt] = e; ++nt; } o += ((c + 255) / 256) * 256; }
        *mb.ntiles = nt; }
    __syncthreads();
}
__device__ __forceinline__ void moe_scatter_ph(const int WID_, const MoeBufs& mb, char* lds) {
    const int lane = lane_id(), wv = WID_;
    int* cur = (int*)lds;
    for (int tile = GB; tile < M / 256; tile += GN) {
        __syncthreads();
        if (wv == 0 && lane < 32) cur[lane] = __hip_atomic_load(mb.offs + lane, __ATOMIC_RELAXED, __HIP_MEMORY_SCOPE_AGENT) + __hip_atomic_load(mb.bbase + tile * 32 + lane, __ATOMIC_RELAXED, __HIP_MEMORY_SCOPE_AGENT);
        __syncthreads();
        const int a = tile * 512 + wv * 64 + lane; const int e = mb.tok_e[a];
        const int pos = atomicAdd(&cur[e], 1);
        mb.slot_tok[pos] = a >> 1; mb.slot_gate[pos] = mb.tok_g[a]; mb.tok_slot[a] = pos;
    }
    __syncthreads();
}
__device__ __forceinline__ void moe_weights_ph(const int WID_, const float* __restrict__ wg, const float* __restrict__ wu, const float* __restrict__ wd, bf16* __restrict__ wgu_t, bf16* __restrict__ wd_t, char* lds, int vb, int nvb) {
    const int lane = (WID_ * 64 + lane_id()) & 63, wv = (WID_ * 64 + lane_id()) >> 6;
    float* scr = (float*)(lds + wv * 16384);
    constexpr int I_GU = 16 * 16;
    constexpr int I_D = 8 * 32;
    constexpr int NIT = NEXP * (2 * I_GU + I_D);
    for (int it = vb * 8 + wv; it < NIT; it += nvb * 8) {
        const int e = it / (2 * I_GU + I_D); int r = it % (2 * I_GU + I_D);
        if (r < 2 * I_GU) {
            const int up = r / I_GU; r %= I_GU;
            const int kb = r / 16, nb = r % 16;
            const int pn = nb / 4, nsub = nb % 4;
            const float* W = (up ? wu : wg) + (size_t)e * D * DEXP + nb * 32;
            transpose_item(W + (size_t)kb * 64 * DEXP, 64, 32, wgu_t, D, e * 1024 + pn * 256 + up * 128 + nsub * 32, kb * 64, scr, 0, lane, nullptr, DEXP);
        } else {
            r -= 2 * I_GU;
            const int kb = r / 32, nb = r % 32;
            const float* W = wd + (size_t)e * DEXP * D + nb * 32;
            transpose_item(W + (size_t)kb * 64 * D, 64, 32, wd_t, DEXP, e * 1024 + nb * 32, kb * 64, scr, 0, lane, nullptr, D);
        }
    }
}
__device__ __forceinline__ void final_ph(const int WID_, float* __restrict__ out, const bf16* __restrict__ yslot, const int* __restrict__ tok_slot, const float* __restrict__ w) {
    const int lane = lane_id(), wv = WID_;
    float4 g[4];
#pragma unroll
    for (int j = 0; j < 4; ++j) g[j] = *(const float4*)(w + (lane + 64 * j) * 4);
    for (int row0 = (GB * 8 + wv) * 2; row0 < M; row0 += GN * 16) {
        float4 v[2][4]; uint2 ya[2][4], yb[2][4];
#pragma unroll
        for (int r = 0; r < 2; ++r) { const int row = row0 + r;
            const float4* xr = (const float4*)(out + (size_t)row * D);
            const uint2* pa = (const uint2*)(yslot + (size_t)tok_slot[2 * row] * D);
            const uint2* pb = (const uint2*)(yslot + (size_t)tok_slot[2 * row + 1] * D);
#pragma unroll
            for (int j = 0; j < 4; ++j) { v[r][j] = xr[lane + 64 * j]; ya[r][j] = pa[lane + 64 * j]; yb[r][j] = pb[lane + 64 * j]; } }
#pragma unroll
        for (int r = 0; r < 2; ++r) { float s = 0.f;
#pragma unroll
            for (int j = 0; j < 4; ++j) { const uint2 a = ya[r][j], b = yb[r][j];
                v[r][j].x += __builtin_bit_cast(float, a.x << 16) + __builtin_bit_cast(float, b.x << 16);
                v[r][j].y += __builtin_bit_cast(float, a.x & 0xffff0000u) + __builtin_bit_cast(float, b.x & 0xffff0000u);
                v[r][j].z += __builtin_bit_cast(float, a.y << 16) + __builtin_bit_cast(float, b.y << 16);
                v[r][j].w += __builtin_bit_cast(float, a.y & 0xffff0000u) + __builtin_bit_cast(float, b.y & 0xffff0000u);
                s += v[r][j].x * v[r][j].x + v[r][j].y * v[r][j].y + v[r][j].z * v[r][j].z + v[r][j].w * v[r][j].w; }
            s = wave_sum(s);
            const float rs = rsqrtf(s * (1.f / D) + 1e-6f);
            float4* xo = (float4*)(out + (size_t)(row0 + r) * D);
#pragma unroll
            for (int j = 0; j < 4; ++j) xo[lane + 64 * j] = make_float4(v[r][j].x * rs * g[j].x, v[r][j].y * rs * g[j].y, v[r][j].z * rs * g[j].z, v[r][j].w * rs * g[j].w); }
    }
}

struct S5Tab { float* Kmat; bf16* BtA; bf16* BtB; };
__device__ __forceinline__ void s5_lam(const float* lam_re, const float* lam_im, const float* log_dt, int g, int n, float& a, float& w) {
    const float dt = __expf(log_dt[g]); a = lam_re[g * 64 + n] * dt; w = lam_im[g * 64 + n] * dt;
}
__device__ __forceinline__ void cexpj(float a, float w, float j, float& re, float& im) { const float e = __expf(a * j); float s, c; sincosf(w * j, &s, &c); re = e * c; im = e * s; }
__device__ __forceinline__ void s5_bbar(const float* lam_re, const float* lam_im, const float* log_dt, const float* b_re, const float* b_im, int g, int n, int h, float& br, float& bi) {
    float a, w; s5_lam(lam_re, lam_im, log_dt, g, n, a, w);
    float lbr, lbi; cexpj(a, w, 1.f, lbr, lbi);
    const float lr = lam_re[g * 64 + n], li = lam_im[g * 64 + n];
    const float nr = lbr - 1.f, ni = lbi, den = lr * lr + li * li;
    const float cr = (nr * lr + ni * li) / den, ci = (ni * lr - nr * li) / den;
    const float xr = b_re[(g * 64 + n) * 16 + h], xi = b_im[(g * 64 + n) * 16 + h];
    br = cr * xr - ci * xi; bi = cr * xi + ci * xr;
}
__device__ __forceinline__ void s5_tables0_ph(const int WID_, const float* lam_re, const float* lam_im, const float* log_dt, const float* b_re, const float* b_im, const float* c_re, const float* c_im, const S5Tab& T, char* lds) {
    float* PWR = (float*)lds; float* PWI = PWR + 64 * 34;
    float* BBR = PWI + 64 * 34; float* BBI = BBR + 64 * 16;
    float* CCR = BBI + 64 * 16; float* CCI = CCR + 16 * 64;
    const int tid = WID_ * 64 + lane_id();
    for (int item = GB; item < 32 * 8; item += GN) {
        const int g = item & 31, part = item >> 5;
        __syncthreads();
        for (int i = tid; i < 64 * 34; i += NT) { const int n = i / 34, j = i % 34; float a, w; s5_lam(lam_re, lam_im, log_dt, g, n, a, w); float pr, pi; cexpj(a, w, (float)j, pr, pi); PWR[i] = pr; PWI[i] = pi; }
        for (int i = tid; i < 64 * 16; i += NT) { const int n = i >> 4, h = i & 15; float br, bi; s5_bbar(lam_re, lam_im, log_dt, b_re, b_im, g, n, h, br, bi); BBR[i] = br; BBI[i] = bi;
            const int hp = i >> 6, n2 = i & 63; CCR[i] = c_re[(g * 16 + hp) * 64 + n2]; CCI[i] = c_im[(g * 16 + hp) * 64 + n2]; }
        __syncthreads();
        for (int i = tid; i < 4 * 256; i += NT) { const int h = i & 15, hp = (i >> 4) & 15, j = 4 * part + (i >> 8);
            float acc = 0.f;
            for (int n = 0; n < 64; ++n) { const float pr = PWR[n * 34 + j], pi = PWI[n * 34 + j], br = BBR[n * 16 + h], bi = BBI[n * 16 + h];
                const float tr = pr * br - pi * bi, ti = pr * bi + pi * br; acc += CCR[hp * 64 + n] * tr - CCI[hp * 64 + n] * ti; }
            T.Kmat[((g * 32 + j) * 16 + hp) * 16 + h] = acc; }
        for (int i = tid; i < 32 * 512; i += NT) { const int col = i & 511, r = 32 * part + (i >> 9); float v = 0.f;
            if (r < 128) { const int n = r & 63, s = col >> 4, h = col & 15; const float pr = PWR[n * 34 + (S5L - 1 - s)], pi = PWI[n * 34 + (S5L - 1 - s)], br = BBR[n * 16 + h], bi = BBI[n * 16 + h];
                v = (r < 64) ? (pr * br - pi * bi) : (pr * bi + pi * br); }
            T.BtA[((size_t)g * 768 + 512 + r) * 512 + col] = f2bf(v); }
        for (int i = tid; i < 64 * 256; i += NT) { const int k = i & 255, row = 64 * part + (i >> 8); float v = 0.f;
            if (k < 128) { const int n = k & 63, sp = row >> 4, hp = row & 15; const float pr = PWR[n * 34 + sp + 1], pi = PWI[n * 34 + sp + 1], cr = CCR[hp * 64 + n], ci = CCI[hp * 64 + n];
                v = (k < 64) ? (cr * pr - ci * pi) : -(cr * pi + ci * pr); }
            T.BtB[((size_t)g * 512 + row) * 256 + k] = f2bf(v); }
    }
    __syncthreads();
}
__device__ __forceinline__ void s5_tables1_ph(const int WID_, const float* dsk, const S5Tab& T) {
    const int gtid = GB * NT + (WID_ * 64 + lane_id()), gsz = GN * NT;
    for (int i = gtid; i < 32 * 512 * 512; i += gsz) {
        const int col = i & 511, row = (i >> 9) & 511, g = i >> 18;
        const int sp = row >> 4, hp = row & 15, s = col >> 4, h = col & 15;
        float v = 0.f;
        if (s <= sp) v = T.Kmat[((g * 32 + (sp - s)) * 16 + hp) * 16 + h];
        if (row == col) v += dsk[g * 16 + hp];
        T.BtA[((size_t)g * 768 + row) * 512 + col] = f2bf(v);
    }
}
__device__ __forceinline__ void s5_carry_ph(const int WID_, const float* lam_re, const float* lam_im, const float* log_dt, const float* __restrict__ F, bf16* __restrict__ XST, int vb, int nvb, char* lds) {
    float* TR = (float*)lds; float* TI = TR + 16 * 32;
    for (int item = vb; item < NB * 32 * 2; item += nvb) {
        const int lane = lane_id(), tid = WID_ * 64 + lane;
        const int nh = item & 1, g = (item >> 1) & 31, b = item >> 6, seg = tid >> 5, n = nh * 32 + (tid & 31);
        float a, w; s5_lam(lam_re, lam_im, log_dt, g, n, a, w);
        float pr, pi; cexpj(a, w, (float)S5L, pr, pi);
        const size_t row0 = (size_t)g * S5R + (size_t)b * (S / S5L) + seg * 16;
        const float* f = F + row0 * 128; bf16* xo = XST + row0 * 256;
        float fr[16], fi[16];
#pragma unroll
        for (int q = 0; q < 16; ++q) { fr[q] = f[(size_t)q * 128 + n]; fi[q] = f[(size_t)q * 128 + 64 + n]; }
#pragma unroll
        for (int q = 0; q < 16; ++q) if (nh == 0) *(uint2*)(xo + (size_t)q * 256 + 128 + (tid & 31) * 4) = make_uint2(0, 0);
        float xr = 0.f, xi = 0.f;
#pragma unroll
        for (int q = 0; q < 16; ++q) { const float nr = pr * xr - pi * xi + fr[q], ni = pr * xi + pi * xr + fi[q]; xr = nr; xi = ni; fr[q] = nr; fi[q] = ni; }
        TR[seg * 32 + (tid & 31)] = xr; TI[seg * 32 + (tid & 31)] = xi;
        __syncthreads();
        float p16r, p16i; cexpj(a, w, (float)(S5L * 16), p16r, p16i);
        float cr = 0.f, ci = 0.f;
        for (int s2 = 0; s2 < seg; ++s2) { const float tr = TR[s2 * 32 + (tid & 31)], ti = TI[s2 * 32 + (tid & 31)];
            const float nr = p16r * cr - p16i * ci + tr, ni = p16r * ci + p16i * cr + ti; cr = nr; ci = ni; }
        float er = cr, ei = ci;
#pragma unroll
        for (int q = 0; q < 16; ++q) {
            const float lr_ = (q > 0) ? fr[q - 1] : 0.f, li_ = (q > 0) ? fi[q - 1] : 0.f;
            xo[(size_t)q * 256 + n] = f2bf(er + lr_); xo[(size_t)q * 256 + 64 + n] = f2bf(ei + li_);
            const float nr = pr * er - pi * ei, ni = pr * ei + pi * er; er = nr; ei = ni;
        }
        __syncthreads();
    }
}
#define XB_TMO      128
#define XB_XCNT(j)  (256  + 64 * (j))
#define XB_XSUB(j)  (1280 + 64 * (j))
#define XB_XGEN(j)  (2304 + 64 * (j))
#define XB_TOP      3328
#define XB_TOPGEN   3392
#define XCD_BAR_WORDS 3456
#define XB_SPIN_CAP (1u << 20)
__device__ __forceinline__ unsigned xb_ld(unsigned* p)              { return __hip_atomic_load(p, __ATOMIC_RELAXED, __HIP_MEMORY_SCOPE_AGENT); }
__device__ __forceinline__ unsigned xb_add(unsigned* p, unsigned v) { return __hip_atomic_fetch_add(p, v, __ATOMIC_RELAXED, __HIP_MEMORY_SCOPE_AGENT); }
__device__ __forceinline__ unsigned xb_xcc_id() { return (unsigned)__builtin_amdgcn_s_getreg((3 << 11) | 20) & 0xFu; }
#define XB_SPIN(cond, bar) do { unsigned _sp = 0; while (cond) { __builtin_amdgcn_s_sleep(1); \
    if ((++_sp & 255u) == 0u) { if (xb_ld(&(bar)[XB_TMO])) break; if (_sp > XB_SPIN_CAP) { atomicAdd(&(bar)[XB_TMO], 1u); break; } } } } while (0)
struct XcdBarrier { unsigned* bar; unsigned x; volatile __attribute__((address_space(3))) unsigned* st; };
__device__ __forceinline__ XcdBarrier xcd_barrier_post(const int WID_, unsigned* bar, volatile __attribute__((address_space(3))) unsigned* st) {
    XcdBarrier b; b.bar = bar; b.x = xb_xcc_id(); b.st = st;
    if ((WID_ * 64 + lane_id()) == 0) (void)xb_add(&bar[XB_XCNT(b.x)], 1u);
    return b;
}
__device__ __forceinline__ void xcd_barrier_complete(unsigned* bar, unsigned x, unsigned& nloc, unsigned& nx) {
    const unsigned G = gridDim.x * gridDim.y * gridDim.z;
    unsigned sum, cnt, mine, sp = 0u;
    for (;;) {
        sum = 0u; cnt = 0u; mine = 0u;
#pragma unroll
        for (unsigned j = 0; j < 16; ++j) { const unsigned c = xb_ld(&bar[XB_XCNT(j)]); sum += c; cnt += (c > 0u) ? 1u : 0u; mine = (j == x) ? c : mine; }
        if (sum == G) break;
        __builtin_amdgcn_s_sleep(1);
        if ((++sp & 255u) == 0u) { if (xb_ld(&bar[XB_TMO])) break; if (sp > XB_SPIN_CAP) { atomicAdd(&bar[XB_TMO], 1u); break; } }
    }
    nloc = mine > 0u ? mine : 1u; nx = cnt > 0u ? cnt : 1u;
}
__device__ __forceinline__ void xcd_barrier(const int WID_, const XcdBarrier& b) {
    asm volatile("s_waitcnt vmcnt(0)" ::: "memory");
    __syncthreads();
    if ((WID_ * 64 + lane_id()) == 0) {
        unsigned* bar = b.bar;
        __builtin_amdgcn_s_waitcnt(0);
        unsigned nloc = b.st[0], nx = b.st[1];
        if (nloc == 0u) { xcd_barrier_complete(bar, b.x, nloc, nx); b.st[0] = nloc; b.st[1] = nx; }
        const unsigned old = xb_add(&bar[XB_XSUB(b.x)], 1u);
        const unsigned gen = old / nloc;
        if (old + 1u == (gen + 1u) * nloc) {
            __builtin_amdgcn_fence(__ATOMIC_RELEASE, "agent");
            asm volatile("s_waitcnt vmcnt(0)" ::: "memory");
            const unsigned og = xb_add(&bar[XB_TOP], 1u);
            const unsigned tg = og / nx;
            if (og + 1u == (tg + 1u) * nx) xb_add(&bar[XB_TOPGEN], 1u);
            else XB_SPIN(xb_ld(&bar[XB_TOPGEN]) == tg, bar);
            __builtin_amdgcn_fence(__ATOMIC_ACQUIRE, "agent");
            xb_add(&bar[XB_XGEN(b.x)], 1u);
            asm volatile("s_waitcnt vmcnt(0)" ::: "memory");
        } else {
            XB_SPIN(xb_ld(&bar[XB_XGEN(b.x)]) == gen, bar);
            __builtin_amdgcn_fence(__ATOMIC_ACQUIRE, "agent");
            asm volatile("s_waitcnt vmcnt(0)" ::: "memory");
        }
    }
    __syncthreads();
}

struct Params { const float* in[41]; float* out; char* ws; };

constexpr size_t W_PROJ = 0;
constexpr size_t W_US5 = 224;
constexpr size_t W_WTS = 288;
constexpr size_t W_YI = 352;
constexpr size_t W_F = 416;
constexpr size_t W_XST = 448;
constexpr size_t W_Z = 480;
constexpr size_t W_MISC = 544;
constexpr size_t W_XN = 576;
constexpr size_t W_CTL = 558;
constexpr size_t WO_IN = 0, WO_GLU = 5 * MiB, WO_MIX = 6 * MiB, WO_Q = 8 * MiB, WO_K = 10 * MiB, WO_V = 12 * MiB, WO_O = 14 * MiB, WO_KMAT = 16 * MiB, WO_BTA = 17 * MiB, WO_BTB = 41 * MiB;

__global__ void __launch_bounds__(NT, 2) fwd_kernel(Params p) {
    extern __shared__ __attribute__((aligned(16))) char lds[];
    const int WID_ = __builtin_amdgcn_readfirstlane((int)(threadIdx.x >> 6));
    cg::grid_group grid = cg::this_grid();
    PG8_LAS unsigned char* ldsl = (PG8_LAS unsigned char*)lds;
    char* ws = p.ws; char* dout = (char*)p.out; float* out = p.out;
#define IN(i) (p.in[i])
    volatile __attribute__((address_space(3))) unsigned* bst = (volatile __attribute__((address_space(3))) unsigned*)(ldsl + LDS_BYTES - 64);
    if (WID_ == 0 && lane_id() < 2) bst[lane_id()] = 0u;
    __syncthreads();
    const XcdBarrier xbar = xcd_barrier_post(WID_, (unsigned*)(ws + W_CTL * MiB), bst);
#ifndef PROBE_PHASE
#define PROBE_PHASE -1
#endif
    int sync_id = 0; unsigned long long pr_t0 = 0, pr_t1 = 0;
    if (PROBE_PHASE == 0) pr_t0 = __builtin_amdgcn_s_memrealtime();
#define SYNC() do { xcd_barrier(WID_, xbar); ++sync_id; if (sync_id == PROBE_PHASE) pr_t0 = __builtin_amdgcn_s_memrealtime(); if (sync_id == PROBE_PHASE + 1) pr_t1 = __builtin_amdgcn_s_memrealtime(); } while (0)
    char* WT = ws + W_WTS * MiB;
    bf16* w_in_t = (bf16*)(WT + WO_IN); bf16* w_glu_t = (bf16*)(WT + WO_GLU); bf16* w_mix_t = (bf16*)(WT + WO_MIX);
    bf16* w_q_t = (bf16*)(WT + WO_Q); bf16* w_k_t = (bf16*)(WT + WO_K); bf16* w_v_t = (bf16*)(WT + WO_V); bf16* w_o_t = (bf16*)(WT + WO_O);
    S5Tab stab; stab.Kmat = (float*)(WT + WO_KMAT); stab.BtA = (bf16*)(WT + WO_BTA); stab.BtB = (bf16*)(WT + WO_BTB);
    bf16* PROJ = (bf16*)(ws + W_PROJ * MiB); bf16* US5 = (bf16*)(ws + W_US5 * MiB);
    bf16* XN = (bf16*)(ws + W_XN * MiB);
    transpose_ph(WID_, IN(3), D, DIN, w_in_t, D, 0, 0, lds);
    transpose_ph(WID_, IN(23), 512, 512, w_glu_t, 512, 0, 0, lds);
    transpose_ph(WID_, IN(25), D, D, w_mix_t, D, 0, 0, lds);
    transpose_ph(WID_, IN(28), D, D, w_q_t, D, 0, 0, lds);
    transpose_ph(WID_, IN(29), D, D, w_k_t, D, 0, 0, lds);
    transpose_ph(WID_, IN(30), D, D, w_v_t, D, 0, 0, lds);
    transpose_ph(WID_, IN(31), D, D, w_o_t, D, 0, 0, lds);
    s5_tables0_ph(WID_, IN(15), IN(16), IN(17), IN(18), IN(19), IN(20), IN(21), stab, lds);
    bf16* wl_t = (bf16*)(WT + 49 * MiB);
    rwkv_wl_ph(WID_, IN(6), IN(8), IN(9), wl_t);
    rmsnorm_ph<bf16>(WID_, IN(0), IN(2), XN, M);
    bf16* MEMN = (bf16*)(ws + (W_MISC + 10) * MiB);
    rmsnorm_ph<bf16>(WID_, IN(1), IN(27), MEMN, NB * NMEM);
    grid.sync(); ++sync_id; if (sync_id == PROBE_PHASE) pr_t0 = __builtin_amdgcn_s_memrealtime(); if (sync_id == PROBE_PHASE + 1) pr_t1 = __builtin_amdgcn_s_memrealtime();
    s5_tables1_ph(WID_, IN(22), stab);
    { pg8::PlainOrder S; S.init(XN, D, w_in_t, D, M, DIN, D); pg8::EpiProj E{PROJ, US5}; pg8::gemm_phase(WID_, ldsl, S, E); }
    SYNC();
    bf16* LIN = (bf16*)(ws + (W_MISC + 16) * MiB);
    rwkv_lin_ph(WID_, PROJ, IN(4), LIN);
    SYNC();
    bf16* YI = (bf16*)(ws + W_YI * MiB); float* F = (float*)(ws + W_F * MiB); bf16* XST = (bf16*)(ws + W_XST * MiB); bf16* Z = (bf16*)(ws + W_Z * MiB);
    bf16* LWb = (bf16*)(ws + 704 * MiB); bf16* AAb = (bf16*)(ws + 768 * MiB); bf16* Gb = (bf16*)(ws + 832 * MiB);
    float* Yr = (float*)(ws + 896 * MiB); float* RKb = (float*)(ws + W_MISC * MiB);
    { pg8::GroupOrder S; S.init(US5, 512, (size_t)S5R * 512, stab.BtA, 512, (size_t)768 * 512, 32, S5R, 768, 512); pg8::EpiS5a E{YI, F}; pg8::gemm_phase(WID_, ldsl, S, E); }
    { pg8::PlainOrder S; S.init(LIN, 256, wl_t, 256, M, 1536, 256); pg8::EpiLora E{LWb, (size_t)32 * MiB, IN(5), IN(7)}; pg8::gemm_phase(WID_, ldsl, S, E); }
    SYNC();
    { ck::In ci{PROJ, LWb, AAb, IN(4), IN(10), IN(11), IN(12), RKb, dout}; ck::phase1(WID_, ci, lds); }
    SYNC();
    bf16* WGU_t = (bf16*)(ws + 704 * MiB); bf16* WD_t = (bf16*)(ws + 768 * MiB);
    ck::phase2(WID_, dout, Yr, lds);
    __syncthreads();
    s5_carry_ph(WID_, IN(15), IN(16), IN(17), F, XST, GB, GN, lds);
    moe_weights_ph(WID_, IN(37), IN(38), IN(39), WGU_t, WD_t, lds, GB, GN);
    SYNC();
    bf16* YMIX = XN;
    bf16* KM = (bf16*)(ws + (W_MISC + 2) * MiB); bf16* VT = (bf16*)(ws + (W_MISC + 6) * MiB);
    { pg8::GroupOrder S; S.init(XST, 256, (size_t)S5R * 256, stab.BtB, 256, (size_t)512 * 256, 32, S5R, 512, 256); pg8::EpiS5b E{YI, Z}; pg8::gemm_phase(WID_, ldsl, S, E); }
    { pg8::PlainOrder S; S.init(MEMN, D, w_k_t, D, NB * NMEM, D, D); pg8::EpiBf16 E{KM, D}; pg8::gemm_phase(WID_, ldsl, S, E); }
    { pg8::PlainOrder S; S.init(w_v_t, D, MEMN, D, D, NB * NMEM, D, 32); pg8::EpiBf16 E{VT, NB * NMEM}; pg8::gemm_phase(WID_, ldsl, S, E); }
    rwkv_post_ph(WID_, Yr, RKb, PROJ, IN(4), Gb, IN(13), IN(14), YMIX);
    SYNC();
    bf16* XN2 = (bf16*)(ws + 0);
    bf16* Q = (bf16*)(ws + 128 * MiB);
    bf16* P = (bf16*)(ws + W_YI * MiB);
    bf16* O = (bf16*)(ws + 800 * MiB);
    bf16* H3 = XN;
    bf16* HID = (bf16*)(ws + 368 * MiB);
    bf16* YSLOT = (bf16*)(ws + 0);
#define MKMB(mb) MoeBufs mb; { char* mbase = p.ws + 976 * MiB; \
    mb.tok_e = (int*)(mbase); mb.tok_g = (float*)(mbase + 1 * MiB); mb.tok_slot = (int*)(mbase + 2 * MiB); mb.slot_tok = (int*)(mbase + 3 * MiB); \
    mb.slot_gate = (float*)(mbase + 4 * MiB); mb.bcnt = (int*)(mbase + 5 * MiB); mb.bbase = mb.bcnt + 16384; mb.offs = mb.bcnt + 32768; mb.ntiles = mb.offs + 64; \
    mb.tiles = (int*)(mbase + 6 * MiB); }
    { MKMB(mb); moe_zero_ph(WID_, mb); }
#define BLK_SYNC() do { asm volatile("s_waitcnt vmcnt(0)" ::: "memory"); __syncthreads(); \
        if (WID_ == 0 && lane_id() == 0) { __builtin_amdgcn_fence(__ATOMIC_ACQUIRE, "agent"); asm volatile("s_waitcnt vmcnt(0)" ::: "memory"); } __syncthreads(); } while (0)
    for (int tl = GB; tl < M / 256; tl += GN) {
        { pg8::TileOrder S; S.init(Z, 512, w_glu_t, 512, 512, 2, tl); pg8::EpiGlu E{Z, IN(24), YMIX}; pg8::gemm_phase(WID_, ldsl, S, E); }
        BLK_SYNC();
        { pg8::TileOrder S; S.init(YMIX, D, w_mix_t, D, D, 4, tl); pg8::EpiF32 E{out, D, IN(0), D}; pg8::gemm_phase(WID_, ldsl, S, E); }
        BLK_SYNC();
        rmsnorm_ph<bf16>(WID_, out, IN(26), XN2, tl * 256 + 256, tl * 256, 0, 1);
        BLK_SYNC();
        { pg8::TileOrder S; S.init(XN2, D, w_q_t, D, D, 4, tl); pg8::EpiBf16 E{Q, D}; pg8::gemm_phase(WID_, ldsl, S, E); }
        BLK_SYNC();
        { pg8::AttnTileOrder S; S.init(Q, KM, D, 0, tl); pg8::EpiSoftmax E{P, (PG8_LAS float*)(ldsl + 131072)}; pg8::gemm_phase(WID_, ldsl, S, E); }
        BLK_SYNC();
        { pg8::AttnTileOrder S; S.init(P, VT, NB * NMEM, 1, tl); pg8::EpiAttnO E{O}; pg8::gemm_phase(WID_, ldsl, S, E); }
        BLK_SYNC();
        { pg8::TileOrder S; S.init(O, D, w_o_t, D, D, 4, tl); pg8::EpiF32 E{out, D, out, D}; pg8::gemm_phase(WID_, ldsl, S, E); }
        BLK_SYNC();
        { MKMB(mb); router_ph(WID_, p.out, IN(32), (bf16*)(p.ws + W_XN * MiB), IN(33), IN(34), IN(35), IN(36), mb, lds, tl); }
    }
    SYNC();
    { MKMB(mb); moe_plan_ph(WID_, mb, lds); }
    SYNC();
    { MKMB(mb); moe_scatter_ph(WID_, mb, lds); }
    MKMB(mb);
    SYNC();
    const int ntiles = __hip_atomic_load(mb.ntiles, __ATOMIC_RELAXED, __HIP_MEMORY_SCOPE_AGENT);
    { pg8::MoeOrderT<true> S; S.init(H3, D, WGU_t, D, D, mb.tiles, ntiles, 1024, mb.slot_tok); pg8::EpiSilu E{HID}; pg8::gemm_phase(WID_, ldsl, S, E); }
    SYNC();
    { pg8::MoeOrderT<false> S; S.init(HID, DEXP, WD_t, DEXP, DEXP, mb.tiles, ntiles, 1024, nullptr); pg8::EpiGate E{YSLOT, mb.slot_gate}; pg8::gemm_phase(WID_, ldsl, S, E); }
    SYNC();
    final_ph(WID_, out, YSLOT, mb.tok_slot, IN(40));
    if (PROBE_PHASE >= 0) {
        if (pr_t1 == 0) pr_t1 = __builtin_amdgcn_s_memrealtime();
        if (GB == 0) { const unsigned long long t_end = __builtin_amdgcn_s_memrealtime(), wait = 8ull * (pr_t1 - pr_t0);
            while (__builtin_amdgcn_s_memrealtime() - t_end < wait) __builtin_amdgcn_s_sleep(8); }
    }
}
}

extern "C" void kernel_launch(void* const* d_in, const int* in_sizes, int n_in, void* d_out, int out_size, void* d_ws, size_t ws_size, hipStream_t stream) {
    (void)in_sizes; (void)out_size; (void)ws_size;
    static int grid = 0;
    if (grid == 0) {
        int dev = 0, cus = 0, per_cu = 0;
        hipGetDevice(&dev);
        hipDeviceGetAttribute(&cus, hipDeviceAttributeMultiprocessorCount, dev);
        hipFuncSetAttribute((const void*)fwd_kernel, hipFuncAttributeMaxDynamicSharedMemorySize, LDS_BYTES);
        hipOccupancyMaxActiveBlocksPerMultiprocessor(&per_cu, (const void*)fwd_kernel, NT, LDS_BYTES);
        if (per_cu < 1) { fprintf(stderr, "occupancy query says %d blocks/CU\n", per_cu); per_cu = 1; }
        grid = cus * 1;
    }
    (void)hipMemsetAsync((char*)d_ws + W_CTL * MiB, 0, 16384, stream);
    Params p{};
    for (int i = 0; i < 41 && i < n_in; ++i) p.in[i] = (const float*)d_in[i];
    p.out = (float*)d_out; p.ws = (char*)d_ws;
    void* args[] = {&p};
    hipError_t e = hipLaunchCooperativeKernel((const void*)fwd_kernel, dim3(grid), dim3(NT), args, LDS_BYTES, stream);
    if (e != hipSuccess) fprintf(stderr, "cooperative launch failed: %s (grid %d)\n", hipGetErrorString(e), grid);
}
```

```cpp
#include <hip/hip_runtime.h>
#include <hip/hip_cooperative_groups.h>
#include <stdint.h>
#include <cstdio>
namespace cg = cooperative_groups;

namespace {
constexpr int NB = 8, S = 8192, D = 1024, M = NB * S;
constexpr int DR = 512, DSHIFT = 1792, DIN = 2304, NMEM = 256;
constexpr int NEXP = 32, DEXP = 512, NASSIGN = 2 * M;
constexpr size_t MiB = 1u << 20;
constexpr int NT = 512;
constexpr int S5L = 32, S5R = M / S5L;
constexpr int LDS_BYTES = 147456;
#define GB ((int)blockIdx.x)
#define GN ((int)gridDim.x)

typedef unsigned short bf16;
typedef float f32x2h __attribute__((ext_vector_type(2)));
typedef __bf16 bf16x2h __attribute__((ext_vector_type(2)));
__device__ __forceinline__ unsigned pk2(float lo, float hi) { const f32x2h v = {lo, hi}; const bf16x2h b = __builtin_convertvector(v, bf16x2h); return __builtin_bit_cast(unsigned, b); }
__device__ __forceinline__ bf16 f2bf(float f) { return (bf16)(pk2(f, f) & 0xffffu); }
__device__ __forceinline__ int lane_id() { int l; asm volatile("v_mbcnt_lo_u32_b32 %0, -1, 0\n\tv_mbcnt_hi_u32_b32 %0, -1, %0" : "=v"(l)); return l; }
__device__ __forceinline__ float bf2f(bf16 h) { return __builtin_bit_cast(float, (unsigned)h << 16); }

template <typename T> __device__ __forceinline__ float ldf(const T* p);
template <> __device__ __forceinline__ float ldf<float>(const float* p) { return *p; }
template <> __device__ __forceinline__ float ldf<bf16>(const bf16* p) { return bf2f(*p); }
template <typename T> __device__ __forceinline__ void stf(T* p, float v);
template <> __device__ __forceinline__ void stf<float>(float* p, float v) { *p = v; }
template <> __device__ __forceinline__ void stf<bf16>(bf16* p, float v) { *p = f2bf(v); }

template <int CTRL, int ROWMASK> __device__ __forceinline__ float dppf_(float x) { return __builtin_bit_cast(float, __builtin_amdgcn_update_dpp(0, __builtin_bit_cast(int, x), CTRL, ROWMASK, 0xf, false)); }
__device__ __forceinline__ float wave_sum(float v) {
    v += dppf_<0xB1, 0xf>(v); v += dppf_<0x4E, 0xf>(v); v += dppf_<0x141, 0xf>(v); v += dppf_<0x140, 0xf>(v);
    v += dppf_<0x142, 0xa>(v);
    v += dppf_<0x143, 0xc>(v);
    return __builtin_bit_cast(float, __builtin_amdgcn_readlane(__builtin_bit_cast(int, v), 63));
}
__device__ __forceinline__ float sigmoidf_(float x) { return 1.f / (1.f + __expf(-x)); }


__device__ __forceinline__ float gelu_tanh(float x) { return x * sigmoidf_(1.5957691216057308f * (x + 0.044715f * x * x * x)); }

namespace pg8 {
#define PG8_LAS __attribute__((address_space(3)))
typedef short bf16x8 __attribute__((ext_vector_type(8)));
typedef float f32x4 __attribute__((ext_vector_type(4)));
typedef unsigned u32x4 __attribute__((ext_vector_type(4)));
constexpr int BM = 256, BK = 64, HALF = 128, HTB = HALF * BK * 2, STAGE_BYTES = 8 * HTB, NXCD = 8, WGM = 8;
__device__ __forceinline__ int lds_byte(int r, int c) { const int st = (r >> 4) * 2 + (c >> 5), rr = r & 15, cc = c & 31, ob = rr * 64 + cc * 2; return st * 1024 + (ob ^ (((ob >> 9) & 1) << 5)); }
__device__ __forceinline__ void stage_rc(int b, int& R, int& C) { const int st = b / 1024, sb = b % 1024, swz = sb ^ (((sb >> 9) & 1) << 5); R = (st >> 1) * 16 + swz / 64; C = (st & 1) * 32 + (swz % 64) / 2; }
__device__ __forceinline__ int perm32(int rho) { const int n = rho >> 4, i = rho & 15; return 8 * (i >> 2) + 4 * n + (i & 3); }
struct Unit { int pm, pn; };
struct PlainOrder {
    static constexpr bool GATHER = false; __device__ __forceinline__ int grow(const Unit&, int) const { return 0; }
    const bf16* A; const bf16* Bt; int lda, ldb, K; int nM, nN, nwg, G, c;
    __device__ void init(const bf16* A_, int lda_, const bf16* Bt_, int ldb_, int M, int N, int K_, int coff = 0) { A = A_; Bt = Bt_; lda = lda_; ldb = ldb_; K = K_; nM = M / BM; nN = N / BM; nwg = nM * nN; G = GN; c = (GB + GN - coff % GN) % GN; }
    __device__ bool next(int i, Unit& u) const {
        const long L = (long)i * G + c; if (L >= nwg) return false;
        int wgid = (int)L; { const int q = nwg / NXCD, r = nwg % NXCD, xcd = wgid % NXCD, off = wgid / NXCD; wgid = (xcd < r ? xcd * (q + 1) : r * (q + 1) + (xcd - r) * q) + off; }
        const int nig = WGM * nN, gid = wgid / nig, fm = gid * WGM, gsz = (nM - fm) < WGM ? (nM - fm) : WGM;
        u.pm = fm + ((wgid % nig) % gsz); u.pn = (wgid % nig) / gsz; return true;
    }
    __device__ __forceinline__ const char* aptr(const Unit& u) const { return (const char*)(A + (size_t)u.pm * BM * lda); }
    __device__ __forceinline__ const char* bptr(const Unit& u) const { return (const char*)(Bt + (size_t)u.pn * BM * ldb); }
};
typedef float f32x2c __attribute__((ext_vector_type(2)));
typedef __bf16 bf16x2c __attribute__((ext_vector_type(2)));
__device__ __forceinline__ unsigned cvt_pk_bf16(float lo, float hi) { const f32x2c v = {lo, hi}; const bf16x2c b = __builtin_convertvector(v, bf16x2c); return __builtin_bit_cast(unsigned, b); }

template <class Epi, class Sched>
__device__ __forceinline__ void gemm_phase(const int WID_, PG8_LAS unsigned char* lds, const Sched& S, const Epi& E) {
    const int tid = (WID_ * 64 + lane_id()), wid = __builtin_amdgcn_readfirstlane(tid >> 6), lane = tid & 63, wr = wid >> 2, wc = wid & 3, fr = lane & 15, fq = lane >> 4;
    const int K = S.K, nt = K / BK;
    unsigned voffA[2], voffB[2];
#pragma unroll
    for (int i = 0; i < 2; ++i) { int R, C; stage_rc(tid * 16 + i * 8192, R, C); const int Rb = Epi::PERM ? ((R & ~31) + perm32(R & 31)) : R;
        voffA[i] = (unsigned)(R * S.lda + C) * 2u; voffB[i] = (unsigned)(Rb * S.ldb + C) * 2u; }
    constexpr bool GA = Sched::GATHER;
    int gR[2], gC[2];
#pragma unroll
    for (int i = 0; i < 2; ++i) stage_rc(tid * 16 + i * 8192, gR[i], gC[i]);
    unsigned vgc[2][2] = {{0u, 0u}, {0u, 0u}}, vgn[2][2] = {{0u, 0u}, {0u, 0u}};
#define PG8_GOFF(dst, u) do { if constexpr (GA) { _Pragma("unroll") for (int h_ = 0; h_ < 2; ++h_) _Pragma("unroll") for (int i_ = 0; i_ < 2; ++i_) \
        dst[h_][i_] = (unsigned)(S.grow(u, h_ * HALF + gR[i_]) * S.lda + gC[i_]) * 2u; } } while (0)
    const size_t kstep = (size_t)(BK * 2);
    const size_t hstepA = GA ? 0 : (size_t)HALF * S.lda * 2, hstepB = (size_t)HALF * S.ldb * 2;
    const unsigned ldsw = (unsigned)wid * 1024u;
    const int aoff = lds_byte(wr * 64 + fr, fq * 8), boff = lds_byte(wc * 32 + fr, fq * 8);
#define PG8_SA(b, h) (((b) * 2 + (h)) * HTB)
#define PG8_SB(b, h) ((4 + (b) * 2 + (h)) * HTB)
#define PG8_STAGE(bufoff, gbase, voff) do { _Pragma("unroll") for (int _i = 0; _i < 2; ++_i) \
        __builtin_amdgcn_global_load_lds((const unsigned*)((const char*)(gbase) + (voff)[_i]), (PG8_LAS unsigned*)(lds + (bufoff) + ldsw + _i * 8192), 16, 0, 0); } while (0)
#define PG8_STAGE_A(bufoff, gbase, h, nx) do { _Pragma("unroll") for (int _i = 0; _i < 2; ++_i) { \
        const unsigned vo_ = GA ? ((nx) ? vgn[h][_i] : vgc[h][_i]) : voffA[_i]; \
        __builtin_amdgcn_global_load_lds((const unsigned*)((const char*)(gbase) + vo_), (PG8_LAS unsigned*)(lds + (bufoff) + ldsw + _i * 8192), 16, 0, 0); } } while (0)
#define PG8_LDA(dst, b, h) do { _Pragma("unroll") for (int m = 0; m < 4; ++m) _Pragma("unroll") for (int k = 0; k < 2; ++k) dst[m][k] = *(const PG8_LAS bf16x8*)(lds + PG8_SA(b, h) + aoff + m * 2048 + k * 1024); } while (0)
#define PG8_LDB(dst, b, h) do { _Pragma("unroll") for (int n = 0; n < 2; ++n) _Pragma("unroll") for (int k = 0; k < 2; ++k) dst[n][k] = *(const PG8_LAS bf16x8*)(lds + PG8_SB(b, h) + boff + n * 2048 + k * 1024); } while (0)
#define PG8_MMA(ai, bj, At, Bt) do { __builtin_amdgcn_s_setprio(1); _Pragma("unroll") for (int m = 0; m < 4; ++m) _Pragma("unroll") for (int n = 0; n < 2; ++n) _Pragma("unroll") for (int k = 0; k < 2; ++k) \
        acc[ai][bj][m][n] = __builtin_amdgcn_mfma_f32_16x16x32_bf16(Bt[n][k], At[m][k], acc[ai][bj][m][n], 0, 0, 0); __builtin_amdgcn_s_setprio(0); } while (0)
#define PG8_WAIT_V(n) asm volatile("s_waitcnt vmcnt(" #n ")" ::: "memory")
#define PG8_WAIT_L(n) asm volatile("s_waitcnt lgkmcnt(" #n ")" ::: "memory")
#define PG8_BAR __builtin_amdgcn_s_barrier()
#define PG8_SCHED __builtin_amdgcn_sched_barrier(0)
    Unit cur, nxt; int ui = 0;
    if (!S.next(0, cur)) return;
    f32x4 acc[2][2][4][2];
#pragma unroll
    for (int a = 0; a < 2; ++a)
#pragma unroll
        for (int b = 0; b < 2; ++b)
#pragma unroll
            for (int m = 0; m < 4; ++m)
#pragma unroll
                for (int n = 0; n < 2; ++n) acc[a][b][m][n] = (f32x4){0.f, 0.f, 0.f, 0.f};
    bf16x8 At[4][2], B0[2][2], B1[2][2];
    const char* cA = S.aptr(cur); const char* cB = S.bptr(cur);
    PG8_STAGE(PG8_SB(0, 0), cB, voffB); PG8_STAGE(PG8_SB(0, 1), cB + hstepB, voffB); PG8_GOFF(vgc, cur); PG8_STAGE_A(PG8_SA(0, 0), cA, 0, false); PG8_STAGE_A(PG8_SA(0, 1), cA + hstepA, 1, false);
    if (wr == 1) PG8_BAR;
    PG8_WAIT_V(2); PG8_BAR;
    PG8_STAGE(PG8_SB(1, 0), cB + kstep, voffB); PG8_STAGE_A(PG8_SA(1, 0), cA + kstep, 0, false); PG8_STAGE(PG8_SB(1, 1), cB + hstepB + kstep, voffB);
    PG8_WAIT_V(6); PG8_BAR;
    for (;;) {
        const bool has_next = S.next(ui + 1, nxt);
        const char* nA = has_next ? S.aptr(nxt) : cA; const char* nB = has_next ? S.bptr(nxt) : cB;
        if (has_next) PG8_GOFF(vgn, nxt); else { if constexpr (GA) { _Pragma("unroll") for (int h_ = 0; h_ < 2; ++h_) _Pragma("unroll") for (int i_ = 0; i_ < 2; ++i_) vgn[h_][i_] = vgc[h_][i_]; } }
        for (int t = 0; t < nt; t += 2) {
            const bool last = (t == nt - 2);
            const char* a1 = cA + (size_t)(t + 1) * kstep;
            const char* a2 = last ? nA : cA + (size_t)(t + 2) * kstep; const char* b2 = last ? nB : cB + (size_t)(t + 2) * kstep;
            const char* a3 = a2 + kstep; const char* b3 = b2 + kstep;
            PG8_LDB(B0, 0, 0); PG8_LDB(B1, 0, 1); PG8_SCHED; PG8_LDA(At, 0, 0); PG8_STAGE_A(PG8_SA(1, 1), a1 + hstepA, 1, false);
            PG8_WAIT_V(8); PG8_WAIT_L(0); PG8_BAR; PG8_MMA(0, 0, At, B0); PG8_MMA(0, 1, At, B1); PG8_BAR; PG8_SCHED;
            PG8_LDA(At, 0, 1); PG8_STAGE(PG8_SB(0, 0), b2, voffB); PG8_STAGE(PG8_SB(0, 1), b2 + hstepB, voffB); PG8_STAGE_A(PG8_SA(0, 0), a2, 0, last);
            PG8_WAIT_V(8); PG8_WAIT_L(0); PG8_BAR; PG8_MMA(1, 0, At, B0); PG8_MMA(1, 1, At, B1); PG8_BAR; PG8_SCHED;
            PG8_LDB(B0, 1, 0); PG8_LDB(B1, 1, 1); PG8_SCHED; PG8_LDA(At, 1, 0); PG8_STAGE_A(PG8_SA(0, 1), a2 + hstepA, 1, last);
            PG8_WAIT_V(8); PG8_WAIT_L(0); PG8_BAR; PG8_MMA(0, 0, At, B0); PG8_MMA(0, 1, At, B1); PG8_BAR; PG8_SCHED;
            PG8_LDA(At, 1, 1); PG8_STAGE(PG8_SB(1, 0), b3, voffB); PG8_STAGE(PG8_SB(1, 1), b3 + hstepB, voffB); PG8_STAGE_A(PG8_SA(1, 0), a3, 0, last);
            PG8_WAIT_V(8); PG8_WAIT_L(0); PG8_BAR; PG8_MMA(1, 0, At, B0); PG8_MMA(1, 1, At, B1); PG8_BAR; PG8_SCHED;
        }
        if (wr == 0) PG8_BAR;
        E(acc, cur, wr, wc, fr, fq);
        if (!has_next) break;
#pragma unroll
        for (int a = 0; a < 2; ++a)
#pragma unroll
            for (int b = 0; b < 2; ++b)
#pragma unroll
                for (int m = 0; m < 4; ++m)
#pragma unroll
                    for (int n = 0; n < 2; ++n) acc[a][b][m][n] = (f32x4){0.f, 0.f, 0.f, 0.f};
        cur = nxt; cA = nA; cB = nB; ++ui;
        if constexpr (GA) { _Pragma("unroll") for (int h_ = 0; h_ < 2; ++h_) _Pragma("unroll") for (int i_ = 0; i_ < 2; ++i_) vgc[h_][i_] = vgn[h_][i_]; }
        if (wr == 1) PG8_BAR;
    }
    PG8_WAIT_V(0);
    PG8_BAR;
#undef PG8_SA
#undef PG8_SB
#undef PG8_STAGE
#undef PG8_STAGE_A
#undef PG8_GOFF
#undef PG8_LDA
#undef PG8_LDB
#undef PG8_MMA
#undef PG8_WAIT_V
#undef PG8_WAIT_L
#undef PG8_BAR
#undef PG8_SCHED
}

struct EpiMixRes {
    static constexpr bool PERM = true;
    bf16* O; const float* R; PG8_LAS float* ss;
    __device__ __forceinline__ void operator()(const f32x4 (&acc)[2][2][4][2], const Unit& u, int wr, int wc, int fr, int fq) const {
        const int row0 = u.pm * BM + wr * 64 + fr, col0 = u.pn * BM + wc * 32 + 8 * fq;
#pragma unroll
        for (int ai = 0; ai < 2; ++ai)
#pragma unroll
            for (int m = 0; m < 4; ++m) { const size_t ro = (size_t)(row0 + ai * HALF + m * 16) * D + col0; float q = 0.f;
#pragma unroll
                for (int bj = 0; bj < 2; ++bj) { const f32x4 v0 = acc[ai][bj][m][0] + *(const f32x4*)(R + ro + bj * HALF), v1 = acc[ai][bj][m][1] + *(const f32x4*)(R + ro + bj * HALF + 4);
                    q += (v0[0] * v0[0] + v0[1] * v0[1]) + (v0[2] * v0[2] + v0[3] * v0[3]) + (v1[0] * v1[0] + v1[1] * v1[1]) + (v1[2] * v1[2] + v1[3] * v1[3]);
                    u32x4 w; w.x = cvt_pk_bf16(v0[0], v0[1]); w.y = cvt_pk_bf16(v0[2], v0[3]); w.z = cvt_pk_bf16(v1[0], v1[1]); w.w = cvt_pk_bf16(v1[2], v1[3]);
                    *(u32x4*)(O + ro + bj * HALF) = w; }
                q += __shfl_xor(q, 16); q += __shfl_xor(q, 32);
                if (fq == 0) { PG8_LAS float* sp = ss + (ai * HALF + wr * 64 + m * 16 + fr) * 4 + wc; *sp += q; } }
    }
};
struct EpiRowScale {
    static constexpr bool PERM = true;
    bf16* O; PG8_LAS const float* ss;
    __device__ __forceinline__ void operator()(const f32x4 (&acc)[2][2][4][2], const Unit& u, int wr, int wc, int fr, int fq) const {
        const int row0 = u.pm * BM + wr * 64 + fr, col0 = u.pn * BM + wc * 32 + 8 * fq;
#pragma unroll
        for (int ai = 0; ai < 2; ++ai)
#pragma unroll
            for (int m = 0; m < 4; ++m) { bf16* rowp = O + (size_t)(row0 + ai * HALF + m * 16) * D + col0;
                const f32x4 s4 = *(PG8_LAS const f32x4*)(ss + (ai * HALF + wr * 64 + m * 16 + fr) * 4);
                const float rs = rsqrtf(((s4[0] + s4[1]) + (s4[2] + s4[3])) * (1.f / D) + 1e-6f);
#pragma unroll
                for (int bj = 0; bj < 2; ++bj) { const f32x4 v0 = acc[ai][bj][m][0] * rs, v1 = acc[ai][bj][m][1] * rs;
                    u32x4 w; w.x = cvt_pk_bf16(v0[0], v0[1]); w.y = cvt_pk_bf16(v0[2], v0[3]); w.z = cvt_pk_bf16(v1[0], v1[1]); w.w = cvt_pk_bf16(v1[2], v1[3]);
                    *(u32x4*)(rowp + bj * HALF) = w; } }
    }
};
struct EpiResBf16 {
    static constexpr bool PERM = true;
    float* C; const bf16* R;
    __device__ __forceinline__ void operator()(const f32x4 (&acc)[2][2][4][2], const Unit& u, int wr, int wc, int fr, int fq) const {
        const int row0 = u.pm * BM + wr * 64 + fr, col0 = u.pn * BM + wc * 32 + 8 * fq;
#pragma unroll
        for (int ai = 0; ai < 2; ++ai)
#pragma unroll
            for (int m = 0; m < 4; ++m) { const size_t ro = (size_t)(row0 + ai * HALF + m * 16) * D + col0;
#pragma unroll
                for (int bj = 0; bj < 2; ++bj) { const u32x4 r = *(const u32x4*)(R + ro + bj * HALF);
                    f32x4 v0 = acc[ai][bj][m][0], v1 = acc[ai][bj][m][1];
                    v0[0] += __builtin_bit_cast(float, r.x << 16); v0[1] += __builtin_bit_cast(float, r.x & 0xffff0000u); v0[2] += __builtin_bit_cast(float, r.y << 16); v0[3] += __builtin_bit_cast(float, r.y & 0xffff0000u);
                    v1[0] += __builtin_bit_cast(float, r.z << 16); v1[1] += __builtin_bit_cast(float, r.z & 0xffff0000u); v1[2] += __builtin_bit_cast(float, r.w << 16); v1[3] += __builtin_bit_cast(float, r.w & 0xffff0000u);
                    *(f32x4*)(C + ro + bj * HALF) = v0; *(f32x4*)(C + ro + bj * HALF + 4) = v1; } }
    }
};
struct EpiF32 {
    static constexpr bool PERM = false;
    float* C; int ldc; const float* R; int ldr;
    __device__ __forceinline__ void operator()(const f32x4 (&acc)[2][2][4][2], const Unit& u, int wr, int wc, int fr, int fq) const {
        const int row0 = u.pm * BM + wr * 64 + fr, col0 = u.pn * BM + wc * 32 + 4 * fq;
#pragma unroll
        for (int ai = 0; ai < 2; ++ai)
#pragma unroll
            for (int m = 0; m < 4; ++m) { const size_t row = (size_t)(row0 + ai * HALF + m * 16);
#pragma unroll
                for (int bj = 0; bj < 2; ++bj)
#pragma unroll
                    for (int n = 0; n < 2; ++n) { const int col = col0 + bj * HALF + 16 * n; f32x4 v = acc[ai][bj][m][n];
                        if (R) v = v + *(const f32x4*)(R + row * ldr + col);
                        *(f32x4*)(C + row * ldc + col) = v; } }
    }
};
struct EpiBf16 {
    static constexpr bool PERM = true;
    bf16* O; int ldc;
    __device__ __forceinline__ void operator()(const f32x4 (&acc)[2][2][4][2], const Unit& u, int wr, int wc, int fr, int fq) const {
        const int row0 = u.pm * BM + wr * 64 + fr, col0 = u.pn * BM + wc * 32 + 8 * fq;
#pragma unroll
        for (int ai = 0; ai < 2; ++ai)
#pragma unroll
            for (int m = 0; m < 4; ++m) { bf16* rowp = O + (size_t)(row0 + ai * HALF + m * 16) * ldc + col0;
#pragma unroll
                for (int bj = 0; bj < 2; ++bj) { const f32x4 v0 = acc[ai][bj][m][0], v1 = acc[ai][bj][m][1];
                    u32x4 w; w.x = cvt_pk_bf16(v0[0], v0[1]); w.y = cvt_pk_bf16(v0[2], v0[3]); w.z = cvt_pk_bf16(v1[0], v1[1]); w.w = cvt_pk_bf16(v1[2], v1[3]);
                    *(u32x4*)(rowp + bj * HALF) = w; } }
    }
};
struct EpiGlu {
    static constexpr bool PERM = true;
    const bf16* Z; const float* bias; bf16* YM;
    __device__ __forceinline__ void operator()(const f32x4 (&acc)[2][2][4][2], const Unit& u, int wr, int wc, int fr, int fq) const {
        const int row0 = u.pm * BM + wr * 64 + fr, col0 = u.pn * BM + wc * 32 + 8 * fq;
#pragma unroll
        for (int ai = 0; ai < 2; ++ai)
#pragma unroll
            for (int m = 0; m < 4; ++m) { const size_t row = (size_t)(row0 + ai * HALF + m * 16);
#pragma unroll
                for (int bj = 0; bj < 2; ++bj) { const int col = col0 + bj * HALF;
                    const u32x4 zz = *(const u32x4*)(Z + row * 512 + col);
                    const f32x4 b0 = *(const f32x4*)(bias + col), b1 = *(const f32x4*)(bias + col + 4);
                    const f32x4 v0 = acc[ai][bj][m][0] + b0, v1 = acc[ai][bj][m][1] + b1;
                    float o[8]; const unsigned zw[4] = {zz.x, zz.y, zz.z, zz.w};
#pragma unroll
                    for (int q = 0; q < 4; ++q) { const float zl = __builtin_bit_cast(float, zw[q] << 16), zh = __builtin_bit_cast(float, zw[q] & 0xffff0000u);
                        const float al = (q < 2) ? v0[2 * q] : v1[2 * q - 4], ah = (q < 2) ? v0[2 * q + 1] : v1[2 * q - 3];
                        o[2 * q] = zl * sigmoidf_(al); o[2 * q + 1] = zh * sigmoidf_(ah); }
                    u32x4 w; w.x = cvt_pk_bf16(o[0], o[1]); w.y = cvt_pk_bf16(o[2], o[3]); w.z = cvt_pk_bf16(o[4], o[5]); w.w = cvt_pk_bf16(o[6], o[7]);
                    *(u32x4*)(YM + row * D + 512 + col) = w; } }
    }
};

template <bool GATHER_>
struct MoeOrderT {
    static constexpr bool GATHER = GATHER_;
    const bf16* A; const bf16* Bt; int lda, ldb, K; const int* tiles; const int* rows; int nunits, G, c; size_t bexp;
    __device__ void init(const bf16* A_, int lda_, const bf16* Bt_, int ldb_, int K_, const int* tiles_, int ntiles, size_t bexp_, const int* rows_) { A = A_; Bt = Bt_; lda = lda_; ldb = ldb_; K = K_; tiles = tiles_; rows = rows_; nunits = ntiles * 4; G = GN; c = GB; bexp = bexp_; }
    __device__ bool next(int i, Unit& u) const { const int L = i * G + c; if (L >= nunits) return false; u.pm = L >> 2; u.pn = L & 3; return true; }
    __device__ __forceinline__ const char* aptr(const Unit& u) const { return GATHER ? (const char*)A : (const char*)(A + (size_t)u.pm * BM * lda); }
    __device__ __forceinline__ int grow(const Unit& u, int r) const { return rows[u.pm * BM + r]; }
    __device__ __forceinline__ const char* bptr(const Unit& u) const { const int e = __hip_atomic_load(tiles + u.pm, __ATOMIC_RELAXED, __HIP_MEMORY_SCOPE_AGENT); return (const char*)(Bt + ((size_t)e * bexp + (size_t)u.pn * BM) * ldb); }
};
struct EpiSilu {
    static constexpr bool PERM = true;
    bf16* HID;
    __device__ __forceinline__ void operator()(const f32x4 (&acc)[2][2][4][2], const Unit& u, int wr, int wc, int fr, int fq) const {
        const int row0 = u.pm * BM + wr * 64 + fr, col0 = u.pn * HALF + wc * 32 + 8 * fq;
#pragma unroll
        for (int ai = 0; ai < 2; ++ai)
#pragma unroll
            for (int m = 0; m < 4; ++m) { const size_t row = (size_t)(row0 + ai * HALF + m * 16);
                float o[8];
#pragma unroll
                for (int n = 0; n < 2; ++n)
#pragma unroll
                    for (int q = 0; q < 4; ++q) { const float g = acc[ai][0][m][n][q], up = acc[ai][1][m][n][q]; o[4 * n + q] = g * sigmoidf_(g) * up; }
                u32x4 w; w.x = cvt_pk_bf16(o[0], o[1]); w.y = cvt_pk_bf16(o[2], o[3]); w.z = cvt_pk_bf16(o[4], o[5]); w.w = cvt_pk_bf16(o[6], o[7]);
                *(u32x4*)(HID + row * DEXP + col0) = w; }
    }
};
struct EpiGate {
    static constexpr bool PERM = true;
    bf16* Y; const float* gate;
    __device__ __forceinline__ void operator()(const f32x4 (&acc)[2][2][4][2], const Unit& u, int wr, int wc, int fr, int fq) const {
        const int row0 = u.pm * BM + wr * 64 + fr, col0 = u.pn * BM + wc * 32 + 8 * fq;
#pragma unroll
        for (int ai = 0; ai < 2; ++ai)
#pragma unroll
            for (int m = 0; m < 4; ++m) { const size_t row = (size_t)(row0 + ai * HALF + m * 16); const float gt = gate[row];
#pragma unroll
                for (int bj = 0; bj < 2; ++bj) { const f32x4 v0 = acc[ai][bj][m][0] * gt, v1 = acc[ai][bj][m][1] * gt;
                    u32x4 w; w.x = cvt_pk_bf16(v0[0], v0[1]); w.y = cvt_pk_bf16(v0[2], v0[3]); w.z = cvt_pk_bf16(v1[0], v1[1]); w.w = cvt_pk_bf16(v1[2], v1[3]);
                    *(u32x4*)(Y + row * D + col0 + bj * HALF) = w; } }
    }
};

struct EpiProj {
    static constexpr bool PERM = true;
    bf16* PROJ; bf16* US5;
    __device__ __forceinline__ void operator()(const f32x4 (&acc)[2][2][4][2], const Unit& u, int wr, int wc, int fr, int fq) const {
        const int row0 = u.pm * BM + wr * 64 + fr, col0 = u.pn * BM + wc * 32 + 8 * fq;
#pragma unroll
        for (int ai = 0; ai < 2; ++ai)
#pragma unroll
            for (int m = 0; m < 4; ++m) { const size_t row = (size_t)(row0 + ai * HALF + m * 16);
#pragma unroll
                for (int bj = 0; bj < 2; ++bj) { const f32x4 v0 = acc[ai][bj][m][0], v1 = acc[ai][bj][m][1]; const int col = col0 + bj * HALF;
                    u32x4 w; w.x = cvt_pk_bf16(v0[0], v0[1]); w.y = cvt_pk_bf16(v0[2], v0[3]); w.z = cvt_pk_bf16(v1[0], v1[1]); w.w = cvt_pk_bf16(v1[2], v1[3]);
                    if (col < DSHIFT) *(u32x4*)(PROJ + row * DSHIFT + col) = w;
                    else { const int cc = col - DSHIFT; *(u32x4*)(US5 + ((size_t)(cc >> 4) * M + row) * 16 + (cc & 15)) = w; } } }
    }
};
struct GroupOrder {
    static constexpr bool GATHER = false; __device__ __forceinline__ int grow(const Unit&, int) const { return 0; }
    const bf16* A; const bf16* Bt; int lda, ldb, K; int nM, nN, nunits, G, c; size_t sA, sB;
    __device__ void init(const bf16* A_, int lda_, size_t sA_, const bf16* Bt_, int ldb_, size_t sB_, int ngroups, int Mg, int Ng, int K_) {
        A = A_; Bt = Bt_; lda = lda_; ldb = ldb_; K = K_; sA = sA_; sB = sB_; nM = Mg / BM; nN = Ng / BM; nunits = ngroups * nM * nN; G = GN; c = GB; }
    __device__ bool next(int i, Unit& u) const { const int L = i * G + c; if (L >= nunits) return false; u.pn = L % nN; u.pm = L / nN; return true; }
    __device__ __forceinline__ const char* aptr(const Unit& u) const { const int g = u.pm / nM, pm = u.pm % nM; return (const char*)(A + (size_t)g * sA + (size_t)pm * BM * lda); }
    __device__ __forceinline__ const char* bptr(const Unit& u) const { const int g = u.pm / nM; return (const char*)(Bt + (size_t)g * sB + (size_t)u.pn * BM * ldb); }
};
struct EpiS5a {
    static constexpr bool PERM = false;
    bf16* YI; float* F;
    __device__ __forceinline__ void operator()(const f32x4 (&acc)[2][2][4][2], const Unit& u, int wr, int wc, int fr, int fq) const {
        const int row0 = u.pm * BM + wr * 64 + fr, col0 = u.pn * BM + wc * 32 + 4 * fq;
#pragma unroll
        for (int ai = 0; ai < 2; ++ai)
#pragma unroll
            for (int m = 0; m < 4; ++m) { const size_t row = (size_t)(row0 + ai * HALF + m * 16);
#pragma unroll
                for (int bj = 0; bj < 2; ++bj)
#pragma unroll
                    for (int n = 0; n < 2; ++n) { const int col = col0 + bj * HALF + 16 * n; const f32x4 v = acc[ai][bj][m][n];
                        if (col < 512) { uint2 w; w.x = cvt_pk_bf16(v[0], v[1]); w.y = cvt_pk_bf16(v[2], v[3]); *(uint2*)(YI + row * 512 + col) = w; }
                        else if (col < 640) *(f32x4*)(F + row * 128 + (col - 512)) = v; } }
    }
};
struct EpiS5b {
    static constexpr bool PERM = true;
    const bf16* YI; bf16* Z;
    __device__ __forceinline__ void operator()(const f32x4 (&acc)[2][2][4][2], const Unit& u, int wr, int wc, int fr, int fq) const {
        const int row0 = u.pm * BM + wr * 64 + fr, col0 = u.pn * BM + wc * 32 + 8 * fq;
#pragma unroll
        for (int ai = 0; ai < 2; ++ai)
#pragma unroll
            for (int m = 0; m < 4; ++m) { const int row = row0 + ai * HALF + m * 16; const int g = row / S5R, rl = row % S5R;
#pragma unroll
                for (int bj = 0; bj < 2; ++bj) { const int col = col0 + bj * HALF;
                    const u32x4 yi = *(const u32x4*)(YI + (size_t)row * 512 + col);
                    const unsigned yw[4] = {yi.x, yi.y, yi.z, yi.w};
                    const f32x4 v0 = acc[ai][bj][m][0], v1 = acc[ai][bj][m][1];
                    float o[8];
#pragma unroll
                    for (int q = 0; q < 4; ++q) { const float al = (q < 2) ? v0[2 * q] : v1[2 * q - 4], ah = (q < 2) ? v0[2 * q + 1] : v1[2 * q - 3];
                        o[2 * q] = gelu_tanh(al + __builtin_bit_cast(float, yw[q] << 16)); o[2 * q + 1] = gelu_tanh(ah + __builtin_bit_cast(float, yw[q] & 0xffff0000u)); }
                    u32x4 w; w.x = cvt_pk_bf16(o[0], o[1]); w.y = cvt_pk_bf16(o[2], o[3]); w.z = cvt_pk_bf16(o[4], o[5]); w.w = cvt_pk_bf16(o[6], o[7]);
                    const size_t tok = (size_t)rl * S5L + (col >> 4);
                    *(u32x4*)(Z + tok * 512 + g * 16 + (col & 15)) = w; } }
    }
};
struct AttnOrder {
    static constexpr bool GATHER = false; __device__ __forceinline__ int grow(const Unit&, int) const { return 0; }
    const bf16* A; const bf16* Bt; int lda, ldb, K; int G, c; int mode;
    __device__ void init(const bf16* A_, const bf16* Bt_, int ldb_, int mode_) { A = A_; Bt = Bt_; lda = D; ldb = ldb_; K = 256; G = GN; c = GB; mode = mode_; }
    __device__ bool next(int i, Unit& u) const { const int L = i * G + c; if (L >= NB * 4 * 32) return false; u.pn = L & 3; u.pm = L >> 2; return true; }
    __device__ __forceinline__ const char* aptr(const Unit& u) const { return (const char*)(A + (size_t)u.pm * BM * D + u.pn * 256); }
    __device__ __forceinline__ const char* bptr(const Unit& u) const { const int b = u.pm >> 5;
        return (const char*)(mode == 0 ? Bt + (size_t)b * 256 * ldb + u.pn * 256 : Bt + (size_t)u.pn * 256 * ldb + b * 256); }
};
struct EpiSoftmax {
    static constexpr bool PERM = true;
    bf16* P; PG8_LAS float* scr;
    __device__ __forceinline__ void operator()(f32x4 (&acc)[2][2][4][2], const Unit& u, int wr, int wc, int fr, int fq) const {
        const float SC = 0.0625f * 1.4426950408889634f;
        PG8_LAS float* smax = scr; PG8_LAS float* ssum = scr + 1024;
#pragma unroll
        for (int ai = 0; ai < 2; ++ai)
#pragma unroll
            for (int m = 0; m < 4; ++m) { float t = -3.0e38f;
#pragma unroll
                for (int bj = 0; bj < 2; ++bj)
#pragma unroll
                    for (int n = 0; n < 2; ++n) { const f32x4 v = acc[ai][bj][m][n]; t = fmaxf(t, fmaxf(fmaxf(v[0], v[1]), fmaxf(v[2], v[3]))); }
                t = fmaxf(t, __shfl_xor(t, 16)); t = fmaxf(t, __shfl_xor(t, 32));
                if (fq == 0) smax[(ai * HALF + wr * 64 + m * 16 + fr) * 4 + wc] = t; }
        asm volatile("s_waitcnt lgkmcnt(0)" ::: "memory"); __builtin_amdgcn_s_barrier(); asm volatile("" ::: "memory");
#pragma unroll
        for (int ai = 0; ai < 2; ++ai)
#pragma unroll
            for (int m = 0; m < 4; ++m) { const f32x4 q = *(const PG8_LAS f32x4*)(smax + (ai * HALF + wr * 64 + m * 16 + fr) * 4);
                const float mm = fmaxf(fmaxf(q[0], q[1]), fmaxf(q[2], q[3])) * SC; float s = 0.f;
#pragma unroll
                for (int bj = 0; bj < 2; ++bj)
#pragma unroll
                    for (int n = 0; n < 2; ++n)
#pragma unroll
                        for (int e = 0; e < 4; ++e) { const float p = __builtin_amdgcn_exp2f(acc[ai][bj][m][n][e] * SC - mm); acc[ai][bj][m][n][e] = p; s += p; }
                s += __shfl_xor(s, 16); s += __shfl_xor(s, 32);
                if (fq == 0) ssum[(ai * HALF + wr * 64 + m * 16 + fr) * 4 + wc] = s; }
        asm volatile("s_waitcnt lgkmcnt(0)" ::: "memory"); __builtin_amdgcn_s_barrier(); asm volatile("" ::: "memory");
        const int row0 = u.pm * BM + wr * 64 + fr, col0 = u.pn * 256 + wc * 32 + 8 * fq;
#pragma unroll
        for (int ai = 0; ai < 2; ++ai)
#pragma unroll
            for (int m = 0; m < 4; ++m) { const f32x4 q = *(const PG8_LAS f32x4*)(ssum + (ai * HALF + wr * 64 + m * 16 + fr) * 4);
                const float iv = 1.f / ((q[0] + q[1]) + (q[2] + q[3]));
                bf16* rowp = P + (size_t)(row0 + ai * HALF + m * 16) * D + col0;
#pragma unroll
                for (int bj = 0; bj < 2; ++bj) { const f32x4 v0 = acc[ai][bj][m][0] * iv, v1 = acc[ai][bj][m][1] * iv; u32x4 w;
                    w.x = cvt_pk_bf16(v0[0], v0[1]); w.y = cvt_pk_bf16(v0[2], v0[3]); w.z = cvt_pk_bf16(v1[0], v1[1]); w.w = cvt_pk_bf16(v1[2], v1[3]);
                    *(u32x4*)(rowp + bj * HALF) = w; } }
    }
};
struct EpiAttnO {
    static constexpr bool PERM = true;
    bf16* O;
    __device__ __forceinline__ void operator()(const f32x4 (&acc)[2][2][4][2], const Unit& u, int wr, int wc, int fr, int fq) const {
        const int row0 = u.pm * BM + wr * 64 + fr, col0 = u.pn * 256 + wc * 32 + 8 * fq;
#pragma unroll
        for (int ai = 0; ai < 2; ++ai)
#pragma unroll
            for (int m = 0; m < 4; ++m) { bf16* rowp = O + (size_t)(row0 + ai * HALF + m * 16) * D + col0;
#pragma unroll
                for (int bj = 0; bj < 2; ++bj) { const f32x4 v0 = acc[ai][bj][m][0], v1 = acc[ai][bj][m][1];
                    u32x4 w; w.x = cvt_pk_bf16(v0[0], v0[1]); w.y = cvt_pk_bf16(v0[2], v0[3]); w.z = cvt_pk_bf16(v1[0], v1[1]); w.w = cvt_pk_bf16(v1[2], v1[3]);
                    *(u32x4*)(rowp + bj * HALF) = w; } }
    }
};

struct EpiLora {
    static constexpr bool PERM = true;
    bf16* LW; size_t ostride; const float* w0; const float* a0;
    __device__ __forceinline__ void operator()(const f32x4 (&acc)[2][2][4][2], const Unit& u, int wr, int wc, int fr, int fq) const {
        const int row0 = u.pm * BM + wr * 64 + fr, col0 = u.pn * BM + wc * 32 + 8 * fq;
        const int kind = u.pn >> 1;
        bf16* O = LW + (size_t)kind * ostride;
#pragma unroll
        for (int bj = 0; bj < 2; ++bj) { const int col = (col0 + bj * HALF) & 511;
            f32x4 b0 = (f32x4){0.f, 0.f, 0.f, 0.f}, b1 = b0;
            if (kind == 0) { b0 = *(const f32x4*)(w0 + col); b1 = *(const f32x4*)(w0 + col + 4); }
            else if (kind == 1) { b0 = *(const f32x4*)(a0 + col); b1 = *(const f32x4*)(a0 + col + 4); }
#pragma unroll
            for (int ai = 0; ai < 2; ++ai)
#pragma unroll
                for (int m = 0; m < 4; ++m) { const size_t row = (size_t)(row0 + ai * HALF + m * 16);
                    const f32x4 v0 = acc[ai][bj][m][0] + b0, v1 = acc[ai][bj][m][1] + b1; float o[8];
#pragma unroll
                    for (int e = 0; e < 8; ++e) { float x = (e < 4) ? v0[e & 3] : v1[e & 3];
                        if (kind == 0) x = -0.6065306597126334f * sigmoidf_(x);
                        else if (kind == 1) x = sigmoidf_(x);
                        o[e] = x; }
                    u32x4 w; w.x = cvt_pk_bf16(o[0], o[1]); w.y = cvt_pk_bf16(o[2], o[3]); w.z = cvt_pk_bf16(o[4], o[5]); w.w = cvt_pk_bf16(o[6], o[7]);
                    *(u32x4*)(O + row * 512 + col) = w; } }
    }
};

struct TileOrder {
    static constexpr bool GATHER = false; __device__ __forceinline__ int grow(const Unit&, int) const { return 0; }
    const bf16* A; const bf16* Bt; int lda, ldb, K, nN, pm;
    __device__ void init(const bf16* A_, int lda_, const bf16* Bt_, int ldb_, int K_, int nN_, int pm_) { A = A_; Bt = Bt_; lda = lda_; ldb = ldb_; K = K_; nN = nN_; pm = pm_; }
    __device__ bool next(int i, Unit& u) const { if (i >= nN) return false; int pm_ = pm; asm volatile("" : "+s"(pm_)); u.pm = pm_; u.pn = (i + (GB >> 3)) & (nN - 1); return true; }
    __device__ __forceinline__ const char* aptr(const Unit& u) const { return (const char*)(A + (size_t)u.pm * BM * lda); }
    __device__ __forceinline__ const char* bptr(const Unit& u) const { return (const char*)(Bt + (size_t)u.pn * BM * ldb); }
};
struct AttnTileOrder {
    static constexpr bool GATHER = false; __device__ __forceinline__ int grow(const Unit&, int) const { return 0; }
    const bf16* A; const bf16* Bt; int lda, ldb, K, pm, mode;
    __device__ void init(const bf16* A_, const bf16* Bt_, int ldb_, int mode_, int pm_) { A = A_; Bt = Bt_; lda = D; ldb = ldb_; K = 256; mode = mode_; pm = pm_; }
    __device__ bool next(int i, Unit& u) const { if (i >= 4) return false; int pm_ = pm; asm volatile("" : "+s"(pm_)); u.pm = pm_; u.pn = (i + (GB >> 3)) & 3; return true; }
    __device__ __forceinline__ const char* aptr(const Unit& u) const { return (const char*)(A + (size_t)u.pm * BM * D + u.pn * 256); }
    __device__ __forceinline__ const char* bptr(const Unit& u) const { const int b = u.pm >> 5;
        return (const char*)(mode == 0 ? Bt + (size_t)b * 256 * ldb + u.pn * 256 : Bt + (size_t)u.pn * 256 * ldb + b * 256); }
};
}

#define LAS __attribute__((address_space(3)))
__device__ __forceinline__ void transpose_item(const float* __restrict__ W, int K, int N, bf16* __restrict__ WT, int ldt, int row_off, int col_off, float* scr, int item, int lane, const float* __restrict__ kscale, int ldw = 0) {
    if (ldw == 0) ldw = N;
    const int nblk = N / 32, kb = item / nblk, nb = item % nblk, k0 = 64 * kb, n0 = 32 * nb;
#pragma unroll 8
    for (int i = 0; i < 32; ++i) { const int kk = 2 * i + (lane >> 5); float v = W[(size_t)(k0 + kk) * ldw + n0 + (lane & 31)]; if (kscale) v *= kscale[k0 + kk]; scr[kk * 33 + (lane & 31)] = v; }
    __builtin_amdgcn_s_waitcnt(0xc07f); asm volatile("" ::: "memory");
    const int c = lane & 7;
#pragma unroll
    for (int j = 0; j < 4; ++j) { const int n = (lane >> 3) + 8 * j; const float* s = scr + (8 * c) * 33 + n;
        uint4 o; o.x = pk2(s[0 * 33], s[1 * 33]); o.y = pk2(s[2 * 33], s[3 * 33]); o.z = pk2(s[4 * 33], s[5 * 33]); o.w = pk2(s[6 * 33], s[7 * 33]);
        *(uint4*)(WT + (size_t)(row_off + n0 + n) * ldt + col_off + k0 + 8 * c) = o; }
    __builtin_amdgcn_s_waitcnt(0xc07f); asm volatile("" ::: "memory");
}
__device__ __forceinline__ void transpose_ph(const int WID_, const float* W, int K, int N, bf16* WT, int ldt, int row_off, int col_off, char* lds, const float* kscale = nullptr) {
    const int lane = (WID_ * 64 + lane_id()) & 63, wv = (WID_ * 64 + lane_id()) >> 6;
    float* scr = (float*)(lds + wv * 16384);
    const int nitems = (K / 64) * (N / 32);
    for (int it = GB * 8 + wv; it < nitems; it += GN * 8) transpose_item(W, K, N, WT, ldt, row_off, col_off, scr, it, lane, kscale);
}

template <typename TO>
__device__ __forceinline__ void rmsnorm_ph(const int WID_, const float* __restrict__ x, const float* __restrict__ w, TO* __restrict__ out, int rows, int row_lo = 0, int vb = GB, int nvb = GN) {
    const int lane = lane_id(), wv = WID_;
    float4 g[4];
#pragma unroll
    for (int j = 0; j < 4; ++j) g[j] = *(const float4*)(w + (lane + 64 * j) * 4);
    for (int row = row_lo + (vb * 8 + wv) * 2; row < rows; row += nvb * 16) {
        const float4* xr = (const float4*)(x + (size_t)row * D);
        float4 v[2][4]; float s[2] = {0.f, 0.f};
#pragma unroll
        for (int r = 0; r < 2; ++r)
#pragma unroll
            for (int j = 0; j < 4; ++j) v[r][j] = xr[r * (D / 4) + lane + 64 * j];
#pragma unroll
        for (int r = 0; r < 2; ++r) {
#pragma unroll
            for (int j = 0; j < 4; ++j) s[r] += v[r][j].x * v[r][j].x + v[r][j].y * v[r][j].y + v[r][j].z * v[r][j].z + v[r][j].w * v[r][j].w;
            s[r] = wave_sum(s[r]);
            const float rs = rsqrtf(s[r] * (1.f / D) + 1e-6f);
#pragma unroll
            for (int j = 0; j < 4; ++j) {
                uint2 o; o.x = pk2(v[r][j].x * rs * g[j].x, v[r][j].y * rs * g[j].y); o.y = pk2(v[r][j].z * rs * g[j].z, v[r][j].w * rs * g[j].w);
                *(uint2*)(out + (size_t)(row + r) * D + (lane + 64 * j) * 4) = o;
            }
        }
    }
}

__device__ __forceinline__ void rwkv_lin_ph(const int WID_, const bf16* __restrict__ proj, const float* __restrict__ mu, bf16* __restrict__ lin) {
    const int lane = lane_id(), wv = WID_;
    const float4 m4 = *(const float4*)(mu + 1536 + 4 * lane);
    const float mm[4] = {m4.x, m4.y, m4.z, m4.w};
    for (int m0 = (GB * 8 + wv) * 4; m0 < M; m0 += GN * 32) {
        uint2 z[4], zp[4];
#pragma unroll
        for (int i = 0; i < 4; ++i) { const int m = m0 + i; z[i] = *(const uint2*)(proj + (size_t)m * DSHIFT + 1536 + 4 * lane);
            zp[i] = make_uint2(0, 0); if ((m & (S - 1)) != 0) zp[i] = *(const uint2*)(proj + (size_t)(m - 1) * DSHIFT + 1536 + 4 * lane); }
#pragma unroll
        for (int i = 0; i < 4; ++i) {
            float c[4] = {__builtin_bit_cast(float, z[i].x << 16), __builtin_bit_cast(float, z[i].x & 0xffff0000u), __builtin_bit_cast(float, z[i].y << 16), __builtin_bit_cast(float, z[i].y & 0xffff0000u)};
            const float q[4] = {__builtin_bit_cast(float, zp[i].x << 16), __builtin_bit_cast(float, zp[i].x & 0xffff0000u), __builtin_bit_cast(float, zp[i].y << 16), __builtin_bit_cast(float, zp[i].y & 0xffff0000u)};
#pragma unroll
            for (int e = 0; e < 4; ++e) { float t = c[e] + (q[e] - c[e]) * mm[e];
                if (lane < 16) t = 1.f - 2.f / (1.f + __expf(2.f * t));
                else if (lane >= 32) t = sigmoidf_(t);
                c[e] = t; }
            uint2 o; o.x = pk2(c[0], c[1]); o.y = pk2(c[2], c[3]);
            *(uint2*)(lin + (size_t)(m0 + i) * 256 + 4 * lane) = o;
        }
    }
}
__device__ __forceinline__ void rwkv_wl_ph(const int WID_, const float* __restrict__ wdec, const float* __restrict__ wiclr, const float* __restrict__ wgate, bf16* __restrict__ wl) {
    for (int i = GB * NT + (WID_ * 64 + lane_id()); i < 1536 * 256; i += GN * NT) {
        const int k = i & 255, n = i >> 8; float v = 0.f;
        if (n < 512) { if (k < 64) v = wdec[k * 512 + n]; }
        else if (n < 1024) { if (k >= 64 && k < 128) v = wiclr[(k - 64) * 512 + (n - 512)]; }
        else { if (k >= 128) v = wgate[(k - 128) * 512 + (n - 1024)]; }
        wl[i] = f2bf(v);
    }
}
template <int CTRL> __device__ __forceinline__ float dpp16(float x) { return __builtin_bit_cast(float, __builtin_amdgcn_update_dpp(0, __builtin_bit_cast(int, x), CTRL, 0xf, 0xf, true)); }
constexpr int RW_ITEMS = NB * 8;

namespace ck {
#define CK_BAR() do { asm volatile("s_waitcnt lgkmcnt(0)" ::: "memory"); __builtin_amdgcn_s_barrier(); asm volatile("" ::: "memory"); } while (0)
typedef float f32x2_t __attribute__((ext_vector_type(2)));
typedef __bf16 bf16x2_t __attribute__((ext_vector_type(2)));
__device__ __forceinline__ unsigned cvtpk(float lo, float hi) { const f32x2_t v = {lo, hi}; const bf16x2_t b = __builtin_convertvector(v, bf16x2_t); return __builtin_bit_cast(unsigned, b); }
typedef short bf16x8 __attribute__((ext_vector_type(8)));
typedef float f32x16 __attribute__((ext_vector_type(16)));
constexpr int LD = 72;
constexpr int MB = 64 * LD * 2;
constexpr int O_AB = 0, O_RB = MB, O_BB = 2 * MB, O_KB = 3 * MB, O_AT = 4 * MB, O_W1T = 5 * MB, O_BT = 6 * MB, O_KT = 7 * MB, O_VT = 8 * MB,
              O_NM = 9 * MB, O_AAK = 10 * MB, O_ARB = 11 * MB, O_ARK = 12 * MB, O_G = 13 * MB, O_TOT = O_G + 16384;
constexpr int O_TM = O_AB, O_X1T = O_BB, O_NMF = O_G, O_TT = O_G + 8192, O_ZT = O_TT + 5120;
constexpr int ITEM_BYTES = 32768;
template <int K, typename PA, typename PB>
__device__ __forceinline__ f32x16 mm_tile(f32x16 acc, PA A, int lda, PB B, int ldb, int lane) {
    const int r = lane & 31, h = lane >> 5;
    bf16x8 a[K / 16], b[K / 16];
#pragma unroll
    for (int q = 0; q < K / 16; ++q) { a[q] = *(const bf16x8*)(A + r * lda + 16 * q + 8 * h); b[q] = *(const bf16x8*)(B + r * ldb + 16 * q + 8 * h); }
#pragma unroll
    for (int q = 0; q < K / 16; ++q) acc = __builtin_amdgcn_mfma_f32_32x32x16_bf16(a[q], b[q], acc, 0, 0, 0);
    return acc;
}
__device__ __forceinline__ int crow(int reg, int h) { return (reg & 3) + 8 * (reg >> 2) + 4 * h; }
__device__ __forceinline__ void store_tr(const f32x16& acc, bf16* Ct, int ldct, int lane) {
    const int c = lane & 31, h = lane >> 5;
#pragma unroll
    for (int g = 0; g < 4; ++g) { uint2 w; w.x = cvtpk(acc[4 * g], acc[4 * g + 1]); w.y = cvtpk(acc[4 * g + 2], acc[4 * g + 3]); *(uint2*)(Ct + c * ldct + 8 * g + 4 * h) = w; }
}
__device__ __forceinline__ void store_rm(const f32x16& acc, bf16* C, int ldc, int lane) {
    const int c = lane & 31, h = lane >> 5;
#pragma unroll
    for (int rg = 0; rg < 16; ++rg) C[crow(rg, h) * ldc + c] = f2bf(acc[rg]);
}
__device__ __forceinline__ f32x16 zero16() { return (f32x16){0.f, 0.f, 0.f, 0.f, 0.f, 0.f, 0.f, 0.f, 0.f, 0.f, 0.f, 0.f, 0.f, 0.f, 0.f, 0.f}; }
__device__ __forceinline__ void store_frag16(const f32x16& acc, bf16* base, int t0, int t1, int lane) {
    const int cc = lane & 31, hh = lane >> 5, col = 32 * t1 + cc;
#pragma unroll
    for (int g = 0; g < 4; ++g) { const int row = 32 * t0 + 8 * g + 4 * hh;
        uint2 w; w.x = cvtpk(acc[4 * g], acc[4 * g + 1]); w.y = cvtpk(acc[4 * g + 2], acc[4 * g + 3]);
        *(uint2*)(base + (((row >> 4) * 4 + (col >> 4)) * 64 + (col & 15) + 16 * ((row & 15) >> 2)) * 4) = w; }
}
struct In { const bf16* proj; const bf16* LW; const bf16* AA; const float* mu; const float* k_k; const float* k_a; const float* r_k; float* RK; char* items; };

__device__ __forceinline__ void phase1(const int WID_, const In& I, char* lds) {
    const int wv = WID_;
#define MAT(off) ((bf16*)(lds + (off)))
    float* G = (float*)(lds + O_G); float* TOT = (float*)(lds + O_TOT); float* NMF = (float*)(lds + O_NMF);
    uint4 nx_r, nx_k, nx_v, nx_qr, nx_qk, nx_qv, nx_a, nx_l;
    { const int lane0 = lane_id(), tid0 = wv * 64 + lane0; const int item = GB;
      if (item < NB * 8 * (S / 64)) { const int c = item & 127, h = (item >> 7) & 7, b = item >> 10, s = tid0 >> 3, cg = tid0 & 7, ch0 = h * 64 + cg * 8, t = c * 64 + s; const size_t m = (size_t)b * S + t;
        const bf16* z = I.proj + m * DSHIFT + ch0;
        nx_r = *(const uint4*)(z); nx_k = *(const uint4*)(z + 512); nx_v = *(const uint4*)(z + 1024);
        nx_qr = make_uint4(0, 0, 0, 0); nx_qk = nx_qr; nx_qv = nx_qr;
        if (t > 0) { nx_qr = *(const uint4*)(z - DSHIFT); nx_qk = *(const uint4*)(z + 512 - DSHIFT); nx_qv = *(const uint4*)(z + 1024 - DSHIFT); }
        nx_a = *(const uint4*)(I.AA + m * 512 + ch0); nx_l = *(const uint4*)(I.LW + m * 512 + ch0); } }
    for (int item = GB; item < NB * 8 * (S / 64); item += GN) {
        const int lane = lane_id(), tid = wv * 64 + lane;
        const int c = item & 127, h = (item >> 7) & 7, b = item >> 10;
        char* out = I.items + (size_t)item * ITEM_BYTES;
        const int s = tid >> 3, cg = tid & 7, ch0 = h * 64 + cg * 8, t = c * 64 + s; const size_t m = (size_t)b * S + t;
        float r_[8], kp_[8], v_[8], kk_[8], b_[8];
        {
            const uint4 gr = nx_r, gk = nx_k, gv = nx_v, qr = nx_qr, qk = nx_qk, qv = nx_qv, ga = nx_a, gl = nx_l;
            const float4 c_mr0 = *(const float4*)(I.mu + ch0), c_mr1 = *(const float4*)(I.mu + ch0 + 4), c_mk0 = *(const float4*)(I.mu + 512 + ch0), c_mk1 = *(const float4*)(I.mu + 512 + ch0 + 4);
            const float4 c_mv0 = *(const float4*)(I.mu + 1024 + ch0), c_mv1 = *(const float4*)(I.mu + 1024 + ch0 + 4), c_kk0 = *(const float4*)(I.k_k + ch0), c_kk1 = *(const float4*)(I.k_k + ch0 + 4);
            const float4 c_ka0 = *(const float4*)(I.k_a + ch0), c_ka1 = *(const float4*)(I.k_a + ch0 + 4), c_rk0 = *(const float4*)(I.r_k + ch0), c_rk1 = *(const float4*)(I.r_k + ch0 + 4);
            const float mur[8] = {c_mr0.x, c_mr0.y, c_mr0.z, c_mr0.w, c_mr1.x, c_mr1.y, c_mr1.z, c_mr1.w}, muk[8] = {c_mk0.x, c_mk0.y, c_mk0.z, c_mk0.w, c_mk1.x, c_mk1.y, c_mk1.z, c_mk1.w};
            const float muv[8] = {c_mv0.x, c_mv0.y, c_mv0.z, c_mv0.w, c_mv1.x, c_mv1.y, c_mv1.z, c_mv1.w}, ckk[8] = {c_kk0.x, c_kk0.y, c_kk0.z, c_kk0.w, c_kk1.x, c_kk1.y, c_kk1.z, c_kk1.w};
            const float cka[8] = {c_ka0.x, c_ka0.y, c_ka0.z, c_ka0.w, c_ka1.x, c_ka1.y, c_ka1.z, c_ka1.w}, crk[8] = {c_rk0.x, c_rk0.y, c_rk0.z, c_rk0.w, c_rk1.x, c_rk1.y, c_rk1.z, c_rk1.w};
            const unsigned wr[4] = {gr.x, gr.y, gr.z, gr.w}, wk[4] = {gk.x, gk.y, gk.z, gk.w}, wv4[4] = {gv.x, gv.y, gv.z, gv.w};
            const unsigned pr[4] = {qr.x, qr.y, qr.z, qr.w}, pk[4] = {qk.x, qk.y, qk.z, qk.w}, pv[4] = {qv.x, qv.y, qv.z, qv.w};
            const unsigned wa[4] = {ga.x, ga.y, ga.z, ga.w}, wl[4] = {gl.x, gl.y, gl.z, gl.w};
            float ss = 0.f, rk = 0.f, a_[8];
#pragma unroll
            for (int e = 0; e < 8; ++e) { const int w_ = e >> 1; const bool hi = e & 1;
                auto ex = [&](unsigned u) { return hi ? __builtin_bit_cast(float, u & 0xffff0000u) : __builtin_bit_cast(float, u << 16); };
                float x = ex(wr[w_]); r_[e] = x + (ex(pr[w_]) - x) * mur[e];
                x = ex(wk[w_]); const float k = x + (ex(pk[w_]) - x) * muk[e];
                x = ex(wv4[w_]); v_[e] = x + (ex(pv[w_]) - x) * muv[e];
                a_[e] = ex(wa[w_]); kk_[e] = k * ckk[e]; ss += kk_[e] * kk_[e];
                kp_[e] = k * (1.f + (a_[e] - 1.f) * cka[e]); rk += r_[e] * kp_[e] * crk[e];
                G[s * 64 + cg * 8 + e] = ex(wl[w_]); }
            ss += dpp16<0xB1>(ss); ss += dpp16<0x4E>(ss); ss += dpp16<0x141>(ss);
            const float inv = 1.f / fmaxf(sqrtf(ss), 1e-12f);
#pragma unroll
            for (int e = 0; e < 8; ++e) { kk_[e] *= inv; b_[e] = kk_[e] * a_[e]; }
            rk += dpp16<0xB1>(rk); rk += dpp16<0x4E>(rk); rk += dpp16<0x141>(rk);
            if (cg == 0) I.RK[m * 8 + h] = rk;
        }
        CK_BAR();
        { const int ch = tid & 63, part = tid >> 6; float run = 0.f;
#pragma unroll
          for (int i = 0; i < 8; ++i) { run += G[(8 * part + i) * 64 + ch]; G[(8 * part + i) * 64 + ch] = run; }
          TOT[part * 64 + ch] = run; }
        CK_BAR();
        { const int ch = tid & 63, part = tid >> 6; float off = 0.f;
          for (int p = 0; p < part; ++p) off += TOT[p * 64 + ch];
#pragma unroll
          for (int i = 0; i < 8; ++i) G[(8 * part + i) * 64 + ch] += off; }
        CK_BAR();
        float glast[8];
        {
            unsigned pab[4], prb[4], pbb[4], pkb[4];
            float ab[8], rb[8], bb[8], kb[8], bt[8], kt[8];
            const float4 g0_ = *(const float4*)(G + s * 64 + cg * 8), g1_ = *(const float4*)(G + s * 64 + cg * 8 + 4);
            const int sm = (s > 0) ? s - 1 : 0; const float msk = (s > 0) ? 1.f : 0.f;
            const float4 m0_ = *(const float4*)(G + sm * 64 + cg * 8), m1_ = *(const float4*)(G + sm * 64 + cg * 8 + 4);
            const float4 l0_ = *(const float4*)(G + 63 * 64 + cg * 8), l1_ = *(const float4*)(G + 63 * 64 + cg * 8 + 4);
            const float gv_[8] = {g0_.x, g0_.y, g0_.z, g0_.w, g1_.x, g1_.y, g1_.z, g1_.w}, mv_[8] = {m0_.x, m0_.y, m0_.z, m0_.w, m1_.x, m1_.y, m1_.z, m1_.w}, lv_[8] = {l0_.x, l0_.y, l0_.z, l0_.w, l1_.x, l1_.y, l1_.z, l1_.w};
#pragma unroll
            for (int e = 0; e < 8; ++e) { const float g = gv_[e], gm1 = mv_[e] * msk, gL = lv_[e];
                glast[e] = gL;
                const float eg = __expf(g), eng = __expf(-g), egm = __expf(gm1), egl = __expf(gL - g);
                ab[e] = -kk_[e] * egm; rb[e] = r_[e] * eg; bb[e] = b_[e] * eng; kb[e] = kp_[e] * eng; bt[e] = b_[e] * egl; kt[e] = kp_[e] * egl; }
#pragma unroll
            for (int q = 0; q < 4; ++q) { pab[q] = pk2(ab[2 * q], ab[2 * q + 1]); prb[q] = pk2(rb[2 * q], rb[2 * q + 1]); pbb[q] = pk2(bb[2 * q], bb[2 * q + 1]); pkb[q] = pk2(kb[2 * q], kb[2 * q + 1]); }
            *(uint4*)(MAT(O_AB) + s * LD + cg * 8) = make_uint4(pab[0], pab[1], pab[2], pab[3]);
            *(uint4*)(MAT(O_RB) + s * LD + cg * 8) = make_uint4(prb[0], prb[1], prb[2], prb[3]);
            *(uint4*)(MAT(O_BB) + s * LD + cg * 8) = make_uint4(pbb[0], pbb[1], pbb[2], pbb[3]);
            *(uint4*)(MAT(O_KB) + s * LD + cg * 8) = make_uint4(pkb[0], pkb[1], pkb[2], pkb[3]);
#pragma unroll
            for (int e = 0; e < 8; ++e) { const int k = cg * 8 + e;
                MAT(O_AT)[k * LD + s] = f2bf(ab[e]); MAT(O_BT)[k * LD + s] = f2bf(bt[e]); MAT(O_KT)[k * LD + s] = f2bf(kt[e]); MAT(O_VT)[k * LD + s] = f2bf(v_[e]); }
        }
        CK_BAR();
        { const int itn = item + GN;
          if (itn < NB * 8 * (S / 64)) { const int c2 = itn & 127, h2 = (itn >> 7) & 7, b2 = itn >> 10, ch2 = h2 * 64 + cg * 8, t2 = c2 * 64 + s; const size_t m2 = (size_t)b2 * S + t2;
            const bf16* z = I.proj + m2 * DSHIFT + ch2;
            nx_r = *(const uint4*)(z); nx_k = *(const uint4*)(z + 512); nx_v = *(const uint4*)(z + 1024);
            nx_qr = make_uint4(0, 0, 0, 0); nx_qk = nx_qr; nx_qv = nx_qr;
            if (t2 > 0) { nx_qr = *(const uint4*)(z - DSHIFT); nx_qk = *(const uint4*)(z + 512 - DSHIFT); nx_qv = *(const uint4*)(z + 1024 - DSHIFT); }
            nx_a = *(const uint4*)(I.AA + m2 * 512 + ch2); nx_l = *(const uint4*)(I.LW + m2 * 512 + ch2); } }
        if (s == 63) {
#pragma unroll
            for (int e = 0; e < 8; ++e) TOT[cg * 8 + e] = __expf(glast[e]);
        }
        {
            const int mat = tid >> 7, row = (tid >> 2) & 31, chunk = tid & 3;
            *(uint4*)(MAT(O_NM + mat * MB) + row * LD + 32 + chunk * 8) = make_uint4(0, 0, 0, 0);
        }
        for (int task = wv; task < 12; task += 8) {
            const int mat = task / 3, tt = task % 3, st = (tt == 0) ? 0 : 1, jt = (tt == 2) ? 1 : 0;
            const bf16* Asrc = MAT((mat & 1) ? O_KB : O_BB) + 32 * jt * LD;
            const bf16* Bsrc = MAT((mat >> 1) ? O_RB : O_AB) + 32 * st * LD;
            f32x16 acc = mm_tile<64>(zero16(), Asrc, LD, Bsrc, LD, lane);
            const int cs = 32 * st + (lane & 31), hh = lane >> 5; const bool incl = (mat >> 1) != 0;
#pragma unroll
            for (int rg = 0; rg < 16; ++rg) { const int j = 32 * jt + crow(rg, hh); const bool keep = incl ? (j <= cs) : (j < cs); if (!keep) acc[rg] = 0.f; }
            store_tr(acc, MAT(O_NM + mat * MB) + 32 * st * LD + 32 * jt, LD, lane);
            if (mat == 0 && st == jt) {
                float* d = NMF + st * 1024 + (lane & 31) * 32;
#pragma unroll
                for (int g = 0; g < 4; ++g) *(float4*)(d + 8 * g + 4 * hh) = make_float4(acc[4 * g], acc[4 * g + 1], acc[4 * g + 2], acc[4 * g + 3]);
            }
        }
        CK_BAR();
        if (wv == 0) {
            const int d = lane >> 4, cc = lane & 15;
            const float* nb = NMF + (d >> 1) * 1024 + (16 * (d & 1)) * 32 + 16 * (d & 1);
            float T[16];
#pragma unroll
            for (int i = 0; i < 16; ++i) {
                float acc = (i == cc) ? 1.f : 0.f;
#pragma unroll
                for (int j4 = 0; j4 < i; j4 += 4) { const float4 n4 = *(const float4*)(nb + i * 32 + j4);
                    acc += n4.x * T[j4]; if (j4 + 1 < i) acc += n4.y * T[j4 + 1]; if (j4 + 2 < i) acc += n4.z * T[j4 + 2]; if (j4 + 3 < i) acc += n4.w * T[j4 + 3]; }
                T[i] = acc;
            }
            bf16* tm = MAT(O_TM) + (16 * d) * LD + 16 * d + cc;
#pragma unroll
            for (int i = 0; i < 16; ++i) tm[i * LD] = f2bf(T[i]);
            bf16* tt = MAT(O_TT) + (d >> 1) * 32 * 40 + (16 * (d & 1) + cc) * 40 + 16 * (d & 1);
            *(uint4*)(tt) = make_uint4(pk2(T[0], T[1]), pk2(T[2], T[3]), pk2(T[4], T[5]), pk2(T[6], T[7]));
            *(uint4*)(tt + 8) = make_uint4(pk2(T[8], T[9]), pk2(T[10], T[11]), pk2(T[12], T[13]), pk2(T[14], T[15]));
            { const int blk = lane >> 5, r16 = (lane >> 1) & 15, hf = lane & 1;
              *(uint4*)(MAT(O_TM) + (32 * blk + r16) * LD + 32 * blk + 16 + 8 * hf) = make_uint4(0, 0, 0, 0);
              *(uint4*)(MAT(O_TT) + blk * 32 * 40 + (16 + r16) * 40 + 8 * hf) = make_uint4(0, 0, 0, 0); }
        } else if (wv == 1) {
            const int row = lane >> 1, half = lane & 1;
            *(uint4*)(MAT(O_TM) + row * LD + 32 + half * 16) = make_uint4(0, 0, 0, 0); *(uint4*)(MAT(O_TM) + row * LD + 32 + half * 16 + 8) = make_uint4(0, 0, 0, 0);
        } else if (wv >= 4) {
            const int st = (wv - 4) >> 1, vt = (wv - 4) & 1;
            f32x16 acc = mm_tile<64>(zero16(), MAT(O_AAK) + 32 * st * LD, LD, MAT(O_VT) + 32 * vt * LD, LD, lane);
            store_tr(acc, MAT(O_W1T) + 32 * vt * LD + 32 * st, LD, lane);
        }
        CK_BAR();
        if (wv < 2) {
            typedef float f32x4v __attribute__((ext_vector_type(4)));
            const int blk = wv, fr = lane & 15, fq = lane >> 4;
            const bf16x8 zf = (bf16x8){0, 0, 0, 0, 0, 0, 0, 0};
            bf16x8 a = zf, bq = zf;
            if (fq < 2) { a = *(const bf16x8*)(MAT(O_NM) + (32 * blk + 16 + fr) * LD + 32 * blk + 8 * fq); bq = *(const bf16x8*)(MAT(O_TT) + blk * 32 * 40 + fr * 40 + 8 * fq); }
            f32x4v z = __builtin_amdgcn_mfma_f32_16x16x32_bf16(a, bq, (f32x4v){0.f, 0.f, 0.f, 0.f}, 0, 0, 0);
            bf16* zt = MAT(O_ZT) + blk * 16 * 24;
            { uint2 w; w.x = cvtpk(z[0], z[1]); w.y = cvtpk(z[2], z[3]); *(uint2*)(zt + fr * 24 + 4 * fq) = w; }
            asm volatile("s_waitcnt lgkmcnt(0)" ::: "memory");
            a = zf; bq = zf;
            if (fq < 2) { a = *(const bf16x8*)(MAT(O_TM) + (32 * blk + 16 + fr) * LD + 32 * blk + 16 + 8 * fq); bq = *(const bf16x8*)(zt + fr * 24 + 8 * fq); }
            const f32x4v t21 = __builtin_amdgcn_mfma_f32_16x16x32_bf16(a, bq, (f32x4v){0.f, 0.f, 0.f, 0.f}, 0, 0, 0);
#pragma unroll
            for (int rg = 0; rg < 4; ++rg) MAT(O_TM)[(32 * blk + 16 + 4 * fq + rg) * LD + 32 * blk + fr] = f2bf(t21[rg]);
            { uint2 w; w.x = cvtpk(t21[0], t21[1]); w.y = cvtpk(t21[2], t21[3]); *(uint2*)(MAT(O_TT) + blk * 32 * 40 + fr * 40 + 16 + 4 * fq) = w; }
        }
        CK_BAR();
        if (wv == 0) { f32x16 acc = mm_tile<32>(zero16(), MAT(O_NM) + 32 * LD, LD, MAT(O_TT), 40, lane); store_tr(acc, MAT(O_ZT), 40, lane); }
        CK_BAR();
        if (wv == 0) { f32x16 acc = mm_tile<32>(zero16(), MAT(O_TM) + 32 * LD + 32, LD, MAT(O_ZT), 40, lane); store_rm(acc, MAT(O_TM) + 32 * LD, LD, lane); }
        CK_BAR();
        { const int st = wv >> 2, ct = wv & 3;
          f32x16 acc = mm_tile<64>(zero16(), MAT(O_TM) + 32 * st * LD, LD, MAT(O_AT) + 32 * ct * LD, LD, lane);
          CK_BAR();
          store_tr(acc, MAT(O_X1T) + 32 * ct * LD + 32 * st, LD, lane); }
        CK_BAR();
        for (int u = wv; u < 16; u += 8) {
            const int kind = u >> 2, t0 = (u >> 1) & 1, t1 = u & 1, hh = lane >> 5, cc = lane & 31;
            if (kind == 0) {
                f32x16 acc = mm_tile<64>(zero16(), MAT(O_BT) + 32 * t0 * LD, LD, MAT(O_X1T) + (64 + 32 * t1) * LD, LD, lane);
                acc = mm_tile<64>(acc, MAT(O_KT) + 32 * t0 * LD, LD, MAT(O_VT) + 32 * t1 * LD, LD, lane);
                store_frag16(acc, (bf16*)(out + 16384), t0, t1, lane);
            } else if (kind == 1) {
                f32x16 acc = mm_tile<64>(zero16(), MAT(O_ARB) + 32 * t0 * LD, LD, MAT(O_X1T) + (64 + 32 * t1) * LD, LD, lane);
                acc = mm_tile<64>(acc, MAT(O_ARK) + 32 * t0 * LD, LD, MAT(O_VT) + 32 * t1 * LD, LD, lane);
                store_frag16(acc, (bf16*)(out + 24576), t0, t1, lane);
            } else if (kind == 2) {
                f32x16 acc = mm_tile<64>(zero16(), MAT(O_X1T) + 32 * t0 * LD, LD, MAT(O_BT) + 32 * t1 * LD, LD, lane);
                const int k = 32 * t1 + cc; const float gl = TOT[k];
                bf16* d = (bf16*)out + k * 64 + 32 * t0;
#pragma unroll
                for (int g = 0; g < 4; ++g) { float x[4];
#pragma unroll
                    for (int e = 0; e < 4; ++e) { const int kp = 32 * t0 + 8 * g + 4 * hh + e; x[e] = acc[4 * g + e] + ((kp == k) ? gl : 0.f); }
                    uint2 w; w.x = cvtpk(x[0], x[1]); w.y = cvtpk(x[2], x[3]); *(uint2*)(d + 8 * g + 4 * hh) = w; }
            } else {
                f32x16 acc = mm_tile<64>(zero16(), MAT(O_X1T) + 32 * t0 * LD, LD, MAT(O_ARB) + 32 * t1 * LD, LD, lane);
                const int sq = 32 * t1 + cc;
                bf16* d = (bf16*)(out + 8192) + sq * 64 + 32 * t0;
                const bf16* rb = MAT(O_RB) + sq * LD + 32 * t0;
#pragma unroll
                for (int g = 0; g < 4; ++g) { const uint2 rr = *(const uint2*)(rb + 8 * g + 4 * hh);
                    const float x0 = acc[4 * g] + __builtin_bit_cast(float, rr.x << 16), x1 = acc[4 * g + 1] + __builtin_bit_cast(float, rr.x & 0xffff0000u);
                    const float x2 = acc[4 * g + 2] + __builtin_bit_cast(float, rr.y << 16), x3 = acc[4 * g + 3] + __builtin_bit_cast(float, rr.y & 0xffff0000u);
                    uint2 w; w.x = cvtpk(x0, x1); w.y = cvtpk(x2, x3); *(uint2*)(d + 8 * g + 4 * hh) = w; }
            }
        }
        CK_BAR();
    }
#undef MAT
}
typedef float f32x4w __attribute__((ext_vector_type(4)));
constexpr int P2_SLOT = 2 * 64 * LD * 2 + 4096;
__device__ __forceinline__ void phase2(const int WID_, const char* items, float* Y, char* lds) {
    const int wv = WID_;
    bf16* HT0 = (bf16*)lds; bf16* HT1 = HT0 + 16 * LD;
    char* SL = lds + 8192;
    for (int item = GB; item < NB * 8 * 4; item += GN) {
        const int lane = lane_id(), tid = wv * 64 + lane, fr = lane & 15, fq = lane >> 4;
        const int vq = (item >> 3) & 3, head = (item & 7) + 8 * (item >> 5), b = head >> 3, h = head & 7;
        for (int i = tid; i < 2 * 16 * LD / 8; i += NT) ((uint4*)lds)[i] = make_uint4(0, 0, 0, 0);
        const bool upd = wv < 4; const int rb = wv & 3;
        const char* rec0 = items + (size_t)(head * 128) * ITEM_BYTES;
        const size_t g_pq = (size_t)tid * 16;
        const int l_pq = (tid >> 3) * (LD * 2) + (tid & 7) * 16;
        const int piece = (tid >> 5) & 7;
        const size_t g_f = 16384 + (size_t)(piece >> 2) * 8192 + (((piece & 3) * 4 + vq) * 64) * 8 + (tid & 31) * 16;
        const int l_f = 2 * 64 * LD * 2 + piece * 512 + (tid & 31) * 16;
        float* yo = Y + ((size_t)b * S + 16 * rb + 4 * fq) * 512 + h * 64 + 16 * vq + fr;
        const int a_lds = (upd ? 0 : 64 * LD * 2) + (16 * rb + fr) * (LD * 2) + 16 * fq;
        const int c_lds = 2 * 64 * LD * 2 + ((upd ? 0 : 4) + rb) * 512 + lane * 8;
        uint4 rp0, rp1, rp2, rp3, rp4, rp5, rp6, rp7, rq0, rq1, rq2, rq3, rq4, rq5, rq6, rq7, rf0, rf1, rf2, rf3, rf4, rf5, rf6, rf7;
#define P2_LD(n, i) do { const char* rc_ = rec0 + (size_t)(i) * ITEM_BYTES; rp##n = *(const uint4*)(rc_ + g_pq); rq##n = *(const uint4*)(rc_ + 8192 + g_pq); rf##n = *(const uint4*)(rc_ + g_f); } while (0)
#define P2_ST(n, slot) do { char* s_ = SL + (slot) * P2_SLOT; *(uint4*)(s_ + l_pq) = rp##n; *(uint4*)(s_ + 64 * LD * 2 + l_pq) = rq##n; *(uint4*)(s_ + l_f) = rf##n; } while (0)
        P2_LD(0, 0); P2_LD(1, 1); P2_LD(2, 2); P2_LD(3, 3); P2_LD(4, 4); P2_LD(5, 5); P2_LD(6, 6); P2_LD(7, 7);
        P2_ST(0, 0); P2_LD(0, 8);
        CK_BAR();
#define P2_STEP(RN, cstep) do { const int c_ = (cstep); \
            const bf16* Hc = (c_ & 1) ? HT1 : HT0; bf16* Hn = (c_ & 1) ? HT0 : HT1; const char* sl_ = SL + (c_ & 1) * P2_SLOT; \
            const uint2 cv = *(const uint2*)(sl_ + c_lds); \
            f32x4w acc = (f32x4w){__builtin_bit_cast(float, cv.x << 16), __builtin_bit_cast(float, cv.x & 0xffff0000u), __builtin_bit_cast(float, cv.y << 16), __builtin_bit_cast(float, cv.y & 0xffff0000u)}; \
            const bf16x8 a0 = *(const bf16x8*)(sl_ + a_lds), a1 = *(const bf16x8*)(sl_ + a_lds + 64); \
            const bf16x8 b0 = *(const bf16x8*)(Hc + fr * LD + 8 * fq), b1 = *(const bf16x8*)(Hc + fr * LD + 32 + 8 * fq); \
            if (c_ + 1 < S / 64) P2_ST(RN, (c_ + 1) & 1); \
            if (c_ + 9 < S / 64) P2_LD(RN, c_ + 9); \
            acc = __builtin_amdgcn_mfma_f32_16x16x32_bf16(a0, b0, acc, 0, 0, 0); acc = __builtin_amdgcn_mfma_f32_16x16x32_bf16(a1, b1, acc, 0, 0, 0); \
            if (upd) { uint2 w; w.x = cvtpk(acc[0], acc[1]); w.y = cvtpk(acc[2], acc[3]); *(uint2*)(Hn + fr * LD + 16 * rb + 4 * fq) = w; } \
            else { float* y_ = yo + (size_t)c_ * 64 * 512; y_[0] = acc[0]; y_[512] = acc[1]; y_[1024] = acc[2]; y_[1536] = acc[3]; } \
            CK_BAR(); } while (0)
        for (int c = 0; c < S / 64; c += 8) {
            P2_STEP(1, c); P2_STEP(2, c + 1); P2_STEP(3, c + 2); P2_STEP(4, c + 3); P2_STEP(5, c + 4); P2_STEP(6, c + 5); P2_STEP(7, c + 6); P2_STEP(0, c + 7);
        }
#undef P2_STEP
#undef P2_LD
#undef P2_ST
    }
}
}

__device__ __forceinline__ void rwkv_post_ph(const int WID_, const float* __restrict__ Y, const float* __restrict__ RK, const bf16* __restrict__ proj, const float* __restrict__ mu, const bf16* __restrict__ G,
                             const float* __restrict__ lnw, const float* __restrict__ lnb, bf16* __restrict__ ymix) {
    const int lane = lane_id(), tk = WID_, grp = lane, ch0 = grp * 8, head = grp >> 3;
    const float4 mv0 = *(const float4*)(mu + 1024 + ch0), mv1 = *(const float4*)(mu + 1024 + ch0 + 4), lw0 = *(const float4*)(lnw + ch0), lw1 = *(const float4*)(lnw + ch0 + 4), lb0 = *(const float4*)(lnb + ch0), lb1 = *(const float4*)(lnb + ch0 + 4);
    const float muv[8] = {mv0.x, mv0.y, mv0.z, mv0.w, mv1.x, mv1.y, mv1.z, mv1.w}, lw_[8] = {lw0.x, lw0.y, lw0.z, lw0.w, lw1.x, lw1.y, lw1.z, lw1.w}, lb_[8] = {lb0.x, lb0.y, lb0.z, lb0.w, lb1.x, lb1.y, lb1.z, lb1.w};
    const int g_lo = GN == 256 ? (GB < 64 ? GB * 9 : 576 + ((GB - 64) * 3520) / 192) : (GB * (M / 16)) / GN;
    const int g_hi = GN == 256 ? (GB < 64 ? GB * 9 + 9 : 576 + ((GB - 63) * 3520) / 192) : ((GB + 1) * (M / 16)) / GN;
    for (int g = g_lo; g < g_hi; ++g) { const int m0 = g * 16 + tk;
        float4 ya[2], yb[2]; uint4 vv[2], pv[2], gg[2]; float rk[2];
#pragma unroll
        for (int u = 0; u < 2; ++u) { const int m = m0 + 8 * u;
            ya[u] = *(const float4*)(Y + (size_t)m * 512 + ch0); yb[u] = *(const float4*)(Y + (size_t)m * 512 + ch0 + 4);
            vv[u] = *(const uint4*)(proj + (size_t)m * DSHIFT + 1024 + ch0);
            pv[u] = (m & (S - 1)) ? *(const uint4*)(proj + (size_t)(m - 1) * DSHIFT + 1024 + ch0) : make_uint4(0, 0, 0, 0);
            gg[u] = *(const uint4*)(G + (size_t)m * 512 + ch0); rk[u] = RK[(size_t)m * 8 + head]; }
#pragma unroll
        for (int u = 0; u < 2; ++u) {
            const float y[8] = {ya[u].x, ya[u].y, ya[u].z, ya[u].w, yb[u].x, yb[u].y, yb[u].z, yb[u].w};
            float s = 0.f;
#pragma unroll
            for (int e = 0; e < 8; ++e) s += y[e];
            s += dpp16<0xB1>(s); s += dpp16<0x4E>(s); s += dpp16<0x141>(s);
            const float mean = s * (1.f / 64.f); float q = 0.f;
#pragma unroll
            for (int e = 0; e < 8; ++e) { const float d = y[e] - mean; q += d * d; }
            q += dpp16<0xB1>(q); q += dpp16<0x4E>(q); q += dpp16<0x141>(q);
            const float rstd = rsqrtf(q * (1.f / 64.f) + 64e-5f);
            const unsigned wv_[4] = {vv[u].x, vv[u].y, vv[u].z, vv[u].w}, wp_[4] = {pv[u].x, pv[u].y, pv[u].z, pv[u].w}, wg_[4] = {gg[u].x, gg[u].y, gg[u].z, gg[u].w};
            float o[8];
#pragma unroll
            for (int e = 0; e < 8; ++e) { const int w_ = e >> 1; const bool hi = e & 1;
                auto ex = [&](unsigned x) { return hi ? __builtin_bit_cast(float, x & 0xffff0000u) : __builtin_bit_cast(float, x << 16); };
                float v = ex(wv_[w_]); v += (ex(wp_[w_]) - v) * muv[e];
                o[e] = ((y[e] - mean) * rstd * lw_[e] + lb_[e] + rk[u] * v) * ex(wg_[w_]); }
            *(uint4*)(ymix + (size_t)(m0 + 8 * u) * D + ch0) = make_uint4(pk2(o[0], o[1]), pk2(o[2], o[3]), pk2(o[4], o[5]), pk2(o[6], o[7]));
        }
    }
}

constexpr int PSLOTS = NASSIGN + NEXP * 256;
constexpr int MAXTILES = PSLOTS / 256;
struct MoeBufs { int* tok_e; float* tok_g; int* tok_slot; int* slot_tok; float* slot_gate; int* bcnt; int* bbase; int* offs; int* tiles; int* ntiles; };
__device__ __forceinline__ void moe_zero_ph(const int WID_, const MoeBufs& mb) {
    for (int i = GB * NT + (WID_ * 64 + lane_id()); i < PSLOTS; i += GN * NT) { mb.slot_tok[i] = 0; mb.slot_gate[i] = 0.f; }
}
__device__ __forceinline__ void router_ph(const int WID_, const float* __restrict__ x3, const float* __restrict__ nw, bf16* __restrict__ h3, const float* __restrict__ wrg, const float* __restrict__ brg,
                          const float* __restrict__ wre, const float* __restrict__ bre, const MoeBufs& mb, char* lds, int tile) {
    const int lane = lane_id(), wv = WID_;
    int* lcnt = (int*)lds;
    _Float16* wg16 = (_Float16*)(lds + 256);
    _Float16* we16 = (_Float16*)(lds + 256 + 8192);
    if (wv == 0 && lane < 32) lcnt[lane] = 0;
    for (int i = wv * 64 + lane; i < 1024; i += NT) { const float4 w = *(const float4*)(wrg + i * 4);
        typedef _Float16 h4 __attribute__((ext_vector_type(4))); *(h4*)(wg16 + i * 4) = (h4){(_Float16)w.x, (_Float16)w.y, (_Float16)w.z, (_Float16)w.w}; }
    for (int i = wv * 64 + lane; i < 4 * 1024 * 2; i += NT) { const float4 w = *(const float4*)(wre + i * 4);
        typedef _Float16 h4 __attribute__((ext_vector_type(4))); *(h4*)(we16 + i * 4) = (h4){(_Float16)w.x, (_Float16)w.y, (_Float16)w.z, (_Float16)w.w}; }
    __syncthreads();
    typedef _Float16 h4 __attribute__((ext_vector_type(4)));
    typedef _Float16 h8 __attribute__((ext_vector_type(8)));
    for (int m = tile * 256 + wv; m < tile * 256 + 256; m += 8) {
        const float4* xr = (const float4*)(x3 + (size_t)m * D);
        float h[16]; float s = 0.f;
#pragma unroll
        for (int j = 0; j < 4; ++j) { const float4 v = xr[lane + 64 * j]; h[4 * j] = v.x; h[4 * j + 1] = v.y; h[4 * j + 2] = v.z; h[4 * j + 3] = v.w; s += v.x * v.x + v.y * v.y + v.z * v.z + v.w * v.w; }
        s = wave_sum(s);
        const float rs = rsqrtf(s * (1.f / D) + 1e-6f);
        float l1[4] = {0.f, 0.f, 0.f, 0.f};
#pragma unroll
        for (int j = 0; j < 4; ++j) {
            const int k0 = (lane + 64 * j) * 4;
            const float4 g = *(const float4*)(nw + k0);
            h[4 * j] *= rs * g.x; h[4 * j + 1] *= rs * g.y; h[4 * j + 2] *= rs * g.z; h[4 * j + 3] *= rs * g.w;
            uint2 o; o.x = pk2(h[4 * j], h[4 * j + 1]); o.y = pk2(h[4 * j + 2], h[4 * j + 3]);
            *(uint2*)(h3 + (size_t)m * D + k0) = o;
#pragma unroll
            for (int e = 0; e < 4; ++e) { const h4 w = *(const h4*)(wg16 + (k0 + e) * 4); const float x = h[4 * j + e];
                l1[0] += x * (float)w[0]; l1[1] += x * (float)w[1]; l1[2] += x * (float)w[2]; l1[3] += x * (float)w[3]; }
        }
#pragma unroll
        for (int i = 0; i < 4; ++i) l1[i] = wave_sum(l1[i]) + brg[i];
        int grp = 0; float best = l1[0];
#pragma unroll
        for (int i = 1; i < 4; ++i) if (l1[i] > best) { best = l1[i]; grp = i; }
        float se = 0.f;
#pragma unroll
        for (int i = 0; i < 4; ++i) se += __expf(l1[i] - best);
        const float g1 = 1.f / se;
        float l2[8] = {};
        const _Float16* we = we16 + (size_t)grp * D * 8;
#pragma unroll
        for (int j = 0; j < 4; ++j) {
            const int k0 = (lane + 64 * j) * 4;
#pragma unroll
            for (int e = 0; e < 4; ++e) { const float x = h[4 * j + e]; const h8 w = *(const h8*)(we + (k0 + e) * 8);
#pragma unroll
                for (int q = 0; q < 8; ++q) l2[q] += x * (float)w[q]; }
        }
#pragma unroll
        for (int i = 0; i < 8; ++i) l2[i] = wave_sum(l2[i]) + bre[grp * 8 + i];
        int i0 = 0; float v0 = l2[0];
#pragma unroll
        for (int i = 1; i < 8; ++i) if (l2[i] > v0) { v0 = l2[i]; i0 = i; }
        int i1 = -1; float v1 = -3.0e38f;
#pragma unroll
        for (int i = 0; i < 8; ++i) if (i != i0 && l2[i] > v1) { v1 = l2[i]; i1 = i; }
        const float e1 = __expf(v1 - v0), inv = 1.f / (1.f + e1);
        if (lane == 0) {
            const int ea = grp * 8 + i0, eb = grp * 8 + i1;
            mb.tok_e[2 * m] = ea; mb.tok_e[2 * m + 1] = eb;
            mb.tok_g[2 * m] = g1 * inv; mb.tok_g[2 * m + 1] = g1 * e1 * inv;
            atomicAdd(&lcnt[ea], 1); atomicAdd(&lcnt[eb], 1);
        }
    }
    __syncthreads();
    if (wv == 0 && lane < 32) mb.bcnt[tile * 32 + lane] = lcnt[lane];
    __syncthreads();
}
__device__ __forceinline__ void moe_plan_ph(const int WID_, const MoeBufs& mb, char* lds) {
    if (GB != 0) return;
    int* tot = (int*)lds; int* off = tot + 32;
    const int t = WID_ * 64 + lane_id();
    if (t < 32) { int run = 0; for (int b = 0; b < M / 256; ++b) { const int c = __hip_atomic_load(mb.bcnt + b * 32 + t, __ATOMIC_RELAXED, __HIP_MEMORY_SCOPE_AGENT); mb.bbase[b * 32 + t] = run; run += c; } tot[t] = run; }
    __syncthreads();
    if (t == 0) { int o = 0, nt = 0;
        for (int e = 0; e < NEXP; ++e) { off[e] = o; mb.offs[e] = o; const int c = tot[e]; for (int r0 = 0; r0 < c; r0 += 256) { mb.tiles[nt] = e; ++nt; } o += ((c + 255) / 256) * 256; }
        *mb.ntiles = nt; }
    __syncthreads();
}
__device__ __forceinline__ void moe_scatter_ph(const int WID_, const MoeBufs& mb, char* lds) {
    const int lane = lane_id(), wv = WID_;
    int* cur = (int*)lds;
    for (int tile = GB; tile < M / 256; tile += GN) {
        __syncthreads();
        if (wv == 0 && lane < 32) cur[lane] = __hip_atomic_load(mb.offs + lane, __ATOMIC_RELAXED, __HIP_MEMORY_SCOPE_AGENT) + __hip_atomic_load(mb.bbase + tile * 32 + lane, __ATOMIC_RELAXED, __HIP_MEMORY_SCOPE_AGENT);
        __syncthreads();
        const int a = tile * 512 + wv * 64 + lane; const int e = mb.tok_e[a];
        const int pos = atomicAdd(&cur[e], 1);
        mb.slot_tok[pos] = a >> 1; mb.slot_gate[pos] = mb.tok_g[a]; mb.tok_slot[a] = pos;
    }
    __syncthreads();
}
__device__ __forceinline__ void moe_weights_ph(const int WID_, const float* __restrict__ wg, const float* __restrict__ wu, const float* __restrict__ wd, bf16* __restrict__ wgu_t, bf16* __restrict__ wd_t, char* lds, int vb, int nvb) {
    const int lane = (WID_ * 64 + lane_id()) & 63, wv = (WID_ * 64 + lane_id()) >> 6;
    float* scr = (float*)(lds + wv * 16384);
    constexpr int I_GU = 16 * 16;
    constexpr int I_D = 8 * 32;
    constexpr int NIT = NEXP * (2 * I_GU + I_D);
    for (int it = vb * 8 + wv; it < NIT; it += nvb * 8) {
        const int e = it / (2 * I_GU + I_D); int r = it % (2 * I_GU + I_D);
        if (r < 2 * I_GU) {
            const int up = r / I_GU; r %= I_GU;
            const int kb = r / 16, nb = r % 16;
            const int pn = nb / 4, nsub = nb % 4;
            const float* W = (up ? wu : wg) + (size_t)e * D * DEXP + nb * 32;
            transpose_item(W + (size_t)kb * 64 * DEXP, 64, 32, wgu_t, D, e * 1024 + pn * 256 + up * 128 + nsub * 32, kb * 64, scr, 0, lane, nullptr, DEXP);
        } else {
            r -= 2 * I_GU;
            const int kb = r / 32, nb = r % 32;
            const float* W = wd + (size_t)e * DEXP * D + nb * 32;
            transpose_item(W + (size_t)kb * 64 * D, 64, 32, wd_t, DEXP, e * 1024 + nb * 32, kb * 64, scr, 0, lane, nullptr, D);
        }
    }
}
__device__ __forceinline__ void final_ph(const int WID_, float* __restrict__ out, const bf16* __restrict__ yslot, const int* __restrict__ tok_slot, const float* __restrict__ w) {
    const int lane = lane_id(), wv = WID_;
    float4 g[4];
#pragma unroll
    for (int j = 0; j < 4; ++j) g[j] = *(const float4*)(w + (lane + 64 * j) * 4);
    for (int row0 = (GB * 8 + wv) * 2; row0 < M; row0 += GN * 16) {
        float4 v[2][4]; uint2 ya[2][4], yb[2][4];
#pragma unroll
        for (int r = 0; r < 2; ++r) { const int row = row0 + r;
            const float4* xr = (const float4*)(out + (size_t)row * D);
            const uint2* pa = (const uint2*)(yslot + (size_t)tok_slot[2 * row] * D);
            const uint2* pb = (const uint2*)(yslot + (size_t)tok_slot[2 * row + 1] * D);
#pragma unroll
            for (int j = 0; j < 4; ++j) { v[r][j] = xr[lane + 64 * j]; ya[r][j] = pa[lane + 64 * j]; yb[r][j] = pb[lane + 64 * j]; } }
#pragma unroll
        for (int r = 0; r < 2; ++r) { float s = 0.f;
#pragma unroll
            for (int j = 0; j < 4; ++j) { const uint2 a = ya[r][j], b = yb[r][j];
                v[r][j].x += __builtin_bit_cast(float, a.x << 16) + __builtin_bit_cast(float, b.x << 16);
                v[r][j].y += __builtin_bit_cast(float, a.x & 0xffff0000u) + __builtin_bit_cast(float, b.x & 0xffff0000u);
                v[r][j].z += __builtin_bit_cast(float, a.y << 16) + __builtin_bit_cast(float, b.y << 16);
                v[r][j].w += __builtin_bit_cast(float, a.y & 0xffff0000u) + __builtin_bit_cast(float, b.y & 0xffff0000u);
                s += v[r][j].x * v[r][j].x + v[r][j].y * v[r][j].y + v[r][j].z * v[r][j].z + v[r][j].w * v[r][j].w; }
            s = wave_sum(s);
            const float rs = rsqrtf(s * (1.f / D) + 1e-6f);
            float4* xo = (float4*)(out + (size_t)(row0 + r) * D);
#pragma unroll
            for (int j = 0; j < 4; ++j) xo[lane + 64 * j] = make_float4(v[r][j].x * rs * g[j].x, v[r][j].y * rs * g[j].y, v[r][j].z * rs * g[j].z, v[r][j].w * rs * g[j].w); }
    }
}

struct S5Tab { float* Kmat; bf16* BtA; bf16* BtB; };
__device__ __forceinline__ void s5_lam(const float* lam_re, const float* lam_im, const float* log_dt, int g, int n, float& a, float& w) {
    const float dt = __expf(log_dt[g]); a = lam_re[g * 64 + n] * dt; w = lam_im[g * 64 + n] * dt;
}
__device__ __forceinline__ void cexpj(float a, float w, float j, float& re, float& im) { const float e = __expf(a * j); float s, c; sincosf(w * j, &s, &c); re = e * c; im = e * s; }
__device__ __forceinline__ void s5_bbar(const float* lam_re, const float* lam_im, const float* log_dt, const float* b_re, const float* b_im, int g, int n, int h, float& br, float& bi) {
    float a, w; s5_lam(lam_re, lam_im, log_dt, g, n, a, w);
    float lbr, lbi; cexpj(a, w, 1.f, lbr, lbi);
    const float lr = lam_re[g * 64 + n], li = lam_im[g * 64 + n];
    const float nr = lbr - 1.f, ni = lbi, den = lr * lr + li * li;
    const float cr = (nr * lr + ni * li) / den, ci = (ni * lr - nr * li) / den;
    const float xr = b_re[(g * 64 + n) * 16 + h], xi = b_im[(g * 64 + n) * 16 + h];
    br = cr * xr - ci * xi; bi = cr * xi + ci * xr;
}
__device__ __forceinline__ void s5_tables0_ph(const int WID_, const float* lam_re, const float* lam_im, const float* log_dt, const float* b_re, const float* b_im, const float* c_re, const float* c_im, const S5Tab& T, char* lds) {
    float* PWR = (float*)lds; float* PWI = PWR + 64 * 34;
    float* BBR = PWI + 64 * 34; float* BBI = BBR + 64 * 16;
    float* CCR = BBI + 64 * 16; float* CCI = CCR + 16 * 64;
    const int tid = WID_ * 64 + lane_id();
    for (int item = GB; item < 32 * 8; item += GN) {
        const int g = item & 31, part = item >> 5;
        __syncthreads();
        for (int i = tid; i < 64 * 34; i += NT) { const int n = i / 34, j = i % 34; float a, w; s5_lam(lam_re, lam_im, log_dt, g, n, a, w); float pr, pi; cexpj(a, w, (float)j, pr, pi); PWR[i] = pr; PWI[i] = pi; }
        for (int i = tid; i < 64 * 16; i += NT) { const int n = i >> 4, h = i & 15; float br, bi; s5_bbar(lam_re, lam_im, log_dt, b_re, b_im, g, n, h, br, bi); BBR[i] = br; BBI[i] = bi;
            const int hp = i >> 6, n2 = i & 63; CCR[i] = c_re[(g * 16 + hp) * 64 + n2]; CCI[i] = c_im[(g * 16 + hp) * 64 + n2]; }
        __syncthreads();
        for (int i = tid; i < 4 * 256; i += NT) { const int h = i & 15, hp = (i >> 4) & 15, j = 4 * part + (i >> 8);
            float acc = 0.f;
            for (int n = 0; n < 64; ++n) { const float pr = PWR[n * 34 + j], pi = PWI[n * 34 + j], br = BBR[n * 16 + h], bi = BBI[n * 16 + h];
                const float tr = pr * br - pi * bi, ti = pr * bi + pi * br; acc += CCR[hp * 64 + n] * tr - CCI[hp * 64 + n] * ti; }
            T.Kmat[((g * 32 + j) * 16 + hp) * 16 + h] = acc; }
        for (int i = tid; i < 32 * 512; i += NT) { const int col = i & 511, r = 32 * part + (i >> 9); float v = 0.f;
            if (r < 128) { const int n = r & 63, s = col >> 4, h = col & 15; const float pr = PWR[n * 34 + (S5L - 1 - s)], pi = PWI[n * 34 + (S5L - 1 - s)], br = BBR[n * 16 + h], bi = BBI[n * 16 + h];
                v = (r < 64) ? (pr * br - pi * bi) : (pr * bi + pi * br); }
            T.BtA[((size_t)g * 768 + 512 + r) * 512 + col] = f2bf(v); }
        for (int i = tid; i < 64 * 256; i += NT) { const int k = i & 255, row = 64 * part + (i >> 8); float v = 0.f;
            if (k < 128) { const int n = k & 63, sp = row >> 4, hp = row & 15; const float pr = PWR[n * 34 + sp + 1], pi = PWI[n * 34 + sp + 1], cr = CCR[hp * 64 + n], ci = CCI[hp * 64 + n];
                v = (k < 64) ? (cr * pr - ci * pi) : -(cr * pi + ci * pr); }
            T.BtB[((size_t)g * 512 + row) * 256 + k] = f2bf(v); }
    }
    __syncthreads();
}
__device__ __forceinline__ void s5_tables1_ph(const int WID_, const float* dsk, const S5Tab& T) {
    const int gtid = GB * NT + (WID_ * 64 + lane_id()), gsz = GN * NT;
    for (int i = gtid; i < 32 * 512 * 512; i += gsz) {
        const int col = i & 511, row = (i >> 9) & 511, g = i >> 18;
        const int sp = row >> 4, hp = row & 15, s = col >> 4, h = col & 15;
        float v = 0.f;
        if (s <= sp) v = T.Kmat[((g * 32 + (sp - s)) * 16 + hp) * 16 + h];
        if (row == col) v += dsk[g * 16 + hp];
        T.BtA[((size_t)g * 768 + row) * 512 + col] = f2bf(v);
    }
}
__device__ __forceinline__ void s5_carry_ph(const int WID_, const float* lam_re, const float* lam_im, const float* log_dt, const float* __restrict__ F, bf16* __restrict__ XST, int vb, int nvb, char* lds) {
    float* TR = (float*)lds; float* TI = TR + 16 * 32;
    for (int item = vb; item < NB * 32 * 2; item += nvb) {
        const int lane = lane_id(), tid = WID_ * 64 + lane;
        const int nh = item & 1, g = (item >> 1) & 31, b = item >> 6, seg = tid >> 5, n = nh * 32 + (tid & 31);
        float a, w; s5_lam(lam_re, lam_im, log_dt, g, n, a, w);
        float pr, pi; cexpj(a, w, (float)S5L, pr, pi);
        const size_t row0 = (size_t)g * S5R + (size_t)b * (S / S5L) + seg * 16;
        const float* f = F + row0 * 128; bf16* xo = XST + row0 * 256;
        float fr[16], fi[16];
#pragma unroll
        for (int q = 0; q < 16; ++q) { fr[q] = f[(size_t)q * 128 + n]; fi[q] = f[(size_t)q * 128 + 64 + n]; }
#pragma unroll
        for (int q = 0; q < 16; ++q) if (nh == 0) *(uint2*)(xo + (size_t)q * 256 + 128 + (tid & 31) * 4) = make_uint2(0, 0);
        float xr = 0.f, xi = 0.f;
#pragma unroll
        for (int q = 0; q < 16; ++q) { const float nr = pr * xr - pi * xi + fr[q], ni = pr * xi + pi * xr + fi[q]; xr = nr; xi = ni; fr[q] = nr; fi[q] = ni; }
        TR[seg * 32 + (tid & 31)] = xr; TI[seg * 32 + (tid & 31)] = xi;
        __syncthreads();
        float p16r, p16i; cexpj(a, w, (float)(S5L * 16), p16r, p16i);
        float cr = 0.f, ci = 0.f;
        for (int s2 = 0; s2 < seg; ++s2) { const float tr = TR[s2 * 32 + (tid & 31)], ti = TI[s2 * 32 + (tid & 31)];
            const float nr = p16r * cr - p16i * ci + tr, ni = p16r * ci + p16i * cr + ti; cr = nr; ci = ni; }
        float er = cr, ei = ci;
#pragma unroll
        for (int q = 0; q < 16; ++q) {
            const float lr_ = (q > 0) ? fr[q - 1] : 0.f, li_ = (q > 0) ? fi[q - 1] : 0.f;
            xo[(size_t)q * 256 + n] = f2bf(er + lr_); xo[(size_t)q * 256 + 64 + n] = f2bf(ei + li_);
            const float nr = pr * er - pi * ei, ni = pr * ei + pi * er; er = nr; ei = ni;
        }
        __syncthreads();
    }
}
#define XB_TMO      128
#define XB_XCNT(j)  (256  + 64 * (j))
#define XB_XSUB(j)  (1280 + 64 * (j))
#define XB_XGEN(j)  (2304 + 64 * (j))
#define XB_TOP      3328
#define XB_TOPGEN   3392
#define XCD_BAR_WORDS 3456
#define XB_SPIN_CAP (1u << 20)
__device__ __forceinline__ unsigned xb_ld(unsigned* p)              { return __hip_atomic_load(p, __ATOMIC_RELAXED, __HIP_MEMORY_SCOPE_AGENT); }
__device__ __forceinline__ unsigned xb_add(unsigned* p, unsigned v) { return __hip_atomic_fetch_add(p, v, __ATOMIC_RELAXED, __HIP_MEMORY_SCOPE_AGENT); }
__device__ __forceinline__ unsigned xb_xcc_id() { return (unsigned)__builtin_amdgcn_s_getreg((3 << 11) | 20) & 0xFu; }
#define XB_SPIN(cond, bar) do { unsigned _sp = 0; while (cond) { __builtin_amdgcn_s_sleep(1); \
    if ((++_sp & 255u) == 0u) { if (xb_ld(&(bar)[XB_TMO])) break; if (_sp > XB_SPIN_CAP) { atomicAdd(&(bar)[XB_TMO], 1u); break; } } } } while (0)
struct XcdBarrier { unsigned* bar; unsigned x; volatile __attribute__((address_space(3))) unsigned* st; };
__device__ __forceinline__ XcdBarrier xcd_barrier_post(const int WID_, unsigned* bar, volatile __attribute__((address_space(3))) unsigned* st) {
    XcdBarrier b; b.bar = bar; b.x = xb_xcc_id(); b.st = st;
    if ((WID_ * 64 + lane_id()) == 0) (void)xb_add(&bar[XB_XCNT(b.x)], 1u);
    return b;
}
__device__ __forceinline__ void xcd_barrier_complete(unsigned* bar, unsigned x, unsigned& nloc, unsigned& nx) {
    const unsigned G = gridDim.x * gridDim.y * gridDim.z;
    unsigned sum, cnt, mine, sp = 0u;
    for (;;) {
        sum = 0u; cnt = 0u; mine = 0u;
#pragma unroll
        for (unsigned j = 0; j < 16; ++j) { const unsigned c = xb_ld(&bar[XB_XCNT(j)]); sum += c; cnt += (c > 0u) ? 1u : 0u; mine = (j == x) ? c : mine; }
        if (sum == G) break;
        __builtin_amdgcn_s_sleep(1);
        if ((++sp & 255u) == 0u) { if (xb_ld(&bar[XB_TMO])) break; if (sp > XB_SPIN_CAP) { atomicAdd(&bar[XB_TMO], 1u); break; } }
    }
    nloc = mine > 0u ? mine : 1u; nx = cnt > 0u ? cnt : 1u;
}
__device__ __forceinline__ void xcd_barrier(const int WID_, const XcdBarrier& b) {
    asm volatile("s_waitcnt vmcnt(0)" ::: "memory");
    __syncthreads();
    if ((WID_ * 64 + lane_id()) == 0) {
        unsigned* bar = b.bar;
        __builtin_amdgcn_s_waitcnt(0);
        unsigned nloc = b.st[0], nx = b.st[1];
        if (nloc == 0u) { xcd_barrier_complete(bar, b.x, nloc, nx); b.st[0] = nloc; b.st[1] = nx; }
        const unsigned old = xb_add(&bar[XB_XSUB(b.x)], 1u);
        const unsigned gen = old / nloc;
        if (old + 1u == (gen + 1u) * nloc) {
            __builtin_amdgcn_fence(__ATOMIC_RELEASE, "agent");
            asm volatile("s_waitcnt vmcnt(0)" ::: "memory");
            const unsigned og = xb_add(&bar[XB_TOP], 1u);
            const unsigned tg = og / nx;
            if (og + 1u == (tg + 1u) * nx) xb_add(&bar[XB_TOPGEN], 1u);
            else XB_SPIN(xb_ld(&bar[XB_TOPGEN]) == tg, bar);
            __builtin_amdgcn_fence(__ATOMIC_ACQUIRE, "agent");
            xb_add(&bar[XB_XGEN(b.x)], 1u);
            asm volatile("s_waitcnt vmcnt(0)" ::: "memory");
        } else {
            XB_SPIN(xb_ld(&bar[XB_XGEN(b.x)]) == gen, bar);
            __builtin_amdgcn_fence(__ATOMIC_ACQUIRE, "agent");
            asm volatile("s_waitcnt vmcnt(0)" ::: "memory");
        }
    }
    __syncthreads();
}

struct Params { const float* in[41]; float* out; char* ws; };

constexpr size_t W_PROJ = 0;
constexpr size_t W_US5 = 224;
constexpr size_t W_WTS = 288;
constexpr size_t W_YI = 352;
constexpr size_t W_F = 416;
constexpr size_t W_XST = 448;
constexpr size_t W_Z = 480;
constexpr size_t W_MISC = 544;
constexpr size_t W_XN = 576;
constexpr size_t W_CTL = 558;
constexpr size_t WO_IN = 0, WO_GLU = 5 * MiB, WO_MIX = 6 * MiB, WO_Q = 8 * MiB, WO_K = 10 * MiB, WO_V = 12 * MiB, WO_O = 14 * MiB, WO_KMAT = 16 * MiB, WO_BTA = 17 * MiB, WO_BTB = 41 * MiB;

__global__ void __launch_bounds__(NT, 2) fwd_kernel(Params p) {
    extern __shared__ __attribute__((aligned(16))) char lds[];
    const int WID_ = __builtin_amdgcn_readfirstlane((int)(threadIdx.x >> 6));
    cg::grid_group grid = cg::this_grid();
    PG8_LAS unsigned char* ldsl = (PG8_LAS unsigned char*)lds;
    char* ws = p.ws; char* dout = (char*)p.out; float* out = p.out;
#define IN(i) (p.in[i])
    volatile __attribute__((address_space(3))) unsigned* bst = (volatile __attribute__((address_space(3))) unsigned*)(ldsl + LDS_BYTES - 64);
    if (WID_ == 0 && lane_id() < 2) bst[lane_id()] = 0u;
    __syncthreads();
    const XcdBarrier xbar = xcd_barrier_post(WID_, (unsigned*)(ws + W_CTL * MiB), bst);
#ifndef PROBE_PHASE
#define PROBE_PHASE -1
#endif
    int sync_id = 0; unsigned long long pr_t0 = 0, pr_t1 = 0;
    if (PROBE_PHASE == 0) pr_t0 = __builtin_amdgcn_s_memrealtime();
#define SYNC() do { xcd_barrier(WID_, xbar); ++sync_id; if (sync_id == PROBE_PHASE) pr_t0 = __builtin_amdgcn_s_memrealtime(); if (sync_id == PROBE_PHASE + 1) pr_t1 = __builtin_amdgcn_s_memrealtime(); } while (0)
    char* WT = ws + W_WTS * MiB;
    bf16* w_in_t = (bf16*)(WT + WO_IN); bf16* w_glu_t = (bf16*)(WT + WO_GLU); bf16* w_mix_t = (bf16*)(WT + WO_MIX);
    bf16* w_q_t = (bf16*)(WT + WO_Q); bf16* w_k_t = (bf16*)(WT + WO_K); bf16* w_v_t = (bf16*)(WT + WO_V); bf16* w_o_t = (bf16*)(WT + WO_O);
    S5Tab stab; stab.Kmat = (float*)(WT + WO_KMAT); stab.BtA = (bf16*)(WT + WO_BTA); stab.BtB = (bf16*)(WT + WO_BTB);
    bf16* PROJ = (bf16*)(ws + W_PROJ * MiB); bf16* US5 = (bf16*)(ws + W_US5 * MiB);
    bf16* XN = (bf16*)(ws + W_XN * MiB);
    transpose_ph(WID_, IN(3), D, DIN, w_in_t, D, 0, 0, lds);
    transpose_ph(WID_, IN(23), 512, 512, w_glu_t, 512, 0, 0, lds);
    transpose_ph(WID_, IN(25), D, D, w_mix_t, D, 0, 0, lds);
    transpose_ph(WID_, IN(28), D, D, w_q_t, D, 0, 0, lds, IN(26));
    transpose_ph(WID_, IN(29), D, D, w_k_t, D, 0, 0, lds);
    transpose_ph(WID_, IN(30), D, D, w_v_t, D, 0, 0, lds);
    transpose_ph(WID_, IN(31), D, D, w_o_t, D, 0, 0, lds);
    s5_tables0_ph(WID_, IN(15), IN(16), IN(17), IN(18), IN(19), IN(20), IN(21), stab, lds);
    bf16* wl_t = (bf16*)(WT + 49 * MiB);
    rwkv_wl_ph(WID_, IN(6), IN(8), IN(9), wl_t);
    rmsnorm_ph<bf16>(WID_, IN(0), IN(2), XN, M);
    bf16* MEMN = (bf16*)(ws + (W_MISC + 10) * MiB);
    rmsnorm_ph<bf16>(WID_, IN(1), IN(27), MEMN, NB * NMEM);
    grid.sync(); ++sync_id; if (sync_id == PROBE_PHASE) pr_t0 = __builtin_amdgcn_s_memrealtime(); if (sync_id == PROBE_PHASE + 1) pr_t1 = __builtin_amdgcn_s_memrealtime();
    s5_tables1_ph(WID_, IN(22), stab);
    { pg8::PlainOrder S; S.init(XN, D, w_in_t, D, M, DIN, D); pg8::EpiProj E{PROJ, US5}; pg8::gemm_phase(WID_, ldsl, S, E); }
    SYNC();
    bf16* LIN = (bf16*)(ws + (W_MISC + 16) * MiB);
    rwkv_lin_ph(WID_, PROJ, IN(4), LIN);
    SYNC();
    bf16* YI = (bf16*)(ws + W_YI * MiB); float* F = (float*)(ws + W_F * MiB); bf16* XST = (bf16*)(ws + W_XST * MiB); bf16* Z = (bf16*)(ws + W_Z * MiB);
    bf16* LWb = (bf16*)(ws + 704 * MiB); bf16* AAb = (bf16*)(ws + 768 * MiB); bf16* Gb = (bf16*)(ws + 832 * MiB);
    float* Yr = (float*)(ws + 896 * MiB); float* RKb = (float*)(ws + W_MISC * MiB);
    { pg8::GroupOrder S; S.init(US5, 512, (size_t)S5R * 512, stab.BtA, 512, (size_t)768 * 512, 32, S5R, 768, 512); pg8::EpiS5a E{YI, F}; pg8::gemm_phase(WID_, ldsl, S, E); }
    { pg8::PlainOrder S; S.init(LIN, 256, wl_t, 256, M, 1536, 256); pg8::EpiLora E{LWb, (size_t)32 * MiB, IN(5), IN(7)}; pg8::gemm_phase(WID_, ldsl, S, E); }
    SYNC();
    { ck::In ci{PROJ, LWb, AAb, IN(4), IN(10), IN(11), IN(12), RKb, dout}; ck::phase1(WID_, ci, lds); }
    SYNC();
    bf16* WGU_t = (bf16*)(ws + 704 * MiB); bf16* WD_t = (bf16*)(ws + 768 * MiB);
    ck::phase2(WID_, dout, Yr, lds);
    __syncthreads();
    s5_carry_ph(WID_, IN(15), IN(16), IN(17), F, XST, GB, GN, lds);
    moe_weights_ph(WID_, IN(37), IN(38), IN(39), WGU_t, WD_t, lds, GB, GN);
    SYNC();
    bf16* YMIX = XN;
    bf16* KM = (bf16*)(ws + (W_MISC + 2) * MiB); bf16* VT = (bf16*)(ws + (W_MISC + 6) * MiB);
    { pg8::GroupOrder S; S.init(XST, 256, (size_t)S5R * 256, stab.BtB, 256, (size_t)512 * 256, 32, S5R, 512, 256); pg8::EpiS5b E{YI, Z}; pg8::gemm_phase(WID_, ldsl, S, E); }
    { pg8::PlainOrder S; S.init(MEMN, D, w_k_t, D, NB * NMEM, D, D); pg8::EpiBf16 E{KM, D}; pg8::gemm_phase(WID_, ldsl, S, E); }
    { pg8::PlainOrder S; S.init(w_v_t, D, MEMN, D, D, NB * NMEM, D, 32); pg8::EpiBf16 E{VT, NB * NMEM}; pg8::gemm_phase(WID_, ldsl, S, E); }
    rwkv_post_ph(WID_, Yr, RKb, PROJ, IN(4), Gb, IN(13), IN(14), YMIX);
    SYNC();
    bf16* X2b = (bf16*)(ws + 0);
    PG8_LAS float* ssq = (PG8_LAS float*)(ldsl + 131072 + 8192);
    bf16* Q = (bf16*)(ws + 128 * MiB);
    bf16* P = (bf16*)(ws + W_YI * MiB);
    bf16* O = (bf16*)(ws + 800 * MiB);
    bf16* H3 = XN;
    bf16* HID = (bf16*)(ws + 368 * MiB);
    bf16* YSLOT = (bf16*)(ws + 0);
#define MKMB(mb) MoeBufs mb; { char* mbase = p.ws + 976 * MiB; \
    mb.tok_e = (int*)(mbase); mb.tok_g = (float*)(mbase + 1 * MiB); mb.tok_slot = (int*)(mbase + 2 * MiB); mb.slot_tok = (int*)(mbase + 3 * MiB); \
    mb.slot_gate = (float*)(mbase + 4 * MiB); mb.bcnt = (int*)(mbase + 5 * MiB); mb.bbase = mb.bcnt + 16384; mb.offs = mb.bcnt + 32768; mb.ntiles = mb.offs + 64; \
    mb.tiles = (int*)(mbase + 6 * MiB); }
    { MKMB(mb); moe_zero_ph(WID_, mb); }
#define BLK_SYNC() do { asm volatile("s_waitcnt vmcnt(0)" ::: "memory"); __syncthreads(); \
        if (WID_ == 0 && lane_id() == 0) { __builtin_amdgcn_fence(__ATOMIC_ACQUIRE, "agent"); asm volatile("s_waitcnt vmcnt(0)" ::: "memory"); } __syncthreads(); } while (0)
    for (int tl = GB; tl < M / 256; tl += GN) {
        for (int i = WID_ * 64 + lane_id(); i < 1024; i += NT) ssq[i] = 0.f;
        { pg8::TileOrder S; S.init(Z, 512, w_glu_t, 512, 512, 2, tl); pg8::EpiGlu E{Z, IN(24), YMIX}; pg8::gemm_phase(WID_, ldsl, S, E); }
        BLK_SYNC();
        { pg8::TileOrder S; S.init(YMIX, D, w_mix_t, D, D, 4, tl); pg8::EpiMixRes E{X2b, IN(0), ssq}; pg8::gemm_phase(WID_, ldsl, S, E); }
        BLK_SYNC();
        { pg8::TileOrder S; S.init(X2b, D, w_q_t, D, D, 4, tl); pg8::EpiRowScale E{Q, ssq}; pg8::gemm_phase(WID_, ldsl, S, E); }
        BLK_SYNC();
        { pg8::AttnTileOrder S; S.init(Q, KM, D, 0, tl); pg8::EpiSoftmax E{P, (PG8_LAS float*)(ldsl + 131072)}; pg8::gemm_phase(WID_, ldsl, S, E); }
        BLK_SYNC();
        { pg8::AttnTileOrder S; S.init(P, VT, NB * NMEM, 1, tl); pg8::EpiAttnO E{O}; pg8::gemm_phase(WID_, ldsl, S, E); }
        BLK_SYNC();
        { pg8::TileOrder S; S.init(O, D, w_o_t, D, D, 4, tl); pg8::EpiResBf16 E{out, X2b}; pg8::gemm_phase(WID_, ldsl, S, E); }
        BLK_SYNC();
        { MKMB(mb); router_ph(WID_, p.out, IN(32), (bf16*)(p.ws + W_XN * MiB), IN(33), IN(34), IN(35), IN(36), mb, lds, tl); }
    }
    SYNC();
    { MKMB(mb); moe_plan_ph(WID_, mb, lds); }
    SYNC();
    { MKMB(mb); moe_scatter_ph(WID_, mb, lds); }
    MKMB(mb);
    SYNC();
    const int ntiles = __hip_atomic_load(mb.ntiles, __ATOMIC_RELAXED, __HIP_MEMORY_SCOPE_AGENT);
    { pg8::MoeOrderT<true> S; S.init(H3, D, WGU_t, D, D, mb.tiles, ntiles, 1024, mb.slot_tok); pg8::EpiSilu E{HID}; pg8::gemm_phase(WID_, ldsl, S, E); }
    SYNC();
    { pg8::MoeOrderT<false> S; S.init(HID, DEXP, WD_t, DEXP, DEXP, mb.tiles, ntiles, 1024, nullptr); pg8::EpiGate E{YSLOT, mb.slot_gate}; pg8::gemm_phase(WID_, ldsl, S, E); }
    SYNC();
    final_ph(WID_, out, YSLOT, mb.tok_slot, IN(40));
    if (PROBE_PHASE >= 0) {
        if (pr_t1 == 0) pr_t1 = __builtin_amdgcn_s_memrealtime();
        if (GB == 0) { const unsigned long long t_end = __builtin_amdgcn_s_memrealtime(), wait = 8ull * (pr_t1 - pr_t0);
            while (__builtin_amdgcn_s_memrealtime() - t_end < wait) __builtin_amdgcn_s_sleep(8); }
    }
}
}

extern "C" void kernel_launch(void* const* d_in, const int* in_sizes, int n_in, void* d_out, int out_size, void* d_ws, size_t ws_size, hipStream_t stream) {
    (void)in_sizes; (void)out_size; (void)ws_size;
    static int grid = 0;
    if (grid == 0) {
        int dev = 0, cus = 0, per_cu = 0;
        hipGetDevice(&dev);
        hipDeviceGetAttribute(&cus, hipDeviceAttributeMultiprocessorCount, dev);
        hipFuncSetAttribute((const void*)fwd_kernel, hipFuncAttributeMaxDynamicSharedMemorySize, LDS_BYTES);
        hipOccupancyMaxActiveBlocksPerMultiprocessor(&per_cu, (const void*)fwd_kernel, NT, LDS_BYTES);
        if (per_cu < 1) { fprintf(stderr, "occupancy query says %d blocks/CU\n", per_cu); per_cu = 1; }
        grid = cus * 1;
    }
    (void)hipMemsetAsync((char*)d_ws + W_CTL * MiB, 0, 16384, stream);
    Params p{};
    for (int i = 0; i < 41 && i < n_in; ++i) p.in[i] = (const float*)d_in[i];
    p.out = (float*)d_out; p.ws = (char*)d_ws;
    void* args[] = {&p};
    hipError_t e = hipLaunchCooperativeKernel((const void*)fwd_kernel, dim3(grid), dim3(NT), args, LDS_BYTES, stream);
    if (e != hipSuccess) fprintf(stderr, "cooperative launch failed: %s (grid %d)\n", hipGetErrorString(e), grid);
}
```

```cpp
#include <hip/hip_runtime.h>
#include <hip/hip_cooperative_groups.h>
#include <stdint.h>
#include <cstdio>
namespace cg = cooperative_groups;

namespace {
constexpr int NB = 8, S = 8192, D = 1024, M = NB * S;
constexpr int DR = 512, DSHIFT = 1792, DIN = 2304, NMEM = 256;
constexpr int NEXP = 32, DEXP = 512, NASSIGN = 2 * M;
constexpr size_t MiB = 1u << 20;
constexpr int NT = 512;
constexpr int S5L = 32, S5R = M / S5L;
constexpr int LDS_BYTES = 147456;
#define GB ((int)blockIdx.x)
#define GN ((int)gridDim.x)

typedef unsigned short bf16;
typedef float f32x2h __attribute__((ext_vector_type(2)));
typedef __bf16 bf16x2h __attribute__((ext_vector_type(2)));
__device__ __forceinline__ unsigned pk2(float lo, float hi) { const f32x2h v = {lo, hi}; const bf16x2h b = __builtin_convertvector(v, bf16x2h); return __builtin_bit_cast(unsigned, b); }
__device__ __forceinline__ bf16 f2bf(float f) { return (bf16)(pk2(f, f) & 0xffffu); }
__device__ __forceinline__ int lane_id() { int l; asm volatile("v_mbcnt_lo_u32_b32 %0, -1, 0\n\tv_mbcnt_hi_u32_b32 %0, -1, %0" : "=v"(l)); return l; }
__device__ __forceinline__ float bf2f(bf16 h) { return __builtin_bit_cast(float, (unsigned)h << 16); }

template <typename T> __device__ __forceinline__ float ldf(const T* p);
template <> __device__ __forceinline__ float ldf<float>(const float* p) { return *p; }
template <> __device__ __forceinline__ float ldf<bf16>(const bf16* p) { return bf2f(*p); }
template <typename T> __device__ __forceinline__ void stf(T* p, float v);
template <> __device__ __forceinline__ void stf<float>(float* p, float v) { *p = v; }
template <> __device__ __forceinline__ void stf<bf16>(bf16* p, float v) { *p = f2bf(v); }

template <int CTRL, int ROWMASK> __device__ __forceinline__ float dppf_(float x) { return __builtin_bit_cast(float, __builtin_amdgcn_update_dpp(0, __builtin_bit_cast(int, x), CTRL, ROWMASK, 0xf, false)); }
__device__ __forceinline__ float wave_sum(float v) {
    v += dppf_<0xB1, 0xf>(v); v += dppf_<0x4E, 0xf>(v); v += dppf_<0x141, 0xf>(v); v += dppf_<0x140, 0xf>(v);
    v += dppf_<0x142, 0xa>(v);
    v += dppf_<0x143, 0xc>(v);
    return __builtin_bit_cast(float, __builtin_amdgcn_readlane(__builtin_bit_cast(int, v), 63));
}
__device__ __forceinline__ float sigmoidf_(float x) { return 1.f / (1.f + __expf(-x)); }


__device__ __forceinline__ float gelu_tanh(float x) { return x * sigmoidf_(1.5957691216057308f * (x + 0.044715f * x * x * x)); }

namespace pg8 {
#define PG8_LAS __attribute__((address_space(3)))
typedef short bf16x8 __attribute__((ext_vector_type(8)));
typedef float f32x4 __attribute__((ext_vector_type(4)));
typedef unsigned u32x4 __attribute__((ext_vector_type(4)));
constexpr int BM = 256, BK = 64, HALF = 128, HTB = HALF * BK * 2, STAGE_BYTES = 8 * HTB, NXCD = 8, WGM = 8;
__device__ __forceinline__ int lds_byte(int r, int c) { const int st = (r >> 4) * 2 + (c >> 5), rr = r & 15, cc = c & 31, ob = rr * 64 + cc * 2; return st * 1024 + (ob ^ (((ob >> 9) & 1) << 5)); }
__device__ __forceinline__ void stage_rc(int b, int& R, int& C) { const int st = b / 1024, sb = b % 1024, swz = sb ^ (((sb >> 9) & 1) << 5); R = (st >> 1) * 16 + swz / 64; C = (st & 1) * 32 + (swz % 64) / 2; }
__device__ __forceinline__ int perm32(int rho) { const int n = rho >> 4, i = rho & 15; return 8 * (i >> 2) + 4 * n + (i & 3); }
struct Unit { int pm, pn; };
struct PlainOrder {
    static constexpr bool GATHER = false; __device__ __forceinline__ int grow(const Unit&, int) const { return 0; }
    const bf16* A; const bf16* Bt; int lda, ldb, K; int nM, nN, nwg, G, c;
    __device__ void init(const bf16* A_, int lda_, const bf16* Bt_, int ldb_, int M, int N, int K_, int coff = 0) { A = A_; Bt = Bt_; lda = lda_; ldb = ldb_; K = K_; nM = M / BM; nN = N / BM; nwg = nM * nN; G = GN; c = (GB + GN - coff % GN) % GN; }
    __device__ bool next(int i, Unit& u) const {
        const long L = (long)i * G + c; if (L >= nwg) return false;
        int wgid = (int)L; { const int q = nwg / NXCD, r = nwg % NXCD, xcd = wgid % NXCD, off = wgid / NXCD; wgid = (xcd < r ? xcd * (q + 1) : r * (q + 1) + (xcd - r) * q) + off; }
        const int nig = WGM * nN, gid = wgid / nig, fm = gid * WGM, gsz = (nM - fm) < WGM ? (nM - fm) : WGM;
        u.pm = fm + ((wgid % nig) % gsz); u.pn = (wgid % nig) / gsz; return true;
    }
    __device__ __forceinline__ const char* aptr(const Unit& u) const { return (const char*)(A + (size_t)u.pm * BM * lda); }
    __device__ __forceinline__ const char* bptr(const Unit& u) const { return (const char*)(Bt + (size_t)u.pn * BM * ldb); }
};
typedef float f32x2c __attribute__((ext_vector_type(2)));
typedef __bf16 bf16x2c __attribute__((ext_vector_type(2)));
__device__ __forceinline__ unsigned cvt_pk_bf16(float lo, float hi) { const f32x2c v = {lo, hi}; const bf16x2c b = __builtin_convertvector(v, bf16x2c); return __builtin_bit_cast(unsigned, b); }

template <class Epi, class Sched>
__device__ __forceinline__ void gemm_phase(const int WID_, PG8_LAS unsigned char* lds, const Sched& S, const Epi& E) {
    const int tid = (WID_ * 64 + lane_id()), wid = __builtin_amdgcn_readfirstlane(tid >> 6), lane = tid & 63, wr = wid >> 2, wc = wid & 3, fr = lane & 15, fq = lane >> 4;
    const int K = S.K, nt = K / BK;
    unsigned voffA[2], voffB[2];
#pragma unroll
    for (int i = 0; i < 2; ++i) { int R, C; stage_rc(tid * 16 + i * 8192, R, C); const int Rb = Epi::PERM ? ((R & ~31) + perm32(R & 31)) : R;
        voffA[i] = (unsigned)(R * S.lda + C) * 2u; voffB[i] = (unsigned)(Rb * S.ldb + C) * 2u; }
    constexpr bool GA = Sched::GATHER;
    int gR[2], gC[2];
#pragma unroll
    for (int i = 0; i < 2; ++i) stage_rc(tid * 16 + i * 8192, gR[i], gC[i]);
    unsigned vgc[2][2] = {{0u, 0u}, {0u, 0u}}, vgn[2][2] = {{0u, 0u}, {0u, 0u}};
#define PG8_GOFF(dst, u) do { if constexpr (GA) { _Pragma("unroll") for (int h_ = 0; h_ < 2; ++h_) _Pragma("unroll") for (int i_ = 0; i_ < 2; ++i_) \
        dst[h_][i_] = (unsigned)(S.grow(u, h_ * HALF + gR[i_]) * S.lda + gC[i_]) * 2u; } } while (0)
    const size_t kstep = (size_t)(BK * 2);
    const size_t hstepA = GA ? 0 : (size_t)HALF * S.lda * 2, hstepB = (size_t)HALF * S.ldb * 2;
    const unsigned ldsw = (unsigned)wid * 1024u;
    const int aoff = lds_byte(wr * 64 + fr, fq * 8), boff = lds_byte(wc * 32 + fr, fq * 8);
#define PG8_SA(b, h) (((b) * 2 + (h)) * HTB)
#define PG8_SB(b, h) ((4 + (b) * 2 + (h)) * HTB)
#define PG8_STAGE(bufoff, gbase, voff) do { _Pragma("unroll") for (int _i = 0; _i < 2; ++_i) \
        __builtin_amdgcn_global_load_lds((const unsigned*)((const char*)(gbase) + (voff)[_i]), (PG8_LAS unsigned*)(lds + (bufoff) + ldsw + _i * 8192), 16, 0, 0); } while (0)
#define PG8_STAGE_A(bufoff, gbase, h, nx) do { _Pragma("unroll") for (int _i = 0; _i < 2; ++_i) { \
        const unsigned vo_ = GA ? ((nx) ? vgn[h][_i] : vgc[h][_i]) : voffA[_i]; \
        __builtin_amdgcn_global_load_lds((const unsigned*)((const char*)(gbase) + vo_), (PG8_LAS unsigned*)(lds + (bufoff) + ldsw + _i * 8192), 16, 0, 0); } } while (0)
#define PG8_LDA(dst, b, h) do { _Pragma("unroll") for (int m = 0; m < 4; ++m) _Pragma("unroll") for (int k = 0; k < 2; ++k) dst[m][k] = *(const PG8_LAS bf16x8*)(lds + PG8_SA(b, h) + aoff + m * 2048 + k * 1024); } while (0)
#define PG8_LDB(dst, b, h) do { _Pragma("unroll") for (int n = 0; n < 2; ++n) _Pragma("unroll") for (int k = 0; k < 2; ++k) dst[n][k] = *(const PG8_LAS bf16x8*)(lds + PG8_SB(b, h) + boff + n * 2048 + k * 1024); } while (0)
#define PG8_MMA(ai, bj, At, Bt) do { __builtin_amdgcn_s_setprio(1); _Pragma("unroll") for (int m = 0; m < 4; ++m) _Pragma("unroll") for (int n = 0; n < 2; ++n) _Pragma("unroll") for (int k = 0; k < 2; ++k) \
        acc[ai][bj][m][n] = __builtin_amdgcn_mfma_f32_16x16x32_bf16(Bt[n][k], At[m][k], acc[ai][bj][m][n], 0, 0, 0); __builtin_amdgcn_s_setprio(0); } while (0)
#define PG8_WAIT_V(n) asm volatile("s_waitcnt vmcnt(" #n ")" ::: "memory")
#define PG8_WAIT_L(n) asm volatile("s_waitcnt lgkmcnt(" #n ")" ::: "memory")
#define PG8_BAR __builtin_amdgcn_s_barrier()
#define PG8_SCHED __builtin_amdgcn_sched_barrier(0)
    Unit cur, nxt; int ui = 0;
    if (!S.next(0, cur)) return;
    f32x4 acc[2][2][4][2];
#pragma unroll
    for (int a = 0; a < 2; ++a)
#pragma unroll
        for (int b = 0; b < 2; ++b)
#pragma unroll
            for (int m = 0; m < 4; ++m)
#pragma unroll
                for (int n = 0; n < 2; ++n) acc[a][b][m][n] = (f32x4){0.f, 0.f, 0.f, 0.f};
    bf16x8 At[4][2], B0[2][2], B1[2][2];
    const char* cA = S.aptr(cur); const char* cB = S.bptr(cur);
    PG8_STAGE(PG8_SB(0, 0), cB, voffB); PG8_STAGE(PG8_SB(0, 1), cB + hstepB, voffB); PG8_GOFF(vgc, cur); PG8_STAGE_A(PG8_SA(0, 0), cA, 0, false); PG8_STAGE_A(PG8_SA(0, 1), cA + hstepA, 1, false);
    if (wr == 1) PG8_BAR;
    PG8_WAIT_V(2); PG8_BAR;
    PG8_STAGE(PG8_SB(1, 0), cB + kstep, voffB); PG8_STAGE_A(PG8_SA(1, 0), cA + kstep, 0, false); PG8_STAGE(PG8_SB(1, 1), cB + hstepB + kstep, voffB);
    PG8_WAIT_V(6); PG8_BAR;
    for (;;) {
        const bool has_next = S.next(ui + 1, nxt);
        const char* nA = has_next ? S.aptr(nxt) : cA; const char* nB = has_next ? S.bptr(nxt) : cB;
        if (has_next) PG8_GOFF(vgn, nxt); else { if constexpr (GA) { _Pragma("unroll") for (int h_ = 0; h_ < 2; ++h_) _Pragma("unroll") for (int i_ = 0; i_ < 2; ++i_) vgn[h_][i_] = vgc[h_][i_]; } }
        for (int t = 0; t < nt; t += 2) {
            const bool last = (t == nt - 2);
            const char* a1 = cA + (size_t)(t + 1) * kstep;
            const char* a2 = last ? nA : cA + (size_t)(t + 2) * kstep; const char* b2 = last ? nB : cB + (size_t)(t + 2) * kstep;
            const char* a3 = a2 + kstep; const char* b3 = b2 + kstep;
            PG8_LDB(B0, 0, 0); PG8_LDB(B1, 0, 1); PG8_SCHED; PG8_LDA(At, 0, 0); PG8_STAGE_A(PG8_SA(1, 1), a1 + hstepA, 1, false);
            PG8_WAIT_V(8); PG8_WAIT_L(0); PG8_BAR; PG8_MMA(0, 0, At, B0); PG8_MMA(0, 1, At, B1); PG8_BAR; PG8_SCHED;
            PG8_LDA(At, 0, 1); PG8_STAGE(PG8_SB(0, 0), b2, voffB); PG8_STAGE(PG8_SB(0, 1), b2 + hstepB, voffB); PG8_STAGE_A(PG8_SA(0, 0), a2, 0, last);
            PG8_WAIT_V(8); PG8_WAIT_L(0); PG8_BAR; PG8_MMA(1, 0, At, B0); PG8_MMA(1, 1, At, B1); PG8_BAR; PG8_SCHED;
            PG8_LDB(B0, 1, 0); PG8_LDB(B1, 1, 1); PG8_SCHED; PG8_LDA(At, 1, 0); PG8_STAGE_A(PG8_SA(0, 1), a2 + hstepA, 1, last);
            PG8_WAIT_V(8); PG8_WAIT_L(0); PG8_BAR; PG8_MMA(0, 0, At, B0); PG8_MMA(0, 1, At, B1); PG8_BAR; PG8_SCHED;
            PG8_LDA(At, 1, 1); PG8_STAGE(PG8_SB(1, 0), b3, voffB); PG8_STAGE(PG8_SB(1, 1), b3 + hstepB, voffB); PG8_STAGE_A(PG8_SA(1, 0), a3, 0, last);
            PG8_WAIT_V(8); PG8_WAIT_L(0); PG8_BAR; PG8_MMA(1, 0, At, B0); PG8_MMA(1, 1, At, B1); PG8_BAR; PG8_SCHED;
        }
        if (wr == 0) PG8_BAR;
        E(acc, cur, wr, wc, fr, fq);
        if (!has_next) break;
#pragma unroll
        for (int a = 0; a < 2; ++a)
#pragma unroll
            for (int b = 0; b < 2; ++b)
#pragma unroll
                for (int m = 0; m < 4; ++m)
#pragma unroll
                    for (int n = 0; n < 2; ++n) acc[a][b][m][n] = (f32x4){0.f, 0.f, 0.f, 0.f};
        cur = nxt; cA = nA; cB = nB; ++ui;
        if constexpr (GA) { _Pragma("unroll") for (int h_ = 0; h_ < 2; ++h_) _Pragma("unroll") for (int i_ = 0; i_ < 2; ++i_) vgc[h_][i_] = vgn[h_][i_]; }
        if (wr == 1) PG8_BAR;
    }
    PG8_WAIT_V(0);
    PG8_BAR;
#undef PG8_SA
#undef PG8_SB
#undef PG8_STAGE
#undef PG8_STAGE_A
#undef PG8_GOFF
#undef PG8_LDA
#undef PG8_LDB
#undef PG8_MMA
#undef PG8_WAIT_V
#undef PG8_WAIT_L
#undef PG8_BAR
#undef PG8_SCHED
}

struct EpiMixRes {
    static constexpr bool PERM = true;
    bf16* O; const float* R; PG8_LAS float* ss;
    __device__ __forceinline__ void operator()(const f32x4 (&acc)[2][2][4][2], const Unit& u, int wr, int wc, int fr, int fq) const {
        const int row0 = u.pm * BM + wr * 64 + fr, col0 = u.pn * BM + wc * 32 + 8 * fq;
#pragma unroll
        for (int ai = 0; ai < 2; ++ai)
#pragma unroll
            for (int m = 0; m < 4; ++m) { const size_t ro = (size_t)(row0 + ai * HALF + m * 16) * D + col0; float q = 0.f;
#pragma unroll
                for (int bj = 0; bj < 2; ++bj) { const f32x4 v0 = acc[ai][bj][m][0] + *(const f32x4*)(R + ro + bj * HALF), v1 = acc[ai][bj][m][1] + *(const f32x4*)(R + ro + bj * HALF + 4);
                    q += (v0[0] * v0[0] + v0[1] * v0[1]) + (v0[2] * v0[2] + v0[3] * v0[3]) + (v1[0] * v1[0] + v1[1] * v1[1]) + (v1[2] * v1[2] + v1[3] * v1[3]);
                    u32x4 w; w.x = cvt_pk_bf16(v0[0], v0[1]); w.y = cvt_pk_bf16(v0[2], v0[3]); w.z = cvt_pk_bf16(v1[0], v1[1]); w.w = cvt_pk_bf16(v1[2], v1[3]);
                    *(u32x4*)(O + ro + bj * HALF) = w; }
                q += __shfl_xor(q, 16); q += __shfl_xor(q, 32);
                if (fq == 0) { PG8_LAS float* sp = ss + (ai * HALF + wr * 64 + m * 16 + fr) * 4 + wc; *sp += q; } }
    }
};
struct EpiRowScale {
    static constexpr bool PERM = true;
    bf16* O; PG8_LAS const float* ss;
    __device__ __forceinline__ void operator()(const f32x4 (&acc)[2][2][4][2], const Unit& u, int wr, int wc, int fr, int fq) const {
        const int row0 = u.pm * BM + wr * 64 + fr, col0 = u.pn * BM + wc * 32 + 8 * fq;
#pragma unroll
        for (int ai = 0; ai < 2; ++ai)
#pragma unroll
            for (int m = 0; m < 4; ++m) { bf16* rowp = O + (size_t)(row0 + ai * HALF + m * 16) * D + col0;
                const f32x4 s4 = *(PG8_LAS const f32x4*)(ss + (ai * HALF + wr * 64 + m * 16 + fr) * 4);
                const float rs = rsqrtf(((s4[0] + s4[1]) + (s4[2] + s4[3])) * (1.f / D) + 1e-6f);
#pragma unroll
                for (int bj = 0; bj < 2; ++bj) { const f32x4 v0 = acc[ai][bj][m][0] * rs, v1 = acc[ai][bj][m][1] * rs;
                    u32x4 w; w.x = cvt_pk_bf16(v0[0], v0[1]); w.y = cvt_pk_bf16(v0[2], v0[3]); w.z = cvt_pk_bf16(v1[0], v1[1]); w.w = cvt_pk_bf16(v1[2], v1[3]);
                    *(u32x4*)(rowp + bj * HALF) = w; } }
    }
};
struct EpiResBf16 {
    static constexpr bool PERM = true;
    float* C; const bf16* R;
    __device__ __forceinline__ void operator()(const f32x4 (&acc)[2][2][4][2], const Unit& u, int wr, int wc, int fr, int fq) const {
        const int row0 = u.pm * BM + wr * 64 + fr, col0 = u.pn * BM + wc * 32 + 8 * fq;
#pragma unroll
        for (int ai = 0; ai < 2; ++ai)
#pragma unroll
            for (int m = 0; m < 4; ++m) { const size_t ro = (size_t)(row0 + ai * HALF + m * 16) * D + col0;
#pragma unroll
                for (int bj = 0; bj < 2; ++bj) { const u32x4 r = *(const u32x4*)(R + ro + bj * HALF);
                    f32x4 v0 = acc[ai][bj][m][0], v1 = acc[ai][bj][m][1];
                    v0[0] += __builtin_bit_cast(float, r.x << 16); v0[1] += __builtin_bit_cast(float, r.x & 0xffff0000u); v0[2] += __builtin_bit_cast(float, r.y << 16); v0[3] += __builtin_bit_cast(float, r.y & 0xffff0000u);
                    v1[0] += __builtin_bit_cast(float, r.z << 16); v1[1] += __builtin_bit_cast(float, r.z & 0xffff0000u); v1[2] += __builtin_bit_cast(float, r.w << 16); v1[3] += __builtin_bit_cast(float, r.w & 0xffff0000u);
                    *(f32x4*)(C + ro + bj * HALF) = v0; *(f32x4*)(C + ro + bj * HALF + 4) = v1; } }
    }
};
struct EpiF32 {
    static constexpr bool PERM = false;
    float* C; int ldc; const float* R; int ldr;
    __device__ __forceinline__ void operator()(const f32x4 (&acc)[2][2][4][2], const Unit& u, int wr, int wc, int fr, int fq) const {
        const int row0 = u.pm * BM + wr * 64 + fr, col0 = u.pn * BM + wc * 32 + 4 * fq;
#pragma unroll
        for (int ai = 0; ai < 2; ++ai)
#pragma unroll
            for (int m = 0; m < 4; ++m) { const size_t row = (size_t)(row0 + ai * HALF + m * 16);
#pragma unroll
                for (int bj = 0; bj < 2; ++bj)
#pragma unroll
                    for (int n = 0; n < 2; ++n) { const int col = col0 + bj * HALF + 16 * n; f32x4 v = acc[ai][bj][m][n];
                        if (R) v = v + *(const f32x4*)(R + row * ldr + col);
                        *(f32x4*)(C + row * ldc + col) = v; } }
    }
};
struct EpiBf16 {
    static constexpr bool PERM = true;
    bf16* O; int ldc;
    __device__ __forceinline__ void operator()(const f32x4 (&acc)[2][2][4][2], const Unit& u, int wr, int wc, int fr, int fq) const {
        const int row0 = u.pm * BM + wr * 64 + fr, col0 = u.pn * BM + wc * 32 + 8 * fq;
#pragma unroll
        for (int ai = 0; ai < 2; ++ai)
#pragma unroll
            for (int m = 0; m < 4; ++m) { bf16* rowp = O + (size_t)(row0 + ai * HALF + m * 16) * ldc + col0;
#pragma unroll
                for (int bj = 0; bj < 2; ++bj) { const f32x4 v0 = acc[ai][bj][m][0], v1 = acc[ai][bj][m][1];
                    u32x4 w; w.x = cvt_pk_bf16(v0[0], v0[1]); w.y = cvt_pk_bf16(v0[2], v0[3]); w.z = cvt_pk_bf16(v1[0], v1[1]); w.w = cvt_pk_bf16(v1[2], v1[3]);
                    *(u32x4*)(rowp + bj * HALF) = w; } }
    }
};
struct EpiGlu {
    static constexpr bool PERM = true;
    const bf16* Z; const float* bias; bf16* YM;
    __device__ __forceinline__ void operator()(const f32x4 (&acc)[2][2][4][2], const Unit& u, int wr, int wc, int fr, int fq) const {
        const int row0 = u.pm * BM + wr * 64 + fr, col0 = u.pn * BM + wc * 32 + 8 * fq;
#pragma unroll
        for (int ai = 0; ai < 2; ++ai)
#pragma unroll
            for (int m = 0; m < 4; ++m) { const size_t row = (size_t)(row0 + ai * HALF + m * 16);
#pragma unroll
                for (int bj = 0; bj < 2; ++bj) { const int col = col0 + bj * HALF;
                    const u32x4 zz = *(const u32x4*)(Z + row * 512 + col);
                    const f32x4 b0 = *(const f32x4*)(bias + col), b1 = *(const f32x4*)(bias + col + 4);
                    const f32x4 v0 = acc[ai][bj][m][0] + b0, v1 = acc[ai][bj][m][1] + b1;
                    float o[8]; const unsigned zw[4] = {zz.x, zz.y, zz.z, zz.w};
#pragma unroll
                    for (int q = 0; q < 4; ++q) { const float zl = __builtin_bit_cast(float, zw[q] << 16), zh = __builtin_bit_cast(float, zw[q] & 0xffff0000u);
                        const float al = (q < 2) ? v0[2 * q] : v1[2 * q - 4], ah = (q < 2) ? v0[2 * q + 1] : v1[2 * q - 3];
                        o[2 * q] = zl * sigmoidf_(al); o[2 * q + 1] = zh * sigmoidf_(ah); }
                    u32x4 w; w.x = cvt_pk_bf16(o[0], o[1]); w.y = cvt_pk_bf16(o[2], o[3]); w.z = cvt_pk_bf16(o[4], o[5]); w.w = cvt_pk_bf16(o[6], o[7]);
                    *(u32x4*)(YM + row * D + 512 + col) = w; } }
    }
};

template <bool GATHER_>
struct MoeOrderT {
    static constexpr bool GATHER = GATHER_;
    const bf16* A; const bf16* Bt; int lda, ldb, K; const int* tiles; const int* rows; int nunits, G, c; size_t bexp;
    __device__ void init(const bf16* A_, int lda_, const bf16* Bt_, int ldb_, int K_, const int* tiles_, int ntiles, size_t bexp_, const int* rows_) { A = A_; Bt = Bt_; lda = lda_; ldb = ldb_; K = K_; tiles = tiles_; rows = rows_; nunits = ntiles * 4; G = GN; c = GB; bexp = bexp_; }
    __device__ bool next(int i, Unit& u) const { const int L = i * G + c; if (L >= nunits) return false; u.pm = L >> 2; u.pn = L & 3; return true; }
    __device__ __forceinline__ const char* aptr(const Unit& u) const { return GATHER ? (const char*)A : (const char*)(A + (size_t)u.pm * BM * lda); }
    __device__ __forceinline__ int grow(const Unit& u, int r) const { return rows[u.pm * BM + r]; }
    __device__ __forceinline__ const char* bptr(const Unit& u) const { const int e = __hip_atomic_load(tiles + u.pm, __ATOMIC_RELAXED, __HIP_MEMORY_SCOPE_AGENT); return (const char*)(Bt + ((size_t)e * bexp + (size_t)u.pn * BM) * ldb); }
};
struct EpiSilu {
    static constexpr bool PERM = true;
    bf16* HID;
    __device__ __forceinline__ void operator()(const f32x4 (&acc)[2][2][4][2], const Unit& u, int wr, int wc, int fr, int fq) const {
        const int row0 = u.pm * BM + wr * 64 + fr, col0 = u.pn * HALF + wc * 32 + 8 * fq;
#pragma unroll
        for (int ai = 0; ai < 2; ++ai)
#pragma unroll
            for (int m = 0; m < 4; ++m) { const size_t row = (size_t)(row0 + ai * HALF + m * 16);
                float o[8];
#pragma unroll
                for (int n = 0; n < 2; ++n)
#pragma unroll
                    for (int q = 0; q < 4; ++q) { const float g = acc[ai][0][m][n][q], up = acc[ai][1][m][n][q]; o[4 * n + q] = g * sigmoidf_(g) * up; }
                u32x4 w; w.x = cvt_pk_bf16(o[0], o[1]); w.y = cvt_pk_bf16(o[2], o[3]); w.z = cvt_pk_bf16(o[4], o[5]); w.w = cvt_pk_bf16(o[6], o[7]);
                *(u32x4*)(HID + row * DEXP + col0) = w; }
    }
};
struct EpiGate {
    static constexpr bool PERM = true;
    bf16* Y; const float* gate;
    __device__ __forceinline__ void operator()(const f32x4 (&acc)[2][2][4][2], const Unit& u, int wr, int wc, int fr, int fq) const {
        const int row0 = u.pm * BM + wr * 64 + fr, col0 = u.pn * BM + wc * 32 + 8 * fq;
#pragma unroll
        for (int ai = 0; ai < 2; ++ai)
#pragma unroll
            for (int m = 0; m < 4; ++m) { const size_t row = (size_t)(row0 + ai * HALF + m * 16); const float gt = gate[row];
#pragma unroll
                for (int bj = 0; bj < 2; ++bj) { const f32x4 v0 = acc[ai][bj][m][0] * gt, v1 = acc[ai][bj][m][1] * gt;
                    u32x4 w; w.x = cvt_pk_bf16(v0[0], v0[1]); w.y = cvt_pk_bf16(v0[2], v0[3]); w.z = cvt_pk_bf16(v1[0], v1[1]); w.w = cvt_pk_bf16(v1[2], v1[3]);
                    *(u32x4*)(Y + row * D + col0 + bj * HALF) = w; } }
    }
};

struct EpiProj {
    static constexpr bool PERM = true;
    bf16* PROJ; bf16* US5;
    __device__ __forceinline__ void operator()(const f32x4 (&acc)[2][2][4][2], const Unit& u, int wr, int wc, int fr, int fq) const {
        const int row0 = u.pm * BM + wr * 64 + fr, col0 = u.pn * BM + wc * 32 + 8 * fq;
#pragma unroll
        for (int ai = 0; ai < 2; ++ai)
#pragma unroll
            for (int m = 0; m < 4; ++m) { const size_t row = (size_t)(row0 + ai * HALF + m * 16);
#pragma unroll
                for (int bj = 0; bj < 2; ++bj) { const f32x4 v0 = acc[ai][bj][m][0], v1 = acc[ai][bj][m][1]; const int col = col0 + bj * HALF;
                    u32x4 w; w.x = cvt_pk_bf16(v0[0], v0[1]); w.y = cvt_pk_bf16(v0[2], v0[3]); w.z = cvt_pk_bf16(v1[0], v1[1]); w.w = cvt_pk_bf16(v1[2], v1[3]);
                    if (col < DSHIFT) *(u32x4*)(PROJ + row * DSHIFT + col) = w;
                    else { const int cc = col - DSHIFT; *(u32x4*)(US5 + ((size_t)(cc >> 4) * M + row) * 16 + (cc & 15)) = w; } } }
    }
};
struct GroupOrder {
    static constexpr bool GATHER = false; __device__ __forceinline__ int grow(const Unit&, int) const { return 0; }
    const bf16* A; const bf16* Bt; int lda, ldb, K; int nM, nN, nunits, G, c; size_t sA, sB;
    __device__ void init(const bf16* A_, int lda_, size_t sA_, const bf16* Bt_, int ldb_, size_t sB_, int ngroups, int Mg, int Ng, int K_) {
        A = A_; Bt = Bt_; lda = lda_; ldb = ldb_; K = K_; sA = sA_; sB = sB_; nM = Mg / BM; nN = Ng / BM; nunits = ngroups * nM * nN; G = GN; c = GB; }
    __device__ bool next(int i, Unit& u) const { const int L = i * G + c; if (L >= nunits) return false; u.pn = L % nN; u.pm = L / nN; return true; }
    __device__ __forceinline__ const char* aptr(const Unit& u) const { const int g = u.pm / nM, pm = u.pm % nM; return (const char*)(A + (size_t)g * sA + (size_t)pm * BM * lda); }
    __device__ __forceinline__ const char* bptr(const Unit& u) const { const int g = u.pm / nM; return (const char*)(Bt + (size_t)g * sB + (size_t)u.pn * BM * ldb); }
};
struct EpiS5a {
    static constexpr bool PERM = false;
    bf16* YI; float* F;
    __device__ __forceinline__ void operator()(const f32x4 (&acc)[2][2][4][2], const Unit& u, int wr, int wc, int fr, int fq) const {
        const int row0 = u.pm * BM + wr * 64 + fr, col0 = u.pn * BM + wc * 32 + 4 * fq;
#pragma unroll
        for (int ai = 0; ai < 2; ++ai)
#pragma unroll
            for (int m = 0; m < 4; ++m) { const size_t row = (size_t)(row0 + ai * HALF + m * 16);
#pragma unroll
                for (int bj = 0; bj < 2; ++bj)
#pragma unroll
                    for (int n = 0; n < 2; ++n) { const int col = col0 + bj * HALF + 16 * n; const f32x4 v = acc[ai][bj][m][n];
                        if (col < 512) { uint2 w; w.x = cvt_pk_bf16(v[0], v[1]); w.y = cvt_pk_bf16(v[2], v[3]); *(uint2*)(YI + row * 512 + col) = w; }
                        else if (col < 640) *(f32x4*)(F + row * 128 + (col - 512)) = v; } }
    }
};
struct EpiS5b {
    static constexpr bool PERM = true;
    const bf16* YI; bf16* Z;
    __device__ __forceinline__ void operator()(const f32x4 (&acc)[2][2][4][2], const Unit& u, int wr, int wc, int fr, int fq) const {
        const int row0 = u.pm * BM + wr * 64 + fr, col0 = u.pn * BM + wc * 32 + 8 * fq;
#pragma unroll
        for (int ai = 0; ai < 2; ++ai)
#pragma unroll
            for (int m = 0; m < 4; ++m) { const int row = row0 + ai * HALF + m * 16; const int g = row / S5R, rl = row % S5R;
#pragma unroll
                for (int bj = 0; bj < 2; ++bj) { const int col = col0 + bj * HALF;
                    const u32x4 yi = *(const u32x4*)(YI + (size_t)row * 512 + col);
                    const unsigned yw[4] = {yi.x, yi.y, yi.z, yi.w};
                    const f32x4 v0 = acc[ai][bj][m][0], v1 = acc[ai][bj][m][1];
                    float o[8];
#pragma unroll
                    for (int q = 0; q < 4; ++q) { const float al = (q < 2) ? v0[2 * q] : v1[2 * q - 4], ah = (q < 2) ? v0[2 * q + 1] : v1[2 * q - 3];
                        o[2 * q] = gelu_tanh(al + __builtin_bit_cast(float, yw[q] << 16)); o[2 * q + 1] = gelu_tanh(ah + __builtin_bit_cast(float, yw[q] & 0xffff0000u)); }
                    u32x4 w; w.x = cvt_pk_bf16(o[0], o[1]); w.y = cvt_pk_bf16(o[2], o[3]); w.z = cvt_pk_bf16(o[4], o[5]); w.w = cvt_pk_bf16(o[6], o[7]);
                    const size_t tok = (size_t)rl * S5L + (col >> 4);
                    *(u32x4*)(Z + tok * 512 + g * 16 + (col & 15)) = w; } }
    }
};
struct AttnOrder {
    static constexpr bool GATHER = false; __device__ __forceinline__ int grow(const Unit&, int) const { return 0; }
    const bf16* A; const bf16* Bt; int lda, ldb, K; int G, c; int mode;
    __device__ void init(const bf16* A_, const bf16* Bt_, int ldb_, int mode_) { A = A_; Bt = Bt_; lda = D; ldb = ldb_; K = 256; G = GN; c = GB; mode = mode_; }
    __device__ bool next(int i, Unit& u) const { const int L = i * G + c; if (L >= NB * 4 * 32) return false; u.pn = L & 3; u.pm = L >> 2; return true; }
    __device__ __forceinline__ const char* aptr(const Unit& u) const { return (const char*)(A + (size_t)u.pm * BM * D + u.pn * 256); }
    __device__ __forceinline__ const char* bptr(const Unit& u) const { const int b = u.pm >> 5;
        return (const char*)(mode == 0 ? Bt + (size_t)b * 256 * ldb + u.pn * 256 : Bt + (size_t)u.pn * 256 * ldb + b * 256); }
};
struct EpiSoftmax {
    static constexpr bool PERM = true;
    bf16* P; PG8_LAS float* scr;
    __device__ __forceinline__ void operator()(f32x4 (&acc)[2][2][4][2], const Unit& u, int wr, int wc, int fr, int fq) const {
        const float SC = 0.0625f * 1.4426950408889634f;
        PG8_LAS float* smax = scr; PG8_LAS float* ssum = scr + 1024;
#pragma unroll
        for (int ai = 0; ai < 2; ++ai)
#pragma unroll
            for (int m = 0; m < 4; ++m) { float t = -3.0e38f;
#pragma unroll
                for (int bj = 0; bj < 2; ++bj)
#pragma unroll
                    for (int n = 0; n < 2; ++n) { const f32x4 v = acc[ai][bj][m][n]; t = fmaxf(t, fmaxf(fmaxf(v[0], v[1]), fmaxf(v[2], v[3]))); }
                t = fmaxf(t, __shfl_xor(t, 16)); t = fmaxf(t, __shfl_xor(t, 32));
                if (fq == 0) smax[(ai * HALF + wr * 64 + m * 16 + fr) * 4 + wc] = t; }
        asm volatile("s_waitcnt lgkmcnt(0)" ::: "memory"); __builtin_amdgcn_s_barrier(); asm volatile("" ::: "memory");
#pragma unroll
        for (int ai = 0; ai < 2; ++ai)
#pragma unroll
            for (int m = 0; m < 4; ++m) { const f32x4 q = *(const PG8_LAS f32x4*)(smax + (ai * HALF + wr * 64 + m * 16 + fr) * 4);
                const float mm = fmaxf(fmaxf(q[0], q[1]), fmaxf(q[2], q[3])) * SC; float s = 0.f;
#pragma unroll
                for (int bj = 0; bj < 2; ++bj)
#pragma unroll
                    for (int n = 0; n < 2; ++n)
#pragma unroll
                        for (int e = 0; e < 4; ++e) { const float p = __builtin_amdgcn_exp2f(acc[ai][bj][m][n][e] * SC - mm); acc[ai][bj][m][n][e] = p; s += p; }
                s += __shfl_xor(s, 16); s += __shfl_xor(s, 32);
                if (fq == 0) ssum[(ai * HALF + wr * 64 + m * 16 + fr) * 4 + wc] = s; }
        asm volatile("s_waitcnt lgkmcnt(0)" ::: "memory"); __builtin_amdgcn_s_barrier(); asm volatile("" ::: "memory");
        const int row0 = u.pm * BM + wr * 64 + fr, col0 = u.pn * 256 + wc * 32 + 8 * fq;
#pragma unroll
        for (int ai = 0; ai < 2; ++ai)
#pragma unroll
            for (int m = 0; m < 4; ++m) { const f32x4 q = *(const PG8_LAS f32x4*)(ssum + (ai * HALF + wr * 64 + m * 16 + fr) * 4);
                const float iv = 1.f / ((q[0] + q[1]) + (q[2] + q[3]));
                bf16* rowp = P + (size_t)(row0 + ai * HALF + m * 16) * D + col0;
#pragma unroll
                for (int bj = 0; bj < 2; ++bj) { const f32x4 v0 = acc[ai][bj][m][0] * iv, v1 = acc[ai][bj][m][1] * iv; u32x4 w;
                    w.x = cvt_pk_bf16(v0[0], v0[1]); w.y = cvt_pk_bf16(v0[2], v0[3]); w.z = cvt_pk_bf16(v1[0], v1[1]); w.w = cvt_pk_bf16(v1[2], v1[3]);
                    *(u32x4*)(rowp + bj * HALF) = w; } }
    }
};
struct EpiAttnO {
    static constexpr bool PERM = true;
    bf16* O;
    __device__ __forceinline__ void operator()(const f32x4 (&acc)[2][2][4][2], const Unit& u, int wr, int wc, int fr, int fq) const {
        const int row0 = u.pm * BM + wr * 64 + fr, col0 = u.pn * 256 + wc * 32 + 8 * fq;
#pragma unroll
        for (int ai = 0; ai < 2; ++ai)
#pragma unroll
            for (int m = 0; m < 4; ++m) { bf16* rowp = O + (size_t)(row0 + ai * HALF + m * 16) * D + col0;
#pragma unroll
                for (int bj = 0; bj < 2; ++bj) { const f32x4 v0 = acc[ai][bj][m][0], v1 = acc[ai][bj][m][1];
                    u32x4 w; w.x = cvt_pk_bf16(v0[0], v0[1]); w.y = cvt_pk_bf16(v0[2], v0[3]); w.z = cvt_pk_bf16(v1[0], v1[1]); w.w = cvt_pk_bf16(v1[2], v1[3]);
                    *(u32x4*)(rowp + bj * HALF) = w; } }
    }
};

struct EpiLora {
    static constexpr bool PERM = true;
    bf16* LW; size_t ostride; const float* w0; const float* a0;
    __device__ __forceinline__ void operator()(const f32x4 (&acc)[2][2][4][2], const Unit& u, int wr, int wc, int fr, int fq) const {
        const int row0 = u.pm * BM + wr * 64 + fr, col0 = u.pn * BM + wc * 32 + 8 * fq;
        const int kind = u.pn >> 1;
        bf16* O = LW + (size_t)kind * ostride;
#pragma unroll
        for (int bj = 0; bj < 2; ++bj) { const int col = (col0 + bj * HALF) & 511;
            f32x4 b0 = (f32x4){0.f, 0.f, 0.f, 0.f}, b1 = b0;
            if (kind == 0) { b0 = *(const f32x4*)(w0 + col); b1 = *(const f32x4*)(w0 + col + 4); }
            else if (kind == 1) { b0 = *(const f32x4*)(a0 + col); b1 = *(const f32x4*)(a0 + col + 4); }
#pragma unroll
            for (int ai = 0; ai < 2; ++ai)
#pragma unroll
                for (int m = 0; m < 4; ++m) { const size_t row = (size_t)(row0 + ai * HALF + m * 16);
                    const f32x4 v0 = acc[ai][bj][m][0] + b0, v1 = acc[ai][bj][m][1] + b1; float o[8];
#pragma unroll
                    for (int e = 0; e < 8; ++e) { float x = (e < 4) ? v0[e & 3] : v1[e & 3];
                        if (kind == 0) x = -0.6065306597126334f * sigmoidf_(x);
                        else if (kind == 1) x = sigmoidf_(x);
                        o[e] = x; }
                    u32x4 w; w.x = cvt_pk_bf16(o[0], o[1]); w.y = cvt_pk_bf16(o[2], o[3]); w.z = cvt_pk_bf16(o[4], o[5]); w.w = cvt_pk_bf16(o[6], o[7]);
                    *(u32x4*)(O + row * 512 + col) = w; } }
    }
};

struct TileOrder {
    static constexpr bool GATHER = false; __device__ __forceinline__ int grow(const Unit&, int) const { return 0; }
    const bf16* A; const bf16* Bt; int lda, ldb, K, nN, pm;
    __device__ void init(const bf16* A_, int lda_, const bf16* Bt_, int ldb_, int K_, int nN_, int pm_) { A = A_; Bt = Bt_; lda = lda_; ldb = ldb_; K = K_; nN = nN_; pm = pm_; }
    __device__ bool next(int i, Unit& u) const { if (i >= nN) return false; int pm_ = pm; asm volatile("" : "+s"(pm_)); u.pm = pm_; u.pn = (i + (GB >> 3)) & (nN - 1); return true; }
    __device__ __forceinline__ const char* aptr(const Unit& u) const { return (const char*)(A + (size_t)u.pm * BM * lda); }
    __device__ __forceinline__ const char* bptr(const Unit& u) const { return (const char*)(Bt + (size_t)u.pn * BM * ldb); }
};
struct AttnTileOrder {
    static constexpr bool GATHER = false; __device__ __forceinline__ int grow(const Unit&, int) const { return 0; }
    const bf16* A; const bf16* Bt; int lda, ldb, K, pm, mode;
    __device__ void init(const bf16* A_, const bf16* Bt_, int ldb_, int mode_, int pm_) { A = A_; Bt = Bt_; lda = D; ldb = ldb_; K = 256; mode = mode_; pm = pm_; }
    __device__ bool next(int i, Unit& u) const { if (i >= 4) return false; int pm_ = pm; asm volatile("" : "+s"(pm_)); u.pm = pm_; u.pn = (i + (GB >> 3)) & 3; return true; }
    __device__ __forceinline__ const char* aptr(const Unit& u) const { return (const char*)(A + (size_t)u.pm * BM * D + u.pn * 256); }
    __device__ __forceinline__ const char* bptr(const Unit& u) const { const int b = u.pm >> 5;
        return (const char*)(mode == 0 ? Bt + (size_t)b * 256 * ldb + u.pn * 256 : Bt + (size_t)u.pn * 256 * ldb + b * 256); }
};
}

#define LAS __attribute__((address_space(3)))
__device__ __forceinline__ void transpose_item(const float* __restrict__ W, int K, int N, bf16* __restrict__ WT, int ldt, int row_off, int col_off, float* scr, int item, int lane, const float* __restrict__ kscale, int ldw = 0) {
    if (ldw == 0) ldw = N;
    const int nblk = N / 32, kb = item / nblk, nb = item % nblk, k0 = 64 * kb, n0 = 32 * nb;
#pragma unroll 8
    for (int i = 0; i < 32; ++i) { const int kk = 2 * i + (lane >> 5); float v = W[(size_t)(k0 + kk) * ldw + n0 + (lane & 31)]; if (kscale) v *= kscale[k0 + kk]; scr[kk * 33 + (lane & 31)] = v; }
    __builtin_amdgcn_s_waitcnt(0xc07f); asm volatile("" ::: "memory");
    const int c = lane & 7;
#pragma unroll
    for (int j = 0; j < 4; ++j) { const int n = (lane >> 3) + 8 * j; const float* s = scr + (8 * c) * 33 + n;
        uint4 o; o.x = pk2(s[0 * 33], s[1 * 33]); o.y = pk2(s[2 * 33], s[3 * 33]); o.z = pk2(s[4 * 33], s[5 * 33]); o.w = pk2(s[6 * 33], s[7 * 33]);
        *(uint4*)(WT + (size_t)(row_off + n0 + n) * ldt + col_off + k0 + 8 * c) = o; }
    __builtin_amdgcn_s_waitcnt(0xc07f); asm volatile("" ::: "memory");
}
__device__ __forceinline__ void transpose_ph(const int WID_, const float* W, int K, int N, bf16* WT, int ldt, int row_off, int col_off, char* lds, const float* kscale = nullptr) {
    const int lane = (WID_ * 64 + lane_id()) & 63, wv = (WID_ * 64 + lane_id()) >> 6;
    float* scr = (float*)(lds + wv * 16384);
    const int nitems = (K / 64) * (N / 32);
    for (int it = GB * 8 + wv; it < nitems; it += GN * 8) transpose_item(W, K, N, WT, ldt, row_off, col_off, scr, it, lane, kscale);
}

template <typename TO>
__device__ __forceinline__ void rmsnorm_ph(const int WID_, const float* __restrict__ x, const float* __restrict__ w, TO* __restrict__ out, int rows, int row_lo = 0, int vb = GB, int nvb = GN) {
    const int lane = lane_id(), wv = WID_;
    float4 g[4];
#pragma unroll
    for (int j = 0; j < 4; ++j) g[j] = *(const float4*)(w + (lane + 64 * j) * 4);
    for (int row = row_lo + (vb * 8 + wv) * 2; row < rows; row += nvb * 16) {
        const float4* xr = (const float4*)(x + (size_t)row * D);
        float4 v[2][4]; float s[2] = {0.f, 0.f};
#pragma unroll
        for (int r = 0; r < 2; ++r)
#pragma unroll
            for (int j = 0; j < 4; ++j) v[r][j] = xr[r * (D / 4) + lane + 64 * j];
#pragma unroll
        for (int r = 0; r < 2; ++r) {
#pragma unroll
            for (int j = 0; j < 4; ++j) s[r] += v[r][j].x * v[r][j].x + v[r][j].y * v[r][j].y + v[r][j].z * v[r][j].z + v[r][j].w * v[r][j].w;
            s[r] = wave_sum(s[r]);
            const float rs = rsqrtf(s[r] * (1.f / D) + 1e-6f);
#pragma unroll
            for (int j = 0; j < 4; ++j) {
                uint2 o; o.x = pk2(v[r][j].x * rs * g[j].x, v[r][j].y * rs * g[j].y); o.y = pk2(v[r][j].z * rs * g[j].z, v[r][j].w * rs * g[j].w);
                *(uint2*)(out + (size_t)(row + r) * D + (lane + 64 * j) * 4) = o;
            }
        }
    }
}

__device__ __forceinline__ void rwkv_lin_ph(const int WID_, const bf16* __restrict__ proj, const float* __restrict__ mu, bf16* __restrict__ lin) {
    const int lane = lane_id(), wv = WID_;
    const float4 m4 = *(const float4*)(mu + 1536 + 4 * lane);
    const float mm[4] = {m4.x, m4.y, m4.z, m4.w};
    for (int m0 = (GB * 8 + wv) * 4; m0 < M; m0 += GN * 32) {
        uint2 z[4], zp[4];
#pragma unroll
        for (int i = 0; i < 4; ++i) { const int m = m0 + i; z[i] = *(const uint2*)(proj + (size_t)m * DSHIFT + 1536 + 4 * lane);
            zp[i] = make_uint2(0, 0); if ((m & (S - 1)) != 0) zp[i] = *(const uint2*)(proj + (size_t)(m - 1) * DSHIFT + 1536 + 4 * lane); }
#pragma unroll
        for (int i = 0; i < 4; ++i) {
            float c[4] = {__builtin_bit_cast(float, z[i].x << 16), __builtin_bit_cast(float, z[i].x & 0xffff0000u), __builtin_bit_cast(float, z[i].y << 16), __builtin_bit_cast(float, z[i].y & 0xffff0000u)};
            const float q[4] = {__builtin_bit_cast(float, zp[i].x << 16), __builtin_bit_cast(float, zp[i].x & 0xffff0000u), __builtin_bit_cast(float, zp[i].y << 16), __builtin_bit_cast(float, zp[i].y & 0xffff0000u)};
#pragma unroll
            for (int e = 0; e < 4; ++e) { float t = c[e] + (q[e] - c[e]) * mm[e];
                if (lane < 16) t = 1.f - 2.f / (1.f + __expf(2.f * t));
                else if (lane >= 32) t = sigmoidf_(t);
                c[e] = t; }
            uint2 o; o.x = pk2(c[0], c[1]); o.y = pk2(c[2], c[3]);
            *(uint2*)(lin + (size_t)(m0 + i) * 256 + 4 * lane) = o;
        }
    }
}
__device__ __forceinline__ void rwkv_wl_ph(const int WID_, const float* __restrict__ wdec, const float* __restrict__ wiclr, const float* __restrict__ wgate, bf16* __restrict__ wl) {
    for (int i = GB * NT + (WID_ * 64 + lane_id()); i < 1536 * 256; i += GN * NT) {
        const int k = i & 255, n = i >> 8; float v = 0.f;
        if (n < 512) { if (k < 64) v = wdec[k * 512 + n]; }
        else if (n < 1024) { if (k >= 64 && k < 128) v = wiclr[(k - 64) * 512 + (n - 512)]; }
        else { if (k >= 128) v = wgate[(k - 128) * 512 + (n - 1024)]; }
        wl[i] = f2bf(v);
    }
}
template <int CTRL> __device__ __forceinline__ float dpp16(float x) { return __builtin_bit_cast(float, __builtin_amdgcn_update_dpp(0, __builtin_bit_cast(int, x), CTRL, 0xf, 0xf, true)); }
constexpr int RW_ITEMS = NB * 8;

namespace ck {
#define CK_BAR() do { asm volatile("s_waitcnt lgkmcnt(0)" ::: "memory"); __builtin_amdgcn_s_barrier(); asm volatile("" ::: "memory"); } while (0)
typedef float f32x2_t __attribute__((ext_vector_type(2)));
typedef __bf16 bf16x2_t __attribute__((ext_vector_type(2)));
__device__ __forceinline__ unsigned cvtpk(float lo, float hi) { const f32x2_t v = {lo, hi}; const bf16x2_t b = __builtin_convertvector(v, bf16x2_t); return __builtin_bit_cast(unsigned, b); }
typedef short bf16x8 __attribute__((ext_vector_type(8)));
typedef float f32x16 __attribute__((ext_vector_type(16)));
constexpr int LD = 72;
constexpr int MB = 64 * LD * 2;
constexpr int O_AB = 0, O_RB = MB, O_BB = 2 * MB, O_KB = 3 * MB, O_AT = 4 * MB, O_W1T = 5 * MB, O_BT = 6 * MB, O_KT = 7 * MB, O_VT = 8 * MB,
              O_NM = 9 * MB, O_AAK = 10 * MB, O_ARB = 11 * MB, O_ARK = 12 * MB, O_G = 13 * MB, O_TOT = O_G + 16384;
constexpr int O_TM = O_AB, O_X1T = O_BB, O_NMF = O_G, O_TT = O_G + 8192, O_ZT = O_TT + 5120;
constexpr int ITEM_BYTES = 32768;
template <int K, typename PA, typename PB>
__device__ __forceinline__ f32x16 mm_tile(f32x16 acc, PA A, int lda, PB B, int ldb, int lane) {
    const int r = lane & 31, h = lane >> 5;
    bf16x8 a[K / 16], b[K / 16];
#pragma unroll
    for (int q = 0; q < K / 16; ++q) { a[q] = *(const bf16x8*)(A + r * lda + 16 * q + 8 * h); b[q] = *(const bf16x8*)(B + r * ldb + 16 * q + 8 * h); }
#pragma unroll
    for (int q = 0; q < K / 16; ++q) acc = __builtin_amdgcn_mfma_f32_32x32x16_bf16(a[q], b[q], acc, 0, 0, 0);
    return acc;
}
__device__ __forceinline__ int crow(int reg, int h) { return (reg & 3) + 8 * (reg >> 2) + 4 * h; }
__device__ __forceinline__ void store_tr(const f32x16& acc, bf16* Ct, int ldct, int lane) {
    const int c = lane & 31, h = lane >> 5;
#pragma unroll
    for (int g = 0; g < 4; ++g) { uint2 w; w.x = cvtpk(acc[4 * g], acc[4 * g + 1]); w.y = cvtpk(acc[4 * g + 2], acc[4 * g + 3]); *(uint2*)(Ct + c * ldct + 8 * g + 4 * h) = w; }
}
__device__ __forceinline__ void store_rm(const f32x16& acc, bf16* C, int ldc, int lane) {
    const int c = lane & 31, h = lane >> 5;
#pragma unroll
    for (int rg = 0; rg < 16; ++rg) C[crow(rg, h) * ldc + c] = f2bf(acc[rg]);
}
__device__ __forceinline__ f32x16 zero16() { return (f32x16){0.f, 0.f, 0.f, 0.f, 0.f, 0.f, 0.f, 0.f, 0.f, 0.f, 0.f, 0.f, 0.f, 0.f, 0.f, 0.f}; }
__device__ __forceinline__ void store_frag16(const f32x16& acc, bf16* base, int t0, int t1, int lane) {
    const int cc = lane & 31, hh = lane >> 5, col = 32 * t1 + cc;
#pragma unroll
    for (int g = 0; g < 4; ++g) { const int row = 32 * t0 + 8 * g + 4 * hh;
        uint2 w; w.x = cvtpk(acc[4 * g], acc[4 * g + 1]); w.y = cvtpk(acc[4 * g + 2], acc[4 * g + 3]);
        *(uint2*)(base + (((row >> 4) * 4 + (col >> 4)) * 64 + (col & 15) + 16 * ((row & 15) >> 2)) * 4) = w; }
}
struct In { const bf16* proj; const bf16* LW; const bf16* AA; const float* mu; const float* k_k; const float* k_a; const float* r_k; float* RK; char* items; };

__device__ __forceinline__ void phase1(const int WID_, const In& I, char* lds) {
    const int wv = WID_;
#define MAT(off) ((bf16*)(lds + (off)))
    float* G = (float*)(lds + O_G); float* TOT = (float*)(lds + O_TOT); float* NMF = (float*)(lds + O_NMF);
    uint4 nx_r, nx_k, nx_v, nx_qr, nx_qk, nx_qv, nx_a, nx_l;
    { const int lane0 = lane_id(), tid0 = wv * 64 + lane0; const int item = GB;
      if (item < NB * 8 * (S / 64)) { const int c = item & 127, h = (item >> 7) & 7, b = item >> 10, s = tid0 >> 3, cg = tid0 & 7, ch0 = h * 64 + cg * 8, t = c * 64 + s; const size_t m = (size_t)b * S + t;
        const bf16* z = I.proj + m * DSHIFT + ch0;
        nx_r = *(const uint4*)(z); nx_k = *(const uint4*)(z + 512); nx_v = *(const uint4*)(z + 1024);
        nx_qr = make_uint4(0, 0, 0, 0); nx_qk = nx_qr; nx_qv = nx_qr;
        if (t > 0) { nx_qr = *(const uint4*)(z - DSHIFT); nx_qk = *(const uint4*)(z + 512 - DSHIFT); nx_qv = *(const uint4*)(z + 1024 - DSHIFT); }
        nx_a = *(const uint4*)(I.AA + m * 512 + ch0); nx_l = *(const uint4*)(I.LW + m * 512 + ch0); } }
    for (int item = GB; item < NB * 8 * (S / 64); item += GN) {
        const int lane = lane_id(), tid = wv * 64 + lane;
        const int c = item & 127, h = (item >> 7) & 7, b = item >> 10;
        char* out = I.items + (size_t)item * ITEM_BYTES;
        const int s = tid >> 3, cg = tid & 7, ch0 = h * 64 + cg * 8, t = c * 64 + s; const size_t m = (size_t)b * S + t;
        float r_[8], kp_[8], v_[8], kk_[8], b_[8];
        {
            const uint4 gr = nx_r, gk = nx_k, gv = nx_v, qr = nx_qr, qk = nx_qk, qv = nx_qv, ga = nx_a, gl = nx_l;
            const float4 c_mr0 = *(const float4*)(I.mu + ch0), c_mr1 = *(const float4*)(I.mu + ch0 + 4), c_mk0 = *(const float4*)(I.mu + 512 + ch0), c_mk1 = *(const float4*)(I.mu + 512 + ch0 + 4);
            const float4 c_mv0 = *(const float4*)(I.mu + 1024 + ch0), c_mv1 = *(const float4*)(I.mu + 1024 + ch0 + 4), c_kk0 = *(const float4*)(I.k_k + ch0), c_kk1 = *(const float4*)(I.k_k + ch0 + 4);
            const float4 c_ka0 = *(const float4*)(I.k_a + ch0), c_ka1 = *(const float4*)(I.k_a + ch0 + 4), c_rk0 = *(const float4*)(I.r_k + ch0), c_rk1 = *(const float4*)(I.r_k + ch0 + 4);
            const float mur[8] = {c_mr0.x, c_mr0.y, c_mr0.z, c_mr0.w, c_mr1.x, c_mr1.y, c_mr1.z, c_mr1.w}, muk[8] = {c_mk0.x, c_mk0.y, c_mk0.z, c_mk0.w, c_mk1.x, c_mk1.y, c_mk1.z, c_mk1.w};
            const float muv[8] = {c_mv0.x, c_mv0.y, c_mv0.z, c_mv0.w, c_mv1.x, c_mv1.y, c_mv1.z, c_mv1.w}, ckk[8] = {c_kk0.x, c_kk0.y, c_kk0.z, c_kk0.w, c_kk1.x, c_kk1.y, c_kk1.z, c_kk1.w};
            const float cka[8] = {c_ka0.x, c_ka0.y, c_ka0.z, c_ka0.w, c_ka1.x, c_ka1.y, c_ka1.z, c_ka1.w}, crk[8] = {c_rk0.x, c_rk0.y, c_rk0.z, c_rk0.w, c_rk1.x, c_rk1.y, c_rk1.z, c_rk1.w};
            const unsigned wr[4] = {gr.x, gr.y, gr.z, gr.w}, wk[4] = {gk.x, gk.y, gk.z, gk.w}, wv4[4] = {gv.x, gv.y, gv.z, gv.w};
            const unsigned pr[4] = {qr.x, qr.y, qr.z, qr.w}, pk[4] = {qk.x, qk.y, qk.z, qk.w}, pv[4] = {qv.x, qv.y, qv.z, qv.w};
            const unsigned wa[4] = {ga.x, ga.y, ga.z, ga.w}, wl[4] = {gl.x, gl.y, gl.z, gl.w};
            float ss = 0.f, rk = 0.f, a_[8];
#pragma unroll
            for (int e = 0; e < 8; ++e) { const int w_ = e >> 1; const bool hi = e & 1;
                auto ex = [&](unsigned u) { return hi ? __builtin_bit_cast(float, u & 0xffff0000u) : __builtin_bit_cast(float, u << 16); };
                float x = ex(wr[w_]); r_[e] = x + (ex(pr[w_]) - x) * mur[e];
                x = ex(wk[w_]); const float k = x + (ex(pk[w_]) - x) * muk[e];
                x = ex(wv4[w_]); v_[e] = x + (ex(pv[w_]) - x) * muv[e];
                a_[e] = ex(wa[w_]); kk_[e] = k * ckk[e]; ss += kk_[e] * kk_[e];
                kp_[e] = k * (1.f + (a_[e] - 1.f) * cka[e]); rk += r_[e] * kp_[e] * crk[e];
                G[s * 64 + cg * 8 + e] = ex(wl[w_]); }
            ss += dpp16<0xB1>(ss); ss += dpp16<0x4E>(ss); ss += dpp16<0x141>(ss);
            const float inv = 1.f / fmaxf(sqrtf(ss), 1e-12f);
#pragma unroll
            for (int e = 0; e < 8; ++e) { kk_[e] *= inv; b_[e] = kk_[e] * a_[e]; }
            rk += dpp16<0xB1>(rk); rk += dpp16<0x4E>(rk); rk += dpp16<0x141>(rk);
            if (cg == 0) I.RK[m * 8 + h] = rk;
        }
        CK_BAR();
        { const int ch = tid & 63, part = tid >> 6; float run = 0.f;
#pragma unroll
          for (int i = 0; i < 8; ++i) { run += G[(8 * part + i) * 64 + ch]; G[(8 * part + i) * 64 + ch] = run; }
          TOT[part * 64 + ch] = run; }
        CK_BAR();
        { const int ch = tid & 63, part = tid >> 6; float off = 0.f;
          for (int p = 0; p < part; ++p) off += TOT[p * 64 + ch];
#pragma unroll
          for (int i = 0; i < 8; ++i) G[(8 * part + i) * 64 + ch] += off; }
        CK_BAR();
        float glast[8];
        {
            unsigned pab[4], prb[4], pbb[4], pkb[4];
            float ab[8], rb[8], bb[8], kb[8], bt[8], kt[8];
            const float4 g0_ = *(const float4*)(G + s * 64 + cg * 8), g1_ = *(const float4*)(G + s * 64 + cg * 8 + 4);
            const int sm = (s > 0) ? s - 1 : 0; const float msk = (s > 0) ? 1.f : 0.f;
            const float4 m0_ = *(const float4*)(G + sm * 64 + cg * 8), m1_ = *(const float4*)(G + sm * 64 + cg * 8 + 4);
            const float4 l0_ = *(const float4*)(G + 63 * 64 + cg * 8), l1_ = *(const float4*)(G + 63 * 64 + cg * 8 + 4);
            const float gv_[8] = {g0_.x, g0_.y, g0_.z, g0_.w, g1_.x, g1_.y, g1_.z, g1_.w}, mv_[8] = {m0_.x, m0_.y, m0_.z, m0_.w, m1_.x, m1_.y, m1_.z, m1_.w}, lv_[8] = {l0_.x, l0_.y, l0_.z, l0_.w, l1_.x, l1_.y, l1_.z, l1_.w};
#pragma unroll
            for (int e = 0; e < 8; ++e) { const float g = gv_[e], gm1 = mv_[e] * msk, gL = lv_[e];
                glast[e] = gL;
                const float eg = __expf(g), eng = __expf(-g), egm = __expf(gm1), egl = __expf(gL - g);
                ab[e] = -kk_[e] * egm; rb[e] = r_[e] * eg; bb[e] = b_[e] * eng; kb[e] = kp_[e] * eng; bt[e] = b_[e] * egl; kt[e] = kp_[e] * egl; }
#pragma unroll
            for (int q = 0; q < 4; ++q) { pab[q] = pk2(ab[2 * q], ab[2 * q + 1]); prb[q] = pk2(rb[2 * q], rb[2 * q + 1]); pbb[q] = pk2(bb[2 * q], bb[2 * q + 1]); pkb[q] = pk2(kb[2 * q], kb[2 * q + 1]); }
            *(uint4*)(MAT(O_AB) + s * LD + cg * 8) = make_uint4(pab[0], pab[1], pab[2], pab[3]);
            *(uint4*)(MAT(O_RB) + s * LD + cg * 8) = make_uint4(prb[0], prb[1], prb[2], prb[3]);
            *(uint4*)(MAT(O_BB) + s * LD + cg * 8) = make_uint4(pbb[0], pbb[1], pbb[2], pbb[3]);
            *(uint4*)(MAT(O_KB) + s * LD + cg * 8) = make_uint4(pkb[0], pkb[1], pkb[2], pkb[3]);
#pragma unroll
            for (int e = 0; e < 8; ++e) { const int k = cg * 8 + e;
                MAT(O_AT)[k * LD + s] = f2bf(ab[e]); MAT(O_BT)[k * LD + s] = f2bf(bt[e]); MAT(O_KT)[k * LD + s] = f2bf(kt[e]); MAT(O_VT)[k * LD + s] = f2bf(v_[e]); }
        }
        CK_BAR();
        { const int itn = item + GN;
          if (itn < NB * 8 * (S / 64)) { const int c2 = itn & 127, h2 = (itn >> 7) & 7, b2 = itn >> 10, ch2 = h2 * 64 + cg * 8, t2 = c2 * 64 + s; const size_t m2 = (size_t)b2 * S + t2;
            const bf16* z = I.proj + m2 * DSHIFT + ch2;
            nx_r = *(const uint4*)(z); nx_k = *(const uint4*)(z + 512); nx_v = *(const uint4*)(z + 1024);
            nx_qr = make_uint4(0, 0, 0, 0); nx_qk = nx_qr; nx_qv = nx_qr;
            if (t2 > 0) { nx_qr = *(const uint4*)(z - DSHIFT); nx_qk = *(const uint4*)(z + 512 - DSHIFT); nx_qv = *(const uint4*)(z + 1024 - DSHIFT); }
            nx_a = *(const uint4*)(I.AA + m2 * 512 + ch2); nx_l = *(const uint4*)(I.LW + m2 * 512 + ch2); } }
        if (s == 63) {
#pragma unroll
            for (int e = 0; e < 8; ++e) TOT[cg * 8 + e] = __expf(glast[e]);
        }
        {
            const int mat = tid >> 7, row = (tid >> 2) & 31, chunk = tid & 3;
            *(uint4*)(MAT(O_NM + mat * MB) + row * LD + 32 + chunk * 8) = make_uint4(0, 0, 0, 0);
        }
        for (int task = wv; task < 12; task += 8) {
            const int mat = task / 3, tt = task % 3, st = (tt == 0) ? 0 : 1, jt = (tt == 2) ? 1 : 0;
            const bf16* Asrc = MAT((mat & 1) ? O_KB : O_BB) + 32 * jt * LD;
            const bf16* Bsrc = MAT((mat >> 1) ? O_RB : O_AB) + 32 * st * LD;
            f32x16 acc = mm_tile<64>(zero16(), Asrc, LD, Bsrc, LD, lane);
            const int cs = 32 * st + (lane & 31), hh = lane >> 5; const bool incl = (mat >> 1) != 0;
#pragma unroll
            for (int rg = 0; rg < 16; ++rg) { const int j = 32 * jt + crow(rg, hh); const bool keep = incl ? (j <= cs) : (j < cs); if (!keep) acc[rg] = 0.f; }
            store_tr(acc, MAT(O_NM + mat * MB) + 32 * st * LD + 32 * jt, LD, lane);
            if (mat == 0 && st == jt) {
                float* d = NMF + st * 1024 + (lane & 31) * 32;
#pragma unroll
                for (int g = 0; g < 4; ++g) *(float4*)(d + 8 * g + 4 * hh) = make_float4(acc[4 * g], acc[4 * g + 1], acc[4 * g + 2], acc[4 * g + 3]);
            }
        }
        CK_BAR();
        if (wv == 0) {
            const int d = lane >> 4, cc = lane & 15;
            const float* nb = NMF + (d >> 1) * 1024 + (16 * (d & 1)) * 32 + 16 * (d & 1);
            float T[16];
#pragma unroll
            for (int i = 0; i < 16; ++i) {
                float acc = (i == cc) ? 1.f : 0.f;
#pragma unroll
                for (int j4 = 0; j4 < i; j4 += 4) { const float4 n4 = *(const float4*)(nb + i * 32 + j4);
                    acc += n4.x * T[j4]; if (j4 + 1 < i) acc += n4.y * T[j4 + 1]; if (j4 + 2 < i) acc += n4.z * T[j4 + 2]; if (j4 + 3 < i) acc += n4.w * T[j4 + 3]; }
                T[i] = acc;
            }
            bf16* tm = MAT(O_TM) + (16 * d) * LD + 16 * d + cc;
#pragma unroll
            for (int i = 0; i < 16; ++i) tm[i * LD] = f2bf(T[i]);
            bf16* tt = MAT(O_TT) + (d >> 1) * 32 * 40 + (16 * (d & 1) + cc) * 40 + 16 * (d & 1);
            *(uint4*)(tt) = make_uint4(pk2(T[0], T[1]), pk2(T[2], T[3]), pk2(T[4], T[5]), pk2(T[6], T[7]));
            *(uint4*)(tt + 8) = make_uint4(pk2(T[8], T[9]), pk2(T[10], T[11]), pk2(T[12], T[13]), pk2(T[14], T[15]));
            { const int blk = lane >> 5, r16 = (lane >> 1) & 15, hf = lane & 1;
              *(uint4*)(MAT(O_TM) + (32 * blk + r16) * LD + 32 * blk + 16 + 8 * hf) = make_uint4(0, 0, 0, 0);
              *(uint4*)(MAT(O_TT) + blk * 32 * 40 + (16 + r16) * 40 + 8 * hf) = make_uint4(0, 0, 0, 0); }
        } else if (wv == 1) {
            const int row = lane >> 1, half = lane & 1;
            *(uint4*)(MAT(O_TM) + row * LD + 32 + half * 16) = make_uint4(0, 0, 0, 0); *(uint4*)(MAT(O_TM) + row * LD + 32 + half * 16 + 8) = make_uint4(0, 0, 0, 0);
        } else if (wv >= 4) {
            const int st = (wv - 4) >> 1, vt = (wv - 4) & 1;
            f32x16 acc = mm_tile<64>(zero16(), MAT(O_AAK) + 32 * st * LD, LD, MAT(O_VT) + 32 * vt * LD, LD, lane);
            store_tr(acc, MAT(O_W1T) + 32 * vt * LD + 32 * st, LD, lane);
        }
        CK_BAR();
        if (wv < 2) {
            typedef float f32x4v __attribute__((ext_vector_type(4)));
            const int blk = wv, fr = lane & 15, fq = lane >> 4;
            const bf16x8 zf = (bf16x8){0, 0, 0, 0, 0, 0, 0, 0};
            bf16x8 a = zf, bq = zf;
            if (fq < 2) { a = *(const bf16x8*)(MAT(O_NM) + (32 * blk + 16 + fr) * LD + 32 * blk + 8 * fq); bq = *(const bf16x8*)(MAT(O_TT) + blk * 32 * 40 + fr * 40 + 8 * fq); }
            f32x4v z = __builtin_amdgcn_mfma_f32_16x16x32_bf16(a, bq, (f32x4v){0.f, 0.f, 0.f, 0.f}, 0, 0, 0);
            bf16* zt = MAT(O_ZT) + blk * 16 * 24;
            { uint2 w; w.x = cvtpk(z[0], z[1]); w.y = cvtpk(z[2], z[3]); *(uint2*)(zt + fr * 24 + 4 * fq) = w; }
            asm volatile("s_waitcnt lgkmcnt(0)" ::: "memory");
            a = zf; bq = zf;
            if (fq < 2) { a = *(const bf16x8*)(MAT(O_TM) + (32 * blk + 16 + fr) * LD + 32 * blk + 16 + 8 * fq); bq = *(const bf16x8*)(zt + fr * 24 + 8 * fq); }
            const f32x4v t21 = __builtin_amdgcn_mfma_f32_16x16x32_bf16(a, bq, (f32x4v){0.f, 0.f, 0.f, 0.f}, 0, 0, 0);
#pragma unroll
            for (int rg = 0; rg < 4; ++rg) MAT(O_TM)[(32 * blk + 16 + 4 * fq + rg) * LD + 32 * blk + fr] = f2bf(t21[rg]);
            { uint2 w; w.x = cvtpk(t21[0], t21[1]); w.y = cvtpk(t21[2], t21[3]); *(uint2*)(MAT(O_TT) + blk * 32 * 40 + fr * 40 + 16 + 4 * fq) = w; }
        }
        CK_BAR();
        if (wv == 0) { f32x16 acc = mm_tile<32>(zero16(), MAT(O_NM) + 32 * LD, LD, MAT(O_TT), 40, lane); store_tr(acc, MAT(O_ZT), 40, lane); }
        CK_BAR();
        if (wv == 0) { f32x16 acc = mm_tile<32>(zero16(), MAT(O_TM) + 32 * LD + 32, LD, MAT(O_ZT), 40, lane); store_rm(acc, MAT(O_TM) + 32 * LD, LD, lane); }
        CK_BAR();
        { const int st = wv >> 2, ct = wv & 3;
          f32x16 acc = mm_tile<64>(zero16(), MAT(O_TM) + 32 * st * LD, LD, MAT(O_AT) + 32 * ct * LD, LD, lane);
          CK_BAR();
          store_tr(acc, MAT(O_X1T) + 32 * ct * LD + 32 * st, LD, lane); }
        CK_BAR();
        for (int u = wv; u < 16; u += 8) {
            const int kind = u >> 2, t0 = (u >> 1) & 1, t1 = u & 1, hh = lane >> 5, cc = lane & 31;
            if (kind == 0) {
                f32x16 acc = mm_tile<64>(zero16(), MAT(O_BT) + 32 * t0 * LD, LD, MAT(O_X1T) + (64 + 32 * t1) * LD, LD, lane);
                acc = mm_tile<64>(acc, MAT(O_KT) + 32 * t0 * LD, LD, MAT(O_VT) + 32 * t1 * LD, LD, lane);
                store_frag16(acc, (bf16*)(out + 16384), t0, t1, lane);
            } else if (kind == 1) {
                f32x16 acc = mm_tile<64>(zero16(), MAT(O_ARB) + 32 * t0 * LD, LD, MAT(O_X1T) + (64 + 32 * t1) * LD, LD, lane);
                acc = mm_tile<64>(acc, MAT(O_ARK) + 32 * t0 * LD, LD, MAT(O_VT) + 32 * t1 * LD, LD, lane);
                store_frag16(acc, (bf16*)(out + 24576), t0, t1, lane);
            } else if (kind == 2) {
                f32x16 acc = mm_tile<64>(zero16(), MAT(O_X1T) + 32 * t0 * LD, LD, MAT(O_BT) + 32 * t1 * LD, LD, lane);
                const int k = 32 * t1 + cc; const float gl = TOT[k];
                bf16* d = (bf16*)out + k * 64 + 32 * t0;
#pragma unroll
                for (int g = 0; g < 4; ++g) { float x[4];
#pragma unroll
                    for (int e = 0; e < 4; ++e) { const int kp = 32 * t0 + 8 * g + 4 * hh + e; x[e] = acc[4 * g + e] + ((kp == k) ? gl : 0.f); }
                    uint2 w; w.x = cvtpk(x[0], x[1]); w.y = cvtpk(x[2], x[3]); *(uint2*)(d + 8 * g + 4 * hh) = w; }
            } else {
                f32x16 acc = mm_tile<64>(zero16(), MAT(O_X1T) + 32 * t0 * LD, LD, MAT(O_ARB) + 32 * t1 * LD, LD, lane);
                const int sq = 32 * t1 + cc;
                bf16* d = (bf16*)(out + 8192) + sq * 64 + 32 * t0;
                const bf16* rb = MAT(O_RB) + sq * LD + 32 * t0;
#pragma unroll
                for (int g = 0; g < 4; ++g) { const uint2 rr = *(const uint2*)(rb + 8 * g + 4 * hh);
                    const float x0 = acc[4 * g] + __builtin_bit_cast(float, rr.x << 16), x1 = acc[4 * g + 1] + __builtin_bit_cast(float, rr.x & 0xffff0000u);
                    const float x2 = acc[4 * g + 2] + __builtin_bit_cast(float, rr.y << 16), x3 = acc[4 * g + 3] + __builtin_bit_cast(float, rr.y & 0xffff0000u);
                    uint2 w; w.x = cvtpk(x0, x1); w.y = cvtpk(x2, x3); *(uint2*)(d + 8 * g + 4 * hh) = w; }
            }
        }
        CK_BAR();
    }
#undef MAT
}
typedef float f32x4w __attribute__((ext_vector_type(4)));
constexpr int P2_SLOT = 2 * 64 * LD * 2 + 4096;
__device__ __forceinline__ void phase2(const int WID_, const char* items, float* Y, char* lds) {
    const int wv = WID_;
    bf16* HT0 = (bf16*)lds; bf16* HT1 = HT0 + 16 * LD;
    char* SL = lds + 8192;
    for (int item = GB; item < NB * 8 * 4; item += GN) {
        const int lane = lane_id(), tid = wv * 64 + lane, fr = lane & 15, fq = lane >> 4;
        const int vq = (item >> 3) & 3, head = (item & 7) + 8 * (item >> 5), b = head >> 3, h = head & 7;
        for (int i = tid; i < 2 * 16 * LD / 8; i += NT) ((uint4*)lds)[i] = make_uint4(0, 0, 0, 0);
        const bool upd = wv < 4; const int rb = wv & 3;
        const char* rec0 = items + (size_t)(head * 128) * ITEM_BYTES;
        const size_t g_pq = (size_t)tid * 16;
        const int l_pq = (tid >> 3) * (LD * 2) + (tid & 7) * 16;
        const int piece = (tid >> 5) & 7;
        const size_t g_f = 16384 + (size_t)(piece >> 2) * 8192 + (((piece & 3) * 4 + vq) * 64) * 8 + (tid & 31) * 16;
        const int l_f = 2 * 64 * LD * 2 + piece * 512 + (tid & 31) * 16;
        float* yo = Y + ((size_t)b * S + 16 * rb + 4 * fq) * 512 + h * 64 + 16 * vq + fr;
        const int a_lds = (upd ? 0 : 64 * LD * 2) + (16 * rb + fr) * (LD * 2) + 16 * fq;
        const int c_lds = 2 * 64 * LD * 2 + ((upd ? 0 : 4) + rb) * 512 + lane * 8;
        uint4 rp0, rp1, rp2, rp3, rp4, rp5, rp6, rp7, rq0, rq1, rq2, rq3, rq4, rq5, rq6, rq7, rf0, rf1, rf2, rf3, rf4, rf5, rf6, rf7;
#define P2_LD(n, i) do { const char* rc_ = rec0 + (size_t)(i) * ITEM_BYTES; rp##n = *(const uint4*)(rc_ + g_pq); rq##n = *(const uint4*)(rc_ + 8192 + g_pq); rf##n = *(const uint4*)(rc_ + g_f); } while (0)
#define P2_ST(n, slot) do { char* s_ = SL + (slot) * P2_SLOT; *(uint4*)(s_ + l_pq) = rp##n; *(uint4*)(s_ + 64 * LD * 2 + l_pq) = rq##n; *(uint4*)(s_ + l_f) = rf##n; } while (0)
        P2_LD(0, 0); P2_LD(1, 1); P2_LD(2, 2); P2_LD(3, 3); P2_LD(4, 4); P2_LD(5, 5); P2_LD(6, 6); P2_LD(7, 7);
        P2_ST(0, 0); P2_LD(0, 8);
        CK_BAR();
#define P2_STEP(RN, cstep) do { const int c_ = (cstep); \
            const bf16* Hc = (c_ & 1) ? HT1 : HT0; bf16* Hn = (c_ & 1) ? HT0 : HT1; const char* sl_ = SL + (c_ & 1) * P2_SLOT; \
            const uint2 cv = *(const uint2*)(sl_ + c_lds); \
            f32x4w acc = (f32x4w){__builtin_bit_cast(float, cv.x << 16), __builtin_bit_cast(float, cv.x & 0xffff0000u), __builtin_bit_cast(float, cv.y << 16), __builtin_bit_cast(float, cv.y & 0xffff0000u)}; \
            const bf16x8 a0 = *(const bf16x8*)(sl_ + a_lds), a1 = *(const bf16x8*)(sl_ + a_lds + 64); \
            const bf16x8 b0 = *(const bf16x8*)(Hc + fr * LD + 8 * fq), b1 = *(const bf16x8*)(Hc + fr * LD + 32 + 8 * fq); \
            if (c_ + 1 < S / 64) P2_ST(RN, (c_ + 1) & 1); \
            if (c_ + 9 < S / 64) P2_LD(RN, c_ + 9); \
            acc = __builtin_amdgcn_mfma_f32_16x16x32_bf16(a0, b0, acc, 0, 0, 0); acc = __builtin_amdgcn_mfma_f32_16x16x32_bf16(a1, b1, acc, 0, 0, 0); \
            if (upd) { uint2 w; w.x = cvtpk(acc[0], acc[1]); w.y = cvtpk(acc[2], acc[3]); *(uint2*)(Hn + fr * LD + 16 * rb + 4 * fq) = w; } \
            else { float* y_ = yo + (size_t)c_ * 64 * 512; y_[0] = acc[0]; y_[512] = acc[1]; y_[1024] = acc[2]; y_[1536] = acc[3]; } \
            CK_BAR(); } while (0)
        for (int c = 0; c < S / 64; c += 8) {
            P2_STEP(1, c); P2_STEP(2, c + 1); P2_STEP(3, c + 2); P2_STEP(4, c + 3); P2_STEP(5, c + 4); P2_STEP(6, c + 5); P2_STEP(7, c + 6); P2_STEP(0, c + 7);
        }
#undef P2_STEP
#undef P2_LD
#undef P2_ST
    }
}
}

__device__ __forceinline__ void rwkv_post_ph(const int WID_, const float* __restrict__ Y, const float* __restrict__ RK, const bf16* __restrict__ proj, const float* __restrict__ mu, const bf16* __restrict__ G,
                             const float* __restrict__ lnw, const float* __restrict__ lnb, bf16* __restrict__ ymix) {
    const int lane = lane_id(), tk = WID_, grp = lane, ch0 = grp * 8, head = grp >> 3;
    const float4 mv0 = *(const float4*)(mu + 1024 + ch0), mv1 = *(const float4*)(mu + 1024 + ch0 + 4), lw0 = *(const float4*)(lnw + ch0), lw1 = *(const float4*)(lnw + ch0 + 4), lb0 = *(const float4*)(lnb + ch0), lb1 = *(const float4*)(lnb + ch0 + 4);
    const float muv[8] = {mv0.x, mv0.y, mv0.z, mv0.w, mv1.x, mv1.y, mv1.z, mv1.w}, lw_[8] = {lw0.x, lw0.y, lw0.z, lw0.w, lw1.x, lw1.y, lw1.z, lw1.w}, lb_[8] = {lb0.x, lb0.y, lb0.z, lb0.w, lb1.x, lb1.y, lb1.z, lb1.w};
    const int g_lo = GN == 256 ? (GB < 64 ? GB * 9 : 576 + ((GB - 64) * 3520) / 192) : (GB * (M / 16)) / GN;
    const int g_hi = GN == 256 ? (GB < 64 ? GB * 9 + 9 : 576 + ((GB - 63) * 3520) / 192) : ((GB + 1) * (M / 16)) / GN;
    for (int g = g_lo; g < g_hi; ++g) { const int m0 = g * 16 + tk;
        float4 ya[2], yb[2]; uint4 vv[2], pv[2], gg[2]; float rk[2];
#pragma unroll
        for (int u = 0; u < 2; ++u) { const int m = m0 + 8 * u;
            ya[u] = *(const float4*)(Y + (size_t)m * 512 + ch0); yb[u] = *(const float4*)(Y + (size_t)m * 512 + ch0 + 4);
            vv[u] = *(const uint4*)(proj + (size_t)m * DSHIFT + 1024 + ch0);
            pv[u] = (m & (S - 1)) ? *(const uint4*)(proj + (size_t)(m - 1) * DSHIFT + 1024 + ch0) : make_uint4(0, 0, 0, 0);
            gg[u] = *(const uint4*)(G + (size_t)m * 512 + ch0); rk[u] = RK[(size_t)m * 8 + head]; }
#pragma unroll
        for (int u = 0; u < 2; ++u) {
            const float y[8] = {ya[u].x, ya[u].y, ya[u].z, ya[u].w, yb[u].x, yb[u].y, yb[u].z, yb[u].w};
            float s = 0.f;
#pragma unroll
            for (int e = 0; e < 8; ++e) s += y[e];
            s += dpp16<0xB1>(s); s += dpp16<0x4E>(s); s += dpp16<0x141>(s);
            const float mean = s * (1.f / 64.f); float q = 0.f;
#pragma unroll
            for (int e = 0; e < 8; ++e) { const float d = y[e] - mean; q += d * d; }
            q += dpp16<0xB1>(q); q += dpp16<0x4E>(q); q += dpp16<0x141>(q);
            const float rstd = rsqrtf(q * (1.f / 64.f) + 64e-5f);
            const unsigned wv_[4] = {vv[u].x, vv[u].y, vv[u].z, vv[u].w}, wp_[4] = {pv[u].x, pv[u].y, pv[u].z, pv[u].w}, wg_[4] = {gg[u].x, gg[u].y, gg[u].z, gg[u].w};
            float o[8];
#pragma unroll
            for (int e = 0; e < 8; ++e) { const int w_ = e >> 1; const bool hi = e & 1;
                auto ex = [&](unsigned x) { return hi ? __builtin_bit_cast(float, x & 0xffff0000u) : __builtin_bit_cast(float, x << 16); };
                float v = ex(wv_[w_]); v += (ex(wp_[w_]) - v) * muv[e];
                o[e] = ((y[e] - mean) * rstd * lw_[e] + lb_[e] + rk[u] * v) * ex(wg_[w_]); }
            *(uint4*)(ymix + (size_t)(m0 + 8 * u) * D + ch0) = make_uint4(pk2(o[0], o[1]), pk2(o[2], o[3]), pk2(o[4], o[5]), pk2(o[6], o[7]));
        }
    }
}

constexpr int PSLOTS = NASSIGN + NEXP * 256;
constexpr int MAXTILES = PSLOTS / 256;
struct MoeBufs { int* tok_e; float* tok_g; int* tok_slot; int* slot_tok; float* slot_gate; int* bcnt; int* bbase; int* offs; int* tiles; int* ntiles; };
__device__ __forceinline__ void moe_zero_ph(const int WID_, const MoeBufs& mb) {
    for (int i = GB * NT + (WID_ * 64 + lane_id()); i < PSLOTS; i += GN * NT) { mb.slot_tok[i] = 0; mb.slot_gate[i] = 0.f; }
}
__device__ __forceinline__ void router_ph(const int WID_, const float* __restrict__ x3, const float* __restrict__ nw, bf16* __restrict__ h3, const float* __restrict__ wrg, const float* __restrict__ brg,
                          const float* __restrict__ wre, const float* __restrict__ bre, const MoeBufs& mb, char* lds, int tile) {
    const int lane = lane_id(), wv = WID_;
    int* lcnt = (int*)lds;
    _Float16* wg16 = (_Float16*)(lds + 256);
    _Float16* we16 = (_Float16*)(lds + 256 + 8192);
    if (wv == 0 && lane < 32) lcnt[lane] = 0;
    for (int i = wv * 64 + lane; i < 1024; i += NT) { const float4 w = *(const float4*)(wrg + i * 4);
        typedef _Float16 h4 __attribute__((ext_vector_type(4))); *(h4*)(wg16 + i * 4) = (h4){(_Float16)w.x, (_Float16)w.y, (_Float16)w.z, (_Float16)w.w}; }
    for (int i = wv * 64 + lane; i < 4 * 1024 * 2; i += NT) { const float4 w = *(const float4*)(wre + i * 4);
        typedef _Float16 h4 __attribute__((ext_vector_type(4))); *(h4*)(we16 + i * 4) = (h4){(_Float16)w.x, (_Float16)w.y, (_Float16)w.z, (_Float16)w.w}; }
    __syncthreads();
    typedef _Float16 h4 __attribute__((ext_vector_type(4)));
    typedef _Float16 h8 __attribute__((ext_vector_type(8)));
    float4 nx[4];
#pragma unroll
    for (int j = 0; j < 4; ++j) nx[j] = ((const float4*)(x3 + (size_t)(tile * 256 + wv) * D))[lane + 64 * j];
    for (int m = tile * 256 + wv; m < tile * 256 + 256; m += 8) {
        float h[16]; float s = 0.f;
#pragma unroll
        for (int j = 0; j < 4; ++j) { const float4 v = nx[j]; h[4 * j] = v.x; h[4 * j + 1] = v.y; h[4 * j + 2] = v.z; h[4 * j + 3] = v.w; s += v.x * v.x + v.y * v.y + v.z * v.z + v.w * v.w; }
        { const int mn = min(m + 8, tile * 256 + 248 + wv); const float4* xr = (const float4*)(x3 + (size_t)mn * D);
#pragma unroll
          for (int j = 0; j < 4; ++j) nx[j] = xr[lane + 64 * j]; }
        s = wave_sum(s);
        const float rs = rsqrtf(s * (1.f / D) + 1e-6f);
        float l1[4] = {0.f, 0.f, 0.f, 0.f};
#pragma unroll
        for (int j = 0; j < 4; ++j) {
            const int k0 = (lane + 64 * j) * 4;
            const float4 g = *(const float4*)(nw + k0);
            h[4 * j] *= rs * g.x; h[4 * j + 1] *= rs * g.y; h[4 * j + 2] *= rs * g.z; h[4 * j + 3] *= rs * g.w;
            uint2 o; o.x = pk2(h[4 * j], h[4 * j + 1]); o.y = pk2(h[4 * j + 2], h[4 * j + 3]);
            *(uint2*)(h3 + (size_t)m * D + k0) = o;
#pragma unroll
            for (int e = 0; e < 4; ++e) { const h4 w = *(const h4*)(wg16 + (k0 + e) * 4); const float x = h[4 * j + e];
                l1[0] += x * (float)w[0]; l1[1] += x * (float)w[1]; l1[2] += x * (float)w[2]; l1[3] += x * (float)w[3]; }
        }
#pragma unroll
        for (int i = 0; i < 4; ++i) l1[i] = wave_sum(l1[i]) + brg[i];
        int grp = 0; float best = l1[0];
#pragma unroll
        for (int i = 1; i < 4; ++i) if (l1[i] > best) { best = l1[i]; grp = i; }
        float se = 0.f;
#pragma unroll
        for (int i = 0; i < 4; ++i) se += __expf(l1[i] - best);
        const float g1 = 1.f / se;
        float l2[8] = {};
        const _Float16* we = we16 + (size_t)grp * D * 8;
#pragma unroll
        for (int j = 0; j < 4; ++j) {
            const int k0 = (lane + 64 * j) * 4;
#pragma unroll
            for (int e = 0; e < 4; ++e) { const float x = h[4 * j + e]; const h8 w = *(const h8*)(we + (k0 + e) * 8);
#pragma unroll
                for (int q = 0; q < 8; ++q) l2[q] += x * (float)w[q]; }
        }
#pragma unroll
        for (int i = 0; i < 8; ++i) l2[i] = wave_sum(l2[i]) + bre[grp * 8 + i];
        int i0 = 0; float v0 = l2[0];
#pragma unroll
        for (int i = 1; i < 8; ++i) if (l2[i] > v0) { v0 = l2[i]; i0 = i; }
        int i1 = -1; float v1 = -3.0e38f;
#pragma unroll
        for (int i = 0; i < 8; ++i) if (i != i0 && l2[i] > v1) { v1 = l2[i]; i1 = i; }
        const float e1 = __expf(v1 - v0), inv = 1.f / (1.f + e1);
        if (lane == 0) {
            const int ea = grp * 8 + i0, eb = grp * 8 + i1;
            mb.tok_e[2 * m] = ea; mb.tok_e[2 * m + 1] = eb;
            mb.tok_g[2 * m] = g1 * inv; mb.tok_g[2 * m + 1] = g1 * e1 * inv;
            atomicAdd(&lcnt[ea], 1); atomicAdd(&lcnt[eb], 1);
        }
    }
    __syncthreads();
    if (wv == 0 && lane < 32) mb.bcnt[tile * 32 + lane] = lcnt[lane];
    __syncthreads();
}
__device__ __forceinline__ void moe_plan_ph(const int WID_, const MoeBufs& mb, char* lds) {
    if (GB != 0) return;
    int* tot = (int*)lds; int* off = tot + 32;
    const int t = WID_ * 64 + lane_id();
    if (t < 32) { int run = 0; for (int b = 0; b < M / 256; ++b) { const int c = __hip_atomic_load(mb.bcnt + b * 32 + t, __ATOMIC_RELAXED, __HIP_MEMORY_SCOPE_AGENT); mb.bbase[b * 32 + t] = run; run += c; } tot[t] = run; }
    __syncthreads();
    if (t == 0) { int o = 0, nt = 0;
        for (int e = 0; e < NEXP; ++e) { off[e] = o; mb.offs[e] = o; const int c = tot[e]; for (int r0 = 0; r0 < c; r0 += 256) { mb.tiles[nt] = e; ++nt; } o += ((c + 255) / 256) * 256; }
        *mb.ntiles = nt; }
    __syncthreads();
}
__device__ __forceinline__ void moe_scatter_ph(const int WID_, const MoeBufs& mb, char* lds) {
    const int lane = lane_id(), wv = WID_;
    int* cur = (int*)lds;
    for (int tile = GB; tile < M / 256; tile += GN) {
        __syncthreads();
        if (wv == 0 && lane < 32) cur[lane] = __hip_atomic_load(mb.offs + lane, __ATOMIC_RELAXED, __HIP_MEMORY_SCOPE_AGENT) + __hip_atomic_load(mb.bbase + tile * 32 + lane, __ATOMIC_RELAXED, __HIP_MEMORY_SCOPE_AGENT);
        __syncthreads();
        const int a = tile * 512 + wv * 64 + lane; const int e = mb.tok_e[a];
        const int pos = atomicAdd(&cur[e], 1);
        mb.slot_tok[pos] = a >> 1; mb.slot_gate[pos] = mb.tok_g[a]; mb.tok_slot[a] = pos;
    }
    __syncthreads();
}
__device__ __forceinline__ void moe_weights_ph(const int WID_, const float* __restrict__ wg, const float* __restrict__ wu, const float* __restrict__ wd, bf16* __restrict__ wgu_t, bf16* __restrict__ wd_t, char* lds, int vb, int nvb) {
    const int lane = (WID_ * 64 + lane_id()) & 63, wv = (WID_ * 64 + lane_id()) >> 6;
    float* scr = (float*)(lds + wv * 16384);
    constexpr int I_GU = 16 * 16;
    constexpr int I_D = 8 * 32;
    constexpr int NIT = NEXP * (2 * I_GU + I_D);
    for (int it = vb * 8 + wv; it < NIT; it += nvb * 8) {
        const int e = it / (2 * I_GU + I_D); int r = it % (2 * I_GU + I_D);
        if (r < 2 * I_GU) {
            const int up = r / I_GU; r %= I_GU;
            const int kb = r / 16, nb = r % 16;
            const int pn = nb / 4, nsub = nb % 4;
            const float* W = (up ? wu : wg) + (size_t)e * D * DEXP + nb * 32;
            transpose_item(W + (size_t)kb * 64 * DEXP, 64, 32, wgu_t, D, e * 1024 + pn * 256 + up * 128 + nsub * 32, kb * 64, scr, 0, lane, nullptr, DEXP);
        } else {
            r -= 2 * I_GU;
            const int kb = r / 32, nb = r % 32;
            const float* W = wd + (size_t)e * DEXP * D + nb * 32;
            transpose_item(W + (size_t)kb * 64 * D, 64, 32, wd_t, DEXP, e * 1024 + nb * 32, kb * 64, scr, 0, lane, nullptr, D);
        }
    }
}
__device__ __forceinline__ void final_ph(const int WID_, float* __restrict__ out, const bf16* __restrict__ yslot, const int* __restrict__ tok_slot, const float* __restrict__ w) {
    const int lane = lane_id(), wv = WID_;
    float4 g[4];
#pragma unroll
    for (int j = 0; j < 4; ++j) g[j] = *(const float4*)(w + (lane + 64 * j) * 4);
    for (int row0 = (GB * 8 + wv) * 2; row0 < M; row0 += GN * 16) {
        float4 v[2][4]; uint2 ya[2][4], yb[2][4];
#pragma unroll
        for (int r = 0; r < 2; ++r) { const int row = row0 + r;
            const float4* xr = (const float4*)(out + (size_t)row * D);
            const uint2* pa = (const uint2*)(yslot + (size_t)tok_slot[2 * row] * D);
            const uint2* pb = (const uint2*)(yslot + (size_t)tok_slot[2 * row + 1] * D);
#pragma unroll
            for (int j = 0; j < 4; ++j) { v[r][j] = xr[lane + 64 * j]; ya[r][j] = pa[lane + 64 * j]; yb[r][j] = pb[lane + 64 * j]; } }
#pragma unroll
        for (int r = 0; r < 2; ++r) { float s = 0.f;
#pragma unroll
            for (int j = 0; j < 4; ++j) { const uint2 a = ya[r][j], b = yb[r][j];
                v[r][j].x += __builtin_bit_cast(float, a.x << 16) + __builtin_bit_cast(float, b.x << 16);
                v[r][j].y += __builtin_bit_cast(float, a.x & 0xffff0000u) + __builtin_bit_cast(float, b.x & 0xffff0000u);
                v[r][j].z += __builtin_bit_cast(float, a.y << 16) + __builtin_bit_cast(float, b.y << 16);
                v[r][j].w += __builtin_bit_cast(float, a.y & 0xffff0000u) + __builtin_bit_cast(float, b.y & 0xffff0000u);
                s += v[r][j].x * v[r][j].x + v[r][j].y * v[r][j].y + v[r][j].z * v[r][j].z + v[r][j].w * v[r][j].w; }
            s = wave_sum(s);
            const float rs = rsqrtf(s * (1.f / D) + 1e-6f);
            float4* xo = (float4*)(out + (size_t)(row0 + r) * D);
#pragma unroll
            for (int j = 0; j < 4; ++j) xo[lane + 64 * j] = make_float4(v[r][j].x * rs * g[j].x, v[r][j].y * rs * g[j].y, v[r][j].z * rs * g[j].z, v[r][j].w * rs * g[j].w); }
    }
}

struct S5Tab { float* Kmat; bf16* BtA; bf16* BtB; };
__device__ __forceinline__ void s5_lam(const float* lam_re, const float* lam_im, const float* log_dt, int g, int n, float& a, float& w) {
    const float dt = __expf(log_dt[g]); a = lam_re[g * 64 + n] * dt; w = lam_im[g * 64 + n] * dt;
}
__device__ __forceinline__ void cexpj(float a, float w, float j, float& re, float& im) { const float e = __expf(a * j); float s, c; sincosf(w * j, &s, &c); re = e * c; im = e * s; }
__device__ __forceinline__ void s5_bbar(const float* lam_re, const float* lam_im, const float* log_dt, const float* b_re, const float* b_im, int g, int n, int h, float& br, float& bi) {
    float a, w; s5_lam(lam_re, lam_im, log_dt, g, n, a, w);
    float lbr, lbi; cexpj(a, w, 1.f, lbr, lbi);
    const float lr = lam_re[g * 64 + n], li = lam_im[g * 64 + n];
    const float nr = lbr - 1.f, ni = lbi, den = lr * lr + li * li;
    const float cr = (nr * lr + ni * li) / den, ci = (ni * lr - nr * li) / den;
    const float xr = b_re[(g * 64 + n) * 16 + h], xi = b_im[(g * 64 + n) * 16 + h];
    br = cr * xr - ci * xi; bi = cr * xi + ci * xr;
}
__device__ __forceinline__ void s5_tables0_ph(const int WID_, const float* lam_re, const float* lam_im, const float* log_dt, const float* b_re, const float* b_im, const float* c_re, const float* c_im, const S5Tab& T, char* lds) {
    float* PWR = (float*)lds; float* PWI = PWR + 64 * 34;
    float* BBR = PWI + 64 * 34; float* BBI = BBR + 64 * 16;
    float* CCR = BBI + 64 * 16; float* CCI = CCR + 16 * 64;
    const int tid = WID_ * 64 + lane_id();
    for (int item = GB; item < 32 * 8; item += GN) {
        const int g = item & 31, part = item >> 5;
        __syncthreads();
        for (int i = tid; i < 64 * 34; i += NT) { const int n = i / 34, j = i % 34; float a, w; s5_lam(lam_re, lam_im, log_dt, g, n, a, w); float pr, pi; cexpj(a, w, (float)j, pr, pi); PWR[i] = pr; PWI[i] = pi; }
        for (int i = tid; i < 64 * 16; i += NT) { const int n = i >> 4, h = i & 15; float br, bi; s5_bbar(lam_re, lam_im, log_dt, b_re, b_im, g, n, h, br, bi); BBR[i] = br; BBI[i] = bi;
            const int hp = i >> 6, n2 = i & 63; CCR[i] = c_re[(g * 16 + hp) * 64 + n2]; CCI[i] = c_im[(g * 16 + hp) * 64 + n2]; }
        __syncthreads();
        for (int i = tid; i < 4 * 256; i += NT) { const int h = i & 15, hp = (i >> 4) & 15, j = 4 * part + (i >> 8);
            float acc = 0.f;
            for (int n = 0; n < 64; ++n) { const float pr = PWR[n * 34 + j], pi = PWI[n * 34 + j], br = BBR[n * 16 + h], bi = BBI[n * 16 + h];
                const float tr = pr * br - pi * bi, ti = pr * bi + pi * br; acc += CCR[hp * 64 + n] * tr - CCI[hp * 64 + n] * ti; }
            T.Kmat[((g * 32 + j) * 16 + hp) * 16 + h] = acc; }
        for (int i = tid; i < 32 * 512; i += NT) { const int col = i & 511, r = 32 * part + (i >> 9); float v = 0.f;
            if (r < 128) { const int n = r & 63, s = col >> 4, h = col & 15; const float pr = PWR[n * 34 + (S5L - 1 - s)], pi = PWI[n * 34 + (S5L - 1 - s)], br = BBR[n * 16 + h], bi = BBI[n * 16 + h];
                v = (r < 64) ? (pr * br - pi * bi) : (pr * bi + pi * br); }
            T.BtA[((size_t)g * 768 + 512 + r) * 512 + col] = f2bf(v); }
        for (int i = tid; i < 64 * 256; i += NT) { const int k = i & 255, row = 64 * part + (i >> 8); float v = 0.f;
            if (k < 128) { const int n = k & 63, sp = row >> 4, hp = row & 15; const float pr = PWR[n * 34 + sp + 1], pi = PWI[n * 34 + sp + 1], cr = CCR[hp * 64 + n], ci = CCI[hp * 64 + n];
                v = (k < 64) ? (cr * pr - ci * pi) : -(cr * pi + ci * pr); }
            T.BtB[((size_t)g * 512 + row) * 256 + k] = f2bf(v); }
    }
    __syncthreads();
}
__device__ __forceinline__ void s5_tables1_ph(const int WID_, const float* dsk, const S5Tab& T) {
    const int gtid = GB * NT + (WID_ * 64 + lane_id()), gsz = GN * NT;
    for (int i = gtid; i < 32 * 512 * 512; i += gsz) {
        const int col = i & 511, row = (i >> 9) & 511, g = i >> 18;
        const int sp = row >> 4, hp = row & 15, s = col >> 4, h = col & 15;
        float v = 0.f;
        if (s <= sp) v = T.Kmat[((g * 32 + (sp - s)) * 16 + hp) * 16 + h];
        if (row == col) v += dsk[g * 16 + hp];
        T.BtA[((size_t)g * 768 + row) * 512 + col] = f2bf(v);
    }
}
__device__ __forceinline__ void s5_carry_ph(const int WID_, const float* lam_re, const float* lam_im, const float* log_dt, const float* __restrict__ F, bf16* __restrict__ XST, int vb, int nvb, char* lds) {
    float* TR = (float*)lds; float* TI = TR + 16 * 32;
    for (int item = vb; item < NB * 32 * 2; item += nvb) {
        const int lane = lane_id(), tid = WID_ * 64 + lane;
        const int nh = item & 1, g = (item >> 1) & 31, b = item >> 6, seg = tid >> 5, n = nh * 32 + (tid & 31);
        float a, w; s5_lam(lam_re, lam_im, log_dt, g, n, a, w);
        float pr, pi; cexpj(a, w, (float)S5L, pr, pi);
        const size_t row0 = (size_t)g * S5R + (size_t)b * (S / S5L) + seg * 16;
        const float* f = F + row0 * 128; bf16* xo = XST + row0 * 256;
        float fr[16], fi[16];
#pragma unroll
        for (int q = 0; q < 16; ++q) { fr[q] = f[(size_t)q * 128 + n]; fi[q] = f[(size_t)q * 128 + 64 + n]; }
#pragma unroll
        for (int q = 0; q < 16; ++q) if (nh == 0) *(uint2*)(xo + (size_t)q * 256 + 128 + (tid & 31) * 4) = make_uint2(0, 0);
        float xr = 0.f, xi = 0.f;
#pragma unroll
        for (int q = 0; q < 16; ++q) { const float nr = pr * xr - pi * xi + fr[q], ni = pr * xi + pi * xr + fi[q]; xr = nr; xi = ni; fr[q] = nr; fi[q] = ni; }
        TR[seg * 32 + (tid & 31)] = xr; TI[seg * 32 + (tid & 31)] = xi;
        __syncthreads();
        float p16r, p16i; cexpj(a, w, (float)(S5L * 16), p16r, p16i);
        float cr = 0.f, ci = 0.f;
        for (int s2 = 0; s2 < seg; ++s2) { const float tr = TR[s2 * 32 + (tid & 31)], ti = TI[s2 * 32 + (tid & 31)];
            const float nr = p16r * cr - p16i * ci + tr, ni = p16r * ci + p16i * cr + ti; cr = nr; ci = ni; }
        float er = cr, ei = ci;
#pragma unroll
        for (int q = 0; q < 16; ++q) {
            const float lr_ = (q > 0) ? fr[q - 1] : 0.f, li_ = (q > 0) ? fi[q - 1] : 0.f;
            xo[(size_t)q * 256 + n] = f2bf(er + lr_); xo[(size_t)q * 256 + 64 + n] = f2bf(ei + li_);
            const float nr = pr * er - pi * ei, ni = pr * ei + pi * er; er = nr; ei = ni;
        }
        __syncthreads();
    }
}
#define XB_TMO      128
#define XB_XCNT(j)  (256  + 64 * (j))
#define XB_XSUB(j)  (1280 + 64 * (j))
#define XB_XGEN(j)  (2304 + 64 * (j))
#define XB_TOP      3328
#define XB_TOPGEN   3392
#define XCD_BAR_WORDS 3456
#define XB_SPIN_CAP (1u << 20)
__device__ __forceinline__ unsigned xb_ld(unsigned* p)              { return __hip_atomic_load(p, __ATOMIC_RELAXED, __HIP_MEMORY_SCOPE_AGENT); }
__device__ __forceinline__ unsigned xb_add(unsigned* p, unsigned v) { return __hip_atomic_fetch_add(p, v, __ATOMIC_RELAXED, __HIP_MEMORY_SCOPE_AGENT); }
__device__ __forceinline__ unsigned xb_xcc_id() { return (unsigned)__builtin_amdgcn_s_getreg((3 << 11) | 20) & 0xFu; }
#define XB_SPIN(cond, bar) do { unsigned _sp = 0; while (cond) { __builtin_amdgcn_s_sleep(1); \
    if ((++_sp & 255u) == 0u) { if (xb_ld(&(bar)[XB_TMO])) break; if (_sp > XB_SPIN_CAP) { atomicAdd(&(bar)[XB_TMO], 1u); break; } } } } while (0)
struct XcdBarrier { unsigned* bar; unsigned x; volatile __attribute__((address_space(3))) unsigned* st; };
__device__ __forceinline__ XcdBarrier xcd_barrier_post(const int WID_, unsigned* bar, volatile __attribute__((address_space(3))) unsigned* st) {
    XcdBarrier b; b.bar = bar; b.x = xb_xcc_id(); b.st = st;
    if ((WID_ * 64 + lane_id()) == 0) (void)xb_add(&bar[XB_XCNT(b.x)], 1u);
    return b;
}
__device__ __forceinline__ void xcd_barrier_complete(unsigned* bar, unsigned x, unsigned& nloc, unsigned& nx) {
    const unsigned G = gridDim.x * gridDim.y * gridDim.z;
    unsigned sum, cnt, mine, sp = 0u;
    for (;;) {
        sum = 0u; cnt = 0u; mine = 0u;
#pragma unroll
        for (unsigned j = 0; j < 16; ++j) { const unsigned c = xb_ld(&bar[XB_XCNT(j)]); sum += c; cnt += (c > 0u) ? 1u : 0u; mine = (j == x) ? c : mine; }
        if (sum == G) break;
        __builtin_amdgcn_s_sleep(1);
        if ((++sp & 255u) == 0u) { if (xb_ld(&bar[XB_TMO])) break; if (sp > XB_SPIN_CAP) { atomicAdd(&bar[XB_TMO], 1u); break; } }
    }
    nloc = mine > 0u ? mine : 1u; nx = cnt > 0u ? cnt : 1u;
}
__device__ __forceinline__ void xcd_barrier(const int WID_, const XcdBarrier& b) {
    asm volatile("s_waitcnt vmcnt(0)" ::: "memory");
    __syncthreads();
    if ((WID_ * 64 + lane_id()) == 0) {
        unsigned* bar = b.bar;
        __builtin_amdgcn_s_waitcnt(0);
        unsigned nloc = b.st[0], nx = b.st[1];
        if (nloc == 0u) { xcd_barrier_complete(bar, b.x, nloc, nx); b.st[0] = nloc; b.st[1] = nx; }
        const unsigned old = xb_add(&bar[XB_XSUB(b.x)], 1u);
        const unsigned gen = old / nloc;
        if (old + 1u == (gen + 1u) * nloc) {
            __builtin_amdgcn_fence(__ATOMIC_RELEASE, "agent");
            asm volatile("s_waitcnt vmcnt(0)" ::: "memory");
            const unsigned og = xb_add(&bar[XB_TOP], 1u);
            const unsigned tg = og / nx;
            if (og + 1u == (tg + 1u) * nx) xb_add(&bar[XB_TOPGEN], 1u);
            else XB_SPIN(xb_ld(&bar[XB_TOPGEN]) == tg, bar);
            __builtin_amdgcn_fence(__ATOMIC_ACQUIRE, "agent");
            xb_add(&bar[XB_XGEN(b.x)], 1u);
            asm volatile("s_waitcnt vmcnt(0)" ::: "memory");
        } else {
            XB_SPIN(xb_ld(&bar[XB_XGEN(b.x)]) == gen, bar);
            __builtin_amdgcn_fence(__ATOMIC_ACQUIRE, "agent");
            asm volatile("s_waitcnt vmcnt(0)" ::: "memory");
        }
    }
    __syncthreads();
}

struct Params { const float* in[41]; float* out; char* ws; };

constexpr size_t W_PROJ = 0;
constexpr size_t W_US5 = 224;
constexpr size_t W_WTS = 288;
constexpr size_t W_YI = 352;
constexpr size_t W_F = 416;
constexpr size_t W_XST = 448;
constexpr size_t W_Z = 480;
constexpr size_t W_MISC = 544;
constexpr size_t W_XN = 576;
constexpr size_t W_CTL = 558;
constexpr size_t WO_IN = 0, WO_GLU = 5 * MiB, WO_MIX = 6 * MiB, WO_Q = 8 * MiB, WO_K = 10 * MiB, WO_V = 12 * MiB, WO_O = 14 * MiB, WO_KMAT = 16 * MiB, WO_BTA = 17 * MiB, WO_BTB = 41 * MiB;

__global__ void __launch_bounds__(NT, 2) fwd_kernel(Params p) {
    extern __shared__ __attribute__((aligned(16))) char lds[];
    const int WID_ = __builtin_amdgcn_readfirstlane((int)(threadIdx.x >> 6));
    cg::grid_group grid = cg::this_grid();
    PG8_LAS unsigned char* ldsl = (PG8_LAS unsigned char*)lds;
    char* ws = p.ws; char* dout = (char*)p.out; float* out = p.out;
#define IN(i) (p.in[i])
    volatile __attribute__((address_space(3))) unsigned* bst = (volatile __attribute__((address_space(3))) unsigned*)(ldsl + LDS_BYTES - 64);
    if (WID_ == 0 && lane_id() < 2) bst[lane_id()] = 0u;
    __syncthreads();
    const XcdBarrier xbar = xcd_barrier_post(WID_, (unsigned*)(ws + W_CTL * MiB), bst);
#ifndef PROBE_PHASE
#define PROBE_PHASE -1
#endif
    int sync_id = 0; unsigned long long pr_t0 = 0, pr_t1 = 0;
    if (PROBE_PHASE == 0) pr_t0 = __builtin_amdgcn_s_memrealtime();
#define SYNC() do { xcd_barrier(WID_, xbar); ++sync_id; if (sync_id == PROBE_PHASE) pr_t0 = __builtin_amdgcn_s_memrealtime(); if (sync_id == PROBE_PHASE + 1) pr_t1 = __builtin_amdgcn_s_memrealtime(); } while (0)
    char* WT = ws + W_WTS * MiB;
    bf16* w_in_t = (bf16*)(WT + WO_IN); bf16* w_glu_t = (bf16*)(WT + WO_GLU); bf16* w_mix_t = (bf16*)(WT + WO_MIX);
    bf16* w_q_t = (bf16*)(WT + WO_Q); bf16* w_k_t = (bf16*)(WT + WO_K); bf16* w_v_t = (bf16*)(WT + WO_V); bf16* w_o_t = (bf16*)(WT + WO_O);
    S5Tab stab; stab.Kmat = (float*)(WT + WO_KMAT); stab.BtA = (bf16*)(WT + WO_BTA); stab.BtB = (bf16*)(WT + WO_BTB);
    bf16* PROJ = (bf16*)(ws + W_PROJ * MiB); bf16* US5 = (bf16*)(ws + W_US5 * MiB);
    bf16* XN = (bf16*)(ws + W_XN * MiB);
    transpose_ph(WID_, IN(3), D, DIN, w_in_t, D, 0, 0, lds);
    transpose_ph(WID_, IN(23), 512, 512, w_glu_t, 512, 0, 0, lds);
    transpose_ph(WID_, IN(25), D, D, w_mix_t, D, 0, 0, lds);
    transpose_ph(WID_, IN(28), D, D, w_q_t, D, 0, 0, lds, IN(26));
    transpose_ph(WID_, IN(29), D, D, w_k_t, D, 0, 0, lds);
    transpose_ph(WID_, IN(30), D, D, w_v_t, D, 0, 0, lds);
    transpose_ph(WID_, IN(31), D, D, w_o_t, D, 0, 0, lds);
    s5_tables0_ph(WID_, IN(15), IN(16), IN(17), IN(18), IN(19), IN(20), IN(21), stab, lds);
    bf16* wl_t = (bf16*)(WT + 49 * MiB);
    rwkv_wl_ph(WID_, IN(6), IN(8), IN(9), wl_t);
    rmsnorm_ph<bf16>(WID_, IN(0), IN(2), XN, M);
    bf16* MEMN = (bf16*)(ws + (W_MISC + 10) * MiB);
    rmsnorm_ph<bf16>(WID_, IN(1), IN(27), MEMN, NB * NMEM);
    grid.sync(); ++sync_id; if (sync_id == PROBE_PHASE) pr_t0 = __builtin_amdgcn_s_memrealtime(); if (sync_id == PROBE_PHASE + 1) pr_t1 = __builtin_amdgcn_s_memrealtime();
    s5_tables1_ph(WID_, IN(22), stab);
    { pg8::PlainOrder S; S.init(XN, D, w_in_t, D, M, DIN, D); pg8::EpiProj E{PROJ, US5}; pg8::gemm_phase(WID_, ldsl, S, E); }
    SYNC();
    bf16* LIN = (bf16*)(ws + (W_MISC + 16) * MiB);
    rwkv_lin_ph(WID_, PROJ, IN(4), LIN);
    SYNC();
    bf16* YI = (bf16*)(ws + W_YI * MiB); float* F = (float*)(ws + W_F * MiB); bf16* XST = (bf16*)(ws + W_XST * MiB); bf16* Z = (bf16*)(ws + W_Z * MiB);
    bf16* LWb = (bf16*)(ws + 704 * MiB); bf16* AAb = (bf16*)(ws + 768 * MiB); bf16* Gb = (bf16*)(ws + 832 * MiB);
    float* Yr = (float*)(ws + 896 * MiB); float* RKb = (float*)(ws + W_MISC * MiB);
    { pg8::GroupOrder S; S.init(US5, 512, (size_t)S5R * 512, stab.BtA, 512, (size_t)768 * 512, 32, S5R, 768, 512); pg8::EpiS5a E{YI, F}; pg8::gemm_phase(WID_, ldsl, S, E); }
    { pg8::PlainOrder S; S.init(LIN, 256, wl_t, 256, M, 1536, 256); pg8::EpiLora E{LWb, (size_t)32 * MiB, IN(5), IN(7)}; pg8::gemm_phase(WID_, ldsl, S, E); }
    SYNC();
    { ck::In ci{PROJ, LWb, AAb, IN(4), IN(10), IN(11), IN(12), RKb, dout}; ck::phase1(WID_, ci, lds); }
    SYNC();
    bf16* WGU_t = (bf16*)(ws + 704 * MiB); bf16* WD_t = (bf16*)(ws + 768 * MiB);
    ck::phase2(WID_, dout, Yr, lds);
    __syncthreads();
    s5_carry_ph(WID_, IN(15), IN(16), IN(17), F, XST, GB, GN, lds);
    moe_weights_ph(WID_, IN(37), IN(38), IN(39), WGU_t, WD_t, lds, GB, GN);
    SYNC();
    bf16* YMIX = XN;
    bf16* KM = (bf16*)(ws + (W_MISC + 2) * MiB); bf16* VT = (bf16*)(ws + (W_MISC + 6) * MiB);
    { pg8::GroupOrder S; S.init(XST, 256, (size_t)S5R * 256, stab.BtB, 256, (size_t)512 * 256, 32, S5R, 512, 256); pg8::EpiS5b E{YI, Z}; pg8::gemm_phase(WID_, ldsl, S, E); }
    { pg8::PlainOrder S; S.init(MEMN, D, w_k_t, D, NB * NMEM, D, D); pg8::EpiBf16 E{KM, D}; pg8::gemm_phase(WID_, ldsl, S, E); }
    { pg8::PlainOrder S; S.init(w_v_t, D, MEMN, D, D, NB * NMEM, D, 32); pg8::EpiBf16 E{VT, NB * NMEM}; pg8::gemm_phase(WID_, ldsl, S, E); }
    rwkv_post_ph(WID_, Yr, RKb, PROJ, IN(4), Gb, IN(13), IN(14), YMIX);
    SYNC();
    bf16* X2b = (bf16*)(ws + 0);
    PG8_LAS float* ssq = (PG8_LAS float*)(ldsl + 131072 + 8192);
    bf16* Q = (bf16*)(ws + 128 * MiB);
    bf16* P = (bf16*)(ws + W_YI * MiB);
    bf16* O = (bf16*)(ws + 800 * MiB);
    bf16* H3 = XN;
    bf16* HID = (bf16*)(ws + 368 * MiB);
    bf16* YSLOT = (bf16*)(ws + 0);
#define MKMB(mb) MoeBufs mb; { char* mbase = p.ws + 976 * MiB; \
    mb.tok_e = (int*)(mbase); mb.tok_g = (float*)(mbase + 1 * MiB); mb.tok_slot = (int*)(mbase + 2 * MiB); mb.slot_tok = (int*)(mbase + 3 * MiB); \
    mb.slot_gate = (float*)(mbase + 4 * MiB); mb.bcnt = (int*)(mbase + 5 * MiB); mb.bbase = mb.bcnt + 16384; mb.offs = mb.bcnt + 32768; mb.ntiles = mb.offs + 64; \
    mb.tiles = (int*)(mbase + 6 * MiB); }
    { MKMB(mb); moe_zero_ph(WID_, mb); }
#define BLK_SYNC() do { asm volatile("s_waitcnt vmcnt(0)" ::: "memory"); __syncthreads(); \
        if (WID_ == 0 && lane_id() == 0) { __builtin_amdgcn_fence(__ATOMIC_ACQUIRE, "agent"); asm volatile("s_waitcnt vmcnt(0)" ::: "memory"); } __syncthreads(); } while (0)
    for (int tl = GB; tl < M / 256; tl += GN) {
        for (int i = WID_ * 64 + lane_id(); i < 1024; i += NT) ssq[i] = 0.f;
        { pg8::TileOrder S; S.init(Z, 512, w_glu_t, 512, 512, 2, tl); pg8::EpiGlu E{Z, IN(24), YMIX}; pg8::gemm_phase(WID_, ldsl, S, E); }
        BLK_SYNC();
        { pg8::TileOrder S; S.init(YMIX, D, w_mix_t, D, D, 4, tl); pg8::EpiMixRes E{X2b, IN(0), ssq}; pg8::gemm_phase(WID_, ldsl, S, E); }
        BLK_SYNC();
        { pg8::TileOrder S; S.init(X2b, D, w_q_t, D, D, 4, tl); pg8::EpiRowScale E{Q, ssq}; pg8::gemm_phase(WID_, ldsl, S, E); }
        BLK_SYNC();
        { pg8::AttnTileOrder S; S.init(Q, KM, D, 0, tl); pg8::EpiSoftmax E{P, (PG8_LAS float*)(ldsl + 131072)}; pg8::gemm_phase(WID_, ldsl, S, E); }
        BLK_SYNC();
        { pg8::AttnTileOrder S; S.init(P, VT, NB * NMEM, 1, tl); pg8::EpiAttnO E{O}; pg8::gemm_phase(WID_, ldsl, S, E); }
        BLK_SYNC();
        { pg8::TileOrder S; S.init(O, D, w_o_t, D, D, 4, tl); pg8::EpiResBf16 E{out, X2b}; pg8::gemm_phase(WID_, ldsl, S, E); }
        BLK_SYNC();
        { MKMB(mb); router_ph(WID_, p.out, IN(32), (bf16*)(p.ws + W_XN * MiB), IN(33), IN(34), IN(35), IN(36), mb, lds, tl); }
    }
    SYNC();
    { MKMB(mb); moe_plan_ph(WID_, mb, lds); }
    SYNC();
    { MKMB(mb); moe_scatter_ph(WID_, mb, lds); }
    MKMB(mb);
    SYNC();
    const int ntiles = __hip_atomic_load(mb.ntiles, __ATOMIC_RELAXED, __HIP_MEMORY_SCOPE_AGENT);
    { pg8::MoeOrderT<true> S; S.init(H3, D, WGU_t, D, D, mb.tiles, ntiles, 1024, mb.slot_tok); pg8::EpiSilu E{HID}; pg8::gemm_phase(WID_, ldsl, S, E); }
    SYNC();
    { pg8::MoeOrderT<false> S; S.init(HID, DEXP, WD_t, DEXP, DEXP, mb.tiles, ntiles, 1024, nullptr); pg8::EpiGate E{YSLOT, mb.slot_gate}; pg8::gemm_phase(WID_, ldsl, S, E); }
    SYNC();
    final_ph(WID_, out, YSLOT, mb.tok_slot, IN(40));
    if (PROBE_PHASE >= 0) {
        if (pr_t1 == 0) pr_t1 = __builtin_amdgcn_s_memrealtime();
        if (GB == 0) { const unsigned long long t_end = __builtin_amdgcn_s_memrealtime(), wait = 8ull * (pr_t1 - pr_t0);
            while (__builtin_amdgcn_s_memrealtime() - t_end < wait) __builtin_amdgcn_s_sleep(8); }
    }
}
}

extern "C" void kernel_launch(void* const* d_in, const int* in_sizes, int n_in, void* d_out, int out_size, void* d_ws, size_t ws_size, hipStream_t stream) {
    (void)in_sizes; (void)out_size; (void)ws_size;
    static int grid = 0;
    if (grid == 0) {
        int dev = 0, cus = 0, per_cu = 0;
        hipGetDevice(&dev);
        hipDeviceGetAttribute(&cus, hipDeviceAttributeMultiprocessorCount, dev);
        hipFuncSetAttribute((const void*)fwd_kernel, hipFuncAttributeMaxDynamicSharedMemorySize, LDS_BYTES);
        hipOccupancyMaxActiveBlocksPerMultiprocessor(&per_cu, (const void*)fwd_kernel, NT, LDS_BYTES);
        if (per_cu < 1) { fprintf(stderr, "occupancy query says %d blocks/CU\n", per_cu); per_cu = 1; }
        grid = cus * 1;
    }
    (void)hipMemsetAsync((char*)d_ws + W_CTL * MiB, 0, 16384, stream);
    Params p{};
    for (int i = 0; i < 41 && i < n_in; ++i) p.in[i] = (const float*)d_in[i];
    p.out = (float*)d_out; p.ws = (char*)d_ws;
    void* args[] = {&p};
    hipError_t e = hipLaunchCooperativeKernel((const void*)fwd_kernel, dim3(grid), dim3(NT), args, LDS_BYTES, stream);
    if (e != hipSuccess) fprintf(stderr, "cooperative launch failed: %s (grid %d)\n", hipGetErrorString(e), grid);
}
```

```cpp
#include <hip/hip_runtime.h>
#include <hip/hip_cooperative_groups.h>
#include <stdint.h>
#include <cstdio>
namespace cg = cooperative_groups;

namespace {
constexpr int NB = 8, S = 8192, D = 1024, M = NB * S;
constexpr int DR = 512, DSHIFT = 1792, DIN = 2304, NMEM = 256;
constexpr int NEXP = 32, DEXP = 512, NASSIGN = 2 * M;
constexpr size_t MiB = 1u << 20;
constexpr int NT = 512;
constexpr int S5L = 32, S5R = M / S5L;
constexpr int LDS_BYTES = 147456;
#define GB ((int)blockIdx.x)
#define GN ((int)gridDim.x)

typedef unsigned short bf16;
typedef float f32x2h __attribute__((ext_vector_type(2)));
typedef __bf16 bf16x2h __attribute__((ext_vector_type(2)));
__device__ __forceinline__ unsigned pk2(float lo, float hi) { const f32x2h v = {lo, hi}; const bf16x2h b = __builtin_convertvector(v, bf16x2h); return __builtin_bit_cast(unsigned, b); }
__device__ __forceinline__ bf16 f2bf(float f) { return (bf16)(pk2(f, f) & 0xffffu); }
__device__ __forceinline__ int lane_id() { int l; asm volatile("v_mbcnt_lo_u32_b32 %0, -1, 0\n\tv_mbcnt_hi_u32_b32 %0, -1, %0" : "=v"(l)); return l; }
__device__ __forceinline__ float bf2f(bf16 h) { return __builtin_bit_cast(float, (unsigned)h << 16); }

template <typename T> __device__ __forceinline__ float ldf(const T* p);
template <> __device__ __forceinline__ float ldf<float>(const float* p) { return *p; }
template <> __device__ __forceinline__ float ldf<bf16>(const bf16* p) { return bf2f(*p); }
template <typename T> __device__ __forceinline__ void stf(T* p, float v);
template <> __device__ __forceinline__ void stf<float>(float* p, float v) { *p = v; }
template <> __device__ __forceinline__ void stf<bf16>(bf16* p, float v) { *p = f2bf(v); }

template <int CTRL, int ROWMASK> __device__ __forceinline__ float dppf_(float x) { return __builtin_bit_cast(float, __builtin_amdgcn_update_dpp(0, __builtin_bit_cast(int, x), CTRL, ROWMASK, 0xf, false)); }
__device__ __forceinline__ float wave_sum(float v) {
    v += dppf_<0xB1, 0xf>(v); v += dppf_<0x4E, 0xf>(v); v += dppf_<0x141, 0xf>(v); v += dppf_<0x140, 0xf>(v);
    v += dppf_<0x142, 0xa>(v);
    v += dppf_<0x143, 0xc>(v);
    return __builtin_bit_cast(float, __builtin_amdgcn_readlane(__builtin_bit_cast(int, v), 63));
}
__device__ __forceinline__ float sigmoidf_(float x) { return 1.f / (1.f + __expf(-x)); }


__device__ __forceinline__ float gelu_tanh(float x) { return x * sigmoidf_(1.5957691216057308f * (x + 0.044715f * x * x * x)); }

namespace pg8 {
#define PG8_LAS __attribute__((address_space(3)))
typedef short bf16x8 __attribute__((ext_vector_type(8)));
typedef float f32x4 __attribute__((ext_vector_type(4)));
typedef unsigned u32x4 __attribute__((ext_vector_type(4)));
constexpr int BM = 256, BK = 64, HALF = 128, HTB = HALF * BK * 2, STAGE_BYTES = 8 * HTB, NXCD = 8, WGM = 8;
__device__ __forceinline__ int lds_byte(int r, int c) { const int st = (r >> 4) * 2 + (c >> 5), rr = r & 15, cc = c & 31, ob = rr * 64 + cc * 2; return st * 1024 + (ob ^ (((ob >> 9) & 1) << 5)); }
__device__ __forceinline__ void stage_rc(int b, int& R, int& C) { const int st = b / 1024, sb = b % 1024, swz = sb ^ (((sb >> 9) & 1) << 5); R = (st >> 1) * 16 + swz / 64; C = (st & 1) * 32 + (swz % 64) / 2; }
__device__ __forceinline__ int perm32(int rho) { const int n = rho >> 4, i = rho & 15; return 8 * (i >> 2) + 4 * n + (i & 3); }
struct Unit { int pm, pn; };
struct PlainOrder {
    static constexpr bool GATHER = false; __device__ __forceinline__ int grow(const Unit&, int) const { return 0; }
    const bf16* A; const bf16* Bt; int lda, ldb, K; int nM, nN, nwg, G, c;
    __device__ void init(const bf16* A_, int lda_, const bf16* Bt_, int ldb_, int M, int N, int K_, int coff = 0) { A = A_; Bt = Bt_; lda = lda_; ldb = ldb_; K = K_; nM = M / BM; nN = N / BM; nwg = nM * nN; G = GN; c = (GB + GN - coff % GN) % GN; }
    __device__ bool next(int i, Unit& u) const {
        const long L = (long)i * G + c; if (L >= nwg) return false;
        int wgid = (int)L; { const int q = nwg / NXCD, r = nwg % NXCD, xcd = wgid % NXCD, off = wgid / NXCD; wgid = (xcd < r ? xcd * (q + 1) : r * (q + 1) + (xcd - r) * q) + off; }
        const int nig = WGM * nN, gid = wgid / nig, fm = gid * WGM, gsz = (nM - fm) < WGM ? (nM - fm) : WGM;
        u.pm = fm + ((wgid % nig) % gsz); u.pn = (wgid % nig) / gsz; return true;
    }
    __device__ __forceinline__ const char* aptr(const Unit& u) const { return (const char*)(A + (size_t)u.pm * BM * lda); }
    __device__ __forceinline__ const char* bptr(const Unit& u) const { return (const char*)(Bt + (size_t)u.pn * BM * ldb); }
};
typedef float f32x2c __attribute__((ext_vector_type(2)));
typedef __bf16 bf16x2c __attribute__((ext_vector_type(2)));
__device__ __forceinline__ void pin4(float4& v) { asm volatile("" : "+v"(v.x), "+v"(v.y), "+v"(v.z), "+v"(v.w)); }
__device__ __forceinline__ unsigned cvt_pk_bf16(float lo, float hi) { const f32x2c v = {lo, hi}; const bf16x2c b = __builtin_convertvector(v, bf16x2c); return __builtin_bit_cast(unsigned, b); }

template <class Epi, class Sched>
__device__ __forceinline__ void gemm_phase(const int WID_, PG8_LAS unsigned char* lds, const Sched& S, const Epi& E) {
    const int tid = (WID_ * 64 + lane_id()), wid = __builtin_amdgcn_readfirstlane(tid >> 6), lane = tid & 63, wr = wid >> 2, wc = wid & 3, fr = lane & 15, fq = lane >> 4;
    const int K = S.K, nt = K / BK;
    unsigned voffA[2], voffB[2];
#pragma unroll
    for (int i = 0; i < 2; ++i) { int R, C; stage_rc(tid * 16 + i * 8192, R, C); const int Rb = Epi::PERM ? ((R & ~31) + perm32(R & 31)) : R;
        voffA[i] = (unsigned)(R * S.lda + C) * 2u; voffB[i] = (unsigned)(Rb * S.ldb + C) * 2u; }
    constexpr bool GA = Sched::GATHER;
    int gR[2], gC[2];
#pragma unroll
    for (int i = 0; i < 2; ++i) stage_rc(tid * 16 + i * 8192, gR[i], gC[i]);
    unsigned vgc[2][2] = {{0u, 0u}, {0u, 0u}}, vgn[2][2] = {{0u, 0u}, {0u, 0u}};
#define PG8_GOFF(dst, u) do { if constexpr (GA) { _Pragma("unroll") for (int h_ = 0; h_ < 2; ++h_) _Pragma("unroll") for (int i_ = 0; i_ < 2; ++i_) \
        dst[h_][i_] = (unsigned)(S.grow(u, h_ * HALF + gR[i_]) * S.lda + gC[i_]) * 2u; } } while (0)
    const size_t kstep = (size_t)(BK * 2);
    const size_t hstepA = GA ? 0 : (size_t)HALF * S.lda * 2, hstepB = (size_t)HALF * S.ldb * 2;
    const unsigned ldsw = (unsigned)wid * 1024u;
    const int aoff = lds_byte(wr * 64 + fr, fq * 8), boff = lds_byte(wc * 32 + fr, fq * 8);
#define PG8_SA(b, h) (((b) * 2 + (h)) * HTB)
#define PG8_SB(b, h) ((4 + (b) * 2 + (h)) * HTB)
#define PG8_STAGE(bufoff, gbase, voff) do { _Pragma("unroll") for (int _i = 0; _i < 2; ++_i) \
        __builtin_amdgcn_global_load_lds((const unsigned*)((const char*)(gbase) + (voff)[_i]), (PG8_LAS unsigned*)(lds + (bufoff) + ldsw + _i * 8192), 16, 0, 0); } while (0)
#define PG8_STAGE_A(bufoff, gbase, h, nx) do { _Pragma("unroll") for (int _i = 0; _i < 2; ++_i) { \
        const unsigned vo_ = GA ? ((nx) ? vgn[h][_i] : vgc[h][_i]) : voffA[_i]; \
        __builtin_amdgcn_global_load_lds((const unsigned*)((const char*)(gbase) + vo_), (PG8_LAS unsigned*)(lds + (bufoff) + ldsw + _i * 8192), 16, 0, 0); } } while (0)
#define PG8_LDA(dst, b, h) do { _Pragma("unroll") for (int m = 0; m < 4; ++m) _Pragma("unroll") for (int k = 0; k < 2; ++k) dst[m][k] = *(const PG8_LAS bf16x8*)(lds + PG8_SA(b, h) + aoff + m * 2048 + k * 1024); } while (0)
#define PG8_LDB(dst, b, h) do { _Pragma("unroll") for (int n = 0; n < 2; ++n) _Pragma("unroll") for (int k = 0; k < 2; ++k) dst[n][k] = *(const PG8_LAS bf16x8*)(lds + PG8_SB(b, h) + boff + n * 2048 + k * 1024); } while (0)
#define PG8_MMA(ai, bj, At, Bt) do { __builtin_amdgcn_s_setprio(1); _Pragma("unroll") for (int m = 0; m < 4; ++m) _Pragma("unroll") for (int n = 0; n < 2; ++n) _Pragma("unroll") for (int k = 0; k < 2; ++k) \
        acc[ai][bj][m][n] = __builtin_amdgcn_mfma_f32_16x16x32_bf16(Bt[n][k], At[m][k], acc[ai][bj][m][n], 0, 0, 0); __builtin_amdgcn_s_setprio(0); } while (0)
#define PG8_WAIT_V(n) asm volatile("s_waitcnt vmcnt(" #n ")" ::: "memory")
#define PG8_WAIT_L(n) asm volatile("s_waitcnt lgkmcnt(" #n ")" ::: "memory")
#define PG8_BAR __builtin_amdgcn_s_barrier()
#define PG8_SCHED __builtin_amdgcn_sched_barrier(0)
    Unit cur, nxt; int ui = 0;
    if (!S.next(0, cur)) return;
    f32x4 acc[2][2][4][2];
#pragma unroll
    for (int a = 0; a < 2; ++a)
#pragma unroll
        for (int b = 0; b < 2; ++b)
#pragma unroll
            for (int m = 0; m < 4; ++m)
#pragma unroll
                for (int n = 0; n < 2; ++n) acc[a][b][m][n] = (f32x4){0.f, 0.f, 0.f, 0.f};
    bf16x8 At[4][2], B0[2][2], B1[2][2];
    const char* cA = S.aptr(cur); const char* cB = S.bptr(cur);
    PG8_STAGE(PG8_SB(0, 0), cB, voffB); PG8_STAGE(PG8_SB(0, 1), cB + hstepB, voffB); PG8_GOFF(vgc, cur); PG8_STAGE_A(PG8_SA(0, 0), cA, 0, false); PG8_STAGE_A(PG8_SA(0, 1), cA + hstepA, 1, false);
    if (wr == 1) PG8_BAR;
    PG8_WAIT_V(2); PG8_BAR;
    PG8_STAGE(PG8_SB(1, 0), cB + kstep, voffB); PG8_STAGE_A(PG8_SA(1, 0), cA + kstep, 0, false); PG8_STAGE(PG8_SB(1, 1), cB + hstepB + kstep, voffB);
    PG8_WAIT_V(6); PG8_BAR;
    for (;;) {
        const bool has_next = S.next(ui + 1, nxt);
        const char* nA = has_next ? S.aptr(nxt) : cA; const char* nB = has_next ? S.bptr(nxt) : cB;
        if (has_next) PG8_GOFF(vgn, nxt); else { if constexpr (GA) { _Pragma("unroll") for (int h_ = 0; h_ < 2; ++h_) _Pragma("unroll") for (int i_ = 0; i_ < 2; ++i_) vgn[h_][i_] = vgc[h_][i_]; } }
        for (int t = 0; t < nt; t += 2) {
            const bool last = (t == nt - 2);
            const char* a1 = cA + (size_t)(t + 1) * kstep;
            const char* a2 = last ? nA : cA + (size_t)(t + 2) * kstep; const char* b2 = last ? nB : cB + (size_t)(t + 2) * kstep;
            const char* a3 = a2 + kstep; const char* b3 = b2 + kstep;
            PG8_LDB(B0, 0, 0); PG8_LDB(B1, 0, 1); PG8_SCHED; PG8_LDA(At, 0, 0); PG8_STAGE_A(PG8_SA(1, 1), a1 + hstepA, 1, false);
            PG8_WAIT_V(8); PG8_WAIT_L(0); PG8_BAR; PG8_MMA(0, 0, At, B0); PG8_MMA(0, 1, At, B1); PG8_BAR; PG8_SCHED;
            PG8_LDA(At, 0, 1); PG8_STAGE(PG8_SB(0, 0), b2, voffB); PG8_STAGE(PG8_SB(0, 1), b2 + hstepB, voffB); PG8_STAGE_A(PG8_SA(0, 0), a2, 0, last);
            PG8_WAIT_V(8); PG8_WAIT_L(0); PG8_BAR; PG8_MMA(1, 0, At, B0); PG8_MMA(1, 1, At, B1); PG8_BAR; PG8_SCHED;
            PG8_LDB(B0, 1, 0); PG8_LDB(B1, 1, 1); PG8_SCHED; PG8_LDA(At, 1, 0); PG8_STAGE_A(PG8_SA(0, 1), a2 + hstepA, 1, last);
            PG8_WAIT_V(8); PG8_WAIT_L(0); PG8_BAR; PG8_MMA(0, 0, At, B0); PG8_MMA(0, 1, At, B1); PG8_BAR; PG8_SCHED;
            PG8_LDA(At, 1, 1); PG8_STAGE(PG8_SB(1, 0), b3, voffB); PG8_STAGE(PG8_SB(1, 1), b3 + hstepB, voffB); PG8_STAGE_A(PG8_SA(1, 0), a3, 0, last);
            PG8_WAIT_V(8); PG8_WAIT_L(0); PG8_BAR; PG8_MMA(1, 0, At, B0); PG8_MMA(1, 1, At, B1); PG8_BAR; PG8_SCHED;
        }
        if (wr == 0) PG8_BAR;
        E(acc, cur, wr, wc, fr, fq);
        if (!has_next) break;
#pragma unroll
        for (int a = 0; a < 2; ++a)
#pragma unroll
            for (int b = 0; b < 2; ++b)
#pragma unroll
                for (int m = 0; m < 4; ++m)
#pragma unroll
                    for (int n = 0; n < 2; ++n) acc[a][b][m][n] = (f32x4){0.f, 0.f, 0.f, 0.f};
        cur = nxt; cA = nA; cB = nB; ++ui;
        if constexpr (GA) { _Pragma("unroll") for (int h_ = 0; h_ < 2; ++h_) _Pragma("unroll") for (int i_ = 0; i_ < 2; ++i_) vgc[h_][i_] = vgn[h_][i_]; }
        if (wr == 1) PG8_BAR;
    }
    PG8_WAIT_V(0);
    PG8_BAR;
#undef PG8_SA
#undef PG8_SB
#undef PG8_STAGE
#undef PG8_STAGE_A
#undef PG8_GOFF
#undef PG8_LDA
#undef PG8_LDB
#undef PG8_MMA
#undef PG8_WAIT_V
#undef PG8_WAIT_L
#undef PG8_BAR
#undef PG8_SCHED
}

struct EpiMixRes {
    static constexpr bool PERM = true;
    bf16* O; const float* R; PG8_LAS float* ss;
    __device__ __forceinline__ void operator()(const f32x4 (&acc)[2][2][4][2], const Unit& u, int wr, int wc, int fr, int fq) const {
        const int row0 = u.pm * BM + wr * 64 + fr, col0 = u.pn * BM + wc * 32 + 8 * fq;
#pragma unroll
        for (int ai = 0; ai < 2; ++ai)
#pragma unroll
            for (int m = 0; m < 4; ++m) { const size_t ro = (size_t)(row0 + ai * HALF + m * 16) * D + col0; float q = 0.f;
#pragma unroll
                for (int bj = 0; bj < 2; ++bj) { const f32x4 v0 = acc[ai][bj][m][0] + *(const f32x4*)(R + ro + bj * HALF), v1 = acc[ai][bj][m][1] + *(const f32x4*)(R + ro + bj * HALF + 4);
                    q += (v0[0] * v0[0] + v0[1] * v0[1]) + (v0[2] * v0[2] + v0[3] * v0[3]) + (v1[0] * v1[0] + v1[1] * v1[1]) + (v1[2] * v1[2] + v1[3] * v1[3]);
                    u32x4 w; w.x = cvt_pk_bf16(v0[0], v0[1]); w.y = cvt_pk_bf16(v0[2], v0[3]); w.z = cvt_pk_bf16(v1[0], v1[1]); w.w = cvt_pk_bf16(v1[2], v1[3]);
                    *(u32x4*)(O + ro + bj * HALF) = w; }
                q += __shfl_xor(q, 16); q += __shfl_xor(q, 32);
                if (fq == 0) { PG8_LAS float* sp = ss + (ai * HALF + wr * 64 + m * 16 + fr) * 4 + wc; *sp += q; } }
    }
};
struct EpiRowScale {
    static constexpr bool PERM = true;
    bf16* O; PG8_LAS const float* ss;
    __device__ __forceinline__ void operator()(const f32x4 (&acc)[2][2][4][2], const Unit& u, int wr, int wc, int fr, int fq) const {
        const int row0 = u.pm * BM + wr * 64 + fr, col0 = u.pn * BM + wc * 32 + 8 * fq;
#pragma unroll
        for (int ai = 0; ai < 2; ++ai)
#pragma unroll
            for (int m = 0; m < 4; ++m) { bf16* rowp = O + (size_t)(row0 + ai * HALF + m * 16) * D + col0;
                const f32x4 s4 = *(PG8_LAS const f32x4*)(ss + (ai * HALF + wr * 64 + m * 16 + fr) * 4);
                const float rs = rsqrtf(((s4[0] + s4[1]) + (s4[2] + s4[3])) * (1.f / D) + 1e-6f);
#pragma unroll
                for (int bj = 0; bj < 2; ++bj) { const f32x4 v0 = acc[ai][bj][m][0] * rs, v1 = acc[ai][bj][m][1] * rs;
                    u32x4 w; w.x = cvt_pk_bf16(v0[0], v0[1]); w.y = cvt_pk_bf16(v0[2], v0[3]); w.z = cvt_pk_bf16(v1[0], v1[1]); w.w = cvt_pk_bf16(v1[2], v1[3]);
                    *(u32x4*)(rowp + bj * HALF) = w; } }
    }
};
struct EpiResBf16 {
    static constexpr bool PERM = true;
    float* C; const bf16* R;
    __device__ __forceinline__ void operator()(const f32x4 (&acc)[2][2][4][2], const Unit& u, int wr, int wc, int fr, int fq) const {
        const int row0 = u.pm * BM + wr * 64 + fr, col0 = u.pn * BM + wc * 32 + 8 * fq;
#pragma unroll
        for (int ai = 0; ai < 2; ++ai)
#pragma unroll
            for (int m = 0; m < 4; ++m) { const size_t ro = (size_t)(row0 + ai * HALF + m * 16) * D + col0;
#pragma unroll
                for (int bj = 0; bj < 2; ++bj) { const u32x4 r = *(const u32x4*)(R + ro + bj * HALF);
                    f32x4 v0 = acc[ai][bj][m][0], v1 = acc[ai][bj][m][1];
                    v0[0] += __builtin_bit_cast(float, r.x << 16); v0[1] += __builtin_bit_cast(float, r.x & 0xffff0000u); v0[2] += __builtin_bit_cast(float, r.y << 16); v0[3] += __builtin_bit_cast(float, r.y & 0xffff0000u);
                    v1[0] += __builtin_bit_cast(float, r.z << 16); v1[1] += __builtin_bit_cast(float, r.z & 0xffff0000u); v1[2] += __builtin_bit_cast(float, r.w << 16); v1[3] += __builtin_bit_cast(float, r.w & 0xffff0000u);
                    *(f32x4*)(C + ro + bj * HALF) = v0; *(f32x4*)(C + ro + bj * HALF + 4) = v1; } }
    }
};
struct EpiF32 {
    static constexpr bool PERM = false;
    float* C; int ldc; const float* R; int ldr;
    __device__ __forceinline__ void operator()(const f32x4 (&acc)[2][2][4][2], const Unit& u, int wr, int wc, int fr, int fq) const {
        const int row0 = u.pm * BM + wr * 64 + fr, col0 = u.pn * BM + wc * 32 + 4 * fq;
#pragma unroll
        for (int ai = 0; ai < 2; ++ai)
#pragma unroll
            for (int m = 0; m < 4; ++m) { const size_t row = (size_t)(row0 + ai * HALF + m * 16);
#pragma unroll
                for (int bj = 0; bj < 2; ++bj)
#pragma unroll
                    for (int n = 0; n < 2; ++n) { const int col = col0 + bj * HALF + 16 * n; f32x4 v = acc[ai][bj][m][n];
                        if (R) v = v + *(const f32x4*)(R + row * ldr + col);
                        *(f32x4*)(C + row * ldc + col) = v; } }
    }
};
struct EpiBf16 {
    static constexpr bool PERM = true;
    bf16* O; int ldc;
    __device__ __forceinline__ void operator()(const f32x4 (&acc)[2][2][4][2], const Unit& u, int wr, int wc, int fr, int fq) const {
        const int row0 = u.pm * BM + wr * 64 + fr, col0 = u.pn * BM + wc * 32 + 8 * fq;
#pragma unroll
        for (int ai = 0; ai < 2; ++ai)
#pragma unroll
            for (int m = 0; m < 4; ++m) { bf16* rowp = O + (size_t)(row0 + ai * HALF + m * 16) * ldc + col0;
#pragma unroll
                for (int bj = 0; bj < 2; ++bj) { const f32x4 v0 = acc[ai][bj][m][0], v1 = acc[ai][bj][m][1];
                    u32x4 w; w.x = cvt_pk_bf16(v0[0], v0[1]); w.y = cvt_pk_bf16(v0[2], v0[3]); w.z = cvt_pk_bf16(v1[0], v1[1]); w.w = cvt_pk_bf16(v1[2], v1[3]);
                    *(u32x4*)(rowp + bj * HALF) = w; } }
    }
};
struct EpiGlu {
    static constexpr bool PERM = true;
    const bf16* Z; const float* bias; bf16* YM;
    __device__ __forceinline__ void operator()(const f32x4 (&acc)[2][2][4][2], const Unit& u, int wr, int wc, int fr, int fq) const {
        const int row0 = u.pm * BM + wr * 64 + fr, col0 = u.pn * BM + wc * 32 + 8 * fq;
#pragma unroll
        for (int ai = 0; ai < 2; ++ai)
#pragma unroll
            for (int m = 0; m < 4; ++m) { const size_t row = (size_t)(row0 + ai * HALF + m * 16);
#pragma unroll
                for (int bj = 0; bj < 2; ++bj) { const int col = col0 + bj * HALF;
                    const u32x4 zz = *(const u32x4*)(Z + row * 512 + col);
                    const f32x4 b0 = *(const f32x4*)(bias + col), b1 = *(const f32x4*)(bias + col + 4);
                    const f32x4 v0 = acc[ai][bj][m][0] + b0, v1 = acc[ai][bj][m][1] + b1;
                    float o[8]; const unsigned zw[4] = {zz.x, zz.y, zz.z, zz.w};
#pragma unroll
                    for (int q = 0; q < 4; ++q) { const float zl = __builtin_bit_cast(float, zw[q] << 16), zh = __builtin_bit_cast(float, zw[q] & 0xffff0000u);
                        const float al = (q < 2) ? v0[2 * q] : v1[2 * q - 4], ah = (q < 2) ? v0[2 * q + 1] : v1[2 * q - 3];
                        o[2 * q] = zl * sigmoidf_(al); o[2 * q + 1] = zh * sigmoidf_(ah); }
                    u32x4 w; w.x = cvt_pk_bf16(o[0], o[1]); w.y = cvt_pk_bf16(o[2], o[3]); w.z = cvt_pk_bf16(o[4], o[5]); w.w = cvt_pk_bf16(o[6], o[7]);
                    *(u32x4*)(YM + row * D + 512 + col) = w; } }
    }
};

template <bool GATHER_>
struct MoeOrderT {
    static constexpr bool GATHER = GATHER_;
    const bf16* A; const bf16* Bt; int lda, ldb, K; const int* tiles; const int* rows; int nunits, G, c; size_t bexp;
    __device__ void init(const bf16* A_, int lda_, const bf16* Bt_, int ldb_, int K_, const int* tiles_, int ntiles, size_t bexp_, const int* rows_) { A = A_; Bt = Bt_; lda = lda_; ldb = ldb_; K = K_; tiles = tiles_; rows = rows_; nunits = ntiles * 4; G = GN; c = GB; bexp = bexp_; }
    __device__ bool next(int i, Unit& u) const { const int L = i * G + c; if (L >= nunits) return false; u.pm = L >> 2; u.pn = L & 3; return true; }
    __device__ __forceinline__ const char* aptr(const Unit& u) const { return GATHER ? (const char*)A : (const char*)(A + (size_t)u.pm * BM * lda); }
    __device__ __forceinline__ int grow(const Unit& u, int r) const { return rows[u.pm * BM + r]; }
    __device__ __forceinline__ const char* bptr(const Unit& u) const { const int e = __hip_atomic_load(tiles + u.pm, __ATOMIC_RELAXED, __HIP_MEMORY_SCOPE_AGENT); return (const char*)(Bt + ((size_t)e * bexp + (size_t)u.pn * BM) * ldb); }
};
struct EpiSilu {
    static constexpr bool PERM = true;
    bf16* HID;
    __device__ __forceinline__ void operator()(const f32x4 (&acc)[2][2][4][2], const Unit& u, int wr, int wc, int fr, int fq) const {
        const int row0 = u.pm * BM + wr * 64 + fr, col0 = u.pn * HALF + wc * 32 + 8 * fq;
#pragma unroll
        for (int ai = 0; ai < 2; ++ai)
#pragma unroll
            for (int m = 0; m < 4; ++m) { const size_t row = (size_t)(row0 + ai * HALF + m * 16);
                float o[8];
#pragma unroll
                for (int n = 0; n < 2; ++n)
#pragma unroll
                    for (int q = 0; q < 4; ++q) { const float g = acc[ai][0][m][n][q], up = acc[ai][1][m][n][q]; o[4 * n + q] = g * sigmoidf_(g) * up; }
                u32x4 w; w.x = cvt_pk_bf16(o[0], o[1]); w.y = cvt_pk_bf16(o[2], o[3]); w.z = cvt_pk_bf16(o[4], o[5]); w.w = cvt_pk_bf16(o[6], o[7]);
                *(u32x4*)(HID + row * DEXP + col0) = w; }
    }
};
struct EpiGate {
    static constexpr bool PERM = true;
    bf16* Y; const float* gate;
    __device__ __forceinline__ void operator()(const f32x4 (&acc)[2][2][4][2], const Unit& u, int wr, int wc, int fr, int fq) const {
        const int row0 = u.pm * BM + wr * 64 + fr, col0 = u.pn * BM + wc * 32 + 8 * fq;
#pragma unroll
        for (int ai = 0; ai < 2; ++ai)
#pragma unroll
            for (int m = 0; m < 4; ++m) { const size_t row = (size_t)(row0 + ai * HALF + m * 16); const float gt = gate[row];
#pragma unroll
                for (int bj = 0; bj < 2; ++bj) { const f32x4 v0 = acc[ai][bj][m][0] * gt, v1 = acc[ai][bj][m][1] * gt;
                    u32x4 w; w.x = cvt_pk_bf16(v0[0], v0[1]); w.y = cvt_pk_bf16(v0[2], v0[3]); w.z = cvt_pk_bf16(v1[0], v1[1]); w.w = cvt_pk_bf16(v1[2], v1[3]);
                    *(u32x4*)(Y + row * D + col0 + bj * HALF) = w; } }
    }
};

struct EpiProj {
    static constexpr bool PERM = true;
    bf16* PROJ; bf16* US5;
    __device__ __forceinline__ void operator()(const f32x4 (&acc)[2][2][4][2], const Unit& u, int wr, int wc, int fr, int fq) const {
        const int row0 = u.pm * BM + wr * 64 + fr, col0 = u.pn * BM + wc * 32 + 8 * fq;
#pragma unroll
        for (int ai = 0; ai < 2; ++ai)
#pragma unroll
            for (int m = 0; m < 4; ++m) { const size_t row = (size_t)(row0 + ai * HALF + m * 16);
#pragma unroll
                for (int bj = 0; bj < 2; ++bj) { const f32x4 v0 = acc[ai][bj][m][0], v1 = acc[ai][bj][m][1]; const int col = col0 + bj * HALF;
                    u32x4 w; w.x = cvt_pk_bf16(v0[0], v0[1]); w.y = cvt_pk_bf16(v0[2], v0[3]); w.z = cvt_pk_bf16(v1[0], v1[1]); w.w = cvt_pk_bf16(v1[2], v1[3]);
                    if (col < DSHIFT) *(u32x4*)(PROJ + row * DSHIFT + col) = w;
                    else { const int cc = col - DSHIFT; *(u32x4*)(US5 + ((size_t)(cc >> 4) * M + row) * 16 + (cc & 15)) = w; } } }
    }
};
struct GroupOrder {
    static constexpr bool GATHER = false; __device__ __forceinline__ int grow(const Unit&, int) const { return 0; }
    const bf16* A; const bf16* Bt; int lda, ldb, K; int nM, nN, nunits, G, c; size_t sA, sB;
    __device__ void init(const bf16* A_, int lda_, size_t sA_, const bf16* Bt_, int ldb_, size_t sB_, int ngroups, int Mg, int Ng, int K_) {
        A = A_; Bt = Bt_; lda = lda_; ldb = ldb_; K = K_; sA = sA_; sB = sB_; nM = Mg / BM; nN = Ng / BM; nunits = ngroups * nM * nN; G = GN; c = GB; }
    __device__ bool next(int i, Unit& u) const { const int L = i * G + c; if (L >= nunits) return false; u.pn = L % nN; u.pm = L / nN; return true; }
    __device__ __forceinline__ const char* aptr(const Unit& u) const { const int g = u.pm / nM, pm = u.pm % nM; return (const char*)(A + (size_t)g * sA + (size_t)pm * BM * lda); }
    __device__ __forceinline__ const char* bptr(const Unit& u) const { const int g = u.pm / nM; return (const char*)(Bt + (size_t)g * sB + (size_t)u.pn * BM * ldb); }
};
struct EpiS5a {
    static constexpr bool PERM = false;
    bf16* YI; float* F;
    __device__ __forceinline__ void operator()(const f32x4 (&acc)[2][2][4][2], const Unit& u, int wr, int wc, int fr, int fq) const {
        const int row0 = u.pm * BM + wr * 64 + fr, col0 = u.pn * BM + wc * 32 + 4 * fq;
#pragma unroll
        for (int ai = 0; ai < 2; ++ai)
#pragma unroll
            for (int m = 0; m < 4; ++m) { const size_t row = (size_t)(row0 + ai * HALF + m * 16);
#pragma unroll
                for (int bj = 0; bj < 2; ++bj)
#pragma unroll
                    for (int n = 0; n < 2; ++n) { const int col = col0 + bj * HALF + 16 * n; const f32x4 v = acc[ai][bj][m][n];
                        if (col < 512) { uint2 w; w.x = cvt_pk_bf16(v[0], v[1]); w.y = cvt_pk_bf16(v[2], v[3]); *(uint2*)(YI + row * 512 + col) = w; }
                        else if (col < 640) *(f32x4*)(F + row * 128 + (col - 512)) = v; } }
    }
};
struct EpiS5b {
    static constexpr bool PERM = true;
    const bf16* YI; bf16* Z;
    __device__ __forceinline__ void operator()(const f32x4 (&acc)[2][2][4][2], const Unit& u, int wr, int wc, int fr, int fq) const {
        const int row0 = u.pm * BM + wr * 64 + fr, col0 = u.pn * BM + wc * 32 + 8 * fq;
#pragma unroll
        for (int ai = 0; ai < 2; ++ai)
#pragma unroll
            for (int m = 0; m < 4; ++m) { const int row = row0 + ai * HALF + m * 16; const int g = row / S5R, rl = row % S5R;
#pragma unroll
                for (int bj = 0; bj < 2; ++bj) { const int col = col0 + bj * HALF;
                    const u32x4 yi = *(const u32x4*)(YI + (size_t)row * 512 + col);
                    const unsigned yw[4] = {yi.x, yi.y, yi.z, yi.w};
                    const f32x4 v0 = acc[ai][bj][m][0], v1 = acc[ai][bj][m][1];
                    float o[8];
#pragma unroll
                    for (int q = 0; q < 4; ++q) { const float al = (q < 2) ? v0[2 * q] : v1[2 * q - 4], ah = (q < 2) ? v0[2 * q + 1] : v1[2 * q - 3];
                        o[2 * q] = gelu_tanh(al + __builtin_bit_cast(float, yw[q] << 16)); o[2 * q + 1] = gelu_tanh(ah + __builtin_bit_cast(float, yw[q] & 0xffff0000u)); }
                    u32x4 w; w.x = cvt_pk_bf16(o[0], o[1]); w.y = cvt_pk_bf16(o[2], o[3]); w.z = cvt_pk_bf16(o[4], o[5]); w.w = cvt_pk_bf16(o[6], o[7]);
                    const size_t tok = (size_t)rl * S5L + (col >> 4);
                    *(u32x4*)(Z + tok * 512 + g * 16 + (col & 15)) = w; } }
    }
};
struct AttnOrder {
    static constexpr bool GATHER = false; __device__ __forceinline__ int grow(const Unit&, int) const { return 0; }
    const bf16* A; const bf16* Bt; int lda, ldb, K; int G, c; int mode;
    __device__ void init(const bf16* A_, const bf16* Bt_, int ldb_, int mode_) { A = A_; Bt = Bt_; lda = D; ldb = ldb_; K = 256; G = GN; c = GB; mode = mode_; }
    __device__ bool next(int i, Unit& u) const { const int L = i * G + c; if (L >= NB * 4 * 32) return false; u.pn = L & 3; u.pm = L >> 2; return true; }
    __device__ __forceinline__ const char* aptr(const Unit& u) const { return (const char*)(A + (size_t)u.pm * BM * D + u.pn * 256); }
    __device__ __forceinline__ const char* bptr(const Unit& u) const { const int b = u.pm >> 5;
        return (const char*)(mode == 0 ? Bt + (size_t)b * 256 * ldb + u.pn * 256 : Bt + (size_t)u.pn * 256 * ldb + b * 256); }
};
struct EpiSoftmax {
    static constexpr bool PERM = true;
    bf16* P; PG8_LAS float* scr;
    __device__ __forceinline__ void operator()(f32x4 (&acc)[2][2][4][2], const Unit& u, int wr, int wc, int fr, int fq) const {
        const float SC = 0.0625f * 1.4426950408889634f;
        PG8_LAS float* smax = scr; PG8_LAS float* ssum = scr + 1024;
#pragma unroll
        for (int ai = 0; ai < 2; ++ai)
#pragma unroll
            for (int m = 0; m < 4; ++m) { float t = -3.0e38f;
#pragma unroll
                for (int bj = 0; bj < 2; ++bj)
#pragma unroll
                    for (int n = 0; n < 2; ++n) { const f32x4 v = acc[ai][bj][m][n]; t = fmaxf(t, fmaxf(fmaxf(v[0], v[1]), fmaxf(v[2], v[3]))); }
                t = fmaxf(t, __shfl_xor(t, 16)); t = fmaxf(t, __shfl_xor(t, 32));
                if (fq == 0) smax[(ai * HALF + wr * 64 + m * 16 + fr) * 4 + wc] = t; }
        asm volatile("s_waitcnt lgkmcnt(0)" ::: "memory"); __builtin_amdgcn_s_barrier(); asm volatile("" ::: "memory");
#pragma unroll
        for (int ai = 0; ai < 2; ++ai)
#pragma unroll
            for (int m = 0; m < 4; ++m) { const f32x4 q = *(const PG8_LAS f32x4*)(smax + (ai * HALF + wr * 64 + m * 16 + fr) * 4);
                const float mm = fmaxf(fmaxf(q[0], q[1]), fmaxf(q[2], q[3])) * SC; float s = 0.f;
#pragma unroll
                for (int bj = 0; bj < 2; ++bj)
#pragma unroll
                    for (int n = 0; n < 2; ++n)
#pragma unroll
                        for (int e = 0; e < 4; ++e) { const float p = __builtin_amdgcn_exp2f(acc[ai][bj][m][n][e] * SC - mm); acc[ai][bj][m][n][e] = p; s += p; }
                s += __shfl_xor(s, 16); s += __shfl_xor(s, 32);
                if (fq == 0) ssum[(ai * HALF + wr * 64 + m * 16 + fr) * 4 + wc] = s; }
        asm volatile("s_waitcnt lgkmcnt(0)" ::: "memory"); __builtin_amdgcn_s_barrier(); asm volatile("" ::: "memory");
        const int row0 = u.pm * BM + wr * 64 + fr, col0 = u.pn * 256 + wc * 32 + 8 * fq;
#pragma unroll
        for (int ai = 0; ai < 2; ++ai)
#pragma unroll
            for (int m = 0; m < 4; ++m) { const f32x4 q = *(const PG8_LAS f32x4*)(ssum + (ai * HALF + wr * 64 + m * 16 + fr) * 4);
                const float iv = 1.f / ((q[0] + q[1]) + (q[2] + q[3]));
                bf16* rowp = P + (size_t)(row0 + ai * HALF + m * 16) * D + col0;
#pragma unroll
                for (int bj = 0; bj < 2; ++bj) { const f32x4 v0 = acc[ai][bj][m][0] * iv, v1 = acc[ai][bj][m][1] * iv; u32x4 w;
                    w.x = cvt_pk_bf16(v0[0], v0[1]); w.y = cvt_pk_bf16(v0[2], v0[3]); w.z = cvt_pk_bf16(v1[0], v1[1]); w.w = cvt_pk_bf16(v1[2], v1[3]);
                    *(u32x4*)(rowp + bj * HALF) = w; } }
    }
};
struct EpiAttnO {
    static constexpr bool PERM = true;
    bf16* O;
    __device__ __forceinline__ void operator()(const f32x4 (&acc)[2][2][4][2], const Unit& u, int wr, int wc, int fr, int fq) const {
        const int row0 = u.pm * BM + wr * 64 + fr, col0 = u.pn * 256 + wc * 32 + 8 * fq;
#pragma unroll
        for (int ai = 0; ai < 2; ++ai)
#pragma unroll
            for (int m = 0; m < 4; ++m) { bf16* rowp = O + (size_t)(row0 + ai * HALF + m * 16) * D + col0;
#pragma unroll
                for (int bj = 0; bj < 2; ++bj) { const f32x4 v0 = acc[ai][bj][m][0], v1 = acc[ai][bj][m][1];
                    u32x4 w; w.x = cvt_pk_bf16(v0[0], v0[1]); w.y = cvt_pk_bf16(v0[2], v0[3]); w.z = cvt_pk_bf16(v1[0], v1[1]); w.w = cvt_pk_bf16(v1[2], v1[3]);
                    *(u32x4*)(rowp + bj * HALF) = w; } }
    }
};

struct EpiLora {
    static constexpr bool PERM = true;
    bf16* LW; size_t ostride; const float* w0; const float* a0;
    __device__ __forceinline__ void operator()(const f32x4 (&acc)[2][2][4][2], const Unit& u, int wr, int wc, int fr, int fq) const {
        const int row0 = u.pm * BM + wr * 64 + fr, col0 = u.pn * BM + wc * 32 + 8 * fq;
        const int kind = u.pn >> 1;
        bf16* O = LW + (size_t)kind * ostride;
#pragma unroll
        for (int bj = 0; bj < 2; ++bj) { const int col = (col0 + bj * HALF) & 511;
            f32x4 b0 = (f32x4){0.f, 0.f, 0.f, 0.f}, b1 = b0;
            if (kind == 0) { b0 = *(const f32x4*)(w0 + col); b1 = *(const f32x4*)(w0 + col + 4); }
            else if (kind == 1) { b0 = *(const f32x4*)(a0 + col); b1 = *(const f32x4*)(a0 + col + 4); }
#pragma unroll
            for (int ai = 0; ai < 2; ++ai)
#pragma unroll
                for (int m = 0; m < 4; ++m) { const size_t row = (size_t)(row0 + ai * HALF + m * 16);
                    const f32x4 v0 = acc[ai][bj][m][0] + b0, v1 = acc[ai][bj][m][1] + b1; float o[8];
#pragma unroll
                    for (int e = 0; e < 8; ++e) { float x = (e < 4) ? v0[e & 3] : v1[e & 3];
                        if (kind == 0) x = -0.6065306597126334f * sigmoidf_(x);
                        else if (kind == 1) x = sigmoidf_(x);
                        o[e] = x; }
                    u32x4 w; w.x = cvt_pk_bf16(o[0], o[1]); w.y = cvt_pk_bf16(o[2], o[3]); w.z = cvt_pk_bf16(o[4], o[5]); w.w = cvt_pk_bf16(o[6], o[7]);
                    *(u32x4*)(O + row * 512 + col) = w; } }
    }
};

struct TileOrder {
    static constexpr bool GATHER = false; __device__ __forceinline__ int grow(const Unit&, int) const { return 0; }
    const bf16* A; const bf16* Bt; int lda, ldb, K, nN, pm;
    __device__ void init(const bf16* A_, int lda_, const bf16* Bt_, int ldb_, int K_, int nN_, int pm_) { A = A_; Bt = Bt_; lda = lda_; ldb = ldb_; K = K_; nN = nN_; pm = pm_; }
    __device__ bool next(int i, Unit& u) const { if (i >= nN) return false; int pm_ = pm; asm volatile("" : "+s"(pm_)); u.pm = pm_; u.pn = (i + (GB >> 3)) & (nN - 1); return true; }
    __device__ __forceinline__ const char* aptr(const Unit& u) const { return (const char*)(A + (size_t)u.pm * BM * lda); }
    __device__ __forceinline__ const char* bptr(const Unit& u) const { return (const char*)(Bt + (size_t)u.pn * BM * ldb); }
};
struct AttnTileOrder {
    static constexpr bool GATHER = false; __device__ __forceinline__ int grow(const Unit&, int) const { return 0; }
    const bf16* A; const bf16* Bt; int lda, ldb, K, pm, mode;
    __device__ void init(const bf16* A_, const bf16* Bt_, int ldb_, int mode_, int pm_) { A = A_; Bt = Bt_; lda = D; ldb = ldb_; K = 256; mode = mode_; pm = pm_; }
    __device__ bool next(int i, Unit& u) const { if (i >= 4) return false; int pm_ = pm; asm volatile("" : "+s"(pm_)); u.pm = pm_; u.pn = (i + (GB >> 3)) & 3; return true; }
    __device__ __forceinline__ const char* aptr(const Unit& u) const { return (const char*)(A + (size_t)u.pm * BM * D + u.pn * 256); }
    __device__ __forceinline__ const char* bptr(const Unit& u) const { const int b = u.pm >> 5;
        return (const char*)(mode == 0 ? Bt + (size_t)b * 256 * ldb + u.pn * 256 : Bt + (size_t)u.pn * 256 * ldb + b * 256); }
};
}

#define LAS __attribute__((address_space(3)))
__device__ __forceinline__ void transpose_item(const float* __restrict__ W, int K, int N, bf16* __restrict__ WT, int ldt, int row_off, int col_off, float* scr, int item, int lane, const float* __restrict__ kscale, int ldw = 0) {
    if (ldw == 0) ldw = N;
    const int nblk = N / 32, kb = item / nblk, nb = item % nblk, k0 = 64 * kb, n0 = 32 * nb;
#pragma unroll 8
    for (int i = 0; i < 32; ++i) { const int kk = 2 * i + (lane >> 5); float v = W[(size_t)(k0 + kk) * ldw + n0 + (lane & 31)]; if (kscale) v *= kscale[k0 + kk]; scr[kk * 33 + (lane & 31)] = v; }
    __builtin_amdgcn_s_waitcnt(0xc07f); asm volatile("" ::: "memory");
    const int c = lane & 7;
#pragma unroll
    for (int j = 0; j < 4; ++j) { const int n = (lane >> 3) + 8 * j; const float* s = scr + (8 * c) * 33 + n;
        uint4 o; o.x = pk2(s[0 * 33], s[1 * 33]); o.y = pk2(s[2 * 33], s[3 * 33]); o.z = pk2(s[4 * 33], s[5 * 33]); o.w = pk2(s[6 * 33], s[7 * 33]);
        *(uint4*)(WT + (size_t)(row_off + n0 + n) * ldt + col_off + k0 + 8 * c) = o; }
    __builtin_amdgcn_s_waitcnt(0xc07f); asm volatile("" ::: "memory");
}
__device__ __forceinline__ void transpose_ph(const int WID_, const float* W, int K, int N, bf16* WT, int ldt, int row_off, int col_off, char* lds, const float* kscale = nullptr) {
    const int lane = (WID_ * 64 + lane_id()) & 63, wv = (WID_ * 64 + lane_id()) >> 6;
    float* scr = (float*)(lds + wv * 16384);
    const int nitems = (K / 64) * (N / 32);
    for (int it = GB * 8 + wv; it < nitems; it += GN * 8) transpose_item(W, K, N, WT, ldt, row_off, col_off, scr, it, lane, kscale);
}

template <typename TO>
__device__ __forceinline__ void rmsnorm_ph(const int WID_, const float* __restrict__ x, const float* __restrict__ w, TO* __restrict__ out, int rows, int row_lo = 0, int vb = GB, int nvb = GN) {
    const int lane = lane_id(), wv = WID_;
    float4 g[4];
#pragma unroll
    for (int j = 0; j < 4; ++j) g[j] = *(const float4*)(w + (lane + 64 * j) * 4);
    for (int row = row_lo + (vb * 8 + wv) * 2; row < rows; row += nvb * 16) {
        const float4* xr = (const float4*)(x + (size_t)row * D);
        float4 v[2][4]; float s[2] = {0.f, 0.f};
#pragma unroll
        for (int r = 0; r < 2; ++r)
#pragma unroll
            for (int j = 0; j < 4; ++j) v[r][j] = xr[r * (D / 4) + lane + 64 * j];
#pragma unroll
        for (int r = 0; r < 2; ++r) {
#pragma unroll
            for (int j = 0; j < 4; ++j) s[r] += v[r][j].x * v[r][j].x + v[r][j].y * v[r][j].y + v[r][j].z * v[r][j].z + v[r][j].w * v[r][j].w;
            s[r] = wave_sum(s[r]);
            const float rs = rsqrtf(s[r] * (1.f / D) + 1e-6f);
#pragma unroll
            for (int j = 0; j < 4; ++j) {
                uint2 o; o.x = pk2(v[r][j].x * rs * g[j].x, v[r][j].y * rs * g[j].y); o.y = pk2(v[r][j].z * rs * g[j].z, v[r][j].w * rs * g[j].w);
                *(uint2*)(out + (size_t)(row + r) * D + (lane + 64 * j) * 4) = o;
            }
        }
    }
}

__device__ __forceinline__ void rwkv_lin_ph(const int WID_, const bf16* __restrict__ proj, const float* __restrict__ mu, bf16* __restrict__ lin) {
    const int lane = lane_id(), wv = WID_;
    const float4 m4 = *(const float4*)(mu + 1536 + 4 * lane);
    const float mm[4] = {m4.x, m4.y, m4.z, m4.w};
    for (int m0 = (GB * 8 + wv) * 4; m0 < M; m0 += GN * 32) {
        uint2 z[4], zp[4];
#pragma unroll
        for (int i = 0; i < 4; ++i) { const int m = m0 + i; z[i] = *(const uint2*)(proj + (size_t)m * DSHIFT + 1536 + 4 * lane);
            zp[i] = make_uint2(0, 0); if ((m & (S - 1)) != 0) zp[i] = *(const uint2*)(proj + (size_t)(m - 1) * DSHIFT + 1536 + 4 * lane); }
#pragma unroll
        for (int i = 0; i < 4; ++i) {
            float c[4] = {__builtin_bit_cast(float, z[i].x << 16), __builtin_bit_cast(float, z[i].x & 0xffff0000u), __builtin_bit_cast(float, z[i].y << 16), __builtin_bit_cast(float, z[i].y & 0xffff0000u)};
            const float q[4] = {__builtin_bit_cast(float, zp[i].x << 16), __builtin_bit_cast(float, zp[i].x & 0xffff0000u), __builtin_bit_cast(float, zp[i].y << 16), __builtin_bit_cast(float, zp[i].y & 0xffff0000u)};
#pragma unroll
            for (int e = 0; e < 4; ++e) { float t = c[e] + (q[e] - c[e]) * mm[e];
                if (lane < 16) t = 1.f - 2.f / (1.f + __expf(2.f * t));
                else if (lane >= 32) t = sigmoidf_(t);
                c[e] = t; }
            uint2 o; o.x = pk2(c[0], c[1]); o.y = pk2(c[2], c[3]);
            *(uint2*)(lin + (size_t)(m0 + i) * 256 + 4 * lane) = o;
        }
    }
}
__device__ __forceinline__ void rwkv_wl_ph(const int WID_, const float* __restrict__ wdec, const float* __restrict__ wiclr, const float* __restrict__ wgate, bf16* __restrict__ wl) {
    for (int i = GB * NT + (WID_ * 64 + lane_id()); i < 1536 * 256; i += GN * NT) {
        const int k = i & 255, n = i >> 8; float v = 0.f;
        if (n < 512) { if (k < 64) v = wdec[k * 512 + n]; }
        else if (n < 1024) { if (k >= 64 && k < 128) v = wiclr[(k - 64) * 512 + (n - 512)]; }
        else { if (k >= 128) v = wgate[(k - 128) * 512 + (n - 1024)]; }
        wl[i] = f2bf(v);
    }
}
template <int CTRL> __device__ __forceinline__ float dpp16(float x) { return __builtin_bit_cast(float, __builtin_amdgcn_update_dpp(0, __builtin_bit_cast(int, x), CTRL, 0xf, 0xf, true)); }
constexpr int RW_ITEMS = NB * 8;

namespace ck {
#define CK_BAR() do { asm volatile("s_waitcnt lgkmcnt(0)" ::: "memory"); __builtin_amdgcn_s_barrier(); asm volatile("" ::: "memory"); } while (0)
typedef float f32x2_t __attribute__((ext_vector_type(2)));
typedef __bf16 bf16x2_t __attribute__((ext_vector_type(2)));
__device__ __forceinline__ unsigned cvtpk(float lo, float hi) { const f32x2_t v = {lo, hi}; const bf16x2_t b = __builtin_convertvector(v, bf16x2_t); return __builtin_bit_cast(unsigned, b); }
typedef short bf16x8 __attribute__((ext_vector_type(8)));
typedef float f32x16 __attribute__((ext_vector_type(16)));
constexpr int LD = 72;
constexpr int MB = 64 * LD * 2;
constexpr int O_AB = 0, O_RB = MB, O_BB = 2 * MB, O_KB = 3 * MB, O_AT = 4 * MB, O_W1T = 5 * MB, O_BT = 6 * MB, O_KT = 7 * MB, O_VT = 8 * MB,
              O_NM = 9 * MB, O_AAK = 10 * MB, O_ARB = 11 * MB, O_ARK = 12 * MB, O_G = 13 * MB, O_TOT = O_G + 16384;
constexpr int O_TM = O_AB, O_X1T = O_BB, O_NMF = O_G, O_TT = O_G + 8192, O_ZT = O_TT + 5120;
constexpr int ITEM_BYTES = 32768;
template <int K, typename PA, typename PB>
__device__ __forceinline__ f32x16 mm_tile(f32x16 acc, PA A, int lda, PB B, int ldb, int lane) {
    const int r = lane & 31, h = lane >> 5;
    bf16x8 a[K / 16], b[K / 16];
#pragma unroll
    for (int q = 0; q < K / 16; ++q) { a[q] = *(const bf16x8*)(A + r * lda + 16 * q + 8 * h); b[q] = *(const bf16x8*)(B + r * ldb + 16 * q + 8 * h); }
#pragma unroll
    for (int q = 0; q < K / 16; ++q) acc = __builtin_amdgcn_mfma_f32_32x32x16_bf16(a[q], b[q], acc, 0, 0, 0);
    return acc;
}
__device__ __forceinline__ int crow(int reg, int h) { return (reg & 3) + 8 * (reg >> 2) + 4 * h; }
__device__ __forceinline__ void store_tr(const f32x16& acc, bf16* Ct, int ldct, int lane) {
    const int c = lane & 31, h = lane >> 5;
#pragma unroll
    for (int g = 0; g < 4; ++g) { uint2 w; w.x = cvtpk(acc[4 * g], acc[4 * g + 1]); w.y = cvtpk(acc[4 * g + 2], acc[4 * g + 3]); *(uint2*)(Ct + c * ldct + 8 * g + 4 * h) = w; }
}
__device__ __forceinline__ void store_rm(const f32x16& acc, bf16* C, int ldc, int lane) {
    const int c = lane & 31, h = lane >> 5;
#pragma unroll
    for (int rg = 0; rg < 16; ++rg) C[crow(rg, h) * ldc + c] = f2bf(acc[rg]);
}
__device__ __forceinline__ f32x16 zero16() { return (f32x16){0.f, 0.f, 0.f, 0.f, 0.f, 0.f, 0.f, 0.f, 0.f, 0.f, 0.f, 0.f, 0.f, 0.f, 0.f, 0.f}; }
__device__ __forceinline__ void store_frag16(const f32x16& acc, bf16* base, int t0, int t1, int lane) {
    const int cc = lane & 31, hh = lane >> 5, col = 32 * t1 + cc;
#pragma unroll
    for (int g = 0; g < 4; ++g) { const int row = 32 * t0 + 8 * g + 4 * hh;
        uint2 w; w.x = cvtpk(acc[4 * g], acc[4 * g + 1]); w.y = cvtpk(acc[4 * g + 2], acc[4 * g + 3]);
        *(uint2*)(base + (((row >> 4) * 4 + (col >> 4)) * 64 + (col & 15) + 16 * ((row & 15) >> 2)) * 4) = w; }
}
struct In { const bf16* proj; const bf16* LW; const bf16* AA; const float* mu; const float* k_k; const float* k_a; const float* r_k; float* RK; char* items; };

__device__ __forceinline__ void phase1(const int WID_, const In& I, char* lds) {
    const int wv = WID_;
#define MAT(off) ((bf16*)(lds + (off)))
    float* G = (float*)(lds + O_G); float* TOT = (float*)(lds + O_TOT); float* NMF = (float*)(lds + O_NMF);
    uint4 nx_r, nx_k, nx_v, nx_qr, nx_qk, nx_qv, nx_a, nx_l;
    { const int lane0 = lane_id(), tid0 = wv * 64 + lane0; const int item = GB;
      if (item < NB * 8 * (S / 64)) { const int c = item & 127, h = (item >> 7) & 7, b = item >> 10, s = tid0 >> 3, cg = tid0 & 7, ch0 = h * 64 + cg * 8, t = c * 64 + s; const size_t m = (size_t)b * S + t;
        const bf16* z = I.proj + m * DSHIFT + ch0;
        nx_r = *(const uint4*)(z); nx_k = *(const uint4*)(z + 512); nx_v = *(const uint4*)(z + 1024);
        nx_qr = make_uint4(0, 0, 0, 0); nx_qk = nx_qr; nx_qv = nx_qr;
        if (t > 0) { nx_qr = *(const uint4*)(z - DSHIFT); nx_qk = *(const uint4*)(z + 512 - DSHIFT); nx_qv = *(const uint4*)(z + 1024 - DSHIFT); }
        nx_a = *(const uint4*)(I.AA + m * 512 + ch0); nx_l = *(const uint4*)(I.LW + m * 512 + ch0); } }
    for (int item = GB; item < NB * 8 * (S / 64); item += GN) {
        const int lane = lane_id(), tid = wv * 64 + lane;
        const int c = item & 127, h = (item >> 7) & 7, b = item >> 10;
        char* out = I.items + (size_t)item * ITEM_BYTES;
        const int s = tid >> 3, cg = tid & 7, ch0 = h * 64 + cg * 8, t = c * 64 + s; const size_t m = (size_t)b * S + t;
        float r_[8], kp_[8], v_[8], kk_[8], b_[8];
        {
            const uint4 gr = nx_r, gk = nx_k, gv = nx_v, qr = nx_qr, qk = nx_qk, qv = nx_qv, ga = nx_a, gl = nx_l;
            const float4 c_mr0 = *(const float4*)(I.mu + ch0), c_mr1 = *(const float4*)(I.mu + ch0 + 4), c_mk0 = *(const float4*)(I.mu + 512 + ch0), c_mk1 = *(const float4*)(I.mu + 512 + ch0 + 4);
            const float4 c_mv0 = *(const float4*)(I.mu + 1024 + ch0), c_mv1 = *(const float4*)(I.mu + 1024 + ch0 + 4), c_kk0 = *(const float4*)(I.k_k + ch0), c_kk1 = *(const float4*)(I.k_k + ch0 + 4);
            const float4 c_ka0 = *(const float4*)(I.k_a + ch0), c_ka1 = *(const float4*)(I.k_a + ch0 + 4), c_rk0 = *(const float4*)(I.r_k + ch0), c_rk1 = *(const float4*)(I.r_k + ch0 + 4);
            const float mur[8] = {c_mr0.x, c_mr0.y, c_mr0.z, c_mr0.w, c_mr1.x, c_mr1.y, c_mr1.z, c_mr1.w}, muk[8] = {c_mk0.x, c_mk0.y, c_mk0.z, c_mk0.w, c_mk1.x, c_mk1.y, c_mk1.z, c_mk1.w};
            const float muv[8] = {c_mv0.x, c_mv0.y, c_mv0.z, c_mv0.w, c_mv1.x, c_mv1.y, c_mv1.z, c_mv1.w}, ckk[8] = {c_kk0.x, c_kk0.y, c_kk0.z, c_kk0.w, c_kk1.x, c_kk1.y, c_kk1.z, c_kk1.w};
            const float cka[8] = {c_ka0.x, c_ka0.y, c_ka0.z, c_ka0.w, c_ka1.x, c_ka1.y, c_ka1.z, c_ka1.w}, crk[8] = {c_rk0.x, c_rk0.y, c_rk0.z, c_rk0.w, c_rk1.x, c_rk1.y, c_rk1.z, c_rk1.w};
            const unsigned wr[4] = {gr.x, gr.y, gr.z, gr.w}, wk[4] = {gk.x, gk.y, gk.z, gk.w}, wv4[4] = {gv.x, gv.y, gv.z, gv.w};
            const unsigned pr[4] = {qr.x, qr.y, qr.z, qr.w}, pk[4] = {qk.x, qk.y, qk.z, qk.w}, pv[4] = {qv.x, qv.y, qv.z, qv.w};
            const unsigned wa[4] = {ga.x, ga.y, ga.z, ga.w}, wl[4] = {gl.x, gl.y, gl.z, gl.w};
            float ss = 0.f, rk = 0.f, a_[8];
#pragma unroll
            for (int e = 0; e < 8; ++e) { const int w_ = e >> 1; const bool hi = e & 1;
                auto ex = [&](unsigned u) { return hi ? __builtin_bit_cast(float, u & 0xffff0000u) : __builtin_bit_cast(float, u << 16); };
                float x = ex(wr[w_]); r_[e] = x + (ex(pr[w_]) - x) * mur[e];
                x = ex(wk[w_]); const float k = x + (ex(pk[w_]) - x) * muk[e];
                x = ex(wv4[w_]); v_[e] = x + (ex(pv[w_]) - x) * muv[e];
                a_[e] = ex(wa[w_]); kk_[e] = k * ckk[e]; ss += kk_[e] * kk_[e];
                kp_[e] = k * (1.f + (a_[e] - 1.f) * cka[e]); rk += r_[e] * kp_[e] * crk[e];
                G[s * 64 + cg * 8 + e] = ex(wl[w_]); }
            ss += dpp16<0xB1>(ss); ss += dpp16<0x4E>(ss); ss += dpp16<0x141>(ss);
            const float inv = 1.f / fmaxf(sqrtf(ss), 1e-12f);
#pragma unroll
            for (int e = 0; e < 8; ++e) { kk_[e] *= inv; b_[e] = kk_[e] * a_[e]; }
            rk += dpp16<0xB1>(rk); rk += dpp16<0x4E>(rk); rk += dpp16<0x141>(rk);
            if (cg == 0) I.RK[m * 8 + h] = rk;
        }
        CK_BAR();
        { const int ch = tid & 63, part = tid >> 6; float run = 0.f;
#pragma unroll
          for (int i = 0; i < 8; ++i) { run += G[(8 * part + i) * 64 + ch]; G[(8 * part + i) * 64 + ch] = run; }
          TOT[part * 64 + ch] = run; }
        CK_BAR();
        { const int ch = tid & 63, part = tid >> 6; float off = 0.f;
          for (int p = 0; p < part; ++p) off += TOT[p * 64 + ch];
#pragma unroll
          for (int i = 0; i < 8; ++i) G[(8 * part + i) * 64 + ch] += off; }
        CK_BAR();
        float glast[8];
        {
            unsigned pab[4], prb[4], pbb[4], pkb[4];
            float ab[8], rb[8], bb[8], kb[8], bt[8], kt[8];
            const float4 g0_ = *(const float4*)(G + s * 64 + cg * 8), g1_ = *(const float4*)(G + s * 64 + cg * 8 + 4);
            const int sm = (s > 0) ? s - 1 : 0; const float msk = (s > 0) ? 1.f : 0.f;
            const float4 m0_ = *(const float4*)(G + sm * 64 + cg * 8), m1_ = *(const float4*)(G + sm * 64 + cg * 8 + 4);
            const float4 l0_ = *(const float4*)(G + 63 * 64 + cg * 8), l1_ = *(const float4*)(G + 63 * 64 + cg * 8 + 4);
            const float gv_[8] = {g0_.x, g0_.y, g0_.z, g0_.w, g1_.x, g1_.y, g1_.z, g1_.w}, mv_[8] = {m0_.x, m0_.y, m0_.z, m0_.w, m1_.x, m1_.y, m1_.z, m1_.w}, lv_[8] = {l0_.x, l0_.y, l0_.z, l0_.w, l1_.x, l1_.y, l1_.z, l1_.w};
#pragma unroll
            for (int e = 0; e < 8; ++e) { const float g = gv_[e], gm1 = mv_[e] * msk, gL = lv_[e];
                glast[e] = gL;
                const float eg = __expf(g), eng = __expf(-g), egm = __expf(gm1), egl = __expf(gL - g);
                ab[e] = -kk_[e] * egm; rb[e] = r_[e] * eg; bb[e] = b_[e] * eng; kb[e] = kp_[e] * eng; bt[e] = b_[e] * egl; kt[e] = kp_[e] * egl; }
#pragma unroll
            for (int q = 0; q < 4; ++q) { pab[q] = pk2(ab[2 * q], ab[2 * q + 1]); prb[q] = pk2(rb[2 * q], rb[2 * q + 1]); pbb[q] = pk2(bb[2 * q], bb[2 * q + 1]); pkb[q] = pk2(kb[2 * q], kb[2 * q + 1]); }
            *(uint4*)(MAT(O_AB) + s * LD + cg * 8) = make_uint4(pab[0], pab[1], pab[2], pab[3]);
            *(uint4*)(MAT(O_RB) + s * LD + cg * 8) = make_uint4(prb[0], prb[1], prb[2], prb[3]);
            *(uint4*)(MAT(O_BB) + s * LD + cg * 8) = make_uint4(pbb[0], pbb[1], pbb[2], pbb[3]);
            *(uint4*)(MAT(O_KB) + s * LD + cg * 8) = make_uint4(pkb[0], pkb[1], pkb[2], pkb[3]);
#pragma unroll
            for (int e = 0; e < 8; ++e) { const int k = cg * 8 + e;
                MAT(O_AT)[k * LD + s] = f2bf(ab[e]); MAT(O_BT)[k * LD + s] = f2bf(bt[e]); MAT(O_KT)[k * LD + s] = f2bf(kt[e]); MAT(O_VT)[k * LD + s] = f2bf(v_[e]); }
        }
        CK_BAR();
        { const int itn = item + GN;
          if (itn < NB * 8 * (S / 64)) { const int c2 = itn & 127, h2 = (itn >> 7) & 7, b2 = itn >> 10, ch2 = h2 * 64 + cg * 8, t2 = c2 * 64 + s; const size_t m2 = (size_t)b2 * S + t2;
            const bf16* z = I.proj + m2 * DSHIFT + ch2;
            nx_r = *(const uint4*)(z); nx_k = *(const uint4*)(z + 512); nx_v = *(const uint4*)(z + 1024);
            nx_qr = make_uint4(0, 0, 0, 0); nx_qk = nx_qr; nx_qv = nx_qr;
            if (t2 > 0) { nx_qr = *(const uint4*)(z - DSHIFT); nx_qk = *(const uint4*)(z + 512 - DSHIFT); nx_qv = *(const uint4*)(z + 1024 - DSHIFT); }
            nx_a = *(const uint4*)(I.AA + m2 * 512 + ch2); nx_l = *(const uint4*)(I.LW + m2 * 512 + ch2); } }
        if (s == 63) {
#pragma unroll
            for (int e = 0; e < 8; ++e) TOT[cg * 8 + e] = __expf(glast[e]);
        }
        {
            const int mat = tid >> 7, row = (tid >> 2) & 31, chunk = tid & 3;
            *(uint4*)(MAT(O_NM + mat * MB) + row * LD + 32 + chunk * 8) = make_uint4(0, 0, 0, 0);
        }
        for (int task = wv; task < 12; task += 8) {
            const int mat = task / 3, tt = task % 3, st = (tt == 0) ? 0 : 1, jt = (tt == 2) ? 1 : 0;
            const bf16* Asrc = MAT((mat & 1) ? O_KB : O_BB) + 32 * jt * LD;
            const bf16* Bsrc = MAT((mat >> 1) ? O_RB : O_AB) + 32 * st * LD;
            f32x16 acc = mm_tile<64>(zero16(), Asrc, LD, Bsrc, LD, lane);
            const int cs = 32 * st + (lane & 31), hh = lane >> 5; const bool incl = (mat >> 1) != 0;
#pragma unroll
            for (int rg = 0; rg < 16; ++rg) { const int j = 32 * jt + crow(rg, hh); const bool keep = incl ? (j <= cs) : (j < cs); if (!keep) acc[rg] = 0.f; }
            store_tr(acc, MAT(O_NM + mat * MB) + 32 * st * LD + 32 * jt, LD, lane);
            if (mat == 0 && st == jt) {
                float* d = NMF + st * 1024 + (lane & 31) * 32;
#pragma unroll
                for (int g = 0; g < 4; ++g) *(float4*)(d + 8 * g + 4 * hh) = make_float4(acc[4 * g], acc[4 * g + 1], acc[4 * g + 2], acc[4 * g + 3]);
            }
        }
        CK_BAR();
        if (wv == 0) {
            const int d = lane >> 4, cc = lane & 15;
            const float* nb = NMF + (d >> 1) * 1024 + (16 * (d & 1)) * 32 + 16 * (d & 1);
            float T[16];
#pragma unroll
            for (int i = 0; i < 16; ++i) {
                float acc = (i == cc) ? 1.f : 0.f;
#pragma unroll
                for (int j4 = 0; j4 < i; j4 += 4) { const float4 n4 = *(const float4*)(nb + i * 32 + j4);
                    acc += n4.x * T[j4]; if (j4 + 1 < i) acc += n4.y * T[j4 + 1]; if (j4 + 2 < i) acc += n4.z * T[j4 + 2]; if (j4 + 3 < i) acc += n4.w * T[j4 + 3]; }
                T[i] = acc;
            }
            bf16* tm = MAT(O_TM) + (16 * d) * LD + 16 * d + cc;
#pragma unroll
            for (int i = 0; i < 16; ++i) tm[i * LD] = f2bf(T[i]);
            bf16* tt = MAT(O_TT) + (d >> 1) * 32 * 40 + (16 * (d & 1) + cc) * 40 + 16 * (d & 1);
            *(uint4*)(tt) = make_uint4(pk2(T[0], T[1]), pk2(T[2], T[3]), pk2(T[4], T[5]), pk2(T[6], T[7]));
            *(uint4*)(tt + 8) = make_uint4(pk2(T[8], T[9]), pk2(T[10], T[11]), pk2(T[12], T[13]), pk2(T[14], T[15]));
            { const int blk = lane >> 5, r16 = (lane >> 1) & 15, hf = lane & 1;
              *(uint4*)(MAT(O_TM) + (32 * blk + r16) * LD + 32 * blk + 16 + 8 * hf) = make_uint4(0, 0, 0, 0);
              *(uint4*)(MAT(O_TT) + blk * 32 * 40 + (16 + r16) * 40 + 8 * hf) = make_uint4(0, 0, 0, 0); }
        } else if (wv == 1) {
            const int row = lane >> 1, half = lane & 1;
            *(uint4*)(MAT(O_TM) + row * LD + 32 + half * 16) = make_uint4(0, 0, 0, 0); *(uint4*)(MAT(O_TM) + row * LD + 32 + half * 16 + 8) = make_uint4(0, 0, 0, 0);
        } else if (wv >= 4) {
            const int st = (wv - 4) >> 1, vt = (wv - 4) & 1;
            f32x16 acc = mm_tile<64>(zero16(), MAT(O_AAK) + 32 * st * LD, LD, MAT(O_VT) + 32 * vt * LD, LD, lane);
            store_tr(acc, MAT(O_W1T) + 32 * vt * LD + 32 * st, LD, lane);
        }
        CK_BAR();
        if (wv < 2) {
            typedef float f32x4v __attribute__((ext_vector_type(4)));
            const int blk = wv, fr = lane & 15, fq = lane >> 4;
            const bf16x8 zf = (bf16x8){0, 0, 0, 0, 0, 0, 0, 0};
            bf16x8 a = zf, bq = zf;
            if (fq < 2) { a = *(const bf16x8*)(MAT(O_NM) + (32 * blk + 16 + fr) * LD + 32 * blk + 8 * fq); bq = *(const bf16x8*)(MAT(O_TT) + blk * 32 * 40 + fr * 40 + 8 * fq); }
            f32x4v z = __builtin_amdgcn_mfma_f32_16x16x32_bf16(a, bq, (f32x4v){0.f, 0.f, 0.f, 0.f}, 0, 0, 0);
            bf16* zt = MAT(O_ZT) + blk * 16 * 24;
            { uint2 w; w.x = cvtpk(z[0], z[1]); w.y = cvtpk(z[2], z[3]); *(uint2*)(zt + fr * 24 + 4 * fq) = w; }
            asm volatile("s_waitcnt lgkmcnt(0)" ::: "memory");
            a = zf; bq = zf;
            if (fq < 2) { a = *(const bf16x8*)(MAT(O_TM) + (32 * blk + 16 + fr) * LD + 32 * blk + 16 + 8 * fq); bq = *(const bf16x8*)(zt + fr * 24 + 8 * fq); }
            const f32x4v t21 = __builtin_amdgcn_mfma_f32_16x16x32_bf16(a, bq, (f32x4v){0.f, 0.f, 0.f, 0.f}, 0, 0, 0);
#pragma unroll
            for (int rg = 0; rg < 4; ++rg) MAT(O_TM)[(32 * blk + 16 + 4 * fq + rg) * LD + 32 * blk + fr] = f2bf(t21[rg]);
            { uint2 w; w.x = cvtpk(t21[0], t21[1]); w.y = cvtpk(t21[2], t21[3]); *(uint2*)(MAT(O_TT) + blk * 32 * 40 + fr * 40 + 16 + 4 * fq) = w; }
        }
        CK_BAR();
        if (wv == 0) { f32x16 acc = mm_tile<32>(zero16(), MAT(O_NM) + 32 * LD, LD, MAT(O_TT), 40, lane); store_tr(acc, MAT(O_ZT), 40, lane); }
        CK_BAR();
        if (wv == 0) { f32x16 acc = mm_tile<32>(zero16(), MAT(O_TM) + 32 * LD + 32, LD, MAT(O_ZT), 40, lane); store_rm(acc, MAT(O_TM) + 32 * LD, LD, lane); }
        CK_BAR();
        { const int st = wv >> 2, ct = wv & 3;
          f32x16 acc = mm_tile<64>(zero16(), MAT(O_TM) + 32 * st * LD, LD, MAT(O_AT) + 32 * ct * LD, LD, lane);
          CK_BAR();
          store_tr(acc, MAT(O_X1T) + 32 * ct * LD + 32 * st, LD, lane); }
        CK_BAR();
        for (int u = wv; u < 16; u += 8) {
            const int kind = u >> 2, t0 = (u >> 1) & 1, t1 = u & 1, hh = lane >> 5, cc = lane & 31;
            if (kind == 0) {
                f32x16 acc = mm_tile<64>(zero16(), MAT(O_BT) + 32 * t0 * LD, LD, MAT(O_X1T) + (64 + 32 * t1) * LD, LD, lane);
                acc = mm_tile<64>(acc, MAT(O_KT) + 32 * t0 * LD, LD, MAT(O_VT) + 32 * t1 * LD, LD, lane);
                store_frag16(acc, (bf16*)(out + 16384), t0, t1, lane);
            } else if (kind == 1) {
                f32x16 acc = mm_tile<64>(zero16(), MAT(O_ARB) + 32 * t0 * LD, LD, MAT(O_X1T) + (64 + 32 * t1) * LD, LD, lane);
                acc = mm_tile<64>(acc, MAT(O_ARK) + 32 * t0 * LD, LD, MAT(O_VT) + 32 * t1 * LD, LD, lane);
                store_frag16(acc, (bf16*)(out + 24576), t0, t1, lane);
            } else if (kind == 2) {
                f32x16 acc = mm_tile<64>(zero16(), MAT(O_X1T) + 32 * t0 * LD, LD, MAT(O_BT) + 32 * t1 * LD, LD, lane);
                const int k = 32 * t1 + cc; const float gl = TOT[k];
                bf16* d = (bf16*)out + k * 64 + 32 * t0;
#pragma unroll
                for (int g = 0; g < 4; ++g) { float x[4];
#pragma unroll
                    for (int e = 0; e < 4; ++e) { const int kp = 32 * t0 + 8 * g + 4 * hh + e; x[e] = acc[4 * g + e] + ((kp == k) ? gl : 0.f); }
                    uint2 w; w.x = cvtpk(x[0], x[1]); w.y = cvtpk(x[2], x[3]); *(uint2*)(d + 8 * g + 4 * hh) = w; }
            } else {
                f32x16 acc = mm_tile<64>(zero16(), MAT(O_X1T) + 32 * t0 * LD, LD, MAT(O_ARB) + 32 * t1 * LD, LD, lane);
                const int sq = 32 * t1 + cc;
                bf16* d = (bf16*)(out + 8192) + sq * 64 + 32 * t0;
                const bf16* rb = MAT(O_RB) + sq * LD + 32 * t0;
#pragma unroll
                for (int g = 0; g < 4; ++g) { const uint2 rr = *(const uint2*)(rb + 8 * g + 4 * hh);
                    const float x0 = acc[4 * g] + __builtin_bit_cast(float, rr.x << 16), x1 = acc[4 * g + 1] + __builtin_bit_cast(float, rr.x & 0xffff0000u);
                    const float x2 = acc[4 * g + 2] + __builtin_bit_cast(float, rr.y << 16), x3 = acc[4 * g + 3] + __builtin_bit_cast(float, rr.y & 0xffff0000u);
                    uint2 w; w.x = cvtpk(x0, x1); w.y = cvtpk(x2, x3); *(uint2*)(d + 8 * g + 4 * hh) = w; }
            }
        }
        CK_BAR();
    }
#undef MAT
}
typedef float f32x4w __attribute__((ext_vector_type(4)));
constexpr int P2_SLOT = 2 * 64 * LD * 2 + 4096;
__device__ __forceinline__ void phase2(const int WID_, const char* items, float* Y, char* lds) {
    const int wv = WID_;
    bf16* HT0 = (bf16*)lds; bf16* HT1 = HT0 + 16 * LD;
    char* SL = lds + 8192;
    for (int item = GB; item < NB * 8 * 4; item += GN) {
        const int lane = lane_id(), tid = wv * 64 + lane, fr = lane & 15, fq = lane >> 4;
        const int vq = (item >> 3) & 3, head = (item & 7) + 8 * (item >> 5), b = head >> 3, h = head & 7;
        for (int i = tid; i < 2 * 16 * LD / 8; i += NT) ((uint4*)lds)[i] = make_uint4(0, 0, 0, 0);
        const bool upd = wv < 4; const int rb = wv & 3;
        const char* rec0 = items + (size_t)(head * 128) * ITEM_BYTES;
        const size_t g_pq = (size_t)tid * 16;
        const int l_pq = (tid >> 3) * (LD * 2) + (tid & 7) * 16;
        const int piece = (tid >> 5) & 7;
        const size_t g_f = 16384 + (size_t)(piece >> 2) * 8192 + (((piece & 3) * 4 + vq) * 64) * 8 + (tid & 31) * 16;
        const int l_f = 2 * 64 * LD * 2 + piece * 512 + (tid & 31) * 16;
        float* yo = Y + ((size_t)b * S + 16 * rb + 4 * fq) * 512 + h * 64 + 16 * vq + fr;
        const int a_lds = (upd ? 0 : 64 * LD * 2) + (16 * rb + fr) * (LD * 2) + 16 * fq;
        const int c_lds = 2 * 64 * LD * 2 + ((upd ? 0 : 4) + rb) * 512 + lane * 8;
        uint4 rp0, rp1, rp2, rp3, rp4, rp5, rp6, rp7, rq0, rq1, rq2, rq3, rq4, rq5, rq6, rq7, rf0, rf1, rf2, rf3, rf4, rf5, rf6, rf7;
#define P2_LD(n, i) do { const char* rc_ = rec0 + (size_t)(i) * ITEM_BYTES; rp##n = *(const uint4*)(rc_ + g_pq); rq##n = *(const uint4*)(rc_ + 8192 + g_pq); rf##n = *(const uint4*)(rc_ + g_f); } while (0)
#define P2_ST(n, slot) do { char* s_ = SL + (slot) * P2_SLOT; *(uint4*)(s_ + l_pq) = rp##n; *(uint4*)(s_ + 64 * LD * 2 + l_pq) = rq##n; *(uint4*)(s_ + l_f) = rf##n; } while (0)
        P2_LD(0, 0); P2_LD(1, 1); P2_LD(2, 2); P2_LD(3, 3); P2_LD(4, 4); P2_LD(5, 5); P2_LD(6, 6); P2_LD(7, 7);
        P2_ST(0, 0); P2_LD(0, 8);
        CK_BAR();
#define P2_STEP(RN, cstep) do { const int c_ = (cstep); \
            const bf16* Hc = (c_ & 1) ? HT1 : HT0; bf16* Hn = (c_ & 1) ? HT0 : HT1; const char* sl_ = SL + (c_ & 1) * P2_SLOT; \
            const uint2 cv = *(const uint2*)(sl_ + c_lds); \
            f32x4w acc = (f32x4w){__builtin_bit_cast(float, cv.x << 16), __builtin_bit_cast(float, cv.x & 0xffff0000u), __builtin_bit_cast(float, cv.y << 16), __builtin_bit_cast(float, cv.y & 0xffff0000u)}; \
            const bf16x8 a0 = *(const bf16x8*)(sl_ + a_lds), a1 = *(const bf16x8*)(sl_ + a_lds + 64); \
            const bf16x8 b0 = *(const bf16x8*)(Hc + fr * LD + 8 * fq), b1 = *(const bf16x8*)(Hc + fr * LD + 32 + 8 * fq); \
            if (c_ + 1 < S / 64) P2_ST(RN, (c_ + 1) & 1); \
            if (c_ + 9 < S / 64) P2_LD(RN, c_ + 9); \
            acc = __builtin_amdgcn_mfma_f32_16x16x32_bf16(a0, b0, acc, 0, 0, 0); acc = __builtin_amdgcn_mfma_f32_16x16x32_bf16(a1, b1, acc, 0, 0, 0); \
            if (upd) { uint2 w; w.x = cvtpk(acc[0], acc[1]); w.y = cvtpk(acc[2], acc[3]); *(uint2*)(Hn + fr * LD + 16 * rb + 4 * fq) = w; } \
            else { float* y_ = yo + (size_t)c_ * 64 * 512; y_[0] = acc[0]; y_[512] = acc[1]; y_[1024] = acc[2]; y_[1536] = acc[3]; } \
            CK_BAR(); } while (0)
        for (int c = 0; c < S / 64; c += 8) {
            P2_STEP(1, c); P2_STEP(2, c + 1); P2_STEP(3, c + 2); P2_STEP(4, c + 3); P2_STEP(5, c + 4); P2_STEP(6, c + 5); P2_STEP(7, c + 6); P2_STEP(0, c + 7);
        }
#undef P2_STEP
#undef P2_LD
#undef P2_ST
    }
}
}

__device__ __forceinline__ void rwkv_post_ph(const int WID_, const float* __restrict__ Y, const float* __restrict__ RK, const bf16* __restrict__ proj, const float* __restrict__ mu, const bf16* __restrict__ G,
                             const float* __restrict__ lnw, const float* __restrict__ lnb, bf16* __restrict__ ymix) {
    const int lane = lane_id(), tk = WID_, grp = lane, ch0 = grp * 8, head = grp >> 3;
    const float4 mv0 = *(const float4*)(mu + 1024 + ch0), mv1 = *(const float4*)(mu + 1024 + ch0 + 4), lw0 = *(const float4*)(lnw + ch0), lw1 = *(const float4*)(lnw + ch0 + 4), lb0 = *(const float4*)(lnb + ch0), lb1 = *(const float4*)(lnb + ch0 + 4);
    const float muv[8] = {mv0.x, mv0.y, mv0.z, mv0.w, mv1.x, mv1.y, mv1.z, mv1.w}, lw_[8] = {lw0.x, lw0.y, lw0.z, lw0.w, lw1.x, lw1.y, lw1.z, lw1.w}, lb_[8] = {lb0.x, lb0.y, lb0.z, lb0.w, lb1.x, lb1.y, lb1.z, lb1.w};
    const int g_lo = GN == 256 ? (GB < 64 ? GB * 9 : 576 + ((GB - 64) * 3520) / 192) : (GB * (M / 16)) / GN;
    const int g_hi = GN == 256 ? (GB < 64 ? GB * 9 + 9 : 576 + ((GB - 63) * 3520) / 192) : ((GB + 1) * (M / 16)) / GN;
    for (int g = g_lo; g < g_hi; ++g) { const int m0 = g * 16 + tk;
        float4 ya[2], yb[2]; uint4 vv[2], pv[2], gg[2]; float rk[2];
#pragma unroll
        for (int u = 0; u < 2; ++u) { const int m = m0 + 8 * u;
            ya[u] = *(const float4*)(Y + (size_t)m * 512 + ch0); yb[u] = *(const float4*)(Y + (size_t)m * 512 + ch0 + 4);
            vv[u] = *(const uint4*)(proj + (size_t)m * DSHIFT + 1024 + ch0);
            pv[u] = (m & (S - 1)) ? *(const uint4*)(proj + (size_t)(m - 1) * DSHIFT + 1024 + ch0) : make_uint4(0, 0, 0, 0);
            gg[u] = *(const uint4*)(G + (size_t)m * 512 + ch0); rk[u] = RK[(size_t)m * 8 + head]; }
#pragma unroll
        for (int u = 0; u < 2; ++u) {
            const float y[8] = {ya[u].x, ya[u].y, ya[u].z, ya[u].w, yb[u].x, yb[u].y, yb[u].z, yb[u].w};
            float s = 0.f;
#pragma unroll
            for (int e = 0; e < 8; ++e) s += y[e];
            s += dpp16<0xB1>(s); s += dpp16<0x4E>(s); s += dpp16<0x141>(s);
            const float mean = s * (1.f / 64.f); float q = 0.f;
#pragma unroll
            for (int e = 0; e < 8; ++e) { const float d = y[e] - mean; q += d * d; }
            q += dpp16<0xB1>(q); q += dpp16<0x4E>(q); q += dpp16<0x141>(q);
            const float rstd = rsqrtf(q * (1.f / 64.f) + 64e-5f);
            const unsigned wv_[4] = {vv[u].x, vv[u].y, vv[u].z, vv[u].w}, wp_[4] = {pv[u].x, pv[u].y, pv[u].z, pv[u].w}, wg_[4] = {gg[u].x, gg[u].y, gg[u].z, gg[u].w};
            float o[8];
#pragma unroll
            for (int e = 0; e < 8; ++e) { const int w_ = e >> 1; const bool hi = e & 1;
                auto ex = [&](unsigned x) { return hi ? __builtin_bit_cast(float, x & 0xffff0000u) : __builtin_bit_cast(float, x << 16); };
                float v = ex(wv_[w_]); v += (ex(wp_[w_]) - v) * muv[e];
                o[e] = ((y[e] - mean) * rstd * lw_[e] + lb_[e] + rk[u] * v) * ex(wg_[w_]); }
            *(uint4*)(ymix + (size_t)(m0 + 8 * u) * D + ch0) = make_uint4(pk2(o[0], o[1]), pk2(o[2], o[3]), pk2(o[4], o[5]), pk2(o[6], o[7]));
        }
    }
}

constexpr int PSLOTS = NASSIGN + NEXP * 256;
constexpr int MAXTILES = PSLOTS / 256;
struct MoeBufs { int* tok_e; float* tok_g; int* tok_slot; int* slot_tok; float* slot_gate; int* bcnt; int* bbase; int* offs; int* tiles; int* ntiles; };
__device__ __forceinline__ void moe_zero_ph(const int WID_, const MoeBufs& mb) {
    for (int i = GB * NT + (WID_ * 64 + lane_id()); i < PSLOTS; i += GN * NT) { mb.slot_tok[i] = 0; mb.slot_gate[i] = 0.f; }
}
__device__ __forceinline__ void router_ph(const int WID_, const float* __restrict__ x3, const float* __restrict__ nw, bf16* __restrict__ h3, const float* __restrict__ wrg, const float* __restrict__ brg,
                          const float* __restrict__ wre, const float* __restrict__ bre, const MoeBufs& mb, char* lds, int tile) {
    const int lane = lane_id(), wv = WID_;
    int* lcnt = (int*)lds;
    _Float16* wg16 = (_Float16*)(lds + 256);
    _Float16* we16 = (_Float16*)(lds + 256 + 8192);
    float* bre_l = (float*)(lds + 128); float* brg_l = (float*)(lds + 256 + 8192 + 65536);
    if (wv == 0 && lane < 32) { lcnt[lane] = 0; bre_l[lane] = bre[lane]; if (lane < 4) brg_l[lane] = brg[lane]; }
    for (int i = wv * 64 + lane; i < 1024; i += NT) { const float4 w = *(const float4*)(wrg + i * 4);
        typedef _Float16 h4 __attribute__((ext_vector_type(4))); *(h4*)(wg16 + i * 4) = (h4){(_Float16)w.x, (_Float16)w.y, (_Float16)w.z, (_Float16)w.w}; }
    for (int i = wv * 64 + lane; i < 4 * 1024 * 2; i += NT) { const float4 w = *(const float4*)(wre + i * 4);
        typedef _Float16 h4 __attribute__((ext_vector_type(4))); *(h4*)(we16 + i * 4) = (h4){(_Float16)w.x, (_Float16)w.y, (_Float16)w.z, (_Float16)w.w}; }
    __syncthreads();
    typedef _Float16 h4 __attribute__((ext_vector_type(4)));
    typedef _Float16 h8 __attribute__((ext_vector_type(8)));
    float4 gw[4];
#pragma unroll
    for (int j = 0; j < 4; ++j) gw[j] = *(const float4*)(nw + (lane + 64 * j) * 4);
    float4 nx[4];
#pragma unroll
    for (int j = 0; j < 4; ++j) nx[j] = ((const float4*)(x3 + (size_t)(tile * 256 + wv) * D))[lane + 64 * j];
#pragma unroll
    for (int j = 0; j < 4; ++j) { pg8::pin4(gw[j]); pg8::pin4(nx[j]); }
    for (int m = tile * 256 + wv; m < tile * 256 + 256; m += 8) {
        float h[16]; float s = 0.f;
#pragma unroll
        for (int j = 0; j < 4; ++j) { const float4 v = nx[j]; h[4 * j] = v.x; h[4 * j + 1] = v.y; h[4 * j + 2] = v.z; h[4 * j + 3] = v.w; s += v.x * v.x + v.y * v.y + v.z * v.z + v.w * v.w; }
        { const int mn = min(m + 8, tile * 256 + 248 + wv); const float4* xr = (const float4*)(x3 + (size_t)mn * D);
#pragma unroll
          for (int j = 0; j < 4; ++j) nx[j] = xr[lane + 64 * j]; }
        s = wave_sum(s);
        const float rs = rsqrtf(s * (1.f / D) + 1e-6f);
        float l1[4] = {0.f, 0.f, 0.f, 0.f};
#pragma unroll
        for (int j = 0; j < 4; ++j) {
            const int k0 = (lane + 64 * j) * 4;
            const float4 g = gw[j];
            h[4 * j] *= rs * g.x; h[4 * j + 1] *= rs * g.y; h[4 * j + 2] *= rs * g.z; h[4 * j + 3] *= rs * g.w;
            uint2 o; o.x = pk2(h[4 * j], h[4 * j + 1]); o.y = pk2(h[4 * j + 2], h[4 * j + 3]);
            *(uint2*)(h3 + (size_t)m * D + k0) = o;
#pragma unroll
            for (int e = 0; e < 4; ++e) { const h4 w = *(const h4*)(wg16 + (k0 + e) * 4); const float x = h[4 * j + e];
                l1[0] += x * (float)w[0]; l1[1] += x * (float)w[1]; l1[2] += x * (float)w[2]; l1[3] += x * (float)w[3]; }
        }
#pragma unroll
        for (int i = 0; i < 4; ++i) l1[i] = wave_sum(l1[i]) + brg_l[i];
        int grp = 0; float best = l1[0];
#pragma unroll
        for (int i = 1; i < 4; ++i) if (l1[i] > best) { best = l1[i]; grp = i; }
        float se = 0.f;
#pragma unroll
        for (int i = 0; i < 4; ++i) se += __expf(l1[i] - best);
        const float g1 = 1.f / se;
        float l2[8] = {};
        const _Float16* we = we16 + (size_t)grp * D * 8;
#pragma unroll
        for (int j = 0; j < 4; ++j) {
            const int k0 = (lane + 64 * j) * 4;
#pragma unroll
            for (int e = 0; e < 4; ++e) { const float x = h[4 * j + e]; const h8 w = *(const h8*)(we + (k0 + e) * 8);
#pragma unroll
                for (int q = 0; q < 8; ++q) l2[q] += x * (float)w[q]; }
        }
#pragma unroll
        for (int i = 0; i < 8; ++i) l2[i] = wave_sum(l2[i]) + bre_l[grp * 8 + i];
        int i0 = 0; float v0 = l2[0];
#pragma unroll
        for (int i = 1; i < 8; ++i) if (l2[i] > v0) { v0 = l2[i]; i0 = i; }
        int i1 = -1; float v1 = -3.0e38f;
#pragma unroll
        for (int i = 0; i < 8; ++i) if (i != i0 && l2[i] > v1) { v1 = l2[i]; i1 = i; }
        const float e1 = __expf(v1 - v0), inv = 1.f / (1.f + e1);
        if (lane == 0) {
            const int ea = grp * 8 + i0, eb = grp * 8 + i1;
            mb.tok_e[2 * m] = ea; mb.tok_e[2 * m + 1] = eb;
            mb.tok_g[2 * m] = g1 * inv; mb.tok_g[2 * m + 1] = g1 * e1 * inv;
            atomicAdd(&lcnt[ea], 1); atomicAdd(&lcnt[eb], 1);
        }
    }
    __syncthreads();
    if (wv == 0 && lane < 32) mb.bcnt[tile * 32 + lane] = lcnt[lane];
    __syncthreads();
}
__device__ __forceinline__ void moe_plan_ph(const int WID_, const MoeBufs& mb, char* lds) {
    if (GB != 0) return;
    int* tot = (int*)lds; int* off = tot + 32;
    const int t = WID_ * 64 + lane_id();
    if (t < 32) { int run = 0; for (int b = 0; b < M / 256; ++b) { const int c = __hip_atomic_load(mb.bcnt + b * 32 + t, __ATOMIC_RELAXED, __HIP_MEMORY_SCOPE_AGENT); mb.bbase[b * 32 + t] = run; run += c; } tot[t] = run; }
    __syncthreads();
    if (t == 0) { int o = 0, nt = 0;
        for (int e = 0; e < NEXP; ++e) { off[e] = o; mb.offs[e] = o; const int c = tot[e]; for (int r0 = 0; r0 < c; r0 += 256) { mb.tiles[nt] = e; ++nt; } o += ((c + 255) / 256) * 256; }
        *mb.ntiles = nt; }
    __syncthreads();
}
__device__ __forceinline__ void moe_scatter_ph(const int WID_, const MoeBufs& mb, char* lds) {
    const int lane = lane_id(), wv = WID_;
    int* cur = (int*)lds;
    for (int tile = GB; tile < M / 256; tile += GN) {
        __syncthreads();
        if (wv == 0 && lane < 32) cur[lane] = __hip_atomic_load(mb.offs + lane, __ATOMIC_RELAXED, __HIP_MEMORY_SCOPE_AGENT) + __hip_atomic_load(mb.bbase + tile * 32 + lane, __ATOMIC_RELAXED, __HIP_MEMORY_SCOPE_AGENT);
        __syncthreads();
        const int a = tile * 512 + wv * 64 + lane; const int e = mb.tok_e[a];
        const int pos = atomicAdd(&cur[e], 1);
        mb.slot_tok[pos] = a >> 1; mb.slot_gate[pos] = mb.tok_g[a]; mb.tok_slot[a] = pos;
    }
    __syncthreads();
}
__device__ __forceinline__ void moe_weights_ph(const int WID_, const float* __restrict__ wg, const float* __restrict__ wu, const float* __restrict__ wd, bf16* __restrict__ wgu_t, bf16* __restrict__ wd_t, char* lds, int vb, int nvb) {
    const int lane = (WID_ * 64 + lane_id()) & 63, wv = (WID_ * 64 + lane_id()) >> 6;
    float* scr = (float*)(lds + wv * 16384);
    constexpr int I_GU = 16 * 16;
    constexpr int I_D = 8 * 32;
    constexpr int NIT = NEXP * (2 * I_GU + I_D);
    for (int it = vb * 8 + wv; it < NIT; it += nvb * 8) {
        const int e = it / (2 * I_GU + I_D); int r = it % (2 * I_GU + I_D);
        if (r < 2 * I_GU) {
            const int up = r / I_GU; r %= I_GU;
            const int kb = r / 16, nb = r % 16;
            const int pn = nb / 4, nsub = nb % 4;
            const float* W = (up ? wu : wg) + (size_t)e * D * DEXP + nb * 32;
            transpose_item(W + (size_t)kb * 64 * DEXP, 64, 32, wgu_t, D, e * 1024 + pn * 256 + up * 128 + nsub * 32, kb * 64, scr, 0, lane, nullptr, DEXP);
        } else {
            r -= 2 * I_GU;
            const int kb = r / 32, nb = r % 32;
            const float* W = wd + (size_t)e * DEXP * D + nb * 32;
            transpose_item(W + (size_t)kb * 64 * D, 64, 32, wd_t, DEXP, e * 1024 + nb * 32, kb * 64, scr, 0, lane, nullptr, D);
        }
    }
}
__device__ __forceinline__ void final_ph(const int WID_, float* __restrict__ out, const bf16* __restrict__ yslot, const int* __restrict__ tok_slot, const float* __restrict__ w) {
    const int lane = lane_id(), wv = WID_;
    float4 g[4];
#pragma unroll
    for (int j = 0; j < 4; ++j) g[j] = *(const float4*)(w + (lane + 64 * j) * 4);
    for (int row0 = (GB * 8 + wv) * 2; row0 < M; row0 += GN * 16) {
        float4 v[2][4]; uint2 ya[2][4], yb[2][4];
#pragma unroll
        for (int r = 0; r < 2; ++r) { const int row = row0 + r;
            const float4* xr = (const float4*)(out + (size_t)row * D);
            const uint2* pa = (const uint2*)(yslot + (size_t)tok_slot[2 * row] * D);
            const uint2* pb = (const uint2*)(yslot + (size_t)tok_slot[2 * row + 1] * D);
#pragma unroll
            for (int j = 0; j < 4; ++j) { v[r][j] = xr[lane + 64 * j]; ya[r][j] = pa[lane + 64 * j]; yb[r][j] = pb[lane + 64 * j]; } }
#pragma unroll
        for (int r = 0; r < 2; ++r) { float s = 0.f;
#pragma unroll
            for (int j = 0; j < 4; ++j) { const uint2 a = ya[r][j], b = yb[r][j];
                v[r][j].x += __builtin_bit_cast(float, a.x << 16) + __builtin_bit_cast(float, b.x << 16);
                v[r][j].y += __builtin_bit_cast(float, a.x & 0xffff0000u) + __builtin_bit_cast(float, b.x & 0xffff0000u);
                v[r][j].z += __builtin_bit_cast(float, a.y << 16) + __builtin_bit_cast(float, b.y << 16);
                v[r][j].w += __builtin_bit_cast(float, a.y & 0xffff0000u) + __builtin_bit_cast(float, b.y & 0xffff0000u);
                s += v[r][j].x * v[r][j].x + v[r][j].y * v[r][j].y + v[r][j].z * v[r][j].z + v[r][j].w * v[r][j].w; }
            s = wave_sum(s);
            const float rs = rsqrtf(s * (1.f / D) + 1e-6f);
            float4* xo = (float4*)(out + (size_t)(row0 + r) * D);
#pragma unroll
            for (int j = 0; j < 4; ++j) xo[lane + 64 * j] = make_float4(v[r][j].x * rs * g[j].x, v[r][j].y * rs * g[j].y, v[r][j].z * rs * g[j].z, v[r][j].w * rs * g[j].w); }
    }
}

struct S5Tab { float* Kmat; bf16* BtA; bf16* BtB; };
__device__ __forceinline__ void s5_lam(const float* lam_re, const float* lam_im, const float* log_dt, int g, int n, float& a, float& w) {
    const float dt = __expf(log_dt[g]); a = lam_re[g * 64 + n] * dt; w = lam_im[g * 64 + n] * dt;
}
__device__ __forceinline__ void cexpj(float a, float w, float j, float& re, float& im) { const float e = __expf(a * j); float s, c; sincosf(w * j, &s, &c); re = e * c; im = e * s; }
__device__ __forceinline__ void s5_bbar(const float* lam_re, const float* lam_im, const float* log_dt, const float* b_re, const float* b_im, int g, int n, int h, float& br, float& bi) {
    float a, w; s5_lam(lam_re, lam_im, log_dt, g, n, a, w);
    float lbr, lbi; cexpj(a, w, 1.f, lbr, lbi);
    const float lr = lam_re[g * 64 + n], li = lam_im[g * 64 + n];
    const float nr = lbr - 1.f, ni = lbi, den = lr * lr + li * li;
    const float cr = (nr * lr + ni * li) / den, ci = (ni * lr - nr * li) / den;
    const float xr = b_re[(g * 64 + n) * 16 + h], xi = b_im[(g * 64 + n) * 16 + h];
    br = cr * xr - ci * xi; bi = cr * xi + ci * xr;
}
__device__ __forceinline__ void s5_tables0_ph(const int WID_, const float* lam_re, const float* lam_im, const float* log_dt, const float* b_re, const float* b_im, const float* c_re, const float* c_im, const S5Tab& T, char* lds) {
    float* PWR = (float*)lds; float* PWI = PWR + 64 * 34;
    float* BBR = PWI + 64 * 34; float* BBI = BBR + 64 * 16;
    float* CCR = BBI + 64 * 16; float* CCI = CCR + 16 * 64;
    const int tid = WID_ * 64 + lane_id();
    for (int item = GB; item < 32 * 8; item += GN) {
        const int g = item & 31, part = item >> 5;
        __syncthreads();
        for (int i = tid; i < 64 * 34; i += NT) { const int n = i / 34, j = i % 34; float a, w; s5_lam(lam_re, lam_im, log_dt, g, n, a, w); float pr, pi; cexpj(a, w, (float)j, pr, pi); PWR[i] = pr; PWI[i] = pi; }
        for (int i = tid; i < 64 * 16; i += NT) { const int n = i >> 4, h = i & 15; float br, bi; s5_bbar(lam_re, lam_im, log_dt, b_re, b_im, g, n, h, br, bi); BBR[i] = br; BBI[i] = bi;
            const int hp = i >> 6, n2 = i & 63; CCR[i] = c_re[(g * 16 + hp) * 64 + n2]; CCI[i] = c_im[(g * 16 + hp) * 64 + n2]; }
        __syncthreads();
        for (int i = tid; i < 4 * 256; i += NT) { const int h = i & 15, hp = (i >> 4) & 15, j = 4 * part + (i >> 8);
            float acc = 0.f;
            for (int n = 0; n < 64; ++n) { const float pr = PWR[n * 34 + j], pi = PWI[n * 34 + j], br = BBR[n * 16 + h], bi = BBI[n * 16 + h];
                const float tr = pr * br - pi * bi, ti = pr * bi + pi * br; acc += CCR[hp * 64 + n] * tr - CCI[hp * 64 + n] * ti; }
            T.Kmat[((g * 32 + j) * 16 + hp) * 16 + h] = acc; }
        for (int i = tid; i < 32 * 512; i += NT) { const int col = i & 511, r = 32 * part + (i >> 9); float v = 0.f;
            if (r < 128) { const int n = r & 63, s = col >> 4, h = col & 15; const float pr = PWR[n * 34 + (S5L - 1 - s)], pi = PWI[n * 34 + (S5L - 1 - s)], br = BBR[n * 16 + h], bi = BBI[n * 16 + h];
                v = (r < 64) ? (pr * br - pi * bi) : (pr * bi + pi * br); }
            T.BtA[((size_t)g * 768 + 512 + r) * 512 + col] = f2bf(v); }
        for (int i = tid; i < 64 * 256; i += NT) { const int k = i & 255, row = 64 * part + (i >> 8); float v = 0.f;
            if (k < 128) { const int n = k & 63, sp = row >> 4, hp = row & 15; const float pr = PWR[n * 34 + sp + 1], pi = PWI[n * 34 + sp + 1], cr = CCR[hp * 64 + n], ci = CCI[hp * 64 + n];
                v = (k < 64) ? (cr * pr - ci * pi) : -(cr * pi + ci * pr); }
            T.BtB[((size_t)g * 512 + row) * 256 + k] = f2bf(v); }
    }
    __syncthreads();
}
__device__ __forceinline__ void s5_tables1_ph(const int WID_, const float* dsk, const S5Tab& T) {
    const int gtid = GB * NT + (WID_ * 64 + lane_id()), gsz = GN * NT;
    for (int i = gtid; i < 32 * 512 * 512; i += gsz) {
        const int col = i & 511, row = (i >> 9) & 511, g = i >> 18;
        const int sp = row >> 4, hp = row & 15, s = col >> 4, h = col & 15;
        float v = 0.f;
        if (s <= sp) v = T.Kmat[((g * 32 + (sp - s)) * 16 + hp) * 16 + h];
        if (row == col) v += dsk[g * 16 + hp];
        T.BtA[((size_t)g * 768 + row) * 512 + col] = f2bf(v);
    }
}
__device__ __forceinline__ void s5_carry_ph(const int WID_, const float* lam_re, const float* lam_im, const float* log_dt, const float* __restrict__ F, bf16* __restrict__ XST, int vb, int nvb, char* lds) {
    float* TR = (float*)lds; float* TI = TR + 16 * 32;
    for (int item = vb; item < NB * 32 * 2; item += nvb) {
        const int lane = lane_id(), tid = WID_ * 64 + lane;
        const int nh = item & 1, g = (item >> 1) & 31, b = item >> 6, seg = tid >> 5, n = nh * 32 + (tid & 31);
        float a, w; s5_lam(lam_re, lam_im, log_dt, g, n, a, w);
        float pr, pi; cexpj(a, w, (float)S5L, pr, pi);
        const size_t row0 = (size_t)g * S5R + (size_t)b * (S / S5L) + seg * 16;
        const float* f = F + row0 * 128; bf16* xo = XST + row0 * 256;
        float fr[16], fi[16];
#pragma unroll
        for (int q = 0; q < 16; ++q) { fr[q] = f[(size_t)q * 128 + n]; fi[q] = f[(size_t)q * 128 + 64 + n]; }
#pragma unroll
        for (int q = 0; q < 16; ++q) if (nh == 0) *(uint2*)(xo + (size_t)q * 256 + 128 + (tid & 31) * 4) = make_uint2(0, 0);
        float xr = 0.f, xi = 0.f;
#pragma unroll
        for (int q = 0; q < 16; ++q) { const float nr = pr * xr - pi * xi + fr[q], ni = pr * xi + pi * xr + fi[q]; xr = nr; xi = ni; fr[q] = nr; fi[q] = ni; }
        TR[seg * 32 + (tid & 31)] = xr; TI[seg * 32 + (tid & 31)] = xi;
        __syncthreads();
        float p16r, p16i; cexpj(a, w, (float)(S5L * 16), p16r, p16i);
        float cr = 0.f, ci = 0.f;
        for (int s2 = 0; s2 < seg; ++s2) { const float tr = TR[s2 * 32 + (tid & 31)], ti = TI[s2 * 32 + (tid & 31)];
            const float nr = p16r * cr - p16i * ci + tr, ni = p16r * ci + p16i * cr + ti; cr = nr; ci = ni; }
        float er = cr, ei = ci;
#pragma unroll
        for (int q = 0; q < 16; ++q) {
            const float lr_ = (q > 0) ? fr[q - 1] : 0.f, li_ = (q > 0) ? fi[q - 1] : 0.f;
            xo[(size_t)q * 256 + n] = f2bf(er + lr_); xo[(size_t)q * 256 + 64 + n] = f2bf(ei + li_);
            const float nr = pr * er - pi * ei, ni = pr * ei + pi * er; er = nr; ei = ni;
        }
        __syncthreads();
    }
}
#define XB_TMO      128
#define XB_XCNT(j)  (256  + 64 * (j))
#define XB_XSUB(j)  (1280 + 64 * (j))
#define XB_XGEN(j)  (2304 + 64 * (j))
#define XB_TOP      3328
#define XB_TOPGEN   3392
#define XCD_BAR_WORDS 3456
#define XB_SPIN_CAP (1u << 20)
__device__ __forceinline__ unsigned xb_ld(unsigned* p)              { return __hip_atomic_load(p, __ATOMIC_RELAXED, __HIP_MEMORY_SCOPE_AGENT); }
__device__ __forceinline__ unsigned xb_add(unsigned* p, unsigned v) { return __hip_atomic_fetch_add(p, v, __ATOMIC_RELAXED, __HIP_MEMORY_SCOPE_AGENT); }
__device__ __forceinline__ unsigned xb_xcc_id() { return (unsigned)__builtin_amdgcn_s_getreg((3 << 11) | 20) & 0xFu; }
#define XB_SPIN(cond, bar) do { unsigned _sp = 0; while (cond) { __builtin_amdgcn_s_sleep(1); \
    if ((++_sp & 255u) == 0u) { if (xb_ld(&(bar)[XB_TMO])) break; if (_sp > XB_SPIN_CAP) { atomicAdd(&(bar)[XB_TMO], 1u); break; } } } } while (0)
struct XcdBarrier { unsigned* bar; unsigned x; volatile __attribute__((address_space(3))) unsigned* st; };
__device__ __forceinline__ XcdBarrier xcd_barrier_post(const int WID_, unsigned* bar, volatile __attribute__((address_space(3))) unsigned* st) {
    XcdBarrier b; b.bar = bar; b.x = xb_xcc_id(); b.st = st;
    if ((WID_ * 64 + lane_id()) == 0) (void)xb_add(&bar[XB_XCNT(b.x)], 1u);
    return b;
}
__device__ __forceinline__ void xcd_barrier_complete(unsigned* bar, unsigned x, unsigned& nloc, unsigned& nx) {
    const unsigned G = gridDim.x * gridDim.y * gridDim.z;
    unsigned sum, cnt, mine, sp = 0u;
    for (;;) {
        sum = 0u; cnt = 0u; mine = 0u;
#pragma unroll
        for (unsigned j = 0; j < 16; ++j) { const unsigned c = xb_ld(&bar[XB_XCNT(j)]); sum += c; cnt += (c > 0u) ? 1u : 0u; mine = (j == x) ? c : mine; }
        if (sum == G) break;
        __builtin_amdgcn_s_sleep(1);
        if ((++sp & 255u) == 0u) { if (xb_ld(&bar[XB_TMO])) break; if (sp > XB_SPIN_CAP) { atomicAdd(&bar[XB_TMO], 1u); break; } }
    }
    nloc = mine > 0u ? mine : 1u; nx = cnt > 0u ? cnt : 1u;
}
__device__ __forceinline__ void xcd_barrier(const int WID_, const XcdBarrier& b) {
    asm volatile("s_waitcnt vmcnt(0)" ::: "memory");
    __syncthreads();
    if ((WID_ * 64 + lane_id()) == 0) {
        unsigned* bar = b.bar;
        __builtin_amdgcn_s_waitcnt(0);
        unsigned nloc = b.st[0], nx = b.st[1];
        if (nloc == 0u) { xcd_barrier_complete(bar, b.x, nloc, nx); b.st[0] = nloc; b.st[1] = nx; }
        const unsigned old = xb_add(&bar[XB_XSUB(b.x)], 1u);
        const unsigned gen = old / nloc;
        if (old + 1u == (gen + 1u) * nloc) {
            __builtin_amdgcn_fence(__ATOMIC_RELEASE, "agent");
            asm volatile("s_waitcnt vmcnt(0)" ::: "memory");
            const unsigned og = xb_add(&bar[XB_TOP], 1u);
            const unsigned tg = og / nx;
            if (og + 1u == (tg + 1u) * nx) xb_add(&bar[XB_TOPGEN], 1u);
            else XB_SPIN(xb_ld(&bar[XB_TOPGEN]) == tg, bar);
            __builtin_amdgcn_fence(__ATOMIC_ACQUIRE, "agent");
            xb_add(&bar[XB_XGEN(b.x)], 1u);
            asm volatile("s_waitcnt vmcnt(0)" ::: "memory");
        } else {
            XB_SPIN(xb_ld(&bar[XB_XGEN(b.x)]) == gen, bar);
            __builtin_amdgcn_fence(__ATOMIC_ACQUIRE, "agent");
            asm volatile("s_waitcnt vmcnt(0)" ::: "memory");
        }
    }
    __syncthreads();
}

struct Params { const float* in[41]; float* out; char* ws; };

constexpr size_t W_PROJ = 0;
constexpr size_t W_US5 = 224;
constexpr size_t W_WTS = 288;
constexpr size_t W_YI = 352;
constexpr size_t W_F = 416;
constexpr size_t W_XST = 448;
constexpr size_t W_Z = 480;
constexpr size_t W_MISC = 544;
constexpr size_t W_XN = 576;
constexpr size_t W_CTL = 558;
constexpr size_t WO_IN = 0, WO_GLU = 5 * MiB, WO_MIX = 6 * MiB, WO_Q = 8 * MiB, WO_K = 10 * MiB, WO_V = 12 * MiB, WO_O = 14 * MiB, WO_KMAT = 16 * MiB, WO_BTA = 17 * MiB, WO_BTB = 41 * MiB;

__global__ void __launch_bounds__(NT, 2) fwd_kernel(Params p) {
    extern __shared__ __attribute__((aligned(16))) char lds[];
    const int WID_ = __builtin_amdgcn_readfirstlane((int)(threadIdx.x >> 6));
    cg::grid_group grid = cg::this_grid();
    PG8_LAS unsigned char* ldsl = (PG8_LAS unsigned char*)lds;
    char* ws = p.ws; char* dout = (char*)p.out; float* out = p.out;
#define IN(i) (p.in[i])
    volatile __attribute__((address_space(3))) unsigned* bst = (volatile __attribute__((address_space(3))) unsigned*)(ldsl + LDS_BYTES - 64);
    if (WID_ == 0 && lane_id() < 2) bst[lane_id()] = 0u;
    __syncthreads();
    const XcdBarrier xbar = xcd_barrier_post(WID_, (unsigned*)(ws + W_CTL * MiB), bst);
#ifndef PROBE_PHASE
#define PROBE_PHASE -1
#endif
    int sync_id = 0; unsigned long long pr_t0 = 0, pr_t1 = 0;
    if (PROBE_PHASE == 0) pr_t0 = __builtin_amdgcn_s_memrealtime();
#define SYNC() do { xcd_barrier(WID_, xbar); ++sync_id; if (sync_id == PROBE_PHASE) pr_t0 = __builtin_amdgcn_s_memrealtime(); if (sync_id == PROBE_PHASE + 1) pr_t1 = __builtin_amdgcn_s_memrealtime(); } while (0)
    char* WT = ws + W_WTS * MiB;
    bf16* w_in_t = (bf16*)(WT + WO_IN); bf16* w_glu_t = (bf16*)(WT + WO_GLU); bf16* w_mix_t = (bf16*)(WT + WO_MIX);
    bf16* w_q_t = (bf16*)(WT + WO_Q); bf16* w_k_t = (bf16*)(WT + WO_K); bf16* w_v_t = (bf16*)(WT + WO_V); bf16* w_o_t = (bf16*)(WT + WO_O);
    S5Tab stab; stab.Kmat = (float*)(WT + WO_KMAT); stab.BtA = (bf16*)(WT + WO_BTA); stab.BtB = (bf16*)(WT + WO_BTB);
    bf16* PROJ = (bf16*)(ws + W_PROJ * MiB); bf16* US5 = (bf16*)(ws + W_US5 * MiB);
    bf16* XN = (bf16*)(ws + W_XN * MiB);
    transpose_ph(WID_, IN(3), D, DIN, w_in_t, D, 0, 0, lds);
    transpose_ph(WID_, IN(23), 512, 512, w_glu_t, 512, 0, 0, lds);
    transpose_ph(WID_, IN(25), D, D, w_mix_t, D, 0, 0, lds);
    transpose_ph(WID_, IN(28), D, D, w_q_t, D, 0, 0, lds, IN(26));
    transpose_ph(WID_, IN(29), D, D, w_k_t, D, 0, 0, lds);
    transpose_ph(WID_, IN(30), D, D, w_v_t, D, 0, 0, lds);
    transpose_ph(WID_, IN(31), D, D, w_o_t, D, 0, 0, lds);
    s5_tables0_ph(WID_, IN(15), IN(16), IN(17), IN(18), IN(19), IN(20), IN(21), stab, lds);
    bf16* wl_t = (bf16*)(WT + 49 * MiB);
    rwkv_wl_ph(WID_, IN(6), IN(8), IN(9), wl_t);
    rmsnorm_ph<bf16>(WID_, IN(0), IN(2), XN, M);
    bf16* MEMN = (bf16*)(ws + (W_MISC + 10) * MiB);
    rmsnorm_ph<bf16>(WID_, IN(1), IN(27), MEMN, NB * NMEM);
    grid.sync(); ++sync_id; if (sync_id == PROBE_PHASE) pr_t0 = __builtin_amdgcn_s_memrealtime(); if (sync_id == PROBE_PHASE + 1) pr_t1 = __builtin_amdgcn_s_memrealtime();
    s5_tables1_ph(WID_, IN(22), stab);
    { pg8::PlainOrder S; S.init(XN, D, w_in_t, D, M, DIN, D); pg8::EpiProj E{PROJ, US5}; pg8::gemm_phase(WID_, ldsl, S, E); }
    SYNC();
    bf16* LIN = (bf16*)(ws + (W_MISC + 16) * MiB);
    rwkv_lin_ph(WID_, PROJ, IN(4), LIN);
    SYNC();
    bf16* YI = (bf16*)(ws + W_YI * MiB); float* F = (float*)(ws + W_F * MiB); bf16* XST = (bf16*)(ws + W_XST * MiB); bf16* Z = (bf16*)(ws + W_Z * MiB);
    bf16* LWb = (bf16*)(ws + 704 * MiB); bf16* AAb = (bf16*)(ws + 768 * MiB); bf16* Gb = (bf16*)(ws + 832 * MiB);
    float* Yr = (float*)(ws + 896 * MiB); float* RKb = (float*)(ws + W_MISC * MiB);
    { pg8::GroupOrder S; S.init(US5, 512, (size_t)S5R * 512, stab.BtA, 512, (size_t)768 * 512, 32, S5R, 768, 512); pg8::EpiS5a E{YI, F}; pg8::gemm_phase(WID_, ldsl, S, E); }
    { pg8::PlainOrder S; S.init(LIN, 256, wl_t, 256, M, 1536, 256); pg8::EpiLora E{LWb, (size_t)32 * MiB, IN(5), IN(7)}; pg8::gemm_phase(WID_, ldsl, S, E); }
    SYNC();
    { ck::In ci{PROJ, LWb, AAb, IN(4), IN(10), IN(11), IN(12), RKb, dout}; ck::phase1(WID_, ci, lds); }
    SYNC();
    bf16* WGU_t = (bf16*)(ws + 704 * MiB); bf16* WD_t = (bf16*)(ws + 768 * MiB);
    ck::phase2(WID_, dout, Yr, lds);
    __syncthreads();
    s5_carry_ph(WID_, IN(15), IN(16), IN(17), F, XST, GB, GN, lds);
    moe_weights_ph(WID_, IN(37), IN(38), IN(39), WGU_t, WD_t, lds, GB, GN);
    SYNC();
    bf16* YMIX = XN;
    bf16* KM = (bf16*)(ws + (W_MISC + 2) * MiB); bf16* VT = (bf16*)(ws + (W_MISC + 6) * MiB);
    { pg8::GroupOrder S; S.init(XST, 256, (size_t)S5R * 256, stab.BtB, 256, (size_t)512 * 256, 32, S5R, 512, 256); pg8::EpiS5b E{YI, Z}; pg8::gemm_phase(WID_, ldsl, S, E); }
    { pg8::PlainOrder S; S.init(MEMN, D, w_k_t, D, NB * NMEM, D, D); pg8::EpiBf16 E{KM, D}; pg8::gemm_phase(WID_, ldsl, S, E); }
    { pg8::PlainOrder S; S.init(w_v_t, D, MEMN, D, D, NB * NMEM, D, 32); pg8::EpiBf16 E{VT, NB * NMEM}; pg8::gemm_phase(WID_, ldsl, S, E); }
    rwkv_post_ph(WID_, Yr, RKb, PROJ, IN(4), Gb, IN(13), IN(14), YMIX);
    SYNC();
    bf16* X2b = (bf16*)(ws + 0);
    PG8_LAS float* ssq = (PG8_LAS float*)(ldsl + 131072 + 8192);
    bf16* Q = (bf16*)(ws + 128 * MiB);
    bf16* P = (bf16*)(ws + W_YI * MiB);
    bf16* O = (bf16*)(ws + 800 * MiB);
    bf16* H3 = XN;
    bf16* HID = (bf16*)(ws + 368 * MiB);
    bf16* YSLOT = (bf16*)(ws + 0);
#define MKMB(mb) MoeBufs mb; { char* mbase = p.ws + 976 * MiB; \
    mb.tok_e = (int*)(mbase); mb.tok_g = (float*)(mbase + 1 * MiB); mb.tok_slot = (int*)(mbase + 2 * MiB); mb.slot_tok = (int*)(mbase + 3 * MiB); \
    mb.slot_gate = (float*)(mbase + 4 * MiB); mb.bcnt = (int*)(mbase + 5 * MiB); mb.bbase = mb.bcnt + 16384; mb.offs = mb.bcnt + 32768; mb.ntiles = mb.offs + 64; \
    mb.tiles = (int*)(mbase + 6 * MiB); }
    { MKMB(mb); moe_zero_ph(WID_, mb); }
#define BLK_SYNC() do { asm volatile("s_waitcnt vmcnt(0)" ::: "memory"); __syncthreads(); \
        if (WID_ == 0 && lane_id() == 0) { __builtin_amdgcn_fence(__ATOMIC_ACQUIRE, "agent"); asm volatile("s_waitcnt vmcnt(0)" ::: "memory"); } __syncthreads(); } while (0)
    for (int tl = GB; tl < M / 256; tl += GN) {
        for (int i = WID_ * 64 + lane_id(); i < 1024; i += NT) ssq[i] = 0.f;
        { pg8::TileOrder S; S.init(Z, 512, w_glu_t, 512, 512, 2, tl); pg8::EpiGlu E{Z, IN(24), YMIX}; pg8::gemm_phase(WID_, ldsl, S, E); }
        BLK_SYNC();
        { pg8::TileOrder S; S.init(YMIX, D, w_mix_t, D, D, 4, tl); pg8::EpiMixRes E{X2b, IN(0), ssq}; pg8::gemm_phase(WID_, ldsl, S, E); }
        BLK_SYNC();
        { pg8::TileOrder S; S.init(X2b, D, w_q_t, D, D, 4, tl); pg8::EpiRowScale E{Q, ssq}; pg8::gemm_phase(WID_, ldsl, S, E); }
        BLK_SYNC();
        { pg8::AttnTileOrder S; S.init(Q, KM, D, 0, tl); pg8::EpiSoftmax E{P, (PG8_LAS float*)(ldsl + 131072)}; pg8::gemm_phase(WID_, ldsl, S, E); }
        BLK_SYNC();
        { pg8::AttnTileOrder S; S.init(P, VT, NB * NMEM, 1, tl); pg8::EpiAttnO E{O}; pg8::gemm_phase(WID_, ldsl, S, E); }
        BLK_SYNC();
        { pg8::TileOrder S; S.init(O, D, w_o_t, D, D, 4, tl); pg8::EpiResBf16 E{out, X2b}; pg8::gemm_phase(WID_, ldsl, S, E); }
        BLK_SYNC();
        { MKMB(mb); router_ph(WID_, p.out, IN(32), (bf16*)(p.ws + W_XN * MiB), IN(33), IN(34), IN(35), IN(36), mb, lds, tl); }
    }
    SYNC();
    { MKMB(mb); moe_plan_ph(WID_, mb, lds); }
    SYNC();
    { MKMB(mb); moe_scatter_ph(WID_, mb, lds); }
    MKMB(mb);
    SYNC();
    const int ntiles = __hip_atomic_load(mb.ntiles, __ATOMIC_RELAXED, __HIP_MEMORY_SCOPE_AGENT);
    { pg8::MoeOrderT<true> S; S.init(H3, D, WGU_t, D, D, mb.tiles, ntiles, 1024, mb.slot_tok); pg8::EpiSilu E{HID}; pg8::gemm_phase(WID_, ldsl, S, E); }
    SYNC();
    { pg8::MoeOrderT<false> S; S.init(HID, DEXP, WD_t, DEXP, DEXP, mb.tiles, ntiles, 1024, nullptr); pg8::EpiGate E{YSLOT, mb.slot_gate}; pg8::gemm_phase(WID_, ldsl, S, E); }
    SYNC();
    final_ph(WID_, out, YSLOT, mb.tok_slot, IN(40));
    if (PROBE_PHASE >= 0) {
        if (pr_t1 == 0) pr_t1 = __builtin_amdgcn_s_memrealtime();
        if (GB == 0) { const unsigned long long t_end = __builtin_amdgcn_s_memrealtime(), wait = 8ull * (pr_t1 - pr_t0);
            while (__builtin_amdgcn_s_memrealtime() - t_end < wait) __builtin_amdgcn_s_sleep(8); }
    }
}
}

extern "C" void kernel_launch(void* const* d_in, const int* in_sizes, int n_in, void* d_out, int out_size, void* d_ws, size_t ws_size, hipStream_t stream) {
    (void)in_sizes; (void)out_size; (void)ws_size;
    static int grid = 0;
    if (grid == 0) {
        int dev = 0, cus = 0, per_cu = 0;
        hipGetDevice(&dev);
        hipDeviceGetAttribute(&cus, hipDeviceAttributeMultiprocessorCount, dev);
        hipFuncSetAttribute((const void*)fwd_kernel, hipFuncAttributeMaxDynamicSharedMemorySize, LDS_BYTES);
        hipOccupancyMaxActiveBlocksPerMultiprocessor(&per_cu, (const void*)fwd_kernel, NT, LDS_BYTES);
        if (per_cu < 1) { fprintf(stderr, "occupancy query says %d blocks/CU\n", per_cu); per_cu = 1; }
        grid = cus * 1;
    }
    (void)hipMemsetAsync((char*)d_ws + W_CTL * MiB, 0, 16384, stream);
    Params p{};
    for (int i = 0; i < 41 && i < n_in; ++i) p.in[i] = (const float*)d_in[i];
    p.out = (float*)d_out; p.ws = (char*)d_ws;
    void* args[] = {&p};
    hipError_t e = hipLaunchCooperativeKernel((const void*)fwd_kernel, dim3(grid), dim3(NT), args, LDS_BYTES, stream);
    if (e != hipSuccess) fprintf(stderr, "cooperative launch failed: %s (grid %d)\n", hipGetErrorString(e), grid);
}
```

```cpp
#include <hip/hip_runtime.h>
#include <hip/hip_cooperative_groups.h>
#include <stdint.h>
#include <cstdio>
namespace cg = cooperative_groups;

namespace {
constexpr int NB = 8, S = 8192, D = 1024, M = NB * S;
constexpr int DR = 512, DSHIFT = 1792, DIN = 2304, NMEM = 256;
constexpr int NEXP = 32, DEXP = 512, NASSIGN = 2 * M;
constexpr size_t MiB = 1u << 20;
constexpr int NT = 512;
constexpr int S5L = 32, S5R = M / S5L;
constexpr int LDS_BYTES = 147456;
#define GB ((int)blockIdx.x)
#define GN ((int)gridDim.x)

typedef unsigned short bf16;
typedef float f32x2h __attribute__((ext_vector_type(2)));
typedef __bf16 bf16x2h __attribute__((ext_vector_type(2)));
__device__ __forceinline__ unsigned pk2(float lo, float hi) { const f32x2h v = {lo, hi}; const bf16x2h b = __builtin_convertvector(v, bf16x2h); return __builtin_bit_cast(unsigned, b); }
__device__ __forceinline__ bf16 f2bf(float f) { return (bf16)(pk2(f, f) & 0xffffu); }
__device__ __forceinline__ int lane_id() { int l; asm volatile("v_mbcnt_lo_u32_b32 %0, -1, 0\n\tv_mbcnt_hi_u32_b32 %0, -1, %0" : "=v"(l)); return l; }
__device__ __forceinline__ float bf2f(bf16 h) { return __builtin_bit_cast(float, (unsigned)h << 16); }

template <typename T> __device__ __forceinline__ float ldf(const T* p);
template <> __device__ __forceinline__ float ldf<float>(const float* p) { return *p; }
template <> __device__ __forceinline__ float ldf<bf16>(const bf16* p) { return bf2f(*p); }
template <typename T> __device__ __forceinline__ void stf(T* p, float v);
template <> __device__ __forceinline__ void stf<float>(float* p, float v) { *p = v; }
template <> __device__ __forceinline__ void stf<bf16>(bf16* p, float v) { *p = f2bf(v); }

template <int CTRL, int ROWMASK> __device__ __forceinline__ float dppf_(float x) { return __builtin_bit_cast(float, __builtin_amdgcn_update_dpp(0, __builtin_bit_cast(int, x), CTRL, ROWMASK, 0xf, false)); }
__device__ __forceinline__ float wave_sum(float v) {
    v += dppf_<0xB1, 0xf>(v); v += dppf_<0x4E, 0xf>(v); v += dppf_<0x141, 0xf>(v); v += dppf_<0x140, 0xf>(v);
    v += dppf_<0x142, 0xa>(v);
    v += dppf_<0x143, 0xc>(v);
    return __builtin_bit_cast(float, __builtin_amdgcn_readlane(__builtin_bit_cast(int, v), 63));
}
__device__ __forceinline__ float sigmoidf_(float x) { return 1.f / (1.f + __expf(-x)); }


__device__ __forceinline__ float gelu_tanh(float x) { return x * sigmoidf_(1.5957691216057308f * (x + 0.044715f * x * x * x)); }

namespace pg8 {
#define PG8_LAS __attribute__((address_space(3)))
typedef short bf16x8 __attribute__((ext_vector_type(8)));
typedef float f32x4 __attribute__((ext_vector_type(4)));
typedef unsigned u32x4 __attribute__((ext_vector_type(4)));
constexpr int BM = 256, BK = 64, HALF = 128, HTB = HALF * BK * 2, STAGE_BYTES = 8 * HTB, NXCD = 8, WGM = 8;
__device__ __forceinline__ int lds_byte(int r, int c) { const int st = (r >> 4) * 2 + (c >> 5), rr = r & 15, cc = c & 31, ob = rr * 64 + cc * 2; return st * 1024 + (ob ^ (((ob >> 9) & 1) << 5)); }
__device__ __forceinline__ void stage_rc(int b, int& R, int& C) { const int st = b / 1024, sb = b % 1024, swz = sb ^ (((sb >> 9) & 1) << 5); R = (st >> 1) * 16 + swz / 64; C = (st & 1) * 32 + (swz % 64) / 2; }
__device__ __forceinline__ int perm32(int rho) { const int n = rho >> 4, i = rho & 15; return 8 * (i >> 2) + 4 * n + (i & 3); }
struct Unit { int pm, pn; };
struct PlainOrder {
    static constexpr bool GATHER = false; __device__ __forceinline__ int grow(const Unit&, int) const { return 0; }
    const bf16* A; const bf16* Bt; int lda, ldb, K; int nM, nN, nwg, G, c;
    __device__ void init(const bf16* A_, int lda_, const bf16* Bt_, int ldb_, int M, int N, int K_, int coff = 0) { A = A_; Bt = Bt_; lda = lda_; ldb = ldb_; K = K_; nM = M / BM; nN = N / BM; nwg = nM * nN; G = GN; c = (GB + GN - coff % GN) % GN; }
    __device__ bool next(int i, Unit& u) const {
        const long L = (long)i * G + c; if (L >= nwg) return false;
        int wgid = (int)L; { const int q = nwg / NXCD, r = nwg % NXCD, xcd = wgid % NXCD, off = wgid / NXCD; wgid = (xcd < r ? xcd * (q + 1) : r * (q + 1) + (xcd - r) * q) + off; }
        const int nig = WGM * nN, gid = wgid / nig, fm = gid * WGM, gsz = (nM - fm) < WGM ? (nM - fm) : WGM;
        u.pm = fm + ((wgid % nig) % gsz); u.pn = (wgid % nig) / gsz; return true;
    }
    __device__ __forceinline__ const char* aptr(const Unit& u) const { return (const char*)(A + (size_t)u.pm * BM * lda); }
    __device__ __forceinline__ const char* bptr(const Unit& u) const { return (const char*)(Bt + (size_t)u.pn * BM * ldb); }
};
typedef float f32x2c __attribute__((ext_vector_type(2)));
typedef __bf16 bf16x2c __attribute__((ext_vector_type(2)));
__device__ __forceinline__ void pin4(float4& v) { asm volatile("" : "+v"(v.x), "+v"(v.y), "+v"(v.z), "+v"(v.w)); }
__device__ __forceinline__ unsigned cvt_pk_bf16(float lo, float hi) { const f32x2c v = {lo, hi}; const bf16x2c b = __builtin_convertvector(v, bf16x2c); return __builtin_bit_cast(unsigned, b); }

template <class Epi, class Sched>
__device__ __forceinline__ void gemm_phase(const int WID_, PG8_LAS unsigned char* lds, const Sched& S, const Epi& E) {
    const int tid = (WID_ * 64 + lane_id()), wid = __builtin_amdgcn_readfirstlane(tid >> 6), lane = tid & 63, wr = wid >> 2, wc = wid & 3, fr = lane & 15, fq = lane >> 4;
    const int K = S.K, nt = K / BK;
    unsigned voffA[2], voffB[2];
#pragma unroll
    for (int i = 0; i < 2; ++i) { int R, C; stage_rc(tid * 16 + i * 8192, R, C); const int Rb = Epi::PERM ? ((R & ~31) + perm32(R & 31)) : R;
        voffA[i] = (unsigned)(R * S.lda + C) * 2u; voffB[i] = (unsigned)(Rb * S.ldb + C) * 2u; }
    constexpr bool GA = Sched::GATHER;
    int gR[2], gC[2];
#pragma unroll
    for (int i = 0; i < 2; ++i) stage_rc(tid * 16 + i * 8192, gR[i], gC[i]);
    unsigned vgc[2][2] = {{0u, 0u}, {0u, 0u}}, vgn[2][2] = {{0u, 0u}, {0u, 0u}};
#define PG8_GOFF(dst, u) do { if constexpr (GA) { _Pragma("unroll") for (int h_ = 0; h_ < 2; ++h_) _Pragma("unroll") for (int i_ = 0; i_ < 2; ++i_) \
        dst[h_][i_] = (unsigned)(S.grow(u, h_ * HALF + gR[i_]) * S.lda + gC[i_]) * 2u; } } while (0)
    const size_t kstep = (size_t)(BK * 2);
    const size_t hstepA = GA ? 0 : (size_t)HALF * S.lda * 2, hstepB = (size_t)HALF * S.ldb * 2;
    const unsigned ldsw = (unsigned)wid * 1024u;
    const int aoff = lds_byte(wr * 64 + fr, fq * 8), boff = lds_byte(wc * 32 + fr, fq * 8);
#define PG8_SA(b, h) (((b) * 2 + (h)) * HTB)
#define PG8_SB(b, h) ((4 + (b) * 2 + (h)) * HTB)
#define PG8_STAGE(bufoff, gbase, voff) do { _Pragma("unroll") for (int _i = 0; _i < 2; ++_i) \
        __builtin_amdgcn_global_load_lds((const unsigned*)((const char*)(gbase) + (voff)[_i]), (PG8_LAS unsigned*)(lds + (bufoff) + ldsw + _i * 8192), 16, 0, 0); } while (0)
#define PG8_STAGE_A(bufoff, gbase, h, nx) do { _Pragma("unroll") for (int _i = 0; _i < 2; ++_i) { \
        const unsigned vo_ = GA ? ((nx) ? vgn[h][_i] : vgc[h][_i]) : voffA[_i]; \
        __builtin_amdgcn_global_load_lds((const unsigned*)((const char*)(gbase) + vo_), (PG8_LAS unsigned*)(lds + (bufoff) + ldsw + _i * 8192), 16, 0, 0); } } while (0)
#define PG8_LDA(dst, b, h) do { _Pragma("unroll") for (int m = 0; m < 4; ++m) _Pragma("unroll") for (int k = 0; k < 2; ++k) dst[m][k] = *(const PG8_LAS bf16x8*)(lds + PG8_SA(b, h) + aoff + m * 2048 + k * 1024); } while (0)
#define PG8_LDB(dst, b, h) do { _Pragma("unroll") for (int n = 0; n < 2; ++n) _Pragma("unroll") for (int k = 0; k < 2; ++k) dst[n][k] = *(const PG8_LAS bf16x8*)(lds + PG8_SB(b, h) + boff + n * 2048 + k * 1024); } while (0)
#define PG8_MMA(ai, bj, At, Bt) do { __builtin_amdgcn_s_setprio(1); _Pragma("unroll") for (int m = 0; m < 4; ++m) _Pragma("unroll") for (int n = 0; n < 2; ++n) _Pragma("unroll") for (int k = 0; k < 2; ++k) \
        acc[ai][bj][m][n] = __builtin_amdgcn_mfma_f32_16x16x32_bf16(Bt[n][k], At[m][k], acc[ai][bj][m][n], 0, 0, 0); __builtin_amdgcn_s_setprio(0); } while (0)
#define PG8_WAIT_V(n) asm volatile("s_waitcnt vmcnt(" #n ")" ::: "memory")
#define PG8_WAIT_L(n) asm volatile("s_waitcnt lgkmcnt(" #n ")" ::: "memory")
#define PG8_BAR __builtin_amdgcn_s_barrier()
#define PG8_SCHED __builtin_amdgcn_sched_barrier(0)
    Unit cur, nxt; int ui = 0;
    if (!S.next(0, cur)) return;
    f32x4 acc[2][2][4][2];
#pragma unroll
    for (int a = 0; a < 2; ++a)
#pragma unroll
        for (int b = 0; b < 2; ++b)
#pragma unroll
            for (int m = 0; m < 4; ++m)
#pragma unroll
                for (int n = 0; n < 2; ++n) acc[a][b][m][n] = (f32x4){0.f, 0.f, 0.f, 0.f};
    bf16x8 At[4][2], B0[2][2], B1[2][2];
    const char* cA = S.aptr(cur); const char* cB = S.bptr(cur);
    PG8_STAGE(PG8_SB(0, 0), cB, voffB); PG8_STAGE(PG8_SB(0, 1), cB + hstepB, voffB); PG8_GOFF(vgc, cur); PG8_STAGE_A(PG8_SA(0, 0), cA, 0, false); PG8_STAGE_A(PG8_SA(0, 1), cA + hstepA, 1, false);
    if (wr == 1) PG8_BAR;
    PG8_WAIT_V(2); PG8_BAR;
    PG8_STAGE(PG8_SB(1, 0), cB + kstep, voffB); PG8_STAGE_A(PG8_SA(1, 0), cA + kstep, 0, false); PG8_STAGE(PG8_SB(1, 1), cB + hstepB + kstep, voffB);
    PG8_WAIT_V(6); PG8_BAR;
    for (;;) {
        const bool has_next = S.next(ui + 1, nxt);
        const char* nA = has_next ? S.aptr(nxt) : cA; const char* nB = has_next ? S.bptr(nxt) : cB;
        if (has_next) PG8_GOFF(vgn, nxt); else { if constexpr (GA) { _Pragma("unroll") for (int h_ = 0; h_ < 2; ++h_) _Pragma("unroll") for (int i_ = 0; i_ < 2; ++i_) vgn[h_][i_] = vgc[h_][i_]; } }
        for (int t = 0; t < nt; t += 2) {
            const bool last = (t == nt - 2);
            const char* a1 = cA + (size_t)(t + 1) * kstep;
            const char* a2 = last ? nA : cA + (size_t)(t + 2) * kstep; const char* b2 = last ? nB : cB + (size_t)(t + 2) * kstep;
            const char* a3 = a2 + kstep; const char* b3 = b2 + kstep;
            PG8_LDB(B0, 0, 0); PG8_LDB(B1, 0, 1); PG8_SCHED; PG8_LDA(At, 0, 0); PG8_STAGE_A(PG8_SA(1, 1), a1 + hstepA, 1, false);
            PG8_WAIT_V(8); PG8_WAIT_L(0); PG8_BAR; PG8_MMA(0, 0, At, B0); PG8_MMA(0, 1, At, B1); PG8_BAR; PG8_SCHED;
            PG8_LDA(At, 0, 1); PG8_STAGE(PG8_SB(0, 0), b2, voffB); PG8_STAGE(PG8_SB(0, 1), b2 + hstepB, voffB); PG8_STAGE_A(PG8_SA(0, 0), a2, 0, last);
            PG8_WAIT_V(8); PG8_WAIT_L(0); PG8_BAR; PG8_MMA(1, 0, At, B0); PG8_MMA(1, 1, At, B1); PG8_BAR; PG8_SCHED;
            PG8_LDB(B0, 1, 0); PG8_LDB(B1, 1, 1); PG8_SCHED; PG8_LDA(At, 1, 0); PG8_STAGE_A(PG8_SA(0, 1), a2 + hstepA, 1, last);
            PG8_WAIT_V(8); PG8_WAIT_L(0); PG8_BAR; PG8_MMA(0, 0, At, B0); PG8_MMA(0, 1, At, B1); PG8_BAR; PG8_SCHED;
            PG8_LDA(At, 1, 1); PG8_STAGE(PG8_SB(1, 0), b3, voffB); PG8_STAGE(PG8_SB(1, 1), b3 + hstepB, voffB); PG8_STAGE_A(PG8_SA(1, 0), a3, 0, last);
            PG8_WAIT_V(8); PG8_WAIT_L(0); PG8_BAR; PG8_MMA(1, 0, At, B0); PG8_MMA(1, 1, At, B1); PG8_BAR; PG8_SCHED;
        }
        if (wr == 0) PG8_BAR;
        E(acc, cur, wr, wc, fr, fq);
        if (!has_next) break;
#pragma unroll
        for (int a = 0; a < 2; ++a)
#pragma unroll
            for (int b = 0; b < 2; ++b)
#pragma unroll
                for (int m = 0; m < 4; ++m)
#pragma unroll
                    for (int n = 0; n < 2; ++n) acc[a][b][m][n] = (f32x4){0.f, 0.f, 0.f, 0.f};
        cur = nxt; cA = nA; cB = nB; ++ui;
        if constexpr (GA) { _Pragma("unroll") for (int h_ = 0; h_ < 2; ++h_) _Pragma("unroll") for (int i_ = 0; i_ < 2; ++i_) vgc[h_][i_] = vgn[h_][i_]; }
        if (wr == 1) PG8_BAR;
    }
    PG8_WAIT_V(0);
    PG8_BAR;
#undef PG8_SA
#undef PG8_SB
#undef PG8_STAGE
#undef PG8_STAGE_A
#undef PG8_GOFF
#undef PG8_LDA
#undef PG8_LDB
#undef PG8_MMA
#undef PG8_WAIT_V
#undef PG8_WAIT_L
#undef PG8_BAR
#undef PG8_SCHED
}

struct EpiMixRes {
    static constexpr bool PERM = true;
    bf16* O; const float* R; PG8_LAS float* ss;
    __device__ __forceinline__ void operator()(const f32x4 (&acc)[2][2][4][2], const Unit& u, int wr, int wc, int fr, int fq) const {
        const int row0 = u.pm * BM + wr * 64 + fr, col0 = u.pn * BM + wc * 32 + 8 * fq;
#pragma unroll
        for (int ai = 0; ai < 2; ++ai)
#pragma unroll
            for (int m = 0; m < 4; ++m) { const size_t ro = (size_t)(row0 + ai * HALF + m * 16) * D + col0; float q = 0.f;
#pragma unroll
                for (int bj = 0; bj < 2; ++bj) { const f32x4 v0 = acc[ai][bj][m][0] + *(const f32x4*)(R + ro + bj * HALF), v1 = acc[ai][bj][m][1] + *(const f32x4*)(R + ro + bj * HALF + 4);
                    q += (v0[0] * v0[0] + v0[1] * v0[1]) + (v0[2] * v0[2] + v0[3] * v0[3]) + (v1[0] * v1[0] + v1[1] * v1[1]) + (v1[2] * v1[2] + v1[3] * v1[3]);
                    u32x4 w; w.x = cvt_pk_bf16(v0[0], v0[1]); w.y = cvt_pk_bf16(v0[2], v0[3]); w.z = cvt_pk_bf16(v1[0], v1[1]); w.w = cvt_pk_bf16(v1[2], v1[3]);
                    *(u32x4*)(O + ro + bj * HALF) = w; }
                q += __shfl_xor(q, 16); q += __shfl_xor(q, 32);
                if (fq == 0) { PG8_LAS float* sp = ss + (ai * HALF + wr * 64 + m * 16 + fr) * 4 + wc; *sp += q; } }
    }
};
struct EpiRowScale {
    static constexpr bool PERM = true;
    bf16* O; PG8_LAS const float* ss;
    __device__ __forceinline__ void operator()(const f32x4 (&acc)[2][2][4][2], const Unit& u, int wr, int wc, int fr, int fq) const {
        const int row0 = u.pm * BM + wr * 64 + fr, col0 = u.pn * BM + wc * 32 + 8 * fq;
#pragma unroll
        for (int ai = 0; ai < 2; ++ai)
#pragma unroll
            for (int m = 0; m < 4; ++m) { bf16* rowp = O + (size_t)(row0 + ai * HALF + m * 16) * D + col0;
                const f32x4 s4 = *(PG8_LAS const f32x4*)(ss + (ai * HALF + wr * 64 + m * 16 + fr) * 4);
                const float rs = rsqrtf(((s4[0] + s4[1]) + (s4[2] + s4[3])) * (1.f / D) + 1e-6f);
#pragma unroll
                for (int bj = 0; bj < 2; ++bj) { const f32x4 v0 = acc[ai][bj][m][0] * rs, v1 = acc[ai][bj][m][1] * rs;
                    u32x4 w; w.x = cvt_pk_bf16(v0[0], v0[1]); w.y = cvt_pk_bf16(v0[2], v0[3]); w.z = cvt_pk_bf16(v1[0], v1[1]); w.w = cvt_pk_bf16(v1[2], v1[3]);
                    *(u32x4*)(rowp + bj * HALF) = w; } }
    }
};
struct EpiResBf16 {
    static constexpr bool PERM = true;
    float* C; const bf16* R;
    __device__ __forceinline__ void operator()(const f32x4 (&acc)[2][2][4][2], const Unit& u, int wr, int wc, int fr, int fq) const {
        const int row0 = u.pm * BM + wr * 64 + fr, col0 = u.pn * BM + wc * 32 + 8 * fq;
#pragma unroll
        for (int ai = 0; ai < 2; ++ai)
#pragma unroll
            for (int m = 0; m < 4; ++m) { const size_t ro = (size_t)(row0 + ai * HALF + m * 16) * D + col0;
#pragma unroll
                for (int bj = 0; bj < 2; ++bj) { const u32x4 r = *(const u32x4*)(R + ro + bj * HALF);
                    f32x4 v0 = acc[ai][bj][m][0], v1 = acc[ai][bj][m][1];
                    v0[0] += __builtin_bit_cast(float, r.x << 16); v0[1] += __builtin_bit_cast(float, r.x & 0xffff0000u); v0[2] += __builtin_bit_cast(float, r.y << 16); v0[3] += __builtin_bit_cast(float, r.y & 0xffff0000u);
                    v1[0] += __builtin_bit_cast(float, r.z << 16); v1[1] += __builtin_bit_cast(float, r.z & 0xffff0000u); v1[2] += __builtin_bit_cast(float, r.w << 16); v1[3] += __builtin_bit_cast(float, r.w & 0xffff0000u);
                    *(f32x4*)(C + ro + bj * HALF) = v0; *(f32x4*)(C + ro + bj * HALF + 4) = v1; } }
    }
};
struct EpiF32 {
    static constexpr bool PERM = false;
    float* C; int ldc; const float* R; int ldr;
    __device__ __forceinline__ void operator()(const f32x4 (&acc)[2][2][4][2], const Unit& u, int wr, int wc, int fr, int fq) const {
        const int row0 = u.pm * BM + wr * 64 + fr, col0 = u.pn * BM + wc * 32 + 4 * fq;
#pragma unroll
        for (int ai = 0; ai < 2; ++ai)
#pragma unroll
            for (int m = 0; m < 4; ++m) { const size_t row = (size_t)(row0 + ai * HALF + m * 16);
#pragma unroll
                for (int bj = 0; bj < 2; ++bj)
#pragma unroll
                    for (int n = 0; n < 2; ++n) { const int col = col0 + bj * HALF + 16 * n; f32x4 v = acc[ai][bj][m][n];
                        if (R) v = v + *(const f32x4*)(R + row * ldr + col);
                        *(f32x4*)(C + row * ldc + col) = v; } }
    }
};
struct EpiBf16 {
    static constexpr bool PERM = true;
    bf16* O; int ldc;
    __device__ __forceinline__ void operator()(const f32x4 (&acc)[2][2][4][2], const Unit& u, int wr, int wc, int fr, int fq) const {
        const int row0 = u.pm * BM + wr * 64 + fr, col0 = u.pn * BM + wc * 32 + 8 * fq;
#pragma unroll
        for (int ai = 0; ai < 2; ++ai)
#pragma unroll
            for (int m = 0; m < 4; ++m) { bf16* rowp = O + (size_t)(row0 + ai * HALF + m * 16) * ldc + col0;
#pragma unroll
                for (int bj = 0; bj < 2; ++bj) { const f32x4 v0 = acc[ai][bj][m][0], v1 = acc[ai][bj][m][1];
                    u32x4 w; w.x = cvt_pk_bf16(v0[0], v0[1]); w.y = cvt_pk_bf16(v0[2], v0[3]); w.z = cvt_pk_bf16(v1[0], v1[1]); w.w = cvt_pk_bf16(v1[2], v1[3]);
                    *(u32x4*)(rowp + bj * HALF) = w; } }
    }
};
struct EpiGlu {
    static constexpr bool PERM = true;
    const bf16* Z; const float* bias; bf16* YM;
    __device__ __forceinline__ void operator()(const f32x4 (&acc)[2][2][4][2], const Unit& u, int wr, int wc, int fr, int fq) const {
        const int row0 = u.pm * BM + wr * 64 + fr, col0 = u.pn * BM + wc * 32 + 8 * fq;
#pragma unroll
        for (int ai = 0; ai < 2; ++ai)
#pragma unroll
            for (int m = 0; m < 4; ++m) { const size_t row = (size_t)(row0 + ai * HALF + m * 16);
#pragma unroll
                for (int bj = 0; bj < 2; ++bj) { const int col = col0 + bj * HALF;
                    const u32x4 zz = *(const u32x4*)(Z + row * 512 + col);
                    const f32x4 b0 = *(const f32x4*)(bias + col), b1 = *(const f32x4*)(bias + col + 4);
                    const f32x4 v0 = acc[ai][bj][m][0] + b0, v1 = acc[ai][bj][m][1] + b1;
                    float o[8]; const unsigned zw[4] = {zz.x, zz.y, zz.z, zz.w};
#pragma unroll
                    for (int q = 0; q < 4; ++q) { const float zl = __builtin_bit_cast(float, zw[q] << 16), zh = __builtin_bit_cast(float, zw[q] & 0xffff0000u);
                        const float al = (q < 2) ? v0[2 * q] : v1[2 * q - 4], ah = (q < 2) ? v0[2 * q + 1] : v1[2 * q - 3];
                        o[2 * q] = zl * sigmoidf_(al); o[2 * q + 1] = zh * sigmoidf_(ah); }
                    u32x4 w; w.x = cvt_pk_bf16(o[0], o[1]); w.y = cvt_pk_bf16(o[2], o[3]); w.z = cvt_pk_bf16(o[4], o[5]); w.w = cvt_pk_bf16(o[6], o[7]);
                    *(u32x4*)(YM + row * D + 512 + col) = w; } }
    }
};

template <bool GATHER_>
struct MoeOrderT {
    static constexpr bool GATHER = GATHER_;
    const bf16* A; const bf16* Bt; int lda, ldb, K; const int* tiles; const int* rows; int nunits, G, c; size_t bexp;
    __device__ void init(const bf16* A_, int lda_, const bf16* Bt_, int ldb_, int K_, const int* tiles_, int ntiles, size_t bexp_, const int* rows_) { A = A_; Bt = Bt_; lda = lda_; ldb = ldb_; K = K_; tiles = tiles_; rows = rows_; nunits = ntiles * 4; G = GN; c = GB; bexp = bexp_; }
    __device__ bool next(int i, Unit& u) const { const int L = i * G + c; if (L >= nunits) return false; u.pm = L >> 2; u.pn = L & 3; return true; }
    __device__ __forceinline__ const char* aptr(const Unit& u) const { return GATHER ? (const char*)A : (const char*)(A + (size_t)u.pm * BM * lda); }
    __device__ __forceinline__ int grow(const Unit& u, int r) const { return rows[u.pm * BM + r]; }
    __device__ __forceinline__ const char* bptr(const Unit& u) const { const int e = __hip_atomic_load(tiles + u.pm, __ATOMIC_RELAXED, __HIP_MEMORY_SCOPE_AGENT); return (const char*)(Bt + ((size_t)e * bexp + (size_t)u.pn * BM) * ldb); }
};
struct EpiSilu {
    static constexpr bool PERM = true;
    bf16* HID;
    __device__ __forceinline__ void operator()(const f32x4 (&acc)[2][2][4][2], const Unit& u, int wr, int wc, int fr, int fq) const {
        const int row0 = u.pm * BM + wr * 64 + fr, col0 = u.pn * HALF + wc * 32 + 8 * fq;
#pragma unroll
        for (int ai = 0; ai < 2; ++ai)
#pragma unroll
            for (int m = 0; m < 4; ++m) { const size_t row = (size_t)(row0 + ai * HALF + m * 16);
                float o[8];
#pragma unroll
                for (int n = 0; n < 2; ++n)
#pragma unroll
                    for (int q = 0; q < 4; ++q) { const float g = acc[ai][0][m][n][q], up = acc[ai][1][m][n][q]; o[4 * n + q] = g * sigmoidf_(g) * up; }
                u32x4 w; w.x = cvt_pk_bf16(o[0], o[1]); w.y = cvt_pk_bf16(o[2], o[3]); w.z = cvt_pk_bf16(o[4], o[5]); w.w = cvt_pk_bf16(o[6], o[7]);
                *(u32x4*)(HID + row * DEXP + col0) = w; }
    }
};
struct EpiGate {
    static constexpr bool PERM = true;
    bf16* Y; const float* gate;
    __device__ __forceinline__ void operator()(const f32x4 (&acc)[2][2][4][2], const Unit& u, int wr, int wc, int fr, int fq) const {
        const int row0 = u.pm * BM + wr * 64 + fr, col0 = u.pn * BM + wc * 32 + 8 * fq;
#pragma unroll
        for (int ai = 0; ai < 2; ++ai)
#pragma unroll
            for (int m = 0; m < 4; ++m) { const size_t row = (size_t)(row0 + ai * HALF + m * 16); const float gt = gate[row];
#pragma unroll
                for (int bj = 0; bj < 2; ++bj) { const f32x4 v0 = acc[ai][bj][m][0] * gt, v1 = acc[ai][bj][m][1] * gt;
                    u32x4 w; w.x = cvt_pk_bf16(v0[0], v0[1]); w.y = cvt_pk_bf16(v0[2], v0[3]); w.z = cvt_pk_bf16(v1[0], v1[1]); w.w = cvt_pk_bf16(v1[2], v1[3]);
                    *(u32x4*)(Y + row * D + col0 + bj * HALF) = w; } }
    }
};

struct EpiProj {
    static constexpr bool PERM = true;
    bf16* PROJ; bf16* US5;
    __device__ __forceinline__ void operator()(const f32x4 (&acc)[2][2][4][2], const Unit& u, int wr, int wc, int fr, int fq) const {
        const int row0 = u.pm * BM + wr * 64 + fr, col0 = u.pn * BM + wc * 32 + 8 * fq;
#pragma unroll
        for (int ai = 0; ai < 2; ++ai)
#pragma unroll
            for (int m = 0; m < 4; ++m) { const size_t row = (size_t)(row0 + ai * HALF + m * 16);
#pragma unroll
                for (int bj = 0; bj < 2; ++bj) { const f32x4 v0 = acc[ai][bj][m][0], v1 = acc[ai][bj][m][1]; const int col = col0 + bj * HALF;
                    u32x4 w; w.x = cvt_pk_bf16(v0[0], v0[1]); w.y = cvt_pk_bf16(v0[2], v0[3]); w.z = cvt_pk_bf16(v1[0], v1[1]); w.w = cvt_pk_bf16(v1[2], v1[3]);
                    if (col < DSHIFT) *(u32x4*)(PROJ + row * DSHIFT + col) = w;
                    else { const int cc = col - DSHIFT; *(u32x4*)(US5 + ((size_t)(cc >> 4) * M + row) * 16 + (cc & 15)) = w; } } }
    }
};
struct GroupOrder {
    static constexpr bool GATHER = false; __device__ __forceinline__ int grow(const Unit&, int) const { return 0; }
    const bf16* A; const bf16* Bt; int lda, ldb, K; int nM, nN, nunits, G, c; size_t sA, sB;
    __device__ void init(const bf16* A_, int lda_, size_t sA_, const bf16* Bt_, int ldb_, size_t sB_, int ngroups, int Mg, int Ng, int K_) {
        A = A_; Bt = Bt_; lda = lda_; ldb = ldb_; K = K_; sA = sA_; sB = sB_; nM = Mg / BM; nN = Ng / BM; nunits = ngroups * nM * nN; G = GN; c = GB; }
    __device__ bool next(int i, Unit& u) const { const int L = i * G + c; if (L >= nunits) return false; u.pn = L % nN; u.pm = L / nN; return true; }
    __device__ __forceinline__ const char* aptr(const Unit& u) const { const int g = u.pm / nM, pm = u.pm % nM; return (const char*)(A + (size_t)g * sA + (size_t)pm * BM * lda); }
    __device__ __forceinline__ const char* bptr(const Unit& u) const { const int g = u.pm / nM; return (const char*)(Bt + (size_t)g * sB + (size_t)u.pn * BM * ldb); }
};
struct EpiS5a {
    static constexpr bool PERM = false;
    bf16* YI; float* F;
    __device__ __forceinline__ void operator()(const f32x4 (&acc)[2][2][4][2], const Unit& u, int wr, int wc, int fr, int fq) const {
        const int row0 = u.pm * BM + wr * 64 + fr, col0 = u.pn * BM + wc * 32 + 4 * fq;
#pragma unroll
        for (int ai = 0; ai < 2; ++ai)
#pragma unroll
            for (int m = 0; m < 4; ++m) { const size_t row = (size_t)(row0 + ai * HALF + m * 16);
#pragma unroll
                for (int bj = 0; bj < 2; ++bj)
#pragma unroll
                    for (int n = 0; n < 2; ++n) { const int col = col0 + bj * HALF + 16 * n; const f32x4 v = acc[ai][bj][m][n];
                        if (col < 512) { uint2 w; w.x = cvt_pk_bf16(v[0], v[1]); w.y = cvt_pk_bf16(v[2], v[3]); *(uint2*)(YI + row * 512 + col) = w; }
                        else if (col < 640) *(f32x4*)(F + row * 128 + (col - 512)) = v; } }
    }
};
struct EpiS5b {
    static constexpr bool PERM = true;
    const bf16* YI; bf16* Z;
    __device__ __forceinline__ void operator()(const f32x4 (&acc)[2][2][4][2], const Unit& u, int wr, int wc, int fr, int fq) const {
        const int row0 = u.pm * BM + wr * 64 + fr, col0 = u.pn * BM + wc * 32 + 8 * fq;
#pragma unroll
        for (int ai = 0; ai < 2; ++ai)
#pragma unroll
            for (int m = 0; m < 4; ++m) { const int row = row0 + ai * HALF + m * 16; const int g = row / S5R, rl = row % S5R;
#pragma unroll
                for (int bj = 0; bj < 2; ++bj) { const int col = col0 + bj * HALF;
                    const u32x4 yi = *(const u32x4*)(YI + (size_t)row * 512 + col);
                    const unsigned yw[4] = {yi.x, yi.y, yi.z, yi.w};
                    const f32x4 v0 = acc[ai][bj][m][0], v1 = acc[ai][bj][m][1];
                    float o[8];
#pragma unroll
                    for (int q = 0; q < 4; ++q) { const float al = (q < 2) ? v0[2 * q] : v1[2 * q - 4], ah = (q < 2) ? v0[2 * q + 1] : v1[2 * q - 3];
                        o[2 * q] = gelu_tanh(al + __builtin_bit_cast(float, yw[q] << 16)); o[2 * q + 1] = gelu_tanh(ah + __builtin_bit_cast(float, yw[q] & 0xffff0000u)); }
                    u32x4 w; w.x = cvt_pk_bf16(o[0], o[1]); w.y = cvt_pk_bf16(o[2], o[3]); w.z = cvt_pk_bf16(o[4], o[5]); w.w = cvt_pk_bf16(o[6], o[7]);
                    const size_t tok = (size_t)rl * S5L + (col >> 4);
                    *(u32x4*)(Z + tok * 512 + g * 16 + (col & 15)) = w; } }
    }
};
struct AttnOrder {
    static constexpr bool GATHER = false; __device__ __forceinline__ int grow(const Unit&, int) const { return 0; }
    const bf16* A; const bf16* Bt; int lda, ldb, K; int G, c; int mode;
    __device__ void init(const bf16* A_, const bf16* Bt_, int ldb_, int mode_) { A = A_; Bt = Bt_; lda = D; ldb = ldb_; K = 256; G = GN; c = GB; mode = mode_; }
    __device__ bool next(int i, Unit& u) const { const int L = i * G + c; if (L >= NB * 4 * 32) return false; u.pn = L & 3; u.pm = L >> 2; return true; }
    __device__ __forceinline__ const char* aptr(const Unit& u) const { return (const char*)(A + (size_t)u.pm * BM * D + u.pn * 256); }
    __device__ __forceinline__ const char* bptr(const Unit& u) const { const int b = u.pm >> 5;
        return (const char*)(mode == 0 ? Bt + (size_t)b * 256 * ldb + u.pn * 256 : Bt + (size_t)u.pn * 256 * ldb + b * 256); }
};
struct EpiSoftmax {
    static constexpr bool PERM = true;
    bf16* P; PG8_LAS float* scr;
    __device__ __forceinline__ void operator()(f32x4 (&acc)[2][2][4][2], const Unit& u, int wr, int wc, int fr, int fq) const {
        const float SC = 0.0625f * 1.4426950408889634f;
        PG8_LAS float* smax = scr; PG8_LAS float* ssum = scr + 1024;
#pragma unroll
        for (int ai = 0; ai < 2; ++ai)
#pragma unroll
            for (int m = 0; m < 4; ++m) { float t = -3.0e38f;
#pragma unroll
                for (int bj = 0; bj < 2; ++bj)
#pragma unroll
                    for (int n = 0; n < 2; ++n) { const f32x4 v = acc[ai][bj][m][n]; t = fmaxf(t, fmaxf(fmaxf(v[0], v[1]), fmaxf(v[2], v[3]))); }
                t = fmaxf(t, __shfl_xor(t, 16)); t = fmaxf(t, __shfl_xor(t, 32));
                if (fq == 0) smax[(ai * HALF + wr * 64 + m * 16 + fr) * 4 + wc] = t; }
        asm volatile("s_waitcnt lgkmcnt(0)" ::: "memory"); __builtin_amdgcn_s_barrier(); asm volatile("" ::: "memory");
#pragma unroll
        for (int ai = 0; ai < 2; ++ai)
#pragma unroll
            for (int m = 0; m < 4; ++m) { const f32x4 q = *(const PG8_LAS f32x4*)(smax + (ai * HALF + wr * 64 + m * 16 + fr) * 4);
                const float mm = fmaxf(fmaxf(q[0], q[1]), fmaxf(q[2], q[3])) * SC; float s = 0.f;
#pragma unroll
                for (int bj = 0; bj < 2; ++bj)
#pragma unroll
                    for (int n = 0; n < 2; ++n)
#pragma unroll
                        for (int e = 0; e < 4; ++e) { const float p = __builtin_amdgcn_exp2f(acc[ai][bj][m][n][e] * SC - mm); acc[ai][bj][m][n][e] = p; s += p; }
                s += __shfl_xor(s, 16); s += __shfl_xor(s, 32);
                if (fq == 0) ssum[(ai * HALF + wr * 64 + m * 16 + fr) * 4 + wc] = s; }
        asm volatile("s_waitcnt lgkmcnt(0)" ::: "memory"); __builtin_amdgcn_s_barrier(); asm volatile("" ::: "memory");
        const int row0 = u.pm * BM + wr * 64 + fr, col0 = u.pn * 256 + wc * 32 + 8 * fq;
#pragma unroll
        for (int ai = 0; ai < 2; ++ai)
#pragma unroll
            for (int m = 0; m < 4; ++m) { const f32x4 q = *(const PG8_LAS f32x4*)(ssum + (ai * HALF + wr * 64 + m * 16 + fr) * 4);
                const float iv = 1.f / ((q[0] + q[1]) + (q[2] + q[3]));
                bf16* rowp = P + (size_t)(row0 + ai * HALF + m * 16) * D + col0;
#pragma unroll
                for (int bj = 0; bj < 2; ++bj) { const f32x4 v0 = acc[ai][bj][m][0] * iv, v1 = acc[ai][bj][m][1] * iv; u32x4 w;
                    w.x = cvt_pk_bf16(v0[0], v0[1]); w.y = cvt_pk_bf16(v0[2], v0[3]); w.z = cvt_pk_bf16(v1[0], v1[1]); w.w = cvt_pk_bf16(v1[2], v1[3]);
                    *(u32x4*)(rowp + bj * HALF) = w; } }
    }
};
struct EpiAttnO {
    static constexpr bool PERM = true;
    bf16* O;
    __device__ __forceinline__ void operator()(const f32x4 (&acc)[2][2][4][2], const Unit& u, int wr, int wc, int fr, int fq) const {
        const int row0 = u.pm * BM + wr * 64 + fr, col0 = u.pn * 256 + wc * 32 + 8 * fq;
#pragma unroll
        for (int ai = 0; ai < 2; ++ai)
#pragma unroll
            for (int m = 0; m < 4; ++m) { bf16* rowp = O + (size_t)(row0 + ai * HALF + m * 16) * D + col0;
#pragma unroll
                for (int bj = 0; bj < 2; ++bj) { const f32x4 v0 = acc[ai][bj][m][0], v1 = acc[ai][bj][m][1];
                    u32x4 w; w.x = cvt_pk_bf16(v0[0], v0[1]); w.y = cvt_pk_bf16(v0[2], v0[3]); w.z = cvt_pk_bf16(v1[0], v1[1]); w.w = cvt_pk_bf16(v1[2], v1[3]);
                    *(u32x4*)(rowp + bj * HALF) = w; } }
    }
};

struct EpiLora {
    static constexpr bool PERM = true;
    bf16* LW; size_t ostride; const float* w0; const float* a0;
    __device__ __forceinline__ void operator()(const f32x4 (&acc)[2][2][4][2], const Unit& u, int wr, int wc, int fr, int fq) const {
        const int row0 = u.pm * BM + wr * 64 + fr, col0 = u.pn * BM + wc * 32 + 8 * fq;
        const int kind = u.pn >> 1;
        bf16* O = LW + (size_t)kind * ostride;
#pragma unroll
        for (int bj = 0; bj < 2; ++bj) { const int col = (col0 + bj * HALF) & 511;
            f32x4 b0 = (f32x4){0.f, 0.f, 0.f, 0.f}, b1 = b0;
            if (kind == 0) { b0 = *(const f32x4*)(w0 + col); b1 = *(const f32x4*)(w0 + col + 4); }
            else if (kind == 1) { b0 = *(const f32x4*)(a0 + col); b1 = *(const f32x4*)(a0 + col + 4); }
#pragma unroll
            for (int ai = 0; ai < 2; ++ai)
#pragma unroll
                for (int m = 0; m < 4; ++m) { const size_t row = (size_t)(row0 + ai * HALF + m * 16);
                    const f32x4 v0 = acc[ai][bj][m][0] + b0, v1 = acc[ai][bj][m][1] + b1; float o[8];
#pragma unroll
                    for (int e = 0; e < 8; ++e) { float x = (e < 4) ? v0[e & 3] : v1[e & 3];
                        if (kind == 0) x = -0.6065306597126334f * sigmoidf_(x);
                        else if (kind == 1) x = sigmoidf_(x);
                        o[e] = x; }
                    u32x4 w; w.x = cvt_pk_bf16(o[0], o[1]); w.y = cvt_pk_bf16(o[2], o[3]); w.z = cvt_pk_bf16(o[4], o[5]); w.w = cvt_pk_bf16(o[6], o[7]);
                    *(u32x4*)(O + row * 512 + col) = w; } }
    }
};

struct TileOrder {
    static constexpr bool GATHER = false; __device__ __forceinline__ int grow(const Unit&, int) const { return 0; }
    const bf16* A; const bf16* Bt; int lda, ldb, K, nN, pm;
    __device__ void init(const bf16* A_, int lda_, const bf16* Bt_, int ldb_, int K_, int nN_, int pm_) { A = A_; Bt = Bt_; lda = lda_; ldb = ldb_; K = K_; nN = nN_; pm = pm_; }
    __device__ bool next(int i, Unit& u) const { if (i >= nN) return false; int pm_ = pm; asm volatile("" : "+s"(pm_)); u.pm = pm_; u.pn = (i + (GB >> 3)) & (nN - 1); return true; }
    __device__ __forceinline__ const char* aptr(const Unit& u) const { return (const char*)(A + (size_t)u.pm * BM * lda); }
    __device__ __forceinline__ const char* bptr(const Unit& u) const { return (const char*)(Bt + (size_t)u.pn * BM * ldb); }
};
struct AttnTileOrder {
    static constexpr bool GATHER = false; __device__ __forceinline__ int grow(const Unit&, int) const { return 0; }
    const bf16* A; const bf16* Bt; int lda, ldb, K, pm, mode;
    __device__ void init(const bf16* A_, const bf16* Bt_, int ldb_, int mode_, int pm_) { A = A_; Bt = Bt_; lda = D; ldb = ldb_; K = 256; mode = mode_; pm = pm_; }
    __device__ bool next(int i, Unit& u) const { if (i >= 4) return false; int pm_ = pm; asm volatile("" : "+s"(pm_)); u.pm = pm_; u.pn = (i + (GB >> 3)) & 3; return true; }
    __device__ __forceinline__ const char* aptr(const Unit& u) const { return (const char*)(A + (size_t)u.pm * BM * D + u.pn * 256); }
    __device__ __forceinline__ const char* bptr(const Unit& u) const { const int b = u.pm >> 5;
        return (const char*)(mode == 0 ? Bt + (size_t)b * 256 * ldb + u.pn * 256 : Bt + (size_t)u.pn * 256 * ldb + b * 256); }
};
}

#define LAS __attribute__((address_space(3)))
__device__ __forceinline__ void transpose_item(const float* __restrict__ W, int K, int N, bf16* __restrict__ WT, int ldt, int row_off, int col_off, float* scr, int item, int lane, const float* __restrict__ kscale, int ldw = 0) {
    if (ldw == 0) ldw = N;
    const int nblk = N / 32, kb = item / nblk, nb = item % nblk, k0 = 64 * kb, n0 = 32 * nb;
#pragma unroll 8
    for (int i = 0; i < 32; ++i) { const int kk = 2 * i + (lane >> 5); float v = W[(size_t)(k0 + kk) * ldw + n0 + (lane & 31)]; if (kscale) v *= kscale[k0 + kk]; scr[kk * 33 + (lane & 31)] = v; }
    __builtin_amdgcn_s_waitcnt(0xc07f); asm volatile("" ::: "memory");
    const int c = lane & 7;
#pragma unroll
    for (int j = 0; j < 4; ++j) { const int n = (lane >> 3) + 8 * j; const float* s = scr + (8 * c) * 33 + n;
        uint4 o; o.x = pk2(s[0 * 33], s[1 * 33]); o.y = pk2(s[2 * 33], s[3 * 33]); o.z = pk2(s[4 * 33], s[5 * 33]); o.w = pk2(s[6 * 33], s[7 * 33]);
        *(uint4*)(WT + (size_t)(row_off + n0 + n) * ldt + col_off + k0 + 8 * c) = o; }
    __builtin_amdgcn_s_waitcnt(0xc07f); asm volatile("" ::: "memory");
}
__device__ __forceinline__ void transpose_ph(const int WID_, const float* W, int K, int N, bf16* WT, int ldt, int row_off, int col_off, char* lds, const float* kscale = nullptr) {
    const int lane = (WID_ * 64 + lane_id()) & 63, wv = (WID_ * 64 + lane_id()) >> 6;
    float* scr = (float*)(lds + wv * 16384);
    const int nitems = (K / 64) * (N / 32);
    for (int it = GB * 8 + wv; it < nitems; it += GN * 8) transpose_item(W, K, N, WT, ldt, row_off, col_off, scr, it, lane, kscale);
}

template <typename TO>
__device__ __forceinline__ void rmsnorm_ph(const int WID_, const float* __restrict__ x, const float* __restrict__ w, TO* __restrict__ out, int rows, int row_lo = 0, int vb = GB, int nvb = GN) {
    const int lane = lane_id(), wv = WID_;
    float4 g[4];
#pragma unroll
    for (int j = 0; j < 4; ++j) g[j] = *(const float4*)(w + (lane + 64 * j) * 4);
    for (int row = row_lo + (vb * 8 + wv) * 2; row < rows; row += nvb * 16) {
        const float4* xr = (const float4*)(x + (size_t)row * D);
        float4 v[2][4]; float s[2] = {0.f, 0.f};
#pragma unroll
        for (int r = 0; r < 2; ++r)
#pragma unroll
            for (int j = 0; j < 4; ++j) v[r][j] = xr[r * (D / 4) + lane + 64 * j];
#pragma unroll
        for (int r = 0; r < 2; ++r) {
#pragma unroll
            for (int j = 0; j < 4; ++j) s[r] += v[r][j].x * v[r][j].x + v[r][j].y * v[r][j].y + v[r][j].z * v[r][j].z + v[r][j].w * v[r][j].w;
            s[r] = wave_sum(s[r]);
            const float rs = rsqrtf(s[r] * (1.f / D) + 1e-6f);
#pragma unroll
            for (int j = 0; j < 4; ++j) {
                uint2 o; o.x = pk2(v[r][j].x * rs * g[j].x, v[r][j].y * rs * g[j].y); o.y = pk2(v[r][j].z * rs * g[j].z, v[r][j].w * rs * g[j].w);
                *(uint2*)(out + (size_t)(row + r) * D + (lane + 64 * j) * 4) = o;
            }
        }
    }
}

__device__ __forceinline__ void rwkv_lin_ph(const int WID_, const bf16* __restrict__ proj, const float* __restrict__ mu, bf16* __restrict__ lin) {
    const int lane = lane_id(), wv = WID_;
    const float4 m4 = *(const float4*)(mu + 1536 + 4 * lane);
    const float mm[4] = {m4.x, m4.y, m4.z, m4.w};
    for (int m0 = (GB * 8 + wv) * 4; m0 < M; m0 += GN * 32) {
        uint2 z[4], zp[4];
#pragma unroll
        for (int i = 0; i < 4; ++i) { const int m = m0 + i; z[i] = *(const uint2*)(proj + (size_t)m * DSHIFT + 1536 + 4 * lane);
            zp[i] = make_uint2(0, 0); if ((m & (S - 1)) != 0) zp[i] = *(const uint2*)(proj + (size_t)(m - 1) * DSHIFT + 1536 + 4 * lane); }
#pragma unroll
        for (int i = 0; i < 4; ++i) {
            float c[4] = {__builtin_bit_cast(float, z[i].x << 16), __builtin_bit_cast(float, z[i].x & 0xffff0000u), __builtin_bit_cast(float, z[i].y << 16), __builtin_bit_cast(float, z[i].y & 0xffff0000u)};
            const float q[4] = {__builtin_bit_cast(float, zp[i].x << 16), __builtin_bit_cast(float, zp[i].x & 0xffff0000u), __builtin_bit_cast(float, zp[i].y << 16), __builtin_bit_cast(float, zp[i].y & 0xffff0000u)};
#pragma unroll
            for (int e = 0; e < 4; ++e) { float t = c[e] + (q[e] - c[e]) * mm[e];
                if (lane < 16) t = 1.f - 2.f / (1.f + __expf(2.f * t));
                else if (lane >= 32) t = sigmoidf_(t);
                c[e] = t; }
            uint2 o; o.x = pk2(c[0], c[1]); o.y = pk2(c[2], c[3]);
            *(uint2*)(lin + (size_t)(m0 + i) * 256 + 4 * lane) = o;
        }
    }
}
__device__ __forceinline__ void rwkv_wl_ph(const int WID_, const float* __restrict__ wdec, const float* __restrict__ wiclr, const float* __restrict__ wgate, bf16* __restrict__ wl) {
    for (int i = GB * NT + (WID_ * 64 + lane_id()); i < 1536 * 256; i += GN * NT) {
        const int k = i & 255, n = i >> 8; float v = 0.f;
        if (n < 512) { if (k < 64) v = wdec[k * 512 + n]; }
        else if (n < 1024) { if (k >= 64 && k < 128) v = wiclr[(k - 64) * 512 + (n - 512)]; }
        else { if (k >= 128) v = wgate[(k - 128) * 512 + (n - 1024)]; }
        wl[i] = f2bf(v);
    }
}
template <int CTRL> __device__ __forceinline__ float dpp16(float x) { return __builtin_bit_cast(float, __builtin_amdgcn_update_dpp(0, __builtin_bit_cast(int, x), CTRL, 0xf, 0xf, true)); }
constexpr int RW_ITEMS = NB * 8;

namespace ck {
#define CK_BAR() do { asm volatile("s_waitcnt lgkmcnt(0)" ::: "memory"); __builtin_amdgcn_s_barrier(); asm volatile("" ::: "memory"); } while (0)
typedef float f32x2_t __attribute__((ext_vector_type(2)));
typedef __bf16 bf16x2_t __attribute__((ext_vector_type(2)));
__device__ __forceinline__ unsigned cvtpk(float lo, float hi) { const f32x2_t v = {lo, hi}; const bf16x2_t b = __builtin_convertvector(v, bf16x2_t); return __builtin_bit_cast(unsigned, b); }
typedef short bf16x8 __attribute__((ext_vector_type(8)));
typedef float f32x16 __attribute__((ext_vector_type(16)));
constexpr int LD = 72;
constexpr int MB = 64 * LD * 2;
constexpr int O_AB = 0, O_RB = MB, O_BB = 2 * MB, O_KB = 3 * MB, O_AT = 4 * MB, O_W1T = 5 * MB, O_BT = 6 * MB, O_KT = 7 * MB, O_VT = 8 * MB,
              O_NM = 9 * MB, O_AAK = 10 * MB, O_ARB = 11 * MB, O_ARK = 12 * MB, O_G = 13 * MB, O_TOT = O_G + 16384;
constexpr int O_TM = O_AB, O_X1T = O_BB, O_NMF = O_G, O_TT = O_G + 8192, O_ZT = O_TT + 5120;
constexpr int ITEM_BYTES = 32768;
template <int K, typename PA, typename PB>
__device__ __forceinline__ f32x16 mm_tile(f32x16 acc, PA A, int lda, PB B, int ldb, int lane) {
    const int r = lane & 31, h = lane >> 5;
    bf16x8 a[K / 16], b[K / 16];
#pragma unroll
    for (int q = 0; q < K / 16; ++q) { a[q] = *(const bf16x8*)(A + r * lda + 16 * q + 8 * h); b[q] = *(const bf16x8*)(B + r * ldb + 16 * q + 8 * h); }
#pragma unroll
    for (int q = 0; q < K / 16; ++q) acc = __builtin_amdgcn_mfma_f32_32x32x16_bf16(a[q], b[q], acc, 0, 0, 0);
    return acc;
}
__device__ __forceinline__ int crow(int reg, int h) { return (reg & 3) + 8 * (reg >> 2) + 4 * h; }
__device__ __forceinline__ void store_tr(const f32x16& acc, bf16* Ct, int ldct, int lane) {
    const int c = lane & 31, h = lane >> 5;
#pragma unroll
    for (int g = 0; g < 4; ++g) { uint2 w; w.x = cvtpk(acc[4 * g], acc[4 * g + 1]); w.y = cvtpk(acc[4 * g + 2], acc[4 * g + 3]); *(uint2*)(Ct + c * ldct + 8 * g + 4 * h) = w; }
}
__device__ __forceinline__ void store_rm(const f32x16& acc, bf16* C, int ldc, int lane) {
    const int c = lane & 31, h = lane >> 5;
#pragma unroll
    for (int rg = 0; rg < 16; ++rg) C[crow(rg, h) * ldc + c] = f2bf(acc[rg]);
}
__device__ __forceinline__ f32x16 zero16() { return (f32x16){0.f, 0.f, 0.f, 0.f, 0.f, 0.f, 0.f, 0.f, 0.f, 0.f, 0.f, 0.f, 0.f, 0.f, 0.f, 0.f}; }
__device__ __forceinline__ void store_frag16(const f32x16& acc, bf16* base, int t0, int t1, int lane) {
    const int cc = lane & 31, hh = lane >> 5, col = 32 * t1 + cc;
#pragma unroll
    for (int g = 0; g < 4; ++g) { const int row = 32 * t0 + 8 * g + 4 * hh;
        uint2 w; w.x = cvtpk(acc[4 * g], acc[4 * g + 1]); w.y = cvtpk(acc[4 * g + 2], acc[4 * g + 3]);
        *(uint2*)(base + (((row >> 4) * 4 + (col >> 4)) * 64 + (col & 15) + 16 * ((row & 15) >> 2)) * 4) = w; }
}
struct In { const bf16* proj; const bf16* LW; const bf16* AA; const float* mu; const float* k_k; const float* k_a; const float* r_k; float* RK; char* items; };

__device__ __forceinline__ void phase1(const int WID_, const In& I, char* lds) {
    const int wv = WID_;
#define MAT(off) ((bf16*)(lds + (off)))
    float* G = (float*)(lds + O_G); float* TOT = (float*)(lds + O_TOT); float* NMF = (float*)(lds + O_NMF);
    _Float16* CST = (_Float16*)(lds + O_TOT + 2048);
    { const int t0 = wv * 64 + lane_id();
      for (int i = t0; i < 1536; i += NT) CST[i] = (_Float16)I.mu[i];
      CST[1536 + t0] = (_Float16)I.k_k[t0]; CST[2048 + t0] = (_Float16)I.k_a[t0]; CST[2560 + t0] = (_Float16)I.r_k[t0]; }
    __syncthreads();
    uint4 nx_r, nx_k, nx_v, nx_qr, nx_qk, nx_qv, nx_a, nx_l;
#define P1_LOADS(itm) do { const int it_ = min((itm), NB * 8 * (S / 64) - 1); const int lane0 = lane_id(), tid0 = wv * 64 + lane0; \
        const int c_ = it_ & 127, h_ = (it_ >> 7) & 7, b_ = it_ >> 10, s_ = tid0 >> 3, cg_ = tid0 & 7, ch_ = h_ * 64 + cg_ * 8, t_ = c_ * 64 + s_; const size_t m_ = (size_t)b_ * S + t_; \
        const bf16* z = I.proj + m_ * DSHIFT + ch_; const bf16* zp = z - (t_ > 0 ? DSHIFT : 0); \
        nx_r = *(const uint4*)(z); nx_k = *(const uint4*)(z + 512); nx_v = *(const uint4*)(z + 1024); \
        nx_qr = *(const uint4*)(zp); nx_qk = *(const uint4*)(zp + 512); nx_qv = *(const uint4*)(zp + 1024); \
        nx_a = *(const uint4*)(I.AA + m_ * 512 + ch_); nx_l = *(const uint4*)(I.LW + m_ * 512 + ch_); } while (0)
#define P1_PIN(v) asm volatile("" : "+v"(v.x), "+v"(v.y), "+v"(v.z), "+v"(v.w))
    P1_LOADS(GB);
    P1_PIN(nx_r); P1_PIN(nx_k); P1_PIN(nx_v); P1_PIN(nx_qr); P1_PIN(nx_qk); P1_PIN(nx_qv); P1_PIN(nx_a); P1_PIN(nx_l);
    for (int item = GB; item < NB * 8 * (S / 64); item += GN) {
        const int lane = lane_id(), tid = wv * 64 + lane;
        const int c = item & 127, h = (item >> 7) & 7, b = item >> 10;
        char* out = I.items + (size_t)item * ITEM_BYTES;
        const int s = tid >> 3, cg = tid & 7, ch0 = h * 64 + cg * 8, t = c * 64 + s; const size_t m = (size_t)b * S + t;
        float r_[8], kp_[8], v_[8], kk_[8], b_[8];
        {
            const uint4 z4 = make_uint4(0, 0, 0, 0);
            const uint4 gr = nx_r, gk = nx_k, gv = nx_v, qr = t > 0 ? nx_qr : z4, qk = t > 0 ? nx_qk : z4, qv = t > 0 ? nx_qv : z4, ga = nx_a, gl = nx_l;
            typedef _Float16 h8_t __attribute__((ext_vector_type(8)));
            const h8_t c_mr = *(const h8_t*)(CST + ch0), c_mk = *(const h8_t*)(CST + 512 + ch0), c_mv = *(const h8_t*)(CST + 1024 + ch0), c_kk = *(const h8_t*)(CST + 1536 + ch0), c_ka = *(const h8_t*)(CST + 2048 + ch0), c_rk = *(const h8_t*)(CST + 2560 + ch0);
            float mur[8], muk[8], muv[8], ckk[8], cka[8], crk[8];
#pragma unroll
            for (int e = 0; e < 8; ++e) { mur[e] = (float)c_mr[e]; muk[e] = (float)c_mk[e]; muv[e] = (float)c_mv[e]; ckk[e] = (float)c_kk[e]; cka[e] = (float)c_ka[e]; crk[e] = (float)c_rk[e]; }
            const unsigned wr[4] = {gr.x, gr.y, gr.z, gr.w}, wk[4] = {gk.x, gk.y, gk.z, gk.w}, wv4[4] = {gv.x, gv.y, gv.z, gv.w};
            const unsigned pr[4] = {qr.x, qr.y, qr.z, qr.w}, pk[4] = {qk.x, qk.y, qk.z, qk.w}, pv[4] = {qv.x, qv.y, qv.z, qv.w};
            const unsigned wa[4] = {ga.x, ga.y, ga.z, ga.w}, wl[4] = {gl.x, gl.y, gl.z, gl.w};
            float ss = 0.f, rk = 0.f, a_[8];
#pragma unroll
            for (int e = 0; e < 8; ++e) { const int w_ = e >> 1; const bool hi = e & 1;
                auto ex = [&](unsigned u) { return hi ? __builtin_bit_cast(float, u & 0xffff0000u) : __builtin_bit_cast(float, u << 16); };
                float x = ex(wr[w_]); r_[e] = x + (ex(pr[w_]) - x) * mur[e];
                x = ex(wk[w_]); const float k = x + (ex(pk[w_]) - x) * muk[e];
                x = ex(wv4[w_]); v_[e] = x + (ex(pv[w_]) - x) * muv[e];
                a_[e] = ex(wa[w_]); kk_[e] = k * ckk[e]; ss += kk_[e] * kk_[e];
                kp_[e] = k * (1.f + (a_[e] - 1.f) * cka[e]); rk += r_[e] * kp_[e] * crk[e];
                G[s * 64 + cg * 8 + e] = ex(wl[w_]); }
            ss += dpp16<0xB1>(ss); ss += dpp16<0x4E>(ss); ss += dpp16<0x141>(ss);
            const float inv = 1.f / fmaxf(sqrtf(ss), 1e-12f);
#pragma unroll
            for (int e = 0; e < 8; ++e) { kk_[e] *= inv; b_[e] = kk_[e] * a_[e]; }
            rk += dpp16<0xB1>(rk); rk += dpp16<0x4E>(rk); rk += dpp16<0x141>(rk);
            if (cg == 0) I.RK[m * 8 + h] = rk;
        }
        CK_BAR();
        { const int ch = tid & 63, part = tid >> 6; float run = 0.f;
#pragma unroll
          for (int i = 0; i < 8; ++i) { run += G[(8 * part + i) * 64 + ch]; G[(8 * part + i) * 64 + ch] = run; }
          TOT[part * 64 + ch] = run; }
        CK_BAR();
        { const int ch = tid & 63, part = tid >> 6; float off = 0.f;
          for (int p = 0; p < part; ++p) off += TOT[p * 64 + ch];
#pragma unroll
          for (int i = 0; i < 8; ++i) G[(8 * part + i) * 64 + ch] += off; }
        CK_BAR();
        float glast[8];
        {
            unsigned pab[4], prb[4], pbb[4], pkb[4];
            float ab[8], rb[8], bb[8], kb[8], bt[8], kt[8];
            const float4 g0_ = *(const float4*)(G + s * 64 + cg * 8), g1_ = *(const float4*)(G + s * 64 + cg * 8 + 4);
            const int sm = (s > 0) ? s - 1 : 0; const float msk = (s > 0) ? 1.f : 0.f;
            const float4 m0_ = *(const float4*)(G + sm * 64 + cg * 8), m1_ = *(const float4*)(G + sm * 64 + cg * 8 + 4);
            const float4 l0_ = *(const float4*)(G + 63 * 64 + cg * 8), l1_ = *(const float4*)(G + 63 * 64 + cg * 8 + 4);
            const float gv_[8] = {g0_.x, g0_.y, g0_.z, g0_.w, g1_.x, g1_.y, g1_.z, g1_.w}, mv_[8] = {m0_.x, m0_.y, m0_.z, m0_.w, m1_.x, m1_.y, m1_.z, m1_.w}, lv_[8] = {l0_.x, l0_.y, l0_.z, l0_.w, l1_.x, l1_.y, l1_.z, l1_.w};
#pragma unroll
            for (int e = 0; e < 8; ++e) { const float g = gv_[e], gm1 = mv_[e] * msk, gL = lv_[e];
                glast[e] = gL;
                const float eg = __expf(g), eng = __expf(-g), egm = __expf(gm1), egl = __expf(gL - g);
                ab[e] = -kk_[e] * egm; rb[e] = r_[e] * eg; bb[e] = b_[e] * eng; kb[e] = kp_[e] * eng; bt[e] = b_[e] * egl; kt[e] = kp_[e] * egl; }
#pragma unroll
            for (int q = 0; q < 4; ++q) { pab[q] = pk2(ab[2 * q], ab[2 * q + 1]); prb[q] = pk2(rb[2 * q], rb[2 * q + 1]); pbb[q] = pk2(bb[2 * q], bb[2 * q + 1]); pkb[q] = pk2(kb[2 * q], kb[2 * q + 1]); }
            *(uint4*)(MAT(O_AB) + s * LD + cg * 8) = make_uint4(pab[0], pab[1], pab[2], pab[3]);
            *(uint4*)(MAT(O_RB) + s * LD + cg * 8) = make_uint4(prb[0], prb[1], prb[2], prb[3]);
            *(uint4*)(MAT(O_BB) + s * LD + cg * 8) = make_uint4(pbb[0], pbb[1], pbb[2], pbb[3]);
            *(uint4*)(MAT(O_KB) + s * LD + cg * 8) = make_uint4(pkb[0], pkb[1], pkb[2], pkb[3]);
#pragma unroll
            for (int e = 0; e < 8; ++e) { const int k = cg * 8 + e;
                MAT(O_AT)[k * LD + s] = f2bf(ab[e]); MAT(O_BT)[k * LD + s] = f2bf(bt[e]); MAT(O_KT)[k * LD + s] = f2bf(kt[e]); MAT(O_VT)[k * LD + s] = f2bf(v_[e]); }
        }
        CK_BAR();
        P1_LOADS(item + GN);
        if (s == 63) {
#pragma unroll
            for (int e = 0; e < 8; ++e) TOT[cg * 8 + e] = __expf(glast[e]);
        }
        {
            const int mat = tid >> 7, row = (tid >> 2) & 31, chunk = tid & 3;
            *(uint4*)(MAT(O_NM + mat * MB) + row * LD + 32 + chunk * 8) = make_uint4(0, 0, 0, 0);
        }
        for (int task = wv; task < 12; task += 8) {
            const int mat = task / 3, tt = task % 3, st = (tt == 0) ? 0 : 1, jt = (tt == 2) ? 1 : 0;
            const bf16* Asrc = MAT((mat & 1) ? O_KB : O_BB) + 32 * jt * LD;
            const bf16* Bsrc = MAT((mat >> 1) ? O_RB : O_AB) + 32 * st * LD;
            f32x16 acc = mm_tile<64>(zero16(), Asrc, LD, Bsrc, LD, lane);
            const int cs = 32 * st + (lane & 31), hh = lane >> 5; const bool incl = (mat >> 1) != 0;
#pragma unroll
            for (int rg = 0; rg < 16; ++rg) { const int j = 32 * jt + crow(rg, hh); const bool keep = incl ? (j <= cs) : (j < cs); if (!keep) acc[rg] = 0.f; }
            store_tr(acc, MAT(O_NM + mat * MB) + 32 * st * LD + 32 * jt, LD, lane);
            if (mat == 0 && st == jt) {
                float* d = NMF + st * 1024 + (lane & 31) * 32;
#pragma unroll
                for (int g = 0; g < 4; ++g) *(float4*)(d + 8 * g + 4 * hh) = make_float4(acc[4 * g], acc[4 * g + 1], acc[4 * g + 2], acc[4 * g + 3]);
            }
        }
        CK_BAR();
        if (wv == 0) {
            const int d = lane >> 4, cc = lane & 15;
            const float* nb = NMF + (d >> 1) * 1024 + (16 * (d & 1)) * 32 + 16 * (d & 1);
            float T[16];
#pragma unroll
            for (int i = 0; i < 16; ++i) {
                float acc = (i == cc) ? 1.f : 0.f;
#pragma unroll
                for (int j4 = 0; j4 < i; j4 += 4) { const float4 n4 = *(const float4*)(nb + i * 32 + j4);
                    acc += n4.x * T[j4]; if (j4 + 1 < i) acc += n4.y * T[j4 + 1]; if (j4 + 2 < i) acc += n4.z * T[j4 + 2]; if (j4 + 3 < i) acc += n4.w * T[j4 + 3]; }
                T[i] = acc;
            }
            bf16* tm = MAT(O_TM) + (16 * d) * LD + 16 * d + cc;
#pragma unroll
            for (int i = 0; i < 16; ++i) tm[i * LD] = f2bf(T[i]);
            bf16* tt = MAT(O_TT) + (d >> 1) * 32 * 40 + (16 * (d & 1) + cc) * 40 + 16 * (d & 1);
            *(uint4*)(tt) = make_uint4(pk2(T[0], T[1]), pk2(T[2], T[3]), pk2(T[4], T[5]), pk2(T[6], T[7]));
            *(uint4*)(tt + 8) = make_uint4(pk2(T[8], T[9]), pk2(T[10], T[11]), pk2(T[12], T[13]), pk2(T[14], T[15]));
            { const int blk = lane >> 5, r16 = (lane >> 1) & 15, hf = lane & 1;
              *(uint4*)(MAT(O_TM) + (32 * blk + r16) * LD + 32 * blk + 16 + 8 * hf) = make_uint4(0, 0, 0, 0);
              *(uint4*)(MAT(O_TT) + blk * 32 * 40 + (16 + r16) * 40 + 8 * hf) = make_uint4(0, 0, 0, 0); }
        } else if (wv == 1) {
            const int row = lane >> 1, half = lane & 1;
            *(uint4*)(MAT(O_TM) + row * LD + 32 + half * 16) = make_uint4(0, 0, 0, 0); *(uint4*)(MAT(O_TM) + row * LD + 32 + half * 16 + 8) = make_uint4(0, 0, 0, 0);
        } else if (wv >= 4) {
            const int st = (wv - 4) >> 1, vt = (wv - 4) & 1;
            f32x16 acc = mm_tile<64>(zero16(), MAT(O_AAK) + 32 * st * LD, LD, MAT(O_VT) + 32 * vt * LD, LD, lane);
            store_tr(acc, MAT(O_W1T) + 32 * vt * LD + 32 * st, LD, lane);
        }
        CK_BAR();
        if (wv < 2) {
            typedef float f32x4v __attribute__((ext_vector_type(4)));
            const int blk = wv, fr = lane & 15, fq = lane >> 4;
            const bf16x8 zf = (bf16x8){0, 0, 0, 0, 0, 0, 0, 0};
            bf16x8 a = zf, bq = zf;
            if (fq < 2) { a = *(const bf16x8*)(MAT(O_NM) + (32 * blk + 16 + fr) * LD + 32 * blk + 8 * fq); bq = *(const bf16x8*)(MAT(O_TT) + blk * 32 * 40 + fr * 40 + 8 * fq); }
            f32x4v z = __builtin_amdgcn_mfma_f32_16x16x32_bf16(a, bq, (f32x4v){0.f, 0.f, 0.f, 0.f}, 0, 0, 0);
            bf16* zt = MAT(O_ZT) + blk * 16 * 24;
            { uint2 w; w.x = cvtpk(z[0], z[1]); w.y = cvtpk(z[2], z[3]); *(uint2*)(zt + fr * 24 + 4 * fq) = w; }
            asm volatile("s_waitcnt lgkmcnt(0)" ::: "memory");
            a = zf; bq = zf;
            if (fq < 2) { a = *(const bf16x8*)(MAT(O_TM) + (32 * blk + 16 + fr) * LD + 32 * blk + 16 + 8 * fq); bq = *(const bf16x8*)(zt + fr * 24 + 8 * fq); }
            const f32x4v t21 = __builtin_amdgcn_mfma_f32_16x16x32_bf16(a, bq, (f32x4v){0.f, 0.f, 0.f, 0.f}, 0, 0, 0);
#pragma unroll
            for (int rg = 0; rg < 4; ++rg) MAT(O_TM)[(32 * blk + 16 + 4 * fq + rg) * LD + 32 * blk + fr] = f2bf(t21[rg]);
            { uint2 w; w.x = cvtpk(t21[0], t21[1]); w.y = cvtpk(t21[2], t21[3]); *(uint2*)(MAT(O_TT) + blk * 32 * 40 + fr * 40 + 16 + 4 * fq) = w; }
        }
        CK_BAR();
        if (wv == 0) { f32x16 acc = mm_tile<32>(zero16(), MAT(O_NM) + 32 * LD, LD, MAT(O_TT), 40, lane); store_tr(acc, MAT(O_ZT), 40, lane); }
        CK_BAR();
        if (wv == 0) { f32x16 acc = mm_tile<32>(zero16(), MAT(O_TM) + 32 * LD + 32, LD, MAT(O_ZT), 40, lane); store_rm(acc, MAT(O_TM) + 32 * LD, LD, lane); }
        CK_BAR();
        { const int st = wv >> 2, ct = wv & 3;
          f32x16 acc = mm_tile<64>(zero16(), MAT(O_TM) + 32 * st * LD, LD, MAT(O_AT) + 32 * ct * LD, LD, lane);
          CK_BAR();
          store_tr(acc, MAT(O_X1T) + 32 * ct * LD + 32 * st, LD, lane); }
        CK_BAR();
#pragma unroll
        for (int ti = 0; ti < 2; ++ti) {
            const int u = wv + 8 * ti;
            const int kind = u >> 2, t0 = (u >> 1) & 1, t1 = u & 1, hh = lane >> 5, cc = lane & 31;
            uint2 w[4]; bf16* dbase;
            if (kind < 2) {
                f32x16 acc = mm_tile<64>(zero16(), MAT(kind == 0 ? O_BT : O_ARB) + 32 * t0 * LD, LD, MAT(O_X1T) + (64 + 32 * t1) * LD, LD, lane);
                acc = mm_tile<64>(acc, MAT(kind == 0 ? O_KT : O_ARK) + 32 * t0 * LD, LD, MAT(O_VT) + 32 * t1 * LD, LD, lane);
                const int col = 32 * t1 + cc;
                dbase = (bf16*)(out + (kind == 0 ? 16384 : 24576)) + ((2 * t0 * 4 + (col >> 4)) * 64 + (col & 15) + 16 * hh) * 4;
#pragma unroll
                for (int g = 0; g < 4; ++g) { w[g].x = cvtpk(acc[4 * g], acc[4 * g + 1]); w[g].y = cvtpk(acc[4 * g + 2], acc[4 * g + 3]); }
            } else if (kind == 2) {
                f32x16 acc = mm_tile<64>(zero16(), MAT(O_X1T) + 32 * t0 * LD, LD, MAT(O_BT) + 32 * t1 * LD, LD, lane);
                const int k = 32 * t1 + cc; const float gl = TOT[k];
                dbase = (bf16*)out + k * 64 + 32 * t0 + 4 * hh;
#pragma unroll
                for (int g = 0; g < 4; ++g) { float x[4];
#pragma unroll
                    for (int e = 0; e < 4; ++e) { const int kp = 32 * t0 + 8 * g + 4 * hh + e; x[e] = acc[4 * g + e] + ((kp == k) ? gl : 0.f); }
                    w[g].x = cvtpk(x[0], x[1]); w[g].y = cvtpk(x[2], x[3]); }
            } else {
                f32x16 acc = mm_tile<64>(zero16(), MAT(O_X1T) + 32 * t0 * LD, LD, MAT(O_ARB) + 32 * t1 * LD, LD, lane);
                const int sq = 32 * t1 + cc;
                dbase = (bf16*)(out + 8192) + sq * 64 + 32 * t0 + 4 * hh;
                const bf16* rb = MAT(O_RB) + sq * LD + 32 * t0;
#pragma unroll
                for (int g = 0; g < 4; ++g) { const uint2 rr = *(const uint2*)(rb + 8 * g + 4 * hh);
                    const float x0 = acc[4 * g] + __builtin_bit_cast(float, rr.x << 16), x1 = acc[4 * g + 1] + __builtin_bit_cast(float, rr.x & 0xffff0000u);
                    const float x2 = acc[4 * g + 2] + __builtin_bit_cast(float, rr.y << 16), x3 = acc[4 * g + 3] + __builtin_bit_cast(float, rr.y & 0xffff0000u);
                    w[g].x = cvtpk(x0, x1); w[g].y = cvtpk(x2, x3); }
            }
            const bool frag = kind < 2;
            *(uint2*)(dbase + 0) = w[0];
            *(uint2*)(dbase + (frag ? 128 : 8)) = w[1];
            *(uint2*)(dbase + (frag ? 1024 : 16)) = w[2];
            *(uint2*)(dbase + (frag ? 1152 : 24)) = w[3];
        }
        CK_BAR();
    }
#undef MAT
}
typedef float f32x4w __attribute__((ext_vector_type(4)));
constexpr int P2_SLOT = 2 * 64 * LD * 2 + 4096;
__device__ __forceinline__ void phase2(const int WID_, const char* items, float* Y, char* lds) {
    const int wv = WID_;
    bf16* HT0 = (bf16*)lds; bf16* HT1 = HT0 + 16 * LD;
    char* SL = lds + 8192;
    for (int item = GB; item < NB * 8 * 4; item += GN) {
        const int lane = lane_id(), tid = wv * 64 + lane, fr = lane & 15, fq = lane >> 4;
        const int vq = (item >> 3) & 3, head = (item & 7) + 8 * (item >> 5), b = head >> 3, h = head & 7;
        for (int i = tid; i < 2 * 16 * LD / 8; i += NT) ((uint4*)lds)[i] = make_uint4(0, 0, 0, 0);
        const bool upd = wv < 4; const int rb = wv & 3;
        const char* rec0 = items + (size_t)(head * 128) * ITEM_BYTES;
        const size_t g_pq = (size_t)tid * 16;
        const int l_pq = (tid >> 3) * (LD * 2) + (tid & 7) * 16;
        const int piece = (tid >> 5) & 7;
        const size_t g_f = 16384 + (size_t)(piece >> 2) * 8192 + (((piece & 3) * 4 + vq) * 64) * 8 + (tid & 31) * 16;
        const int l_f = 2 * 64 * LD * 2 + piece * 512 + (tid & 31) * 16;
        float* yo = Y + ((size_t)b * S + 16 * rb + 4 * fq) * 512 + h * 64 + 16 * vq + fr;
        const int a_lds = (upd ? 0 : 64 * LD * 2) + (16 * rb + fr) * (LD * 2) + 16 * fq;
        const int c_lds = 2 * 64 * LD * 2 + ((upd ? 0 : 4) + rb) * 512 + lane * 8;
        uint4 rp0, rp1, rp2, rp3, rp4, rp5, rp6, rp7, rq0, rq1, rq2, rq3, rq4, rq5, rq6, rq7, rf0, rf1, rf2, rf3, rf4, rf5, rf6, rf7;
#define P2_LD(n, i) do { const char* rc_ = rec0 + (size_t)(i) * ITEM_BYTES; rp##n = *(const uint4*)(rc_ + g_pq); rq##n = *(const uint4*)(rc_ + 8192 + g_pq); rf##n = *(const uint4*)(rc_ + g_f); } while (0)
#define P2_ST(n, slot) do { char* s_ = SL + (slot) * P2_SLOT; *(uint4*)(s_ + l_pq) = rp##n; *(uint4*)(s_ + 64 * LD * 2 + l_pq) = rq##n; *(uint4*)(s_ + l_f) = rf##n; } while (0)
        P2_LD(0, 0); P2_LD(1, 1); P2_LD(2, 2); P2_LD(3, 3); P2_LD(4, 4); P2_LD(5, 5); P2_LD(6, 6); P2_LD(7, 7);
        P2_ST(0, 0); P2_LD(0, 8);
        CK_BAR();
#define P2_STEP(RN, cstep) do { const int c_ = (cstep); \
            const bf16* Hc = (c_ & 1) ? HT1 : HT0; bf16* Hn = (c_ & 1) ? HT0 : HT1; const char* sl_ = SL + (c_ & 1) * P2_SLOT; \
            const uint2 cv = *(const uint2*)(sl_ + c_lds); \
            f32x4w acc = (f32x4w){__builtin_bit_cast(float, cv.x << 16), __builtin_bit_cast(float, cv.x & 0xffff0000u), __builtin_bit_cast(float, cv.y << 16), __builtin_bit_cast(float, cv.y & 0xffff0000u)}; \
            const bf16x8 a0 = *(const bf16x8*)(sl_ + a_lds), a1 = *(const bf16x8*)(sl_ + a_lds + 64); \
            const bf16x8 b0 = *(const bf16x8*)(Hc + fr * LD + 8 * fq), b1 = *(const bf16x8*)(Hc + fr * LD + 32 + 8 * fq); \
            if (c_ + 1 < S / 64) P2_ST(RN, (c_ + 1) & 1); \
            if (c_ + 9 < S / 64) P2_LD(RN, c_ + 9); \
            acc = __builtin_amdgcn_mfma_f32_16x16x32_bf16(a0, b0, acc, 0, 0, 0); acc = __builtin_amdgcn_mfma_f32_16x16x32_bf16(a1, b1, acc, 0, 0, 0); \
            if (upd) { uint2 w; w.x = cvtpk(acc[0], acc[1]); w.y = cvtpk(acc[2], acc[3]); *(uint2*)(Hn + fr * LD + 16 * rb + 4 * fq) = w; } \
            else { float* y_ = yo + (size_t)c_ * 64 * 512; y_[0] = acc[0]; y_[512] = acc[1]; y_[1024] = acc[2]; y_[1536] = acc[3]; } \
            CK_BAR(); } while (0)
        for (int c = 0; c < S / 64; c += 8) {
            P2_STEP(1, c); P2_STEP(2, c + 1); P2_STEP(3, c + 2); P2_STEP(4, c + 3); P2_STEP(5, c + 4); P2_STEP(6, c + 5); P2_STEP(7, c + 6); P2_STEP(0, c + 7);
        }
#undef P2_STEP
#undef P2_LD
#undef P2_ST
    }
}
}

__device__ __forceinline__ void rwkv_post_ph(const int WID_, const float* __restrict__ Y, const float* __restrict__ RK, const bf16* __restrict__ proj, const float* __restrict__ mu, const bf16* __restrict__ G,
                             const float* __restrict__ lnw, const float* __restrict__ lnb, bf16* __restrict__ ymix) {
    const int lane = lane_id(), tk = WID_, grp = lane, ch0 = grp * 8, head = grp >> 3;
    const float4 mv0 = *(const float4*)(mu + 1024 + ch0), mv1 = *(const float4*)(mu + 1024 + ch0 + 4), lw0 = *(const float4*)(lnw + ch0), lw1 = *(const float4*)(lnw + ch0 + 4), lb0 = *(const float4*)(lnb + ch0), lb1 = *(const float4*)(lnb + ch0 + 4);
    const float muv[8] = {mv0.x, mv0.y, mv0.z, mv0.w, mv1.x, mv1.y, mv1.z, mv1.w}, lw_[8] = {lw0.x, lw0.y, lw0.z, lw0.w, lw1.x, lw1.y, lw1.z, lw1.w}, lb_[8] = {lb0.x, lb0.y, lb0.z, lb0.w, lb1.x, lb1.y, lb1.z, lb1.w};
    const int g_lo = GN == 256 ? (GB < 64 ? GB * 9 : 576 + ((GB - 64) * 3520) / 192) : (GB * (M / 16)) / GN;
    const int g_hi = GN == 256 ? (GB < 64 ? GB * 9 + 9 : 576 + ((GB - 63) * 3520) / 192) : ((GB + 1) * (M / 16)) / GN;
    for (int g = g_lo; g < g_hi; ++g) { const int m0 = g * 16 + tk;
        float4 ya[2], yb[2]; uint4 vv[2], pv[2], gg[2]; float rk[2];
#pragma unroll
        for (int u = 0; u < 2; ++u) { const int m = m0 + 8 * u;
            ya[u] = *(const float4*)(Y + (size_t)m * 512 + ch0); yb[u] = *(const float4*)(Y + (size_t)m * 512 + ch0 + 4);
            vv[u] = *(const uint4*)(proj + (size_t)m * DSHIFT + 1024 + ch0);
            pv[u] = (m & (S - 1)) ? *(const uint4*)(proj + (size_t)(m - 1) * DSHIFT + 1024 + ch0) : make_uint4(0, 0, 0, 0);
            gg[u] = *(const uint4*)(G + (size_t)m * 512 + ch0); rk[u] = RK[(size_t)m * 8 + head]; }
#pragma unroll
        for (int u = 0; u < 2; ++u) {
            const float y[8] = {ya[u].x, ya[u].y, ya[u].z, ya[u].w, yb[u].x, yb[u].y, yb[u].z, yb[u].w};
            float s = 0.f;
#pragma unroll
            for (int e = 0; e < 8; ++e) s += y[e];
            s += dpp16<0xB1>(s); s += dpp16<0x4E>(s); s += dpp16<0x141>(s);
            const float mean = s * (1.f / 64.f); float q = 0.f;
#pragma unroll
            for (int e = 0; e < 8; ++e) { const float d = y[e] - mean; q += d * d; }
            q += dpp16<0xB1>(q); q += dpp16<0x4E>(q); q += dpp16<0x141>(q);
            const float rstd = rsqrtf(q * (1.f / 64.f) + 64e-5f);
            const unsigned wv_[4] = {vv[u].x, vv[u].y, vv[u].z, vv[u].w}, wp_[4] = {pv[u].x, pv[u].y, pv[u].z, pv[u].w}, wg_[4] = {gg[u].x, gg[u].y, gg[u].z, gg[u].w};
            float o[8];
#pragma unroll
            for (int e = 0; e < 8; ++e) { const int w_ = e >> 1; const bool hi = e & 1;
                auto ex = [&](unsigned x) { return hi ? __builtin_bit_cast(float, x & 0xffff0000u) : __builtin_bit_cast(float, x << 16); };
                float v = ex(wv_[w_]); v += (ex(wp_[w_]) - v) * muv[e];
                o[e] = ((y[e] - mean) * rstd * lw_[e] + lb_[e] + rk[u] * v) * ex(wg_[w_]); }
            *(uint4*)(ymix + (size_t)(m0 + 8 * u) * D + ch0) = make_uint4(pk2(o[0], o[1]), pk2(o[2], o[3]), pk2(o[4], o[5]), pk2(o[6], o[7]));
        }
    }
}

constexpr int PSLOTS = NASSIGN + NEXP * 256;
constexpr int MAXTILES = PSLOTS / 256;
struct MoeBufs { int* tok_e; float* tok_g; int* tok_slot; int* slot_tok; float* slot_gate; int* bcnt; int* bbase; int* offs; int* tiles; int* ntiles; };
__device__ __forceinline__ void moe_zero_ph(const int WID_, const MoeBufs& mb) {
    for (int i = GB * NT + (WID_ * 64 + lane_id()); i < PSLOTS; i += GN * NT) { mb.slot_tok[i] = 0; mb.slot_gate[i] = 0.f; }
}
__device__ __forceinline__ void router_ph(const int WID_, const float* __restrict__ x3, const float* __restrict__ nw, bf16* __restrict__ h3, const float* __restrict__ wrg, const float* __restrict__ brg,
                          const float* __restrict__ wre, const float* __restrict__ bre, const MoeBufs& mb, char* lds, int tile) {
    const int lane = lane_id(), wv = WID_;
    int* lcnt = (int*)lds;
    _Float16* wg16 = (_Float16*)(lds + 256);
    _Float16* we16 = (_Float16*)(lds + 256 + 8192);
    float* bre_l = (float*)(lds + 128); float* brg_l = (float*)(lds + 256 + 8192 + 65536);
    if (wv == 0 && lane < 32) { lcnt[lane] = 0; bre_l[lane] = bre[lane]; if (lane < 4) brg_l[lane] = brg[lane]; }
    for (int i = wv * 64 + lane; i < 1024; i += NT) { const float4 w = *(const float4*)(wrg + i * 4);
        typedef _Float16 h4 __attribute__((ext_vector_type(4))); *(h4*)(wg16 + i * 4) = (h4){(_Float16)w.x, (_Float16)w.y, (_Float16)w.z, (_Float16)w.w}; }
    for (int i = wv * 64 + lane; i < 4 * 1024 * 2; i += NT) { const float4 w = *(const float4*)(wre + i * 4);
        typedef _Float16 h4 __attribute__((ext_vector_type(4))); *(h4*)(we16 + i * 4) = (h4){(_Float16)w.x, (_Float16)w.y, (_Float16)w.z, (_Float16)w.w}; }
    __syncthreads();
    typedef _Float16 h4 __attribute__((ext_vector_type(4)));
    typedef _Float16 h8 __attribute__((ext_vector_type(8)));
    float4 gw[4];
#pragma unroll
    for (int j = 0; j < 4; ++j) gw[j] = *(const float4*)(nw + (lane + 64 * j) * 4);
    float4 nx[4];
#pragma unroll
    for (int j = 0; j < 4; ++j) nx[j] = ((const float4*)(x3 + (size_t)(tile * 256 + wv) * D))[lane + 64 * j];
#pragma unroll
    for (int j = 0; j < 4; ++j) { pg8::pin4(gw[j]); pg8::pin4(nx[j]); }
    for (int m = tile * 256 + wv; m < tile * 256 + 256; m += 8) {
        float h[16]; float s = 0.f;
#pragma unroll
        for (int j = 0; j < 4; ++j) { const float4 v = nx[j]; h[4 * j] = v.x; h[4 * j + 1] = v.y; h[4 * j + 2] = v.z; h[4 * j + 3] = v.w; s += v.x * v.x + v.y * v.y + v.z * v.z + v.w * v.w; }
        { const int mn = min(m + 8, tile * 256 + 248 + wv); const float4* xr = (const float4*)(x3 + (size_t)mn * D);
#pragma unroll
          for (int j = 0; j < 4; ++j) nx[j] = xr[lane + 64 * j]; }
        s = wave_sum(s);
        const float rs = rsqrtf(s * (1.f / D) + 1e-6f);
        float l1[4] = {0.f, 0.f, 0.f, 0.f};
#pragma unroll
        for (int j = 0; j < 4; ++j) {
            const int k0 = (lane + 64 * j) * 4;
            const float4 g = gw[j];
            h[4 * j] *= rs * g.x; h[4 * j + 1] *= rs * g.y; h[4 * j + 2] *= rs * g.z; h[4 * j + 3] *= rs * g.w;
            uint2 o; o.x = pk2(h[4 * j], h[4 * j + 1]); o.y = pk2(h[4 * j + 2], h[4 * j + 3]);
            *(uint2*)(h3 + (size_t)m * D + k0) = o;
#pragma unroll
            for (int e = 0; e < 4; ++e) { const h4 w = *(const h4*)(wg16 + (k0 + e) * 4); const float x = h[4 * j + e];
                l1[0] += x * (float)w[0]; l1[1] += x * (float)w[1]; l1[2] += x * (float)w[2]; l1[3] += x * (float)w[3]; }
        }
#pragma unroll
        for (int i = 0; i < 4; ++i) l1[i] = wave_sum(l1[i]) + brg_l[i];
        int grp = 0; float best = l1[0];
#pragma unroll
        for (int i = 1; i < 4; ++i) if (l1[i] > best) { best = l1[i]; grp = i; }
        float se = 0.f;
#pragma unroll
        for (int i = 0; i < 4; ++i) se += __expf(l1[i] - best);
        const float g1 = 1.f / se;
        float l2[8] = {};
        const _Float16* we = we16 + (size_t)grp * D * 8;
#pragma unroll
        for (int j = 0; j < 4; ++j) {
            const int k0 = (lane + 64 * j) * 4;
#pragma unroll
            for (int e = 0; e < 4; ++e) { const float x = h[4 * j + e]; const h8 w = *(const h8*)(we + (k0 + e) * 8);
#pragma unroll
                for (int q = 0; q < 8; ++q) l2[q] += x * (float)w[q]; }
        }
#pragma unroll
        for (int i = 0; i < 8; ++i) l2[i] = wave_sum(l2[i]) + bre_l[grp * 8 + i];
        int i0 = 0; float v0 = l2[0];
#pragma unroll
        for (int i = 1; i < 8; ++i) if (l2[i] > v0) { v0 = l2[i]; i0 = i; }
        int i1 = -1; float v1 = -3.0e38f;
#pragma unroll
        for (int i = 0; i < 8; ++i) if (i != i0 && l2[i] > v1) { v1 = l2[i]; i1 = i; }
        const float e1 = __expf(v1 - v0), inv = 1.f / (1.f + e1);
        if (lane == 0) {
            const int ea = grp * 8 + i0, eb = grp * 8 + i1;
            mb.tok_e[2 * m] = ea; mb.tok_e[2 * m + 1] = eb;
            mb.tok_g[2 * m] = g1 * inv; mb.tok_g[2 * m + 1] = g1 * e1 * inv;
            atomicAdd(&lcnt[ea], 1); atomicAdd(&lcnt[eb], 1);
        }
    }
    __syncthreads();
    if (wv == 0 && lane < 32) mb.bcnt[tile * 32 + lane] = lcnt[lane];
    __syncthreads();
}
__device__ __forceinline__ void moe_plan_ph(const int WID_, const MoeBufs& mb, char* lds) {
    if (GB != 0) return;
    int* tot = (int*)lds; int* off = tot + 32;
    const int t = WID_ * 64 + lane_id();
    if (t < 32) { int run = 0; for (int b = 0; b < M / 256; ++b) { const int c = __hip_atomic_load(mb.bcnt + b * 32 + t, __ATOMIC_RELAXED, __HIP_MEMORY_SCOPE_AGENT); mb.bbase[b * 32 + t] = run; run += c; } tot[t] = run; }
    __syncthreads();
    if (t == 0) { int o = 0, nt = 0;
        for (int e = 0; e < NEXP; ++e) { off[e] = o; mb.offs[e] = o; const int c = tot[e]; for (int r0 = 0; r0 < c; r0 += 256) { mb.tiles[nt] = e; ++nt; } o += ((c + 255) / 256) * 256; }
        *mb.ntiles = nt; }
    __syncthreads();
}
__device__ __forceinline__ void moe_scatter_ph(const int WID_, const MoeBufs& mb, char* lds) {
    const int lane = lane_id(), wv = WID_;
    int* cur = (int*)lds;
    for (int tile = GB; tile < M / 256; tile += GN) {
        __syncthreads();
        if (wv == 0 && lane < 32) cur[lane] = __hip_atomic_load(mb.offs + lane, __ATOMIC_RELAXED, __HIP_MEMORY_SCOPE_AGENT) + __hip_atomic_load(mb.bbase + tile * 32 + lane, __ATOMIC_RELAXED, __HIP_MEMORY_SCOPE_AGENT);
        __syncthreads();
        const int a = tile * 512 + wv * 64 + lane; const int e = mb.tok_e[a];
        const int pos = atomicAdd(&cur[e], 1);
        mb.slot_tok[pos] = a >> 1; mb.slot_gate[pos] = mb.tok_g[a]; mb.tok_slot[a] = pos;
    }
    __syncthreads();
}
__device__ __forceinline__ void moe_weights_ph(const int WID_, const float* __restrict__ wg, const float* __restrict__ wu, const float* __restrict__ wd, bf16* __restrict__ wgu_t, bf16* __restrict__ wd_t, char* lds, int vb, int nvb) {
    const int lane = (WID_ * 64 + lane_id()) & 63, wv = (WID_ * 64 + lane_id()) >> 6;
    float* scr = (float*)(lds + wv * 16384);
    constexpr int I_GU = 16 * 16;
    constexpr int I_D = 8 * 32;
    constexpr int NIT = NEXP * (2 * I_GU + I_D);
    for (int it = vb * 8 + wv; it < NIT; it += nvb * 8) {
        const int e = it / (2 * I_GU + I_D); int r = it % (2 * I_GU + I_D);
        if (r < 2 * I_GU) {
            const int up = r / I_GU; r %= I_GU;
            const int kb = r / 16, nb = r % 16;
            const int pn = nb / 4, nsub = nb % 4;
            const float* W = (up ? wu : wg) + (size_t)e * D * DEXP + nb * 32;
            transpose_item(W + (size_t)kb * 64 * DEXP, 64, 32, wgu_t, D, e * 1024 + pn * 256 + up * 128 + nsub * 32, kb * 64, scr, 0, lane, nullptr, DEXP);
        } else {
            r -= 2 * I_GU;
            const int kb = r / 32, nb = r % 32;
            const float* W = wd + (size_t)e * DEXP * D + nb * 32;
            transpose_item(W + (size_t)kb * 64 * D, 64, 32, wd_t, DEXP, e * 1024 + nb * 32, kb * 64, scr, 0, lane, nullptr, D);
        }
    }
}
__device__ __forceinline__ void final_ph(const int WID_, float* __restrict__ out, const bf16* __restrict__ yslot, const int* __restrict__ tok_slot, const float* __restrict__ w) {
    const int lane = lane_id(), wv = WID_;
    float4 g[4];
#pragma unroll
    for (int j = 0; j < 4; ++j) g[j] = *(const float4*)(w + (lane + 64 * j) * 4);
    for (int row0 = (GB * 8 + wv) * 2; row0 < M; row0 += GN * 16) {
        float4 v[2][4]; uint2 ya[2][4], yb[2][4];
#pragma unroll
        for (int r = 0; r < 2; ++r) { const int row = row0 + r;
            const float4* xr = (const float4*)(out + (size_t)row * D);
            const uint2* pa = (const uint2*)(yslot + (size_t)tok_slot[2 * row] * D);
            const uint2* pb = (const uint2*)(yslot + (size_t)tok_slot[2 * row + 1] * D);
#pragma unroll
            for (int j = 0; j < 4; ++j) { v[r][j] = xr[lane + 64 * j]; ya[r][j] = pa[lane + 64 * j]; yb[r][j] = pb[lane + 64 * j]; } }
#pragma unroll
        for (int r = 0; r < 2; ++r) { float s = 0.f;
#pragma unroll
            for (int j = 0; j < 4; ++j) { const uint2 a = ya[r][j], b = yb[r][j];
                v[r][j].x += __builtin_bit_cast(float, a.x << 16) + __builtin_bit_cast(float, b.x << 16);
                v[r][j].y += __builtin_bit_cast(float, a.x & 0xffff0000u) + __builtin_bit_cast(float, b.x & 0xffff0000u);
                v[r][j].z += __builtin_bit_cast(float, a.y << 16) + __builtin_bit_cast(float, b.y << 16);
                v[r][j].w += __builtin_bit_cast(float, a.y & 0xffff0000u) + __builtin_bit_cast(float, b.y & 0xffff0000u);
                s += v[r][j].x * v[r][j].x + v[r][j].y * v[r][j].y + v[r][j].z * v[r][j].z + v[r][j].w * v[r][j].w; }
            s = wave_sum(s);
            const float rs = rsqrtf(s * (1.f / D) + 1e-6f);
            float4* xo = (float4*)(out + (size_t)(row0 + r) * D);
#pragma unroll
            for (int j = 0; j < 4; ++j) xo[lane + 64 * j] = make_float4(v[r][j].x * rs * g[j].x, v[r][j].y * rs * g[j].y, v[r][j].z * rs * g[j].z, v[r][j].w * rs * g[j].w); }
    }
}

struct S5Tab { float* Kmat; bf16* BtA; bf16* BtB; };
__device__ __forceinline__ void s5_lam(const float* lam_re, const float* lam_im, const float* log_dt, int g, int n, float& a, float& w) {
    const float dt = __expf(log_dt[g]); a = lam_re[g * 64 + n] * dt; w = lam_im[g * 64 + n] * dt;
}
__device__ __forceinline__ void cexpj(float a, float w, float j, float& re, float& im) { const float e = __expf(a * j); float s, c; sincosf(w * j, &s, &c); re = e * c; im = e * s; }
__device__ __forceinline__ void s5_bbar(const float* lam_re, const float* lam_im, const float* log_dt, const float* b_re, const float* b_im, int g, int n, int h, float& br, float& bi) {
    float a, w; s5_lam(lam_re, lam_im, log_dt, g, n, a, w);
    float lbr, lbi; cexpj(a, w, 1.f, lbr, lbi);
    const float lr = lam_re[g * 64 + n], li = lam_im[g * 64 + n];
    const float nr = lbr - 1.f, ni = lbi, den = lr * lr + li * li;
    const float cr = (nr * lr + ni * li) / den, ci = (ni * lr - nr * li) / den;
    const float xr = b_re[(g * 64 + n) * 16 + h], xi = b_im[(g * 64 + n) * 16 + h];
    br = cr * xr - ci * xi; bi = cr * xi + ci * xr;
}
__device__ __forceinline__ void s5_tables0_ph(const int WID_, const float* lam_re, const float* lam_im, const float* log_dt, const float* b_re, const float* b_im, const float* c_re, const float* c_im, const S5Tab& T, char* lds) {
    float* PWR = (float*)lds; float* PWI = PWR + 64 * 34;
    float* BBR = PWI + 64 * 34; float* BBI = BBR + 64 * 16;
    float* CCR = BBI + 64 * 16; float* CCI = CCR + 16 * 64;
    const int tid = WID_ * 64 + lane_id();
    for (int item = GB; item < 32 * 8; item += GN) {
        const int g = item & 31, part = item >> 5;
        __syncthreads();
        for (int i = tid; i < 64 * 34; i += NT) { const int n = i / 34, j = i % 34; float a, w; s5_lam(lam_re, lam_im, log_dt, g, n, a, w); float pr, pi; cexpj(a, w, (float)j, pr, pi); PWR[i] = pr; PWI[i] = pi; }
        for (int i = tid; i < 64 * 16; i += NT) { const int n = i >> 4, h = i & 15; float br, bi; s5_bbar(lam_re, lam_im, log_dt, b_re, b_im, g, n, h, br, bi); BBR[i] = br; BBI[i] = bi;
            const int hp = i >> 6, n2 = i & 63; CCR[i] = c_re[(g * 16 + hp) * 64 + n2]; CCI[i] = c_im[(g * 16 + hp) * 64 + n2]; }
        __syncthreads();
        for (int i = tid; i < 4 * 256; i += NT) { const int h = i & 15, hp = (i >> 4) & 15, j = 4 * part + (i >> 8);
            float acc = 0.f;
            for (int n = 0; n < 64; ++n) { const float pr = PWR[n * 34 + j], pi = PWI[n * 34 + j], br = BBR[n * 16 + h], bi = BBI[n * 16 + h];
                const float tr = pr * br - pi * bi, ti = pr * bi + pi * br; acc += CCR[hp * 64 + n] * tr - CCI[hp * 64 + n] * ti; }
            T.Kmat[((g * 32 + j) * 16 + hp) * 16 + h] = acc; }
        for (int i = tid; i < 32 * 512; i += NT) { const int col = i & 511, r = 32 * part + (i >> 9); float v = 0.f;
            if (r < 128) { const int n = r & 63, s = col >> 4, h = col & 15; const float pr = PWR[n * 34 + (S5L - 1 - s)], pi = PWI[n * 34 + (S5L - 1 - s)], br = BBR[n * 16 + h], bi = BBI[n * 16 + h];
                v = (r < 64) ? (pr * br - pi * bi) : (pr * bi + pi * br); }
            T.BtA[((size_t)g * 768 + 512 + r) * 512 + col] = f2bf(v); }
        for (int i = tid; i < 64 * 256; i += NT) { const int k = i & 255, row = 64 * part + (i >> 8); float v = 0.f;
            if (k < 128) { const int n = k & 63, sp = row >> 4, hp = row & 15; const float pr = PWR[n * 34 + sp + 1], pi = PWI[n * 34 + sp + 1], cr = CCR[hp * 64 + n], ci = CCI[hp * 64 + n];
                v = (k < 64) ? (cr * pr - ci * pi) : -(cr * pi + ci * pr); }
            T.BtB[((size_t)g * 512 + row) * 256 + k] = f2bf(v); }
    }
    __syncthreads();
}
__device__ __forceinline__ void s5_tables1_ph(const int WID_, const float* dsk, const S5Tab& T) {
    const int gtid = GB * NT + (WID_ * 64 + lane_id()), gsz = GN * NT;
    for (int i = gtid; i < 32 * 512 * 512; i += gsz) {
        const int col = i & 511, row = (i >> 9) & 511, g = i >> 18;
        const int sp = row >> 4, hp = row & 15, s = col >> 4, h = col & 15;
        float v = 0.f;
        if (s <= sp) v = T.Kmat[((g * 32 + (sp - s)) * 16 + hp) * 16 + h];
        if (row == col) v += dsk[g * 16 + hp];
        T.BtA[((size_t)g * 768 + row) * 512 + col] = f2bf(v);
    }
}
__device__ __forceinline__ void s5_carry_ph(const int WID_, const float* lam_re, const float* lam_im, const float* log_dt, const float* __restrict__ F, bf16* __restrict__ XST, int vb, int nvb, char* lds) {
    float* TR = (float*)lds; float* TI = TR + 16 * 32;
    for (int item = vb; item < NB * 32 * 2; item += nvb) {
        const int lane = lane_id(), tid = WID_ * 64 + lane;
        const int nh = item & 1, g = (item >> 1) & 31, b = item >> 6, seg = tid >> 5, n = nh * 32 + (tid & 31);
        float a, w; s5_lam(lam_re, lam_im, log_dt, g, n, a, w);
        float pr, pi; cexpj(a, w, (float)S5L, pr, pi);
        const size_t row0 = (size_t)g * S5R + (size_t)b * (S / S5L) + seg * 16;
        const float* f = F + row0 * 128; bf16* xo = XST + row0 * 256;
        float fr[16], fi[16];
#pragma unroll
        for (int q = 0; q < 16; ++q) { fr[q] = f[(size_t)q * 128 + n]; fi[q] = f[(size_t)q * 128 + 64 + n]; }
#pragma unroll
        for (int q = 0; q < 16; ++q) if (nh == 0) *(uint2*)(xo + (size_t)q * 256 + 128 + (tid & 31) * 4) = make_uint2(0, 0);
        float xr = 0.f, xi = 0.f;
#pragma unroll
        for (int q = 0; q < 16; ++q) { const float nr = pr * xr - pi * xi + fr[q], ni = pr * xi + pi * xr + fi[q]; xr = nr; xi = ni; fr[q] = nr; fi[q] = ni; }
        TR[seg * 32 + (tid & 31)] = xr; TI[seg * 32 + (tid & 31)] = xi;
        __syncthreads();
        float p16r, p16i; cexpj(a, w, (float)(S5L * 16), p16r, p16i);
        float cr = 0.f, ci = 0.f;
        for (int s2 = 0; s2 < seg; ++s2) { const float tr = TR[s2 * 32 + (tid & 31)], ti = TI[s2 * 32 + (tid & 31)];
            const float nr = p16r * cr - p16i * ci + tr, ni = p16r * ci + p16i * cr + ti; cr = nr; ci = ni; }
        float er = cr, ei = ci;
#pragma unroll
        for (int q = 0; q < 16; ++q) {
            const float lr_ = (q > 0) ? fr[q - 1] : 0.f, li_ = (q > 0) ? fi[q - 1] : 0.f;
            xo[(size_t)q * 256 + n] = f2bf(er + lr_); xo[(size_t)q * 256 + 64 + n] = f2bf(ei + li_);
            const float nr = pr * er - pi * ei, ni = pr * ei + pi * er; er = nr; ei = ni;
        }
        __syncthreads();
    }
}
#define XB_TMO      128
#define XB_XCNT(j)  (256  + 64 * (j))
#define XB_XSUB(j)  (1280 + 64 * (j))
#define XB_XGEN(j)  (2304 + 64 * (j))
#define XB_TOP      3328
#define XB_TOPGEN   3392
#define XCD_BAR_WORDS 3456
#define XB_SPIN_CAP (1u << 20)
__device__ __forceinline__ unsigned xb_ld(unsigned* p)              { return __hip_atomic_load(p, __ATOMIC_RELAXED, __HIP_MEMORY_SCOPE_AGENT); }
__device__ __forceinline__ unsigned xb_add(unsigned* p, unsigned v) { return __hip_atomic_fetch_add(p, v, __ATOMIC_RELAXED, __HIP_MEMORY_SCOPE_AGENT); }
__device__ __forceinline__ unsigned xb_xcc_id() { return (unsigned)__builtin_amdgcn_s_getreg((3 << 11) | 20) & 0xFu; }
#define XB_SPIN(cond, bar) do { unsigned _sp = 0; while (cond) { __builtin_amdgcn_s_sleep(1); \
    if ((++_sp & 255u) == 0u) { if (xb_ld(&(bar)[XB_TMO])) break; if (_sp > XB_SPIN_CAP) { atomicAdd(&(bar)[XB_TMO], 1u); break; } } } } while (0)
struct XcdBarrier { unsigned* bar; unsigned x; volatile __attribute__((address_space(3))) unsigned* st; };
__device__ __forceinline__ XcdBarrier xcd_barrier_post(const int WID_, unsigned* bar, volatile __attribute__((address_space(3))) unsigned* st) {
    XcdBarrier b; b.bar = bar; b.x = xb_xcc_id(); b.st = st;
    if ((WID_ * 64 + lane_id()) == 0) (void)xb_add(&bar[XB_XCNT(b.x)], 1u);
    return b;
}
__device__ __forceinline__ void xcd_barrier_complete(unsigned* bar, unsigned x, unsigned& nloc, unsigned& nx) {
    const unsigned G = gridDim.x * gridDim.y * gridDim.z;
    unsigned sum, cnt, mine, sp = 0u;
    for (;;) {
        sum = 0u; cnt = 0u; mine = 0u;
#pragma unroll
        for (unsigned j = 0; j < 16; ++j) { const unsigned c = xb_ld(&bar[XB_XCNT(j)]); sum += c; cnt += (c > 0u) ? 1u : 0u; mine = (j == x) ? c : mine; }
        if (sum == G) break;
        __builtin_amdgcn_s_sleep(1);
        if ((++sp & 255u) == 0u) { if (xb_ld(&bar[XB_TMO])) break; if (sp > XB_SPIN_CAP) { atomicAdd(&bar[XB_TMO], 1u); break; } }
    }
    nloc = mine > 0u ? mine : 1u; nx = cnt > 0u ? cnt : 1u;
}
__device__ __forceinline__ void xcd_barrier(const int WID_, const XcdBarrier& b) {
    asm volatile("s_waitcnt vmcnt(0)" ::: "memory");
    __syncthreads();
    if ((WID_ * 64 + lane_id()) == 0) {
        unsigned* bar = b.bar;
        __builtin_amdgcn_s_waitcnt(0);
        unsigned nloc = b.st[0], nx = b.st[1];
        if (nloc == 0u) { xcd_barrier_complete(bar, b.x, nloc, nx); b.st[0] = nloc; b.st[1] = nx; }
        const unsigned old = xb_add(&bar[XB_XSUB(b.x)], 1u);
        const unsigned gen = old / nloc;
        if (old + 1u == (gen + 1u) * nloc) {
            __builtin_amdgcn_fence(__ATOMIC_RELEASE, "agent");
            asm volatile("s_waitcnt vmcnt(0)" ::: "memory");
            const unsigned og = xb_add(&bar[XB_TOP], 1u);
            const unsigned tg = og / nx;
            if (og + 1u == (tg + 1u) * nx) xb_add(&bar[XB_TOPGEN], 1u);
            else XB_SPIN(xb_ld(&bar[XB_TOPGEN]) == tg, bar);
            __builtin_amdgcn_fence(__ATOMIC_ACQUIRE, "agent");
            xb_add(&bar[XB_XGEN(b.x)], 1u);
            asm volatile("s_waitcnt vmcnt(0)" ::: "memory");
        } else {
            XB_SPIN(xb_ld(&bar[XB_XGEN(b.x)]) == gen, bar);
            __builtin_amdgcn_fence(__ATOMIC_ACQUIRE, "agent");
            asm volatile("s_waitcnt vmcnt(0)" ::: "memory");
        }
    }
    __syncthreads();
}

struct Params { const float* in[41]; float* out; char* ws; };

constexpr size_t W_PROJ = 0;
constexpr size_t W_US5 = 224;
constexpr size_t W_WTS = 288;
constexpr size_t W_YI = 352;
constexpr size_t W_F = 416;
constexpr size_t W_XST = 448;
constexpr size_t W_Z = 480;
constexpr size_t W_MISC = 544;
constexpr size_t W_XN = 576;
constexpr size_t W_CTL = 558;
constexpr size_t WO_IN = 0, WO_GLU = 5 * MiB, WO_MIX = 6 * MiB, WO_Q = 8 * MiB, WO_K = 10 * MiB, WO_V = 12 * MiB, WO_O = 14 * MiB, WO_KMAT = 16 * MiB, WO_BTA = 17 * MiB, WO_BTB = 41 * MiB;

__global__ void __launch_bounds__(NT, 2) fwd_kernel(Params p) {
    extern __shared__ __attribute__((aligned(16))) char lds[];
    const int WID_ = __builtin_amdgcn_readfirstlane((int)(threadIdx.x >> 6));
    cg::grid_group grid = cg::this_grid();
    PG8_LAS unsigned char* ldsl = (PG8_LAS unsigned char*)lds;
    char* ws = p.ws; char* dout = (char*)p.out; float* out = p.out;
#define IN(i) (p.in[i])
    volatile __attribute__((address_space(3))) unsigned* bst = (volatile __attribute__((address_space(3))) unsigned*)(ldsl + LDS_BYTES - 64);
    if (WID_ == 0 && lane_id() < 2) bst[lane_id()] = 0u;
    __syncthreads();
    const XcdBarrier xbar = xcd_barrier_post(WID_, (unsigned*)(ws + W_CTL * MiB), bst);
#ifndef PROBE_PHASE
#define PROBE_PHASE -1
#endif
    int sync_id = 0; unsigned long long pr_t0 = 0, pr_t1 = 0;
    if (PROBE_PHASE == 0) pr_t0 = __builtin_amdgcn_s_memrealtime();
#define SYNC() do { xcd_barrier(WID_, xbar); ++sync_id; if (sync_id == PROBE_PHASE) pr_t0 = __builtin_amdgcn_s_memrealtime(); if (sync_id == PROBE_PHASE + 1) pr_t1 = __builtin_amdgcn_s_memrealtime(); } while (0)
    char* WT = ws + W_WTS * MiB;
    bf16* w_in_t = (bf16*)(WT + WO_IN); bf16* w_glu_t = (bf16*)(WT + WO_GLU); bf16* w_mix_t = (bf16*)(WT + WO_MIX);
    bf16* w_q_t = (bf16*)(WT + WO_Q); bf16* w_k_t = (bf16*)(WT + WO_K); bf16* w_v_t = (bf16*)(WT + WO_V); bf16* w_o_t = (bf16*)(WT + WO_O);
    S5Tab stab; stab.Kmat = (float*)(WT + WO_KMAT); stab.BtA = (bf16*)(WT + WO_BTA); stab.BtB = (bf16*)(WT + WO_BTB);
    bf16* PROJ = (bf16*)(ws + W_PROJ * MiB); bf16* US5 = (bf16*)(ws + W_US5 * MiB);
    bf16* XN = (bf16*)(ws + W_XN * MiB);
    transpose_ph(WID_, IN(3), D, DIN, w_in_t, D, 0, 0, lds);
    transpose_ph(WID_, IN(23), 512, 512, w_glu_t, 512, 0, 0, lds);
    transpose_ph(WID_, IN(25), D, D, w_mix_t, D, 0, 0, lds);
    transpose_ph(WID_, IN(28), D, D, w_q_t, D, 0, 0, lds, IN(26));
    transpose_ph(WID_, IN(29), D, D, w_k_t, D, 0, 0, lds);
    transpose_ph(WID_, IN(30), D, D, w_v_t, D, 0, 0, lds);
    transpose_ph(WID_, IN(31), D, D, w_o_t, D, 0, 0, lds);
    s5_tables0_ph(WID_, IN(15), IN(16), IN(17), IN(18), IN(19), IN(20), IN(21), stab, lds);
    bf16* wl_t = (bf16*)(WT + 49 * MiB);
    rwkv_wl_ph(WID_, IN(6), IN(8), IN(9), wl_t);
    rmsnorm_ph<bf16>(WID_, IN(0), IN(2), XN, M);
    bf16* MEMN = (bf16*)(ws + (W_MISC + 10) * MiB);
    rmsnorm_ph<bf16>(WID_, IN(1), IN(27), MEMN, NB * NMEM);
    grid.sync(); ++sync_id; if (sync_id == PROBE_PHASE) pr_t0 = __builtin_amdgcn_s_memrealtime(); if (sync_id == PROBE_PHASE + 1) pr_t1 = __builtin_amdgcn_s_memrealtime();
    s5_tables1_ph(WID_, IN(22), stab);
    { pg8::PlainOrder S; S.init(XN, D, w_in_t, D, M, DIN, D); pg8::EpiProj E{PROJ, US5}; pg8::gemm_phase(WID_, ldsl, S, E); }
    SYNC();
    bf16* LIN = (bf16*)(ws + (W_MISC + 16) * MiB);
    rwkv_lin_ph(WID_, PROJ, IN(4), LIN);
    SYNC();
    bf16* YI = (bf16*)(ws + W_YI * MiB); float* F = (float*)(ws + W_F * MiB); bf16* XST = (bf16*)(ws + W_XST * MiB); bf16* Z = (bf16*)(ws + W_Z * MiB);
    bf16* LWb = (bf16*)(ws + 704 * MiB); bf16* AAb = (bf16*)(ws + 768 * MiB); bf16* Gb = (bf16*)(ws + 832 * MiB);
    float* Yr = (float*)(ws + 896 * MiB); float* RKb = (float*)(ws + W_MISC * MiB);
    { pg8::GroupOrder S; S.init(US5, 512, (size_t)S5R * 512, stab.BtA, 512, (size_t)768 * 512, 32, S5R, 768, 512); pg8::EpiS5a E{YI, F}; pg8::gemm_phase(WID_, ldsl, S, E); }
    { pg8::PlainOrder S; S.init(LIN, 256, wl_t, 256, M, 1536, 256); pg8::EpiLora E{LWb, (size_t)32 * MiB, IN(5), IN(7)}; pg8::gemm_phase(WID_, ldsl, S, E); }
    SYNC();
    { ck::In ci{PROJ, LWb, AAb, IN(4), IN(10), IN(11), IN(12), RKb, dout}; ck::phase1(WID_, ci, lds); }
    SYNC();
    bf16* WGU_t = (bf16*)(ws + 704 * MiB); bf16* WD_t = (bf16*)(ws + 768 * MiB);
    ck::phase2(WID_, dout, Yr, lds);
    __syncthreads();
    s5_carry_ph(WID_, IN(15), IN(16), IN(17), F, XST, GB, GN, lds);
    moe_weights_ph(WID_, IN(37), IN(38), IN(39), WGU_t, WD_t, lds, GB, GN);
    SYNC();
    bf16* YMIX = XN;
    bf16* KM = (bf16*)(ws + (W_MISC + 2) * MiB); bf16* VT = (bf16*)(ws + (W_MISC + 6) * MiB);
    { pg8::GroupOrder S; S.init(XST, 256, (size_t)S5R * 256, stab.BtB, 256, (size_t)512 * 256, 32, S5R, 512, 256); pg8::EpiS5b E{YI, Z}; pg8::gemm_phase(WID_, ldsl, S, E); }
    { pg8::PlainOrder S; S.init(MEMN, D, w_k_t, D, NB * NMEM, D, D); pg8::EpiBf16 E{KM, D}; pg8::gemm_phase(WID_, ldsl, S, E); }
    { pg8::PlainOrder S; S.init(w_v_t, D, MEMN, D, D, NB * NMEM, D, 32); pg8::EpiBf16 E{VT, NB * NMEM}; pg8::gemm_phase(WID_, ldsl, S, E); }
    rwkv_post_ph(WID_, Yr, RKb, PROJ, IN(4), Gb, IN(13), IN(14), YMIX);
    SYNC();
    bf16* X2b = (bf16*)(ws + 0);
    PG8_LAS float* ssq = (PG8_LAS float*)(ldsl + 131072 + 8192);
    bf16* Q = (bf16*)(ws + 128 * MiB);
    bf16* P = (bf16*)(ws + W_YI * MiB);
    bf16* O = (bf16*)(ws + 800 * MiB);
    bf16* H3 = XN;
    bf16* HID = (bf16*)(ws + 368 * MiB);
    bf16* YSLOT = (bf16*)(ws + 0);
#define MKMB(mb) MoeBufs mb; { char* mbase = p.ws + 976 * MiB; \
    mb.tok_e = (int*)(mbase); mb.tok_g = (float*)(mbase + 1 * MiB); mb.tok_slot = (int*)(mbase + 2 * MiB); mb.slot_tok = (int*)(mbase + 3 * MiB); \
    mb.slot_gate = (float*)(mbase + 4 * MiB); mb.bcnt = (int*)(mbase + 5 * MiB); mb.bbase = mb.bcnt + 16384; mb.offs = mb.bcnt + 32768; mb.ntiles = mb.offs + 64; \
    mb.tiles = (int*)(mbase + 6 * MiB); }
    { MKMB(mb); moe_zero_ph(WID_, mb); }
#define BLK_SYNC() do { asm volatile("s_waitcnt vmcnt(0)" ::: "memory"); __syncthreads(); \
        if (WID_ == 0 && lane_id() == 0) { __builtin_amdgcn_fence(__ATOMIC_ACQUIRE, "agent"); asm volatile("s_waitcnt vmcnt(0)" ::: "memory"); } __syncthreads(); } while (0)
    for (int tl = GB; tl < M / 256; tl += GN) {
        for (int i = WID_ * 64 + lane_id(); i < 1024; i += NT) ssq[i] = 0.f;
        { pg8::TileOrder S; S.init(Z, 512, w_glu_t, 512, 512, 2, tl); pg8::EpiGlu E{Z, IN(24), YMIX}; pg8::gemm_phase(WID_, ldsl, S, E); }
        BLK_SYNC();
        { pg8::TileOrder S; S.init(YMIX, D, w_mix_t, D, D, 4, tl); pg8::EpiMixRes E{X2b, IN(0), ssq}; pg8::gemm_phase(WID_, ldsl, S, E); }
        BLK_SYNC();
        { pg8::TileOrder S; S.init(X2b, D, w_q_t, D, D, 4, tl); pg8::EpiRowScale E{Q, ssq}; pg8::gemm_phase(WID_, ldsl, S, E); }
        BLK_SYNC();
        { pg8::AttnTileOrder S; S.init(Q, KM, D, 0, tl); pg8::EpiSoftmax E{P, (PG8_LAS float*)(ldsl + 131072)}; pg8::gemm_phase(WID_, ldsl, S, E); }
        BLK_SYNC();
        { pg8::AttnTileOrder S; S.init(P, VT, NB * NMEM, 1, tl); pg8::EpiAttnO E{O}; pg8::gemm_phase(WID_, ldsl, S, E); }
        BLK_SYNC();
        { pg8::TileOrder S; S.init(O, D, w_o_t, D, D, 4, tl); pg8::EpiResBf16 E{out, X2b}; pg8::gemm_phase(WID_, ldsl, S, E); }
        BLK_SYNC();
        { MKMB(mb); router_ph(WID_, p.out, IN(32), (bf16*)(p.ws + W_XN * MiB), IN(33), IN(34), IN(35), IN(36), mb, lds, tl); }
    }
    SYNC();
    { MKMB(mb); moe_plan_ph(WID_, mb, lds); }
    SYNC();
    { MKMB(mb); moe_scatter_ph(WID_, mb, lds); }
    MKMB(mb);
    SYNC();
    const int ntiles = __hip_atomic_load(mb.ntiles, __ATOMIC_RELAXED, __HIP_MEMORY_SCOPE_AGENT);
    { pg8::MoeOrderT<true> S; S.init(H3, D, WGU_t, D, D, mb.tiles, ntiles, 1024, mb.slot_tok); pg8::EpiSilu E{HID}; pg8::gemm_phase(WID_, ldsl, S, E); }
    SYNC();
    { pg8::MoeOrderT<false> S; S.init(HID, DEXP, WD_t, DEXP, DEXP, mb.tiles, ntiles, 1024, nullptr); pg8::EpiGate E{YSLOT, mb.slot_gate}; pg8::gemm_phase(WID_, ldsl, S, E); }
    SYNC();
    final_ph(WID_, out, YSLOT, mb.tok_slot, IN(40));
    if (PROBE_PHASE >= 0) {
        if (pr_t1 == 0) pr_t1 = __builtin_amdgcn_s_memrealtime();
        if (GB == 0) { const unsigned long long t_end = __builtin_amdgcn_s_memrealtime(), wait = 8ull * (pr_t1 - pr_t0);
            while (__builtin_amdgcn_s_memrealtime() - t_end < wait) __builtin_amdgcn_s_sleep(8); }
    }
}
}

extern "C" void kernel_launch(void* const* d_in, const int* in_sizes, int n_in, void* d_out, int out_size, void* d_ws, size_t ws_size, hipStream_t stream) {
    (void)in_sizes; (void)out_size; (void)ws_size;
    static int grid = 0;
    if (grid == 0) {
        int dev = 0, cus = 0, per_cu = 0;
        hipGetDevice(&dev);
        hipDeviceGetAttribute(&cus, hipDeviceAttributeMultiprocessorCount, dev);
        hipFuncSetAttribute((const void*)fwd_kernel, hipFuncAttributeMaxDynamicSharedMemorySize, LDS_BYTES);
        hipOccupancyMaxActiveBlocksPerMultiprocessor(&per_cu, (const void*)fwd_kernel, NT, LDS_BYTES);
        if (per_cu < 1) { fprintf(stderr, "occupancy query says %d blocks/CU\n", per_cu); per_cu = 1; }
        grid = cus * 1;
    }
    (void)hipMemsetAsync((char*)d_ws + W_CTL * MiB, 0, 16384, stream);
    Params p{};
    for (int i = 0; i < 41 && i < n_in; ++i) p.in[i] = (const float*)d_in[i];
    p.out = (float*)d_out; p.ws = (char*)d_ws;
    void* args[] = {&p};
    hipError_t e = hipLaunchCooperativeKernel((const void*)fwd_kernel, dim3(grid), dim3(NT), args, LDS_BYTES, stream);
    if (e != hipSuccess) fprintf(stderr, "cooperative launch failed: %s (grid %d)\n", hipGetErrorString(e), grid);
}
```
